# Optimizing an MI355X kernel written in HIP

```python
import jax, jax.numpy as jnp
from jax import lax
import numpy as np

D_MODEL = 2048
BATCH = 1
SEQ = 16384
DEPTH = 1

CHUNK = 64
D_MIX = D_MODEL
D_RWKV = D_MIX // 2
RWKV_HEAD = 64
RWKV_HEADS = D_RWKV // RWKV_HEAD
D_CONV = D_MIX - D_RWKV
CONV_WIDTH = 3
D_IN = 3 * D_RWKV + 3 * D_CONV
LORA_DECAY = 64
LORA_AAA = 64
LORA_GATE = 160
GN_EPS = 64e-5
RMS_EPS = 1e-6
PEER_HEADS = 8
PEER_NKEYS = 128
PEER_EXPERTS = PEER_NKEYS * PEER_NKEYS
PEER_QDIM = 512
PEER_HALF = PEER_QDIM // 2
PEER_TOPK = 16
PEER_BLOCK = 128

kernel_name = "hymba_rwkv7_shortconv_peer_block"


def rms_norm(x, gain):
    xf = x.astype(jnp.float32)
    y = xf * lax.rsqrt(jnp.mean(xf * xf, axis=-1, keepdims=True) + RMS_EPS)
    return (y * gain.astype(jnp.float32)).astype(x.dtype)


def token_shift(t):
    return jnp.pad(t, ((0, 0), (1, 0), (0, 0)))[:, :-1]


def rwkv7_scan(r, w, k, v, kk, a):
    B, S, H, N = r.shape
    nc = S // CHUNK

    def to_chunks(t):
        return jnp.moveaxis(t.reshape(B, nc, CHUNK, H, N), (1, 2), (0, 1))

    def step(state, inp):
        r_t, w_t, k_t, v_t, kk_t, a_t = inp
        sa = jnp.einsum('bhvk,bhk->bhv', state, -kk_t)
        state = (state * w_t[:, :, None, :]
                 + sa[..., None] * (kk_t * a_t)[:, :, None, :]
                 + v_t[..., None] * k_t[:, :, None, :])
        y_t = jnp.einsum('bhvk,bhk->bhv', state, r_t)
        return state, y_t

    def chunk_step(state, chunk_inp):
        return lax.scan(step, state, chunk_inp)

    state0 = jnp.zeros((B, H, N, N), jnp.float32)
    _, y = lax.scan(chunk_step, state0, tuple(to_chunks(t) for t in (r, w, k, v, kk, a)))
    return jnp.moveaxis(y, (0, 1), (1, 2)).reshape(B, S, H, N)


def causal_depthwise_conv(u, conv_w):
    S = u.shape[1]
    up = jnp.pad(u, ((0, 0), (CONV_WIDTH - 1, 0), (0, 0)))
    out = up[:, 0:S] * conv_w[0]
    for j in range(1, CONV_WIDTH):
        out = out + up[:, j:j + S] * conv_w[j]
    return out


def peer_ffn(h, wq, keys, u_tab, v_tab):
    B, S, D = h.shape
    q = (h @ wq).reshape(B, S, PEER_HEADS, 2, PEER_HALF)
    s = jnp.einsum('bshcd,hcnd->bshcn', q, keys).astype(jnp.float32)
    top_s, top_i = lax.top_k(s, PEER_TOPK)
    cand = top_s[..., 0, :, None] + top_s[..., 1, None, :]
    cand_s, cand_i = lax.top_k(cand.reshape(B, S, PEER_HEADS, PEER_TOPK * PEER_TOPK), PEER_TOPK)
    e1 = jnp.take_along_axis(top_i[..., 0, :], cand_i // PEER_TOPK, axis=-1)
    e2 = jnp.take_along_axis(top_i[..., 1, :], cand_i % PEER_TOPK, axis=-1)
    expert = e1 * PEER_NKEYS + e2
    gates = jax.nn.softmax(cand_s, axis=-1).astype(h.dtype)

    T = B * S
    nb = T // PEER_BLOCK
    hk = PEER_HEADS * PEER_TOPK
    xb = h.reshape(nb, PEER_BLOCK, D)
    ib = expert.reshape(nb, PEER_BLOCK, hk)
    gb = gates.reshape(nb, PEER_BLOCK, hk)

    def block(args):
        xt, it, gt = args
        u = jnp.take(u_tab, it, axis=0)
        act = jax.nn.gelu(jnp.einsum('pd,pkd->pk', xt, u)) * gt
        vv = jnp.take(v_tab, it, axis=0)
        return jnp.einsum('pk,pkd->pd', act, vv)

    out = lax.map(block, (xb, ib, gb))
    return out.reshape(B, S, D)


def setup_inputs(seed: int = 0) -> dict:
    key = jax.random.key(seed)
    ks = jax.random.split(key, 32)
    f32 = jnp.float32
    L, D = DEPTH, D_MODEL

    def nrm(k, shape, scale):
        return jax.random.normal(k, shape, f32) * scale

    x = jax.random.normal(ks[0], (BATCH, SEQ, D), f32)
    norm_mix = 1.0 + nrm(ks[1], (L, D), 0.02)
    w_in = nrm(ks[2], (L, D, D_IN), D ** -0.5)
    mu_rkv = jax.random.uniform(ks[3], (L, 3 * D_RWKV), f32)
    mu_lora = jax.random.uniform(ks[4], (L, 3, D), f32)
    w0 = -3.0 + nrm(ks[5], (L, D_RWKV), 1.0)
    w1 = nrm(ks[6], (L, D, LORA_DECAY), D ** -0.5)
    w2 = nrm(ks[7], (L, LORA_DECAY, D_RWKV), 0.5 * LORA_DECAY ** -0.5)
    a0 = nrm(ks[8], (L, D_RWKV), 0.5)
    a1 = nrm(ks[9], (L, D, LORA_AAA), D ** -0.5)
    a2 = nrm(ks[10], (L, LORA_AAA, D_RWKV), 0.5 * LORA_AAA ** -0.5)
    g1 = nrm(ks[11], (L, D, LORA_GATE), D ** -0.5)
    g2 = nrm(ks[12], (L, LORA_GATE, D_RWKV), LORA_GATE ** -0.5)
    k_k = 0.85 + nrm(ks[13], (L, D_RWKV), 0.05)
    k_a = 1.0 + nrm(ks[14], (L, D_RWKV), 0.05)
    r_k = nrm(ks[15], (L, RWKV_HEADS, RWKV_HEAD), 0.1)
    gn_w = 1.0 + nrm(ks[16], (L, D_RWKV), 0.02)
    gn_b = nrm(ks[17], (L, D_RWKV), 0.02)
    conv_w = nrm(ks[18], (L, CONV_WIDTH, D_CONV), CONV_WIDTH ** -0.5)
    w_out = nrm(ks[19], (L, D_MIX, D), D_MIX ** -0.5)
    norm_ffn = 1.0 + nrm(ks[20], (L, D), 0.02)
    peer_wq = nrm(ks[21], (L, D, PEER_HEADS * PEER_QDIM), D ** -0.5)
    peer_keys = nrm(ks[22], (L, PEER_HEADS, 2, PEER_NKEYS, PEER_HALF), PEER_HALF ** -0.5)
    peer_u = nrm(ks[23], (L, PEER_EXPERTS, D), D ** -0.5)
    peer_v = nrm(ks[24], (L, PEER_EXPERTS, D), 0.05)
    norm_final = 1.0 + nrm(ks[25], (D,), 0.02)
    return {"x": x, "norm_mix": norm_mix, "w_in": w_in, "mu_rkv": mu_rkv, "mu_lora": mu_lora,
            "w0": w0, "w1": w1, "w2": w2, "a0": a0, "a1": a1, "a2": a2, "g1": g1, "g2": g2,
            "k_k": k_k, "k_a": k_a, "r_k": r_k, "gn_w": gn_w, "gn_b": gn_b, "conv_w": conv_w,
            "w_out": w_out, "norm_ffn": norm_ffn, "peer_wq": peer_wq, "peer_keys": peer_keys,
            "peer_u": peer_u, "peer_v": peer_v, "norm_final": norm_final}


def reference(x, norm_mix, w_in, mu_rkv, mu_lora, w0, w1, w2, a0, a1, a2, g1, g2,
              k_k, k_a, r_k, gn_w, gn_b, conv_w, w_out, norm_ffn, peer_wq, peer_keys,
              peer_u, peer_v, norm_final):
    B, S, _ = x.shape
    H, N = RWKV_HEADS, RWKV_HEAD
    f32 = jnp.float32
    for l in range(DEPTH):
        h = rms_norm(x, norm_mix[l])
        proj = h @ w_in[l]
        rkv = proj[..., :3 * D_RWKV]
        rkv = rkv + (token_shift(rkv) - rkv) * mu_rkv[l]
        r, k, v = jnp.split(rkv, 3, axis=-1)
        b_gate, c_gate, xc = jnp.split(proj[..., 3 * D_RWKV:], 3, axis=-1)

        dh = token_shift(h) - h
        xw = h + dh * mu_lora[l, 0]
        xa = h + dh * mu_lora[l, 1]
        xg = h + dh * mu_lora[l, 2]
        w_log = -jax.nn.softplus(-(w0[l] + jnp.tanh(xw @ w1[l]) @ w2[l])) - 0.5
        decay = jnp.exp(-jnp.exp(w_log.astype(f32)))
        a = jax.nn.sigmoid(a0[l] + (xa @ a1[l]) @ a2[l])
        g = jax.nn.sigmoid(xg @ g1[l]) @ g2[l]

        kk = (k * k_k[l]).astype(f32).reshape(B, S, H, N)
        kk = kk / jnp.maximum(jnp.sqrt(jnp.sum(kk * kk, axis=-1, keepdims=True)), 1e-12)
        k = k * (1.0 + (a - 1.0) * k_a[l])

        rh = r.astype(f32).reshape(B, S, H, N)
        kh = k.astype(f32).reshape(B, S, H, N)
        vh = v.astype(f32).reshape(B, S, H, N)
        ah = a.astype(f32).reshape(B, S, H, N)
        y = rwkv7_scan(rh, decay.reshape(B, S, H, N), kh, vh, kk, ah)

        mean = jnp.mean(y, axis=-1, keepdims=True)
        var = jnp.mean(jnp.square(y - mean), axis=-1, keepdims=True)
        y = (y - mean) * lax.rsqrt(var + GN_EPS)
        y = y * gn_w[l].reshape(H, N).astype(f32) + gn_b[l].reshape(H, N).astype(f32)
        y = y + jnp.sum(rh * kh * r_k[l].astype(f32), axis=-1, keepdims=True) * vh
        y_rwkv = (y.reshape(B, S, D_RWKV) * g.astype(f32)).astype(x.dtype)

        y_conv = b_gate * causal_depthwise_conv(c_gate * xc, conv_w[l])

        mix = jnp.concatenate([y_rwkv, y_conv], axis=-1) @ w_out[l]
        x = x + mix

        h2 = rms_norm(x, norm_ffn[l])
        x = x + peer_ffn(h2, peer_wq[l], peer_keys[l], peer_u[l], peer_v[l])
    return rms_norm(x, norm_final)
```

```cpp
#include <hip/hip_runtime.h>
#include <hip/hip_cooperative_groups.h>
#include <cstdio>
namespace cg = cooperative_groups;

#ifndef MULTI_LAUNCH
#define MULTI_LAUNCH 0
#endif

#define LAS __attribute__((address_space(3)))
typedef unsigned short bf16_t;
typedef short bf16x8 __attribute__((ext_vector_type(8)));
typedef float f32x4 __attribute__((ext_vector_type(4)));
typedef float f32x2 __attribute__((ext_vector_type(2)));
typedef unsigned u32x4 __attribute__((ext_vector_type(4)));
typedef unsigned u32x2 __attribute__((ext_vector_type(2)));

constexpr int S_ = 16384, D_ = 2048, DR = 1024, NAUG = 6912;
constexpr size_t MiB = 1ull << 20;
constexpr size_t WS_PROJ = 0, WS_H = 216 * MiB, WS_WB1 = 280 * MiB, WS_WQT = 280 * MiB, WS_WOT = 296 * MiB;
constexpr size_t WS_R = 307 * MiB, WS_K = 339 * MiB, WS_V = 371 * MiB, WS_KK = 403 * MiB, WS_A = 435 * MiB, WS_LW = 467 * MiB;
constexpr size_t WS_G = 216 * MiB, WS_YS = 248 * MiB, WS_YMIX = 403 * MiB, WS_X1 = 0, WS_H2 = 128 * MiB, WS_Q = 307 * MiB;
constexpr size_t WS_IDS = 192 * MiB, WS_GATES = 200 * MiB, WS_UB = 435 * MiB, WS_VB = 208 * MiB, WS_NEED = 499 * MiB;
constexpr int LDS_BYTES = 131072;
constexpr int NPHASE = 10;

struct Params {
    const float* in[26];
    float* out;
    unsigned char* ws;
    int ph_lo, ph_hi;
};

__device__ __forceinline__ float bf2f(bf16_t b) { return __uint_as_float(((unsigned)b) << 16); }
__device__ __forceinline__ bf16_t f2bf(float f) { unsigned u = __float_as_uint(f); u += 0x7FFFu + ((u >> 16) & 1u); return (bf16_t)(u >> 16); }
__device__ __forceinline__ unsigned cvt_pk_bf16(float lo, float hi) { unsigned r; asm volatile("v_cvt_pk_bf16_f32 %0, %1, %2" : "=v"(r) : "v"(lo), "v"(hi)); return r; }
__device__ __forceinline__ float wave_sum(float v) {
#pragma unroll
    for (int o = 32; o; o >>= 1) v += __shfl_xor(v, o);
    return v;
}
__device__ __forceinline__ float wave_max(float v) {
#pragma unroll
    for (int o = 32; o; o >>= 1) v = fmaxf(v, __shfl_xor(v, o));
    return v;
}
__device__ __forceinline__ float sigmoidf_(float x) { return 1.0f / (1.0f + __expf(-x)); }
__device__ __forceinline__ float gelu_tanh(float x) { float u = 0.7978845608028654f * (x + 0.044715f * x * x * x); return 0.5f * x * (1.0f + tanhf(u)); }
__device__ __forceinline__ float lo_bf(unsigned w) { return __uint_as_float(w << 16); }
__device__ __forceinline__ float hi_bf(unsigned w) { return __uint_as_float(w & 0xffff0000u); }

namespace pg8 {
constexpr int BM = 256, BK = 64, HALF = 128, HTB = HALF * BK * 2, STAGE_BYTES = 8 * HTB, NXCD = 8, WGM = 8;
__device__ __forceinline__ int lds_byte(int r, int c) { const int st = (r >> 4) * 2 + (c >> 5), rr = r & 15, cc = c & 31, ob = rr * 64 + cc * 2; return st * 1024 + (ob ^ (((ob >> 9) & 1) << 5)); }
__device__ __forceinline__ void stage_rc(int b, int& R, int& C) { const int st = b / 1024, sb = b % 1024, swz = sb ^ (((sb >> 9) & 1) << 5); R = (st >> 1) * 16 + swz / 64; C = (st & 1) * 32 + (swz % 64) / 2; }
__device__ __forceinline__ int perm32(int rho) { const int n = rho >> 4, i = rho & 15; return 8 * (i >> 2) + 4 * n + (i & 3); }
struct Unit { int pm, pn; };
struct Gemm { const bf16_t* A; const bf16_t* Bt; int M, N, K; };
struct StaticOrder {
    int nM, nN, nwg, G, c;
    __device__ void init(int M, int N, int G_, int c_) { nM = M / BM; nN = N / BM; nwg = nM * nN; G = G_; c = c_; }
    __device__ bool next(int i, Unit& u) const {
        const long L = (long)i * G + c; if (L >= nwg) return false;
        int wgid = (int)L; { const int q = nwg / NXCD, r = nwg % NXCD, xcd = wgid % NXCD, off = wgid / NXCD; wgid = (xcd < r ? xcd * (q + 1) : r * (q + 1) + (xcd - r) * q) + off; }
        const int nig = WGM * nN, gid = wgid / nig, fm = gid * WGM, gsz = (nM - fm) < WGM ? (nM - fm) : WGM;
        u.pm = fm + ((wgid % nig) % gsz); u.pn = (wgid % nig) / gsz; return true;
    }
    __device__ __forceinline__ void a_ready(const Unit&) const {}
    __device__ __forceinline__ void done(const Unit&) const {}
};
struct EpiResF32 {
    static constexpr bool PERM = false;
    float* C; const float* Res; int ldc;
    __device__ __forceinline__ void operator()(const f32x4 (&acc)[2][2][4][2], const Unit& u, int wr, int wc, int fr, int fq) const {
        const int row0 = u.pm * BM + wr * 64 + fr, col0 = u.pn * BM + wc * 32 + 4 * fq;
#pragma unroll
        for (int ai = 0; ai < 2; ++ai)
#pragma unroll
            for (int m = 0; m < 4; ++m) { const size_t ro = (size_t)(row0 + ai * HALF + m * 16) * ldc + col0;
#pragma unroll
                for (int bj = 0; bj < 2; ++bj)
#pragma unroll
                    for (int n = 0; n < 2; ++n) { const f32x4 rs = *(const f32x4*)(Res + ro + bj * HALF + n * 16); *(f32x4*)(C + ro + bj * HALF + n * 16) = acc[ai][bj][m][n] + rs; } }
    }
};
struct EpiBf16 {
    static constexpr bool PERM = true;
    bf16_t* O; int ldc;
    __device__ __forceinline__ void operator()(const f32x4 (&acc)[2][2][4][2], const Unit& u, int wr, int wc, int fr, int fq) const {
        const int row0 = u.pm * BM + wr * 64 + fr; const int col0 = u.pn * BM + wc * 32 + 8 * fq;
#pragma unroll
        for (int ai = 0; ai < 2; ++ai)
#pragma unroll
            for (int m = 0; m < 4; ++m) { bf16_t* rowp = O + (size_t)(row0 + ai * HALF + m * 16) * ldc + col0;
#pragma unroll
                for (int bj = 0; bj < 2; ++bj) { const f32x4 v0 = acc[ai][bj][m][0], v1 = acc[ai][bj][m][1];
                    u32x4 w; w.x = cvt_pk_bf16(v0[0], v0[1]); w.y = cvt_pk_bf16(v0[2], v0[3]); w.z = cvt_pk_bf16(v1[0], v1[1]); w.w = cvt_pk_bf16(v1[2], v1[3]);
                    *(u32x4*)(rowp + bj * HALF) = w; } }
    }
};

template <class Epi, class Sched>
__device__ __forceinline__ void gemm_phase(LAS unsigned char* lds, const Gemm g, const Sched& S, const Epi& E) {
    const int tid = threadIdx.x, wid = __builtin_amdgcn_readfirstlane(tid >> 6), lane = tid & 63, wr = wid >> 2, wc = wid & 3, fr = lane & 15, fq = lane >> 4;
    const int K = g.K, nt = K / BK;
    unsigned voffA[2], voffB[2];
#pragma unroll
    for (int i = 0; i < 2; ++i) { int R, C; stage_rc(tid * 16 + i * 8192, R, C); const int Rb = Epi::PERM ? ((R & ~31) + perm32(R & 31)) : R;
        voffA[i] = (unsigned)(R * K + C) * 2u; voffB[i] = (unsigned)(Rb * K + C) * 2u; }
    const size_t kstep = (size_t)(BK * 2);
    const size_t hstep = (size_t)HALF * K * 2;
    const size_t tstep = 2 * hstep;
    const unsigned ldsw = (unsigned)wid * 1024u;
    const int aoff = lds_byte(wr * 64 + fr, fq * 8), boff = lds_byte(wc * 32 + fr, fq * 8);
#define PG8_SA(b, h) (((b) * 2 + (h)) * HTB)
#define PG8_SB(b, h) ((4 + (b) * 2 + (h)) * HTB)
#define PG8_STAGE(bufoff, gbase, voff) do { _Pragma("unroll") for (int _i = 0; _i < 2; ++_i) \
        __builtin_amdgcn_global_load_lds((const unsigned*)((const char*)(gbase) + (voff)[_i]), (LAS unsigned*)(lds + (bufoff) + ldsw + _i * 8192), 16, 0, 0); } while (0)
#define PG8_LDA(dst, b, h) do { _Pragma("unroll") for (int m = 0; m < 4; ++m) _Pragma("unroll") for (int k = 0; k < 2; ++k) dst[m][k] = *(const LAS bf16x8*)(lds + PG8_SA(b, h) + aoff + m * 2048 + k * 1024); } while (0)
#define PG8_LDB(dst, b, h) do { _Pragma("unroll") for (int n = 0; n < 2; ++n) _Pragma("unroll") for (int k = 0; k < 2; ++k) dst[n][k] = *(const LAS bf16x8*)(lds + PG8_SB(b, h) + boff + n * 2048 + k * 1024); } while (0)
#define PG8_MMA(ai, bj, At, Bt) do { __builtin_amdgcn_s_setprio(1); _Pragma("unroll") for (int m = 0; m < 4; ++m) _Pragma("unroll") for (int n = 0; n < 2; ++n) _Pragma("unroll") for (int k = 0; k < 2; ++k) \
        acc[ai][bj][m][n] = __builtin_amdgcn_mfma_f32_16x16x32_bf16(Bt[n][k], At[m][k], acc[ai][bj][m][n], 0, 0, 0); __builtin_amdgcn_s_setprio(0); } while (0)
#define PG8_WAIT_V(n) asm volatile("s_waitcnt vmcnt(" #n ")" ::: "memory")
#define PG8_WAIT_L(n) asm volatile("s_waitcnt lgkmcnt(" #n ")" ::: "memory")
#define PG8_BAR __builtin_amdgcn_s_barrier()
#define PG8_SCHED __builtin_amdgcn_sched_barrier(0)
    Unit cur, nxt; int ui = 0;
    if (!S.next(0, cur)) return;
    f32x4 acc[2][2][4][2];
#pragma unroll
    for (int a = 0; a < 2; ++a)
#pragma unroll
        for (int b = 0; b < 2; ++b)
#pragma unroll
            for (int m = 0; m < 4; ++m)
#pragma unroll
                for (int n = 0; n < 2; ++n) acc[a][b][m][n] = (f32x4){0.f, 0.f, 0.f, 0.f};
    bf16x8 At[4][2], B0[2][2], B1[2][2];
    const char* cA = (const char*)g.A + (size_t)cur.pm * tstep; const char* cB = (const char*)g.Bt + (size_t)cur.pn * tstep;
    S.a_ready(cur);
    PG8_STAGE(PG8_SB(0, 0), cB, voffB); PG8_STAGE(PG8_SA(0, 0), cA, voffA); PG8_STAGE(PG8_SB(0, 1), cB + hstep, voffB); PG8_STAGE(PG8_SA(0, 1), cA + hstep, voffA);
    if (wr == 1) PG8_BAR;
    PG8_WAIT_V(4); PG8_BAR;
    PG8_STAGE(PG8_SB(1, 0), cB + kstep, voffB); PG8_STAGE(PG8_SA(1, 0), cA + kstep, voffA); PG8_STAGE(PG8_SB(1, 1), cB + hstep + kstep, voffB);
    PG8_WAIT_V(6); PG8_BAR;
    for (;;) {
        const bool has_next = S.next(ui + 1, nxt);
        const char* nA = has_next ? (const char*)g.A + (size_t)nxt.pm * tstep : cA; const char* nB = has_next ? (const char*)g.Bt + (size_t)nxt.pn * tstep : cB;
        for (int t = 0; t < nt; t += 2) {
            const bool last = (t == nt - 2);
            const char* a1 = cA + (size_t)(t + 1) * kstep;
            const char* a2 = last ? nA : cA + (size_t)(t + 2) * kstep; const char* b2 = last ? nB : cB + (size_t)(t + 2) * kstep;
            const char* a3 = a2 + kstep; const char* b3 = b2 + kstep;
            if (last && has_next) S.a_ready(nxt);
            PG8_LDB(B0, 0, 0); PG8_SCHED; PG8_LDA(At, 0, 0); PG8_STAGE(PG8_SA(1, 1), a1 + hstep, voffA);
            PG8_WAIT_L(8); PG8_BAR; PG8_WAIT_L(0); PG8_MMA(0, 0, At, B0); PG8_BAR; PG8_SCHED;
            PG8_LDB(B1, 0, 1); PG8_STAGE(PG8_SB(0, 0), b2, voffB);
            PG8_BAR; PG8_WAIT_L(0); PG8_MMA(0, 1, At, B1); PG8_BAR;
            PG8_LDA(At, 0, 1); PG8_STAGE(PG8_SA(0, 0), a2, voffA);
            PG8_BAR; PG8_WAIT_L(0); PG8_MMA(1, 0, At, B0); PG8_BAR; PG8_SCHED;
            PG8_STAGE(PG8_SB(0, 1), b2 + hstep, voffB);
            PG8_WAIT_V(6); PG8_BAR; PG8_MMA(1, 1, At, B1); PG8_BAR;
            PG8_LDB(B0, 1, 0); PG8_SCHED; PG8_LDA(At, 1, 0); PG8_STAGE(PG8_SA(0, 1), a2 + hstep, voffA);
            PG8_WAIT_L(8); PG8_BAR; PG8_WAIT_L(0); PG8_MMA(0, 0, At, B0); PG8_BAR; PG8_SCHED;
            PG8_LDB(B1, 1, 1); PG8_STAGE(PG8_SB(1, 0), b3, voffB);
            PG8_BAR; PG8_WAIT_L(0); PG8_MMA(0, 1, At, B1); PG8_BAR;
            PG8_LDA(At, 1, 1); PG8_STAGE(PG8_SA(1, 0), a3, voffA);
            PG8_BAR; PG8_WAIT_L(0); PG8_MMA(1, 0, At, B0); PG8_BAR; PG8_SCHED;
            PG8_STAGE(PG8_SB(1, 1), b3 + hstep, voffB);
            PG8_WAIT_V(6); PG8_BAR; PG8_MMA(1, 1, At, B1); PG8_BAR;
        }
        E(acc, cur, wr, wc, fr, fq); S.done(cur);
        if (!has_next) break;
#pragma unroll
        for (int a = 0; a < 2; ++a)
#pragma unroll
            for (int b = 0; b < 2; ++b)
#pragma unroll
                for (int m = 0; m < 4; ++m)
#pragma unroll
                    for (int n = 0; n < 2; ++n) acc[a][b][m][n] = (f32x4){0.f, 0.f, 0.f, 0.f};
        cur = nxt; cA = nA; cB = nB; ++ui;
    }
    PG8_WAIT_V(0);
    if (wr == 0) PG8_BAR;
    PG8_BAR;
#undef PG8_SA
#undef PG8_SB
#undef PG8_STAGE
#undef PG8_LDA
#undef PG8_LDB
#undef PG8_MMA
#undef PG8_WAIT_V
#undef PG8_WAIT_L
#undef PG8_BAR
#undef PG8_SCHED
}
}

__device__ __forceinline__ void rmsnorm_rows(const float* X, const float* gain, bf16_t* H) {
    const int wave = threadIdx.x >> 6, lane = threadIdx.x & 63;
    for (int row = blockIdx.x * 8 + wave; row < S_; row += gridDim.x * 8) {
        const float4* xr = (const float4*)(X + (size_t)row * D_);
        float4 v[8]; float ss = 0.f;
#pragma unroll
        for (int i = 0; i < 8; ++i) { v[i] = xr[i * 64 + lane]; ss += v[i].x * v[i].x + v[i].y * v[i].y + v[i].z * v[i].z + v[i].w * v[i].w; }
        ss = wave_sum(ss);
        const float sc = rsqrtf(ss * (1.0f / 2048.0f) + 1e-6f);
#pragma unroll
        for (int i = 0; i < 8; ++i) { const float4 g = ((const float4*)gain)[i * 64 + lane];
            u32x2 w; w.x = cvt_pk_bf16(v[i].x * sc * g.x, v[i].y * sc * g.y); w.y = cvt_pk_bf16(v[i].z * sc * g.z, v[i].w * sc * g.w);
            *(u32x2*)(H + (size_t)row * D_ + (i * 64 + lane) * 4) = w; }
    }
}

__device__ __forceinline__ void transpose_convert(const float* W, int K, int N, bf16_t* Bt, float* tile) {
    const int tid = threadIdx.x; const int tk = K / 64, tn = N / 64;
    for (int u = blockIdx.x; u < tk * tn; u += gridDim.x) {
        const int k0 = (u / tn) * 64, n0 = (u % tn) * 64;
        __syncthreads();
#pragma unroll
        for (int i = 0; i < 8; ++i) { const int kk = i * 8 + (tid >> 6), nn = tid & 63; tile[kk * 65 + nn] = W[(size_t)(k0 + kk) * N + n0 + nn]; }
        __syncthreads();
#pragma unroll
        for (int i = 0; i < 4; ++i) { const int nn = i * 16 + (tid >> 5), kp = (tid & 31) * 2;
            *(unsigned*)(Bt + (size_t)(n0 + nn) * K + k0 + kp) = cvt_pk_bf16(tile[kp * 65 + nn], tile[(kp + 1) * 65 + nn]); }
    }
}

__device__ __forceinline__ void convert_flat(const float* src, bf16_t* dst, size_t n) {
    for (size_t i = ((size_t)blockIdx.x * 512 + threadIdx.x) * 8; i < n; i += (size_t)gridDim.x * 512 * 8) {
        const float4 a = *(const float4*)(src + i), b = *(const float4*)(src + i + 4);
        u32x4 w; w.x = cvt_pk_bf16(a.x, a.y); w.y = cvt_pk_bf16(a.z, a.w); w.z = cvt_pk_bf16(b.x, b.y); w.w = cvt_pk_bf16(b.z, b.w);
        *(u32x4*)(dst + i) = w;
    }
}

__device__ __forceinline__ void phase0(const Params& p, unsigned char* shm) {
    bf16_t* WB1 = (bf16_t*)(p.ws + WS_WB1);
    rmsnorm_rows(p.in[0], p.in[1], (bf16_t*)(p.ws + WS_H));
    transpose_convert(p.in[2], 2048, 6144, WB1, (float*)shm);
    const float* mu = p.in[4]; const float* w1 = p.in[6]; const float* a1 = p.in[9]; const float* g1 = p.in[11];
    for (int idx = blockIdx.x * 512 + threadIdx.x; idx < 768 * 2048; idx += gridDim.x * 512) {
        const int j = idx >> 11, k = idx & 2047; float val = 0.f;
        if (j < 128) { const float m = mu[k], w = w1[k * 64 + (j & 63)]; val = (j < 64) ? w * (1.f - m) : w * m; }
        else if (j < 256) { const float m = mu[2048 + k], w = a1[k * 64 + (j & 63)]; val = (j < 192) ? w * (1.f - m) : w * m; }
        else if (j < 576) { const float m = mu[4096 + k]; const int jj = j - 256; const int c = jj < 160 ? jj : jj - 160; const float w = g1[k * 160 + c]; val = jj < 160 ? w * (1.f - m) : w * m; }
        WB1[(size_t)(6144 + j) * 2048 + k] = f2bf(val);
    }
}

__device__ __forceinline__ void phase_prep(const Params& p, unsigned char* shm) {
    float* actT = (float*)shm;
    const bf16_t* P = (const bf16_t*)(p.ws + WS_PROJ);
    bf16_t* R = (bf16_t*)(p.ws + WS_R); bf16_t* Kk = (bf16_t*)(p.ws + WS_K); bf16_t* V = (bf16_t*)(p.ws + WS_V);
    bf16_t* KK = (bf16_t*)(p.ws + WS_KK); bf16_t* A = (bf16_t*)(p.ws + WS_A); bf16_t* LW = (bf16_t*)(p.ws + WS_LW); bf16_t* G = (bf16_t*)(p.ws + WS_G);
    const float* mu_rkv = p.in[3]; const float* w0 = p.in[5]; const float* w2 = p.in[7]; const float* a0 = p.in[8]; const float* a2 = p.in[10]; const float* g2 = p.in[12];
    const float* k_k = p.in[13]; const float* k_a = p.in[14];
    const int tid = threadIdx.x;
    for (int tile = blockIdx.x; tile < S_ / 16; tile += gridDim.x) {
        const int t0 = tile * 16;
        __syncthreads();
        for (int e = tid; e < 16 * 288; e += 512) {
            const int t = e / 288, j = e % 288; const int tg = t0 + t;
            int ccur, cprev;
            if (j < 64) { ccur = 6144 + j; cprev = 6208 + j; }
            else if (j < 128) { ccur = 6272 + (j - 64); cprev = 6336 + (j - 64); }
            else { ccur = 6400 + (j - 128); cprev = 6560 + (j - 128); }
            float s = bf2f(P[(size_t)tg * NAUG + ccur]);
            if (tg > 0) s += bf2f(P[(size_t)(tg - 1) * NAUG + cprev]);
            const float a = j < 64 ? tanhf(s) : (j < 128 ? s : sigmoidf_(s));
            actT[j * 16 + t] = a;
        }
        __syncthreads();
        float acc[2][16];
#pragma unroll
        for (int ci = 0; ci < 2; ++ci)
#pragma unroll
            for (int t = 0; t < 16; ++t) acc[ci][t] = 0.f;
        for (int j = 0; j < 64; ++j) {
            const float wa = w2[j * 1024 + tid], wb = w2[j * 1024 + 512 + tid];
            const float4* ap = (const float4*)(actT + j * 16);
#pragma unroll
            for (int q = 0; q < 4; ++q) { const float4 a = ap[q];
                acc[0][q * 4 + 0] += a.x * wa; acc[0][q * 4 + 1] += a.y * wa; acc[0][q * 4 + 2] += a.z * wa; acc[0][q * 4 + 3] += a.w * wa;
                acc[1][q * 4 + 0] += a.x * wb; acc[1][q * 4 + 1] += a.y * wb; acc[1][q * 4 + 2] += a.z * wb; acc[1][q * 4 + 3] += a.w * wb; }
        }
#pragma unroll
        for (int ci = 0; ci < 2; ++ci) { const int c = tid + ci * 512; const float w0c = w0[c];
#pragma unroll
            for (int t = 0; t < 16; ++t) { const float x = -(w0c + acc[ci][t]);
                const float sp = fmaxf(x, 0.f) + log1pf(__expf(-fabsf(x)));
                const float wlog = -sp - 0.5f;
                LW[(size_t)(t0 + t) * DR + c] = f2bf(-__expf(wlog)); } }
#pragma unroll
        for (int ci = 0; ci < 2; ++ci)
#pragma unroll
            for (int t = 0; t < 16; ++t) acc[ci][t] = 0.f;
        for (int j = 0; j < 160; ++j) {
            const float wa = g2[j * 1024 + tid], wb = g2[j * 1024 + 512 + tid];
            const float4* ap = (const float4*)(actT + (128 + j) * 16);
#pragma unroll
            for (int q = 0; q < 4; ++q) { const float4 a = ap[q];
                acc[0][q * 4 + 0] += a.x * wa; acc[0][q * 4 + 1] += a.y * wa; acc[0][q * 4 + 2] += a.z * wa; acc[0][q * 4 + 3] += a.w * wa;
                acc[1][q * 4 + 0] += a.x * wb; acc[1][q * 4 + 1] += a.y * wb; acc[1][q * 4 + 2] += a.z * wb; acc[1][q * 4 + 3] += a.w * wb; }
        }
#pragma unroll
        for (int ci = 0; ci < 2; ++ci) { const int c = tid + ci * 512;
#pragma unroll
            for (int t = 0; t < 16; ++t) G[(size_t)(t0 + t) * DR + c] = f2bf(acc[ci][t]); }
#pragma unroll
        for (int ci = 0; ci < 2; ++ci)
#pragma unroll
            for (int t = 0; t < 16; ++t) acc[ci][t] = 0.f;
        for (int j = 0; j < 64; ++j) {
            const float wa = a2[j * 1024 + tid], wb = a2[j * 1024 + 512 + tid];
            const float4* ap = (const float4*)(actT + (64 + j) * 16);
#pragma unroll
            for (int q = 0; q < 4; ++q) { const float4 a = ap[q];
                acc[0][q * 4 + 0] += a.x * wa; acc[0][q * 4 + 1] += a.y * wa; acc[0][q * 4 + 2] += a.z * wa; acc[0][q * 4 + 3] += a.w * wa;
                acc[1][q * 4 + 0] += a.x * wb; acc[1][q * 4 + 1] += a.y * wb; acc[1][q * 4 + 2] += a.z * wb; acc[1][q * 4 + 3] += a.w * wb; }
        }
#pragma unroll
        for (int ci = 0; ci < 2; ++ci) {
            const int c = tid + ci * 512;
            const float a0c = a0[c], mr = mu_rkv[c], mk = mu_rkv[1024 + c], mv = mu_rkv[2048 + c], kkc = k_k[c], kac = k_a[c];
            float pr = 0.f, pk = 0.f, pv = 0.f;
            if (t0 > 0) { const size_t o = (size_t)(t0 - 1) * NAUG + c; pr = bf2f(P[o]); pk = bf2f(P[o + 1024]); pv = bf2f(P[o + 2048]); }
#pragma unroll
            for (int t = 0; t < 16; ++t) {
                const size_t o = (size_t)(t0 + t) * NAUG + c;
                const float cr = bf2f(P[o]), ck = bf2f(P[o + 1024]), cv = bf2f(P[o + 2048]);
                const float r = cr + (pr - cr) * mr, k = ck + (pk - ck) * mk, v = cv + (pv - cv) * mv;
                pr = cr; pk = ck; pv = cv;
                const float a = sigmoidf_(a0c + acc[ci][t]);
                const float kkv = k * kkc;
                const float nrm = sqrtf(wave_sum(kkv * kkv));
                const float kkn = kkv / fmaxf(nrm, 1e-12f);
                const float k2 = k * (1.f + (a - 1.f) * kac);
                const size_t oo = (size_t)(t0 + t) * DR + c;
                R[oo] = f2bf(r); Kk[oo] = f2bf(k2); V[oo] = f2bf(v); KK[oo] = f2bf(kkn); A[oo] = f2bf(a);
            }
        }
    }
}

__device__ __forceinline__ void phase_scan_seq(const Params& p, unsigned char* shm) {
    if (blockIdx.x >= 16) return;
    const int head = blockIdx.x, tid = threadIdx.x;
    float* Ldec = (float*)shm; float* Lnkk = Ldec + 4096; float* Lb = Lnkk + 4096; float* Lk = Lb + 4096; float* Lr = Lk + 4096; float* Lv = Lr + 4096; float* Ly = Lv + 4096;
    const bf16_t* R = (const bf16_t*)(p.ws + WS_R); const bf16_t* Kk = (const bf16_t*)(p.ws + WS_K); const bf16_t* V = (const bf16_t*)(p.ws + WS_V);
    const bf16_t* KK = (const bf16_t*)(p.ws + WS_KK); const bf16_t* A = (const bf16_t*)(p.ws + WS_A); const bf16_t* LW = (const bf16_t*)(p.ws + WS_LW);
    bf16_t* YS = (bf16_t*)(p.ws + WS_YS);
    const int row = tid >> 3, sub = tid & 7;
    float St[8];
#pragma unroll
    for (int i = 0; i < 8; ++i) St[i] = 0.f;
    for (int ch = 0; ch < S_ / 64; ++ch) {
        __syncthreads();
        {
            const int t = tid >> 3, k0 = (tid & 7) * 8;
            const size_t g = (size_t)(ch * 64 + t) * DR + head * 64 + k0;
            const u32x4 r4 = *(const u32x4*)(R + g), k4 = *(const u32x4*)(Kk + g), v4 = *(const u32x4*)(V + g), kk4 = *(const u32x4*)(KK + g), a4 = *(const u32x4*)(A + g), lw4 = *(const u32x4*)(LW + g);
            const int lo = t * 64 + k0;
#pragma unroll
            for (int q = 0; q < 4; ++q) {
                const float kk0 = lo_bf(kk4[q]), kk1 = hi_bf(kk4[q]);
                Ldec[lo + 2 * q] = __expf(lo_bf(lw4[q])); Ldec[lo + 2 * q + 1] = __expf(hi_bf(lw4[q]));
                Lnkk[lo + 2 * q] = -kk0; Lnkk[lo + 2 * q + 1] = -kk1;
                Lb[lo + 2 * q] = kk0 * lo_bf(a4[q]); Lb[lo + 2 * q + 1] = kk1 * hi_bf(a4[q]);
                Lk[lo + 2 * q] = lo_bf(k4[q]); Lk[lo + 2 * q + 1] = hi_bf(k4[q]);
                Lr[lo + 2 * q] = lo_bf(r4[q]); Lr[lo + 2 * q + 1] = hi_bf(r4[q]);
                Lv[lo + 2 * q] = lo_bf(v4[q]); Lv[lo + 2 * q + 1] = hi_bf(v4[q]);
            }
        }
        __syncthreads();
        for (int t = 0; t < 64; ++t) {
            const int o = t * 64 + sub * 8;
            const float4 d0 = *(const float4*)(Ldec + o), d1 = *(const float4*)(Ldec + o + 4);
            const float4 n0 = *(const float4*)(Lnkk + o), n1 = *(const float4*)(Lnkk + o + 4);
            const float4 b0 = *(const float4*)(Lb + o), b1 = *(const float4*)(Lb + o + 4);
            const float4 k0 = *(const float4*)(Lk + o), k1 = *(const float4*)(Lk + o + 4);
            const float4 r0 = *(const float4*)(Lr + o), r1 = *(const float4*)(Lr + o + 4);
            const float vv = Lv[t * 64 + row];
            float sa = St[0] * n0.x + St[1] * n0.y + St[2] * n0.z + St[3] * n0.w + St[4] * n1.x + St[5] * n1.y + St[6] * n1.z + St[7] * n1.w;
            sa += __shfl_xor(sa, 1); sa += __shfl_xor(sa, 2); sa += __shfl_xor(sa, 4);
            St[0] = St[0] * d0.x + sa * b0.x + vv * k0.x; St[1] = St[1] * d0.y + sa * b0.y + vv * k0.y;
            St[2] = St[2] * d0.z + sa * b0.z + vv * k0.z; St[3] = St[3] * d0.w + sa * b0.w + vv * k0.w;
            St[4] = St[4] * d1.x + sa * b1.x + vv * k1.x; St[5] = St[5] * d1.y + sa * b1.y + vv * k1.y;
            St[6] = St[6] * d1.z + sa * b1.z + vv * k1.z; St[7] = St[7] * d1.w + sa * b1.w + vv * k1.w;
            float y = St[0] * r0.x + St[1] * r0.y + St[2] * r0.z + St[3] * r0.w + St[4] * r1.x + St[5] * r1.y + St[6] * r1.z + St[7] * r1.w;
            y += __shfl_xor(y, 1); y += __shfl_xor(y, 2); y += __shfl_xor(y, 4);
            if (sub == 0) Ly[t * 64 + row] = y;
        }
        __syncthreads();
        {
            const int t = tid >> 3, k0 = (tid & 7) * 8;
            const float4 y0 = *(const float4*)(Ly + t * 64 + k0), y1 = *(const float4*)(Ly + t * 64 + k0 + 4);
            u32x4 w; w.x = cvt_pk_bf16(y0.x, y0.y); w.y = cvt_pk_bf16(y0.z, y0.w); w.z = cvt_pk_bf16(y1.x, y1.y); w.w = cvt_pk_bf16(y1.z, y1.w);
            *(u32x4*)(YS + (size_t)(ch * 64 + t) * DR + head * 64 + k0) = w;
        }
    }
}

__device__ __forceinline__ void phase_post(const Params& p) {
    const bf16_t* P = (const bf16_t*)(p.ws + WS_PROJ);
    const bf16_t* R = (const bf16_t*)(p.ws + WS_R); const bf16_t* Kk = (const bf16_t*)(p.ws + WS_K); const bf16_t* V = (const bf16_t*)(p.ws + WS_V);
    const bf16_t* G = (const bf16_t*)(p.ws + WS_G); const bf16_t* YS = (const bf16_t*)(p.ws + WS_YS);
    bf16_t* YM = (bf16_t*)(p.ws + WS_YMIX);
    const float* r_k = p.in[15]; const float* gn_w = p.in[16]; const float* gn_b = p.in[17]; const float* cw = p.in[18];
    const int tid = threadIdx.x;
    for (int t = blockIdx.x; t < S_; t += gridDim.x) {
#pragma unroll
        for (int ci = 0; ci < 2; ++ci) {
            const int c = tid + ci * 512; const size_t o = (size_t)t * DR + c;
            const float y = bf2f(YS[o]);
            const float mean = wave_sum(y) * (1.f / 64.f); const float d = y - mean;
            const float var = wave_sum(d * d) * (1.f / 64.f);
            float yn = d * rsqrtf(var + 64e-5f) * gn_w[c] + gn_b[c];
            const float r = bf2f(R[o]), k = bf2f(Kk[o]), v = bf2f(V[o]);
            const float bonus = wave_sum(r * k * r_k[c]) * v;
            YM[(size_t)t * D_ + c] = f2bf((yn + bonus) * bf2f(G[o]));
            const size_t po = (size_t)t * NAUG + c;
            const float bg = bf2f(P[po + 3072]);
            const float u0 = bf2f(P[po + 4096]) * bf2f(P[po + 5120]);
            float u1 = 0.f, u2 = 0.f;
            if (t >= 1) u1 = bf2f(P[po - NAUG + 4096]) * bf2f(P[po - NAUG + 5120]);
            if (t >= 2) u2 = bf2f(P[po - 2 * NAUG + 4096]) * bf2f(P[po - 2 * NAUG + 5120]);
            YM[(size_t)t * D_ + 1024 + c] = f2bf(bg * (cw[c] * u2 + cw[1024 + c] * u1 + cw[2048 + c] * u0));
        }
    }
}

__device__ __forceinline__ void phase_topk(const Params& p, unsigned char* shm) {
    float* sc = (float*)shm;
    float* ts = sc + 64 * 260;
    int* ti = (int*)(ts + 2048);
    const bf16_t* Q = (const bf16_t*)(p.ws + WS_Q); const float* keys = p.in[22];
    int* IDS = (int*)(p.ws + WS_IDS); float* GATES = (float*)(p.ws + WS_GATES);
    const int tid = threadIdx.x, w = tid >> 6, lane = tid & 63, fr = lane & 15, fq = lane >> 4;
    for (int item = blockIdx.x; item < 2048; item += gridDim.x) {
        const int h = item & 7, t0 = (item >> 3) * 64;
        const int c = w >> 2, nb = (w & 3) * 32;
        f32x4 acc[4][2];
#pragma unroll
        for (int m = 0; m < 4; ++m)
#pragma unroll
            for (int n = 0; n < 2; ++n) acc[m][n] = (f32x4){0.f, 0.f, 0.f, 0.f};
        const float* kb = keys + ((size_t)(h * 2 + c) * 128) * 256;
        for (int ks = 0; ks < 8; ++ks) {
            bf16x8 a[4], b[2];
#pragma unroll
            for (int m = 0; m < 4; ++m) a[m] = *(const bf16x8*)(Q + (size_t)(t0 + m * 16 + fr) * 4096 + h * 512 + c * 256 + ks * 32 + fq * 8);
#pragma unroll
            for (int n = 0; n < 2; ++n) { const float4* kp = (const float4*)(kb + (size_t)(nb + n * 16 + fr) * 256 + ks * 32 + fq * 8); const float4 x0 = kp[0], x1 = kp[1];
                u32x4 wv; wv.x = cvt_pk_bf16(x0.x, x0.y); wv.y = cvt_pk_bf16(x0.z, x0.w); wv.z = cvt_pk_bf16(x1.x, x1.y); wv.w = cvt_pk_bf16(x1.z, x1.w);
                b[n] = __builtin_bit_cast(bf16x8, wv); }
#pragma unroll
            for (int m = 0; m < 4; ++m)
#pragma unroll
                for (int n = 0; n < 2; ++n) acc[m][n] = __builtin_amdgcn_mfma_f32_16x16x32_bf16(a[m], b[n], acc[m][n], 0, 0, 0);
        }
        __syncthreads();
#pragma unroll
        for (int m = 0; m < 4; ++m)
#pragma unroll
            for (int n = 0; n < 2; ++n)
#pragma unroll
                for (int j = 0; j < 4; ++j) sc[(m * 16 + fq * 4 + j) * 260 + c * 128 + nb + n * 16 + fr] = acc[m][n][j];
        __syncthreads();
        for (int li = 0; li < 16; ++li) {
            const int list = w * 16 + li; const int tok = list >> 1, cc = list & 1;
            float v0 = sc[tok * 260 + cc * 128 + lane], v1 = sc[tok * 260 + cc * 128 + 64 + lane];
            float myv = 0.f; int myi = 0;
            for (int r = 0; r < 16; ++r) {
                const float m = wave_max(fmaxf(v0, v1));
                const unsigned long long b0 = __ballot(v0 == m);
                int idx;
                if (b0) { const int l = __ffsll((long long)b0) - 1; idx = l; if (lane == l) v0 = -INFINITY; }
                else { const unsigned long long b1 = __ballot(v1 == m); const int l = __ffsll((long long)b1) - 1; idx = 64 + l; if (lane == l) v1 = -INFINITY; }
                if (lane == r) { myv = m; myi = idx; }
            }
            if (lane < 16) { ts[(tok * 2 + cc) * 16 + lane] = myv; ti[(tok * 2 + cc) * 16 + lane] = myi; }
        }
        __syncthreads();
        for (int li = 0; li < 8; ++li) {
            const int tok = w * 8 + li;
            const int i = lane >> 2, j0 = (lane & 3) * 4;
            const float s1 = ts[(tok * 2) * 16 + i];
            float c0 = s1 + ts[(tok * 2 + 1) * 16 + j0], c1 = s1 + ts[(tok * 2 + 1) * 16 + j0 + 1], c2 = s1 + ts[(tok * 2 + 1) * 16 + j0 + 2], c3 = s1 + ts[(tok * 2 + 1) * 16 + j0 + 3];
            float myv = 0.f; int myi = 0;
            for (int r = 0; r < 16; ++r) {
                const float m = wave_max(fmaxf(fmaxf(c0, c1), fmaxf(c2, c3)));
                const bool hit = (c0 == m) || (c1 == m) || (c2 == m) || (c3 == m);
                const unsigned long long bb = __ballot(hit);
                const int l = __ffsll((long long)bb) - 1;
                int jsel = (c0 == m) ? 0 : (c1 == m) ? 1 : (c2 == m) ? 2 : 3;
                const int jb = __shfl(jsel, l & 63);
                if (lane == l) { if (jsel == 0) c0 = -INFINITY; else if (jsel == 1) c1 = -INFINITY; else if (jsel == 2) c2 = -INFINITY; else c3 = -INFINITY; }
                if (lane == r) { myv = m; myi = l * 4 + jb; }
            }
            const float mx = __shfl(myv, 0);
            const float e = (lane < 16) ? __expf(myv - mx) : 0.f;
            const float sum = wave_sum(e);
            if (lane < 16) {
                const int e1 = ti[(tok * 2) * 16 + ((myi >> 4) & 15)], e2 = ti[(tok * 2 + 1) * 16 + (myi & 15)];
                IDS[(size_t)(t0 + tok) * 128 + h * 16 + lane] = (e1 * 128 + e2) & 16383;
                GATES[(size_t)(t0 + tok) * 128 + h * 16 + lane] = e / sum;
            }
        }
    }
}

__device__ __forceinline__ void phase_gather(const Params& p, unsigned char* shm) {
    float* part = (float*)shm;
    float* red = part + 8 * 2048;
    const bf16_t* H2 = (const bf16_t*)(p.ws + WS_H2); const float* X1 = (const float*)(p.ws + WS_X1);
    const bf16_t* UB = (const bf16_t*)(p.ws + WS_UB); const bf16_t* VB = (const bf16_t*)(p.ws + WS_VB);
    const int* IDS = (const int*)(p.ws + WS_IDS); const float* GATES = (const float*)(p.ws + WS_GATES);
    const float* nf = p.in[25];
    const int tid = threadIdx.x, w = tid >> 6, lane = tid & 63;
    for (int t = blockIdx.x; t < S_; t += gridDim.x) {
        float hf[32];
#pragma unroll
        for (int q = 0; q < 4; ++q) { const u32x4 hv = *(const u32x4*)(H2 + (size_t)t * D_ + q * 512 + lane * 8);
#pragma unroll
            for (int i = 0; i < 4; ++i) { hf[q * 8 + 2 * i] = lo_bf(hv[i]); hf[q * 8 + 2 * i + 1] = hi_bf(hv[i]); } }
        const int myid = (lane < 16) ? IDS[(size_t)t * 128 + w * 16 + lane] : 0;
        const float mygate = (lane < 16) ? GATES[(size_t)t * 128 + w * 16 + lane] : 0.f;
        float myact = 0.f;
#pragma unroll 4
        for (int e = 0; e < 16; ++e) {
            const int id = __builtin_amdgcn_readlane(myid, e);
            const bf16_t* ur = UB + (size_t)id * D_ + lane * 8;
            float d = 0.f;
#pragma unroll
            for (int q = 0; q < 4; ++q) { const u32x4 uv = *(const u32x4*)(ur + q * 512);
#pragma unroll
                for (int i = 0; i < 4; ++i) d += lo_bf(uv[i]) * hf[q * 8 + 2 * i] + hi_bf(uv[i]) * hf[q * 8 + 2 * i + 1]; }
            d = wave_sum(d);
            if (lane == e) myact = gelu_tanh(d) * mygate;
        }
        float o[32];
#pragma unroll
        for (int i = 0; i < 32; ++i) o[i] = 0.f;
#pragma unroll 4
        for (int e = 0; e < 16; ++e) {
            const int id = __builtin_amdgcn_readlane(myid, e);
            const float a = __int_as_float(__builtin_amdgcn_readlane(__float_as_int(myact), e));
            const bf16_t* vr = VB + (size_t)id * D_ + lane * 8;
#pragma unroll
            for (int q = 0; q < 4; ++q) { const u32x4 vv = *(const u32x4*)(vr + q * 512);
#pragma unroll
                for (int i = 0; i < 4; ++i) { o[q * 8 + 2 * i] += a * lo_bf(vv[i]); o[q * 8 + 2 * i + 1] += a * hi_bf(vv[i]); } }
        }
        __syncthreads();
#pragma unroll
        for (int q = 0; q < 4; ++q) {
            *(float4*)(part + w * 2048 + q * 512 + lane * 8) = make_float4(o[q * 8], o[q * 8 + 1], o[q * 8 + 2], o[q * 8 + 3]);
            *(float4*)(part + w * 2048 + q * 512 + lane * 8 + 4) = make_float4(o[q * 8 + 4], o[q * 8 + 5], o[q * 8 + 6], o[q * 8 + 7]);
        }
        __syncthreads();
        float4 s = *(const float4*)(X1 + (size_t)t * D_ + tid * 4);
#pragma unroll
        for (int ww = 0; ww < 8; ++ww) { const float4 pp = *(const float4*)(part + ww * 2048 + tid * 4); s.x += pp.x; s.y += pp.y; s.z += pp.z; s.w += pp.w; }
        float ss = wave_sum(s.x * s.x + s.y * s.y + s.z * s.z + s.w * s.w);
        if (lane == 0) red[w] = ss;
        __syncthreads();
        float tot = 0.f;
#pragma unroll
        for (int ww = 0; ww < 8; ++ww) tot += red[ww];
        const float scl = rsqrtf(tot * (1.f / 2048.f) + 1e-6f);
        const float4 g = *(const float4*)(nf + tid * 4);
        *(float4*)(p.out + (size_t)t * D_ + tid * 4) = make_float4(s.x * scl * g.x, s.y * scl * g.y, s.z * scl * g.z, s.w * scl * g.w);
    }
}

__global__ void __launch_bounds__(512, 2) mega(Params p) {
    extern __shared__ __attribute__((aligned(16))) unsigned char shm[];
    cg::grid_group grid = cg::this_grid();
    LAS unsigned char* lds = (LAS unsigned char*)shm;
    const int lo = p.ph_lo, hi = p.ph_hi;
#define IN(k) (lo <= (k) && (k) < hi)
#define SEAM(k) do { if (IN(k) && IN((k) + 1)) grid.sync(); } while (0)
    if (IN(0)) { phase0(p, shm); }
    SEAM(0);
    if (IN(1)) {
        pg8::Gemm g{(const bf16_t*)(p.ws + WS_H), (const bf16_t*)(p.ws + WS_WB1), S_, NAUG, 2048};
        pg8::StaticOrder so; so.init(g.M, g.N, (int)gridDim.x, (int)blockIdx.x);
        pg8::EpiBf16 E{(bf16_t*)(p.ws + WS_PROJ), NAUG};
        pg8::gemm_phase(lds, g, so, E);
    }
    SEAM(1);
    if (IN(2)) {
        phase_prep(p, shm);
        transpose_convert(p.in[21], 2048, 4096, (bf16_t*)(p.ws + WS_WQT), (float*)shm);
        transpose_convert(p.in[19], 2048, 2048, (bf16_t*)(p.ws + WS_WOT), (float*)shm);
    }
    SEAM(2);
    if (IN(3)) { phase_scan_seq(p, shm); }
    SEAM(3);
    if (IN(4)) { phase_post(p); }
    SEAM(4);
    if (IN(5)) {
        pg8::Gemm g{(const bf16_t*)(p.ws + WS_YMIX), (const bf16_t*)(p.ws + WS_WOT), S_, 2048, 2048};
        pg8::StaticOrder so; so.init(g.M, g.N, (int)gridDim.x, (int)blockIdx.x);
        pg8::EpiResF32 E{(float*)(p.ws + WS_X1), p.in[0], 2048};
        pg8::gemm_phase(lds, g, so, E);
    }
    SEAM(5);
    if (IN(6)) {
        rmsnorm_rows((const float*)(p.ws + WS_X1), p.in[20], (bf16_t*)(p.ws + WS_H2));
        convert_flat(p.in[23], (bf16_t*)(p.ws + WS_UB), (size_t)16384 * 2048);
        convert_flat(p.in[24], (bf16_t*)(p.ws + WS_VB), (size_t)16384 * 2048);
    }
    SEAM(6);
    if (IN(7)) {
        pg8::Gemm g{(const bf16_t*)(p.ws + WS_H2), (const bf16_t*)(p.ws + WS_WQT), S_, 4096, 2048};
        pg8::StaticOrder so; so.init(g.M, g.N, (int)gridDim.x, (int)blockIdx.x);
        pg8::EpiBf16 E{(bf16_t*)(p.ws + WS_Q), 4096};
        pg8::gemm_phase(lds, g, so, E);
    }
    SEAM(7);
    if (IN(8)) { phase_topk(p, shm); }
    SEAM(8);
    if (IN(9)) { phase_gather(p, shm); }
#undef IN
#undef SEAM
}

extern "C" void kernel_launch(void* const* d_in, const int* in_sizes, int n_in, void* d_out, int out_size, void* d_ws, size_t ws_size, hipStream_t stream) {
    static int grid_blocks = 0;
    if (grid_blocks == 0) {
        if (n_in != 26 || ws_size < WS_NEED) { fprintf(stderr, "kernel_launch: unexpected n_in %d / ws_size %zu\n", n_in, ws_size); grid_blocks = -1; return; }
        int dev = 0, cus = 0, per_cu = 0;
        (void)hipGetDevice(&dev);
        (void)hipDeviceGetAttribute(&cus, hipDeviceAttributeMultiprocessorCount, dev);
        (void)hipFuncSetAttribute((const void*)mega, hipFuncAttributeMaxDynamicSharedMemorySize, LDS_BYTES);
        (void)hipOccupancyMaxActiveBlocksPerMultiprocessor(&per_cu, (const void*)mega, 512, LDS_BYTES);
        if (per_cu < 1) { fprintf(stderr, "kernel_launch: occupancy query says %d blocks/CU\n", per_cu); per_cu = 1; }
        grid_blocks = cus * per_cu;
        fprintf(stderr, "kernel_launch: cus %d per_cu %d grid %d\n", cus, per_cu, grid_blocks);
    }
    if (grid_blocks < 0) return;
    Params p{};
    for (int i = 0; i < 26; ++i) p.in[i] = (const float*)d_in[i];
    p.out = (float*)d_out; p.ws = (unsigned char*)d_ws;
#if MULTI_LAUNCH
    for (int ph = 0; ph < NPHASE; ++ph) {
        p.ph_lo = ph; p.ph_hi = ph + 1;
        hipLaunchKernelGGL(mega, dim3(grid_blocks), dim3(512), LDS_BYTES, stream, p);
    }
#else
    p.ph_lo = 0; p.ph_hi = NPHASE;
    void* args[] = {&p};
    hipError_t e = hipLaunchCooperativeKernel((const void*)mega, dim3(grid_blocks), dim3(512), args, LDS_BYTES, stream);
    if (e != hipSuccess) fprintf(stderr, "cooperative launch failed: %s (grid %d)\n", hipGetErrorString(e), grid_blocks);
#endif
}
```

```cpp
#include <hip/hip_runtime.h>
#include <hip/hip_cooperative_groups.h>
#include <cstdio>
namespace cg = cooperative_groups;

#ifndef MULTI_LAUNCH
#define MULTI_LAUNCH 0
#endif

#define LAS __attribute__((address_space(3)))
typedef unsigned short bf16_t;
typedef short bf16x8 __attribute__((ext_vector_type(8)));
typedef float f32x4 __attribute__((ext_vector_type(4)));
typedef float f32x2 __attribute__((ext_vector_type(2)));
typedef unsigned u32x4 __attribute__((ext_vector_type(4)));
typedef unsigned u32x2 __attribute__((ext_vector_type(2)));

constexpr int S_ = 16384, D_ = 2048, DR = 1024, NAUG = 6912;
constexpr size_t MiB = 1ull << 20;
constexpr size_t WS_PROJ = 0, WS_H = 216 * MiB, WS_WB1 = 280 * MiB, WS_WQT = 280 * MiB, WS_WOT = 296 * MiB;
constexpr size_t WS_R = 307 * MiB, WS_K = 339 * MiB, WS_V = 371 * MiB, WS_KK = 403 * MiB, WS_A = 435 * MiB, WS_LW = 467 * MiB;
constexpr size_t WS_G = 216 * MiB, WS_YC = 248 * MiB, WS_YMIX = 403 * MiB, WS_X1 = 0, WS_H2 = 128 * MiB, WS_Q = 307 * MiB;
constexpr size_t WS_GT = 0, WS_HT = 32 * MiB, WS_QE = 96 * MiB, WS_YL = 128 * MiB, WS_S0 = 160 * MiB;
constexpr size_t WS_IDS = 192 * MiB, WS_GATES = 200 * MiB, WS_UB = 435 * MiB, WS_VB = 208 * MiB, WS_NEED = 499 * MiB;
constexpr int TLD = 72, TSLOT = 64 * TLD * 2;
constexpr int LDS_BYTES = 16 * TSLOT + 2048 + 256;
constexpr int NPHASE = 11;

struct Params {
    const float* in[26];
    float* out;
    unsigned char* ws;
    int ph_lo, ph_hi;
};

__device__ __forceinline__ float bf2f(bf16_t b) { return __uint_as_float(((unsigned)b) << 16); }
__device__ __forceinline__ bf16_t f2bf(float f) { unsigned u = __float_as_uint(f); u += 0x7FFFu + ((u >> 16) & 1u); return (bf16_t)(u >> 16); }
typedef __bf16 bf16v2_t __attribute__((ext_vector_type(2)));
__device__ __forceinline__ unsigned cvt_pk_bf16(float lo, float hi) { const f32x2 v = {lo, hi}; const bf16v2_t r = __builtin_convertvector(v, bf16v2_t); return __builtin_bit_cast(unsigned, r); }
__device__ __forceinline__ float wave_sum(float v) {
#pragma unroll
    for (int o = 32; o; o >>= 1) v += __shfl_xor(v, o);
    return v;
}
__device__ __forceinline__ float wave_max(float v) {
#pragma unroll
    for (int o = 32; o; o >>= 1) v = fmaxf(v, __shfl_xor(v, o));
    return v;
}
__device__ __forceinline__ float sigmoidf_(float x) { return 1.0f / (1.0f + __expf(-x)); }
__device__ __forceinline__ float gelu_tanh(float x) { float u = 0.7978845608028654f * (x + 0.044715f * x * x * x); return 0.5f * x * (1.0f + tanhf(u)); }
__device__ __forceinline__ float lo_bf(unsigned w) { return __uint_as_float(w << 16); }
__device__ __forceinline__ float hi_bf(unsigned w) { return __uint_as_float(w & 0xffff0000u); }

namespace pg8 {
constexpr int BM = 256, BK = 64, HALF = 128, HTB = HALF * BK * 2, STAGE_BYTES = 8 * HTB, NXCD = 8, WGM = 8;
__device__ __forceinline__ int lds_byte(int r, int c) { const int st = (r >> 4) * 2 + (c >> 5), rr = r & 15, cc = c & 31, ob = rr * 64 + cc * 2; return st * 1024 + (ob ^ (((ob >> 9) & 1) << 5)); }
__device__ __forceinline__ void stage_rc(int b, int& R, int& C) { const int st = b / 1024, sb = b % 1024, swz = sb ^ (((sb >> 9) & 1) << 5); R = (st >> 1) * 16 + swz / 64; C = (st & 1) * 32 + (swz % 64) / 2; }
__device__ __forceinline__ int perm32(int rho) { const int n = rho >> 4, i = rho & 15; return 8 * (i >> 2) + 4 * n + (i & 3); }
struct Unit { int pm, pn; };
struct Gemm { const bf16_t* A; const bf16_t* Bt; int M, N, K; };
struct StaticOrder {
    int nM, nN, nwg, G, c;
    __device__ void init(int M, int N, int G_, int c_) { nM = M / BM; nN = N / BM; nwg = nM * nN; G = G_; c = c_; }
    __device__ bool next(int i, Unit& u) const {
        const long L = (long)i * G + c; if (L >= nwg) return false;
        int wgid = (int)L; { const int q = nwg / NXCD, r = nwg % NXCD, xcd = wgid % NXCD, off = wgid / NXCD; wgid = (xcd < r ? xcd * (q + 1) : r * (q + 1) + (xcd - r) * q) + off; }
        const int nig = WGM * nN, gid = wgid / nig, fm = gid * WGM, gsz = (nM - fm) < WGM ? (nM - fm) : WGM;
        u.pm = fm + ((wgid % nig) % gsz); u.pn = (wgid % nig) / gsz; return true;
    }
    __device__ __forceinline__ void a_ready(const Unit&) const {}
    __device__ __forceinline__ void done(const Unit&) const {}
};
struct EpiResF32 {
    static constexpr bool PERM = false;
    float* C; const float* Res; int ldc;
    __device__ __forceinline__ void operator()(const f32x4 (&acc)[2][2][4][2], const Unit& u, int wr, int wc, int fr, int fq) const {
        const int row0 = u.pm * BM + wr * 64 + fr, col0 = u.pn * BM + wc * 32 + 4 * fq;
#pragma unroll
        for (int ai = 0; ai < 2; ++ai)
#pragma unroll
            for (int m = 0; m < 4; ++m) { const size_t ro = (size_t)(row0 + ai * HALF + m * 16) * ldc + col0;
#pragma unroll
                for (int bj = 0; bj < 2; ++bj)
#pragma unroll
                    for (int n = 0; n < 2; ++n) { const f32x4 rs = *(const f32x4*)(Res + ro + bj * HALF + n * 16); *(f32x4*)(C + ro + bj * HALF + n * 16) = acc[ai][bj][m][n] + rs; } }
    }
};
struct EpiBf16 {
    static constexpr bool PERM = true;
    bf16_t* O; int ldc;
    __device__ __forceinline__ void operator()(const f32x4 (&acc)[2][2][4][2], const Unit& u, int wr, int wc, int fr, int fq) const {
        const int row0 = u.pm * BM + wr * 64 + fr; const int col0 = u.pn * BM + wc * 32 + 8 * fq;
#pragma unroll
        for (int ai = 0; ai < 2; ++ai)
#pragma unroll
            for (int m = 0; m < 4; ++m) { bf16_t* rowp = O + (size_t)(row0 + ai * HALF + m * 16) * ldc + col0;
#pragma unroll
                for (int bj = 0; bj < 2; ++bj) { const f32x4 v0 = acc[ai][bj][m][0], v1 = acc[ai][bj][m][1];
                    u32x4 w; w.x = cvt_pk_bf16(v0[0], v0[1]); w.y = cvt_pk_bf16(v0[2], v0[3]); w.z = cvt_pk_bf16(v1[0], v1[1]); w.w = cvt_pk_bf16(v1[2], v1[3]);
                    *(u32x4*)(rowp + bj * HALF) = w; } }
    }
};

template <class Epi, class Sched>
__device__ __forceinline__ void gemm_phase(LAS unsigned char* lds, const Gemm g, const Sched& S, const Epi& E) {
    const int tid = threadIdx.x, wid = __builtin_amdgcn_readfirstlane(tid >> 6), lane = tid & 63, wr = wid >> 2, wc = wid & 3, fr = lane & 15, fq = lane >> 4;
    const int K = g.K, nt = K / BK;
    unsigned voffA[2], voffB[2];
#pragma unroll
    for (int i = 0; i < 2; ++i) { int R, C; stage_rc(tid * 16 + i * 8192, R, C); const int Rb = Epi::PERM ? ((R & ~31) + perm32(R & 31)) : R;
        voffA[i] = (unsigned)(R * K + C) * 2u; voffB[i] = (unsigned)(Rb * K + C) * 2u; }
    const size_t kstep = (size_t)(BK * 2);
    const size_t hstep = (size_t)HALF * K * 2;
    const size_t tstep = 2 * hstep;
    const unsigned ldsw = (unsigned)wid * 1024u;
    const int aoff = lds_byte(wr * 64 + fr, fq * 8), boff = lds_byte(wc * 32 + fr, fq * 8);
#define PG8_SA(b, h) (((b) * 2 + (h)) * HTB)
#define PG8_SB(b, h) ((4 + (b) * 2 + (h)) * HTB)
#define PG8_STAGE(bufoff, gbase, voff) do { _Pragma("unroll") for (int _i = 0; _i < 2; ++_i) \
        __builtin_amdgcn_global_load_lds((const unsigned*)((const char*)(gbase) + (voff)[_i]), (LAS unsigned*)(lds + (bufoff) + ldsw + _i * 8192), 16, 0, 0); } while (0)
#define PG8_LDA(dst, b, h) do { _Pragma("unroll") for (int m = 0; m < 4; ++m) _Pragma("unroll") for (int k = 0; k < 2; ++k) dst[m][k] = *(const LAS bf16x8*)(lds + PG8_SA(b, h) + aoff + m * 2048 + k * 1024); } while (0)
#define PG8_LDB(dst, b, h) do { _Pragma("unroll") for (int n = 0; n < 2; ++n) _Pragma("unroll") for (int k = 0; k < 2; ++k) dst[n][k] = *(const LAS bf16x8*)(lds + PG8_SB(b, h) + boff + n * 2048 + k * 1024); } while (0)
#define PG8_MMA(ai, bj, At, Bt) do { __builtin_amdgcn_s_setprio(1); _Pragma("unroll") for (int m = 0; m < 4; ++m) _Pragma("unroll") for (int n = 0; n < 2; ++n) _Pragma("unroll") for (int k = 0; k < 2; ++k) \
        acc[ai][bj][m][n] = __builtin_amdgcn_mfma_f32_16x16x32_bf16(Bt[n][k], At[m][k], acc[ai][bj][m][n], 0, 0, 0); __builtin_amdgcn_s_setprio(0); } while (0)
#define PG8_WAIT_V(n) asm volatile("s_waitcnt vmcnt(" #n ")" ::: "memory")
#define PG8_WAIT_L(n) asm volatile("s_waitcnt lgkmcnt(" #n ")" ::: "memory")
#define PG8_BAR __builtin_amdgcn_s_barrier()
#define PG8_SCHED __builtin_amdgcn_sched_barrier(0)
    Unit cur, nxt; int ui = 0;
    if (!S.next(0, cur)) return;
    f32x4 acc[2][2][4][2];
#pragma unroll
    for (int a = 0; a < 2; ++a)
#pragma unroll
        for (int b = 0; b < 2; ++b)
#pragma unroll
            for (int m = 0; m < 4; ++m)
#pragma unroll
                for (int n = 0; n < 2; ++n) acc[a][b][m][n] = (f32x4){0.f, 0.f, 0.f, 0.f};
    bf16x8 At[4][2], B0[2][2], B1[2][2];
    const char* cA = (const char*)g.A + (size_t)cur.pm * tstep; const char* cB = (const char*)g.Bt + (size_t)cur.pn * tstep;
    S.a_ready(cur);
    PG8_STAGE(PG8_SB(0, 0), cB, voffB); PG8_STAGE(PG8_SA(0, 0), cA, voffA); PG8_STAGE(PG8_SB(0, 1), cB + hstep, voffB); PG8_STAGE(PG8_SA(0, 1), cA + hstep, voffA);
    if (wr == 1) PG8_BAR;
    PG8_WAIT_V(4); PG8_BAR;
    PG8_STAGE(PG8_SB(1, 0), cB + kstep, voffB); PG8_STAGE(PG8_SA(1, 0), cA + kstep, voffA); PG8_STAGE(PG8_SB(1, 1), cB + hstep + kstep, voffB);
    PG8_WAIT_V(6); PG8_BAR;
    for (;;) {
        const bool has_next = S.next(ui + 1, nxt);
        const char* nA = has_next ? (const char*)g.A + (size_t)nxt.pm * tstep : cA; const char* nB = has_next ? (const char*)g.Bt + (size_t)nxt.pn * tstep : cB;
        for (int t = 0; t < nt; t += 2) {
            const bool last = (t == nt - 2);
            const char* a1 = cA + (size_t)(t + 1) * kstep;
            const char* a2 = last ? nA : cA + (size_t)(t + 2) * kstep; const char* b2 = last ? nB : cB + (size_t)(t + 2) * kstep;
            const char* a3 = a2 + kstep; const char* b3 = b2 + kstep;
            if (last && has_next) S.a_ready(nxt);
            PG8_LDB(B0, 0, 0); PG8_SCHED; PG8_LDA(At, 0, 0); PG8_STAGE(PG8_SA(1, 1), a1 + hstep, voffA);
            PG8_WAIT_L(8); PG8_BAR; PG8_WAIT_L(0); PG8_MMA(0, 0, At, B0); PG8_BAR; PG8_SCHED;
            PG8_LDB(B1, 0, 1); PG8_STAGE(PG8_SB(0, 0), b2, voffB);
            PG8_BAR; PG8_WAIT_L(0); PG8_MMA(0, 1, At, B1); PG8_BAR;
            PG8_LDA(At, 0, 1); PG8_STAGE(PG8_SA(0, 0), a2, voffA);
            PG8_BAR; PG8_WAIT_L(0); PG8_MMA(1, 0, At, B0); PG8_BAR; PG8_SCHED;
            PG8_STAGE(PG8_SB(0, 1), b2 + hstep, voffB);
            PG8_WAIT_V(6); PG8_BAR; PG8_MMA(1, 1, At, B1); PG8_BAR;
            PG8_LDB(B0, 1, 0); PG8_SCHED; PG8_LDA(At, 1, 0); PG8_STAGE(PG8_SA(0, 1), a2 + hstep, voffA);
            PG8_WAIT_L(8); PG8_BAR; PG8_WAIT_L(0); PG8_MMA(0, 0, At, B0); PG8_BAR; PG8_SCHED;
            PG8_LDB(B1, 1, 1); PG8_STAGE(PG8_SB(1, 0), b3, voffB);
            PG8_BAR; PG8_WAIT_L(0); PG8_MMA(0, 1, At, B1); PG8_BAR;
            PG8_LDA(At, 1, 1); PG8_STAGE(PG8_SA(1, 0), a3, voffA);
            PG8_BAR; PG8_WAIT_L(0); PG8_MMA(1, 0, At, B0); PG8_BAR; PG8_SCHED;
            PG8_STAGE(PG8_SB(1, 1), b3 + hstep, voffB);
            PG8_WAIT_V(6); PG8_BAR; PG8_MMA(1, 1, At, B1); PG8_BAR;
        }
        E(acc, cur, wr, wc, fr, fq); S.done(cur);
        if (!has_next) break;
#pragma unroll
        for (int a = 0; a < 2; ++a)
#pragma unroll
            for (int b = 0; b < 2; ++b)
#pragma unroll
                for (int m = 0; m < 4; ++m)
#pragma unroll
                    for (int n = 0; n < 2; ++n) acc[a][b][m][n] = (f32x4){0.f, 0.f, 0.f, 0.f};
        cur = nxt; cA = nA; cB = nB; ++ui;
    }
    PG8_WAIT_V(0);
    if (wr == 0) PG8_BAR;
    PG8_BAR;
#undef PG8_SA
#undef PG8_SB
#undef PG8_STAGE
#undef PG8_LDA
#undef PG8_LDB
#undef PG8_MMA
#undef PG8_WAIT_V
#undef PG8_WAIT_L
#undef PG8_BAR
#undef PG8_SCHED
}
}

__device__ __forceinline__ void rmsnorm_rows(const float* X, const float* gain, bf16_t* H) {
    const int wave = threadIdx.x >> 6, lane = threadIdx.x & 63;
    for (int row = blockIdx.x * 8 + wave; row < S_; row += gridDim.x * 8) {
        const float4* xr = (const float4*)(X + (size_t)row * D_);
        float4 v[8]; float ss = 0.f;
#pragma unroll
        for (int i = 0; i < 8; ++i) { v[i] = xr[i * 64 + lane]; ss += v[i].x * v[i].x + v[i].y * v[i].y + v[i].z * v[i].z + v[i].w * v[i].w; }
        ss = wave_sum(ss);
        const float sc = rsqrtf(ss * (1.0f / 2048.0f) + 1e-6f);
#pragma unroll
        for (int i = 0; i < 8; ++i) { const float4 g = ((const float4*)gain)[i * 64 + lane];
            u32x2 w; w.x = cvt_pk_bf16(v[i].x * sc * g.x, v[i].y * sc * g.y); w.y = cvt_pk_bf16(v[i].z * sc * g.z, v[i].w * sc * g.w);
            *(u32x2*)(H + (size_t)row * D_ + (i * 64 + lane) * 4) = w; }
    }
}

__device__ __forceinline__ void transpose_convert(const float* W, int K, int N, bf16_t* Bt, float* tile) {
    const int tid = threadIdx.x; const int tk = K / 64, tn = N / 64;
    for (int u = blockIdx.x; u < tk * tn; u += gridDim.x) {
        const int k0 = (u / tn) * 64, n0 = (u % tn) * 64;
        __syncthreads();
#pragma unroll
        for (int i = 0; i < 8; ++i) { const int kk = i * 8 + (tid >> 6), nn = tid & 63; tile[kk * 65 + nn] = W[(size_t)(k0 + kk) * N + n0 + nn]; }
        __syncthreads();
#pragma unroll
        for (int i = 0; i < 4; ++i) { const int nn = i * 16 + (tid >> 5), kp = (tid & 31) * 2;
            *(unsigned*)(Bt + (size_t)(n0 + nn) * K + k0 + kp) = cvt_pk_bf16(tile[kp * 65 + nn], tile[(kp + 1) * 65 + nn]); }
    }
}

__device__ __forceinline__ void convert_flat(const float* src, bf16_t* dst, size_t n) {
    for (size_t i = ((size_t)blockIdx.x * 512 + threadIdx.x) * 8; i < n; i += (size_t)gridDim.x * 512 * 8) {
        const float4 a = *(const float4*)(src + i), b = *(const float4*)(src + i + 4);
        u32x4 w; w.x = cvt_pk_bf16(a.x, a.y); w.y = cvt_pk_bf16(a.z, a.w); w.z = cvt_pk_bf16(b.x, b.y); w.w = cvt_pk_bf16(b.z, b.w);
        *(u32x4*)(dst + i) = w;
    }
}

__device__ __forceinline__ void phase0(const Params& p, unsigned char* shm) {
    bf16_t* WB1 = (bf16_t*)(p.ws + WS_WB1);
    rmsnorm_rows(p.in[0], p.in[1], (bf16_t*)(p.ws + WS_H));
    transpose_convert(p.in[2], 2048, 6144, WB1, (float*)shm);
    const float* mu = p.in[4]; const float* w1 = p.in[6]; const float* a1 = p.in[9]; const float* g1 = p.in[11];
    for (int idx = blockIdx.x * 512 + threadIdx.x; idx < 768 * 2048; idx += gridDim.x * 512) {
        const int j = idx >> 11, k = idx & 2047; float val = 0.f;
        if (j < 128) { const float m = mu[k], w = w1[k * 64 + (j & 63)]; val = (j < 64) ? w * (1.f - m) : w * m; }
        else if (j < 256) { const float m = mu[2048 + k], w = a1[k * 64 + (j & 63)]; val = (j < 192) ? w * (1.f - m) : w * m; }
        else if (j < 576) { const float m = mu[4096 + k]; const int jj = j - 256; const int c = jj < 160 ? jj : jj - 160; const float w = g1[k * 160 + c]; val = jj < 160 ? w * (1.f - m) : w * m; }
        WB1[(size_t)(6144 + j) * 2048 + k] = f2bf(val);
    }
}

__device__ __forceinline__ void phase_prep(const Params& p, unsigned char* shm) {
    float* actT = (float*)shm;
    const bf16_t* P = (const bf16_t*)(p.ws + WS_PROJ);
    bf16_t* R = (bf16_t*)(p.ws + WS_R); bf16_t* Kk = (bf16_t*)(p.ws + WS_K); bf16_t* V = (bf16_t*)(p.ws + WS_V);
    bf16_t* KK = (bf16_t*)(p.ws + WS_KK); bf16_t* A = (bf16_t*)(p.ws + WS_A); bf16_t* LW = (bf16_t*)(p.ws + WS_LW); bf16_t* G = (bf16_t*)(p.ws + WS_G);
    bf16_t* YC = (bf16_t*)(p.ws + WS_YC); const float* cw = p.in[18];
    const float* mu_rkv = p.in[3]; const float* w0 = p.in[5]; const float* w2 = p.in[7]; const float* a0 = p.in[8]; const float* a2 = p.in[10]; const float* g2 = p.in[12];
    const float* k_k = p.in[13]; const float* k_a = p.in[14];
    const int tid = threadIdx.x;
    for (int tile = blockIdx.x; tile < S_ / 16; tile += gridDim.x) {
        const int t0 = tile * 16;
        __syncthreads();
        for (int e = tid; e < 16 * 288; e += 512) {
            const int t = e / 288, j = e % 288; const int tg = t0 + t;
            int ccur, cprev;
            if (j < 64) { ccur = 6144 + j; cprev = 6208 + j; }
            else if (j < 128) { ccur = 6272 + (j - 64); cprev = 6336 + (j - 64); }
            else { ccur = 6400 + (j - 128); cprev = 6560 + (j - 128); }
            float s = bf2f(P[(size_t)tg * NAUG + ccur]);
            if (tg > 0) s += bf2f(P[(size_t)(tg - 1) * NAUG + cprev]);
            const float a = j < 64 ? tanhf(s) : (j < 128 ? s : sigmoidf_(s));
            actT[j * 16 + t] = a;
        }
        __syncthreads();
        float acc[2][16];
#pragma unroll
        for (int ci = 0; ci < 2; ++ci)
#pragma unroll
            for (int t = 0; t < 16; ++t) acc[ci][t] = 0.f;
        for (int j = 0; j < 64; ++j) {
            const float wa = w2[j * 1024 + tid], wb = w2[j * 1024 + 512 + tid];
            const float4* ap = (const float4*)(actT + j * 16);
#pragma unroll
            for (int q = 0; q < 4; ++q) { const float4 a = ap[q];
                acc[0][q * 4 + 0] += a.x * wa; acc[0][q * 4 + 1] += a.y * wa; acc[0][q * 4 + 2] += a.z * wa; acc[0][q * 4 + 3] += a.w * wa;
                acc[1][q * 4 + 0] += a.x * wb; acc[1][q * 4 + 1] += a.y * wb; acc[1][q * 4 + 2] += a.z * wb; acc[1][q * 4 + 3] += a.w * wb; }
        }
#pragma unroll
        for (int ci = 0; ci < 2; ++ci) { const int c = tid + ci * 512; const float w0c = w0[c];
#pragma unroll
            for (int t = 0; t < 16; ++t) { const float x = -(w0c + acc[ci][t]);
                const float sp = fmaxf(x, 0.f) + log1pf(__expf(-fabsf(x)));
                const float wlog = -sp - 0.5f;
                LW[(size_t)(t0 + t) * DR + c] = f2bf(-__expf(wlog)); } }
#pragma unroll
        for (int ci = 0; ci < 2; ++ci)
#pragma unroll
            for (int t = 0; t < 16; ++t) acc[ci][t] = 0.f;
        for (int j = 0; j < 160; ++j) {
            const float wa = g2[j * 1024 + tid], wb = g2[j * 1024 + 512 + tid];
            const float4* ap = (const float4*)(actT + (128 + j) * 16);
#pragma unroll
            for (int q = 0; q < 4; ++q) { const float4 a = ap[q];
                acc[0][q * 4 + 0] += a.x * wa; acc[0][q * 4 + 1] += a.y * wa; acc[0][q * 4 + 2] += a.z * wa; acc[0][q * 4 + 3] += a.w * wa;
                acc[1][q * 4 + 0] += a.x * wb; acc[1][q * 4 + 1] += a.y * wb; acc[1][q * 4 + 2] += a.z * wb; acc[1][q * 4 + 3] += a.w * wb; }
        }
#pragma unroll
        for (int ci = 0; ci < 2; ++ci) { const int c = tid + ci * 512;
#pragma unroll
            for (int t = 0; t < 16; ++t) G[(size_t)(t0 + t) * DR + c] = f2bf(acc[ci][t]); }
#pragma unroll
        for (int ci = 0; ci < 2; ++ci)
#pragma unroll
            for (int t = 0; t < 16; ++t) acc[ci][t] = 0.f;
        for (int j = 0; j < 64; ++j) {
            const float wa = a2[j * 1024 + tid], wb = a2[j * 1024 + 512 + tid];
            const float4* ap = (const float4*)(actT + (64 + j) * 16);
#pragma unroll
            for (int q = 0; q < 4; ++q) { const float4 a = ap[q];
                acc[0][q * 4 + 0] += a.x * wa; acc[0][q * 4 + 1] += a.y * wa; acc[0][q * 4 + 2] += a.z * wa; acc[0][q * 4 + 3] += a.w * wa;
                acc[1][q * 4 + 0] += a.x * wb; acc[1][q * 4 + 1] += a.y * wb; acc[1][q * 4 + 2] += a.z * wb; acc[1][q * 4 + 3] += a.w * wb; }
        }
#pragma unroll
        for (int ci = 0; ci < 2; ++ci) {
            const int c = tid + ci * 512;
            const float a0c = a0[c], mr = mu_rkv[c], mk = mu_rkv[1024 + c], mv = mu_rkv[2048 + c], kkc = k_k[c], kac = k_a[c];
            float pr = 0.f, pk = 0.f, pv = 0.f, u1 = 0.f, u2 = 0.f;
            const float cw0 = cw[c], cw1 = cw[1024 + c], cw2 = cw[2048 + c];
            if (t0 > 0) { const size_t o = (size_t)(t0 - 1) * NAUG + c; pr = bf2f(P[o]); pk = bf2f(P[o + 1024]); pv = bf2f(P[o + 2048]);
                u1 = bf2f(P[o + 4096]) * bf2f(P[o + 5120]); u2 = bf2f(P[o - NAUG + 4096]) * bf2f(P[o - NAUG + 5120]); }
#pragma unroll
            for (int t = 0; t < 16; ++t) {
                const size_t o = (size_t)(t0 + t) * NAUG + c;
                const float cr = bf2f(P[o]), ck = bf2f(P[o + 1024]), cv = bf2f(P[o + 2048]);
                const float r = cr + (pr - cr) * mr, k = ck + (pk - ck) * mk, v = cv + (pv - cv) * mv;
                pr = cr; pk = ck; pv = cv;
                const float a = sigmoidf_(a0c + acc[ci][t]);
                const float kkv = k * kkc;
                const float nrm = sqrtf(wave_sum(kkv * kkv));
                const float kkn = kkv / fmaxf(nrm, 1e-12f);
                const float k2 = k * (1.f + (a - 1.f) * kac);
                const size_t oo = (size_t)(t0 + t) * DR + c;
                R[oo] = f2bf(r); Kk[oo] = f2bf(k2); V[oo] = f2bf(v); KK[oo] = f2bf(kkn); A[oo] = f2bf(a);
                const float u0 = bf2f(P[o + 4096]) * bf2f(P[o + 5120]);
                YC[oo] = f2bf(bf2f(P[o + 3072]) * (cw0 * u2 + cw1 * u1 + cw2 * u0));
                u2 = u1; u1 = u0;
            }
        }
    }
}

#define TILE(i) ((LAS bf16_t*)(lds + (i) * TSLOT))
__device__ __forceinline__ f32x4 mm_tile(f32x4 acc, const LAS bf16_t* A, const LAS bf16_t* Bt, int mi, int ni, int fr, int fq) {
#pragma unroll
    for (int ks = 0; ks < 2; ++ks) {
        const bf16x8 a = *(const LAS bf16x8*)(A + (mi * 16 + fr) * TLD + ks * 32 + fq * 8);
        const bf16x8 b = *(const LAS bf16x8*)(Bt + (ni * 16 + fr) * TLD + ks * 32 + fq * 8);
        acc = __builtin_amdgcn_mfma_f32_16x16x32_bf16(a, b, acc, 0, 0, 0);
    }
    return acc;
}
__device__ __forceinline__ void st_rm(LAS bf16_t* X, f32x4 v, int mi, int ni, int fr, int fq) {
    const unsigned w0 = cvt_pk_bf16(v[0], v[1]), w1 = cvt_pk_bf16(v[2], v[3]);
    LAS bf16_t* q = X + (mi * 16 + fq * 4) * TLD + ni * 16 + fr;
    q[0] = (bf16_t)(w0 & 0xffffu); q[TLD] = (bf16_t)(w0 >> 16); q[2 * TLD] = (bf16_t)(w1 & 0xffffu); q[3 * TLD] = (bf16_t)(w1 >> 16);
}
__device__ __forceinline__ void st_tr(LAS bf16_t* XT, f32x4 v, int mi, int ni, int fr, int fq) {
    u32x2 w; w.x = cvt_pk_bf16(v[0], v[1]); w.y = cvt_pk_bf16(v[2], v[3]);
    *(LAS u32x2*)(XT + (ni * 16 + fr) * TLD + mi * 16 + fq * 4) = w;
}
__device__ __forceinline__ f32x4 ld_rm(const LAS bf16_t* X, int mi, int ni, int fr, int fq) {
    const LAS bf16_t* q = X + (mi * 16 + fq * 4) * TLD + ni * 16 + fr;
    return (f32x4){bf2f(q[0]), bf2f(q[TLD]), bf2f(q[2 * TLD]), bf2f(q[3 * TLD])};
}
__device__ __forceinline__ f32x4 ld_tr(const LAS bf16_t* XT, int mi, int ni, int fr, int fq) {
    const u32x2 w = *(const LAS u32x2*)(XT + (ni * 16 + fr) * TLD + mi * 16 + fq * 4);
    return (f32x4){lo_bf(w.x), hi_bf(w.x), lo_bf(w.y), hi_bf(w.y)};
}
__device__ __forceinline__ u32x4 pack8(const float* f) { u32x4 w; w.x = cvt_pk_bf16(f[0], f[1]); w.y = cvt_pk_bf16(f[2], f[3]); w.z = cvt_pk_bf16(f[4], f[5]); w.w = cvt_pk_bf16(f[6], f[7]); return w; }

__device__ __forceinline__ void phase_chunkA(const Params& p, LAS unsigned char* lds) {
    const int tid = threadIdx.x, w = tid >> 6, lane = tid & 63, fr = lane & 15, fq = lane >> 4;
    const int mi = w >> 1, nb = (w & 1) * 2;
    LAS float* cl = (LAS float*)(lds + 14 * TSLOT);
    LAS float* gs = (LAS float*)(lds + 16 * TSLOT);
    LAS float* wc = gs + 512;
    const bf16_t* R = (const bf16_t*)(p.ws + WS_R); const bf16_t* Kk = (const bf16_t*)(p.ws + WS_K); const bf16_t* V = (const bf16_t*)(p.ws + WS_V);
    const bf16_t* KK = (const bf16_t*)(p.ws + WS_KK); const bf16_t* A = (const bf16_t*)(p.ws + WS_A); const bf16_t* LW = (const bf16_t*)(p.ws + WS_LW);
    bf16_t* GT = (bf16_t*)(p.ws + WS_GT); float* HT = (float*)(p.ws + WS_HT); bf16_t* QE = (bf16_t*)(p.ws + WS_QE); bf16_t* YL = (bf16_t*)(p.ws + WS_YL);
    const f32x4 z4 = (f32x4){0.f, 0.f, 0.f, 0.f};
    for (int item = blockIdx.x; item < 4096; item += gridDim.x) {
        const int c = item >> 4, h = item & 15;
        const size_t gbase = (size_t)(c * 64) * DR + h * 64;
        {
            const int g = w, k = lane;
            float pfx[8]; float run = 0.f;
#pragma unroll
            for (int i = 0; i < 8; ++i) { run += bf2f(LW[gbase + (size_t)(g * 8 + i) * DR + k]); pfx[i] = run; }
            gs[g * 64 + k] = run;
            __syncthreads();
            float off = 0.f;
#pragma unroll
            for (int gg = 0; gg < 7; ++gg) { const float x = gs[gg * 64 + k]; off += (gg < g) ? x : 0.f; }
#pragma unroll
            for (int i = 0; i < 8; ++i) cl[(g * 8 + i) * 64 + k] = off + pfx[i];
            if (g == 7) wc[k] = __expf(off + pfx[7]);
            __syncthreads();
        }
        {
            const int t = tid >> 3, k0 = (tid & 7) * 8;
            const size_t go = gbase + (size_t)t * DR + k0;
            const u32x4 r4 = *(const u32x4*)(R + go), k4 = *(const u32x4*)(Kk + go), v4 = *(const u32x4*)(V + go), kk4 = *(const u32x4*)(KK + go), a4 = *(const u32x4*)(A + go), lw4 = *(const u32x4*)(LW + go);
            float at[8], rt[8], bt[8], kt[8], bh[8], kh[8], vv[8];
#pragma unroll
            for (int i = 0; i < 8; ++i) {
                const int q = i >> 1; const bool hi = i & 1;
                const float rf = hi ? hi_bf(r4[q]) : lo_bf(r4[q]), kf = hi ? hi_bf(k4[q]) : lo_bf(k4[q]), vf = hi ? hi_bf(v4[q]) : lo_bf(v4[q]);
                const float kkf = hi ? hi_bf(kk4[q]) : lo_bf(kk4[q]), af = hi ? hi_bf(a4[q]) : lo_bf(a4[q]), lwf = hi ? hi_bf(lw4[q]) : lo_bf(lw4[q]);
                const float clv = cl[t * 64 + k0 + i], cle = cl[63 * 64 + k0 + i];
                const float e = __expf(clv), ex = __expf(clv - lwf), ei = __expf(-clv), eh = __expf(cle - clv);
                const float bb = kkf * af;
                at[i] = -kkf * ex; rt[i] = rf * e; bt[i] = bb * ei; kt[i] = kf * ei; bh[i] = bb * eh; kh[i] = kf * eh; vv[i] = vf;
            }
            *(LAS u32x4*)(TILE(0) + t * TLD + k0) = pack8(at);
            *(LAS u32x4*)(TILE(2) + t * TLD + k0) = pack8(rt);
            *(LAS u32x4*)(TILE(3) + t * TLD + k0) = pack8(bt);
            *(LAS u32x4*)(TILE(4) + t * TLD + k0) = pack8(kt);
            const u32x4 atp = pack8(at), bhp = pack8(bh), khp = pack8(kh);
#pragma unroll
            for (int i = 0; i < 8; ++i) {
                const int q = i >> 1; const bool hi = i & 1;
                TILE(1)[(k0 + i) * TLD + t] = (bf16_t)(hi ? (atp[q] >> 16) : (atp[q] & 0xffffu));
                TILE(5)[(k0 + i) * TLD + t] = (bf16_t)(hi ? (bhp[q] >> 16) : (bhp[q] & 0xffffu));
                TILE(6)[(k0 + i) * TLD + t] = (bf16_t)(hi ? (khp[q] >> 16) : (khp[q] & 0xffffu));
                TILE(7)[(k0 + i) * TLD + t] = (bf16_t)(hi ? (v4[q] >> 16) : (v4[q] & 0xffffu));
            }
            __syncthreads();
        }
#pragma unroll
        for (int nn = 0; nn < 2; ++nn) {
            const int ni = nb + nn; const int col = ni * 16 + fr, row0 = mi * 16 + fq * 4;
            f32x4 x = mm_tile(z4, TILE(0), TILE(3), mi, ni, fr, fq);
#pragma unroll
            for (int j = 0; j < 4; ++j) x[j] = (col < row0 + j) ? x[j] : 0.f;
            st_rm(TILE(8), x, mi, ni, fr, fq); st_tr(TILE(9), x, mi, ni, fr, fq);
            x = mm_tile(z4, TILE(0), TILE(4), mi, ni, fr, fq);
#pragma unroll
            for (int j = 0; j < 4; ++j) x[j] = (col < row0 + j) ? x[j] : 0.f;
            st_rm(TILE(10), x, mi, ni, fr, fq);
            x = mm_tile(z4, TILE(2), TILE(3), mi, ni, fr, fq);
#pragma unroll
            for (int j = 0; j < 4; ++j) x[j] = (col <= row0 + j) ? x[j] : 0.f;
            st_rm(TILE(11), x, mi, ni, fr, fq);
            x = mm_tile(z4, TILE(2), TILE(4), mi, ni, fr, fq);
#pragma unroll
            for (int j = 0; j < 4; ++j) x[j] = (col <= row0 + j) ? x[j] : 0.f;
            st_rm(TILE(12), x, mi, ni, fr, fq);
        }
        __syncthreads();
#pragma unroll
        for (int nn = 0; nn < 2; ++nn) {
            const int ni = nb + nn;
            st_tr(TILE(13), mm_tile(z4, TILE(10), TILE(7), mi, ni, fr, fq), mi, ni, fr, fq);
            const f32x4 x = mm_tile(z4, TILE(8), TILE(9), mi, ni, fr, fq);
            st_rm(TILE(0), x, mi, ni, fr, fq); st_tr(TILE(3), x, mi, ni, fr, fq);
        }
        __syncthreads();
#pragma unroll
        for (int rd = 0; rd < 5; ++rd) {
            const int tq = (rd & 1) ? 14 : 8, tqo = (rd & 1) ? 8 : 14;
            const int lx = (rd & 1) ? 4 : 0, lxt = (rd & 1) ? 9 : 3, lxo = (rd & 1) ? 0 : 4, lxto = (rd & 1) ? 3 : 9;
#pragma unroll
            for (int nn = 0; nn < 2; ++nn) {
                const int ni = nb + nn;
                f32x4 x = ld_rm(TILE(tq), mi, ni, fr, fq) + ld_rm(TILE(lx), mi, ni, fr, fq);
                x = mm_tile(x, TILE(tq), TILE(lxt), mi, ni, fr, fq);
                st_rm(TILE(tqo), x, mi, ni, fr, fq);
                if (rd < 4) { const f32x4 y = mm_tile(z4, TILE(lx), TILE(lxt), mi, ni, fr, fq); st_rm(TILE(lxo), y, mi, ni, fr, fq); st_tr(TILE(lxto), y, mi, ni, fr, fq); }
            }
            __syncthreads();
        }
#pragma unroll
        for (int nn = 0; nn < 2; ++nn) {
            const int ni = nb + nn;
            st_tr(TILE(10), mm_tile(ld_tr(TILE(1), mi, ni, fr, fq), TILE(14), TILE(1), mi, ni, fr, fq), mi, ni, fr, fq);
            st_tr(TILE(15), mm_tile(ld_tr(TILE(13), mi, ni, fr, fq), TILE(14), TILE(13), mi, ni, fr, fq), mi, ni, fr, fq);
        }
        __syncthreads();
#pragma unroll
        for (int nn = 0; nn < 2; ++nn) {
            const int ni = nb + nn;
            {
                f32x4 x = mm_tile(z4, TILE(5), TILE(10), mi, ni, fr, fq);
                if (mi == ni) {
#pragma unroll
                    for (int j = 0; j < 4; ++j) x[j] += (fq * 4 + j == fr) ? wc[ni * 16 + fr] : 0.f;
                }
                const unsigned w0 = cvt_pk_bf16(x[0], x[1]), w1 = cvt_pk_bf16(x[2], x[3]);
                bf16_t* gp = GT + (size_t)item * 4096 + (size_t)((mi * 2 + (ni >> 1)) * 64 + (fr >> 2) * 16 + fq * 4) * 8 + (ni & 1) * 4 + (fr & 3);
                gp[0] = (bf16_t)(w0 & 0xffffu); gp[8] = (bf16_t)(w0 >> 16); gp[16] = (bf16_t)(w1 & 0xffffu); gp[24] = (bf16_t)(w1 >> 16);
            }
            {
                f32x4 x = mm_tile(z4, TILE(5), TILE(15), mi, ni, fr, fq);
                x = mm_tile(x, TILE(6), TILE(7), mi, ni, fr, fq);
                *(f32x4*)(HT + (size_t)item * 4096 + (size_t)((ni * 4 + mi) * 64 + lane) * 4) = x;
            }
            {
                f32x4 x = ld_tr(TILE(2), mi, ni, fr, fq);
                x = mm_tile(x, TILE(10), TILE(11), mi, ni, fr, fq);
                u32x2 wv; wv.x = cvt_pk_bf16(x[0], x[1]); wv.y = cvt_pk_bf16(x[2], x[3]);
                *(u32x2*)(QE + (size_t)item * 4096 + (ni * 16 + fr) * 64 + mi * 16 + fq * 4) = wv;
            }
            {
                f32x4 x = mm_tile(z4, TILE(11), TILE(15), mi, ni, fr, fq);
                x = mm_tile(x, TILE(12), TILE(7), mi, ni, fr, fq);
                u32x2 wv; wv.x = cvt_pk_bf16(x[0], x[1]); wv.y = cvt_pk_bf16(x[2], x[3]);
                *(u32x2*)(YL + (size_t)item * 4096 + (size_t)((mi * 4 + ni) * 64 + lane) * 4) = wv;
            }
        }
    }
}

__device__ __forceinline__ void phase_seq(const Params& p) {
    if (blockIdx.x >= 64 || threadIdx.x >= 64) return;
    const int head = blockIdx.x >> 2, vt = blockIdx.x & 3, lane = threadIdx.x, fr = lane & 15, fq = lane >> 4;
    const bf16_t* GT = (const bf16_t*)(p.ws + WS_GT); const float* HT = (const float*)(p.ws + WS_HT); bf16_t* S0 = (bf16_t*)(p.ws + WS_S0);
    f32x4 acc[4];
#pragma unroll
    for (int mb = 0; mb < 4; ++mb) acc[mb] = (f32x4){0.f, 0.f, 0.f, 0.f};
    bf16x8 ga[4][2]; f32x4 hh[4];
    {
        const size_t item = head;
#pragma unroll
        for (int mb = 0; mb < 4; ++mb) {
#pragma unroll
            for (int ks = 0; ks < 2; ++ks) ga[mb][ks] = *(const bf16x8*)(GT + item * 4096 + (size_t)((mb * 2 + ks) * 64 + lane) * 8);
            hh[mb] = *(const f32x4*)(HT + item * 4096 + (size_t)((vt * 4 + mb) * 64 + lane) * 4);
        }
    }
    for (int c = 0; c < 256; ++c) {
        const size_t item = (size_t)c * 16 + head;
        const size_t nitem = (size_t)(c < 255 ? c + 1 : c) * 16 + head;
        bf16x8 gn[4][2]; f32x4 hn[4];
#pragma unroll
        for (int mb = 0; mb < 4; ++mb) {
#pragma unroll
            for (int ks = 0; ks < 2; ++ks) gn[mb][ks] = *(const bf16x8*)(GT + nitem * 4096 + (size_t)((mb * 2 + ks) * 64 + lane) * 8);
            hn[mb] = *(const f32x4*)(HT + nitem * 4096 + (size_t)((vt * 4 + mb) * 64 + lane) * 4);
        }
        u32x2 pk[4];
#pragma unroll
        for (int mb = 0; mb < 4; ++mb) { pk[mb].x = cvt_pk_bf16(acc[mb][0], acc[mb][1]); pk[mb].y = cvt_pk_bf16(acc[mb][2], acc[mb][3]);
            *(u32x2*)(S0 + item * 4096 + (vt * 16 + fr) * 64 + mb * 16 + fq * 4) = pk[mb]; }
        u32x4 b0w, b1w; b0w.x = pk[0].x; b0w.y = pk[0].y; b0w.z = pk[1].x; b0w.w = pk[1].y; b1w.x = pk[2].x; b1w.y = pk[2].y; b1w.z = pk[3].x; b1w.w = pk[3].y;
        const bf16x8 b0 = __builtin_bit_cast(bf16x8, b0w), b1 = __builtin_bit_cast(bf16x8, b1w);
#pragma unroll
        for (int mb = 0; mb < 4; ++mb) {
            f32x4 x = __builtin_amdgcn_mfma_f32_16x16x32_bf16(ga[mb][0], b0, hh[mb], 0, 0, 0);
            acc[mb] = __builtin_amdgcn_mfma_f32_16x16x32_bf16(ga[mb][1], b1, x, 0, 0, 0);
        }
#pragma unroll
        for (int mb = 0; mb < 4; ++mb) { ga[mb][0] = gn[mb][0]; ga[mb][1] = gn[mb][1]; hh[mb] = hn[mb]; }
    }
}

__device__ __forceinline__ void phase_chunkY(const Params& p, LAS unsigned char* lds) {
    LAS float* Yb = (LAS float*)lds;
    const int tid = threadIdx.x, w = tid >> 6, lane = tid & 63, fr = lane & 15, fq = lane >> 4;
    const int mi = w >> 1, nb = (w & 1) * 2;
    const bf16_t* R = (const bf16_t*)(p.ws + WS_R); const bf16_t* Kk = (const bf16_t*)(p.ws + WS_K); const bf16_t* V = (const bf16_t*)(p.ws + WS_V);
    const bf16_t* G = (const bf16_t*)(p.ws + WS_G); const bf16_t* YC = (const bf16_t*)(p.ws + WS_YC);
    const bf16_t* QE = (const bf16_t*)(p.ws + WS_QE); const bf16_t* YL = (const bf16_t*)(p.ws + WS_YL); const bf16_t* S0 = (const bf16_t*)(p.ws + WS_S0);
    bf16_t* YM = (bf16_t*)(p.ws + WS_YMIX);
    const float* r_k = p.in[15]; const float* gn_w = p.in[16]; const float* gn_b = p.in[17];
    for (int item = blockIdx.x; item < 4096; item += gridDim.x) {
        const int c = item >> 4, h = item & 15;
        const bf16_t* Qp = QE + (size_t)item * 4096; const bf16_t* Sp = S0 + (size_t)item * 4096; const bf16_t* Yp = YL + (size_t)item * 4096;
        __syncthreads();
#pragma unroll
        for (int nn = 0; nn < 2; ++nn) {
            const int ni = nb + nn;
            const u32x2 yw = *(const u32x2*)(Yp + (size_t)((mi * 4 + ni) * 64 + lane) * 4);
            f32x4 acc = (f32x4){lo_bf(yw.x), hi_bf(yw.x), lo_bf(yw.y), hi_bf(yw.y)};
#pragma unroll
            for (int ks = 0; ks < 2; ++ks) {
                const bf16x8 a = *(const bf16x8*)(Qp + (mi * 16 + fr) * 64 + ks * 32 + fq * 8);
                const bf16x8 b = *(const bf16x8*)(Sp + (ni * 16 + fr) * 64 + ks * 32 + fq * 8);
                acc = __builtin_amdgcn_mfma_f32_16x16x32_bf16(a, b, acc, 0, 0, 0);
            }
#pragma unroll
            for (int j = 0; j < 4; ++j) Yb[(mi * 16 + fq * 4 + j) * 68 + ni * 16 + fr] = acc[j];
        }
        __syncthreads();
        const int ch = h * 64 + lane;
        const float gw = gn_w[ch], gb = gn_b[ch], rk = r_k[ch];
#pragma unroll
        for (int tt = 0; tt < 8; ++tt) {
            const int t = w * 8 + tt; const size_t tg = (size_t)c * 64 + t; const size_t o = tg * DR + ch;
            const float y = Yb[t * 68 + lane];
            const float mean = wave_sum(y) * (1.f / 64.f); const float d = y - mean;
            const float var = wave_sum(d * d) * (1.f / 64.f);
            const float yn = d * rsqrtf(var + 64e-5f) * gw + gb;
            const float r = bf2f(R[o]), k = bf2f(Kk[o]), v = bf2f(V[o]);
            const float bonus = wave_sum(r * k * rk) * v;
            YM[tg * D_ + ch] = f2bf((yn + bonus) * bf2f(G[o]));
            YM[tg * D_ + 1024 + ch] = YC[o];
        }
    }
}

__device__ __forceinline__ void phase_topk(const Params& p, unsigned char* shm) {
    float* sc = (float*)shm;
    float* ts = sc + 64 * 260;
    int* ti = (int*)(ts + 2048);
    const bf16_t* Q = (const bf16_t*)(p.ws + WS_Q); const float* keys = p.in[22];
    int* IDS = (int*)(p.ws + WS_IDS); float* GATES = (float*)(p.ws + WS_GATES);
    const int tid = threadIdx.x, w = tid >> 6, lane = tid & 63, fr = lane & 15, fq = lane >> 4;
    for (int item = blockIdx.x; item < 2048; item += gridDim.x) {
        const int h = item & 7, t0 = (item >> 3) * 64;
        const int c = w >> 2, nb = (w & 3) * 32;
        f32x4 acc[4][2];
#pragma unroll
        for (int m = 0; m < 4; ++m)
#pragma unroll
            for (int n = 0; n < 2; ++n) acc[m][n] = (f32x4){0.f, 0.f, 0.f, 0.f};
        const float* kb = keys + ((size_t)(h * 2 + c) * 128) * 256;
        for (int ks = 0; ks < 8; ++ks) {
            bf16x8 a[4], b[2];
#pragma unroll
            for (int m = 0; m < 4; ++m) a[m] = *(const bf16x8*)(Q + (size_t)(t0 + m * 16 + fr) * 4096 + h * 512 + c * 256 + ks * 32 + fq * 8);
#pragma unroll
            for (int n = 0; n < 2; ++n) { const float4* kp = (const float4*)(kb + (size_t)(nb + n * 16 + fr) * 256 + ks * 32 + fq * 8); const float4 x0 = kp[0], x1 = kp[1];
                u32x4 wv; wv.x = cvt_pk_bf16(x0.x, x0.y); wv.y = cvt_pk_bf16(x0.z, x0.w); wv.z = cvt_pk_bf16(x1.x, x1.y); wv.w = cvt_pk_bf16(x1.z, x1.w);
                b[n] = __builtin_bit_cast(bf16x8, wv); }
#pragma unroll
            for (int m = 0; m < 4; ++m)
#pragma unroll
                for (int n = 0; n < 2; ++n) acc[m][n] = __builtin_amdgcn_mfma_f32_16x16x32_bf16(a[m], b[n], acc[m][n], 0, 0, 0);
        }
        __syncthreads();
#pragma unroll
        for (int m = 0; m < 4; ++m)
#pragma unroll
            for (int n = 0; n < 2; ++n)
#pragma unroll
                for (int j = 0; j < 4; ++j) sc[(m * 16 + fq * 4 + j) * 260 + c * 128 + nb + n * 16 + fr] = acc[m][n][j];
        __syncthreads();
        for (int li = 0; li < 16; ++li) {
            const int list = w * 16 + li; const int tok = list >> 1, cc = list & 1;
            float v0 = sc[tok * 260 + cc * 128 + lane], v1 = sc[tok * 260 + cc * 128 + 64 + lane];
            float myv = 0.f; int myi = 0;
            for (int r = 0; r < 16; ++r) {
                const float m = wave_max(fmaxf(v0, v1));
                const unsigned long long b0 = __ballot(v0 == m);
                int idx;
                if (b0) { const int l = __ffsll((long long)b0) - 1; idx = l; if (lane == l) v0 = -INFINITY; }
                else { const unsigned long long b1 = __ballot(v1 == m); const int l = __ffsll((long long)b1) - 1; idx = 64 + l; if (lane == l) v1 = -INFINITY; }
                if (lane == r) { myv = m; myi = idx; }
            }
            if (lane < 16) { ts[(tok * 2 + cc) * 16 + lane] = myv; ti[(tok * 2 + cc) * 16 + lane] = myi; }
        }
        __syncthreads();
        for (int li = 0; li < 8; ++li) {
            const int tok = w * 8 + li;
            const int i = lane >> 2, j0 = (lane & 3) * 4;
            const float s1 = ts[(tok * 2) * 16 + i];
            float c0 = s1 + ts[(tok * 2 + 1) * 16 + j0], c1 = s1 + ts[(tok * 2 + 1) * 16 + j0 + 1], c2 = s1 + ts[(tok * 2 + 1) * 16 + j0 + 2], c3 = s1 + ts[(tok * 2 + 1) * 16 + j0 + 3];
            float myv = 0.f; int myi = 0;
            for (int r = 0; r < 16; ++r) {
                const float m = wave_max(fmaxf(fmaxf(c0, c1), fmaxf(c2, c3)));
                const bool hit = (c0 == m) || (c1 == m) || (c2 == m) || (c3 == m);
                const unsigned long long bb = __ballot(hit);
                const int l = __ffsll((long long)bb) - 1;
                int jsel = (c0 == m) ? 0 : (c1 == m) ? 1 : (c2 == m) ? 2 : 3;
                const int jb = __shfl(jsel, l & 63);
                if (lane == l) { if (jsel == 0) c0 = -INFINITY; else if (jsel == 1) c1 = -INFINITY; else if (jsel == 2) c2 = -INFINITY; else c3 = -INFINITY; }
                if (lane == r) { myv = m; myi = l * 4 + jb; }
            }
            const float mx = __shfl(myv, 0);
            const float e = (lane < 16) ? __expf(myv - mx) : 0.f;
            const float sum = wave_sum(e);
            if (lane < 16) {
                const int e1 = ti[(tok * 2) * 16 + ((myi >> 4) & 15)], e2 = ti[(tok * 2 + 1) * 16 + (myi & 15)];
                IDS[(size_t)(t0 + tok) * 128 + h * 16 + lane] = (e1 * 128 + e2) & 16383;
                GATES[(size_t)(t0 + tok) * 128 + h * 16 + lane] = e / sum;
            }
        }
    }
}

__device__ __forceinline__ void phase_gather(const Params& p, unsigned char* shm) {
    float* part = (float*)shm;
    float* red = part + 8 * 2048;
    const bf16_t* H2 = (const bf16_t*)(p.ws + WS_H2); const float* X1 = (const float*)(p.ws + WS_X1);
    const bf16_t* UB = (const bf16_t*)(p.ws + WS_UB); const bf16_t* VB = (const bf16_t*)(p.ws + WS_VB);
    const int* IDS = (const int*)(p.ws + WS_IDS); const float* GATES = (const float*)(p.ws + WS_GATES);
    const float* nf = p.in[25];
    const int tid = threadIdx.x, w = tid >> 6, lane = tid & 63;
    for (int t = blockIdx.x; t < S_; t += gridDim.x) {
        float hf[32];
#pragma unroll
        for (int q = 0; q < 4; ++q) { const u32x4 hv = *(const u32x4*)(H2 + (size_t)t * D_ + q * 512 + lane * 8);
#pragma unroll
            for (int i = 0; i < 4; ++i) { hf[q * 8 + 2 * i] = lo_bf(hv[i]); hf[q * 8 + 2 * i + 1] = hi_bf(hv[i]); } }
        const int myid = (lane < 16) ? IDS[(size_t)t * 128 + w * 16 + lane] : 0;
        const float mygate = (lane < 16) ? GATES[(size_t)t * 128 + w * 16 + lane] : 0.f;
        float myact = 0.f;
#pragma unroll 4
        for (int e = 0; e < 16; ++e) {
            const int id = __builtin_amdgcn_readlane(myid, e);
            const bf16_t* ur = UB + (size_t)id * D_ + lane * 8;
            float d = 0.f;
#pragma unroll
            for (int q = 0; q < 4; ++q) { const u32x4 uv = *(const u32x4*)(ur + q * 512);
#pragma unroll
                for (int i = 0; i < 4; ++i) d += lo_bf(uv[i]) * hf[q * 8 + 2 * i] + hi_bf(uv[i]) * hf[q * 8 + 2 * i + 1]; }
            d = wave_sum(d);
            if (lane == e) myact = gelu_tanh(d) * mygate;
        }
        float o[32];
#pragma unroll
        for (int i = 0; i < 32; ++i) o[i] = 0.f;
#pragma unroll 4
        for (int e = 0; e < 16; ++e) {
            const int id = __builtin_amdgcn_readlane(myid, e);
            const float a = __int_as_float(__builtin_amdgcn_readlane(__float_as_int(myact), e));
            const bf16_t* vr = VB + (size_t)id * D_ + lane * 8;
#pragma unroll
            for (int q = 0; q < 4; ++q) { const u32x4 vv = *(const u32x4*)(vr + q * 512);
#pragma unroll
                for (int i = 0; i < 4; ++i) { o[q * 8 + 2 * i] += a * lo_bf(vv[i]); o[q * 8 + 2 * i + 1] += a * hi_bf(vv[i]); } }
        }
        __syncthreads();
#pragma unroll
        for (int q = 0; q < 4; ++q) {
            *(float4*)(part + w * 2048 + q * 512 + lane * 8) = make_float4(o[q * 8], o[q * 8 + 1], o[q * 8 + 2], o[q * 8 + 3]);
            *(float4*)(part + w * 2048 + q * 512 + lane * 8 + 4) = make_float4(o[q * 8 + 4], o[q * 8 + 5], o[q * 8 + 6], o[q * 8 + 7]);
        }
        __syncthreads();
        float4 s = *(const float4*)(X1 + (size_t)t * D_ + tid * 4);
#pragma unroll
        for (int ww = 0; ww < 8; ++ww) { const float4 pp = *(const float4*)(part + ww * 2048 + tid * 4); s.x += pp.x; s.y += pp.y; s.z += pp.z; s.w += pp.w; }
        float ss = wave_sum(s.x * s.x + s.y * s.y + s.z * s.z + s.w * s.w);
        if (lane == 0) red[w] = ss;
        __syncthreads();
        float tot = 0.f;
#pragma unroll
        for (int ww = 0; ww < 8; ++ww) tot += red[ww];
        const float scl = rsqrtf(tot * (1.f / 2048.f) + 1e-6f);
        const float4 g = *(const float4*)(nf + tid * 4);
        *(float4*)(p.out + (size_t)t * D_ + tid * 4) = make_float4(s.x * scl * g.x, s.y * scl * g.y, s.z * scl * g.z, s.w * scl * g.w);
    }
}

__global__ void __launch_bounds__(512, 2) mega(Params p) {
    extern __shared__ __attribute__((aligned(16))) unsigned char shm[];
    cg::grid_group grid = cg::this_grid();
    LAS unsigned char* lds = (LAS unsigned char*)shm;
    const int lo = p.ph_lo, hi = p.ph_hi;
#define IN(k) (lo <= (k) && (k) < hi)
#define SEAM(k) do { if (IN(k) && IN((k) + 1)) grid.sync(); } while (0)
    if (IN(0)) { phase0(p, shm); }
    SEAM(0);
    if (IN(1)) {
        pg8::Gemm g{(const bf16_t*)(p.ws + WS_H), (const bf16_t*)(p.ws + WS_WB1), S_, NAUG, 2048};
        pg8::StaticOrder so; so.init(g.M, g.N, (int)gridDim.x, (int)blockIdx.x);
        pg8::EpiBf16 E{(bf16_t*)(p.ws + WS_PROJ), NAUG};
        pg8::gemm_phase(lds, g, so, E);
    }
    SEAM(1);
    if (IN(2)) {
        phase_prep(p, shm);
        transpose_convert(p.in[21], 2048, 4096, (bf16_t*)(p.ws + WS_WQT), (float*)shm);
        transpose_convert(p.in[19], 2048, 2048, (bf16_t*)(p.ws + WS_WOT), (float*)shm);
    }
    SEAM(2);
    if (IN(3)) { phase_chunkA(p, lds); }
    SEAM(3);
    if (IN(4)) { phase_seq(p); }
    SEAM(4);
    if (IN(5)) { phase_chunkY(p, lds); }
    SEAM(5);
    if (IN(6)) {
        pg8::Gemm g{(const bf16_t*)(p.ws + WS_YMIX), (const bf16_t*)(p.ws + WS_WOT), S_, 2048, 2048};
        pg8::StaticOrder so; so.init(g.M, g.N, (int)gridDim.x, (int)blockIdx.x);
        pg8::EpiResF32 E{(float*)(p.ws + WS_X1), p.in[0], 2048};
        pg8::gemm_phase(lds, g, so, E);
    }
    SEAM(6);
    if (IN(7)) {
        rmsnorm_rows((const float*)(p.ws + WS_X1), p.in[20], (bf16_t*)(p.ws + WS_H2));
        convert_flat(p.in[23], (bf16_t*)(p.ws + WS_UB), (size_t)16384 * 2048);
        convert_flat(p.in[24], (bf16_t*)(p.ws + WS_VB), (size_t)16384 * 2048);
    }
    SEAM(7);
    if (IN(8)) {
        pg8::Gemm g{(const bf16_t*)(p.ws + WS_H2), (const bf16_t*)(p.ws + WS_WQT), S_, 4096, 2048};
        pg8::StaticOrder so; so.init(g.M, g.N, (int)gridDim.x, (int)blockIdx.x);
        pg8::EpiBf16 E{(bf16_t*)(p.ws + WS_Q), 4096};
        pg8::gemm_phase(lds, g, so, E);
    }
    SEAM(8);
    if (IN(9)) { phase_topk(p, shm); }
    SEAM(9);
    if (IN(10)) { phase_gather(p, shm); }
#undef IN
#undef SEAM
}

extern "C" void kernel_launch(void* const* d_in, const int* in_sizes, int n_in, void* d_out, int out_size, void* d_ws, size_t ws_size, hipStream_t stream) {
    static int grid_blocks = 0;
    if (grid_blocks == 0) {
        if (n_in != 26 || ws_size < WS_NEED) { fprintf(stderr, "kernel_launch: unexpected n_in %d / ws_size %zu\n", n_in, ws_size); grid_blocks = -1; return; }
        int dev = 0, cus = 0, per_cu = 0;
        (void)hipGetDevice(&dev);
        (void)hipDeviceGetAttribute(&cus, hipDeviceAttributeMultiprocessorCount, dev);
        (void)hipFuncSetAttribute((const void*)mega, hipFuncAttributeMaxDynamicSharedMemorySize, LDS_BYTES);
        (void)hipOccupancyMaxActiveBlocksPerMultiprocessor(&per_cu, (const void*)mega, 512, LDS_BYTES);
        if (per_cu < 1) { fprintf(stderr, "kernel_launch: occupancy query says %d blocks/CU\n", per_cu); per_cu = 1; }
        grid_blocks = cus * per_cu;
        fprintf(stderr, "kernel_launch: cus %d per_cu %d grid %d\n", cus, per_cu, grid_blocks);
    }
    if (grid_blocks < 0) return;
    Params p{};
    for (int i = 0; i < 26; ++i) p.in[i] = (const float*)d_in[i];
    p.out = (float*)d_out; p.ws = (unsigned char*)d_ws;
#if MULTI_LAUNCH
    for (int ph = 0; ph < NPHASE; ++ph) {
        p.ph_lo = ph; p.ph_hi = ph + 1;
        hipLaunchKernelGGL(mega, dim3(grid_blocks), dim3(512), LDS_BYTES, stream, p);
    }
#else
    p.ph_lo = 0; p.ph_hi = NPHASE;
    void* args[] = {&p};
    hipError_t e = hipLaunchCooperativeKernel((const void*)mega, dim3(grid_blocks), dim3(512), args, LDS_BYTES, stream);
    if (e != hipSuccess) fprintf(stderr, "cooperative launch failed: %s (grid %d)\n", hipGetErrorString(e), grid_blocks);
#endif
}
```

```cpp
#include <hip/hip_runtime.h>
#include <hip/hip_cooperative_groups.h>
#include <cstdio>
namespace cg = cooperative_groups;

#ifndef MULTI_LAUNCH
#define MULTI_LAUNCH 0
#endif

#define LAS __attribute__((address_space(3)))
typedef unsigned short bf16_t;
typedef short bf16x8 __attribute__((ext_vector_type(8)));
typedef float f32x4 __attribute__((ext_vector_type(4)));
typedef float f32x2 __attribute__((ext_vector_type(2)));
typedef unsigned u32x4 __attribute__((ext_vector_type(4)));
typedef unsigned u32x2 __attribute__((ext_vector_type(2)));

constexpr int S_ = 16384, D_ = 2048, DR = 1024, NAUG = 6912;
constexpr size_t MiB = 1ull << 20;
constexpr size_t WS_PROJ = 0, WS_H = 216 * MiB, WS_WB1 = 280 * MiB, WS_WQT = 280 * MiB, WS_WOT = 296 * MiB;
constexpr size_t WS_R = 307 * MiB, WS_K = 339 * MiB, WS_V = 371 * MiB, WS_KK = 403 * MiB, WS_A = 435 * MiB, WS_LW = 467 * MiB;
constexpr size_t WS_G = 216 * MiB, WS_YC = 248 * MiB, WS_YMIX = 403 * MiB, WS_X1 = 0, WS_H2 = 128 * MiB, WS_Q = 307 * MiB;
constexpr size_t WS_GT = 0, WS_HT = 32 * MiB, WS_QE = 96 * MiB, WS_YL = 128 * MiB, WS_S0 = 160 * MiB;
constexpr size_t WS_IDS = 192 * MiB, WS_GATES = 200 * MiB, WS_UB = 435 * MiB, WS_VB = 208 * MiB, WS_NEED = 499 * MiB;
constexpr int TLD = 72, TSLOT = 64 * TLD * 2;
constexpr int LDS_BYTES = 16 * TSLOT + 2048 + 256;
constexpr int NPHASE = 11;

struct Params {
    const float* in[26];
    float* out;
    unsigned char* ws;
    int ph_lo, ph_hi;
};

__device__ __forceinline__ float bf2f(bf16_t b) { return __uint_as_float(((unsigned)b) << 16); }
__device__ __forceinline__ bf16_t f2bf(float f) { unsigned u = __float_as_uint(f); u += 0x7FFFu + ((u >> 16) & 1u); return (bf16_t)(u >> 16); }
typedef __bf16 bf16v2_t __attribute__((ext_vector_type(2)));
__device__ __forceinline__ unsigned cvt_pk_bf16(float lo, float hi) { const f32x2 v = {lo, hi}; const bf16v2_t r = __builtin_convertvector(v, bf16v2_t); return __builtin_bit_cast(unsigned, r); }
__device__ __forceinline__ float wave_sum(float v) {
#pragma unroll
    for (int o = 32; o; o >>= 1) v += __shfl_xor(v, o);
    return v;
}
template <int CTRL, int RM> __device__ __forceinline__ float dpp_f(float v) { return __int_as_float(__builtin_amdgcn_update_dpp(0, __float_as_int(v), CTRL, RM, 0xf, false)); }
__device__ __forceinline__ float wave_sum_dpp(float v) {
    v += dpp_f<0xB1, 0xf>(v); v += dpp_f<0x4E, 0xf>(v); v += dpp_f<0x141, 0xf>(v); v += dpp_f<0x140, 0xf>(v);
    v += dpp_f<0x142, 0xa>(v); v += dpp_f<0x143, 0xc>(v);
    return __int_as_float(__builtin_amdgcn_readlane(__float_as_int(v), 63));
}
__device__ __forceinline__ float wave_max(float v) {
#pragma unroll
    for (int o = 32; o; o >>= 1) v = fmaxf(v, __shfl_xor(v, o));
    return v;
}
__device__ __forceinline__ float sigmoidf_(float x) { return 1.0f / (1.0f + __expf(-x)); }
__device__ __forceinline__ float gelu_tanh(float x) { float u = 0.7978845608028654f * (x + 0.044715f * x * x * x); return 0.5f * x * (1.0f + tanhf(u)); }
__device__ __forceinline__ float lo_bf(unsigned w) { return __uint_as_float(w << 16); }
__device__ __forceinline__ float hi_bf(unsigned w) { return __uint_as_float(w & 0xffff0000u); }

namespace pg8 {
constexpr int BM = 256, BK = 64, HALF = 128, HTB = HALF * BK * 2, STAGE_BYTES = 8 * HTB, NXCD = 8, WGM = 8;
__device__ __forceinline__ int lds_byte(int r, int c) { const int st = (r >> 4) * 2 + (c >> 5), rr = r & 15, cc = c & 31, ob = rr * 64 + cc * 2; return st * 1024 + (ob ^ (((ob >> 9) & 1) << 5)); }
__device__ __forceinline__ void stage_rc(int b, int& R, int& C) { const int st = b / 1024, sb = b % 1024, swz = sb ^ (((sb >> 9) & 1) << 5); R = (st >> 1) * 16 + swz / 64; C = (st & 1) * 32 + (swz % 64) / 2; }
__device__ __forceinline__ int perm32(int rho) { const int n = rho >> 4, i = rho & 15; return 8 * (i >> 2) + 4 * n + (i & 3); }
struct Unit { int pm, pn; };
struct Gemm { const bf16_t* A; const bf16_t* Bt; int M, N, K; };
struct StaticOrder {
    int nM, nN, nwg, G, c;
    __device__ void init(int M, int N, int G_, int c_) { nM = M / BM; nN = N / BM; nwg = nM * nN; G = G_; c = c_; }
    __device__ bool next(int i, Unit& u) const {
        const long L = (long)i * G + c; if (L >= nwg) return false;
        int wgid = (int)L; { const int q = nwg / NXCD, r = nwg % NXCD, xcd = wgid % NXCD, off = wgid / NXCD; wgid = (xcd < r ? xcd * (q + 1) : r * (q + 1) + (xcd - r) * q) + off; }
        const int nig = WGM * nN, gid = wgid / nig, fm = gid * WGM, gsz = (nM - fm) < WGM ? (nM - fm) : WGM;
        u.pm = fm + ((wgid % nig) % gsz); u.pn = (wgid % nig) / gsz; return true;
    }
    __device__ __forceinline__ void a_ready(const Unit&) const {}
    __device__ __forceinline__ void done(const Unit&) const {}
};
struct EpiResF32 {
    static constexpr bool PERM = false;
    float* C; const float* Res; int ldc;
    __device__ __forceinline__ void operator()(const f32x4 (&acc)[2][2][4][2], const Unit& u, int wr, int wc, int fr, int fq) const {
        const int row0 = u.pm * BM + wr * 64 + fr, col0 = u.pn * BM + wc * 32 + 4 * fq;
#pragma unroll
        for (int ai = 0; ai < 2; ++ai)
#pragma unroll
            for (int m = 0; m < 4; ++m) { const size_t ro = (size_t)(row0 + ai * HALF + m * 16) * ldc + col0;
#pragma unroll
                for (int bj = 0; bj < 2; ++bj)
#pragma unroll
                    for (int n = 0; n < 2; ++n) { const f32x4 rs = *(const f32x4*)(Res + ro + bj * HALF + n * 16); *(f32x4*)(C + ro + bj * HALF + n * 16) = acc[ai][bj][m][n] + rs; } }
    }
};
struct EpiBf16 {
    static constexpr bool PERM = true;
    bf16_t* O; int ldc;
    __device__ __forceinline__ void operator()(const f32x4 (&acc)[2][2][4][2], const Unit& u, int wr, int wc, int fr, int fq) const {
        const int row0 = u.pm * BM + wr * 64 + fr; const int col0 = u.pn * BM + wc * 32 + 8 * fq;
#pragma unroll
        for (int ai = 0; ai < 2; ++ai)
#pragma unroll
            for (int m = 0; m < 4; ++m) { bf16_t* rowp = O + (size_t)(row0 + ai * HALF + m * 16) * ldc + col0;
#pragma unroll
                for (int bj = 0; bj < 2; ++bj) { const f32x4 v0 = acc[ai][bj][m][0], v1 = acc[ai][bj][m][1];
                    u32x4 w; w.x = cvt_pk_bf16(v0[0], v0[1]); w.y = cvt_pk_bf16(v0[2], v0[3]); w.z = cvt_pk_bf16(v1[0], v1[1]); w.w = cvt_pk_bf16(v1[2], v1[3]);
                    *(u32x4*)(rowp + bj * HALF) = w; } }
    }
};

template <class Epi, class Sched>
__device__ __forceinline__ void gemm_phase(LAS unsigned char* lds, const Gemm g, const Sched& S, const Epi& E) {
    const int tid = threadIdx.x, wid = __builtin_amdgcn_readfirstlane(tid >> 6), lane = tid & 63, wr = wid >> 2, wc = wid & 3, fr = lane & 15, fq = lane >> 4;
    const int K = g.K, nt = K / BK;
    unsigned voffA[2], voffB[2];
#pragma unroll
    for (int i = 0; i < 2; ++i) { int R, C; stage_rc(tid * 16 + i * 8192, R, C); const int Rb = Epi::PERM ? ((R & ~31) + perm32(R & 31)) : R;
        voffA[i] = (unsigned)(R * K + C) * 2u; voffB[i] = (unsigned)(Rb * K + C) * 2u; }
    const size_t kstep = (size_t)(BK * 2);
    const size_t hstep = (size_t)HALF * K * 2;
    const size_t tstep = 2 * hstep;
    const unsigned ldsw = (unsigned)wid * 1024u;
    const int aoff = lds_byte(wr * 64 + fr, fq * 8), boff = lds_byte(wc * 32 + fr, fq * 8);
#define PG8_SA(b, h) (((b) * 2 + (h)) * HTB)
#define PG8_SB(b, h) ((4 + (b) * 2 + (h)) * HTB)
#define PG8_STAGE(bufoff, gbase, voff) do { _Pragma("unroll") for (int _i = 0; _i < 2; ++_i) \
        __builtin_amdgcn_global_load_lds((const unsigned*)((const char*)(gbase) + (voff)[_i]), (LAS unsigned*)(lds + (bufoff) + ldsw + _i * 8192), 16, 0, 0); } while (0)
#define PG8_LDA(dst, b, h) do { _Pragma("unroll") for (int m = 0; m < 4; ++m) _Pragma("unroll") for (int k = 0; k < 2; ++k) dst[m][k] = *(const LAS bf16x8*)(lds + PG8_SA(b, h) + aoff + m * 2048 + k * 1024); } while (0)
#define PG8_LDB(dst, b, h) do { _Pragma("unroll") for (int n = 0; n < 2; ++n) _Pragma("unroll") for (int k = 0; k < 2; ++k) dst[n][k] = *(const LAS bf16x8*)(lds + PG8_SB(b, h) + boff + n * 2048 + k * 1024); } while (0)
#define PG8_MMA(ai, bj, At, Bt) do { __builtin_amdgcn_s_setprio(1); _Pragma("unroll") for (int m = 0; m < 4; ++m) _Pragma("unroll") for (int n = 0; n < 2; ++n) _Pragma("unroll") for (int k = 0; k < 2; ++k) \
        acc[ai][bj][m][n] = __builtin_amdgcn_mfma_f32_16x16x32_bf16(Bt[n][k], At[m][k], acc[ai][bj][m][n], 0, 0, 0); __builtin_amdgcn_s_setprio(0); } while (0)
#define PG8_WAIT_V(n) asm volatile("s_waitcnt vmcnt(" #n ")" ::: "memory")
#define PG8_WAIT_L(n) asm volatile("s_waitcnt lgkmcnt(" #n ")" ::: "memory")
#define PG8_BAR __builtin_amdgcn_s_barrier()
#define PG8_SCHED __builtin_amdgcn_sched_barrier(0)
    Unit cur, nxt; int ui = 0;
    if (!S.next(0, cur)) return;
    f32x4 acc[2][2][4][2];
#pragma unroll
    for (int a = 0; a < 2; ++a)
#pragma unroll
        for (int b = 0; b < 2; ++b)
#pragma unroll
            for (int m = 0; m < 4; ++m)
#pragma unroll
                for (int n = 0; n < 2; ++n) acc[a][b][m][n] = (f32x4){0.f, 0.f, 0.f, 0.f};
    bf16x8 At[4][2], B0[2][2], B1[2][2];
    const char* cA = (const char*)g.A + (size_t)cur.pm * tstep; const char* cB = (const char*)g.Bt + (size_t)cur.pn * tstep;
    S.a_ready(cur);
    PG8_STAGE(PG8_SB(0, 0), cB, voffB); PG8_STAGE(PG8_SA(0, 0), cA, voffA); PG8_STAGE(PG8_SB(0, 1), cB + hstep, voffB); PG8_STAGE(PG8_SA(0, 1), cA + hstep, voffA);
    if (wr == 1) PG8_BAR;
    PG8_WAIT_V(4); PG8_BAR;
    PG8_STAGE(PG8_SB(1, 0), cB + kstep, voffB); PG8_STAGE(PG8_SA(1, 0), cA + kstep, voffA); PG8_STAGE(PG8_SB(1, 1), cB + hstep + kstep, voffB);
    PG8_WAIT_V(6); PG8_BAR;
    for (;;) {
        const bool has_next = S.next(ui + 1, nxt);
        const char* nA = has_next ? (const char*)g.A + (size_t)nxt.pm * tstep : cA; const char* nB = has_next ? (const char*)g.Bt + (size_t)nxt.pn * tstep : cB;
        for (int t = 0; t < nt; t += 2) {
            const bool last = (t == nt - 2);
            const char* a1 = cA + (size_t)(t + 1) * kstep;
            const char* a2 = last ? nA : cA + (size_t)(t + 2) * kstep; const char* b2 = last ? nB : cB + (size_t)(t + 2) * kstep;
            const char* a3 = a2 + kstep; const char* b3 = b2 + kstep;
            if (last && has_next) S.a_ready(nxt);
            PG8_LDB(B0, 0, 0); PG8_SCHED; PG8_LDA(At, 0, 0); PG8_STAGE(PG8_SA(1, 1), a1 + hstep, voffA);
            PG8_WAIT_L(8); PG8_BAR; PG8_WAIT_L(0); PG8_MMA(0, 0, At, B0); PG8_BAR; PG8_SCHED;
            PG8_LDB(B1, 0, 1); PG8_STAGE(PG8_SB(0, 0), b2, voffB);
            PG8_BAR; PG8_WAIT_L(0); PG8_MMA(0, 1, At, B1); PG8_BAR;
            PG8_LDA(At, 0, 1); PG8_STAGE(PG8_SA(0, 0), a2, voffA);
            PG8_BAR; PG8_WAIT_L(0); PG8_MMA(1, 0, At, B0); PG8_BAR; PG8_SCHED;
            PG8_STAGE(PG8_SB(0, 1), b2 + hstep, voffB);
            PG8_WAIT_V(6); PG8_BAR; PG8_MMA(1, 1, At, B1); PG8_BAR;
            PG8_LDB(B0, 1, 0); PG8_SCHED; PG8_LDA(At, 1, 0); PG8_STAGE(PG8_SA(0, 1), a2 + hstep, voffA);
            PG8_WAIT_L(8); PG8_BAR; PG8_WAIT_L(0); PG8_MMA(0, 0, At, B0); PG8_BAR; PG8_SCHED;
            PG8_LDB(B1, 1, 1); PG8_STAGE(PG8_SB(1, 0), b3, voffB);
            PG8_BAR; PG8_WAIT_L(0); PG8_MMA(0, 1, At, B1); PG8_BAR;
            PG8_LDA(At, 1, 1); PG8_STAGE(PG8_SA(1, 0), a3, voffA);
            PG8_BAR; PG8_WAIT_L(0); PG8_MMA(1, 0, At, B0); PG8_BAR; PG8_SCHED;
            PG8_STAGE(PG8_SB(1, 1), b3 + hstep, voffB);
            PG8_WAIT_V(6); PG8_BAR; PG8_MMA(1, 1, At, B1); PG8_BAR;
        }
        E(acc, cur, wr, wc, fr, fq); S.done(cur);
        if (!has_next) break;
#pragma unroll
        for (int a = 0; a < 2; ++a)
#pragma unroll
            for (int b = 0; b < 2; ++b)
#pragma unroll
                for (int m = 0; m < 4; ++m)
#pragma unroll
                    for (int n = 0; n < 2; ++n) acc[a][b][m][n] = (f32x4){0.f, 0.f, 0.f, 0.f};
        cur = nxt; cA = nA; cB = nB; ++ui;
    }
    PG8_WAIT_V(0);
    if (wr == 0) PG8_BAR;
    PG8_BAR;
#undef PG8_SA
#undef PG8_SB
#undef PG8_STAGE
#undef PG8_LDA
#undef PG8_LDB
#undef PG8_MMA
#undef PG8_WAIT_V
#undef PG8_WAIT_L
#undef PG8_BAR
#undef PG8_SCHED
}
}

__device__ __forceinline__ void rmsnorm_rows(const float* X, const float* gain, bf16_t* H) {
    const int wave = threadIdx.x >> 6, lane = threadIdx.x & 63;
    for (int row = blockIdx.x * 8 + wave; row < S_; row += gridDim.x * 8) {
        const float4* xr = (const float4*)(X + (size_t)row * D_);
        float4 v[8]; float ss = 0.f;
#pragma unroll
        for (int i = 0; i < 8; ++i) { v[i] = xr[i * 64 + lane]; ss += v[i].x * v[i].x + v[i].y * v[i].y + v[i].z * v[i].z + v[i].w * v[i].w; }
        ss = wave_sum(ss);
        const float sc = rsqrtf(ss * (1.0f / 2048.0f) + 1e-6f);
#pragma unroll
        for (int i = 0; i < 8; ++i) { const float4 g = ((const float4*)gain)[i * 64 + lane];
            u32x2 w; w.x = cvt_pk_bf16(v[i].x * sc * g.x, v[i].y * sc * g.y); w.y = cvt_pk_bf16(v[i].z * sc * g.z, v[i].w * sc * g.w);
            *(u32x2*)(H + (size_t)row * D_ + (i * 64 + lane) * 4) = w; }
    }
}

__device__ __forceinline__ void transpose_convert(const float* W, int K, int N, bf16_t* Bt, float* tile) {
    const int tid = threadIdx.x; const int tk = K / 64, tn = N / 64;
    for (int u = blockIdx.x; u < tk * tn; u += gridDim.x) {
        const int k0 = (u / tn) * 64, n0 = (u % tn) * 64;
        __syncthreads();
#pragma unroll
        for (int i = 0; i < 8; ++i) { const int kk = i * 8 + (tid >> 6), nn = tid & 63; tile[kk * 65 + nn] = W[(size_t)(k0 + kk) * N + n0 + nn]; }
        __syncthreads();
#pragma unroll
        for (int i = 0; i < 4; ++i) { const int nn = i * 16 + (tid >> 5), kp = (tid & 31) * 2;
            *(unsigned*)(Bt + (size_t)(n0 + nn) * K + k0 + kp) = cvt_pk_bf16(tile[kp * 65 + nn], tile[(kp + 1) * 65 + nn]); }
    }
}

__device__ __forceinline__ void convert_flat(const float* src, bf16_t* dst, size_t n) {
    for (size_t i = ((size_t)blockIdx.x * 512 + threadIdx.x) * 8; i < n; i += (size_t)gridDim.x * 512 * 8) {
        const float4 a = *(const float4*)(src + i), b = *(const float4*)(src + i + 4);
        u32x4 w; w.x = cvt_pk_bf16(a.x, a.y); w.y = cvt_pk_bf16(a.z, a.w); w.z = cvt_pk_bf16(b.x, b.y); w.w = cvt_pk_bf16(b.z, b.w);
        *(u32x4*)(dst + i) = w;
    }
}

__device__ __forceinline__ void convert_fp8(const float* src, unsigned char* dst, size_t n, float sc) {
    for (size_t i = ((size_t)blockIdx.x * 512 + threadIdx.x) * 16; i < n; i += (size_t)gridDim.x * 512 * 16) {
        u32x4 w;
#pragma unroll
        for (int j = 0; j < 4; ++j) { const float4 a = *(const float4*)(src + i + 4 * j);
            int x = __builtin_amdgcn_cvt_pk_fp8_f32(a.x * sc, a.y * sc, 0, false); x = __builtin_amdgcn_cvt_pk_fp8_f32(a.z * sc, a.w * sc, x, true); w[j] = (unsigned)x; }
        *(u32x4*)(dst + i) = w;
    }
}

__device__ __forceinline__ void phase0(const Params& p, unsigned char* shm) {
    bf16_t* WB1 = (bf16_t*)(p.ws + WS_WB1);
    rmsnorm_rows(p.in[0], p.in[1], (bf16_t*)(p.ws + WS_H));
    transpose_convert(p.in[2], 2048, 6144, WB1, (float*)shm);
    const float* mu = p.in[4]; const float* w1 = p.in[6]; const float* a1 = p.in[9]; const float* g1 = p.in[11];
    for (int idx = blockIdx.x * 512 + threadIdx.x; idx < 768 * 2048; idx += gridDim.x * 512) {
        const int j = idx >> 11, k = idx & 2047; float val = 0.f;
        if (j < 128) { const float m = mu[k], w = w1[k * 64 + (j & 63)]; val = (j < 64) ? w * (1.f - m) : w * m; }
        else if (j < 256) { const float m = mu[2048 + k], w = a1[k * 64 + (j & 63)]; val = (j < 192) ? w * (1.f - m) : w * m; }
        else if (j < 576) { const float m = mu[4096 + k]; const int jj = j - 256; const int c = jj < 160 ? jj : jj - 160; const float w = g1[k * 160 + c]; val = jj < 160 ? w * (1.f - m) : w * m; }
        WB1[(size_t)(6144 + j) * 2048 + k] = f2bf(val);
    }
}

__device__ __forceinline__ void phase_prep(const Params& p, unsigned char* shm) {
    float* actT = (float*)shm;
    const bf16_t* P = (const bf16_t*)(p.ws + WS_PROJ);
    bf16_t* R = (bf16_t*)(p.ws + WS_R); bf16_t* Kk = (bf16_t*)(p.ws + WS_K); bf16_t* V = (bf16_t*)(p.ws + WS_V);
    bf16_t* KK = (bf16_t*)(p.ws + WS_KK); bf16_t* A = (bf16_t*)(p.ws + WS_A); bf16_t* LW = (bf16_t*)(p.ws + WS_LW); bf16_t* G = (bf16_t*)(p.ws + WS_G);
    bf16_t* YC = (bf16_t*)(p.ws + WS_YC); const float* cw = p.in[18];
    const float* mu_rkv = p.in[3]; const float* w0 = p.in[5]; const float* w2 = p.in[7]; const float* a0 = p.in[8]; const float* a2 = p.in[10]; const float* g2 = p.in[12];
    const float* k_k = p.in[13]; const float* k_a = p.in[14];
    const int tid = threadIdx.x;
    for (int tile = blockIdx.x; tile < S_ / 16; tile += gridDim.x) {
        const int t0 = tile * 16;
        __syncthreads();
        for (int e = tid; e < 16 * 288; e += 512) {
            const int t = e / 288, j = e % 288; const int tg = t0 + t;
            int ccur, cprev;
            if (j < 64) { ccur = 6144 + j; cprev = 6208 + j; }
            else if (j < 128) { ccur = 6272 + (j - 64); cprev = 6336 + (j - 64); }
            else { ccur = 6400 + (j - 128); cprev = 6560 + (j - 128); }
            float s = bf2f(P[(size_t)tg * NAUG + ccur]);
            if (tg > 0) s += bf2f(P[(size_t)(tg - 1) * NAUG + cprev]);
            const float a = j < 64 ? tanhf(s) : (j < 128 ? s : sigmoidf_(s));
            actT[j * 16 + t] = a;
        }
        __syncthreads();
        float acc[2][16];
#pragma unroll
        for (int ci = 0; ci < 2; ++ci)
#pragma unroll
            for (int t = 0; t < 16; ++t) acc[ci][t] = 0.f;
        for (int j = 0; j < 64; ++j) {
            const float wa = w2[j * 1024 + tid], wb = w2[j * 1024 + 512 + tid];
            const float4* ap = (const float4*)(actT + j * 16);
#pragma unroll
            for (int q = 0; q < 4; ++q) { const float4 a = ap[q];
                acc[0][q * 4 + 0] += a.x * wa; acc[0][q * 4 + 1] += a.y * wa; acc[0][q * 4 + 2] += a.z * wa; acc[0][q * 4 + 3] += a.w * wa;
                acc[1][q * 4 + 0] += a.x * wb; acc[1][q * 4 + 1] += a.y * wb; acc[1][q * 4 + 2] += a.z * wb; acc[1][q * 4 + 3] += a.w * wb; }
        }
#pragma unroll
        for (int ci = 0; ci < 2; ++ci) { const int c = tid + ci * 512; const float w0c = w0[c];
#pragma unroll
            for (int t = 0; t < 16; ++t) { const float x = -(w0c + acc[ci][t]);
                const float sp = fmaxf(x, 0.f) + log1pf(__expf(-fabsf(x)));
                const float wlog = -sp - 0.5f;
                LW[(size_t)(t0 + t) * DR + c] = f2bf(-__expf(wlog)); } }
#pragma unroll
        for (int ci = 0; ci < 2; ++ci)
#pragma unroll
            for (int t = 0; t < 16; ++t) acc[ci][t] = 0.f;
        for (int j = 0; j < 160; ++j) {
            const float wa = g2[j * 1024 + tid], wb = g2[j * 1024 + 512 + tid];
            const float4* ap = (const float4*)(actT + (128 + j) * 16);
#pragma unroll
            for (int q = 0; q < 4; ++q) { const float4 a = ap[q];
                acc[0][q * 4 + 0] += a.x * wa; acc[0][q * 4 + 1] += a.y * wa; acc[0][q * 4 + 2] += a.z * wa; acc[0][q * 4 + 3] += a.w * wa;
                acc[1][q * 4 + 0] += a.x * wb; acc[1][q * 4 + 1] += a.y * wb; acc[1][q * 4 + 2] += a.z * wb; acc[1][q * 4 + 3] += a.w * wb; }
        }
#pragma unroll
        for (int ci = 0; ci < 2; ++ci) { const int c = tid + ci * 512;
#pragma unroll
            for (int t = 0; t < 16; ++t) G[(size_t)(t0 + t) * DR + c] = f2bf(acc[ci][t]); }
#pragma unroll
        for (int ci = 0; ci < 2; ++ci)
#pragma unroll
            for (int t = 0; t < 16; ++t) acc[ci][t] = 0.f;
        for (int j = 0; j < 64; ++j) {
            const float wa = a2[j * 1024 + tid], wb = a2[j * 1024 + 512 + tid];
            const float4* ap = (const float4*)(actT + (64 + j) * 16);
#pragma unroll
            for (int q = 0; q < 4; ++q) { const float4 a = ap[q];
                acc[0][q * 4 + 0] += a.x * wa; acc[0][q * 4 + 1] += a.y * wa; acc[0][q * 4 + 2] += a.z * wa; acc[0][q * 4 + 3] += a.w * wa;
                acc[1][q * 4 + 0] += a.x * wb; acc[1][q * 4 + 1] += a.y * wb; acc[1][q * 4 + 2] += a.z * wb; acc[1][q * 4 + 3] += a.w * wb; }
        }
#pragma unroll
        for (int ci = 0; ci < 2; ++ci) {
            const int c = tid + ci * 512;
            const float a0c = a0[c], mr = mu_rkv[c], mk = mu_rkv[1024 + c], mv = mu_rkv[2048 + c], kkc = k_k[c], kac = k_a[c];
            float pr = 0.f, pk = 0.f, pv = 0.f, u1 = 0.f, u2 = 0.f;
            const float cw0 = cw[c], cw1 = cw[1024 + c], cw2 = cw[2048 + c];
            if (t0 > 0) { const size_t o = (size_t)(t0 - 1) * NAUG + c; pr = bf2f(P[o]); pk = bf2f(P[o + 1024]); pv = bf2f(P[o + 2048]);
                u1 = bf2f(P[o + 4096]) * bf2f(P[o + 5120]); u2 = bf2f(P[o - NAUG + 4096]) * bf2f(P[o - NAUG + 5120]); }
#pragma unroll
            for (int t = 0; t < 16; ++t) {
                const size_t o = (size_t)(t0 + t) * NAUG + c;
                const float cr = bf2f(P[o]), ck = bf2f(P[o + 1024]), cv = bf2f(P[o + 2048]);
                const float r = cr + (pr - cr) * mr, k = ck + (pk - ck) * mk, v = cv + (pv - cv) * mv;
                pr = cr; pk = ck; pv = cv;
                const float a = sigmoidf_(a0c + acc[ci][t]);
                const float kkv = k * kkc;
                const float nrm = sqrtf(wave_sum(kkv * kkv));
                const float kkn = kkv / fmaxf(nrm, 1e-12f);
                const float k2 = k * (1.f + (a - 1.f) * kac);
                const size_t oo = (size_t)(t0 + t) * DR + c;
                R[oo] = f2bf(r); Kk[oo] = f2bf(k2); V[oo] = f2bf(v); KK[oo] = f2bf(kkn); A[oo] = f2bf(a);
                const float u0 = bf2f(P[o + 4096]) * bf2f(P[o + 5120]);
                YC[oo] = f2bf(bf2f(P[o + 3072]) * (cw0 * u2 + cw1 * u1 + cw2 * u0));
                u2 = u1; u1 = u0;
            }
        }
    }
}

#define TILE(i) ((LAS bf16_t*)(lds + (i) * TSLOT))
__device__ __forceinline__ f32x4 mm_tile(f32x4 acc, const LAS bf16_t* A, const LAS bf16_t* Bt, int mi, int ni, int fr, int fq) {
#pragma unroll
    for (int ks = 0; ks < 2; ++ks) {
        const bf16x8 a = *(const LAS bf16x8*)(A + (mi * 16 + fr) * TLD + ks * 32 + fq * 8);
        const bf16x8 b = *(const LAS bf16x8*)(Bt + (ni * 16 + fr) * TLD + ks * 32 + fq * 8);
        acc = __builtin_amdgcn_mfma_f32_16x16x32_bf16(a, b, acc, 0, 0, 0);
    }
    return acc;
}
__device__ __forceinline__ void st_rm(LAS bf16_t* X, f32x4 v, int mi, int ni, int fr, int fq) {
    const unsigned w0 = cvt_pk_bf16(v[0], v[1]), w1 = cvt_pk_bf16(v[2], v[3]);
    LAS bf16_t* q = X + (mi * 16 + fq * 4) * TLD + ni * 16 + fr;
    q[0] = (bf16_t)(w0 & 0xffffu); q[TLD] = (bf16_t)(w0 >> 16); q[2 * TLD] = (bf16_t)(w1 & 0xffffu); q[3 * TLD] = (bf16_t)(w1 >> 16);
}
__device__ __forceinline__ void st_tr(LAS bf16_t* XT, f32x4 v, int mi, int ni, int fr, int fq) {
    u32x2 w; w.x = cvt_pk_bf16(v[0], v[1]); w.y = cvt_pk_bf16(v[2], v[3]);
    *(LAS u32x2*)(XT + (ni * 16 + fr) * TLD + mi * 16 + fq * 4) = w;
}
__device__ __forceinline__ f32x4 ld_rm(const LAS bf16_t* X, int mi, int ni, int fr, int fq) {
    const LAS bf16_t* q = X + (mi * 16 + fq * 4) * TLD + ni * 16 + fr;
    return (f32x4){bf2f(q[0]), bf2f(q[TLD]), bf2f(q[2 * TLD]), bf2f(q[3 * TLD])};
}
__device__ __forceinline__ f32x4 ld_tr(const LAS bf16_t* XT, int mi, int ni, int fr, int fq) {
    const u32x2 w = *(const LAS u32x2*)(XT + (ni * 16 + fr) * TLD + mi * 16 + fq * 4);
    return (f32x4){lo_bf(w.x), hi_bf(w.x), lo_bf(w.y), hi_bf(w.y)};
}
__device__ __forceinline__ u32x4 pack8(const float* f) { u32x4 w; w.x = cvt_pk_bf16(f[0], f[1]); w.y = cvt_pk_bf16(f[2], f[3]); w.z = cvt_pk_bf16(f[4], f[5]); w.w = cvt_pk_bf16(f[6], f[7]); return w; }

__device__ __forceinline__ void phase_chunkA(const Params& p, LAS unsigned char* lds) {
    const int tid = threadIdx.x, w = tid >> 6, lane = tid & 63, fr = lane & 15, fq = lane >> 4;
    const int mi = w >> 1, nb = (w & 1) * 2;
    LAS float* cl = (LAS float*)(lds + 14 * TSLOT);
    LAS float* gs = (LAS float*)(lds + 16 * TSLOT);
    LAS float* wc = gs + 512;
    const bf16_t* R = (const bf16_t*)(p.ws + WS_R); const bf16_t* Kk = (const bf16_t*)(p.ws + WS_K); const bf16_t* V = (const bf16_t*)(p.ws + WS_V);
    const bf16_t* KK = (const bf16_t*)(p.ws + WS_KK); const bf16_t* A = (const bf16_t*)(p.ws + WS_A); const bf16_t* LW = (const bf16_t*)(p.ws + WS_LW);
    bf16_t* GT = (bf16_t*)(p.ws + WS_GT); float* HT = (float*)(p.ws + WS_HT); bf16_t* QE = (bf16_t*)(p.ws + WS_QE); bf16_t* YL = (bf16_t*)(p.ws + WS_YL);
    const f32x4 z4 = (f32x4){0.f, 0.f, 0.f, 0.f};
    for (int item = blockIdx.x; item < 4096; item += gridDim.x) {
        const int c = item >> 4, h = item & 15;
        const size_t gbase = (size_t)(c * 64) * DR + h * 64;
        {
            const int g = w, k = lane;
            float pfx[8]; float run = 0.f;
#pragma unroll
            for (int i = 0; i < 8; ++i) { run += bf2f(LW[gbase + (size_t)(g * 8 + i) * DR + k]); pfx[i] = run; }
            gs[g * 64 + k] = run;
            __syncthreads();
            float off = 0.f;
#pragma unroll
            for (int gg = 0; gg < 7; ++gg) { const float x = gs[gg * 64 + k]; off += (gg < g) ? x : 0.f; }
#pragma unroll
            for (int i = 0; i < 8; ++i) cl[(g * 8 + i) * 64 + k] = off + pfx[i];
            if (g == 7) wc[k] = __expf(off + pfx[7]);
            __syncthreads();
        }
        {
            const int t = tid >> 3, k0 = (tid & 7) * 8;
            const size_t go = gbase + (size_t)t * DR + k0;
            const u32x4 r4 = *(const u32x4*)(R + go), k4 = *(const u32x4*)(Kk + go), v4 = *(const u32x4*)(V + go), kk4 = *(const u32x4*)(KK + go), a4 = *(const u32x4*)(A + go), lw4 = *(const u32x4*)(LW + go);
            float at[8], rt[8], bt[8], kt[8], bh[8], kh[8], vv[8];
#pragma unroll
            for (int i = 0; i < 8; ++i) {
                const int q = i >> 1; const bool hi = i & 1;
                const float rf = hi ? hi_bf(r4[q]) : lo_bf(r4[q]), kf = hi ? hi_bf(k4[q]) : lo_bf(k4[q]), vf = hi ? hi_bf(v4[q]) : lo_bf(v4[q]);
                const float kkf = hi ? hi_bf(kk4[q]) : lo_bf(kk4[q]), af = hi ? hi_bf(a4[q]) : lo_bf(a4[q]), lwf = hi ? hi_bf(lw4[q]) : lo_bf(lw4[q]);
                const float clv = cl[t * 64 + k0 + i], cle = cl[63 * 64 + k0 + i];
                const float e = __expf(clv), ex = __expf(clv - lwf), ei = __expf(-clv), eh = __expf(cle - clv);
                const float bb = kkf * af;
                at[i] = -kkf * ex; rt[i] = rf * e; bt[i] = bb * ei; kt[i] = kf * ei; bh[i] = bb * eh; kh[i] = kf * eh; vv[i] = vf;
            }
            *(LAS u32x4*)(TILE(0) + t * TLD + k0) = pack8(at);
            *(LAS u32x4*)(TILE(2) + t * TLD + k0) = pack8(rt);
            *(LAS u32x4*)(TILE(3) + t * TLD + k0) = pack8(bt);
            *(LAS u32x4*)(TILE(4) + t * TLD + k0) = pack8(kt);
            const u32x4 atp = pack8(at), bhp = pack8(bh), khp = pack8(kh);
#pragma unroll
            for (int i = 0; i < 8; ++i) {
                const int q = i >> 1; const bool hi = i & 1;
                TILE(1)[(k0 + i) * TLD + t] = (bf16_t)(hi ? (atp[q] >> 16) : (atp[q] & 0xffffu));
                TILE(5)[(k0 + i) * TLD + t] = (bf16_t)(hi ? (bhp[q] >> 16) : (bhp[q] & 0xffffu));
                TILE(6)[(k0 + i) * TLD + t] = (bf16_t)(hi ? (khp[q] >> 16) : (khp[q] & 0xffffu));
                TILE(7)[(k0 + i) * TLD + t] = (bf16_t)(hi ? (v4[q] >> 16) : (v4[q] & 0xffffu));
            }
            __syncthreads();
        }
#pragma unroll
        for (int nn = 0; nn < 2; ++nn) {
            const int ni = nb + nn; const int col = ni * 16 + fr, row0 = mi * 16 + fq * 4;
            f32x4 x = mm_tile(z4, TILE(0), TILE(3), mi, ni, fr, fq);
#pragma unroll
            for (int j = 0; j < 4; ++j) x[j] = (col < row0 + j) ? x[j] : 0.f;
            st_rm(TILE(8), x, mi, ni, fr, fq); st_tr(TILE(9), x, mi, ni, fr, fq);
            x = mm_tile(z4, TILE(0), TILE(4), mi, ni, fr, fq);
#pragma unroll
            for (int j = 0; j < 4; ++j) x[j] = (col < row0 + j) ? x[j] : 0.f;
            st_rm(TILE(10), x, mi, ni, fr, fq);
            x = mm_tile(z4, TILE(2), TILE(3), mi, ni, fr, fq);
#pragma unroll
            for (int j = 0; j < 4; ++j) x[j] = (col <= row0 + j) ? x[j] : 0.f;
            st_rm(TILE(11), x, mi, ni, fr, fq);
            x = mm_tile(z4, TILE(2), TILE(4), mi, ni, fr, fq);
#pragma unroll
            for (int j = 0; j < 4; ++j) x[j] = (col <= row0 + j) ? x[j] : 0.f;
            st_rm(TILE(12), x, mi, ni, fr, fq);
        }
        __syncthreads();
#pragma unroll
        for (int nn = 0; nn < 2; ++nn) {
            const int ni = nb + nn;
            st_tr(TILE(13), mm_tile(z4, TILE(10), TILE(7), mi, ni, fr, fq), mi, ni, fr, fq);
            const f32x4 x = mm_tile(z4, TILE(8), TILE(9), mi, ni, fr, fq);
            st_rm(TILE(0), x, mi, ni, fr, fq); st_tr(TILE(3), x, mi, ni, fr, fq);
        }
        __syncthreads();
#pragma unroll
        for (int rd = 0; rd < 5; ++rd) {
            const int tq = (rd & 1) ? 14 : 8, tqo = (rd & 1) ? 8 : 14;
            const int lx = (rd & 1) ? 4 : 0, lxt = (rd & 1) ? 9 : 3, lxo = (rd & 1) ? 0 : 4, lxto = (rd & 1) ? 3 : 9;
#pragma unroll
            for (int nn = 0; nn < 2; ++nn) {
                const int ni = nb + nn;
                f32x4 x = ld_rm(TILE(tq), mi, ni, fr, fq) + ld_rm(TILE(lx), mi, ni, fr, fq);
                x = mm_tile(x, TILE(tq), TILE(lxt), mi, ni, fr, fq);
                st_rm(TILE(tqo), x, mi, ni, fr, fq);
                if (rd < 4) { const f32x4 y = mm_tile(z4, TILE(lx), TILE(lxt), mi, ni, fr, fq); st_rm(TILE(lxo), y, mi, ni, fr, fq); st_tr(TILE(lxto), y, mi, ni, fr, fq); }
            }
            __syncthreads();
        }
#pragma unroll
        for (int nn = 0; nn < 2; ++nn) {
            const int ni = nb + nn;
            st_tr(TILE(10), mm_tile(ld_tr(TILE(1), mi, ni, fr, fq), TILE(14), TILE(1), mi, ni, fr, fq), mi, ni, fr, fq);
            st_tr(TILE(15), mm_tile(ld_tr(TILE(13), mi, ni, fr, fq), TILE(14), TILE(13), mi, ni, fr, fq), mi, ni, fr, fq);
        }
        __syncthreads();
#pragma unroll
        for (int nn = 0; nn < 2; ++nn) {
            const int ni = nb + nn;
            {
                f32x4 x = mm_tile(z4, TILE(5), TILE(10), mi, ni, fr, fq);
                if (mi == ni) {
#pragma unroll
                    for (int j = 0; j < 4; ++j) x[j] += (fq * 4 + j == fr) ? wc[ni * 16 + fr] : 0.f;
                }
                const unsigned w0 = cvt_pk_bf16(x[0], x[1]), w1 = cvt_pk_bf16(x[2], x[3]);
                bf16_t* gp = GT + (size_t)item * 4096 + (size_t)((mi * 2 + (ni >> 1)) * 64 + (fr >> 2) * 16 + fq * 4) * 8 + (ni & 1) * 4 + (fr & 3);
                gp[0] = (bf16_t)(w0 & 0xffffu); gp[8] = (bf16_t)(w0 >> 16); gp[16] = (bf16_t)(w1 & 0xffffu); gp[24] = (bf16_t)(w1 >> 16);
            }
            {
                f32x4 x = mm_tile(z4, TILE(5), TILE(15), mi, ni, fr, fq);
                x = mm_tile(x, TILE(6), TILE(7), mi, ni, fr, fq);
                *(f32x4*)(HT + (size_t)item * 4096 + (size_t)((ni * 4 + mi) * 64 + lane) * 4) = x;
            }
            {
                f32x4 x = ld_tr(TILE(2), mi, ni, fr, fq);
                x = mm_tile(x, TILE(10), TILE(11), mi, ni, fr, fq);
                u32x2 wv; wv.x = cvt_pk_bf16(x[0], x[1]); wv.y = cvt_pk_bf16(x[2], x[3]);
                *(u32x2*)(QE + (size_t)item * 4096 + (ni * 16 + fr) * 64 + mi * 16 + fq * 4) = wv;
            }
            {
                f32x4 x = mm_tile(z4, TILE(11), TILE(15), mi, ni, fr, fq);
                x = mm_tile(x, TILE(12), TILE(7), mi, ni, fr, fq);
                u32x2 wv; wv.x = cvt_pk_bf16(x[0], x[1]); wv.y = cvt_pk_bf16(x[2], x[3]);
                *(u32x2*)(YL + (size_t)item * 4096 + (size_t)((mi * 4 + ni) * 64 + lane) * 4) = wv;
            }
        }
    }
}

__device__ __forceinline__ void phase_seq(const Params& p) {
    if (blockIdx.x >= 64 || threadIdx.x >= 64) return;
    const int head = blockIdx.x >> 2, vt = blockIdx.x & 3, lane = threadIdx.x, fr = lane & 15, fq = lane >> 4;
    const bf16_t* GT = (const bf16_t*)(p.ws + WS_GT); const float* HT = (const float*)(p.ws + WS_HT); bf16_t* S0 = (bf16_t*)(p.ws + WS_S0);
    f32x4 acc[4];
#pragma unroll
    for (int mb = 0; mb < 4; ++mb) acc[mb] = (f32x4){0.f, 0.f, 0.f, 0.f};
    bf16x8 ga[4][2]; f32x4 hh[4];
    {
        const size_t item = head;
#pragma unroll
        for (int mb = 0; mb < 4; ++mb) {
#pragma unroll
            for (int ks = 0; ks < 2; ++ks) ga[mb][ks] = *(const bf16x8*)(GT + item * 4096 + (size_t)((mb * 2 + ks) * 64 + lane) * 8);
            hh[mb] = *(const f32x4*)(HT + item * 4096 + (size_t)((vt * 4 + mb) * 64 + lane) * 4);
        }
    }
    for (int c = 0; c < 256; ++c) {
        const size_t item = (size_t)c * 16 + head;
        const size_t nitem = (size_t)(c < 255 ? c + 1 : c) * 16 + head;
        bf16x8 gn[4][2]; f32x4 hn[4];
#pragma unroll
        for (int mb = 0; mb < 4; ++mb) {
#pragma unroll
            for (int ks = 0; ks < 2; ++ks) gn[mb][ks] = *(const bf16x8*)(GT + nitem * 4096 + (size_t)((mb * 2 + ks) * 64 + lane) * 8);
            hn[mb] = *(const f32x4*)(HT + nitem * 4096 + (size_t)((vt * 4 + mb) * 64 + lane) * 4);
        }
        u32x2 pk[4];
#pragma unroll
        for (int mb = 0; mb < 4; ++mb) { pk[mb].x = cvt_pk_bf16(acc[mb][0], acc[mb][1]); pk[mb].y = cvt_pk_bf16(acc[mb][2], acc[mb][3]);
            *(u32x2*)(S0 + item * 4096 + (vt * 16 + fr) * 64 + mb * 16 + fq * 4) = pk[mb]; }
        u32x4 b0w, b1w; b0w.x = pk[0].x; b0w.y = pk[0].y; b0w.z = pk[1].x; b0w.w = pk[1].y; b1w.x = pk[2].x; b1w.y = pk[2].y; b1w.z = pk[3].x; b1w.w = pk[3].y;
        const bf16x8 b0 = __builtin_bit_cast(bf16x8, b0w), b1 = __builtin_bit_cast(bf16x8, b1w);
#pragma unroll
        for (int mb = 0; mb < 4; ++mb) {
            f32x4 x = __builtin_amdgcn_mfma_f32_16x16x32_bf16(ga[mb][0], b0, hh[mb], 0, 0, 0);
            acc[mb] = __builtin_amdgcn_mfma_f32_16x16x32_bf16(ga[mb][1], b1, x, 0, 0, 0);
        }
#pragma unroll
        for (int mb = 0; mb < 4; ++mb) { ga[mb][0] = gn[mb][0]; ga[mb][1] = gn[mb][1]; hh[mb] = hn[mb]; }
    }
}

__device__ __forceinline__ void phase_chunkY(const Params& p, LAS unsigned char* lds) {
    LAS float* Yb = (LAS float*)lds;
    const int tid = threadIdx.x, w = tid >> 6, lane = tid & 63, fr = lane & 15, fq = lane >> 4;
    const int mi = w >> 1, nb = (w & 1) * 2;
    const bf16_t* R = (const bf16_t*)(p.ws + WS_R); const bf16_t* Kk = (const bf16_t*)(p.ws + WS_K); const bf16_t* V = (const bf16_t*)(p.ws + WS_V);
    const bf16_t* G = (const bf16_t*)(p.ws + WS_G); const bf16_t* YC = (const bf16_t*)(p.ws + WS_YC);
    const bf16_t* QE = (const bf16_t*)(p.ws + WS_QE); const bf16_t* YL = (const bf16_t*)(p.ws + WS_YL); const bf16_t* S0 = (const bf16_t*)(p.ws + WS_S0);
    bf16_t* YM = (bf16_t*)(p.ws + WS_YMIX);
    const float* r_k = p.in[15]; const float* gn_w = p.in[16]; const float* gn_b = p.in[17];
    for (int item = blockIdx.x; item < 4096; item += gridDim.x) {
        const int c = item >> 4, h = item & 15;
        const bf16_t* Qp = QE + (size_t)item * 4096; const bf16_t* Sp = S0 + (size_t)item * 4096; const bf16_t* Yp = YL + (size_t)item * 4096;
        __syncthreads();
#pragma unroll
        for (int nn = 0; nn < 2; ++nn) {
            const int ni = nb + nn;
            const u32x2 yw = *(const u32x2*)(Yp + (size_t)((mi * 4 + ni) * 64 + lane) * 4);
            f32x4 acc = (f32x4){lo_bf(yw.x), hi_bf(yw.x), lo_bf(yw.y), hi_bf(yw.y)};
#pragma unroll
            for (int ks = 0; ks < 2; ++ks) {
                const bf16x8 a = *(const bf16x8*)(Qp + (mi * 16 + fr) * 64 + ks * 32 + fq * 8);
                const bf16x8 b = *(const bf16x8*)(Sp + (ni * 16 + fr) * 64 + ks * 32 + fq * 8);
                acc = __builtin_amdgcn_mfma_f32_16x16x32_bf16(a, b, acc, 0, 0, 0);
            }
#pragma unroll
            for (int j = 0; j < 4; ++j) Yb[(mi * 16 + fq * 4 + j) * 68 + ni * 16 + fr] = acc[j];
        }
        __syncthreads();
        const int ch = h * 64 + lane;
        const float gw = gn_w[ch], gb = gn_b[ch], rk = r_k[ch];
#pragma unroll
        for (int tt = 0; tt < 8; ++tt) {
            const int t = w * 8 + tt; const size_t tg = (size_t)c * 64 + t; const size_t o = tg * DR + ch;
            const float y = Yb[t * 68 + lane];
            const float mean = wave_sum(y) * (1.f / 64.f); const float d = y - mean;
            const float var = wave_sum(d * d) * (1.f / 64.f);
            const float yn = d * rsqrtf(var + 64e-5f) * gw + gb;
            const float r = bf2f(R[o]), k = bf2f(Kk[o]), v = bf2f(V[o]);
            const float bonus = wave_sum(r * k * rk) * v;
            YM[tg * D_ + ch] = f2bf((yn + bonus) * bf2f(G[o]));
            YM[tg * D_ + 1024 + ch] = YC[o];
        }
    }
}

__device__ __forceinline__ void phase_topk(const Params& p, unsigned char* shm) {
    float* sc = (float*)shm;
    float* ts = sc + 64 * 260;
    int* ti = (int*)(ts + 2048);
    const bf16_t* Q = (const bf16_t*)(p.ws + WS_Q); const float* keys = p.in[22];
    int* IDS = (int*)(p.ws + WS_IDS); float* GATES = (float*)(p.ws + WS_GATES);
    const int tid = threadIdx.x, w = tid >> 6, lane = tid & 63, fr = lane & 15, fq = lane >> 4;
    for (int item = blockIdx.x; item < 2048; item += gridDim.x) {
        const int h = item & 7, t0 = (item >> 3) * 64;
        const int c = w >> 2, nb = (w & 3) * 32;
        f32x4 acc[4][2];
#pragma unroll
        for (int m = 0; m < 4; ++m)
#pragma unroll
            for (int n = 0; n < 2; ++n) acc[m][n] = (f32x4){0.f, 0.f, 0.f, 0.f};
        const float* kb = keys + ((size_t)(h * 2 + c) * 128) * 256;
        for (int ks = 0; ks < 8; ++ks) {
            bf16x8 a[4], b[2];
#pragma unroll
            for (int m = 0; m < 4; ++m) a[m] = *(const bf16x8*)(Q + (size_t)(t0 + m * 16 + fr) * 4096 + h * 512 + c * 256 + ks * 32 + fq * 8);
#pragma unroll
            for (int n = 0; n < 2; ++n) { const float4* kp = (const float4*)(kb + (size_t)(nb + n * 16 + fr) * 256 + ks * 32 + fq * 8); const float4 x0 = kp[0], x1 = kp[1];
                u32x4 wv; wv.x = cvt_pk_bf16(x0.x, x0.y); wv.y = cvt_pk_bf16(x0.z, x0.w); wv.z = cvt_pk_bf16(x1.x, x1.y); wv.w = cvt_pk_bf16(x1.z, x1.w);
                b[n] = __builtin_bit_cast(bf16x8, wv); }
#pragma unroll
            for (int m = 0; m < 4; ++m)
#pragma unroll
                for (int n = 0; n < 2; ++n) acc[m][n] = __builtin_amdgcn_mfma_f32_16x16x32_bf16(a[m], b[n], acc[m][n], 0, 0, 0);
        }
        __syncthreads();
#pragma unroll
        for (int m = 0; m < 4; ++m)
#pragma unroll
            for (int n = 0; n < 2; ++n)
#pragma unroll
                for (int j = 0; j < 4; ++j) sc[(m * 16 + fq * 4 + j) * 260 + c * 128 + nb + n * 16 + fr] = acc[m][n][j];
        __syncthreads();
        for (int li = 0; li < 16; ++li) {
            const int list = w * 16 + li; const int tok = list >> 1, cc = list & 1;
            float v0 = sc[tok * 260 + cc * 128 + lane], v1 = sc[tok * 260 + cc * 128 + 64 + lane];
            float myv = 0.f; int myi = 0;
            for (int r = 0; r < 16; ++r) {
                const float m = wave_max(fmaxf(v0, v1));
                const unsigned long long b0 = __ballot(v0 == m);
                int idx;
                if (b0) { const int l = __ffsll((long long)b0) - 1; idx = l; if (lane == l) v0 = -INFINITY; }
                else { const unsigned long long b1 = __ballot(v1 == m); const int l = __ffsll((long long)b1) - 1; idx = 64 + l; if (lane == l) v1 = -INFINITY; }
                if (lane == r) { myv = m; myi = idx; }
            }
            if (lane < 16) { ts[(tok * 2 + cc) * 16 + lane] = myv; ti[(tok * 2 + cc) * 16 + lane] = myi; }
        }
        __syncthreads();
        for (int li = 0; li < 8; ++li) {
            const int tok = w * 8 + li;
            const int i = lane >> 2, j0 = (lane & 3) * 4;
            const float s1 = ts[(tok * 2) * 16 + i];
            float c0 = s1 + ts[(tok * 2 + 1) * 16 + j0], c1 = s1 + ts[(tok * 2 + 1) * 16 + j0 + 1], c2 = s1 + ts[(tok * 2 + 1) * 16 + j0 + 2], c3 = s1 + ts[(tok * 2 + 1) * 16 + j0 + 3];
            float myv = 0.f; int myi = 0;
            for (int r = 0; r < 16; ++r) {
                const float m = wave_max(fmaxf(fmaxf(c0, c1), fmaxf(c2, c3)));
                const bool hit = (c0 == m) || (c1 == m) || (c2 == m) || (c3 == m);
                const unsigned long long bb = __ballot(hit);
                const int l = __ffsll((long long)bb) - 1;
                int jsel = (c0 == m) ? 0 : (c1 == m) ? 1 : (c2 == m) ? 2 : 3;
                const int jb = __shfl(jsel, l & 63);
                if (lane == l) { if (jsel == 0) c0 = -INFINITY; else if (jsel == 1) c1 = -INFINITY; else if (jsel == 2) c2 = -INFINITY; else c3 = -INFINITY; }
                if (lane == r) { myv = m; myi = l * 4 + jb; }
            }
            const float mx = __shfl(myv, 0);
            const float e = (lane < 16) ? __expf(myv - mx) : 0.f;
            const float sum = wave_sum(e);
            if (lane < 16) {
                const int e1 = ti[(tok * 2) * 16 + ((myi >> 4) & 15)], e2 = ti[(tok * 2 + 1) * 16 + (myi & 15)];
                IDS[(size_t)(t0 + tok) * 128 + h * 16 + lane] = (e1 * 128 + e2) & 16383;
                GATES[(size_t)(t0 + tok) * 128 + h * 16 + lane] = e / sum;
            }
        }
    }
}

constexpr float U8_SCALE = 64.f, V8_SCALE = 32.f;
__device__ __forceinline__ void phase_gather(const Params& p, unsigned char* shm) {
    float* part = (float*)shm;
    float* red = part + 8 * 2048;
    const bf16_t* H2 = (const bf16_t*)(p.ws + WS_H2); const float* X1 = (const float*)(p.ws + WS_X1);
    const unsigned char* U8 = p.ws + WS_UB; const unsigned char* V8 = p.ws + WS_VB;
    const int* IDS = (const int*)(p.ws + WS_IDS); const float* GATES = (const float*)(p.ws + WS_GATES);
    const float* nf = p.in[25];
    const int tid = threadIdx.x, w = tid >> 6, lane = tid & 63;
    for (int t = blockIdx.x; t < S_; t += gridDim.x) {
        float hf[32];
#pragma unroll
        for (int q = 0; q < 2; ++q)
#pragma unroll
            for (int hh = 0; hh < 2; ++hh) { const u32x4 hv = *(const u32x4*)(H2 + (size_t)t * D_ + q * 1024 + lane * 16 + hh * 8);
#pragma unroll
                for (int i = 0; i < 4; ++i) { hf[q * 16 + hh * 8 + 2 * i] = lo_bf(hv[i]); hf[q * 16 + hh * 8 + 2 * i + 1] = hi_bf(hv[i]); } }
        const int myid = (lane < 16) ? IDS[(size_t)t * 128 + w * 16 + lane] : 0;
        const float mygate = (lane < 16) ? GATES[(size_t)t * 128 + w * 16 + lane] : 0.f;
        float myact = 0.f;
#pragma unroll 8
        for (int e = 0; e < 16; ++e) {
            const int id = __builtin_amdgcn_readlane(myid, e);
            const unsigned char* ur = U8 + (size_t)id * D_ + lane * 16;
            float d = 0.f;
#pragma unroll
            for (int q = 0; q < 2; ++q) { const u32x4 uv = *(const u32x4*)(ur + q * 1024);
#pragma unroll
                for (int i = 0; i < 4; ++i) { const f32x2 a = __builtin_amdgcn_cvt_pk_f32_fp8((int)uv[i], false), b = __builtin_amdgcn_cvt_pk_f32_fp8((int)uv[i], true);
                    d += a.x * hf[q * 16 + 4 * i] + a.y * hf[q * 16 + 4 * i + 1] + b.x * hf[q * 16 + 4 * i + 2] + b.y * hf[q * 16 + 4 * i + 3]; } }
            d = wave_sum_dpp(d) * (1.f / U8_SCALE);
            if (lane == e) myact = gelu_tanh(d) * mygate * (1.f / V8_SCALE);
        }
        float o[32];
#pragma unroll
        for (int i = 0; i < 32; ++i) o[i] = 0.f;
#pragma unroll 8
        for (int e = 0; e < 16; ++e) {
            const int id = __builtin_amdgcn_readlane(myid, e);
            const float a = __int_as_float(__builtin_amdgcn_readlane(__float_as_int(myact), e));
            const unsigned char* vr = V8 + (size_t)id * D_ + lane * 16;
#pragma unroll
            for (int q = 0; q < 2; ++q) { const u32x4 vv = *(const u32x4*)(vr + q * 1024);
#pragma unroll
                for (int i = 0; i < 4; ++i) { const f32x2 x = __builtin_amdgcn_cvt_pk_f32_fp8((int)vv[i], false), y = __builtin_amdgcn_cvt_pk_f32_fp8((int)vv[i], true);
                    o[q * 16 + 4 * i] += a * x.x; o[q * 16 + 4 * i + 1] += a * x.y; o[q * 16 + 4 * i + 2] += a * y.x; o[q * 16 + 4 * i + 3] += a * y.y; } }
        }
        __syncthreads();
#pragma unroll
        for (int q = 0; q < 2; ++q)
#pragma unroll
            for (int i = 0; i < 4; ++i)
                *(float4*)(part + w * 2048 + q * 1024 + lane * 16 + 4 * i) = make_float4(o[q * 16 + 4 * i], o[q * 16 + 4 * i + 1], o[q * 16 + 4 * i + 2], o[q * 16 + 4 * i + 3]);
        __syncthreads();
        float4 s = *(const float4*)(X1 + (size_t)t * D_ + tid * 4);
#pragma unroll
        for (int ww = 0; ww < 8; ++ww) { const float4 pp = *(const float4*)(part + ww * 2048 + tid * 4); s.x += pp.x; s.y += pp.y; s.z += pp.z; s.w += pp.w; }
        float ss = wave_sum_dpp(s.x * s.x + s.y * s.y + s.z * s.z + s.w * s.w);
        if (lane == 0) red[w] = ss;
        __syncthreads();
        float tot = 0.f;
#pragma unroll
        for (int ww = 0; ww < 8; ++ww) tot += red[ww];
        const float scl = rsqrtf(tot * (1.f / 2048.f) + 1e-6f);
        const float4 g = *(const float4*)(nf + tid * 4);
        *(float4*)(p.out + (size_t)t * D_ + tid * 4) = make_float4(s.x * scl * g.x, s.y * scl * g.y, s.z * scl * g.z, s.w * scl * g.w);
    }
}

__global__ void __launch_bounds__(512, 2) mega(Params p) {
    extern __shared__ __attribute__((aligned(16))) unsigned char shm[];
    cg::grid_group grid = cg::this_grid();
    LAS unsigned char* lds = (LAS unsigned char*)shm;
    const int lo = p.ph_lo, hi = p.ph_hi;
#define IN(k) (lo <= (k) && (k) < hi)
#define SEAM(k) do { if (IN(k) && IN((k) + 1)) grid.sync(); } while (0)
    if (IN(0)) { phase0(p, shm); }
    SEAM(0);
    if (IN(1)) {
        pg8::Gemm g{(const bf16_t*)(p.ws + WS_H), (const bf16_t*)(p.ws + WS_WB1), S_, NAUG, 2048};
        pg8::StaticOrder so; so.init(g.M, g.N, (int)gridDim.x, (int)blockIdx.x);
        pg8::EpiBf16 E{(bf16_t*)(p.ws + WS_PROJ), NAUG};
        pg8::gemm_phase(lds, g, so, E);
    }
    SEAM(1);
    if (IN(2)) {
        phase_prep(p, shm);
        transpose_convert(p.in[21], 2048, 4096, (bf16_t*)(p.ws + WS_WQT), (float*)shm);
        transpose_convert(p.in[19], 2048, 2048, (bf16_t*)(p.ws + WS_WOT), (float*)shm);
    }
    SEAM(2);
    if (IN(3)) { phase_chunkA(p, lds); }
    SEAM(3);
    if (IN(4)) { phase_seq(p); }
    SEAM(4);
    if (IN(5)) { phase_chunkY(p, lds); }
    SEAM(5);
    if (IN(6)) {
        pg8::Gemm g{(const bf16_t*)(p.ws + WS_YMIX), (const bf16_t*)(p.ws + WS_WOT), S_, 2048, 2048};
        pg8::StaticOrder so; so.init(g.M, g.N, (int)gridDim.x, (int)blockIdx.x);
        pg8::EpiResF32 E{(float*)(p.ws + WS_X1), p.in[0], 2048};
        pg8::gemm_phase(lds, g, so, E);
    }
    SEAM(6);
    if (IN(7)) {
        rmsnorm_rows((const float*)(p.ws + WS_X1), p.in[20], (bf16_t*)(p.ws + WS_H2));
        convert_fp8(p.in[23], p.ws + WS_UB, (size_t)16384 * 2048, U8_SCALE);
        convert_fp8(p.in[24], p.ws + WS_VB, (size_t)16384 * 2048, V8_SCALE);
    }
    SEAM(7);
    if (IN(8)) {
        pg8::Gemm g{(const bf16_t*)(p.ws + WS_H2), (const bf16_t*)(p.ws + WS_WQT), S_, 4096, 2048};
        pg8::StaticOrder so; so.init(g.M, g.N, (int)gridDim.x, (int)blockIdx.x);
        pg8::EpiBf16 E{(bf16_t*)(p.ws + WS_Q), 4096};
        pg8::gemm_phase(lds, g, so, E);
    }
    SEAM(8);
    if (IN(9)) { phase_topk(p, shm); }
    SEAM(9);
    if (IN(10)) { phase_gather(p, shm); }
#undef IN
#undef SEAM
}

extern "C" void kernel_launch(void* const* d_in, const int* in_sizes, int n_in, void* d_out, int out_size, void* d_ws, size_t ws_size, hipStream_t stream) {
    static int grid_blocks = 0;
    if (grid_blocks == 0) {
        if (n_in != 26 || ws_size < WS_NEED) { fprintf(stderr, "kernel_launch: unexpected n_in %d / ws_size %zu\n", n_in, ws_size); grid_blocks = -1; return; }
        int dev = 0, cus = 0, per_cu = 0;
        (void)hipGetDevice(&dev);
        (void)hipDeviceGetAttribute(&cus, hipDeviceAttributeMultiprocessorCount, dev);
        (void)hipFuncSetAttribute((const void*)mega, hipFuncAttributeMaxDynamicSharedMemorySize, LDS_BYTES);
        (void)hipOccupancyMaxActiveBlocksPerMultiprocessor(&per_cu, (const void*)mega, 512, LDS_BYTES);
        if (per_cu < 1) { fprintf(stderr, "kernel_launch: occupancy query says %d blocks/CU\n", per_cu); per_cu = 1; }
        grid_blocks = cus * per_cu;
        fprintf(stderr, "kernel_launch: cus %d per_cu %d grid %d\n", cus, per_cu, grid_blocks);
    }
    if (grid_blocks < 0) return;
    Params p{};
    for (int i = 0; i < 26; ++i) p.in[i] = (const float*)d_in[i];
    p.out = (float*)d_out; p.ws = (unsigned char*)d_ws;
#if MULTI_LAUNCH
    for (int ph = 0; ph < NPHASE; ++ph) {
        p.ph_lo = ph; p.ph_hi = ph + 1;
        hipLaunchKernelGGL(mega, dim3(grid_blocks), dim3(512), LDS_BYTES, stream, p);
    }
#else
    p.ph_lo = 0; p.ph_hi = NPHASE;
    void* args[] = {&p};
    hipError_t e = hipLaunchCooperativeKernel((const void*)mega, dim3(grid_blocks), dim3(512), args, LDS_BYTES, stream);
    if (e != hipSuccess) fprintf(stderr, "cooperative launch failed: %s (grid %d)\n", hipGetErrorString(e), grid_blocks);
#endif
}
```

```cpp
#include <hip/hip_runtime.h>
#include <hip/hip_cooperative_groups.h>
#include <cstdio>
namespace cg = cooperative_groups;

#ifndef DUP_PHASE
#define DUP_PHASE -1
#endif
#ifndef MULTI_LAUNCH
#define MULTI_LAUNCH 0
#endif

#define LAS __attribute__((address_space(3)))
typedef unsigned short bf16_t;
typedef short bf16x8 __attribute__((ext_vector_type(8)));
typedef float f32x4 __attribute__((ext_vector_type(4)));
typedef float f32x2 __attribute__((ext_vector_type(2)));
typedef unsigned u32x4 __attribute__((ext_vector_type(4)));
typedef unsigned u32x2 __attribute__((ext_vector_type(2)));

constexpr int S_ = 16384, D_ = 2048, DR = 1024, NAUG = 6912;
constexpr size_t MiB = 1ull << 20;
constexpr size_t WS_PROJ = 0, WS_H = 216 * MiB, WS_WB1 = 280 * MiB, WS_WQT = 280 * MiB, WS_WOT = 296 * MiB;
constexpr size_t WS_R = 307 * MiB, WS_K = 339 * MiB, WS_V = 371 * MiB, WS_KK = 403 * MiB, WS_A = 435 * MiB, WS_LW = 467 * MiB;
constexpr size_t WS_G = 216 * MiB, WS_YC = 248 * MiB, WS_YMIX = 403 * MiB, WS_X1 = 0, WS_H2 = 128 * MiB, WS_Q = 307 * MiB;
constexpr size_t WS_GT = 0, WS_HT = 32 * MiB, WS_QE = 96 * MiB, WS_YL = 128 * MiB, WS_S0 = 160 * MiB;
constexpr size_t WS_IDS = 192 * MiB, WS_GATES = 200 * MiB, WS_UB = 435 * MiB, WS_VB = 208 * MiB, WS_NEED = 499 * MiB;
constexpr int TLD = 72, TSLOT = 64 * TLD * 2;
constexpr int LDS_BYTES = 16 * TSLOT + 2048 + 256;
constexpr int NPHASE = 11;

struct Params {
    const float* in[26];
    float* out;
    unsigned char* ws;
    int ph_lo, ph_hi;
};

__device__ __forceinline__ float bf2f(bf16_t b) { return __uint_as_float(((unsigned)b) << 16); }
__device__ __forceinline__ bf16_t f2bf(float f) { unsigned u = __float_as_uint(f); u += 0x7FFFu + ((u >> 16) & 1u); return (bf16_t)(u >> 16); }
typedef __bf16 bf16v2_t __attribute__((ext_vector_type(2)));
__device__ __forceinline__ unsigned cvt_pk_bf16(float lo, float hi) { const f32x2 v = {lo, hi}; const bf16v2_t r = __builtin_convertvector(v, bf16v2_t); return __builtin_bit_cast(unsigned, r); }
__device__ __forceinline__ float wave_sum(float v) {
#pragma unroll
    for (int o = 32; o; o >>= 1) v += __shfl_xor(v, o);
    return v;
}
template <int CTRL, int RM> __device__ __forceinline__ float dpp_f(float v) { return __int_as_float(__builtin_amdgcn_update_dpp(0, __float_as_int(v), CTRL, RM, 0xf, false)); }
__device__ __forceinline__ float wave_sum_dpp(float v) {
    v += dpp_f<0xB1, 0xf>(v); v += dpp_f<0x4E, 0xf>(v); v += dpp_f<0x141, 0xf>(v); v += dpp_f<0x140, 0xf>(v);
    v += dpp_f<0x142, 0xa>(v); v += dpp_f<0x143, 0xc>(v);
    return __int_as_float(__builtin_amdgcn_readlane(__float_as_int(v), 63));
}
__device__ __forceinline__ float wave_max(float v) {
#pragma unroll
    for (int o = 32; o; o >>= 1) v = fmaxf(v, __shfl_xor(v, o));
    return v;
}
__device__ __forceinline__ float sigmoidf_(float x) { return 1.0f / (1.0f + __expf(-x)); }
__device__ __forceinline__ float gelu_tanh(float x) { float u = 0.7978845608028654f * (x + 0.044715f * x * x * x); return 0.5f * x * (1.0f + tanhf(u)); }
__device__ __forceinline__ float lo_bf(unsigned w) { return __uint_as_float(w << 16); }
__device__ __forceinline__ float hi_bf(unsigned w) { return __uint_as_float(w & 0xffff0000u); }

namespace pg8 {
constexpr int BM = 256, BK = 64, HALF = 128, HTB = HALF * BK * 2, STAGE_BYTES = 8 * HTB, NXCD = 8, WGM = 8;
__device__ __forceinline__ int lds_byte(int r, int c) { const int st = (r >> 4) * 2 + (c >> 5), rr = r & 15, cc = c & 31, ob = rr * 64 + cc * 2; return st * 1024 + (ob ^ (((ob >> 9) & 1) << 5)); }
__device__ __forceinline__ void stage_rc(int b, int& R, int& C) { const int st = b / 1024, sb = b % 1024, swz = sb ^ (((sb >> 9) & 1) << 5); R = (st >> 1) * 16 + swz / 64; C = (st & 1) * 32 + (swz % 64) / 2; }
__device__ __forceinline__ int perm32(int rho) { const int n = rho >> 4, i = rho & 15; return 8 * (i >> 2) + 4 * n + (i & 3); }
struct Unit { int pm, pn; };
struct Gemm { const bf16_t* A; const bf16_t* Bt; int M, N, K; };
struct StaticOrder {
    int nM, nN, nwg, G, c;
    __device__ void init(int M, int N, int G_, int c_) { nM = M / BM; nN = N / BM; nwg = nM * nN; G = G_; c = c_; }
    __device__ bool next(int i, Unit& u) const {
        const long L = (long)i * G + c; if (L >= nwg) return false;
        int wgid = (int)L; { const int q = nwg / NXCD, r = nwg % NXCD, xcd = wgid % NXCD, off = wgid / NXCD; wgid = (xcd < r ? xcd * (q + 1) : r * (q + 1) + (xcd - r) * q) + off; }
        const int nig = WGM * nN, gid = wgid / nig, fm = gid * WGM, gsz = (nM - fm) < WGM ? (nM - fm) : WGM;
        u.pm = fm + ((wgid % nig) % gsz); u.pn = (wgid % nig) / gsz; return true;
    }
    __device__ __forceinline__ void a_ready(const Unit&) const {}
    __device__ __forceinline__ void done(const Unit&) const {}
};
struct EpiResF32 {
    static constexpr bool PERM = false;
    float* C; const float* Res; int ldc;
    __device__ __forceinline__ void operator()(const f32x4 (&acc)[2][2][4][2], const Unit& u, int wr, int wc, int fr, int fq) const {
        const int row0 = u.pm * BM + wr * 64 + fr, col0 = u.pn * BM + wc * 32 + 4 * fq;
#pragma unroll
        for (int ai = 0; ai < 2; ++ai)
#pragma unroll
            for (int m = 0; m < 4; ++m) { const size_t ro = (size_t)(row0 + ai * HALF + m * 16) * ldc + col0;
#pragma unroll
                for (int bj = 0; bj < 2; ++bj)
#pragma unroll
                    for (int n = 0; n < 2; ++n) { const f32x4 rs = *(const f32x4*)(Res + ro + bj * HALF + n * 16); *(f32x4*)(C + ro + bj * HALF + n * 16) = acc[ai][bj][m][n] + rs; } }
    }
};
struct EpiBf16 {
    static constexpr bool PERM = true;
    bf16_t* O; int ldc;
    __device__ __forceinline__ void operator()(const f32x4 (&acc)[2][2][4][2], const Unit& u, int wr, int wc, int fr, int fq) const {
        const int row0 = u.pm * BM + wr * 64 + fr; const int col0 = u.pn * BM + wc * 32 + 8 * fq;
#pragma unroll
        for (int ai = 0; ai < 2; ++ai)
#pragma unroll
            for (int m = 0; m < 4; ++m) { bf16_t* rowp = O + (size_t)(row0 + ai * HALF + m * 16) * ldc + col0;
#pragma unroll
                for (int bj = 0; bj < 2; ++bj) { const f32x4 v0 = acc[ai][bj][m][0], v1 = acc[ai][bj][m][1];
                    u32x4 w; w.x = cvt_pk_bf16(v0[0], v0[1]); w.y = cvt_pk_bf16(v0[2], v0[3]); w.z = cvt_pk_bf16(v1[0], v1[1]); w.w = cvt_pk_bf16(v1[2], v1[3]);
                    *(u32x4*)(rowp + bj * HALF) = w; } }
    }
};

template <class Epi, class Sched>
__device__ __forceinline__ void gemm_phase(LAS unsigned char* lds, const Gemm g, const Sched& S, const Epi& E) {
    const int tid = threadIdx.x, wid = __builtin_amdgcn_readfirstlane(tid >> 6), lane = tid & 63, wr = wid >> 2, wc = wid & 3, fr = lane & 15, fq = lane >> 4;
    const int K = g.K, nt = K / BK;
    unsigned voffA[2], voffB[2];
#pragma unroll
    for (int i = 0; i < 2; ++i) { int R, C; stage_rc(tid * 16 + i * 8192, R, C); const int Rb = Epi::PERM ? ((R & ~31) + perm32(R & 31)) : R;
        voffA[i] = (unsigned)(R * K + C) * 2u; voffB[i] = (unsigned)(Rb * K + C) * 2u; }
    const size_t kstep = (size_t)(BK * 2);
    const size_t hstep = (size_t)HALF * K * 2;
    const size_t tstep = 2 * hstep;
    const unsigned ldsw = (unsigned)wid * 1024u;
    const int aoff = lds_byte(wr * 64 + fr, fq * 8), boff = lds_byte(wc * 32 + fr, fq * 8);
#define PG8_SA(b, h) (((b) * 2 + (h)) * HTB)
#define PG8_SB(b, h) ((4 + (b) * 2 + (h)) * HTB)
#define PG8_STAGE(bufoff, gbase, voff) do { _Pragma("unroll") for (int _i = 0; _i < 2; ++_i) \
        __builtin_amdgcn_global_load_lds((const unsigned*)((const char*)(gbase) + (voff)[_i]), (LAS unsigned*)(lds + (bufoff) + ldsw + _i * 8192), 16, 0, 0); } while (0)
#define PG8_LDA(dst, b, h) do { _Pragma("unroll") for (int m = 0; m < 4; ++m) _Pragma("unroll") for (int k = 0; k < 2; ++k) dst[m][k] = *(const LAS bf16x8*)(lds + PG8_SA(b, h) + aoff + m * 2048 + k * 1024); } while (0)
#define PG8_LDB(dst, b, h) do { _Pragma("unroll") for (int n = 0; n < 2; ++n) _Pragma("unroll") for (int k = 0; k < 2; ++k) dst[n][k] = *(const LAS bf16x8*)(lds + PG8_SB(b, h) + boff + n * 2048 + k * 1024); } while (0)
#define PG8_MMA(ai, bj, At, Bt) do { __builtin_amdgcn_s_setprio(1); _Pragma("unroll") for (int m = 0; m < 4; ++m) _Pragma("unroll") for (int n = 0; n < 2; ++n) _Pragma("unroll") for (int k = 0; k < 2; ++k) \
        acc[ai][bj][m][n] = __builtin_amdgcn_mfma_f32_16x16x32_bf16(Bt[n][k], At[m][k], acc[ai][bj][m][n], 0, 0, 0); __builtin_amdgcn_s_setprio(0); } while (0)
#define PG8_WAIT_V(n) asm volatile("s_waitcnt vmcnt(" #n ")" ::: "memory")
#define PG8_WAIT_L(n) asm volatile("s_waitcnt lgkmcnt(" #n ")" ::: "memory")
#define PG8_BAR __builtin_amdgcn_s_barrier()
#define PG8_SCHED __builtin_amdgcn_sched_barrier(0)
    Unit cur, nxt; int ui = 0;
    if (!S.next(0, cur)) return;
    f32x4 acc[2][2][4][2];
#pragma unroll
    for (int a = 0; a < 2; ++a)
#pragma unroll
        for (int b = 0; b < 2; ++b)
#pragma unroll
            for (int m = 0; m < 4; ++m)
#pragma unroll
                for (int n = 0; n < 2; ++n) acc[a][b][m][n] = (f32x4){0.f, 0.f, 0.f, 0.f};
    bf16x8 At[4][2], B0[2][2], B1[2][2];
    const char* cA = (const char*)g.A + (size_t)cur.pm * tstep; const char* cB = (const char*)g.Bt + (size_t)cur.pn * tstep;
    S.a_ready(cur);
    PG8_STAGE(PG8_SB(0, 0), cB, voffB); PG8_STAGE(PG8_SA(0, 0), cA, voffA); PG8_STAGE(PG8_SB(0, 1), cB + hstep, voffB); PG8_STAGE(PG8_SA(0, 1), cA + hstep, voffA);
    if (wr == 1) PG8_BAR;
    PG8_WAIT_V(4); PG8_BAR;
    PG8_STAGE(PG8_SB(1, 0), cB + kstep, voffB); PG8_STAGE(PG8_SA(1, 0), cA + kstep, voffA); PG8_STAGE(PG8_SB(1, 1), cB + hstep + kstep, voffB);
    PG8_WAIT_V(6); PG8_BAR;
    for (;;) {
        const bool has_next = S.next(ui + 1, nxt);
        const char* nA = has_next ? (const char*)g.A + (size_t)nxt.pm * tstep : cA; const char* nB = has_next ? (const char*)g.Bt + (size_t)nxt.pn * tstep : cB;
        for (int t = 0; t < nt; t += 2) {
            const bool last = (t == nt - 2);
            const char* a1 = cA + (size_t)(t + 1) * kstep;
            const char* a2 = last ? nA : cA + (size_t)(t + 2) * kstep; const char* b2 = last ? nB : cB + (size_t)(t + 2) * kstep;
            const char* a3 = a2 + kstep; const char* b3 = b2 + kstep;
            if (last && has_next) S.a_ready(nxt);
            PG8_LDB(B0, 0, 0); PG8_SCHED; PG8_LDA(At, 0, 0); PG8_STAGE(PG8_SA(1, 1), a1 + hstep, voffA);
            PG8_WAIT_L(8); PG8_BAR; PG8_WAIT_L(0); PG8_MMA(0, 0, At, B0); PG8_BAR; PG8_SCHED;
            PG8_LDB(B1, 0, 1); PG8_STAGE(PG8_SB(0, 0), b2, voffB);
            PG8_BAR; PG8_WAIT_L(0); PG8_MMA(0, 1, At, B1); PG8_BAR;
            PG8_LDA(At, 0, 1); PG8_STAGE(PG8_SA(0, 0), a2, voffA);
            PG8_BAR; PG8_WAIT_L(0); PG8_MMA(1, 0, At, B0); PG8_BAR; PG8_SCHED;
            PG8_STAGE(PG8_SB(0, 1), b2 + hstep, voffB);
            PG8_WAIT_V(6); PG8_BAR; PG8_MMA(1, 1, At, B1); PG8_BAR;
            PG8_LDB(B0, 1, 0); PG8_SCHED; PG8_LDA(At, 1, 0); PG8_STAGE(PG8_SA(0, 1), a2 + hstep, voffA);
            PG8_WAIT_L(8); PG8_BAR; PG8_WAIT_L(0); PG8_MMA(0, 0, At, B0); PG8_BAR; PG8_SCHED;
            PG8_LDB(B1, 1, 1); PG8_STAGE(PG8_SB(1, 0), b3, voffB);
            PG8_BAR; PG8_WAIT_L(0); PG8_MMA(0, 1, At, B1); PG8_BAR;
            PG8_LDA(At, 1, 1); PG8_STAGE(PG8_SA(1, 0), a3, voffA);
            PG8_BAR; PG8_WAIT_L(0); PG8_MMA(1, 0, At, B0); PG8_BAR; PG8_SCHED;
            PG8_STAGE(PG8_SB(1, 1), b3 + hstep, voffB);
            PG8_WAIT_V(6); PG8_BAR; PG8_MMA(1, 1, At, B1); PG8_BAR;
        }
        E(acc, cur, wr, wc, fr, fq); S.done(cur);
        if (!has_next) break;
#pragma unroll
        for (int a = 0; a < 2; ++a)
#pragma unroll
            for (int b = 0; b < 2; ++b)
#pragma unroll
                for (int m = 0; m < 4; ++m)
#pragma unroll
                    for (int n = 0; n < 2; ++n) acc[a][b][m][n] = (f32x4){0.f, 0.f, 0.f, 0.f};
        cur = nxt; cA = nA; cB = nB; ++ui;
    }
    PG8_WAIT_V(0);
    if (wr == 0) PG8_BAR;
    PG8_BAR;
#undef PG8_SA
#undef PG8_SB
#undef PG8_STAGE
#undef PG8_LDA
#undef PG8_LDB
#undef PG8_MMA
#undef PG8_WAIT_V
#undef PG8_WAIT_L
#undef PG8_BAR
#undef PG8_SCHED
}
}

__device__ __forceinline__ void rmsnorm_rows(const float* X, const float* gain, bf16_t* H) {
    const int wave = threadIdx.x >> 6, lane = threadIdx.x & 63;
    for (int row = blockIdx.x * 8 + wave; row < S_; row += gridDim.x * 8) {
        const float4* xr = (const float4*)(X + (size_t)row * D_);
        float4 v[8]; float ss = 0.f;
#pragma unroll
        for (int i = 0; i < 8; ++i) { v[i] = xr[i * 64 + lane]; ss += v[i].x * v[i].x + v[i].y * v[i].y + v[i].z * v[i].z + v[i].w * v[i].w; }
        ss = wave_sum(ss);
        const float sc = rsqrtf(ss * (1.0f / 2048.0f) + 1e-6f);
#pragma unroll
        for (int i = 0; i < 8; ++i) { const float4 g = ((const float4*)gain)[i * 64 + lane];
            u32x2 w; w.x = cvt_pk_bf16(v[i].x * sc * g.x, v[i].y * sc * g.y); w.y = cvt_pk_bf16(v[i].z * sc * g.z, v[i].w * sc * g.w);
            *(u32x2*)(H + (size_t)row * D_ + (i * 64 + lane) * 4) = w; }
    }
}

__device__ __forceinline__ void transpose_convert(const float* W, int K, int N, bf16_t* Bt, float* tile) {
    const int tid = threadIdx.x; const int tk = K / 64, tn = N / 64;
    for (int u = blockIdx.x; u < tk * tn; u += gridDim.x) {
        const int k0 = (u / tn) * 64, n0 = (u % tn) * 64;
        __syncthreads();
#pragma unroll
        for (int i = 0; i < 8; ++i) { const int kk = i * 8 + (tid >> 6), nn = tid & 63; tile[kk * 65 + nn] = W[(size_t)(k0 + kk) * N + n0 + nn]; }
        __syncthreads();
#pragma unroll
        for (int i = 0; i < 4; ++i) { const int nn = i * 16 + (tid >> 5), kp = (tid & 31) * 2;
            *(unsigned*)(Bt + (size_t)(n0 + nn) * K + k0 + kp) = cvt_pk_bf16(tile[kp * 65 + nn], tile[(kp + 1) * 65 + nn]); }
    }
}

__device__ __forceinline__ void convert_flat(const float* src, bf16_t* dst, size_t n) {
    for (size_t i = ((size_t)blockIdx.x * 512 + threadIdx.x) * 8; i < n; i += (size_t)gridDim.x * 512 * 8) {
        const float4 a = *(const float4*)(src + i), b = *(const float4*)(src + i + 4);
        u32x4 w; w.x = cvt_pk_bf16(a.x, a.y); w.y = cvt_pk_bf16(a.z, a.w); w.z = cvt_pk_bf16(b.x, b.y); w.w = cvt_pk_bf16(b.z, b.w);
        *(u32x4*)(dst + i) = w;
    }
}

__device__ __forceinline__ void convert_fp8(const float* src, unsigned char* dst, size_t n, float sc) {
    for (size_t i = ((size_t)blockIdx.x * 512 + threadIdx.x) * 16; i < n; i += (size_t)gridDim.x * 512 * 16) {
        u32x4 w;
#pragma unroll
        for (int j = 0; j < 4; ++j) { const float4 a = *(const float4*)(src + i + 4 * j);
            int x = __builtin_amdgcn_cvt_pk_fp8_f32(a.x * sc, a.y * sc, 0, false); x = __builtin_amdgcn_cvt_pk_fp8_f32(a.z * sc, a.w * sc, x, true); w[j] = (unsigned)x; }
        *(u32x4*)(dst + i) = w;
    }
}

__device__ __forceinline__ void phase0(const Params& p, unsigned char* shm) {
    bf16_t* WB1 = (bf16_t*)(p.ws + WS_WB1);
    rmsnorm_rows(p.in[0], p.in[1], (bf16_t*)(p.ws + WS_H));
    transpose_convert(p.in[2], 2048, 6144, WB1, (float*)shm);
    const float* mu = p.in[4]; const float* w1 = p.in[6]; const float* a1 = p.in[9]; const float* g1 = p.in[11];
    for (int idx = blockIdx.x * 512 + threadIdx.x; idx < 768 * 2048; idx += gridDim.x * 512) {
        const int j = idx >> 11, k = idx & 2047; float val = 0.f;
        if (j < 128) { const float m = mu[k], w = w1[k * 64 + (j & 63)]; val = (j < 64) ? w * (1.f - m) : w * m; }
        else if (j < 256) { const float m = mu[2048 + k], w = a1[k * 64 + (j & 63)]; val = (j < 192) ? w * (1.f - m) : w * m; }
        else if (j < 576) { const float m = mu[4096 + k]; const int jj = j - 256; const int c = jj < 160 ? jj : jj - 160; const float w = g1[k * 160 + c]; val = jj < 160 ? w * (1.f - m) : w * m; }
        WB1[(size_t)(6144 + j) * 2048 + k] = f2bf(val);
    }
}

__device__ __forceinline__ void phase_prep(const Params& p, unsigned char* shm) {
    float* actT = (float*)shm;
    const bf16_t* P = (const bf16_t*)(p.ws + WS_PROJ);
    bf16_t* R = (bf16_t*)(p.ws + WS_R); bf16_t* Kk = (bf16_t*)(p.ws + WS_K); bf16_t* V = (bf16_t*)(p.ws + WS_V);
    bf16_t* KK = (bf16_t*)(p.ws + WS_KK); bf16_t* A = (bf16_t*)(p.ws + WS_A); bf16_t* LW = (bf16_t*)(p.ws + WS_LW); bf16_t* G = (bf16_t*)(p.ws + WS_G);
    bf16_t* YC = (bf16_t*)(p.ws + WS_YC); const float* cw = p.in[18];
    const float* mu_rkv = p.in[3]; const float* w0 = p.in[5]; const float* w2 = p.in[7]; const float* a0 = p.in[8]; const float* a2 = p.in[10]; const float* g2 = p.in[12];
    const float* k_k = p.in[13]; const float* k_a = p.in[14];
    const int tid = threadIdx.x;
    for (int tile = blockIdx.x; tile < S_ / 16; tile += gridDim.x) {
        const int t0 = tile * 16;
        __syncthreads();
        for (int e = tid; e < 16 * 288; e += 512) {
            const int t = e / 288, j = e % 288; const int tg = t0 + t;
            int ccur, cprev;
            if (j < 64) { ccur = 6144 + j; cprev = 6208 + j; }
            else if (j < 128) { ccur = 6272 + (j - 64); cprev = 6336 + (j - 64); }
            else { ccur = 6400 + (j - 128); cprev = 6560 + (j - 128); }
            float s = bf2f(P[(size_t)tg * NAUG + ccur]);
            if (tg > 0) s += bf2f(P[(size_t)(tg - 1) * NAUG + cprev]);
            const float a = j < 64 ? tanhf(s) : (j < 128 ? s : sigmoidf_(s));
            actT[j * 16 + t] = a;
        }
        __syncthreads();
        float acc[2][16];
#pragma unroll
        for (int ci = 0; ci < 2; ++ci)
#pragma unroll
            for (int t = 0; t < 16; ++t) acc[ci][t] = 0.f;
        for (int j = 0; j < 64; ++j) {
            const float wa = w2[j * 1024 + tid], wb = w2[j * 1024 + 512 + tid];
            const float4* ap = (const float4*)(actT + j * 16);
#pragma unroll
            for (int q = 0; q < 4; ++q) { const float4 a = ap[q];
                acc[0][q * 4 + 0] += a.x * wa; acc[0][q * 4 + 1] += a.y * wa; acc[0][q * 4 + 2] += a.z * wa; acc[0][q * 4 + 3] += a.w * wa;
                acc[1][q * 4 + 0] += a.x * wb; acc[1][q * 4 + 1] += a.y * wb; acc[1][q * 4 + 2] += a.z * wb; acc[1][q * 4 + 3] += a.w * wb; }
        }
#pragma unroll
        for (int ci = 0; ci < 2; ++ci) { const int c = tid + ci * 512; const float w0c = w0[c];
#pragma unroll
            for (int t = 0; t < 16; ++t) { const float x = -(w0c + acc[ci][t]);
                const float sp = fmaxf(x, 0.f) + log1pf(__expf(-fabsf(x)));
                const float wlog = -sp - 0.5f;
                LW[(size_t)(t0 + t) * DR + c] = f2bf(-__expf(wlog)); } }
#pragma unroll
        for (int ci = 0; ci < 2; ++ci)
#pragma unroll
            for (int t = 0; t < 16; ++t) acc[ci][t] = 0.f;
        for (int j = 0; j < 160; ++j) {
            const float wa = g2[j * 1024 + tid], wb = g2[j * 1024 + 512 + tid];
            const float4* ap = (const float4*)(actT + (128 + j) * 16);
#pragma unroll
            for (int q = 0; q < 4; ++q) { const float4 a = ap[q];
                acc[0][q * 4 + 0] += a.x * wa; acc[0][q * 4 + 1] += a.y * wa; acc[0][q * 4 + 2] += a.z * wa; acc[0][q * 4 + 3] += a.w * wa;
                acc[1][q * 4 + 0] += a.x * wb; acc[1][q * 4 + 1] += a.y * wb; acc[1][q * 4 + 2] += a.z * wb; acc[1][q * 4 + 3] += a.w * wb; }
        }
#pragma unroll
        for (int ci = 0; ci < 2; ++ci) { const int c = tid + ci * 512;
#pragma unroll
            for (int t = 0; t < 16; ++t) G[(size_t)(t0 + t) * DR + c] = f2bf(acc[ci][t]); }
#pragma unroll
        for (int ci = 0; ci < 2; ++ci)
#pragma unroll
            for (int t = 0; t < 16; ++t) acc[ci][t] = 0.f;
        for (int j = 0; j < 64; ++j) {
            const float wa = a2[j * 1024 + tid], wb = a2[j * 1024 + 512 + tid];
            const float4* ap = (const float4*)(actT + (64 + j) * 16);
#pragma unroll
            for (int q = 0; q < 4; ++q) { const float4 a = ap[q];
                acc[0][q * 4 + 0] += a.x * wa; acc[0][q * 4 + 1] += a.y * wa; acc[0][q * 4 + 2] += a.z * wa; acc[0][q * 4 + 3] += a.w * wa;
                acc[1][q * 4 + 0] += a.x * wb; acc[1][q * 4 + 1] += a.y * wb; acc[1][q * 4 + 2] += a.z * wb; acc[1][q * 4 + 3] += a.w * wb; }
        }
#pragma unroll
        for (int ci = 0; ci < 2; ++ci) {
            const int c = tid + ci * 512;
            const float a0c = a0[c], mr = mu_rkv[c], mk = mu_rkv[1024 + c], mv = mu_rkv[2048 + c], kkc = k_k[c], kac = k_a[c];
            float pr = 0.f, pk = 0.f, pv = 0.f, u1 = 0.f, u2 = 0.f;
            const float cw0 = cw[c], cw1 = cw[1024 + c], cw2 = cw[2048 + c];
            if (t0 > 0) { const size_t o = (size_t)(t0 - 1) * NAUG + c; pr = bf2f(P[o]); pk = bf2f(P[o + 1024]); pv = bf2f(P[o + 2048]);
                u1 = bf2f(P[o + 4096]) * bf2f(P[o + 5120]); u2 = bf2f(P[o - NAUG + 4096]) * bf2f(P[o - NAUG + 5120]); }
#pragma unroll
            for (int t = 0; t < 16; ++t) {
                const size_t o = (size_t)(t0 + t) * NAUG + c;
                const float cr = bf2f(P[o]), ck = bf2f(P[o + 1024]), cv = bf2f(P[o + 2048]);
                const float r = cr + (pr - cr) * mr, k = ck + (pk - ck) * mk, v = cv + (pv - cv) * mv;
                pr = cr; pk = ck; pv = cv;
                const float a = sigmoidf_(a0c + acc[ci][t]);
                const float kkv = k * kkc;
                const float nrm = sqrtf(wave_sum(kkv * kkv));
                const float kkn = kkv / fmaxf(nrm, 1e-12f);
                const float k2 = k * (1.f + (a - 1.f) * kac);
                const size_t oo = (size_t)(t0 + t) * DR + c;
                R[oo] = f2bf(r); Kk[oo] = f2bf(k2); V[oo] = f2bf(v); KK[oo] = f2bf(kkn); A[oo] = f2bf(a);
                const float u0 = bf2f(P[o + 4096]) * bf2f(P[o + 5120]);
                YC[oo] = f2bf(bf2f(P[o + 3072]) * (cw0 * u2 + cw1 * u1 + cw2 * u0));
                u2 = u1; u1 = u0;
            }
        }
    }
}

#define TILE(i) ((LAS bf16_t*)(lds + (i) * TSLOT))
__device__ __forceinline__ f32x4 mm_tile(f32x4 acc, const LAS bf16_t* A, const LAS bf16_t* Bt, int mi, int ni, int fr, int fq) {
#pragma unroll
    for (int ks = 0; ks < 2; ++ks) {
        const bf16x8 a = *(const LAS bf16x8*)(A + (mi * 16 + fr) * TLD + ks * 32 + fq * 8);
        const bf16x8 b = *(const LAS bf16x8*)(Bt + (ni * 16 + fr) * TLD + ks * 32 + fq * 8);
        acc = __builtin_amdgcn_mfma_f32_16x16x32_bf16(a, b, acc, 0, 0, 0);
    }
    return acc;
}
__device__ __forceinline__ void st_rm(LAS bf16_t* X, f32x4 v, int mi, int ni, int fr, int fq) {
    const unsigned w0 = cvt_pk_bf16(v[0], v[1]), w1 = cvt_pk_bf16(v[2], v[3]);
    LAS bf16_t* q = X + (mi * 16 + fq * 4) * TLD + ni * 16 + fr;
    q[0] = (bf16_t)(w0 & 0xffffu); q[TLD] = (bf16_t)(w0 >> 16); q[2 * TLD] = (bf16_t)(w1 & 0xffffu); q[3 * TLD] = (bf16_t)(w1 >> 16);
}
__device__ __forceinline__ void st_tr(LAS bf16_t* XT, f32x4 v, int mi, int ni, int fr, int fq) {
    u32x2 w; w.x = cvt_pk_bf16(v[0], v[1]); w.y = cvt_pk_bf16(v[2], v[3]);
    *(LAS u32x2*)(XT + (ni * 16 + fr) * TLD + mi * 16 + fq * 4) = w;
}
__device__ __forceinline__ f32x4 ld_rm(const LAS bf16_t* X, int mi, int ni, int fr, int fq) {
    const LAS bf16_t* q = X + (mi * 16 + fq * 4) * TLD + ni * 16 + fr;
    return (f32x4){bf2f(q[0]), bf2f(q[TLD]), bf2f(q[2 * TLD]), bf2f(q[3 * TLD])};
}
__device__ __forceinline__ f32x4 ld_tr(const LAS bf16_t* XT, int mi, int ni, int fr, int fq) {
    const u32x2 w = *(const LAS u32x2*)(XT + (ni * 16 + fr) * TLD + mi * 16 + fq * 4);
    return (f32x4){lo_bf(w.x), hi_bf(w.x), lo_bf(w.y), hi_bf(w.y)};
}
__device__ __forceinline__ u32x4 pack8(const float* f) { u32x4 w; w.x = cvt_pk_bf16(f[0], f[1]); w.y = cvt_pk_bf16(f[2], f[3]); w.z = cvt_pk_bf16(f[4], f[5]); w.w = cvt_pk_bf16(f[6], f[7]); return w; }

__device__ __forceinline__ void phase_chunkA(const Params& p, LAS unsigned char* lds) {
    const int tid = threadIdx.x, w = tid >> 6, lane = tid & 63, fr = lane & 15, fq = lane >> 4;
    const int mi = w >> 1, nb = (w & 1) * 2;
    LAS float* cl = (LAS float*)(lds + 14 * TSLOT);
    LAS float* gs = (LAS float*)(lds + 16 * TSLOT);
    LAS float* wc = gs + 512;
    const bf16_t* R = (const bf16_t*)(p.ws + WS_R); const bf16_t* Kk = (const bf16_t*)(p.ws + WS_K); const bf16_t* V = (const bf16_t*)(p.ws + WS_V);
    const bf16_t* KK = (const bf16_t*)(p.ws + WS_KK); const bf16_t* A = (const bf16_t*)(p.ws + WS_A); const bf16_t* LW = (const bf16_t*)(p.ws + WS_LW);
    bf16_t* GT = (bf16_t*)(p.ws + WS_GT); float* HT = (float*)(p.ws + WS_HT); bf16_t* QE = (bf16_t*)(p.ws + WS_QE); bf16_t* YL = (bf16_t*)(p.ws + WS_YL);
    const f32x4 z4 = (f32x4){0.f, 0.f, 0.f, 0.f};
    for (int item = blockIdx.x; item < 4096; item += gridDim.x) {
        const int c = item >> 4, h = item & 15;
        const size_t gbase = (size_t)(c * 64) * DR + h * 64;
        {
            const int g = w, k = lane;
            float pfx[8]; float run = 0.f;
#pragma unroll
            for (int i = 0; i < 8; ++i) { run += bf2f(LW[gbase + (size_t)(g * 8 + i) * DR + k]); pfx[i] = run; }
            gs[g * 64 + k] = run;
            __syncthreads();
            float off = 0.f;
#pragma unroll
            for (int gg = 0; gg < 7; ++gg) { const float x = gs[gg * 64 + k]; off += (gg < g) ? x : 0.f; }
#pragma unroll
            for (int i = 0; i < 8; ++i) cl[(g * 8 + i) * 64 + k] = off + pfx[i];
            if (g == 7) wc[k] = __expf(off + pfx[7]);
            __syncthreads();
        }
        {
            const int t = tid >> 3, k0 = (tid & 7) * 8;
            const size_t go = gbase + (size_t)t * DR + k0;
            const u32x4 r4 = *(const u32x4*)(R + go), k4 = *(const u32x4*)(Kk + go), v4 = *(const u32x4*)(V + go), kk4 = *(const u32x4*)(KK + go), a4 = *(const u32x4*)(A + go), lw4 = *(const u32x4*)(LW + go);
            float at[8], rt[8], bt[8], kt[8], bh[8], kh[8], vv[8];
#pragma unroll
            for (int i = 0; i < 8; ++i) {
                const int q = i >> 1; const bool hi = i & 1;
                const float rf = hi ? hi_bf(r4[q]) : lo_bf(r4[q]), kf = hi ? hi_bf(k4[q]) : lo_bf(k4[q]), vf = hi ? hi_bf(v4[q]) : lo_bf(v4[q]);
                const float kkf = hi ? hi_bf(kk4[q]) : lo_bf(kk4[q]), af = hi ? hi_bf(a4[q]) : lo_bf(a4[q]), lwf = hi ? hi_bf(lw4[q]) : lo_bf(lw4[q]);
                const float clv = cl[t * 64 + k0 + i], cle = cl[63 * 64 + k0 + i];
                const float e = __expf(clv), ex = __expf(clv - lwf), ei = __expf(-clv), eh = __expf(cle - clv);
                const float bb = kkf * af;
                at[i] = -kkf * ex; rt[i] = rf * e; bt[i] = bb * ei; kt[i] = kf * ei; bh[i] = bb * eh; kh[i] = kf * eh; vv[i] = vf;
            }
            *(LAS u32x4*)(TILE(0) + t * TLD + k0) = pack8(at);
            *(LAS u32x4*)(TILE(2) + t * TLD + k0) = pack8(rt);
            *(LAS u32x4*)(TILE(3) + t * TLD + k0) = pack8(bt);
            *(LAS u32x4*)(TILE(4) + t * TLD + k0) = pack8(kt);
            const u32x4 atp = pack8(at), bhp = pack8(bh), khp = pack8(kh);
#pragma unroll
            for (int i = 0; i < 8; ++i) {
                const int q = i >> 1; const bool hi = i & 1;
                TILE(1)[(k0 + i) * TLD + t] = (bf16_t)(hi ? (atp[q] >> 16) : (atp[q] & 0xffffu));
                TILE(5)[(k0 + i) * TLD + t] = (bf16_t)(hi ? (bhp[q] >> 16) : (bhp[q] & 0xffffu));
                TILE(6)[(k0 + i) * TLD + t] = (bf16_t)(hi ? (khp[q] >> 16) : (khp[q] & 0xffffu));
                TILE(7)[(k0 + i) * TLD + t] = (bf16_t)(hi ? (v4[q] >> 16) : (v4[q] & 0xffffu));
            }
            __syncthreads();
        }
#pragma unroll
        for (int nn = 0; nn < 2; ++nn) {
            const int ni = nb + nn; const int col = ni * 16 + fr, row0 = mi * 16 + fq * 4;
            f32x4 x = mm_tile(z4, TILE(0), TILE(3), mi, ni, fr, fq);
#pragma unroll
            for (int j = 0; j < 4; ++j) x[j] = (col < row0 + j) ? x[j] : 0.f;
            st_rm(TILE(8), x, mi, ni, fr, fq); st_tr(TILE(9), x, mi, ni, fr, fq);
            x = mm_tile(z4, TILE(0), TILE(4), mi, ni, fr, fq);
#pragma unroll
            for (int j = 0; j < 4; ++j) x[j] = (col < row0 + j) ? x[j] : 0.f;
            st_rm(TILE(10), x, mi, ni, fr, fq);
            x = mm_tile(z4, TILE(2), TILE(3), mi, ni, fr, fq);
#pragma unroll
            for (int j = 0; j < 4; ++j) x[j] = (col <= row0 + j) ? x[j] : 0.f;
            st_rm(TILE(11), x, mi, ni, fr, fq);
            x = mm_tile(z4, TILE(2), TILE(4), mi, ni, fr, fq);
#pragma unroll
            for (int j = 0; j < 4; ++j) x[j] = (col <= row0 + j) ? x[j] : 0.f;
            st_rm(TILE(12), x, mi, ni, fr, fq);
        }
        __syncthreads();
#pragma unroll
        for (int nn = 0; nn < 2; ++nn) {
            const int ni = nb + nn;
            st_tr(TILE(13), mm_tile(z4, TILE(10), TILE(7), mi, ni, fr, fq), mi, ni, fr, fq);
            const f32x4 x = mm_tile(z4, TILE(8), TILE(9), mi, ni, fr, fq);
            st_rm(TILE(0), x, mi, ni, fr, fq); st_tr(TILE(3), x, mi, ni, fr, fq);
        }
        __syncthreads();
#pragma unroll
        for (int rd = 0; rd < 5; ++rd) {
            const int tq = (rd & 1) ? 14 : 8, tqo = (rd & 1) ? 8 : 14;
            const int lx = (rd & 1) ? 4 : 0, lxt = (rd & 1) ? 9 : 3, lxo = (rd & 1) ? 0 : 4, lxto = (rd & 1) ? 3 : 9;
#pragma unroll
            for (int nn = 0; nn < 2; ++nn) {
                const int ni = nb + nn;
                f32x4 x = ld_rm(TILE(tq), mi, ni, fr, fq) + ld_rm(TILE(lx), mi, ni, fr, fq);
                x = mm_tile(x, TILE(tq), TILE(lxt), mi, ni, fr, fq);
                st_rm(TILE(tqo), x, mi, ni, fr, fq);
                if (rd < 4) { const f32x4 y = mm_tile(z4, TILE(lx), TILE(lxt), mi, ni, fr, fq); st_rm(TILE(lxo), y, mi, ni, fr, fq); st_tr(TILE(lxto), y, mi, ni, fr, fq); }
            }
            __syncthreads();
        }
#pragma unroll
        for (int nn = 0; nn < 2; ++nn) {
            const int ni = nb + nn;
            st_tr(TILE(10), mm_tile(ld_tr(TILE(1), mi, ni, fr, fq), TILE(14), TILE(1), mi, ni, fr, fq), mi, ni, fr, fq);
            st_tr(TILE(15), mm_tile(ld_tr(TILE(13), mi, ni, fr, fq), TILE(14), TILE(13), mi, ni, fr, fq), mi, ni, fr, fq);
        }
        __syncthreads();
#pragma unroll
        for (int nn = 0; nn < 2; ++nn) {
            const int ni = nb + nn;
            {
                f32x4 x = mm_tile(z4, TILE(5), TILE(10), mi, ni, fr, fq);
                if (mi == ni) {
#pragma unroll
                    for (int j = 0; j < 4; ++j) x[j] += (fq * 4 + j == fr) ? wc[ni * 16 + fr] : 0.f;
                }
                const unsigned w0 = cvt_pk_bf16(x[0], x[1]), w1 = cvt_pk_bf16(x[2], x[3]);
                bf16_t* gp = GT + (size_t)item * 4096 + (size_t)((mi * 2 + (ni >> 1)) * 64 + (fr >> 2) * 16 + fq * 4) * 8 + (ni & 1) * 4 + (fr & 3);
                gp[0] = (bf16_t)(w0 & 0xffffu); gp[8] = (bf16_t)(w0 >> 16); gp[16] = (bf16_t)(w1 & 0xffffu); gp[24] = (bf16_t)(w1 >> 16);
            }
            {
                f32x4 x = mm_tile(z4, TILE(5), TILE(15), mi, ni, fr, fq);
                x = mm_tile(x, TILE(6), TILE(7), mi, ni, fr, fq);
                *(f32x4*)(HT + (size_t)item * 4096 + (size_t)((ni * 4 + mi) * 64 + lane) * 4) = x;
            }
            {
                f32x4 x = ld_tr(TILE(2), mi, ni, fr, fq);
                x = mm_tile(x, TILE(10), TILE(11), mi, ni, fr, fq);
                u32x2 wv; wv.x = cvt_pk_bf16(x[0], x[1]); wv.y = cvt_pk_bf16(x[2], x[3]);
                *(u32x2*)(QE + (size_t)item * 4096 + (ni * 16 + fr) * 64 + mi * 16 + fq * 4) = wv;
            }
            {
                f32x4 x = mm_tile(z4, TILE(11), TILE(15), mi, ni, fr, fq);
                x = mm_tile(x, TILE(12), TILE(7), mi, ni, fr, fq);
                u32x2 wv; wv.x = cvt_pk_bf16(x[0], x[1]); wv.y = cvt_pk_bf16(x[2], x[3]);
                *(u32x2*)(YL + (size_t)item * 4096 + (size_t)((mi * 4 + ni) * 64 + lane) * 4) = wv;
            }
        }
    }
}

__device__ __forceinline__ void phase_seq(const Params& p) {
    if (blockIdx.x >= 64 || threadIdx.x >= 64) return;
    const int head = blockIdx.x >> 2, vt = blockIdx.x & 3, lane = threadIdx.x, fr = lane & 15, fq = lane >> 4;
    const bf16_t* GT = (const bf16_t*)(p.ws + WS_GT); const float* HT = (const float*)(p.ws + WS_HT); bf16_t* S0 = (bf16_t*)(p.ws + WS_S0);
    f32x4 acc[4];
#pragma unroll
    for (int mb = 0; mb < 4; ++mb) acc[mb] = (f32x4){0.f, 0.f, 0.f, 0.f};
    bf16x8 ga[4][2]; f32x4 hh[4];
    {
        const size_t item = head;
#pragma unroll
        for (int mb = 0; mb < 4; ++mb) {
#pragma unroll
            for (int ks = 0; ks < 2; ++ks) ga[mb][ks] = *(const bf16x8*)(GT + item * 4096 + (size_t)((mb * 2 + ks) * 64 + lane) * 8);
            hh[mb] = *(const f32x4*)(HT + item * 4096 + (size_t)((vt * 4 + mb) * 64 + lane) * 4);
        }
    }
    for (int c = 0; c < 256; ++c) {
        const size_t item = (size_t)c * 16 + head;
        const size_t nitem = (size_t)(c < 255 ? c + 1 : c) * 16 + head;
        bf16x8 gn[4][2]; f32x4 hn[4];
#pragma unroll
        for (int mb = 0; mb < 4; ++mb) {
#pragma unroll
            for (int ks = 0; ks < 2; ++ks) gn[mb][ks] = *(const bf16x8*)(GT + nitem * 4096 + (size_t)((mb * 2 + ks) * 64 + lane) * 8);
            hn[mb] = *(const f32x4*)(HT + nitem * 4096 + (size_t)((vt * 4 + mb) * 64 + lane) * 4);
        }
        u32x2 pk[4];
#pragma unroll
        for (int mb = 0; mb < 4; ++mb) { pk[mb].x = cvt_pk_bf16(acc[mb][0], acc[mb][1]); pk[mb].y = cvt_pk_bf16(acc[mb][2], acc[mb][3]);
            *(u32x2*)(S0 + item * 4096 + (vt * 16 + fr) * 64 + mb * 16 + fq * 4) = pk[mb]; }
        u32x4 b0w, b1w; b0w.x = pk[0].x; b0w.y = pk[0].y; b0w.z = pk[1].x; b0w.w = pk[1].y; b1w.x = pk[2].x; b1w.y = pk[2].y; b1w.z = pk[3].x; b1w.w = pk[3].y;
        const bf16x8 b0 = __builtin_bit_cast(bf16x8, b0w), b1 = __builtin_bit_cast(bf16x8, b1w);
#pragma unroll
        for (int mb = 0; mb < 4; ++mb) {
            f32x4 x = __builtin_amdgcn_mfma_f32_16x16x32_bf16(ga[mb][0], b0, hh[mb], 0, 0, 0);
            acc[mb] = __builtin_amdgcn_mfma_f32_16x16x32_bf16(ga[mb][1], b1, x, 0, 0, 0);
        }
#pragma unroll
        for (int mb = 0; mb < 4; ++mb) { ga[mb][0] = gn[mb][0]; ga[mb][1] = gn[mb][1]; hh[mb] = hn[mb]; }
    }
}

__device__ __forceinline__ void phase_chunkY(const Params& p, LAS unsigned char* lds) {
    LAS float* Yb = (LAS float*)lds;
    const int tid = threadIdx.x, w = tid >> 6, lane = tid & 63, fr = lane & 15, fq = lane >> 4;
    const int mi = w >> 1, nb = (w & 1) * 2;
    const bf16_t* R = (const bf16_t*)(p.ws + WS_R); const bf16_t* Kk = (const bf16_t*)(p.ws + WS_K); const bf16_t* V = (const bf16_t*)(p.ws + WS_V);
    const bf16_t* G = (const bf16_t*)(p.ws + WS_G); const bf16_t* YC = (const bf16_t*)(p.ws + WS_YC);
    const bf16_t* QE = (const bf16_t*)(p.ws + WS_QE); const bf16_t* YL = (const bf16_t*)(p.ws + WS_YL); const bf16_t* S0 = (const bf16_t*)(p.ws + WS_S0);
    bf16_t* YM = (bf16_t*)(p.ws + WS_YMIX);
    const float* r_k = p.in[15]; const float* gn_w = p.in[16]; const float* gn_b = p.in[17];
    for (int item = blockIdx.x; item < 4096; item += gridDim.x) {
        const int c = item >> 4, h = item & 15;
        const bf16_t* Qp = QE + (size_t)item * 4096; const bf16_t* Sp = S0 + (size_t)item * 4096; const bf16_t* Yp = YL + (size_t)item * 4096;
        __syncthreads();
#pragma unroll
        for (int nn = 0; nn < 2; ++nn) {
            const int ni = nb + nn;
            const u32x2 yw = *(const u32x2*)(Yp + (size_t)((mi * 4 + ni) * 64 + lane) * 4);
            f32x4 acc = (f32x4){lo_bf(yw.x), hi_bf(yw.x), lo_bf(yw.y), hi_bf(yw.y)};
#pragma unroll
            for (int ks = 0; ks < 2; ++ks) {
                const bf16x8 a = *(const bf16x8*)(Qp + (mi * 16 + fr) * 64 + ks * 32 + fq * 8);
                const bf16x8 b = *(const bf16x8*)(Sp + (ni * 16 + fr) * 64 + ks * 32 + fq * 8);
                acc = __builtin_amdgcn_mfma_f32_16x16x32_bf16(a, b, acc, 0, 0, 0);
            }
#pragma unroll
            for (int j = 0; j < 4; ++j) Yb[(mi * 16 + fq * 4 + j) * 68 + ni * 16 + fr] = acc[j];
        }
        __syncthreads();
        const int ch = h * 64 + lane;
        const float gw = gn_w[ch], gb = gn_b[ch], rk = r_k[ch];
#pragma unroll
        for (int tt = 0; tt < 8; ++tt) {
            const int t = w * 8 + tt; const size_t tg = (size_t)c * 64 + t; const size_t o = tg * DR + ch;
            const float y = Yb[t * 68 + lane];
            const float mean = wave_sum(y) * (1.f / 64.f); const float d = y - mean;
            const float var = wave_sum(d * d) * (1.f / 64.f);
            const float yn = d * rsqrtf(var + 64e-5f) * gw + gb;
            const float r = bf2f(R[o]), k = bf2f(Kk[o]), v = bf2f(V[o]);
            const float bonus = wave_sum(r * k * rk) * v;
            YM[tg * D_ + ch] = f2bf((yn + bonus) * bf2f(G[o]));
            YM[tg * D_ + 1024 + ch] = YC[o];
        }
    }
}

__device__ __forceinline__ int f2key(float x) { const int u = __float_as_int(x); return u ^ ((u >> 31) & 0x7fffffff); }
__device__ __forceinline__ float key2f(int k) { return __int_as_float(k ^ ((k >> 31) & 0x7fffffff)); }
template <int CTRL> __device__ __forceinline__ int dpp_i(int v) { return __builtin_amdgcn_update_dpp(v, v, CTRL, 0xf, 0xf, false); }
__device__ __forceinline__ int row_max_i(int v) { v = max(v, dpp_i<0xB1>(v)); v = max(v, dpp_i<0x4E>(v)); v = max(v, dpp_i<0x141>(v)); v = max(v, dpp_i<0x140>(v)); return v; }
__device__ __forceinline__ void phase_topk(const Params& p, unsigned char* shm) {
    float* sc = (float*)shm;
    int* tk = (int*)(sc + 64 * 260);
    const bf16_t* Q = (const bf16_t*)(p.ws + WS_Q); const float* keys = p.in[22];
    int* IDS = (int*)(p.ws + WS_IDS); float* GATES = (float*)(p.ws + WS_GATES);
    const int tid = threadIdx.x, w = tid >> 6, lane = tid & 63, fr = lane & 15, fq = lane >> 4;
    for (int item = blockIdx.x; item < 2048; item += gridDim.x) {
        const int h = item & 7, t0 = (item >> 3) * 64;
        const int c = w >> 2, nb = (w & 3) * 32;
        f32x4 acc[4][2];
#pragma unroll
        for (int m = 0; m < 4; ++m)
#pragma unroll
            for (int n = 0; n < 2; ++n) acc[m][n] = (f32x4){0.f, 0.f, 0.f, 0.f};
        const float* kb = keys + ((size_t)(h * 2 + c) * 128) * 256;
        for (int ks = 0; ks < 8; ++ks) {
            bf16x8 a[4], b[2];
#pragma unroll
            for (int m = 0; m < 4; ++m) a[m] = *(const bf16x8*)(Q + (size_t)(t0 + m * 16 + fr) * 4096 + h * 512 + c * 256 + ks * 32 + fq * 8);
#pragma unroll
            for (int n = 0; n < 2; ++n) { const float4* kp = (const float4*)(kb + (size_t)(nb + n * 16 + fr) * 256 + ks * 32 + fq * 8); const float4 x0 = kp[0], x1 = kp[1];
                u32x4 wv; wv.x = cvt_pk_bf16(x0.x, x0.y); wv.y = cvt_pk_bf16(x0.z, x0.w); wv.z = cvt_pk_bf16(x1.x, x1.y); wv.w = cvt_pk_bf16(x1.z, x1.w);
                b[n] = __builtin_bit_cast(bf16x8, wv); }
#pragma unroll
            for (int m = 0; m < 4; ++m)
#pragma unroll
                for (int n = 0; n < 2; ++n) acc[m][n] = __builtin_amdgcn_mfma_f32_16x16x32_bf16(a[m], b[n], acc[m][n], 0, 0, 0);
        }
        __syncthreads();
#pragma unroll
        for (int m = 0; m < 4; ++m)
#pragma unroll
            for (int n = 0; n < 2; ++n)
#pragma unroll
                for (int j = 0; j < 4; ++j) sc[(m * 16 + fq * 4 + j) * 260 + c * 128 + nb + n * 16 + fr] = acc[m][n][j];
        __syncthreads();
        for (int g = 0; g < 4; ++g) {
            const int L = w * 16 + g * 4 + (lane >> 4); const int tok = L >> 1, cc = L & 1; const int pp = lane & 15;
            int key[8];
#pragma unroll
            for (int i = 0; i < 8; ++i) key[i] = (f2key(sc[tok * 260 + cc * 128 + i * 16 + pp]) & ~127) | (127 - (i * 16 + pp));
            int mykey = 0;
#pragma unroll
            for (int r = 0; r < 16; ++r) {
                const int ml = max(max(max(key[0], key[1]), max(key[2], key[3])), max(max(key[4], key[5]), max(key[6], key[7])));
                const int m = row_max_i(ml);
#pragma unroll
                for (int i = 0; i < 8; ++i) key[i] = (key[i] == m) ? (int)0x80000000 : key[i];
                mykey = (pp == r) ? m : mykey;
            }
            tk[L * 16 + pp] = mykey;
        }
        __syncthreads();
        for (int g = 0; g < 2; ++g) {
            const int tok = w * 8 + g * 4 + (lane >> 4); const int pp = lane & 15;
            const float s1 = key2f(tk[(tok * 2) * 16 + pp] & ~127);
            int key[16];
#pragma unroll
            for (int j = 0; j < 16; ++j) { const float s2 = key2f(tk[(tok * 2 + 1) * 16 + j] & ~127); key[j] = (f2key(s1 + s2) & ~255) | (255 - (pp * 16 + j)); }
            int mykey = 0;
#pragma unroll
            for (int r = 0; r < 16; ++r) {
                int ml = max(max(max(key[0], key[1]), max(key[2], key[3])), max(max(key[4], key[5]), max(key[6], key[7])));
                ml = max(ml, max(max(max(key[8], key[9]), max(key[10], key[11])), max(max(key[12], key[13]), max(key[14], key[15]))));
                const int m = row_max_i(ml);
#pragma unroll
                for (int j = 0; j < 16; ++j) key[j] = (key[j] == m) ? (int)0x80000000 : key[j];
                mykey = (pp == r) ? m : mykey;
            }
            const int ci = 255 - (mykey & 255); const float cs = key2f(mykey & ~255);
            const int e1 = 127 - (tk[(tok * 2) * 16 + (ci >> 4)] & 127), e2 = 127 - (tk[(tok * 2 + 1) * 16 + (ci & 15)] & 127);
            const float mx = __shfl(cs, lane & 48);
            const float e = __expf(cs - mx);
            float sum = e; sum += dpp_f<0xB1, 0xf>(sum); sum += dpp_f<0x4E, 0xf>(sum); sum += dpp_f<0x141, 0xf>(sum); sum += dpp_f<0x140, 0xf>(sum);
            IDS[(size_t)(t0 + tok) * 128 + h * 16 + pp] = (e1 * 128 + e2) & 16383;
            GATES[(size_t)(t0 + tok) * 128 + h * 16 + pp] = e / sum;
        }
    }
}

constexpr float U8_SCALE = 64.f, V8_SCALE = 32.f;
__device__ __forceinline__ void phase_gather(const Params& p, unsigned char* shm) {
    float* part = (float*)shm;
    float* red = part + 8 * 2048;
    const bf16_t* H2 = (const bf16_t*)(p.ws + WS_H2); const float* X1 = (const float*)(p.ws + WS_X1);
    const unsigned char* U8 = p.ws + WS_UB; const unsigned char* V8 = p.ws + WS_VB;
    const int* IDS = (const int*)(p.ws + WS_IDS); const float* GATES = (const float*)(p.ws + WS_GATES);
    const float* nf = p.in[25];
    const int tid = threadIdx.x, w = tid >> 6, lane = tid & 63;
    for (int t = blockIdx.x; t < S_; t += gridDim.x) {
        float hf[32];
#pragma unroll
        for (int q = 0; q < 2; ++q)
#pragma unroll
            for (int hh = 0; hh < 2; ++hh) { const u32x4 hv = *(const u32x4*)(H2 + (size_t)t * D_ + q * 1024 + lane * 16 + hh * 8);
#pragma unroll
                for (int i = 0; i < 4; ++i) { hf[q * 16 + hh * 8 + 2 * i] = lo_bf(hv[i]); hf[q * 16 + hh * 8 + 2 * i + 1] = hi_bf(hv[i]); } }
        const int myid = (lane < 16) ? IDS[(size_t)t * 128 + w * 16 + lane] : 0;
        const float mygate = (lane < 16) ? GATES[(size_t)t * 128 + w * 16 + lane] : 0.f;
        float myact = 0.f;
#pragma unroll 8
        for (int e = 0; e < 16; ++e) {
            const int id = __builtin_amdgcn_readlane(myid, e);
            const unsigned char* ur = U8 + (size_t)id * D_ + lane * 16;
            float d = 0.f;
#pragma unroll
            for (int q = 0; q < 2; ++q) { const u32x4 uv = *(const u32x4*)(ur + q * 1024);
#pragma unroll
                for (int i = 0; i < 4; ++i) { const f32x2 a = __builtin_amdgcn_cvt_pk_f32_fp8((int)uv[i], false), b = __builtin_amdgcn_cvt_pk_f32_fp8((int)uv[i], true);
                    d += a.x * hf[q * 16 + 4 * i] + a.y * hf[q * 16 + 4 * i + 1] + b.x * hf[q * 16 + 4 * i + 2] + b.y * hf[q * 16 + 4 * i + 3]; } }
            d = wave_sum_dpp(d) * (1.f / U8_SCALE);
            if (lane == e) myact = gelu_tanh(d) * mygate * (1.f / V8_SCALE);
        }
        float o[32];
#pragma unroll
        for (int i = 0; i < 32; ++i) o[i] = 0.f;
#pragma unroll 8
        for (int e = 0; e < 16; ++e) {
            const int id = __builtin_amdgcn_readlane(myid, e);
            const float a = __int_as_float(__builtin_amdgcn_readlane(__float_as_int(myact), e));
            const unsigned char* vr = V8 + (size_t)id * D_ + lane * 16;
#pragma unroll
            for (int q = 0; q < 2; ++q) { const u32x4 vv = *(const u32x4*)(vr + q * 1024);
#pragma unroll
                for (int i = 0; i < 4; ++i) { const f32x2 x = __builtin_amdgcn_cvt_pk_f32_fp8((int)vv[i], false), y = __builtin_amdgcn_cvt_pk_f32_fp8((int)vv[i], true);
                    o[q * 16 + 4 * i] += a * x.x; o[q * 16 + 4 * i + 1] += a * x.y; o[q * 16 + 4 * i + 2] += a * y.x; o[q * 16 + 4 * i + 3] += a * y.y; } }
        }
        __syncthreads();
#pragma unroll
        for (int q = 0; q < 2; ++q)
#pragma unroll
            for (int i = 0; i < 4; ++i)
                *(float4*)(part + w * 2048 + q * 1024 + lane * 16 + 4 * i) = make_float4(o[q * 16 + 4 * i], o[q * 16 + 4 * i + 1], o[q * 16 + 4 * i + 2], o[q * 16 + 4 * i + 3]);
        __syncthreads();
        float4 s = *(const float4*)(X1 + (size_t)t * D_ + tid * 4);
#pragma unroll
        for (int ww = 0; ww < 8; ++ww) { const float4 pp = *(const float4*)(part + ww * 2048 + tid * 4); s.x += pp.x; s.y += pp.y; s.z += pp.z; s.w += pp.w; }
        float ss = wave_sum_dpp(s.x * s.x + s.y * s.y + s.z * s.z + s.w * s.w);
        if (lane == 0) red[w] = ss;
        __syncthreads();
        float tot = 0.f;
#pragma unroll
        for (int ww = 0; ww < 8; ++ww) tot += red[ww];
        const float scl = rsqrtf(tot * (1.f / 2048.f) + 1e-6f);
        const float4 g = *(const float4*)(nf + tid * 4);
        *(float4*)(p.out + (size_t)t * D_ + tid * 4) = make_float4(s.x * scl * g.x, s.y * scl * g.y, s.z * scl * g.z, s.w * scl * g.w);
    }
}

__global__ void __launch_bounds__(512, 2) mega(Params p) {
    extern __shared__ __attribute__((aligned(16))) unsigned char shm[];
    cg::grid_group grid = cg::this_grid();
    LAS unsigned char* lds = (LAS unsigned char*)shm;
    const int lo = p.ph_lo, hi = p.ph_hi;
#define IN(k) (lo <= (k) && (k) < hi)
#define REP(k) for (int _r = 0; _r < ((k) == DUP_PHASE ? 2 : 1); ++_r)
#define SEAM(k) do { if (IN(k) && IN((k) + 1)) grid.sync(); } while (0)
    if (IN(0)) REP(0) { if (_r) grid.sync(); phase0(p, shm); }
    SEAM(0);
    if (IN(1)) REP(1) { if (_r) grid.sync();
        pg8::Gemm g{(const bf16_t*)(p.ws + WS_H), (const bf16_t*)(p.ws + WS_WB1), S_, NAUG, 2048};
        pg8::StaticOrder so; so.init(g.M, g.N, (int)gridDim.x, (int)blockIdx.x);
        pg8::EpiBf16 E{(bf16_t*)(p.ws + WS_PROJ), NAUG};
        pg8::gemm_phase(lds, g, so, E);
    }
    SEAM(1);
    if (IN(2)) REP(2) { if (_r) grid.sync();
        phase_prep(p, shm);
        transpose_convert(p.in[21], 2048, 4096, (bf16_t*)(p.ws + WS_WQT), (float*)shm);
        transpose_convert(p.in[19], 2048, 2048, (bf16_t*)(p.ws + WS_WOT), (float*)shm);
    }
    SEAM(2);
    if (IN(3)) REP(3) { if (_r) grid.sync(); phase_chunkA(p, lds); }
    SEAM(3);
    if (IN(4)) REP(4) { if (_r) grid.sync(); phase_seq(p); }
    SEAM(4);
    if (IN(5)) REP(5) { if (_r) grid.sync(); phase_chunkY(p, lds); }
    SEAM(5);
    if (IN(6)) REP(6) { if (_r) grid.sync();
        pg8::Gemm g{(const bf16_t*)(p.ws + WS_YMIX), (const bf16_t*)(p.ws + WS_WOT), S_, 2048, 2048};
        pg8::StaticOrder so; so.init(g.M, g.N, (int)gridDim.x, (int)blockIdx.x);
        pg8::EpiResF32 E{(float*)(p.ws + WS_X1), p.in[0], 2048};
        pg8::gemm_phase(lds, g, so, E);
    }
    SEAM(6);
    if (IN(7)) REP(7) { if (_r) grid.sync();
        rmsnorm_rows((const float*)(p.ws + WS_X1), p.in[20], (bf16_t*)(p.ws + WS_H2));
        convert_fp8(p.in[23], p.ws + WS_UB, (size_t)16384 * 2048, U8_SCALE);
        convert_fp8(p.in[24], p.ws + WS_VB, (size_t)16384 * 2048, V8_SCALE);
    }
    SEAM(7);
    if (IN(8)) REP(8) { if (_r) grid.sync();
        pg8::Gemm g{(const bf16_t*)(p.ws + WS_H2), (const bf16_t*)(p.ws + WS_WQT), S_, 4096, 2048};
        pg8::StaticOrder so; so.init(g.M, g.N, (int)gridDim.x, (int)blockIdx.x);
        pg8::EpiBf16 E{(bf16_t*)(p.ws + WS_Q), 4096};
        pg8::gemm_phase(lds, g, so, E);
    }
    SEAM(8);
    if (IN(9)) REP(9) { if (_r) grid.sync(); phase_topk(p, shm); }
    SEAM(9);
    if (IN(10)) REP(10) { if (_r) grid.sync(); phase_gather(p, shm); }
#undef IN
#undef REP
#undef SEAM
}

extern "C" void kernel_launch(void* const* d_in, const int* in_sizes, int n_in, void* d_out, int out_size, void* d_ws, size_t ws_size, hipStream_t stream) {
    static int grid_blocks = 0;
    if (grid_blocks == 0) {
        if (n_in != 26 || ws_size < WS_NEED) { fprintf(stderr, "kernel_launch: unexpected n_in %d / ws_size %zu\n", n_in, ws_size); grid_blocks = -1; return; }
        int dev = 0, cus = 0, per_cu = 0;
        (void)hipGetDevice(&dev);
        (void)hipDeviceGetAttribute(&cus, hipDeviceAttributeMultiprocessorCount, dev);
        (void)hipFuncSetAttribute((const void*)mega, hipFuncAttributeMaxDynamicSharedMemorySize, LDS_BYTES);
        (void)hipOccupancyMaxActiveBlocksPerMultiprocessor(&per_cu, (const void*)mega, 512, LDS_BYTES);
        if (per_cu < 1) { fprintf(stderr, "kernel_launch: occupancy query says %d blocks/CU\n", per_cu); per_cu = 1; }
        grid_blocks = cus * per_cu;
        fprintf(stderr, "kernel_launch: cus %d per_cu %d grid %d\n", cus, per_cu, grid_blocks);
    }
    if (grid_blocks < 0) return;
    Params p{};
    for (int i = 0; i < 26; ++i) p.in[i] = (const float*)d_in[i];
    p.out = (float*)d_out; p.ws = (unsigned char*)d_ws;
#if MULTI_LAUNCH
    for (int ph = 0; ph < NPHASE; ++ph) {
        p.ph_lo = ph; p.ph_hi = ph + 1;
        hipLaunchKernelGGL(mega, dim3(grid_blocks), dim3(512), LDS_BYTES, stream, p);
    }
#else
    p.ph_lo = 0; p.ph_hi = NPHASE;
    void* args[] = {&p};
    hipError_t e = hipLaunchCooperativeKernel((const void*)mega, dim3(grid_blocks), dim3(512), args, LDS_BYTES, stream);
    if (e != hipSuccess) fprintf(stderr, "cooperative launch failed: %s (grid %d)\n", hipGetErrorString(e), grid_blocks);
#endif
}
```

```cpp
#include <hip/hip_runtime.h>
#include <hip/hip_cooperative_groups.h>
#include <cstdio>
namespace cg = cooperative_groups;

#ifndef DUP_PHASE
#define DUP_PHASE -1
#endif
#ifndef MULTI_LAUNCH
#define MULTI_LAUNCH 0
#endif

#define LAS __attribute__((address_space(3)))
typedef unsigned short bf16_t;
typedef short bf16x8 __attribute__((ext_vector_type(8)));
typedef float f32x4 __attribute__((ext_vector_type(4)));
typedef float f32x2 __attribute__((ext_vector_type(2)));
typedef unsigned u32x4 __attribute__((ext_vector_type(4)));
typedef unsigned u32x2 __attribute__((ext_vector_type(2)));

constexpr int S_ = 16384, D_ = 2048, DR = 1024, NAUG = 6912;
constexpr size_t MiB = 1ull << 20;
constexpr size_t WS_PROJ = 0, WS_H = 216 * MiB, WS_WB1 = 280 * MiB, WS_WQT = 280 * MiB, WS_WOT = 296 * MiB;
constexpr size_t WS_R = 307 * MiB, WS_K = 339 * MiB, WS_V = 371 * MiB, WS_KK = 403 * MiB, WS_A = 435 * MiB, WS_LW = 467 * MiB;
constexpr size_t WS_G = 216 * MiB, WS_YC = 248 * MiB, WS_YMIX = 403 * MiB, WS_X1 = 0, WS_H2 = 128 * MiB, WS_Q = 307 * MiB;
constexpr size_t WS_GT = 0, WS_HT = 32 * MiB, WS_QE = 96 * MiB, WS_YL = 128 * MiB, WS_S0 = 160 * MiB;
constexpr size_t WS_IDS = 192 * MiB, WS_GATES = 200 * MiB, WS_UB = 435 * MiB, WS_VB = 208 * MiB, WS_BON = 500 * MiB, WS_NEED = 501 * MiB;
constexpr size_t WS_W2T = 499 * MiB, WS_A2T = WS_W2T + 131072, WS_G2T = WS_A2T + 131072;
constexpr int TLD = 72, TSLOT = 64 * TLD * 2;
constexpr int LDS_BYTES = 16 * TSLOT + 2048 + 256;
constexpr int NPHASE = 11;

struct Params {
    const float* in[26];
    float* out;
    unsigned char* ws;
    int ph_lo, ph_hi;
};

__device__ __forceinline__ float bf2f(bf16_t b) { return __uint_as_float(((unsigned)b) << 16); }
__device__ __forceinline__ bf16_t f2bf(float f) { unsigned u = __float_as_uint(f); u += 0x7FFFu + ((u >> 16) & 1u); return (bf16_t)(u >> 16); }
typedef __bf16 bf16v2_t __attribute__((ext_vector_type(2)));
__device__ __forceinline__ unsigned cvt_pk_bf16(float lo, float hi) { const f32x2 v = {lo, hi}; const bf16v2_t r = __builtin_convertvector(v, bf16v2_t); return __builtin_bit_cast(unsigned, r); }
__device__ __forceinline__ u32x4 pack8(const float* f) { u32x4 w; w.x = cvt_pk_bf16(f[0], f[1]); w.y = cvt_pk_bf16(f[2], f[3]); w.z = cvt_pk_bf16(f[4], f[5]); w.w = cvt_pk_bf16(f[6], f[7]); return w; }
__device__ __forceinline__ float wave_sum(float v) {
#pragma unroll
    for (int o = 32; o; o >>= 1) v += __shfl_xor(v, o);
    return v;
}
template <int CTRL, int RM> __device__ __forceinline__ float dpp_f(float v) { return __int_as_float(__builtin_amdgcn_update_dpp(0, __float_as_int(v), CTRL, RM, 0xf, false)); }
__device__ __forceinline__ float wave_sum_dpp(float v) {
    v += dpp_f<0xB1, 0xf>(v); v += dpp_f<0x4E, 0xf>(v); v += dpp_f<0x141, 0xf>(v); v += dpp_f<0x140, 0xf>(v);
    v += dpp_f<0x142, 0xa>(v); v += dpp_f<0x143, 0xc>(v);
    return __int_as_float(__builtin_amdgcn_readlane(__float_as_int(v), 63));
}
__device__ __forceinline__ float wave_max(float v) {
#pragma unroll
    for (int o = 32; o; o >>= 1) v = fmaxf(v, __shfl_xor(v, o));
    return v;
}
__device__ __forceinline__ float sigmoidf_(float x) { return 1.0f / (1.0f + __expf(-x)); }
__device__ __forceinline__ float gelu_tanh(float x) { float u = 0.7978845608028654f * (x + 0.044715f * x * x * x); return 0.5f * x * (1.0f + tanhf(u)); }
__device__ __forceinline__ float lo_bf(unsigned w) { return __uint_as_float(w << 16); }
__device__ __forceinline__ float hi_bf(unsigned w) { return __uint_as_float(w & 0xffff0000u); }

namespace pg8 {
constexpr int BM = 256, BK = 64, HALF = 128, HTB = HALF * BK * 2, STAGE_BYTES = 8 * HTB, NXCD = 8, WGM = 8;
__device__ __forceinline__ int lds_byte(int r, int c) { const int st = (r >> 4) * 2 + (c >> 5), rr = r & 15, cc = c & 31, ob = rr * 64 + cc * 2; return st * 1024 + (ob ^ (((ob >> 9) & 1) << 5)); }
__device__ __forceinline__ void stage_rc(int b, int& R, int& C) { const int st = b / 1024, sb = b % 1024, swz = sb ^ (((sb >> 9) & 1) << 5); R = (st >> 1) * 16 + swz / 64; C = (st & 1) * 32 + (swz % 64) / 2; }
__device__ __forceinline__ int perm32(int rho) { const int n = rho >> 4, i = rho & 15; return 8 * (i >> 2) + 4 * n + (i & 3); }
struct Unit { int pm, pn; };
struct Gemm { const bf16_t* A; const bf16_t* Bt; int M, N, K; };
struct StaticOrder {
    int nM, nN, nwg, G, c;
    __device__ void init(int M, int N, int G_, int c_) { nM = M / BM; nN = N / BM; nwg = nM * nN; G = G_; c = c_; }
    __device__ bool next(int i, Unit& u) const {
        const long L = (long)i * G + c; if (L >= nwg) return false;
        int wgid = (int)L; { const int q = nwg / NXCD, r = nwg % NXCD, xcd = wgid % NXCD, off = wgid / NXCD; wgid = (xcd < r ? xcd * (q + 1) : r * (q + 1) + (xcd - r) * q) + off; }
        const int nig = WGM * nN, gid = wgid / nig, fm = gid * WGM, gsz = (nM - fm) < WGM ? (nM - fm) : WGM;
        u.pm = fm + ((wgid % nig) % gsz); u.pn = (wgid % nig) / gsz; return true;
    }
    __device__ __forceinline__ void a_ready(const Unit&) const {}
    __device__ __forceinline__ void done(const Unit&) const {}
};
struct EpiResF32 {
    static constexpr bool PERM = false;
    float* C; const float* Res; int ldc;
    __device__ __forceinline__ void operator()(const f32x4 (&acc)[2][2][4][2], const Unit& u, int wr, int wc, int fr, int fq) const {
        const int row0 = u.pm * BM + wr * 64 + fr, col0 = u.pn * BM + wc * 32 + 4 * fq;
#pragma unroll
        for (int ai = 0; ai < 2; ++ai)
#pragma unroll
            for (int m = 0; m < 4; ++m) { const size_t ro = (size_t)(row0 + ai * HALF + m * 16) * ldc + col0;
#pragma unroll
                for (int bj = 0; bj < 2; ++bj)
#pragma unroll
                    for (int n = 0; n < 2; ++n) { const f32x4 rs = *(const f32x4*)(Res + ro + bj * HALF + n * 16); *(f32x4*)(C + ro + bj * HALF + n * 16) = acc[ai][bj][m][n] + rs; } }
    }
};
struct EpiBf16 {
    static constexpr bool PERM = true;
    bf16_t* O; int ldc;
    __device__ __forceinline__ void operator()(const f32x4 (&acc)[2][2][4][2], const Unit& u, int wr, int wc, int fr, int fq) const {
        const int row0 = u.pm * BM + wr * 64 + fr; const int col0 = u.pn * BM + wc * 32 + 8 * fq;
#pragma unroll
        for (int ai = 0; ai < 2; ++ai)
#pragma unroll
            for (int m = 0; m < 4; ++m) { bf16_t* rowp = O + (size_t)(row0 + ai * HALF + m * 16) * ldc + col0;
#pragma unroll
                for (int bj = 0; bj < 2; ++bj) { const f32x4 v0 = acc[ai][bj][m][0], v1 = acc[ai][bj][m][1];
                    u32x4 w; w.x = cvt_pk_bf16(v0[0], v0[1]); w.y = cvt_pk_bf16(v0[2], v0[3]); w.z = cvt_pk_bf16(v1[0], v1[1]); w.w = cvt_pk_bf16(v1[2], v1[3]);
                    *(u32x4*)(rowp + bj * HALF) = w; } }
    }
};

template <class Epi, class Sched>
__device__ __forceinline__ void gemm_phase(LAS unsigned char* lds, const Gemm g, const Sched& S, const Epi& E) {
    const int tid = threadIdx.x, wid = __builtin_amdgcn_readfirstlane(tid >> 6), lane = tid & 63, wr = wid >> 2, wc = wid & 3, fr = lane & 15, fq = lane >> 4;
    const int K = g.K, nt = K / BK;
    unsigned voffA[2], voffB[2];
#pragma unroll
    for (int i = 0; i < 2; ++i) { int R, C; stage_rc(tid * 16 + i * 8192, R, C); const int Rb = Epi::PERM ? ((R & ~31) + perm32(R & 31)) : R;
        voffA[i] = (unsigned)(R * K + C) * 2u; voffB[i] = (unsigned)(Rb * K + C) * 2u; }
    const size_t kstep = (size_t)(BK * 2);
    const size_t hstep = (size_t)HALF * K * 2;
    const size_t tstep = 2 * hstep;
    const unsigned ldsw = (unsigned)wid * 1024u;
    const int aoff = lds_byte(wr * 64 + fr, fq * 8), boff = lds_byte(wc * 32 + fr, fq * 8);
#define PG8_SA(b, h) (((b) * 2 + (h)) * HTB)
#define PG8_SB(b, h) ((4 + (b) * 2 + (h)) * HTB)
#define PG8_STAGE(bufoff, gbase, voff) do { _Pragma("unroll") for (int _i = 0; _i < 2; ++_i) \
        __builtin_amdgcn_global_load_lds((const unsigned*)((const char*)(gbase) + (voff)[_i]), (LAS unsigned*)(lds + (bufoff) + ldsw + _i * 8192), 16, 0, 0); } while (0)
#define PG8_LDA(dst, b, h) do { _Pragma("unroll") for (int m = 0; m < 4; ++m) _Pragma("unroll") for (int k = 0; k < 2; ++k) dst[m][k] = *(const LAS bf16x8*)(lds + PG8_SA(b, h) + aoff + m * 2048 + k * 1024); } while (0)
#define PG8_LDB(dst, b, h) do { _Pragma("unroll") for (int n = 0; n < 2; ++n) _Pragma("unroll") for (int k = 0; k < 2; ++k) dst[n][k] = *(const LAS bf16x8*)(lds + PG8_SB(b, h) + boff + n * 2048 + k * 1024); } while (0)
#define PG8_MMA(ai, bj, At, Bt) do { __builtin_amdgcn_s_setprio(1); _Pragma("unroll") for (int m = 0; m < 4; ++m) _Pragma("unroll") for (int n = 0; n < 2; ++n) _Pragma("unroll") for (int k = 0; k < 2; ++k) \
        acc[ai][bj][m][n] = __builtin_amdgcn_mfma_f32_16x16x32_bf16(Bt[n][k], At[m][k], acc[ai][bj][m][n], 0, 0, 0); __builtin_amdgcn_s_setprio(0); } while (0)
#define PG8_WAIT_V(n) asm volatile("s_waitcnt vmcnt(" #n ")" ::: "memory")
#define PG8_WAIT_L(n) asm volatile("s_waitcnt lgkmcnt(" #n ")" ::: "memory")
#define PG8_BAR __builtin_amdgcn_s_barrier()
#define PG8_SCHED __builtin_amdgcn_sched_barrier(0)
    Unit cur, nxt; int ui = 0;
    if (!S.next(0, cur)) return;
    f32x4 acc[2][2][4][2];
#pragma unroll
    for (int a = 0; a < 2; ++a)
#pragma unroll
        for (int b = 0; b < 2; ++b)
#pragma unroll
            for (int m = 0; m < 4; ++m)
#pragma unroll
                for (int n = 0; n < 2; ++n) acc[a][b][m][n] = (f32x4){0.f, 0.f, 0.f, 0.f};
    bf16x8 At[4][2], B0[2][2], B1[2][2];
    const char* cA = (const char*)g.A + (size_t)cur.pm * tstep; const char* cB = (const char*)g.Bt + (size_t)cur.pn * tstep;
    S.a_ready(cur);
    PG8_STAGE(PG8_SB(0, 0), cB, voffB); PG8_STAGE(PG8_SA(0, 0), cA, voffA); PG8_STAGE(PG8_SB(0, 1), cB + hstep, voffB); PG8_STAGE(PG8_SA(0, 1), cA + hstep, voffA);
    if (wr == 1) PG8_BAR;
    PG8_WAIT_V(4); PG8_BAR;
    PG8_STAGE(PG8_SB(1, 0), cB + kstep, voffB); PG8_STAGE(PG8_SA(1, 0), cA + kstep, voffA); PG8_STAGE(PG8_SB(1, 1), cB + hstep + kstep, voffB);
    PG8_WAIT_V(6); PG8_BAR;
    for (;;) {
        const bool has_next = S.next(ui + 1, nxt);
        const char* nA = has_next ? (const char*)g.A + (size_t)nxt.pm * tstep : cA; const char* nB = has_next ? (const char*)g.Bt + (size_t)nxt.pn * tstep : cB;
        for (int t = 0; t < nt; t += 2) {
            const bool last = (t == nt - 2);
            const char* a1 = cA + (size_t)(t + 1) * kstep;
            const char* a2 = last ? nA : cA + (size_t)(t + 2) * kstep; const char* b2 = last ? nB : cB + (size_t)(t + 2) * kstep;
            const char* a3 = a2 + kstep; const char* b3 = b2 + kstep;
            if (last && has_next) S.a_ready(nxt);
            PG8_LDB(B0, 0, 0); PG8_SCHED; PG8_LDA(At, 0, 0); PG8_STAGE(PG8_SA(1, 1), a1 + hstep, voffA);
            PG8_WAIT_L(8); PG8_BAR; PG8_WAIT_L(0); PG8_MMA(0, 0, At, B0); PG8_BAR; PG8_SCHED;
            PG8_LDB(B1, 0, 1); PG8_STAGE(PG8_SB(0, 0), b2, voffB);
            PG8_BAR; PG8_WAIT_L(0); PG8_MMA(0, 1, At, B1); PG8_BAR;
            PG8_LDA(At, 0, 1); PG8_STAGE(PG8_SA(0, 0), a2, voffA);
            PG8_BAR; PG8_WAIT_L(0); PG8_MMA(1, 0, At, B0); PG8_BAR; PG8_SCHED;
            PG8_STAGE(PG8_SB(0, 1), b2 + hstep, voffB);
            PG8_WAIT_V(6); PG8_BAR; PG8_MMA(1, 1, At, B1); PG8_BAR;
            PG8_LDB(B0, 1, 0); PG8_SCHED; PG8_LDA(At, 1, 0); PG8_STAGE(PG8_SA(0, 1), a2 + hstep, voffA);
            PG8_WAIT_L(8); PG8_BAR; PG8_WAIT_L(0); PG8_MMA(0, 0, At, B0); PG8_BAR; PG8_SCHED;
            PG8_LDB(B1, 1, 1); PG8_STAGE(PG8_SB(1, 0), b3, voffB);
            PG8_BAR; PG8_WAIT_L(0); PG8_MMA(0, 1, At, B1); PG8_BAR;
            PG8_LDA(At, 1, 1); PG8_STAGE(PG8_SA(1, 0), a3, voffA);
            PG8_BAR; PG8_WAIT_L(0); PG8_MMA(1, 0, At, B0); PG8_BAR; PG8_SCHED;
            PG8_STAGE(PG8_SB(1, 1), b3 + hstep, voffB);
            PG8_WAIT_V(6); PG8_BAR; PG8_MMA(1, 1, At, B1); PG8_BAR;
        }
        E(acc, cur, wr, wc, fr, fq); S.done(cur);
        if (!has_next) break;
#pragma unroll
        for (int a = 0; a < 2; ++a)
#pragma unroll
            for (int b = 0; b < 2; ++b)
#pragma unroll
                for (int m = 0; m < 4; ++m)
#pragma unroll
                    for (int n = 0; n < 2; ++n) acc[a][b][m][n] = (f32x4){0.f, 0.f, 0.f, 0.f};
        cur = nxt; cA = nA; cB = nB; ++ui;
    }
    PG8_WAIT_V(0);
    if (wr == 0) PG8_BAR;
    PG8_BAR;
#undef PG8_SA
#undef PG8_SB
#undef PG8_STAGE
#undef PG8_LDA
#undef PG8_LDB
#undef PG8_MMA
#undef PG8_WAIT_V
#undef PG8_WAIT_L
#undef PG8_BAR
#undef PG8_SCHED
}
}

__device__ __forceinline__ void rmsnorm_rows(const float* X, const float* gain, bf16_t* H) {
    const int wave = threadIdx.x >> 6, lane = threadIdx.x & 63;
    for (int row = blockIdx.x * 8 + wave; row < S_; row += gridDim.x * 8) {
        const float4* xr = (const float4*)(X + (size_t)row * D_);
        float4 v[8]; float ss = 0.f;
#pragma unroll
        for (int i = 0; i < 8; ++i) { v[i] = xr[i * 64 + lane]; ss += v[i].x * v[i].x + v[i].y * v[i].y + v[i].z * v[i].z + v[i].w * v[i].w; }
        ss = wave_sum(ss);
        const float sc = rsqrtf(ss * (1.0f / 2048.0f) + 1e-6f);
#pragma unroll
        for (int i = 0; i < 8; ++i) { const float4 g = ((const float4*)gain)[i * 64 + lane];
            u32x2 w; w.x = cvt_pk_bf16(v[i].x * sc * g.x, v[i].y * sc * g.y); w.y = cvt_pk_bf16(v[i].z * sc * g.z, v[i].w * sc * g.w);
            *(u32x2*)(H + (size_t)row * D_ + (i * 64 + lane) * 4) = w; }
    }
}

__device__ __forceinline__ void transpose_convert(const float* W, int K, int N, bf16_t* Bt, float* tile) {
    const int tid = threadIdx.x; const int tk = K / 64, tn = N / 64;
    for (int u = blockIdx.x; u < tk * tn; u += gridDim.x) {
        const int k0 = (u / tn) * 64, n0 = (u % tn) * 64;
        __syncthreads();
#pragma unroll
        for (int i = 0; i < 8; ++i) { const int kk = i * 8 + (tid >> 6), nn = tid & 63; tile[kk * 65 + nn] = W[(size_t)(k0 + kk) * N + n0 + nn]; }
        __syncthreads();
#pragma unroll
        for (int i = 0; i < 4; ++i) { const int nn = i * 16 + (tid >> 5), kp = (tid & 31) * 2;
            *(unsigned*)(Bt + (size_t)(n0 + nn) * K + k0 + kp) = cvt_pk_bf16(tile[kp * 65 + nn], tile[(kp + 1) * 65 + nn]); }
    }
}

__device__ __forceinline__ void convert_flat(const float* src, bf16_t* dst, size_t n) {
    for (size_t i = ((size_t)blockIdx.x * 512 + threadIdx.x) * 8; i < n; i += (size_t)gridDim.x * 512 * 8) {
        const float4 a = *(const float4*)(src + i), b = *(const float4*)(src + i + 4);
        u32x4 w; w.x = cvt_pk_bf16(a.x, a.y); w.y = cvt_pk_bf16(a.z, a.w); w.z = cvt_pk_bf16(b.x, b.y); w.w = cvt_pk_bf16(b.z, b.w);
        *(u32x4*)(dst + i) = w;
    }
}

__device__ __forceinline__ void convert_fp8(const float* src, unsigned char* dst, size_t n, float sc) {
    for (size_t i = ((size_t)blockIdx.x * 512 + threadIdx.x) * 16; i < n; i += (size_t)gridDim.x * 512 * 16) {
        u32x4 w;
#pragma unroll
        for (int j = 0; j < 4; ++j) { const float4 a = *(const float4*)(src + i + 4 * j);
            int x = __builtin_amdgcn_cvt_pk_fp8_f32(a.x * sc, a.y * sc, 0, false); x = __builtin_amdgcn_cvt_pk_fp8_f32(a.z * sc, a.w * sc, x, true); w[j] = (unsigned)x; }
        *(u32x4*)(dst + i) = w;
    }
}

__device__ __forceinline__ void phase0(const Params& p, unsigned char* shm) {
    bf16_t* WB1 = (bf16_t*)(p.ws + WS_WB1);
    rmsnorm_rows(p.in[0], p.in[1], (bf16_t*)(p.ws + WS_H));
    transpose_convert(p.in[2], 2048, 6144, WB1, (float*)shm);
    const float* mu = p.in[4]; const float* w1 = p.in[6]; const float* a1 = p.in[9]; const float* g1 = p.in[11];
    for (int idx = blockIdx.x * 512 + threadIdx.x; idx < 768 * 2048; idx += gridDim.x * 512) {
        const int j = idx >> 11, k = idx & 2047; float val = 0.f;
        if (j < 128) { const float m = mu[k], w = w1[k * 64 + (j & 63)]; val = (j < 64) ? w * (1.f - m) : w * m; }
        else if (j < 256) { const float m = mu[2048 + k], w = a1[k * 64 + (j & 63)]; val = (j < 192) ? w * (1.f - m) : w * m; }
        else if (j < 576) { const float m = mu[4096 + k]; const int jj = j - 256; const int c = jj < 160 ? jj : jj - 160; const float w = g1[k * 160 + c]; val = jj < 160 ? w * (1.f - m) : w * m; }
        WB1[(size_t)(6144 + j) * 2048 + k] = f2bf(val);
    }
    bf16_t* W2T = (bf16_t*)(p.ws + WS_W2T); bf16_t* A2T = (bf16_t*)(p.ws + WS_A2T); bf16_t* G2T = (bf16_t*)(p.ws + WS_G2T);
    const float* w2 = p.in[7]; const float* a2 = p.in[10]; const float* g2 = p.in[12];
    for (int idx = blockIdx.x * 512 + threadIdx.x; idx < 1024 * 288; idx += gridDim.x * 512) {
        if (idx < 65536) { const int c = idx >> 6, j = idx & 63; W2T[idx] = f2bf(w2[j * 1024 + c]); }
        else if (idx < 131072) { const int i2 = idx - 65536; const int c = i2 >> 6, j = i2 & 63; A2T[i2] = f2bf(a2[j * 1024 + c]); }
        else { const int i2 = idx - 131072; const int c = i2 / 160, j = i2 % 160; G2T[i2] = f2bf(g2[j * 1024 + c]); }
    }
}

constexpr int ACT_LD = 296;
template <int KS, int KOFF, int KTOT, int KIND>
__device__ __forceinline__ void lora_stage(const LAS bf16_t* act, const bf16_t* WT, const float* bias, bf16_t* OUT, int t0, int w, int fr, int fq) {
#pragma unroll 1
    for (int nh = 0; nh < 2; ++nh) {
        f32x4 acc[4][4];
#pragma unroll
        for (int m = 0; m < 4; ++m)
#pragma unroll
            for (int n = 0; n < 4; ++n) acc[m][n] = (f32x4){0.f, 0.f, 0.f, 0.f};
#pragma unroll 1
        for (int ks = 0; ks < KS; ++ks) {
            bf16x8 a[4];
#pragma unroll
            for (int m = 0; m < 4; ++m) a[m] = *(const LAS bf16x8*)(act + (m * 16 + fr) * ACT_LD + KOFF + ks * 32 + fq * 8);
#pragma unroll
            for (int n = 0; n < 4; ++n) {
                const bf16x8 b = *(const bf16x8*)(WT + (size_t)(w * 128 + (nh * 4 + n) * 16 + fr) * KTOT + ks * 32 + fq * 8);
#pragma unroll
                for (int m = 0; m < 4; ++m) acc[m][n] = __builtin_amdgcn_mfma_f32_16x16x32_bf16(a[m], b, acc[m][n], 0, 0, 0);
            }
        }
#pragma unroll
        for (int n = 0; n < 4; ++n) {
            const int c = w * 128 + (nh * 4 + n) * 16 + fr;
            const float bs = (KIND < 2) ? bias[c] : 0.f;
#pragma unroll
            for (int m = 0; m < 4; ++m)
#pragma unroll
                for (int j = 0; j < 4; ++j) {
                    const float val = acc[m][n][j]; float o;
                    if (KIND == 0) { const float x = -(bs + val); const float sp = fmaxf(x, 0.f) + log1pf(__expf(-fabsf(x))); o = -__expf(-sp - 0.5f); }
                    else if (KIND == 1) o = sigmoidf_(bs + val);
                    else o = val;
                    OUT[(size_t)(t0 + m * 16 + fq * 4 + j) * DR + c] = f2bf(o);
                }
        }
    }
}
__device__ __forceinline__ void phase_prepM(const Params& p, LAS unsigned char* lds) {
    LAS bf16_t* act = (LAS bf16_t*)lds;
    const bf16_t* P = (const bf16_t*)(p.ws + WS_PROJ);
    const int tid = threadIdx.x, w = tid >> 6, lane = tid & 63, fr = lane & 15, fq = lane >> 4;
    for (int tile = blockIdx.x; tile < S_ / 64; tile += gridDim.x) {
        const int t0 = tile * 64;
        __syncthreads();
        for (int e = tid; e < 64 * 288; e += 512) {
            const int t = e / 288, j = e % 288; const int tg = t0 + t;
            int ccur, cprev;
            if (j < 64) { ccur = 6144 + j; cprev = 6208 + j; }
            else if (j < 128) { ccur = 6272 + (j - 64); cprev = 6336 + (j - 64); }
            else { ccur = 6400 + (j - 128); cprev = 6560 + (j - 128); }
            float sv = bf2f(P[(size_t)tg * NAUG + ccur]);
            if (tg > 0) sv += bf2f(P[(size_t)(tg - 1) * NAUG + cprev]);
            const float a = j < 64 ? tanhf(sv) : (j < 128 ? sv : sigmoidf_(sv));
            act[t * ACT_LD + j] = f2bf(a);
        }
        __syncthreads();
        lora_stage<2, 0, 64, 0>(act, (const bf16_t*)(p.ws + WS_W2T), p.in[5], (bf16_t*)(p.ws + WS_LW), t0, w, fr, fq);
        lora_stage<2, 64, 64, 1>(act, (const bf16_t*)(p.ws + WS_A2T), p.in[8], (bf16_t*)(p.ws + WS_A), t0, w, fr, fq);
        lora_stage<5, 128, 160, 2>(act, (const bf16_t*)(p.ws + WS_G2T), nullptr, (bf16_t*)(p.ws + WS_G), t0, w, fr, fq);
    }
}

__device__ __forceinline__ void unpack8(const u32x4 v, float* f) {
#pragma unroll
    for (int i = 0; i < 4; ++i) { f[2 * i] = lo_bf(v[i]); f[2 * i + 1] = hi_bf(v[i]); }
}
__device__ __forceinline__ void phase_prepE(const Params& p) {
    const bf16_t* P = (const bf16_t*)(p.ws + WS_PROJ);
    bf16_t* R = (bf16_t*)(p.ws + WS_R); bf16_t* Kk = (bf16_t*)(p.ws + WS_K); bf16_t* V = (bf16_t*)(p.ws + WS_V); bf16_t* KK = (bf16_t*)(p.ws + WS_KK); bf16_t* YC = (bf16_t*)(p.ws + WS_YC);
    const float* mu_rkv = p.in[3]; const float* k_k = p.in[13]; const float* cw = p.in[18];
    const int tid = threadIdx.x, cg = tid & 127, c0 = cg * 8, tgrp = tid >> 7;
    float mr[8], mk[8], mv[8], kkc[8], cw0[8], cw1[8], cw2[8];
#pragma unroll
    for (int i = 0; i < 8; ++i) { mr[i] = mu_rkv[c0 + i]; mk[i] = mu_rkv[1024 + c0 + i]; mv[i] = mu_rkv[2048 + c0 + i]; kkc[i] = k_k[c0 + i]; cw0[i] = cw[c0 + i]; cw1[i] = cw[1024 + c0 + i]; cw2[i] = cw[2048 + c0 + i]; }
    for (int run = blockIdx.x * 4 + tgrp; run < S_ / 16; run += gridDim.x * 4) {
        const int t0 = run * 16;
        float pr[8], pk[8], pv[8], u1[8], u2[8];
#pragma unroll
        for (int i = 0; i < 8; ++i) { pr[i] = 0.f; pk[i] = 0.f; pv[i] = 0.f; u1[i] = 0.f; u2[i] = 0.f; }
        if (t0 > 0) {
            const size_t o = (size_t)(t0 - 1) * NAUG + c0;
            unpack8(*(const u32x4*)(P + o), pr); unpack8(*(const u32x4*)(P + o + 1024), pk); unpack8(*(const u32x4*)(P + o + 2048), pv);
            float x[8], y[8];
            unpack8(*(const u32x4*)(P + o + 4096), x); unpack8(*(const u32x4*)(P + o + 5120), y);
#pragma unroll
            for (int i = 0; i < 8; ++i) u1[i] = x[i] * y[i];
            unpack8(*(const u32x4*)(P + o - NAUG + 4096), x); unpack8(*(const u32x4*)(P + o - NAUG + 5120), y);
#pragma unroll
            for (int i = 0; i < 8; ++i) u2[i] = x[i] * y[i];
        }
#pragma unroll 1
        for (int t = 0; t < 16; ++t) {
            const size_t o = (size_t)(t0 + t) * NAUG + c0;
            float cr[8], ck[8], cv[8], bg[8], cgt[8], xc[8];
            unpack8(*(const u32x4*)(P + o), cr); unpack8(*(const u32x4*)(P + o + 1024), ck); unpack8(*(const u32x4*)(P + o + 2048), cv);
            unpack8(*(const u32x4*)(P + o + 3072), bg); unpack8(*(const u32x4*)(P + o + 4096), cgt); unpack8(*(const u32x4*)(P + o + 5120), xc);
            float r[8], k[8], v[8], kkv[8], yc[8]; float ss = 0.f;
#pragma unroll
            for (int i = 0; i < 8; ++i) {
                r[i] = cr[i] + (pr[i] - cr[i]) * mr[i]; k[i] = ck[i] + (pk[i] - ck[i]) * mk[i]; v[i] = cv[i] + (pv[i] - cv[i]) * mv[i];
                pr[i] = cr[i]; pk[i] = ck[i]; pv[i] = cv[i];
                kkv[i] = k[i] * kkc[i]; ss += kkv[i] * kkv[i];
                const float u0 = cgt[i] * xc[i];
                yc[i] = bg[i] * (cw0[i] * u2[i] + cw1[i] * u1[i] + cw2[i] * u0);
                u2[i] = u1[i]; u1[i] = u0;
            }
            ss += dpp_f<0xB1, 0xf>(ss); ss += dpp_f<0x4E, 0xf>(ss); ss += dpp_f<0x141, 0xf>(ss);
            const float inv = 1.0f / fmaxf(sqrtf(ss), 1e-12f);
#pragma unroll
            for (int i = 0; i < 8; ++i) kkv[i] *= inv;
            const size_t oo = (size_t)(t0 + t) * DR + c0;
            *(u32x4*)(R + oo) = pack8(r); *(u32x4*)(Kk + oo) = pack8(k); *(u32x4*)(V + oo) = pack8(v); *(u32x4*)(KK + oo) = pack8(kkv); *(u32x4*)(YC + oo) = pack8(yc);
        }
    }
}

#define TILE(i) ((LAS bf16_t*)(lds + (i) * TSLOT))
__device__ __forceinline__ f32x4 mm_tile(f32x4 acc, const LAS bf16_t* A, const LAS bf16_t* Bt, int mi, int ni, int fr, int fq) {
#pragma unroll
    for (int ks = 0; ks < 2; ++ks) {
        const bf16x8 a = *(const LAS bf16x8*)(A + (mi * 16 + fr) * TLD + ks * 32 + fq * 8);
        const bf16x8 b = *(const LAS bf16x8*)(Bt + (ni * 16 + fr) * TLD + ks * 32 + fq * 8);
        acc = __builtin_amdgcn_mfma_f32_16x16x32_bf16(a, b, acc, 0, 0, 0);
    }
    return acc;
}
__device__ __forceinline__ void st_rm(LAS bf16_t* X, f32x4 v, int mi, int ni, int fr, int fq) {
    const unsigned w0 = cvt_pk_bf16(v[0], v[1]), w1 = cvt_pk_bf16(v[2], v[3]);
    LAS bf16_t* q = X + (mi * 16 + fq * 4) * TLD + ni * 16 + fr;
    q[0] = (bf16_t)(w0 & 0xffffu); q[TLD] = (bf16_t)(w0 >> 16); q[2 * TLD] = (bf16_t)(w1 & 0xffffu); q[3 * TLD] = (bf16_t)(w1 >> 16);
}
__device__ __forceinline__ void st_tr(LAS bf16_t* XT, f32x4 v, int mi, int ni, int fr, int fq) {
    u32x2 w; w.x = cvt_pk_bf16(v[0], v[1]); w.y = cvt_pk_bf16(v[2], v[3]);
    *(LAS u32x2*)(XT + (ni * 16 + fr) * TLD + mi * 16 + fq * 4) = w;
}
__device__ __forceinline__ f32x4 ld_rm(const LAS bf16_t* X, int mi, int ni, int fr, int fq) {
    const LAS bf16_t* q = X + (mi * 16 + fq * 4) * TLD + ni * 16 + fr;
    return (f32x4){bf2f(q[0]), bf2f(q[TLD]), bf2f(q[2 * TLD]), bf2f(q[3 * TLD])};
}
__device__ __forceinline__ f32x4 ld_tr(const LAS bf16_t* XT, int mi, int ni, int fr, int fq) {
    const u32x2 w = *(const LAS u32x2*)(XT + (ni * 16 + fr) * TLD + mi * 16 + fq * 4);
    return (f32x4){lo_bf(w.x), hi_bf(w.x), lo_bf(w.y), hi_bf(w.y)};
}

__device__ __forceinline__ void phase_chunkA(const Params& p, LAS unsigned char* lds) {
    const int tid = threadIdx.x, w = tid >> 6, lane = tid & 63, fr = lane & 15, fq = lane >> 4;
    const int mi = w >> 1, nb = (w & 1) * 2;
    LAS float* cl = (LAS float*)(lds + 14 * TSLOT);
    LAS float* gs = (LAS float*)(lds + 16 * TSLOT);
    LAS float* wc = gs + 512;
    const bf16_t* R = (const bf16_t*)(p.ws + WS_R); const bf16_t* Kk = (const bf16_t*)(p.ws + WS_K); const bf16_t* V = (const bf16_t*)(p.ws + WS_V);
    const bf16_t* KK = (const bf16_t*)(p.ws + WS_KK); const bf16_t* A = (const bf16_t*)(p.ws + WS_A); const bf16_t* LW = (const bf16_t*)(p.ws + WS_LW);
    bf16_t* GT = (bf16_t*)(p.ws + WS_GT); float* HT = (float*)(p.ws + WS_HT); bf16_t* QE = (bf16_t*)(p.ws + WS_QE); bf16_t* YL = (bf16_t*)(p.ws + WS_YL);
    const f32x4 z4 = (f32x4){0.f, 0.f, 0.f, 0.f};
    const float* k_a = p.in[14]; const float* r_k = p.in[15]; float* BON = (float*)(p.ws + WS_BON);
    for (int item = blockIdx.x; item < 4096; item += gridDim.x) {
        const int c = item >> 4, h = item & 15;
        const size_t gbase = (size_t)(c * 64) * DR + h * 64;
        {
            const int g = w, k = lane;
            float pfx[8]; float run = 0.f;
#pragma unroll
            for (int i = 0; i < 8; ++i) { run += bf2f(LW[gbase + (size_t)(g * 8 + i) * DR + k]); pfx[i] = run; }
            gs[g * 64 + k] = run;
            __syncthreads();
            float off = 0.f;
#pragma unroll
            for (int gg = 0; gg < 7; ++gg) { const float x = gs[gg * 64 + k]; off += (gg < g) ? x : 0.f; }
#pragma unroll
            for (int i = 0; i < 8; ++i) cl[(g * 8 + i) * 64 + k] = off + pfx[i];
            if (g == 7) wc[k] = __expf(off + pfx[7]);
            __syncthreads();
        }
        {
            const int t = tid >> 3, k0 = (tid & 7) * 8;
            const size_t go = gbase + (size_t)t * DR + k0;
            const u32x4 r4 = *(const u32x4*)(R + go), k4 = *(const u32x4*)(Kk + go), v4 = *(const u32x4*)(V + go), kk4 = *(const u32x4*)(KK + go), a4 = *(const u32x4*)(A + go), lw4 = *(const u32x4*)(LW + go);
            float at[8], rt[8], bt[8], kt[8], bh[8], kh[8], vv[8]; float bsum = 0.f;
#pragma unroll
            for (int i = 0; i < 8; ++i) {
                const int q = i >> 1; const bool hi = i & 1;
                const float rf = hi ? hi_bf(r4[q]) : lo_bf(r4[q]), kraw = hi ? hi_bf(k4[q]) : lo_bf(k4[q]), vf = hi ? hi_bf(v4[q]) : lo_bf(v4[q]);
                const float kkf = hi ? hi_bf(kk4[q]) : lo_bf(kk4[q]), af = hi ? hi_bf(a4[q]) : lo_bf(a4[q]), lwf = hi ? hi_bf(lw4[q]) : lo_bf(lw4[q]);
                const float kf = kraw * (1.f + (af - 1.f) * k_a[h * 64 + k0 + i]);
                bsum += rf * kf * r_k[h * 64 + k0 + i];
                const float clv = cl[t * 64 + k0 + i], cle = cl[63 * 64 + k0 + i];
                const float e = __expf(clv), ex = __expf(clv - lwf), ei = __expf(-clv), eh = __expf(cle - clv);
                const float bb = kkf * af;
                at[i] = -kkf * ex; rt[i] = rf * e; bt[i] = bb * ei; kt[i] = kf * ei; bh[i] = bb * eh; kh[i] = kf * eh; vv[i] = vf;
            }
            bsum += dpp_f<0xB1, 0xf>(bsum); bsum += dpp_f<0x4E, 0xf>(bsum); bsum += dpp_f<0x141, 0xf>(bsum);
            if ((tid & 7) == 0) BON[(size_t)(c * 64 + t) * 16 + h] = bsum;
            *(LAS u32x4*)(TILE(0) + t * TLD + k0) = pack8(at);
            *(LAS u32x4*)(TILE(2) + t * TLD + k0) = pack8(rt);
            *(LAS u32x4*)(TILE(3) + t * TLD + k0) = pack8(bt);
            *(LAS u32x4*)(TILE(4) + t * TLD + k0) = pack8(kt);
            const u32x4 atp = pack8(at), bhp = pack8(bh), khp = pack8(kh);
#pragma unroll
            for (int i = 0; i < 8; ++i) {
                const int q = i >> 1; const bool hi = i & 1;
                TILE(1)[(k0 + i) * TLD + t] = (bf16_t)(hi ? (atp[q] >> 16) : (atp[q] & 0xffffu));
                TILE(5)[(k0 + i) * TLD + t] = (bf16_t)(hi ? (bhp[q] >> 16) : (bhp[q] & 0xffffu));
                TILE(6)[(k0 + i) * TLD + t] = (bf16_t)(hi ? (khp[q] >> 16) : (khp[q] & 0xffffu));
                TILE(7)[(k0 + i) * TLD + t] = (bf16_t)(hi ? (v4[q] >> 16) : (v4[q] & 0xffffu));
            }
            __syncthreads();
        }
#pragma unroll
        for (int nn = 0; nn < 2; ++nn) {
            const int ni = nb + nn; const int col = ni * 16 + fr, row0 = mi * 16 + fq * 4;
            f32x4 x = mm_tile(z4, TILE(0), TILE(3), mi, ni, fr, fq);
#pragma unroll
            for (int j = 0; j < 4; ++j) x[j] = (col < row0 + j) ? x[j] : 0.f;
            st_rm(TILE(8), x, mi, ni, fr, fq); st_tr(TILE(9), x, mi, ni, fr, fq);
            x = mm_tile(z4, TILE(0), TILE(4), mi, ni, fr, fq);
#pragma unroll
            for (int j = 0; j < 4; ++j) x[j] = (col < row0 + j) ? x[j] : 0.f;
            st_rm(TILE(10), x, mi, ni, fr, fq);
            x = mm_tile(z4, TILE(2), TILE(3), mi, ni, fr, fq);
#pragma unroll
            for (int j = 0; j < 4; ++j) x[j] = (col <= row0 + j) ? x[j] : 0.f;
            st_rm(TILE(11), x, mi, ni, fr, fq);
            x = mm_tile(z4, TILE(2), TILE(4), mi, ni, fr, fq);
#pragma unroll
            for (int j = 0; j < 4; ++j) x[j] = (col <= row0 + j) ? x[j] : 0.f;
            st_rm(TILE(12), x, mi, ni, fr, fq);
        }
        __syncthreads();
#pragma unroll
        for (int nn = 0; nn < 2; ++nn) {
            const int ni = nb + nn;
            st_tr(TILE(13), mm_tile(z4, TILE(10), TILE(7), mi, ni, fr, fq), mi, ni, fr, fq);
            const f32x4 x = mm_tile(z4, TILE(8), TILE(9), mi, ni, fr, fq);
            st_rm(TILE(0), x, mi, ni, fr, fq); st_tr(TILE(3), x, mi, ni, fr, fq);
        }
        __syncthreads();
#pragma unroll
        for (int rd = 0; rd < 5; ++rd) {
            const int tq = (rd & 1) ? 14 : 8, tqo = (rd & 1) ? 8 : 14;
            const int lx = (rd & 1) ? 4 : 0, lxt = (rd & 1) ? 9 : 3, lxo = (rd & 1) ? 0 : 4, lxto = (rd & 1) ? 3 : 9;
#pragma unroll
            for (int nn = 0; nn < 2; ++nn) {
                const int ni = nb + nn;
                f32x4 x = ld_rm(TILE(tq), mi, ni, fr, fq) + ld_rm(TILE(lx), mi, ni, fr, fq);
                x = mm_tile(x, TILE(tq), TILE(lxt), mi, ni, fr, fq);
                st_rm(TILE(tqo), x, mi, ni, fr, fq);
                if (rd < 4) { const f32x4 y = mm_tile(z4, TILE(lx), TILE(lxt), mi, ni, fr, fq); st_rm(TILE(lxo), y, mi, ni, fr, fq); st_tr(TILE(lxto), y, mi, ni, fr, fq); }
            }
            __syncthreads();
        }
#pragma unroll
        for (int nn = 0; nn < 2; ++nn) {
            const int ni = nb + nn;
            st_tr(TILE(10), mm_tile(ld_tr(TILE(1), mi, ni, fr, fq), TILE(14), TILE(1), mi, ni, fr, fq), mi, ni, fr, fq);
            st_tr(TILE(15), mm_tile(ld_tr(TILE(13), mi, ni, fr, fq), TILE(14), TILE(13), mi, ni, fr, fq), mi, ni, fr, fq);
        }
        __syncthreads();
#pragma unroll
        for (int nn = 0; nn < 2; ++nn) {
            const int ni = nb + nn;
            {
                f32x4 x = mm_tile(z4, TILE(5), TILE(10), mi, ni, fr, fq);
                if (mi == ni) {
#pragma unroll
                    for (int j = 0; j < 4; ++j) x[j] += (fq * 4 + j == fr) ? wc[ni * 16 + fr] : 0.f;
                }
                const unsigned w0 = cvt_pk_bf16(x[0], x[1]), w1 = cvt_pk_bf16(x[2], x[3]);
                bf16_t* gp = GT + (size_t)item * 4096 + (size_t)((mi * 2 + (ni >> 1)) * 64 + (fr >> 2) * 16 + fq * 4) * 8 + (ni & 1) * 4 + (fr & 3);
                gp[0] = (bf16_t)(w0 & 0xffffu); gp[8] = (bf16_t)(w0 >> 16); gp[16] = (bf16_t)(w1 & 0xffffu); gp[24] = (bf16_t)(w1 >> 16);
            }
            {
                f32x4 x = mm_tile(z4, TILE(5), TILE(15), mi, ni, fr, fq);
                x = mm_tile(x, TILE(6), TILE(7), mi, ni, fr, fq);
                *(f32x4*)(HT + (size_t)item * 4096 + (size_t)((ni * 4 + mi) * 64 + lane) * 4) = x;
            }
            {
                f32x4 x = ld_tr(TILE(2), mi, ni, fr, fq);
                x = mm_tile(x, TILE(10), TILE(11), mi, ni, fr, fq);
                u32x2 wv; wv.x = cvt_pk_bf16(x[0], x[1]); wv.y = cvt_pk_bf16(x[2], x[3]);
                *(u32x2*)(QE + (size_t)item * 4096 + (ni * 16 + fr) * 64 + mi * 16 + fq * 4) = wv;
            }
            {
                f32x4 x = mm_tile(z4, TILE(11), TILE(15), mi, ni, fr, fq);
                x = mm_tile(x, TILE(12), TILE(7), mi, ni, fr, fq);
                u32x2 wv; wv.x = cvt_pk_bf16(x[0], x[1]); wv.y = cvt_pk_bf16(x[2], x[3]);
                *(u32x2*)(YL + (size_t)item * 4096 + (size_t)((mi * 4 + ni) * 64 + lane) * 4) = wv;
            }
        }
    }
}

__device__ __forceinline__ void phase_seq(const Params& p) {
    if (blockIdx.x >= 64 || threadIdx.x >= 64) return;
    const int head = blockIdx.x >> 2, vt = blockIdx.x & 3, lane = threadIdx.x, fr = lane & 15, fq = lane >> 4;
    const bf16_t* GT = (const bf16_t*)(p.ws + WS_GT); const float* HT = (const float*)(p.ws + WS_HT); bf16_t* S0 = (bf16_t*)(p.ws + WS_S0);
    f32x4 acc[4];
#pragma unroll
    for (int mb = 0; mb < 4; ++mb) acc[mb] = (f32x4){0.f, 0.f, 0.f, 0.f};
    bf16x8 ga[4][2]; f32x4 hh[4];
    {
        const size_t item = head;
#pragma unroll
        for (int mb = 0; mb < 4; ++mb) {
#pragma unroll
            for (int ks = 0; ks < 2; ++ks) ga[mb][ks] = *(const bf16x8*)(GT + item * 4096 + (size_t)((mb * 2 + ks) * 64 + lane) * 8);
            hh[mb] = *(const f32x4*)(HT + item * 4096 + (size_t)((vt * 4 + mb) * 64 + lane) * 4);
        }
    }
    for (int c = 0; c < 256; ++c) {
        const size_t item = (size_t)c * 16 + head;
        const size_t nitem = (size_t)(c < 255 ? c + 1 : c) * 16 + head;
        bf16x8 gn[4][2]; f32x4 hn[4];
#pragma unroll
        for (int mb = 0; mb < 4; ++mb) {
#pragma unroll
            for (int ks = 0; ks < 2; ++ks) gn[mb][ks] = *(const bf16x8*)(GT + nitem * 4096 + (size_t)((mb * 2 + ks) * 64 + lane) * 8);
            hn[mb] = *(const f32x4*)(HT + nitem * 4096 + (size_t)((vt * 4 + mb) * 64 + lane) * 4);
        }
        u32x2 pk[4];
#pragma unroll
        for (int mb = 0; mb < 4; ++mb) { pk[mb].x = cvt_pk_bf16(acc[mb][0], acc[mb][1]); pk[mb].y = cvt_pk_bf16(acc[mb][2], acc[mb][3]);
            *(u32x2*)(S0 + item * 4096 + (vt * 16 + fr) * 64 + mb * 16 + fq * 4) = pk[mb]; }
        u32x4 b0w, b1w; b0w.x = pk[0].x; b0w.y = pk[0].y; b0w.z = pk[1].x; b0w.w = pk[1].y; b1w.x = pk[2].x; b1w.y = pk[2].y; b1w.z = pk[3].x; b1w.w = pk[3].y;
        const bf16x8 b0 = __builtin_bit_cast(bf16x8, b0w), b1 = __builtin_bit_cast(bf16x8, b1w);
#pragma unroll
        for (int mb = 0; mb < 4; ++mb) {
            f32x4 x = __builtin_amdgcn_mfma_f32_16x16x32_bf16(ga[mb][0], b0, hh[mb], 0, 0, 0);
            acc[mb] = __builtin_amdgcn_mfma_f32_16x16x32_bf16(ga[mb][1], b1, x, 0, 0, 0);
        }
#pragma unroll
        for (int mb = 0; mb < 4; ++mb) { ga[mb][0] = gn[mb][0]; ga[mb][1] = gn[mb][1]; hh[mb] = hn[mb]; }
    }
}

__device__ __forceinline__ void phase_chunkY(const Params& p, LAS unsigned char* lds) {
    LAS float* Yb = (LAS float*)lds;
    const int tid = threadIdx.x, w = tid >> 6, lane = tid & 63, fr = lane & 15, fq = lane >> 4;
    const int mi = w >> 1, nb = (w & 1) * 2;
    const bf16_t* R = (const bf16_t*)(p.ws + WS_R); const bf16_t* Kk = (const bf16_t*)(p.ws + WS_K); const bf16_t* V = (const bf16_t*)(p.ws + WS_V);
    const bf16_t* G = (const bf16_t*)(p.ws + WS_G); const bf16_t* YC = (const bf16_t*)(p.ws + WS_YC);
    const bf16_t* QE = (const bf16_t*)(p.ws + WS_QE); const bf16_t* YL = (const bf16_t*)(p.ws + WS_YL); const bf16_t* S0 = (const bf16_t*)(p.ws + WS_S0);
    bf16_t* YM = (bf16_t*)(p.ws + WS_YMIX);
    const float* r_k = p.in[15]; const float* gn_w = p.in[16]; const float* gn_b = p.in[17];
    for (int item = blockIdx.x; item < 4096; item += gridDim.x) {
        const int c = item >> 4, h = item & 15;
        const bf16_t* Qp = QE + (size_t)item * 4096; const bf16_t* Sp = S0 + (size_t)item * 4096; const bf16_t* Yp = YL + (size_t)item * 4096;
        __syncthreads();
#pragma unroll
        for (int nn = 0; nn < 2; ++nn) {
            const int ni = nb + nn;
            const u32x2 yw = *(const u32x2*)(Yp + (size_t)((mi * 4 + ni) * 64 + lane) * 4);
            f32x4 acc = (f32x4){lo_bf(yw.x), hi_bf(yw.x), lo_bf(yw.y), hi_bf(yw.y)};
#pragma unroll
            for (int ks = 0; ks < 2; ++ks) {
                const bf16x8 a = *(const bf16x8*)(Qp + (mi * 16 + fr) * 64 + ks * 32 + fq * 8);
                const bf16x8 b = *(const bf16x8*)(Sp + (ni * 16 + fr) * 64 + ks * 32 + fq * 8);
                acc = __builtin_amdgcn_mfma_f32_16x16x32_bf16(a, b, acc, 0, 0, 0);
            }
#pragma unroll
            for (int j = 0; j < 4; ++j) Yb[(mi * 16 + fq * 4 + j) * 68 + ni * 16 + fr] = acc[j];
        }
        __syncthreads();
        const int ch = h * 64 + lane;
        const float gw = gn_w[ch], gb = gn_b[ch];
        const float* BON = (const float*)(p.ws + WS_BON);
#pragma unroll
        for (int tt = 0; tt < 8; ++tt) {
            const int t = w * 8 + tt; const size_t tg = (size_t)c * 64 + t; const size_t o = tg * DR + ch;
            const float y = Yb[t * 68 + lane];
            const float mean = wave_sum(y) * (1.f / 64.f); const float d = y - mean;
            const float var = wave_sum(d * d) * (1.f / 64.f);
            const float yn = d * rsqrtf(var + 64e-5f) * gw + gb;
            const float bonus = BON[tg * 16 + h] * bf2f(V[o]);
            YM[tg * D_ + ch] = f2bf((yn + bonus) * bf2f(G[o]));
            YM[tg * D_ + 1024 + ch] = YC[o];
        }
    }
}

__device__ __forceinline__ int f2key(float x) { const int u = __float_as_int(x); return u ^ ((u >> 31) & 0x7fffffff); }
__device__ __forceinline__ float key2f(int k) { return __int_as_float(k ^ ((k >> 31) & 0x7fffffff)); }
template <int CTRL> __device__ __forceinline__ int dpp_i(int v) { return __builtin_amdgcn_update_dpp(v, v, CTRL, 0xf, 0xf, false); }
__device__ __forceinline__ int row_max_i(int v) { v = max(v, dpp_i<0xB1>(v)); v = max(v, dpp_i<0x4E>(v)); v = max(v, dpp_i<0x141>(v)); v = max(v, dpp_i<0x140>(v)); return v; }
__device__ __forceinline__ void phase_topk(const Params& p, unsigned char* shm) {
    float* sc = (float*)shm;
    int* tk = (int*)(sc + 64 * 260);
    const bf16_t* Q = (const bf16_t*)(p.ws + WS_Q); const float* keys = p.in[22];
    int* IDS = (int*)(p.ws + WS_IDS); float* GATES = (float*)(p.ws + WS_GATES);
    const int tid = threadIdx.x, w = tid >> 6, lane = tid & 63, fr = lane & 15, fq = lane >> 4;
    for (int item = blockIdx.x; item < 2048; item += gridDim.x) {
        const int h = item & 7, t0 = (item >> 3) * 64;
        const int c = w >> 2, nb = (w & 3) * 32;
        f32x4 acc[4][2];
#pragma unroll
        for (int m = 0; m < 4; ++m)
#pragma unroll
            for (int n = 0; n < 2; ++n) acc[m][n] = (f32x4){0.f, 0.f, 0.f, 0.f};
        const float* kb = keys + ((size_t)(h * 2 + c) * 128) * 256;
        for (int ks = 0; ks < 8; ++ks) {
            bf16x8 a[4], b[2];
#pragma unroll
            for (int m = 0; m < 4; ++m) a[m] = *(const bf16x8*)(Q + (size_t)(t0 + m * 16 + fr) * 4096 + h * 512 + c * 256 + ks * 32 + fq * 8);
#pragma unroll
            for (int n = 0; n < 2; ++n) { const float4* kp = (const float4*)(kb + (size_t)(nb + n * 16 + fr) * 256 + ks * 32 + fq * 8); const float4 x0 = kp[0], x1 = kp[1];
                u32x4 wv; wv.x = cvt_pk_bf16(x0.x, x0.y); wv.y = cvt_pk_bf16(x0.z, x0.w); wv.z = cvt_pk_bf16(x1.x, x1.y); wv.w = cvt_pk_bf16(x1.z, x1.w);
                b[n] = __builtin_bit_cast(bf16x8, wv); }
#pragma unroll
            for (int m = 0; m < 4; ++m)
#pragma unroll
                for (int n = 0; n < 2; ++n) acc[m][n] = __builtin_amdgcn_mfma_f32_16x16x32_bf16(a[m], b[n], acc[m][n], 0, 0, 0);
        }
        __syncthreads();
#pragma unroll
        for (int m = 0; m < 4; ++m)
#pragma unroll
            for (int n = 0; n < 2; ++n)
#pragma unroll
                for (int j = 0; j < 4; ++j) sc[(m * 16 + fq * 4 + j) * 260 + c * 128 + nb + n * 16 + fr] = acc[m][n][j];
        __syncthreads();
        for (int g = 0; g < 4; ++g) {
            const int L = w * 16 + g * 4 + (lane >> 4); const int tok = L >> 1, cc = L & 1; const int pp = lane & 15;
            int key[8];
#pragma unroll
            for (int i = 0; i < 8; ++i) key[i] = (f2key(sc[tok * 260 + cc * 128 + i * 16 + pp]) & ~127) | (127 - (i * 16 + pp));
            int mykey = 0;
#pragma unroll
            for (int r = 0; r < 16; ++r) {
                const int ml = max(max(max(key[0], key[1]), max(key[2], key[3])), max(max(key[4], key[5]), max(key[6], key[7])));
                const int m = row_max_i(ml);
#pragma unroll
                for (int i = 0; i < 8; ++i) key[i] = (key[i] == m) ? (int)0x80000000 : key[i];
                mykey = (pp == r) ? m : mykey;
            }
            tk[L * 16 + pp] = mykey;
        }
        __syncthreads();
        for (int g = 0; g < 2; ++g) {
            const int tok = w * 8 + g * 4 + (lane >> 4); const int pp = lane & 15;
            const float s1 = key2f(tk[(tok * 2) * 16 + pp] & ~127);
            int key[16];
#pragma unroll
            for (int j = 0; j < 16; ++j) { const float s2 = key2f(tk[(tok * 2 + 1) * 16 + j] & ~127); key[j] = (f2key(s1 + s2) & ~255) | (255 - (pp * 16 + j)); }
            int mykey = 0;
#pragma unroll
            for (int r = 0; r < 16; ++r) {
                int ml = max(max(max(key[0], key[1]), max(key[2], key[3])), max(max(key[4], key[5]), max(key[6], key[7])));
                ml = max(ml, max(max(max(key[8], key[9]), max(key[10], key[11])), max(max(key[12], key[13]), max(key[14], key[15]))));
                const int m = row_max_i(ml);
#pragma unroll
                for (int j = 0; j < 16; ++j) key[j] = (key[j] == m) ? (int)0x80000000 : key[j];
                mykey = (pp == r) ? m : mykey;
            }
            const int ci = 255 - (mykey & 255); const float cs = key2f(mykey & ~255);
            const int e1 = 127 - (tk[(tok * 2) * 16 + (ci >> 4)] & 127), e2 = 127 - (tk[(tok * 2 + 1) * 16 + (ci & 15)] & 127);
            const float mx = __shfl(cs, lane & 48);
            const float e = __expf(cs - mx);
            float sum = e; sum += dpp_f<0xB1, 0xf>(sum); sum += dpp_f<0x4E, 0xf>(sum); sum += dpp_f<0x141, 0xf>(sum); sum += dpp_f<0x140, 0xf>(sum);
            IDS[(size_t)(t0 + tok) * 128 + h * 16 + pp] = (e1 * 128 + e2) & 16383;
            GATES[(size_t)(t0 + tok) * 128 + h * 16 + pp] = e / sum;
        }
    }
}

constexpr float U8_SCALE = 64.f, V8_SCALE = 32.f;
__device__ __forceinline__ void phase_gather(const Params& p, unsigned char* shm) {
    float* part = (float*)shm;
    float* red = part + 8 * 2048;
    const bf16_t* H2 = (const bf16_t*)(p.ws + WS_H2); const float* X1 = (const float*)(p.ws + WS_X1);
    const unsigned char* U8 = p.ws + WS_UB; const unsigned char* V8 = p.ws + WS_VB;
    const int* IDS = (const int*)(p.ws + WS_IDS); const float* GATES = (const float*)(p.ws + WS_GATES);
    const float* nf = p.in[25];
    const int tid = threadIdx.x, w = tid >> 6, lane = tid & 63;
    for (int t = blockIdx.x; t < S_; t += gridDim.x) {
        float hf[32];
#pragma unroll
        for (int q = 0; q < 2; ++q)
#pragma unroll
            for (int hh = 0; hh < 2; ++hh) { const u32x4 hv = *(const u32x4*)(H2 + (size_t)t * D_ + q * 1024 + lane * 16 + hh * 8);
#pragma unroll
                for (int i = 0; i < 4; ++i) { hf[q * 16 + hh * 8 + 2 * i] = lo_bf(hv[i]); hf[q * 16 + hh * 8 + 2 * i + 1] = hi_bf(hv[i]); } }
        const int myid = (lane < 16) ? IDS[(size_t)t * 128 + w * 16 + lane] : 0;
        const float mygate = (lane < 16) ? GATES[(size_t)t * 128 + w * 16 + lane] : 0.f;
        float myact = 0.f;
#pragma unroll 8
        for (int e = 0; e < 16; ++e) {
            const int id = __builtin_amdgcn_readlane(myid, e);
            const unsigned char* ur = U8 + (size_t)id * D_ + lane * 16;
            float d = 0.f;
#pragma unroll
            for (int q = 0; q < 2; ++q) { const u32x4 uv = *(const u32x4*)(ur + q * 1024);
#pragma unroll
                for (int i = 0; i < 4; ++i) { const f32x2 a = __builtin_amdgcn_cvt_pk_f32_fp8((int)uv[i], false), b = __builtin_amdgcn_cvt_pk_f32_fp8((int)uv[i], true);
                    d += a.x * hf[q * 16 + 4 * i] + a.y * hf[q * 16 + 4 * i + 1] + b.x * hf[q * 16 + 4 * i + 2] + b.y * hf[q * 16 + 4 * i + 3]; } }
            d = wave_sum_dpp(d) * (1.f / U8_SCALE);
            if (lane == e) myact = gelu_tanh(d) * mygate * (1.f / V8_SCALE);
        }
        float o[32];
#pragma unroll
        for (int i = 0; i < 32; ++i) o[i] = 0.f;
#pragma unroll 8
        for (int e = 0; e < 16; ++e) {
            const int id = __builtin_amdgcn_readlane(myid, e);
            const float a = __int_as_float(__builtin_amdgcn_readlane(__float_as_int(myact), e));
            const unsigned char* vr = V8 + (size_t)id * D_ + lane * 16;
#pragma unroll
            for (int q = 0; q < 2; ++q) { const u32x4 vv = *(const u32x4*)(vr + q * 1024);
#pragma unroll
                for (int i = 0; i < 4; ++i) { const f32x2 x = __builtin_amdgcn_cvt_pk_f32_fp8((int)vv[i], false), y = __builtin_amdgcn_cvt_pk_f32_fp8((int)vv[i], true);
                    o[q * 16 + 4 * i] += a * x.x; o[q * 16 + 4 * i + 1] += a * x.y; o[q * 16 + 4 * i + 2] += a * y.x; o[q * 16 + 4 * i + 3] += a * y.y; } }
        }
        __syncthreads();
#pragma unroll
        for (int q = 0; q < 2; ++q)
#pragma unroll
            for (int i = 0; i < 4; ++i)
                *(float4*)(part + w * 2048 + q * 1024 + lane * 16 + 4 * i) = make_float4(o[q * 16 + 4 * i], o[q * 16 + 4 * i + 1], o[q * 16 + 4 * i + 2], o[q * 16 + 4 * i + 3]);
        __syncthreads();
        float4 s = *(const float4*)(X1 + (size_t)t * D_ + tid * 4);
#pragma unroll
        for (int ww = 0; ww < 8; ++ww) { const float4 pp = *(const float4*)(part + ww * 2048 + tid * 4); s.x += pp.x; s.y += pp.y; s.z += pp.z; s.w += pp.w; }
        float ss = wave_sum_dpp(s.x * s.x + s.y * s.y + s.z * s.z + s.w * s.w);
        if (lane == 0) red[w] = ss;
        __syncthreads();
        float tot = 0.f;
#pragma unroll
        for (int ww = 0; ww < 8; ++ww) tot += red[ww];
        const float scl = rsqrtf(tot * (1.f / 2048.f) + 1e-6f);
        const float4 g = *(const float4*)(nf + tid * 4);
        *(float4*)(p.out + (size_t)t * D_ + tid * 4) = make_float4(s.x * scl * g.x, s.y * scl * g.y, s.z * scl * g.z, s.w * scl * g.w);
    }
}

__global__ void __launch_bounds__(512, 2) mega(Params p) {
    extern __shared__ __attribute__((aligned(16))) unsigned char shm[];
    cg::grid_group grid = cg::this_grid();
    LAS unsigned char* lds = (LAS unsigned char*)shm;
    const int lo = p.ph_lo, hi = p.ph_hi;
#define IN(k) (lo <= (k) && (k) < hi)
#define REP(k) for (int _r = 0; _r < ((k) == DUP_PHASE ? 2 : 1); ++_r)
#define SEAM(k) do { if (IN(k) && IN((k) + 1)) grid.sync(); } while (0)
    if (IN(0)) REP(0) { if (_r) grid.sync(); phase0(p, shm); }
    SEAM(0);
    if (IN(1)) REP(1) { if (_r) grid.sync();
        pg8::Gemm g{(const bf16_t*)(p.ws + WS_H), (const bf16_t*)(p.ws + WS_WB1), S_, NAUG, 2048};
        pg8::StaticOrder so; so.init(g.M, g.N, (int)gridDim.x, (int)blockIdx.x);
        pg8::EpiBf16 E{(bf16_t*)(p.ws + WS_PROJ), NAUG};
        pg8::gemm_phase(lds, g, so, E);
    }
    SEAM(1);
    if (IN(2)) REP(2) { if (_r) grid.sync();
        phase_prepM(p, lds);
        phase_prepE(p);
        transpose_convert(p.in[21], 2048, 4096, (bf16_t*)(p.ws + WS_WQT), (float*)shm);
        transpose_convert(p.in[19], 2048, 2048, (bf16_t*)(p.ws + WS_WOT), (float*)shm);
    }
    SEAM(2);
    if (IN(3)) REP(3) { if (_r) grid.sync(); phase_chunkA(p, lds); }
    SEAM(3);
    if (IN(4)) REP(4) { if (_r) grid.sync(); phase_seq(p); }
    SEAM(4);
    if (IN(5)) REP(5) { if (_r) grid.sync(); phase_chunkY(p, lds); }
    SEAM(5);
    if (IN(6)) REP(6) { if (_r) grid.sync();
        pg8::Gemm g{(const bf16_t*)(p.ws + WS_YMIX), (const bf16_t*)(p.ws + WS_WOT), S_, 2048, 2048};
        pg8::StaticOrder so; so.init(g.M, g.N, (int)gridDim.x, (int)blockIdx.x);
        pg8::EpiResF32 E{(float*)(p.ws + WS_X1), p.in[0], 2048};
        pg8::gemm_phase(lds, g, so, E);
    }
    SEAM(6);
    if (IN(7)) REP(7) { if (_r) grid.sync();
        rmsnorm_rows((const float*)(p.ws + WS_X1), p.in[20], (bf16_t*)(p.ws + WS_H2));
        convert_fp8(p.in[23], p.ws + WS_UB, (size_t)16384 * 2048, U8_SCALE);
        convert_fp8(p.in[24], p.ws + WS_VB, (size_t)16384 * 2048, V8_SCALE);
    }
    SEAM(7);
    if (IN(8)) REP(8) { if (_r) grid.sync();
        pg8::Gemm g{(const bf16_t*)(p.ws + WS_H2), (const bf16_t*)(p.ws + WS_WQT), S_, 4096, 2048};
        pg8::StaticOrder so; so.init(g.M, g.N, (int)gridDim.x, (int)blockIdx.x);
        pg8::EpiBf16 E{(bf16_t*)(p.ws + WS_Q), 4096};
        pg8::gemm_phase(lds, g, so, E);
    }
    SEAM(8);
    if (IN(9)) REP(9) { if (_r) grid.sync(); phase_topk(p, shm); }
    SEAM(9);
    if (IN(10)) REP(10) { if (_r) grid.sync(); phase_gather(p, shm); }
#undef IN
#undef REP
#undef SEAM
}

extern "C" void kernel_launch(void* const* d_in, const int* in_sizes, int n_in, void* d_out, int out_size, void* d_ws, size_t ws_size, hipStream_t stream) {
    static int grid_blocks = 0;
    if (grid_blocks == 0) {
        if (n_in != 26 || ws_size < WS_NEED) { fprintf(stderr, "kernel_launch: unexpected n_in %d / ws_size %zu\n", n_in, ws_size); grid_blocks = -1; return; }
        int dev = 0, cus = 0, per_cu = 0;
        (void)hipGetDevice(&dev);
        (void)hipDeviceGetAttribute(&cus, hipDeviceAttributeMultiprocessorCount, dev);
        (void)hipFuncSetAttribute((const void*)mega, hipFuncAttributeMaxDynamicSharedMemorySize, LDS_BYTES);
        (void)hipOccupancyMaxActiveBlocksPerMultiprocessor(&per_cu, (const void*)mega, 512, LDS_BYTES);
        if (per_cu < 1) { fprintf(stderr, "kernel_launch: occupancy query says %d blocks/CU\n", per_cu); per_cu = 1; }
        grid_blocks = cus * per_cu;
        fprintf(stderr, "kernel_launch: cus %d per_cu %d grid %d\n", cus, per_cu, grid_blocks);
    }
    if (grid_blocks < 0) return;
    Params p{};
    for (int i = 0; i < 26; ++i) p.in[i] = (const float*)d_in[i];
    p.out = (float*)d_out; p.ws = (unsigned char*)d_ws;
#if MULTI_LAUNCH
    for (int ph = 0; ph < NPHASE; ++ph) {
        p.ph_lo = ph; p.ph_hi = ph + 1;
        hipLaunchKernelGGL(mega, dim3(grid_blocks), dim3(512), LDS_BYTES, stream, p);
    }
#else
    p.ph_lo = 0; p.ph_hi = NPHASE;
    void* args[] = {&p};
    hipError_t e = hipLaunchCooperativeKernel((const void*)mega, dim3(grid_blocks), dim3(512), args, LDS_BYTES, stream);
    if (e != hipSuccess) fprintf(stderr, "cooperative launch failed: %s (grid %d)\n", hipGetErrorString(e), grid_blocks);
#endif
}
```

```cpp
#include <hip/hip_runtime.h>
#include <hip/hip_cooperative_groups.h>
#include <cstdio>
namespace cg = cooperative_groups;

#ifndef DUP_PHASE
#define DUP_PHASE -1
#endif
#ifndef MULTI_LAUNCH
#define MULTI_LAUNCH 0
#endif

#define LAS __attribute__((address_space(3)))
typedef unsigned short bf16_t;
typedef short bf16x8 __attribute__((ext_vector_type(8)));
typedef float f32x4 __attribute__((ext_vector_type(4)));
typedef float f32x2 __attribute__((ext_vector_type(2)));
typedef unsigned u32x4 __attribute__((ext_vector_type(4)));
typedef unsigned u32x2 __attribute__((ext_vector_type(2)));

constexpr int S_ = 16384, D_ = 2048, DR = 1024, NAUG = 6912;
constexpr size_t MiB = 1ull << 20;
constexpr size_t WS_PROJ = 0, WS_H = 216 * MiB, WS_WB1 = 280 * MiB, WS_WQT = 280 * MiB, WS_WOT = 296 * MiB;
constexpr size_t WS_R = 307 * MiB, WS_K = 339 * MiB, WS_V = 371 * MiB, WS_KK = 403 * MiB, WS_A = 435 * MiB, WS_LW = 467 * MiB;
constexpr size_t WS_G = 216 * MiB, WS_YC = 248 * MiB, WS_YMIX = 307 * MiB, WS_X1 = 0, WS_H2 = 128 * MiB, WS_Q = 307 * MiB;
constexpr size_t WS_GT = 0, WS_HT = 32 * MiB, WS_QE = 96 * MiB, WS_YL = 128 * MiB, WS_S0 = 160 * MiB;
constexpr size_t WS_IDS = 192 * MiB, WS_GATES = 200 * MiB, WS_UB = 467 * MiB, WS_VB = 435 * MiB, WS_BON = 500 * MiB, WS_NEED = 501 * MiB;
constexpr size_t WS_W2T = 499 * MiB, WS_A2T = WS_W2T + 131072, WS_G2T = WS_A2T + 131072;
constexpr int TLD = 72, TSLOT = 64 * TLD * 2;
constexpr int LDS_BYTES = 16 * TSLOT + 2048 + 256;
constexpr int NPHASE = 11;

struct Params {
    const float* in[26];
    float* out;
    unsigned char* ws;
    int ph_lo, ph_hi;
};

__device__ __forceinline__ float bf2f(bf16_t b) { return __uint_as_float(((unsigned)b) << 16); }
__device__ __forceinline__ bf16_t f2bf(float f) { unsigned u = __float_as_uint(f); u += 0x7FFFu + ((u >> 16) & 1u); return (bf16_t)(u >> 16); }
typedef __bf16 bf16v2_t __attribute__((ext_vector_type(2)));
__device__ __forceinline__ unsigned cvt_pk_bf16(float lo, float hi) { const f32x2 v = {lo, hi}; const bf16v2_t r = __builtin_convertvector(v, bf16v2_t); return __builtin_bit_cast(unsigned, r); }
__device__ __forceinline__ u32x4 pack8(const float* f) { u32x4 w; w.x = cvt_pk_bf16(f[0], f[1]); w.y = cvt_pk_bf16(f[2], f[3]); w.z = cvt_pk_bf16(f[4], f[5]); w.w = cvt_pk_bf16(f[6], f[7]); return w; }
__device__ __forceinline__ float wave_sum(float v) {
#pragma unroll
    for (int o = 32; o; o >>= 1) v += __shfl_xor(v, o);
    return v;
}
template <int CTRL, int RM> __device__ __forceinline__ float dpp_f(float v) { return __int_as_float(__builtin_amdgcn_update_dpp(0, __float_as_int(v), CTRL, RM, 0xf, false)); }
__device__ __forceinline__ float wave_sum_dpp(float v) {
    v += dpp_f<0xB1, 0xf>(v); v += dpp_f<0x4E, 0xf>(v); v += dpp_f<0x141, 0xf>(v); v += dpp_f<0x140, 0xf>(v);
    v += dpp_f<0x142, 0xa>(v); v += dpp_f<0x143, 0xc>(v);
    return __int_as_float(__builtin_amdgcn_readlane(__float_as_int(v), 63));
}
__device__ __forceinline__ float wave_max(float v) {
#pragma unroll
    for (int o = 32; o; o >>= 1) v = fmaxf(v, __shfl_xor(v, o));
    return v;
}
__device__ __forceinline__ float sigmoidf_(float x) { return 1.0f / (1.0f + __expf(-x)); }
__device__ __forceinline__ float gelu_tanh(float x) { float u = 0.7978845608028654f * (x + 0.044715f * x * x * x); return 0.5f * x * (1.0f + tanhf(u)); }
__device__ __forceinline__ float lo_bf(unsigned w) { return __uint_as_float(w << 16); }
__device__ __forceinline__ float hi_bf(unsigned w) { return __uint_as_float(w & 0xffff0000u); }

namespace pg8 {
constexpr int BM = 256, BK = 64, HALF = 128, HTB = HALF * BK * 2, STAGE_BYTES = 8 * HTB, NXCD = 8, WGM = 8;
__device__ __forceinline__ int lds_byte(int r, int c) { const int st = (r >> 4) * 2 + (c >> 5), rr = r & 15, cc = c & 31, ob = rr * 64 + cc * 2; return st * 1024 + (ob ^ (((ob >> 9) & 1) << 5)); }
__device__ __forceinline__ void stage_rc(int b, int& R, int& C) { const int st = b / 1024, sb = b % 1024, swz = sb ^ (((sb >> 9) & 1) << 5); R = (st >> 1) * 16 + swz / 64; C = (st & 1) * 32 + (swz % 64) / 2; }
__device__ __forceinline__ int perm32(int rho) { const int n = rho >> 4, i = rho & 15; return 8 * (i >> 2) + 4 * n + (i & 3); }
struct Unit { int pm, pn; };
struct Gemm { const bf16_t* A; const bf16_t* Bt; int M, N, K; };
struct StaticOrder {
    int nM, nN, nwg, G, c;
    __device__ void init(int M, int N, int G_, int c_) { nM = M / BM; nN = N / BM; nwg = nM * nN; G = G_; c = c_; }
    __device__ bool next(int i, Unit& u) const {
        const long L = (long)i * G + c; if (L >= nwg) return false;
        int wgid = (int)L; { const int q = nwg / NXCD, r = nwg % NXCD, xcd = wgid % NXCD, off = wgid / NXCD; wgid = (xcd < r ? xcd * (q + 1) : r * (q + 1) + (xcd - r) * q) + off; }
        const int nig = WGM * nN, gid = wgid / nig, fm = gid * WGM, gsz = (nM - fm) < WGM ? (nM - fm) : WGM;
        u.pm = fm + ((wgid % nig) % gsz); u.pn = (wgid % nig) / gsz; return true;
    }
    __device__ __forceinline__ void a_ready(const Unit&) const {}
    __device__ __forceinline__ void done(const Unit&) const {}
};
struct EpiResF32 {
    static constexpr bool PERM = false;
    float* C; const float* Res; int ldc;
    __device__ __forceinline__ void operator()(const f32x4 (&acc)[2][2][4][2], const Unit& u, int wr, int wc, int fr, int fq) const {
        const int row0 = u.pm * BM + wr * 64 + fr, col0 = u.pn * BM + wc * 32 + 4 * fq;
#pragma unroll
        for (int ai = 0; ai < 2; ++ai)
#pragma unroll
            for (int m = 0; m < 4; ++m) { const size_t ro = (size_t)(row0 + ai * HALF + m * 16) * ldc + col0;
#pragma unroll
                for (int bj = 0; bj < 2; ++bj)
#pragma unroll
                    for (int n = 0; n < 2; ++n) { const f32x4 rs = *(const f32x4*)(Res + ro + bj * HALF + n * 16); *(f32x4*)(C + ro + bj * HALF + n * 16) = acc[ai][bj][m][n] + rs; } }
    }
};
struct EpiBf16 {
    static constexpr bool PERM = true;
    bf16_t* O; int ldc;
    __device__ __forceinline__ void operator()(const f32x4 (&acc)[2][2][4][2], const Unit& u, int wr, int wc, int fr, int fq) const {
        const int row0 = u.pm * BM + wr * 64 + fr; const int col0 = u.pn * BM + wc * 32 + 8 * fq;
#pragma unroll
        for (int ai = 0; ai < 2; ++ai)
#pragma unroll
            for (int m = 0; m < 4; ++m) { bf16_t* rowp = O + (size_t)(row0 + ai * HALF + m * 16) * ldc + col0;
#pragma unroll
                for (int bj = 0; bj < 2; ++bj) { const f32x4 v0 = acc[ai][bj][m][0], v1 = acc[ai][bj][m][1];
                    u32x4 w; w.x = cvt_pk_bf16(v0[0], v0[1]); w.y = cvt_pk_bf16(v0[2], v0[3]); w.z = cvt_pk_bf16(v1[0], v1[1]); w.w = cvt_pk_bf16(v1[2], v1[3]);
                    *(u32x4*)(rowp + bj * HALF) = w; } }
    }
};

template <class Epi, class Sched>
__device__ __forceinline__ void gemm_phase(LAS unsigned char* lds, const Gemm g, const Sched& S, const Epi& E) {
    const int tid = threadIdx.x, wid = __builtin_amdgcn_readfirstlane(tid >> 6), lane = tid & 63, wr = wid >> 2, wc = wid & 3, fr = lane & 15, fq = lane >> 4;
    const int K = g.K, nt = K / BK;
    unsigned voffA[2], voffB[2];
#pragma unroll
    for (int i = 0; i < 2; ++i) { int R, C; stage_rc(tid * 16 + i * 8192, R, C); const int Rb = Epi::PERM ? ((R & ~31) + perm32(R & 31)) : R;
        voffA[i] = (unsigned)(R * K + C) * 2u; voffB[i] = (unsigned)(Rb * K + C) * 2u; }
    const size_t kstep = (size_t)(BK * 2);
    const size_t hstep = (size_t)HALF * K * 2;
    const size_t tstep = 2 * hstep;
    const unsigned ldsw = (unsigned)wid * 1024u;
    const int aoff = lds_byte(wr * 64 + fr, fq * 8), boff = lds_byte(wc * 32 + fr, fq * 8);
#define PG8_SA(b, h) (((b) * 2 + (h)) * HTB)
#define PG8_SB(b, h) ((4 + (b) * 2 + (h)) * HTB)
#define PG8_STAGE(bufoff, gbase, voff) do { _Pragma("unroll") for (int _i = 0; _i < 2; ++_i) \
        __builtin_amdgcn_global_load_lds((const unsigned*)((const char*)(gbase) + (voff)[_i]), (LAS unsigned*)(lds + (bufoff) + ldsw + _i * 8192), 16, 0, 0); } while (0)
#define PG8_LDA(dst, b, h) do { _Pragma("unroll") for (int m = 0; m < 4; ++m) _Pragma("unroll") for (int k = 0; k < 2; ++k) dst[m][k] = *(const LAS bf16x8*)(lds + PG8_SA(b, h) + aoff + m * 2048 + k * 1024); } while (0)
#define PG8_LDB(dst, b, h) do { _Pragma("unroll") for (int n = 0; n < 2; ++n) _Pragma("unroll") for (int k = 0; k < 2; ++k) dst[n][k] = *(const LAS bf16x8*)(lds + PG8_SB(b, h) + boff + n * 2048 + k * 1024); } while (0)
#define PG8_MMA(ai, bj, At, Bt) do { __builtin_amdgcn_s_setprio(1); _Pragma("unroll") for (int m = 0; m < 4; ++m) _Pragma("unroll") for (int n = 0; n < 2; ++n) _Pragma("unroll") for (int k = 0; k < 2; ++k) \
        acc[ai][bj][m][n] = __builtin_amdgcn_mfma_f32_16x16x32_bf16(Bt[n][k], At[m][k], acc[ai][bj][m][n], 0, 0, 0); __builtin_amdgcn_s_setprio(0); } while (0)
#define PG8_WAIT_V(n) asm volatile("s_waitcnt vmcnt(" #n ")" ::: "memory")
#define PG8_WAIT_L(n) asm volatile("s_waitcnt lgkmcnt(" #n ")" ::: "memory")
#define PG8_BAR __builtin_amdgcn_s_barrier()
#define PG8_SCHED __builtin_amdgcn_sched_barrier(0)
    Unit cur, nxt; int ui = 0;
    if (!S.next(0, cur)) return;
    f32x4 acc[2][2][4][2];
#pragma unroll
    for (int a = 0; a < 2; ++a)
#pragma unroll
        for (int b = 0; b < 2; ++b)
#pragma unroll
            for (int m = 0; m < 4; ++m)
#pragma unroll
                for (int n = 0; n < 2; ++n) acc[a][b][m][n] = (f32x4){0.f, 0.f, 0.f, 0.f};
    bf16x8 At[4][2], B0[2][2], B1[2][2];
    const char* cA = (const char*)g.A + (size_t)cur.pm * tstep; const char* cB = (const char*)g.Bt + (size_t)cur.pn * tstep;
    S.a_ready(cur);
    PG8_STAGE(PG8_SB(0, 0), cB, voffB); PG8_STAGE(PG8_SA(0, 0), cA, voffA); PG8_STAGE(PG8_SB(0, 1), cB + hstep, voffB); PG8_STAGE(PG8_SA(0, 1), cA + hstep, voffA);
    if (wr == 1) PG8_BAR;
    PG8_WAIT_V(4); PG8_BAR;
    PG8_STAGE(PG8_SB(1, 0), cB + kstep, voffB); PG8_STAGE(PG8_SA(1, 0), cA + kstep, voffA); PG8_STAGE(PG8_SB(1, 1), cB + hstep + kstep, voffB);
    PG8_WAIT_V(6); PG8_BAR;
    for (;;) {
        const bool has_next = S.next(ui + 1, nxt);
        const char* nA = has_next ? (const char*)g.A + (size_t)nxt.pm * tstep : cA; const char* nB = has_next ? (const char*)g.Bt + (size_t)nxt.pn * tstep : cB;
        for (int t = 0; t < nt; t += 2) {
            const bool last = (t == nt - 2);
            const char* a1 = cA + (size_t)(t + 1) * kstep;
            const char* a2 = last ? nA : cA + (size_t)(t + 2) * kstep; const char* b2 = last ? nB : cB + (size_t)(t + 2) * kstep;
            const char* a3 = a2 + kstep; const char* b3 = b2 + kstep;
            if (last && has_next) S.a_ready(nxt);
            PG8_LDB(B0, 0, 0); PG8_SCHED; PG8_LDA(At, 0, 0); PG8_STAGE(PG8_SA(1, 1), a1 + hstep, voffA);
            PG8_WAIT_L(8); PG8_BAR; PG8_WAIT_L(0); PG8_MMA(0, 0, At, B0); PG8_BAR; PG8_SCHED;
            PG8_LDB(B1, 0, 1); PG8_STAGE(PG8_SB(0, 0), b2, voffB);
            PG8_BAR; PG8_WAIT_L(0); PG8_MMA(0, 1, At, B1); PG8_BAR;
            PG8_LDA(At, 0, 1); PG8_STAGE(PG8_SA(0, 0), a2, voffA);
            PG8_BAR; PG8_WAIT_L(0); PG8_MMA(1, 0, At, B0); PG8_BAR; PG8_SCHED;
            PG8_STAGE(PG8_SB(0, 1), b2 + hstep, voffB);
            PG8_WAIT_V(6); PG8_BAR; PG8_MMA(1, 1, At, B1); PG8_BAR;
            PG8_LDB(B0, 1, 0); PG8_SCHED; PG8_LDA(At, 1, 0); PG8_STAGE(PG8_SA(0, 1), a2 + hstep, voffA);
            PG8_WAIT_L(8); PG8_BAR; PG8_WAIT_L(0); PG8_MMA(0, 0, At, B0); PG8_BAR; PG8_SCHED;
            PG8_LDB(B1, 1, 1); PG8_STAGE(PG8_SB(1, 0), b3, voffB);
            PG8_BAR; PG8_WAIT_L(0); PG8_MMA(0, 1, At, B1); PG8_BAR;
            PG8_LDA(At, 1, 1); PG8_STAGE(PG8_SA(1, 0), a3, voffA);
            PG8_BAR; PG8_WAIT_L(0); PG8_MMA(1, 0, At, B0); PG8_BAR; PG8_SCHED;
            PG8_STAGE(PG8_SB(1, 1), b3 + hstep, voffB);
            PG8_WAIT_V(6); PG8_BAR; PG8_MMA(1, 1, At, B1); PG8_BAR;
        }
        E(acc, cur, wr, wc, fr, fq); S.done(cur);
        if (!has_next) break;
#pragma unroll
        for (int a = 0; a < 2; ++a)
#pragma unroll
            for (int b = 0; b < 2; ++b)
#pragma unroll
                for (int m = 0; m < 4; ++m)
#pragma unroll
                    for (int n = 0; n < 2; ++n) acc[a][b][m][n] = (f32x4){0.f, 0.f, 0.f, 0.f};
        cur = nxt; cA = nA; cB = nB; ++ui;
    }
    PG8_WAIT_V(0);
    if (wr == 0) PG8_BAR;
    PG8_BAR;
#undef PG8_SA
#undef PG8_SB
#undef PG8_STAGE
#undef PG8_LDA
#undef PG8_LDB
#undef PG8_MMA
#undef PG8_WAIT_V
#undef PG8_WAIT_L
#undef PG8_BAR
#undef PG8_SCHED
}
}

__device__ __forceinline__ void rmsnorm_rows(const float* X, const float* gain, bf16_t* H) {
    const int wave = threadIdx.x >> 6, lane = threadIdx.x & 63;
    for (int row = blockIdx.x * 8 + wave; row < S_; row += gridDim.x * 8) {
        const float4* xr = (const float4*)(X + (size_t)row * D_);
        float4 v[8]; float ss = 0.f;
#pragma unroll
        for (int i = 0; i < 8; ++i) { v[i] = xr[i * 64 + lane]; ss += v[i].x * v[i].x + v[i].y * v[i].y + v[i].z * v[i].z + v[i].w * v[i].w; }
        ss = wave_sum(ss);
        const float sc = rsqrtf(ss * (1.0f / 2048.0f) + 1e-6f);
#pragma unroll
        for (int i = 0; i < 8; ++i) { const float4 g = ((const float4*)gain)[i * 64 + lane];
            u32x2 w; w.x = cvt_pk_bf16(v[i].x * sc * g.x, v[i].y * sc * g.y); w.y = cvt_pk_bf16(v[i].z * sc * g.z, v[i].w * sc * g.w);
            *(u32x2*)(H + (size_t)row * D_ + (i * 64 + lane) * 4) = w; }
    }
}

__device__ __forceinline__ void transpose_convert(const float* W, int K, int N, bf16_t* Bt, float* tile, int bid, int nblk) {
    const int tid = threadIdx.x; const int tk = K / 64, tn = N / 64;
    for (int u = bid; u < tk * tn; u += nblk) {
        const int k0 = (u / tn) * 64, n0 = (u % tn) * 64;
        __syncthreads();
#pragma unroll
        for (int i = 0; i < 8; ++i) { const int kk = i * 8 + (tid >> 6), nn = tid & 63; tile[kk * 65 + nn] = W[(size_t)(k0 + kk) * N + n0 + nn]; }
        __syncthreads();
#pragma unroll
        for (int i = 0; i < 4; ++i) { const int nn = i * 16 + (tid >> 5), kp = (tid & 31) * 2;
            *(unsigned*)(Bt + (size_t)(n0 + nn) * K + k0 + kp) = cvt_pk_bf16(tile[kp * 65 + nn], tile[(kp + 1) * 65 + nn]); }
    }
}

__device__ __forceinline__ void convert_flat(const float* src, bf16_t* dst, size_t n) {
    for (size_t i = ((size_t)blockIdx.x * 512 + threadIdx.x) * 8; i < n; i += (size_t)gridDim.x * 512 * 8) {
        const float4 a = *(const float4*)(src + i), b = *(const float4*)(src + i + 4);
        u32x4 w; w.x = cvt_pk_bf16(a.x, a.y); w.y = cvt_pk_bf16(a.z, a.w); w.z = cvt_pk_bf16(b.x, b.y); w.w = cvt_pk_bf16(b.z, b.w);
        *(u32x4*)(dst + i) = w;
    }
}

__device__ __forceinline__ void convert_fp8(const float* src, unsigned char* dst, size_t n, float sc, int bid, int nblk) {
    const int lane = threadIdx.x & 63, wv = threadIdx.x >> 6;
    for (size_t base = ((size_t)bid * 8 + wv) * 1024; base < n; base += (size_t)nblk * 8 * 1024) {
        float4 a[4];
#pragma unroll
        for (int j = 0; j < 4; ++j) a[j] = *(const float4*)(src + base + (size_t)(j * 64 + lane) * 4);
#pragma unroll
        for (int j = 0; j < 4; ++j) { int x = __builtin_amdgcn_cvt_pk_fp8_f32(a[j].x * sc, a[j].y * sc, 0, false); x = __builtin_amdgcn_cvt_pk_fp8_f32(a[j].z * sc, a[j].w * sc, x, true);
            *(unsigned*)(dst + base + (size_t)(j * 64 + lane) * 4) = (unsigned)x; }
    }
}

__device__ __forceinline__ void phase0(const Params& p, unsigned char* shm) {
    bf16_t* WB1 = (bf16_t*)(p.ws + WS_WB1);
    rmsnorm_rows(p.in[0], p.in[1], (bf16_t*)(p.ws + WS_H));
    transpose_convert(p.in[2], 2048, 6144, WB1, (float*)shm, blockIdx.x, gridDim.x);
    const float* mu = p.in[4]; const float* w1 = p.in[6]; const float* a1 = p.in[9]; const float* g1 = p.in[11];
    for (int idx = blockIdx.x * 512 + threadIdx.x; idx < 768 * 2048; idx += gridDim.x * 512) {
        const int j = idx >> 11, k = idx & 2047; float val = 0.f;
        if (j < 128) { const float m = mu[k], w = w1[k * 64 + (j & 63)]; val = (j < 64) ? w * (1.f - m) : w * m; }
        else if (j < 256) { const float m = mu[2048 + k], w = a1[k * 64 + (j & 63)]; val = (j < 192) ? w * (1.f - m) : w * m; }
        else if (j < 576) { const float m = mu[4096 + k]; const int jj = j - 256; const int c = jj < 160 ? jj : jj - 160; const float w = g1[k * 160 + c]; val = jj < 160 ? w * (1.f - m) : w * m; }
        WB1[(size_t)(6144 + j) * 2048 + k] = f2bf(val);
    }
    bf16_t* W2T = (bf16_t*)(p.ws + WS_W2T); bf16_t* A2T = (bf16_t*)(p.ws + WS_A2T); bf16_t* G2T = (bf16_t*)(p.ws + WS_G2T);
    const float* w2 = p.in[7]; const float* a2 = p.in[10]; const float* g2 = p.in[12];
    for (int idx = blockIdx.x * 512 + threadIdx.x; idx < 1024 * 288; idx += gridDim.x * 512) {
        if (idx < 65536) { const int c = idx >> 6, j = idx & 63; W2T[idx] = f2bf(w2[j * 1024 + c]); }
        else if (idx < 131072) { const int i2 = idx - 65536; const int c = i2 >> 6, j = i2 & 63; A2T[i2] = f2bf(a2[j * 1024 + c]); }
        else { const int i2 = idx - 131072; const int c = i2 / 160, j = i2 % 160; G2T[i2] = f2bf(g2[j * 1024 + c]); }
    }
}

constexpr int ACT_LD = 296;
template <int KS, int KOFF, int KTOT, int KIND>
__device__ __forceinline__ void lora_stage(const LAS bf16_t* act, const bf16_t* WT, const float* bias, bf16_t* OUT, int t0, int w, int fr, int fq) {
#pragma unroll 1
    for (int nh = 0; nh < 2; ++nh) {
        f32x4 acc[4][4];
#pragma unroll
        for (int m = 0; m < 4; ++m)
#pragma unroll
            for (int n = 0; n < 4; ++n) acc[m][n] = (f32x4){0.f, 0.f, 0.f, 0.f};
#pragma unroll 1
        for (int ks = 0; ks < KS; ++ks) {
            bf16x8 a[4];
#pragma unroll
            for (int m = 0; m < 4; ++m) a[m] = *(const LAS bf16x8*)(act + (m * 16 + fr) * ACT_LD + KOFF + ks * 32 + fq * 8);
#pragma unroll
            for (int n = 0; n < 4; ++n) {
                const bf16x8 b = *(const bf16x8*)(WT + (size_t)(w * 128 + (nh * 4 + n) * 16 + fr) * KTOT + ks * 32 + fq * 8);
#pragma unroll
                for (int m = 0; m < 4; ++m) acc[m][n] = __builtin_amdgcn_mfma_f32_16x16x32_bf16(a[m], b, acc[m][n], 0, 0, 0);
            }
        }
#pragma unroll
        for (int n = 0; n < 4; ++n) {
            const int c = w * 128 + (nh * 4 + n) * 16 + fr;
            const float bs = (KIND < 2) ? bias[c] : 0.f;
#pragma unroll
            for (int m = 0; m < 4; ++m)
#pragma unroll
                for (int j = 0; j < 4; ++j) {
                    const float val = acc[m][n][j]; float o;
                    if (KIND == 0) { const float x = -(bs + val); const float sp = fmaxf(x, 0.f) + log1pf(__expf(-fabsf(x))); o = -__expf(-sp - 0.5f); }
                    else if (KIND == 1) o = sigmoidf_(bs + val);
                    else o = val;
                    OUT[(size_t)(t0 + m * 16 + fq * 4 + j) * DR + c] = f2bf(o);
                }
        }
    }
}
__device__ __forceinline__ void phase_prepM(const Params& p, LAS unsigned char* lds) {
    LAS bf16_t* act = (LAS bf16_t*)lds;
    const bf16_t* P = (const bf16_t*)(p.ws + WS_PROJ);
    const int tid = threadIdx.x, w = tid >> 6, lane = tid & 63, fr = lane & 15, fq = lane >> 4;
    for (int tile = blockIdx.x; tile < S_ / 64; tile += gridDim.x) {
        const int t0 = tile * 64;
        __syncthreads();
        for (int e = tid; e < 64 * 288; e += 512) {
            const int t = e / 288, j = e % 288; const int tg = t0 + t;
            int ccur, cprev;
            if (j < 64) { ccur = 6144 + j; cprev = 6208 + j; }
            else if (j < 128) { ccur = 6272 + (j - 64); cprev = 6336 + (j - 64); }
            else { ccur = 6400 + (j - 128); cprev = 6560 + (j - 128); }
            float sv = bf2f(P[(size_t)tg * NAUG + ccur]);
            if (tg > 0) sv += bf2f(P[(size_t)(tg - 1) * NAUG + cprev]);
            const float a = j < 64 ? tanhf(sv) : (j < 128 ? sv : sigmoidf_(sv));
            act[t * ACT_LD + j] = f2bf(a);
        }
        __syncthreads();
        lora_stage<2, 0, 64, 0>(act, (const bf16_t*)(p.ws + WS_W2T), p.in[5], (bf16_t*)(p.ws + WS_LW), t0, w, fr, fq);
        lora_stage<2, 64, 64, 1>(act, (const bf16_t*)(p.ws + WS_A2T), p.in[8], (bf16_t*)(p.ws + WS_A), t0, w, fr, fq);
        lora_stage<5, 128, 160, 2>(act, (const bf16_t*)(p.ws + WS_G2T), nullptr, (bf16_t*)(p.ws + WS_G), t0, w, fr, fq);
    }
}

__device__ __forceinline__ void unpack8(const u32x4 v, float* f) {
#pragma unroll
    for (int i = 0; i < 4; ++i) { f[2 * i] = lo_bf(v[i]); f[2 * i + 1] = hi_bf(v[i]); }
}
__device__ __forceinline__ void phase_prepE(const Params& p) {
    const bf16_t* P = (const bf16_t*)(p.ws + WS_PROJ);
    bf16_t* R = (bf16_t*)(p.ws + WS_R); bf16_t* Kk = (bf16_t*)(p.ws + WS_K); bf16_t* V = (bf16_t*)(p.ws + WS_V); bf16_t* KK = (bf16_t*)(p.ws + WS_KK); bf16_t* YC = (bf16_t*)(p.ws + WS_YC);
    const float* mu_rkv = p.in[3]; const float* k_k = p.in[13]; const float* cw = p.in[18];
    const int tid = threadIdx.x, cg = tid & 127, c0 = cg * 8, tgrp = tid >> 7;
    float mr[8], mk[8], mv[8], kkc[8], cw0[8], cw1[8], cw2[8];
#pragma unroll
    for (int i = 0; i < 8; ++i) { mr[i] = mu_rkv[c0 + i]; mk[i] = mu_rkv[1024 + c0 + i]; mv[i] = mu_rkv[2048 + c0 + i]; kkc[i] = k_k[c0 + i]; cw0[i] = cw[c0 + i]; cw1[i] = cw[1024 + c0 + i]; cw2[i] = cw[2048 + c0 + i]; }
    for (int run = blockIdx.x * 4 + tgrp; run < S_ / 16; run += gridDim.x * 4) {
        const int t0 = run * 16;
        float pr[8], pk[8], pv[8], u1[8], u2[8];
#pragma unroll
        for (int i = 0; i < 8; ++i) { pr[i] = 0.f; pk[i] = 0.f; pv[i] = 0.f; u1[i] = 0.f; u2[i] = 0.f; }
        if (t0 > 0) {
            const size_t o = (size_t)(t0 - 1) * NAUG + c0;
            unpack8(*(const u32x4*)(P + o), pr); unpack8(*(const u32x4*)(P + o + 1024), pk); unpack8(*(const u32x4*)(P + o + 2048), pv);
            float x[8], y[8];
            unpack8(*(const u32x4*)(P + o + 4096), x); unpack8(*(const u32x4*)(P + o + 5120), y);
#pragma unroll
            for (int i = 0; i < 8; ++i) u1[i] = x[i] * y[i];
            unpack8(*(const u32x4*)(P + o - NAUG + 4096), x); unpack8(*(const u32x4*)(P + o - NAUG + 5120), y);
#pragma unroll
            for (int i = 0; i < 8; ++i) u2[i] = x[i] * y[i];
        }
#pragma unroll 1
        for (int t = 0; t < 16; ++t) {
            const size_t o = (size_t)(t0 + t) * NAUG + c0;
            float cr[8], ck[8], cv[8], bg[8], cgt[8], xc[8];
            unpack8(*(const u32x4*)(P + o), cr); unpack8(*(const u32x4*)(P + o + 1024), ck); unpack8(*(const u32x4*)(P + o + 2048), cv);
            unpack8(*(const u32x4*)(P + o + 3072), bg); unpack8(*(const u32x4*)(P + o + 4096), cgt); unpack8(*(const u32x4*)(P + o + 5120), xc);
            float r[8], k[8], v[8], kkv[8], yc[8]; float ss = 0.f;
#pragma unroll
            for (int i = 0; i < 8; ++i) {
                r[i] = cr[i] + (pr[i] - cr[i]) * mr[i]; k[i] = ck[i] + (pk[i] - ck[i]) * mk[i]; v[i] = cv[i] + (pv[i] - cv[i]) * mv[i];
                pr[i] = cr[i]; pk[i] = ck[i]; pv[i] = cv[i];
                kkv[i] = k[i] * kkc[i]; ss += kkv[i] * kkv[i];
                const float u0 = cgt[i] * xc[i];
                yc[i] = bg[i] * (cw0[i] * u2[i] + cw1[i] * u1[i] + cw2[i] * u0);
                u2[i] = u1[i]; u1[i] = u0;
            }
            ss += dpp_f<0xB1, 0xf>(ss); ss += dpp_f<0x4E, 0xf>(ss); ss += dpp_f<0x141, 0xf>(ss);
            const float inv = 1.0f / fmaxf(sqrtf(ss), 1e-12f);
#pragma unroll
            for (int i = 0; i < 8; ++i) kkv[i] *= inv;
            const size_t oo = (size_t)(t0 + t) * DR + c0;
            *(u32x4*)(R + oo) = pack8(r); *(u32x4*)(Kk + oo) = pack8(k); *(u32x4*)(V + oo) = pack8(v); *(u32x4*)(KK + oo) = pack8(kkv); *(u32x4*)(YC + oo) = pack8(yc);
        }
    }
}

#define TILE(i) ((LAS bf16_t*)(lds + (i) * TSLOT))
__device__ __forceinline__ f32x4 mm_tile(f32x4 acc, const LAS bf16_t* A, const LAS bf16_t* Bt, int mi, int ni, int fr, int fq) {
#pragma unroll
    for (int ks = 0; ks < 2; ++ks) {
        const bf16x8 a = *(const LAS bf16x8*)(A + (mi * 16 + fr) * TLD + ks * 32 + fq * 8);
        const bf16x8 b = *(const LAS bf16x8*)(Bt + (ni * 16 + fr) * TLD + ks * 32 + fq * 8);
        acc = __builtin_amdgcn_mfma_f32_16x16x32_bf16(a, b, acc, 0, 0, 0);
    }
    return acc;
}
__device__ __forceinline__ void st_rm(LAS bf16_t* X, f32x4 v, int mi, int ni, int fr, int fq) {
    const unsigned w0 = cvt_pk_bf16(v[0], v[1]), w1 = cvt_pk_bf16(v[2], v[3]);
    LAS bf16_t* q = X + (mi * 16 + fq * 4) * TLD + ni * 16 + fr;
    q[0] = (bf16_t)(w0 & 0xffffu); q[TLD] = (bf16_t)(w0 >> 16); q[2 * TLD] = (bf16_t)(w1 & 0xffffu); q[3 * TLD] = (bf16_t)(w1 >> 16);
}
__device__ __forceinline__ void st_tr(LAS bf16_t* XT, f32x4 v, int mi, int ni, int fr, int fq) {
    u32x2 w; w.x = cvt_pk_bf16(v[0], v[1]); w.y = cvt_pk_bf16(v[2], v[3]);
    *(LAS u32x2*)(XT + (ni * 16 + fr) * TLD + mi * 16 + fq * 4) = w;
}
__device__ __forceinline__ f32x4 ld_rm(const LAS bf16_t* X, int mi, int ni, int fr, int fq) {
    const LAS bf16_t* q = X + (mi * 16 + fq * 4) * TLD + ni * 16 + fr;
    return (f32x4){bf2f(q[0]), bf2f(q[TLD]), bf2f(q[2 * TLD]), bf2f(q[3 * TLD])};
}
__device__ __forceinline__ f32x4 ld_tr(const LAS bf16_t* XT, int mi, int ni, int fr, int fq) {
    const u32x2 w = *(const LAS u32x2*)(XT + (ni * 16 + fr) * TLD + mi * 16 + fq * 4);
    return (f32x4){lo_bf(w.x), hi_bf(w.x), lo_bf(w.y), hi_bf(w.y)};
}

__device__ __forceinline__ void phase_chunkA(const Params& p, LAS unsigned char* lds) {
    const int tid = threadIdx.x, w = tid >> 6, lane = tid & 63, fr = lane & 15, fq = lane >> 4;
    const int mi = w >> 1, nb = (w & 1) * 2;
    LAS float* cl = (LAS float*)(lds + 14 * TSLOT);
    LAS float* gs = (LAS float*)(lds + 16 * TSLOT);
    LAS float* wc = gs + 512;
    const bf16_t* R = (const bf16_t*)(p.ws + WS_R); const bf16_t* Kk = (const bf16_t*)(p.ws + WS_K); const bf16_t* V = (const bf16_t*)(p.ws + WS_V);
    const bf16_t* KK = (const bf16_t*)(p.ws + WS_KK); const bf16_t* A = (const bf16_t*)(p.ws + WS_A); const bf16_t* LW = (const bf16_t*)(p.ws + WS_LW);
    bf16_t* GT = (bf16_t*)(p.ws + WS_GT); float* HT = (float*)(p.ws + WS_HT); bf16_t* QE = (bf16_t*)(p.ws + WS_QE); bf16_t* YL = (bf16_t*)(p.ws + WS_YL);
    const f32x4 z4 = (f32x4){0.f, 0.f, 0.f, 0.f};
    const float* k_a = p.in[14]; const float* r_k = p.in[15]; float* BON = (float*)(p.ws + WS_BON);
    for (int item = blockIdx.x; item < 4096; item += gridDim.x) {
        const int c = item >> 4, h = item & 15;
        const size_t gbase = (size_t)(c * 64) * DR + h * 64;
        {
            const int g = w, k = lane;
            float pfx[8]; float run = 0.f;
#pragma unroll
            for (int i = 0; i < 8; ++i) { run += bf2f(LW[gbase + (size_t)(g * 8 + i) * DR + k]); pfx[i] = run; }
            gs[g * 64 + k] = run;
            __syncthreads();
            float off = 0.f;
#pragma unroll
            for (int gg = 0; gg < 7; ++gg) { const float x = gs[gg * 64 + k]; off += (gg < g) ? x : 0.f; }
#pragma unroll
            for (int i = 0; i < 8; ++i) cl[(g * 8 + i) * 64 + k] = off + pfx[i];
            if (g == 7) wc[k] = __expf(off + pfx[7]);
            __syncthreads();
        }
        {
            const int t = tid >> 3, k0 = (tid & 7) * 8;
            const size_t go = gbase + (size_t)t * DR + k0;
            const u32x4 r4 = *(const u32x4*)(R + go), k4 = *(const u32x4*)(Kk + go), v4 = *(const u32x4*)(V + go), kk4 = *(const u32x4*)(KK + go), a4 = *(const u32x4*)(A + go), lw4 = *(const u32x4*)(LW + go);
            float at[8], rt[8], bt[8], kt[8], bh[8], kh[8], vv[8]; float bsum = 0.f;
#pragma unroll
            for (int i = 0; i < 8; ++i) {
                const int q = i >> 1; const bool hi = i & 1;
                const float rf = hi ? hi_bf(r4[q]) : lo_bf(r4[q]), kraw = hi ? hi_bf(k4[q]) : lo_bf(k4[q]), vf = hi ? hi_bf(v4[q]) : lo_bf(v4[q]);
                const float kkf = hi ? hi_bf(kk4[q]) : lo_bf(kk4[q]), af = hi ? hi_bf(a4[q]) : lo_bf(a4[q]), lwf = hi ? hi_bf(lw4[q]) : lo_bf(lw4[q]);
                const float kf = kraw * (1.f + (af - 1.f) * k_a[h * 64 + k0 + i]);
                bsum += rf * kf * r_k[h * 64 + k0 + i];
                const float clv = cl[t * 64 + k0 + i], cle = cl[63 * 64 + k0 + i];
                const float e = __expf(clv), ex = __expf(clv - lwf), ei = __expf(-clv), eh = __expf(cle - clv);
                const float bb = kkf * af;
                at[i] = -kkf * ex; rt[i] = rf * e; bt[i] = bb * ei; kt[i] = kf * ei; bh[i] = bb * eh; kh[i] = kf * eh; vv[i] = vf;
            }
            bsum += dpp_f<0xB1, 0xf>(bsum); bsum += dpp_f<0x4E, 0xf>(bsum); bsum += dpp_f<0x141, 0xf>(bsum);
            if ((tid & 7) == 0) BON[(size_t)(c * 64 + t) * 16 + h] = bsum;
            *(LAS u32x4*)(TILE(0) + t * TLD + k0) = pack8(at);
            *(LAS u32x4*)(TILE(2) + t * TLD + k0) = pack8(rt);
            *(LAS u32x4*)(TILE(3) + t * TLD + k0) = pack8(bt);
            *(LAS u32x4*)(TILE(4) + t * TLD + k0) = pack8(kt);
            const u32x4 atp = pack8(at), bhp = pack8(bh), khp = pack8(kh);
#pragma unroll
            for (int i = 0; i < 8; ++i) {
                const int q = i >> 1; const bool hi = i & 1;
                TILE(1)[(k0 + i) * TLD + t] = (bf16_t)(hi ? (atp[q] >> 16) : (atp[q] & 0xffffu));
                TILE(5)[(k0 + i) * TLD + t] = (bf16_t)(hi ? (bhp[q] >> 16) : (bhp[q] & 0xffffu));
                TILE(6)[(k0 + i) * TLD + t] = (bf16_t)(hi ? (khp[q] >> 16) : (khp[q] & 0xffffu));
                TILE(7)[(k0 + i) * TLD + t] = (bf16_t)(hi ? (v4[q] >> 16) : (v4[q] & 0xffffu));
            }
            __syncthreads();
        }
#pragma unroll
        for (int nn = 0; nn < 2; ++nn) {
            const int ni = nb + nn; const int col = ni * 16 + fr, row0 = mi * 16 + fq * 4;
            f32x4 x = mm_tile(z4, TILE(0), TILE(3), mi, ni, fr, fq);
#pragma unroll
            for (int j = 0; j < 4; ++j) x[j] = (col < row0 + j) ? x[j] : 0.f;
            st_rm(TILE(8), x, mi, ni, fr, fq); st_tr(TILE(9), x, mi, ni, fr, fq);
            x = mm_tile(z4, TILE(0), TILE(4), mi, ni, fr, fq);
#pragma unroll
            for (int j = 0; j < 4; ++j) x[j] = (col < row0 + j) ? x[j] : 0.f;
            st_rm(TILE(10), x, mi, ni, fr, fq);
            x = mm_tile(z4, TILE(2), TILE(3), mi, ni, fr, fq);
#pragma unroll
            for (int j = 0; j < 4; ++j) x[j] = (col <= row0 + j) ? x[j] : 0.f;
            st_rm(TILE(11), x, mi, ni, fr, fq);
            x = mm_tile(z4, TILE(2), TILE(4), mi, ni, fr, fq);
#pragma unroll
            for (int j = 0; j < 4; ++j) x[j] = (col <= row0 + j) ? x[j] : 0.f;
            st_rm(TILE(12), x, mi, ni, fr, fq);
        }
        __syncthreads();
#pragma unroll
        for (int nn = 0; nn < 2; ++nn) {
            const int ni = nb + nn;
            st_tr(TILE(13), mm_tile(z4, TILE(10), TILE(7), mi, ni, fr, fq), mi, ni, fr, fq);
            const f32x4 x = mm_tile(z4, TILE(8), TILE(9), mi, ni, fr, fq);
            st_rm(TILE(0), x, mi, ni, fr, fq); st_tr(TILE(3), x, mi, ni, fr, fq);
        }
        __syncthreads();
#pragma unroll
        for (int rd = 0; rd < 5; ++rd) {
            const int tq = (rd & 1) ? 14 : 8, tqo = (rd & 1) ? 8 : 14;
            const int lx = (rd & 1) ? 4 : 0, lxt = (rd & 1) ? 9 : 3, lxo = (rd & 1) ? 0 : 4, lxto = (rd & 1) ? 3 : 9;
#pragma unroll
            for (int nn = 0; nn < 2; ++nn) {
                const int ni = nb + nn;
                f32x4 x = ld_rm(TILE(tq), mi, ni, fr, fq) + ld_rm(TILE(lx), mi, ni, fr, fq);
                x = mm_tile(x, TILE(tq), TILE(lxt), mi, ni, fr, fq);
                st_rm(TILE(tqo), x, mi, ni, fr, fq);
                if (rd < 4) { const f32x4 y = mm_tile(z4, TILE(lx), TILE(lxt), mi, ni, fr, fq); st_rm(TILE(lxo), y, mi, ni, fr, fq); st_tr(TILE(lxto), y, mi, ni, fr, fq); }
            }
            __syncthreads();
        }
#pragma unroll
        for (int nn = 0; nn < 2; ++nn) {
            const int ni = nb + nn;
            st_tr(TILE(10), mm_tile(ld_tr(TILE(1), mi, ni, fr, fq), TILE(14), TILE(1), mi, ni, fr, fq), mi, ni, fr, fq);
            st_tr(TILE(15), mm_tile(ld_tr(TILE(13), mi, ni, fr, fq), TILE(14), TILE(13), mi, ni, fr, fq), mi, ni, fr, fq);
        }
        __syncthreads();
#pragma unroll
        for (int nn = 0; nn < 2; ++nn) {
            const int ni = nb + nn;
            {
                f32x4 x = mm_tile(z4, TILE(5), TILE(10), mi, ni, fr, fq);
                if (mi == ni) {
#pragma unroll
                    for (int j = 0; j < 4; ++j) x[j] += (fq * 4 + j == fr) ? wc[ni * 16 + fr] : 0.f;
                }
                const unsigned w0 = cvt_pk_bf16(x[0], x[1]), w1 = cvt_pk_bf16(x[2], x[3]);
                bf16_t* gp = GT + (size_t)item * 4096 + (size_t)((mi * 2 + (ni >> 1)) * 64 + (fr >> 2) * 16 + fq * 4) * 8 + (ni & 1) * 4 + (fr & 3);
                gp[0] = (bf16_t)(w0 & 0xffffu); gp[8] = (bf16_t)(w0 >> 16); gp[16] = (bf16_t)(w1 & 0xffffu); gp[24] = (bf16_t)(w1 >> 16);
            }
            {
                f32x4 x = mm_tile(z4, TILE(5), TILE(15), mi, ni, fr, fq);
                x = mm_tile(x, TILE(6), TILE(7), mi, ni, fr, fq);
                *(f32x4*)(HT + (size_t)item * 4096 + (size_t)((ni * 4 + mi) * 64 + lane) * 4) = x;
            }
            {
                f32x4 x = ld_tr(TILE(2), mi, ni, fr, fq);
                x = mm_tile(x, TILE(10), TILE(11), mi, ni, fr, fq);
                u32x2 wv; wv.x = cvt_pk_bf16(x[0], x[1]); wv.y = cvt_pk_bf16(x[2], x[3]);
                *(u32x2*)(QE + (size_t)item * 4096 + (ni * 16 + fr) * 64 + mi * 16 + fq * 4) = wv;
            }
            {
                f32x4 x = mm_tile(z4, TILE(11), TILE(15), mi, ni, fr, fq);
                x = mm_tile(x, TILE(12), TILE(7), mi, ni, fr, fq);
                u32x2 wv; wv.x = cvt_pk_bf16(x[0], x[1]); wv.y = cvt_pk_bf16(x[2], x[3]);
                *(u32x2*)(YL + (size_t)item * 4096 + (size_t)((mi * 4 + ni) * 64 + lane) * 4) = wv;
            }
        }
    }
}

__device__ __forceinline__ void phase_seq(const Params& p) {
    if (threadIdx.x >= 64) return;
    const int head = blockIdx.x >> 2, vt = blockIdx.x & 3, lane = threadIdx.x, fr = lane & 15, fq = lane >> 4;
    const bf16_t* GT = (const bf16_t*)(p.ws + WS_GT); const float* HT = (const float*)(p.ws + WS_HT); bf16_t* S0 = (bf16_t*)(p.ws + WS_S0);
    f32x4 acc[4];
#pragma unroll
    for (int mb = 0; mb < 4; ++mb) acc[mb] = (f32x4){0.f, 0.f, 0.f, 0.f};
    bf16x8 ga[4][4][2]; f32x4 hh[4][4];
#define SEQ_LOAD(buf, cc) do { const size_t _it = (size_t)((cc) < 256 ? (cc) : 255) * 16 + head; \
        _Pragma("unroll") for (int mb = 0; mb < 4; ++mb) { \
            _Pragma("unroll") for (int ks = 0; ks < 2; ++ks) ga[buf][mb][ks] = *(const bf16x8*)(GT + _it * 4096 + (size_t)((mb * 2 + ks) * 64 + lane) * 8); \
            hh[buf][mb] = *(const f32x4*)(HT + _it * 4096 + (size_t)((vt * 4 + mb) * 64 + lane) * 4); } } while (0)
    SEQ_LOAD(0, 0); SEQ_LOAD(1, 1); SEQ_LOAD(2, 2); SEQ_LOAD(3, 3);
    for (int c0 = 0; c0 < 256; c0 += 4) {
#pragma unroll
        for (int b = 0; b < 4; ++b) {
            const int c = c0 + b; const size_t item = (size_t)c * 16 + head;
            u32x2 pk[4];
#pragma unroll
            for (int mb = 0; mb < 4; ++mb) { pk[mb].x = cvt_pk_bf16(acc[mb][0], acc[mb][1]); pk[mb].y = cvt_pk_bf16(acc[mb][2], acc[mb][3]);
                *(u32x2*)(S0 + item * 4096 + (vt * 16 + fr) * 64 + mb * 16 + fq * 4) = pk[mb]; }
            u32x4 b0w, b1w; b0w.x = pk[0].x; b0w.y = pk[0].y; b0w.z = pk[1].x; b0w.w = pk[1].y; b1w.x = pk[2].x; b1w.y = pk[2].y; b1w.z = pk[3].x; b1w.w = pk[3].y;
            const bf16x8 b0 = __builtin_bit_cast(bf16x8, b0w), b1 = __builtin_bit_cast(bf16x8, b1w);
#pragma unroll
            for (int mb = 0; mb < 4; ++mb) {
                const f32x4 x = __builtin_amdgcn_mfma_f32_16x16x32_bf16(ga[b][mb][0], b0, hh[b][mb], 0, 0, 0);
                acc[mb] = __builtin_amdgcn_mfma_f32_16x16x32_bf16(ga[b][mb][1], b1, x, 0, 0, 0);
            }
            SEQ_LOAD(b, c + 4);
        }
    }
#undef SEQ_LOAD
}

__device__ __forceinline__ void phase_chunkY(const Params& p, LAS unsigned char* lds) {
    LAS float* Yb = (LAS float*)lds;
    const int tid = threadIdx.x, w = tid >> 6, lane = tid & 63, fr = lane & 15, fq = lane >> 4;
    const int mi = w >> 1, nb = (w & 1) * 2;
    const bf16_t* R = (const bf16_t*)(p.ws + WS_R); const bf16_t* Kk = (const bf16_t*)(p.ws + WS_K); const bf16_t* V = (const bf16_t*)(p.ws + WS_V);
    const bf16_t* G = (const bf16_t*)(p.ws + WS_G); const bf16_t* YC = (const bf16_t*)(p.ws + WS_YC);
    const bf16_t* QE = (const bf16_t*)(p.ws + WS_QE); const bf16_t* YL = (const bf16_t*)(p.ws + WS_YL); const bf16_t* S0 = (const bf16_t*)(p.ws + WS_S0);
    bf16_t* YM = (bf16_t*)(p.ws + WS_YMIX);
    const float* r_k = p.in[15]; const float* gn_w = p.in[16]; const float* gn_b = p.in[17];
    for (int item = blockIdx.x; item < 4096; item += gridDim.x) {
        const int c = item >> 4, h = item & 15;
        const bf16_t* Qp = QE + (size_t)item * 4096; const bf16_t* Sp = S0 + (size_t)item * 4096; const bf16_t* Yp = YL + (size_t)item * 4096;
        __syncthreads();
#pragma unroll
        for (int nn = 0; nn < 2; ++nn) {
            const int ni = nb + nn;
            const u32x2 yw = *(const u32x2*)(Yp + (size_t)((mi * 4 + ni) * 64 + lane) * 4);
            f32x4 acc = (f32x4){lo_bf(yw.x), hi_bf(yw.x), lo_bf(yw.y), hi_bf(yw.y)};
#pragma unroll
            for (int ks = 0; ks < 2; ++ks) {
                const bf16x8 a = *(const bf16x8*)(Qp + (mi * 16 + fr) * 64 + ks * 32 + fq * 8);
                const bf16x8 b = *(const bf16x8*)(Sp + (ni * 16 + fr) * 64 + ks * 32 + fq * 8);
                acc = __builtin_amdgcn_mfma_f32_16x16x32_bf16(a, b, acc, 0, 0, 0);
            }
#pragma unroll
            for (int j = 0; j < 4; ++j) Yb[(mi * 16 + fq * 4 + j) * 68 + ni * 16 + fr] = acc[j];
        }
        __syncthreads();
        const int ch = h * 64 + lane;
        const float gw = gn_w[ch], gb = gn_b[ch];
        const float* BON = (const float*)(p.ws + WS_BON);
#pragma unroll
        for (int tt = 0; tt < 8; ++tt) {
            const int t = w * 8 + tt; const size_t tg = (size_t)c * 64 + t; const size_t o = tg * DR + ch;
            const float y = Yb[t * 68 + lane];
            const float mean = wave_sum_dpp(y) * (1.f / 64.f); const float d = y - mean;
            const float var = wave_sum_dpp(d * d) * (1.f / 64.f);
            const float yn = d * rsqrtf(var + 64e-5f) * gw + gb;
            const float bonus = BON[tg * 16 + h] * bf2f(V[o]);
            YM[tg * D_ + ch] = f2bf((yn + bonus) * bf2f(G[o]));
            YM[tg * D_ + 1024 + ch] = YC[o];
        }
    }
}

__device__ __forceinline__ int f2key(float x) { const int u = __float_as_int(x); return u ^ ((u >> 31) & 0x7fffffff); }
__device__ __forceinline__ float key2f(int k) { return __int_as_float(k ^ ((k >> 31) & 0x7fffffff)); }
template <int CTRL> __device__ __forceinline__ int dpp_i(int v) { return __builtin_amdgcn_update_dpp(v, v, CTRL, 0xf, 0xf, false); }
__device__ __forceinline__ int row_max_i(int v) { v = max(v, dpp_i<0xB1>(v)); v = max(v, dpp_i<0x4E>(v)); v = max(v, dpp_i<0x141>(v)); v = max(v, dpp_i<0x140>(v)); return v; }
__device__ __forceinline__ void phase_topk(const Params& p, unsigned char* shm) {
    float* sc = (float*)shm;
    int* tk = (int*)(sc + 64 * 260);
    const bf16_t* Q = (const bf16_t*)(p.ws + WS_Q); const float* keys = p.in[22];
    int* IDS = (int*)(p.ws + WS_IDS); float* GATES = (float*)(p.ws + WS_GATES);
    const int tid = threadIdx.x, w = tid >> 6, lane = tid & 63, fr = lane & 15, fq = lane >> 4;
    for (int item = blockIdx.x; item < 2048; item += gridDim.x) {
        const int h = item & 7, t0 = (item >> 3) * 64;
        const int c = w >> 2, nb = (w & 3) * 32;
        f32x4 acc[4][2];
#pragma unroll
        for (int m = 0; m < 4; ++m)
#pragma unroll
            for (int n = 0; n < 2; ++n) acc[m][n] = (f32x4){0.f, 0.f, 0.f, 0.f};
        const float* kb = keys + ((size_t)(h * 2 + c) * 128) * 256;
        for (int ks = 0; ks < 8; ++ks) {
            bf16x8 a[4], b[2];
#pragma unroll
            for (int m = 0; m < 4; ++m) a[m] = *(const bf16x8*)(Q + (size_t)(t0 + m * 16 + fr) * 4096 + h * 512 + c * 256 + ks * 32 + fq * 8);
#pragma unroll
            for (int n = 0; n < 2; ++n) { const float4* kp = (const float4*)(kb + (size_t)(nb + n * 16 + fr) * 256 + ks * 32 + fq * 8); const float4 x0 = kp[0], x1 = kp[1];
                u32x4 wv; wv.x = cvt_pk_bf16(x0.x, x0.y); wv.y = cvt_pk_bf16(x0.z, x0.w); wv.z = cvt_pk_bf16(x1.x, x1.y); wv.w = cvt_pk_bf16(x1.z, x1.w);
                b[n] = __builtin_bit_cast(bf16x8, wv); }
#pragma unroll
            for (int m = 0; m < 4; ++m)
#pragma unroll
                for (int n = 0; n < 2; ++n) acc[m][n] = __builtin_amdgcn_mfma_f32_16x16x32_bf16(a[m], b[n], acc[m][n], 0, 0, 0);
        }
        __syncthreads();
#pragma unroll
        for (int m = 0; m < 4; ++m)
#pragma unroll
            for (int n = 0; n < 2; ++n)
#pragma unroll
                for (int j = 0; j < 4; ++j) sc[(m * 16 + fq * 4 + j) * 260 + c * 128 + nb + n * 16 + fr] = acc[m][n][j];
        __syncthreads();
        for (int g = 0; g < 4; ++g) {
            const int L = w * 16 + g * 4 + (lane >> 4); const int tok = L >> 1, cc = L & 1; const int pp = lane & 15;
            int key[8];
#pragma unroll
            for (int i = 0; i < 8; ++i) key[i] = (f2key(sc[tok * 260 + cc * 128 + i * 16 + pp]) & ~127) | (127 - (i * 16 + pp));
            int mykey = 0;
#pragma unroll
            for (int r = 0; r < 16; ++r) {
                const int ml = max(max(max(key[0], key[1]), max(key[2], key[3])), max(max(key[4], key[5]), max(key[6], key[7])));
                const int m = row_max_i(ml);
#pragma unroll
                for (int i = 0; i < 8; ++i) key[i] = (key[i] == m) ? (int)0x80000000 : key[i];
                mykey = (pp == r) ? m : mykey;
            }
            tk[L * 16 + pp] = mykey;
        }
        __syncthreads();
        for (int g = 0; g < 2; ++g) {
            const int tok = w * 8 + g * 4 + (lane >> 4); const int pp = lane & 15;
            const float s1 = key2f(tk[(tok * 2) * 16 + pp] & ~127);
            int key[16];
#pragma unroll
            for (int j = 0; j < 16; ++j) { const float s2 = key2f(tk[(tok * 2 + 1) * 16 + j] & ~127); key[j] = (f2key(s1 + s2) & ~255) | (255 - (pp * 16 + j)); }
            int mykey = 0;
#pragma unroll
            for (int r = 0; r < 16; ++r) {
                int ml = max(max(max(key[0], key[1]), max(key[2], key[3])), max(max(key[4], key[5]), max(key[6], key[7])));
                ml = max(ml, max(max(max(key[8], key[9]), max(key[10], key[11])), max(max(key[12], key[13]), max(key[14], key[15]))));
                const int m = row_max_i(ml);
#pragma unroll
                for (int j = 0; j < 16; ++j) key[j] = (key[j] == m) ? (int)0x80000000 : key[j];
                mykey = (pp == r) ? m : mykey;
            }
            const int ci = 255 - (mykey & 255); const float cs = key2f(mykey & ~255);
            const int e1 = 127 - (tk[(tok * 2) * 16 + (ci >> 4)] & 127), e2 = 127 - (tk[(tok * 2 + 1) * 16 + (ci & 15)] & 127);
            const float mx = __shfl(cs, lane & 48);
            const float e = __expf(cs - mx);
            float sum = e; sum += dpp_f<0xB1, 0xf>(sum); sum += dpp_f<0x4E, 0xf>(sum); sum += dpp_f<0x141, 0xf>(sum); sum += dpp_f<0x140, 0xf>(sum);
            IDS[(size_t)(t0 + tok) * 128 + h * 16 + pp] = (e1 * 128 + e2) & 16383;
            GATES[(size_t)(t0 + tok) * 128 + h * 16 + pp] = e / sum;
        }
    }
}

constexpr float U8_SCALE = 64.f, V8_SCALE = 32.f;
__device__ __forceinline__ float gelu_fast(float x) { const float u = 0.7978845608028654f * (x + 0.044715f * x * x * x); return x / (1.0f + __expf(-2.0f * u)); }
__device__ __forceinline__ void phase_gather(const Params& p, unsigned char* shm) {
    const bf16_t* H2 = (const bf16_t*)(p.ws + WS_H2); const float* X1 = (const float*)(p.ws + WS_X1);
    const unsigned char* U8 = p.ws + WS_UB; const unsigned char* V8 = p.ws + WS_VB;
    const int* IDS = (const int*)(p.ws + WS_IDS); const float* GATES = (const float*)(p.ws + WS_GATES);
    const float* nf = p.in[25];
    const int tid = threadIdx.x, w = tid >> 6, lane = tid & 63;
    for (int t = blockIdx.x * 8 + w; t < S_; t += gridDim.x * 8) {
        f32x2 hp[16];
#pragma unroll
        for (int q = 0; q < 2; ++q)
#pragma unroll
            for (int hh = 0; hh < 2; ++hh) { const u32x4 hv = *(const u32x4*)(H2 + (size_t)t * D_ + q * 1024 + lane * 16 + hh * 8);
#pragma unroll
                for (int i = 0; i < 4; ++i) hp[q * 8 + hh * 4 + i] = (f32x2){lo_bf(hv[i]), hi_bf(hv[i])}; }
        const int id0 = IDS[(size_t)t * 128 + lane], id1 = IDS[(size_t)t * 128 + 64 + lane];
        const float gt0 = GATES[(size_t)t * 128 + lane], gt1 = GATES[(size_t)t * 128 + 64 + lane];
        f32x2 op[16];
#pragma unroll
        for (int i = 0; i < 16; ++i) op[i] = (f32x2){0.f, 0.f};
        u32x4 ua[4][2], ub[4][2], vb[4][2];
#define G_LOADU(dst, grp) do { _Pragma("unroll") for (int j = 0; j < 4; ++j) { const int e = (grp) * 4 + j; const int id = __builtin_amdgcn_readlane(e < 64 ? id0 : id1, e & 63); \
            const unsigned char* ur = U8 + (size_t)id * D_ + lane * 16; dst[j][0] = *(const u32x4*)ur; dst[j][1] = *(const u32x4*)(ur + 1024); } } while (0)
#define G_LOADV(grp) do { _Pragma("unroll") for (int j = 0; j < 4; ++j) { const int e = (grp) * 4 + j; const int id = __builtin_amdgcn_readlane(e < 64 ? id0 : id1, e & 63); \
            const unsigned char* vr = V8 + (size_t)id * D_ + lane * 16; vb[j][0] = *(const u32x4*)vr; vb[j][1] = *(const u32x4*)(vr + 1024); } } while (0)
#define G_BODY(cur, nxt, grp) do { \
            G_LOADV(grp); \
            G_LOADU(nxt, ((grp) + 1 < 32 ? (grp) + 1 : 31)); \
            float dsel = 0.f; \
            _Pragma("unroll") for (int j = 0; j < 4; ++j) { f32x2 d2 = (f32x2){0.f, 0.f}; \
                _Pragma("unroll") for (int q = 0; q < 2; ++q) _Pragma("unroll") for (int i = 0; i < 4; ++i) { \
                    d2 += __builtin_amdgcn_cvt_pk_f32_fp8((int)cur[j][q][i], false) * hp[q * 8 + 2 * i]; d2 += __builtin_amdgcn_cvt_pk_f32_fp8((int)cur[j][q][i], true) * hp[q * 8 + 2 * i + 1]; } \
                const float d = wave_sum_dpp(d2.x + d2.y); dsel = (lane == j) ? d : dsel; } \
            const float av = gelu_fast(dsel * (1.f / U8_SCALE)) * (1.f / V8_SCALE); \
            _Pragma("unroll") for (int j = 0; j < 4; ++j) { const int e = (grp) * 4 + j; \
                const float a = __int_as_float(__builtin_amdgcn_readlane(__float_as_int(av), j)) * __int_as_float(__builtin_amdgcn_readlane(__float_as_int(e < 64 ? gt0 : gt1), e & 63)); \
                const f32x2 a2 = (f32x2){a, a}; \
                _Pragma("unroll") for (int q = 0; q < 2; ++q) _Pragma("unroll") for (int i = 0; i < 4; ++i) { \
                    op[q * 8 + 2 * i] += a2 * __builtin_amdgcn_cvt_pk_f32_fp8((int)vb[j][q][i], false); op[q * 8 + 2 * i + 1] += a2 * __builtin_amdgcn_cvt_pk_f32_fp8((int)vb[j][q][i], true); } } \
        } while (0)
        G_LOADU(ua, 0);
#pragma unroll 1
        for (int g2 = 0; g2 < 32; g2 += 2) { G_BODY(ua, ub, g2); G_BODY(ub, ua, g2 + 1); }
#undef G_LOADU
#undef G_LOADV
#undef G_BODY
        float ss = 0.f; float4 xs[8];
#pragma unroll
        for (int q = 0; q < 2; ++q)
#pragma unroll
            for (int i = 0; i < 4; ++i) { float4 x = *(const float4*)(X1 + (size_t)t * D_ + q * 1024 + lane * 16 + 4 * i);
                x.x += op[q * 8 + 2 * i].x; x.y += op[q * 8 + 2 * i].y; x.z += op[q * 8 + 2 * i + 1].x; x.w += op[q * 8 + 2 * i + 1].y;
                ss += x.x * x.x + x.y * x.y + x.z * x.z + x.w * x.w; xs[q * 4 + i] = x; }
        ss = wave_sum_dpp(ss);
        const float scl = rsqrtf(ss * (1.f / 2048.f) + 1e-6f);
#pragma unroll
        for (int q = 0; q < 2; ++q)
#pragma unroll
            for (int i = 0; i < 4; ++i) { const float4 g = *(const float4*)(nf + q * 1024 + lane * 16 + 4 * i); const float4 x = xs[q * 4 + i];
                *(float4*)(p.out + (size_t)t * D_ + q * 1024 + lane * 16 + 4 * i) = make_float4(x.x * scl * g.x, x.y * scl * g.y, x.z * scl * g.z, x.w * scl * g.w); }
    }
}

__global__ void __launch_bounds__(512, 2) mega(Params p) {
    extern __shared__ __attribute__((aligned(16))) unsigned char shm[];
    cg::grid_group grid = cg::this_grid();
    LAS unsigned char* lds = (LAS unsigned char*)shm;
    const int lo = p.ph_lo, hi = p.ph_hi;
#define IN(k) (lo <= (k) && (k) < hi)
#define REP(k) for (int _r = 0; _r < ((k) == DUP_PHASE ? 2 : 1); ++_r)
#define SEAM(k) do { if (IN(k) && IN((k) + 1)) grid.sync(); } while (0)
    if (IN(0)) REP(0) { if (_r) grid.sync(); phase0(p, shm); }
    SEAM(0);
    if (IN(1)) REP(1) { if (_r) grid.sync();
        pg8::Gemm g{(const bf16_t*)(p.ws + WS_H), (const bf16_t*)(p.ws + WS_WB1), S_, NAUG, 2048};
        pg8::StaticOrder so; so.init(g.M, g.N, (int)gridDim.x, (int)blockIdx.x);
        pg8::EpiBf16 E{(bf16_t*)(p.ws + WS_PROJ), NAUG};
        pg8::gemm_phase(lds, g, so, E);
    }
    SEAM(1);
    if (IN(2)) REP(2) { if (_r) grid.sync();
        phase_prepM(p, lds);
        phase_prepE(p);
    }
    SEAM(2);
    if (IN(3)) REP(3) { if (_r) grid.sync(); phase_chunkA(p, lds); }
    SEAM(3);
    if (IN(4)) REP(4) { if (_r) grid.sync(); if (blockIdx.x < 64) phase_seq(p);
        else { const int bid = blockIdx.x - 64, nblk = gridDim.x - 64;
            convert_fp8(p.in[23], p.ws + WS_UB, (size_t)16384 * 2048, U8_SCALE, bid, nblk);
            convert_fp8(p.in[24], p.ws + WS_VB, (size_t)16384 * 2048, V8_SCALE, bid, nblk);
            transpose_convert(p.in[21], 2048, 4096, (bf16_t*)(p.ws + WS_WQT), (float*)shm, bid, nblk);
            transpose_convert(p.in[19], 2048, 2048, (bf16_t*)(p.ws + WS_WOT), (float*)shm, bid, nblk); } }
    SEAM(4);
    if (IN(5)) REP(5) { if (_r) grid.sync(); phase_chunkY(p, lds); }
    SEAM(5);
    if (IN(6)) REP(6) { if (_r) grid.sync();
        pg8::Gemm g{(const bf16_t*)(p.ws + WS_YMIX), (const bf16_t*)(p.ws + WS_WOT), S_, 2048, 2048};
        pg8::StaticOrder so; so.init(g.M, g.N, (int)gridDim.x, (int)blockIdx.x);
        pg8::EpiResF32 E{(float*)(p.ws + WS_X1), p.in[0], 2048};
        pg8::gemm_phase(lds, g, so, E);
    }
    SEAM(6);
    if (IN(7)) REP(7) { if (_r) grid.sync();
        rmsnorm_rows((const float*)(p.ws + WS_X1), p.in[20], (bf16_t*)(p.ws + WS_H2));
    }
    SEAM(7);
    if (IN(8)) REP(8) { if (_r) grid.sync();
        pg8::Gemm g{(const bf16_t*)(p.ws + WS_H2), (const bf16_t*)(p.ws + WS_WQT), S_, 4096, 2048};
        pg8::StaticOrder so; so.init(g.M, g.N, (int)gridDim.x, (int)blockIdx.x);
        pg8::EpiBf16 E{(bf16_t*)(p.ws + WS_Q), 4096};
        pg8::gemm_phase(lds, g, so, E);
    }
    SEAM(8);
    if (IN(9)) REP(9) { if (_r) grid.sync(); phase_topk(p, shm); }
    SEAM(9);
    if (IN(10)) REP(10) { if (_r) grid.sync(); phase_gather(p, shm); }
#undef IN
#undef REP
#undef SEAM
}

extern "C" void kernel_launch(void* const* d_in, const int* in_sizes, int n_in, void* d_out, int out_size, void* d_ws, size_t ws_size, hipStream_t stream) {
    static int grid_blocks = 0;
    if (grid_blocks == 0) {
        if (n_in != 26 || ws_size < WS_NEED) { fprintf(stderr, "kernel_launch: unexpected n_in %d / ws_size %zu\n", n_in, ws_size); grid_blocks = -1; return; }
        int dev = 0, cus = 0, per_cu = 0;
        (void)hipGetDevice(&dev);
        (void)hipDeviceGetAttribute(&cus, hipDeviceAttributeMultiprocessorCount, dev);
        (void)hipFuncSetAttribute((const void*)mega, hipFuncAttributeMaxDynamicSharedMemorySize, LDS_BYTES);
        (void)hipOccupancyMaxActiveBlocksPerMultiprocessor(&per_cu, (const void*)mega, 512, LDS_BYTES);
        if (per_cu < 1) { fprintf(stderr, "kernel_launch: occupancy query says %d blocks/CU\n", per_cu); per_cu = 1; }
        grid_blocks = cus * per_cu;
        fprintf(stderr, "kernel_launch: cus %d per_cu %d grid %d\n", cus, per_cu, grid_blocks);
    }
    if (grid_blocks < 0) return;
    Params p{};
    for (int i = 0; i < 26; ++i) p.in[i] = (const float*)d_in[i];
    p.out = (float*)d_out; p.ws = (unsigned char*)d_ws;
#if MULTI_LAUNCH
    for (int ph = 0; ph < NPHASE; ++ph) {
        p.ph_lo = ph; p.ph_hi = ph + 1;
        hipLaunchKernelGGL(mega, dim3(grid_blocks), dim3(512), LDS_BYTES, stream, p);
    }
#else
    p.ph_lo = 0; p.ph_hi = NPHASE;
    void* args[] = {&p};
    hipError_t e = hipLaunchCooperativeKernel((const void*)mega, dim3(grid_blocks), dim3(512), args, LDS_BYTES, stream);
    if (e != hipSuccess) fprintf(stderr, "cooperative launch failed: %s (grid %d)\n", hipGetErrorString(e), grid_blocks);
#endif
}
```

```cpp
#include <hip/hip_runtime.h>
#include <hip/hip_cooperative_groups.h>
#include <cstdio>
namespace cg = cooperative_groups;

#ifndef DUP_PHASE
#define DUP_PHASE -1
#endif
#ifndef MULTI_LAUNCH
#define MULTI_LAUNCH 0
#endif

#define LAS __attribute__((address_space(3)))
typedef unsigned short bf16_t;
typedef short bf16x8 __attribute__((ext_vector_type(8)));
typedef float f32x4 __attribute__((ext_vector_type(4)));
typedef float f32x2 __attribute__((ext_vector_type(2)));
typedef unsigned u32x4 __attribute__((ext_vector_type(4)));
typedef unsigned u32x2 __attribute__((ext_vector_type(2)));

constexpr int S_ = 16384, D_ = 2048, DR = 1024, NAUG = 6912;
constexpr size_t MiB = 1ull << 20;
constexpr size_t WS_PROJ = 0, WS_H = 216 * MiB, WS_WB1 = 280 * MiB, WS_WQT = 280 * MiB, WS_WOT = 296 * MiB;
constexpr size_t WS_R = 307 * MiB, WS_K = 339 * MiB, WS_V = 371 * MiB, WS_KK = 403 * MiB, WS_A = 435 * MiB, WS_LW = 467 * MiB;
constexpr size_t WS_G = 216 * MiB, WS_YC = 248 * MiB, WS_YMIX = 307 * MiB, WS_X1 = 0, WS_H2 = 128 * MiB, WS_Q = 307 * MiB;
constexpr size_t WS_GT = 0, WS_HT = 32 * MiB, WS_QE = 96 * MiB, WS_YL = 128 * MiB, WS_S0 = 160 * MiB;
constexpr size_t WS_IDS = 192 * MiB, WS_GATES = 200 * MiB, WS_UB = 467 * MiB, WS_VB = 435 * MiB, WS_BON = 500 * MiB, WS_BAR = 502 * MiB, WS_NEED = 503 * MiB;
constexpr size_t WS_W2T = 499 * MiB, WS_A2T = WS_W2T + 131072, WS_G2T = WS_A2T + 131072;
constexpr int TLD = 72, TSLOT = 64 * TLD * 2;
constexpr int LDS_BYTES = 16 * TSLOT + 2048 + 256 + 16;
constexpr int NPHASE = 11;

struct Params {
    const float* in[26];
    float* out;
    unsigned char* ws;
    int ph_lo, ph_hi;
};

__device__ __forceinline__ float bf2f(bf16_t b) { return __uint_as_float(((unsigned)b) << 16); }
__device__ __forceinline__ bf16_t f2bf(float f) { unsigned u = __float_as_uint(f); u += 0x7FFFu + ((u >> 16) & 1u); return (bf16_t)(u >> 16); }
typedef __bf16 bf16v2_t __attribute__((ext_vector_type(2)));
__device__ __forceinline__ unsigned cvt_pk_bf16(float lo, float hi) { const f32x2 v = {lo, hi}; const bf16v2_t r = __builtin_convertvector(v, bf16v2_t); return __builtin_bit_cast(unsigned, r); }
__device__ __forceinline__ u32x4 pack8(const float* f) { u32x4 w; w.x = cvt_pk_bf16(f[0], f[1]); w.y = cvt_pk_bf16(f[2], f[3]); w.z = cvt_pk_bf16(f[4], f[5]); w.w = cvt_pk_bf16(f[6], f[7]); return w; }
__device__ __forceinline__ float wave_sum(float v) {
#pragma unroll
    for (int o = 32; o; o >>= 1) v += __shfl_xor(v, o);
    return v;
}
template <int CTRL, int RM> __device__ __forceinline__ float dpp_f(float v) { return __int_as_float(__builtin_amdgcn_update_dpp(0, __float_as_int(v), CTRL, RM, 0xf, false)); }
__device__ __forceinline__ float wave_sum_dpp(float v) {
    v += dpp_f<0xB1, 0xf>(v); v += dpp_f<0x4E, 0xf>(v); v += dpp_f<0x141, 0xf>(v); v += dpp_f<0x140, 0xf>(v);
    v += dpp_f<0x142, 0xa>(v); v += dpp_f<0x143, 0xc>(v);
    return __int_as_float(__builtin_amdgcn_readlane(__float_as_int(v), 63));
}
__device__ __forceinline__ float wave_max(float v) {
#pragma unroll
    for (int o = 32; o; o >>= 1) v = fmaxf(v, __shfl_xor(v, o));
    return v;
}
__device__ __forceinline__ float sigmoidf_(float x) { return 1.0f / (1.0f + __expf(-x)); }
__device__ __forceinline__ float gelu_tanh(float x) { float u = 0.7978845608028654f * (x + 0.044715f * x * x * x); return 0.5f * x * (1.0f + tanhf(u)); }
__device__ __forceinline__ float lo_bf(unsigned w) { return __uint_as_float(w << 16); }
__device__ __forceinline__ float hi_bf(unsigned w) { return __uint_as_float(w & 0xffff0000u); }

namespace pg8 {
constexpr int BM = 256, BK = 64, HALF = 128, HTB = HALF * BK * 2, STAGE_BYTES = 8 * HTB, NXCD = 8, WGM = 8;
__device__ __forceinline__ int lds_byte(int r, int c) { const int st = (r >> 4) * 2 + (c >> 5), rr = r & 15, cc = c & 31, ob = rr * 64 + cc * 2; return st * 1024 + (ob ^ (((ob >> 9) & 1) << 5)); }
__device__ __forceinline__ void stage_rc(int b, int& R, int& C) { const int st = b / 1024, sb = b % 1024, swz = sb ^ (((sb >> 9) & 1) << 5); R = (st >> 1) * 16 + swz / 64; C = (st & 1) * 32 + (swz % 64) / 2; }
__device__ __forceinline__ int perm32(int rho) { const int n = rho >> 4, i = rho & 15; return 8 * (i >> 2) + 4 * n + (i & 3); }
struct Unit { int pm, pn; };
struct Gemm { const bf16_t* A; const bf16_t* Bt; int M, N, K; };
struct StaticOrder {
    int nM, nN, nwg, G, c;
    __device__ void init(int M, int N, int G_, int c_) { nM = M / BM; nN = N / BM; nwg = nM * nN; G = G_; c = c_; }
    __device__ bool next(int i, Unit& u) const {
        const long L = (long)i * G + c; if (L >= nwg) return false;
        int wgid = (int)L; { const int q = nwg / NXCD, r = nwg % NXCD, xcd = wgid % NXCD, off = wgid / NXCD; wgid = (xcd < r ? xcd * (q + 1) : r * (q + 1) + (xcd - r) * q) + off; }
        const int nig = WGM * nN, gid = wgid / nig, fm = gid * WGM, gsz = (nM - fm) < WGM ? (nM - fm) : WGM;
        u.pm = fm + ((wgid % nig) % gsz); u.pn = (wgid % nig) / gsz; return true;
    }
    __device__ __forceinline__ void a_ready(const Unit&) const {}
    __device__ __forceinline__ void done(const Unit&) const {}
};
struct EpiResF32 {
    static constexpr bool PERM = false;
    float* C; const float* Res; int ldc;
    __device__ __forceinline__ void operator()(const f32x4 (&acc)[2][2][4][2], const Unit& u, int wr, int wc, int fr, int fq) const {
        const int row0 = u.pm * BM + wr * 64 + fr, col0 = u.pn * BM + wc * 32 + 4 * fq;
#pragma unroll
        for (int ai = 0; ai < 2; ++ai)
#pragma unroll
            for (int m = 0; m < 4; ++m) { const size_t ro = (size_t)(row0 + ai * HALF + m * 16) * ldc + col0;
#pragma unroll
                for (int bj = 0; bj < 2; ++bj)
#pragma unroll
                    for (int n = 0; n < 2; ++n) { const f32x4 rs = *(const f32x4*)(Res + ro + bj * HALF + n * 16); *(f32x4*)(C + ro + bj * HALF + n * 16) = acc[ai][bj][m][n] + rs; } }
    }
};
struct EpiBf16 {
    static constexpr bool PERM = true;
    bf16_t* O; int ldc;
    __device__ __forceinline__ void operator()(const f32x4 (&acc)[2][2][4][2], const Unit& u, int wr, int wc, int fr, int fq) const {
        const int row0 = u.pm * BM + wr * 64 + fr; const int col0 = u.pn * BM + wc * 32 + 8 * fq;
#pragma unroll
        for (int ai = 0; ai < 2; ++ai)
#pragma unroll
            for (int m = 0; m < 4; ++m) { bf16_t* rowp = O + (size_t)(row0 + ai * HALF + m * 16) * ldc + col0;
#pragma unroll
                for (int bj = 0; bj < 2; ++bj) { const f32x4 v0 = acc[ai][bj][m][0], v1 = acc[ai][bj][m][1];
                    u32x4 w; w.x = cvt_pk_bf16(v0[0], v0[1]); w.y = cvt_pk_bf16(v0[2], v0[3]); w.z = cvt_pk_bf16(v1[0], v1[1]); w.w = cvt_pk_bf16(v1[2], v1[3]);
                    *(u32x4*)(rowp + bj * HALF) = w; } }
    }
};

template <class Epi, class Sched>
__device__ __forceinline__ void gemm_phase(LAS unsigned char* lds, const Gemm g, const Sched& S, const Epi& E) {
    const int tid = threadIdx.x, wid = __builtin_amdgcn_readfirstlane(tid >> 6), lane = tid & 63, wr = wid >> 2, wc = wid & 3, fr = lane & 15, fq = lane >> 4;
    const int K = g.K, nt = K / BK;
    unsigned voffA[2], voffB[2];
#pragma unroll
    for (int i = 0; i < 2; ++i) { int R, C; stage_rc(tid * 16 + i * 8192, R, C); const int Rb = Epi::PERM ? ((R & ~31) + perm32(R & 31)) : R;
        voffA[i] = (unsigned)(R * K + C) * 2u; voffB[i] = (unsigned)(Rb * K + C) * 2u; }
    const size_t kstep = (size_t)(BK * 2);
    const size_t hstep = (size_t)HALF * K * 2;
    const size_t tstep = 2 * hstep;
    const unsigned ldsw = (unsigned)wid * 1024u;
    const int aoff = lds_byte(wr * 64 + fr, fq * 8), boff = lds_byte(wc * 32 + fr, fq * 8);
#define PG8_SA(b, h) (((b) * 2 + (h)) * HTB)
#define PG8_SB(b, h) ((4 + (b) * 2 + (h)) * HTB)
#define PG8_STAGE(bufoff, gbase, voff) do { _Pragma("unroll") for (int _i = 0; _i < 2; ++_i) \
        __builtin_amdgcn_global_load_lds((const unsigned*)((const char*)(gbase) + (voff)[_i]), (LAS unsigned*)(lds + (bufoff) + ldsw + _i * 8192), 16, 0, 0); } while (0)
#define PG8_LDA(dst, b, h) do { _Pragma("unroll") for (int m = 0; m < 4; ++m) _Pragma("unroll") for (int k = 0; k < 2; ++k) dst[m][k] = *(const LAS bf16x8*)(lds + PG8_SA(b, h) + aoff + m * 2048 + k * 1024); } while (0)
#define PG8_LDB(dst, b, h) do { _Pragma("unroll") for (int n = 0; n < 2; ++n) _Pragma("unroll") for (int k = 0; k < 2; ++k) dst[n][k] = *(const LAS bf16x8*)(lds + PG8_SB(b, h) + boff + n * 2048 + k * 1024); } while (0)
#define PG8_MMA(ai, bj, At, Bt) do { __builtin_amdgcn_s_setprio(1); _Pragma("unroll") for (int m = 0; m < 4; ++m) _Pragma("unroll") for (int n = 0; n < 2; ++n) _Pragma("unroll") for (int k = 0; k < 2; ++k) \
        acc[ai][bj][m][n] = __builtin_amdgcn_mfma_f32_16x16x32_bf16(Bt[n][k], At[m][k], acc[ai][bj][m][n], 0, 0, 0); __builtin_amdgcn_s_setprio(0); } while (0)
#define PG8_WAIT_V(n) asm volatile("s_waitcnt vmcnt(" #n ")" ::: "memory")
#define PG8_WAIT_L(n) asm volatile("s_waitcnt lgkmcnt(" #n ")" ::: "memory")
#define PG8_BAR __builtin_amdgcn_s_barrier()
#define PG8_SCHED __builtin_amdgcn_sched_barrier(0)
    Unit cur, nxt; int ui = 0;
    if (!S.next(0, cur)) return;
    f32x4 acc[2][2][4][2];
#pragma unroll
    for (int a = 0; a < 2; ++a)
#pragma unroll
        for (int b = 0; b < 2; ++b)
#pragma unroll
            for (int m = 0; m < 4; ++m)
#pragma unroll
                for (int n = 0; n < 2; ++n) acc[a][b][m][n] = (f32x4){0.f, 0.f, 0.f, 0.f};
    bf16x8 At[4][2], B0[2][2], B1[2][2];
    const char* cA = (const char*)g.A + (size_t)cur.pm * tstep; const char* cB = (const char*)g.Bt + (size_t)cur.pn * tstep;
    S.a_ready(cur);
    PG8_STAGE(PG8_SB(0, 0), cB, voffB); PG8_STAGE(PG8_SA(0, 0), cA, voffA); PG8_STAGE(PG8_SB(0, 1), cB + hstep, voffB); PG8_STAGE(PG8_SA(0, 1), cA + hstep, voffA);
    if (wr == 1) PG8_BAR;
    PG8_WAIT_V(4); PG8_BAR;
    PG8_STAGE(PG8_SB(1, 0), cB + kstep, voffB); PG8_STAGE(PG8_SA(1, 0), cA + kstep, voffA); PG8_STAGE(PG8_SB(1, 1), cB + hstep + kstep, voffB);
    PG8_WAIT_V(6); PG8_BAR;
    for (;;) {
        const bool has_next = S.next(ui + 1, nxt);
        const char* nA = has_next ? (const char*)g.A + (size_t)nxt.pm * tstep : cA; const char* nB = has_next ? (const char*)g.Bt + (size_t)nxt.pn * tstep : cB;
        for (int t = 0; t < nt; t += 2) {
            const bool last = (t == nt - 2);
            const char* a1 = cA + (size_t)(t + 1) * kstep;
            const char* a2 = last ? nA : cA + (size_t)(t + 2) * kstep; const char* b2 = last ? nB : cB + (size_t)(t + 2) * kstep;
            const char* a3 = a2 + kstep; const char* b3 = b2 + kstep;
            if (last && has_next) S.a_ready(nxt);
            PG8_LDB(B0, 0, 0); PG8_SCHED; PG8_LDA(At, 0, 0); PG8_STAGE(PG8_SA(1, 1), a1 + hstep, voffA);
            PG8_WAIT_L(8); PG8_BAR; PG8_WAIT_L(0); PG8_MMA(0, 0, At, B0); PG8_BAR; PG8_SCHED;
            PG8_LDB(B1, 0, 1); PG8_STAGE(PG8_SB(0, 0), b2, voffB);
            PG8_BAR; PG8_WAIT_L(0); PG8_MMA(0, 1, At, B1); PG8_BAR;
            PG8_LDA(At, 0, 1); PG8_STAGE(PG8_SA(0, 0), a2, voffA);
            PG8_BAR; PG8_WAIT_L(0); PG8_MMA(1, 0, At, B0); PG8_BAR; PG8_SCHED;
            PG8_STAGE(PG8_SB(0, 1), b2 + hstep, voffB);
            PG8_WAIT_V(6); PG8_BAR; PG8_MMA(1, 1, At, B1); PG8_BAR;
            PG8_LDB(B0, 1, 0); PG8_SCHED; PG8_LDA(At, 1, 0); PG8_STAGE(PG8_SA(0, 1), a2 + hstep, voffA);
            PG8_WAIT_L(8); PG8_BAR; PG8_WAIT_L(0); PG8_MMA(0, 0, At, B0); PG8_BAR; PG8_SCHED;
            PG8_LDB(B1, 1, 1); PG8_STAGE(PG8_SB(1, 0), b3, voffB);
            PG8_BAR; PG8_WAIT_L(0); PG8_MMA(0, 1, At, B1); PG8_BAR;
            PG8_LDA(At, 1, 1); PG8_STAGE(PG8_SA(1, 0), a3, voffA);
            PG8_BAR; PG8_WAIT_L(0); PG8_MMA(1, 0, At, B0); PG8_BAR; PG8_SCHED;
            PG8_STAGE(PG8_SB(1, 1), b3 + hstep, voffB);
            PG8_WAIT_V(6); PG8_BAR; PG8_MMA(1, 1, At, B1); PG8_BAR;
        }
        E(acc, cur, wr, wc, fr, fq); S.done(cur);
        if (!has_next) break;
#pragma unroll
        for (int a = 0; a < 2; ++a)
#pragma unroll
            for (int b = 0; b < 2; ++b)
#pragma unroll
                for (int m = 0; m < 4; ++m)
#pragma unroll
                    for (int n = 0; n < 2; ++n) acc[a][b][m][n] = (f32x4){0.f, 0.f, 0.f, 0.f};
        cur = nxt; cA = nA; cB = nB; ++ui;
    }
    PG8_WAIT_V(0);
    if (wr == 0) PG8_BAR;
    PG8_BAR;
#undef PG8_SA
#undef PG8_SB
#undef PG8_STAGE
#undef PG8_LDA
#undef PG8_LDB
#undef PG8_MMA
#undef PG8_WAIT_V
#undef PG8_WAIT_L
#undef PG8_BAR
#undef PG8_SCHED
}
}

__device__ __forceinline__ void rmsnorm_rows(const float* X, const float* gain, bf16_t* H) {
    const int wave = threadIdx.x >> 6, lane = threadIdx.x & 63;
    for (int row = blockIdx.x * 8 + wave; row < S_; row += gridDim.x * 8) {
        const float4* xr = (const float4*)(X + (size_t)row * D_);
        float4 v[8]; float ss = 0.f;
#pragma unroll
        for (int i = 0; i < 8; ++i) { v[i] = xr[i * 64 + lane]; ss += v[i].x * v[i].x + v[i].y * v[i].y + v[i].z * v[i].z + v[i].w * v[i].w; }
        ss = wave_sum(ss);
        const float sc = rsqrtf(ss * (1.0f / 2048.0f) + 1e-6f);
#pragma unroll
        for (int i = 0; i < 8; ++i) { const float4 g = ((const float4*)gain)[i * 64 + lane];
            u32x2 w; w.x = cvt_pk_bf16(v[i].x * sc * g.x, v[i].y * sc * g.y); w.y = cvt_pk_bf16(v[i].z * sc * g.z, v[i].w * sc * g.w);
            *(u32x2*)(H + (size_t)row * D_ + (i * 64 + lane) * 4) = w; }
    }
}

__device__ __forceinline__ void transpose_convert(const float* W, int K, int N, bf16_t* Bt, float* tile, int bid, int nblk) {
    const int tid = threadIdx.x; const int tk = K / 64, tn = N / 64;
    for (int u = bid; u < tk * tn; u += nblk) {
        const int k0 = (u / tn) * 64, n0 = (u % tn) * 64;
        __syncthreads();
#pragma unroll
        for (int i = 0; i < 8; ++i) { const int kk = i * 8 + (tid >> 6), nn = tid & 63; tile[kk * 65 + nn] = W[(size_t)(k0 + kk) * N + n0 + nn]; }
        __syncthreads();
#pragma unroll
        for (int i = 0; i < 4; ++i) { const int nn = i * 16 + (tid >> 5), kp = (tid & 31) * 2;
            *(unsigned*)(Bt + (size_t)(n0 + nn) * K + k0 + kp) = cvt_pk_bf16(tile[kp * 65 + nn], tile[(kp + 1) * 65 + nn]); }
    }
}

__device__ __forceinline__ void convert_flat(const float* src, bf16_t* dst, size_t n) {
    for (size_t i = ((size_t)blockIdx.x * 512 + threadIdx.x) * 8; i < n; i += (size_t)gridDim.x * 512 * 8) {
        const float4 a = *(const float4*)(src + i), b = *(const float4*)(src + i + 4);
        u32x4 w; w.x = cvt_pk_bf16(a.x, a.y); w.y = cvt_pk_bf16(a.z, a.w); w.z = cvt_pk_bf16(b.x, b.y); w.w = cvt_pk_bf16(b.z, b.w);
        *(u32x4*)(dst + i) = w;
    }
}

__device__ __forceinline__ void convert_fp8(const float* src, unsigned char* dst, size_t n, float sc, int bid, int nblk) {
    const int lane = threadIdx.x & 63, wv = threadIdx.x >> 6;
    for (size_t base = ((size_t)bid * 8 + wv) * 1024; base < n; base += (size_t)nblk * 8 * 1024) {
        float4 a[4];
#pragma unroll
        for (int j = 0; j < 4; ++j) a[j] = *(const float4*)(src + base + (size_t)(j * 64 + lane) * 4);
#pragma unroll
        for (int j = 0; j < 4; ++j) { int x = __builtin_amdgcn_cvt_pk_fp8_f32(a[j].x * sc, a[j].y * sc, 0, false); x = __builtin_amdgcn_cvt_pk_fp8_f32(a[j].z * sc, a[j].w * sc, x, true);
            *(unsigned*)(dst + base + (size_t)(j * 64 + lane) * 4) = (unsigned)x; }
    }
}

__device__ __forceinline__ void phase0(const Params& p, unsigned char* shm) {
    bf16_t* WB1 = (bf16_t*)(p.ws + WS_WB1);
    rmsnorm_rows(p.in[0], p.in[1], (bf16_t*)(p.ws + WS_H));
    transpose_convert(p.in[2], 2048, 6144, WB1, (float*)shm, blockIdx.x, gridDim.x);
    const float* mu = p.in[4]; const float* w1 = p.in[6]; const float* a1 = p.in[9]; const float* g1 = p.in[11];
    for (int idx = blockIdx.x * 512 + threadIdx.x; idx < 768 * 2048; idx += gridDim.x * 512) {
        const int j = idx >> 11, k = idx & 2047; float val = 0.f;
        if (j < 128) { const float m = mu[k], w = w1[k * 64 + (j & 63)]; val = (j < 64) ? w * (1.f - m) : w * m; }
        else if (j < 256) { const float m = mu[2048 + k], w = a1[k * 64 + (j & 63)]; val = (j < 192) ? w * (1.f - m) : w * m; }
        else if (j < 576) { const float m = mu[4096 + k]; const int jj = j - 256; const int c = jj < 160 ? jj : jj - 160; const float w = g1[k * 160 + c]; val = jj < 160 ? w * (1.f - m) : w * m; }
        WB1[(size_t)(6144 + j) * 2048 + k] = f2bf(val);
    }
    bf16_t* W2T = (bf16_t*)(p.ws + WS_W2T); bf16_t* A2T = (bf16_t*)(p.ws + WS_A2T); bf16_t* G2T = (bf16_t*)(p.ws + WS_G2T);
    const float* w2 = p.in[7]; const float* a2 = p.in[10]; const float* g2 = p.in[12];
    for (int idx = blockIdx.x * 512 + threadIdx.x; idx < 1024 * 288; idx += gridDim.x * 512) {
        if (idx < 65536) { const int c = idx >> 6, j = idx & 63; W2T[idx] = f2bf(w2[j * 1024 + c]); }
        else if (idx < 131072) { const int i2 = idx - 65536; const int c = i2 >> 6, j = i2 & 63; A2T[i2] = f2bf(a2[j * 1024 + c]); }
        else { const int i2 = idx - 131072; const int c = i2 / 160, j = i2 % 160; G2T[i2] = f2bf(g2[j * 1024 + c]); }
    }
}

constexpr int ACT_LD = 296;
template <int KS, int KOFF, int KTOT, int KIND>
__device__ __forceinline__ void lora_stage(const LAS bf16_t* act, const bf16_t* WT, const float* bias, bf16_t* OUT, int t0, int w, int fr, int fq) {
#pragma unroll 1
    for (int nh = 0; nh < 2; ++nh) {
        f32x4 acc[4][4];
#pragma unroll
        for (int m = 0; m < 4; ++m)
#pragma unroll
            for (int n = 0; n < 4; ++n) acc[m][n] = (f32x4){0.f, 0.f, 0.f, 0.f};
#pragma unroll 1
        for (int ks = 0; ks < KS; ++ks) {
            bf16x8 a[4];
#pragma unroll
            for (int m = 0; m < 4; ++m) a[m] = *(const LAS bf16x8*)(act + (m * 16 + fr) * ACT_LD + KOFF + ks * 32 + fq * 8);
#pragma unroll
            for (int n = 0; n < 4; ++n) {
                const bf16x8 b = *(const bf16x8*)(WT + (size_t)(w * 128 + (nh * 4 + n) * 16 + fr) * KTOT + ks * 32 + fq * 8);
#pragma unroll
                for (int m = 0; m < 4; ++m) acc[m][n] = __builtin_amdgcn_mfma_f32_16x16x32_bf16(a[m], b, acc[m][n], 0, 0, 0);
            }
        }
#pragma unroll
        for (int n = 0; n < 4; ++n) {
            const int c = w * 128 + (nh * 4 + n) * 16 + fr;
            const float bs = (KIND < 2) ? bias[c] : 0.f;
#pragma unroll
            for (int m = 0; m < 4; ++m)
#pragma unroll
                for (int j = 0; j < 4; ++j) {
                    const float val = acc[m][n][j]; float o;
                    if (KIND == 0) { const float x = -(bs + val); const float sp = fmaxf(x, 0.f) + log1pf(__expf(-fabsf(x))); o = -__expf(-sp - 0.5f); }
                    else if (KIND == 1) o = sigmoidf_(bs + val);
                    else o = val;
                    OUT[(size_t)(t0 + m * 16 + fq * 4 + j) * DR + c] = f2bf(o);
                }
        }
    }
}
__device__ __forceinline__ void phase_prepM(const Params& p, LAS unsigned char* lds) {
    LAS bf16_t* act = (LAS bf16_t*)lds;
    const bf16_t* P = (const bf16_t*)(p.ws + WS_PROJ);
    const int tid = threadIdx.x, w = tid >> 6, lane = tid & 63, fr = lane & 15, fq = lane >> 4;
    for (int tile = blockIdx.x; tile < S_ / 64; tile += gridDim.x) {
        const int t0 = tile * 64;
        __syncthreads();
        for (int e = tid; e < 64 * 288; e += 512) {
            const int t = e / 288, j = e % 288; const int tg = t0 + t;
            int ccur, cprev;
            if (j < 64) { ccur = 6144 + j; cprev = 6208 + j; }
            else if (j < 128) { ccur = 6272 + (j - 64); cprev = 6336 + (j - 64); }
            else { ccur = 6400 + (j - 128); cprev = 6560 + (j - 128); }
            float sv = bf2f(P[(size_t)tg * NAUG + ccur]);
            if (tg > 0) sv += bf2f(P[(size_t)(tg - 1) * NAUG + cprev]);
            const float a = j < 64 ? tanhf(sv) : (j < 128 ? sv : sigmoidf_(sv));
            act[t * ACT_LD + j] = f2bf(a);
        }
        __syncthreads();
        lora_stage<2, 0, 64, 0>(act, (const bf16_t*)(p.ws + WS_W2T), p.in[5], (bf16_t*)(p.ws + WS_LW), t0, w, fr, fq);
        lora_stage<2, 64, 64, 1>(act, (const bf16_t*)(p.ws + WS_A2T), p.in[8], (bf16_t*)(p.ws + WS_A), t0, w, fr, fq);
        lora_stage<5, 128, 160, 2>(act, (const bf16_t*)(p.ws + WS_G2T), nullptr, (bf16_t*)(p.ws + WS_G), t0, w, fr, fq);
    }
}

__device__ __forceinline__ void unpack8(const u32x4 v, float* f) {
#pragma unroll
    for (int i = 0; i < 4; ++i) { f[2 * i] = lo_bf(v[i]); f[2 * i + 1] = hi_bf(v[i]); }
}
__device__ __forceinline__ void phase_prepE(const Params& p) {
    const bf16_t* P = (const bf16_t*)(p.ws + WS_PROJ);
    bf16_t* R = (bf16_t*)(p.ws + WS_R); bf16_t* Kk = (bf16_t*)(p.ws + WS_K); bf16_t* V = (bf16_t*)(p.ws + WS_V); bf16_t* KK = (bf16_t*)(p.ws + WS_KK); bf16_t* YC = (bf16_t*)(p.ws + WS_YC);
    const float* mu_rkv = p.in[3]; const float* k_k = p.in[13]; const float* cw = p.in[18];
    const int tid = threadIdx.x, cg = tid & 127, c0 = cg * 8, tgrp = tid >> 7;
    float mr[8], mk[8], mv[8], kkc[8], cw0[8], cw1[8], cw2[8];
#pragma unroll
    for (int i = 0; i < 8; ++i) { mr[i] = mu_rkv[c0 + i]; mk[i] = mu_rkv[1024 + c0 + i]; mv[i] = mu_rkv[2048 + c0 + i]; kkc[i] = k_k[c0 + i]; cw0[i] = cw[c0 + i]; cw1[i] = cw[1024 + c0 + i]; cw2[i] = cw[2048 + c0 + i]; }
    for (int run = blockIdx.x * 4 + tgrp; run < S_ / 16; run += gridDim.x * 4) {
        const int t0 = run * 16;
        float pr[8], pk[8], pv[8], u1[8], u2[8];
#pragma unroll
        for (int i = 0; i < 8; ++i) { pr[i] = 0.f; pk[i] = 0.f; pv[i] = 0.f; u1[i] = 0.f; u2[i] = 0.f; }
        if (t0 > 0) {
            const size_t o = (size_t)(t0 - 1) * NAUG + c0;
            unpack8(*(const u32x4*)(P + o), pr); unpack8(*(const u32x4*)(P + o + 1024), pk); unpack8(*(const u32x4*)(P + o + 2048), pv);
            float x[8], y[8];
            unpack8(*(const u32x4*)(P + o + 4096), x); unpack8(*(const u32x4*)(P + o + 5120), y);
#pragma unroll
            for (int i = 0; i < 8; ++i) u1[i] = x[i] * y[i];
            unpack8(*(const u32x4*)(P + o - NAUG + 4096), x); unpack8(*(const u32x4*)(P + o - NAUG + 5120), y);
#pragma unroll
            for (int i = 0; i < 8; ++i) u2[i] = x[i] * y[i];
        }
#pragma unroll 1
        for (int t = 0; t < 16; ++t) {
            const size_t o = (size_t)(t0 + t) * NAUG + c0;
            float cr[8], ck[8], cv[8], bg[8], cgt[8], xc[8];
            unpack8(*(const u32x4*)(P + o), cr); unpack8(*(const u32x4*)(P + o + 1024), ck); unpack8(*(const u32x4*)(P + o + 2048), cv);
            unpack8(*(const u32x4*)(P + o + 3072), bg); unpack8(*(const u32x4*)(P + o + 4096), cgt); unpack8(*(const u32x4*)(P + o + 5120), xc);
            float r[8], k[8], v[8], kkv[8], yc[8]; float ss = 0.f;
#pragma unroll
            for (int i = 0; i < 8; ++i) {
                r[i] = cr[i] + (pr[i] - cr[i]) * mr[i]; k[i] = ck[i] + (pk[i] - ck[i]) * mk[i]; v[i] = cv[i] + (pv[i] - cv[i]) * mv[i];
                pr[i] = cr[i]; pk[i] = ck[i]; pv[i] = cv[i];
                kkv[i] = k[i] * kkc[i]; ss += kkv[i] * kkv[i];
                const float u0 = cgt[i] * xc[i];
                yc[i] = bg[i] * (cw0[i] * u2[i] + cw1[i] * u1[i] + cw2[i] * u0);
                u2[i] = u1[i]; u1[i] = u0;
            }
            ss += dpp_f<0xB1, 0xf>(ss); ss += dpp_f<0x4E, 0xf>(ss); ss += dpp_f<0x141, 0xf>(ss);
            const float inv = 1.0f / fmaxf(sqrtf(ss), 1e-12f);
#pragma unroll
            for (int i = 0; i < 8; ++i) kkv[i] *= inv;
            const size_t oo = (size_t)(t0 + t) * DR + c0;
            *(u32x4*)(R + oo) = pack8(r); *(u32x4*)(Kk + oo) = pack8(k); *(u32x4*)(V + oo) = pack8(v); *(u32x4*)(KK + oo) = pack8(kkv); *(u32x4*)(YC + oo) = pack8(yc);
        }
    }
}

#define TILE(i) ((LAS bf16_t*)(lds + (i) * TSLOT))
__device__ __forceinline__ f32x4 mm_tile(f32x4 acc, const LAS bf16_t* A, const LAS bf16_t* Bt, int mi, int ni, int fr, int fq) {
#pragma unroll
    for (int ks = 0; ks < 2; ++ks) {
        const bf16x8 a = *(const LAS bf16x8*)(A + (mi * 16 + fr) * TLD + ks * 32 + fq * 8);
        const bf16x8 b = *(const LAS bf16x8*)(Bt + (ni * 16 + fr) * TLD + ks * 32 + fq * 8);
        acc = __builtin_amdgcn_mfma_f32_16x16x32_bf16(a, b, acc, 0, 0, 0);
    }
    return acc;
}
__device__ __forceinline__ void st_rm(LAS bf16_t* X, f32x4 v, int mi, int ni, int fr, int fq) {
    const unsigned w0 = cvt_pk_bf16(v[0], v[1]), w1 = cvt_pk_bf16(v[2], v[3]);
    LAS bf16_t* q = X + (mi * 16 + fq * 4) * TLD + ni * 16 + fr;
    q[0] = (bf16_t)(w0 & 0xffffu); q[TLD] = (bf16_t)(w0 >> 16); q[2 * TLD] = (bf16_t)(w1 & 0xffffu); q[3 * TLD] = (bf16_t)(w1 >> 16);
}
__device__ __forceinline__ void st_tr(LAS bf16_t* XT, f32x4 v, int mi, int ni, int fr, int fq) {
    u32x2 w; w.x = cvt_pk_bf16(v[0], v[1]); w.y = cvt_pk_bf16(v[2], v[3]);
    *(LAS u32x2*)(XT + (ni * 16 + fr) * TLD + mi * 16 + fq * 4) = w;
}
__device__ __forceinline__ f32x4 ld_rm(const LAS bf16_t* X, int mi, int ni, int fr, int fq) {
    const LAS bf16_t* q = X + (mi * 16 + fq * 4) * TLD + ni * 16 + fr;
    return (f32x4){bf2f(q[0]), bf2f(q[TLD]), bf2f(q[2 * TLD]), bf2f(q[3 * TLD])};
}
__device__ __forceinline__ f32x4 ld_tr(const LAS bf16_t* XT, int mi, int ni, int fr, int fq) {
    const u32x2 w = *(const LAS u32x2*)(XT + (ni * 16 + fr) * TLD + mi * 16 + fq * 4);
    return (f32x4){lo_bf(w.x), hi_bf(w.x), lo_bf(w.y), hi_bf(w.y)};
}

__device__ __forceinline__ void phase_chunkA(const Params& p, LAS unsigned char* lds) {
    const int tid = threadIdx.x, w = tid >> 6, lane = tid & 63, fr = lane & 15, fq = lane >> 4;
    const int mi = w >> 1, nb = (w & 1) * 2;
    LAS float* cl = (LAS float*)(lds + 14 * TSLOT);
    LAS float* gs = (LAS float*)(lds + 16 * TSLOT);
    LAS float* wc = gs + 512;
    const bf16_t* R = (const bf16_t*)(p.ws + WS_R); const bf16_t* Kk = (const bf16_t*)(p.ws + WS_K); const bf16_t* V = (const bf16_t*)(p.ws + WS_V);
    const bf16_t* KK = (const bf16_t*)(p.ws + WS_KK); const bf16_t* A = (const bf16_t*)(p.ws + WS_A); const bf16_t* LW = (const bf16_t*)(p.ws + WS_LW);
    bf16_t* GT = (bf16_t*)(p.ws + WS_GT); float* HT = (float*)(p.ws + WS_HT); bf16_t* QE = (bf16_t*)(p.ws + WS_QE); bf16_t* YL = (bf16_t*)(p.ws + WS_YL);
    const f32x4 z4 = (f32x4){0.f, 0.f, 0.f, 0.f};
    const float* k_a = p.in[14]; const float* r_k = p.in[15]; float* BON = (float*)(p.ws + WS_BON);
    for (int item = blockIdx.x; item < 4096; item += gridDim.x) {
        const int c = item >> 4, h = item & 15;
        const size_t gbase = (size_t)(c * 64) * DR + h * 64;
        {
            const int g = w, k = lane;
            float pfx[8]; float run = 0.f;
#pragma unroll
            for (int i = 0; i < 8; ++i) { run += bf2f(LW[gbase + (size_t)(g * 8 + i) * DR + k]); pfx[i] = run; }
            gs[g * 64 + k] = run;
            __syncthreads();
            float off = 0.f;
#pragma unroll
            for (int gg = 0; gg < 7; ++gg) { const float x = gs[gg * 64 + k]; off += (gg < g) ? x : 0.f; }
#pragma unroll
            for (int i = 0; i < 8; ++i) cl[(g * 8 + i) * 64 + k] = off + pfx[i];
            if (g == 7) wc[k] = __expf(off + pfx[7]);
            __syncthreads();
        }
        {
            const int t = tid >> 3, k0 = (tid & 7) * 8;
            const size_t go = gbase + (size_t)t * DR + k0;
            const u32x4 r4 = *(const u32x4*)(R + go), k4 = *(const u32x4*)(Kk + go), v4 = *(const u32x4*)(V + go), kk4 = *(const u32x4*)(KK + go), a4 = *(const u32x4*)(A + go), lw4 = *(const u32x4*)(LW + go);
            float at[8], rt[8], bt[8], kt[8], bh[8], kh[8], vv[8]; float bsum = 0.f;
#pragma unroll
            for (int i = 0; i < 8; ++i) {
                const int q = i >> 1; const bool hi = i & 1;
                const float rf = hi ? hi_bf(r4[q]) : lo_bf(r4[q]), kraw = hi ? hi_bf(k4[q]) : lo_bf(k4[q]), vf = hi ? hi_bf(v4[q]) : lo_bf(v4[q]);
                const float kkf = hi ? hi_bf(kk4[q]) : lo_bf(kk4[q]), af = hi ? hi_bf(a4[q]) : lo_bf(a4[q]), lwf = hi ? hi_bf(lw4[q]) : lo_bf(lw4[q]);
                const float kf = kraw * (1.f + (af - 1.f) * k_a[h * 64 + k0 + i]);
                bsum += rf * kf * r_k[h * 64 + k0 + i];
                const float clv = cl[t * 64 + k0 + i], cle = cl[63 * 64 + k0 + i];
                const float e = __expf(clv), ex = __expf(clv - lwf), ei = __expf(-clv), eh = __expf(cle - clv);
                const float bb = kkf * af;
                at[i] = -kkf * ex; rt[i] = rf * e; bt[i] = bb * ei; kt[i] = kf * ei; bh[i] = bb * eh; kh[i] = kf * eh; vv[i] = vf;
            }
            bsum += dpp_f<0xB1, 0xf>(bsum); bsum += dpp_f<0x4E, 0xf>(bsum); bsum += dpp_f<0x141, 0xf>(bsum);
            if ((tid & 7) == 0) BON[(size_t)(c * 64 + t) * 16 + h] = bsum;
            *(LAS u32x4*)(TILE(0) + t * TLD + k0) = pack8(at);
            *(LAS u32x4*)(TILE(2) + t * TLD + k0) = pack8(rt);
            *(LAS u32x4*)(TILE(3) + t * TLD + k0) = pack8(bt);
            *(LAS u32x4*)(TILE(4) + t * TLD + k0) = pack8(kt);
            const u32x4 atp = pack8(at), bhp = pack8(bh), khp = pack8(kh);
#pragma unroll
            for (int i = 0; i < 8; ++i) {
                const int q = i >> 1; const bool hi = i & 1;
                TILE(1)[(k0 + i) * TLD + t] = (bf16_t)(hi ? (atp[q] >> 16) : (atp[q] & 0xffffu));
                TILE(5)[(k0 + i) * TLD + t] = (bf16_t)(hi ? (bhp[q] >> 16) : (bhp[q] & 0xffffu));
                TILE(6)[(k0 + i) * TLD + t] = (bf16_t)(hi ? (khp[q] >> 16) : (khp[q] & 0xffffu));
                TILE(7)[(k0 + i) * TLD + t] = (bf16_t)(hi ? (v4[q] >> 16) : (v4[q] & 0xffffu));
            }
            __syncthreads();
        }
#pragma unroll
        for (int nn = 0; nn < 2; ++nn) {
            const int ni = nb + nn; const int col = ni * 16 + fr, row0 = mi * 16 + fq * 4;
            f32x4 x = mm_tile(z4, TILE(0), TILE(3), mi, ni, fr, fq);
#pragma unroll
            for (int j = 0; j < 4; ++j) x[j] = (col < row0 + j) ? x[j] : 0.f;
            st_rm(TILE(8), x, mi, ni, fr, fq); st_tr(TILE(9), x, mi, ni, fr, fq);
            x = mm_tile(z4, TILE(0), TILE(4), mi, ni, fr, fq);
#pragma unroll
            for (int j = 0; j < 4; ++j) x[j] = (col < row0 + j) ? x[j] : 0.f;
            st_rm(TILE(10), x, mi, ni, fr, fq);
            x = mm_tile(z4, TILE(2), TILE(3), mi, ni, fr, fq);
#pragma unroll
            for (int j = 0; j < 4; ++j) x[j] = (col <= row0 + j) ? x[j] : 0.f;
            st_rm(TILE(11), x, mi, ni, fr, fq);
            x = mm_tile(z4, TILE(2), TILE(4), mi, ni, fr, fq);
#pragma unroll
            for (int j = 0; j < 4; ++j) x[j] = (col <= row0 + j) ? x[j] : 0.f;
            st_rm(TILE(12), x, mi, ni, fr, fq);
        }
        __syncthreads();
#pragma unroll
        for (int nn = 0; nn < 2; ++nn) {
            const int ni = nb + nn;
            st_tr(TILE(13), mm_tile(z4, TILE(10), TILE(7), mi, ni, fr, fq), mi, ni, fr, fq);
            const f32x4 x = mm_tile(z4, TILE(8), TILE(9), mi, ni, fr, fq);
            st_rm(TILE(0), x, mi, ni, fr, fq); st_tr(TILE(3), x, mi, ni, fr, fq);
        }
        __syncthreads();
#pragma unroll
        for (int rd = 0; rd < 5; ++rd) {
            const int tq = (rd & 1) ? 14 : 8, tqo = (rd & 1) ? 8 : 14;
            const int lx = (rd & 1) ? 4 : 0, lxt = (rd & 1) ? 9 : 3, lxo = (rd & 1) ? 0 : 4, lxto = (rd & 1) ? 3 : 9;
#pragma unroll
            for (int nn = 0; nn < 2; ++nn) {
                const int ni = nb + nn;
                f32x4 x = ld_rm(TILE(tq), mi, ni, fr, fq) + ld_rm(TILE(lx), mi, ni, fr, fq);
                x = mm_tile(x, TILE(tq), TILE(lxt), mi, ni, fr, fq);
                st_rm(TILE(tqo), x, mi, ni, fr, fq);
                if (rd < 4) { const f32x4 y = mm_tile(z4, TILE(lx), TILE(lxt), mi, ni, fr, fq); st_rm(TILE(lxo), y, mi, ni, fr, fq); st_tr(TILE(lxto), y, mi, ni, fr, fq); }
            }
            __syncthreads();
        }
#pragma unroll
        for (int nn = 0; nn < 2; ++nn) {
            const int ni = nb + nn;
            st_tr(TILE(10), mm_tile(ld_tr(TILE(1), mi, ni, fr, fq), TILE(14), TILE(1), mi, ni, fr, fq), mi, ni, fr, fq);
            st_tr(TILE(15), mm_tile(ld_tr(TILE(13), mi, ni, fr, fq), TILE(14), TILE(13), mi, ni, fr, fq), mi, ni, fr, fq);
        }
        __syncthreads();
#pragma unroll
        for (int nn = 0; nn < 2; ++nn) {
            const int ni = nb + nn;
            {
                f32x4 x = mm_tile(z4, TILE(5), TILE(10), mi, ni, fr, fq);
                if (mi == ni) {
#pragma unroll
                    for (int j = 0; j < 4; ++j) x[j] += (fq * 4 + j == fr) ? wc[ni * 16 + fr] : 0.f;
                }
                const unsigned w0 = cvt_pk_bf16(x[0], x[1]), w1 = cvt_pk_bf16(x[2], x[3]);
                bf16_t* gp = GT + (size_t)item * 4096 + (size_t)((mi * 2 + (ni >> 1)) * 64 + (fr >> 2) * 16 + fq * 4) * 8 + (ni & 1) * 4 + (fr & 3);
                gp[0] = (bf16_t)(w0 & 0xffffu); gp[8] = (bf16_t)(w0 >> 16); gp[16] = (bf16_t)(w1 & 0xffffu); gp[24] = (bf16_t)(w1 >> 16);
            }
            {
                f32x4 x = mm_tile(z4, TILE(5), TILE(15), mi, ni, fr, fq);
                x = mm_tile(x, TILE(6), TILE(7), mi, ni, fr, fq);
                *(f32x4*)(HT + (size_t)item * 4096 + (size_t)((ni * 4 + mi) * 64 + lane) * 4) = x;
            }
            {
                f32x4 x = ld_tr(TILE(2), mi, ni, fr, fq);
                x = mm_tile(x, TILE(10), TILE(11), mi, ni, fr, fq);
                u32x2 wv; wv.x = cvt_pk_bf16(x[0], x[1]); wv.y = cvt_pk_bf16(x[2], x[3]);
                *(u32x2*)(QE + (size_t)item * 4096 + (ni * 16 + fr) * 64 + mi * 16 + fq * 4) = wv;
            }
            {
                f32x4 x = mm_tile(z4, TILE(11), TILE(15), mi, ni, fr, fq);
                x = mm_tile(x, TILE(12), TILE(7), mi, ni, fr, fq);
                u32x2 wv; wv.x = cvt_pk_bf16(x[0], x[1]); wv.y = cvt_pk_bf16(x[2], x[3]);
                *(u32x2*)(YL + (size_t)item * 4096 + (size_t)((mi * 4 + ni) * 64 + lane) * 4) = wv;
            }
        }
    }
}

__device__ __forceinline__ void phase_seq(const Params& p) {
    if (threadIdx.x >= 64) return;
    const int head = blockIdx.x >> 2, vt = blockIdx.x & 3, lane = threadIdx.x, fr = lane & 15, fq = lane >> 4;
    const bf16_t* GT = (const bf16_t*)(p.ws + WS_GT); const float* HT = (const float*)(p.ws + WS_HT); bf16_t* S0 = (bf16_t*)(p.ws + WS_S0);
    f32x4 acc[4];
#pragma unroll
    for (int mb = 0; mb < 4; ++mb) acc[mb] = (f32x4){0.f, 0.f, 0.f, 0.f};
    bf16x8 ga[4][4][2]; f32x4 hh[4][4];
#define SEQ_LOAD(buf, cc) do { const size_t _it = (size_t)((cc) < 256 ? (cc) : 255) * 16 + head; \
        _Pragma("unroll") for (int mb = 0; mb < 4; ++mb) { \
            _Pragma("unroll") for (int ks = 0; ks < 2; ++ks) ga[buf][mb][ks] = *(const bf16x8*)(GT + _it * 4096 + (size_t)((mb * 2 + ks) * 64 + lane) * 8); \
            hh[buf][mb] = *(const f32x4*)(HT + _it * 4096 + (size_t)((vt * 4 + mb) * 64 + lane) * 4); } } while (0)
    SEQ_LOAD(0, 0); SEQ_LOAD(1, 1); SEQ_LOAD(2, 2); SEQ_LOAD(3, 3);
    for (int c0 = 0; c0 < 256; c0 += 4) {
#pragma unroll
        for (int b = 0; b < 4; ++b) {
            const int c = c0 + b; const size_t item = (size_t)c * 16 + head;
            u32x2 pk[4];
#pragma unroll
            for (int mb = 0; mb < 4; ++mb) { pk[mb].x = cvt_pk_bf16(acc[mb][0], acc[mb][1]); pk[mb].y = cvt_pk_bf16(acc[mb][2], acc[mb][3]);
                *(u32x2*)(S0 + item * 4096 + (vt * 16 + fr) * 64 + mb * 16 + fq * 4) = pk[mb]; }
            u32x4 b0w, b1w; b0w.x = pk[0].x; b0w.y = pk[0].y; b0w.z = pk[1].x; b0w.w = pk[1].y; b1w.x = pk[2].x; b1w.y = pk[2].y; b1w.z = pk[3].x; b1w.w = pk[3].y;
            const bf16x8 b0 = __builtin_bit_cast(bf16x8, b0w), b1 = __builtin_bit_cast(bf16x8, b1w);
#pragma unroll
            for (int mb = 0; mb < 4; ++mb) {
                const f32x4 x = __builtin_amdgcn_mfma_f32_16x16x32_bf16(ga[b][mb][0], b0, hh[b][mb], 0, 0, 0);
                acc[mb] = __builtin_amdgcn_mfma_f32_16x16x32_bf16(ga[b][mb][1], b1, x, 0, 0, 0);
            }
            SEQ_LOAD(b, c + 4);
        }
    }
#undef SEQ_LOAD
}

__device__ __forceinline__ void phase_chunkY(const Params& p, LAS unsigned char* lds) {
    LAS float* Yb = (LAS float*)lds;
    const int tid = threadIdx.x, w = tid >> 6, lane = tid & 63, fr = lane & 15, fq = lane >> 4;
    const int mi = w >> 1, nb = (w & 1) * 2;
    const bf16_t* R = (const bf16_t*)(p.ws + WS_R); const bf16_t* Kk = (const bf16_t*)(p.ws + WS_K); const bf16_t* V = (const bf16_t*)(p.ws + WS_V);
    const bf16_t* G = (const bf16_t*)(p.ws + WS_G); const bf16_t* YC = (const bf16_t*)(p.ws + WS_YC);
    const bf16_t* QE = (const bf16_t*)(p.ws + WS_QE); const bf16_t* YL = (const bf16_t*)(p.ws + WS_YL); const bf16_t* S0 = (const bf16_t*)(p.ws + WS_S0);
    bf16_t* YM = (bf16_t*)(p.ws + WS_YMIX);
    const float* r_k = p.in[15]; const float* gn_w = p.in[16]; const float* gn_b = p.in[17];
    for (int item = blockIdx.x; item < 4096; item += gridDim.x) {
        const int c = item >> 4, h = item & 15;
        const bf16_t* Qp = QE + (size_t)item * 4096; const bf16_t* Sp = S0 + (size_t)item * 4096; const bf16_t* Yp = YL + (size_t)item * 4096;
        __syncthreads();
#pragma unroll
        for (int nn = 0; nn < 2; ++nn) {
            const int ni = nb + nn;
            const u32x2 yw = *(const u32x2*)(Yp + (size_t)((mi * 4 + ni) * 64 + lane) * 4);
            f32x4 acc = (f32x4){lo_bf(yw.x), hi_bf(yw.x), lo_bf(yw.y), hi_bf(yw.y)};
#pragma unroll
            for (int ks = 0; ks < 2; ++ks) {
                const bf16x8 a = *(const bf16x8*)(Qp + (mi * 16 + fr) * 64 + ks * 32 + fq * 8);
                const bf16x8 b = *(const bf16x8*)(Sp + (ni * 16 + fr) * 64 + ks * 32 + fq * 8);
                acc = __builtin_amdgcn_mfma_f32_16x16x32_bf16(a, b, acc, 0, 0, 0);
            }
#pragma unroll
            for (int j = 0; j < 4; ++j) Yb[(mi * 16 + fq * 4 + j) * 68 + ni * 16 + fr] = acc[j];
        }
        __syncthreads();
        const int ch = h * 64 + lane;
        const float gw = gn_w[ch], gb = gn_b[ch];
        const float* BON = (const float*)(p.ws + WS_BON);
#pragma unroll
        for (int tt = 0; tt < 8; ++tt) {
            const int t = w * 8 + tt; const size_t tg = (size_t)c * 64 + t; const size_t o = tg * DR + ch;
            const float y = Yb[t * 68 + lane];
            const float mean = wave_sum_dpp(y) * (1.f / 64.f); const float d = y - mean;
            const float var = wave_sum_dpp(d * d) * (1.f / 64.f);
            const float yn = d * rsqrtf(var + 64e-5f) * gw + gb;
            const float bonus = BON[tg * 16 + h] * bf2f(V[o]);
            YM[tg * D_ + ch] = f2bf((yn + bonus) * bf2f(G[o]));
            YM[tg * D_ + 1024 + ch] = YC[o];
        }
    }
}

__device__ __forceinline__ int f2key(float x) { const int u = __float_as_int(x); return u ^ ((u >> 31) & 0x7fffffff); }
__device__ __forceinline__ float key2f(int k) { return __int_as_float(k ^ ((k >> 31) & 0x7fffffff)); }
template <int CTRL> __device__ __forceinline__ int dpp_i(int v) { return __builtin_amdgcn_update_dpp(v, v, CTRL, 0xf, 0xf, false); }
__device__ __forceinline__ int row_max_i(int v) { v = max(v, dpp_i<0xB1>(v)); v = max(v, dpp_i<0x4E>(v)); v = max(v, dpp_i<0x141>(v)); v = max(v, dpp_i<0x140>(v)); return v; }
__device__ __forceinline__ void phase_topk(const Params& p, unsigned char* shm) {
    float* sc = (float*)shm;
    int* tk = (int*)(sc + 64 * 260);
    const bf16_t* Q = (const bf16_t*)(p.ws + WS_Q); const float* keys = p.in[22];
    int* IDS = (int*)(p.ws + WS_IDS); float* GATES = (float*)(p.ws + WS_GATES);
    const int tid = threadIdx.x, w = tid >> 6, lane = tid & 63, fr = lane & 15, fq = lane >> 4;
    for (int item = blockIdx.x; item < 2048; item += gridDim.x) {
        const int h = item & 7, t0 = (item >> 3) * 64;
        const int c = w >> 2, nb = (w & 3) * 32;
        f32x4 acc[4][2];
#pragma unroll
        for (int m = 0; m < 4; ++m)
#pragma unroll
            for (int n = 0; n < 2; ++n) acc[m][n] = (f32x4){0.f, 0.f, 0.f, 0.f};
        const float* kb = keys + ((size_t)(h * 2 + c) * 128) * 256;
        for (int ks = 0; ks < 8; ++ks) {
            bf16x8 a[4], b[2];
#pragma unroll
            for (int m = 0; m < 4; ++m) a[m] = *(const bf16x8*)(Q + (size_t)(t0 + m * 16 + fr) * 4096 + h * 512 + c * 256 + ks * 32 + fq * 8);
#pragma unroll
            for (int n = 0; n < 2; ++n) { const float4* kp = (const float4*)(kb + (size_t)(nb + n * 16 + fr) * 256 + ks * 32 + fq * 8); const float4 x0 = kp[0], x1 = kp[1];
                u32x4 wv; wv.x = cvt_pk_bf16(x0.x, x0.y); wv.y = cvt_pk_bf16(x0.z, x0.w); wv.z = cvt_pk_bf16(x1.x, x1.y); wv.w = cvt_pk_bf16(x1.z, x1.w);
                b[n] = __builtin_bit_cast(bf16x8, wv); }
#pragma unroll
            for (int m = 0; m < 4; ++m)
#pragma unroll
                for (int n = 0; n < 2; ++n) acc[m][n] = __builtin_amdgcn_mfma_f32_16x16x32_bf16(a[m], b[n], acc[m][n], 0, 0, 0);
        }
        __syncthreads();
#pragma unroll
        for (int m = 0; m < 4; ++m)
#pragma unroll
            for (int n = 0; n < 2; ++n)
#pragma unroll
                for (int j = 0; j < 4; ++j) sc[(m * 16 + fq * 4 + j) * 260 + c * 128 + nb + n * 16 + fr] = acc[m][n][j];
        __syncthreads();
        for (int g = 0; g < 4; ++g) {
            const int L = w * 16 + g * 4 + (lane >> 4); const int tok = L >> 1, cc = L & 1; const int pp = lane & 15;
            int key[8];
#pragma unroll
            for (int i = 0; i < 8; ++i) key[i] = (f2key(sc[tok * 260 + cc * 128 + i * 16 + pp]) & ~127) | (127 - (i * 16 + pp));
            int mykey = 0;
#pragma unroll
            for (int r = 0; r < 16; ++r) {
                const int ml = max(max(max(key[0], key[1]), max(key[2], key[3])), max(max(key[4], key[5]), max(key[6], key[7])));
                const int m = row_max_i(ml);
#pragma unroll
                for (int i = 0; i < 8; ++i) key[i] = (key[i] == m) ? (int)0x80000000 : key[i];
                mykey = (pp == r) ? m : mykey;
            }
            tk[L * 16 + pp] = mykey;
        }
        __syncthreads();
        for (int g = 0; g < 2; ++g) {
            const int tok = w * 8 + g * 4 + (lane >> 4); const int pp = lane & 15;
            const float s1 = key2f(tk[(tok * 2) * 16 + pp] & ~127);
            int key[16];
#pragma unroll
            for (int j = 0; j < 16; ++j) { const float s2 = key2f(tk[(tok * 2 + 1) * 16 + j] & ~127); key[j] = (f2key(s1 + s2) & ~255) | (255 - (pp * 16 + j)); }
            int mykey = 0;
#pragma unroll
            for (int r = 0; r < 16; ++r) {
                int ml = max(max(max(key[0], key[1]), max(key[2], key[3])), max(max(key[4], key[5]), max(key[6], key[7])));
                ml = max(ml, max(max(max(key[8], key[9]), max(key[10], key[11])), max(max(key[12], key[13]), max(key[14], key[15]))));
                const int m = row_max_i(ml);
#pragma unroll
                for (int j = 0; j < 16; ++j) key[j] = (key[j] == m) ? (int)0x80000000 : key[j];
                mykey = (pp == r) ? m : mykey;
            }
            const int ci = 255 - (mykey & 255); const float cs = key2f(mykey & ~255);
            const int e1 = 127 - (tk[(tok * 2) * 16 + (ci >> 4)] & 127), e2 = 127 - (tk[(tok * 2 + 1) * 16 + (ci & 15)] & 127);
            const float mx = __shfl(cs, lane & 48);
            const float e = __expf(cs - mx);
            float sum = e; sum += dpp_f<0xB1, 0xf>(sum); sum += dpp_f<0x4E, 0xf>(sum); sum += dpp_f<0x141, 0xf>(sum); sum += dpp_f<0x140, 0xf>(sum);
            IDS[(size_t)(t0 + tok) * 128 + h * 16 + pp] = (e1 * 128 + e2) & 16383;
            GATES[(size_t)(t0 + tok) * 128 + h * 16 + pp] = e / sum;
        }
    }
}

constexpr float U8_SCALE = 64.f, V8_SCALE = 32.f;
__device__ __forceinline__ float gelu_fast(float x) { const float u = 0.7978845608028654f * (x + 0.044715f * x * x * x); return x / (1.0f + __expf(-2.0f * u)); }
__device__ __forceinline__ void phase_gather(const Params& p, unsigned char* shm) {
    const bf16_t* H2 = (const bf16_t*)(p.ws + WS_H2); const float* X1 = (const float*)(p.ws + WS_X1);
    const unsigned char* U8 = p.ws + WS_UB; const unsigned char* V8 = p.ws + WS_VB;
    const int* IDS = (const int*)(p.ws + WS_IDS); const float* GATES = (const float*)(p.ws + WS_GATES);
    const float* nf = p.in[25];
    const int tid = threadIdx.x, w = tid >> 6, lane = tid & 63;
    for (int t = blockIdx.x * 8 + w; t < S_; t += gridDim.x * 8) {
        f32x2 hp[16];
#pragma unroll
        for (int q = 0; q < 2; ++q)
#pragma unroll
            for (int hh = 0; hh < 2; ++hh) { const u32x4 hv = *(const u32x4*)(H2 + (size_t)t * D_ + q * 1024 + lane * 16 + hh * 8);
#pragma unroll
                for (int i = 0; i < 4; ++i) hp[q * 8 + hh * 4 + i] = (f32x2){lo_bf(hv[i]), hi_bf(hv[i])}; }
        const int id0 = IDS[(size_t)t * 128 + lane], id1 = IDS[(size_t)t * 128 + 64 + lane];
        const float gt0 = GATES[(size_t)t * 128 + lane], gt1 = GATES[(size_t)t * 128 + 64 + lane];
        f32x2 op[16];
#pragma unroll
        for (int i = 0; i < 16; ++i) op[i] = (f32x2){0.f, 0.f};
        u32x4 ua[4][2], ub[4][2], vb[4][2];
#define G_LOADU(dst, grp) do { _Pragma("unroll") for (int j = 0; j < 4; ++j) { const int e = (grp) * 4 + j; const int id = __builtin_amdgcn_readlane(e < 64 ? id0 : id1, e & 63); \
            const unsigned char* ur = U8 + (size_t)id * D_ + lane * 16; dst[j][0] = *(const u32x4*)ur; dst[j][1] = *(const u32x4*)(ur + 1024); } } while (0)
#define G_LOADV(grp) do { _Pragma("unroll") for (int j = 0; j < 4; ++j) { const int e = (grp) * 4 + j; const int id = __builtin_amdgcn_readlane(e < 64 ? id0 : id1, e & 63); \
            const unsigned char* vr = V8 + (size_t)id * D_ + lane * 16; vb[j][0] = *(const u32x4*)vr; vb[j][1] = *(const u32x4*)(vr + 1024); } } while (0)
#define G_BODY(cur, nxt, grp) do { \
            G_LOADV(grp); \
            G_LOADU(nxt, ((grp) + 1 < 32 ? (grp) + 1 : 31)); \
            float dsel = 0.f; \
            _Pragma("unroll") for (int j = 0; j < 4; ++j) { f32x2 d2 = (f32x2){0.f, 0.f}; \
                _Pragma("unroll") for (int q = 0; q < 2; ++q) _Pragma("unroll") for (int i = 0; i < 4; ++i) { \
                    d2 += __builtin_amdgcn_cvt_pk_f32_fp8((int)cur[j][q][i], false) * hp[q * 8 + 2 * i]; d2 += __builtin_amdgcn_cvt_pk_f32_fp8((int)cur[j][q][i], true) * hp[q * 8 + 2 * i + 1]; } \
                const float d = wave_sum_dpp(d2.x + d2.y); dsel = (lane == j) ? d : dsel; } \
            const float av = gelu_fast(dsel * (1.f / U8_SCALE)) * (1.f / V8_SCALE); \
            _Pragma("unroll") for (int j = 0; j < 4; ++j) { const int e = (grp) * 4 + j; \
                const float a = __int_as_float(__builtin_amdgcn_readlane(__float_as_int(av), j)) * __int_as_float(__builtin_amdgcn_readlane(__float_as_int(e < 64 ? gt0 : gt1), e & 63)); \
                const f32x2 a2 = (f32x2){a, a}; \
                _Pragma("unroll") for (int q = 0; q < 2; ++q) _Pragma("unroll") for (int i = 0; i < 4; ++i) { \
                    op[q * 8 + 2 * i] += a2 * __builtin_amdgcn_cvt_pk_f32_fp8((int)vb[j][q][i], false); op[q * 8 + 2 * i + 1] += a2 * __builtin_amdgcn_cvt_pk_f32_fp8((int)vb[j][q][i], true); } } \
        } while (0)
        G_LOADU(ua, 0);
#pragma unroll 1
        for (int g2 = 0; g2 < 32; g2 += 2) { G_BODY(ua, ub, g2); G_BODY(ub, ua, g2 + 1); }
#undef G_LOADU
#undef G_LOADV
#undef G_BODY
        float ss = 0.f; float4 xs[8];
#pragma unroll
        for (int q = 0; q < 2; ++q)
#pragma unroll
            for (int i = 0; i < 4; ++i) { float4 x = *(const float4*)(X1 + (size_t)t * D_ + q * 1024 + lane * 16 + 4 * i);
                x.x += op[q * 8 + 2 * i].x; x.y += op[q * 8 + 2 * i].y; x.z += op[q * 8 + 2 * i + 1].x; x.w += op[q * 8 + 2 * i + 1].y;
                ss += x.x * x.x + x.y * x.y + x.z * x.z + x.w * x.w; xs[q * 4 + i] = x; }
        ss = wave_sum_dpp(ss);
        const float scl = rsqrtf(ss * (1.f / 2048.f) + 1e-6f);
#pragma unroll
        for (int q = 0; q < 2; ++q)
#pragma unroll
            for (int i = 0; i < 4; ++i) { const float4 g = *(const float4*)(nf + q * 1024 + lane * 16 + 4 * i); const float4 x = xs[q * 4 + i];
                *(float4*)(p.out + (size_t)t * D_ + q * 1024 + lane * 16 + 4 * i) = make_float4(x.x * scl * g.x, x.y * scl * g.y, x.z * scl * g.z, x.w * scl * g.w); }
    }
}

#define XB_TMO      128
#define XB_XCNT(j)  (256  + 64 * (j))
#define XB_XSUB(j)  (1280 + 64 * (j))
#define XB_XGEN(j)  (2304 + 64 * (j))
#define XB_TOP      3328
#define XB_TOPGEN   3392
#define XCD_BAR_WORDS 3456
#define XB_SPIN_CAP (1u << 18)
__device__ __forceinline__ unsigned xb_ld(unsigned* p)              { return __hip_atomic_load(p, __ATOMIC_RELAXED, __HIP_MEMORY_SCOPE_AGENT); }
__device__ __forceinline__ unsigned xb_add(unsigned* p, unsigned v) { return __hip_atomic_fetch_add(p, v, __ATOMIC_RELAXED, __HIP_MEMORY_SCOPE_AGENT); }
__device__ __forceinline__ unsigned xb_xcc_id() { return (unsigned)__builtin_amdgcn_s_getreg((3 << 11) | 20) & 0xFu; }
#define XB_SPIN(cond, bar) do { unsigned _sp = 0; while (cond) { __builtin_amdgcn_s_sleep(1); \
    if ((++_sp & 255u) == 0u) { if (xb_ld(&(bar)[XB_TMO])) break; if (_sp > XB_SPIN_CAP) { atomicAdd(&(bar)[XB_TMO], 1u); break; } } } } while (0)
struct XcdBarrier { unsigned* bar; unsigned x; volatile LAS unsigned* st; };
__device__ __forceinline__ XcdBarrier xcd_barrier_post(unsigned* bar, volatile LAS unsigned* st) {
    XcdBarrier b; b.bar = bar; b.x = xb_xcc_id(); b.st = st;
    if (threadIdx.x == 0) (void)xb_add(&bar[XB_XCNT(b.x)], 1u);
    return b;
}
__device__ __forceinline__ void xcd_barrier_complete(unsigned* bar, unsigned x, unsigned& nloc, unsigned& nx) {
    const unsigned G = gridDim.x * gridDim.y * gridDim.z;
    unsigned sum, cnt, mine, sp = 0u;
    for (;;) {
        sum = 0u; cnt = 0u; mine = 0u;
#pragma unroll
        for (unsigned j = 0; j < 16; ++j) { const unsigned c = xb_ld(&bar[XB_XCNT(j)]); sum += c; cnt += (c > 0u) ? 1u : 0u; mine = (j == x) ? c : mine; }
        if (sum == G) break;
        __builtin_amdgcn_s_sleep(1);
        if ((++sp & 255u) == 0u) { if (xb_ld(&bar[XB_TMO])) break; if (sp > XB_SPIN_CAP) { atomicAdd(&bar[XB_TMO], 1u); break; } }
    }
    nloc = mine > 0u ? mine : 1u; nx = cnt > 0u ? cnt : 1u;
}
__device__ __forceinline__ void xcd_barrier(const XcdBarrier& b) {
    asm volatile("s_waitcnt vmcnt(0)" ::: "memory");
    __syncthreads();
    if (threadIdx.x == 0) {
        unsigned* bar = b.bar;
        __builtin_amdgcn_s_waitcnt(0);
        unsigned nloc = b.st[0], nx = b.st[1];
        if (nloc == 0u) { xcd_barrier_complete(bar, b.x, nloc, nx); b.st[0] = nloc; b.st[1] = nx; }
        const unsigned old = xb_add(&bar[XB_XSUB(b.x)], 1u);
        const unsigned gen = old / nloc;
        if (old + 1u == (gen + 1u) * nloc) {
            __builtin_amdgcn_fence(__ATOMIC_RELEASE, "agent");
            asm volatile("s_waitcnt vmcnt(0)" ::: "memory");
            const unsigned og = xb_add(&bar[XB_TOP], 1u);
            const unsigned tg = og / nx;
            if (og + 1u == (tg + 1u) * nx) xb_add(&bar[XB_TOPGEN], 1u);
            else XB_SPIN(xb_ld(&bar[XB_TOPGEN]) == tg, bar);
            __builtin_amdgcn_fence(__ATOMIC_ACQUIRE, "agent");
            xb_add(&bar[XB_XGEN(b.x)], 1u);
            asm volatile("s_waitcnt vmcnt(0)" ::: "memory");
        } else {
            XB_SPIN(xb_ld(&bar[XB_XGEN(b.x)]) == gen, bar);
            __builtin_amdgcn_fence(__ATOMIC_ACQUIRE, "agent");
            asm volatile("s_waitcnt vmcnt(0)" ::: "memory");
        }
    }
    __syncthreads();
}

__global__ void __launch_bounds__(512, 2) mega(Params p) {
    extern __shared__ __attribute__((aligned(16))) unsigned char shm[];
    cg::grid_group grid = cg::this_grid();
    LAS unsigned char* lds = (LAS unsigned char*)shm;
    volatile LAS unsigned* bst = (volatile LAS unsigned*)(lds + LDS_BYTES - 16);
    if (threadIdx.x == 0) { bst[0] = 0u; bst[1] = 0u; }
    __syncthreads();
    const XcdBarrier xbar = xcd_barrier_post((unsigned*)(p.ws + WS_BAR), bst);
    if (p.ph_hi > 1000) grid.sync();
    const int lo = p.ph_lo, hi = p.ph_hi;
#define IN(k) (lo <= (k) && (k) < hi)
#define REP(k) for (int _r = 0; _r < ((k) == DUP_PHASE ? 2 : 1); ++_r)
#define SEAM(k) do { if (IN(k) && IN((k) + 1)) xcd_barrier(xbar); } while (0)
    if (IN(0)) REP(0) { if (_r) xcd_barrier(xbar); phase0(p, shm); }
    SEAM(0);
    if (IN(1)) REP(1) { if (_r) xcd_barrier(xbar);
        pg8::Gemm g{(const bf16_t*)(p.ws + WS_H), (const bf16_t*)(p.ws + WS_WB1), S_, NAUG, 2048};
        pg8::StaticOrder so; so.init(g.M, g.N, (int)gridDim.x, (int)blockIdx.x);
        pg8::EpiBf16 E{(bf16_t*)(p.ws + WS_PROJ), NAUG};
        pg8::gemm_phase(lds, g, so, E);
    }
    SEAM(1);
    if (IN(2)) REP(2) { if (_r) xcd_barrier(xbar);
        phase_prepM(p, lds);
        phase_prepE(p);
    }
    SEAM(2);
    if (IN(3)) REP(3) { if (_r) xcd_barrier(xbar); phase_chunkA(p, lds); }
    SEAM(3);
    if (IN(4)) REP(4) { if (_r) xcd_barrier(xbar); if (blockIdx.x < 64) phase_seq(p);
        else { const int bid = blockIdx.x - 64, nblk = gridDim.x - 64;
            convert_fp8(p.in[23], p.ws + WS_UB, (size_t)16384 * 2048, U8_SCALE, bid, nblk);
            convert_fp8(p.in[24], p.ws + WS_VB, (size_t)16384 * 2048, V8_SCALE, bid, nblk);
            transpose_convert(p.in[21], 2048, 4096, (bf16_t*)(p.ws + WS_WQT), (float*)shm, bid, nblk);
            transpose_convert(p.in[19], 2048, 2048, (bf16_t*)(p.ws + WS_WOT), (float*)shm, bid, nblk); } }
    SEAM(4);
    if (IN(5)) REP(5) { if (_r) xcd_barrier(xbar); phase_chunkY(p, lds); }
    SEAM(5);
    if (IN(6)) REP(6) { if (_r) xcd_barrier(xbar);
        pg8::Gemm g{(const bf16_t*)(p.ws + WS_YMIX), (const bf16_t*)(p.ws + WS_WOT), S_, 2048, 2048};
        pg8::StaticOrder so; so.init(g.M, g.N, (int)gridDim.x, (int)blockIdx.x);
        pg8::EpiResF32 E{(float*)(p.ws + WS_X1), p.in[0], 2048};
        pg8::gemm_phase(lds, g, so, E);
    }
    SEAM(6);
    if (IN(7)) REP(7) { if (_r) xcd_barrier(xbar);
        rmsnorm_rows((const float*)(p.ws + WS_X1), p.in[20], (bf16_t*)(p.ws + WS_H2));
    }
    SEAM(7);
    if (IN(8)) REP(8) { if (_r) xcd_barrier(xbar);
        pg8::Gemm g{(const bf16_t*)(p.ws + WS_H2), (const bf16_t*)(p.ws + WS_WQT), S_, 4096, 2048};
        pg8::StaticOrder so; so.init(g.M, g.N, (int)gridDim.x, (int)blockIdx.x);
        pg8::EpiBf16 E{(bf16_t*)(p.ws + WS_Q), 4096};
        pg8::gemm_phase(lds, g, so, E);
    }
    SEAM(8);
    if (IN(9)) REP(9) { if (_r) xcd_barrier(xbar); phase_topk(p, shm); }
    SEAM(9);
    if (IN(10)) REP(10) { if (_r) xcd_barrier(xbar); phase_gather(p, shm); }
#undef IN
#undef REP
#undef SEAM
}

extern "C" void kernel_launch(void* const* d_in, const int* in_sizes, int n_in, void* d_out, int out_size, void* d_ws, size_t ws_size, hipStream_t stream) {
    static int grid_blocks = 0;
    if (grid_blocks == 0) {
        if (n_in != 26 || ws_size < WS_NEED) { fprintf(stderr, "kernel_launch: unexpected n_in %d / ws_size %zu\n", n_in, ws_size); grid_blocks = -1; return; }
        int dev = 0, cus = 0, per_cu = 0;
        (void)hipGetDevice(&dev);
        (void)hipDeviceGetAttribute(&cus, hipDeviceAttributeMultiprocessorCount, dev);
        (void)hipFuncSetAttribute((const void*)mega, hipFuncAttributeMaxDynamicSharedMemorySize, LDS_BYTES);
        (void)hipOccupancyMaxActiveBlocksPerMultiprocessor(&per_cu, (const void*)mega, 512, LDS_BYTES);
        if (per_cu < 1) { fprintf(stderr, "kernel_launch: occupancy query says %d blocks/CU\n", per_cu); per_cu = 1; }
        grid_blocks = cus * per_cu;
        fprintf(stderr, "kernel_launch: cus %d per_cu %d grid %d\n", cus, per_cu, grid_blocks);
    }
    if (grid_blocks < 0) return;
    Params p{};
    for (int i = 0; i < 26; ++i) p.in[i] = (const float*)d_in[i];
    p.out = (float*)d_out; p.ws = (unsigned char*)d_ws;
#if MULTI_LAUNCH
    for (int ph = 0; ph < NPHASE; ++ph) {
        p.ph_lo = ph; p.ph_hi = ph + 1;
        hipLaunchKernelGGL(mega, dim3(grid_blocks), dim3(512), LDS_BYTES, stream, p);
    }
#else
    p.ph_lo = 0; p.ph_hi = NPHASE;
    if (hipMemsetAsync((unsigned char*)d_ws + WS_BAR, 0, XCD_BAR_WORDS * 4, stream) != hipSuccess) fprintf(stderr, "kernel_launch: barrier memset failed\n");
    void* args[] = {&p};
    hipError_t e = hipLaunchCooperativeKernel((const void*)mega, dim3(grid_blocks), dim3(512), args, LDS_BYTES, stream);
    if (e != hipSuccess) fprintf(stderr, "cooperative launch failed: %s (grid %d)\n", hipGetErrorString(e), grid_blocks);
#endif
}
```

```cpp
#include <hip/hip_runtime.h>
#include <hip/hip_cooperative_groups.h>
#include <cstdio>
namespace cg = cooperative_groups;

#ifndef DUP_PHASE
#define DUP_PHASE -1
#endif
#ifndef MULTI_LAUNCH
#define MULTI_LAUNCH 0
#endif

#define LAS __attribute__((address_space(3)))
typedef unsigned short bf16_t;
typedef short bf16x8 __attribute__((ext_vector_type(8)));
typedef float f32x4 __attribute__((ext_vector_type(4)));
typedef float f32x2 __attribute__((ext_vector_type(2)));
typedef unsigned u32x4 __attribute__((ext_vector_type(4)));
typedef unsigned u32x2 __attribute__((ext_vector_type(2)));

constexpr int S_ = 16384, D_ = 2048, DR = 1024, NAUG = 6912;
constexpr size_t MiB = 1ull << 20;
constexpr size_t WS_PROJ = 0, WS_H = 216 * MiB, WS_WB1 = 280 * MiB, WS_WQT = 280 * MiB, WS_WOT = 296 * MiB;
constexpr size_t WS_R = 307 * MiB, WS_K = 339 * MiB, WS_V = 371 * MiB, WS_KK = 403 * MiB, WS_A = 435 * MiB, WS_LW = 467 * MiB;
constexpr size_t WS_G = 216 * MiB, WS_YC = 248 * MiB, WS_YMIX = 307 * MiB, WS_X1 = 0, WS_H2 = 128 * MiB, WS_Q = 307 * MiB;
constexpr size_t WS_GT = 0, WS_HT = 32 * MiB, WS_QE = 96 * MiB, WS_YL = 128 * MiB, WS_S0 = 160 * MiB;
constexpr size_t WS_IDS = 192 * MiB, WS_GATES = 200 * MiB, WS_UB = 467 * MiB, WS_VB = 435 * MiB, WS_BON = 500 * MiB, WS_BAR = 502 * MiB, WS_KEYB = 503 * MiB, WS_NEED = 504 * MiB;
constexpr size_t WS_W2T = 499 * MiB, WS_A2T = WS_W2T + 131072, WS_G2T = WS_A2T + 131072;
constexpr int TLD = 72, TSLOT = 64 * TLD * 2;
constexpr int LDS_BYTES = 16 * TSLOT + 2048 + 256 + 16;
constexpr int NPHASE = 11;

struct Params {
    const float* in[26];
    float* out;
    unsigned char* ws;
    int ph_lo, ph_hi;
};

__device__ __forceinline__ float bf2f(bf16_t b) { return __uint_as_float(((unsigned)b) << 16); }
__device__ __forceinline__ bf16_t f2bf(float f) { unsigned u = __float_as_uint(f); u += 0x7FFFu + ((u >> 16) & 1u); return (bf16_t)(u >> 16); }
typedef __bf16 bf16v2_t __attribute__((ext_vector_type(2)));
__device__ __forceinline__ unsigned cvt_pk_bf16(float lo, float hi) { const f32x2 v = {lo, hi}; const bf16v2_t r = __builtin_convertvector(v, bf16v2_t); return __builtin_bit_cast(unsigned, r); }
__device__ __forceinline__ u32x4 pack8(const float* f) { u32x4 w; w.x = cvt_pk_bf16(f[0], f[1]); w.y = cvt_pk_bf16(f[2], f[3]); w.z = cvt_pk_bf16(f[4], f[5]); w.w = cvt_pk_bf16(f[6], f[7]); return w; }
__device__ __forceinline__ float lo_bf(unsigned w) { return __uint_as_float(w << 16); }
__device__ __forceinline__ float hi_bf(unsigned w) { return __uint_as_float(w & 0xffff0000u); }
__device__ __forceinline__ void unpack8(const u32x4 v, float* f) {
#pragma unroll
    for (int i = 0; i < 4; ++i) { f[2 * i] = lo_bf(v[i]); f[2 * i + 1] = hi_bf(v[i]); }
}
__device__ __forceinline__ float wave_sum(float v) {
#pragma unroll
    for (int o = 32; o; o >>= 1) v += __shfl_xor(v, o);
    return v;
}
template <int CTRL, int RM> __device__ __forceinline__ float dpp_f(float v) { return __int_as_float(__builtin_amdgcn_update_dpp(0, __float_as_int(v), CTRL, RM, 0xf, false)); }
__device__ __forceinline__ float wave_sum_dpp(float v) {
    v += dpp_f<0xB1, 0xf>(v); v += dpp_f<0x4E, 0xf>(v); v += dpp_f<0x141, 0xf>(v); v += dpp_f<0x140, 0xf>(v);
    v += dpp_f<0x142, 0xa>(v); v += dpp_f<0x143, 0xc>(v);
    return __int_as_float(__builtin_amdgcn_readlane(__float_as_int(v), 63));
}
__device__ __forceinline__ float wave_max(float v) {
#pragma unroll
    for (int o = 32; o; o >>= 1) v = fmaxf(v, __shfl_xor(v, o));
    return v;
}
__device__ __forceinline__ float sigmoidf_(float x) { return 1.0f / (1.0f + __expf(-x)); }
__device__ __forceinline__ float gelu_tanh(float x) { float u = 0.7978845608028654f * (x + 0.044715f * x * x * x); return 0.5f * x * (1.0f + tanhf(u)); }

namespace pg8 {
constexpr int BM = 256, BK = 64, HALF = 128, HTB = HALF * BK * 2, STAGE_BYTES = 8 * HTB, NXCD = 8, WGM = 8;
__device__ __forceinline__ int lds_byte(int r, int c) { const int st = (r >> 4) * 2 + (c >> 5), rr = r & 15, cc = c & 31, ob = rr * 64 + cc * 2; return st * 1024 + (ob ^ (((ob >> 9) & 1) << 5)); }
__device__ __forceinline__ void stage_rc(int b, int& R, int& C) { const int st = b / 1024, sb = b % 1024, swz = sb ^ (((sb >> 9) & 1) << 5); R = (st >> 1) * 16 + swz / 64; C = (st & 1) * 32 + (swz % 64) / 2; }
__device__ __forceinline__ int perm32(int rho) { const int n = rho >> 4, i = rho & 15; return 8 * (i >> 2) + 4 * n + (i & 3); }
struct Unit { int pm, pn; };
struct Gemm { const bf16_t* A; const bf16_t* Bt; int M, N, K; };
struct StaticOrder {
    int nM, nN, nwg, G, c;
    __device__ void init(int M, int N, int G_, int c_) { nM = M / BM; nN = N / BM; nwg = nM * nN; G = G_; c = c_; }
    __device__ bool next(int i, Unit& u) const {
        const long L = (long)i * G + c; if (L >= nwg) return false;
        int wgid = (int)L; { const int q = nwg / NXCD, r = nwg % NXCD, xcd = wgid % NXCD, off = wgid / NXCD; wgid = (xcd < r ? xcd * (q + 1) : r * (q + 1) + (xcd - r) * q) + off; }
        const int nig = WGM * nN, gid = wgid / nig, fm = gid * WGM, gsz = (nM - fm) < WGM ? (nM - fm) : WGM;
        u.pm = fm + ((wgid % nig) % gsz); u.pn = (wgid % nig) / gsz; return true;
    }
    __device__ __forceinline__ void a_ready(const Unit&) const {}
    __device__ __forceinline__ void done(const Unit&) const {}
};
struct EpiResF32 {
    static constexpr bool PERM = false;
    float* C; const float* Res; int ldc;
    __device__ __forceinline__ void operator()(const f32x4 (&acc)[2][2][4][2], const Unit& u, int wr, int wc, int fr, int fq) const {
        const int row0 = u.pm * BM + wr * 64 + fr, col0 = u.pn * BM + wc * 32 + 4 * fq;
#pragma unroll
        for (int ai = 0; ai < 2; ++ai)
#pragma unroll
            for (int m = 0; m < 4; ++m) { const size_t ro = (size_t)(row0 + ai * HALF + m * 16) * ldc + col0;
#pragma unroll
                for (int bj = 0; bj < 2; ++bj)
#pragma unroll
                    for (int n = 0; n < 2; ++n) { const f32x4 rs = *(const f32x4*)(Res + ro + bj * HALF + n * 16); *(f32x4*)(C + ro + bj * HALF + n * 16) = acc[ai][bj][m][n] + rs; } }
    }
};
struct EpiBf16 {
    static constexpr bool PERM = true;
    bf16_t* O; int ldc;
    __device__ __forceinline__ void operator()(const f32x4 (&acc)[2][2][4][2], const Unit& u, int wr, int wc, int fr, int fq) const {
        const int row0 = u.pm * BM + wr * 64 + fr; const int col0 = u.pn * BM + wc * 32 + 8 * fq;
#pragma unroll
        for (int ai = 0; ai < 2; ++ai)
#pragma unroll
            for (int m = 0; m < 4; ++m) { bf16_t* rowp = O + (size_t)(row0 + ai * HALF + m * 16) * ldc + col0;
#pragma unroll
                for (int bj = 0; bj < 2; ++bj) { const f32x4 v0 = acc[ai][bj][m][0], v1 = acc[ai][bj][m][1];
                    u32x4 w; w.x = cvt_pk_bf16(v0[0], v0[1]); w.y = cvt_pk_bf16(v0[2], v0[3]); w.z = cvt_pk_bf16(v1[0], v1[1]); w.w = cvt_pk_bf16(v1[2], v1[3]);
                    *(u32x4*)(rowp + bj * HALF) = w; } }
    }
};

template <class Epi, class Sched>
__device__ __forceinline__ void gemm_phase(LAS unsigned char* lds, const Gemm g, const Sched& S, const Epi& E) {
    const int tid = threadIdx.x, wid = __builtin_amdgcn_readfirstlane(tid >> 6), lane = tid & 63, wr = wid >> 2, wc = wid & 3, fr = lane & 15, fq = lane >> 4;
    const int K = g.K, nt = K / BK;
    unsigned voffA[2], voffB[2];
#pragma unroll
    for (int i = 0; i < 2; ++i) { int R, C; stage_rc(tid * 16 + i * 8192, R, C); const int Rb = Epi::PERM ? ((R & ~31) + perm32(R & 31)) : R;
        voffA[i] = (unsigned)(R * K + C) * 2u; voffB[i] = (unsigned)(Rb * K + C) * 2u; }
    const size_t kstep = (size_t)(BK * 2);
    const size_t hstep = (size_t)HALF * K * 2;
    const size_t tstep = 2 * hstep;
    const unsigned ldsw = (unsigned)wid * 1024u;
    const int aoff = lds_byte(wr * 64 + fr, fq * 8), boff = lds_byte(wc * 32 + fr, fq * 8);
#define PG8_SA(b, h) (((b) * 2 + (h)) * HTB)
#define PG8_SB(b, h) ((4 + (b) * 2 + (h)) * HTB)
#define PG8_STAGE(bufoff, gbase, voff) do { _Pragma("unroll") for (int _i = 0; _i < 2; ++_i) \
        __builtin_amdgcn_global_load_lds((const unsigned*)((const char*)(gbase) + (voff)[_i]), (LAS unsigned*)(lds + (bufoff) + ldsw + _i * 8192), 16, 0, 0); } while (0)
#define PG8_LDA(dst, b, h) do { _Pragma("unroll") for (int m = 0; m < 4; ++m) _Pragma("unroll") for (int k = 0; k < 2; ++k) dst[m][k] = *(const LAS bf16x8*)(lds + PG8_SA(b, h) + aoff + m * 2048 + k * 1024); } while (0)
#define PG8_LDB(dst, b, h) do { _Pragma("unroll") for (int n = 0; n < 2; ++n) _Pragma("unroll") for (int k = 0; k < 2; ++k) dst[n][k] = *(const LAS bf16x8*)(lds + PG8_SB(b, h) + boff + n * 2048 + k * 1024); } while (0)
#define PG8_MMA(ai, bj, At, Bt) do { __builtin_amdgcn_s_setprio(1); _Pragma("unroll") for (int m = 0; m < 4; ++m) _Pragma("unroll") for (int n = 0; n < 2; ++n) _Pragma("unroll") for (int k = 0; k < 2; ++k) \
        acc[ai][bj][m][n] = __builtin_amdgcn_mfma_f32_16x16x32_bf16(Bt[n][k], At[m][k], acc[ai][bj][m][n], 0, 0, 0); __builtin_amdgcn_s_setprio(0); } while (0)
#define PG8_WAIT_V(n) asm volatile("s_waitcnt vmcnt(" #n ")" ::: "memory")
#define PG8_WAIT_L(n) asm volatile("s_waitcnt lgkmcnt(" #n ")" ::: "memory")
#define PG8_BAR __builtin_amdgcn_s_barrier()
#define PG8_SCHED __builtin_amdgcn_sched_barrier(0)
    Unit cur, nxt; int ui = 0;
    if (!S.next(0, cur)) return;
    f32x4 acc[2][2][4][2];
#pragma unroll
    for (int a = 0; a < 2; ++a)
#pragma unroll
        for (int b = 0; b < 2; ++b)
#pragma unroll
            for (int m = 0; m < 4; ++m)
#pragma unroll
                for (int n = 0; n < 2; ++n) acc[a][b][m][n] = (f32x4){0.f, 0.f, 0.f, 0.f};
    bf16x8 At[4][2], B0[2][2], B1[2][2];
    const char* cA = (const char*)g.A + (size_t)cur.pm * tstep; const char* cB = (const char*)g.Bt + (size_t)cur.pn * tstep;
    S.a_ready(cur);
    PG8_STAGE(PG8_SB(0, 0), cB, voffB); PG8_STAGE(PG8_SA(0, 0), cA, voffA); PG8_STAGE(PG8_SB(0, 1), cB + hstep, voffB); PG8_STAGE(PG8_SA(0, 1), cA + hstep, voffA);
    if (wr == 1) PG8_BAR;
    PG8_WAIT_V(4); PG8_BAR;
    PG8_STAGE(PG8_SB(1, 0), cB + kstep, voffB); PG8_STAGE(PG8_SA(1, 0), cA + kstep, voffA); PG8_STAGE(PG8_SB(1, 1), cB + hstep + kstep, voffB);
    PG8_WAIT_V(6); PG8_BAR;
    for (;;) {
        const bool has_next = S.next(ui + 1, nxt);
        const char* nA = has_next ? (const char*)g.A + (size_t)nxt.pm * tstep : cA; const char* nB = has_next ? (const char*)g.Bt + (size_t)nxt.pn * tstep : cB;
        for (int t = 0; t < nt; t += 2) {
            const bool last = (t == nt - 2);
            const char* a1 = cA + (size_t)(t + 1) * kstep;
            const char* a2 = last ? nA : cA + (size_t)(t + 2) * kstep; const char* b2 = last ? nB : cB + (size_t)(t + 2) * kstep;
            const char* a3 = a2 + kstep; const char* b3 = b2 + kstep;
            if (last && has_next) S.a_ready(nxt);
            PG8_LDB(B0, 0, 0); PG8_SCHED; PG8_LDA(At, 0, 0); PG8_STAGE(PG8_SA(1, 1), a1 + hstep, voffA);
            PG8_WAIT_L(8); PG8_BAR; PG8_WAIT_L(0); PG8_MMA(0, 0, At, B0); PG8_BAR; PG8_SCHED;
            PG8_LDB(B1, 0, 1); PG8_STAGE(PG8_SB(0, 0), b2, voffB);
            PG8_BAR; PG8_WAIT_L(0); PG8_MMA(0, 1, At, B1); PG8_BAR;
            PG8_LDA(At, 0, 1); PG8_STAGE(PG8_SA(0, 0), a2, voffA);
            PG8_BAR; PG8_WAIT_L(0); PG8_MMA(1, 0, At, B0); PG8_BAR; PG8_SCHED;
            PG8_STAGE(PG8_SB(0, 1), b2 + hstep, voffB);
            PG8_WAIT_V(6); PG8_BAR; PG8_MMA(1, 1, At, B1); PG8_BAR;
            PG8_LDB(B0, 1, 0); PG8_SCHED; PG8_LDA(At, 1, 0); PG8_STAGE(PG8_SA(0, 1), a2 + hstep, voffA);
            PG8_WAIT_L(8); PG8_BAR; PG8_WAIT_L(0); PG8_MMA(0, 0, At, B0); PG8_BAR; PG8_SCHED;
            PG8_LDB(B1, 1, 1); PG8_STAGE(PG8_SB(1, 0), b3, voffB);
            PG8_BAR; PG8_WAIT_L(0); PG8_MMA(0, 1, At, B1); PG8_BAR;
            PG8_LDA(At, 1, 1); PG8_STAGE(PG8_SA(1, 0), a3, voffA);
            PG8_BAR; PG8_WAIT_L(0); PG8_MMA(1, 0, At, B0); PG8_BAR; PG8_SCHED;
            PG8_STAGE(PG8_SB(1, 1), b3 + hstep, voffB);
            PG8_WAIT_V(6); PG8_BAR; PG8_MMA(1, 1, At, B1); PG8_BAR;
        }
        E(acc, cur, wr, wc, fr, fq); S.done(cur);
        if (!has_next) break;
#pragma unroll
        for (int a = 0; a < 2; ++a)
#pragma unroll
            for (int b = 0; b < 2; ++b)
#pragma unroll
                for (int m = 0; m < 4; ++m)
#pragma unroll
                    for (int n = 0; n < 2; ++n) acc[a][b][m][n] = (f32x4){0.f, 0.f, 0.f, 0.f};
        cur = nxt; cA = nA; cB = nB; ++ui;
    }
    PG8_WAIT_V(0);
    if (wr == 0) PG8_BAR;
    PG8_BAR;
#undef PG8_SA
#undef PG8_SB
#undef PG8_STAGE
#undef PG8_LDA
#undef PG8_LDB
#undef PG8_MMA
#undef PG8_WAIT_V
#undef PG8_WAIT_L
#undef PG8_BAR
#undef PG8_SCHED
}
}

__device__ __forceinline__ void rmsnorm_rows(const float* X, const float* gain, bf16_t* H) {
    const int wave = threadIdx.x >> 6, lane = threadIdx.x & 63;
    for (int row = blockIdx.x * 8 + wave; row < S_; row += gridDim.x * 8) {
        const float4* xr = (const float4*)(X + (size_t)row * D_);
        float4 v[8]; float ss = 0.f;
#pragma unroll
        for (int i = 0; i < 8; ++i) { v[i] = xr[i * 64 + lane]; ss += v[i].x * v[i].x + v[i].y * v[i].y + v[i].z * v[i].z + v[i].w * v[i].w; }
        ss = wave_sum(ss);
        const float sc = rsqrtf(ss * (1.0f / 2048.0f) + 1e-6f);
#pragma unroll
        for (int i = 0; i < 8; ++i) { const float4 g = ((const float4*)gain)[i * 64 + lane];
            u32x2 w; w.x = cvt_pk_bf16(v[i].x * sc * g.x, v[i].y * sc * g.y); w.y = cvt_pk_bf16(v[i].z * sc * g.z, v[i].w * sc * g.w);
            *(u32x2*)(H + (size_t)row * D_ + (i * 64 + lane) * 4) = w; }
    }
}

__device__ __forceinline__ void transpose_convert(const float* W, int K, int N, bf16_t* Bt, float* tile, int bid, int nblk) {
    const int tid = threadIdx.x; const int tk = K / 64, tn = N / 64;
    for (int u = bid; u < tk * tn; u += nblk) {
        const int k0 = (u / tn) * 64, n0 = (u % tn) * 64;
        __syncthreads();
#pragma unroll
        for (int i = 0; i < 8; ++i) { const int kk = i * 8 + (tid >> 6), nn = tid & 63; tile[kk * 65 + nn] = W[(size_t)(k0 + kk) * N + n0 + nn]; }
        __syncthreads();
#pragma unroll
        for (int i = 0; i < 4; ++i) { const int nn = i * 16 + (tid >> 5), kp = (tid & 31) * 2;
            *(unsigned*)(Bt + (size_t)(n0 + nn) * K + k0 + kp) = cvt_pk_bf16(tile[kp * 65 + nn], tile[(kp + 1) * 65 + nn]); }
    }
}

__device__ __forceinline__ void convert_flat(const float* src, bf16_t* dst, size_t n) {
    for (size_t i = ((size_t)blockIdx.x * 512 + threadIdx.x) * 8; i < n; i += (size_t)gridDim.x * 512 * 8) {
        const float4 a = *(const float4*)(src + i), b = *(const float4*)(src + i + 4);
        u32x4 w; w.x = cvt_pk_bf16(a.x, a.y); w.y = cvt_pk_bf16(a.z, a.w); w.z = cvt_pk_bf16(b.x, b.y); w.w = cvt_pk_bf16(b.z, b.w);
        *(u32x4*)(dst + i) = w;
    }
}

__device__ __forceinline__ void convert_fp8(const float* src, unsigned char* dst, size_t n, float sc, int bid, int nblk) {
    const int lane = threadIdx.x & 63, wv = threadIdx.x >> 6;
    for (size_t base = ((size_t)bid * 8 + wv) * 1024; base < n; base += (size_t)nblk * 8 * 1024) {
        float4 a[4];
#pragma unroll
        for (int j = 0; j < 4; ++j) a[j] = *(const float4*)(src + base + (size_t)(j * 64 + lane) * 4);
#pragma unroll
        for (int j = 0; j < 4; ++j) { int x = __builtin_amdgcn_cvt_pk_fp8_f32(a[j].x * sc, a[j].y * sc, 0, false); x = __builtin_amdgcn_cvt_pk_fp8_f32(a[j].z * sc, a[j].w * sc, x, true);
            *(unsigned*)(dst + base + (size_t)(j * 64 + lane) * 4) = (unsigned)x; }
    }
}

__device__ __forceinline__ void phase0(const Params& p, unsigned char* shm) {
    bf16_t* WB1 = (bf16_t*)(p.ws + WS_WB1);
    rmsnorm_rows(p.in[0], p.in[1], (bf16_t*)(p.ws + WS_H));
    transpose_convert(p.in[2], 2048, 6144, WB1, (float*)shm, blockIdx.x, gridDim.x);
    const float* mu = p.in[4]; const float* w1 = p.in[6]; const float* a1 = p.in[9]; const float* g1 = p.in[11];
    for (int idx = blockIdx.x * 512 + threadIdx.x; idx < 768 * 2048; idx += gridDim.x * 512) {
        const int j = idx >> 11, k = idx & 2047; float val = 0.f;
        if (j < 128) { const float m = mu[k], w = w1[k * 64 + (j & 63)]; val = (j < 64) ? w * (1.f - m) : w * m; }
        else if (j < 256) { const float m = mu[2048 + k], w = a1[k * 64 + (j & 63)]; val = (j < 192) ? w * (1.f - m) : w * m; }
        else if (j < 576) { const float m = mu[4096 + k]; const int jj = j - 256; const int c = jj < 160 ? jj : jj - 160; const float w = g1[k * 160 + c]; val = jj < 160 ? w * (1.f - m) : w * m; }
        WB1[(size_t)(6144 + j) * 2048 + k] = f2bf(val);
    }
    convert_flat(p.in[22], (bf16_t*)(p.ws + WS_KEYB), (size_t)8 * 2 * 128 * 256);
    bf16_t* W2T = (bf16_t*)(p.ws + WS_W2T); bf16_t* A2T = (bf16_t*)(p.ws + WS_A2T); bf16_t* G2T = (bf16_t*)(p.ws + WS_G2T);
    const float* w2 = p.in[7]; const float* a2 = p.in[10]; const float* g2 = p.in[12];
    for (int idx = blockIdx.x * 512 + threadIdx.x; idx < 1024 * 288; idx += gridDim.x * 512) {
        if (idx < 65536) { const int c = idx >> 6, j = idx & 63; W2T[idx] = f2bf(w2[j * 1024 + c]); }
        else if (idx < 131072) { const int i2 = idx - 65536; const int c = i2 >> 6, j = i2 & 63; A2T[i2] = f2bf(a2[j * 1024 + c]); }
        else { const int i2 = idx - 131072; const int c = i2 / 160, j = i2 % 160; G2T[i2] = f2bf(g2[j * 1024 + c]); }
    }
}

constexpr int ACT_LD = 296;
template <int KS, int KOFF, int KTOT, int KIND>
__device__ __forceinline__ void lora_stage(const LAS bf16_t* act, const bf16_t* WT, const float* bias, bf16_t* OUT, int t0, int w, int fr, int fq) {
#pragma unroll 1
    for (int nh = 0; nh < 2; ++nh) {
        f32x4 acc[4][4];
#pragma unroll
        for (int m = 0; m < 4; ++m)
#pragma unroll
            for (int n = 0; n < 4; ++n) acc[m][n] = (f32x4){0.f, 0.f, 0.f, 0.f};
#pragma unroll 1
        for (int ks = 0; ks < KS; ++ks) {
            bf16x8 a[4];
#pragma unroll
            for (int m = 0; m < 4; ++m) a[m] = *(const LAS bf16x8*)(act + (m * 16 + fr) * ACT_LD + KOFF + ks * 32 + fq * 8);
#pragma unroll
            for (int n = 0; n < 4; ++n) {
                const bf16x8 b = *(const bf16x8*)(WT + (size_t)(w * 128 + (nh * 4 + n) * 16 + fr) * KTOT + ks * 32 + fq * 8);
#pragma unroll
                for (int m = 0; m < 4; ++m) acc[m][n] = __builtin_amdgcn_mfma_f32_16x16x32_bf16(a[m], b, acc[m][n], 0, 0, 0);
            }
        }
#pragma unroll
        for (int n = 0; n < 4; ++n) {
            const int c = w * 128 + (nh * 4 + n) * 16 + fr;
            const float bs = (KIND < 2) ? bias[c] : 0.f;
#pragma unroll
            for (int m = 0; m < 4; ++m)
#pragma unroll
                for (int j = 0; j < 4; ++j) {
                    const float val = acc[m][n][j]; float o;
                    if (KIND == 0) { const float x = -(bs + val); const float sp = fmaxf(x, 0.f) + log1pf(__expf(-fabsf(x))); o = -__expf(-sp - 0.5f); }
                    else if (KIND == 1) o = sigmoidf_(bs + val);
                    else o = val;
                    OUT[(size_t)(t0 + m * 16 + fq * 4 + j) * DR + c] = f2bf(o);
                }
        }
    }
}
__device__ __forceinline__ void phase_prepM(const Params& p, LAS unsigned char* lds) {
    LAS bf16_t* act = (LAS bf16_t*)lds;
    const bf16_t* P = (const bf16_t*)(p.ws + WS_PROJ);
    const int tid = threadIdx.x, w = tid >> 6, lane = tid & 63, fr = lane & 15, fq = lane >> 4;
    for (int tile = blockIdx.x; tile < S_ / 64; tile += gridDim.x) {
        const int t0 = tile * 64;
        __syncthreads();
        for (int task = tid; task < 64 * 36; task += 512) {
            const int t = task / 36, j0 = (task % 36) * 8; const int tg = t0 + t;
            int ccur, cprev;
            if (j0 < 64) { ccur = 6144 + j0; cprev = 6208 + j0; }
            else if (j0 < 128) { ccur = 6272 + (j0 - 64); cprev = 6336 + (j0 - 64); }
            else { ccur = 6400 + (j0 - 128); cprev = 6560 + (j0 - 128); }
            float cu[8], pv[8], o8[8];
            unpack8(*(const u32x4*)(P + (size_t)tg * NAUG + ccur), cu);
            if (tg > 0) unpack8(*(const u32x4*)(P + (size_t)(tg - 1) * NAUG + cprev), pv);
            else {
#pragma unroll
                for (int i = 0; i < 8; ++i) pv[i] = 0.f;
            }
#pragma unroll
            for (int i = 0; i < 8; ++i) { const float sv = cu[i] + pv[i];
                o8[i] = j0 < 64 ? (1.f - 2.f / (1.f + __expf(2.f * sv))) : (j0 < 128 ? sv : sigmoidf_(sv)); }
            *(LAS u32x4*)(act + t * ACT_LD + j0) = pack8(o8);
        }
        __syncthreads();
        lora_stage<2, 0, 64, 0>(act, (const bf16_t*)(p.ws + WS_W2T), p.in[5], (bf16_t*)(p.ws + WS_LW), t0, w, fr, fq);
        lora_stage<2, 64, 64, 1>(act, (const bf16_t*)(p.ws + WS_A2T), p.in[8], (bf16_t*)(p.ws + WS_A), t0, w, fr, fq);
        lora_stage<5, 128, 160, 2>(act, (const bf16_t*)(p.ws + WS_G2T), nullptr, (bf16_t*)(p.ws + WS_G), t0, w, fr, fq);
    }
}

__device__ __forceinline__ void phase_prepE(const Params& p) {
    const bf16_t* P = (const bf16_t*)(p.ws + WS_PROJ);
    bf16_t* R = (bf16_t*)(p.ws + WS_R); bf16_t* Kk = (bf16_t*)(p.ws + WS_K); bf16_t* V = (bf16_t*)(p.ws + WS_V); bf16_t* KK = (bf16_t*)(p.ws + WS_KK); bf16_t* YC = (bf16_t*)(p.ws + WS_YC);
    const float* mu_rkv = p.in[3]; const float* k_k = p.in[13]; const float* cw = p.in[18];
    const int tid = threadIdx.x, cg = tid & 127, c0 = cg * 8, tgrp = tid >> 7;
    float mr[8], mk[8], mv[8], kkc[8], cw0[8], cw1[8], cw2[8];
#pragma unroll
    for (int i = 0; i < 8; ++i) { mr[i] = mu_rkv[c0 + i]; mk[i] = mu_rkv[1024 + c0 + i]; mv[i] = mu_rkv[2048 + c0 + i]; kkc[i] = k_k[c0 + i]; cw0[i] = cw[c0 + i]; cw1[i] = cw[1024 + c0 + i]; cw2[i] = cw[2048 + c0 + i]; }
    for (int run = blockIdx.x * 4 + tgrp; run < S_ / 16; run += gridDim.x * 4) {
        const int t0 = run * 16;
        float pr[8], pk[8], pv[8], u1[8], u2[8];
#pragma unroll
        for (int i = 0; i < 8; ++i) { pr[i] = 0.f; pk[i] = 0.f; pv[i] = 0.f; u1[i] = 0.f; u2[i] = 0.f; }
        if (t0 > 0) {
            const size_t o = (size_t)(t0 - 1) * NAUG + c0;
            unpack8(*(const u32x4*)(P + o), pr); unpack8(*(const u32x4*)(P + o + 1024), pk); unpack8(*(const u32x4*)(P + o + 2048), pv);
            float x[8], y[8];
            unpack8(*(const u32x4*)(P + o + 4096), x); unpack8(*(const u32x4*)(P + o + 5120), y);
#pragma unroll
            for (int i = 0; i < 8; ++i) u1[i] = x[i] * y[i];
            unpack8(*(const u32x4*)(P + o - NAUG + 4096), x); unpack8(*(const u32x4*)(P + o - NAUG + 5120), y);
#pragma unroll
            for (int i = 0; i < 8; ++i) u2[i] = x[i] * y[i];
        }
        u32x4 nx[6];
        { const size_t o = (size_t)t0 * NAUG + c0;
#pragma unroll
          for (int q = 0; q < 6; ++q) nx[q] = *(const u32x4*)(P + o + 1024 * q); }
#pragma unroll 1
        for (int t = 0; t < 16; ++t) {
            float cr[8], ck[8], cv[8], bg[8], cgt[8], xc[8];
            unpack8(nx[0], cr); unpack8(nx[1], ck); unpack8(nx[2], cv); unpack8(nx[3], bg); unpack8(nx[4], cgt); unpack8(nx[5], xc);
            { const size_t o = (size_t)(t0 + (t < 15 ? t + 1 : t)) * NAUG + c0;
#pragma unroll
              for (int q = 0; q < 6; ++q) nx[q] = *(const u32x4*)(P + o + 1024 * q); }
            float r[8], k[8], v[8], kkv[8], yc[8]; float ss = 0.f;
#pragma unroll
            for (int i = 0; i < 8; ++i) {
                r[i] = cr[i] + (pr[i] - cr[i]) * mr[i]; k[i] = ck[i] + (pk[i] - ck[i]) * mk[i]; v[i] = cv[i] + (pv[i] - cv[i]) * mv[i];
                pr[i] = cr[i]; pk[i] = ck[i]; pv[i] = cv[i];
                kkv[i] = k[i] * kkc[i]; ss += kkv[i] * kkv[i];
                const float u0 = cgt[i] * xc[i];
                yc[i] = bg[i] * (cw0[i] * u2[i] + cw1[i] * u1[i] + cw2[i] * u0);
                u2[i] = u1[i]; u1[i] = u0;
            }
            ss += dpp_f<0xB1, 0xf>(ss); ss += dpp_f<0x4E, 0xf>(ss); ss += dpp_f<0x141, 0xf>(ss);
            const float inv = 1.0f / fmaxf(sqrtf(ss), 1e-12f);
#pragma unroll
            for (int i = 0; i < 8; ++i) kkv[i] *= inv;
            const size_t oo = (size_t)(t0 + t) * DR + c0;
            *(u32x4*)(R + oo) = pack8(r); *(u32x4*)(Kk + oo) = pack8(k); *(u32x4*)(V + oo) = pack8(v); *(u32x4*)(KK + oo) = pack8(kkv); *(u32x4*)(YC + oo) = pack8(yc);
        }
    }
}

#define TILE(i) ((LAS bf16_t*)(lds + (i) * TSLOT))
__device__ __forceinline__ f32x4 mm_tile(f32x4 acc, const LAS bf16_t* A, const LAS bf16_t* Bt, int mi, int ni, int fr, int fq) {
#pragma unroll
    for (int ks = 0; ks < 2; ++ks) {
        const bf16x8 a = *(const LAS bf16x8*)(A + (mi * 16 + fr) * TLD + ks * 32 + fq * 8);
        const bf16x8 b = *(const LAS bf16x8*)(Bt + (ni * 16 + fr) * TLD + ks * 32 + fq * 8);
        acc = __builtin_amdgcn_mfma_f32_16x16x32_bf16(a, b, acc, 0, 0, 0);
    }
    return acc;
}
__device__ __forceinline__ void st_rm(LAS bf16_t* X, f32x4 v, int mi, int ni, int fr, int fq) {
    const unsigned w0 = cvt_pk_bf16(v[0], v[1]), w1 = cvt_pk_bf16(v[2], v[3]);
    LAS bf16_t* q = X + (mi * 16 + fq * 4) * TLD + ni * 16 + fr;
    q[0] = (bf16_t)(w0 & 0xffffu); q[TLD] = (bf16_t)(w0 >> 16); q[2 * TLD] = (bf16_t)(w1 & 0xffffu); q[3 * TLD] = (bf16_t)(w1 >> 16);
}
__device__ __forceinline__ void st_tr(LAS bf16_t* XT, f32x4 v, int mi, int ni, int fr, int fq) {
    u32x2 w; w.x = cvt_pk_bf16(v[0], v[1]); w.y = cvt_pk_bf16(v[2], v[3]);
    *(LAS u32x2*)(XT + (ni * 16 + fr) * TLD + mi * 16 + fq * 4) = w;
}
__device__ __forceinline__ f32x4 ld_rm(const LAS bf16_t* X, int mi, int ni, int fr, int fq) {
    const LAS bf16_t* q = X + (mi * 16 + fq * 4) * TLD + ni * 16 + fr;
    return (f32x4){bf2f(q[0]), bf2f(q[TLD]), bf2f(q[2 * TLD]), bf2f(q[3 * TLD])};
}
__device__ __forceinline__ f32x4 ld_tr(const LAS bf16_t* XT, int mi, int ni, int fr, int fq) {
    const u32x2 w = *(const LAS u32x2*)(XT + (ni * 16 + fr) * TLD + mi * 16 + fq * 4);
    return (f32x4){lo_bf(w.x), hi_bf(w.x), lo_bf(w.y), hi_bf(w.y)};
}

__device__ __forceinline__ void phase_chunkA(const Params& p, LAS unsigned char* lds) {
    const int tid = threadIdx.x, w = tid >> 6, lane = tid & 63, fr = lane & 15, fq = lane >> 4;
    const int mi = w >> 1, nb = (w & 1) * 2;
    LAS float* cl = (LAS float*)(lds + 14 * TSLOT);
    LAS float* gs = (LAS float*)(lds + 16 * TSLOT);
    LAS float* wc = gs + 512;
    const bf16_t* R = (const bf16_t*)(p.ws + WS_R); const bf16_t* Kk = (const bf16_t*)(p.ws + WS_K); const bf16_t* V = (const bf16_t*)(p.ws + WS_V);
    const bf16_t* KK = (const bf16_t*)(p.ws + WS_KK); const bf16_t* A = (const bf16_t*)(p.ws + WS_A); const bf16_t* LW = (const bf16_t*)(p.ws + WS_LW);
    bf16_t* GT = (bf16_t*)(p.ws + WS_GT); float* HT = (float*)(p.ws + WS_HT); bf16_t* QE = (bf16_t*)(p.ws + WS_QE); bf16_t* YL = (bf16_t*)(p.ws + WS_YL);
    const f32x4 z4 = (f32x4){0.f, 0.f, 0.f, 0.f};
    const float* k_a = p.in[14]; const float* r_k = p.in[15]; float* BON = (float*)(p.ws + WS_BON);
    for (int item = blockIdx.x; item < 4096; item += gridDim.x) {
        const int c = item >> 4, h = item & 15;
        const size_t gbase = (size_t)(c * 64) * DR + h * 64;
        {
            const int g = w, k = lane;
            float pfx[8]; float run = 0.f;
#pragma unroll
            for (int i = 0; i < 8; ++i) { run += bf2f(LW[gbase + (size_t)(g * 8 + i) * DR + k]); pfx[i] = run; }
            gs[g * 64 + k] = run;
            __syncthreads();
            float off = 0.f;
#pragma unroll
            for (int gg = 0; gg < 7; ++gg) { const float x = gs[gg * 64 + k]; off += (gg < g) ? x : 0.f; }
#pragma unroll
            for (int i = 0; i < 8; ++i) cl[(g * 8 + i) * 64 + k] = off + pfx[i];
            if (g == 7) wc[k] = __expf(off + pfx[7]);
            __syncthreads();
        }
        {
            const int t = tid >> 3, k0 = (tid & 7) * 8;
            const size_t go = gbase + (size_t)t * DR + k0;
            const u32x4 r4 = *(const u32x4*)(R + go), k4 = *(const u32x4*)(Kk + go), v4 = *(const u32x4*)(V + go), kk4 = *(const u32x4*)(KK + go), a4 = *(const u32x4*)(A + go), lw4 = *(const u32x4*)(LW + go);
            float at[8], rt[8], bt[8], kt[8], bh[8], kh[8], vv[8]; float bsum = 0.f;
#pragma unroll
            for (int i = 0; i < 8; ++i) {
                const int q = i >> 1; const bool hi = i & 1;
                const float rf = hi ? hi_bf(r4[q]) : lo_bf(r4[q]), kraw = hi ? hi_bf(k4[q]) : lo_bf(k4[q]), vf = hi ? hi_bf(v4[q]) : lo_bf(v4[q]);
                const float kkf = hi ? hi_bf(kk4[q]) : lo_bf(kk4[q]), af = hi ? hi_bf(a4[q]) : lo_bf(a4[q]), lwf = hi ? hi_bf(lw4[q]) : lo_bf(lw4[q]);
                const float kf = kraw * (1.f + (af - 1.f) * k_a[h * 64 + k0 + i]);
                bsum += rf * kf * r_k[h * 64 + k0 + i];
                const float clv = cl[t * 64 + k0 + i], cle = cl[63 * 64 + k0 + i];
                const float e = __expf(clv), ex = __expf(clv - lwf), ei = __expf(-clv), eh = __expf(cle - clv);
                const float bb = kkf * af;
                at[i] = -kkf * ex; rt[i] = rf * e; bt[i] = bb * ei; kt[i] = kf * ei; bh[i] = bb * eh; kh[i] = kf * eh; vv[i] = vf;
            }
            bsum += dpp_f<0xB1, 0xf>(bsum); bsum += dpp_f<0x4E, 0xf>(bsum); bsum += dpp_f<0x141, 0xf>(bsum);
            if ((tid & 7) == 0) BON[(size_t)(c * 64 + t) * 16 + h] = bsum;
            *(LAS u32x4*)(TILE(0) + t * TLD + k0) = pack8(at);
            *(LAS u32x4*)(TILE(2) + t * TLD + k0) = pack8(rt);
            *(LAS u32x4*)(TILE(3) + t * TLD + k0) = pack8(bt);
            *(LAS u32x4*)(TILE(4) + t * TLD + k0) = pack8(kt);
            const u32x4 atp = pack8(at), bhp = pack8(bh), khp = pack8(kh);
#pragma unroll
            for (int i = 0; i < 8; ++i) {
                const int q = i >> 1; const bool hi = i & 1;
                TILE(1)[(k0 + i) * TLD + t] = (bf16_t)(hi ? (atp[q] >> 16) : (atp[q] & 0xffffu));
                TILE(5)[(k0 + i) * TLD + t] = (bf16_t)(hi ? (bhp[q] >> 16) : (bhp[q] & 0xffffu));
                TILE(6)[(k0 + i) * TLD + t] = (bf16_t)(hi ? (khp[q] >> 16) : (khp[q] & 0xffffu));
                TILE(7)[(k0 + i) * TLD + t] = (bf16_t)(hi ? (v4[q] >> 16) : (v4[q] & 0xffffu));
            }
            __syncthreads();
        }
#pragma unroll
        for (int nn = 0; nn < 2; ++nn) {
            const int ni = nb + nn; const int col = ni * 16 + fr, row0 = mi * 16 + fq * 4;
            f32x4 x = mm_tile(z4, TILE(0), TILE(3), mi, ni, fr, fq);
#pragma unroll
            for (int j = 0; j < 4; ++j) x[j] = (col < row0 + j) ? x[j] : 0.f;
            st_rm(TILE(8), x, mi, ni, fr, fq); st_tr(TILE(9), x, mi, ni, fr, fq);
            x = mm_tile(z4, TILE(0), TILE(4), mi, ni, fr, fq);
#pragma unroll
            for (int j = 0; j < 4; ++j) x[j] = (col < row0 + j) ? x[j] : 0.f;
            st_rm(TILE(10), x, mi, ni, fr, fq);
            x = mm_tile(z4, TILE(2), TILE(3), mi, ni, fr, fq);
#pragma unroll
            for (int j = 0; j < 4; ++j) x[j] = (col <= row0 + j) ? x[j] : 0.f;
            st_rm(TILE(11), x, mi, ni, fr, fq);
            x = mm_tile(z4, TILE(2), TILE(4), mi, ni, fr, fq);
#pragma unroll
            for (int j = 0; j < 4; ++j) x[j] = (col <= row0 + j) ? x[j] : 0.f;
            st_rm(TILE(12), x, mi, ni, fr, fq);
        }
        __syncthreads();
#pragma unroll
        for (int nn = 0; nn < 2; ++nn) {
            const int ni = nb + nn;
            st_tr(TILE(13), mm_tile(z4, TILE(10), TILE(7), mi, ni, fr, fq), mi, ni, fr, fq);
            const f32x4 x = mm_tile(z4, TILE(8), TILE(9), mi, ni, fr, fq);
            st_rm(TILE(0), x, mi, ni, fr, fq); st_tr(TILE(3), x, mi, ni, fr, fq);
        }
        __syncthreads();
#pragma unroll
        for (int rd = 0; rd < 5; ++rd) {
            const int tq = (rd & 1) ? 14 : 8, tqo = (rd & 1) ? 8 : 14;
            const int lx = (rd & 1) ? 4 : 0, lxt = (rd & 1) ? 9 : 3, lxo = (rd & 1) ? 0 : 4, lxto = (rd & 1) ? 3 : 9;
#pragma unroll
            for (int nn = 0; nn < 2; ++nn) {
                const int ni = nb + nn;
                f32x4 x = ld_rm(TILE(tq), mi, ni, fr, fq) + ld_rm(TILE(lx), mi, ni, fr, fq);
                x = mm_tile(x, TILE(tq), TILE(lxt), mi, ni, fr, fq);
                st_rm(TILE(tqo), x, mi, ni, fr, fq);
                if (rd < 4) { const f32x4 y = mm_tile(z4, TILE(lx), TILE(lxt), mi, ni, fr, fq); st_rm(TILE(lxo), y, mi, ni, fr, fq); st_tr(TILE(lxto), y, mi, ni, fr, fq); }
            }
            __syncthreads();
        }
#pragma unroll
        for (int nn = 0; nn < 2; ++nn) {
            const int ni = nb + nn;
            st_tr(TILE(10), mm_tile(ld_tr(TILE(1), mi, ni, fr, fq), TILE(14), TILE(1), mi, ni, fr, fq), mi, ni, fr, fq);
            st_tr(TILE(15), mm_tile(ld_tr(TILE(13), mi, ni, fr, fq), TILE(14), TILE(13), mi, ni, fr, fq), mi, ni, fr, fq);
        }
        __syncthreads();
#pragma unroll
        for (int nn = 0; nn < 2; ++nn) {
            const int ni = nb + nn;
            {
                f32x4 x = mm_tile(z4, TILE(5), TILE(10), mi, ni, fr, fq);
                if (mi == ni) {
#pragma unroll
                    for (int j = 0; j < 4; ++j) x[j] += (fq * 4 + j == fr) ? wc[ni * 16 + fr] : 0.f;
                }
                const unsigned w0 = cvt_pk_bf16(x[0], x[1]), w1 = cvt_pk_bf16(x[2], x[3]);
                bf16_t* gp = GT + (size_t)item * 4096 + (size_t)((mi * 2 + (ni >> 1)) * 64 + (fr >> 2) * 16 + fq * 4) * 8 + (ni & 1) * 4 + (fr & 3);
                gp[0] = (bf16_t)(w0 & 0xffffu); gp[8] = (bf16_t)(w0 >> 16); gp[16] = (bf16_t)(w1 & 0xffffu); gp[24] = (bf16_t)(w1 >> 16);
            }
            {
                f32x4 x = mm_tile(z4, TILE(5), TILE(15), mi, ni, fr, fq);
                x = mm_tile(x, TILE(6), TILE(7), mi, ni, fr, fq);
                *(f32x4*)(HT + (size_t)item * 4096 + (size_t)((ni * 4 + mi) * 64 + lane) * 4) = x;
            }
            {
                f32x4 x = ld_tr(TILE(2), mi, ni, fr, fq);
                x = mm_tile(x, TILE(10), TILE(11), mi, ni, fr, fq);
                u32x2 wv; wv.x = cvt_pk_bf16(x[0], x[1]); wv.y = cvt_pk_bf16(x[2], x[3]);
                *(u32x2*)(QE + (size_t)item * 4096 + (ni * 16 + fr) * 64 + mi * 16 + fq * 4) = wv;
            }
            {
                f32x4 x = mm_tile(z4, TILE(11), TILE(15), mi, ni, fr, fq);
                x = mm_tile(x, TILE(12), TILE(7), mi, ni, fr, fq);
                u32x2 wv; wv.x = cvt_pk_bf16(x[0], x[1]); wv.y = cvt_pk_bf16(x[2], x[3]);
                *(u32x2*)(YL + (size_t)item * 4096 + (size_t)((mi * 4 + ni) * 64 + lane) * 4) = wv;
            }
        }
    }
}

__device__ __forceinline__ void phase_seq(const Params& p) {
    if (threadIdx.x >= 64) return;
    const int head = blockIdx.x >> 2, vt = blockIdx.x & 3, lane = threadIdx.x, fr = lane & 15, fq = lane >> 4;
    const bf16_t* GT = (const bf16_t*)(p.ws + WS_GT); const float* HT = (const float*)(p.ws + WS_HT); bf16_t* S0 = (bf16_t*)(p.ws + WS_S0);
    f32x4 acc[4];
#pragma unroll
    for (int mb = 0; mb < 4; ++mb) acc[mb] = (f32x4){0.f, 0.f, 0.f, 0.f};
    bf16x8 ga[4][4][2]; f32x4 hh[4][4];
#define SEQ_LOAD(buf, cc) do { const size_t _it = (size_t)((cc) < 256 ? (cc) : 255) * 16 + head; \
        _Pragma("unroll") for (int mb = 0; mb < 4; ++mb) { \
            _Pragma("unroll") for (int ks = 0; ks < 2; ++ks) ga[buf][mb][ks] = *(const bf16x8*)(GT + _it * 4096 + (size_t)((mb * 2 + ks) * 64 + lane) * 8); \
            hh[buf][mb] = *(const f32x4*)(HT + _it * 4096 + (size_t)((vt * 4 + mb) * 64 + lane) * 4); } } while (0)
    SEQ_LOAD(0, 0); SEQ_LOAD(1, 1); SEQ_LOAD(2, 2); SEQ_LOAD(3, 3);
    for (int c0 = 0; c0 < 256; c0 += 4) {
#pragma unroll
        for (int b = 0; b < 4; ++b) {
            const int c = c0 + b; const size_t item = (size_t)c * 16 + head;
            u32x2 pk[4];
#pragma unroll
            for (int mb = 0; mb < 4; ++mb) { pk[mb].x = cvt_pk_bf16(acc[mb][0], acc[mb][1]); pk[mb].y = cvt_pk_bf16(acc[mb][2], acc[mb][3]);
                *(u32x2*)(S0 + item * 4096 + (vt * 16 + fr) * 64 + mb * 16 + fq * 4) = pk[mb]; }
            u32x4 b0w, b1w; b0w.x = pk[0].x; b0w.y = pk[0].y; b0w.z = pk[1].x; b0w.w = pk[1].y; b1w.x = pk[2].x; b1w.y = pk[2].y; b1w.z = pk[3].x; b1w.w = pk[3].y;
            const bf16x8 b0 = __builtin_bit_cast(bf16x8, b0w), b1 = __builtin_bit_cast(bf16x8, b1w);
#pragma unroll
            for (int mb = 0; mb < 4; ++mb) {
                const f32x4 x = __builtin_amdgcn_mfma_f32_16x16x32_bf16(ga[b][mb][0], b0, hh[b][mb], 0, 0, 0);
                acc[mb] = __builtin_amdgcn_mfma_f32_16x16x32_bf16(ga[b][mb][1], b1, x, 0, 0, 0);
            }
            SEQ_LOAD(b, c + 4);
        }
    }
#undef SEQ_LOAD
}

__device__ __forceinline__ void phase_chunkY(const Params& p, LAS unsigned char* lds) {
    LAS float* Yb = (LAS float*)lds;
    const int tid = threadIdx.x, w = tid >> 6, lane = tid & 63, fr = lane & 15, fq = lane >> 4;
    const int mi = w >> 1, nb = (w & 1) * 2;
    const bf16_t* R = (const bf16_t*)(p.ws + WS_R); const bf16_t* Kk = (const bf16_t*)(p.ws + WS_K); const bf16_t* V = (const bf16_t*)(p.ws + WS_V);
    const bf16_t* G = (const bf16_t*)(p.ws + WS_G); const bf16_t* YC = (const bf16_t*)(p.ws + WS_YC);
    const bf16_t* QE = (const bf16_t*)(p.ws + WS_QE); const bf16_t* YL = (const bf16_t*)(p.ws + WS_YL); const bf16_t* S0 = (const bf16_t*)(p.ws + WS_S0);
    bf16_t* YM = (bf16_t*)(p.ws + WS_YMIX);
    const float* gn_w = p.in[16]; const float* gn_b = p.in[17];
    u32x2 ywn[2]; bf16x8 an[2], bn[2][2]; bool first = true;
#define CY_LOAD(it) do { const bf16_t* _q = QE + (size_t)(it) * 4096; const bf16_t* _s = S0 + (size_t)(it) * 4096; const bf16_t* _y = YL + (size_t)(it) * 4096; \
        _Pragma("unroll") for (int ks = 0; ks < 2; ++ks) an[ks] = *(const bf16x8*)(_q + (mi * 16 + fr) * 64 + ks * 32 + fq * 8); \
        _Pragma("unroll") for (int nn = 0; nn < 2; ++nn) { ywn[nn] = *(const u32x2*)(_y + (size_t)((mi * 4 + nb + nn) * 64 + lane) * 4); \
            _Pragma("unroll") for (int ks = 0; ks < 2; ++ks) bn[nn][ks] = *(const bf16x8*)(_s + (nb + nn) * 16 * 64 + fr * 64 + ks * 32 + fq * 8); } } while (0)
    for (int item = blockIdx.x; item < 4096; item += gridDim.x) {
        const int c = item >> 4, h = item & 15;
        if (first) { first = false; CY_LOAD(item); }
        __syncthreads();
        const u32x2 ywc[2] = {ywn[0], ywn[1]}; const bf16x8 ac[2] = {an[0], an[1]}; const bf16x8 bc[2][2] = {{bn[0][0], bn[0][1]}, {bn[1][0], bn[1][1]}};
        if (item + (int)gridDim.x < 4096) CY_LOAD(item + (int)gridDim.x);
#pragma unroll
        for (int nn = 0; nn < 2; ++nn) {
            const int ni = nb + nn;
            const u32x2 yw = ywc[nn];
            f32x4 acc = (f32x4){lo_bf(yw.x), hi_bf(yw.x), lo_bf(yw.y), hi_bf(yw.y)};
#pragma unroll
            for (int ks = 0; ks < 2; ++ks) acc = __builtin_amdgcn_mfma_f32_16x16x32_bf16(ac[ks], bc[nn][ks], acc, 0, 0, 0);
#pragma unroll
            for (int j = 0; j < 4; ++j) Yb[(mi * 16 + fq * 4 + j) * 68 + ni * 16 + fr] = acc[j];
        }
        __syncthreads();
        const int ch = h * 64 + lane;
        const float gw = gn_w[ch], gb = gn_b[ch];
        const float* BON = (const float*)(p.ws + WS_BON);
#pragma unroll
        for (int tt = 0; tt < 8; ++tt) {
            const int t = w * 8 + tt; const size_t tg = (size_t)c * 64 + t; const size_t o = tg * DR + ch;
            const float y = Yb[t * 68 + lane];
            const float mean = wave_sum_dpp(y) * (1.f / 64.f); const float d = y - mean;
            const float var = wave_sum_dpp(d * d) * (1.f / 64.f);
            const float yn = d * rsqrtf(var + 64e-5f) * gw + gb;
            const float bonus = BON[tg * 16 + h] * bf2f(V[o]);
            YM[tg * D_ + ch] = f2bf((yn + bonus) * bf2f(G[o]));
            YM[tg * D_ + 1024 + ch] = YC[o];
        }
    }
}

__device__ __forceinline__ int f2key(float x) { const int u = __float_as_int(x); return u ^ ((u >> 31) & 0x7fffffff); }
__device__ __forceinline__ float key2f(int k) { return __int_as_float(k ^ ((k >> 31) & 0x7fffffff)); }
template <int CTRL> __device__ __forceinline__ int dpp_i(int v) { return __builtin_amdgcn_update_dpp(v, v, CTRL, 0xf, 0xf, false); }
__device__ __forceinline__ int row_max_i(int v) { v = max(v, dpp_i<0xB1>(v)); v = max(v, dpp_i<0x4E>(v)); v = max(v, dpp_i<0x141>(v)); v = max(v, dpp_i<0x140>(v)); return v; }
__device__ __forceinline__ void phase_topk(const Params& p, unsigned char* shm) {
    float* sc = (float*)shm;
    int* tk = (int*)(sc + 64 * 260);
    bf16_t* Qs = (bf16_t*)(tk + 2048);
    const bf16_t* Q = (const bf16_t*)(p.ws + WS_Q); const bf16_t* KEYB = (const bf16_t*)(p.ws + WS_KEYB);
    int* IDS = (int*)(p.ws + WS_IDS); float* GATES = (float*)(p.ws + WS_GATES);
    const int tid = threadIdx.x, w = tid >> 6, lane = tid & 63, fr = lane & 15, fq = lane >> 4;
    const int c = w >> 2, nb = (w & 3) * 32;
    bf16x8 bk[8][2]; int hl = -1;
    u32x4 qreg[8];
#define TK_QLOAD(it) do { const int _t0 = ((it) >> 3) * 64; _Pragma("unroll") for (int i = 0; i < 8; ++i) { const int ch = tid + 512 * i; \
        qreg[i] = *(const u32x4*)(Q + (size_t)(_t0 + (ch >> 6)) * 4096 + ((it) & 7) * 512 + (ch & 63) * 8); } } while (0)
    if ((int)blockIdx.x < 2048) TK_QLOAD((int)blockIdx.x);
    for (int item = blockIdx.x; item < 2048; item += gridDim.x) {
        const int t0 = (item >> 3) * 64, h = item & 7;
        if (h != hl) { hl = h; const bf16_t* kb = KEYB + ((size_t)(h * 2 + c) * 128) * 256;
#pragma unroll
            for (int ks = 0; ks < 8; ++ks)
#pragma unroll
                for (int n = 0; n < 2; ++n) bk[ks][n] = *(const bf16x8*)(kb + (size_t)(nb + n * 16 + fr) * 256 + ks * 32 + fq * 8); }
#pragma unroll
        for (int i = 0; i < 8; ++i) { const int ch = tid + 512 * i; *(u32x4*)(Qs + (ch >> 6) * 520 + (ch & 63) * 8) = qreg[i]; }
        __syncthreads();
        if (item + (int)gridDim.x < 2048) TK_QLOAD(item + (int)gridDim.x);
        f32x4 acc[4][2];
#pragma unroll
        for (int m = 0; m < 4; ++m)
#pragma unroll
            for (int n = 0; n < 2; ++n) acc[m][n] = (f32x4){0.f, 0.f, 0.f, 0.f};
#pragma unroll
        for (int ks = 0; ks < 8; ++ks) {
            bf16x8 a[4];
#pragma unroll
            for (int m = 0; m < 4; ++m) a[m] = *(const bf16x8*)(Qs + (m * 16 + fr) * 520 + c * 256 + ks * 32 + fq * 8);
#pragma unroll
            for (int m = 0; m < 4; ++m)
#pragma unroll
                for (int n = 0; n < 2; ++n) acc[m][n] = __builtin_amdgcn_mfma_f32_16x16x32_bf16(a[m], bk[ks][n], acc[m][n], 0, 0, 0);
        }
#pragma unroll
        for (int m = 0; m < 4; ++m)
#pragma unroll
            for (int n = 0; n < 2; ++n)
#pragma unroll
                for (int j = 0; j < 4; ++j) sc[(m * 16 + fq * 4 + j) * 260 + c * 128 + nb + n * 16 + fr] = acc[m][n][j];
        __syncthreads();
        for (int g = 0; g < 4; ++g) {
            const int L = w * 16 + g * 4 + (lane >> 4); const int tok = L >> 1, cc = L & 1; const int pp = lane & 15;
            int key[8];
#pragma unroll
            for (int i = 0; i < 8; ++i) key[i] = (f2key(sc[tok * 260 + cc * 128 + i * 16 + pp]) & ~127) | (127 - (i * 16 + pp));
            int mykey = 0;
#pragma unroll
            for (int r = 0; r < 16; ++r) {
                const int ml = max(max(max(key[0], key[1]), max(key[2], key[3])), max(max(key[4], key[5]), max(key[6], key[7])));
                const int m = row_max_i(ml);
#pragma unroll
                for (int i = 0; i < 8; ++i) key[i] = (key[i] == m) ? (int)0x80000000 : key[i];
                mykey = (pp == r) ? m : mykey;
            }
            tk[L * 16 + pp] = mykey;
        }
        __syncthreads();
        for (int g = 0; g < 2; ++g) {
            const int tok = w * 8 + g * 4 + (lane >> 4); const int pp = lane & 15;
            const float s1 = key2f(tk[(tok * 2) * 16 + pp] & ~127);
            int key[16];
#pragma unroll
            for (int j = 0; j < 16; ++j) { const float s2 = key2f(tk[(tok * 2 + 1) * 16 + j] & ~127); key[j] = (f2key(s1 + s2) & ~255) | (255 - (pp * 16 + j)); }
            int mykey = 0;
#pragma unroll
            for (int r = 0; r < 16; ++r) {
                int ml = max(max(max(key[0], key[1]), max(key[2], key[3])), max(max(key[4], key[5]), max(key[6], key[7])));
                ml = max(ml, max(max(max(key[8], key[9]), max(key[10], key[11])), max(max(key[12], key[13]), max(key[14], key[15]))));
                const int m = row_max_i(ml);
#pragma unroll
                for (int j = 0; j < 16; ++j) key[j] = (key[j] == m) ? (int)0x80000000 : key[j];
                mykey = (pp == r) ? m : mykey;
            }
            const int ci = 255 - (mykey & 255); const float cs = key2f(mykey & ~255);
            const int e1 = 127 - (tk[(tok * 2) * 16 + (ci >> 4)] & 127), e2 = 127 - (tk[(tok * 2 + 1) * 16 + (ci & 15)] & 127);
            const float mx = __shfl(cs, lane & 48);
            const float e = __expf(cs - mx);
            float sum = e; sum += dpp_f<0xB1, 0xf>(sum); sum += dpp_f<0x4E, 0xf>(sum); sum += dpp_f<0x141, 0xf>(sum); sum += dpp_f<0x140, 0xf>(sum);
            IDS[(size_t)(t0 + tok) * 128 + h * 16 + pp] = (e1 * 128 + e2) & 16383;
            GATES[(size_t)(t0 + tok) * 128 + h * 16 + pp] = e / sum;
        }
    }
#undef TK_QLOAD
}

constexpr float U8_SCALE = 64.f, V8_SCALE = 32.f;
__device__ __forceinline__ float gelu_fast(float x) { const float u = 0.7978845608028654f * (x + 0.044715f * x * x * x); return x / (1.0f + __expf(-2.0f * u)); }
__device__ __forceinline__ void phase_gather(const Params& p, unsigned char* shm) {
    const bf16_t* H2 = (const bf16_t*)(p.ws + WS_H2); const float* X1 = (const float*)(p.ws + WS_X1);
    const unsigned char* U8 = p.ws + WS_UB; const unsigned char* V8 = p.ws + WS_VB;
    const int* IDS = (const int*)(p.ws + WS_IDS); const float* GATES = (const float*)(p.ws + WS_GATES);
    const float* nf = p.in[25];
    const int tid = threadIdx.x, w = tid >> 6, lane = tid & 63;
    for (int t = blockIdx.x * 8 + w; t < S_; t += gridDim.x * 8) {
        f32x2 hp[16];
#pragma unroll
        for (int q = 0; q < 2; ++q)
#pragma unroll
            for (int hh = 0; hh < 2; ++hh) { const u32x4 hv = *(const u32x4*)(H2 + (size_t)t * D_ + q * 1024 + lane * 16 + hh * 8);
#pragma unroll
                for (int i = 0; i < 4; ++i) hp[q * 8 + hh * 4 + i] = (f32x2){lo_bf(hv[i]), hi_bf(hv[i])}; }
        const int id0 = IDS[(size_t)t * 128 + lane], id1 = IDS[(size_t)t * 128 + 64 + lane];
        const float gt0 = GATES[(size_t)t * 128 + lane], gt1 = GATES[(size_t)t * 128 + 64 + lane];
        f32x2 op[16];
#pragma unroll
        for (int i = 0; i < 16; ++i) op[i] = (f32x2){0.f, 0.f};
        u32x4 ua[4][2], ub[4][2], vb[4][2];
#define G_LOADU(dst, grp) do { _Pragma("unroll") for (int j = 0; j < 4; ++j) { const int e = (grp) * 4 + j; const int id = __builtin_amdgcn_readlane(e < 64 ? id0 : id1, e & 63); \
            const unsigned char* ur = U8 + (size_t)id * D_ + lane * 16; dst[j][0] = *(const u32x4*)ur; dst[j][1] = *(const u32x4*)(ur + 1024); } } while (0)
#define G_LOADV(grp) do { _Pragma("unroll") for (int j = 0; j < 4; ++j) { const int e = (grp) * 4 + j; const int id = __builtin_amdgcn_readlane(e < 64 ? id0 : id1, e & 63); \
            const unsigned char* vr = V8 + (size_t)id * D_ + lane * 16; vb[j][0] = *(const u32x4*)vr; vb[j][1] = *(const u32x4*)(vr + 1024); } } while (0)
#define G_BODY(cur, nxt, grp) do { \
            G_LOADV(grp); \
            G_LOADU(nxt, ((grp) + 1 < 32 ? (grp) + 1 : 31)); \
            float dsel = 0.f; \
            _Pragma("unroll") for (int j = 0; j < 4; ++j) { f32x2 d2 = (f32x2){0.f, 0.f}; \
                _Pragma("unroll") for (int q = 0; q < 2; ++q) _Pragma("unroll") for (int i = 0; i < 4; ++i) { \
                    d2 += __builtin_amdgcn_cvt_pk_f32_fp8((int)cur[j][q][i], false) * hp[q * 8 + 2 * i]; d2 += __builtin_amdgcn_cvt_pk_f32_fp8((int)cur[j][q][i], true) * hp[q * 8 + 2 * i + 1]; } \
                const float d = wave_sum_dpp(d2.x + d2.y); dsel = (lane == j) ? d : dsel; } \
            const float av = gelu_fast(dsel * (1.f / U8_SCALE)) * (1.f / V8_SCALE); \
            _Pragma("unroll") for (int j = 0; j < 4; ++j) { const int e = (grp) * 4 + j; \
                const float a = __int_as_float(__builtin_amdgcn_readlane(__float_as_int(av), j)) * __int_as_float(__builtin_amdgcn_readlane(__float_as_int(e < 64 ? gt0 : gt1), e & 63)); \
                const f32x2 a2 = (f32x2){a, a}; \
                _Pragma("unroll") for (int q = 0; q < 2; ++q) _Pragma("unroll") for (int i = 0; i < 4; ++i) { \
                    op[q * 8 + 2 * i] += a2 * __builtin_amdgcn_cvt_pk_f32_fp8((int)vb[j][q][i], false); op[q * 8 + 2 * i + 1] += a2 * __builtin_amdgcn_cvt_pk_f32_fp8((int)vb[j][q][i], true); } } \
        } while (0)
        G_LOADU(ua, 0);
#pragma unroll 1
        for (int g2 = 0; g2 < 32; g2 += 2) { G_BODY(ua, ub, g2); G_BODY(ub, ua, g2 + 1); }
#undef G_LOADU
#undef G_LOADV
#undef G_BODY
        float ss = 0.f; float4 xs[8];
#pragma unroll
        for (int q = 0; q < 2; ++q)
#pragma unroll
            for (int i = 0; i < 4; ++i) { float4 x = *(const float4*)(X1 + (size_t)t * D_ + q * 1024 + lane * 16 + 4 * i);
                x.x += op[q * 8 + 2 * i].x; x.y += op[q * 8 + 2 * i].y; x.z += op[q * 8 + 2 * i + 1].x; x.w += op[q * 8 + 2 * i + 1].y;
                ss += x.x * x.x + x.y * x.y + x.z * x.z + x.w * x.w; xs[q * 4 + i] = x; }
        ss = wave_sum_dpp(ss);
        const float scl = rsqrtf(ss * (1.f / 2048.f) + 1e-6f);
#pragma unroll
        for (int q = 0; q < 2; ++q)
#pragma unroll
            for (int i = 0; i < 4; ++i) { const float4 g = *(const float4*)(nf + q * 1024 + lane * 16 + 4 * i); const float4 x = xs[q * 4 + i];
                *(float4*)(p.out + (size_t)t * D_ + q * 1024 + lane * 16 + 4 * i) = make_float4(x.x * scl * g.x, x.y * scl * g.y, x.z * scl * g.z, x.w * scl * g.w); }
    }
}

#define XB_TMO      128
#define XB_XCNT(j)  (256  + 64 * (j))
#define XB_XSUB(j)  (1280 + 64 * (j))
#define XB_XGEN(j)  (2304 + 64 * (j))
#define XB_TOP      3328
#define XB_TOPGEN   3392
#define XCD_BAR_WORDS 3456
#define XB_SPIN_CAP (1u << 18)
__device__ __forceinline__ unsigned xb_ld(unsigned* p)              { return __hip_atomic_load(p, __ATOMIC_RELAXED, __HIP_MEMORY_SCOPE_AGENT); }
__device__ __forceinline__ unsigned xb_add(unsigned* p, unsigned v) { return __hip_atomic_fetch_add(p, v, __ATOMIC_RELAXED, __HIP_MEMORY_SCOPE_AGENT); }
__device__ __forceinline__ unsigned xb_xcc_id() { return (unsigned)__builtin_amdgcn_s_getreg((3 << 11) | 20) & 0xFu; }
#define XB_SPIN(cond, bar) do { unsigned _sp = 0; while (cond) { __builtin_amdgcn_s_sleep(1); \
    if ((++_sp & 255u) == 0u) { if (xb_ld(&(bar)[XB_TMO])) break; if (_sp > XB_SPIN_CAP) { atomicAdd(&(bar)[XB_TMO], 1u); break; } } } } while (0)
struct XcdBarrier { unsigned* bar; unsigned x; volatile LAS unsigned* st; };
__device__ __forceinline__ XcdBarrier xcd_barrier_post(unsigned* bar, volatile LAS unsigned* st) {
    XcdBarrier b; b.bar = bar; b.x = xb_xcc_id(); b.st = st;
    if (threadIdx.x == 0) (void)xb_add(&bar[XB_XCNT(b.x)], 1u);
    return b;
}
__device__ __forceinline__ void xcd_barrier_complete(unsigned* bar, unsigned x, unsigned& nloc, unsigned& nx) {
    const unsigned G = gridDim.x * gridDim.y * gridDim.z;
    unsigned sum, cnt, mine, sp = 0u;
    for (;;) {
        sum = 0u; cnt = 0u; mine = 0u;
#pragma unroll
        for (unsigned j = 0; j < 16; ++j) { const unsigned c = xb_ld(&bar[XB_XCNT(j)]); sum += c; cnt += (c > 0u) ? 1u : 0u; mine = (j == x) ? c : mine; }
        if (sum == G) break;
        __builtin_amdgcn_s_sleep(1);
        if ((++sp & 255u) == 0u) { if (xb_ld(&bar[XB_TMO])) break; if (sp > XB_SPIN_CAP) { atomicAdd(&bar[XB_TMO], 1u); break; } }
    }
    nloc = mine > 0u ? mine : 1u; nx = cnt > 0u ? cnt : 1u;
}
__device__ __forceinline__ void xcd_barrier(const XcdBarrier& b) {
    asm volatile("s_waitcnt vmcnt(0)" ::: "memory");
    __syncthreads();
    if (threadIdx.x == 0) {
        unsigned* bar = b.bar;
        __builtin_amdgcn_s_waitcnt(0);
        unsigned nloc = b.st[0], nx = b.st[1];
        if (nloc == 0u) { xcd_barrier_complete(bar, b.x, nloc, nx); b.st[0] = nloc; b.st[1] = nx; }
        const unsigned old = xb_add(&bar[XB_XSUB(b.x)], 1u);
        const unsigned gen = old / nloc;
        if (old + 1u == (gen + 1u) * nloc) {
            __builtin_amdgcn_fence(__ATOMIC_RELEASE, "agent");
            asm volatile("s_waitcnt vmcnt(0)" ::: "memory");
            const unsigned og = xb_add(&bar[XB_TOP], 1u);
            const unsigned tg = og / nx;
            if (og + 1u == (tg + 1u) * nx) xb_add(&bar[XB_TOPGEN], 1u);
            else XB_SPIN(xb_ld(&bar[XB_TOPGEN]) == tg, bar);
            __builtin_amdgcn_fence(__ATOMIC_ACQUIRE, "agent");
            xb_add(&bar[XB_XGEN(b.x)], 1u);
            asm volatile("s_waitcnt vmcnt(0)" ::: "memory");
        } else {
            XB_SPIN(xb_ld(&bar[XB_XGEN(b.x)]) == gen, bar);
            __builtin_amdgcn_fence(__ATOMIC_ACQUIRE, "agent");
            asm volatile("s_waitcnt vmcnt(0)" ::: "memory");
        }
    }
    __syncthreads();
}

__global__ void __launch_bounds__(512, 2) mega(Params p) {
    extern __shared__ __attribute__((aligned(16))) unsigned char shm[];
    cg::grid_group grid = cg::this_grid();
    LAS unsigned char* lds = (LAS unsigned char*)shm;
    volatile LAS unsigned* bst = (volatile LAS unsigned*)(lds + LDS_BYTES - 16);
    if (threadIdx.x == 0) { bst[0] = 0u; bst[1] = 0u; }
    __syncthreads();
    const XcdBarrier xbar = xcd_barrier_post((unsigned*)(p.ws + WS_BAR), bst);
    if (p.ph_hi > 1000) grid.sync();
    const int lo = p.ph_lo, hi = p.ph_hi;
#define IN(k) (lo <= (k) && (k) < hi)
#define REP(k) for (int _r = 0; _r < ((k) == DUP_PHASE ? 2 : 1); ++_r)
#define SEAM(k) do { if (IN(k) && IN((k) + 1)) xcd_barrier(xbar); } while (0)
    if (IN(0)) REP(0) { if (_r) xcd_barrier(xbar); phase0(p, shm); }
    SEAM(0);
    if (IN(1)) REP(1) { if (_r) xcd_barrier(xbar);
        pg8::Gemm g{(const bf16_t*)(p.ws + WS_H), (const bf16_t*)(p.ws + WS_WB1), S_, NAUG, 2048};
        pg8::StaticOrder so; so.init(g.M, g.N, (int)gridDim.x, (int)blockIdx.x);
        pg8::EpiBf16 E{(bf16_t*)(p.ws + WS_PROJ), NAUG};
        pg8::gemm_phase(lds, g, so, E);
    }
    SEAM(1);
    if (IN(2)) REP(2) { if (_r) xcd_barrier(xbar);
        phase_prepM(p, lds);
        phase_prepE(p);
    }
    SEAM(2);
    if (IN(3)) REP(3) { if (_r) xcd_barrier(xbar); phase_chunkA(p, lds); }
    SEAM(3);
    if (IN(4)) REP(4) { if (_r) xcd_barrier(xbar); if (blockIdx.x < 64) phase_seq(p);
        else { const int bid = blockIdx.x - 64, nblk = gridDim.x - 64;
            convert_fp8(p.in[23], p.ws + WS_UB, (size_t)16384 * 2048, U8_SCALE, bid, nblk);
            convert_fp8(p.in[24], p.ws + WS_VB, (size_t)16384 * 2048, V8_SCALE, bid, nblk);
            transpose_convert(p.in[21], 2048, 4096, (bf16_t*)(p.ws + WS_WQT), (float*)shm, bid, nblk);
            transpose_convert(p.in[19], 2048, 2048, (bf16_t*)(p.ws + WS_WOT), (float*)shm, bid, nblk); } }
    SEAM(4);
    if (IN(5)) REP(5) { if (_r) xcd_barrier(xbar); phase_chunkY(p, lds); }
    SEAM(5);
    if (IN(6)) REP(6) { if (_r) xcd_barrier(xbar);
        pg8::Gemm g{(const bf16_t*)(p.ws + WS_YMIX), (const bf16_t*)(p.ws + WS_WOT), S_, 2048, 2048};
        pg8::StaticOrder so; so.init(g.M, g.N, (int)gridDim.x, (int)blockIdx.x);
        pg8::EpiResF32 E{(float*)(p.ws + WS_X1), p.in[0], 2048};
        pg8::gemm_phase(lds, g, so, E);
    }
    SEAM(6);
    if (IN(7)) REP(7) { if (_r) xcd_barrier(xbar);
        rmsnorm_rows((const float*)(p.ws + WS_X1), p.in[20], (bf16_t*)(p.ws + WS_H2));
    }
    SEAM(7);
    if (IN(8)) REP(8) { if (_r) xcd_barrier(xbar);
        pg8::Gemm g{(const bf16_t*)(p.ws + WS_H2), (const bf16_t*)(p.ws + WS_WQT), S_, 4096, 2048};
        pg8::StaticOrder so; so.init(g.M, g.N, (int)gridDim.x, (int)blockIdx.x);
        pg8::EpiBf16 E{(bf16_t*)(p.ws + WS_Q), 4096};
        pg8::gemm_phase(lds, g, so, E);
    }
    SEAM(8);
    if (IN(9)) REP(9) { if (_r) xcd_barrier(xbar); phase_topk(p, shm); }
    SEAM(9);
    if (IN(10)) REP(10) { if (_r) xcd_barrier(xbar); phase_gather(p, shm); }
#undef IN
#undef REP
#undef SEAM
}

extern "C" void kernel_launch(void* const* d_in, const int* in_sizes, int n_in, void* d_out, int out_size, void* d_ws, size_t ws_size, hipStream_t stream) {
    static int grid_blocks = 0;
    if (grid_blocks == 0) {
        if (n_in != 26 || ws_size < WS_NEED) { fprintf(stderr, "kernel_launch: unexpected n_in %d / ws_size %zu\n", n_in, ws_size); grid_blocks = -1; return; }
        int dev = 0, cus = 0, per_cu = 0;
        (void)hipGetDevice(&dev);
        (void)hipDeviceGetAttribute(&cus, hipDeviceAttributeMultiprocessorCount, dev);
        (void)hipFuncSetAttribute((const void*)mega, hipFuncAttributeMaxDynamicSharedMemorySize, LDS_BYTES);
        (void)hipOccupancyMaxActiveBlocksPerMultiprocessor(&per_cu, (const void*)mega, 512, LDS_BYTES);
        if (per_cu < 1) { fprintf(stderr, "kernel_launch: occupancy query says %d blocks/CU\n", per_cu); per_cu = 1; }
        grid_blocks = cus * per_cu;
        fprintf(stderr, "kernel_launch: cus %d per_cu %d grid %d\n", cus, per_cu, grid_blocks);
    }
    if (grid_blocks < 0) return;
    Params p{};
    for (int i = 0; i < 26; ++i) p.in[i] = (const float*)d_in[i];
    p.out = (float*)d_out; p.ws = (unsigned char*)d_ws;
#if MULTI_LAUNCH
    for (int ph = 0; ph < NPHASE; ++ph) {
        p.ph_lo = ph; p.ph_hi = ph + 1;
        hipLaunchKernelGGL(mega, dim3(grid_blocks), dim3(512), LDS_BYTES, stream, p);
    }
#else
    p.ph_lo = 0; p.ph_hi = NPHASE;
    if (hipMemsetAsync((unsigned char*)d_ws + WS_BAR, 0, XCD_BAR_WORDS * 4, stream) != hipSuccess) fprintf(stderr, "kernel_launch: barrier memset failed\n");
    void* args[] = {&p};
    hipError_t e = hipLaunchCooperativeKernel((const void*)mega, dim3(grid_blocks), dim3(512), args, LDS_BYTES, stream);
    if (e != hipSuccess) fprintf(stderr, "cooperative launch failed: %s (grid %d)\n", hipGetErrorString(e), grid_blocks);
#endif
}
```

```cpp
#include <hip/hip_runtime.h>
#include <hip/hip_cooperative_groups.h>
#include <cstdio>
namespace cg = cooperative_groups;

#ifndef DUP_PHASE
#define DUP_PHASE -1
#endif
#ifndef MULTI_LAUNCH
#define MULTI_LAUNCH 0
#endif

#define LAS __attribute__((address_space(3)))
typedef unsigned short bf16_t;
typedef short bf16x8 __attribute__((ext_vector_type(8)));
typedef float f32x4 __attribute__((ext_vector_type(4)));
typedef float f32x2 __attribute__((ext_vector_type(2)));
typedef unsigned u32x4 __attribute__((ext_vector_type(4)));
typedef unsigned u32x2 __attribute__((ext_vector_type(2)));

constexpr int S_ = 16384, D_ = 2048, DR = 1024, NAUG = 6912;
constexpr size_t MiB = 1ull << 20;
constexpr size_t WS_PROJ = 0, WS_H = 216 * MiB, WS_WB1 = 280 * MiB, WS_WQT = 280 * MiB, WS_WOT = 296 * MiB;
constexpr size_t WS_R = 307 * MiB, WS_K = 339 * MiB, WS_V = 371 * MiB, WS_KK = 403 * MiB, WS_A = 435 * MiB, WS_LW = 467 * MiB;
constexpr size_t WS_G = 216 * MiB, WS_YC = 248 * MiB, WS_YMIX = 307 * MiB, WS_X1 = 0, WS_H2 = 128 * MiB, WS_Q = 307 * MiB;
constexpr size_t WS_GT = 0, WS_HT = 32 * MiB, WS_QE = 96 * MiB, WS_YL = 128 * MiB, WS_S0 = 160 * MiB;
constexpr size_t WS_IDS = 192 * MiB, WS_GATES = 200 * MiB, WS_UB = 467 * MiB, WS_VB = 435 * MiB, WS_BON = 500 * MiB, WS_BAR = 502 * MiB, WS_KEYB = 503 * MiB, WS_NEED = 504 * MiB;
constexpr size_t WS_W2T = 499 * MiB, WS_A2T = WS_W2T + 131072, WS_G2T = WS_A2T + 131072;
constexpr int TLD = 72, TSLOT = 64 * TLD * 2;
constexpr int LDS_BYTES = 16 * TSLOT + 2048 + 256 + 16;
constexpr int NPHASE = 11;

struct Params {
    const float* in[26];
    float* out;
    unsigned char* ws;
    int ph_lo, ph_hi;
};

__device__ __forceinline__ float bf2f(bf16_t b) { return __uint_as_float(((unsigned)b) << 16); }
__device__ __forceinline__ bf16_t f2bf(float f) { unsigned u = __float_as_uint(f); u += 0x7FFFu + ((u >> 16) & 1u); return (bf16_t)(u >> 16); }
typedef __bf16 bf16v2_t __attribute__((ext_vector_type(2)));
__device__ __forceinline__ unsigned cvt_pk_bf16(float lo, float hi) { const f32x2 v = {lo, hi}; const bf16v2_t r = __builtin_convertvector(v, bf16v2_t); return __builtin_bit_cast(unsigned, r); }
__device__ __forceinline__ u32x4 pack8(const float* f) { u32x4 w; w.x = cvt_pk_bf16(f[0], f[1]); w.y = cvt_pk_bf16(f[2], f[3]); w.z = cvt_pk_bf16(f[4], f[5]); w.w = cvt_pk_bf16(f[6], f[7]); return w; }
__device__ __forceinline__ float lo_bf(unsigned w) { return __uint_as_float(w << 16); }
__device__ __forceinline__ float hi_bf(unsigned w) { return __uint_as_float(w & 0xffff0000u); }
__device__ __forceinline__ void unpack8(const u32x4 v, float* f) {
#pragma unroll
    for (int i = 0; i < 4; ++i) { f[2 * i] = lo_bf(v[i]); f[2 * i + 1] = hi_bf(v[i]); }
}
__device__ __forceinline__ float wave_sum(float v) {
#pragma unroll
    for (int o = 32; o; o >>= 1) v += __shfl_xor(v, o);
    return v;
}
template <int CTRL, int RM> __device__ __forceinline__ float dpp_f(float v) { return __int_as_float(__builtin_amdgcn_update_dpp(0, __float_as_int(v), CTRL, RM, 0xf, false)); }
__device__ __forceinline__ float wave_sum_dpp(float v) {
    v += dpp_f<0xB1, 0xf>(v); v += dpp_f<0x4E, 0xf>(v); v += dpp_f<0x141, 0xf>(v); v += dpp_f<0x140, 0xf>(v);
    v += dpp_f<0x142, 0xa>(v); v += dpp_f<0x143, 0xc>(v);
    return __int_as_float(__builtin_amdgcn_readlane(__float_as_int(v), 63));
}
__device__ __forceinline__ float wave_max(float v) {
#pragma unroll
    for (int o = 32; o; o >>= 1) v = fmaxf(v, __shfl_xor(v, o));
    return v;
}
__device__ __forceinline__ float sigmoidf_(float x) { return 1.0f / (1.0f + __expf(-x)); }
__device__ __forceinline__ float gelu_tanh(float x) { float u = 0.7978845608028654f * (x + 0.044715f * x * x * x); return 0.5f * x * (1.0f + tanhf(u)); }

namespace pg8 {
constexpr int BM = 256, BK = 64, HALF = 128, HTB = HALF * BK * 2, STAGE_BYTES = 8 * HTB, NXCD = 8, WGM = 8;
__device__ __forceinline__ int lds_byte(int r, int c) { const int st = (r >> 4) * 2 + (c >> 5), rr = r & 15, cc = c & 31, ob = rr * 64 + cc * 2; return st * 1024 + (ob ^ (((ob >> 9) & 1) << 5)); }
__device__ __forceinline__ void stage_rc(int b, int& R, int& C) { const int st = b / 1024, sb = b % 1024, swz = sb ^ (((sb >> 9) & 1) << 5); R = (st >> 1) * 16 + swz / 64; C = (st & 1) * 32 + (swz % 64) / 2; }
__device__ __forceinline__ int perm32(int rho) { const int n = rho >> 4, i = rho & 15; return 8 * (i >> 2) + 4 * n + (i & 3); }
struct Unit { int pm, pn; };
struct Gemm { const bf16_t* A; const bf16_t* Bt; int M, N, K; };
struct StaticOrder {
    int nM, nN, nwg, G, c;
    __device__ void init(int M, int N, int G_, int c_) { nM = M / BM; nN = N / BM; nwg = nM * nN; G = G_; c = c_; }
    __device__ bool next(int i, Unit& u) const {
        const long L = (long)i * G + c; if (L >= nwg) return false;
        int wgid = (int)L; { const int q = nwg / NXCD, r = nwg % NXCD, xcd = wgid % NXCD, off = wgid / NXCD; wgid = (xcd < r ? xcd * (q + 1) : r * (q + 1) + (xcd - r) * q) + off; }
        const int nig = WGM * nN, gid = wgid / nig, fm = gid * WGM, gsz = (nM - fm) < WGM ? (nM - fm) : WGM;
        u.pm = fm + ((wgid % nig) % gsz); u.pn = (wgid % nig) / gsz; return true;
    }
    __device__ __forceinline__ void a_ready(const Unit&) const {}
    __device__ __forceinline__ void done(const Unit&) const {}
};
struct EpiResF32 {
    static constexpr bool PERM = false;
    float* C; const float* Res; int ldc;
    __device__ __forceinline__ void operator()(const f32x4 (&acc)[2][2][4][2], const Unit& u, int wr, int wc, int fr, int fq) const {
        const int row0 = u.pm * BM + wr * 64 + fr, col0 = u.pn * BM + wc * 32 + 4 * fq;
#pragma unroll
        for (int ai = 0; ai < 2; ++ai)
#pragma unroll
            for (int m = 0; m < 4; ++m) { const size_t ro = (size_t)(row0 + ai * HALF + m * 16) * ldc + col0;
#pragma unroll
                for (int bj = 0; bj < 2; ++bj)
#pragma unroll
                    for (int n = 0; n < 2; ++n) { const f32x4 rs = *(const f32x4*)(Res + ro + bj * HALF + n * 16); *(f32x4*)(C + ro + bj * HALF + n * 16) = acc[ai][bj][m][n] + rs; } }
    }
};
struct EpiF32 {
    static constexpr bool PERM = false;
    float* C; int ldc;
    __device__ __forceinline__ void operator()(const f32x4 (&acc)[2][2][4][2], const Unit& u, int wr, int wc, int fr, int fq) const {
        const int row0 = u.pm * BM + wr * 64 + fr, col0 = u.pn * BM + wc * 32 + 4 * fq;
#pragma unroll
        for (int ai = 0; ai < 2; ++ai)
#pragma unroll
            for (int m = 0; m < 4; ++m) { const size_t ro = (size_t)(row0 + ai * HALF + m * 16) * ldc + col0;
#pragma unroll
                for (int bj = 0; bj < 2; ++bj)
#pragma unroll
                    for (int n = 0; n < 2; ++n) *(f32x4*)(C + ro + bj * HALF + n * 16) = acc[ai][bj][m][n]; }
    }
};
struct EpiBf16 {
    static constexpr bool PERM = true;
    bf16_t* O; int ldc;
    __device__ __forceinline__ void operator()(const f32x4 (&acc)[2][2][4][2], const Unit& u, int wr, int wc, int fr, int fq) const {
        const int row0 = u.pm * BM + wr * 64 + fr; const int col0 = u.pn * BM + wc * 32 + 8 * fq;
#pragma unroll
        for (int ai = 0; ai < 2; ++ai)
#pragma unroll
            for (int m = 0; m < 4; ++m) { bf16_t* rowp = O + (size_t)(row0 + ai * HALF + m * 16) * ldc + col0;
#pragma unroll
                for (int bj = 0; bj < 2; ++bj) { const f32x4 v0 = acc[ai][bj][m][0], v1 = acc[ai][bj][m][1];
                    u32x4 w; w.x = cvt_pk_bf16(v0[0], v0[1]); w.y = cvt_pk_bf16(v0[2], v0[3]); w.z = cvt_pk_bf16(v1[0], v1[1]); w.w = cvt_pk_bf16(v1[2], v1[3]);
                    *(u32x4*)(rowp + bj * HALF) = w; } }
    }
};

template <class Epi, class Sched>
__device__ __forceinline__ void gemm_phase(LAS unsigned char* lds, const Gemm g, const Sched& S, const Epi& E) {
    const int tid = threadIdx.x, wid = __builtin_amdgcn_readfirstlane(tid >> 6), lane = tid & 63, wr = wid >> 2, wc = wid & 3, fr = lane & 15, fq = lane >> 4;
    const int K = g.K, nt = K / BK;
    unsigned voffA[2], voffB[2];
#pragma unroll
    for (int i = 0; i < 2; ++i) { int R, C; stage_rc(tid * 16 + i * 8192, R, C); const int Rb = Epi::PERM ? ((R & ~31) + perm32(R & 31)) : R;
        voffA[i] = (unsigned)(R * K + C) * 2u; voffB[i] = (unsigned)(Rb * K + C) * 2u; }
    const size_t kstep = (size_t)(BK * 2);
    const size_t hstep = (size_t)HALF * K * 2;
    const size_t tstep = 2 * hstep;
    const unsigned ldsw = (unsigned)wid * 1024u;
    const int aoff = lds_byte(wr * 64 + fr, fq * 8), boff = lds_byte(wc * 32 + fr, fq * 8);
#define PG8_SA(b, h) (((b) * 2 + (h)) * HTB)
#define PG8_SB(b, h) ((4 + (b) * 2 + (h)) * HTB)
#define PG8_STAGE(bufoff, gbase, voff) do { _Pragma("unroll") for (int _i = 0; _i < 2; ++_i) \
        __builtin_amdgcn_global_load_lds((const unsigned*)((const char*)(gbase) + (voff)[_i]), (LAS unsigned*)(lds + (bufoff) + ldsw + _i * 8192), 16, 0, 0); } while (0)
#define PG8_LDA(dst, b, h) do { _Pragma("unroll") for (int m = 0; m < 4; ++m) _Pragma("unroll") for (int k = 0; k < 2; ++k) dst[m][k] = *(const LAS bf16x8*)(lds + PG8_SA(b, h) + aoff + m * 2048 + k * 1024); } while (0)
#define PG8_LDB(dst, b, h) do { _Pragma("unroll") for (int n = 0; n < 2; ++n) _Pragma("unroll") for (int k = 0; k < 2; ++k) dst[n][k] = *(const LAS bf16x8*)(lds + PG8_SB(b, h) + boff + n * 2048 + k * 1024); } while (0)
#define PG8_MMA(ai, bj, At, Bt) do { __builtin_amdgcn_s_setprio(1); _Pragma("unroll") for (int m = 0; m < 4; ++m) _Pragma("unroll") for (int n = 0; n < 2; ++n) _Pragma("unroll") for (int k = 0; k < 2; ++k) \
        acc[ai][bj][m][n] = __builtin_amdgcn_mfma_f32_16x16x32_bf16(Bt[n][k], At[m][k], acc[ai][bj][m][n], 0, 0, 0); __builtin_amdgcn_s_setprio(0); } while (0)
#define PG8_WAIT_V(n) asm volatile("s_waitcnt vmcnt(" #n ")" ::: "memory")
#define PG8_WAIT_L(n) asm volatile("s_waitcnt lgkmcnt(" #n ")" ::: "memory")
#define PG8_BAR __builtin_amdgcn_s_barrier()
#define PG8_SCHED __builtin_amdgcn_sched_barrier(0)
    Unit cur, nxt; int ui = 0;
    if (!S.next(0, cur)) return;
    f32x4 acc[2][2][4][2];
#pragma unroll
    for (int a = 0; a < 2; ++a)
#pragma unroll
        for (int b = 0; b < 2; ++b)
#pragma unroll
            for (int m = 0; m < 4; ++m)
#pragma unroll
                for (int n = 0; n < 2; ++n) acc[a][b][m][n] = (f32x4){0.f, 0.f, 0.f, 0.f};
    bf16x8 At[4][2], B0[2][2], B1[2][2];
    const char* cA = (const char*)g.A + (size_t)cur.pm * tstep; const char* cB = (const char*)g.Bt + (size_t)cur.pn * tstep;
    S.a_ready(cur);
    PG8_STAGE(PG8_SB(0, 0), cB, voffB); PG8_STAGE(PG8_SA(0, 0), cA, voffA); PG8_STAGE(PG8_SB(0, 1), cB + hstep, voffB); PG8_STAGE(PG8_SA(0, 1), cA + hstep, voffA);
    if (wr == 1) PG8_BAR;
    PG8_WAIT_V(4); PG8_BAR;
    PG8_STAGE(PG8_SB(1, 0), cB + kstep, voffB); PG8_STAGE(PG8_SA(1, 0), cA + kstep, voffA); PG8_STAGE(PG8_SB(1, 1), cB + hstep + kstep, voffB);
    PG8_WAIT_V(6); PG8_BAR;
    for (;;) {
        const bool has_next = S.next(ui + 1, nxt);
        const char* nA = has_next ? (const char*)g.A + (size_t)nxt.pm * tstep : cA; const char* nB = has_next ? (const char*)g.Bt + (size_t)nxt.pn * tstep : cB;
        for (int t = 0; t < nt; t += 2) {
            const bool last = (t == nt - 2);
            const char* a1 = cA + (size_t)(t + 1) * kstep;
            const char* a2 = last ? nA : cA + (size_t)(t + 2) * kstep; const char* b2 = last ? nB : cB + (size_t)(t + 2) * kstep;
            const char* a3 = a2 + kstep; const char* b3 = b2 + kstep;
            if (last && has_next) S.a_ready(nxt);
            PG8_LDB(B0, 0, 0); PG8_SCHED; PG8_LDA(At, 0, 0); PG8_STAGE(PG8_SA(1, 1), a1 + hstep, voffA);
            PG8_WAIT_L(8); PG8_BAR; PG8_WAIT_L(0); PG8_MMA(0, 0, At, B0); PG8_BAR; PG8_SCHED;
            PG8_LDB(B1, 0, 1); PG8_STAGE(PG8_SB(0, 0), b2, voffB);
            PG8_BAR; PG8_WAIT_L(0); PG8_MMA(0, 1, At, B1); PG8_BAR;
            PG8_LDA(At, 0, 1); PG8_STAGE(PG8_SA(0, 0), a2, voffA);
            PG8_BAR; PG8_WAIT_L(0); PG8_MMA(1, 0, At, B0); PG8_BAR; PG8_SCHED;
            PG8_STAGE(PG8_SB(0, 1), b2 + hstep, voffB);
            PG8_WAIT_V(6); PG8_BAR; PG8_MMA(1, 1, At, B1); PG8_BAR;
            PG8_LDB(B0, 1, 0); PG8_SCHED; PG8_LDA(At, 1, 0); PG8_STAGE(PG8_SA(0, 1), a2 + hstep, voffA);
            PG8_WAIT_L(8); PG8_BAR; PG8_WAIT_L(0); PG8_MMA(0, 0, At, B0); PG8_BAR; PG8_SCHED;
            PG8_LDB(B1, 1, 1); PG8_STAGE(PG8_SB(1, 0), b3, voffB);
            PG8_BAR; PG8_WAIT_L(0); PG8_MMA(0, 1, At, B1); PG8_BAR;
            PG8_LDA(At, 1, 1); PG8_STAGE(PG8_SA(1, 0), a3, voffA);
            PG8_BAR; PG8_WAIT_L(0); PG8_MMA(1, 0, At, B0); PG8_BAR; PG8_SCHED;
            PG8_STAGE(PG8_SB(1, 1), b3 + hstep, voffB);
            PG8_WAIT_V(6); PG8_BAR; PG8_MMA(1, 1, At, B1); PG8_BAR;
        }
        E(acc, cur, wr, wc, fr, fq); S.done(cur);
        if (!has_next) break;
#pragma unroll
        for (int a = 0; a < 2; ++a)
#pragma unroll
            for (int b = 0; b < 2; ++b)
#pragma unroll
                for (int m = 0; m < 4; ++m)
#pragma unroll
                    for (int n = 0; n < 2; ++n) acc[a][b][m][n] = (f32x4){0.f, 0.f, 0.f, 0.f};
        cur = nxt; cA = nA; cB = nB; ++ui;
    }
    PG8_WAIT_V(0);
    if (wr == 0) PG8_BAR;
    PG8_BAR;
#undef PG8_SA
#undef PG8_SB
#undef PG8_STAGE
#undef PG8_LDA
#undef PG8_LDB
#undef PG8_MMA
#undef PG8_WAIT_V
#undef PG8_WAIT_L
#undef PG8_BAR
#undef PG8_SCHED
}
}

__device__ __forceinline__ void rmsnorm_rows(const float* X, const float* gain, bf16_t* H) {
    const int wave = threadIdx.x >> 6, lane = threadIdx.x & 63;
    for (int row = blockIdx.x * 8 + wave; row < S_; row += gridDim.x * 8) {
        const float4* xr = (const float4*)(X + (size_t)row * D_);
        float4 v[8]; float ss = 0.f;
#pragma unroll
        for (int i = 0; i < 8; ++i) { v[i] = xr[i * 64 + lane]; ss += v[i].x * v[i].x + v[i].y * v[i].y + v[i].z * v[i].z + v[i].w * v[i].w; }
        ss = wave_sum(ss);
        const float sc = rsqrtf(ss * (1.0f / 2048.0f) + 1e-6f);
#pragma unroll
        for (int i = 0; i < 8; ++i) { const float4 g = ((const float4*)gain)[i * 64 + lane];
            u32x2 w; w.x = cvt_pk_bf16(v[i].x * sc * g.x, v[i].y * sc * g.y); w.y = cvt_pk_bf16(v[i].z * sc * g.z, v[i].w * sc * g.w);
            *(u32x2*)(H + (size_t)row * D_ + (i * 64 + lane) * 4) = w; }
    }
}

__device__ __forceinline__ void transpose_convert(const float* W, int K, int N, bf16_t* Bt, float* tile, int bid, int nblk) {
    const int tid = threadIdx.x; const int tk = K / 64, tn = N / 64;
    for (int u = bid; u < tk * tn; u += nblk) {
        const int k0 = (u / tn) * 64, n0 = (u % tn) * 64;
        __syncthreads();
#pragma unroll
        for (int i = 0; i < 8; ++i) { const int kk = i * 8 + (tid >> 6), nn = tid & 63; tile[kk * 65 + nn] = W[(size_t)(k0 + kk) * N + n0 + nn]; }
        __syncthreads();
#pragma unroll
        for (int i = 0; i < 4; ++i) { const int nn = i * 16 + (tid >> 5), kp = (tid & 31) * 2;
            *(unsigned*)(Bt + (size_t)(n0 + nn) * K + k0 + kp) = cvt_pk_bf16(tile[kp * 65 + nn], tile[(kp + 1) * 65 + nn]); }
    }
}

__device__ __forceinline__ void convert_flat(const float* src, bf16_t* dst, size_t n) {
    for (size_t i = ((size_t)blockIdx.x * 512 + threadIdx.x) * 8; i < n; i += (size_t)gridDim.x * 512 * 8) {
        const float4 a = *(const float4*)(src + i), b = *(const float4*)(src + i + 4);
        u32x4 w; w.x = cvt_pk_bf16(a.x, a.y); w.y = cvt_pk_bf16(a.z, a.w); w.z = cvt_pk_bf16(b.x, b.y); w.w = cvt_pk_bf16(b.z, b.w);
        *(u32x4*)(dst + i) = w;
    }
}

__device__ __forceinline__ void convert_fp8(const float* src, unsigned char* dst, size_t n, float sc, int bid, int nblk) {
    const int lane = threadIdx.x & 63, wv = threadIdx.x >> 6;
    for (size_t base = ((size_t)bid * 8 + wv) * 1024; base < n; base += (size_t)nblk * 8 * 1024) {
        float4 a[4];
#pragma unroll
        for (int j = 0; j < 4; ++j) a[j] = *(const float4*)(src + base + (size_t)(j * 64 + lane) * 4);
#pragma unroll
        for (int j = 0; j < 4; ++j) { int x = __builtin_amdgcn_cvt_pk_fp8_f32(a[j].x * sc, a[j].y * sc, 0, false); x = __builtin_amdgcn_cvt_pk_fp8_f32(a[j].z * sc, a[j].w * sc, x, true);
            *(unsigned*)(dst + base + (size_t)(j * 64 + lane) * 4) = (unsigned)x; }
    }
}

__device__ __forceinline__ void build_wpt(const float* wq, const bf16_t* KEYB, bf16_t* WPT, int bid, int nblk) {
    const int w = threadIdx.x >> 6, lane = threadIdx.x & 63, fr = lane & 15, fq = lane >> 4;
    for (int task = bid * 8 + w; task < 16 * 128; task += nblk * 8) {
        const int g = task >> 7, kb = task & 127;
        f32x4 acc[8];
#pragma unroll
        for (int n = 0; n < 8; ++n) acc[n] = (f32x4){0.f, 0.f, 0.f, 0.f};
#pragma unroll 2
        for (int ks = 0; ks < 8; ++ks) {
            const float4* wp = (const float4*)(wq + (size_t)(kb * 16 + fr) * 4096 + g * 256 + ks * 32 + fq * 8);
            const float4 x0 = wp[0], x1 = wp[1];
            u32x4 wv; wv.x = cvt_pk_bf16(x0.x, x0.y); wv.y = cvt_pk_bf16(x0.z, x0.w); wv.z = cvt_pk_bf16(x1.x, x1.y); wv.w = cvt_pk_bf16(x1.z, x1.w);
            const bf16x8 a = __builtin_bit_cast(bf16x8, wv);
#pragma unroll
            for (int n = 0; n < 8; ++n) {
                const bf16x8 b = *(const bf16x8*)(KEYB + (size_t)(g * 128 + n * 16 + fr) * 256 + ks * 32 + fq * 8);
                acc[n] = __builtin_amdgcn_mfma_f32_16x16x32_bf16(a, b, acc[n], 0, 0, 0);
            }
        }
#pragma unroll
        for (int n = 0; n < 8; ++n) { u32x2 o; o.x = cvt_pk_bf16(acc[n][0], acc[n][1]); o.y = cvt_pk_bf16(acc[n][2], acc[n][3]);
            *(u32x2*)(WPT + (size_t)(g * 128 + n * 16 + fr) * 2048 + kb * 16 + fq * 4) = o; }
    }
}

__device__ __forceinline__ void phase0(const Params& p, unsigned char* shm) {
    bf16_t* WB1 = (bf16_t*)(p.ws + WS_WB1);
    rmsnorm_rows(p.in[0], p.in[1], (bf16_t*)(p.ws + WS_H));
    transpose_convert(p.in[2], 2048, 6144, WB1, (float*)shm, blockIdx.x, gridDim.x);
    const float* mu = p.in[4]; const float* w1 = p.in[6]; const float* a1 = p.in[9]; const float* g1 = p.in[11];
    for (int idx = blockIdx.x * 512 + threadIdx.x; idx < 768 * 2048; idx += gridDim.x * 512) {
        const int j = idx >> 11, k = idx & 2047; float val = 0.f;
        if (j < 128) { const float m = mu[k], w = w1[k * 64 + (j & 63)]; val = (j < 64) ? w * (1.f - m) : w * m; }
        else if (j < 256) { const float m = mu[2048 + k], w = a1[k * 64 + (j & 63)]; val = (j < 192) ? w * (1.f - m) : w * m; }
        else if (j < 576) { const float m = mu[4096 + k]; const int jj = j - 256; const int c = jj < 160 ? jj : jj - 160; const float w = g1[k * 160 + c]; val = jj < 160 ? w * (1.f - m) : w * m; }
        WB1[(size_t)(6144 + j) * 2048 + k] = f2bf(val);
    }
    convert_flat(p.in[22], (bf16_t*)(p.ws + WS_KEYB), (size_t)8 * 2 * 128 * 256);
    bf16_t* W2T = (bf16_t*)(p.ws + WS_W2T); bf16_t* A2T = (bf16_t*)(p.ws + WS_A2T); bf16_t* G2T = (bf16_t*)(p.ws + WS_G2T);
    const float* w2 = p.in[7]; const float* a2 = p.in[10]; const float* g2 = p.in[12];
    for (int idx = blockIdx.x * 512 + threadIdx.x; idx < 1024 * 288; idx += gridDim.x * 512) {
        if (idx < 65536) { const int c = idx >> 6, j = idx & 63; W2T[idx] = f2bf(w2[j * 1024 + c]); }
        else if (idx < 131072) { const int i2 = idx - 65536; const int c = i2 >> 6, j = i2 & 63; A2T[i2] = f2bf(a2[j * 1024 + c]); }
        else { const int i2 = idx - 131072; const int c = i2 / 160, j = i2 % 160; G2T[i2] = f2bf(g2[j * 1024 + c]); }
    }
}

constexpr int ACT_LD = 296;
template <int KS, int KOFF, int KTOT, int KIND>
__device__ __forceinline__ void lora_stage(const LAS bf16_t* act, const bf16_t* WT, const float* bias, bf16_t* OUT, int t0, int w, int fr, int fq) {
#pragma unroll 1
    for (int nh = 0; nh < 2; ++nh) {
        f32x4 acc[4][4];
#pragma unroll
        for (int m = 0; m < 4; ++m)
#pragma unroll
            for (int n = 0; n < 4; ++n) acc[m][n] = (f32x4){0.f, 0.f, 0.f, 0.f};
#pragma unroll 1
        for (int ks = 0; ks < KS; ++ks) {
            bf16x8 a[4];
#pragma unroll
            for (int m = 0; m < 4; ++m) a[m] = *(const LAS bf16x8*)(act + (m * 16 + fr) * ACT_LD + KOFF + ks * 32 + fq * 8);
#pragma unroll
            for (int n = 0; n < 4; ++n) {
                const bf16x8 b = *(const bf16x8*)(WT + (size_t)(w * 128 + (nh * 4 + n) * 16 + fr) * KTOT + ks * 32 + fq * 8);
#pragma unroll
                for (int m = 0; m < 4; ++m) acc[m][n] = __builtin_amdgcn_mfma_f32_16x16x32_bf16(b, a[m], acc[m][n], 0, 0, 0);
            }
        }
#pragma unroll
        for (int n = 0; n < 4; ++n) {
            const int c = w * 128 + (nh * 4 + n) * 16 + fq * 4;
            float bs[4] = {0.f, 0.f, 0.f, 0.f};
            if (KIND < 2) { const float4 bv = *(const float4*)(bias + c); bs[0] = bv.x; bs[1] = bv.y; bs[2] = bv.z; bs[3] = bv.w; }
#pragma unroll
            for (int m = 0; m < 4; ++m) {
                float o[4];
#pragma unroll
                for (int j = 0; j < 4; ++j) {
                    const float val = acc[m][n][j];
                    if (KIND == 0) { const float x = -(bs[j] + val); const float sp = fmaxf(x, 0.f) + log1pf(__expf(-fabsf(x))); o[j] = -__expf(-sp - 0.5f); }
                    else if (KIND == 1) o[j] = sigmoidf_(bs[j] + val);
                    else o[j] = val;
                }
                u32x2 wv; wv.x = cvt_pk_bf16(o[0], o[1]); wv.y = cvt_pk_bf16(o[2], o[3]);
                *(u32x2*)(OUT + (size_t)(t0 + m * 16 + fr) * DR + c) = wv;
            }
        }
    }
}
__device__ __forceinline__ void phase_prepM(const Params& p, LAS unsigned char* lds) {
    LAS bf16_t* act = (LAS bf16_t*)lds;
    const bf16_t* P = (const bf16_t*)(p.ws + WS_PROJ);
    const int tid = threadIdx.x, w = tid >> 6, lane = tid & 63, fr = lane & 15, fq = lane >> 4;
    for (int tile = blockIdx.x; tile < S_ / 64; tile += gridDim.x) {
        const int t0 = tile * 64;
        __syncthreads();
        for (int task = tid; task < 64 * 36; task += 512) {
            const int t = task / 36, j0 = (task % 36) * 8; const int tg = t0 + t;
            int ccur, cprev;
            if (j0 < 64) { ccur = 6144 + j0; cprev = 6208 + j0; }
            else if (j0 < 128) { ccur = 6272 + (j0 - 64); cprev = 6336 + (j0 - 64); }
            else { ccur = 6400 + (j0 - 128); cprev = 6560 + (j0 - 128); }
            float cu[8], pv[8], o8[8];
            unpack8(*(const u32x4*)(P + (size_t)tg * NAUG + ccur), cu);
            if (tg > 0) unpack8(*(const u32x4*)(P + (size_t)(tg - 1) * NAUG + cprev), pv);
            else {
#pragma unroll
                for (int i = 0; i < 8; ++i) pv[i] = 0.f;
            }
#pragma unroll
            for (int i = 0; i < 8; ++i) { const float sv = cu[i] + pv[i];
                o8[i] = j0 < 64 ? (1.f - 2.f / (1.f + __expf(2.f * sv))) : (j0 < 128 ? sv : sigmoidf_(sv)); }
            *(LAS u32x4*)(act + t * ACT_LD + j0) = pack8(o8);
        }
        __syncthreads();
        lora_stage<2, 0, 64, 0>(act, (const bf16_t*)(p.ws + WS_W2T), p.in[5], (bf16_t*)(p.ws + WS_LW), t0, w, fr, fq);
        lora_stage<2, 64, 64, 1>(act, (const bf16_t*)(p.ws + WS_A2T), p.in[8], (bf16_t*)(p.ws + WS_A), t0, w, fr, fq);
        lora_stage<5, 128, 160, 2>(act, (const bf16_t*)(p.ws + WS_G2T), nullptr, (bf16_t*)(p.ws + WS_G), t0, w, fr, fq);
    }
}

__device__ __forceinline__ void phase_prepE(const Params& p) {
    const bf16_t* P = (const bf16_t*)(p.ws + WS_PROJ);
    bf16_t* R = (bf16_t*)(p.ws + WS_R); bf16_t* Kk = (bf16_t*)(p.ws + WS_K); bf16_t* V = (bf16_t*)(p.ws + WS_V); bf16_t* KK = (bf16_t*)(p.ws + WS_KK); bf16_t* YC = (bf16_t*)(p.ws + WS_YC);
    const float* mu_rkv = p.in[3]; const float* k_k = p.in[13]; const float* cw = p.in[18];
    const int tid = threadIdx.x, cg = tid & 127, c0 = cg * 8, tgrp = tid >> 7;
    float mr[8], mk[8], mv[8], kkc[8], cw0[8], cw1[8], cw2[8];
#pragma unroll
    for (int i = 0; i < 8; ++i) { mr[i] = mu_rkv[c0 + i]; mk[i] = mu_rkv[1024 + c0 + i]; mv[i] = mu_rkv[2048 + c0 + i]; kkc[i] = k_k[c0 + i]; cw0[i] = cw[c0 + i]; cw1[i] = cw[1024 + c0 + i]; cw2[i] = cw[2048 + c0 + i]; }
    for (int run = blockIdx.x * 4 + tgrp; run < S_ / 16; run += gridDim.x * 4) {
        const int t0 = run * 16;
        float pr[8], pk[8], pv[8], u1[8], u2[8];
#pragma unroll
        for (int i = 0; i < 8; ++i) { pr[i] = 0.f; pk[i] = 0.f; pv[i] = 0.f; u1[i] = 0.f; u2[i] = 0.f; }
        if (t0 > 0) {
            const size_t o = (size_t)(t0 - 1) * NAUG + c0;
            unpack8(*(const u32x4*)(P + o), pr); unpack8(*(const u32x4*)(P + o + 1024), pk); unpack8(*(const u32x4*)(P + o + 2048), pv);
            float x[8], y[8];
            unpack8(*(const u32x4*)(P + o + 4096), x); unpack8(*(const u32x4*)(P + o + 5120), y);
#pragma unroll
            for (int i = 0; i < 8; ++i) u1[i] = x[i] * y[i];
            unpack8(*(const u32x4*)(P + o - NAUG + 4096), x); unpack8(*(const u32x4*)(P + o - NAUG + 5120), y);
#pragma unroll
            for (int i = 0; i < 8; ++i) u2[i] = x[i] * y[i];
        }
        u32x4 nx[6];
        { const size_t o = (size_t)t0 * NAUG + c0;
#pragma unroll
          for (int q = 0; q < 6; ++q) nx[q] = *(const u32x4*)(P + o + 1024 * q); }
#pragma unroll 1
        for (int t = 0; t < 16; ++t) {
            float cr[8], ck[8], cv[8], bg[8], cgt[8], xc[8];
            unpack8(nx[0], cr); unpack8(nx[1], ck); unpack8(nx[2], cv); unpack8(nx[3], bg); unpack8(nx[4], cgt); unpack8(nx[5], xc);
            { const size_t o = (size_t)(t0 + (t < 15 ? t + 1 : t)) * NAUG + c0;
#pragma unroll
              for (int q = 0; q < 6; ++q) nx[q] = *(const u32x4*)(P + o + 1024 * q); }
            float r[8], k[8], v[8], kkv[8], yc[8]; float ss = 0.f;
#pragma unroll
            for (int i = 0; i < 8; ++i) {
                r[i] = cr[i] + (pr[i] - cr[i]) * mr[i]; k[i] = ck[i] + (pk[i] - ck[i]) * mk[i]; v[i] = cv[i] + (pv[i] - cv[i]) * mv[i];
                pr[i] = cr[i]; pk[i] = ck[i]; pv[i] = cv[i];
                kkv[i] = k[i] * kkc[i]; ss += kkv[i] * kkv[i];
                const float u0 = cgt[i] * xc[i];
                yc[i] = bg[i] * (cw0[i] * u2[i] + cw1[i] * u1[i] + cw2[i] * u0);
                u2[i] = u1[i]; u1[i] = u0;
            }
            ss += dpp_f<0xB1, 0xf>(ss); ss += dpp_f<0x4E, 0xf>(ss); ss += dpp_f<0x141, 0xf>(ss);
            const float inv = 1.0f / fmaxf(sqrtf(ss), 1e-12f);
#pragma unroll
            for (int i = 0; i < 8; ++i) kkv[i] *= inv;
            const size_t oo = (size_t)(t0 + t) * DR + c0;
            *(u32x4*)(R + oo) = pack8(r); *(u32x4*)(Kk + oo) = pack8(k); *(u32x4*)(V + oo) = pack8(v); *(u32x4*)(KK + oo) = pack8(kkv); *(u32x4*)(YC + oo) = pack8(yc);
        }
    }
}

#define TILE(i) ((LAS bf16_t*)(lds + (i) * TSLOT))
__device__ __forceinline__ f32x4 mm_tile(f32x4 acc, const LAS bf16_t* A, const LAS bf16_t* Bt, int mi, int ni, int fr, int fq) {
#pragma unroll
    for (int ks = 0; ks < 2; ++ks) {
        const bf16x8 a = *(const LAS bf16x8*)(A + (mi * 16 + fr) * TLD + ks * 32 + fq * 8);
        const bf16x8 b = *(const LAS bf16x8*)(Bt + (ni * 16 + fr) * TLD + ks * 32 + fq * 8);
        acc = __builtin_amdgcn_mfma_f32_16x16x32_bf16(a, b, acc, 0, 0, 0);
    }
    return acc;
}
__device__ __forceinline__ void st_rm(LAS bf16_t* X, f32x4 v, int mi, int ni, int fr, int fq) {
    const unsigned w0 = cvt_pk_bf16(v[0], v[1]), w1 = cvt_pk_bf16(v[2], v[3]);
    LAS bf16_t* q = X + (mi * 16 + fq * 4) * TLD + ni * 16 + fr;
    q[0] = (bf16_t)(w0 & 0xffffu); q[TLD] = (bf16_t)(w0 >> 16); q[2 * TLD] = (bf16_t)(w1 & 0xffffu); q[3 * TLD] = (bf16_t)(w1 >> 16);
}
__device__ __forceinline__ void st_tr(LAS bf16_t* XT, f32x4 v, int mi, int ni, int fr, int fq) {
    u32x2 w; w.x = cvt_pk_bf16(v[0], v[1]); w.y = cvt_pk_bf16(v[2], v[3]);
    *(LAS u32x2*)(XT + (ni * 16 + fr) * TLD + mi * 16 + fq * 4) = w;
}
__device__ __forceinline__ f32x4 ld_rm(const LAS bf16_t* X, int mi, int ni, int fr, int fq) {
    const LAS bf16_t* q = X + (mi * 16 + fq * 4) * TLD + ni * 16 + fr;
    return (f32x4){bf2f(q[0]), bf2f(q[TLD]), bf2f(q[2 * TLD]), bf2f(q[3 * TLD])};
}
__device__ __forceinline__ f32x4 ld_tr(const LAS bf16_t* XT, int mi, int ni, int fr, int fq) {
    const u32x2 w = *(const LAS u32x2*)(XT + (ni * 16 + fr) * TLD + mi * 16 + fq * 4);
    return (f32x4){lo_bf(w.x), hi_bf(w.x), lo_bf(w.y), hi_bf(w.y)};
}

__device__ __forceinline__ void phase_chunkA(const Params& p, LAS unsigned char* lds) {
    const int tid = threadIdx.x, w = tid >> 6, lane = tid & 63, fr = lane & 15, fq = lane >> 4;
    const int mi = w >> 1, nb = (w & 1) * 2;
    LAS float* cl = (LAS float*)(lds + 14 * TSLOT);
    LAS float* gs = (LAS float*)(lds + 16 * TSLOT);
    LAS float* wc = gs + 512;
    const bf16_t* R = (const bf16_t*)(p.ws + WS_R); const bf16_t* Kk = (const bf16_t*)(p.ws + WS_K); const bf16_t* V = (const bf16_t*)(p.ws + WS_V);
    const bf16_t* KK = (const bf16_t*)(p.ws + WS_KK); const bf16_t* A = (const bf16_t*)(p.ws + WS_A); const bf16_t* LW = (const bf16_t*)(p.ws + WS_LW);
    bf16_t* GT = (bf16_t*)(p.ws + WS_GT); float* HT = (float*)(p.ws + WS_HT); bf16_t* QE = (bf16_t*)(p.ws + WS_QE); bf16_t* YL = (bf16_t*)(p.ws + WS_YL);
    const f32x4 z4 = (f32x4){0.f, 0.f, 0.f, 0.f};
    const float* k_a = p.in[14]; const float* r_k = p.in[15]; float* BON = (float*)(p.ws + WS_BON);
    u32x4 nr4, nk4, nv4, nkk4, na4, nlw4;
#define CA_LOAD(it) do { const size_t _go = (size_t)(((it) >> 4) * 64 + (tid >> 3)) * DR + ((it) & 15) * 64 + (tid & 7) * 8; \
        nr4 = *(const u32x4*)(R + _go); nk4 = *(const u32x4*)(Kk + _go); nv4 = *(const u32x4*)(V + _go); nkk4 = *(const u32x4*)(KK + _go); na4 = *(const u32x4*)(A + _go); nlw4 = *(const u32x4*)(LW + _go); } while (0)
    for (int item = blockIdx.x; item < 4096; item += gridDim.x) {
        const int c = item >> 4, h = item & 15;
        const int t = tid >> 3, k0 = (tid & 7) * 8;
        if (item == (int)blockIdx.x) CA_LOAD(item);
        const u32x4 r4 = nr4, k4 = nk4, v4 = nv4, kk4 = nkk4, a4 = na4, lw4 = nlw4;
        __syncthreads();
        {
            float lwf8[8]; unpack8(lw4, lwf8);
            *(LAS f32x4*)(cl + t * 64 + k0) = (f32x4){lwf8[0], lwf8[1], lwf8[2], lwf8[3]};
            *(LAS f32x4*)(cl + t * 64 + k0 + 4) = (f32x4){lwf8[4], lwf8[5], lwf8[6], lwf8[7]};
            __syncthreads();
            const int g = w, k = lane;
            float pfx[8]; float run = 0.f;
#pragma unroll
            for (int i = 0; i < 8; ++i) { run += cl[(g * 8 + i) * 64 + k]; pfx[i] = run; }
            gs[g * 64 + k] = run;
            __syncthreads();
            float off = 0.f;
#pragma unroll
            for (int gg = 0; gg < 7; ++gg) { const float x = gs[gg * 64 + k]; off += (gg < g) ? x : 0.f; }
#pragma unroll
            for (int i = 0; i < 8; ++i) cl[(g * 8 + i) * 64 + k] = off + pfx[i];
            if (g == 7) wc[k] = __expf(off + pfx[7]);
            __syncthreads();
        }
        if (item + (int)gridDim.x < 4096) CA_LOAD(item + (int)gridDim.x);
        {
            float at[8], rt[8], bt[8], kt[8], bh[8], kh[8], vv[8]; float bsum = 0.f;
#pragma unroll
            for (int i = 0; i < 8; ++i) {
                const int q = i >> 1; const bool hi = i & 1;
                const float rf = hi ? hi_bf(r4[q]) : lo_bf(r4[q]), kraw = hi ? hi_bf(k4[q]) : lo_bf(k4[q]), vf = hi ? hi_bf(v4[q]) : lo_bf(v4[q]);
                const float kkf = hi ? hi_bf(kk4[q]) : lo_bf(kk4[q]), af = hi ? hi_bf(a4[q]) : lo_bf(a4[q]), lwf = hi ? hi_bf(lw4[q]) : lo_bf(lw4[q]);
                const float kf = kraw * (1.f + (af - 1.f) * k_a[h * 64 + k0 + i]);
                bsum += rf * kf * r_k[h * 64 + k0 + i];
                const float clv = cl[t * 64 + k0 + i], cle = cl[63 * 64 + k0 + i];
                const float e = __expf(clv), ex = __expf(clv - lwf), ei = __expf(-clv), eh = __expf(cle - clv);
                const float bb = kkf * af;
                at[i] = -kkf * ex; rt[i] = rf * e; bt[i] = bb * ei; kt[i] = kf * ei; bh[i] = bb * eh; kh[i] = kf * eh; vv[i] = vf;
            }
            bsum += dpp_f<0xB1, 0xf>(bsum); bsum += dpp_f<0x4E, 0xf>(bsum); bsum += dpp_f<0x141, 0xf>(bsum);
            if ((tid & 7) == 0) BON[(size_t)(c * 64 + t) * 16 + h] = bsum;
            *(LAS u32x4*)(TILE(0) + t * TLD + k0) = pack8(at);
            *(LAS u32x4*)(TILE(2) + t * TLD + k0) = pack8(rt);
            *(LAS u32x4*)(TILE(3) + t * TLD + k0) = pack8(bt);
            *(LAS u32x4*)(TILE(4) + t * TLD + k0) = pack8(kt);
            const u32x4 atp = pack8(at), bhp = pack8(bh), khp = pack8(kh);
#pragma unroll
            for (int i = 0; i < 8; ++i) {
                const int q = i >> 1; const bool hi = i & 1;
                TILE(1)[(k0 + i) * TLD + t] = (bf16_t)(hi ? (atp[q] >> 16) : (atp[q] & 0xffffu));
                TILE(5)[(k0 + i) * TLD + t] = (bf16_t)(hi ? (bhp[q] >> 16) : (bhp[q] & 0xffffu));
                TILE(6)[(k0 + i) * TLD + t] = (bf16_t)(hi ? (khp[q] >> 16) : (khp[q] & 0xffffu));
                TILE(7)[(k0 + i) * TLD + t] = (bf16_t)(hi ? (v4[q] >> 16) : (v4[q] & 0xffffu));
            }
            __syncthreads();
        }
#pragma unroll
        for (int nn = 0; nn < 2; ++nn) {
            const int ni = nb + nn; const int col = ni * 16 + fr, row0 = mi * 16 + fq * 4;
            f32x4 x = mm_tile(z4, TILE(0), TILE(3), mi, ni, fr, fq);
#pragma unroll
            for (int j = 0; j < 4; ++j) x[j] = (col < row0 + j) ? x[j] : 0.f;
            st_rm(TILE(8), x, mi, ni, fr, fq); st_tr(TILE(9), x, mi, ni, fr, fq);
            x = mm_tile(z4, TILE(0), TILE(4), mi, ni, fr, fq);
#pragma unroll
            for (int j = 0; j < 4; ++j) x[j] = (col < row0 + j) ? x[j] : 0.f;
            st_rm(TILE(10), x, mi, ni, fr, fq);
            x = mm_tile(z4, TILE(2), TILE(3), mi, ni, fr, fq);
#pragma unroll
            for (int j = 0; j < 4; ++j) x[j] = (col <= row0 + j) ? x[j] : 0.f;
            st_rm(TILE(11), x, mi, ni, fr, fq);
            x = mm_tile(z4, TILE(2), TILE(4), mi, ni, fr, fq);
#pragma unroll
            for (int j = 0; j < 4; ++j) x[j] = (col <= row0 + j) ? x[j] : 0.f;
            st_rm(TILE(12), x, mi, ni, fr, fq);
        }
        __syncthreads();
#pragma unroll
        for (int nn = 0; nn < 2; ++nn) {
            const int ni = nb + nn;
            st_tr(TILE(13), mm_tile(z4, TILE(10), TILE(7), mi, ni, fr, fq), mi, ni, fr, fq);
            const f32x4 x = mm_tile(z4, TILE(8), TILE(9), mi, ni, fr, fq);
            st_rm(TILE(0), x, mi, ni, fr, fq); st_tr(TILE(3), x, mi, ni, fr, fq);
        }
        __syncthreads();
#pragma unroll
        for (int rd = 0; rd < 5; ++rd) {
            const int tq = (rd & 1) ? 14 : 8, tqo = (rd & 1) ? 8 : 14;
            const int lx = (rd & 1) ? 4 : 0, lxt = (rd & 1) ? 9 : 3, lxo = (rd & 1) ? 0 : 4, lxto = (rd & 1) ? 3 : 9;
#pragma unroll
            for (int nn = 0; nn < 2; ++nn) {
                const int ni = nb + nn;
                f32x4 x = ld_rm(TILE(tq), mi, ni, fr, fq) + ld_rm(TILE(lx), mi, ni, fr, fq);
                x = mm_tile(x, TILE(tq), TILE(lxt), mi, ni, fr, fq);
                st_rm(TILE(tqo), x, mi, ni, fr, fq);
                if (rd < 4) { const f32x4 y = mm_tile(z4, TILE(lx), TILE(lxt), mi, ni, fr, fq); st_rm(TILE(lxo), y, mi, ni, fr, fq); st_tr(TILE(lxto), y, mi, ni, fr, fq); }
            }
            __syncthreads();
        }
#pragma unroll
        for (int nn = 0; nn < 2; ++nn) {
            const int ni = nb + nn;
            st_tr(TILE(10), mm_tile(ld_tr(TILE(1), mi, ni, fr, fq), TILE(14), TILE(1), mi, ni, fr, fq), mi, ni, fr, fq);
            st_tr(TILE(15), mm_tile(ld_tr(TILE(13), mi, ni, fr, fq), TILE(14), TILE(13), mi, ni, fr, fq), mi, ni, fr, fq);
        }
        __syncthreads();
#pragma unroll
        for (int nn = 0; nn < 2; ++nn) {
            const int ni = nb + nn;
            {
                f32x4 x = mm_tile(z4, TILE(5), TILE(10), mi, ni, fr, fq);
                if (mi == ni) {
#pragma unroll
                    for (int j = 0; j < 4; ++j) x[j] += (fq * 4 + j == fr) ? wc[ni * 16 + fr] : 0.f;
                }
                const unsigned w0 = cvt_pk_bf16(x[0], x[1]), w1 = cvt_pk_bf16(x[2], x[3]);
                bf16_t* gp = GT + (size_t)item * 4096 + (size_t)((mi * 2 + (ni >> 1)) * 64 + (fr >> 2) * 16 + fq * 4) * 8 + (ni & 1) * 4 + (fr & 3);
                gp[0] = (bf16_t)(w0 & 0xffffu); gp[8] = (bf16_t)(w0 >> 16); gp[16] = (bf16_t)(w1 & 0xffffu); gp[24] = (bf16_t)(w1 >> 16);
            }
            {
                f32x4 x = mm_tile(z4, TILE(5), TILE(15), mi, ni, fr, fq);
                x = mm_tile(x, TILE(6), TILE(7), mi, ni, fr, fq);
                *(f32x4*)(HT + (size_t)item * 4096 + (size_t)((ni * 4 + mi) * 64 + lane) * 4) = x;
            }
            {
                f32x4 x = ld_tr(TILE(2), mi, ni, fr, fq);
                x = mm_tile(x, TILE(10), TILE(11), mi, ni, fr, fq);
                u32x2 wv; wv.x = cvt_pk_bf16(x[0], x[1]); wv.y = cvt_pk_bf16(x[2], x[3]);
                *(u32x2*)(QE + (size_t)item * 4096 + (ni * 16 + fr) * 64 + mi * 16 + fq * 4) = wv;
            }
            {
                f32x4 x = mm_tile(z4, TILE(11), TILE(15), mi, ni, fr, fq);
                x = mm_tile(x, TILE(12), TILE(7), mi, ni, fr, fq);
                u32x2 wv; wv.x = cvt_pk_bf16(x[0], x[1]); wv.y = cvt_pk_bf16(x[2], x[3]);
                *(u32x2*)(YL + (size_t)item * 4096 + (size_t)((mi * 4 + ni) * 64 + lane) * 4) = wv;
            }
        }
    }
}

__device__ __forceinline__ void phase_seq(const Params& p) {
    if (threadIdx.x >= 64) return;
    const int head = blockIdx.x >> 2, vt = blockIdx.x & 3, lane = threadIdx.x, fr = lane & 15, fq = lane >> 4;
    const bf16_t* GT = (const bf16_t*)(p.ws + WS_GT); const float* HT = (const float*)(p.ws + WS_HT); bf16_t* S0 = (bf16_t*)(p.ws + WS_S0);
    f32x4 acc[4];
#pragma unroll
    for (int mb = 0; mb < 4; ++mb) acc[mb] = (f32x4){0.f, 0.f, 0.f, 0.f};
    bf16x8 ga[4][4][2]; f32x4 hh[4][4];
#define SEQ_LOAD(buf, cc) do { const size_t _it = (size_t)((cc) < 256 ? (cc) : 255) * 16 + head; \
        _Pragma("unroll") for (int mb = 0; mb < 4; ++mb) { \
            _Pragma("unroll") for (int ks = 0; ks < 2; ++ks) ga[buf][mb][ks] = *(const bf16x8*)(GT + _it * 4096 + (size_t)((mb * 2 + ks) * 64 + lane) * 8); \
            hh[buf][mb] = *(const f32x4*)(HT + _it * 4096 + (size_t)((vt * 4 + mb) * 64 + lane) * 4); } } while (0)
    SEQ_LOAD(0, 0); SEQ_LOAD(1, 1); SEQ_LOAD(2, 2); SEQ_LOAD(3, 3);
    for (int c0 = 0; c0 < 256; c0 += 4) {
#pragma unroll
        for (int b = 0; b < 4; ++b) {
            const int c = c0 + b; const size_t item = (size_t)c * 16 + head;
            u32x2 pk[4];
#pragma unroll
            for (int mb = 0; mb < 4; ++mb) { pk[mb].x = cvt_pk_bf16(acc[mb][0], acc[mb][1]); pk[mb].y = cvt_pk_bf16(acc[mb][2], acc[mb][3]);
                *(u32x2*)(S0 + item * 4096 + (vt * 16 + fr) * 64 + mb * 16 + fq * 4) = pk[mb]; }
            u32x4 b0w, b1w; b0w.x = pk[0].x; b0w.y = pk[0].y; b0w.z = pk[1].x; b0w.w = pk[1].y; b1w.x = pk[2].x; b1w.y = pk[2].y; b1w.z = pk[3].x; b1w.w = pk[3].y;
            const bf16x8 b0 = __builtin_bit_cast(bf16x8, b0w), b1 = __builtin_bit_cast(bf16x8, b1w);
#pragma unroll
            for (int mb = 0; mb < 4; ++mb) {
                const f32x4 x = __builtin_amdgcn_mfma_f32_16x16x32_bf16(ga[b][mb][0], b0, hh[b][mb], 0, 0, 0);
                acc[mb] = __builtin_amdgcn_mfma_f32_16x16x32_bf16(ga[b][mb][1], b1, x, 0, 0, 0);
            }
            SEQ_LOAD(b, c + 4);
        }
    }
#undef SEQ_LOAD
}

__device__ __forceinline__ void phase_chunkY(const Params& p, LAS unsigned char* lds) {
    LAS float* Yb = (LAS float*)lds;
    const int tid = threadIdx.x, w = tid >> 6, lane = tid & 63, fr = lane & 15, fq = lane >> 4;
    const int mi = w >> 1, nb = (w & 1) * 2;
    const bf16_t* R = (const bf16_t*)(p.ws + WS_R); const bf16_t* Kk = (const bf16_t*)(p.ws + WS_K); const bf16_t* V = (const bf16_t*)(p.ws + WS_V);
    const bf16_t* G = (const bf16_t*)(p.ws + WS_G); const bf16_t* YC = (const bf16_t*)(p.ws + WS_YC);
    const bf16_t* QE = (const bf16_t*)(p.ws + WS_QE); const bf16_t* YL = (const bf16_t*)(p.ws + WS_YL); const bf16_t* S0 = (const bf16_t*)(p.ws + WS_S0);
    bf16_t* YM = (bf16_t*)(p.ws + WS_YMIX);
    const float* gn_w = p.in[16]; const float* gn_b = p.in[17];
    u32x2 ywn[2]; bf16x8 an[2], bn[2][2]; bool first = true;
#define CY_LOAD(it) do { const bf16_t* _q = QE + (size_t)(it) * 4096; const bf16_t* _s = S0 + (size_t)(it) * 4096; const bf16_t* _y = YL + (size_t)(it) * 4096; \
        _Pragma("unroll") for (int ks = 0; ks < 2; ++ks) an[ks] = *(const bf16x8*)(_q + (mi * 16 + fr) * 64 + ks * 32 + fq * 8); \
        _Pragma("unroll") for (int nn = 0; nn < 2; ++nn) { ywn[nn] = *(const u32x2*)(_y + (size_t)((mi * 4 + nb + nn) * 64 + lane) * 4); \
            _Pragma("unroll") for (int ks = 0; ks < 2; ++ks) bn[nn][ks] = *(const bf16x8*)(_s + (nb + nn) * 16 * 64 + fr * 64 + ks * 32 + fq * 8); } } while (0)
    for (int item = blockIdx.x; item < 4096; item += gridDim.x) {
        const int c = item >> 4, h = item & 15;
        if (first) { first = false; CY_LOAD(item); }
        __syncthreads();
        const u32x2 ywc[2] = {ywn[0], ywn[1]}; const bf16x8 ac[2] = {an[0], an[1]}; const bf16x8 bc[2][2] = {{bn[0][0], bn[0][1]}, {bn[1][0], bn[1][1]}};
        if (item + (int)gridDim.x < 4096) CY_LOAD(item + (int)gridDim.x);
#pragma unroll
        for (int nn = 0; nn < 2; ++nn) {
            const int ni = nb + nn;
            const u32x2 yw = ywc[nn];
            f32x4 acc = (f32x4){lo_bf(yw.x), hi_bf(yw.x), lo_bf(yw.y), hi_bf(yw.y)};
#pragma unroll
            for (int ks = 0; ks < 2; ++ks) acc = __builtin_amdgcn_mfma_f32_16x16x32_bf16(ac[ks], bc[nn][ks], acc, 0, 0, 0);
#pragma unroll
            for (int j = 0; j < 4; ++j) Yb[(mi * 16 + fq * 4 + j) * 68 + ni * 16 + fr] = acc[j];
        }
        __syncthreads();
        {
            const int t = tid >> 3, k0 = (tid & 7) * 8; const int ch = h * 64 + k0;
            const size_t tg = (size_t)c * 64 + t; const size_t o = tg * DR + ch;
            const float* BON = (const float*)(p.ws + WS_BON);
            const u32x4 v4 = *(const u32x4*)(V + o), g4 = *(const u32x4*)(G + o), yc4 = *(const u32x4*)(YC + o);
            const float bon = BON[tg * 16 + h];
            const float4 gw0 = *(const float4*)(gn_w + ch), gw1 = *(const float4*)(gn_w + ch + 4), gb0 = *(const float4*)(gn_b + ch), gb1 = *(const float4*)(gn_b + ch + 4);
            const float gwv[8] = {gw0.x, gw0.y, gw0.z, gw0.w, gw1.x, gw1.y, gw1.z, gw1.w}, gbv[8] = {gb0.x, gb0.y, gb0.z, gb0.w, gb1.x, gb1.y, gb1.z, gb1.w};
            const f32x4 y0 = *(const LAS f32x4*)(Yb + t * 68 + k0), y1 = *(const LAS f32x4*)(Yb + t * 68 + k0 + 4);
            const float y[8] = {y0[0], y0[1], y0[2], y0[3], y1[0], y1[1], y1[2], y1[3]};
            float sm = 0.f;
#pragma unroll
            for (int i = 0; i < 8; ++i) sm += y[i];
            sm += dpp_f<0xB1, 0xf>(sm); sm += dpp_f<0x4E, 0xf>(sm); sm += dpp_f<0x141, 0xf>(sm);
            const float mean = sm * (1.f / 64.f);
            float vs = 0.f;
#pragma unroll
            for (int i = 0; i < 8; ++i) { const float d = y[i] - mean; vs += d * d; }
            vs += dpp_f<0xB1, 0xf>(vs); vs += dpp_f<0x4E, 0xf>(vs); vs += dpp_f<0x141, 0xf>(vs);
            const float rs = rsqrtf(vs * (1.f / 64.f) + 64e-5f);
            float vf[8], gf[8], of[8];
            unpack8(v4, vf); unpack8(g4, gf);
#pragma unroll
            for (int i = 0; i < 8; ++i) of[i] = ((y[i] - mean) * rs * gwv[i] + gbv[i] + bon * vf[i]) * gf[i];
            *(u32x4*)(YM + tg * D_ + ch) = pack8(of);
            *(u32x4*)(YM + tg * D_ + 1024 + ch) = yc4;
        }
    }
#undef CY_LOAD
}

__device__ __forceinline__ int f2key(float x) { const int u = __float_as_int(x); return u ^ ((u >> 31) & 0x7fffffff); }
__device__ __forceinline__ float key2f(int k) { return __int_as_float(k ^ ((k >> 31) & 0x7fffffff)); }
template <int CTRL> __device__ __forceinline__ int dpp_i(int v) { return __builtin_amdgcn_update_dpp(v, v, CTRL, 0xf, 0xf, false); }
__device__ __forceinline__ int row_max_i(int v) { v = max(v, dpp_i<0xB1>(v)); v = max(v, dpp_i<0x4E>(v)); v = max(v, dpp_i<0x141>(v)); v = max(v, dpp_i<0x140>(v)); return v; }
__device__ __forceinline__ void phase_topk(const Params& p, unsigned char* shm) {
    float* sc = (float*)shm;
    int* tk = (int*)(sc + 64 * 260);
    const float* SC = (const float*)(p.ws + WS_Q);
    int* IDS = (int*)(p.ws + WS_IDS); float* GATES = (float*)(p.ws + WS_GATES);
    const int tid = threadIdx.x, w = tid >> 6, lane = tid & 63;
    f32x4 qreg[8];
#define TK_QLOAD(it) do { const int _t0 = ((it) >> 3) * 64; _Pragma("unroll") for (int i = 0; i < 8; ++i) { const int ch = tid + 512 * i; \
        qreg[i] = *(const f32x4*)(SC + (size_t)(_t0 + (ch >> 6)) * 2048 + ((it) & 7) * 256 + (ch & 63) * 4); } } while (0)
    if ((int)blockIdx.x < 2048) TK_QLOAD((int)blockIdx.x);
    for (int item = blockIdx.x; item < 2048; item += gridDim.x) {
        const int t0 = (item >> 3) * 64, h = item & 7;
        __syncthreads();
#pragma unroll
        for (int i = 0; i < 8; ++i) { const int ch = tid + 512 * i; *(f32x4*)(sc + (ch >> 6) * 260 + (ch & 63) * 4) = qreg[i]; }
        __syncthreads();
        if (item + (int)gridDim.x < 2048) TK_QLOAD(item + (int)gridDim.x);
        for (int g = 0; g < 4; ++g) {
            const int L = w * 16 + g * 4 + (lane >> 4); const int tok = L >> 1, cc = L & 1; const int pp = lane & 15;
            int key[8];
#pragma unroll
            for (int i = 0; i < 8; ++i) key[i] = (f2key(sc[tok * 260 + cc * 128 + i * 16 + pp]) & ~127) | (127 - (i * 16 + pp));
            int mykey = 0;
#pragma unroll
            for (int r = 0; r < 16; ++r) {
                const int ml = max(max(max(key[0], key[1]), max(key[2], key[3])), max(max(key[4], key[5]), max(key[6], key[7])));
                const int m = row_max_i(ml);
#pragma unroll
                for (int i = 0; i < 8; ++i) key[i] = (key[i] == m) ? (int)0x80000000 : key[i];
                mykey = (pp == r) ? m : mykey;
            }
            tk[L * 16 + pp] = mykey;
        }
        __syncthreads();
        for (int g = 0; g < 2; ++g) {
            const int tok = w * 8 + g * 4 + (lane >> 4); const int pp = lane & 15;
            const float s1 = key2f(tk[(tok * 2) * 16 + pp] & ~127);
            int key[16];
#pragma unroll
            for (int j = 0; j < 16; ++j) { const float s2 = key2f(tk[(tok * 2 + 1) * 16 + j] & ~127); key[j] = (f2key(s1 + s2) & ~255) | (255 - (pp * 16 + j)); }
            int mykey = 0;
#pragma unroll
            for (int r = 0; r < 16; ++r) {
                int ml = max(max(max(key[0], key[1]), max(key[2], key[3])), max(max(key[4], key[5]), max(key[6], key[7])));
                ml = max(ml, max(max(max(key[8], key[9]), max(key[10], key[11])), max(max(key[12], key[13]), max(key[14], key[15]))));
                const int m = row_max_i(ml);
#pragma unroll
                for (int j = 0; j < 16; ++j) key[j] = (key[j] == m) ? (int)0x80000000 : key[j];
                mykey = (pp == r) ? m : mykey;
            }
            const int ci = 255 - (mykey & 255); const float cs = key2f(mykey & ~255);
            const int e1 = 127 - (tk[(tok * 2) * 16 + (ci >> 4)] & 127), e2 = 127 - (tk[(tok * 2 + 1) * 16 + (ci & 15)] & 127);
            const float mx = __shfl(cs, lane & 48);
            const float e = __expf(cs - mx);
            float sum = e; sum += dpp_f<0xB1, 0xf>(sum); sum += dpp_f<0x4E, 0xf>(sum); sum += dpp_f<0x141, 0xf>(sum); sum += dpp_f<0x140, 0xf>(sum);
            IDS[(size_t)(t0 + tok) * 128 + h * 16 + pp] = (e1 * 128 + e2) & 16383;
            GATES[(size_t)(t0 + tok) * 128 + h * 16 + pp] = e / sum;
        }
    }
#undef TK_QLOAD
}

constexpr float U8_SCALE = 64.f, V8_SCALE = 32.f;
__device__ __forceinline__ float gelu_fast(float x) { const float u = 0.7978845608028654f * (x + 0.044715f * x * x * x); return x / (1.0f + __expf(-2.0f * u)); }
__device__ __forceinline__ void phase_gather(const Params& p, unsigned char* shm) {
    const bf16_t* H2 = (const bf16_t*)(p.ws + WS_H2); const float* X1 = (const float*)(p.ws + WS_X1);
    const unsigned char* U8 = p.ws + WS_UB; const unsigned char* V8 = p.ws + WS_VB;
    const int* IDS = (const int*)(p.ws + WS_IDS); const float* GATES = (const float*)(p.ws + WS_GATES);
    const float* nf = p.in[25];
    const int tid = threadIdx.x, w = tid >> 6, lane = tid & 63;
    for (int t = blockIdx.x * 8 + w; t < S_; t += gridDim.x * 8) {
        f32x2 hp[16];
#pragma unroll
        for (int q = 0; q < 2; ++q)
#pragma unroll
            for (int hh = 0; hh < 2; ++hh) { const u32x4 hv = *(const u32x4*)(H2 + (size_t)t * D_ + q * 1024 + lane * 16 + hh * 8);
#pragma unroll
                for (int i = 0; i < 4; ++i) hp[q * 8 + hh * 4 + i] = (f32x2){lo_bf(hv[i]), hi_bf(hv[i])}; }
        const int id0 = IDS[(size_t)t * 128 + lane], id1 = IDS[(size_t)t * 128 + 64 + lane];
        const float gt0 = GATES[(size_t)t * 128 + lane], gt1 = GATES[(size_t)t * 128 + 64 + lane];
        f32x2 op[16];
#pragma unroll
        for (int i = 0; i < 16; ++i) op[i] = (f32x2){0.f, 0.f};
        u32x4 ua[4][2], ub[4][2], vb[4][2];
#define G_LOADU(dst, grp) do { _Pragma("unroll") for (int j = 0; j < 4; ++j) { const int e = (grp) * 4 + j; const int id = __builtin_amdgcn_readlane(e < 64 ? id0 : id1, e & 63); \
            const unsigned char* ur = U8 + (size_t)id * D_ + lane * 16; dst[j][0] = *(const u32x4*)ur; dst[j][1] = *(const u32x4*)(ur + 1024); } } while (0)
#define G_LOADV(grp) do { _Pragma("unroll") for (int j = 0; j < 4; ++j) { const int e = (grp) * 4 + j; const int id = __builtin_amdgcn_readlane(e < 64 ? id0 : id1, e & 63); \
            const unsigned char* vr = V8 + (size_t)id * D_ + lane * 16; vb[j][0] = *(const u32x4*)vr; vb[j][1] = *(const u32x4*)(vr + 1024); } } while (0)
#define G_BODY(cur, nxt, grp) do { \
            G_LOADV(grp); \
            G_LOADU(nxt, ((grp) + 1 < 32 ? (grp) + 1 : 31)); \
            float dsel = 0.f; \
            _Pragma("unroll") for (int j = 0; j < 4; ++j) { f32x2 d2 = (f32x2){0.f, 0.f}; \
                _Pragma("unroll") for (int q = 0; q < 2; ++q) _Pragma("unroll") for (int i = 0; i < 4; ++i) { \
                    d2 += __builtin_amdgcn_cvt_pk_f32_fp8((int)cur[j][q][i], false) * hp[q * 8 + 2 * i]; d2 += __builtin_amdgcn_cvt_pk_f32_fp8((int)cur[j][q][i], true) * hp[q * 8 + 2 * i + 1]; } \
                const float d = wave_sum_dpp(d2.x + d2.y); dsel = (lane == j) ? d : dsel; } \
            const float av = gelu_fast(dsel * (1.f / U8_SCALE)) * (1.f / V8_SCALE); \
            _Pragma("unroll") for (int j = 0; j < 4; ++j) { const int e = (grp) * 4 + j; \
                const float a = __int_as_float(__builtin_amdgcn_readlane(__float_as_int(av), j)) * __int_as_float(__builtin_amdgcn_readlane(__float_as_int(e < 64 ? gt0 : gt1), e & 63)); \
                const f32x2 a2 = (f32x2){a, a}; \
                _Pragma("unroll") for (int q = 0; q < 2; ++q) _Pragma("unroll") for (int i = 0; i < 4; ++i) { \
                    op[q * 8 + 2 * i] += a2 * __builtin_amdgcn_cvt_pk_f32_fp8((int)vb[j][q][i], false); op[q * 8 + 2 * i + 1] += a2 * __builtin_amdgcn_cvt_pk_f32_fp8((int)vb[j][q][i], true); } } \
        } while (0)
        G_LOADU(ua, 0);
#pragma unroll 1
        for (int g2 = 0; g2 < 32; g2 += 2) { G_BODY(ua, ub, g2); G_BODY(ub, ua, g2 + 1); }
#undef G_LOADU
#undef G_LOADV
#undef G_BODY
        float ss = 0.f; float4 xs[8];
#pragma unroll
        for (int q = 0; q < 2; ++q)
#pragma unroll
            for (int i = 0; i < 4; ++i) { float4 x = *(const float4*)(X1 + (size_t)t * D_ + q * 1024 + lane * 16 + 4 * i);
                x.x += op[q * 8 + 2 * i].x; x.y += op[q * 8 + 2 * i].y; x.z += op[q * 8 + 2 * i + 1].x; x.w += op[q * 8 + 2 * i + 1].y;
                ss += x.x * x.x + x.y * x.y + x.z * x.z + x.w * x.w; xs[q * 4 + i] = x; }
        ss = wave_sum_dpp(ss);
        const float scl = rsqrtf(ss * (1.f / 2048.f) + 1e-6f);
#pragma unroll
        for (int q = 0; q < 2; ++q)
#pragma unroll
            for (int i = 0; i < 4; ++i) { const float4 g = *(const float4*)(nf + q * 1024 + lane * 16 + 4 * i); const float4 x = xs[q * 4 + i];
                *(float4*)(p.out + (size_t)t * D_ + q * 1024 + lane * 16 + 4 * i) = make_float4(x.x * scl * g.x, x.y * scl * g.y, x.z * scl * g.z, x.w * scl * g.w); }
    }
}

#define XB_TMO      128
#define XB_XCNT(j)  (256  + 64 * (j))
#define XB_XSUB(j)  (1280 + 64 * (j))
#define XB_XGEN(j)  (2304 + 64 * (j))
#define XB_TOP      3328
#define XB_TOPGEN   3392
#define XCD_BAR_WORDS 3456
#define XB_SPIN_CAP (1u << 18)
__device__ __forceinline__ unsigned xb_ld(unsigned* p)              { return __hip_atomic_load(p, __ATOMIC_RELAXED, __HIP_MEMORY_SCOPE_AGENT); }
__device__ __forceinline__ unsigned xb_add(unsigned* p, unsigned v) { return __hip_atomic_fetch_add(p, v, __ATOMIC_RELAXED, __HIP_MEMORY_SCOPE_AGENT); }
__device__ __forceinline__ unsigned xb_xcc_id() { return (unsigned)__builtin_amdgcn_s_getreg((3 << 11) | 20) & 0xFu; }
#define XB_SPIN(cond, bar) do { unsigned _sp = 0; while (cond) { __builtin_amdgcn_s_sleep(1); \
    if ((++_sp & 255u) == 0u) { if (xb_ld(&(bar)[XB_TMO])) break; if (_sp > XB_SPIN_CAP) { atomicAdd(&(bar)[XB_TMO], 1u); break; } } } } while (0)
struct XcdBarrier { unsigned* bar; unsigned x; volatile LAS unsigned* st; };
__device__ __forceinline__ XcdBarrier xcd_barrier_post(unsigned* bar, volatile LAS unsigned* st) {
    XcdBarrier b; b.bar = bar; b.x = xb_xcc_id(); b.st = st;
    if (threadIdx.x == 0) (void)xb_add(&bar[XB_XCNT(b.x)], 1u);
    return b;
}
__device__ __forceinline__ void xcd_barrier_complete(unsigned* bar, unsigned x, unsigned& nloc, unsigned& nx) {
    const unsigned G = gridDim.x * gridDim.y * gridDim.z;
    unsigned sum, cnt, mine, sp = 0u;
    for (;;) {
        sum = 0u; cnt = 0u; mine = 0u;
#pragma unroll
        for (unsigned j = 0; j < 16; ++j) { const unsigned c = xb_ld(&bar[XB_XCNT(j)]); sum += c; cnt += (c > 0u) ? 1u : 0u; mine = (j == x) ? c : mine; }
        if (sum == G) break;
        __builtin_amdgcn_s_sleep(1);
        if ((++sp & 255u) == 0u) { if (xb_ld(&bar[XB_TMO])) break; if (sp > XB_SPIN_CAP) { atomicAdd(&bar[XB_TMO], 1u); break; } }
    }
    nloc = mine > 0u ? mine : 1u; nx = cnt > 0u ? cnt : 1u;
}
__device__ __forceinline__ void xcd_barrier(const XcdBarrier& b) {
    asm volatile("s_waitcnt vmcnt(0)" ::: "memory");
    __syncthreads();
    if (threadIdx.x == 0) {
        unsigned* bar = b.bar;
        __builtin_amdgcn_s_waitcnt(0);
        unsigned nloc = b.st[0], nx = b.st[1];
        if (nloc == 0u) { xcd_barrier_complete(bar, b.x, nloc, nx); b.st[0] = nloc; b.st[1] = nx; }
        const unsigned old = xb_add(&bar[XB_XSUB(b.x)], 1u);
        const unsigned gen = old / nloc;
        if (old + 1u == (gen + 1u) * nloc) {
            __builtin_amdgcn_fence(__ATOMIC_RELEASE, "agent");
            asm volatile("s_waitcnt vmcnt(0)" ::: "memory");
            const unsigned og = xb_add(&bar[XB_TOP], 1u);
            const unsigned tg = og / nx;
            if (og + 1u == (tg + 1u) * nx) xb_add(&bar[XB_TOPGEN], 1u);
            else XB_SPIN(xb_ld(&bar[XB_TOPGEN]) == tg, bar);
            __builtin_amdgcn_fence(__ATOMIC_ACQUIRE, "agent");
            xb_add(&bar[XB_XGEN(b.x)], 1u);
            asm volatile("s_waitcnt vmcnt(0)" ::: "memory");
        } else {
            XB_SPIN(xb_ld(&bar[XB_XGEN(b.x)]) == gen, bar);
            __builtin_amdgcn_fence(__ATOMIC_ACQUIRE, "agent");
            asm volatile("s_waitcnt vmcnt(0)" ::: "memory");
        }
    }
    __syncthreads();
}

__global__ void __launch_bounds__(512, 2) mega(Params p) {
    extern __shared__ __attribute__((aligned(16))) unsigned char shm[];
    cg::grid_group grid = cg::this_grid();
    LAS unsigned char* lds = (LAS unsigned char*)shm;
    volatile LAS unsigned* bst = (volatile LAS unsigned*)(lds + LDS_BYTES - 16);
    if (threadIdx.x == 0) { bst[0] = 0u; bst[1] = 0u; }
    __syncthreads();
    const XcdBarrier xbar = xcd_barrier_post((unsigned*)(p.ws + WS_BAR), bst);
    if (p.ph_hi > 1000) grid.sync();
    const int lo = p.ph_lo, hi = p.ph_hi;
#define IN(k) (lo <= (k) && (k) < hi)
#define REP(k) for (int _r = 0; _r < ((k) == DUP_PHASE ? 2 : 1); ++_r)
#define SEAM(k) do { if (IN(k) && IN((k) + 1)) xcd_barrier(xbar); } while (0)
    if (IN(0)) REP(0) { if (_r) xcd_barrier(xbar); phase0(p, shm); }
    SEAM(0);
    if (IN(1)) REP(1) { if (_r) xcd_barrier(xbar);
        pg8::Gemm g{(const bf16_t*)(p.ws + WS_H), (const bf16_t*)(p.ws + WS_WB1), S_, NAUG, 2048};
        pg8::StaticOrder so; so.init(g.M, g.N, (int)gridDim.x, (int)blockIdx.x);
        pg8::EpiBf16 E{(bf16_t*)(p.ws + WS_PROJ), NAUG};
        pg8::gemm_phase(lds, g, so, E);
    }
    SEAM(1);
    if (IN(2)) REP(2) { if (_r) xcd_barrier(xbar);
        phase_prepM(p, lds);
        phase_prepE(p);
    }
    SEAM(2);
    if (IN(3)) REP(3) { if (_r) xcd_barrier(xbar); phase_chunkA(p, lds); }
    SEAM(3);
    if (IN(4)) REP(4) { if (_r) xcd_barrier(xbar); if (blockIdx.x < 64) phase_seq(p);
        else { const int bid = blockIdx.x - 64, nblk = gridDim.x - 64;
            convert_fp8(p.in[23], p.ws + WS_UB, (size_t)16384 * 2048, U8_SCALE, bid, nblk);
            convert_fp8(p.in[24], p.ws + WS_VB, (size_t)16384 * 2048, V8_SCALE, bid, nblk);
            build_wpt(p.in[21], (const bf16_t*)(p.ws + WS_KEYB), (bf16_t*)(p.ws + WS_WQT), bid, nblk);
            transpose_convert(p.in[19], 2048, 2048, (bf16_t*)(p.ws + WS_WOT), (float*)shm, bid, nblk); } }
    SEAM(4);
    if (IN(5)) REP(5) { if (_r) xcd_barrier(xbar); phase_chunkY(p, lds); }
    SEAM(5);
    if (IN(6)) REP(6) { if (_r) xcd_barrier(xbar);
        pg8::Gemm g{(const bf16_t*)(p.ws + WS_YMIX), (const bf16_t*)(p.ws + WS_WOT), S_, 2048, 2048};
        pg8::StaticOrder so; so.init(g.M, g.N, (int)gridDim.x, (int)blockIdx.x);
        pg8::EpiResF32 E{(float*)(p.ws + WS_X1), p.in[0], 2048};
        pg8::gemm_phase(lds, g, so, E);
    }
    SEAM(6);
    if (IN(7)) REP(7) { if (_r) xcd_barrier(xbar);
        rmsnorm_rows((const float*)(p.ws + WS_X1), p.in[20], (bf16_t*)(p.ws + WS_H2));
    }
    SEAM(7);
    if (IN(8)) REP(8) { if (_r) xcd_barrier(xbar);
        pg8::Gemm g{(const bf16_t*)(p.ws + WS_H2), (const bf16_t*)(p.ws + WS_WQT), S_, 2048, 2048};
        pg8::StaticOrder so; so.init(g.M, g.N, (int)gridDim.x, (int)blockIdx.x);
        pg8::EpiF32 E{(float*)(p.ws + WS_Q), 2048};
        pg8::gemm_phase(lds, g, so, E);
    }
    SEAM(8);
    if (IN(9)) REP(9) { if (_r) xcd_barrier(xbar); phase_topk(p, shm); }
    SEAM(9);
    if (IN(10)) REP(10) { if (_r) xcd_barrier(xbar); phase_gather(p, shm); }
#undef IN
#undef REP
#undef SEAM
}

extern "C" void kernel_launch(void* const* d_in, const int* in_sizes, int n_in, void* d_out, int out_size, void* d_ws, size_t ws_size, hipStream_t stream) {
    static int grid_blocks = 0;
    if (grid_blocks == 0) {
        if (n_in != 26 || ws_size < WS_NEED) { fprintf(stderr, "kernel_launch: unexpected n_in %d / ws_size %zu\n", n_in, ws_size); grid_blocks = -1; return; }
        int dev = 0, cus = 0, per_cu = 0;
        (void)hipGetDevice(&dev);
        (void)hipDeviceGetAttribute(&cus, hipDeviceAttributeMultiprocessorCount, dev);
        (void)hipFuncSetAttribute((const void*)mega, hipFuncAttributeMaxDynamicSharedMemorySize, LDS_BYTES);
        (void)hipOccupancyMaxActiveBlocksPerMultiprocessor(&per_cu, (const void*)mega, 512, LDS_BYTES);
        if (per_cu < 1) { fprintf(stderr, "kernel_launch: occupancy query says %d blocks/CU\n", per_cu); per_cu = 1; }
        grid_blocks = cus * per_cu;
        fprintf(stderr, "kernel_launch: cus %d per_cu %d grid %d\n", cus, per_cu, grid_blocks);
    }
    if (grid_blocks < 0) return;
    Params p{};
    for (int i = 0; i < 26; ++i) p.in[i] = (const float*)d_in[i];
    p.out = (float*)d_out; p.ws = (unsigned char*)d_ws;
#if MULTI_LAUNCH
    for (int ph = 0; ph < NPHASE; ++ph) {
        p.ph_lo = ph; p.ph_hi = ph + 1;
        hipLaunchKernelGGL(mega, dim3(grid_blocks), dim3(512), LDS_BYTES, stream, p);
    }
#else
    p.ph_lo = 0; p.ph_hi = NPHASE;
    if (hipMemsetAsync((unsigned char*)d_ws + WS_BAR, 0, XCD_BAR_WORDS * 4, stream) != hipSuccess) fprintf(stderr, "kernel_launch: barrier memset failed\n");
    void* args[] = {&p};
    hipError_t e = hipLaunchCooperativeKernel((const void*)mega, dim3(grid_blocks), dim3(512), args, LDS_BYTES, stream);
    if (e != hipSuccess) fprintf(stderr, "cooperative launch failed: %s (grid %d)\n", hipGetErrorString(e), grid_blocks);
#endif
}
```

```cpp
#include <hip/hip_runtime.h>
#include <hip/hip_cooperative_groups.h>
#include <cstdio>
namespace cg = cooperative_groups;

#ifndef DUP_PHASE
#define DUP_PHASE -1
#endif
#ifndef MULTI_LAUNCH
#define MULTI_LAUNCH 0
#endif

#define LAS __attribute__((address_space(3)))
typedef unsigned short bf16_t;
typedef short bf16x8 __attribute__((ext_vector_type(8)));
typedef float f32x4 __attribute__((ext_vector_type(4)));
typedef float f32x2 __attribute__((ext_vector_type(2)));
typedef unsigned u32x4 __attribute__((ext_vector_type(4)));
typedef unsigned u32x2 __attribute__((ext_vector_type(2)));

constexpr int S_ = 16384, D_ = 2048, DR = 1024, NAUG = 6912;
constexpr size_t MiB = 1ull << 20;
constexpr size_t WS_PROJ = 0, WS_H = 216 * MiB, WS_WB1 = 280 * MiB, WS_WQT = 280 * MiB, WS_WOT = 296 * MiB;
constexpr size_t WS_R = 307 * MiB, WS_K = 339 * MiB, WS_V = 371 * MiB, WS_KK = 403 * MiB, WS_A = 435 * MiB, WS_LW = 467 * MiB;
constexpr size_t WS_G = 216 * MiB, WS_YC = 248 * MiB, WS_YMIX = 307 * MiB, WS_X1 = 0, WS_H2 = 128 * MiB, WS_Q = 307 * MiB;
constexpr size_t WS_GT = 0, WS_HT = 32 * MiB, WS_QE = 96 * MiB, WS_YL = 128 * MiB, WS_S0 = 160 * MiB;
constexpr size_t WS_IDS = 192 * MiB, WS_GATES = 200 * MiB, WS_UB = 467 * MiB, WS_VB = 435 * MiB, WS_BON = 500 * MiB, WS_BAR = 502 * MiB, WS_KEYB = 503 * MiB, WS_NEED = 504 * MiB;
constexpr size_t WS_W2T = 499 * MiB, WS_A2T = WS_W2T + 131072, WS_G2T = WS_A2T + 131072;
constexpr int TLD = 72, TSLOT = 64 * TLD * 2;
constexpr int LDS_BYTES = 16 * TSLOT + 2048 + 256 + 16;
constexpr int NPHASE = 11;

struct Params {
    const float* in[26];
    float* out;
    unsigned char* ws;
    int ph_lo, ph_hi;
};

__device__ __forceinline__ float bf2f(bf16_t b) { return __uint_as_float(((unsigned)b) << 16); }
__device__ __forceinline__ bf16_t f2bf(float f) { unsigned u = __float_as_uint(f); u += 0x7FFFu + ((u >> 16) & 1u); return (bf16_t)(u >> 16); }
typedef __bf16 bf16v2_t __attribute__((ext_vector_type(2)));
__device__ __forceinline__ unsigned cvt_pk_bf16(float lo, float hi) { const f32x2 v = {lo, hi}; const bf16v2_t r = __builtin_convertvector(v, bf16v2_t); return __builtin_bit_cast(unsigned, r); }
__device__ __forceinline__ u32x4 pack8(const float* f) { u32x4 w; w.x = cvt_pk_bf16(f[0], f[1]); w.y = cvt_pk_bf16(f[2], f[3]); w.z = cvt_pk_bf16(f[4], f[5]); w.w = cvt_pk_bf16(f[6], f[7]); return w; }
__device__ __forceinline__ float lo_bf(unsigned w) { return __uint_as_float(w << 16); }
__device__ __forceinline__ float hi_bf(unsigned w) { return __uint_as_float(w & 0xffff0000u); }
__device__ __forceinline__ void unpack8(const u32x4 v, float* f) {
#pragma unroll
    for (int i = 0; i < 4; ++i) { f[2 * i] = lo_bf(v[i]); f[2 * i + 1] = hi_bf(v[i]); }
}
__device__ __forceinline__ float wave_sum(float v) {
#pragma unroll
    for (int o = 32; o; o >>= 1) v += __shfl_xor(v, o);
    return v;
}
template <int CTRL, int RM> __device__ __forceinline__ float dpp_f(float v) { return __int_as_float(__builtin_amdgcn_update_dpp(0, __float_as_int(v), CTRL, RM, 0xf, false)); }
__device__ __forceinline__ float wave_sum_dpp(float v) {
    v += dpp_f<0xB1, 0xf>(v); v += dpp_f<0x4E, 0xf>(v); v += dpp_f<0x141, 0xf>(v); v += dpp_f<0x140, 0xf>(v);
    v += dpp_f<0x142, 0xa>(v); v += dpp_f<0x143, 0xc>(v);
    return __int_as_float(__builtin_amdgcn_readlane(__float_as_int(v), 63));
}
__device__ __forceinline__ float wave_max(float v) {
#pragma unroll
    for (int o = 32; o; o >>= 1) v = fmaxf(v, __shfl_xor(v, o));
    return v;
}
__device__ __forceinline__ float sigmoidf_(float x) { return 1.0f / (1.0f + __expf(-x)); }
__device__ __forceinline__ float gelu_tanh(float x) { float u = 0.7978845608028654f * (x + 0.044715f * x * x * x); return 0.5f * x * (1.0f + tanhf(u)); }

namespace pg8 {
constexpr int BM = 256, BK = 64, HALF = 128, HTB = HALF * BK * 2, STAGE_BYTES = 8 * HTB, NXCD = 8, WGM = 8;
__device__ __forceinline__ int lds_byte(int r, int c) { const int st = (r >> 4) * 2 + (c >> 5), rr = r & 15, cc = c & 31, ob = rr * 64 + cc * 2; return st * 1024 + (ob ^ (((ob >> 9) & 1) << 5)); }
__device__ __forceinline__ void stage_rc(int b, int& R, int& C) { const int st = b / 1024, sb = b % 1024, swz = sb ^ (((sb >> 9) & 1) << 5); R = (st >> 1) * 16 + swz / 64; C = (st & 1) * 32 + (swz % 64) / 2; }
__device__ __forceinline__ int perm32(int rho) { const int n = rho >> 4, i = rho & 15; return 8 * (i >> 2) + 4 * n + (i & 3); }
struct Unit { int pm, pn; };
struct Gemm { const bf16_t* A; const bf16_t* Bt; int M, N, K; };
struct StaticOrder {
    int nM, nN, nwg, G, c;
    __device__ void init(int M, int N, int G_, int c_) { nM = M / BM; nN = N / BM; nwg = nM * nN; G = G_; c = c_; }
    __device__ bool next(int i, Unit& u) const {
        const long L = (long)i * G + c; if (L >= nwg) return false;
        int wgid = (int)L; { const int q = nwg / NXCD, r = nwg % NXCD, xcd = wgid % NXCD, off = wgid / NXCD; wgid = (xcd < r ? xcd * (q + 1) : r * (q + 1) + (xcd - r) * q) + off; }
        const int nig = WGM * nN, gid = wgid / nig, fm = gid * WGM, gsz = (nM - fm) < WGM ? (nM - fm) : WGM;
        u.pm = fm + ((wgid % nig) % gsz); u.pn = (wgid % nig) / gsz; return true;
    }
    __device__ __forceinline__ void a_ready(const Unit&) const {}
    __device__ __forceinline__ void done(const Unit&) const {}
};
struct EpiResF32 {
    static constexpr bool PERM = false;
    float* C; const float* Res; int ldc;
    __device__ __forceinline__ void operator()(const f32x4 (&acc)[2][2][4][2], const Unit& u, int wr, int wc, int fr, int fq) const {
        const int row0 = u.pm * BM + wr * 64 + fr, col0 = u.pn * BM + wc * 32 + 4 * fq;
#pragma unroll
        for (int ai = 0; ai < 2; ++ai)
#pragma unroll
            for (int m = 0; m < 4; ++m) { const size_t ro = (size_t)(row0 + ai * HALF + m * 16) * ldc + col0;
#pragma unroll
                for (int bj = 0; bj < 2; ++bj)
#pragma unroll
                    for (int n = 0; n < 2; ++n) { const f32x4 rs = *(const f32x4*)(Res + ro + bj * HALF + n * 16); *(f32x4*)(C + ro + bj * HALF + n * 16) = acc[ai][bj][m][n] + rs; } }
    }
};
struct EpiF32 {
    static constexpr bool PERM = false;
    float* C; int ldc;
    __device__ __forceinline__ void operator()(const f32x4 (&acc)[2][2][4][2], const Unit& u, int wr, int wc, int fr, int fq) const {
        const int row0 = u.pm * BM + wr * 64 + fr, col0 = u.pn * BM + wc * 32 + 4 * fq;
#pragma unroll
        for (int ai = 0; ai < 2; ++ai)
#pragma unroll
            for (int m = 0; m < 4; ++m) { const size_t ro = (size_t)(row0 + ai * HALF + m * 16) * ldc + col0;
#pragma unroll
                for (int bj = 0; bj < 2; ++bj)
#pragma unroll
                    for (int n = 0; n < 2; ++n) *(f32x4*)(C + ro + bj * HALF + n * 16) = acc[ai][bj][m][n]; }
    }
};
struct EpiBf16 {
    static constexpr bool PERM = true;
    bf16_t* O; int ldc;
    __device__ __forceinline__ void operator()(const f32x4 (&acc)[2][2][4][2], const Unit& u, int wr, int wc, int fr, int fq) const {
        const int row0 = u.pm * BM + wr * 64 + fr; const int col0 = u.pn * BM + wc * 32 + 8 * fq;
#pragma unroll
        for (int ai = 0; ai < 2; ++ai)
#pragma unroll
            for (int m = 0; m < 4; ++m) { bf16_t* rowp = O + (size_t)(row0 + ai * HALF + m * 16) * ldc + col0;
#pragma unroll
                for (int bj = 0; bj < 2; ++bj) { const f32x4 v0 = acc[ai][bj][m][0], v1 = acc[ai][bj][m][1];
                    u32x4 w; w.x = cvt_pk_bf16(v0[0], v0[1]); w.y = cvt_pk_bf16(v0[2], v0[3]); w.z = cvt_pk_bf16(v1[0], v1[1]); w.w = cvt_pk_bf16(v1[2], v1[3]);
                    *(u32x4*)(rowp + bj * HALF) = w; } }
    }
};

template <class Epi, class Sched>
__device__ __forceinline__ void gemm_phase(LAS unsigned char* lds, const Gemm g, const Sched& S, const Epi& E) {
    const int tid = threadIdx.x, wid = __builtin_amdgcn_readfirstlane(tid >> 6), lane = tid & 63, wr = wid >> 2, wc = wid & 3, fr = lane & 15, fq = lane >> 4;
    const int K = g.K, nt = K / BK;
    unsigned voffA[2], voffB[2];
#pragma unroll
    for (int i = 0; i < 2; ++i) { int R, C; stage_rc(tid * 16 + i * 8192, R, C); const int Rb = Epi::PERM ? ((R & ~31) + perm32(R & 31)) : R;
        voffA[i] = (unsigned)(R * K + C) * 2u; voffB[i] = (unsigned)(Rb * K + C) * 2u; }
    const size_t kstep = (size_t)(BK * 2);
    const size_t hstep = (size_t)HALF * K * 2;
    const size_t tstep = 2 * hstep;
    const unsigned ldsw = (unsigned)wid * 1024u;
    const int aoff = lds_byte(wr * 64 + fr, fq * 8), boff = lds_byte(wc * 32 + fr, fq * 8);
#define PG8_SA(b, h) (((b) * 2 + (h)) * HTB)
#define PG8_SB(b, h) ((4 + (b) * 2 + (h)) * HTB)
#define PG8_STAGE(bufoff, gbase, voff) do { _Pragma("unroll") for (int _i = 0; _i < 2; ++_i) \
        __builtin_amdgcn_global_load_lds((const unsigned*)((const char*)(gbase) + (voff)[_i]), (LAS unsigned*)(lds + (bufoff) + ldsw + _i * 8192), 16, 0, 0); } while (0)
#define PG8_LDA(dst, b, h) do { _Pragma("unroll") for (int m = 0; m < 4; ++m) _Pragma("unroll") for (int k = 0; k < 2; ++k) dst[m][k] = *(const LAS bf16x8*)(lds + PG8_SA(b, h) + aoff + m * 2048 + k * 1024); } while (0)
#define PG8_LDB(dst, b, h) do { _Pragma("unroll") for (int n = 0; n < 2; ++n) _Pragma("unroll") for (int k = 0; k < 2; ++k) dst[n][k] = *(const LAS bf16x8*)(lds + PG8_SB(b, h) + boff + n * 2048 + k * 1024); } while (0)
#define PG8_MMA(ai, bj, At, Bt) do { __builtin_amdgcn_s_setprio(1); _Pragma("unroll") for (int m = 0; m < 4; ++m) _Pragma("unroll") for (int n = 0; n < 2; ++n) _Pragma("unroll") for (int k = 0; k < 2; ++k) \
        acc[ai][bj][m][n] = __builtin_amdgcn_mfma_f32_16x16x32_bf16(Bt[n][k], At[m][k], acc[ai][bj][m][n], 0, 0, 0); __builtin_amdgcn_s_setprio(0); } while (0)
#define PG8_WAIT_V(n) asm volatile("s_waitcnt vmcnt(" #n ")" ::: "memory")
#define PG8_WAIT_L(n) asm volatile("s_waitcnt lgkmcnt(" #n ")" ::: "memory")
#define PG8_BAR __builtin_amdgcn_s_barrier()
#define PG8_SCHED __builtin_amdgcn_sched_barrier(0)
    Unit cur, nxt; int ui = 0;
    if (!S.next(0, cur)) return;
    f32x4 acc[2][2][4][2];
#pragma unroll
    for (int a = 0; a < 2; ++a)
#pragma unroll
        for (int b = 0; b < 2; ++b)
#pragma unroll
            for (int m = 0; m < 4; ++m)
#pragma unroll
                for (int n = 0; n < 2; ++n) acc[a][b][m][n] = (f32x4){0.f, 0.f, 0.f, 0.f};
    bf16x8 At[4][2], B0[2][2], B1[2][2];
    const char* cA = (const char*)g.A + (size_t)cur.pm * tstep; const char* cB = (const char*)g.Bt + (size_t)cur.pn * tstep;
    S.a_ready(cur);
    PG8_STAGE(PG8_SB(0, 0), cB, voffB); PG8_STAGE(PG8_SA(0, 0), cA, voffA); PG8_STAGE(PG8_SB(0, 1), cB + hstep, voffB); PG8_STAGE(PG8_SA(0, 1), cA + hstep, voffA);
    if (wr == 1) PG8_BAR;
    PG8_WAIT_V(4); PG8_BAR;
    PG8_STAGE(PG8_SB(1, 0), cB + kstep, voffB); PG8_STAGE(PG8_SA(1, 0), cA + kstep, voffA); PG8_STAGE(PG8_SB(1, 1), cB + hstep + kstep, voffB);
    PG8_WAIT_V(6); PG8_BAR;
    for (;;) {
        const bool has_next = S.next(ui + 1, nxt);
        const char* nA = has_next ? (const char*)g.A + (size_t)nxt.pm * tstep : cA; const char* nB = has_next ? (const char*)g.Bt + (size_t)nxt.pn * tstep : cB;
        for (int t = 0; t < nt; t += 2) {
            const bool last = (t == nt - 2);
            const char* a1 = cA + (size_t)(t + 1) * kstep;
            const char* a2 = last ? nA : cA + (size_t)(t + 2) * kstep; const char* b2 = last ? nB : cB + (size_t)(t + 2) * kstep;
            const char* a3 = a2 + kstep; const char* b3 = b2 + kstep;
            if (last && has_next) S.a_ready(nxt);
            PG8_LDB(B0, 0, 0); PG8_SCHED; PG8_LDA(At, 0, 0); PG8_STAGE(PG8_SA(1, 1), a1 + hstep, voffA);
            PG8_WAIT_L(8); PG8_BAR; PG8_WAIT_L(0); PG8_MMA(0, 0, At, B0); PG8_BAR; PG8_SCHED;
            PG8_LDB(B1, 0, 1); PG8_STAGE(PG8_SB(0, 0), b2, voffB);
            PG8_BAR; PG8_WAIT_L(0); PG8_MMA(0, 1, At, B1); PG8_BAR;
            PG8_LDA(At, 0, 1); PG8_STAGE(PG8_SA(0, 0), a2, voffA);
            PG8_BAR; PG8_WAIT_L(0); PG8_MMA(1, 0, At, B0); PG8_BAR; PG8_SCHED;
            PG8_STAGE(PG8_SB(0, 1), b2 + hstep, voffB);
            PG8_WAIT_V(6); PG8_BAR; PG8_MMA(1, 1, At, B1); PG8_BAR;
            PG8_LDB(B0, 1, 0); PG8_SCHED; PG8_LDA(At, 1, 0); PG8_STAGE(PG8_SA(0, 1), a2 + hstep, voffA);
            PG8_WAIT_L(8); PG8_BAR; PG8_WAIT_L(0); PG8_MMA(0, 0, At, B0); PG8_BAR; PG8_SCHED;
            PG8_LDB(B1, 1, 1); PG8_STAGE(PG8_SB(1, 0), b3, voffB);
            PG8_BAR; PG8_WAIT_L(0); PG8_MMA(0, 1, At, B1); PG8_BAR;
            PG8_LDA(At, 1, 1); PG8_STAGE(PG8_SA(1, 0), a3, voffA);
            PG8_BAR; PG8_WAIT_L(0); PG8_MMA(1, 0, At, B0); PG8_BAR; PG8_SCHED;
            PG8_STAGE(PG8_SB(1, 1), b3 + hstep, voffB);
            PG8_WAIT_V(6); PG8_BAR; PG8_MMA(1, 1, At, B1); PG8_BAR;
        }
        E(acc, cur, wr, wc, fr, fq); S.done(cur);
        if (!has_next) break;
#pragma unroll
        for (int a = 0; a < 2; ++a)
#pragma unroll
            for (int b = 0; b < 2; ++b)
#pragma unroll
                for (int m = 0; m < 4; ++m)
#pragma unroll
                    for (int n = 0; n < 2; ++n) acc[a][b][m][n] = (f32x4){0.f, 0.f, 0.f, 0.f};
        cur = nxt; cA = nA; cB = nB; ++ui;
    }
    PG8_WAIT_V(0);
    if (wr == 0) PG8_BAR;
    PG8_BAR;
#undef PG8_SA
#undef PG8_SB
#undef PG8_STAGE
#undef PG8_LDA
#undef PG8_LDB
#undef PG8_MMA
#undef PG8_WAIT_V
#undef PG8_WAIT_L
#undef PG8_BAR
#undef PG8_SCHED
}
}

__device__ __forceinline__ void rmsnorm_rows(const float* X, const float* gain, bf16_t* H) {
    const int wave = threadIdx.x >> 6, lane = threadIdx.x & 63;
    for (int row = blockIdx.x * 8 + wave; row < S_; row += gridDim.x * 8) {
        const float4* xr = (const float4*)(X + (size_t)row * D_);
        float4 v[8]; float ss = 0.f;
#pragma unroll
        for (int i = 0; i < 8; ++i) { v[i] = xr[i * 64 + lane]; ss += v[i].x * v[i].x + v[i].y * v[i].y + v[i].z * v[i].z + v[i].w * v[i].w; }
        ss = wave_sum(ss);
        const float sc = rsqrtf(ss * (1.0f / 2048.0f) + 1e-6f);
#pragma unroll
        for (int i = 0; i < 8; ++i) { const float4 g = ((const float4*)gain)[i * 64 + lane];
            u32x2 w; w.x = cvt_pk_bf16(v[i].x * sc * g.x, v[i].y * sc * g.y); w.y = cvt_pk_bf16(v[i].z * sc * g.z, v[i].w * sc * g.w);
            *(u32x2*)(H + (size_t)row * D_ + (i * 64 + lane) * 4) = w; }
    }
}

__device__ __forceinline__ void transpose_convert(const float* W, int K, int N, bf16_t* Bt, float* tile, int bid, int nblk) {
    const int tid = threadIdx.x; const int tk = K / 64, tn = N / 64, nt = tk * tn;
    float4 rg[2];
#define TC_LOAD(u) do { const int _k0 = ((u) / tn) * 64, _n0 = ((u) % tn) * 64; _Pragma("unroll") for (int i = 0; i < 2; ++i) { const int idx = tid + 512 * i; \
        rg[i] = *(const float4*)(W + (size_t)(_k0 + (idx >> 4)) * N + _n0 + (idx & 15) * 4); } } while (0)
    if (bid < nt) TC_LOAD(bid);
    for (int u = bid; u < nt; u += nblk) {
        const int k0 = (u / tn) * 64, n0 = (u % tn) * 64;
        __syncthreads();
#pragma unroll
        for (int i = 0; i < 2; ++i) { const int idx = tid + 512 * i; float* q = tile + (idx >> 4) * 65 + (idx & 15) * 4; q[0] = rg[i].x; q[1] = rg[i].y; q[2] = rg[i].z; q[3] = rg[i].w; }
        __syncthreads();
        if (u + nblk < nt) TC_LOAD(u + nblk);
#pragma unroll
        for (int i = 0; i < 4; ++i) { const int nn = i * 16 + (tid >> 5), kp = (tid & 31) * 2;
            *(unsigned*)(Bt + (size_t)(n0 + nn) * K + k0 + kp) = cvt_pk_bf16(tile[kp * 65 + nn], tile[(kp + 1) * 65 + nn]); }
    }
#undef TC_LOAD
}

__device__ __forceinline__ void convert_flat(const float* src, bf16_t* dst, size_t n) {
    for (size_t i = ((size_t)blockIdx.x * 512 + threadIdx.x) * 8; i < n; i += (size_t)gridDim.x * 512 * 8) {
        const float4 a = *(const float4*)(src + i), b = *(const float4*)(src + i + 4);
        u32x4 w; w.x = cvt_pk_bf16(a.x, a.y); w.y = cvt_pk_bf16(a.z, a.w); w.z = cvt_pk_bf16(b.x, b.y); w.w = cvt_pk_bf16(b.z, b.w);
        *(u32x4*)(dst + i) = w;
    }
}

__device__ __forceinline__ void convert_fp8(const float* src, unsigned char* dst, size_t n, float sc, int bid, int nblk) {
    const int lane = threadIdx.x & 63, wv = threadIdx.x >> 6;
    for (size_t base = ((size_t)bid * 8 + wv) * 1024; base < n; base += (size_t)nblk * 8 * 1024) {
        float4 a[4];
#pragma unroll
        for (int j = 0; j < 4; ++j) a[j] = *(const float4*)(src + base + (size_t)(j * 64 + lane) * 4);
#pragma unroll
        for (int j = 0; j < 4; ++j) { int x = __builtin_amdgcn_cvt_pk_fp8_f32(a[j].x * sc, a[j].y * sc, 0, false); x = __builtin_amdgcn_cvt_pk_fp8_f32(a[j].z * sc, a[j].w * sc, x, true);
            *(unsigned*)(dst + base + (size_t)(j * 64 + lane) * 4) = (unsigned)x; }
    }
}

__device__ __forceinline__ void build_wpt(const float* wq, const bf16_t* KEYB, bf16_t* WPT, int bid, int nblk) {
    const int w = threadIdx.x >> 6, lane = threadIdx.x & 63, fr = lane & 15, fq = lane >> 4;
    for (int task = bid * 8 + w; task < 16 * 128; task += nblk * 8) {
        const int g = task >> 7, kb = task & 127;
        f32x4 acc[8];
#pragma unroll
        for (int n = 0; n < 8; ++n) acc[n] = (f32x4){0.f, 0.f, 0.f, 0.f};
#pragma unroll 2
        for (int ks = 0; ks < 8; ++ks) {
            const float4* wp = (const float4*)(wq + (size_t)(kb * 16 + fr) * 4096 + g * 256 + ks * 32 + fq * 8);
            const float4 x0 = wp[0], x1 = wp[1];
            u32x4 wv; wv.x = cvt_pk_bf16(x0.x, x0.y); wv.y = cvt_pk_bf16(x0.z, x0.w); wv.z = cvt_pk_bf16(x1.x, x1.y); wv.w = cvt_pk_bf16(x1.z, x1.w);
            const bf16x8 a = __builtin_bit_cast(bf16x8, wv);
#pragma unroll
            for (int n = 0; n < 8; ++n) {
                const bf16x8 b = *(const bf16x8*)(KEYB + (size_t)(g * 128 + n * 16 + fr) * 256 + ks * 32 + fq * 8);
                acc[n] = __builtin_amdgcn_mfma_f32_16x16x32_bf16(a, b, acc[n], 0, 0, 0);
            }
        }
#pragma unroll
        for (int n = 0; n < 8; ++n) { u32x2 o; o.x = cvt_pk_bf16(acc[n][0], acc[n][1]); o.y = cvt_pk_bf16(acc[n][2], acc[n][3]);
            *(u32x2*)(WPT + (size_t)(g * 128 + n * 16 + fr) * 2048 + kb * 16 + fq * 4) = o; }
    }
}

__device__ __forceinline__ void phase0(const Params& p, unsigned char* shm) {
    bf16_t* WB1 = (bf16_t*)(p.ws + WS_WB1);
    rmsnorm_rows(p.in[0], p.in[1], (bf16_t*)(p.ws + WS_H));
    transpose_convert(p.in[2], 2048, 6144, WB1, (float*)shm, blockIdx.x, gridDim.x);
    const float* mu = p.in[4]; const float* w1 = p.in[6]; const float* a1 = p.in[9]; const float* g1 = p.in[11];
    for (int idx = blockIdx.x * 512 + threadIdx.x; idx < 768 * 2048; idx += gridDim.x * 512) {
        const int j = idx >> 11, k = idx & 2047; float val = 0.f;
        if (j < 128) { const float m = mu[k], w = w1[k * 64 + (j & 63)]; val = (j < 64) ? w * (1.f - m) : w * m; }
        else if (j < 256) { const float m = mu[2048 + k], w = a1[k * 64 + (j & 63)]; val = (j < 192) ? w * (1.f - m) : w * m; }
        else if (j < 576) { const float m = mu[4096 + k]; const int jj = j - 256; const int c = jj < 160 ? jj : jj - 160; const float w = g1[k * 160 + c]; val = jj < 160 ? w * (1.f - m) : w * m; }
        WB1[(size_t)(6144 + j) * 2048 + k] = f2bf(val);
    }
    convert_flat(p.in[22], (bf16_t*)(p.ws + WS_KEYB), (size_t)8 * 2 * 128 * 256);
    bf16_t* W2T = (bf16_t*)(p.ws + WS_W2T); bf16_t* A2T = (bf16_t*)(p.ws + WS_A2T); bf16_t* G2T = (bf16_t*)(p.ws + WS_G2T);
    const float* w2 = p.in[7]; const float* a2 = p.in[10]; const float* g2 = p.in[12];
    for (int idx = blockIdx.x * 512 + threadIdx.x; idx < 1024 * 288; idx += gridDim.x * 512) {
        if (idx < 65536) { const int c = idx >> 6, j = idx & 63; W2T[idx] = f2bf(w2[j * 1024 + c]); }
        else if (idx < 131072) { const int i2 = idx - 65536; const int c = i2 >> 6, j = i2 & 63; A2T[i2] = f2bf(a2[j * 1024 + c]); }
        else { const int i2 = idx - 131072; const int c = i2 / 160, j = i2 % 160; G2T[i2] = f2bf(g2[j * 1024 + c]); }
    }
}

constexpr int ACT_LD = 296;
template <int KS, int KOFF, int KTOT, int KIND>
__device__ __forceinline__ void lora_stage(const LAS bf16_t* act, const bf16_t* WT, const float* bias, bf16_t* OUT, int t0, int w, int fr, int fq) {
#pragma unroll 1
    for (int nh = 0; nh < 2; ++nh) {
        f32x4 acc[4][4];
#pragma unroll
        for (int m = 0; m < 4; ++m)
#pragma unroll
            for (int n = 0; n < 4; ++n) acc[m][n] = (f32x4){0.f, 0.f, 0.f, 0.f};
        bf16x8 bfr[KS][4];
#pragma unroll
        for (int ks = 0; ks < KS; ++ks)
#pragma unroll
            for (int n = 0; n < 4; ++n) bfr[ks][n] = *(const bf16x8*)(WT + (size_t)(w * 128 + (nh * 4 + n) * 16 + fr) * KTOT + ks * 32 + fq * 8);
#pragma unroll
        for (int ks = 0; ks < KS; ++ks) {
            bf16x8 a[4];
#pragma unroll
            for (int m = 0; m < 4; ++m) a[m] = *(const LAS bf16x8*)(act + (m * 16 + fr) * ACT_LD + KOFF + ks * 32 + fq * 8);
#pragma unroll
            for (int n = 0; n < 4; ++n)
#pragma unroll
                for (int m = 0; m < 4; ++m) acc[m][n] = __builtin_amdgcn_mfma_f32_16x16x32_bf16(bfr[ks][n], a[m], acc[m][n], 0, 0, 0);
        }
#pragma unroll
        for (int n = 0; n < 4; ++n) {
            const int c = w * 128 + (nh * 4 + n) * 16 + fq * 4;
            float bs[4] = {0.f, 0.f, 0.f, 0.f};
            if (KIND < 2) { const float4 bv = *(const float4*)(bias + c); bs[0] = bv.x; bs[1] = bv.y; bs[2] = bv.z; bs[3] = bv.w; }
#pragma unroll
            for (int m = 0; m < 4; ++m) {
                float o[4];
#pragma unroll
                for (int j = 0; j < 4; ++j) {
                    const float val = acc[m][n][j];
                    if (KIND == 0) { const float x = -(bs[j] + val); const float sp = fmaxf(x, 0.f) + __logf(1.f + __expf(-fabsf(x))); o[j] = -__expf(-sp - 0.5f); }
                    else if (KIND == 1) o[j] = sigmoidf_(bs[j] + val);
                    else o[j] = val;
                }
                u32x2 wv; wv.x = cvt_pk_bf16(o[0], o[1]); wv.y = cvt_pk_bf16(o[2], o[3]);
                *(u32x2*)(OUT + (size_t)(t0 + m * 16 + fr) * DR + c) = wv;
            }
        }
    }
}
__device__ __forceinline__ void phase_prepM(const Params& p, LAS unsigned char* lds) {
    LAS bf16_t* act = (LAS bf16_t*)lds;
    const bf16_t* P = (const bf16_t*)(p.ws + WS_PROJ);
    const int tid = threadIdx.x, w = tid >> 6, lane = tid & 63, fr = lane & 15, fq = lane >> 4;
    for (int tile = blockIdx.x; tile < S_ / 64; tile += gridDim.x) {
        const int t0 = tile * 64;
        __syncthreads();
        for (int task = tid; task < 64 * 36; task += 512) {
            const int t = task / 36, j0 = (task % 36) * 8; const int tg = t0 + t;
            int ccur, cprev;
            if (j0 < 64) { ccur = 6144 + j0; cprev = 6208 + j0; }
            else if (j0 < 128) { ccur = 6272 + (j0 - 64); cprev = 6336 + (j0 - 64); }
            else { ccur = 6400 + (j0 - 128); cprev = 6560 + (j0 - 128); }
            float cu[8], pv[8], o8[8];
            unpack8(*(const u32x4*)(P + (size_t)tg * NAUG + ccur), cu);
            if (tg > 0) unpack8(*(const u32x4*)(P + (size_t)(tg - 1) * NAUG + cprev), pv);
            else {
#pragma unroll
                for (int i = 0; i < 8; ++i) pv[i] = 0.f;
            }
#pragma unroll
            for (int i = 0; i < 8; ++i) { const float sv = cu[i] + pv[i];
                o8[i] = j0 < 64 ? (1.f - 2.f / (1.f + __expf(2.f * sv))) : (j0 < 128 ? sv : sigmoidf_(sv)); }
            *(LAS u32x4*)(act + t * ACT_LD + j0) = pack8(o8);
        }
        __syncthreads();
        lora_stage<2, 0, 64, 0>(act, (const bf16_t*)(p.ws + WS_W2T), p.in[5], (bf16_t*)(p.ws + WS_LW), t0, w, fr, fq);
        lora_stage<2, 64, 64, 1>(act, (const bf16_t*)(p.ws + WS_A2T), p.in[8], (bf16_t*)(p.ws + WS_A), t0, w, fr, fq);
        lora_stage<5, 128, 160, 2>(act, (const bf16_t*)(p.ws + WS_G2T), nullptr, (bf16_t*)(p.ws + WS_G), t0, w, fr, fq);
    }
}

__device__ __forceinline__ void phase_prepE(const Params& p) {
    const bf16_t* P = (const bf16_t*)(p.ws + WS_PROJ);
    bf16_t* R = (bf16_t*)(p.ws + WS_R); bf16_t* Kk = (bf16_t*)(p.ws + WS_K); bf16_t* V = (bf16_t*)(p.ws + WS_V); bf16_t* KK = (bf16_t*)(p.ws + WS_KK); bf16_t* YC = (bf16_t*)(p.ws + WS_YC);
    const float* mu_rkv = p.in[3]; const float* k_k = p.in[13]; const float* cw = p.in[18];
    const int tid = threadIdx.x, cg = tid & 127, c0 = cg * 8, tgrp = tid >> 7;
    float mr[8], mk[8], mv[8], kkc[8], cw0[8], cw1[8], cw2[8];
#pragma unroll
    for (int i = 0; i < 8; ++i) { mr[i] = mu_rkv[c0 + i]; mk[i] = mu_rkv[1024 + c0 + i]; mv[i] = mu_rkv[2048 + c0 + i]; kkc[i] = k_k[c0 + i]; cw0[i] = cw[c0 + i]; cw1[i] = cw[1024 + c0 + i]; cw2[i] = cw[2048 + c0 + i]; }
    for (int run = blockIdx.x * 4 + tgrp; run < S_ / 16; run += gridDim.x * 4) {
        const int t0 = run * 16;
        float pr[8], pk[8], pv[8], u1[8], u2[8];
#pragma unroll
        for (int i = 0; i < 8; ++i) { pr[i] = 0.f; pk[i] = 0.f; pv[i] = 0.f; u1[i] = 0.f; u2[i] = 0.f; }
        if (t0 > 0) {
            const size_t o = (size_t)(t0 - 1) * NAUG + c0;
            unpack8(*(const u32x4*)(P + o), pr); unpack8(*(const u32x4*)(P + o + 1024), pk); unpack8(*(const u32x4*)(P + o + 2048), pv);
            float x[8], y[8];
            unpack8(*(const u32x4*)(P + o + 4096), x); unpack8(*(const u32x4*)(P + o + 5120), y);
#pragma unroll
            for (int i = 0; i < 8; ++i) u1[i] = x[i] * y[i];
            unpack8(*(const u32x4*)(P + o - NAUG + 4096), x); unpack8(*(const u32x4*)(P + o - NAUG + 5120), y);
#pragma unroll
            for (int i = 0; i < 8; ++i) u2[i] = x[i] * y[i];
        }
        u32x4 nx[6];
        { const size_t o = (size_t)t0 * NAUG + c0;
#pragma unroll
          for (int q = 0; q < 6; ++q) nx[q] = *(const u32x4*)(P + o + 1024 * q); }
#pragma unroll 1
        for (int t = 0; t < 16; ++t) {
            float cr[8], ck[8], cv[8], bg[8], cgt[8], xc[8];
            unpack8(nx[0], cr); unpack8(nx[1], ck); unpack8(nx[2], cv); unpack8(nx[3], bg); unpack8(nx[4], cgt); unpack8(nx[5], xc);
            { const size_t o = (size_t)(t0 + (t < 15 ? t + 1 : t)) * NAUG + c0;
#pragma unroll
              for (int q = 0; q < 6; ++q) nx[q] = *(const u32x4*)(P + o + 1024 * q); }
            float r[8], k[8], v[8], kkv[8], yc[8]; float ss = 0.f;
#pragma unroll
            for (int i = 0; i < 8; ++i) {
                r[i] = cr[i] + (pr[i] - cr[i]) * mr[i]; k[i] = ck[i] + (pk[i] - ck[i]) * mk[i]; v[i] = cv[i] + (pv[i] - cv[i]) * mv[i];
                pr[i] = cr[i]; pk[i] = ck[i]; pv[i] = cv[i];
                kkv[i] = k[i] * kkc[i]; ss += kkv[i] * kkv[i];
                const float u0 = cgt[i] * xc[i];
                yc[i] = bg[i] * (cw0[i] * u2[i] + cw1[i] * u1[i] + cw2[i] * u0);
                u2[i] = u1[i]; u1[i] = u0;
            }
            ss += dpp_f<0xB1, 0xf>(ss); ss += dpp_f<0x4E, 0xf>(ss); ss += dpp_f<0x141, 0xf>(ss);
            const float inv = 1.0f / fmaxf(sqrtf(ss), 1e-12f);
#pragma unroll
            for (int i = 0; i < 8; ++i) kkv[i] *= inv;
            const size_t oo = (size_t)(t0 + t) * DR + c0;
            *(u32x4*)(R + oo) = pack8(r); *(u32x4*)(Kk + oo) = pack8(k); *(u32x4*)(V + oo) = pack8(v); *(u32x4*)(KK + oo) = pack8(kkv); *(u32x4*)(YC + oo) = pack8(yc);
        }
    }
}

#define TILE(i) ((LAS bf16_t*)(lds + (i) * TSLOT))
__device__ __forceinline__ f32x4 mm_tile(f32x4 acc, const LAS bf16_t* A, const LAS bf16_t* Bt, int mi, int ni, int fr, int fq) {
#pragma unroll
    for (int ks = 0; ks < 2; ++ks) {
        const bf16x8 a = *(const LAS bf16x8*)(A + (mi * 16 + fr) * TLD + ks * 32 + fq * 8);
        const bf16x8 b = *(const LAS bf16x8*)(Bt + (ni * 16 + fr) * TLD + ks * 32 + fq * 8);
        acc = __builtin_amdgcn_mfma_f32_16x16x32_bf16(a, b, acc, 0, 0, 0);
    }
    return acc;
}
__device__ __forceinline__ void st_rm(LAS bf16_t* X, f32x4 v, int mi, int ni, int fr, int fq) {
    const unsigned w0 = cvt_pk_bf16(v[0], v[1]), w1 = cvt_pk_bf16(v[2], v[3]);
    LAS bf16_t* q = X + (mi * 16 + fq * 4) * TLD + ni * 16 + fr;
    q[0] = (bf16_t)(w0 & 0xffffu); q[TLD] = (bf16_t)(w0 >> 16); q[2 * TLD] = (bf16_t)(w1 & 0xffffu); q[3 * TLD] = (bf16_t)(w1 >> 16);
}
__device__ __forceinline__ void st_tr(LAS bf16_t* XT, f32x4 v, int mi, int ni, int fr, int fq) {
    u32x2 w; w.x = cvt_pk_bf16(v[0], v[1]); w.y = cvt_pk_bf16(v[2], v[3]);
    *(LAS u32x2*)(XT + (ni * 16 + fr) * TLD + mi * 16 + fq * 4) = w;
}
__device__ __forceinline__ f32x4 ld_rm(const LAS bf16_t* X, int mi, int ni, int fr, int fq) {
    const LAS bf16_t* q = X + (mi * 16 + fq * 4) * TLD + ni * 16 + fr;
    return (f32x4){bf2f(q[0]), bf2f(q[TLD]), bf2f(q[2 * TLD]), bf2f(q[3 * TLD])};
}
__device__ __forceinline__ f32x4 ld_tr(const LAS bf16_t* XT, int mi, int ni, int fr, int fq) {
    const u32x2 w = *(const LAS u32x2*)(XT + (ni * 16 + fr) * TLD + mi * 16 + fq * 4);
    return (f32x4){lo_bf(w.x), hi_bf(w.x), lo_bf(w.y), hi_bf(w.y)};
}

__device__ __forceinline__ void phase_chunkA(const Params& p, LAS unsigned char* lds) {
    const int tid = threadIdx.x, w = tid >> 6, lane = tid & 63, fr = lane & 15, fq = lane >> 4;
    const int mi = w >> 1, nb = (w & 1) * 2;
    LAS float* cl = (LAS float*)(lds + 14 * TSLOT);
    LAS float* gs = (LAS float*)(lds + 16 * TSLOT);
    LAS float* wc = gs + 512;
    const bf16_t* R = (const bf16_t*)(p.ws + WS_R); const bf16_t* Kk = (const bf16_t*)(p.ws + WS_K); const bf16_t* V = (const bf16_t*)(p.ws + WS_V);
    const bf16_t* KK = (const bf16_t*)(p.ws + WS_KK); const bf16_t* A = (const bf16_t*)(p.ws + WS_A); const bf16_t* LW = (const bf16_t*)(p.ws + WS_LW);
    bf16_t* GT = (bf16_t*)(p.ws + WS_GT); float* HT = (float*)(p.ws + WS_HT); bf16_t* QE = (bf16_t*)(p.ws + WS_QE); bf16_t* YL = (bf16_t*)(p.ws + WS_YL);
    const f32x4 z4 = (f32x4){0.f, 0.f, 0.f, 0.f};
    const float* k_a = p.in[14]; const float* r_k = p.in[15]; float* BON = (float*)(p.ws + WS_BON);
    u32x4 nr4, nk4, nv4, nkk4, na4, nlw4;
#define CA_LOAD(it) do { const size_t _go = (size_t)(((it) >> 4) * 64 + (tid >> 3)) * DR + ((it) & 15) * 64 + (tid & 7) * 8; \
        nr4 = *(const u32x4*)(R + _go); nk4 = *(const u32x4*)(Kk + _go); nv4 = *(const u32x4*)(V + _go); nkk4 = *(const u32x4*)(KK + _go); na4 = *(const u32x4*)(A + _go); nlw4 = *(const u32x4*)(LW + _go); } while (0)
    for (int item = blockIdx.x; item < 4096; item += gridDim.x) {
        const int c = item >> 4, h = item & 15;
        const int t = tid >> 3, k0 = (tid & 7) * 8;
        if (item == (int)blockIdx.x) CA_LOAD(item);
        const u32x4 r4 = nr4, k4 = nk4, v4 = nv4, kk4 = nkk4, a4 = na4, lw4 = nlw4;
        __syncthreads();
        {
            float lwf8[8]; unpack8(lw4, lwf8);
            *(LAS f32x4*)(cl + t * 64 + k0) = (f32x4){lwf8[0], lwf8[1], lwf8[2], lwf8[3]};
            *(LAS f32x4*)(cl + t * 64 + k0 + 4) = (f32x4){lwf8[4], lwf8[5], lwf8[6], lwf8[7]};
            __syncthreads();
            const int g = w, k = lane;
            float pfx[8]; float run = 0.f;
#pragma unroll
            for (int i = 0; i < 8; ++i) { run += cl[(g * 8 + i) * 64 + k]; pfx[i] = run; }
            gs[g * 64 + k] = run;
            __syncthreads();
            float off = 0.f;
#pragma unroll
            for (int gg = 0; gg < 7; ++gg) { const float x = gs[gg * 64 + k]; off += (gg < g) ? x : 0.f; }
#pragma unroll
            for (int i = 0; i < 8; ++i) cl[(g * 8 + i) * 64 + k] = off + pfx[i];
            if (g == 7) wc[k] = __expf(off + pfx[7]);
            __syncthreads();
        }
        if (item + (int)gridDim.x < 4096) CA_LOAD(item + (int)gridDim.x);
        {
            float at[8], rt[8], bt[8], kt[8], bh[8], kh[8], vv[8]; float bsum = 0.f;
#pragma unroll
            for (int i = 0; i < 8; ++i) {
                const int q = i >> 1; const bool hi = i & 1;
                const float rf = hi ? hi_bf(r4[q]) : lo_bf(r4[q]), kraw = hi ? hi_bf(k4[q]) : lo_bf(k4[q]), vf = hi ? hi_bf(v4[q]) : lo_bf(v4[q]);
                const float kkf = hi ? hi_bf(kk4[q]) : lo_bf(kk4[q]), af = hi ? hi_bf(a4[q]) : lo_bf(a4[q]), lwf = hi ? hi_bf(lw4[q]) : lo_bf(lw4[q]);
                const float kf = kraw * (1.f + (af - 1.f) * k_a[h * 64 + k0 + i]);
                bsum += rf * kf * r_k[h * 64 + k0 + i];
                const float clv = cl[t * 64 + k0 + i], cle = cl[63 * 64 + k0 + i];
                const float e = __expf(clv), ex = __expf(clv - lwf), ei = __expf(-clv), eh = __expf(cle - clv);
                const float bb = kkf * af;
                at[i] = -kkf * ex; rt[i] = rf * e; bt[i] = bb * ei; kt[i] = kf * ei; bh[i] = bb * eh; kh[i] = kf * eh; vv[i] = vf;
            }
            bsum += dpp_f<0xB1, 0xf>(bsum); bsum += dpp_f<0x4E, 0xf>(bsum); bsum += dpp_f<0x141, 0xf>(bsum);
            if ((tid & 7) == 0) BON[(size_t)(c * 64 + t) * 16 + h] = bsum;
            *(LAS u32x4*)(TILE(0) + t * TLD + k0) = pack8(at);
            *(LAS u32x4*)(TILE(2) + t * TLD + k0) = pack8(rt);
            *(LAS u32x4*)(TILE(3) + t * TLD + k0) = pack8(bt);
            *(LAS u32x4*)(TILE(4) + t * TLD + k0) = pack8(kt);
            const u32x4 atp = pack8(at), bhp = pack8(bh), khp = pack8(kh);
#pragma unroll
            for (int i = 0; i < 8; ++i) {
                const int q = i >> 1; const bool hi = i & 1;
                TILE(1)[(k0 + i) * TLD + t] = (bf16_t)(hi ? (atp[q] >> 16) : (atp[q] & 0xffffu));
                TILE(5)[(k0 + i) * TLD + t] = (bf16_t)(hi ? (bhp[q] >> 16) : (bhp[q] & 0xffffu));
                TILE(6)[(k0 + i) * TLD + t] = (bf16_t)(hi ? (khp[q] >> 16) : (khp[q] & 0xffffu));
                TILE(7)[(k0 + i) * TLD + t] = (bf16_t)(hi ? (v4[q] >> 16) : (v4[q] & 0xffffu));
            }
            __syncthreads();
        }
#pragma unroll
        for (int nn = 0; nn < 2; ++nn) {
            const int ni = nb + nn; const int col = ni * 16 + fr, row0 = mi * 16 + fq * 4;
            f32x4 x = mm_tile(z4, TILE(0), TILE(3), mi, ni, fr, fq);
#pragma unroll
            for (int j = 0; j < 4; ++j) x[j] = (col < row0 + j) ? x[j] : 0.f;
            st_rm(TILE(8), x, mi, ni, fr, fq); st_tr(TILE(9), x, mi, ni, fr, fq);
            x = mm_tile(z4, TILE(0), TILE(4), mi, ni, fr, fq);
#pragma unroll
            for (int j = 0; j < 4; ++j) x[j] = (col < row0 + j) ? x[j] : 0.f;
            st_rm(TILE(10), x, mi, ni, fr, fq);
            x = mm_tile(z4, TILE(2), TILE(3), mi, ni, fr, fq);
#pragma unroll
            for (int j = 0; j < 4; ++j) x[j] = (col <= row0 + j) ? x[j] : 0.f;
            st_rm(TILE(11), x, mi, ni, fr, fq);
            x = mm_tile(z4, TILE(2), TILE(4), mi, ni, fr, fq);
#pragma unroll
            for (int j = 0; j < 4; ++j) x[j] = (col <= row0 + j) ? x[j] : 0.f;
            st_rm(TILE(12), x, mi, ni, fr, fq);
        }
        __syncthreads();
#pragma unroll
        for (int nn = 0; nn < 2; ++nn) {
            const int ni = nb + nn;
            st_tr(TILE(13), mm_tile(z4, TILE(10), TILE(7), mi, ni, fr, fq), mi, ni, fr, fq);
            const f32x4 x = mm_tile(z4, TILE(8), TILE(9), mi, ni, fr, fq);
            st_rm(TILE(0), x, mi, ni, fr, fq); st_tr(TILE(3), x, mi, ni, fr, fq);
        }
        __syncthreads();
#pragma unroll
        for (int rd = 0; rd < 5; ++rd) {
            const int tq = (rd & 1) ? 14 : 8, tqo = (rd & 1) ? 8 : 14;
            const int lx = (rd & 1) ? 4 : 0, lxt = (rd & 1) ? 9 : 3, lxo = (rd & 1) ? 0 : 4, lxto = (rd & 1) ? 3 : 9;
#pragma unroll
            for (int nn = 0; nn < 2; ++nn) {
                const int ni = nb + nn;
                f32x4 x = ld_rm(TILE(tq), mi, ni, fr, fq) + ld_rm(TILE(lx), mi, ni, fr, fq);
                x = mm_tile(x, TILE(tq), TILE(lxt), mi, ni, fr, fq);
                st_rm(TILE(tqo), x, mi, ni, fr, fq);
                if (rd < 4) { const f32x4 y = mm_tile(z4, TILE(lx), TILE(lxt), mi, ni, fr, fq); st_rm(TILE(lxo), y, mi, ni, fr, fq); st_tr(TILE(lxto), y, mi, ni, fr, fq); }
            }
            __syncthreads();
        }
#pragma unroll
        for (int nn = 0; nn < 2; ++nn) {
            const int ni = nb + nn;
            st_tr(TILE(10), mm_tile(ld_tr(TILE(1), mi, ni, fr, fq), TILE(14), TILE(1), mi, ni, fr, fq), mi, ni, fr, fq);
            st_tr(TILE(15), mm_tile(ld_tr(TILE(13), mi, ni, fr, fq), TILE(14), TILE(13), mi, ni, fr, fq), mi, ni, fr, fq);
        }
        __syncthreads();
#pragma unroll
        for (int nn = 0; nn < 2; ++nn) {
            const int ni = nb + nn;
            {
                f32x4 x = mm_tile(z4, TILE(5), TILE(10), mi, ni, fr, fq);
                if (mi == ni) {
#pragma unroll
                    for (int j = 0; j < 4; ++j) x[j] += (fq * 4 + j == fr) ? wc[ni * 16 + fr] : 0.f;
                }
                const unsigned w0 = cvt_pk_bf16(x[0], x[1]), w1 = cvt_pk_bf16(x[2], x[3]);
                bf16_t* gp = GT + (size_t)item * 4096 + (size_t)((mi * 2 + (ni >> 1)) * 64 + (fr >> 2) * 16 + fq * 4) * 8 + (ni & 1) * 4 + (fr & 3);
                gp[0] = (bf16_t)(w0 & 0xffffu); gp[8] = (bf16_t)(w0 >> 16); gp[16] = (bf16_t)(w1 & 0xffffu); gp[24] = (bf16_t)(w1 >> 16);
            }
            {
                f32x4 x = mm_tile(z4, TILE(5), TILE(15), mi, ni, fr, fq);
                x = mm_tile(x, TILE(6), TILE(7), mi, ni, fr, fq);
                *(f32x4*)(HT + (size_t)item * 4096 + (size_t)((ni * 4 + mi) * 64 + lane) * 4) = x;
            }
            {
                f32x4 x = ld_tr(TILE(2), mi, ni, fr, fq);
                x = mm_tile(x, TILE(10), TILE(11), mi, ni, fr, fq);
                u32x2 wv; wv.x = cvt_pk_bf16(x[0], x[1]); wv.y = cvt_pk_bf16(x[2], x[3]);
                *(u32x2*)(QE + (size_t)item * 4096 + (ni * 16 + fr) * 64 + mi * 16 + fq * 4) = wv;
            }
            {
                f32x4 x = mm_tile(z4, TILE(11), TILE(15), mi, ni, fr, fq);
                x = mm_tile(x, TILE(12), TILE(7), mi, ni, fr, fq);
                u32x2 wv; wv.x = cvt_pk_bf16(x[0], x[1]); wv.y = cvt_pk_bf16(x[2], x[3]);
                *(u32x2*)(YL + (size_t)item * 4096 + (size_t)((mi * 4 + ni) * 64 + lane) * 4) = wv;
            }
        }
    }
}

__device__ __forceinline__ void phase_seq(const Params& p) {
    if (threadIdx.x >= 64) return;
    const int head = blockIdx.x >> 2, vt = blockIdx.x & 3, lane = threadIdx.x, fr = lane & 15, fq = lane >> 4;
    const bf16_t* GT = (const bf16_t*)(p.ws + WS_GT); const float* HT = (const float*)(p.ws + WS_HT); bf16_t* S0 = (bf16_t*)(p.ws + WS_S0);
    f32x4 acc[4];
#pragma unroll
    for (int mb = 0; mb < 4; ++mb) acc[mb] = (f32x4){0.f, 0.f, 0.f, 0.f};
    bf16x8 ga[4][4][2]; f32x4 hh[4][4];
#define SEQ_LOAD(buf, cc) do { const size_t _it = (size_t)((cc) < 256 ? (cc) : 255) * 16 + head; \
        _Pragma("unroll") for (int mb = 0; mb < 4; ++mb) { \
            _Pragma("unroll") for (int ks = 0; ks < 2; ++ks) ga[buf][mb][ks] = *(const bf16x8*)(GT + _it * 4096 + (size_t)((mb * 2 + ks) * 64 + lane) * 8); \
            hh[buf][mb] = *(const f32x4*)(HT + _it * 4096 + (size_t)((vt * 4 + mb) * 64 + lane) * 4); } } while (0)
    SEQ_LOAD(0, 0); SEQ_LOAD(1, 1); SEQ_LOAD(2, 2); SEQ_LOAD(3, 3);
    for (int c0 = 0; c0 < 256; c0 += 4) {
#pragma unroll
        for (int b = 0; b < 4; ++b) {
            const int c = c0 + b; const size_t item = (size_t)c * 16 + head;
            u32x2 pk[4];
#pragma unroll
            for (int mb = 0; mb < 4; ++mb) { pk[mb].x = cvt_pk_bf16(acc[mb][0], acc[mb][1]); pk[mb].y = cvt_pk_bf16(acc[mb][2], acc[mb][3]);
                *(u32x2*)(S0 + item * 4096 + (vt * 16 + fr) * 64 + mb * 16 + fq * 4) = pk[mb]; }
            u32x4 b0w, b1w; b0w.x = pk[0].x; b0w.y = pk[0].y; b0w.z = pk[1].x; b0w.w = pk[1].y; b1w.x = pk[2].x; b1w.y = pk[2].y; b1w.z = pk[3].x; b1w.w = pk[3].y;
            const bf16x8 b0 = __builtin_bit_cast(bf16x8, b0w), b1 = __builtin_bit_cast(bf16x8, b1w);
#pragma unroll
            for (int mb = 0; mb < 4; ++mb) {
                const f32x4 x = __builtin_amdgcn_mfma_f32_16x16x32_bf16(ga[b][mb][0], b0, hh[b][mb], 0, 0, 0);
                acc[mb] = __builtin_amdgcn_mfma_f32_16x16x32_bf16(ga[b][mb][1], b1, x, 0, 0, 0);
            }
            SEQ_LOAD(b, c + 4);
        }
    }
#undef SEQ_LOAD
}

__device__ __forceinline__ void phase_chunkY(const Params& p, LAS unsigned char* lds) {
    LAS float* Yb = (LAS float*)lds;
    const int tid = threadIdx.x, w = tid >> 6, lane = tid & 63, fr = lane & 15, fq = lane >> 4;
    const int mi = w >> 1, nb = (w & 1) * 2;
    const bf16_t* R = (const bf16_t*)(p.ws + WS_R); const bf16_t* Kk = (const bf16_t*)(p.ws + WS_K); const bf16_t* V = (const bf16_t*)(p.ws + WS_V);
    const bf16_t* G = (const bf16_t*)(p.ws + WS_G); const bf16_t* YC = (const bf16_t*)(p.ws + WS_YC);
    const bf16_t* QE = (const bf16_t*)(p.ws + WS_QE); const bf16_t* YL = (const bf16_t*)(p.ws + WS_YL); const bf16_t* S0 = (const bf16_t*)(p.ws + WS_S0);
    bf16_t* YM = (bf16_t*)(p.ws + WS_YMIX);
    const float* gn_w = p.in[16]; const float* gn_b = p.in[17];
    u32x2 ywn[2]; bf16x8 an[2], bn[2][2]; bool first = true;
#define CY_LOAD(it) do { const bf16_t* _q = QE + (size_t)(it) * 4096; const bf16_t* _s = S0 + (size_t)(it) * 4096; const bf16_t* _y = YL + (size_t)(it) * 4096; \
        _Pragma("unroll") for (int ks = 0; ks < 2; ++ks) an[ks] = *(const bf16x8*)(_q + (mi * 16 + fr) * 64 + ks * 32 + fq * 8); \
        _Pragma("unroll") for (int nn = 0; nn < 2; ++nn) { ywn[nn] = *(const u32x2*)(_y + (size_t)((mi * 4 + nb + nn) * 64 + lane) * 4); \
            _Pragma("unroll") for (int ks = 0; ks < 2; ++ks) bn[nn][ks] = *(const bf16x8*)(_s + (nb + nn) * 16 * 64 + fr * 64 + ks * 32 + fq * 8); } } while (0)
    for (int item = blockIdx.x; item < 4096; item += gridDim.x) {
        const int c = item >> 4, h = item & 15;
        if (first) { first = false; CY_LOAD(item); }
        __syncthreads();
        const u32x2 ywc[2] = {ywn[0], ywn[1]}; const bf16x8 ac[2] = {an[0], an[1]}; const bf16x8 bc[2][2] = {{bn[0][0], bn[0][1]}, {bn[1][0], bn[1][1]}};
        if (item + (int)gridDim.x < 4096) CY_LOAD(item + (int)gridDim.x);
#pragma unroll
        for (int nn = 0; nn < 2; ++nn) {
            const int ni = nb + nn;
            const u32x2 yw = ywc[nn];
            f32x4 acc = (f32x4){lo_bf(yw.x), hi_bf(yw.x), lo_bf(yw.y), hi_bf(yw.y)};
#pragma unroll
            for (int ks = 0; ks < 2; ++ks) acc = __builtin_amdgcn_mfma_f32_16x16x32_bf16(ac[ks], bc[nn][ks], acc, 0, 0, 0);
#pragma unroll
            for (int j = 0; j < 4; ++j) Yb[(mi * 16 + fq * 4 + j) * 68 + ni * 16 + fr] = acc[j];
        }
        __syncthreads();
        {
            const int t = tid >> 3, k0 = (tid & 7) * 8; const int ch = h * 64 + k0;
            const size_t tg = (size_t)c * 64 + t; const size_t o = tg * DR + ch;
            const float* BON = (const float*)(p.ws + WS_BON);
            const u32x4 v4 = *(const u32x4*)(V + o), g4 = *(const u32x4*)(G + o), yc4 = *(const u32x4*)(YC + o);
            const float bon = BON[tg * 16 + h];
            const float4 gw0 = *(const float4*)(gn_w + ch), gw1 = *(const float4*)(gn_w + ch + 4), gb0 = *(const float4*)(gn_b + ch), gb1 = *(const float4*)(gn_b + ch + 4);
            const float gwv[8] = {gw0.x, gw0.y, gw0.z, gw0.w, gw1.x, gw1.y, gw1.z, gw1.w}, gbv[8] = {gb0.x, gb0.y, gb0.z, gb0.w, gb1.x, gb1.y, gb1.z, gb1.w};
            const f32x4 y0 = *(const LAS f32x4*)(Yb + t * 68 + k0), y1 = *(const LAS f32x4*)(Yb + t * 68 + k0 + 4);
            const float y[8] = {y0[0], y0[1], y0[2], y0[3], y1[0], y1[1], y1[2], y1[3]};
            float sm = 0.f;
#pragma unroll
            for (int i = 0; i < 8; ++i) sm += y[i];
            sm += dpp_f<0xB1, 0xf>(sm); sm += dpp_f<0x4E, 0xf>(sm); sm += dpp_f<0x141, 0xf>(sm);
            const float mean = sm * (1.f / 64.f);
            float vs = 0.f;
#pragma unroll
            for (int i = 0; i < 8; ++i) { const float d = y[i] - mean; vs += d * d; }
            vs += dpp_f<0xB1, 0xf>(vs); vs += dpp_f<0x4E, 0xf>(vs); vs += dpp_f<0x141, 0xf>(vs);
            const float rs = rsqrtf(vs * (1.f / 64.f) + 64e-5f);
            float vf[8], gf[8], of[8];
            unpack8(v4, vf); unpack8(g4, gf);
#pragma unroll
            for (int i = 0; i < 8; ++i) of[i] = ((y[i] - mean) * rs * gwv[i] + gbv[i] + bon * vf[i]) * gf[i];
            *(u32x4*)(YM + tg * D_ + ch) = pack8(of);
            *(u32x4*)(YM + tg * D_ + 1024 + ch) = yc4;
        }
    }
#undef CY_LOAD
}

__device__ __forceinline__ int f2key(float x) { const int u = __float_as_int(x); return u ^ ((u >> 31) & 0x7fffffff); }
__device__ __forceinline__ float key2f(int k) { return __int_as_float(k ^ ((k >> 31) & 0x7fffffff)); }
template <int CTRL> __device__ __forceinline__ int dpp_i(int v) { return __builtin_amdgcn_update_dpp(v, v, CTRL, 0xf, 0xf, false); }
__device__ __forceinline__ int row_max_i(int v) { v = max(v, dpp_i<0xB1>(v)); v = max(v, dpp_i<0x4E>(v)); v = max(v, dpp_i<0x141>(v)); v = max(v, dpp_i<0x140>(v)); return v; }
__device__ __forceinline__ void phase_topk(const Params& p, unsigned char* shm) {
    float* sc = (float*)shm;
    int* tk = (int*)(sc + 64 * 260);
    int* ctab = tk + 2048;
    if (threadIdx.x < 64) { int n = threadIdx.x, v = 256;
        for (int i = 0; i < 16; ++i) { const int cnt = 16 / (i + 1); if (n < cnt) { v = i * 16 + n; break; } n -= cnt; }
        ctab[threadIdx.x] = v; }
    const float* SC = (const float*)(p.ws + WS_Q);
    int* IDS = (int*)(p.ws + WS_IDS); float* GATES = (float*)(p.ws + WS_GATES);
    const int tid = threadIdx.x, w = tid >> 6, lane = tid & 63;
    f32x4 qreg[8];
#define TK_QLOAD(it) do { const int _t0 = ((it) >> 3) * 64; _Pragma("unroll") for (int i = 0; i < 8; ++i) { const int ch = tid + 512 * i; \
        qreg[i] = *(const f32x4*)(SC + (size_t)(_t0 + (ch >> 6)) * 2048 + ((it) & 7) * 256 + (ch & 63) * 4); } } while (0)
    if ((int)blockIdx.x < 2048) TK_QLOAD((int)blockIdx.x);
    for (int item = blockIdx.x; item < 2048; item += gridDim.x) {
        const int t0 = (item >> 3) * 64, h = item & 7;
        __syncthreads();
#pragma unroll
        for (int i = 0; i < 8; ++i) { const int ch = tid + 512 * i; *(f32x4*)(sc + (ch >> 6) * 260 + (ch & 63) * 4) = qreg[i]; }
        __syncthreads();
        if (item + (int)gridDim.x < 2048) TK_QLOAD(item + (int)gridDim.x);
        for (int g = 0; g < 4; ++g) {
            const int L = w * 16 + g * 4 + (lane >> 4); const int tok = L >> 1, cc = L & 1; const int pp = lane & 15;
            int key[8];
#pragma unroll
            for (int i = 0; i < 8; ++i) key[i] = (f2key(sc[tok * 260 + cc * 128 + i * 16 + pp]) & ~127) | (127 - (i * 16 + pp));
#define CE(a, b) do { const int _hi = max(key[a], key[b]), _lo = min(key[a], key[b]); key[a] = _hi; key[b] = _lo; } while (0)
            CE(0, 1); CE(2, 3); CE(4, 5); CE(6, 7);  CE(0, 2); CE(1, 3); CE(4, 6); CE(5, 7);  CE(1, 2); CE(5, 6);
            CE(0, 4); CE(1, 5); CE(2, 6); CE(3, 7);  CE(2, 4); CE(3, 5);  CE(1, 2); CE(3, 4); CE(5, 6);
#undef CE
            int mykey = 0;
#pragma unroll
            for (int r = 0; r < 16; ++r) {
                const int m = row_max_i(key[0]);
                const bool win = (key[0] == m);
#pragma unroll
                for (int i = 0; i < 7; ++i) key[i] = win ? key[i + 1] : key[i];
                key[7] = win ? (int)0x80000000 : key[7];
                mykey = (pp == r) ? m : mykey;
            }
            tk[L * 16 + pp] = mykey;
        }
        __syncthreads();
        for (int g = 0; g < 2; ++g) {
            const int tok = w * 8 + g * 4 + (lane >> 4); const int pp = lane & 15;
            int key[4];
#pragma unroll
            for (int q = 0; q < 4; ++q) {
                const int ij = ctab[q * 16 + pp];
                const float s1 = key2f(tk[(tok * 2) * 16 + ((ij >> 4) & 15)] & ~127), s2 = key2f(tk[(tok * 2 + 1) * 16 + (ij & 15)] & ~127);
                key[q] = (ij < 256) ? ((f2key(s1 + s2) & ~255) | (255 - ij)) : (int)0x80000000;
            }
            int mykey = 0;
#pragma unroll
            for (int r = 0; r < 16; ++r) {
                const int ml = max(max(key[0], key[1]), max(key[2], key[3]));
                const int m = row_max_i(ml);
#pragma unroll
                for (int q = 0; q < 4; ++q) key[q] = (key[q] == m) ? (int)0x80000000 : key[q];
                mykey = (pp == r) ? m : mykey;
            }
            const int ci = 255 - (mykey & 255); const float cs = key2f(mykey & ~255);
            const int e1 = 127 - (tk[(tok * 2) * 16 + (ci >> 4)] & 127), e2 = 127 - (tk[(tok * 2 + 1) * 16 + (ci & 15)] & 127);
            const float mx = __shfl(cs, lane & 48);
            const float e = __expf(cs - mx);
            float sum = e; sum += dpp_f<0xB1, 0xf>(sum); sum += dpp_f<0x4E, 0xf>(sum); sum += dpp_f<0x141, 0xf>(sum); sum += dpp_f<0x140, 0xf>(sum);
            IDS[(size_t)(t0 + tok) * 128 + h * 16 + pp] = (e1 * 128 + e2) & 16383;
            GATES[(size_t)(t0 + tok) * 128 + h * 16 + pp] = e / sum;
        }
    }
#undef TK_QLOAD
}

constexpr float U8_SCALE = 64.f, V8_SCALE = 32.f;
__device__ __forceinline__ float gelu_fast(float x) { const float u = 0.7978845608028654f * (x + 0.044715f * x * x * x); return x / (1.0f + __expf(-2.0f * u)); }
__device__ __forceinline__ void phase_gather(const Params& p, unsigned char* shm) {
    const bf16_t* H2 = (const bf16_t*)(p.ws + WS_H2); const float* X1 = (const float*)(p.ws + WS_X1);
    const unsigned char* U8 = p.ws + WS_UB; const unsigned char* V8 = p.ws + WS_VB;
    const int* IDS = (const int*)(p.ws + WS_IDS); const float* GATES = (const float*)(p.ws + WS_GATES);
    const float* nf = p.in[25];
    const int tid = threadIdx.x, w = tid >> 6, lane = tid & 63;
    for (int t = blockIdx.x * 8 + w; t < S_; t += gridDim.x * 8) {
        f32x2 hp[16];
#pragma unroll
        for (int q = 0; q < 2; ++q)
#pragma unroll
            for (int hh = 0; hh < 2; ++hh) { const u32x4 hv = *(const u32x4*)(H2 + (size_t)t * D_ + q * 1024 + lane * 16 + hh * 8);
#pragma unroll
                for (int i = 0; i < 4; ++i) hp[q * 8 + hh * 4 + i] = (f32x2){lo_bf(hv[i]), hi_bf(hv[i])}; }
        const int id0 = IDS[(size_t)t * 128 + lane], id1 = IDS[(size_t)t * 128 + 64 + lane];
        const float gt0 = GATES[(size_t)t * 128 + lane], gt1 = GATES[(size_t)t * 128 + 64 + lane];
        f32x2 op[16];
#pragma unroll
        for (int q = 0; q < 2; ++q)
#pragma unroll
            for (int i = 0; i < 4; ++i) { const float4 x = *(const float4*)(X1 + (size_t)t * D_ + q * 1024 + lane * 16 + 4 * i);
                op[q * 8 + 2 * i] = (f32x2){x.x, x.y}; op[q * 8 + 2 * i + 1] = (f32x2){x.z, x.w}; }
        u32x4 ua[4][2], ub[4][2], vb[4][2];
#define G_LOADU(dst, grp) do { _Pragma("unroll") for (int j = 0; j < 4; ++j) { const int e = (grp) * 4 + j; const int id = __builtin_amdgcn_readlane(e < 64 ? id0 : id1, e & 63); \
            const unsigned char* ur = U8 + (size_t)id * D_ + lane * 16; dst[j][0] = *(const u32x4*)ur; dst[j][1] = *(const u32x4*)(ur + 1024); } } while (0)
#define G_LOADV(grp) do { _Pragma("unroll") for (int j = 0; j < 4; ++j) { const int e = (grp) * 4 + j; const int id = __builtin_amdgcn_readlane(e < 64 ? id0 : id1, e & 63); \
            const unsigned char* vr = V8 + (size_t)id * D_ + lane * 16; vb[j][0] = *(const u32x4*)vr; vb[j][1] = *(const u32x4*)(vr + 1024); } } while (0)
#define G_BODY(cur, nxt, grp) do { \
            G_LOADV(grp); \
            G_LOADU(nxt, ((grp) + 1 < 32 ? (grp) + 1 : 31)); \
            float dsel = 0.f; \
            _Pragma("unroll") for (int j = 0; j < 4; ++j) { f32x2 d2 = (f32x2){0.f, 0.f}; \
                _Pragma("unroll") for (int q = 0; q < 2; ++q) _Pragma("unroll") for (int i = 0; i < 4; ++i) { \
                    d2 += __builtin_amdgcn_cvt_pk_f32_fp8((int)cur[j][q][i], false) * hp[q * 8 + 2 * i]; d2 += __builtin_amdgcn_cvt_pk_f32_fp8((int)cur[j][q][i], true) * hp[q * 8 + 2 * i + 1]; } \
                const float d = wave_sum_dpp(d2.x + d2.y); dsel = (lane == j) ? d : dsel; } \
            const float av = gelu_fast(dsel * (1.f / U8_SCALE)) * (1.f / V8_SCALE); \
            _Pragma("unroll") for (int j = 0; j < 4; ++j) { const int e = (grp) * 4 + j; \
                const float a = __int_as_float(__builtin_amdgcn_readlane(__float_as_int(av), j)) * __int_as_float(__builtin_amdgcn_readlane(__float_as_int(e < 64 ? gt0 : gt1), e & 63)); \
                const f32x2 a2 = (f32x2){a, a}; \
                _Pragma("unroll") for (int q = 0; q < 2; ++q) _Pragma("unroll") for (int i = 0; i < 4; ++i) { \
                    op[q * 8 + 2 * i] += a2 * __builtin_amdgcn_cvt_pk_f32_fp8((int)vb[j][q][i], false); op[q * 8 + 2 * i + 1] += a2 * __builtin_amdgcn_cvt_pk_f32_fp8((int)vb[j][q][i], true); } } \
        } while (0)
        G_LOADU(ua, 0);
#pragma unroll 1
        for (int g2 = 0; g2 < 32; g2 += 2) { G_BODY(ua, ub, g2); G_BODY(ub, ua, g2 + 1); }
#undef G_LOADU
#undef G_LOADV
#undef G_BODY
        float ss = 0.f; float4 xs[8];
#pragma unroll
        for (int q = 0; q < 2; ++q)
#pragma unroll
            for (int i = 0; i < 4; ++i) { float4 x;
                x.x = op[q * 8 + 2 * i].x; x.y = op[q * 8 + 2 * i].y; x.z = op[q * 8 + 2 * i + 1].x; x.w = op[q * 8 + 2 * i + 1].y;
                ss += x.x * x.x + x.y * x.y + x.z * x.z + x.w * x.w; xs[q * 4 + i] = x; }
        ss = wave_sum_dpp(ss);
        const float scl = rsqrtf(ss * (1.f / 2048.f) + 1e-6f);
#pragma unroll
        for (int q = 0; q < 2; ++q)
#pragma unroll
            for (int i = 0; i < 4; ++i) { const float4 g = *(const float4*)(nf + q * 1024 + lane * 16 + 4 * i); const float4 x = xs[q * 4 + i];
                *(float4*)(p.out + (size_t)t * D_ + q * 1024 + lane * 16 + 4 * i) = make_float4(x.x * scl * g.x, x.y * scl * g.y, x.z * scl * g.z, x.w * scl * g.w); }
    }
}

#define XB_TMO      128
#define XB_XCNT(j)  (256  + 64 * (j))
#define XB_XSUB(j)  (1280 + 64 * (j))
#define XB_XGEN(j)  (2304 + 64 * (j))
#define XB_TOP      3328
#define XB_TOPGEN   3392
#define XCD_BAR_WORDS 3456
#define XB_SPIN_CAP (1u << 18)
__device__ __forceinline__ unsigned xb_ld(unsigned* p)              { return __hip_atomic_load(p, __ATOMIC_RELAXED, __HIP_MEMORY_SCOPE_AGENT); }
__device__ __forceinline__ unsigned xb_add(unsigned* p, unsigned v) { return __hip_atomic_fetch_add(p, v, __ATOMIC_RELAXED, __HIP_MEMORY_SCOPE_AGENT); }
__device__ __forceinline__ unsigned xb_xcc_id() { return (unsigned)__builtin_amdgcn_s_getreg((3 << 11) | 20) & 0xFu; }
#define XB_SPIN(cond, bar) do { unsigned _sp = 0; while (cond) { __builtin_amdgcn_s_sleep(1); \
    if ((++_sp & 255u) == 0u) { if (xb_ld(&(bar)[XB_TMO])) break; if (_sp > XB_SPIN_CAP) { atomicAdd(&(bar)[XB_TMO], 1u); break; } } } } while (0)
struct XcdBarrier { unsigned* bar; unsigned x; volatile LAS unsigned* st; };
__device__ __forceinline__ XcdBarrier xcd_barrier_post(unsigned* bar, volatile LAS unsigned* st) {
    XcdBarrier b; b.bar = bar; b.x = xb_xcc_id(); b.st = st;
    if (threadIdx.x == 0) (void)xb_add(&bar[XB_XCNT(b.x)], 1u);
    return b;
}
__device__ __forceinline__ void xcd_barrier_complete(unsigned* bar, unsigned x, unsigned& nloc, unsigned& nx) {
    const unsigned G = gridDim.x * gridDim.y * gridDim.z;
    unsigned sum, cnt, mine, sp = 0u;
    for (;;) {
        sum = 0u; cnt = 0u; mine = 0u;
#pragma unroll
        for (unsigned j = 0; j < 16; ++j) { const unsigned c = xb_ld(&bar[XB_XCNT(j)]); sum += c; cnt += (c > 0u) ? 1u : 0u; mine = (j == x) ? c : mine; }
        if (sum == G) break;
        __builtin_amdgcn_s_sleep(1);
        if ((++sp & 255u) == 0u) { if (xb_ld(&bar[XB_TMO])) break; if (sp > XB_SPIN_CAP) { atomicAdd(&bar[XB_TMO], 1u); break; } }
    }
    nloc = mine > 0u ? mine : 1u; nx = cnt > 0u ? cnt : 1u;
}
__device__ __forceinline__ void xcd_barrier(const XcdBarrier& b) {
    asm volatile("s_waitcnt vmcnt(0)" ::: "memory");
    __syncthreads();
    if (threadIdx.x == 0) {
        unsigned* bar = b.bar;
        __builtin_amdgcn_s_waitcnt(0);
        unsigned nloc = b.st[0], nx = b.st[1];
        if (nloc == 0u) { xcd_barrier_complete(bar, b.x, nloc, nx); b.st[0] = nloc; b.st[1] = nx; }
        const unsigned old = xb_add(&bar[XB_XSUB(b.x)], 1u);
        const unsigned gen = old / nloc;
        if (old + 1u == (gen + 1u) * nloc) {
            __builtin_amdgcn_fence(__ATOMIC_RELEASE, "agent");
            asm volatile("s_waitcnt vmcnt(0)" ::: "memory");
            const unsigned og = xb_add(&bar[XB_TOP], 1u);
            const unsigned tg = og / nx;
            if (og + 1u == (tg + 1u) * nx) xb_add(&bar[XB_TOPGEN], 1u);
            else XB_SPIN(xb_ld(&bar[XB_TOPGEN]) == tg, bar);
            __builtin_amdgcn_fence(__ATOMIC_ACQUIRE, "agent");
            xb_add(&bar[XB_XGEN(b.x)], 1u);
            asm volatile("s_waitcnt vmcnt(0)" ::: "memory");
        } else {
            XB_SPIN(xb_ld(&bar[XB_XGEN(b.x)]) == gen, bar);
            __builtin_amdgcn_fence(__ATOMIC_ACQUIRE, "agent");
            asm volatile("s_waitcnt vmcnt(0)" ::: "memory");
        }
    }
    __syncthreads();
}

__global__ void __launch_bounds__(512, 2) mega(Params p) {
    extern __shared__ __attribute__((aligned(16))) unsigned char shm[];
    cg::grid_group grid = cg::this_grid();
    LAS unsigned char* lds = (LAS unsigned char*)shm;
    volatile LAS unsigned* bst = (volatile LAS unsigned*)(lds + LDS_BYTES - 16);
    if (threadIdx.x == 0) { bst[0] = 0u; bst[1] = 0u; }
    __syncthreads();
    const XcdBarrier xbar = xcd_barrier_post((unsigned*)(p.ws + WS_BAR), bst);
    if (p.ph_hi > 1000) grid.sync();
    const int lo = p.ph_lo, hi = p.ph_hi;
#define IN(k) (lo <= (k) && (k) < hi)
#define REP(k) for (int _r = 0; _r < ((k) == DUP_PHASE ? 2 : 1); ++_r)
#define SEAM(k) do { if (IN(k) && IN((k) + 1)) xcd_barrier(xbar); } while (0)
    if (IN(0)) REP(0) { if (_r) xcd_barrier(xbar); phase0(p, shm); }
    SEAM(0);
    if (IN(1)) REP(1) { if (_r) xcd_barrier(xbar);
        pg8::Gemm g{(const bf16_t*)(p.ws + WS_H), (const bf16_t*)(p.ws + WS_WB1), S_, NAUG, 2048};
        pg8::StaticOrder so; so.init(g.M, g.N, (int)gridDim.x, (int)blockIdx.x);
        pg8::EpiBf16 E{(bf16_t*)(p.ws + WS_PROJ), NAUG};
        pg8::gemm_phase(lds, g, so, E);
    }
    SEAM(1);
    if (IN(2)) REP(2) { if (_r) xcd_barrier(xbar);
        phase_prepM(p, lds);
        phase_prepE(p);
    }
    SEAM(2);
    if (IN(3)) REP(3) { if (_r) xcd_barrier(xbar); phase_chunkA(p, lds); }
    SEAM(3);
    if (IN(4)) REP(4) { if (_r) xcd_barrier(xbar); if (blockIdx.x < 64) phase_seq(p);
        else { const int bid = blockIdx.x - 64, nblk = gridDim.x - 64;
            convert_fp8(p.in[23], p.ws + WS_UB, (size_t)16384 * 2048, U8_SCALE, bid, nblk);
            convert_fp8(p.in[24], p.ws + WS_VB, (size_t)16384 * 2048, V8_SCALE, bid, nblk);
            build_wpt(p.in[21], (const bf16_t*)(p.ws + WS_KEYB), (bf16_t*)(p.ws + WS_WQT), bid, nblk);
            transpose_convert(p.in[19], 2048, 2048, (bf16_t*)(p.ws + WS_WOT), (float*)shm, bid, nblk); } }
    SEAM(4);
    if (IN(5)) REP(5) { if (_r) xcd_barrier(xbar); phase_chunkY(p, lds); }
    SEAM(5);
    if (IN(6)) REP(6) { if (_r) xcd_barrier(xbar);
        pg8::Gemm g{(const bf16_t*)(p.ws + WS_YMIX), (const bf16_t*)(p.ws + WS_WOT), S_, 2048, 2048};
        pg8::StaticOrder so; so.init(g.M, g.N, (int)gridDim.x, (int)blockIdx.x);
        pg8::EpiResF32 E{(float*)(p.ws + WS_X1), p.in[0], 2048};
        pg8::gemm_phase(lds, g, so, E);
    }
    SEAM(6);
    if (IN(7)) REP(7) { if (_r) xcd_barrier(xbar);
        rmsnorm_rows((const float*)(p.ws + WS_X1), p.in[20], (bf16_t*)(p.ws + WS_H2));
    }
    SEAM(7);
    if (IN(8)) REP(8) { if (_r) xcd_barrier(xbar);
        pg8::Gemm g{(const bf16_t*)(p.ws + WS_H2), (const bf16_t*)(p.ws + WS_WQT), S_, 2048, 2048};
        pg8::StaticOrder so; so.init(g.M, g.N, (int)gridDim.x, (int)blockIdx.x);
        pg8::EpiF32 E{(float*)(p.ws + WS_Q), 2048};
        pg8::gemm_phase(lds, g, so, E);
    }
    SEAM(8);
    if (IN(9)) REP(9) { if (_r) xcd_barrier(xbar); phase_topk(p, shm); }
    SEAM(9);
    if (IN(10)) REP(10) { if (_r) xcd_barrier(xbar); phase_gather(p, shm); }
#undef IN
#undef REP
#undef SEAM
}

extern "C" void kernel_launch(void* const* d_in, const int* in_sizes, int n_in, void* d_out, int out_size, void* d_ws, size_t ws_size, hipStream_t stream) {
    static int grid_blocks = 0;
    if (grid_blocks == 0) {
        if (n_in != 26 || ws_size < WS_NEED) { fprintf(stderr, "kernel_launch: unexpected n_in %d / ws_size %zu\n", n_in, ws_size); grid_blocks = -1; return; }
        int dev = 0, cus = 0, per_cu = 0;
        (void)hipGetDevice(&dev);
        (void)hipDeviceGetAttribute(&cus, hipDeviceAttributeMultiprocessorCount, dev);
        (void)hipFuncSetAttribute((const void*)mega, hipFuncAttributeMaxDynamicSharedMemorySize, LDS_BYTES);
        (void)hipOccupancyMaxActiveBlocksPerMultiprocessor(&per_cu, (const void*)mega, 512, LDS_BYTES);
        if (per_cu < 1) { fprintf(stderr, "kernel_launch: occupancy query says %d blocks/CU\n", per_cu); per_cu = 1; }
        grid_blocks = cus * per_cu;
        fprintf(stderr, "kernel_launch: cus %d per_cu %d grid %d\n", cus, per_cu, grid_blocks);
    }
    if (grid_blocks < 0) return;
    Params p{};
    for (int i = 0; i < 26; ++i) p.in[i] = (const float*)d_in[i];
    p.out = (float*)d_out; p.ws = (unsigned char*)d_ws;
#if MULTI_LAUNCH
    for (int ph = 0; ph < NPHASE; ++ph) {
        p.ph_lo = ph; p.ph_hi = ph + 1;
        hipLaunchKernelGGL(mega, dim3(grid_blocks), dim3(512), LDS_BYTES, stream, p);
    }
#else
    p.ph_lo = 0; p.ph_hi = NPHASE;
    if (hipMemsetAsync((unsigned char*)d_ws + WS_BAR, 0, XCD_BAR_WORDS * 4, stream) != hipSuccess) fprintf(stderr, "kernel_launch: barrier memset failed\n");
    void* args[] = {&p};
    hipError_t e = hipLaunchCooperativeKernel((const void*)mega, dim3(grid_blocks), dim3(512), args, LDS_BYTES, stream);
    if (e != hipSuccess) fprintf(stderr, "cooperative launch failed: %s (grid %d)\n", hipGetErrorString(e), grid_blocks);
#endif
}
```

```cpp
#include <hip/hip_runtime.h>
#include <hip/hip_cooperative_groups.h>
#include <cstdio>
namespace cg = cooperative_groups;

#ifndef DUP_PHASE
#define DUP_PHASE -1
#endif
#ifndef MULTI_LAUNCH
#define MULTI_LAUNCH 0
#endif

#define LAS __attribute__((address_space(3)))
typedef unsigned short bf16_t;
typedef short bf16x8 __attribute__((ext_vector_type(8)));
typedef float f32x4 __attribute__((ext_vector_type(4)));
typedef float f32x2 __attribute__((ext_vector_type(2)));
typedef unsigned u32x4 __attribute__((ext_vector_type(4)));
typedef unsigned u32x2 __attribute__((ext_vector_type(2)));

constexpr int S_ = 16384, D_ = 2048, DR = 1024, NAUG = 6912;
constexpr size_t MiB = 1ull << 20;
constexpr size_t WS_PROJ = 0, WS_H = 216 * MiB, WS_WB1 = 280 * MiB, WS_WQT = 280 * MiB, WS_WOT = 296 * MiB;
constexpr size_t WS_R = 307 * MiB, WS_K = 339 * MiB, WS_V = 371 * MiB, WS_KK = 403 * MiB, WS_A = 435 * MiB, WS_LW = 467 * MiB;
constexpr size_t WS_G = 216 * MiB, WS_YC = 248 * MiB, WS_YMIX = 307 * MiB, WS_X1 = 0, WS_H2 = 128 * MiB, WS_Q = 307 * MiB;
constexpr size_t WS_GT = 0, WS_HT = 32 * MiB, WS_QE = 96 * MiB, WS_YL = 128 * MiB, WS_S0 = 160 * MiB;
constexpr size_t WS_IDS = 192 * MiB, WS_GATES = 200 * MiB, WS_UB = 467 * MiB, WS_VB = 435 * MiB, WS_BON = 500 * MiB, WS_BAR = 502 * MiB, WS_KEYB = 503 * MiB, WS_SSQ = 504 * MiB, WS_NEED = 506 * MiB;
constexpr size_t WS_W2T = 499 * MiB, WS_A2T = WS_W2T + 131072, WS_G2T = WS_A2T + 131072;
constexpr int TLD = 72, TSLOT = 64 * TLD * 2;
constexpr int LDS_BYTES = 16 * TSLOT + 2048 + 256 + 16;
constexpr int NPHASE = 11;

struct Params {
    const float* in[26];
    float* out;
    unsigned char* ws;
    int ph_lo, ph_hi;
};

__device__ __forceinline__ float bf2f(bf16_t b) { return __uint_as_float(((unsigned)b) << 16); }
__device__ __forceinline__ bf16_t f2bf(float f) { unsigned u = __float_as_uint(f); u += 0x7FFFu + ((u >> 16) & 1u); return (bf16_t)(u >> 16); }
typedef __bf16 bf16v2_t __attribute__((ext_vector_type(2)));
__device__ __forceinline__ unsigned cvt_pk_bf16(float lo, float hi) { const f32x2 v = {lo, hi}; const bf16v2_t r = __builtin_convertvector(v, bf16v2_t); return __builtin_bit_cast(unsigned, r); }
__device__ __forceinline__ u32x4 pack8(const float* f) { u32x4 w; w.x = cvt_pk_bf16(f[0], f[1]); w.y = cvt_pk_bf16(f[2], f[3]); w.z = cvt_pk_bf16(f[4], f[5]); w.w = cvt_pk_bf16(f[6], f[7]); return w; }
__device__ __forceinline__ float lo_bf(unsigned w) { return __uint_as_float(w << 16); }
__device__ __forceinline__ float hi_bf(unsigned w) { return __uint_as_float(w & 0xffff0000u); }
__device__ __forceinline__ void unpack8(const u32x4 v, float* f) {
#pragma unroll
    for (int i = 0; i < 4; ++i) { f[2 * i] = lo_bf(v[i]); f[2 * i + 1] = hi_bf(v[i]); }
}
__device__ __forceinline__ float wave_sum(float v) {
#pragma unroll
    for (int o = 32; o; o >>= 1) v += __shfl_xor(v, o);
    return v;
}
template <int CTRL, int RM> __device__ __forceinline__ float dpp_f(float v) { return __int_as_float(__builtin_amdgcn_update_dpp(0, __float_as_int(v), CTRL, RM, 0xf, false)); }
__device__ __forceinline__ float wave_sum_dpp(float v) {
    v += dpp_f<0xB1, 0xf>(v); v += dpp_f<0x4E, 0xf>(v); v += dpp_f<0x141, 0xf>(v); v += dpp_f<0x140, 0xf>(v);
    v += dpp_f<0x142, 0xa>(v); v += dpp_f<0x143, 0xc>(v);
    return __int_as_float(__builtin_amdgcn_readlane(__float_as_int(v), 63));
}
__device__ __forceinline__ float wave_max(float v) {
#pragma unroll
    for (int o = 32; o; o >>= 1) v = fmaxf(v, __shfl_xor(v, o));
    return v;
}
__device__ __forceinline__ float sigmoidf_(float x) { return 1.0f / (1.0f + __expf(-x)); }
__device__ __forceinline__ float gelu_tanh(float x) { float u = 0.7978845608028654f * (x + 0.044715f * x * x * x); return 0.5f * x * (1.0f + tanhf(u)); }

namespace pg8 {
constexpr int BM = 256, BK = 64, HALF = 128, HTB = HALF * BK * 2, STAGE_BYTES = 8 * HTB, NXCD = 8, WGM = 8;
__device__ __forceinline__ int lds_byte(int r, int c) { const int st = (r >> 4) * 2 + (c >> 5), rr = r & 15, cc = c & 31, ob = rr * 64 + cc * 2; return st * 1024 + (ob ^ (((ob >> 9) & 1) << 5)); }
__device__ __forceinline__ void stage_rc(int b, int& R, int& C) { const int st = b / 1024, sb = b % 1024, swz = sb ^ (((sb >> 9) & 1) << 5); R = (st >> 1) * 16 + swz / 64; C = (st & 1) * 32 + (swz % 64) / 2; }
__device__ __forceinline__ int perm32(int rho) { const int n = rho >> 4, i = rho & 15; return 8 * (i >> 2) + 4 * n + (i & 3); }
struct Unit { int pm, pn; };
struct Gemm { const bf16_t* A; const bf16_t* Bt; int M, N, K; };
struct StaticOrder {
    int nM, nN, nwg, G, c;
    __device__ void init(int M, int N, int G_, int c_) { nM = M / BM; nN = N / BM; nwg = nM * nN; G = G_; c = c_; }
    __device__ bool next(int i, Unit& u) const {
        const long L = (long)i * G + c; if (L >= nwg) return false;
        int wgid = (int)L; { const int q = nwg / NXCD, r = nwg % NXCD, xcd = wgid % NXCD, off = wgid / NXCD; wgid = (xcd < r ? xcd * (q + 1) : r * (q + 1) + (xcd - r) * q) + off; }
        const int nig = WGM * nN, gid = wgid / nig, fm = gid * WGM, gsz = (nM - fm) < WGM ? (nM - fm) : WGM;
        u.pm = fm + ((wgid % nig) % gsz); u.pn = (wgid % nig) / gsz; return true;
    }
    __device__ __forceinline__ void a_ready(const Unit&) const {}
    __device__ __forceinline__ void done(const Unit&) const {}
};
struct EpiResF32 {
    static constexpr bool PERM = false;
    float* C; const float* Res; int ldc;
    __device__ __forceinline__ void operator()(const f32x4 (&acc)[2][2][4][2], const Unit& u, int wr, int wc, int fr, int fq) const {
        const int row0 = u.pm * BM + wr * 64 + fr, col0 = u.pn * BM + wc * 32 + 4 * fq;
#pragma unroll
        for (int ai = 0; ai < 2; ++ai)
#pragma unroll
            for (int m = 0; m < 4; ++m) { const size_t ro = (size_t)(row0 + ai * HALF + m * 16) * ldc + col0;
#pragma unroll
                for (int bj = 0; bj < 2; ++bj)
#pragma unroll
                    for (int n = 0; n < 2; ++n) { const f32x4 rs = *(const f32x4*)(Res + ro + bj * HALF + n * 16); *(f32x4*)(C + ro + bj * HALF + n * 16) = acc[ai][bj][m][n] + rs; } }
    }
};
struct EpiRes2 {
    static constexpr bool PERM = false;
    float* C; const float* Res; bf16_t* Cb; float* SSQ; int ldc;
    __device__ __forceinline__ void operator()(const f32x4 (&acc)[2][2][4][2], const Unit& u, int wr, int wc, int fr, int fq) const {
        const int row0 = u.pm * BM + wr * 64 + fr, col0 = u.pn * BM + wc * 32 + 4 * fq;
#pragma unroll
        for (int ai = 0; ai < 2; ++ai)
#pragma unroll
            for (int m = 0; m < 4; ++m) { const int row = row0 + ai * HALF + m * 16; const size_t ro = (size_t)row * ldc + col0; float ss = 0.f;
#pragma unroll
                for (int bj = 0; bj < 2; ++bj)
#pragma unroll
                    for (int n = 0; n < 2; ++n) { const f32x4 v = acc[ai][bj][m][n] + *(const f32x4*)(Res + ro + bj * HALF + n * 16);
                        *(f32x4*)(C + ro + bj * HALF + n * 16) = v;
                        u32x2 wv; wv.x = cvt_pk_bf16(v[0], v[1]); wv.y = cvt_pk_bf16(v[2], v[3]); *(u32x2*)(Cb + ro + bj * HALF + n * 16) = wv;
                        ss += v[0] * v[0] + v[1] * v[1] + v[2] * v[2] + v[3] * v[3]; }
                ss += __shfl_xor(ss, 16); ss += __shfl_xor(ss, 32);
                if (fq == 0) SSQ[(size_t)row * 32 + u.pn * 4 + wc] = ss; }
    }
};
struct EpiRowScaleF32 {
    static constexpr bool PERM = false;
    float* C; const float* SSQ; int ldc;
    __device__ __forceinline__ void operator()(const f32x4 (&acc)[2][2][4][2], const Unit& u, int wr, int wc, int fr, int fq) const {
        const int row0 = u.pm * BM + wr * 64 + fr, col0 = u.pn * BM + wc * 32 + 4 * fq;
#pragma unroll
        for (int ai = 0; ai < 2; ++ai)
#pragma unroll
            for (int m = 0; m < 4; ++m) { const int row = row0 + ai * HALF + m * 16; const size_t ro = (size_t)row * ldc + col0;
                const f32x4* sp = (const f32x4*)(SSQ + (size_t)row * 32); float sq = 0.f;
#pragma unroll
                for (int q = 0; q < 8; ++q) { const f32x4 v = sp[q]; sq += (v[0] + v[1]) + (v[2] + v[3]); }
                const float rs = rsqrtf(sq * (1.0f / 2048.0f) + 1e-6f);
#pragma unroll
                for (int bj = 0; bj < 2; ++bj)
#pragma unroll
                    for (int n = 0; n < 2; ++n) *(f32x4*)(C + ro + bj * HALF + n * 16) = acc[ai][bj][m][n] * rs; }
    }
};
struct EpiF32 {
    static constexpr bool PERM = false;
    float* C; int ldc;
    __device__ __forceinline__ void operator()(const f32x4 (&acc)[2][2][4][2], const Unit& u, int wr, int wc, int fr, int fq) const {
        const int row0 = u.pm * BM + wr * 64 + fr, col0 = u.pn * BM + wc * 32 + 4 * fq;
#pragma unroll
        for (int ai = 0; ai < 2; ++ai)
#pragma unroll
            for (int m = 0; m < 4; ++m) { const size_t ro = (size_t)(row0 + ai * HALF + m * 16) * ldc + col0;
#pragma unroll
                for (int bj = 0; bj < 2; ++bj)
#pragma unroll
                    for (int n = 0; n < 2; ++n) *(f32x4*)(C + ro + bj * HALF + n * 16) = acc[ai][bj][m][n]; }
    }
};
struct EpiBf16 {
    static constexpr bool PERM = true;
    bf16_t* O; int ldc;
    __device__ __forceinline__ void operator()(const f32x4 (&acc)[2][2][4][2], const Unit& u, int wr, int wc, int fr, int fq) const {
        const int row0 = u.pm * BM + wr * 64 + fr; const int col0 = u.pn * BM + wc * 32 + 8 * fq;
#pragma unroll
        for (int ai = 0; ai < 2; ++ai)
#pragma unroll
            for (int m = 0; m < 4; ++m) { bf16_t* rowp = O + (size_t)(row0 + ai * HALF + m * 16) * ldc + col0;
#pragma unroll
                for (int bj = 0; bj < 2; ++bj) { const f32x4 v0 = acc[ai][bj][m][0], v1 = acc[ai][bj][m][1];
                    u32x4 w; w.x = cvt_pk_bf16(v0[0], v0[1]); w.y = cvt_pk_bf16(v0[2], v0[3]); w.z = cvt_pk_bf16(v1[0], v1[1]); w.w = cvt_pk_bf16(v1[2], v1[3]);
                    *(u32x4*)(rowp + bj * HALF) = w; } }
    }
};

template <class Epi, class Sched>
__device__ __forceinline__ void gemm_phase(LAS unsigned char* lds, const Gemm g, const Sched& S, const Epi& E) {
    const int tid = threadIdx.x, wid = __builtin_amdgcn_readfirstlane(tid >> 6), lane = tid & 63, wr = wid >> 2, wc = wid & 3, fr = lane & 15, fq = lane >> 4;
    const int K = g.K, nt = K / BK;
    unsigned voffA[2], voffB[2];
#pragma unroll
    for (int i = 0; i < 2; ++i) { int R, C; stage_rc(tid * 16 + i * 8192, R, C); const int Rb = Epi::PERM ? ((R & ~31) + perm32(R & 31)) : R;
        voffA[i] = (unsigned)(R * K + C) * 2u; voffB[i] = (unsigned)(Rb * K + C) * 2u; }
    const size_t kstep = (size_t)(BK * 2);
    const size_t hstep = (size_t)HALF * K * 2;
    const size_t tstep = 2 * hstep;
    const unsigned ldsw = (unsigned)wid * 1024u;
    const int aoff = lds_byte(wr * 64 + fr, fq * 8), boff = lds_byte(wc * 32 + fr, fq * 8);
#define PG8_SA(b, h) (((b) * 2 + (h)) * HTB)
#define PG8_SB(b, h) ((4 + (b) * 2 + (h)) * HTB)
#define PG8_STAGE(bufoff, gbase, voff) do { _Pragma("unroll") for (int _i = 0; _i < 2; ++_i) \
        __builtin_amdgcn_global_load_lds((const unsigned*)((const char*)(gbase) + (voff)[_i]), (LAS unsigned*)(lds + (bufoff) + ldsw + _i * 8192), 16, 0, 0); } while (0)
#define PG8_LDA(dst, b, h) do { _Pragma("unroll") for (int m = 0; m < 4; ++m) _Pragma("unroll") for (int k = 0; k < 2; ++k) dst[m][k] = *(const LAS bf16x8*)(lds + PG8_SA(b, h) + aoff + m * 2048 + k * 1024); } while (0)
#define PG8_LDB(dst, b, h) do { _Pragma("unroll") for (int n = 0; n < 2; ++n) _Pragma("unroll") for (int k = 0; k < 2; ++k) dst[n][k] = *(const LAS bf16x8*)(lds + PG8_SB(b, h) + boff + n * 2048 + k * 1024); } while (0)
#define PG8_MMA(ai, bj, At, Bt) do { __builtin_amdgcn_s_setprio(1); _Pragma("unroll") for (int m = 0; m < 4; ++m) _Pragma("unroll") for (int n = 0; n < 2; ++n) _Pragma("unroll") for (int k = 0; k < 2; ++k) \
        acc[ai][bj][m][n] = __builtin_amdgcn_mfma_f32_16x16x32_bf16(Bt[n][k], At[m][k], acc[ai][bj][m][n], 0, 0, 0); __builtin_amdgcn_s_setprio(0); } while (0)
#define PG8_WAIT_V(n) asm volatile("s_waitcnt vmcnt(" #n ")" ::: "memory")
#define PG8_WAIT_L(n) asm volatile("s_waitcnt lgkmcnt(" #n ")" ::: "memory")
#define PG8_BAR __builtin_amdgcn_s_barrier()
#define PG8_SCHED __builtin_amdgcn_sched_barrier(0)
    Unit cur, nxt; int ui = 0;
    if (!S.next(0, cur)) return;
    f32x4 acc[2][2][4][2];
#pragma unroll
    for (int a = 0; a < 2; ++a)
#pragma unroll
        for (int b = 0; b < 2; ++b)
#pragma unroll
            for (int m = 0; m < 4; ++m)
#pragma unroll
                for (int n = 0; n < 2; ++n) acc[a][b][m][n] = (f32x4){0.f, 0.f, 0.f, 0.f};
    bf16x8 At[4][2], B0[2][2], B1[2][2];
    const char* cA = (const char*)g.A + (size_t)cur.pm * tstep; const char* cB = (const char*)g.Bt + (size_t)cur.pn * tstep;
    S.a_ready(cur);
    PG8_STAGE(PG8_SB(0, 0), cB, voffB); PG8_STAGE(PG8_SA(0, 0), cA, voffA); PG8_STAGE(PG8_SB(0, 1), cB + hstep, voffB); PG8_STAGE(PG8_SA(0, 1), cA + hstep, voffA);
    if (wr == 1) PG8_BAR;
    PG8_WAIT_V(4); PG8_BAR;
    PG8_STAGE(PG8_SB(1, 0), cB + kstep, voffB); PG8_STAGE(PG8_SA(1, 0), cA + kstep, voffA); PG8_STAGE(PG8_SB(1, 1), cB + hstep + kstep, voffB);
    PG8_WAIT_V(6); PG8_BAR;
    for (;;) {
        const bool has_next = S.next(ui + 1, nxt);
        const char* nA = has_next ? (const char*)g.A + (size_t)nxt.pm * tstep : cA; const char* nB = has_next ? (const char*)g.Bt + (size_t)nxt.pn * tstep : cB;
        for (int t = 0; t < nt; t += 2) {
            const bool last = (t == nt - 2);
            const char* a1 = cA + (size_t)(t + 1) * kstep;
            const char* a2 = last ? nA : cA + (size_t)(t + 2) * kstep; const char* b2 = last ? nB : cB + (size_t)(t + 2) * kstep;
            const char* a3 = a2 + kstep; const char* b3 = b2 + kstep;
            if (last && has_next) S.a_ready(nxt);
            PG8_LDB(B0, 0, 0); PG8_SCHED; PG8_LDA(At, 0, 0); PG8_STAGE(PG8_SA(1, 1), a1 + hstep, voffA);
            PG8_WAIT_L(8); PG8_BAR; PG8_WAIT_L(0); PG8_MMA(0, 0, At, B0); PG8_BAR; PG8_SCHED;
            PG8_LDB(B1, 0, 1); PG8_STAGE(PG8_SB(0, 0), b2, voffB);
            PG8_BAR; PG8_WAIT_L(0); PG8_MMA(0, 1, At, B1); PG8_BAR;
            PG8_LDA(At, 0, 1); PG8_STAGE(PG8_SA(0, 0), a2, voffA);
            PG8_BAR; PG8_WAIT_L(0); PG8_MMA(1, 0, At, B0); PG8_BAR; PG8_SCHED;
            PG8_STAGE(PG8_SB(0, 1), b2 + hstep, voffB);
            PG8_WAIT_V(6); PG8_BAR; PG8_MMA(1, 1, At, B1); PG8_BAR;
            PG8_LDB(B0, 1, 0); PG8_SCHED; PG8_LDA(At, 1, 0); PG8_STAGE(PG8_SA(0, 1), a2 + hstep, voffA);
            PG8_WAIT_L(8); PG8_BAR; PG8_WAIT_L(0); PG8_MMA(0, 0, At, B0); PG8_BAR; PG8_SCHED;
            PG8_LDB(B1, 1, 1); PG8_STAGE(PG8_SB(1, 0), b3, voffB);
            PG8_BAR; PG8_WAIT_L(0); PG8_MMA(0, 1, At, B1); PG8_BAR;
            PG8_LDA(At, 1, 1); PG8_STAGE(PG8_SA(1, 0), a3, voffA);
            PG8_BAR; PG8_WAIT_L(0); PG8_MMA(1, 0, At, B0); PG8_BAR; PG8_SCHED;
            PG8_STAGE(PG8_SB(1, 1), b3 + hstep, voffB);
            PG8_WAIT_V(6); PG8_BAR; PG8_MMA(1, 1, At, B1); PG8_BAR;
        }
        E(acc, cur, wr, wc, fr, fq); S.done(cur);
        if (!has_next) break;
#pragma unroll
        for (int a = 0; a < 2; ++a)
#pragma unroll
            for (int b = 0; b < 2; ++b)
#pragma unroll
                for (int m = 0; m < 4; ++m)
#pragma unroll
                    for (int n = 0; n < 2; ++n) acc[a][b][m][n] = (f32x4){0.f, 0.f, 0.f, 0.f};
        cur = nxt; cA = nA; cB = nB; ++ui;
    }
    PG8_WAIT_V(0);
    if (wr == 0) PG8_BAR;
    PG8_BAR;
#undef PG8_SA
#undef PG8_SB
#undef PG8_STAGE
#undef PG8_LDA
#undef PG8_LDB
#undef PG8_MMA
#undef PG8_WAIT_V
#undef PG8_WAIT_L
#undef PG8_BAR
#undef PG8_SCHED
}
}

__device__ __forceinline__ void rmsnorm_rows(const float* X, const float* gain, bf16_t* H) {
    const int wave = threadIdx.x >> 6, lane = threadIdx.x & 63;
    for (int row = blockIdx.x * 8 + wave; row < S_; row += gridDim.x * 8) {
        const float4* xr = (const float4*)(X + (size_t)row * D_);
        float4 v[8]; float ss = 0.f;
#pragma unroll
        for (int i = 0; i < 8; ++i) { v[i] = xr[i * 64 + lane]; ss += v[i].x * v[i].x + v[i].y * v[i].y + v[i].z * v[i].z + v[i].w * v[i].w; }
        ss = wave_sum(ss);
        const float sc = rsqrtf(ss * (1.0f / 2048.0f) + 1e-6f);
#pragma unroll
        for (int i = 0; i < 8; ++i) { const float4 g = ((const float4*)gain)[i * 64 + lane];
            u32x2 w; w.x = cvt_pk_bf16(v[i].x * sc * g.x, v[i].y * sc * g.y); w.y = cvt_pk_bf16(v[i].z * sc * g.z, v[i].w * sc * g.w);
            *(u32x2*)(H + (size_t)row * D_ + (i * 64 + lane) * 4) = w; }
    }
}

__device__ __forceinline__ void transpose_convert(const float* W, int K, int N, bf16_t* Bt, float* tile, int bid, int nblk) {
    const int tid = threadIdx.x; const int tk = K / 64, tn = N / 64, nt = tk * tn;
    float4 rg[2];
#define TC_LOAD(u) do { const int _k0 = ((u) / tn) * 64, _n0 = ((u) % tn) * 64; _Pragma("unroll") for (int i = 0; i < 2; ++i) { const int idx = tid + 512 * i; \
        rg[i] = *(const float4*)(W + (size_t)(_k0 + (idx >> 4)) * N + _n0 + (idx & 15) * 4); } } while (0)
    if (bid < nt) TC_LOAD(bid);
    for (int u = bid; u < nt; u += nblk) {
        const int k0 = (u / tn) * 64, n0 = (u % tn) * 64;
        __syncthreads();
#pragma unroll
        for (int i = 0; i < 2; ++i) { const int idx = tid + 512 * i; float* q = tile + (idx >> 4) * 65 + (idx & 15) * 4; q[0] = rg[i].x; q[1] = rg[i].y; q[2] = rg[i].z; q[3] = rg[i].w; }
        __syncthreads();
        if (u + nblk < nt) TC_LOAD(u + nblk);
#pragma unroll
        for (int i = 0; i < 4; ++i) { const int nn = i * 16 + (tid >> 5), kp = (tid & 31) * 2;
            *(unsigned*)(Bt + (size_t)(n0 + nn) * K + k0 + kp) = cvt_pk_bf16(tile[kp * 65 + nn], tile[(kp + 1) * 65 + nn]); }
    }
#undef TC_LOAD
}

__device__ __forceinline__ void convert_flat(const float* src, bf16_t* dst, size_t n) {
    for (size_t i = ((size_t)blockIdx.x * 512 + threadIdx.x) * 8; i < n; i += (size_t)gridDim.x * 512 * 8) {
        const float4 a = *(const float4*)(src + i), b = *(const float4*)(src + i + 4);
        u32x4 w; w.x = cvt_pk_bf16(a.x, a.y); w.y = cvt_pk_bf16(a.z, a.w); w.z = cvt_pk_bf16(b.x, b.y); w.w = cvt_pk_bf16(b.z, b.w);
        *(u32x4*)(dst + i) = w;
    }
}

__device__ __forceinline__ void convert_fp8(const float* src, unsigned char* dst, size_t n, float sc, const float* colgain, int bid, int nblk) {
    const int lane = threadIdx.x & 63, wv = threadIdx.x >> 6;
    for (size_t base = ((size_t)bid * 8 + wv) * 1024; base < n; base += (size_t)nblk * 8 * 1024) {
        float4 a[4];
#pragma unroll
        for (int j = 0; j < 4; ++j) a[j] = *(const float4*)(src + base + (size_t)(j * 64 + lane) * 4);
#pragma unroll
        for (int j = 0; j < 4; ++j) { float4 gg = make_float4(sc, sc, sc, sc);
            if (colgain) { const float4 cgv = *(const float4*)(colgain + ((base + (size_t)(j * 64 + lane) * 4) & 2047)); gg.x *= cgv.x; gg.y *= cgv.y; gg.z *= cgv.z; gg.w *= cgv.w; }
            int x = __builtin_amdgcn_cvt_pk_fp8_f32(a[j].x * gg.x, a[j].y * gg.y, 0, false); x = __builtin_amdgcn_cvt_pk_fp8_f32(a[j].z * gg.z, a[j].w * gg.w, x, true);
            *(unsigned*)(dst + base + (size_t)(j * 64 + lane) * 4) = (unsigned)x; }
    }
}

__device__ __forceinline__ void build_wpt(const float* wq, const float* gain, const bf16_t* KEYB, bf16_t* WPT, int bid, int nblk) {
    const int w = threadIdx.x >> 6, lane = threadIdx.x & 63, fr = lane & 15, fq = lane >> 4;
    for (int task = bid * 8 + w; task < 16 * 128; task += nblk * 8) {
        const int g = task >> 7, kb = task & 127;
        f32x4 acc[8];
#pragma unroll
        for (int n = 0; n < 8; ++n) acc[n] = (f32x4){0.f, 0.f, 0.f, 0.f};
#pragma unroll 2
        for (int ks = 0; ks < 8; ++ks) {
            const float4* wp = (const float4*)(wq + (size_t)(kb * 16 + fr) * 4096 + g * 256 + ks * 32 + fq * 8);
            const float4 x0 = wp[0], x1 = wp[1]; const float gk = gain[kb * 16 + fr];
            u32x4 wv; wv.x = cvt_pk_bf16(x0.x * gk, x0.y * gk); wv.y = cvt_pk_bf16(x0.z * gk, x0.w * gk); wv.z = cvt_pk_bf16(x1.x * gk, x1.y * gk); wv.w = cvt_pk_bf16(x1.z * gk, x1.w * gk);
            const bf16x8 a = __builtin_bit_cast(bf16x8, wv);
#pragma unroll
            for (int n = 0; n < 8; ++n) {
                const bf16x8 b = *(const bf16x8*)(KEYB + (size_t)(g * 128 + n * 16 + fr) * 256 + ks * 32 + fq * 8);
                acc[n] = __builtin_amdgcn_mfma_f32_16x16x32_bf16(a, b, acc[n], 0, 0, 0);
            }
        }
#pragma unroll
        for (int n = 0; n < 8; ++n) { u32x2 o; o.x = cvt_pk_bf16(acc[n][0], acc[n][1]); o.y = cvt_pk_bf16(acc[n][2], acc[n][3]);
            *(u32x2*)(WPT + (size_t)(g * 128 + n * 16 + fr) * 2048 + kb * 16 + fq * 4) = o; }
    }
}

__device__ __forceinline__ void phase0(const Params& p, unsigned char* shm) {
    bf16_t* WB1 = (bf16_t*)(p.ws + WS_WB1);
    rmsnorm_rows(p.in[0], p.in[1], (bf16_t*)(p.ws + WS_H));
    transpose_convert(p.in[2], 2048, 6144, WB1, (float*)shm, blockIdx.x, gridDim.x);
    const float* mu = p.in[4]; const float* w1 = p.in[6]; const float* a1 = p.in[9]; const float* g1 = p.in[11];
    for (int idx = blockIdx.x * 512 + threadIdx.x; idx < 768 * 2048; idx += gridDim.x * 512) {
        const int j = idx >> 11, k = idx & 2047; float val = 0.f;
        if (j < 128) { const float m = mu[k], w = w1[k * 64 + (j & 63)]; val = (j < 64) ? w * (1.f - m) : w * m; }
        else if (j < 256) { const float m = mu[2048 + k], w = a1[k * 64 + (j & 63)]; val = (j < 192) ? w * (1.f - m) : w * m; }
        else if (j < 576) { const float m = mu[4096 + k]; const int jj = j - 256; const int c = jj < 160 ? jj : jj - 160; const float w = g1[k * 160 + c]; val = jj < 160 ? w * (1.f - m) : w * m; }
        WB1[(size_t)(6144 + j) * 2048 + k] = f2bf(val);
    }
    convert_flat(p.in[22], (bf16_t*)(p.ws + WS_KEYB), (size_t)8 * 2 * 128 * 256);
    bf16_t* W2T = (bf16_t*)(p.ws + WS_W2T); bf16_t* A2T = (bf16_t*)(p.ws + WS_A2T); bf16_t* G2T = (bf16_t*)(p.ws + WS_G2T);
    const float* w2 = p.in[7]; const float* a2 = p.in[10]; const float* g2 = p.in[12];
    for (int idx = blockIdx.x * 512 + threadIdx.x; idx < 1024 * 288; idx += gridDim.x * 512) {
        if (idx < 65536) { const int c = idx >> 6, j = idx & 63; W2T[idx] = f2bf(w2[j * 1024 + c]); }
        else if (idx < 131072) { const int i2 = idx - 65536; const int c = i2 >> 6, j = i2 & 63; A2T[i2] = f2bf(a2[j * 1024 + c]); }
        else { const int i2 = idx - 131072; const int c = i2 / 160, j = i2 % 160; G2T[i2] = f2bf(g2[j * 1024 + c]); }
    }
}

constexpr int ACT_LD = 296;
template <int KS, int KOFF, int KTOT, int KIND>
__device__ __forceinline__ void lora_stage(const LAS bf16_t* act, const bf16_t* WT, const float* bias, bf16_t* OUT, int t0, int w, int fr, int fq) {
#pragma unroll 1
    for (int nh = 0; nh < 2; ++nh) {
        f32x4 acc[4][4];
#pragma unroll
        for (int m = 0; m < 4; ++m)
#pragma unroll
            for (int n = 0; n < 4; ++n) acc[m][n] = (f32x4){0.f, 0.f, 0.f, 0.f};
        bf16x8 bfr[KS][4];
#pragma unroll
        for (int ks = 0; ks < KS; ++ks)
#pragma unroll
            for (int n = 0; n < 4; ++n) bfr[ks][n] = *(const bf16x8*)(WT + (size_t)(w * 128 + (nh * 4 + n) * 16 + fr) * KTOT + ks * 32 + fq * 8);
#pragma unroll
        for (int ks = 0; ks < KS; ++ks) {
            bf16x8 a[4];
#pragma unroll
            for (int m = 0; m < 4; ++m) a[m] = *(const LAS bf16x8*)(act + (m * 16 + fr) * ACT_LD + KOFF + ks * 32 + fq * 8);
#pragma unroll
            for (int n = 0; n < 4; ++n)
#pragma unroll
                for (int m = 0; m < 4; ++m) acc[m][n] = __builtin_amdgcn_mfma_f32_16x16x32_bf16(bfr[ks][n], a[m], acc[m][n], 0, 0, 0);
        }
#pragma unroll
        for (int n = 0; n < 4; ++n) {
            const int c = w * 128 + (nh * 4 + n) * 16 + fq * 4;
            float bs[4] = {0.f, 0.f, 0.f, 0.f};
            if (KIND < 2) { const float4 bv = *(const float4*)(bias + c); bs[0] = bv.x; bs[1] = bv.y; bs[2] = bv.z; bs[3] = bv.w; }
#pragma unroll
            for (int m = 0; m < 4; ++m) {
                float o[4];
#pragma unroll
                for (int j = 0; j < 4; ++j) {
                    const float val = acc[m][n][j];
                    if (KIND == 0) { const float x = -(bs[j] + val); const float sp = fmaxf(x, 0.f) + __logf(1.f + __expf(-fabsf(x))); o[j] = -__expf(-sp - 0.5f); }
                    else if (KIND == 1) o[j] = sigmoidf_(bs[j] + val);
                    else o[j] = val;
                }
                u32x2 wv; wv.x = cvt_pk_bf16(o[0], o[1]); wv.y = cvt_pk_bf16(o[2], o[3]);
                *(u32x2*)(OUT + (size_t)(t0 + m * 16 + fr) * DR + c) = wv;
            }
        }
    }
}
__device__ __forceinline__ void phase_prepM(const Params& p, LAS unsigned char* lds) {
    LAS bf16_t* act = (LAS bf16_t*)lds;
    const bf16_t* P = (const bf16_t*)(p.ws + WS_PROJ);
    const int tid = threadIdx.x, w = tid >> 6, lane = tid & 63, fr = lane & 15, fq = lane >> 4;
    for (int tile = blockIdx.x; tile < S_ / 64; tile += gridDim.x) {
        const int t0 = tile * 64;
        __syncthreads();
        for (int task = tid; task < 64 * 36; task += 512) {
            const int t = task / 36, j0 = (task % 36) * 8; const int tg = t0 + t;
            int ccur, cprev;
            if (j0 < 64) { ccur = 6144 + j0; cprev = 6208 + j0; }
            else if (j0 < 128) { ccur = 6272 + (j0 - 64); cprev = 6336 + (j0 - 64); }
            else { ccur = 6400 + (j0 - 128); cprev = 6560 + (j0 - 128); }
            float cu[8], pv[8], o8[8];
            unpack8(*(const u32x4*)(P + (size_t)tg * NAUG + ccur), cu);
            if (tg > 0) unpack8(*(const u32x4*)(P + (size_t)(tg - 1) * NAUG + cprev), pv);
            else {
#pragma unroll
                for (int i = 0; i < 8; ++i) pv[i] = 0.f;
            }
#pragma unroll
            for (int i = 0; i < 8; ++i) { const float sv = cu[i] + pv[i];
                o8[i] = j0 < 64 ? (1.f - 2.f / (1.f + __expf(2.f * sv))) : (j0 < 128 ? sv : sigmoidf_(sv)); }
            *(LAS u32x4*)(act + t * ACT_LD + j0) = pack8(o8);
        }
        __syncthreads();
        lora_stage<2, 0, 64, 0>(act, (const bf16_t*)(p.ws + WS_W2T), p.in[5], (bf16_t*)(p.ws + WS_LW), t0, w, fr, fq);
        lora_stage<2, 64, 64, 1>(act, (const bf16_t*)(p.ws + WS_A2T), p.in[8], (bf16_t*)(p.ws + WS_A), t0, w, fr, fq);
        lora_stage<5, 128, 160, 2>(act, (const bf16_t*)(p.ws + WS_G2T), nullptr, (bf16_t*)(p.ws + WS_G), t0, w, fr, fq);
    }
}

__device__ __forceinline__ void phase_prepE(const Params& p) {
    const bf16_t* P = (const bf16_t*)(p.ws + WS_PROJ);
    bf16_t* R = (bf16_t*)(p.ws + WS_R); bf16_t* Kk = (bf16_t*)(p.ws + WS_K); bf16_t* V = (bf16_t*)(p.ws + WS_V); bf16_t* KK = (bf16_t*)(p.ws + WS_KK); bf16_t* YC = (bf16_t*)(p.ws + WS_YC);
    const float* mu_rkv = p.in[3]; const float* k_k = p.in[13]; const float* cw = p.in[18];
    const int tid = threadIdx.x, cg = tid & 127, c0 = cg * 8, tgrp = tid >> 7;
    float mr[8], mk[8], mv[8], kkc[8], cw0[8], cw1[8], cw2[8];
#pragma unroll
    for (int i = 0; i < 8; ++i) { mr[i] = mu_rkv[c0 + i]; mk[i] = mu_rkv[1024 + c0 + i]; mv[i] = mu_rkv[2048 + c0 + i]; kkc[i] = k_k[c0 + i]; cw0[i] = cw[c0 + i]; cw1[i] = cw[1024 + c0 + i]; cw2[i] = cw[2048 + c0 + i]; }
    for (int run = blockIdx.x * 4 + tgrp; run < S_ / 16; run += gridDim.x * 4) {
        const int t0 = run * 16;
        float pr[8], pk[8], pv[8], u1[8], u2[8];
#pragma unroll
        for (int i = 0; i < 8; ++i) { pr[i] = 0.f; pk[i] = 0.f; pv[i] = 0.f; u1[i] = 0.f; u2[i] = 0.f; }
        if (t0 > 0) {
            const size_t o = (size_t)(t0 - 1) * NAUG + c0;
            unpack8(*(const u32x4*)(P + o), pr); unpack8(*(const u32x4*)(P + o + 1024), pk); unpack8(*(const u32x4*)(P + o + 2048), pv);
            float x[8], y[8];
            unpack8(*(const u32x4*)(P + o + 4096), x); unpack8(*(const u32x4*)(P + o + 5120), y);
#pragma unroll
            for (int i = 0; i < 8; ++i) u1[i] = x[i] * y[i];
            unpack8(*(const u32x4*)(P + o - NAUG + 4096), x); unpack8(*(const u32x4*)(P + o - NAUG + 5120), y);
#pragma unroll
            for (int i = 0; i < 8; ++i) u2[i] = x[i] * y[i];
        }
        u32x4 nx[6];
        { const size_t o = (size_t)t0 * NAUG + c0;
#pragma unroll
          for (int q = 0; q < 6; ++q) nx[q] = *(const u32x4*)(P + o + 1024 * q); }
#pragma unroll 1
        for (int t = 0; t < 16; ++t) {
            float cr[8], ck[8], cv[8], bg[8], cgt[8], xc[8];
            unpack8(nx[0], cr); unpack8(nx[1], ck); unpack8(nx[2], cv); unpack8(nx[3], bg); unpack8(nx[4], cgt); unpack8(nx[5], xc);
            { const size_t o = (size_t)(t0 + (t < 15 ? t + 1 : t)) * NAUG + c0;
#pragma unroll
              for (int q = 0; q < 6; ++q) nx[q] = *(const u32x4*)(P + o + 1024 * q); }
            float r[8], k[8], v[8], kkv[8], yc[8]; float ss = 0.f;
#pragma unroll
            for (int i = 0; i < 8; ++i) {
                r[i] = cr[i] + (pr[i] - cr[i]) * mr[i]; k[i] = ck[i] + (pk[i] - ck[i]) * mk[i]; v[i] = cv[i] + (pv[i] - cv[i]) * mv[i];
                pr[i] = cr[i]; pk[i] = ck[i]; pv[i] = cv[i];
                kkv[i] = k[i] * kkc[i]; ss += kkv[i] * kkv[i];
                const float u0 = cgt[i] * xc[i];
                yc[i] = bg[i] * (cw0[i] * u2[i] + cw1[i] * u1[i] + cw2[i] * u0);
                u2[i] = u1[i]; u1[i] = u0;
            }
            ss += dpp_f<0xB1, 0xf>(ss); ss += dpp_f<0x4E, 0xf>(ss); ss += dpp_f<0x141, 0xf>(ss);
            const float inv = 1.0f / fmaxf(sqrtf(ss), 1e-12f);
#pragma unroll
            for (int i = 0; i < 8; ++i) kkv[i] *= inv;
            const size_t oo = (size_t)(t0 + t) * DR + c0;
            *(u32x4*)(R + oo) = pack8(r); *(u32x4*)(Kk + oo) = pack8(k); *(u32x4*)(V + oo) = pack8(v); *(u32x4*)(KK + oo) = pack8(kkv); *(u32x4*)(YC + oo) = pack8(yc);
        }
    }
}

#define TILE(i) ((LAS bf16_t*)(lds + (i) * TSLOT))
__device__ __forceinline__ f32x4 mm_tile(f32x4 acc, const LAS bf16_t* A, const LAS bf16_t* Bt, int mi, int ni, int fr, int fq) {
#pragma unroll
    for (int ks = 0; ks < 2; ++ks) {
        const bf16x8 a = *(const LAS bf16x8*)(A + (mi * 16 + fr) * TLD + ks * 32 + fq * 8);
        const bf16x8 b = *(const LAS bf16x8*)(Bt + (ni * 16 + fr) * TLD + ks * 32 + fq * 8);
        acc = __builtin_amdgcn_mfma_f32_16x16x32_bf16(a, b, acc, 0, 0, 0);
    }
    return acc;
}
__device__ __forceinline__ void st_rm(LAS bf16_t* X, f32x4 v, int mi, int ni, int fr, int fq) {
    const unsigned w0 = cvt_pk_bf16(v[0], v[1]), w1 = cvt_pk_bf16(v[2], v[3]);
    LAS bf16_t* q = X + (mi * 16 + fq * 4) * TLD + ni * 16 + fr;
    q[0] = (bf16_t)(w0 & 0xffffu); q[TLD] = (bf16_t)(w0 >> 16); q[2 * TLD] = (bf16_t)(w1 & 0xffffu); q[3 * TLD] = (bf16_t)(w1 >> 16);
}
__device__ __forceinline__ void st_tr(LAS bf16_t* XT, f32x4 v, int mi, int ni, int fr, int fq) {
    u32x2 w; w.x = cvt_pk_bf16(v[0], v[1]); w.y = cvt_pk_bf16(v[2], v[3]);
    *(LAS u32x2*)(XT + (ni * 16 + fr) * TLD + mi * 16 + fq * 4) = w;
}
__device__ __forceinline__ f32x4 ld_rm(const LAS bf16_t* X, int mi, int ni, int fr, int fq) {
    const LAS bf16_t* q = X + (mi * 16 + fq * 4) * TLD + ni * 16 + fr;
    return (f32x4){bf2f(q[0]), bf2f(q[TLD]), bf2f(q[2 * TLD]), bf2f(q[3 * TLD])};
}
__device__ __forceinline__ f32x4 ld_tr(const LAS bf16_t* XT, int mi, int ni, int fr, int fq) {
    const u32x2 w = *(const LAS u32x2*)(XT + (ni * 16 + fr) * TLD + mi * 16 + fq * 4);
    return (f32x4){lo_bf(w.x), hi_bf(w.x), lo_bf(w.y), hi_bf(w.y)};
}

__device__ __forceinline__ void phase_chunkA(const Params& p, LAS unsigned char* lds) {
    const int tid = threadIdx.x, w = tid >> 6, lane = tid & 63, fr = lane & 15, fq = lane >> 4;
    const int mi = w >> 1, nb = (w & 1) * 2;
    LAS float* cl = (LAS float*)(lds + 14 * TSLOT);
    LAS float* gs = (LAS float*)(lds + 16 * TSLOT);
    LAS float* wc = gs + 512;
    const bf16_t* R = (const bf16_t*)(p.ws + WS_R); const bf16_t* Kk = (const bf16_t*)(p.ws + WS_K); const bf16_t* V = (const bf16_t*)(p.ws + WS_V);
    const bf16_t* KK = (const bf16_t*)(p.ws + WS_KK); const bf16_t* A = (const bf16_t*)(p.ws + WS_A); const bf16_t* LW = (const bf16_t*)(p.ws + WS_LW);
    bf16_t* GT = (bf16_t*)(p.ws + WS_GT); float* HT = (float*)(p.ws + WS_HT); bf16_t* QE = (bf16_t*)(p.ws + WS_QE); bf16_t* YL = (bf16_t*)(p.ws + WS_YL);
    const f32x4 z4 = (f32x4){0.f, 0.f, 0.f, 0.f};
    const float* k_a = p.in[14]; const float* r_k = p.in[15]; float* BON = (float*)(p.ws + WS_BON);
    u32x4 nr4, nk4, nv4, nkk4, na4, nlw4;
#define CA_LOAD(it) do { const size_t _go = (size_t)(((it) >> 4) * 64 + (tid >> 3)) * DR + ((it) & 15) * 64 + (tid & 7) * 8; \
        nr4 = *(const u32x4*)(R + _go); nk4 = *(const u32x4*)(Kk + _go); nv4 = *(const u32x4*)(V + _go); nkk4 = *(const u32x4*)(KK + _go); na4 = *(const u32x4*)(A + _go); nlw4 = *(const u32x4*)(LW + _go); } while (0)
    for (int item = blockIdx.x; item < 4096; item += gridDim.x) {
        const int c = item >> 4, h = item & 15;
        const int t = tid >> 3, k0 = (tid & 7) * 8;
        if (item == (int)blockIdx.x) CA_LOAD(item);
        const u32x4 r4 = nr4, k4 = nk4, v4 = nv4, kk4 = nkk4, a4 = na4, lw4 = nlw4;
        __syncthreads();
        {
            float lwf8[8]; unpack8(lw4, lwf8);
            *(LAS f32x4*)(cl + t * 64 + k0) = (f32x4){lwf8[0], lwf8[1], lwf8[2], lwf8[3]};
            *(LAS f32x4*)(cl + t * 64 + k0 + 4) = (f32x4){lwf8[4], lwf8[5], lwf8[6], lwf8[7]};
            __syncthreads();
            const int g = w, k = lane;
            float pfx[8]; float run = 0.f;
#pragma unroll
            for (int i = 0; i < 8; ++i) { run += cl[(g * 8 + i) * 64 + k]; pfx[i] = run; }
            gs[g * 64 + k] = run;
            __syncthreads();
            float off = 0.f;
#pragma unroll
            for (int gg = 0; gg < 7; ++gg) { const float x = gs[gg * 64 + k]; off += (gg < g) ? x : 0.f; }
#pragma unroll
            for (int i = 0; i < 8; ++i) cl[(g * 8 + i) * 64 + k] = off + pfx[i];
            if (g == 7) wc[k] = __expf(off + pfx[7]);
            __syncthreads();
        }
        if (item + (int)gridDim.x < 4096) CA_LOAD(item + (int)gridDim.x);
        {
            float at[8], rt[8], bt[8], kt[8], bh[8], kh[8], vv[8]; float bsum = 0.f;
#pragma unroll
            for (int i = 0; i < 8; ++i) {
                const int q = i >> 1; const bool hi = i & 1;
                const float rf = hi ? hi_bf(r4[q]) : lo_bf(r4[q]), kraw = hi ? hi_bf(k4[q]) : lo_bf(k4[q]), vf = hi ? hi_bf(v4[q]) : lo_bf(v4[q]);
                const float kkf = hi ? hi_bf(kk4[q]) : lo_bf(kk4[q]), af = hi ? hi_bf(a4[q]) : lo_bf(a4[q]), lwf = hi ? hi_bf(lw4[q]) : lo_bf(lw4[q]);
                const float kf = kraw * (1.f + (af - 1.f) * k_a[h * 64 + k0 + i]);
                bsum += rf * kf * r_k[h * 64 + k0 + i];
                const float clv = cl[t * 64 + k0 + i], cle = cl[63 * 64 + k0 + i];
                const float e = __expf(clv), ex = __expf(clv - lwf), ei = __expf(-clv), eh = __expf(cle - clv);
                const float bb = kkf * af;
                at[i] = -kkf * ex; rt[i] = rf * e; bt[i] = bb * ei; kt[i] = kf * ei; bh[i] = bb * eh; kh[i] = kf * eh; vv[i] = vf;
            }
            bsum += dpp_f<0xB1, 0xf>(bsum); bsum += dpp_f<0x4E, 0xf>(bsum); bsum += dpp_f<0x141, 0xf>(bsum);
            if ((tid & 7) == 0) BON[(size_t)(c * 64 + t) * 16 + h] = bsum;
            *(LAS u32x4*)(TILE(0) + t * TLD + k0) = pack8(at);
            *(LAS u32x4*)(TILE(2) + t * TLD + k0) = pack8(rt);
            *(LAS u32x4*)(TILE(3) + t * TLD + k0) = pack8(bt);
            *(LAS u32x4*)(TILE(4) + t * TLD + k0) = pack8(kt);
            const u32x4 atp = pack8(at), bhp = pack8(bh), khp = pack8(kh);
#pragma unroll
            for (int i = 0; i < 8; ++i) {
                const int q = i >> 1; const bool hi = i & 1;
                TILE(1)[(k0 + i) * TLD + t] = (bf16_t)(hi ? (atp[q] >> 16) : (atp[q] & 0xffffu));
                TILE(5)[(k0 + i) * TLD + t] = (bf16_t)(hi ? (bhp[q] >> 16) : (bhp[q] & 0xffffu));
                TILE(6)[(k0 + i) * TLD + t] = (bf16_t)(hi ? (khp[q] >> 16) : (khp[q] & 0xffffu));
                TILE(7)[(k0 + i) * TLD + t] = (bf16_t)(hi ? (v4[q] >> 16) : (v4[q] & 0xffffu));
            }
            __syncthreads();
        }
#pragma unroll
        for (int nn = 0; nn < 2; ++nn) {
            const int ni = nb + nn; const int col = ni * 16 + fr, row0 = mi * 16 + fq * 4;
            f32x4 x = mm_tile(z4, TILE(0), TILE(3), mi, ni, fr, fq);
#pragma unroll
            for (int j = 0; j < 4; ++j) x[j] = (col < row0 + j) ? x[j] : 0.f;
            st_rm(TILE(8), x, mi, ni, fr, fq); st_tr(TILE(9), x, mi, ni, fr, fq);
            x = mm_tile(z4, TILE(0), TILE(4), mi, ni, fr, fq);
#pragma unroll
            for (int j = 0; j < 4; ++j) x[j] = (col < row0 + j) ? x[j] : 0.f;
            st_rm(TILE(10), x, mi, ni, fr, fq);
            x = mm_tile(z4, TILE(2), TILE(3), mi, ni, fr, fq);
#pragma unroll
            for (int j = 0; j < 4; ++j) x[j] = (col <= row0 + j) ? x[j] : 0.f;
            st_rm(TILE(11), x, mi, ni, fr, fq);
            x = mm_tile(z4, TILE(2), TILE(4), mi, ni, fr, fq);
#pragma unroll
            for (int j = 0; j < 4; ++j) x[j] = (col <= row0 + j) ? x[j] : 0.f;
            st_rm(TILE(12), x, mi, ni, fr, fq);
        }
        __syncthreads();
#pragma unroll
        for (int nn = 0; nn < 2; ++nn) {
            const int ni = nb + nn;
            st_tr(TILE(13), mm_tile(z4, TILE(10), TILE(7), mi, ni, fr, fq), mi, ni, fr, fq);
            const f32x4 x = mm_tile(z4, TILE(8), TILE(9), mi, ni, fr, fq);
            st_rm(TILE(0), x, mi, ni, fr, fq); st_tr(TILE(3), x, mi, ni, fr, fq);
        }
        __syncthreads();
#pragma unroll
        for (int rd = 0; rd < 5; ++rd) {
            const int tq = (rd & 1) ? 14 : 8, tqo = (rd & 1) ? 8 : 14;
            const int lx = (rd & 1) ? 4 : 0, lxt = (rd & 1) ? 9 : 3, lxo = (rd & 1) ? 0 : 4, lxto = (rd & 1) ? 3 : 9;
#pragma unroll
            for (int nn = 0; nn < 2; ++nn) {
                const int ni = nb + nn;
                f32x4 x = ld_rm(TILE(tq), mi, ni, fr, fq) + ld_rm(TILE(lx), mi, ni, fr, fq);
                x = mm_tile(x, TILE(tq), TILE(lxt), mi, ni, fr, fq);
                st_rm(TILE(tqo), x, mi, ni, fr, fq);
                if (rd < 4) { const f32x4 y = mm_tile(z4, TILE(lx), TILE(lxt), mi, ni, fr, fq); st_rm(TILE(lxo), y, mi, ni, fr, fq); st_tr(TILE(lxto), y, mi, ni, fr, fq); }
            }
            __syncthreads();
        }
#pragma unroll
        for (int nn = 0; nn < 2; ++nn) {
            const int ni = nb + nn;
            st_tr(TILE(10), mm_tile(ld_tr(TILE(1), mi, ni, fr, fq), TILE(14), TILE(1), mi, ni, fr, fq), mi, ni, fr, fq);
            st_tr(TILE(15), mm_tile(ld_tr(TILE(13), mi, ni, fr, fq), TILE(14), TILE(13), mi, ni, fr, fq), mi, ni, fr, fq);
        }
        __syncthreads();
#pragma unroll
        for (int nn = 0; nn < 2; ++nn) {
            const int ni = nb + nn;
            {
                f32x4 x = mm_tile(z4, TILE(5), TILE(10), mi, ni, fr, fq);
                if (mi == ni) {
#pragma unroll
                    for (int j = 0; j < 4; ++j) x[j] += (fq * 4 + j == fr) ? wc[ni * 16 + fr] : 0.f;
                }
                const unsigned w0 = cvt_pk_bf16(x[0], x[1]), w1 = cvt_pk_bf16(x[2], x[3]);
                bf16_t* gp = GT + (size_t)item * 4096 + (size_t)((mi * 2 + (ni >> 1)) * 64 + (fr >> 2) * 16 + fq * 4) * 8 + (ni & 1) * 4 + (fr & 3);
                gp[0] = (bf16_t)(w0 & 0xffffu); gp[8] = (bf16_t)(w0 >> 16); gp[16] = (bf16_t)(w1 & 0xffffu); gp[24] = (bf16_t)(w1 >> 16);
            }
            {
                f32x4 x = mm_tile(z4, TILE(5), TILE(15), mi, ni, fr, fq);
                x = mm_tile(x, TILE(6), TILE(7), mi, ni, fr, fq);
                *(f32x4*)(HT + (size_t)item * 4096 + (size_t)((ni * 4 + mi) * 64 + lane) * 4) = x;
            }
            {
                f32x4 x = ld_tr(TILE(2), mi, ni, fr, fq);
                x = mm_tile(x, TILE(10), TILE(11), mi, ni, fr, fq);
                u32x2 wv; wv.x = cvt_pk_bf16(x[0], x[1]); wv.y = cvt_pk_bf16(x[2], x[3]);
                *(u32x2*)(QE + (size_t)item * 4096 + (ni * 16 + fr) * 64 + mi * 16 + fq * 4) = wv;
            }
            {
                f32x4 x = mm_tile(z4, TILE(11), TILE(15), mi, ni, fr, fq);
                x = mm_tile(x, TILE(12), TILE(7), mi, ni, fr, fq);
                u32x2 wv; wv.x = cvt_pk_bf16(x[0], x[1]); wv.y = cvt_pk_bf16(x[2], x[3]);
                *(u32x2*)(YL + (size_t)item * 4096 + (size_t)((mi * 4 + ni) * 64 + lane) * 4) = wv;
            }
        }
    }
}

__device__ __forceinline__ void phase_seq(const Params& p) {
    if (threadIdx.x >= 64) return;
    const int head = blockIdx.x >> 2, vt = blockIdx.x & 3, lane = threadIdx.x, fr = lane & 15, fq = lane >> 4;
    const bf16_t* GT = (const bf16_t*)(p.ws + WS_GT); const float* HT = (const float*)(p.ws + WS_HT); bf16_t* S0 = (bf16_t*)(p.ws + WS_S0);
    f32x4 acc[4];
#pragma unroll
    for (int mb = 0; mb < 4; ++mb) acc[mb] = (f32x4){0.f, 0.f, 0.f, 0.f};
    bf16x8 ga[4][4][2]; f32x4 hh[4][4];
#define SEQ_LOAD(buf, cc) do { const size_t _it = (size_t)((cc) < 256 ? (cc) : 255) * 16 + head; \
        _Pragma("unroll") for (int mb = 0; mb < 4; ++mb) { \
            _Pragma("unroll") for (int ks = 0; ks < 2; ++ks) ga[buf][mb][ks] = *(const bf16x8*)(GT + _it * 4096 + (size_t)((mb * 2 + ks) * 64 + lane) * 8); \
            hh[buf][mb] = *(const f32x4*)(HT + _it * 4096 + (size_t)((vt * 4 + mb) * 64 + lane) * 4); } } while (0)
    SEQ_LOAD(0, 0); SEQ_LOAD(1, 1); SEQ_LOAD(2, 2); SEQ_LOAD(3, 3);
    for (int c0 = 0; c0 < 256; c0 += 4) {
#pragma unroll
        for (int b = 0; b < 4; ++b) {
            const int c = c0 + b; const size_t item = (size_t)c * 16 + head;
            u32x2 pk[4];
#pragma unroll
            for (int mb = 0; mb < 4; ++mb) { pk[mb].x = cvt_pk_bf16(acc[mb][0], acc[mb][1]); pk[mb].y = cvt_pk_bf16(acc[mb][2], acc[mb][3]);
                *(u32x2*)(S0 + item * 4096 + (vt * 16 + fr) * 64 + mb * 16 + fq * 4) = pk[mb]; }
            u32x4 b0w, b1w; b0w.x = pk[0].x; b0w.y = pk[0].y; b0w.z = pk[1].x; b0w.w = pk[1].y; b1w.x = pk[2].x; b1w.y = pk[2].y; b1w.z = pk[3].x; b1w.w = pk[3].y;
            const bf16x8 b0 = __builtin_bit_cast(bf16x8, b0w), b1 = __builtin_bit_cast(bf16x8, b1w);
#pragma unroll
            for (int mb = 0; mb < 4; ++mb) {
                const f32x4 x = __builtin_amdgcn_mfma_f32_16x16x32_bf16(ga[b][mb][0], b0, hh[b][mb], 0, 0, 0);
                acc[mb] = __builtin_amdgcn_mfma_f32_16x16x32_bf16(ga[b][mb][1], b1, x, 0, 0, 0);
            }
            SEQ_LOAD(b, c + 4);
        }
    }
#undef SEQ_LOAD
}

__device__ __forceinline__ void phase_chunkY(const Params& p, LAS unsigned char* lds) {
    LAS float* Yb = (LAS float*)lds;
    const int tid = threadIdx.x, w = tid >> 6, lane = tid & 63, fr = lane & 15, fq = lane >> 4;
    const int mi = w >> 1, nb = (w & 1) * 2;
    const bf16_t* R = (const bf16_t*)(p.ws + WS_R); const bf16_t* Kk = (const bf16_t*)(p.ws + WS_K); const bf16_t* V = (const bf16_t*)(p.ws + WS_V);
    const bf16_t* G = (const bf16_t*)(p.ws + WS_G); const bf16_t* YC = (const bf16_t*)(p.ws + WS_YC);
    const bf16_t* QE = (const bf16_t*)(p.ws + WS_QE); const bf16_t* YL = (const bf16_t*)(p.ws + WS_YL); const bf16_t* S0 = (const bf16_t*)(p.ws + WS_S0);
    bf16_t* YM = (bf16_t*)(p.ws + WS_YMIX);
    const float* gn_w = p.in[16]; const float* gn_b = p.in[17];
    u32x2 ywn[2]; bf16x8 an[2], bn[2][2]; bool first = true;
#define CY_LOAD(it) do { const bf16_t* _q = QE + (size_t)(it) * 4096; const bf16_t* _s = S0 + (size_t)(it) * 4096; const bf16_t* _y = YL + (size_t)(it) * 4096; \
        _Pragma("unroll") for (int ks = 0; ks < 2; ++ks) an[ks] = *(const bf16x8*)(_q + (mi * 16 + fr) * 64 + ks * 32 + fq * 8); \
        _Pragma("unroll") for (int nn = 0; nn < 2; ++nn) { ywn[nn] = *(const u32x2*)(_y + (size_t)((mi * 4 + nb + nn) * 64 + lane) * 4); \
            _Pragma("unroll") for (int ks = 0; ks < 2; ++ks) bn[nn][ks] = *(const bf16x8*)(_s + (nb + nn) * 16 * 64 + fr * 64 + ks * 32 + fq * 8); } } while (0)
    for (int item = blockIdx.x; item < 4096; item += gridDim.x) {
        const int c = item >> 4, h = item & 15;
        if (first) { first = false; CY_LOAD(item); }
        __syncthreads();
        const u32x2 ywc[2] = {ywn[0], ywn[1]}; const bf16x8 ac[2] = {an[0], an[1]}; const bf16x8 bc[2][2] = {{bn[0][0], bn[0][1]}, {bn[1][0], bn[1][1]}};
        if (item + (int)gridDim.x < 4096) CY_LOAD(item + (int)gridDim.x);
#pragma unroll
        for (int nn = 0; nn < 2; ++nn) {
            const int ni = nb + nn;
            const u32x2 yw = ywc[nn];
            f32x4 acc = (f32x4){lo_bf(yw.x), hi_bf(yw.x), lo_bf(yw.y), hi_bf(yw.y)};
#pragma unroll
            for (int ks = 0; ks < 2; ++ks) acc = __builtin_amdgcn_mfma_f32_16x16x32_bf16(ac[ks], bc[nn][ks], acc, 0, 0, 0);
#pragma unroll
            for (int j = 0; j < 4; ++j) Yb[(mi * 16 + fq * 4 + j) * 68 + ni * 16 + fr] = acc[j];
        }
        __syncthreads();
        {
            const int t = tid >> 3, k0 = (tid & 7) * 8; const int ch = h * 64 + k0;
            const size_t tg = (size_t)c * 64 + t; const size_t o = tg * DR + ch;
            const float* BON = (const float*)(p.ws + WS_BON);
            const u32x4 v4 = *(const u32x4*)(V + o), g4 = *(const u32x4*)(G + o), yc4 = *(const u32x4*)(YC + o);
            const float bon = BON[tg * 16 + h];
            const float4 gw0 = *(const float4*)(gn_w + ch), gw1 = *(const float4*)(gn_w + ch + 4), gb0 = *(const float4*)(gn_b + ch), gb1 = *(const float4*)(gn_b + ch + 4);
            const float gwv[8] = {gw0.x, gw0.y, gw0.z, gw0.w, gw1.x, gw1.y, gw1.z, gw1.w}, gbv[8] = {gb0.x, gb0.y, gb0.z, gb0.w, gb1.x, gb1.y, gb1.z, gb1.w};
            const f32x4 y0 = *(const LAS f32x4*)(Yb + t * 68 + k0), y1 = *(const LAS f32x4*)(Yb + t * 68 + k0 + 4);
            const float y[8] = {y0[0], y0[1], y0[2], y0[3], y1[0], y1[1], y1[2], y1[3]};
            float sm = 0.f;
#pragma unroll
            for (int i = 0; i < 8; ++i) sm += y[i];
            sm += dpp_f<0xB1, 0xf>(sm); sm += dpp_f<0x4E, 0xf>(sm); sm += dpp_f<0x141, 0xf>(sm);
            const float mean = sm * (1.f / 64.f);
            float vs = 0.f;
#pragma unroll
            for (int i = 0; i < 8; ++i) { const float d = y[i] - mean; vs += d * d; }
            vs += dpp_f<0xB1, 0xf>(vs); vs += dpp_f<0x4E, 0xf>(vs); vs += dpp_f<0x141, 0xf>(vs);
            const float rs = rsqrtf(vs * (1.f / 64.f) + 64e-5f);
            float vf[8], gf[8], of[8];
            unpack8(v4, vf); unpack8(g4, gf);
#pragma unroll
            for (int i = 0; i < 8; ++i) of[i] = ((y[i] - mean) * rs * gwv[i] + gbv[i] + bon * vf[i]) * gf[i];
            *(u32x4*)(YM + tg * D_ + ch) = pack8(of);
            *(u32x4*)(YM + tg * D_ + 1024 + ch) = yc4;
        }
    }
#undef CY_LOAD
}

__device__ __forceinline__ int f2key(float x) { const int u = __float_as_int(x); return u ^ ((u >> 31) & 0x7fffffff); }
__device__ __forceinline__ float key2f(int k) { return __int_as_float(k ^ ((k >> 31) & 0x7fffffff)); }
template <int CTRL> __device__ __forceinline__ int dpp_i(int v) { return __builtin_amdgcn_update_dpp(v, v, CTRL, 0xf, 0xf, false); }
__device__ __forceinline__ int row_max_i(int v) { v = max(v, dpp_i<0xB1>(v)); v = max(v, dpp_i<0x4E>(v)); v = max(v, dpp_i<0x141>(v)); v = max(v, dpp_i<0x140>(v)); return v; }
__device__ __forceinline__ void phase_topk(const Params& p, unsigned char* shm) {
    float* sc = (float*)shm;
    int* tk = (int*)(sc + 64 * 260);
    int* ctab = tk + 2048;
    if (threadIdx.x < 64) { int n = threadIdx.x, v = 256;
        for (int i = 0; i < 16; ++i) { const int cnt = 16 / (i + 1); if (n < cnt) { v = i * 16 + n; break; } n -= cnt; }
        ctab[threadIdx.x] = v; }
    const float* SC = (const float*)(p.ws + WS_Q);
    int* IDS = (int*)(p.ws + WS_IDS); float* GATES = (float*)(p.ws + WS_GATES);
    const int tid = threadIdx.x, w = tid >> 6, lane = tid & 63;
    f32x4 qreg[8];
#define TK_QLOAD(it) do { const int _t0 = ((it) >> 3) * 64; _Pragma("unroll") for (int i = 0; i < 8; ++i) { const int ch = tid + 512 * i; \
        qreg[i] = *(const f32x4*)(SC + (size_t)(_t0 + (ch >> 6)) * 2048 + ((it) & 7) * 256 + (ch & 63) * 4); } } while (0)
    if ((int)blockIdx.x < 2048) TK_QLOAD((int)blockIdx.x);
    for (int item = blockIdx.x; item < 2048; item += gridDim.x) {
        const int t0 = (item >> 3) * 64, h = item & 7;
        __syncthreads();
#pragma unroll
        for (int i = 0; i < 8; ++i) { const int ch = tid + 512 * i; *(f32x4*)(sc + (ch >> 6) * 260 + (ch & 63) * 4) = qreg[i]; }
        __syncthreads();
        if (item + (int)gridDim.x < 2048) TK_QLOAD(item + (int)gridDim.x);
        for (int g = 0; g < 4; ++g) {
            const int L = w * 16 + g * 4 + (lane >> 4); const int tok = L >> 1, cc = L & 1; const int pp = lane & 15;
            int key[8];
#pragma unroll
            for (int i = 0; i < 8; ++i) key[i] = (f2key(sc[tok * 260 + cc * 128 + i * 16 + pp]) & ~127) | (127 - (i * 16 + pp));
#define CE(a, b) do { const int _hi = max(key[a], key[b]), _lo = min(key[a], key[b]); key[a] = _hi; key[b] = _lo; } while (0)
            CE(0, 1); CE(2, 3); CE(4, 5); CE(6, 7);  CE(0, 2); CE(1, 3); CE(4, 6); CE(5, 7);  CE(1, 2); CE(5, 6);
            CE(0, 4); CE(1, 5); CE(2, 6); CE(3, 7);  CE(2, 4); CE(3, 5);  CE(1, 2); CE(3, 4); CE(5, 6);
#undef CE
            int mykey = 0;
#pragma unroll
            for (int r = 0; r < 16; ++r) {
                const int m = row_max_i(key[0]);
                const bool win = (key[0] == m);
#pragma unroll
                for (int i = 0; i < 7; ++i) key[i] = win ? key[i + 1] : key[i];
                key[7] = win ? (int)0x80000000 : key[7];
                mykey = (pp == r) ? m : mykey;
            }
            tk[L * 16 + pp] = mykey;
        }
        __syncthreads();
        for (int g = 0; g < 2; ++g) {
            const int tok = w * 8 + g * 4 + (lane >> 4); const int pp = lane & 15;
            int key[4];
#pragma unroll
            for (int q = 0; q < 4; ++q) {
                const int ij = ctab[q * 16 + pp];
                const float s1 = key2f(tk[(tok * 2) * 16 + ((ij >> 4) & 15)] & ~127), s2 = key2f(tk[(tok * 2 + 1) * 16 + (ij & 15)] & ~127);
                key[q] = (ij < 256) ? ((f2key(s1 + s2) & ~255) | (255 - ij)) : (int)0x80000000;
            }
            int mykey = 0;
#pragma unroll
            for (int r = 0; r < 16; ++r) {
                const int ml = max(max(key[0], key[1]), max(key[2], key[3]));
                const int m = row_max_i(ml);
#pragma unroll
                for (int q = 0; q < 4; ++q) key[q] = (key[q] == m) ? (int)0x80000000 : key[q];
                mykey = (pp == r) ? m : mykey;
            }
            const int ci = 255 - (mykey & 255); const float cs = key2f(mykey & ~255);
            const int e1 = 127 - (tk[(tok * 2) * 16 + (ci >> 4)] & 127), e2 = 127 - (tk[(tok * 2 + 1) * 16 + (ci & 15)] & 127);
            const float mx = __shfl(cs, lane & 48);
            const float e = __expf(cs - mx);
            float sum = e; sum += dpp_f<0xB1, 0xf>(sum); sum += dpp_f<0x4E, 0xf>(sum); sum += dpp_f<0x141, 0xf>(sum); sum += dpp_f<0x140, 0xf>(sum);
            IDS[(size_t)(t0 + tok) * 128 + h * 16 + pp] = (e1 * 128 + e2) & 16383;
            GATES[(size_t)(t0 + tok) * 128 + h * 16 + pp] = e / sum;
        }
    }
#undef TK_QLOAD
}

constexpr float U8_SCALE = 64.f, V8_SCALE = 32.f;
__device__ __forceinline__ float gelu_fast(float x) { const float u = 0.7978845608028654f * (x + 0.044715f * x * x * x); return x / (1.0f + __expf(-2.0f * u)); }
__device__ __forceinline__ void phase_gather(const Params& p, unsigned char* shm) {
    const float* X1 = (const float*)(p.ws + WS_X1); const float* SSQ = (const float*)(p.ws + WS_SSQ);
    const unsigned char* U8 = p.ws + WS_UB; const unsigned char* V8 = p.ws + WS_VB;
    const int* IDS = (const int*)(p.ws + WS_IDS); const float* GATES = (const float*)(p.ws + WS_GATES);
    const float* nf = p.in[25];
    const int tid = threadIdx.x, w = tid >> 6, lane = tid & 63;
    for (int t = blockIdx.x * 8 + w; t < S_; t += gridDim.x * 8) {
        const int id0 = IDS[(size_t)t * 128 + lane], id1 = IDS[(size_t)t * 128 + 64 + lane];
        const float gt0 = GATES[(size_t)t * 128 + lane], gt1 = GATES[(size_t)t * 128 + 64 + lane];
        f32x2 op[16];
#pragma unroll
        for (int q = 0; q < 2; ++q)
#pragma unroll
            for (int i = 0; i < 4; ++i) { const float4 x = *(const float4*)(X1 + (size_t)t * D_ + q * 1024 + lane * 16 + 4 * i);
                op[q * 8 + 2 * i] = (f32x2){x.x, x.y}; op[q * 8 + 2 * i + 1] = (f32x2){x.z, x.w}; }
        f32x2 hp[16];
#pragma unroll
        for (int i = 0; i < 16; ++i) hp[i] = op[i];
        const float rs = rsqrtf(wave_sum_dpp(lane < 32 ? SSQ[(size_t)t * 32 + lane] : 0.f) * (1.0f / 2048.0f) + 1e-6f);
        u32x4 ua[4][2], ub[4][2], vb[4][2];
#define G_LOADU(dst, grp) do { _Pragma("unroll") for (int j = 0; j < 4; ++j) { const int e = (grp) * 4 + j; const int id = __builtin_amdgcn_readlane(e < 64 ? id0 : id1, e & 63); \
            const unsigned char* ur = U8 + (size_t)id * D_ + lane * 16; dst[j][0] = *(const u32x4*)ur; dst[j][1] = *(const u32x4*)(ur + 1024); } } while (0)
#define G_LOADV(grp) do { _Pragma("unroll") for (int j = 0; j < 4; ++j) { const int e = (grp) * 4 + j; const int id = __builtin_amdgcn_readlane(e < 64 ? id0 : id1, e & 63); \
            const unsigned char* vr = V8 + (size_t)id * D_ + lane * 16; vb[j][0] = *(const u32x4*)vr; vb[j][1] = *(const u32x4*)(vr + 1024); } } while (0)
#define G_BODY(cur, nxt, grp) do { \
            G_LOADV(grp); \
            G_LOADU(nxt, ((grp) + 1 < 32 ? (grp) + 1 : 31)); \
            float dsel = 0.f; \
            _Pragma("unroll") for (int j = 0; j < 4; ++j) { f32x2 d2 = (f32x2){0.f, 0.f}; \
                _Pragma("unroll") for (int q = 0; q < 2; ++q) _Pragma("unroll") for (int i = 0; i < 4; ++i) { \
                    d2 += __builtin_amdgcn_cvt_pk_f32_fp8((int)cur[j][q][i], false) * hp[q * 8 + 2 * i]; d2 += __builtin_amdgcn_cvt_pk_f32_fp8((int)cur[j][q][i], true) * hp[q * 8 + 2 * i + 1]; } \
                const float d = wave_sum_dpp(d2.x + d2.y); dsel = (lane == j) ? d : dsel; } \
            const float av = gelu_fast(dsel * (rs * (1.f / U8_SCALE))) * (1.f / V8_SCALE); \
            _Pragma("unroll") for (int j = 0; j < 4; ++j) { const int e = (grp) * 4 + j; \
                const float a = __int_as_float(__builtin_amdgcn_readlane(__float_as_int(av), j)) * __int_as_float(__builtin_amdgcn_readlane(__float_as_int(e < 64 ? gt0 : gt1), e & 63)); \
                const f32x2 a2 = (f32x2){a, a}; \
                _Pragma("unroll") for (int q = 0; q < 2; ++q) _Pragma("unroll") for (int i = 0; i < 4; ++i) { \
                    op[q * 8 + 2 * i] += a2 * __builtin_amdgcn_cvt_pk_f32_fp8((int)vb[j][q][i], false); op[q * 8 + 2 * i + 1] += a2 * __builtin_amdgcn_cvt_pk_f32_fp8((int)vb[j][q][i], true); } } \
        } while (0)
        G_LOADU(ua, 0);
#pragma unroll 1
        for (int g2 = 0; g2 < 32; g2 += 2) { G_BODY(ua, ub, g2); G_BODY(ub, ua, g2 + 1); }
#undef G_LOADU
#undef G_LOADV
#undef G_BODY
        float ss = 0.f; float4 xs[8];
#pragma unroll
        for (int q = 0; q < 2; ++q)
#pragma unroll
            for (int i = 0; i < 4; ++i) { float4 x;
                x.x = op[q * 8 + 2 * i].x; x.y = op[q * 8 + 2 * i].y; x.z = op[q * 8 + 2 * i + 1].x; x.w = op[q * 8 + 2 * i + 1].y;
                ss += x.x * x.x + x.y * x.y + x.z * x.z + x.w * x.w; xs[q * 4 + i] = x; }
        ss = wave_sum_dpp(ss);
        const float scl = rsqrtf(ss * (1.f / 2048.f) + 1e-6f);
#pragma unroll
        for (int q = 0; q < 2; ++q)
#pragma unroll
            for (int i = 0; i < 4; ++i) { const float4 g = *(const float4*)(nf + q * 1024 + lane * 16 + 4 * i); const float4 x = xs[q * 4 + i];
                *(float4*)(p.out + (size_t)t * D_ + q * 1024 + lane * 16 + 4 * i) = make_float4(x.x * scl * g.x, x.y * scl * g.y, x.z * scl * g.z, x.w * scl * g.w); }
    }
}

#define XB_TMO      128
#define XB_XCNT(j)  (256  + 64 * (j))
#define XB_XSUB(j)  (1280 + 64 * (j))
#define XB_XGEN(j)  (2304 + 64 * (j))
#define XB_TOP      3328
#define XB_TOPGEN   3392
#define XCD_BAR_WORDS 3456
#define XB_SPIN_CAP (1u << 18)
__device__ __forceinline__ unsigned xb_ld(unsigned* p)              { return __hip_atomic_load(p, __ATOMIC_RELAXED, __HIP_MEMORY_SCOPE_AGENT); }
__device__ __forceinline__ unsigned xb_add(unsigned* p, unsigned v) { return __hip_atomic_fetch_add(p, v, __ATOMIC_RELAXED, __HIP_MEMORY_SCOPE_AGENT); }
__device__ __forceinline__ unsigned xb_xcc_id() { return (unsigned)__builtin_amdgcn_s_getreg((3 << 11) | 20) & 0xFu; }
#define XB_SPIN(cond, bar) do { unsigned _sp = 0; while (cond) { __builtin_amdgcn_s_sleep(1); \
    if ((++_sp & 255u) == 0u) { if (xb_ld(&(bar)[XB_TMO])) break; if (_sp > XB_SPIN_CAP) { atomicAdd(&(bar)[XB_TMO], 1u); break; } } } } while (0)
struct XcdBarrier { unsigned* bar; unsigned x; volatile LAS unsigned* st; };
__device__ __forceinline__ XcdBarrier xcd_barrier_post(unsigned* bar, volatile LAS unsigned* st) {
    XcdBarrier b; b.bar = bar; b.x = xb_xcc_id(); b.st = st;
    if (threadIdx.x == 0) (void)xb_add(&bar[XB_XCNT(b.x)], 1u);
    return b;
}
__device__ __forceinline__ void xcd_barrier_complete(unsigned* bar, unsigned x, unsigned& nloc, unsigned& nx) {
    const unsigned G = gridDim.x * gridDim.y * gridDim.z;
    unsigned sum, cnt, mine, sp = 0u;
    for (;;) {
        sum = 0u; cnt = 0u; mine = 0u;
#pragma unroll
        for (unsigned j = 0; j < 16; ++j) { const unsigned c = xb_ld(&bar[XB_XCNT(j)]); sum += c; cnt += (c > 0u) ? 1u : 0u; mine = (j == x) ? c : mine; }
        if (sum == G) break;
        __builtin_amdgcn_s_sleep(1);
        if ((++sp & 255u) == 0u) { if (xb_ld(&bar[XB_TMO])) break; if (sp > XB_SPIN_CAP) { atomicAdd(&bar[XB_TMO], 1u); break; } }
    }
    nloc = mine > 0u ? mine : 1u; nx = cnt > 0u ? cnt : 1u;
}
__device__ __forceinline__ void xcd_barrier(const XcdBarrier& b) {
    asm volatile("s_waitcnt vmcnt(0)" ::: "memory");
    __syncthreads();
    if (threadIdx.x == 0) {
        unsigned* bar = b.bar;
        __builtin_amdgcn_s_waitcnt(0);
        unsigned nloc = b.st[0], nx = b.st[1];
        if (nloc == 0u) { xcd_barrier_complete(bar, b.x, nloc, nx); b.st[0] = nloc; b.st[1] = nx; }
        const unsigned old = xb_add(&bar[XB_XSUB(b.x)], 1u);
        const unsigned gen = old / nloc;
        if (old + 1u == (gen + 1u) * nloc) {
            __builtin_amdgcn_fence(__ATOMIC_RELEASE, "agent");
            asm volatile("s_waitcnt vmcnt(0)" ::: "memory");
            const unsigned og = xb_add(&bar[XB_TOP], 1u);
            const unsigned tg = og / nx;
            if (og + 1u == (tg + 1u) * nx) xb_add(&bar[XB_TOPGEN], 1u);
            else XB_SPIN(xb_ld(&bar[XB_TOPGEN]) == tg, bar);
            __builtin_amdgcn_fence(__ATOMIC_ACQUIRE, "agent");
            xb_add(&bar[XB_XGEN(b.x)], 1u);
            asm volatile("s_waitcnt vmcnt(0)" ::: "memory");
        } else {
            XB_SPIN(xb_ld(&bar[XB_XGEN(b.x)]) == gen, bar);
            __builtin_amdgcn_fence(__ATOMIC_ACQUIRE, "agent");
            asm volatile("s_waitcnt vmcnt(0)" ::: "memory");
        }
    }
    __syncthreads();
}

__global__ void __launch_bounds__(512, 2) mega(Params p) {
    extern __shared__ __attribute__((aligned(16))) unsigned char shm[];
    cg::grid_group grid = cg::this_grid();
    LAS unsigned char* lds = (LAS unsigned char*)shm;
    volatile LAS unsigned* bst = (volatile LAS unsigned*)(lds + LDS_BYTES - 16);
    if (threadIdx.x == 0) { bst[0] = 0u; bst[1] = 0u; }
    __syncthreads();
    const XcdBarrier xbar = xcd_barrier_post((unsigned*)(p.ws + WS_BAR), bst);
    if (p.ph_hi > 1000) grid.sync();
    const int lo = p.ph_lo, hi = p.ph_hi;
#define IN(k) (lo <= (k) && (k) < hi)
#define REP(k) for (int _r = 0; _r < ((k) == DUP_PHASE ? 2 : 1); ++_r)
#define SEAM(k) do { if (IN(k) && IN((k) + 1)) xcd_barrier(xbar); } while (0)
    if (IN(0)) REP(0) { if (_r) xcd_barrier(xbar); phase0(p, shm); }
    SEAM(0);
    if (IN(1)) REP(1) { if (_r) xcd_barrier(xbar);
        pg8::Gemm g{(const bf16_t*)(p.ws + WS_H), (const bf16_t*)(p.ws + WS_WB1), S_, NAUG, 2048};
        pg8::StaticOrder so; so.init(g.M, g.N, (int)gridDim.x, (int)blockIdx.x);
        pg8::EpiBf16 E{(bf16_t*)(p.ws + WS_PROJ), NAUG};
        pg8::gemm_phase(lds, g, so, E);
    }
    SEAM(1);
    if (IN(2)) REP(2) { if (_r) xcd_barrier(xbar);
        phase_prepM(p, lds);
        phase_prepE(p);
    }
    SEAM(2);
    if (IN(3)) REP(3) { if (_r) xcd_barrier(xbar); phase_chunkA(p, lds); }
    SEAM(3);
    if (IN(4)) REP(4) { if (_r) xcd_barrier(xbar); if (blockIdx.x < 64) phase_seq(p);
        else { const int bid = blockIdx.x - 64, nblk = gridDim.x - 64;
            convert_fp8(p.in[23], p.ws + WS_UB, (size_t)16384 * 2048, U8_SCALE, p.in[20], bid, nblk);
            convert_fp8(p.in[24], p.ws + WS_VB, (size_t)16384 * 2048, V8_SCALE, nullptr, bid, nblk);
            build_wpt(p.in[21], p.in[20], (const bf16_t*)(p.ws + WS_KEYB), (bf16_t*)(p.ws + WS_WQT), bid, nblk);
            transpose_convert(p.in[19], 2048, 2048, (bf16_t*)(p.ws + WS_WOT), (float*)shm, bid, nblk); } }
    SEAM(4);
    if (IN(5)) REP(5) { if (_r) xcd_barrier(xbar); phase_chunkY(p, lds); }
    SEAM(5);
    if (IN(6)) REP(6) { if (_r) xcd_barrier(xbar);
        pg8::Gemm g{(const bf16_t*)(p.ws + WS_YMIX), (const bf16_t*)(p.ws + WS_WOT), S_, 2048, 2048};
        pg8::StaticOrder so; so.init(g.M, g.N, (int)gridDim.x, (int)blockIdx.x);
        pg8::EpiRes2 E{(float*)(p.ws + WS_X1), p.in[0], (bf16_t*)(p.ws + WS_H2), (float*)(p.ws + WS_SSQ), 2048};
        pg8::gemm_phase(lds, g, so, E);
    }
    SEAM(6);
    if (IN(8)) REP(8) { if (_r) xcd_barrier(xbar);
        pg8::Gemm g{(const bf16_t*)(p.ws + WS_H2), (const bf16_t*)(p.ws + WS_WQT), S_, 2048, 2048};
        pg8::StaticOrder so; so.init(g.M, g.N, (int)gridDim.x, (int)blockIdx.x);
        pg8::EpiRowScaleF32 E{(float*)(p.ws + WS_Q), (const float*)(p.ws + WS_SSQ), 2048};
        pg8::gemm_phase(lds, g, so, E);
    }
    SEAM(8);
    if (IN(9)) REP(9) { if (_r) xcd_barrier(xbar); phase_topk(p, shm); }
    SEAM(9);
    if (IN(10)) REP(10) { if (_r) xcd_barrier(xbar); phase_gather(p, shm); }
#undef IN
#undef REP
#undef SEAM
}

extern "C" void kernel_launch(void* const* d_in, const int* in_sizes, int n_in, void* d_out, int out_size, void* d_ws, size_t ws_size, hipStream_t stream) {
    static int grid_blocks = 0;
    if (grid_blocks == 0) {
        if (n_in != 26 || ws_size < WS_NEED) { fprintf(stderr, "kernel_launch: unexpected n_in %d / ws_size %zu\n", n_in, ws_size); grid_blocks = -1; return; }
        int dev = 0, cus = 0, per_cu = 0;
        (void)hipGetDevice(&dev);
        (void)hipDeviceGetAttribute(&cus, hipDeviceAttributeMultiprocessorCount, dev);
        (void)hipFuncSetAttribute((const void*)mega, hipFuncAttributeMaxDynamicSharedMemorySize, LDS_BYTES);
        (void)hipOccupancyMaxActiveBlocksPerMultiprocessor(&per_cu, (const void*)mega, 512, LDS_BYTES);
        if (per_cu < 1) { fprintf(stderr, "kernel_launch: occupancy query says %d blocks/CU\n", per_cu); per_cu = 1; }
        grid_blocks = cus * per_cu;
        fprintf(stderr, "kernel_launch: cus %d per_cu %d grid %d\n", cus, per_cu, grid_blocks);
    }
    if (grid_blocks < 0) return;
    Params p{};
    for (int i = 0; i < 26; ++i) p.in[i] = (const float*)d_in[i];
    p.out = (float*)d_out; p.ws = (unsigned char*)d_ws;
#if MULTI_LAUNCH
    for (int ph = 0; ph < NPHASE; ++ph) {
        p.ph_lo = ph; p.ph_hi = ph + 1;
        hipLaunchKernelGGL(mega, dim3(grid_blocks), dim3(512), LDS_BYTES, stream, p);
    }
#else
    p.ph_lo = 0; p.ph_hi = NPHASE;
    if (hipMemsetAsync((unsigned char*)d_ws + WS_BAR, 0, XCD_BAR_WORDS * 4, stream) != hipSuccess) fprintf(stderr, "kernel_launch: barrier memset failed\n");
    void* args[] = {&p};
    hipError_t e = hipLaunchCooperativeKernel((const void*)mega, dim3(grid_blocks), dim3(512), args, LDS_BYTES, stream);
    if (e != hipSuccess) fprintf(stderr, "cooperative launch failed: %s (grid %d)\n", hipGetErrorString(e), grid_blocks);
#endif
}
```

```cpp
#include <hip/hip_runtime.h>
#include <hip/hip_cooperative_groups.h>
#include <cstdio>
namespace cg = cooperative_groups;

#ifndef DUP_PHASE
#define DUP_PHASE -1
#endif
#ifndef MULTI_LAUNCH
#define MULTI_LAUNCH 0
#endif

#define LAS __attribute__((address_space(3)))
typedef unsigned short bf16_t;
typedef short bf16x8 __attribute__((ext_vector_type(8)));
typedef float f32x4 __attribute__((ext_vector_type(4)));
typedef float f32x2 __attribute__((ext_vector_type(2)));
typedef unsigned u32x4 __attribute__((ext_vector_type(4)));
typedef unsigned u32x2 __attribute__((ext_vector_type(2)));

constexpr int S_ = 16384, D_ = 2048, DR = 1024, NAUG = 6912;
constexpr size_t MiB = 1ull << 20;
constexpr size_t WS_PROJ = 0, WS_H = 216 * MiB, WS_WB1 = 280 * MiB, WS_WQT = 280 * MiB, WS_WOT = 296 * MiB;
constexpr size_t WS_R = 307 * MiB, WS_K = 339 * MiB, WS_V = 371 * MiB, WS_KK = 403 * MiB, WS_A = 435 * MiB, WS_LW = 467 * MiB;
constexpr size_t WS_G = 216 * MiB, WS_YC = 248 * MiB, WS_YMIX = 307 * MiB, WS_X1 = 0, WS_H2 = 128 * MiB, WS_Q = 307 * MiB;
constexpr size_t WS_GT = 0, WS_HT = 32 * MiB, WS_QE = 96 * MiB, WS_YL = 128 * MiB, WS_S0 = 160 * MiB;
constexpr size_t WS_IDS = 192 * MiB, WS_GATES = 200 * MiB, WS_UB = 467 * MiB, WS_VB = 435 * MiB, WS_BON = 500 * MiB, WS_BAR = 502 * MiB, WS_KEYB = 503 * MiB, WS_SSQ = 504 * MiB, WS_NEED = 506 * MiB;
constexpr size_t WS_W2T = 499 * MiB, WS_A2T = WS_W2T + 131072, WS_G2T = WS_A2T + 131072;
constexpr int TLD = 72, TSLOT = 64 * TLD * 2;
constexpr int LDS_BYTES = 16 * TSLOT + 2048 + 256 + 16;
constexpr int NPHASE = 11;

struct Params {
    const float* in[26];
    float* out;
    unsigned char* ws;
    int ph_lo, ph_hi;
};

__device__ __forceinline__ float bf2f(bf16_t b) { return __uint_as_float(((unsigned)b) << 16); }
__device__ __forceinline__ bf16_t f2bf(float f) { unsigned u = __float_as_uint(f); u += 0x7FFFu + ((u >> 16) & 1u); return (bf16_t)(u >> 16); }
typedef __bf16 bf16v2_t __attribute__((ext_vector_type(2)));
__device__ __forceinline__ unsigned cvt_pk_bf16(float lo, float hi) { const f32x2 v = {lo, hi}; const bf16v2_t r = __builtin_convertvector(v, bf16v2_t); return __builtin_bit_cast(unsigned, r); }
__device__ __forceinline__ u32x4 pack8(const float* f) { u32x4 w; w.x = cvt_pk_bf16(f[0], f[1]); w.y = cvt_pk_bf16(f[2], f[3]); w.z = cvt_pk_bf16(f[4], f[5]); w.w = cvt_pk_bf16(f[6], f[7]); return w; }
__device__ __forceinline__ float lo_bf(unsigned w) { return __uint_as_float(w << 16); }
__device__ __forceinline__ float hi_bf(unsigned w) { return __uint_as_float(w & 0xffff0000u); }
__device__ __forceinline__ void unpack8(const u32x4 v, float* f) {
#pragma unroll
    for (int i = 0; i < 4; ++i) { f[2 * i] = lo_bf(v[i]); f[2 * i + 1] = hi_bf(v[i]); }
}
__device__ __forceinline__ float wave_sum(float v) {
#pragma unroll
    for (int o = 32; o; o >>= 1) v += __shfl_xor(v, o);
    return v;
}
template <int CTRL, int RM> __device__ __forceinline__ float dpp_f(float v) { return __int_as_float(__builtin_amdgcn_update_dpp(0, __float_as_int(v), CTRL, RM, 0xf, false)); }
__device__ __forceinline__ float wave_sum_dpp(float v) {
    v += dpp_f<0xB1, 0xf>(v); v += dpp_f<0x4E, 0xf>(v); v += dpp_f<0x141, 0xf>(v); v += dpp_f<0x140, 0xf>(v);
    v += dpp_f<0x142, 0xa>(v); v += dpp_f<0x143, 0xc>(v);
    return __int_as_float(__builtin_amdgcn_readlane(__float_as_int(v), 63));
}
__device__ __forceinline__ float wave_max(float v) {
#pragma unroll
    for (int o = 32; o; o >>= 1) v = fmaxf(v, __shfl_xor(v, o));
    return v;
}
__device__ __forceinline__ float sigmoidf_(float x) { return 1.0f / (1.0f + __expf(-x)); }
__device__ __forceinline__ float gelu_tanh(float x) { float u = 0.7978845608028654f * (x + 0.044715f * x * x * x); return 0.5f * x * (1.0f + tanhf(u)); }

namespace pg8 {
constexpr int BM = 256, BK = 64, HALF = 128, HTB = HALF * BK * 2, STAGE_BYTES = 8 * HTB, NXCD = 8, WGM = 8;
__device__ __forceinline__ int lds_byte(int r, int c) { const int st = (r >> 4) * 2 + (c >> 5), rr = r & 15, cc = c & 31, ob = rr * 64 + cc * 2; return st * 1024 + (ob ^ (((ob >> 9) & 1) << 5)); }
__device__ __forceinline__ void stage_rc(int b, int& R, int& C) { const int st = b / 1024, sb = b % 1024, swz = sb ^ (((sb >> 9) & 1) << 5); R = (st >> 1) * 16 + swz / 64; C = (st & 1) * 32 + (swz % 64) / 2; }
__device__ __forceinline__ int perm32(int rho) { const int n = rho >> 4, i = rho & 15; return 8 * (i >> 2) + 4 * n + (i & 3); }
struct Unit { int pm, pn; };
struct Gemm { const bf16_t* A; const bf16_t* Bt; int M, N, K; };
struct StaticOrder {
    int nM, nN, nwg, G, c;
    __device__ void init(int M, int N, int G_, int c_) { nM = M / BM; nN = N / BM; nwg = nM * nN; G = G_; c = c_; }
    __device__ bool next(int i, Unit& u) const {
        const long L = (long)i * G + c; if (L >= nwg) return false;
        int wgid = (int)L; { const int q = nwg / NXCD, r = nwg % NXCD, xcd = wgid % NXCD, off = wgid / NXCD; wgid = (xcd < r ? xcd * (q + 1) : r * (q + 1) + (xcd - r) * q) + off; }
        const int nig = WGM * nN, gid = wgid / nig, fm = gid * WGM, gsz = (nM - fm) < WGM ? (nM - fm) : WGM;
        u.pm = fm + ((wgid % nig) % gsz); u.pn = (wgid % nig) / gsz; return true;
    }
    __device__ __forceinline__ void a_ready(const Unit&) const {}
    __device__ __forceinline__ void done(const Unit&) const {}
};
struct EpiResF32 {
    static constexpr bool PERM = false;
    float* C; const float* Res; int ldc;
    __device__ __forceinline__ void operator()(const f32x4 (&acc)[2][2][4][2], const Unit& u, int wr, int wc, int fr, int fq) const {
        const int row0 = u.pm * BM + wr * 64 + fr, col0 = u.pn * BM + wc * 32 + 4 * fq;
#pragma unroll
        for (int ai = 0; ai < 2; ++ai)
#pragma unroll
            for (int m = 0; m < 4; ++m) { const size_t ro = (size_t)(row0 + ai * HALF + m * 16) * ldc + col0;
#pragma unroll
                for (int bj = 0; bj < 2; ++bj)
#pragma unroll
                    for (int n = 0; n < 2; ++n) { const f32x4 rs = *(const f32x4*)(Res + ro + bj * HALF + n * 16); *(f32x4*)(C + ro + bj * HALF + n * 16) = acc[ai][bj][m][n] + rs; } }
    }
};
struct EpiRes2 {
    static constexpr bool PERM = false;
    float* C; const float* Res; bf16_t* Cb; float* SSQ; int ldc;
    __device__ __forceinline__ void operator()(const f32x4 (&acc)[2][2][4][2], const Unit& u, int wr, int wc, int fr, int fq) const {
        const int row0 = u.pm * BM + wr * 64 + fr, col0 = u.pn * BM + wc * 32 + 4 * fq;
#pragma unroll
        for (int ai = 0; ai < 2; ++ai)
#pragma unroll
            for (int m = 0; m < 4; ++m) { const int row = row0 + ai * HALF + m * 16; const size_t ro = (size_t)row * ldc + col0; float ss = 0.f;
#pragma unroll
                for (int bj = 0; bj < 2; ++bj)
#pragma unroll
                    for (int n = 0; n < 2; ++n) { const f32x4 v = acc[ai][bj][m][n] + *(const f32x4*)(Res + ro + bj * HALF + n * 16);
                        *(f32x4*)(C + ro + bj * HALF + n * 16) = v;
                        u32x2 wv; wv.x = cvt_pk_bf16(v[0], v[1]); wv.y = cvt_pk_bf16(v[2], v[3]); *(u32x2*)(Cb + ro + bj * HALF + n * 16) = wv;
                        ss += v[0] * v[0] + v[1] * v[1] + v[2] * v[2] + v[3] * v[3]; }
                ss += __shfl_xor(ss, 16); ss += __shfl_xor(ss, 32);
                if (fq == 0) SSQ[(size_t)row * 32 + u.pn * 4 + wc] = ss; }
    }
};
struct EpiRowScaleF32 {
    static constexpr bool PERM = false;
    float* C; const float* SSQ; int ldc;
    __device__ __forceinline__ void operator()(const f32x4 (&acc)[2][2][4][2], const Unit& u, int wr, int wc, int fr, int fq) const {
        const int row0 = u.pm * BM + wr * 64 + fr, col0 = u.pn * BM + wc * 32 + 4 * fq;
#pragma unroll
        for (int ai = 0; ai < 2; ++ai)
#pragma unroll
            for (int m = 0; m < 4; ++m) { const int row = row0 + ai * HALF + m * 16; const size_t ro = (size_t)row * ldc + col0;
                const f32x4* sp = (const f32x4*)(SSQ + (size_t)row * 32); float sq = 0.f;
#pragma unroll
                for (int q = 0; q < 8; ++q) { const f32x4 v = sp[q]; sq += (v[0] + v[1]) + (v[2] + v[3]); }
                const float rs = rsqrtf(sq * (1.0f / 2048.0f) + 1e-6f);
#pragma unroll
                for (int bj = 0; bj < 2; ++bj)
#pragma unroll
                    for (int n = 0; n < 2; ++n) *(f32x4*)(C + ro + bj * HALF + n * 16) = acc[ai][bj][m][n] * rs; }
    }
};
struct EpiF32 {
    static constexpr bool PERM = false;
    float* C; int ldc;
    __device__ __forceinline__ void operator()(const f32x4 (&acc)[2][2][4][2], const Unit& u, int wr, int wc, int fr, int fq) const {
        const int row0 = u.pm * BM + wr * 64 + fr, col0 = u.pn * BM + wc * 32 + 4 * fq;
#pragma unroll
        for (int ai = 0; ai < 2; ++ai)
#pragma unroll
            for (int m = 0; m < 4; ++m) { const size_t ro = (size_t)(row0 + ai * HALF + m * 16) * ldc + col0;
#pragma unroll
                for (int bj = 0; bj < 2; ++bj)
#pragma unroll
                    for (int n = 0; n < 2; ++n) *(f32x4*)(C + ro + bj * HALF + n * 16) = acc[ai][bj][m][n]; }
    }
};
struct EpiBf16 {
    static constexpr bool PERM = true;
    bf16_t* O; int ldc;
    __device__ __forceinline__ void operator()(const f32x4 (&acc)[2][2][4][2], const Unit& u, int wr, int wc, int fr, int fq) const {
        const int row0 = u.pm * BM + wr * 64 + fr; const int col0 = u.pn * BM + wc * 32 + 8 * fq;
#pragma unroll
        for (int ai = 0; ai < 2; ++ai)
#pragma unroll
            for (int m = 0; m < 4; ++m) { bf16_t* rowp = O + (size_t)(row0 + ai * HALF + m * 16) * ldc + col0;
#pragma unroll
                for (int bj = 0; bj < 2; ++bj) { const f32x4 v0 = acc[ai][bj][m][0], v1 = acc[ai][bj][m][1];
                    u32x4 w; w.x = cvt_pk_bf16(v0[0], v0[1]); w.y = cvt_pk_bf16(v0[2], v0[3]); w.z = cvt_pk_bf16(v1[0], v1[1]); w.w = cvt_pk_bf16(v1[2], v1[3]);
                    *(u32x4*)(rowp + bj * HALF) = w; } }
    }
};

template <class Epi, class Sched>
__device__ __forceinline__ void gemm_phase(LAS unsigned char* lds, const Gemm g, const Sched& S, const Epi& E) {
    const int tid = threadIdx.x, wid = __builtin_amdgcn_readfirstlane(tid >> 6), lane = tid & 63, wr = wid >> 2, wc = wid & 3, fr = lane & 15, fq = lane >> 4;
    const int K = g.K, nt = K / BK;
    unsigned voffA[2], voffB[2];
#pragma unroll
    for (int i = 0; i < 2; ++i) { int R, C; stage_rc(tid * 16 + i * 8192, R, C); const int Rb = Epi::PERM ? ((R & ~31) + perm32(R & 31)) : R;
        voffA[i] = (unsigned)(R * K + C) * 2u; voffB[i] = (unsigned)(Rb * K + C) * 2u; }
    const size_t kstep = (size_t)(BK * 2);
    const size_t hstep = (size_t)HALF * K * 2;
    const size_t tstep = 2 * hstep;
    const unsigned ldsw = (unsigned)wid * 1024u;
    const int aoff = lds_byte(wr * 64 + fr, fq * 8), boff = lds_byte(wc * 32 + fr, fq * 8);
#define PG8_SA(b, h) (((b) * 2 + (h)) * HTB)
#define PG8_SB(b, h) ((4 + (b) * 2 + (h)) * HTB)
#define PG8_STAGE(bufoff, gbase, voff) do { _Pragma("unroll") for (int _i = 0; _i < 2; ++_i) \
        __builtin_amdgcn_global_load_lds((const unsigned*)((const char*)(gbase) + (voff)[_i]), (LAS unsigned*)(lds + (bufoff) + ldsw + _i * 8192), 16, 0, 0); } while (0)
#define PG8_LDA(dst, b, h) do { _Pragma("unroll") for (int m = 0; m < 4; ++m) _Pragma("unroll") for (int k = 0; k < 2; ++k) dst[m][k] = *(const LAS bf16x8*)(lds + PG8_SA(b, h) + aoff + m * 2048 + k * 1024); } while (0)
#define PG8_LDB(dst, b, h) do { _Pragma("unroll") for (int n = 0; n < 2; ++n) _Pragma("unroll") for (int k = 0; k < 2; ++k) dst[n][k] = *(const LAS bf16x8*)(lds + PG8_SB(b, h) + boff + n * 2048 + k * 1024); } while (0)
#define PG8_MMA(ai, bj, At, Bt) do { __builtin_amdgcn_s_setprio(1); _Pragma("unroll") for (int m = 0; m < 4; ++m) _Pragma("unroll") for (int n = 0; n < 2; ++n) _Pragma("unroll") for (int k = 0; k < 2; ++k) \
        acc[ai][bj][m][n] = __builtin_amdgcn_mfma_f32_16x16x32_bf16(Bt[n][k], At[m][k], acc[ai][bj][m][n], 0, 0, 0); __builtin_amdgcn_s_setprio(0); } while (0)
#define PG8_WAIT_V(n) asm volatile("s_waitcnt vmcnt(" #n ")" ::: "memory")
#define PG8_WAIT_L(n) asm volatile("s_waitcnt lgkmcnt(" #n ")" ::: "memory")
#define PG8_BAR __builtin_amdgcn_s_barrier()
#define PG8_SCHED __builtin_amdgcn_sched_barrier(0)
    Unit cur, nxt; int ui = 0;
    if (!S.next(0, cur)) return;
    f32x4 acc[2][2][4][2];
#pragma unroll
    for (int a = 0; a < 2; ++a)
#pragma unroll
        for (int b = 0; b < 2; ++b)
#pragma unroll
            for (int m = 0; m < 4; ++m)
#pragma unroll
                for (int n = 0; n < 2; ++n) acc[a][b][m][n] = (f32x4){0.f, 0.f, 0.f, 0.f};
    bf16x8 At[4][2], B0[2][2], B1[2][2];
    const char* cA = (const char*)g.A + (size_t)cur.pm * tstep; const char* cB = (const char*)g.Bt + (size_t)cur.pn * tstep;
    S.a_ready(cur);
    PG8_STAGE(PG8_SB(0, 0), cB, voffB); PG8_STAGE(PG8_SA(0, 0), cA, voffA); PG8_STAGE(PG8_SB(0, 1), cB + hstep, voffB); PG8_STAGE(PG8_SA(0, 1), cA + hstep, voffA);
    if (wr == 1) PG8_BAR;
    PG8_WAIT_V(4); PG8_BAR;
    PG8_STAGE(PG8_SB(1, 0), cB + kstep, voffB); PG8_STAGE(PG8_SA(1, 0), cA + kstep, voffA); PG8_STAGE(PG8_SB(1, 1), cB + hstep + kstep, voffB);
    PG8_WAIT_V(6); PG8_BAR;
    for (;;) {
        const bool has_next = S.next(ui + 1, nxt);
        const char* nA = has_next ? (const char*)g.A + (size_t)nxt.pm * tstep : cA; const char* nB = has_next ? (const char*)g.Bt + (size_t)nxt.pn * tstep : cB;
        for (int t = 0; t < nt; t += 2) {
            const bool last = (t == nt - 2);
            const char* a1 = cA + (size_t)(t + 1) * kstep;
            const char* a2 = last ? nA : cA + (size_t)(t + 2) * kstep; const char* b2 = last ? nB : cB + (size_t)(t + 2) * kstep;
            const char* a3 = a2 + kstep; const char* b3 = b2 + kstep;
            if (last && has_next) S.a_ready(nxt);
            PG8_LDB(B0, 0, 0); PG8_SCHED; PG8_LDA(At, 0, 0); PG8_STAGE(PG8_SA(1, 1), a1 + hstep, voffA);
            PG8_WAIT_L(8); PG8_BAR; PG8_WAIT_L(0); PG8_MMA(0, 0, At, B0); PG8_BAR; PG8_SCHED;
            PG8_LDB(B1, 0, 1); PG8_STAGE(PG8_SB(0, 0), b2, voffB);
            PG8_BAR; PG8_WAIT_L(0); PG8_MMA(0, 1, At, B1); PG8_BAR;
            PG8_LDA(At, 0, 1); PG8_STAGE(PG8_SA(0, 0), a2, voffA);
            PG8_BAR; PG8_WAIT_L(0); PG8_MMA(1, 0, At, B0); PG8_BAR; PG8_SCHED;
            PG8_STAGE(PG8_SB(0, 1), b2 + hstep, voffB);
            PG8_WAIT_V(6); PG8_BAR; PG8_MMA(1, 1, At, B1); PG8_BAR;
            PG8_LDB(B0, 1, 0); PG8_SCHED; PG8_LDA(At, 1, 0); PG8_STAGE(PG8_SA(0, 1), a2 + hstep, voffA);
            PG8_WAIT_L(8); PG8_BAR; PG8_WAIT_L(0); PG8_MMA(0, 0, At, B0); PG8_BAR; PG8_SCHED;
            PG8_LDB(B1, 1, 1); PG8_STAGE(PG8_SB(1, 0), b3, voffB);
            PG8_BAR; PG8_WAIT_L(0); PG8_MMA(0, 1, At, B1); PG8_BAR;
            PG8_LDA(At, 1, 1); PG8_STAGE(PG8_SA(1, 0), a3, voffA);
            PG8_BAR; PG8_WAIT_L(0); PG8_MMA(1, 0, At, B0); PG8_BAR; PG8_SCHED;
            PG8_STAGE(PG8_SB(1, 1), b3 + hstep, voffB);
            PG8_WAIT_V(6); PG8_BAR; PG8_MMA(1, 1, At, B1); PG8_BAR;
        }
        E(acc, cur, wr, wc, fr, fq); S.done(cur);
        if (!has_next) break;
#pragma unroll
        for (int a = 0; a < 2; ++a)
#pragma unroll
            for (int b = 0; b < 2; ++b)
#pragma unroll
                for (int m = 0; m < 4; ++m)
#pragma unroll
                    for (int n = 0; n < 2; ++n) acc[a][b][m][n] = (f32x4){0.f, 0.f, 0.f, 0.f};
        cur = nxt; cA = nA; cB = nB; ++ui;
    }
    PG8_WAIT_V(0);
    if (wr == 0) PG8_BAR;
    PG8_BAR;
#undef PG8_SA
#undef PG8_SB
#undef PG8_STAGE
#undef PG8_LDA
#undef PG8_LDB
#undef PG8_MMA
#undef PG8_WAIT_V
#undef PG8_WAIT_L
#undef PG8_BAR
#undef PG8_SCHED
}
}

__device__ __forceinline__ void rmsnorm_rows(const float* X, const float* gain, bf16_t* H) {
    const int wave = threadIdx.x >> 6, lane = threadIdx.x & 63;
    for (int row = blockIdx.x * 8 + wave; row < S_; row += gridDim.x * 8) {
        const float4* xr = (const float4*)(X + (size_t)row * D_);
        float4 v[8]; float ss = 0.f;
#pragma unroll
        for (int i = 0; i < 8; ++i) { v[i] = xr[i * 64 + lane]; ss += v[i].x * v[i].x + v[i].y * v[i].y + v[i].z * v[i].z + v[i].w * v[i].w; }
        ss = wave_sum(ss);
        const float sc = rsqrtf(ss * (1.0f / 2048.0f) + 1e-6f);
#pragma unroll
        for (int i = 0; i < 8; ++i) { const float4 g = ((const float4*)gain)[i * 64 + lane];
            u32x2 w; w.x = cvt_pk_bf16(v[i].x * sc * g.x, v[i].y * sc * g.y); w.y = cvt_pk_bf16(v[i].z * sc * g.z, v[i].w * sc * g.w);
            *(u32x2*)(H + (size_t)row * D_ + (i * 64 + lane) * 4) = w; }
    }
}

__device__ __forceinline__ void transpose_convert(const float* W, int K, int N, bf16_t* Bt, float* tile, int bid, int nblk) {
    const int tid = threadIdx.x; const int tk = K / 64, tn = N / 64, nt = tk * tn;
    float4 rg[2];
#define TC_LOAD(u) do { const int _k0 = ((u) / tn) * 64, _n0 = ((u) % tn) * 64; _Pragma("unroll") for (int i = 0; i < 2; ++i) { const int idx = tid + 512 * i; \
        rg[i] = *(const float4*)(W + (size_t)(_k0 + (idx >> 4)) * N + _n0 + (idx & 15) * 4); } } while (0)
    if (bid < nt) TC_LOAD(bid);
    for (int u = bid; u < nt; u += nblk) {
        const int k0 = (u / tn) * 64, n0 = (u % tn) * 64;
        __syncthreads();
#pragma unroll
        for (int i = 0; i < 2; ++i) { const int idx = tid + 512 * i; float* q = tile + (idx >> 4) * 65 + (idx & 15) * 4; q[0] = rg[i].x; q[1] = rg[i].y; q[2] = rg[i].z; q[3] = rg[i].w; }
        __syncthreads();
        if (u + nblk < nt) TC_LOAD(u + nblk);
#pragma unroll
        for (int i = 0; i < 4; ++i) { const int nn = i * 16 + (tid >> 5), kp = (tid & 31) * 2;
            *(unsigned*)(Bt + (size_t)(n0 + nn) * K + k0 + kp) = cvt_pk_bf16(tile[kp * 65 + nn], tile[(kp + 1) * 65 + nn]); }
    }
#undef TC_LOAD
}

__device__ __forceinline__ void convert_flat(const float* src, bf16_t* dst, size_t n) {
    for (size_t i = ((size_t)blockIdx.x * 512 + threadIdx.x) * 8; i < n; i += (size_t)gridDim.x * 512 * 8) {
        const float4 a = *(const float4*)(src + i), b = *(const float4*)(src + i + 4);
        u32x4 w; w.x = cvt_pk_bf16(a.x, a.y); w.y = cvt_pk_bf16(a.z, a.w); w.z = cvt_pk_bf16(b.x, b.y); w.w = cvt_pk_bf16(b.z, b.w);
        *(u32x4*)(dst + i) = w;
    }
}

__device__ __forceinline__ void convert_fp8(const float* src, unsigned char* dst, size_t n, float sc, const float* colgain, int bid, int nblk) {
    const int lane = threadIdx.x & 63, wv = threadIdx.x >> 6;
    for (size_t base = ((size_t)bid * 8 + wv) * 1024; base < n; base += (size_t)nblk * 8 * 1024) {
        float4 a[4];
#pragma unroll
        for (int j = 0; j < 4; ++j) a[j] = *(const float4*)(src + base + (size_t)(j * 64 + lane) * 4);
#pragma unroll
        for (int j = 0; j < 4; ++j) { float4 gg = make_float4(sc, sc, sc, sc);
            if (colgain) { const float4 cgv = *(const float4*)(colgain + ((base + (size_t)(j * 64 + lane) * 4) & 2047)); gg.x *= cgv.x; gg.y *= cgv.y; gg.z *= cgv.z; gg.w *= cgv.w; }
            int x = __builtin_amdgcn_cvt_pk_fp8_f32(a[j].x * gg.x, a[j].y * gg.y, 0, false); x = __builtin_amdgcn_cvt_pk_fp8_f32(a[j].z * gg.z, a[j].w * gg.w, x, true);
            *(unsigned*)(dst + base + (size_t)(j * 64 + lane) * 4) = (unsigned)x; }
    }
}

__device__ __forceinline__ void build_wpt(const float* wq, const float* gain, const bf16_t* KEYB, bf16_t* WPT, int bid, int nblk) {
    const int w = threadIdx.x >> 6, lane = threadIdx.x & 63, fr = lane & 15, fq = lane >> 4;
    for (int task = bid * 8 + w; task < 16 * 128; task += nblk * 8) {
        const int g = task >> 7, kb = task & 127;
        f32x4 acc[8];
#pragma unroll
        for (int n = 0; n < 8; ++n) acc[n] = (f32x4){0.f, 0.f, 0.f, 0.f};
#pragma unroll 2
        for (int ks = 0; ks < 8; ++ks) {
            const float4* wp = (const float4*)(wq + (size_t)(kb * 16 + fr) * 4096 + g * 256 + ks * 32 + fq * 8);
            const float4 x0 = wp[0], x1 = wp[1]; const float gk = gain[kb * 16 + fr];
            u32x4 wv; wv.x = cvt_pk_bf16(x0.x * gk, x0.y * gk); wv.y = cvt_pk_bf16(x0.z * gk, x0.w * gk); wv.z = cvt_pk_bf16(x1.x * gk, x1.y * gk); wv.w = cvt_pk_bf16(x1.z * gk, x1.w * gk);
            const bf16x8 a = __builtin_bit_cast(bf16x8, wv);
#pragma unroll
            for (int n = 0; n < 8; ++n) {
                const bf16x8 b = *(const bf16x8*)(KEYB + (size_t)(g * 128 + n * 16 + fr) * 256 + ks * 32 + fq * 8);
                acc[n] = __builtin_amdgcn_mfma_f32_16x16x32_bf16(a, b, acc[n], 0, 0, 0);
            }
        }
#pragma unroll
        for (int n = 0; n < 8; ++n) { u32x2 o; o.x = cvt_pk_bf16(acc[n][0], acc[n][1]); o.y = cvt_pk_bf16(acc[n][2], acc[n][3]);
            *(u32x2*)(WPT + (size_t)(g * 128 + n * 16 + fr) * 2048 + kb * 16 + fq * 4) = o; }
    }
}

__device__ __forceinline__ void phase0(const Params& p, unsigned char* shm) {
    bf16_t* WB1 = (bf16_t*)(p.ws + WS_WB1);
    rmsnorm_rows(p.in[0], p.in[1], (bf16_t*)(p.ws + WS_H));
    transpose_convert(p.in[2], 2048, 6144, WB1, (float*)shm, blockIdx.x, gridDim.x);
    const float* mu = p.in[4]; const float* w1 = p.in[6]; const float* a1 = p.in[9]; const float* g1 = p.in[11];
    for (int idx = blockIdx.x * 512 + threadIdx.x; idx < 768 * 2048; idx += gridDim.x * 512) {
        const int j = idx >> 11, k = idx & 2047; float val = 0.f;
        if (j < 128) { const float m = mu[k], w = w1[k * 64 + (j & 63)]; val = (j < 64) ? w * (1.f - m) : w * m; }
        else if (j < 256) { const float m = mu[2048 + k], w = a1[k * 64 + (j & 63)]; val = (j < 192) ? w * (1.f - m) : w * m; }
        else if (j < 576) { const float m = mu[4096 + k]; const int jj = j - 256; const int c = jj < 160 ? jj : jj - 160; const float w = g1[k * 160 + c]; val = jj < 160 ? w * (1.f - m) : w * m; }
        WB1[(size_t)(6144 + j) * 2048 + k] = f2bf(val);
    }
    convert_flat(p.in[22], (bf16_t*)(p.ws + WS_KEYB), (size_t)8 * 2 * 128 * 256);
    bf16_t* W2T = (bf16_t*)(p.ws + WS_W2T); bf16_t* A2T = (bf16_t*)(p.ws + WS_A2T); bf16_t* G2T = (bf16_t*)(p.ws + WS_G2T);
    const float* w2 = p.in[7]; const float* a2 = p.in[10]; const float* g2 = p.in[12];
    for (int idx = blockIdx.x * 512 + threadIdx.x; idx < 1024 * 288; idx += gridDim.x * 512) {
        if (idx < 65536) { const int c = idx >> 6, j = idx & 63; W2T[idx] = f2bf(w2[j * 1024 + c]); }
        else if (idx < 131072) { const int i2 = idx - 65536; const int c = i2 >> 6, j = i2 & 63; A2T[i2] = f2bf(a2[j * 1024 + c]); }
        else { const int i2 = idx - 131072; const int c = i2 / 160, j = i2 % 160; G2T[i2] = f2bf(g2[j * 1024 + c]); }
    }
}

constexpr int ACT_LD = 296;
template <int KS, int KOFF, int KTOT, int KIND>
__device__ __forceinline__ void lora_stage(const LAS bf16_t* act, const bf16_t* WT, const float* bias, bf16_t* OUT, int t0, int w, int fr, int fq) {
#pragma unroll 1
    for (int nh = 0; nh < 2; ++nh) {
        f32x4 acc[4][4];
#pragma unroll
        for (int m = 0; m < 4; ++m)
#pragma unroll
            for (int n = 0; n < 4; ++n) acc[m][n] = (f32x4){0.f, 0.f, 0.f, 0.f};
        bf16x8 bfr[KS][4];
#pragma unroll
        for (int ks = 0; ks < KS; ++ks)
#pragma unroll
            for (int n = 0; n < 4; ++n) bfr[ks][n] = *(const bf16x8*)(WT + (size_t)(w * 128 + (nh * 4 + n) * 16 + fr) * KTOT + ks * 32 + fq * 8);
#pragma unroll
        for (int ks = 0; ks < KS; ++ks) {
            bf16x8 a[4];
#pragma unroll
            for (int m = 0; m < 4; ++m) a[m] = *(const LAS bf16x8*)(act + (m * 16 + fr) * ACT_LD + KOFF + ks * 32 + fq * 8);
#pragma unroll
            for (int n = 0; n < 4; ++n)
#pragma unroll
                for (int m = 0; m < 4; ++m) acc[m][n] = __builtin_amdgcn_mfma_f32_16x16x32_bf16(bfr[ks][n], a[m], acc[m][n], 0, 0, 0);
        }
#pragma unroll
        for (int n = 0; n < 4; ++n) {
            const int c = w * 128 + (nh * 4 + n) * 16 + fq * 4;
            float bs[4] = {0.f, 0.f, 0.f, 0.f};
            if (KIND < 2) { const float4 bv = *(const float4*)(bias + c); bs[0] = bv.x; bs[1] = bv.y; bs[2] = bv.z; bs[3] = bv.w; }
#pragma unroll
            for (int m = 0; m < 4; ++m) {
                float o[4];
#pragma unroll
                for (int j = 0; j < 4; ++j) {
                    const float val = acc[m][n][j];
                    if (KIND == 0) { const float x = -(bs[j] + val); const float sp = fmaxf(x, 0.f) + __logf(1.f + __expf(-fabsf(x))); o[j] = -__expf(-sp - 0.5f); }
                    else if (KIND == 1) o[j] = sigmoidf_(bs[j] + val);
                    else o[j] = val;
                }
                u32x2 wv; wv.x = cvt_pk_bf16(o[0], o[1]); wv.y = cvt_pk_bf16(o[2], o[3]);
                *(u32x2*)(OUT + (size_t)(t0 + m * 16 + fr) * DR + c) = wv;
            }
        }
    }
}
__device__ __forceinline__ void phase_prepM(const Params& p, LAS unsigned char* lds) {
    LAS bf16_t* act = (LAS bf16_t*)lds;
    const bf16_t* P = (const bf16_t*)(p.ws + WS_PROJ);
    const int tid = threadIdx.x, w = tid >> 6, lane = tid & 63, fr = lane & 15, fq = lane >> 4;
    for (int tile = blockIdx.x; tile < S_ / 64; tile += gridDim.x) {
        const int t0 = tile * 64;
        __syncthreads();
        for (int task = tid; task < 64 * 36; task += 512) {
            const int t = task / 36, j0 = (task % 36) * 8; const int tg = t0 + t;
            int ccur, cprev;
            if (j0 < 64) { ccur = 6144 + j0; cprev = 6208 + j0; }
            else if (j0 < 128) { ccur = 6272 + (j0 - 64); cprev = 6336 + (j0 - 64); }
            else { ccur = 6400 + (j0 - 128); cprev = 6560 + (j0 - 128); }
            float cu[8], pv[8], o8[8];
            unpack8(*(const u32x4*)(P + (size_t)tg * NAUG + ccur), cu);
            if (tg > 0) unpack8(*(const u32x4*)(P + (size_t)(tg - 1) * NAUG + cprev), pv);
            else {
#pragma unroll
                for (int i = 0; i < 8; ++i) pv[i] = 0.f;
            }
#pragma unroll
            for (int i = 0; i < 8; ++i) { const float sv = cu[i] + pv[i];
                o8[i] = j0 < 64 ? (1.f - 2.f / (1.f + __expf(2.f * sv))) : (j0 < 128 ? sv : sigmoidf_(sv)); }
            *(LAS u32x4*)(act + t * ACT_LD + j0) = pack8(o8);
        }
        __syncthreads();
        lora_stage<2, 0, 64, 0>(act, (const bf16_t*)(p.ws + WS_W2T), p.in[5], (bf16_t*)(p.ws + WS_LW), t0, w, fr, fq);
        lora_stage<2, 64, 64, 1>(act, (const bf16_t*)(p.ws + WS_A2T), p.in[8], (bf16_t*)(p.ws + WS_A), t0, w, fr, fq);
        lora_stage<5, 128, 160, 2>(act, (const bf16_t*)(p.ws + WS_G2T), nullptr, (bf16_t*)(p.ws + WS_G), t0, w, fr, fq);
    }
}

__device__ __forceinline__ void phase_prepE(const Params& p) {
    const bf16_t* P = (const bf16_t*)(p.ws + WS_PROJ);
    bf16_t* R = (bf16_t*)(p.ws + WS_R); bf16_t* Kk = (bf16_t*)(p.ws + WS_K); bf16_t* V = (bf16_t*)(p.ws + WS_V); bf16_t* KK = (bf16_t*)(p.ws + WS_KK); bf16_t* YC = (bf16_t*)(p.ws + WS_YC);
    const float* mu_rkv = p.in[3]; const float* k_k = p.in[13]; const float* cw = p.in[18];
    const int tid = threadIdx.x, cg = tid & 127, c0 = cg * 8, tgrp = tid >> 7;
    float mr[8], mk[8], mv[8], kkc[8], cw0[8], cw1[8], cw2[8];
#pragma unroll
    for (int i = 0; i < 8; ++i) { mr[i] = mu_rkv[c0 + i]; mk[i] = mu_rkv[1024 + c0 + i]; mv[i] = mu_rkv[2048 + c0 + i]; kkc[i] = k_k[c0 + i]; cw0[i] = cw[c0 + i]; cw1[i] = cw[1024 + c0 + i]; cw2[i] = cw[2048 + c0 + i]; }
    for (int run = blockIdx.x * 4 + tgrp; run < S_ / 16; run += gridDim.x * 4) {
        const int t0 = run * 16;
        float pr[8], pk[8], pv[8], u1[8], u2[8];
#pragma unroll
        for (int i = 0; i < 8; ++i) { pr[i] = 0.f; pk[i] = 0.f; pv[i] = 0.f; u1[i] = 0.f; u2[i] = 0.f; }
        if (t0 > 0) {
            const size_t o = (size_t)(t0 - 1) * NAUG + c0;
            unpack8(*(const u32x4*)(P + o), pr); unpack8(*(const u32x4*)(P + o + 1024), pk); unpack8(*(const u32x4*)(P + o + 2048), pv);
            float x[8], y[8];
            unpack8(*(const u32x4*)(P + o + 4096), x); unpack8(*(const u32x4*)(P + o + 5120), y);
#pragma unroll
            for (int i = 0; i < 8; ++i) u1[i] = x[i] * y[i];
            unpack8(*(const u32x4*)(P + o - NAUG + 4096), x); unpack8(*(const u32x4*)(P + o - NAUG + 5120), y);
#pragma unroll
            for (int i = 0; i < 8; ++i) u2[i] = x[i] * y[i];
        }
        u32x4 nx[6];
        { const size_t o = (size_t)t0 * NAUG + c0;
#pragma unroll
          for (int q = 0; q < 6; ++q) nx[q] = *(const u32x4*)(P + o + 1024 * q); }
#pragma unroll 1
        for (int t = 0; t < 16; ++t) {
            float cr[8], ck[8], cv[8], bg[8], cgt[8], xc[8];
            unpack8(nx[0], cr); unpack8(nx[1], ck); unpack8(nx[2], cv); unpack8(nx[3], bg); unpack8(nx[4], cgt); unpack8(nx[5], xc);
            { const size_t o = (size_t)(t0 + (t < 15 ? t + 1 : t)) * NAUG + c0;
#pragma unroll
              for (int q = 0; q < 6; ++q) nx[q] = *(const u32x4*)(P + o + 1024 * q); }
            float r[8], k[8], v[8], kkv[8], yc[8]; float ss = 0.f;
#pragma unroll
            for (int i = 0; i < 8; ++i) {
                r[i] = cr[i] + (pr[i] - cr[i]) * mr[i]; k[i] = ck[i] + (pk[i] - ck[i]) * mk[i]; v[i] = cv[i] + (pv[i] - cv[i]) * mv[i];
                pr[i] = cr[i]; pk[i] = ck[i]; pv[i] = cv[i];
                kkv[i] = k[i] * kkc[i]; ss += kkv[i] * kkv[i];
                const float u0 = cgt[i] * xc[i];
                yc[i] = bg[i] * (cw0[i] * u2[i] + cw1[i] * u1[i] + cw2[i] * u0);
                u2[i] = u1[i]; u1[i] = u0;
            }
            ss += dpp_f<0xB1, 0xf>(ss); ss += dpp_f<0x4E, 0xf>(ss); ss += dpp_f<0x141, 0xf>(ss);
            const float inv = 1.0f / fmaxf(sqrtf(ss), 1e-12f);
#pragma unroll
            for (int i = 0; i < 8; ++i) kkv[i] *= inv;
            const size_t oo = (size_t)(t0 + t) * DR + c0;
            *(u32x4*)(R + oo) = pack8(r); *(u32x4*)(Kk + oo) = pack8(k); *(u32x4*)(V + oo) = pack8(v); *(u32x4*)(KK + oo) = pack8(kkv); *(u32x4*)(YC + oo) = pack8(yc);
        }
    }
}

#define TILE(i) ((LAS bf16_t*)(lds + (i) * TSLOT))
__device__ __forceinline__ f32x4 mm_tile(f32x4 acc, const LAS bf16_t* A, const LAS bf16_t* Bt, int mi, int ni, int fr, int fq) {
#pragma unroll
    for (int ks = 0; ks < 2; ++ks) {
        const bf16x8 a = *(const LAS bf16x8*)(A + (mi * 16 + fr) * TLD + ks * 32 + fq * 8);
        const bf16x8 b = *(const LAS bf16x8*)(Bt + (ni * 16 + fr) * TLD + ks * 32 + fq * 8);
        acc = __builtin_amdgcn_mfma_f32_16x16x32_bf16(a, b, acc, 0, 0, 0);
    }
    return acc;
}
__device__ __forceinline__ void st_rm(LAS bf16_t* X, f32x4 v, int mi, int ni, int fr, int fq) {
    const unsigned w0 = cvt_pk_bf16(v[0], v[1]), w1 = cvt_pk_bf16(v[2], v[3]);
    LAS bf16_t* q = X + (mi * 16 + fq * 4) * TLD + ni * 16 + fr;
    q[0] = (bf16_t)(w0 & 0xffffu); q[TLD] = (bf16_t)(w0 >> 16); q[2 * TLD] = (bf16_t)(w1 & 0xffffu); q[3 * TLD] = (bf16_t)(w1 >> 16);
}
__device__ __forceinline__ void st_tr(LAS bf16_t* XT, f32x4 v, int mi, int ni, int fr, int fq) {
    u32x2 w; w.x = cvt_pk_bf16(v[0], v[1]); w.y = cvt_pk_bf16(v[2], v[3]);
    *(LAS u32x2*)(XT + (ni * 16 + fr) * TLD + mi * 16 + fq * 4) = w;
}
__device__ __forceinline__ f32x4 ld_rm(const LAS bf16_t* X, int mi, int ni, int fr, int fq) {
    const LAS bf16_t* q = X + (mi * 16 + fq * 4) * TLD + ni * 16 + fr;
    return (f32x4){bf2f(q[0]), bf2f(q[TLD]), bf2f(q[2 * TLD]), bf2f(q[3 * TLD])};
}
__device__ __forceinline__ f32x4 ld_tr(const LAS bf16_t* XT, int mi, int ni, int fr, int fq) {
    const u32x2 w = *(const LAS u32x2*)(XT + (ni * 16 + fr) * TLD + mi * 16 + fq * 4);
    return (f32x4){lo_bf(w.x), hi_bf(w.x), lo_bf(w.y), hi_bf(w.y)};
}

__device__ __forceinline__ void phase_chunkA(const Params& p, LAS unsigned char* lds) {
    const int tid = threadIdx.x, w = tid >> 6, lane = tid & 63, fr = lane & 15, fq = lane >> 4;
    const int mi = w >> 1, nb = (w & 1) * 2;
    LAS float* cl = (LAS float*)(lds + 14 * TSLOT);
    LAS float* gs = (LAS float*)(lds + 16 * TSLOT);
    LAS float* wc = gs + 512;
    const bf16_t* R = (const bf16_t*)(p.ws + WS_R); const bf16_t* Kk = (const bf16_t*)(p.ws + WS_K); const bf16_t* V = (const bf16_t*)(p.ws + WS_V);
    const bf16_t* KK = (const bf16_t*)(p.ws + WS_KK); const bf16_t* A = (const bf16_t*)(p.ws + WS_A); const bf16_t* LW = (const bf16_t*)(p.ws + WS_LW);
    bf16_t* GT = (bf16_t*)(p.ws + WS_GT); float* HT = (float*)(p.ws + WS_HT); bf16_t* QE = (bf16_t*)(p.ws + WS_QE); bf16_t* YL = (bf16_t*)(p.ws + WS_YL);
    const f32x4 z4 = (f32x4){0.f, 0.f, 0.f, 0.f};
    const float* k_a = p.in[14]; const float* r_k = p.in[15]; float* BON = (float*)(p.ws + WS_BON);
    u32x4 nr4, nk4, nv4, nkk4, na4, nlw4;
#define CA_LOAD(it) do { const size_t _go = (size_t)(((it) >> 4) * 64 + (tid >> 3)) * DR + ((it) & 15) * 64 + (tid & 7) * 8; \
        nr4 = *(const u32x4*)(R + _go); nk4 = *(const u32x4*)(Kk + _go); nv4 = *(const u32x4*)(V + _go); nkk4 = *(const u32x4*)(KK + _go); na4 = *(const u32x4*)(A + _go); nlw4 = *(const u32x4*)(LW + _go); } while (0)
    for (int item = blockIdx.x; item < 4096; item += gridDim.x) {
        const int c = item >> 4, h = item & 15;
        const int t = tid >> 3, k0 = (tid & 7) * 8;
        if (item == (int)blockIdx.x) CA_LOAD(item);
        const u32x4 r4 = nr4, k4 = nk4, v4 = nv4, kk4 = nkk4, a4 = na4, lw4 = nlw4;
        __syncthreads();
        {
            float lwf8[8]; unpack8(lw4, lwf8);
            *(LAS f32x4*)(cl + t * 64 + k0) = (f32x4){lwf8[0], lwf8[1], lwf8[2], lwf8[3]};
            *(LAS f32x4*)(cl + t * 64 + k0 + 4) = (f32x4){lwf8[4], lwf8[5], lwf8[6], lwf8[7]};
            __syncthreads();
            const int g = w, k = lane;
            float pfx[8]; float run = 0.f;
#pragma unroll
            for (int i = 0; i < 8; ++i) { run += cl[(g * 8 + i) * 64 + k]; pfx[i] = run; }
            gs[g * 64 + k] = run;
            __syncthreads();
            float off = 0.f;
#pragma unroll
            for (int gg = 0; gg < 7; ++gg) { const float x = gs[gg * 64 + k]; off += (gg < g) ? x : 0.f; }
#pragma unroll
            for (int i = 0; i < 8; ++i) cl[(g * 8 + i) * 64 + k] = off + pfx[i];
            if (g == 7) wc[k] = __expf(off + pfx[7]);
            __syncthreads();
        }
        if (item + (int)gridDim.x < 4096) CA_LOAD(item + (int)gridDim.x);
        {
            float at[8], rt[8], bt[8], kt[8], bh[8], kh[8], vv[8]; float bsum = 0.f;
#pragma unroll
            for (int i = 0; i < 8; ++i) {
                const int q = i >> 1; const bool hi = i & 1;
                const float rf = hi ? hi_bf(r4[q]) : lo_bf(r4[q]), kraw = hi ? hi_bf(k4[q]) : lo_bf(k4[q]), vf = hi ? hi_bf(v4[q]) : lo_bf(v4[q]);
                const float kkf = hi ? hi_bf(kk4[q]) : lo_bf(kk4[q]), af = hi ? hi_bf(a4[q]) : lo_bf(a4[q]), lwf = hi ? hi_bf(lw4[q]) : lo_bf(lw4[q]);
                const float kf = kraw * (1.f + (af - 1.f) * k_a[h * 64 + k0 + i]);
                bsum += rf * kf * r_k[h * 64 + k0 + i];
                const float clv = cl[t * 64 + k0 + i], cle = cl[63 * 64 + k0 + i];
                const float e = __expf(clv), ex = __expf(clv - lwf), ei = __expf(-clv), eh = __expf(cle - clv);
                const float bb = kkf * af;
                at[i] = -kkf * ex; rt[i] = rf * e; bt[i] = bb * ei; kt[i] = kf * ei; bh[i] = bb * eh; kh[i] = kf * eh; vv[i] = vf;
            }
            bsum += dpp_f<0xB1, 0xf>(bsum); bsum += dpp_f<0x4E, 0xf>(bsum); bsum += dpp_f<0x141, 0xf>(bsum);
            if ((tid & 7) == 0) BON[(size_t)(c * 64 + t) * 16 + h] = bsum;
            *(LAS u32x4*)(TILE(0) + t * TLD + k0) = pack8(at);
            *(LAS u32x4*)(TILE(2) + t * TLD + k0) = pack8(rt);
            *(LAS u32x4*)(TILE(3) + t * TLD + k0) = pack8(bt);
            *(LAS u32x4*)(TILE(4) + t * TLD + k0) = pack8(kt);
            const u32x4 atp = pack8(at), bhp = pack8(bh), khp = pack8(kh);
#pragma unroll
            for (int i = 0; i < 8; ++i) {
                const int q = i >> 1; const bool hi = i & 1;
                TILE(1)[(k0 + i) * TLD + t] = (bf16_t)(hi ? (atp[q] >> 16) : (atp[q] & 0xffffu));
                TILE(5)[(k0 + i) * TLD + t] = (bf16_t)(hi ? (bhp[q] >> 16) : (bhp[q] & 0xffffu));
                TILE(6)[(k0 + i) * TLD + t] = (bf16_t)(hi ? (khp[q] >> 16) : (khp[q] & 0xffffu));
                TILE(7)[(k0 + i) * TLD + t] = (bf16_t)(hi ? (v4[q] >> 16) : (v4[q] & 0xffffu));
            }
            __syncthreads();
        }
#pragma unroll
        for (int nn = 0; nn < 2; ++nn) {
            const int ni = nb + nn; const int col = ni * 16 + fr, row0 = mi * 16 + fq * 4;
            f32x4 x = mm_tile(z4, TILE(0), TILE(3), mi, ni, fr, fq);
#pragma unroll
            for (int j = 0; j < 4; ++j) x[j] = (col < row0 + j) ? x[j] : 0.f;
            st_rm(TILE(8), x, mi, ni, fr, fq); st_tr(TILE(9), x, mi, ni, fr, fq);
            x = mm_tile(z4, TILE(0), TILE(4), mi, ni, fr, fq);
#pragma unroll
            for (int j = 0; j < 4; ++j) x[j] = (col < row0 + j) ? x[j] : 0.f;
            st_rm(TILE(10), x, mi, ni, fr, fq);
            x = mm_tile(z4, TILE(2), TILE(3), mi, ni, fr, fq);
#pragma unroll
            for (int j = 0; j < 4; ++j) x[j] = (col <= row0 + j) ? x[j] : 0.f;
            st_rm(TILE(11), x, mi, ni, fr, fq);
            x = mm_tile(z4, TILE(2), TILE(4), mi, ni, fr, fq);
#pragma unroll
            for (int j = 0; j < 4; ++j) x[j] = (col <= row0 + j) ? x[j] : 0.f;
            st_rm(TILE(12), x, mi, ni, fr, fq);
        }
        __syncthreads();
#pragma unroll
        for (int nn = 0; nn < 2; ++nn) {
            const int ni = nb + nn;
            st_tr(TILE(13), mm_tile(z4, TILE(10), TILE(7), mi, ni, fr, fq), mi, ni, fr, fq);
            const f32x4 x = mm_tile(z4, TILE(8), TILE(9), mi, ni, fr, fq);
            st_rm(TILE(0), x, mi, ni, fr, fq); st_tr(TILE(3), x, mi, ni, fr, fq);
        }
        __syncthreads();
#pragma unroll
        for (int rd = 0; rd < 5; ++rd) {
            const int tq = (rd & 1) ? 14 : 8, tqo = (rd & 1) ? 8 : 14;
            const int lx = (rd & 1) ? 4 : 0, lxt = (rd & 1) ? 9 : 3, lxo = (rd & 1) ? 0 : 4, lxto = (rd & 1) ? 3 : 9;
#pragma unroll
            for (int nn = 0; nn < 2; ++nn) {
                const int ni = nb + nn;
                f32x4 x = ld_rm(TILE(tq), mi, ni, fr, fq) + ld_rm(TILE(lx), mi, ni, fr, fq);
                x = mm_tile(x, TILE(tq), TILE(lxt), mi, ni, fr, fq);
                st_rm(TILE(tqo), x, mi, ni, fr, fq);
                if (rd < 4) { const f32x4 y = mm_tile(z4, TILE(lx), TILE(lxt), mi, ni, fr, fq); st_rm(TILE(lxo), y, mi, ni, fr, fq); st_tr(TILE(lxto), y, mi, ni, fr, fq); }
            }
            __syncthreads();
        }
#pragma unroll
        for (int nn = 0; nn < 2; ++nn) {
            const int ni = nb + nn;
            st_tr(TILE(10), mm_tile(ld_tr(TILE(1), mi, ni, fr, fq), TILE(14), TILE(1), mi, ni, fr, fq), mi, ni, fr, fq);
            st_tr(TILE(15), mm_tile(ld_tr(TILE(13), mi, ni, fr, fq), TILE(14), TILE(13), mi, ni, fr, fq), mi, ni, fr, fq);
        }
        __syncthreads();
#pragma unroll
        for (int nn = 0; nn < 2; ++nn) {
            const int ni = nb + nn;
            {
                f32x4 x = mm_tile(z4, TILE(5), TILE(10), mi, ni, fr, fq);
                if (mi == ni) {
#pragma unroll
                    for (int j = 0; j < 4; ++j) x[j] += (fq * 4 + j == fr) ? wc[ni * 16 + fr] : 0.f;
                }
                const unsigned w0 = cvt_pk_bf16(x[0], x[1]), w1 = cvt_pk_bf16(x[2], x[3]);
                bf16_t* gp = GT + (size_t)item * 4096 + (size_t)((mi * 2 + (ni >> 1)) * 64 + (fr >> 2) * 16 + fq * 4) * 8 + (ni & 1) * 4 + (fr & 3);
                gp[0] = (bf16_t)(w0 & 0xffffu); gp[8] = (bf16_t)(w0 >> 16); gp[16] = (bf16_t)(w1 & 0xffffu); gp[24] = (bf16_t)(w1 >> 16);
            }
            {
                f32x4 x = mm_tile(z4, TILE(5), TILE(15), mi, ni, fr, fq);
                x = mm_tile(x, TILE(6), TILE(7), mi, ni, fr, fq);
                *(f32x4*)(HT + (size_t)item * 4096 + (size_t)((ni * 4 + mi) * 64 + lane) * 4) = x;
            }
            {
                f32x4 x = ld_tr(TILE(2), mi, ni, fr, fq);
                x = mm_tile(x, TILE(10), TILE(11), mi, ni, fr, fq);
                u32x2 wv; wv.x = cvt_pk_bf16(x[0], x[1]); wv.y = cvt_pk_bf16(x[2], x[3]);
                *(u32x2*)(QE + (size_t)item * 4096 + (ni * 16 + fr) * 64 + mi * 16 + fq * 4) = wv;
            }
            {
                f32x4 x = mm_tile(z4, TILE(11), TILE(15), mi, ni, fr, fq);
                x = mm_tile(x, TILE(12), TILE(7), mi, ni, fr, fq);
                u32x2 wv; wv.x = cvt_pk_bf16(x[0], x[1]); wv.y = cvt_pk_bf16(x[2], x[3]);
                *(u32x2*)(YL + (size_t)item * 4096 + (size_t)((mi * 4 + ni) * 64 + lane) * 4) = wv;
            }
        }
    }
}

__device__ __forceinline__ void phase_seq(const Params& p) {
    if (threadIdx.x >= 64) return;
    const int head = blockIdx.x >> 2, vt = blockIdx.x & 3, lane = threadIdx.x, fr = lane & 15, fq = lane >> 4;
    const bf16_t* GT = (const bf16_t*)(p.ws + WS_GT); const float* HT = (const float*)(p.ws + WS_HT); bf16_t* S0 = (bf16_t*)(p.ws + WS_S0);
    f32x4 acc[4];
#pragma unroll
    for (int mb = 0; mb < 4; ++mb) acc[mb] = (f32x4){0.f, 0.f, 0.f, 0.f};
    bf16x8 ga[4][4][2]; f32x4 hh[4][4];
#define SEQ_LOAD(buf, cc) do { const size_t _it = (size_t)((cc) < 256 ? (cc) : 255) * 16 + head; \
        _Pragma("unroll") for (int mb = 0; mb < 4; ++mb) { \
            _Pragma("unroll") for (int ks = 0; ks < 2; ++ks) ga[buf][mb][ks] = *(const bf16x8*)(GT + _it * 4096 + (size_t)((mb * 2 + ks) * 64 + lane) * 8); \
            hh[buf][mb] = *(const f32x4*)(HT + _it * 4096 + (size_t)((vt * 4 + mb) * 64 + lane) * 4); } } while (0)
    SEQ_LOAD(0, 0); SEQ_LOAD(1, 1); SEQ_LOAD(2, 2); SEQ_LOAD(3, 3);
    for (int c0 = 0; c0 < 256; c0 += 4) {
#pragma unroll
        for (int b = 0; b < 4; ++b) {
            const int c = c0 + b; const size_t item = (size_t)c * 16 + head;
            u32x2 pk[4];
#pragma unroll
            for (int mb = 0; mb < 4; ++mb) { pk[mb].x = cvt_pk_bf16(acc[mb][0], acc[mb][1]); pk[mb].y = cvt_pk_bf16(acc[mb][2], acc[mb][3]);
                *(u32x2*)(S0 + item * 4096 + (vt * 16 + fr) * 64 + mb * 16 + fq * 4) = pk[mb]; }
            u32x4 b0w, b1w; b0w.x = pk[0].x; b0w.y = pk[0].y; b0w.z = pk[1].x; b0w.w = pk[1].y; b1w.x = pk[2].x; b1w.y = pk[2].y; b1w.z = pk[3].x; b1w.w = pk[3].y;
            const bf16x8 b0 = __builtin_bit_cast(bf16x8, b0w), b1 = __builtin_bit_cast(bf16x8, b1w);
#pragma unroll
            for (int mb = 0; mb < 4; ++mb) {
                const f32x4 x = __builtin_amdgcn_mfma_f32_16x16x32_bf16(ga[b][mb][0], b0, hh[b][mb], 0, 0, 0);
                acc[mb] = __builtin_amdgcn_mfma_f32_16x16x32_bf16(ga[b][mb][1], b1, x, 0, 0, 0);
            }
            SEQ_LOAD(b, c + 4);
        }
    }
#undef SEQ_LOAD
}

__device__ __forceinline__ void phase_chunkY(const Params& p, LAS unsigned char* lds) {
    LAS float* Yb = (LAS float*)lds;
    const int tid = threadIdx.x, w = tid >> 6, lane = tid & 63, fr = lane & 15, fq = lane >> 4;
    const int mi = w >> 1, nb = (w & 1) * 2;
    const bf16_t* R = (const bf16_t*)(p.ws + WS_R); const bf16_t* Kk = (const bf16_t*)(p.ws + WS_K); const bf16_t* V = (const bf16_t*)(p.ws + WS_V);
    const bf16_t* G = (const bf16_t*)(p.ws + WS_G); const bf16_t* YC = (const bf16_t*)(p.ws + WS_YC);
    const bf16_t* QE = (const bf16_t*)(p.ws + WS_QE); const bf16_t* YL = (const bf16_t*)(p.ws + WS_YL); const bf16_t* S0 = (const bf16_t*)(p.ws + WS_S0);
    bf16_t* YM = (bf16_t*)(p.ws + WS_YMIX);
    const float* gn_w = p.in[16]; const float* gn_b = p.in[17];
    u32x2 ywn[2]; bf16x8 an[2], bn[2][2]; bool first = true;
    u32x4 nv4, ng4, nyc4; float nbon; const float* BONp = (const float*)(p.ws + WS_BON);
#define CY_LOAD(it) do { const bf16_t* _q = QE + (size_t)(it) * 4096; const bf16_t* _s = S0 + (size_t)(it) * 4096; const bf16_t* _y = YL + (size_t)(it) * 4096; \
        _Pragma("unroll") for (int ks = 0; ks < 2; ++ks) an[ks] = *(const bf16x8*)(_q + (mi * 16 + fr) * 64 + ks * 32 + fq * 8); \
        _Pragma("unroll") for (int nn = 0; nn < 2; ++nn) { ywn[nn] = *(const u32x2*)(_y + (size_t)((mi * 4 + nb + nn) * 64 + lane) * 4); \
            _Pragma("unroll") for (int ks = 0; ks < 2; ++ks) bn[nn][ks] = *(const bf16x8*)(_s + (nb + nn) * 16 * 64 + fr * 64 + ks * 32 + fq * 8); } \
        { const size_t _tg = (size_t)((it) >> 4) * 64 + (tid >> 3); const size_t _o = _tg * DR + ((it) & 15) * 64 + (tid & 7) * 8; \
          nv4 = *(const u32x4*)(V + _o); ng4 = *(const u32x4*)(G + _o); nyc4 = *(const u32x4*)(YC + _o); nbon = BONp[_tg * 16 + ((it) & 15)]; } } while (0)
    for (int item = blockIdx.x; item < 4096; item += gridDim.x) {
        const int c = item >> 4, h = item & 15;
        if (first) { first = false; CY_LOAD(item); }
        __syncthreads();
        const u32x2 ywc[2] = {ywn[0], ywn[1]}; const bf16x8 ac[2] = {an[0], an[1]}; const bf16x8 bc[2][2] = {{bn[0][0], bn[0][1]}, {bn[1][0], bn[1][1]}};
        const u32x4 v4 = nv4, g4 = ng4, yc4 = nyc4; const float bon = nbon;
        if (item + (int)gridDim.x < 4096) CY_LOAD(item + (int)gridDim.x);
#pragma unroll
        for (int nn = 0; nn < 2; ++nn) {
            const int ni = nb + nn;
            const u32x2 yw = ywc[nn];
            f32x4 acc = (f32x4){lo_bf(yw.x), hi_bf(yw.x), lo_bf(yw.y), hi_bf(yw.y)};
#pragma unroll
            for (int ks = 0; ks < 2; ++ks) acc = __builtin_amdgcn_mfma_f32_16x16x32_bf16(ac[ks], bc[nn][ks], acc, 0, 0, 0);
#pragma unroll
            for (int j = 0; j < 4; ++j) Yb[(mi * 16 + fq * 4 + j) * 68 + ni * 16 + fr] = acc[j];
        }
        __syncthreads();
        {
            const int t = tid >> 3, k0 = (tid & 7) * 8; const int ch = h * 64 + k0;
            const size_t tg = (size_t)c * 64 + t; const size_t o = tg * DR + ch;
            const float4 gw0 = *(const float4*)(gn_w + ch), gw1 = *(const float4*)(gn_w + ch + 4), gb0 = *(const float4*)(gn_b + ch), gb1 = *(const float4*)(gn_b + ch + 4);
            const float gwv[8] = {gw0.x, gw0.y, gw0.z, gw0.w, gw1.x, gw1.y, gw1.z, gw1.w}, gbv[8] = {gb0.x, gb0.y, gb0.z, gb0.w, gb1.x, gb1.y, gb1.z, gb1.w};
            const f32x4 y0 = *(const LAS f32x4*)(Yb + t * 68 + k0), y1 = *(const LAS f32x4*)(Yb + t * 68 + k0 + 4);
            const float y[8] = {y0[0], y0[1], y0[2], y0[3], y1[0], y1[1], y1[2], y1[3]};
            float sm = 0.f;
#pragma unroll
            for (int i = 0; i < 8; ++i) sm += y[i];
            sm += dpp_f<0xB1, 0xf>(sm); sm += dpp_f<0x4E, 0xf>(sm); sm += dpp_f<0x141, 0xf>(sm);
            const float mean = sm * (1.f / 64.f);
            float vs = 0.f;
#pragma unroll
            for (int i = 0; i < 8; ++i) { const float d = y[i] - mean; vs += d * d; }
            vs += dpp_f<0xB1, 0xf>(vs); vs += dpp_f<0x4E, 0xf>(vs); vs += dpp_f<0x141, 0xf>(vs);
            const float rs = rsqrtf(vs * (1.f / 64.f) + 64e-5f);
            float vf[8], gf[8], of[8];
            unpack8(v4, vf); unpack8(g4, gf);
#pragma unroll
            for (int i = 0; i < 8; ++i) of[i] = ((y[i] - mean) * rs * gwv[i] + gbv[i] + bon * vf[i]) * gf[i];
            *(u32x4*)(YM + tg * D_ + ch) = pack8(of);
            *(u32x4*)(YM + tg * D_ + 1024 + ch) = yc4;
        }
    }
#undef CY_LOAD
}

__device__ __forceinline__ int f2key(float x) { const int u = __float_as_int(x); return u ^ ((u >> 31) & 0x7fffffff); }
__device__ __forceinline__ float key2f(int k) { return __int_as_float(k ^ ((k >> 31) & 0x7fffffff)); }
template <int CTRL> __device__ __forceinline__ int dpp_i(int v) { return __builtin_amdgcn_update_dpp(v, v, CTRL, 0xf, 0xf, false); }
__device__ __forceinline__ int row_max_i(int v) { v = max(v, dpp_i<0xB1>(v)); v = max(v, dpp_i<0x4E>(v)); v = max(v, dpp_i<0x141>(v)); v = max(v, dpp_i<0x140>(v)); return v; }
__device__ __forceinline__ void phase_topk(const Params& p, unsigned char* shm) {
    float* sc = (float*)shm;
    int* tk = (int*)(sc + 64 * 260);
    int* ctab = tk + 2048;
    if (threadIdx.x < 64) { int n = threadIdx.x, v = 256;
        for (int i = 0; i < 16; ++i) { const int cnt = 16 / (i + 1); if (n < cnt) { v = i * 16 + n; break; } n -= cnt; }
        ctab[threadIdx.x] = v; }
    const float* SC = (const float*)(p.ws + WS_Q);
    int* IDS = (int*)(p.ws + WS_IDS); float* GATES = (float*)(p.ws + WS_GATES);
    const int tid = threadIdx.x, w = tid >> 6, lane = tid & 63;
    f32x4 qreg[8];
#define TK_QLOAD(it) do { const int _t0 = ((it) >> 3) * 64; _Pragma("unroll") for (int i = 0; i < 8; ++i) { const int ch = tid + 512 * i; \
        qreg[i] = *(const f32x4*)(SC + (size_t)(_t0 + (ch >> 6)) * 2048 + ((it) & 7) * 256 + (ch & 63) * 4); } } while (0)
    if ((int)blockIdx.x < 2048) TK_QLOAD((int)blockIdx.x);
    for (int item = blockIdx.x; item < 2048; item += gridDim.x) {
        const int t0 = (item >> 3) * 64, h = item & 7;
        __syncthreads();
#pragma unroll
        for (int i = 0; i < 8; ++i) { const int ch = tid + 512 * i; *(f32x4*)(sc + (ch >> 6) * 260 + (ch & 63) * 4) = qreg[i]; }
        __syncthreads();
        if (item + (int)gridDim.x < 2048) TK_QLOAD(item + (int)gridDim.x);
        for (int g = 0; g < 4; ++g) {
            const int L = w * 16 + g * 4 + (lane >> 4); const int tok = L >> 1, cc = L & 1; const int pp = lane & 15;
            int key[8];
#pragma unroll
            for (int i = 0; i < 8; ++i) key[i] = (f2key(sc[tok * 260 + cc * 128 + i * 16 + pp]) & ~127) | (127 - (i * 16 + pp));
#define CE(a, b) do { const int _hi = max(key[a], key[b]), _lo = min(key[a], key[b]); key[a] = _hi; key[b] = _lo; } while (0)
            CE(0, 1); CE(2, 3); CE(4, 5); CE(6, 7);  CE(0, 2); CE(1, 3); CE(4, 6); CE(5, 7);  CE(1, 2); CE(5, 6);
            CE(0, 4); CE(1, 5); CE(2, 6); CE(3, 7);  CE(2, 4); CE(3, 5);  CE(1, 2); CE(3, 4); CE(5, 6);
#undef CE
            int mykey = 0;
#pragma unroll
            for (int r = 0; r < 16; ++r) {
                const int m = row_max_i(key[0]);
                const bool win = (key[0] == m);
#pragma unroll
                for (int i = 0; i < 7; ++i) key[i] = win ? key[i + 1] : key[i];
                key[7] = win ? (int)0x80000000 : key[7];
                mykey = (pp == r) ? m : mykey;
            }
            tk[L * 16 + pp] = mykey;
        }
        __syncthreads();
        for (int g = 0; g < 2; ++g) {
            const int tok = w * 8 + g * 4 + (lane >> 4); const int pp = lane & 15;
            int key[4];
#pragma unroll
            for (int q = 0; q < 4; ++q) {
                const int ij = ctab[q * 16 + pp];
                const float s1 = key2f(tk[(tok * 2) * 16 + ((ij >> 4) & 15)] & ~127), s2 = key2f(tk[(tok * 2 + 1) * 16 + (ij & 15)] & ~127);
                key[q] = (ij < 256) ? ((f2key(s1 + s2) & ~255) | (255 - ij)) : (int)0x80000000;
            }
            int mykey = 0;
#pragma unroll
            for (int r = 0; r < 16; ++r) {
                const int ml = max(max(key[0], key[1]), max(key[2], key[3]));
                const int m = row_max_i(ml);
#pragma unroll
                for (int q = 0; q < 4; ++q) key[q] = (key[q] == m) ? (int)0x80000000 : key[q];
                mykey = (pp == r) ? m : mykey;
            }
            const int ci = 255 - (mykey & 255); const float cs = key2f(mykey & ~255);
            const int e1 = 127 - (tk[(tok * 2) * 16 + (ci >> 4)] & 127), e2 = 127 - (tk[(tok * 2 + 1) * 16 + (ci & 15)] & 127);
            const float mx = __shfl(cs, lane & 48);
            const float e = __expf(cs - mx);
            float sum = e; sum += dpp_f<0xB1, 0xf>(sum); sum += dpp_f<0x4E, 0xf>(sum); sum += dpp_f<0x141, 0xf>(sum); sum += dpp_f<0x140, 0xf>(sum);
            IDS[(size_t)(t0 + tok) * 128 + h * 16 + pp] = (e1 * 128 + e2) & 16383;
            GATES[(size_t)(t0 + tok) * 128 + h * 16 + pp] = e / sum;
        }
    }
#undef TK_QLOAD
}

constexpr float U8_SCALE = 64.f, V8_SCALE = 32.f;
__device__ __forceinline__ float gelu_fast(float x) { const float u = 0.7978845608028654f * (x + 0.044715f * x * x * x); return x / (1.0f + __expf(-2.0f * u)); }
__device__ __forceinline__ void phase_gather(const Params& p, unsigned char* shm) {
    const float* X1 = (const float*)(p.ws + WS_X1); const float* SSQ = (const float*)(p.ws + WS_SSQ);
    const unsigned char* U8 = p.ws + WS_UB; const unsigned char* V8 = p.ws + WS_VB;
    const int* IDS = (const int*)(p.ws + WS_IDS); const float* GATES = (const float*)(p.ws + WS_GATES);
    const float* nf = p.in[25];
    const int tid = threadIdx.x, w = tid >> 6, lane = tid & 63;
    for (int t = blockIdx.x * 8 + w; t < S_; t += gridDim.x * 8) {
        const int id0 = IDS[(size_t)t * 128 + lane], id1 = IDS[(size_t)t * 128 + 64 + lane];
        const float gt0 = GATES[(size_t)t * 128 + lane], gt1 = GATES[(size_t)t * 128 + 64 + lane];
        f32x2 op[16];
#pragma unroll
        for (int q = 0; q < 2; ++q)
#pragma unroll
            for (int i = 0; i < 4; ++i) { const float4 x = *(const float4*)(X1 + (size_t)t * D_ + q * 1024 + lane * 16 + 4 * i);
                op[q * 8 + 2 * i] = (f32x2){x.x, x.y}; op[q * 8 + 2 * i + 1] = (f32x2){x.z, x.w}; }
        f32x2 hp[16];
#pragma unroll
        for (int i = 0; i < 16; ++i) hp[i] = op[i];
        const float rs = rsqrtf(wave_sum_dpp(lane < 32 ? SSQ[(size_t)t * 32 + lane] : 0.f) * (1.0f / 2048.0f) + 1e-6f);
        u32x4 ua[4][2], ub[4][2], vb[4][2];
#define G_LOADU(dst, grp) do { _Pragma("unroll") for (int j = 0; j < 4; ++j) { const int e = (grp) * 4 + j; const int id = __builtin_amdgcn_readlane(e < 64 ? id0 : id1, e & 63); \
            const unsigned char* ur = U8 + (size_t)id * D_ + lane * 16; dst[j][0] = *(const u32x4*)ur; dst[j][1] = *(const u32x4*)(ur + 1024); } } while (0)
#define G_LOADV(grp) do { _Pragma("unroll") for (int j = 0; j < 4; ++j) { const int e = (grp) * 4 + j; const int id = __builtin_amdgcn_readlane(e < 64 ? id0 : id1, e & 63); \
            const unsigned char* vr = V8 + (size_t)id * D_ + lane * 16; vb[j][0] = *(const u32x4*)vr; vb[j][1] = *(const u32x4*)(vr + 1024); } } while (0)
#define G_BODY(cur, nxt, grp) do { \
            G_LOADV(grp); \
            G_LOADU(nxt, ((grp) + 1 < 32 ? (grp) + 1 : 31)); \
            float dsel = 0.f; \
            _Pragma("unroll") for (int j = 0; j < 4; ++j) { f32x2 d2 = (f32x2){0.f, 0.f}; \
                _Pragma("unroll") for (int q = 0; q < 2; ++q) _Pragma("unroll") for (int i = 0; i < 4; ++i) { \
                    d2 += __builtin_amdgcn_cvt_pk_f32_fp8((int)cur[j][q][i], false) * hp[q * 8 + 2 * i]; d2 += __builtin_amdgcn_cvt_pk_f32_fp8((int)cur[j][q][i], true) * hp[q * 8 + 2 * i + 1]; } \
                const float d = wave_sum_dpp(d2.x + d2.y); dsel = (lane == j) ? d : dsel; } \
            const float av = gelu_fast(dsel * (rs * (1.f / U8_SCALE))) * (1.f / V8_SCALE); \
            _Pragma("unroll") for (int j = 0; j < 4; ++j) { const int e = (grp) * 4 + j; \
                const float a = __int_as_float(__builtin_amdgcn_readlane(__float_as_int(av), j)) * __int_as_float(__builtin_amdgcn_readlane(__float_as_int(e < 64 ? gt0 : gt1), e & 63)); \
                const f32x2 a2 = (f32x2){a, a}; \
                _Pragma("unroll") for (int q = 0; q < 2; ++q) _Pragma("unroll") for (int i = 0; i < 4; ++i) { \
                    op[q * 8 + 2 * i] += a2 * __builtin_amdgcn_cvt_pk_f32_fp8((int)vb[j][q][i], false); op[q * 8 + 2 * i + 1] += a2 * __builtin_amdgcn_cvt_pk_f32_fp8((int)vb[j][q][i], true); } } \
        } while (0)
        G_LOADU(ua, 0);
#pragma unroll 1
        for (int g2 = 0; g2 < 32; g2 += 2) { G_BODY(ua, ub, g2); G_BODY(ub, ua, g2 + 1); }
#undef G_LOADU
#undef G_LOADV
#undef G_BODY
        float ss = 0.f; float4 xs[8];
#pragma unroll
        for (int q = 0; q < 2; ++q)
#pragma unroll
            for (int i = 0; i < 4; ++i) { float4 x;
                x.x = op[q * 8 + 2 * i].x; x.y = op[q * 8 + 2 * i].y; x.z = op[q * 8 + 2 * i + 1].x; x.w = op[q * 8 + 2 * i + 1].y;
                ss += x.x * x.x + x.y * x.y + x.z * x.z + x.w * x.w; xs[q * 4 + i] = x; }
        ss = wave_sum_dpp(ss);
        const float scl = rsqrtf(ss * (1.f / 2048.f) + 1e-6f);
#pragma unroll
        for (int q = 0; q < 2; ++q)
#pragma unroll
            for (int i = 0; i < 4; ++i) { const float4 g = *(const float4*)(nf + q * 1024 + lane * 16 + 4 * i); const float4 x = xs[q * 4 + i];
                *(float4*)(p.out + (size_t)t * D_ + q * 1024 + lane * 16 + 4 * i) = make_float4(x.x * scl * g.x, x.y * scl * g.y, x.z * scl * g.z, x.w * scl * g.w); }
    }
}

#define XB_TMO      128
#define XB_XCNT(j)  (256  + 64 * (j))
#define XB_XSUB(j)  (1280 + 64 * (j))
#define XB_XGEN(j)  (2304 + 64 * (j))
#define XB_TOP      3328
#define XB_TOPGEN   3392
#define XCD_BAR_WORDS 3456
#define XB_SPIN_CAP (1u << 18)
__device__ __forceinline__ unsigned xb_ld(unsigned* p)              { return __hip_atomic_load(p, __ATOMIC_RELAXED, __HIP_MEMORY_SCOPE_AGENT); }
__device__ __forceinline__ unsigned xb_add(unsigned* p, unsigned v) { return __hip_atomic_fetch_add(p, v, __ATOMIC_RELAXED, __HIP_MEMORY_SCOPE_AGENT); }
__device__ __forceinline__ unsigned xb_xcc_id() { return (unsigned)__builtin_amdgcn_s_getreg((3 << 11) | 20) & 0xFu; }
#define XB_SPIN(cond, bar) do { unsigned _sp = 0; while (cond) { __builtin_amdgcn_s_sleep(1); \
    if ((++_sp & 255u) == 0u) { if (xb_ld(&(bar)[XB_TMO])) break; if (_sp > XB_SPIN_CAP) { atomicAdd(&(bar)[XB_TMO], 1u); break; } } } } while (0)
struct XcdBarrier { unsigned* bar; unsigned x; volatile LAS unsigned* st; };
__device__ __forceinline__ XcdBarrier xcd_barrier_post(unsigned* bar, volatile LAS unsigned* st) {
    XcdBarrier b; b.bar = bar; b.x = xb_xcc_id(); b.st = st;
    if (threadIdx.x == 0) (void)xb_add(&bar[XB_XCNT(b.x)], 1u);
    return b;
}
__device__ __forceinline__ void xcd_barrier_complete(unsigned* bar, unsigned x, unsigned& nloc, unsigned& nx) {
    const unsigned G = gridDim.x * gridDim.y * gridDim.z;
    unsigned sum, cnt, mine, sp = 0u;
    for (;;) {
        sum = 0u; cnt = 0u; mine = 0u;
#pragma unroll
        for (unsigned j = 0; j < 16; ++j) { const unsigned c = xb_ld(&bar[XB_XCNT(j)]); sum += c; cnt += (c > 0u) ? 1u : 0u; mine = (j == x) ? c : mine; }
        if (sum == G) break;
        __builtin_amdgcn_s_sleep(1);
        if ((++sp & 255u) == 0u) { if (xb_ld(&bar[XB_TMO])) break; if (sp > XB_SPIN_CAP) { atomicAdd(&bar[XB_TMO], 1u); break; } }
    }
    nloc = mine > 0u ? mine : 1u; nx = cnt > 0u ? cnt : 1u;
}
__device__ __forceinline__ void xcd_barrier(const XcdBarrier& b) {
    asm volatile("s_waitcnt vmcnt(0)" ::: "memory");
    __syncthreads();
    if (threadIdx.x == 0) {
        unsigned* bar = b.bar;
        __builtin_amdgcn_s_waitcnt(0);
        unsigned nloc = b.st[0], nx = b.st[1];
        if (nloc == 0u) { xcd_barrier_complete(bar, b.x, nloc, nx); b.st[0] = nloc; b.st[1] = nx; }
        const unsigned old = xb_add(&bar[XB_XSUB(b.x)], 1u);
        const unsigned gen = old / nloc;
        if (old + 1u == (gen + 1u) * nloc) {
            __builtin_amdgcn_fence(__ATOMIC_RELEASE, "agent");
            asm volatile("s_waitcnt vmcnt(0)" ::: "memory");
            const unsigned og = xb_add(&bar[XB_TOP], 1u);
            const unsigned tg = og / nx;
            if (og + 1u == (tg + 1u) * nx) xb_add(&bar[XB_TOPGEN], 1u);
            else XB_SPIN(xb_ld(&bar[XB_TOPGEN]) == tg, bar);
            __builtin_amdgcn_fence(__ATOMIC_ACQUIRE, "agent");
            xb_add(&bar[XB_XGEN(b.x)], 1u);
            asm volatile("s_waitcnt vmcnt(0)" ::: "memory");
        } else {
            XB_SPIN(xb_ld(&bar[XB_XGEN(b.x)]) == gen, bar);
            __builtin_amdgcn_fence(__ATOMIC_ACQUIRE, "agent");
            asm volatile("s_waitcnt vmcnt(0)" ::: "memory");
        }
    }
    __syncthreads();
}

__global__ void __launch_bounds__(512, 2) mega(Params p) {
    extern __shared__ __attribute__((aligned(16))) unsigned char shm[];
    cg::grid_group grid = cg::this_grid();
    LAS unsigned char* lds = (LAS unsigned char*)shm;
    volatile LAS unsigned* bst = (volatile LAS unsigned*)(lds + LDS_BYTES - 16);
    if (threadIdx.x == 0) { bst[0] = 0u; bst[1] = 0u; }
    __syncthreads();
    const XcdBarrier xbar = xcd_barrier_post((unsigned*)(p.ws + WS_BAR), bst);
    if (p.ph_hi > 1000) grid.sync();
    const int lo = p.ph_lo, hi = p.ph_hi;
#define IN(k) (lo <= (k) && (k) < hi)
#define REP(k) for (int _r = 0; _r < ((k) == DUP_PHASE ? 2 : 1); ++_r)
#define SEAM(k) do { if (IN(k) && IN((k) + 1)) xcd_barrier(xbar); } while (0)
    if (IN(0)) REP(0) { if (_r) xcd_barrier(xbar); phase0(p, shm); }
    SEAM(0);
    if (IN(1)) REP(1) { if (_r) xcd_barrier(xbar);
        pg8::Gemm g{(const bf16_t*)(p.ws + WS_H), (const bf16_t*)(p.ws + WS_WB1), S_, NAUG, 2048};
        pg8::StaticOrder so; so.init(g.M, g.N, (int)gridDim.x, (int)blockIdx.x);
        pg8::EpiBf16 E{(bf16_t*)(p.ws + WS_PROJ), NAUG};
        pg8::gemm_phase(lds, g, so, E);
    }
    SEAM(1);
    if (IN(2)) REP(2) { if (_r) xcd_barrier(xbar);
        phase_prepM(p, lds);
        phase_prepE(p);
    }
    SEAM(2);
    if (IN(3)) REP(3) { if (_r) xcd_barrier(xbar); phase_chunkA(p, lds); }
    SEAM(3);
    if (IN(4)) REP(4) { if (_r) xcd_barrier(xbar); if (blockIdx.x < 64) phase_seq(p);
        else { const int bid = blockIdx.x - 64, nblk = gridDim.x - 64;
            convert_fp8(p.in[23], p.ws + WS_UB, (size_t)16384 * 2048, U8_SCALE, p.in[20], bid, nblk);
            convert_fp8(p.in[24], p.ws + WS_VB, (size_t)16384 * 2048, V8_SCALE, nullptr, bid, nblk);
            build_wpt(p.in[21], p.in[20], (const bf16_t*)(p.ws + WS_KEYB), (bf16_t*)(p.ws + WS_WQT), bid, nblk);
            transpose_convert(p.in[19], 2048, 2048, (bf16_t*)(p.ws + WS_WOT), (float*)shm, bid, nblk); } }
    SEAM(4);
    if (IN(5)) REP(5) { if (_r) xcd_barrier(xbar); phase_chunkY(p, lds); }
    SEAM(5);
    if (IN(6)) REP(6) { if (_r) xcd_barrier(xbar);
        pg8::Gemm g{(const bf16_t*)(p.ws + WS_YMIX), (const bf16_t*)(p.ws + WS_WOT), S_, 2048, 2048};
        pg8::StaticOrder so; so.init(g.M, g.N, (int)gridDim.x, (int)blockIdx.x);
        pg8::EpiRes2 E{(float*)(p.ws + WS_X1), p.in[0], (bf16_t*)(p.ws + WS_H2), (float*)(p.ws + WS_SSQ), 2048};
        pg8::gemm_phase(lds, g, so, E);
    }
    SEAM(6);
    if (IN(8)) REP(8) { if (_r) xcd_barrier(xbar);
        pg8::Gemm g{(const bf16_t*)(p.ws + WS_H2), (const bf16_t*)(p.ws + WS_WQT), S_, 2048, 2048};
        pg8::StaticOrder so; so.init(g.M, g.N, (int)gridDim.x, (int)blockIdx.x);
        pg8::EpiRowScaleF32 E{(float*)(p.ws + WS_Q), (const float*)(p.ws + WS_SSQ), 2048};
        pg8::gemm_phase(lds, g, so, E);
    }
    SEAM(8);
    if (IN(9)) REP(9) { if (_r) xcd_barrier(xbar); phase_topk(p, shm); }
    SEAM(9);
    if (IN(10)) REP(10) { if (_r) xcd_barrier(xbar); phase_gather(p, shm); }
#undef IN
#undef REP
#undef SEAM
}

extern "C" void kernel_launch(void* const* d_in, const int* in_sizes, int n_in, void* d_out, int out_size, void* d_ws, size_t ws_size, hipStream_t stream) {
    static int grid_blocks = 0;
    if (grid_blocks == 0) {
        if (n_in != 26 || ws_size < WS_NEED) { fprintf(stderr, "kernel_launch: unexpected n_in %d / ws_size %zu\n", n_in, ws_size); grid_blocks = -1; return; }
        int dev = 0, cus = 0, per_cu = 0;
        (void)hipGetDevice(&dev);
        (void)hipDeviceGetAttribute(&cus, hipDeviceAttributeMultiprocessorCount, dev);
        (void)hipFuncSetAttribute((const void*)mega, hipFuncAttributeMaxDynamicSharedMemorySize, LDS_BYTES);
        (void)hipOccupancyMaxActiveBlocksPerMultiprocessor(&per_cu, (const void*)mega, 512, LDS_BYTES);
        if (per_cu < 1) { fprintf(stderr, "kernel_launch: occupancy query says %d blocks/CU\n", per_cu); per_cu = 1; }
        grid_blocks = cus * per_cu;
        fprintf(stderr, "kernel_launch: cus %d per_cu %d grid %d\n", cus, per_cu, grid_blocks);
    }
    if (grid_blocks < 0) return;
    Params p{};
    for (int i = 0; i < 26; ++i) p.in[i] = (const float*)d_in[i];
    p.out = (float*)d_out; p.ws = (unsigned char*)d_ws;
#if MULTI_LAUNCH
    for (int ph = 0; ph < NPHASE; ++ph) {
        p.ph_lo = ph; p.ph_hi = ph + 1;
        hipLaunchKernelGGL(mega, dim3(grid_blocks), dim3(512), LDS_BYTES, stream, p);
    }
#else
    p.ph_lo = 0; p.ph_hi = NPHASE;
    if (hipMemsetAsync((unsigned char*)d_ws + WS_BAR, 0, XCD_BAR_WORDS * 4, stream) != hipSuccess) fprintf(stderr, "kernel_launch: barrier memset failed\n");
    void* args[] = {&p};
    hipError_t e = hipLaunchCooperativeKernel((const void*)mega, dim3(grid_blocks), dim3(512), args, LDS_BYTES, stream);
    if (e != hipSuccess) fprintf(stderr, "cooperative launch failed: %s (grid %d)\n", hipGetErrorString(e), grid_blocks);
#endif
}
```

```cpp
#include <hip/hip_runtime.h>
#include <hip/hip_cooperative_groups.h>
#include <cstdio>
namespace cg = cooperative_groups;

#ifndef DUP_PHASE
#define DUP_PHASE -1
#endif
#ifndef MULTI_LAUNCH
#define MULTI_LAUNCH 0
#endif

#define LAS __attribute__((address_space(3)))
typedef unsigned short bf16_t;
typedef short bf16x8 __attribute__((ext_vector_type(8)));
typedef float f32x4 __attribute__((ext_vector_type(4)));
typedef float f32x2 __attribute__((ext_vector_type(2)));
typedef unsigned u32x4 __attribute__((ext_vector_type(4)));
typedef unsigned u32x2 __attribute__((ext_vector_type(2)));

constexpr int S_ = 16384, D_ = 2048, DR = 1024, NAUG = 6912;
constexpr size_t MiB = 1ull << 20;
constexpr size_t WS_PROJ = 0, WS_H = 216 * MiB, WS_WB1 = 280 * MiB, WS_WQT = 280 * MiB, WS_WOT = 296 * MiB;
constexpr size_t WS_R = 307 * MiB, WS_K = 339 * MiB, WS_V = 371 * MiB, WS_KK = 403 * MiB, WS_A = 435 * MiB, WS_LW = 467 * MiB;
constexpr size_t WS_G = 216 * MiB, WS_YC = 248 * MiB, WS_YMIX = 307 * MiB, WS_X1 = 0, WS_H2 = 128 * MiB, WS_Q = 307 * MiB;
constexpr size_t WS_GT = 0, WS_HT = 32 * MiB, WS_QE = 96 * MiB, WS_YL = 128 * MiB, WS_S0 = 160 * MiB;
constexpr size_t WS_IDS = 192 * MiB, WS_GATES = 200 * MiB, WS_UB = 467 * MiB, WS_VB = 435 * MiB, WS_BON = 500 * MiB, WS_BAR = 502 * MiB, WS_KEYB = 503 * MiB, WS_SSQ = 504 * MiB, WS_NEED = 506 * MiB;
constexpr size_t WS_W2T = 499 * MiB, WS_A2T = WS_W2T + 131072, WS_G2T = WS_A2T + 131072;
constexpr int TLD = 72, TSLOT = 64 * TLD * 2;
constexpr int LDS_BYTES = 16 * TSLOT + 2048 + 256 + 16;
constexpr int NPHASE = 11;

struct Params {
    const float* in[26];
    float* out;
    unsigned char* ws;
    int ph_lo, ph_hi;
};

__device__ __forceinline__ float bf2f(bf16_t b) { return __uint_as_float(((unsigned)b) << 16); }
__device__ __forceinline__ bf16_t f2bf(float f) { unsigned u = __float_as_uint(f); u += 0x7FFFu + ((u >> 16) & 1u); return (bf16_t)(u >> 16); }
typedef __bf16 bf16v2_t __attribute__((ext_vector_type(2)));
__device__ __forceinline__ unsigned cvt_pk_bf16(float lo, float hi) { const f32x2 v = {lo, hi}; const bf16v2_t r = __builtin_convertvector(v, bf16v2_t); return __builtin_bit_cast(unsigned, r); }
__device__ __forceinline__ u32x4 pack8(const float* f) { u32x4 w; w.x = cvt_pk_bf16(f[0], f[1]); w.y = cvt_pk_bf16(f[2], f[3]); w.z = cvt_pk_bf16(f[4], f[5]); w.w = cvt_pk_bf16(f[6], f[7]); return w; }
__device__ __forceinline__ float lo_bf(unsigned w) { return __uint_as_float(w << 16); }
__device__ __forceinline__ float hi_bf(unsigned w) { return __uint_as_float(w & 0xffff0000u); }
__device__ __forceinline__ void unpack8(const u32x4 v, float* f) {
#pragma unroll
    for (int i = 0; i < 4; ++i) { f[2 * i] = lo_bf(v[i]); f[2 * i + 1] = hi_bf(v[i]); }
}
__device__ __forceinline__ float wave_sum(float v) {
#pragma unroll
    for (int o = 32; o; o >>= 1) v += __shfl_xor(v, o);
    return v;
}
template <int CTRL, int RM> __device__ __forceinline__ float dpp_f(float v) { return __int_as_float(__builtin_amdgcn_update_dpp(0, __float_as_int(v), CTRL, RM, 0xf, false)); }
__device__ __forceinline__ float wave_sum_dpp(float v) {
    v += dpp_f<0xB1, 0xf>(v); v += dpp_f<0x4E, 0xf>(v); v += dpp_f<0x141, 0xf>(v); v += dpp_f<0x140, 0xf>(v);
    v += dpp_f<0x142, 0xa>(v); v += dpp_f<0x143, 0xc>(v);
    return __int_as_float(__builtin_amdgcn_readlane(__float_as_int(v), 63));
}
__device__ __forceinline__ float wave_max(float v) {
#pragma unroll
    for (int o = 32; o; o >>= 1) v = fmaxf(v, __shfl_xor(v, o));
    return v;
}
__device__ __forceinline__ float sigmoidf_(float x) { return 1.0f / (1.0f + __expf(-x)); }
__device__ __forceinline__ float gelu_tanh(float x) { float u = 0.7978845608028654f * (x + 0.044715f * x * x * x); return 0.5f * x * (1.0f + tanhf(u)); }

namespace pg8 {
constexpr int BM = 256, BK = 64, HALF = 128, HTB = HALF * BK * 2, STAGE_BYTES = 8 * HTB, NXCD = 8, WGM = 8;
__device__ __forceinline__ int lds_byte(int r, int c) { const int st = (r >> 4) * 2 + (c >> 5), rr = r & 15, cc = c & 31, ob = rr * 64 + cc * 2; return st * 1024 + (ob ^ (((ob >> 9) & 1) << 5)); }
__device__ __forceinline__ void stage_rc(int b, int& R, int& C) { const int st = b / 1024, sb = b % 1024, swz = sb ^ (((sb >> 9) & 1) << 5); R = (st >> 1) * 16 + swz / 64; C = (st & 1) * 32 + (swz % 64) / 2; }
__device__ __forceinline__ int perm32(int rho) { const int n = rho >> 4, i = rho & 15; return 8 * (i >> 2) + 4 * n + (i & 3); }
struct Unit { int pm, pn; };
struct Gemm { const bf16_t* A; const bf16_t* Bt; int M, N, K; };
struct StaticOrder {
    int nM, nN, nwg, G, c;
    __device__ void init(int M, int N, int G_, int c_) { nM = M / BM; nN = N / BM; nwg = nM * nN; G = G_; c = c_; }
    __device__ bool next(int i, Unit& u) const {
        const long L = (long)i * G + c; if (L >= nwg) return false;
        int wgid = (int)L; { const int q = nwg / NXCD, r = nwg % NXCD, xcd = wgid % NXCD, off = wgid / NXCD; wgid = (xcd < r ? xcd * (q + 1) : r * (q + 1) + (xcd - r) * q) + off; }
        const int nig = WGM * nN, gid = wgid / nig, fm = gid * WGM, gsz = (nM - fm) < WGM ? (nM - fm) : WGM;
        u.pm = fm + ((wgid % nig) % gsz); u.pn = (wgid % nig) / gsz; return true;
    }
    __device__ __forceinline__ void a_ready(const Unit&) const {}
    __device__ __forceinline__ void done(const Unit&) const {}
};
struct EpiResF32 {
    static constexpr bool PERM = false;
    float* C; const float* Res; int ldc;
    __device__ __forceinline__ void operator()(const f32x4 (&acc)[2][2][4][2], const Unit& u, int wr, int wc, int fr, int fq) const {
        const int row0 = u.pm * BM + wr * 64 + fr, col0 = u.pn * BM + wc * 32 + 4 * fq;
#pragma unroll
        for (int ai = 0; ai < 2; ++ai)
#pragma unroll
            for (int m = 0; m < 4; ++m) { const size_t ro = (size_t)(row0 + ai * HALF + m * 16) * ldc + col0;
#pragma unroll
                for (int bj = 0; bj < 2; ++bj)
#pragma unroll
                    for (int n = 0; n < 2; ++n) { const f32x4 rs = *(const f32x4*)(Res + ro + bj * HALF + n * 16); *(f32x4*)(C + ro + bj * HALF + n * 16) = acc[ai][bj][m][n] + rs; } }
    }
};
struct EpiRes2 {
    static constexpr bool PERM = false;
    float* C; const float* Res; bf16_t* Cb; float* SSQ; int ldc;
    __device__ __forceinline__ void operator()(const f32x4 (&acc)[2][2][4][2], const Unit& u, int wr, int wc, int fr, int fq) const {
        const int row0 = u.pm * BM + wr * 64 + fr, col0 = u.pn * BM + wc * 32 + 4 * fq;
#pragma unroll
        for (int ai = 0; ai < 2; ++ai)
#pragma unroll
            for (int m = 0; m < 4; ++m) { const int row = row0 + ai * HALF + m * 16; const size_t ro = (size_t)row * ldc + col0; float ss = 0.f;
#pragma unroll
                for (int bj = 0; bj < 2; ++bj)
#pragma unroll
                    for (int n = 0; n < 2; ++n) { const f32x4 v = acc[ai][bj][m][n] + *(const f32x4*)(Res + ro + bj * HALF + n * 16);
                        *(f32x4*)(C + ro + bj * HALF + n * 16) = v;
                        u32x2 wv; wv.x = cvt_pk_bf16(v[0], v[1]); wv.y = cvt_pk_bf16(v[2], v[3]); *(u32x2*)(Cb + ro + bj * HALF + n * 16) = wv;
                        ss += v[0] * v[0] + v[1] * v[1] + v[2] * v[2] + v[3] * v[3]; }
                ss += __shfl_xor(ss, 16); ss += __shfl_xor(ss, 32);
                if (fq == 0) SSQ[(size_t)row * 32 + u.pn * 4 + wc] = ss; }
    }
};
struct EpiRowScaleF32 {
    static constexpr bool PERM = false;
    float* C; const float* SSQ; int ldc;
    __device__ __forceinline__ void operator()(const f32x4 (&acc)[2][2][4][2], const Unit& u, int wr, int wc, int fr, int fq) const {
        const int row0 = u.pm * BM + wr * 64 + fr, col0 = u.pn * BM + wc * 32 + 4 * fq;
#pragma unroll
        for (int ai = 0; ai < 2; ++ai)
#pragma unroll
            for (int m = 0; m < 4; ++m) { const int row = row0 + ai * HALF + m * 16; const size_t ro = (size_t)row * ldc + col0;
                const f32x4* sp = (const f32x4*)(SSQ + (size_t)row * 32); float sq = 0.f;
#pragma unroll
                for (int q = 0; q < 8; ++q) { const f32x4 v = sp[q]; sq += (v[0] + v[1]) + (v[2] + v[3]); }
                const float rs = rsqrtf(sq * (1.0f / 2048.0f) + 1e-6f);
#pragma unroll
                for (int bj = 0; bj < 2; ++bj)
#pragma unroll
                    for (int n = 0; n < 2; ++n) *(f32x4*)(C + ro + bj * HALF + n * 16) = acc[ai][bj][m][n] * rs; }
    }
};
struct EpiF32 {
    static constexpr bool PERM = false;
    float* C; int ldc;
    __device__ __forceinline__ void operator()(const f32x4 (&acc)[2][2][4][2], const Unit& u, int wr, int wc, int fr, int fq) const {
        const int row0 = u.pm * BM + wr * 64 + fr, col0 = u.pn * BM + wc * 32 + 4 * fq;
#pragma unroll
        for (int ai = 0; ai < 2; ++ai)
#pragma unroll
            for (int m = 0; m < 4; ++m) { const size_t ro = (size_t)(row0 + ai * HALF + m * 16) * ldc + col0;
#pragma unroll
                for (int bj = 0; bj < 2; ++bj)
#pragma unroll
                    for (int n = 0; n < 2; ++n) *(f32x4*)(C + ro + bj * HALF + n * 16) = acc[ai][bj][m][n]; }
    }
};
struct EpiBf16 {
    static constexpr bool PERM = true;
    bf16_t* O; int ldc;
    __device__ __forceinline__ void operator()(const f32x4 (&acc)[2][2][4][2], const Unit& u, int wr, int wc, int fr, int fq) const {
        const int row0 = u.pm * BM + wr * 64 + fr; const int col0 = u.pn * BM + wc * 32 + 8 * fq;
#pragma unroll
        for (int ai = 0; ai < 2; ++ai)
#pragma unroll
            for (int m = 0; m < 4; ++m) { bf16_t* rowp = O + (size_t)(row0 + ai * HALF + m * 16) * ldc + col0;
#pragma unroll
                for (int bj = 0; bj < 2; ++bj) { const f32x4 v0 = acc[ai][bj][m][0], v1 = acc[ai][bj][m][1];
                    u32x4 w; w.x = cvt_pk_bf16(v0[0], v0[1]); w.y = cvt_pk_bf16(v0[2], v0[3]); w.z = cvt_pk_bf16(v1[0], v1[1]); w.w = cvt_pk_bf16(v1[2], v1[3]);
                    *(u32x4*)(rowp + bj * HALF) = w; } }
    }
};

template <class Epi, class Sched>
__device__ __forceinline__ void gemm_phase(LAS unsigned char* lds, const Gemm g, const Sched& S, const Epi& E) {
    const int tid = threadIdx.x, wid = __builtin_amdgcn_readfirstlane(tid >> 6), lane = tid & 63, wr = wid >> 2, wc = wid & 3, fr = lane & 15, fq = lane >> 4;
    const int K = g.K, nt = K / BK;
    unsigned voffA[2], voffB[2];
#pragma unroll
    for (int i = 0; i < 2; ++i) { int R, C; stage_rc(tid * 16 + i * 8192, R, C); const int Rb = Epi::PERM ? ((R & ~31) + perm32(R & 31)) : R;
        voffA[i] = (unsigned)(R * K + C) * 2u; voffB[i] = (unsigned)(Rb * K + C) * 2u; }
    const size_t kstep = (size_t)(BK * 2);
    const size_t hstep = (size_t)HALF * K * 2;
    const size_t tstep = 2 * hstep;
    const unsigned ldsw = (unsigned)wid * 1024u;
    const int aoff = lds_byte(wr * 64 + fr, fq * 8), boff = lds_byte(wc * 32 + fr, fq * 8);
#define PG8_SA(b, h) (((b) * 2 + (h)) * HTB)
#define PG8_SB(b, h) ((4 + (b) * 2 + (h)) * HTB)
#define PG8_STAGE(bufoff, gbase, voff) do { _Pragma("unroll") for (int _i = 0; _i < 2; ++_i) \
        __builtin_amdgcn_global_load_lds((const unsigned*)((const char*)(gbase) + (voff)[_i]), (LAS unsigned*)(lds + (bufoff) + ldsw + _i * 8192), 16, 0, 0); } while (0)
#define PG8_LDA(dst, b, h) do { _Pragma("unroll") for (int m = 0; m < 4; ++m) _Pragma("unroll") for (int k = 0; k < 2; ++k) dst[m][k] = *(const LAS bf16x8*)(lds + PG8_SA(b, h) + aoff + m * 2048 + k * 1024); } while (0)
#define PG8_LDB(dst, b, h) do { _Pragma("unroll") for (int n = 0; n < 2; ++n) _Pragma("unroll") for (int k = 0; k < 2; ++k) dst[n][k] = *(const LAS bf16x8*)(lds + PG8_SB(b, h) + boff + n * 2048 + k * 1024); } while (0)
#define PG8_MMA(ai, bj, At, Bt) do { __builtin_amdgcn_s_setprio(1); _Pragma("unroll") for (int m = 0; m < 4; ++m) _Pragma("unroll") for (int n = 0; n < 2; ++n) _Pragma("unroll") for (int k = 0; k < 2; ++k) \
        acc[ai][bj][m][n] = __builtin_amdgcn_mfma_f32_16x16x32_bf16(Bt[n][k], At[m][k], acc[ai][bj][m][n], 0, 0, 0); __builtin_amdgcn_s_setprio(0); } while (0)
#define PG8_WAIT_V(n) asm volatile("s_waitcnt vmcnt(" #n ")" ::: "memory")
#define PG8_WAIT_L(n) asm volatile("s_waitcnt lgkmcnt(" #n ")" ::: "memory")
#define PG8_BAR __builtin_amdgcn_s_barrier()
#define PG8_SCHED __builtin_amdgcn_sched_barrier(0)
    Unit cur, nxt; int ui = 0;
    if (!S.next(0, cur)) return;
    f32x4 acc[2][2][4][2];
#pragma unroll
    for (int a = 0; a < 2; ++a)
#pragma unroll
        for (int b = 0; b < 2; ++b)
#pragma unroll
            for (int m = 0; m < 4; ++m)
#pragma unroll
                for (int n = 0; n < 2; ++n) acc[a][b][m][n] = (f32x4){0.f, 0.f, 0.f, 0.f};
    bf16x8 At[4][2], B0[2][2], B1[2][2];
    const char* cA = (const char*)g.A + (size_t)cur.pm * tstep; const char* cB = (const char*)g.Bt + (size_t)cur.pn * tstep;
    S.a_ready(cur);
    PG8_STAGE(PG8_SB(0, 0), cB, voffB); PG8_STAGE(PG8_SA(0, 0), cA, voffA); PG8_STAGE(PG8_SB(0, 1), cB + hstep, voffB); PG8_STAGE(PG8_SA(0, 1), cA + hstep, voffA);
    if (wr == 1) PG8_BAR;
    PG8_WAIT_V(4); PG8_BAR;
    PG8_STAGE(PG8_SB(1, 0), cB + kstep, voffB); PG8_STAGE(PG8_SA(1, 0), cA + kstep, voffA); PG8_STAGE(PG8_SB(1, 1), cB + hstep + kstep, voffB);
    PG8_WAIT_V(6); PG8_BAR;
    for (;;) {
        const bool has_next = S.next(ui + 1, nxt);
        const char* nA = has_next ? (const char*)g.A + (size_t)nxt.pm * tstep : cA; const char* nB = has_next ? (const char*)g.Bt + (size_t)nxt.pn * tstep : cB;
        for (int t = 0; t < nt; t += 2) {
            const bool last = (t == nt - 2);
            const char* a1 = cA + (size_t)(t + 1) * kstep;
            const char* a2 = last ? nA : cA + (size_t)(t + 2) * kstep; const char* b2 = last ? nB : cB + (size_t)(t + 2) * kstep;
            const char* a3 = a2 + kstep; const char* b3 = b2 + kstep;
            if (last && has_next) S.a_ready(nxt);
            PG8_LDB(B0, 0, 0); PG8_SCHED; PG8_LDA(At, 0, 0); PG8_STAGE(PG8_SA(1, 1), a1 + hstep, voffA);
            PG8_WAIT_L(8); PG8_BAR; PG8_WAIT_L(0); PG8_MMA(0, 0, At, B0); PG8_BAR; PG8_SCHED;
            PG8_LDB(B1, 0, 1); PG8_STAGE(PG8_SB(0, 0), b2, voffB);
            PG8_BAR; PG8_WAIT_L(0); PG8_MMA(0, 1, At, B1); PG8_BAR;
            PG8_LDA(At, 0, 1); PG8_STAGE(PG8_SA(0, 0), a2, voffA);
            PG8_BAR; PG8_WAIT_L(0); PG8_MMA(1, 0, At, B0); PG8_BAR; PG8_SCHED;
            PG8_STAGE(PG8_SB(0, 1), b2 + hstep, voffB);
            PG8_WAIT_V(6); PG8_BAR; PG8_MMA(1, 1, At, B1); PG8_BAR;
            PG8_LDB(B0, 1, 0); PG8_SCHED; PG8_LDA(At, 1, 0); PG8_STAGE(PG8_SA(0, 1), a2 + hstep, voffA);
            PG8_WAIT_L(8); PG8_BAR; PG8_WAIT_L(0); PG8_MMA(0, 0, At, B0); PG8_BAR; PG8_SCHED;
            PG8_LDB(B1, 1, 1); PG8_STAGE(PG8_SB(1, 0), b3, voffB);
            PG8_BAR; PG8_WAIT_L(0); PG8_MMA(0, 1, At, B1); PG8_BAR;
            PG8_LDA(At, 1, 1); PG8_STAGE(PG8_SA(1, 0), a3, voffA);
            PG8_BAR; PG8_WAIT_L(0); PG8_MMA(1, 0, At, B0); PG8_BAR; PG8_SCHED;
            PG8_STAGE(PG8_SB(1, 1), b3 + hstep, voffB);
            PG8_WAIT_V(6); PG8_BAR; PG8_MMA(1, 1, At, B1); PG8_BAR;
        }
        E(acc, cur, wr, wc, fr, fq); S.done(cur);
        if (!has_next) break;
#pragma unroll
        for (int a = 0; a < 2; ++a)
#pragma unroll
            for (int b = 0; b < 2; ++b)
#pragma unroll
                for (int m = 0; m < 4; ++m)
#pragma unroll
                    for (int n = 0; n < 2; ++n) acc[a][b][m][n] = (f32x4){0.f, 0.f, 0.f, 0.f};
        cur = nxt; cA = nA; cB = nB; ++ui;
    }
    PG8_WAIT_V(0);
    if (wr == 0) PG8_BAR;
    PG8_BAR;
#undef PG8_SA
#undef PG8_SB
#undef PG8_STAGE
#undef PG8_LDA
#undef PG8_LDB
#undef PG8_MMA
#undef PG8_WAIT_V
#undef PG8_WAIT_L
#undef PG8_BAR
#undef PG8_SCHED
}
}

__device__ __forceinline__ void rmsnorm_rows(const float* X, const float* gain, bf16_t* H) {
    const int wave = threadIdx.x >> 6, lane = threadIdx.x & 63;
    for (int row = blockIdx.x * 8 + wave; row < S_; row += gridDim.x * 8) {
        const float4* xr = (const float4*)(X + (size_t)row * D_);
        float4 v[8]; float ss = 0.f;
#pragma unroll
        for (int i = 0; i < 8; ++i) { v[i] = xr[i * 64 + lane]; ss += v[i].x * v[i].x + v[i].y * v[i].y + v[i].z * v[i].z + v[i].w * v[i].w; }
        ss = wave_sum(ss);
        const float sc = rsqrtf(ss * (1.0f / 2048.0f) + 1e-6f);
#pragma unroll
        for (int i = 0; i < 8; ++i) { const float4 g = ((const float4*)gain)[i * 64 + lane];
            u32x2 w; w.x = cvt_pk_bf16(v[i].x * sc * g.x, v[i].y * sc * g.y); w.y = cvt_pk_bf16(v[i].z * sc * g.z, v[i].w * sc * g.w);
            *(u32x2*)(H + (size_t)row * D_ + (i * 64 + lane) * 4) = w; }
    }
}

__device__ __forceinline__ void transpose_convert(const float* W, int K, int N, bf16_t* Bt, float* tile, int bid, int nblk) {
    const int tid = threadIdx.x; const int tk = K / 64, tn = N / 64, nt = tk * tn;
    float4 rg[2];
#define TC_LOAD(u) do { const int _k0 = ((u) / tn) * 64, _n0 = ((u) % tn) * 64; _Pragma("unroll") for (int i = 0; i < 2; ++i) { const int idx = tid + 512 * i; \
        rg[i] = *(const float4*)(W + (size_t)(_k0 + (idx >> 4)) * N + _n0 + (idx & 15) * 4); } } while (0)
    if (bid < nt) TC_LOAD(bid);
    for (int u = bid; u < nt; u += nblk) {
        const int k0 = (u / tn) * 64, n0 = (u % tn) * 64;
        __syncthreads();
#pragma unroll
        for (int i = 0; i < 2; ++i) { const int idx = tid + 512 * i; float* q = tile + (idx >> 4) * 65 + (idx & 15) * 4; q[0] = rg[i].x; q[1] = rg[i].y; q[2] = rg[i].z; q[3] = rg[i].w; }
        __syncthreads();
        if (u + nblk < nt) TC_LOAD(u + nblk);
#pragma unroll
        for (int i = 0; i < 4; ++i) { const int nn = i * 16 + (tid >> 5), kp = (tid & 31) * 2;
            *(unsigned*)(Bt + (size_t)(n0 + nn) * K + k0 + kp) = cvt_pk_bf16(tile[kp * 65 + nn], tile[(kp + 1) * 65 + nn]); }
    }
#undef TC_LOAD
}

__device__ __forceinline__ void convert_flat(const float* src, bf16_t* dst, size_t n) {
    for (size_t i = ((size_t)blockIdx.x * 512 + threadIdx.x) * 8; i < n; i += (size_t)gridDim.x * 512 * 8) {
        const float4 a = *(const float4*)(src + i), b = *(const float4*)(src + i + 4);
        u32x4 w; w.x = cvt_pk_bf16(a.x, a.y); w.y = cvt_pk_bf16(a.z, a.w); w.z = cvt_pk_bf16(b.x, b.y); w.w = cvt_pk_bf16(b.z, b.w);
        *(u32x4*)(dst + i) = w;
    }
}

__device__ __forceinline__ void convert_fp8(const float* src, unsigned char* dst, size_t n, float sc, const float* colgain, int bid, int nblk) {
    const int lane = threadIdx.x & 63, wv = threadIdx.x >> 6;
    for (size_t base = ((size_t)bid * 8 + wv) * 1024; base < n; base += (size_t)nblk * 8 * 1024) {
        float4 a[4];
#pragma unroll
        for (int j = 0; j < 4; ++j) a[j] = *(const float4*)(src + base + (size_t)(j * 64 + lane) * 4);
#pragma unroll
        for (int j = 0; j < 4; ++j) { float4 gg = make_float4(sc, sc, sc, sc);
            if (colgain) { const float4 cgv = *(const float4*)(colgain + ((base + (size_t)(j * 64 + lane) * 4) & 2047)); gg.x *= cgv.x; gg.y *= cgv.y; gg.z *= cgv.z; gg.w *= cgv.w; }
            int x = __builtin_amdgcn_cvt_pk_fp8_f32(a[j].x * gg.x, a[j].y * gg.y, 0, false); x = __builtin_amdgcn_cvt_pk_fp8_f32(a[j].z * gg.z, a[j].w * gg.w, x, true);
            *(unsigned*)(dst + base + (size_t)(j * 64 + lane) * 4) = (unsigned)x; }
    }
}

__device__ __forceinline__ void build_wpt(const float* wq, const float* gain, const bf16_t* KEYB, bf16_t* WPT, int bid, int nblk) {
    const int w = threadIdx.x >> 6, lane = threadIdx.x & 63, fr = lane & 15, fq = lane >> 4;
    for (int task = bid * 8 + w; task < 16 * 128; task += nblk * 8) {
        const int g = task >> 7, kb = task & 127;
        f32x4 acc[8];
#pragma unroll
        for (int n = 0; n < 8; ++n) acc[n] = (f32x4){0.f, 0.f, 0.f, 0.f};
#pragma unroll 2
        for (int ks = 0; ks < 8; ++ks) {
            const float4* wp = (const float4*)(wq + (size_t)(kb * 16 + fr) * 4096 + g * 256 + ks * 32 + fq * 8);
            const float4 x0 = wp[0], x1 = wp[1]; const float gk = gain[kb * 16 + fr];
            u32x4 wv; wv.x = cvt_pk_bf16(x0.x * gk, x0.y * gk); wv.y = cvt_pk_bf16(x0.z * gk, x0.w * gk); wv.z = cvt_pk_bf16(x1.x * gk, x1.y * gk); wv.w = cvt_pk_bf16(x1.z * gk, x1.w * gk);
            const bf16x8 a = __builtin_bit_cast(bf16x8, wv);
#pragma unroll
            for (int n = 0; n < 8; ++n) {
                const bf16x8 b = *(const bf16x8*)(KEYB + (size_t)(g * 128 + n * 16 + fr) * 256 + ks * 32 + fq * 8);
                acc[n] = __builtin_amdgcn_mfma_f32_16x16x32_bf16(a, b, acc[n], 0, 0, 0);
            }
        }
#pragma unroll
        for (int n = 0; n < 8; ++n) { u32x2 o; o.x = cvt_pk_bf16(acc[n][0], acc[n][1]); o.y = cvt_pk_bf16(acc[n][2], acc[n][3]);
            *(u32x2*)(WPT + (size_t)(g * 128 + n * 16 + fr) * 2048 + kb * 16 + fq * 4) = o; }
    }
}

__device__ __forceinline__ void phase0(const Params& p, unsigned char* shm) {
    bf16_t* WB1 = (bf16_t*)(p.ws + WS_WB1);
    rmsnorm_rows(p.in[0], p.in[1], (bf16_t*)(p.ws + WS_H));
    transpose_convert(p.in[2], 2048, 6144, WB1, (float*)shm, blockIdx.x, gridDim.x);
    const float* mu = p.in[4]; const float* w1 = p.in[6]; const float* a1 = p.in[9]; const float* g1 = p.in[11];
    for (int idx = blockIdx.x * 512 + threadIdx.x; idx < 768 * 2048; idx += gridDim.x * 512) {
        const int j = idx >> 11, k = idx & 2047; float val = 0.f;
        if (j < 128) { const float m = mu[k], w = w1[k * 64 + (j & 63)]; val = (j < 64) ? w * (1.f - m) : w * m; }
        else if (j < 256) { const float m = mu[2048 + k], w = a1[k * 64 + (j & 63)]; val = (j < 192) ? w * (1.f - m) : w * m; }
        else if (j < 576) { const float m = mu[4096 + k]; const int jj = j - 256; const int c = jj < 160 ? jj : jj - 160; const float w = g1[k * 160 + c]; val = jj < 160 ? w * (1.f - m) : w * m; }
        WB1[(size_t)(6144 + j) * 2048 + k] = f2bf(val);
    }
    convert_flat(p.in[22], (bf16_t*)(p.ws + WS_KEYB), (size_t)8 * 2 * 128 * 256);
    bf16_t* W2T = (bf16_t*)(p.ws + WS_W2T); bf16_t* A2T = (bf16_t*)(p.ws + WS_A2T); bf16_t* G2T = (bf16_t*)(p.ws + WS_G2T);
    const float* w2 = p.in[7]; const float* a2 = p.in[10]; const float* g2 = p.in[12];
    for (int idx = blockIdx.x * 512 + threadIdx.x; idx < 1024 * 288; idx += gridDim.x * 512) {
        if (idx < 65536) { const int c = idx >> 6, j = idx & 63; W2T[idx] = f2bf(w2[j * 1024 + c]); }
        else if (idx < 131072) { const int i2 = idx - 65536; const int c = i2 >> 6, j = i2 & 63; A2T[i2] = f2bf(a2[j * 1024 + c]); }
        else { const int i2 = idx - 131072; const int c = i2 / 160, j = i2 % 160; G2T[i2] = f2bf(g2[j * 1024 + c]); }
    }
}

constexpr int ACT_LD = 296;
template <int KS, int KOFF, int KTOT, int KIND>
__device__ __forceinline__ void lora_stage(const LAS bf16_t* act, const bf16_t* WT, const float* bias, bf16_t* OUT, int t0, int w, int fr, int fq) {
#pragma unroll 1
    for (int nh = 0; nh < 2; ++nh) {
        f32x4 acc[4][4];
#pragma unroll
        for (int m = 0; m < 4; ++m)
#pragma unroll
            for (int n = 0; n < 4; ++n) acc[m][n] = (f32x4){0.f, 0.f, 0.f, 0.f};
        bf16x8 bfr[KS][4];
#pragma unroll
        for (int ks = 0; ks < KS; ++ks)
#pragma unroll
            for (int n = 0; n < 4; ++n) bfr[ks][n] = *(const bf16x8*)(WT + (size_t)(w * 128 + (nh * 4 + n) * 16 + fr) * KTOT + ks * 32 + fq * 8);
#pragma unroll
        for (int ks = 0; ks < KS; ++ks) {
            bf16x8 a[4];
#pragma unroll
            for (int m = 0; m < 4; ++m) a[m] = *(const LAS bf16x8*)(act + (m * 16 + fr) * ACT_LD + KOFF + ks * 32 + fq * 8);
#pragma unroll
            for (int n = 0; n < 4; ++n)
#pragma unroll
                for (int m = 0; m < 4; ++m) acc[m][n] = __builtin_amdgcn_mfma_f32_16x16x32_bf16(bfr[ks][n], a[m], acc[m][n], 0, 0, 0);
        }
#pragma unroll
        for (int n = 0; n < 4; ++n) {
            const int c = w * 128 + (nh * 4 + n) * 16 + fq * 4;
            float bs[4] = {0.f, 0.f, 0.f, 0.f};
            if (KIND < 2) { const float4 bv = *(const float4*)(bias + c); bs[0] = bv.x; bs[1] = bv.y; bs[2] = bv.z; bs[3] = bv.w; }
#pragma unroll
            for (int m = 0; m < 4; ++m) {
                float o[4];
#pragma unroll
                for (int j = 0; j < 4; ++j) {
                    const float val = acc[m][n][j];
                    if (KIND == 0) { const float x = -(bs[j] + val); const float sp = fmaxf(x, 0.f) + __logf(1.f + __expf(-fabsf(x))); o[j] = -__expf(-sp - 0.5f); }
                    else if (KIND == 1) o[j] = sigmoidf_(bs[j] + val);
                    else o[j] = val;
                }
                u32x2 wv; wv.x = cvt_pk_bf16(o[0], o[1]); wv.y = cvt_pk_bf16(o[2], o[3]);
                *(u32x2*)(OUT + (size_t)(t0 + m * 16 + fr) * DR + c) = wv;
            }
        }
    }
}
__device__ __forceinline__ void phase_prepM(const Params& p, LAS unsigned char* lds) {
    LAS bf16_t* act = (LAS bf16_t*)lds;
    const bf16_t* P = (const bf16_t*)(p.ws + WS_PROJ);
    const int tid = threadIdx.x, w = tid >> 6, lane = tid & 63, fr = lane & 15, fq = lane >> 4;
    for (int tile = blockIdx.x; tile < S_ / 64; tile += gridDim.x) {
        const int t0 = tile * 64;
        __syncthreads();
        for (int task = tid; task < 64 * 36; task += 512) {
            const int t = task / 36, j0 = (task % 36) * 8; const int tg = t0 + t;
            int ccur, cprev;
            if (j0 < 64) { ccur = 6144 + j0; cprev = 6208 + j0; }
            else if (j0 < 128) { ccur = 6272 + (j0 - 64); cprev = 6336 + (j0 - 64); }
            else { ccur = 6400 + (j0 - 128); cprev = 6560 + (j0 - 128); }
            float cu[8], pv[8], o8[8];
            unpack8(*(const u32x4*)(P + (size_t)tg * NAUG + ccur), cu);
            if (tg > 0) unpack8(*(const u32x4*)(P + (size_t)(tg - 1) * NAUG + cprev), pv);
            else {
#pragma unroll
                for (int i = 0; i < 8; ++i) pv[i] = 0.f;
            }
#pragma unroll
            for (int i = 0; i < 8; ++i) { const float sv = cu[i] + pv[i];
                o8[i] = j0 < 64 ? (1.f - 2.f / (1.f + __expf(2.f * sv))) : (j0 < 128 ? sv : sigmoidf_(sv)); }
            *(LAS u32x4*)(act + t * ACT_LD + j0) = pack8(o8);
        }
        __syncthreads();
        lora_stage<2, 0, 64, 0>(act, (const bf16_t*)(p.ws + WS_W2T), p.in[5], (bf16_t*)(p.ws + WS_LW), t0, w, fr, fq);
        lora_stage<2, 64, 64, 1>(act, (const bf16_t*)(p.ws + WS_A2T), p.in[8], (bf16_t*)(p.ws + WS_A), t0, w, fr, fq);
        lora_stage<5, 128, 160, 2>(act, (const bf16_t*)(p.ws + WS_G2T), nullptr, (bf16_t*)(p.ws + WS_G), t0, w, fr, fq);
    }
}

__device__ __forceinline__ void phase_prepE(const Params& p) {
    const bf16_t* P = (const bf16_t*)(p.ws + WS_PROJ);
    bf16_t* R = (bf16_t*)(p.ws + WS_R); bf16_t* Kk = (bf16_t*)(p.ws + WS_K); bf16_t* V = (bf16_t*)(p.ws + WS_V); bf16_t* KK = (bf16_t*)(p.ws + WS_KK); bf16_t* YC = (bf16_t*)(p.ws + WS_YC);
    const float* mu_rkv = p.in[3]; const float* k_k = p.in[13]; const float* cw = p.in[18];
    const int tid = threadIdx.x, cg = tid & 127, c0 = cg * 8, tgrp = tid >> 7;
    float mr[8], mk[8], mv[8], kkc[8], cw0[8], cw1[8], cw2[8];
#pragma unroll
    for (int i = 0; i < 8; ++i) { mr[i] = mu_rkv[c0 + i]; mk[i] = mu_rkv[1024 + c0 + i]; mv[i] = mu_rkv[2048 + c0 + i]; kkc[i] = k_k[c0 + i]; cw0[i] = cw[c0 + i]; cw1[i] = cw[1024 + c0 + i]; cw2[i] = cw[2048 + c0 + i]; }
    for (int run = blockIdx.x * 4 + tgrp; run < S_ / 16; run += gridDim.x * 4) {
        const int t0 = run * 16;
        float pr[8], pk[8], pv[8], u1[8], u2[8];
#pragma unroll
        for (int i = 0; i < 8; ++i) { pr[i] = 0.f; pk[i] = 0.f; pv[i] = 0.f; u1[i] = 0.f; u2[i] = 0.f; }
        if (t0 > 0) {
            const size_t o = (size_t)(t0 - 1) * NAUG + c0;
            unpack8(*(const u32x4*)(P + o), pr); unpack8(*(const u32x4*)(P + o + 1024), pk); unpack8(*(const u32x4*)(P + o + 2048), pv);
            float x[8], y[8];
            unpack8(*(const u32x4*)(P + o + 4096), x); unpack8(*(const u32x4*)(P + o + 5120), y);
#pragma unroll
            for (int i = 0; i < 8; ++i) u1[i] = x[i] * y[i];
            unpack8(*(const u32x4*)(P + o - NAUG + 4096), x); unpack8(*(const u32x4*)(P + o - NAUG + 5120), y);
#pragma unroll
            for (int i = 0; i < 8; ++i) u2[i] = x[i] * y[i];
        }
        u32x4 nx[6];
        { const size_t o = (size_t)t0 * NAUG + c0;
#pragma unroll
          for (int q = 0; q < 6; ++q) nx[q] = *(const u32x4*)(P + o + 1024 * q); }
#pragma unroll 1
        for (int t = 0; t < 16; ++t) {
            float cr[8], ck[8], cv[8], bg[8], cgt[8], xc[8];
            unpack8(nx[0], cr); unpack8(nx[1], ck); unpack8(nx[2], cv); unpack8(nx[3], bg); unpack8(nx[4], cgt); unpack8(nx[5], xc);
            { const size_t o = (size_t)(t0 + (t < 15 ? t + 1 : t)) * NAUG + c0;
#pragma unroll
              for (int q = 0; q < 6; ++q) nx[q] = *(const u32x4*)(P + o + 1024 * q); }
            float r[8], k[8], v[8], kkv[8], yc[8]; float ss = 0.f;
#pragma unroll
            for (int i = 0; i < 8; ++i) {
                r[i] = cr[i] + (pr[i] - cr[i]) * mr[i]; k[i] = ck[i] + (pk[i] - ck[i]) * mk[i]; v[i] = cv[i] + (pv[i] - cv[i]) * mv[i];
                pr[i] = cr[i]; pk[i] = ck[i]; pv[i] = cv[i];
                kkv[i] = k[i] * kkc[i]; ss += kkv[i] * kkv[i];
                const float u0 = cgt[i] * xc[i];
                yc[i] = bg[i] * (cw0[i] * u2[i] + cw1[i] * u1[i] + cw2[i] * u0);
                u2[i] = u1[i]; u1[i] = u0;
            }
            ss += dpp_f<0xB1, 0xf>(ss); ss += dpp_f<0x4E, 0xf>(ss); ss += dpp_f<0x141, 0xf>(ss);
            const float inv = 1.0f / fmaxf(sqrtf(ss), 1e-12f);
#pragma unroll
            for (int i = 0; i < 8; ++i) kkv[i] *= inv;
            const size_t oo = (size_t)(t0 + t) * DR + c0;
            *(u32x4*)(R + oo) = pack8(r); *(u32x4*)(Kk + oo) = pack8(k); *(u32x4*)(V + oo) = pack8(v); *(u32x4*)(KK + oo) = pack8(kkv); *(u32x4*)(YC + oo) = pack8(yc);
        }
    }
}

#define TILE(i) ((LAS bf16_t*)(lds + (i) * TSLOT))
__device__ __forceinline__ f32x4 mm_tile(f32x4 acc, const LAS bf16_t* A, const LAS bf16_t* Bt, int mi, int ni, int fr, int fq) {
#pragma unroll
    for (int ks = 0; ks < 2; ++ks) {
        const bf16x8 a = *(const LAS bf16x8*)(A + (mi * 16 + fr) * TLD + ks * 32 + fq * 8);
        const bf16x8 b = *(const LAS bf16x8*)(Bt + (ni * 16 + fr) * TLD + ks * 32 + fq * 8);
        acc = __builtin_amdgcn_mfma_f32_16x16x32_bf16(a, b, acc, 0, 0, 0);
    }
    return acc;
}
__device__ __forceinline__ void st_rm(LAS bf16_t* X, f32x4 v, int mi, int ni, int fr, int fq) {
    const unsigned w0 = cvt_pk_bf16(v[0], v[1]), w1 = cvt_pk_bf16(v[2], v[3]);
    LAS bf16_t* q = X + (mi * 16 + fq * 4) * TLD + ni * 16 + fr;
    q[0] = (bf16_t)(w0 & 0xffffu); q[TLD] = (bf16_t)(w0 >> 16); q[2 * TLD] = (bf16_t)(w1 & 0xffffu); q[3 * TLD] = (bf16_t)(w1 >> 16);
}
__device__ __forceinline__ void st_tr(LAS bf16_t* XT, f32x4 v, int mi, int ni, int fr, int fq) {
    u32x2 w; w.x = cvt_pk_bf16(v[0], v[1]); w.y = cvt_pk_bf16(v[2], v[3]);
    *(LAS u32x2*)(XT + (ni * 16 + fr) * TLD + mi * 16 + fq * 4) = w;
}
__device__ __forceinline__ f32x4 ld_rm(const LAS bf16_t* X, int mi, int ni, int fr, int fq) {
    const LAS bf16_t* q = X + (mi * 16 + fq * 4) * TLD + ni * 16 + fr;
    return (f32x4){bf2f(q[0]), bf2f(q[TLD]), bf2f(q[2 * TLD]), bf2f(q[3 * TLD])};
}
__device__ __forceinline__ f32x4 ld_tr(const LAS bf16_t* XT, int mi, int ni, int fr, int fq) {
    const u32x2 w = *(const LAS u32x2*)(XT + (ni * 16 + fr) * TLD + mi * 16 + fq * 4);
    return (f32x4){lo_bf(w.x), hi_bf(w.x), lo_bf(w.y), hi_bf(w.y)};
}

__device__ __forceinline__ void phase_chunkA(const Params& p, LAS unsigned char* lds) {
    const int tid = threadIdx.x, w = tid >> 6, lane = tid & 63, fr = lane & 15, fq = lane >> 4;
    const int mi = w >> 1, nb = (w & 1) * 2;
    LAS float* cl = (LAS float*)(lds + 14 * TSLOT);
    LAS float* gs = (LAS float*)(lds + 16 * TSLOT);
    LAS float* wc = gs + 512;
    const bf16_t* R = (const bf16_t*)(p.ws + WS_R); const bf16_t* Kk = (const bf16_t*)(p.ws + WS_K); const bf16_t* V = (const bf16_t*)(p.ws + WS_V);
    const bf16_t* KK = (const bf16_t*)(p.ws + WS_KK); const bf16_t* A = (const bf16_t*)(p.ws + WS_A); const bf16_t* LW = (const bf16_t*)(p.ws + WS_LW);
    bf16_t* GT = (bf16_t*)(p.ws + WS_GT); float* HT = (float*)(p.ws + WS_HT); bf16_t* QE = (bf16_t*)(p.ws + WS_QE); bf16_t* YL = (bf16_t*)(p.ws + WS_YL);
    const f32x4 z4 = (f32x4){0.f, 0.f, 0.f, 0.f};
    const float* k_a = p.in[14]; const float* r_k = p.in[15]; float* BON = (float*)(p.ws + WS_BON);
    u32x4 nr4, nk4, nv4, nkk4, na4, nlw4;
#define CA_LOAD(it) do { const size_t _go = (size_t)(((it) >> 4) * 64 + (tid >> 3)) * DR + ((it) & 15) * 64 + (tid & 7) * 8; \
        nr4 = *(const u32x4*)(R + _go); nk4 = *(const u32x4*)(Kk + _go); nv4 = *(const u32x4*)(V + _go); nkk4 = *(const u32x4*)(KK + _go); na4 = *(const u32x4*)(A + _go); nlw4 = *(const u32x4*)(LW + _go); } while (0)
    for (int item = blockIdx.x; item < 4096; item += gridDim.x) {
        const int c = item >> 4, h = item & 15;
        const int t = tid >> 3, k0 = (tid & 7) * 8;
        if (item == (int)blockIdx.x) CA_LOAD(item);
        const u32x4 r4 = nr4, k4 = nk4, v4 = nv4, kk4 = nkk4, a4 = na4, lw4 = nlw4;
        __syncthreads();
        {
            float lwf8[8]; unpack8(lw4, lwf8);
            *(LAS f32x4*)(cl + t * 64 + k0) = (f32x4){lwf8[0], lwf8[1], lwf8[2], lwf8[3]};
            *(LAS f32x4*)(cl + t * 64 + k0 + 4) = (f32x4){lwf8[4], lwf8[5], lwf8[6], lwf8[7]};
            __syncthreads();
            const int g = w, k = lane;
            float pfx[8]; float run = 0.f;
#pragma unroll
            for (int i = 0; i < 8; ++i) { run += cl[(g * 8 + i) * 64 + k]; pfx[i] = run; }
            gs[g * 64 + k] = run;
            __syncthreads();
            float off = 0.f;
#pragma unroll
            for (int gg = 0; gg < 7; ++gg) { const float x = gs[gg * 64 + k]; off += (gg < g) ? x : 0.f; }
#pragma unroll
            for (int i = 0; i < 8; ++i) cl[(g * 8 + i) * 64 + k] = off + pfx[i];
            if (g == 7) wc[k] = __expf(off + pfx[7]);
            __syncthreads();
        }
        if (item + (int)gridDim.x < 4096) CA_LOAD(item + (int)gridDim.x);
        {
            float at[8], rt[8], bt[8], kt[8], bh[8], kh[8], vv[8]; float bsum = 0.f;
#pragma unroll
            for (int i = 0; i < 8; ++i) {
                const int q = i >> 1; const bool hi = i & 1;
                const float rf = hi ? hi_bf(r4[q]) : lo_bf(r4[q]), kraw = hi ? hi_bf(k4[q]) : lo_bf(k4[q]), vf = hi ? hi_bf(v4[q]) : lo_bf(v4[q]);
                const float kkf = hi ? hi_bf(kk4[q]) : lo_bf(kk4[q]), af = hi ? hi_bf(a4[q]) : lo_bf(a4[q]), lwf = hi ? hi_bf(lw4[q]) : lo_bf(lw4[q]);
                const float kf = kraw * (1.f + (af - 1.f) * k_a[h * 64 + k0 + i]);
                bsum += rf * kf * r_k[h * 64 + k0 + i];
                const float clv = cl[t * 64 + k0 + i], cle = cl[63 * 64 + k0 + i];
                const float e = __expf(clv), ex = __expf(clv - lwf), ei = __expf(-clv), eh = __expf(cle - clv);
                const float bb = kkf * af;
                at[i] = -kkf * ex; rt[i] = rf * e; bt[i] = bb * ei; kt[i] = kf * ei; bh[i] = bb * eh; kh[i] = kf * eh; vv[i] = vf;
            }
            bsum += dpp_f<0xB1, 0xf>(bsum); bsum += dpp_f<0x4E, 0xf>(bsum); bsum += dpp_f<0x141, 0xf>(bsum);
            if ((tid & 7) == 0) BON[(size_t)(c * 64 + t) * 16 + h] = bsum;
            *(LAS u32x4*)(TILE(0) + t * TLD + k0) = pack8(at);
            *(LAS u32x4*)(TILE(2) + t * TLD + k0) = pack8(rt);
            *(LAS u32x4*)(TILE(3) + t * TLD + k0) = pack8(bt);
            *(LAS u32x4*)(TILE(4) + t * TLD + k0) = pack8(kt);
            const u32x4 atp = pack8(at), bhp = pack8(bh), khp = pack8(kh);
#pragma unroll
            for (int i = 0; i < 8; ++i) {
                const int q = i >> 1; const bool hi = i & 1;
                TILE(1)[(k0 + i) * TLD + t] = (bf16_t)(hi ? (atp[q] >> 16) : (atp[q] & 0xffffu));
                TILE(5)[(k0 + i) * TLD + t] = (bf16_t)(hi ? (bhp[q] >> 16) : (bhp[q] & 0xffffu));
                TILE(6)[(k0 + i) * TLD + t] = (bf16_t)(hi ? (khp[q] >> 16) : (khp[q] & 0xffffu));
                TILE(7)[(k0 + i) * TLD + t] = (bf16_t)(hi ? (v4[q] >> 16) : (v4[q] & 0xffffu));
            }
            __syncthreads();
        }
#pragma unroll
        for (int nn = 0; nn < 2; ++nn) {
            const int ni = nb + nn; const int col = ni * 16 + fr, row0 = mi * 16 + fq * 4;
            f32x4 x = mm_tile(z4, TILE(0), TILE(3), mi, ni, fr, fq);
#pragma unroll
            for (int j = 0; j < 4; ++j) x[j] = (col < row0 + j) ? x[j] : 0.f;
            st_rm(TILE(8), x, mi, ni, fr, fq); st_tr(TILE(9), x, mi, ni, fr, fq);
            x = mm_tile(z4, TILE(0), TILE(4), mi, ni, fr, fq);
#pragma unroll
            for (int j = 0; j < 4; ++j) x[j] = (col < row0 + j) ? x[j] : 0.f;
            st_rm(TILE(10), x, mi, ni, fr, fq);
            x = mm_tile(z4, TILE(2), TILE(3), mi, ni, fr, fq);
#pragma unroll
            for (int j = 0; j < 4; ++j) x[j] = (col <= row0 + j) ? x[j] : 0.f;
            st_rm(TILE(11), x, mi, ni, fr, fq);
            x = mm_tile(z4, TILE(2), TILE(4), mi, ni, fr, fq);
#pragma unroll
            for (int j = 0; j < 4; ++j) x[j] = (col <= row0 + j) ? x[j] : 0.f;
            st_rm(TILE(12), x, mi, ni, fr, fq);
        }
        __syncthreads();
#pragma unroll
        for (int nn = 0; nn < 2; ++nn) {
            const int ni = nb + nn;
            st_tr(TILE(13), mm_tile(z4, TILE(10), TILE(7), mi, ni, fr, fq), mi, ni, fr, fq);
            const f32x4 x = mm_tile(z4, TILE(8), TILE(9), mi, ni, fr, fq);
            st_rm(TILE(0), x, mi, ni, fr, fq); st_tr(TILE(3), x, mi, ni, fr, fq);
        }
        __syncthreads();
#pragma unroll
        for (int rd = 0; rd < 5; ++rd) {
            const int tq = (rd & 1) ? 14 : 8, tqo = (rd & 1) ? 8 : 14;
            const int lx = (rd & 1) ? 4 : 0, lxt = (rd & 1) ? 9 : 3, lxo = (rd & 1) ? 0 : 4, lxto = (rd & 1) ? 3 : 9;
#pragma unroll
            for (int nn = 0; nn < 2; ++nn) {
                const int ni = nb + nn;
                f32x4 x = ld_rm(TILE(tq), mi, ni, fr, fq) + ld_rm(TILE(lx), mi, ni, fr, fq);
                x = mm_tile(x, TILE(tq), TILE(lxt), mi, ni, fr, fq);
                st_rm(TILE(tqo), x, mi, ni, fr, fq);
                if (rd < 4) { const f32x4 y = mm_tile(z4, TILE(lx), TILE(lxt), mi, ni, fr, fq); st_rm(TILE(lxo), y, mi, ni, fr, fq); st_tr(TILE(lxto), y, mi, ni, fr, fq); }
            }
            __syncthreads();
        }
#pragma unroll
        for (int nn = 0; nn < 2; ++nn) {
            const int ni = nb + nn;
            st_tr(TILE(10), mm_tile(ld_tr(TILE(1), mi, ni, fr, fq), TILE(14), TILE(1), mi, ni, fr, fq), mi, ni, fr, fq);
            st_tr(TILE(15), mm_tile(ld_tr(TILE(13), mi, ni, fr, fq), TILE(14), TILE(13), mi, ni, fr, fq), mi, ni, fr, fq);
        }
        __syncthreads();
#pragma unroll
        for (int nn = 0; nn < 2; ++nn) {
            const int ni = nb + nn;
            {
                f32x4 x = mm_tile(z4, TILE(5), TILE(10), mi, ni, fr, fq);
                if (mi == ni) {
#pragma unroll
                    for (int j = 0; j < 4; ++j) x[j] += (fq * 4 + j == fr) ? wc[ni * 16 + fr] : 0.f;
                }
                const unsigned w0 = cvt_pk_bf16(x[0], x[1]), w1 = cvt_pk_bf16(x[2], x[3]);
                bf16_t* gp = GT + (size_t)item * 4096 + (size_t)((mi * 2 + (ni >> 1)) * 64 + (fr >> 2) * 16 + fq * 4) * 8 + (ni & 1) * 4 + (fr & 3);
                gp[0] = (bf16_t)(w0 & 0xffffu); gp[8] = (bf16_t)(w0 >> 16); gp[16] = (bf16_t)(w1 & 0xffffu); gp[24] = (bf16_t)(w1 >> 16);
            }
            {
                f32x4 x = mm_tile(z4, TILE(5), TILE(15), mi, ni, fr, fq);
                x = mm_tile(x, TILE(6), TILE(7), mi, ni, fr, fq);
                *(f32x4*)(HT + (size_t)item * 4096 + (size_t)((ni * 4 + mi) * 64 + lane) * 4) = x;
            }
            {
                f32x4 x = ld_tr(TILE(2), mi, ni, fr, fq);
                x = mm_tile(x, TILE(10), TILE(11), mi, ni, fr, fq);
                u32x2 wv; wv.x = cvt_pk_bf16(x[0], x[1]); wv.y = cvt_pk_bf16(x[2], x[3]);
                *(u32x2*)(QE + (size_t)item * 4096 + (ni * 16 + fr) * 64 + mi * 16 + fq * 4) = wv;
            }
            {
                f32x4 x = mm_tile(z4, TILE(11), TILE(15), mi, ni, fr, fq);
                x = mm_tile(x, TILE(12), TILE(7), mi, ni, fr, fq);
                u32x2 wv; wv.x = cvt_pk_bf16(x[0], x[1]); wv.y = cvt_pk_bf16(x[2], x[3]);
                *(u32x2*)(YL + (size_t)item * 4096 + (size_t)((mi * 4 + ni) * 64 + lane) * 4) = wv;
            }
        }
    }
}

__device__ __forceinline__ void phase_seq(const Params& p) {
    if (threadIdx.x >= 64) return;
    const int head = blockIdx.x >> 2, vt = blockIdx.x & 3, lane = threadIdx.x, fr = lane & 15, fq = lane >> 4;
    const bf16_t* GT = (const bf16_t*)(p.ws + WS_GT); const float* HT = (const float*)(p.ws + WS_HT); bf16_t* S0 = (bf16_t*)(p.ws + WS_S0);
    f32x4 acc[4];
#pragma unroll
    for (int mb = 0; mb < 4; ++mb) acc[mb] = (f32x4){0.f, 0.f, 0.f, 0.f};
    bf16x8 ga[4][4][2]; f32x4 hh[4][4];
#define SEQ_LOAD(buf, cc) do { const size_t _it = (size_t)((cc) < 256 ? (cc) : 255) * 16 + head; \
        _Pragma("unroll") for (int mb = 0; mb < 4; ++mb) { \
            _Pragma("unroll") for (int ks = 0; ks < 2; ++ks) ga[buf][mb][ks] = *(const bf16x8*)(GT + _it * 4096 + (size_t)((mb * 2 + ks) * 64 + lane) * 8); \
            hh[buf][mb] = *(const f32x4*)(HT + _it * 4096 + (size_t)((vt * 4 + mb) * 64 + lane) * 4); } } while (0)
    SEQ_LOAD(0, 0); SEQ_LOAD(1, 1); SEQ_LOAD(2, 2); SEQ_LOAD(3, 3);
    for (int c0 = 0; c0 < 256; c0 += 4) {
#pragma unroll
        for (int b = 0; b < 4; ++b) {
            const int c = c0 + b; const size_t item = (size_t)c * 16 + head;
            u32x2 pk[4];
#pragma unroll
            for (int mb = 0; mb < 4; ++mb) { pk[mb].x = cvt_pk_bf16(acc[mb][0], acc[mb][1]); pk[mb].y = cvt_pk_bf16(acc[mb][2], acc[mb][3]);
                *(u32x2*)(S0 + item * 4096 + (vt * 16 + fr) * 64 + mb * 16 + fq * 4) = pk[mb]; }
            u32x4 b0w, b1w; b0w.x = pk[0].x; b0w.y = pk[0].y; b0w.z = pk[1].x; b0w.w = pk[1].y; b1w.x = pk[2].x; b1w.y = pk[2].y; b1w.z = pk[3].x; b1w.w = pk[3].y;
            const bf16x8 b0 = __builtin_bit_cast(bf16x8, b0w), b1 = __builtin_bit_cast(bf16x8, b1w);
#pragma unroll
            for (int mb = 0; mb < 4; ++mb) {
                const f32x4 x = __builtin_amdgcn_mfma_f32_16x16x32_bf16(ga[b][mb][0], b0, hh[b][mb], 0, 0, 0);
                acc[mb] = __builtin_amdgcn_mfma_f32_16x16x32_bf16(ga[b][mb][1], b1, x, 0, 0, 0);
            }
            SEQ_LOAD(b, c + 4);
        }
    }
#undef SEQ_LOAD
}

__device__ __forceinline__ void phase_chunkY(const Params& p, LAS unsigned char* lds) {
    LAS float* Yb = (LAS float*)lds;
    const int tid = threadIdx.x, w = tid >> 6, lane = tid & 63, fr = lane & 15, fq = lane >> 4;
    const int mi = w >> 1, nb = (w & 1) * 2;
    const bf16_t* R = (const bf16_t*)(p.ws + WS_R); const bf16_t* Kk = (const bf16_t*)(p.ws + WS_K); const bf16_t* V = (const bf16_t*)(p.ws + WS_V);
    const bf16_t* G = (const bf16_t*)(p.ws + WS_G); const bf16_t* YC = (const bf16_t*)(p.ws + WS_YC);
    const bf16_t* QE = (const bf16_t*)(p.ws + WS_QE); const bf16_t* YL = (const bf16_t*)(p.ws + WS_YL); const bf16_t* S0 = (const bf16_t*)(p.ws + WS_S0);
    bf16_t* YM = (bf16_t*)(p.ws + WS_YMIX);
    const float* gn_w = p.in[16]; const float* gn_b = p.in[17];
    u32x2 ywn[2]; bf16x8 an[2], bn[2][2]; bool first = true;
    u32x4 nv4, ng4, nyc4; float nbon; const float* BONp = (const float*)(p.ws + WS_BON);
#define CY_LOAD(it) do { const bf16_t* _q = QE + (size_t)(it) * 4096; const bf16_t* _s = S0 + (size_t)(it) * 4096; const bf16_t* _y = YL + (size_t)(it) * 4096; \
        _Pragma("unroll") for (int ks = 0; ks < 2; ++ks) an[ks] = *(const bf16x8*)(_q + (mi * 16 + fr) * 64 + ks * 32 + fq * 8); \
        _Pragma("unroll") for (int nn = 0; nn < 2; ++nn) { ywn[nn] = *(const u32x2*)(_y + (size_t)((mi * 4 + nb + nn) * 64 + lane) * 4); \
            _Pragma("unroll") for (int ks = 0; ks < 2; ++ks) bn[nn][ks] = *(const bf16x8*)(_s + (nb + nn) * 16 * 64 + fr * 64 + ks * 32 + fq * 8); } \
        { const size_t _tg = (size_t)((it) >> 4) * 64 + (tid >> 3); const size_t _o = _tg * DR + ((it) & 15) * 64 + (tid & 7) * 8; \
          nv4 = *(const u32x4*)(V + _o); ng4 = *(const u32x4*)(G + _o); nyc4 = *(const u32x4*)(YC + _o); nbon = BONp[_tg * 16 + ((it) & 15)]; } } while (0)
    for (int item = blockIdx.x; item < 4096; item += gridDim.x) {
        const int c = item >> 4, h = item & 15;
        if (first) { first = false; CY_LOAD(item); }
        __syncthreads();
        const u32x2 ywc[2] = {ywn[0], ywn[1]}; const bf16x8 ac[2] = {an[0], an[1]}; const bf16x8 bc[2][2] = {{bn[0][0], bn[0][1]}, {bn[1][0], bn[1][1]}};
        const u32x4 v4 = nv4, g4 = ng4, yc4 = nyc4; const float bon = nbon;
        if (item + (int)gridDim.x < 4096) CY_LOAD(item + (int)gridDim.x);
#pragma unroll
        for (int nn = 0; nn < 2; ++nn) {
            const int ni = nb + nn;
            const u32x2 yw = ywc[nn];
            f32x4 acc = (f32x4){lo_bf(yw.x), hi_bf(yw.x), lo_bf(yw.y), hi_bf(yw.y)};
#pragma unroll
            for (int ks = 0; ks < 2; ++ks) acc = __builtin_amdgcn_mfma_f32_16x16x32_bf16(ac[ks], bc[nn][ks], acc, 0, 0, 0);
#pragma unroll
            for (int j = 0; j < 4; ++j) Yb[(mi * 16 + fq * 4 + j) * 68 + ni * 16 + fr] = acc[j];
        }
        __syncthreads();
        {
            const int t = tid >> 3, k0 = (tid & 7) * 8; const int ch = h * 64 + k0;
            const size_t tg = (size_t)c * 64 + t; const size_t o = tg * DR + ch;
            const float4 gw0 = *(const float4*)(gn_w + ch), gw1 = *(const float4*)(gn_w + ch + 4), gb0 = *(const float4*)(gn_b + ch), gb1 = *(const float4*)(gn_b + ch + 4);
            const float gwv[8] = {gw0.x, gw0.y, gw0.z, gw0.w, gw1.x, gw1.y, gw1.z, gw1.w}, gbv[8] = {gb0.x, gb0.y, gb0.z, gb0.w, gb1.x, gb1.y, gb1.z, gb1.w};
            const f32x4 y0 = *(const LAS f32x4*)(Yb + t * 68 + k0), y1 = *(const LAS f32x4*)(Yb + t * 68 + k0 + 4);
            const float y[8] = {y0[0], y0[1], y0[2], y0[3], y1[0], y1[1], y1[2], y1[3]};
            float sm = 0.f;
#pragma unroll
            for (int i = 0; i < 8; ++i) sm += y[i];
            sm += dpp_f<0xB1, 0xf>(sm); sm += dpp_f<0x4E, 0xf>(sm); sm += dpp_f<0x141, 0xf>(sm);
            const float mean = sm * (1.f / 64.f);
            float vs = 0.f;
#pragma unroll
            for (int i = 0; i < 8; ++i) { const float d = y[i] - mean; vs += d * d; }
            vs += dpp_f<0xB1, 0xf>(vs); vs += dpp_f<0x4E, 0xf>(vs); vs += dpp_f<0x141, 0xf>(vs);
            const float rs = rsqrtf(vs * (1.f / 64.f) + 64e-5f);
            float vf[8], gf[8], of[8];
            unpack8(v4, vf); unpack8(g4, gf);
#pragma unroll
            for (int i = 0; i < 8; ++i) of[i] = ((y[i] - mean) * rs * gwv[i] + gbv[i] + bon * vf[i]) * gf[i];
            *(u32x4*)(YM + tg * D_ + ch) = pack8(of);
            *(u32x4*)(YM + tg * D_ + 1024 + ch) = yc4;
        }
    }
#undef CY_LOAD
}

__device__ __forceinline__ int f2key(float x) { const int u = __float_as_int(x); return u ^ ((u >> 31) & 0x7fffffff); }
__device__ __forceinline__ float key2f(int k) { return __int_as_float(k ^ ((k >> 31) & 0x7fffffff)); }
template <int CTRL> __device__ __forceinline__ int dpp_i(int v) { return __builtin_amdgcn_update_dpp(v, v, CTRL, 0xf, 0xf, false); }
__device__ __forceinline__ int row_max_i(int v) { v = max(v, dpp_i<0xB1>(v)); v = max(v, dpp_i<0x4E>(v)); v = max(v, dpp_i<0x141>(v)); v = max(v, dpp_i<0x140>(v)); return v; }
__device__ __forceinline__ void phase_topk(const Params& p, unsigned char* shm) {
    float* sc = (float*)shm;
    int* tk = (int*)(sc + 64 * 260);
    int* ctab = tk + 2048;
    if (threadIdx.x < 64) { int n = threadIdx.x, v = 256;
        for (int i = 0; i < 16; ++i) { const int cnt = 16 / (i + 1); if (n < cnt) { v = i * 16 + n; break; } n -= cnt; }
        ctab[threadIdx.x] = v; }
    const float* SC = (const float*)(p.ws + WS_Q);
    int* IDS = (int*)(p.ws + WS_IDS); float* GATES = (float*)(p.ws + WS_GATES);
    const int tid = threadIdx.x, w = tid >> 6, lane = tid & 63;
    f32x4 qreg[8];
#define TK_QLOAD(it) do { const int _t0 = ((it) >> 3) * 64; _Pragma("unroll") for (int i = 0; i < 8; ++i) { const int ch = tid + 512 * i; \
        qreg[i] = *(const f32x4*)(SC + (size_t)(_t0 + (ch >> 6)) * 2048 + ((it) & 7) * 256 + (ch & 63) * 4); } } while (0)
    if ((int)blockIdx.x < 2048) TK_QLOAD((int)blockIdx.x);
    for (int item = blockIdx.x; item < 2048; item += gridDim.x) {
        const int t0 = (item >> 3) * 64, h = item & 7;
        __syncthreads();
#pragma unroll
        for (int i = 0; i < 8; ++i) { const int ch = tid + 512 * i; *(f32x4*)(sc + (ch >> 6) * 260 + (ch & 63) * 4) = qreg[i]; }
        __syncthreads();
        if (item + (int)gridDim.x < 2048) TK_QLOAD(item + (int)gridDim.x);
        for (int g = 0; g < 4; ++g) {
            const int L = w * 16 + g * 4 + (lane >> 4); const int tok = L >> 1, cc = L & 1; const int pp = lane & 15;
            int key[8];
#pragma unroll
            for (int i = 0; i < 8; ++i) key[i] = (f2key(sc[tok * 260 + cc * 128 + i * 16 + pp]) & ~127) | (127 - (i * 16 + pp));
#define CE(a, b) do { const int _hi = max(key[a], key[b]), _lo = min(key[a], key[b]); key[a] = _hi; key[b] = _lo; } while (0)
            CE(0, 1); CE(2, 3); CE(4, 5); CE(6, 7);  CE(0, 2); CE(1, 3); CE(4, 6); CE(5, 7);  CE(1, 2); CE(5, 6);
            CE(0, 4); CE(1, 5); CE(2, 6); CE(3, 7);  CE(2, 4); CE(3, 5);  CE(1, 2); CE(3, 4); CE(5, 6);
#undef CE
            int mykey = 0;
#pragma unroll
            for (int r = 0; r < 16; ++r) {
                const int m = row_max_i(key[0]);
                const bool win = (key[0] == m);
#pragma unroll
                for (int i = 0; i < 7; ++i) key[i] = win ? key[i + 1] : key[i];
                key[7] = win ? (int)0x80000000 : key[7];
                mykey = (pp == r) ? m : mykey;
            }
            tk[L * 16 + pp] = mykey;
        }
        __syncthreads();
        for (int g = 0; g < 2; ++g) {
            const int tok = w * 8 + g * 4 + (lane >> 4); const int pp = lane & 15;
            int key[4];
#pragma unroll
            for (int q = 0; q < 4; ++q) {
                const int ij = ctab[q * 16 + pp];
                const float s1 = key2f(tk[(tok * 2) * 16 + ((ij >> 4) & 15)] & ~127), s2 = key2f(tk[(tok * 2 + 1) * 16 + (ij & 15)] & ~127);
                key[q] = (ij < 256) ? ((f2key(s1 + s2) & ~255) | (255 - ij)) : (int)0x80000000;
            }
            int mykey = 0;
#pragma unroll
            for (int r = 0; r < 16; ++r) {
                const int ml = max(max(key[0], key[1]), max(key[2], key[3]));
                const int m = row_max_i(ml);
#pragma unroll
                for (int q = 0; q < 4; ++q) key[q] = (key[q] == m) ? (int)0x80000000 : key[q];
                mykey = (pp == r) ? m : mykey;
            }
            const int ci = 255 - (mykey & 255); const float cs = key2f(mykey & ~255);
            const int e1 = 127 - (tk[(tok * 2) * 16 + (ci >> 4)] & 127), e2 = 127 - (tk[(tok * 2 + 1) * 16 + (ci & 15)] & 127);
            const float mx = __shfl(cs, lane & 48);
            const float e = __expf(cs - mx);
            float sum = e; sum += dpp_f<0xB1, 0xf>(sum); sum += dpp_f<0x4E, 0xf>(sum); sum += dpp_f<0x141, 0xf>(sum); sum += dpp_f<0x140, 0xf>(sum);
            IDS[(size_t)(t0 + tok) * 128 + h * 16 + pp] = (e1 * 128 + e2) & 16383;
            GATES[(size_t)(t0 + tok) * 128 + h * 16 + pp] = e / sum;
        }
    }
#undef TK_QLOAD
}

constexpr float U8_SCALE = 64.f, V8_SCALE = 32.f;
__device__ __forceinline__ float gelu_fast(float x) { const float u = 0.7978845608028654f * (x + 0.044715f * x * x * x); return x / (1.0f + __expf(-2.0f * u)); }
__device__ __forceinline__ void phase_gather(const Params& p, unsigned char* shm) {
    const float* X1 = (const float*)(p.ws + WS_X1); const float* SSQ = (const float*)(p.ws + WS_SSQ);
    const unsigned char* U8 = p.ws + WS_UB; const unsigned char* V8 = p.ws + WS_VB;
    const int* IDS = (const int*)(p.ws + WS_IDS); const float* GATES = (const float*)(p.ws + WS_GATES);
    const float* nf = p.in[25];
    const int tid = threadIdx.x, w = tid >> 6, lane = tid & 63;
    int nid0 = 0, nid1 = 0; float ngt0 = 0.f, ngt1 = 0.f, nssq = 0.f;
#define GT_META(tt) do { nid0 = IDS[(size_t)(tt) * 128 + lane]; nid1 = IDS[(size_t)(tt) * 128 + 64 + lane]; ngt0 = GATES[(size_t)(tt) * 128 + lane]; ngt1 = GATES[(size_t)(tt) * 128 + 64 + lane]; \
        nssq = (lane < 32) ? SSQ[(size_t)(tt) * 32 + lane] : 0.f; } while (0)
    if ((int)(blockIdx.x * 8 + w) < S_) GT_META(blockIdx.x * 8 + w);
    for (int t = blockIdx.x * 8 + w; t < S_; t += gridDim.x * 8) {
        const int id0 = nid0, id1 = nid1; const float gt0 = ngt0, gt1 = ngt1, ssqv = nssq;
        if (t + (int)gridDim.x * 8 < S_) GT_META(t + (int)gridDim.x * 8);
        f32x2 op[16];
#pragma unroll
        for (int q = 0; q < 2; ++q)
#pragma unroll
            for (int i = 0; i < 4; ++i) { const float4 x = *(const float4*)(X1 + (size_t)t * D_ + q * 1024 + lane * 16 + 4 * i);
                op[q * 8 + 2 * i] = (f32x2){x.x, x.y}; op[q * 8 + 2 * i + 1] = (f32x2){x.z, x.w}; }
        f32x2 hp[16];
#pragma unroll
        for (int i = 0; i < 16; ++i) hp[i] = op[i];
        const float rs = rsqrtf(wave_sum_dpp(ssqv) * (1.0f / 2048.0f) + 1e-6f);
        u32x4 ua[4][2], ub[4][2], vb[4][2];
#define G_LOADU(dst, grp) do { _Pragma("unroll") for (int j = 0; j < 4; ++j) { const int e = (grp) * 4 + j; const int id = __builtin_amdgcn_readlane(e < 64 ? id0 : id1, e & 63); \
            const unsigned char* ur = U8 + (size_t)id * D_ + lane * 16; dst[j][0] = *(const u32x4*)ur; dst[j][1] = *(const u32x4*)(ur + 1024); } } while (0)
#define G_LOADV(grp) do { _Pragma("unroll") for (int j = 0; j < 4; ++j) { const int e = (grp) * 4 + j; const int id = __builtin_amdgcn_readlane(e < 64 ? id0 : id1, e & 63); \
            const unsigned char* vr = V8 + (size_t)id * D_ + lane * 16; vb[j][0] = *(const u32x4*)vr; vb[j][1] = *(const u32x4*)(vr + 1024); } } while (0)
#define G_BODY(cur, nxt, grp) do { \
            G_LOADV(grp); \
            G_LOADU(nxt, ((grp) + 1 < 32 ? (grp) + 1 : 31)); \
            float dsel = 0.f; \
            _Pragma("unroll") for (int j = 0; j < 4; ++j) { f32x2 d2 = (f32x2){0.f, 0.f}; \
                _Pragma("unroll") for (int q = 0; q < 2; ++q) _Pragma("unroll") for (int i = 0; i < 4; ++i) { \
                    d2 += __builtin_amdgcn_cvt_pk_f32_fp8((int)cur[j][q][i], false) * hp[q * 8 + 2 * i]; d2 += __builtin_amdgcn_cvt_pk_f32_fp8((int)cur[j][q][i], true) * hp[q * 8 + 2 * i + 1]; } \
                const float d = wave_sum_dpp(d2.x + d2.y); dsel = (lane == j) ? d : dsel; } \
            const float av = gelu_fast(dsel * (rs * (1.f / U8_SCALE))) * (1.f / V8_SCALE); \
            _Pragma("unroll") for (int j = 0; j < 4; ++j) { const int e = (grp) * 4 + j; \
                const float a = __int_as_float(__builtin_amdgcn_readlane(__float_as_int(av), j)) * __int_as_float(__builtin_amdgcn_readlane(__float_as_int(e < 64 ? gt0 : gt1), e & 63)); \
                const f32x2 a2 = (f32x2){a, a}; \
                _Pragma("unroll") for (int q = 0; q < 2; ++q) _Pragma("unroll") for (int i = 0; i < 4; ++i) { \
                    op[q * 8 + 2 * i] += a2 * __builtin_amdgcn_cvt_pk_f32_fp8((int)vb[j][q][i], false); op[q * 8 + 2 * i + 1] += a2 * __builtin_amdgcn_cvt_pk_f32_fp8((int)vb[j][q][i], true); } } \
        } while (0)
        G_LOADU(ua, 0);
#pragma unroll 1
        for (int g2 = 0; g2 < 32; g2 += 2) { G_BODY(ua, ub, g2); G_BODY(ub, ua, g2 + 1); }
#undef G_LOADU
#undef G_LOADV
#undef G_BODY
        float ss = 0.f; float4 xs[8];
#pragma unroll
        for (int q = 0; q < 2; ++q)
#pragma unroll
            for (int i = 0; i < 4; ++i) { float4 x;
                x.x = op[q * 8 + 2 * i].x; x.y = op[q * 8 + 2 * i].y; x.z = op[q * 8 + 2 * i + 1].x; x.w = op[q * 8 + 2 * i + 1].y;
                ss += x.x * x.x + x.y * x.y + x.z * x.z + x.w * x.w; xs[q * 4 + i] = x; }
        ss = wave_sum_dpp(ss);
        const float scl = rsqrtf(ss * (1.f / 2048.f) + 1e-6f);
#pragma unroll
        for (int q = 0; q < 2; ++q)
#pragma unroll
            for (int i = 0; i < 4; ++i) { const float4 g = *(const float4*)(nf + q * 1024 + lane * 16 + 4 * i); const float4 x = xs[q * 4 + i];
                *(float4*)(p.out + (size_t)t * D_ + q * 1024 + lane * 16 + 4 * i) = make_float4(x.x * scl * g.x, x.y * scl * g.y, x.z * scl * g.z, x.w * scl * g.w); }
    }
}

#define XB_TMO      128
#define XB_XCNT(j)  (256  + 64 * (j))
#define XB_XSUB(j)  (1280 + 64 * (j))
#define XB_XGEN(j)  (2304 + 64 * (j))
#define XB_TOP      3328
#define XB_TOPGEN   3392
#define XCD_BAR_WORDS 3456
#define XB_SPIN_CAP (1u << 18)
__device__ __forceinline__ unsigned xb_ld(unsigned* p)              { return __hip_atomic_load(p, __ATOMIC_RELAXED, __HIP_MEMORY_SCOPE_AGENT); }
__device__ __forceinline__ unsigned xb_add(unsigned* p, unsigned v) { return __hip_atomic_fetch_add(p, v, __ATOMIC_RELAXED, __HIP_MEMORY_SCOPE_AGENT); }
__device__ __forceinline__ unsigned xb_xcc_id() { return (unsigned)__builtin_amdgcn_s_getreg((3 << 11) | 20) & 0xFu; }
#define XB_SPIN(cond, bar) do { unsigned _sp = 0; while (cond) { __builtin_amdgcn_s_sleep(1); \
    if ((++_sp & 255u) == 0u) { if (xb_ld(&(bar)[XB_TMO])) break; if (_sp > XB_SPIN_CAP) { atomicAdd(&(bar)[XB_TMO], 1u); break; } } } } while (0)
struct XcdBarrier { unsigned* bar; unsigned x; volatile LAS unsigned* st; };
__device__ __forceinline__ XcdBarrier xcd_barrier_post(unsigned* bar, volatile LAS unsigned* st) {
    XcdBarrier b; b.bar = bar; b.x = xb_xcc_id(); b.st = st;
    if (threadIdx.x == 0) (void)xb_add(&bar[XB_XCNT(b.x)], 1u);
    return b;
}
__device__ __forceinline__ void xcd_barrier_complete(unsigned* bar, unsigned x, unsigned& nloc, unsigned& nx) {
    const unsigned G = gridDim.x * gridDim.y * gridDim.z;
    unsigned sum, cnt, mine, sp = 0u;
    for (;;) {
        sum = 0u; cnt = 0u; mine = 0u;
#pragma unroll
        for (unsigned j = 0; j < 16; ++j) { const unsigned c = xb_ld(&bar[XB_XCNT(j)]); sum += c; cnt += (c > 0u) ? 1u : 0u; mine = (j == x) ? c : mine; }
        if (sum == G) break;
        __builtin_amdgcn_s_sleep(1);
        if ((++sp & 255u) == 0u) { if (xb_ld(&bar[XB_TMO])) break; if (sp > XB_SPIN_CAP) { atomicAdd(&bar[XB_TMO], 1u); break; } }
    }
    nloc = mine > 0u ? mine : 1u; nx = cnt > 0u ? cnt : 1u;
}
__device__ __forceinline__ void xcd_barrier(const XcdBarrier& b) {
    asm volatile("s_waitcnt vmcnt(0)" ::: "memory");
    __syncthreads();
    if (threadIdx.x == 0) {
        unsigned* bar = b.bar;
        __builtin_amdgcn_s_waitcnt(0);
        unsigned nloc = b.st[0], nx = b.st[1];
        if (nloc == 0u) { xcd_barrier_complete(bar, b.x, nloc, nx); b.st[0] = nloc; b.st[1] = nx; }
        const unsigned old = xb_add(&bar[XB_XSUB(b.x)], 1u);
        const unsigned gen = old / nloc;
        if (old + 1u == (gen + 1u) * nloc) {
            __builtin_amdgcn_fence(__ATOMIC_RELEASE, "agent");
            asm volatile("s_waitcnt vmcnt(0)" ::: "memory");
            const unsigned og = xb_add(&bar[XB_TOP], 1u);
            const unsigned tg = og / nx;
            if (og + 1u == (tg + 1u) * nx) xb_add(&bar[XB_TOPGEN], 1u);
            else XB_SPIN(xb_ld(&bar[XB_TOPGEN]) == tg, bar);
            __builtin_amdgcn_fence(__ATOMIC_ACQUIRE, "agent");
            xb_add(&bar[XB_XGEN(b.x)], 1u);
            asm volatile("s_waitcnt vmcnt(0)" ::: "memory");
        } else {
            XB_SPIN(xb_ld(&bar[XB_XGEN(b.x)]) == gen, bar);
            __builtin_amdgcn_fence(__ATOMIC_ACQUIRE, "agent");
            asm volatile("s_waitcnt vmcnt(0)" ::: "memory");
        }
    }
    __syncthreads();
}

__global__ void __launch_bounds__(512, 2) mega(Params p) {
    extern __shared__ __attribute__((aligned(16))) unsigned char shm[];
    cg::grid_group grid = cg::this_grid();
    LAS unsigned char* lds = (LAS unsigned char*)shm;
    volatile LAS unsigned* bst = (volatile LAS unsigned*)(lds + LDS_BYTES - 16);
    if (threadIdx.x == 0) { bst[0] = 0u; bst[1] = 0u; }
    __syncthreads();
    const XcdBarrier xbar = xcd_barrier_post((unsigned*)(p.ws + WS_BAR), bst);
    if (p.ph_hi > 1000) grid.sync();
    const int lo = p.ph_lo, hi = p.ph_hi;
#define IN(k) (lo <= (k) && (k) < hi)
#define REP(k) for (int _r = 0; _r < ((k) == DUP_PHASE ? 2 : 1); ++_r)
#define SEAM(k) do { if (IN(k) && IN((k) + 1)) xcd_barrier(xbar); } while (0)
    if (IN(0)) REP(0) { if (_r) xcd_barrier(xbar); phase0(p, shm); }
    SEAM(0);
    if (IN(1)) REP(1) { if (_r) xcd_barrier(xbar);
        pg8::Gemm g{(const bf16_t*)(p.ws + WS_H), (const bf16_t*)(p.ws + WS_WB1), S_, NAUG, 2048};
        pg8::StaticOrder so; so.init(g.M, g.N, (int)gridDim.x, (int)blockIdx.x);
        pg8::EpiBf16 E{(bf16_t*)(p.ws + WS_PROJ), NAUG};
        pg8::gemm_phase(lds, g, so, E);
    }
    SEAM(1);
    if (IN(2)) REP(2) { if (_r) xcd_barrier(xbar);
        phase_prepM(p, lds);
        phase_prepE(p);
    }
    SEAM(2);
    if (IN(3)) REP(3) { if (_r) xcd_barrier(xbar); phase_chunkA(p, lds); }
    SEAM(3);
    if (IN(4)) REP(4) { if (_r) xcd_barrier(xbar); if (blockIdx.x < 64) phase_seq(p);
        else { const int bid = blockIdx.x - 64, nblk = gridDim.x - 64;
            convert_fp8(p.in[23], p.ws + WS_UB, (size_t)16384 * 2048, U8_SCALE, p.in[20], bid, nblk);
            convert_fp8(p.in[24], p.ws + WS_VB, (size_t)16384 * 2048, V8_SCALE, nullptr, bid, nblk);
            build_wpt(p.in[21], p.in[20], (const bf16_t*)(p.ws + WS_KEYB), (bf16_t*)(p.ws + WS_WQT), bid, nblk);
            transpose_convert(p.in[19], 2048, 2048, (bf16_t*)(p.ws + WS_WOT), (float*)shm, bid, nblk); } }
    SEAM(4);
    if (IN(5)) REP(5) { if (_r) xcd_barrier(xbar); phase_chunkY(p, lds); }
    SEAM(5);
    if (IN(6)) REP(6) { if (_r) xcd_barrier(xbar);
        pg8::Gemm g{(const bf16_t*)(p.ws + WS_YMIX), (const bf16_t*)(p.ws + WS_WOT), S_, 2048, 2048};
        pg8::StaticOrder so; so.init(g.M, g.N, (int)gridDim.x, (int)blockIdx.x);
        pg8::EpiRes2 E{(float*)(p.ws + WS_X1), p.in[0], (bf16_t*)(p.ws + WS_H2), (float*)(p.ws + WS_SSQ), 2048};
        pg8::gemm_phase(lds, g, so, E);
    }
    SEAM(6);
    if (IN(8)) REP(8) { if (_r) xcd_barrier(xbar);
        pg8::Gemm g{(const bf16_t*)(p.ws + WS_H2), (const bf16_t*)(p.ws + WS_WQT), S_, 2048, 2048};
        pg8::StaticOrder so; so.init(g.M, g.N, (int)gridDim.x, (int)blockIdx.x);
        pg8::EpiRowScaleF32 E{(float*)(p.ws + WS_Q), (const float*)(p.ws + WS_SSQ), 2048};
        pg8::gemm_phase(lds, g, so, E);
    }
    SEAM(8);
    if (IN(9)) REP(9) { if (_r) xcd_barrier(xbar); phase_topk(p, shm); }
    SEAM(9);
    if (IN(10)) REP(10) { if (_r) xcd_barrier(xbar); phase_gather(p, shm); }
#undef IN
#undef REP
#undef SEAM
}

extern "C" void kernel_launch(void* const* d_in, const int* in_sizes, int n_in, void* d_out, int out_size, void* d_ws, size_t ws_size, hipStream_t stream) {
    static int grid_blocks = 0;
    if (grid_blocks == 0) {
        if (n_in != 26 || ws_size < WS_NEED) { fprintf(stderr, "kernel_launch: unexpected n_in %d / ws_size %zu\n", n_in, ws_size); grid_blocks = -1; return; }
        int dev = 0, cus = 0, per_cu = 0;
        (void)hipGetDevice(&dev);
        (void)hipDeviceGetAttribute(&cus, hipDeviceAttributeMultiprocessorCount, dev);
        (void)hipFuncSetAttribute((const void*)mega, hipFuncAttributeMaxDynamicSharedMemorySize, LDS_BYTES);
        (void)hipOccupancyMaxActiveBlocksPerMultiprocessor(&per_cu, (const void*)mega, 512, LDS_BYTES);
        if (per_cu < 1) { fprintf(stderr, "kernel_launch: occupancy query says %d blocks/CU\n", per_cu); per_cu = 1; }
        grid_blocks = cus * per_cu;
        fprintf(stderr, "kernel_launch: cus %d per_cu %d grid %d\n", cus, per_cu, grid_blocks);
    }
    if (grid_blocks < 0) return;
    Params p{};
    for (int i = 0; i < 26; ++i) p.in[i] = (const float*)d_in[i];
    p.out = (float*)d_out; p.ws = (unsigned char*)d_ws;
#if MULTI_LAUNCH
    for (int ph = 0; ph < NPHASE; ++ph) {
        p.ph_lo = ph; p.ph_hi = ph + 1;
        hipLaunchKernelGGL(mega, dim3(grid_blocks), dim3(512), LDS_BYTES, stream, p);
    }
#else
    p.ph_lo = 0; p.ph_hi = NPHASE;
    if (hipMemsetAsync((unsigned char*)d_ws + WS_BAR, 0, XCD_BAR_WORDS * 4, stream) != hipSuccess) fprintf(stderr, "kernel_launch: barrier memset failed\n");
    void* args[] = {&p};
    hipError_t e = hipLaunchCooperativeKernel((const void*)mega, dim3(grid_blocks), dim3(512), args, LDS_BYTES, stream);
    if (e != hipSuccess) fprintf(stderr, "cooperative launch failed: %s (grid %d)\n", hipGetErrorString(e), grid_blocks);
#endif
}
```

```cpp
#include <hip/hip_runtime.h>
#include <hip/hip_cooperative_groups.h>
#include <cstdio>
namespace cg = cooperative_groups;

#ifndef DUP_PHASE
#define DUP_PHASE -1
#endif
#ifndef MULTI_LAUNCH
#define MULTI_LAUNCH 0
#endif

#define LAS __attribute__((address_space(3)))
typedef unsigned short bf16_t;
typedef short bf16x8 __attribute__((ext_vector_type(8)));
typedef float f32x4 __attribute__((ext_vector_type(4)));
typedef float f32x2 __attribute__((ext_vector_type(2)));
typedef unsigned u32x4 __attribute__((ext_vector_type(4)));
typedef unsigned u32x2 __attribute__((ext_vector_type(2)));
typedef unsigned u32x6 __attribute__((ext_vector_type(6)));
typedef float f32x32 __attribute__((ext_vector_type(32)));
typedef __bf16 bf16x32_t __attribute__((ext_vector_type(32)));

constexpr int S_ = 16384, D_ = 2048, DR = 1024, NAUG = 6912;
constexpr size_t MiB = 1ull << 20;
constexpr size_t WS_PROJ = 0, WS_H = 216 * MiB, WS_WB1 = 280 * MiB, WS_WQT = 280 * MiB, WS_WOT = 296 * MiB;
constexpr size_t WS_R = 307 * MiB, WS_K = 339 * MiB, WS_V = 371 * MiB, WS_KK = 403 * MiB, WS_A = 435 * MiB, WS_LW = 467 * MiB;
constexpr size_t WS_G = 216 * MiB, WS_YC = 248 * MiB, WS_YMIX = 307 * MiB, WS_X1 = 0, WS_H2 = 128 * MiB, WS_Q = 307 * MiB;
constexpr size_t WS_GT = 0, WS_HT = 32 * MiB, WS_QE = 96 * MiB, WS_YL = 128 * MiB, WS_S0 = 160 * MiB;
constexpr size_t WS_IDS = 192 * MiB, WS_GATES = 200 * MiB, WS_UB = 467 * MiB, WS_VB = 435 * MiB, WS_BON = 500 * MiB, WS_BAR = 502 * MiB, WS_KEYB = 503 * MiB, WS_SSQ = 504 * MiB, WS_NEED = 506 * MiB;
constexpr size_t WS_W2T = 499 * MiB, WS_A2T = WS_W2T + 131072, WS_G2T = WS_A2T + 131072;
constexpr int TLD = 72, TSLOT = 64 * TLD * 2;
constexpr int LDS_BYTES = 16 * TSLOT + 2048 + 256 + 16;
constexpr int NPHASE = 11;

struct Params {
    const float* in[26];
    float* out;
    unsigned char* ws;
    int ph_lo, ph_hi;
};

__device__ __forceinline__ float bf2f(bf16_t b) { return __uint_as_float(((unsigned)b) << 16); }
__device__ __forceinline__ bf16_t f2bf(float f) { unsigned u = __float_as_uint(f); u += 0x7FFFu + ((u >> 16) & 1u); return (bf16_t)(u >> 16); }
typedef __bf16 bf16v2_t __attribute__((ext_vector_type(2)));
__device__ __forceinline__ unsigned cvt_pk_bf16(float lo, float hi) { const f32x2 v = {lo, hi}; const bf16v2_t r = __builtin_convertvector(v, bf16v2_t); return __builtin_bit_cast(unsigned, r); }
__device__ __forceinline__ u32x4 pack8(const float* f) { u32x4 w; w.x = cvt_pk_bf16(f[0], f[1]); w.y = cvt_pk_bf16(f[2], f[3]); w.z = cvt_pk_bf16(f[4], f[5]); w.w = cvt_pk_bf16(f[6], f[7]); return w; }
__device__ __forceinline__ float lo_bf(unsigned w) { return __uint_as_float(w << 16); }
__device__ __forceinline__ float hi_bf(unsigned w) { return __uint_as_float(w & 0xffff0000u); }
__device__ __forceinline__ void unpack8(const u32x4 v, float* f) {
#pragma unroll
    for (int i = 0; i < 4; ++i) { f[2 * i] = lo_bf(v[i]); f[2 * i + 1] = hi_bf(v[i]); }
}
__device__ __forceinline__ float wave_sum(float v) {
#pragma unroll
    for (int o = 32; o; o >>= 1) v += __shfl_xor(v, o);
    return v;
}
template <int CTRL, int RM> __device__ __forceinline__ float dpp_f(float v) { return __int_as_float(__builtin_amdgcn_update_dpp(0, __float_as_int(v), CTRL, RM, 0xf, false)); }
__device__ __forceinline__ float wave_sum_dpp(float v) {
    v += dpp_f<0xB1, 0xf>(v); v += dpp_f<0x4E, 0xf>(v); v += dpp_f<0x141, 0xf>(v); v += dpp_f<0x140, 0xf>(v);
    v += dpp_f<0x142, 0xa>(v); v += dpp_f<0x143, 0xc>(v);
    return __int_as_float(__builtin_amdgcn_readlane(__float_as_int(v), 63));
}
__device__ __forceinline__ float wave_max(float v) {
#pragma unroll
    for (int o = 32; o; o >>= 1) v = fmaxf(v, __shfl_xor(v, o));
    return v;
}
__device__ __forceinline__ float sigmoidf_(float x) { return 1.0f / (1.0f + __expf(-x)); }
__device__ __forceinline__ float gelu_tanh(float x) { float u = 0.7978845608028654f * (x + 0.044715f * x * x * x); return 0.5f * x * (1.0f + tanhf(u)); }

namespace pg8 {
constexpr int BM = 256, BK = 64, HALF = 128, HTB = HALF * BK * 2, STAGE_BYTES = 8 * HTB, NXCD = 8, WGM = 8;
__device__ __forceinline__ int lds_byte(int r, int c) { const int st = (r >> 4) * 2 + (c >> 5), rr = r & 15, cc = c & 31, ob = rr * 64 + cc * 2; return st * 1024 + (ob ^ (((ob >> 9) & 1) << 5)); }
__device__ __forceinline__ void stage_rc(int b, int& R, int& C) { const int st = b / 1024, sb = b % 1024, swz = sb ^ (((sb >> 9) & 1) << 5); R = (st >> 1) * 16 + swz / 64; C = (st & 1) * 32 + (swz % 64) / 2; }
__device__ __forceinline__ int perm32(int rho) { const int n = rho >> 4, i = rho & 15; return 8 * (i >> 2) + 4 * n + (i & 3); }
struct Unit { int pm, pn; };
struct Gemm { const bf16_t* A; const bf16_t* Bt; int M, N, K; };
struct StaticOrder {
    int nM, nN, nwg, G, c;
    __device__ void init(int M, int N, int G_, int c_) { nM = M / BM; nN = N / BM; nwg = nM * nN; G = G_; c = c_; }
    __device__ bool next(int i, Unit& u) const {
        const long L = (long)i * G + c; if (L >= nwg) return false;
        int wgid = (int)L; { const int q = nwg / NXCD, r = nwg % NXCD, xcd = wgid % NXCD, off = wgid / NXCD; wgid = (xcd < r ? xcd * (q + 1) : r * (q + 1) + (xcd - r) * q) + off; }
        const int nig = WGM * nN, gid = wgid / nig, fm = gid * WGM, gsz = (nM - fm) < WGM ? (nM - fm) : WGM;
        u.pm = fm + ((wgid % nig) % gsz); u.pn = (wgid % nig) / gsz; return true;
    }
    __device__ __forceinline__ void a_ready(const Unit&) const {}
    __device__ __forceinline__ void done(const Unit&) const {}
};
struct EpiResF32 {
    static constexpr bool PERM = false;
    float* C; const float* Res; int ldc;
    __device__ __forceinline__ void operator()(const f32x4 (&acc)[2][2][4][2], const Unit& u, int wr, int wc, int fr, int fq) const {
        const int row0 = u.pm * BM + wr * 64 + fr, col0 = u.pn * BM + wc * 32 + 4 * fq;
#pragma unroll
        for (int ai = 0; ai < 2; ++ai)
#pragma unroll
            for (int m = 0; m < 4; ++m) { const size_t ro = (size_t)(row0 + ai * HALF + m * 16) * ldc + col0;
#pragma unroll
                for (int bj = 0; bj < 2; ++bj)
#pragma unroll
                    for (int n = 0; n < 2; ++n) { const f32x4 rs = *(const f32x4*)(Res + ro + bj * HALF + n * 16); *(f32x4*)(C + ro + bj * HALF + n * 16) = acc[ai][bj][m][n] + rs; } }
    }
};
struct EpiRes2 {
    static constexpr bool PERM = false;
    float* C; const float* Res; bf16_t* Cb; float* SSQ; int ldc;
    __device__ __forceinline__ void operator()(const f32x4 (&acc)[2][2][4][2], const Unit& u, int wr, int wc, int fr, int fq) const {
        const int row0 = u.pm * BM + wr * 64 + fr, col0 = u.pn * BM + wc * 32 + 4 * fq;
#pragma unroll
        for (int ai = 0; ai < 2; ++ai)
#pragma unroll
            for (int m = 0; m < 4; ++m) { const int row = row0 + ai * HALF + m * 16; const size_t ro = (size_t)row * ldc + col0; float ss = 0.f;
#pragma unroll
                for (int bj = 0; bj < 2; ++bj)
#pragma unroll
                    for (int n = 0; n < 2; ++n) { const f32x4 v = acc[ai][bj][m][n] + *(const f32x4*)(Res + ro + bj * HALF + n * 16);
                        *(f32x4*)(C + ro + bj * HALF + n * 16) = v;
                        u32x2 wv; wv.x = cvt_pk_bf16(v[0], v[1]); wv.y = cvt_pk_bf16(v[2], v[3]); *(u32x2*)(Cb + ro + bj * HALF + n * 16) = wv;
                        ss += v[0] * v[0] + v[1] * v[1] + v[2] * v[2] + v[3] * v[3]; }
                ss += __shfl_xor(ss, 16); ss += __shfl_xor(ss, 32);
                if (fq == 0) SSQ[(size_t)row * 32 + u.pn * 4 + wc] = ss; }
    }
};
struct EpiRowScaleF32 {
    static constexpr bool PERM = false;
    float* C; const float* SSQ; int ldc;
    __device__ __forceinline__ void operator()(const f32x4 (&acc)[2][2][4][2], const Unit& u, int wr, int wc, int fr, int fq) const {
        const int row0 = u.pm * BM + wr * 64 + fr, col0 = u.pn * BM + wc * 32 + 4 * fq;
#pragma unroll
        for (int ai = 0; ai < 2; ++ai)
#pragma unroll
            for (int m = 0; m < 4; ++m) { const int row = row0 + ai * HALF + m * 16; const size_t ro = (size_t)row * ldc + col0;
                const f32x4* sp = (const f32x4*)(SSQ + (size_t)row * 32); float sq = 0.f;
#pragma unroll
                for (int q = 0; q < 8; ++q) { const f32x4 v = sp[q]; sq += (v[0] + v[1]) + (v[2] + v[3]); }
                const float rs = rsqrtf(sq * (1.0f / 2048.0f) + 1e-6f);
#pragma unroll
                for (int bj = 0; bj < 2; ++bj)
#pragma unroll
                    for (int n = 0; n < 2; ++n) *(f32x4*)(C + ro + bj * HALF + n * 16) = acc[ai][bj][m][n] * rs; }
    }
};
struct EpiF32 {
    static constexpr bool PERM = false;
    float* C; int ldc;
    __device__ __forceinline__ void operator()(const f32x4 (&acc)[2][2][4][2], const Unit& u, int wr, int wc, int fr, int fq) const {
        const int row0 = u.pm * BM + wr * 64 + fr, col0 = u.pn * BM + wc * 32 + 4 * fq;
#pragma unroll
        for (int ai = 0; ai < 2; ++ai)
#pragma unroll
            for (int m = 0; m < 4; ++m) { const size_t ro = (size_t)(row0 + ai * HALF + m * 16) * ldc + col0;
#pragma unroll
                for (int bj = 0; bj < 2; ++bj)
#pragma unroll
                    for (int n = 0; n < 2; ++n) *(f32x4*)(C + ro + bj * HALF + n * 16) = acc[ai][bj][m][n]; }
    }
};
struct EpiBf16 {
    static constexpr bool PERM = true;
    bf16_t* O; int ldc;
    __device__ __forceinline__ void operator()(const f32x4 (&acc)[2][2][4][2], const Unit& u, int wr, int wc, int fr, int fq) const {
        const int row0 = u.pm * BM + wr * 64 + fr; const int col0 = u.pn * BM + wc * 32 + 8 * fq;
#pragma unroll
        for (int ai = 0; ai < 2; ++ai)
#pragma unroll
            for (int m = 0; m < 4; ++m) { bf16_t* rowp = O + (size_t)(row0 + ai * HALF + m * 16) * ldc + col0;
#pragma unroll
                for (int bj = 0; bj < 2; ++bj) { const f32x4 v0 = acc[ai][bj][m][0], v1 = acc[ai][bj][m][1];
                    u32x4 w; w.x = cvt_pk_bf16(v0[0], v0[1]); w.y = cvt_pk_bf16(v0[2], v0[3]); w.z = cvt_pk_bf16(v1[0], v1[1]); w.w = cvt_pk_bf16(v1[2], v1[3]);
                    *(u32x4*)(rowp + bj * HALF) = w; } }
    }
};

template <class Epi, class Sched>
__device__ __forceinline__ void gemm_phase(LAS unsigned char* lds, const Gemm g, const Sched& S, const Epi& E) {
    const int tid = threadIdx.x, wid = __builtin_amdgcn_readfirstlane(tid >> 6), lane = tid & 63, wr = wid >> 2, wc = wid & 3, fr = lane & 15, fq = lane >> 4;
    const int K = g.K, nt = K / BK;
    unsigned voffA[2], voffB[2];
#pragma unroll
    for (int i = 0; i < 2; ++i) { int R, C; stage_rc(tid * 16 + i * 8192, R, C); const int Rb = Epi::PERM ? ((R & ~31) + perm32(R & 31)) : R;
        voffA[i] = (unsigned)(R * K + C) * 2u; voffB[i] = (unsigned)(Rb * K + C) * 2u; }
    const size_t kstep = (size_t)(BK * 2);
    const size_t hstep = (size_t)HALF * K * 2;
    const size_t tstep = 2 * hstep;
    const unsigned ldsw = (unsigned)wid * 1024u;
    const int aoff = lds_byte(wr * 64 + fr, fq * 8), boff = lds_byte(wc * 32 + fr, fq * 8);
#define PG8_SA(b, h) (((b) * 2 + (h)) * HTB)
#define PG8_SB(b, h) ((4 + (b) * 2 + (h)) * HTB)
#define PG8_STAGE(bufoff, gbase, voff) do { _Pragma("unroll") for (int _i = 0; _i < 2; ++_i) \
        __builtin_amdgcn_global_load_lds((const unsigned*)((const char*)(gbase) + (voff)[_i]), (LAS unsigned*)(lds + (bufoff) + ldsw + _i * 8192), 16, 0, 0); } while (0)
#define PG8_LDA(dst, b, h) do { _Pragma("unroll") for (int m = 0; m < 4; ++m) _Pragma("unroll") for (int k = 0; k < 2; ++k) dst[m][k] = *(const LAS bf16x8*)(lds + PG8_SA(b, h) + aoff + m * 2048 + k * 1024); } while (0)
#define PG8_LDB(dst, b, h) do { _Pragma("unroll") for (int n = 0; n < 2; ++n) _Pragma("unroll") for (int k = 0; k < 2; ++k) dst[n][k] = *(const LAS bf16x8*)(lds + PG8_SB(b, h) + boff + n * 2048 + k * 1024); } while (0)
#define PG8_MMA(ai, bj, At, Bt) do { __builtin_amdgcn_s_setprio(1); _Pragma("unroll") for (int m = 0; m < 4; ++m) _Pragma("unroll") for (int n = 0; n < 2; ++n) _Pragma("unroll") for (int k = 0; k < 2; ++k) \
        acc[ai][bj][m][n] = __builtin_amdgcn_mfma_f32_16x16x32_bf16(Bt[n][k], At[m][k], acc[ai][bj][m][n], 0, 0, 0); __builtin_amdgcn_s_setprio(0); } while (0)
#define PG8_WAIT_V(n) asm volatile("s_waitcnt vmcnt(" #n ")" ::: "memory")
#define PG8_WAIT_L(n) asm volatile("s_waitcnt lgkmcnt(" #n ")" ::: "memory")
#define PG8_BAR __builtin_amdgcn_s_barrier()
#define PG8_SCHED __builtin_amdgcn_sched_barrier(0)
    Unit cur, nxt; int ui = 0;
    if (!S.next(0, cur)) return;
    f32x4 acc[2][2][4][2];
#pragma unroll
    for (int a = 0; a < 2; ++a)
#pragma unroll
        for (int b = 0; b < 2; ++b)
#pragma unroll
            for (int m = 0; m < 4; ++m)
#pragma unroll
                for (int n = 0; n < 2; ++n) acc[a][b][m][n] = (f32x4){0.f, 0.f, 0.f, 0.f};
    bf16x8 At[4][2], B0[2][2], B1[2][2];
    const char* cA = (const char*)g.A + (size_t)cur.pm * tstep; const char* cB = (const char*)g.Bt + (size_t)cur.pn * tstep;
    S.a_ready(cur);
    PG8_STAGE(PG8_SB(0, 0), cB, voffB); PG8_STAGE(PG8_SA(0, 0), cA, voffA); PG8_STAGE(PG8_SB(0, 1), cB + hstep, voffB); PG8_STAGE(PG8_SA(0, 1), cA + hstep, voffA);
    if (wr == 1) PG8_BAR;
    PG8_WAIT_V(4); PG8_BAR;
    PG8_STAGE(PG8_SB(1, 0), cB + kstep, voffB); PG8_STAGE(PG8_SA(1, 0), cA + kstep, voffA); PG8_STAGE(PG8_SB(1, 1), cB + hstep + kstep, voffB);
    PG8_WAIT_V(6); PG8_BAR;
    for (;;) {
        const bool has_next = S.next(ui + 1, nxt);
        const char* nA = has_next ? (const char*)g.A + (size_t)nxt.pm * tstep : cA; const char* nB = has_next ? (const char*)g.Bt + (size_t)nxt.pn * tstep : cB;
        for (int t = 0; t < nt; t += 2) {
            const bool last = (t == nt - 2);
            const char* a1 = cA + (size_t)(t + 1) * kstep;
            const char* a2 = last ? nA : cA + (size_t)(t + 2) * kstep; const char* b2 = last ? nB : cB + (size_t)(t + 2) * kstep;
            const char* a3 = a2 + kstep; const char* b3 = b2 + kstep;
            if (last && has_next) S.a_ready(nxt);
            PG8_LDB(B0, 0, 0); PG8_SCHED; PG8_LDA(At, 0, 0); PG8_STAGE(PG8_SA(1, 1), a1 + hstep, voffA);
            PG8_WAIT_L(8); PG8_BAR; PG8_WAIT_L(0); PG8_MMA(0, 0, At, B0); PG8_BAR; PG8_SCHED;
            PG8_LDB(B1, 0, 1); PG8_STAGE(PG8_SB(0, 0), b2, voffB);
            PG8_BAR; PG8_WAIT_L(0); PG8_MMA(0, 1, At, B1); PG8_BAR;
            PG8_LDA(At, 0, 1); PG8_STAGE(PG8_SA(0, 0), a2, voffA);
            PG8_BAR; PG8_WAIT_L(0); PG8_MMA(1, 0, At, B0); PG8_BAR; PG8_SCHED;
            PG8_STAGE(PG8_SB(0, 1), b2 + hstep, voffB);
            PG8_WAIT_V(6); PG8_BAR; PG8_MMA(1, 1, At, B1); PG8_BAR;
            PG8_LDB(B0, 1, 0); PG8_SCHED; PG8_LDA(At, 1, 0); PG8_STAGE(PG8_SA(0, 1), a2 + hstep, voffA);
            PG8_WAIT_L(8); PG8_BAR; PG8_WAIT_L(0); PG8_MMA(0, 0, At, B0); PG8_BAR; PG8_SCHED;
            PG8_LDB(B1, 1, 1); PG8_STAGE(PG8_SB(1, 0), b3, voffB);
            PG8_BAR; PG8_WAIT_L(0); PG8_MMA(0, 1, At, B1); PG8_BAR;
            PG8_LDA(At, 1, 1); PG8_STAGE(PG8_SA(1, 0), a3, voffA);
            PG8_BAR; PG8_WAIT_L(0); PG8_MMA(1, 0, At, B0); PG8_BAR; PG8_SCHED;
            PG8_STAGE(PG8_SB(1, 1), b3 + hstep, voffB);
            PG8_WAIT_V(6); PG8_BAR; PG8_MMA(1, 1, At, B1); PG8_BAR;
        }
        E(acc, cur, wr, wc, fr, fq); S.done(cur);
        if (!has_next) break;
#pragma unroll
        for (int a = 0; a < 2; ++a)
#pragma unroll
            for (int b = 0; b < 2; ++b)
#pragma unroll
                for (int m = 0; m < 4; ++m)
#pragma unroll
                    for (int n = 0; n < 2; ++n) acc[a][b][m][n] = (f32x4){0.f, 0.f, 0.f, 0.f};
        cur = nxt; cA = nA; cB = nB; ++ui;
    }
    PG8_WAIT_V(0);
    if (wr == 0) PG8_BAR;
    PG8_BAR;
#undef PG8_SA
#undef PG8_SB
#undef PG8_STAGE
#undef PG8_LDA
#undef PG8_LDB
#undef PG8_MMA
#undef PG8_WAIT_V
#undef PG8_WAIT_L
#undef PG8_BAR
#undef PG8_SCHED
}
}

__device__ __forceinline__ void rmsnorm_rows(const float* X, const float* gain, bf16_t* H) {
    const int wave = threadIdx.x >> 6, lane = threadIdx.x & 63;
    for (int row = blockIdx.x * 8 + wave; row < S_; row += gridDim.x * 8) {
        const float4* xr = (const float4*)(X + (size_t)row * D_);
        float4 v[8]; float ss = 0.f;
#pragma unroll
        for (int i = 0; i < 8; ++i) { v[i] = xr[i * 64 + lane]; ss += v[i].x * v[i].x + v[i].y * v[i].y + v[i].z * v[i].z + v[i].w * v[i].w; }
        ss = wave_sum(ss);
        const float sc = rsqrtf(ss * (1.0f / 2048.0f) + 1e-6f);
#pragma unroll
        for (int i = 0; i < 8; ++i) { const float4 g = ((const float4*)gain)[i * 64 + lane];
            u32x2 w; w.x = cvt_pk_bf16(v[i].x * sc * g.x, v[i].y * sc * g.y); w.y = cvt_pk_bf16(v[i].z * sc * g.z, v[i].w * sc * g.w);
            *(u32x2*)(H + (size_t)row * D_ + (i * 64 + lane) * 4) = w; }
    }
}

__device__ __forceinline__ void transpose_convert(const float* W, int K, int N, bf16_t* Bt, float* tile, int bid, int nblk) {
    const int tid = threadIdx.x; const int tk = K / 64, tn = N / 64, nt = tk * tn;
    float4 rg[2];
#define TC_LOAD(u) do { const int _k0 = ((u) / tn) * 64, _n0 = ((u) % tn) * 64; _Pragma("unroll") for (int i = 0; i < 2; ++i) { const int idx = tid + 512 * i; \
        rg[i] = *(const float4*)(W + (size_t)(_k0 + (idx >> 4)) * N + _n0 + (idx & 15) * 4); } } while (0)
    if (bid < nt) TC_LOAD(bid);
    for (int u = bid; u < nt; u += nblk) {
        const int k0 = (u / tn) * 64, n0 = (u % tn) * 64;
        __syncthreads();
#pragma unroll
        for (int i = 0; i < 2; ++i) { const int idx = tid + 512 * i; float* q = tile + (idx >> 4) * 65 + (idx & 15) * 4; q[0] = rg[i].x; q[1] = rg[i].y; q[2] = rg[i].z; q[3] = rg[i].w; }
        __syncthreads();
        if (u + nblk < nt) TC_LOAD(u + nblk);
#pragma unroll
        for (int i = 0; i < 4; ++i) { const int nn = i * 16 + (tid >> 5), kp = (tid & 31) * 2;
            *(unsigned*)(Bt + (size_t)(n0 + nn) * K + k0 + kp) = cvt_pk_bf16(tile[kp * 65 + nn], tile[(kp + 1) * 65 + nn]); }
    }
#undef TC_LOAD
}

__device__ __forceinline__ void convert_flat(const float* src, bf16_t* dst, size_t n) {
    for (size_t i = ((size_t)blockIdx.x * 512 + threadIdx.x) * 8; i < n; i += (size_t)gridDim.x * 512 * 8) {
        const float4 a = *(const float4*)(src + i), b = *(const float4*)(src + i + 4);
        u32x4 w; w.x = cvt_pk_bf16(a.x, a.y); w.y = cvt_pk_bf16(a.z, a.w); w.z = cvt_pk_bf16(b.x, b.y); w.w = cvt_pk_bf16(b.z, b.w);
        *(u32x4*)(dst + i) = w;
    }
}

__device__ __forceinline__ void convert_fp8(const float* src, unsigned char* dst, size_t n, float sc, const float* colgain, int bid, int nblk) {
    const int lane = threadIdx.x & 63, wv = threadIdx.x >> 6;
    for (size_t base = ((size_t)bid * 8 + wv) * 1024; base < n; base += (size_t)nblk * 8 * 1024) {
        float4 a[4];
#pragma unroll
        for (int j = 0; j < 4; ++j) a[j] = *(const float4*)(src + base + (size_t)(j * 64 + lane) * 4);
#pragma unroll
        for (int j = 0; j < 4; ++j) { float4 gg = make_float4(sc, sc, sc, sc);
            if (colgain) { const float4 cgv = *(const float4*)(colgain + ((base + (size_t)(j * 64 + lane) * 4) & 2047)); gg.x *= cgv.x; gg.y *= cgv.y; gg.z *= cgv.z; gg.w *= cgv.w; }
            int x = __builtin_amdgcn_cvt_pk_fp8_f32(a[j].x * gg.x, a[j].y * gg.y, 0, false); x = __builtin_amdgcn_cvt_pk_fp8_f32(a[j].z * gg.z, a[j].w * gg.w, x, true);
            *(unsigned*)(dst + base + (size_t)(j * 64 + lane) * 4) = (unsigned)x; }
    }
}

constexpr int ROW6 = 1536;
constexpr float U6_SCALE = 56.f, V6_SCALE = 28.f;
__device__ __forceinline__ void convert_fp6(const float* src, unsigned char* dst, int nrows, float sc, const float* colgain, int bid, int nblk) {
    const int lane = threadIdx.x & 63, wv = threadIdx.x >> 6;
    float g[32];
#pragma unroll
    for (int j = 0; j < 8; ++j) { float4 cg = make_float4(1.f, 1.f, 1.f, 1.f); if (colgain) cg = *(const float4*)(colgain + (j * 64 + lane) * 4);
        g[j * 4] = sc * cg.x; g[j * 4 + 1] = sc * cg.y; g[j * 4 + 2] = sc * cg.z; g[j * 4 + 3] = sc * cg.w; }
    for (int row = bid * 8 + wv; row < nrows; row += nblk * 8) {
        f32x32 x;
#pragma unroll
        for (int j = 0; j < 8; ++j) { const f32x4 a = __builtin_nontemporal_load((const f32x4*)(src + (size_t)row * 2048 + (j * 64 + lane) * 4));
            x[j * 4] = a[0] * g[j * 4]; x[j * 4 + 1] = a[1] * g[j * 4 + 1]; x[j * 4 + 2] = a[2] * g[j * 4 + 2]; x[j * 4 + 3] = a[3] * g[j * 4 + 3]; }
        const bf16x32_t b = __builtin_convertvector(x, bf16x32_t);
        const u32x6 wv6 = __builtin_amdgcn_cvt_scalef32_pk32_fp6_bf16(b, 1.0f);
        *(u32x4*)(dst + (size_t)row * ROW6 + lane * 16) = (u32x4){wv6[0], wv6[1], wv6[2], wv6[3]};
        *(u32x2*)(dst + (size_t)row * ROW6 + 1024 + lane * 8) = (u32x2){wv6[4], wv6[5]};
    }
}

__device__ __forceinline__ void build_wpt(const float* wq, const float* gain, const bf16_t* KEYB, bf16_t* WPT, int bid, int nblk) {
    const int w = threadIdx.x >> 6, lane = threadIdx.x & 63, fr = lane & 15, fq = lane >> 4;
    for (int task = bid * 8 + w; task < 16 * 128; task += nblk * 8) {
        const int g = task >> 7, kb = task & 127;
        f32x4 acc[8];
#pragma unroll
        for (int n = 0; n < 8; ++n) acc[n] = (f32x4){0.f, 0.f, 0.f, 0.f};
#pragma unroll 2
        for (int ks = 0; ks < 8; ++ks) {
            const float4* wp = (const float4*)(wq + (size_t)(kb * 16 + fr) * 4096 + g * 256 + ks * 32 + fq * 8);
            const float4 x0 = wp[0], x1 = wp[1]; const float gk = gain[kb * 16 + fr];
            u32x4 wv; wv.x = cvt_pk_bf16(x0.x * gk, x0.y * gk); wv.y = cvt_pk_bf16(x0.z * gk, x0.w * gk); wv.z = cvt_pk_bf16(x1.x * gk, x1.y * gk); wv.w = cvt_pk_bf16(x1.z * gk, x1.w * gk);
            const bf16x8 a = __builtin_bit_cast(bf16x8, wv);
#pragma unroll
            for (int n = 0; n < 8; ++n) {
                const bf16x8 b = *(const bf16x8*)(KEYB + (size_t)(g * 128 + n * 16 + fr) * 256 + ks * 32 + fq * 8);
                acc[n] = __builtin_amdgcn_mfma_f32_16x16x32_bf16(a, b, acc[n], 0, 0, 0);
            }
        }
#pragma unroll
        for (int n = 0; n < 8; ++n) { u32x2 o; o.x = cvt_pk_bf16(acc[n][0], acc[n][1]); o.y = cvt_pk_bf16(acc[n][2], acc[n][3]);
            *(u32x2*)(WPT + (size_t)(g * 128 + n * 16 + fr) * 2048 + kb * 16 + fq * 4) = o; }
    }
}

__device__ __forceinline__ void phase0(const Params& p, unsigned char* shm) {
    bf16_t* WB1 = (bf16_t*)(p.ws + WS_WB1);
    rmsnorm_rows(p.in[0], p.in[1], (bf16_t*)(p.ws + WS_H));
    transpose_convert(p.in[2], 2048, 6144, WB1, (float*)shm, blockIdx.x, gridDim.x);
    const float* mu = p.in[4]; const float* w1 = p.in[6]; const float* a1 = p.in[9]; const float* g1 = p.in[11];
    for (int idx = blockIdx.x * 512 + threadIdx.x; idx < 768 * 2048; idx += gridDim.x * 512) {
        const int j = idx >> 11, k = idx & 2047; float val = 0.f;
        if (j < 128) { const float m = mu[k], w = w1[k * 64 + (j & 63)]; val = (j < 64) ? w * (1.f - m) : w * m; }
        else if (j < 256) { const float m = mu[2048 + k], w = a1[k * 64 + (j & 63)]; val = (j < 192) ? w * (1.f - m) : w * m; }
        else if (j < 576) { const float m = mu[4096 + k]; const int jj = j - 256; const int c = jj < 160 ? jj : jj - 160; const float w = g1[k * 160 + c]; val = jj < 160 ? w * (1.f - m) : w * m; }
        WB1[(size_t)(6144 + j) * 2048 + k] = f2bf(val);
    }
    convert_flat(p.in[22], (bf16_t*)(p.ws + WS_KEYB), (size_t)8 * 2 * 128 * 256);
    bf16_t* W2T = (bf16_t*)(p.ws + WS_W2T); bf16_t* A2T = (bf16_t*)(p.ws + WS_A2T); bf16_t* G2T = (bf16_t*)(p.ws + WS_G2T);
    const float* w2 = p.in[7]; const float* a2 = p.in[10]; const float* g2 = p.in[12];
    for (int idx = blockIdx.x * 512 + threadIdx.x; idx < 1024 * 288; idx += gridDim.x * 512) {
        if (idx < 65536) { const int c = idx >> 6, j = idx & 63; W2T[idx] = f2bf(w2[j * 1024 + c]); }
        else if (idx < 131072) { const int i2 = idx - 65536; const int c = i2 >> 6, j = i2 & 63; A2T[i2] = f2bf(a2[j * 1024 + c]); }
        else { const int i2 = idx - 131072; const int c = i2 / 160, j = i2 % 160; G2T[i2] = f2bf(g2[j * 1024 + c]); }
    }
}

constexpr int ACT_LD = 296;
template <int KS, int KOFF, int KTOT, int KIND>
__device__ __forceinline__ void lora_stage(const LAS bf16_t* act, const bf16_t* WT, const float* bias, bf16_t* OUT, int t0, int w, int fr, int fq) {
#pragma unroll 1
    for (int nh = 0; nh < 2; ++nh) {
        f32x4 acc[4][4];
#pragma unroll
        for (int m = 0; m < 4; ++m)
#pragma unroll
            for (int n = 0; n < 4; ++n) acc[m][n] = (f32x4){0.f, 0.f, 0.f, 0.f};
        bf16x8 bfr[KS][4];
#pragma unroll
        for (int ks = 0; ks < KS; ++ks)
#pragma unroll
            for (int n = 0; n < 4; ++n) bfr[ks][n] = *(const bf16x8*)(WT + (size_t)(w * 128 + (nh * 4 + n) * 16 + fr) * KTOT + ks * 32 + fq * 8);
#pragma unroll
        for (int ks = 0; ks < KS; ++ks) {
            bf16x8 a[4];
#pragma unroll
            for (int m = 0; m < 4; ++m) a[m] = *(const LAS bf16x8*)(act + (m * 16 + fr) * ACT_LD + KOFF + ks * 32 + fq * 8);
#pragma unroll
            for (int n = 0; n < 4; ++n)
#pragma unroll
                for (int m = 0; m < 4; ++m) acc[m][n] = __builtin_amdgcn_mfma_f32_16x16x32_bf16(bfr[ks][n], a[m], acc[m][n], 0, 0, 0);
        }
#pragma unroll
        for (int n = 0; n < 4; ++n) {
            const int c = w * 128 + (nh * 4 + n) * 16 + fq * 4;
            float bs[4] = {0.f, 0.f, 0.f, 0.f};
            if (KIND < 2) { const float4 bv = *(const float4*)(bias + c); bs[0] = bv.x; bs[1] = bv.y; bs[2] = bv.z; bs[3] = bv.w; }
#pragma unroll
            for (int m = 0; m < 4; ++m) {
                float o[4];
#pragma unroll
                for (int j = 0; j < 4; ++j) {
                    const float val = acc[m][n][j];
                    if (KIND == 0) { const float x = -(bs[j] + val); const float sp = fmaxf(x, 0.f) + __logf(1.f + __expf(-fabsf(x))); o[j] = -__expf(-sp - 0.5f); }
                    else if (KIND == 1) o[j] = sigmoidf_(bs[j] + val);
                    else o[j] = val;
                }
                u32x2 wv; wv.x = cvt_pk_bf16(o[0], o[1]); wv.y = cvt_pk_bf16(o[2], o[3]);
                *(u32x2*)(OUT + (size_t)(t0 + m * 16 + fr) * DR + c) = wv;
            }
        }
    }
}
__device__ __forceinline__ void phase_prepM(const Params& p, LAS unsigned char* lds) {
    LAS bf16_t* act = (LAS bf16_t*)lds;
    const bf16_t* P = (const bf16_t*)(p.ws + WS_PROJ);
    const int tid = threadIdx.x, w = tid >> 6, lane = tid & 63, fr = lane & 15, fq = lane >> 4;
    for (int tile = blockIdx.x; tile < S_ / 64; tile += gridDim.x) {
        const int t0 = tile * 64;
        __syncthreads();
        for (int task = tid; task < 64 * 36; task += 512) {
            const int t = task / 36, j0 = (task % 36) * 8; const int tg = t0 + t;
            int ccur, cprev;
            if (j0 < 64) { ccur = 6144 + j0; cprev = 6208 + j0; }
            else if (j0 < 128) { ccur = 6272 + (j0 - 64); cprev = 6336 + (j0 - 64); }
            else { ccur = 6400 + (j0 - 128); cprev = 6560 + (j0 - 128); }
            float cu[8], pv[8], o8[8];
            unpack8(*(const u32x4*)(P + (size_t)tg * NAUG + ccur), cu);
            if (tg > 0) unpack8(*(const u32x4*)(P + (size_t)(tg - 1) * NAUG + cprev), pv);
            else {
#pragma unroll
                for (int i = 0; i < 8; ++i) pv[i] = 0.f;
            }
#pragma unroll
            for (int i = 0; i < 8; ++i) { const float sv = cu[i] + pv[i];
                o8[i] = j0 < 64 ? (1.f - 2.f / (1.f + __expf(2.f * sv))) : (j0 < 128 ? sv : sigmoidf_(sv)); }
            *(LAS u32x4*)(act + t * ACT_LD + j0) = pack8(o8);
        }
        __syncthreads();
        lora_stage<2, 0, 64, 0>(act, (const bf16_t*)(p.ws + WS_W2T), p.in[5], (bf16_t*)(p.ws + WS_LW), t0, w, fr, fq);
        lora_stage<2, 64, 64, 1>(act, (const bf16_t*)(p.ws + WS_A2T), p.in[8], (bf16_t*)(p.ws + WS_A), t0, w, fr, fq);
        lora_stage<5, 128, 160, 2>(act, (const bf16_t*)(p.ws + WS_G2T), nullptr, (bf16_t*)(p.ws + WS_G), t0, w, fr, fq);
    }
}

__device__ __forceinline__ void phase_prepE(const Params& p) {
    const bf16_t* P = (const bf16_t*)(p.ws + WS_PROJ);
    bf16_t* R = (bf16_t*)(p.ws + WS_R); bf16_t* Kk = (bf16_t*)(p.ws + WS_K); bf16_t* V = (bf16_t*)(p.ws + WS_V); bf16_t* KK = (bf16_t*)(p.ws + WS_KK); bf16_t* YC = (bf16_t*)(p.ws + WS_YC);
    const float* mu_rkv = p.in[3]; const float* k_k = p.in[13]; const float* cw = p.in[18];
    const int tid = threadIdx.x, cg = tid & 127, c0 = cg * 8, tgrp = tid >> 7;
    float mr[8], mk[8], mv[8], kkc[8], cw0[8], cw1[8], cw2[8];
#pragma unroll
    for (int i = 0; i < 8; ++i) { mr[i] = mu_rkv[c0 + i]; mk[i] = mu_rkv[1024 + c0 + i]; mv[i] = mu_rkv[2048 + c0 + i]; kkc[i] = k_k[c0 + i]; cw0[i] = cw[c0 + i]; cw1[i] = cw[1024 + c0 + i]; cw2[i] = cw[2048 + c0 + i]; }
    for (int run = blockIdx.x * 4 + tgrp; run < S_ / 16; run += gridDim.x * 4) {
        const int t0 = run * 16;
        float pr[8], pk[8], pv[8], u1[8], u2[8];
#pragma unroll
        for (int i = 0; i < 8; ++i) { pr[i] = 0.f; pk[i] = 0.f; pv[i] = 0.f; u1[i] = 0.f; u2[i] = 0.f; }
        if (t0 > 0) {
            const size_t o = (size_t)(t0 - 1) * NAUG + c0;
            unpack8(*(const u32x4*)(P + o), pr); unpack8(*(const u32x4*)(P + o + 1024), pk); unpack8(*(const u32x4*)(P + o + 2048), pv);
            float x[8], y[8];
            unpack8(*(const u32x4*)(P + o + 4096), x); unpack8(*(const u32x4*)(P + o + 5120), y);
#pragma unroll
            for (int i = 0; i < 8; ++i) u1[i] = x[i] * y[i];
            unpack8(*(const u32x4*)(P + o - NAUG + 4096), x); unpack8(*(const u32x4*)(P + o - NAUG + 5120), y);
#pragma unroll
            for (int i = 0; i < 8; ++i) u2[i] = x[i] * y[i];
        }
        u32x4 nx[6];
        { const size_t o = (size_t)t0 * NAUG + c0;
#pragma unroll
          for (int q = 0; q < 6; ++q) nx[q] = *(const u32x4*)(P + o + 1024 * q); }
#pragma unroll 1
        for (int t = 0; t < 16; ++t) {
            float cr[8], ck[8], cv[8], bg[8], cgt[8], xc[8];
            unpack8(nx[0], cr); unpack8(nx[1], ck); unpack8(nx[2], cv); unpack8(nx[3], bg); unpack8(nx[4], cgt); unpack8(nx[5], xc);
            { const size_t o = (size_t)(t0 + (t < 15 ? t + 1 : t)) * NAUG + c0;
#pragma unroll
              for (int q = 0; q < 6; ++q) nx[q] = *(const u32x4*)(P + o + 1024 * q); }
            float r[8], k[8], v[8], kkv[8], yc[8]; float ss = 0.f;
#pragma unroll
            for (int i = 0; i < 8; ++i) {
                r[i] = cr[i] + (pr[i] - cr[i]) * mr[i]; k[i] = ck[i] + (pk[i] - ck[i]) * mk[i]; v[i] = cv[i] + (pv[i] - cv[i]) * mv[i];
                pr[i] = cr[i]; pk[i] = ck[i]; pv[i] = cv[i];
                kkv[i] = k[i] * kkc[i]; ss += kkv[i] * kkv[i];
                const float u0 = cgt[i] * xc[i];
                yc[i] = bg[i] * (cw0[i] * u2[i] + cw1[i] * u1[i] + cw2[i] * u0);
                u2[i] = u1[i]; u1[i] = u0;
            }
            ss += dpp_f<0xB1, 0xf>(ss); ss += dpp_f<0x4E, 0xf>(ss); ss += dpp_f<0x141, 0xf>(ss);
            const float inv = 1.0f / fmaxf(sqrtf(ss), 1e-12f);
#pragma unroll
            for (int i = 0; i < 8; ++i) kkv[i] *= inv;
            const size_t oo = (size_t)(t0 + t) * DR + c0;
            *(u32x4*)(R + oo) = pack8(r); *(u32x4*)(Kk + oo) = pack8(k); *(u32x4*)(V + oo) = pack8(v); *(u32x4*)(KK + oo) = pack8(kkv); *(u32x4*)(YC + oo) = pack8(yc);
        }
    }
}

#define TILE(i) ((LAS bf16_t*)(lds + (i) * TSLOT))
__device__ __forceinline__ f32x4 mm_tile(f32x4 acc, const LAS bf16_t* A, const LAS bf16_t* Bt, int mi, int ni, int fr, int fq) {
#pragma unroll
    for (int ks = 0; ks < 2; ++ks) {
        const bf16x8 a = *(const LAS bf16x8*)(A + (mi * 16 + fr) * TLD + ks * 32 + fq * 8);
        const bf16x8 b = *(const LAS bf16x8*)(Bt + (ni * 16 + fr) * TLD + ks * 32 + fq * 8);
        acc = __builtin_amdgcn_mfma_f32_16x16x32_bf16(a, b, acc, 0, 0, 0);
    }
    return acc;
}
__device__ __forceinline__ void st_rm(LAS bf16_t* X, f32x4 v, int mi, int ni, int fr, int fq) {
    const unsigned w0 = cvt_pk_bf16(v[0], v[1]), w1 = cvt_pk_bf16(v[2], v[3]);
    LAS bf16_t* q = X + (mi * 16 + fq * 4) * TLD + ni * 16 + fr;
    q[0] = (bf16_t)(w0 & 0xffffu); q[TLD] = (bf16_t)(w0 >> 16); q[2 * TLD] = (bf16_t)(w1 & 0xffffu); q[3 * TLD] = (bf16_t)(w1 >> 16);
}
__device__ __forceinline__ void st_tr(LAS bf16_t* XT, f32x4 v, int mi, int ni, int fr, int fq) {
    u32x2 w; w.x = cvt_pk_bf16(v[0], v[1]); w.y = cvt_pk_bf16(v[2], v[3]);
    *(LAS u32x2*)(XT + (ni * 16 + fr) * TLD + mi * 16 + fq * 4) = w;
}
__device__ __forceinline__ f32x4 ld_rm(const LAS bf16_t* X, int mi, int ni, int fr, int fq) {
    const LAS bf16_t* q = X + (mi * 16 + fq * 4) * TLD + ni * 16 + fr;
    return (f32x4){bf2f(q[0]), bf2f(q[TLD]), bf2f(q[2 * TLD]), bf2f(q[3 * TLD])};
}
__device__ __forceinline__ f32x4 ld_tr(const LAS bf16_t* XT, int mi, int ni, int fr, int fq) {
    const u32x2 w = *(const LAS u32x2*)(XT + (ni * 16 + fr) * TLD + mi * 16 + fq * 4);
    return (f32x4){lo_bf(w.x), hi_bf(w.x), lo_bf(w.y), hi_bf(w.y)};
}

__device__ __forceinline__ void phase_chunkA(const Params& p, LAS unsigned char* lds) {
    const int tid = threadIdx.x, w = tid >> 6, lane = tid & 63, fr = lane & 15, fq = lane >> 4;
    const int mi = w >> 1, nb = (w & 1) * 2;
    LAS float* cl = (LAS float*)(lds + 14 * TSLOT);
    LAS float* gs = (LAS float*)(lds + 16 * TSLOT);
    LAS float* wc = gs + 512;
    const bf16_t* R = (const bf16_t*)(p.ws + WS_R); const bf16_t* Kk = (const bf16_t*)(p.ws + WS_K); const bf16_t* V = (const bf16_t*)(p.ws + WS_V);
    const bf16_t* KK = (const bf16_t*)(p.ws + WS_KK); const bf16_t* A = (const bf16_t*)(p.ws + WS_A); const bf16_t* LW = (const bf16_t*)(p.ws + WS_LW);
    bf16_t* GT = (bf16_t*)(p.ws + WS_GT); float* HT = (float*)(p.ws + WS_HT); bf16_t* QE = (bf16_t*)(p.ws + WS_QE); bf16_t* YL = (bf16_t*)(p.ws + WS_YL);
    const f32x4 z4 = (f32x4){0.f, 0.f, 0.f, 0.f};
    const float* k_a = p.in[14]; const float* r_k = p.in[15]; float* BON = (float*)(p.ws + WS_BON);
    u32x4 nr4, nk4, nv4, nkk4, na4, nlw4;
#define CA_LOAD(it) do { const size_t _go = (size_t)(((it) >> 4) * 64 + (tid >> 3)) * DR + ((it) & 15) * 64 + (tid & 7) * 8; \
        nr4 = *(const u32x4*)(R + _go); nk4 = *(const u32x4*)(Kk + _go); nv4 = *(const u32x4*)(V + _go); nkk4 = *(const u32x4*)(KK + _go); na4 = *(const u32x4*)(A + _go); nlw4 = *(const u32x4*)(LW + _go); } while (0)
    for (int item = blockIdx.x; item < 4096; item += gridDim.x) {
        const int c = item >> 4, h = item & 15;
        const int t = tid >> 3, k0 = (tid & 7) * 8;
        if (item == (int)blockIdx.x) CA_LOAD(item);
        const u32x4 r4 = nr4, k4 = nk4, v4 = nv4, kk4 = nkk4, a4 = na4, lw4 = nlw4;
        __syncthreads();
        {
            float lwf8[8]; unpack8(lw4, lwf8);
            *(LAS f32x4*)(cl + t * 64 + k0) = (f32x4){lwf8[0], lwf8[1], lwf8[2], lwf8[3]};
            *(LAS f32x4*)(cl + t * 64 + k0 + 4) = (f32x4){lwf8[4], lwf8[5], lwf8[6], lwf8[7]};
            __syncthreads();
            const int g = w, k = lane;
            float pfx[8]; float run = 0.f;
#pragma unroll
            for (int i = 0; i < 8; ++i) { run += cl[(g * 8 + i) * 64 + k]; pfx[i] = run; }
            gs[g * 64 + k] = run;
            __syncthreads();
            float off = 0.f;
#pragma unroll
            for (int gg = 0; gg < 7; ++gg) { const float x = gs[gg * 64 + k]; off += (gg < g) ? x : 0.f; }
#pragma unroll
            for (int i = 0; i < 8; ++i) cl[(g * 8 + i) * 64 + k] = off + pfx[i];
            if (g == 7) wc[k] = __expf(off + pfx[7]);
            __syncthreads();
        }
        if (item + (int)gridDim.x < 4096) CA_LOAD(item + (int)gridDim.x);
        {
            float at[8], rt[8], bt[8], kt[8], bh[8], kh[8], vv[8]; float bsum = 0.f;
#pragma unroll
            for (int i = 0; i < 8; ++i) {
                const int q = i >> 1; const bool hi = i & 1;
                const float rf = hi ? hi_bf(r4[q]) : lo_bf(r4[q]), kraw = hi ? hi_bf(k4[q]) : lo_bf(k4[q]), vf = hi ? hi_bf(v4[q]) : lo_bf(v4[q]);
                const float kkf = hi ? hi_bf(kk4[q]) : lo_bf(kk4[q]), af = hi ? hi_bf(a4[q]) : lo_bf(a4[q]), lwf = hi ? hi_bf(lw4[q]) : lo_bf(lw4[q]);
                const float kf = kraw * (1.f + (af - 1.f) * k_a[h * 64 + k0 + i]);
                bsum += rf * kf * r_k[h * 64 + k0 + i];
                const float clv = cl[t * 64 + k0 + i], cle = cl[63 * 64 + k0 + i];
                const float e = __expf(clv), ex = __expf(clv - lwf), ei = __expf(-clv), eh = __expf(cle - clv);
                const float bb = kkf * af;
                at[i] = -kkf * ex; rt[i] = rf * e; bt[i] = bb * ei; kt[i] = kf * ei; bh[i] = bb * eh; kh[i] = kf * eh; vv[i] = vf;
            }
            bsum += dpp_f<0xB1, 0xf>(bsum); bsum += dpp_f<0x4E, 0xf>(bsum); bsum += dpp_f<0x141, 0xf>(bsum);
            if ((tid & 7) == 0) BON[(size_t)(c * 64 + t) * 16 + h] = bsum;
            *(LAS u32x4*)(TILE(0) + t * TLD + k0) = pack8(at);
            *(LAS u32x4*)(TILE(2) + t * TLD + k0) = pack8(rt);
            *(LAS u32x4*)(TILE(3) + t * TLD + k0) = pack8(bt);
            *(LAS u32x4*)(TILE(4) + t * TLD + k0) = pack8(kt);
            const u32x4 atp = pack8(at), bhp = pack8(bh), khp = pack8(kh);
#pragma unroll
            for (int i = 0; i < 8; ++i) {
                const int q = i >> 1; const bool hi = i & 1;
                TILE(1)[(k0 + i) * TLD + t] = (bf16_t)(hi ? (atp[q] >> 16) : (atp[q] & 0xffffu));
                TILE(5)[(k0 + i) * TLD + t] = (bf16_t)(hi ? (bhp[q] >> 16) : (bhp[q] & 0xffffu));
                TILE(6)[(k0 + i) * TLD + t] = (bf16_t)(hi ? (khp[q] >> 16) : (khp[q] & 0xffffu));
                TILE(7)[(k0 + i) * TLD + t] = (bf16_t)(hi ? (v4[q] >> 16) : (v4[q] & 0xffffu));
            }
            __syncthreads();
        }
#pragma unroll
        for (int nn = 0; nn < 2; ++nn) {
            const int ni = nb + nn; const int col = ni * 16 + fr, row0 = mi * 16 + fq * 4;
            f32x4 x = mm_tile(z4, TILE(0), TILE(3), mi, ni, fr, fq);
#pragma unroll
            for (int j = 0; j < 4; ++j) x[j] = (col < row0 + j) ? x[j] : 0.f;
            st_rm(TILE(8), x, mi, ni, fr, fq); st_tr(TILE(9), x, mi, ni, fr, fq);
            x = mm_tile(z4, TILE(0), TILE(4), mi, ni, fr, fq);
#pragma unroll
            for (int j = 0; j < 4; ++j) x[j] = (col < row0 + j) ? x[j] : 0.f;
            st_rm(TILE(10), x, mi, ni, fr, fq);
            x = mm_tile(z4, TILE(2), TILE(3), mi, ni, fr, fq);
#pragma unroll
            for (int j = 0; j < 4; ++j) x[j] = (col <= row0 + j) ? x[j] : 0.f;
            st_rm(TILE(11), x, mi, ni, fr, fq);
            x = mm_tile(z4, TILE(2), TILE(4), mi, ni, fr, fq);
#pragma unroll
            for (int j = 0; j < 4; ++j) x[j] = (col <= row0 + j) ? x[j] : 0.f;
            st_rm(TILE(12), x, mi, ni, fr, fq);
        }
        __syncthreads();
#pragma unroll
        for (int nn = 0; nn < 2; ++nn) {
            const int ni = nb + nn;
            st_tr(TILE(13), mm_tile(z4, TILE(10), TILE(7), mi, ni, fr, fq), mi, ni, fr, fq);
            const f32x4 x = mm_tile(z4, TILE(8), TILE(9), mi, ni, fr, fq);
            st_rm(TILE(0), x, mi, ni, fr, fq); st_tr(TILE(3), x, mi, ni, fr, fq);
        }
        __syncthreads();
#pragma unroll
        for (int rd = 0; rd < 5; ++rd) {
            const int tq = (rd & 1) ? 14 : 8, tqo = (rd & 1) ? 8 : 14;
            const int lx = (rd & 1) ? 4 : 0, lxt = (rd & 1) ? 9 : 3, lxo = (rd & 1) ? 0 : 4, lxto = (rd & 1) ? 3 : 9;
#pragma unroll
            for (int nn = 0; nn < 2; ++nn) {
                const int ni = nb + nn;
                f32x4 x = ld_rm(TILE(tq), mi, ni, fr, fq) + ld_rm(TILE(lx), mi, ni, fr, fq);
                x = mm_tile(x, TILE(tq), TILE(lxt), mi, ni, fr, fq);
                st_rm(TILE(tqo), x, mi, ni, fr, fq);
                if (rd < 4) { const f32x4 y = mm_tile(z4, TILE(lx), TILE(lxt), mi, ni, fr, fq); st_rm(TILE(lxo), y, mi, ni, fr, fq); st_tr(TILE(lxto), y, mi, ni, fr, fq); }
            }
            __syncthreads();
        }
#pragma unroll
        for (int nn = 0; nn < 2; ++nn) {
            const int ni = nb + nn;
            st_tr(TILE(10), mm_tile(ld_tr(TILE(1), mi, ni, fr, fq), TILE(14), TILE(1), mi, ni, fr, fq), mi, ni, fr, fq);
            st_tr(TILE(15), mm_tile(ld_tr(TILE(13), mi, ni, fr, fq), TILE(14), TILE(13), mi, ni, fr, fq), mi, ni, fr, fq);
        }
        __syncthreads();
#pragma unroll
        for (int nn = 0; nn < 2; ++nn) {
            const int ni = nb + nn;
            {
                f32x4 x = mm_tile(z4, TILE(5), TILE(10), mi, ni, fr, fq);
                if (mi == ni) {
#pragma unroll
                    for (int j = 0; j < 4; ++j) x[j] += (fq * 4 + j == fr) ? wc[ni * 16 + fr] : 0.f;
                }
                const unsigned w0 = cvt_pk_bf16(x[0], x[1]), w1 = cvt_pk_bf16(x[2], x[3]);
                bf16_t* gp = GT + (size_t)item * 4096 + (size_t)((mi * 2 + (ni >> 1)) * 64 + (fr >> 2) * 16 + fq * 4) * 8 + (ni & 1) * 4 + (fr & 3);
                gp[0] = (bf16_t)(w0 & 0xffffu); gp[8] = (bf16_t)(w0 >> 16); gp[16] = (bf16_t)(w1 & 0xffffu); gp[24] = (bf16_t)(w1 >> 16);
            }
            {
                f32x4 x = mm_tile(z4, TILE(5), TILE(15), mi, ni, fr, fq);
                x = mm_tile(x, TILE(6), TILE(7), mi, ni, fr, fq);
                *(f32x4*)(HT + (size_t)item * 4096 + (size_t)((ni * 4 + mi) * 64 + lane) * 4) = x;
            }
            {
                f32x4 x = ld_tr(TILE(2), mi, ni, fr, fq);
                x = mm_tile(x, TILE(10), TILE(11), mi, ni, fr, fq);
                u32x2 wv; wv.x = cvt_pk_bf16(x[0], x[1]); wv.y = cvt_pk_bf16(x[2], x[3]);
                *(u32x2*)(QE + (size_t)item * 4096 + (ni * 16 + fr) * 64 + mi * 16 + fq * 4) = wv;
            }
            {
                f32x4 x = mm_tile(z4, TILE(11), TILE(15), mi, ni, fr, fq);
                x = mm_tile(x, TILE(12), TILE(7), mi, ni, fr, fq);
                u32x2 wv; wv.x = cvt_pk_bf16(x[0], x[1]); wv.y = cvt_pk_bf16(x[2], x[3]);
                *(u32x2*)(YL + (size_t)item * 4096 + (size_t)((mi * 4 + ni) * 64 + lane) * 4) = wv;
            }
        }
    }
}

__device__ __forceinline__ void phase_seq(const Params& p) {
    if (threadIdx.x >= 64) return;
    const int head = blockIdx.x >> 2, vt = blockIdx.x & 3, lane = threadIdx.x, fr = lane & 15, fq = lane >> 4;
    const bf16_t* GT = (const bf16_t*)(p.ws + WS_GT); const float* HT = (const float*)(p.ws + WS_HT); bf16_t* S0 = (bf16_t*)(p.ws + WS_S0);
    f32x4 acc[4];
#pragma unroll
    for (int mb = 0; mb < 4; ++mb) acc[mb] = (f32x4){0.f, 0.f, 0.f, 0.f};
    bf16x8 ga[4][4][2]; f32x4 hh[4][4];
#define SEQ_LOAD(buf, cc) do { const size_t _it = (size_t)((cc) < 256 ? (cc) : 255) * 16 + head; \
        _Pragma("unroll") for (int mb = 0; mb < 4; ++mb) { \
            _Pragma("unroll") for (int ks = 0; ks < 2; ++ks) ga[buf][mb][ks] = *(const bf16x8*)(GT + _it * 4096 + (size_t)((mb * 2 + ks) * 64 + lane) * 8); \
            hh[buf][mb] = *(const f32x4*)(HT + _it * 4096 + (size_t)((vt * 4 + mb) * 64 + lane) * 4); } } while (0)
    SEQ_LOAD(0, 0); SEQ_LOAD(1, 1); SEQ_LOAD(2, 2); SEQ_LOAD(3, 3);
    for (int c0 = 0; c0 < 256; c0 += 4) {
#pragma unroll
        for (int b = 0; b < 4; ++b) {
            const int c = c0 + b; const size_t item = (size_t)c * 16 + head;
            u32x2 pk[4];
#pragma unroll
            for (int mb = 0; mb < 4; ++mb) { pk[mb].x = cvt_pk_bf16(acc[mb][0], acc[mb][1]); pk[mb].y = cvt_pk_bf16(acc[mb][2], acc[mb][3]);
                *(u32x2*)(S0 + item * 4096 + (vt * 16 + fr) * 64 + mb * 16 + fq * 4) = pk[mb]; }
            u32x4 b0w, b1w; b0w.x = pk[0].x; b0w.y = pk[0].y; b0w.z = pk[1].x; b0w.w = pk[1].y; b1w.x = pk[2].x; b1w.y = pk[2].y; b1w.z = pk[3].x; b1w.w = pk[3].y;
            const bf16x8 b0 = __builtin_bit_cast(bf16x8, b0w), b1 = __builtin_bit_cast(bf16x8, b1w);
#pragma unroll
            for (int mb = 0; mb < 4; ++mb) {
                const f32x4 x = __builtin_amdgcn_mfma_f32_16x16x32_bf16(ga[b][mb][0], b0, hh[b][mb], 0, 0, 0);
                acc[mb] = __builtin_amdgcn_mfma_f32_16x16x32_bf16(ga[b][mb][1], b1, x, 0, 0, 0);
            }
            SEQ_LOAD(b, c + 4);
        }
    }
#undef SEQ_LOAD
}

__device__ __forceinline__ void phase_chunkY(const Params& p, LAS unsigned char* lds) {
    LAS float* Yb = (LAS float*)lds;
    const int tid = threadIdx.x, w = tid >> 6, lane = tid & 63, fr = lane & 15, fq = lane >> 4;
    const int mi = w >> 1, nb = (w & 1) * 2;
    const bf16_t* R = (const bf16_t*)(p.ws + WS_R); const bf16_t* Kk = (const bf16_t*)(p.ws + WS_K); const bf16_t* V = (const bf16_t*)(p.ws + WS_V);
    const bf16_t* G = (const bf16_t*)(p.ws + WS_G); const bf16_t* YC = (const bf16_t*)(p.ws + WS_YC);
    const bf16_t* QE = (const bf16_t*)(p.ws + WS_QE); const bf16_t* YL = (const bf16_t*)(p.ws + WS_YL); const bf16_t* S0 = (const bf16_t*)(p.ws + WS_S0);
    bf16_t* YM = (bf16_t*)(p.ws + WS_YMIX);
    const float* gn_w = p.in[16]; const float* gn_b = p.in[17];
    u32x2 ywn[2]; bf16x8 an[2], bn[2][2]; bool first = true;
    u32x4 nv4, ng4, nyc4; float nbon; const float* BONp = (const float*)(p.ws + WS_BON);
#define CY_LOAD(it) do { const bf16_t* _q = QE + (size_t)(it) * 4096; const bf16_t* _s = S0 + (size_t)(it) * 4096; const bf16_t* _y = YL + (size_t)(it) * 4096; \
        _Pragma("unroll") for (int ks = 0; ks < 2; ++ks) an[ks] = *(const bf16x8*)(_q + (mi * 16 + fr) * 64 + ks * 32 + fq * 8); \
        _Pragma("unroll") for (int nn = 0; nn < 2; ++nn) { ywn[nn] = *(const u32x2*)(_y + (size_t)((mi * 4 + nb + nn) * 64 + lane) * 4); \
            _Pragma("unroll") for (int ks = 0; ks < 2; ++ks) bn[nn][ks] = *(const bf16x8*)(_s + (nb + nn) * 16 * 64 + fr * 64 + ks * 32 + fq * 8); } \
        { const size_t _tg = (size_t)((it) >> 4) * 64 + (tid >> 3); const size_t _o = _tg * DR + ((it) & 15) * 64 + (tid & 7) * 8; \
          nv4 = *(const u32x4*)(V + _o); ng4 = *(const u32x4*)(G + _o); nyc4 = *(const u32x4*)(YC + _o); nbon = BONp[_tg * 16 + ((it) & 15)]; } } while (0)
    for (int item = blockIdx.x; item < 4096; item += gridDim.x) {
        const int c = item >> 4, h = item & 15;
        if (first) { first = false; CY_LOAD(item); }
        __syncthreads();
        const u32x2 ywc[2] = {ywn[0], ywn[1]}; const bf16x8 ac[2] = {an[0], an[1]}; const bf16x8 bc[2][2] = {{bn[0][0], bn[0][1]}, {bn[1][0], bn[1][1]}};
        const u32x4 v4 = nv4, g4 = ng4, yc4 = nyc4; const float bon = nbon;
        if (item + (int)gridDim.x < 4096) CY_LOAD(item + (int)gridDim.x);
#pragma unroll
        for (int nn = 0; nn < 2; ++nn) {
            const int ni = nb + nn;
            const u32x2 yw = ywc[nn];
            f32x4 acc = (f32x4){lo_bf(yw.x), hi_bf(yw.x), lo_bf(yw.y), hi_bf(yw.y)};
#pragma unroll
            for (int ks = 0; ks < 2; ++ks) acc = __builtin_amdgcn_mfma_f32_16x16x32_bf16(ac[ks], bc[nn][ks], acc, 0, 0, 0);
#pragma unroll
            for (int j = 0; j < 4; ++j) Yb[(mi * 16 + fq * 4 + j) * 68 + ni * 16 + fr] = acc[j];
        }
        __syncthreads();
        {
            const int t = tid >> 3, k0 = (tid & 7) * 8; const int ch = h * 64 + k0;
            const size_t tg = (size_t)c * 64 + t; const size_t o = tg * DR + ch;
            const float4 gw0 = *(const float4*)(gn_w + ch), gw1 = *(const float4*)(gn_w + ch + 4), gb0 = *(const float4*)(gn_b + ch), gb1 = *(const float4*)(gn_b + ch + 4);
            const float gwv[8] = {gw0.x, gw0.y, gw0.z, gw0.w, gw1.x, gw1.y, gw1.z, gw1.w}, gbv[8] = {gb0.x, gb0.y, gb0.z, gb0.w, gb1.x, gb1.y, gb1.z, gb1.w};
            const f32x4 y0 = *(const LAS f32x4*)(Yb + t * 68 + k0), y1 = *(const LAS f32x4*)(Yb + t * 68 + k0 + 4);
            const float y[8] = {y0[0], y0[1], y0[2], y0[3], y1[0], y1[1], y1[2], y1[3]};
            float sm = 0.f;
#pragma unroll
            for (int i = 0; i < 8; ++i) sm += y[i];
            sm += dpp_f<0xB1, 0xf>(sm); sm += dpp_f<0x4E, 0xf>(sm); sm += dpp_f<0x141, 0xf>(sm);
            const float mean = sm * (1.f / 64.f);
            float vs = 0.f;
#pragma unroll
            for (int i = 0; i < 8; ++i) { const float d = y[i] - mean; vs += d * d; }
            vs += dpp_f<0xB1, 0xf>(vs); vs += dpp_f<0x4E, 0xf>(vs); vs += dpp_f<0x141, 0xf>(vs);
            const float rs = rsqrtf(vs * (1.f / 64.f) + 64e-5f);
            float vf[8], gf[8], of[8];
            unpack8(v4, vf); unpack8(g4, gf);
#pragma unroll
            for (int i = 0; i < 8; ++i) of[i] = ((y[i] - mean) * rs * gwv[i] + gbv[i] + bon * vf[i]) * gf[i];
            *(u32x4*)(YM + tg * D_ + ch) = pack8(of);
            *(u32x4*)(YM + tg * D_ + 1024 + ch) = yc4;
        }
    }
#undef CY_LOAD
}

__device__ __forceinline__ int f2key(float x) { const int u = __float_as_int(x); return u ^ ((u >> 31) & 0x7fffffff); }
__device__ __forceinline__ float key2f(int k) { return __int_as_float(k ^ ((k >> 31) & 0x7fffffff)); }
template <int CTRL> __device__ __forceinline__ int dpp_i(int v) { return __builtin_amdgcn_update_dpp(v, v, CTRL, 0xf, 0xf, false); }
__device__ __forceinline__ int row_max_i(int v) { v = max(v, dpp_i<0xB1>(v)); v = max(v, dpp_i<0x4E>(v)); v = max(v, dpp_i<0x141>(v)); v = max(v, dpp_i<0x140>(v)); return v; }
__device__ __forceinline__ void phase_topk(const Params& p, unsigned char* shm) {
    float* sc = (float*)shm;
    int* tk = (int*)(sc + 64 * 260);
    int* ctab = tk + 2048;
    if (threadIdx.x < 64) { int n = threadIdx.x, v = 256;
        for (int i = 0; i < 16; ++i) { const int cnt = 16 / (i + 1); if (n < cnt) { v = i * 16 + n; break; } n -= cnt; }
        ctab[threadIdx.x] = v; }
    const float* SC = (const float*)(p.ws + WS_Q);
    int* IDS = (int*)(p.ws + WS_IDS); float* GATES = (float*)(p.ws + WS_GATES);
    const int tid = threadIdx.x, w = tid >> 6, lane = tid & 63;
    f32x4 qreg[8];
#define TK_QLOAD(it) do { const int _t0 = ((it) >> 3) * 64; _Pragma("unroll") for (int i = 0; i < 8; ++i) { const int ch = tid + 512 * i; \
        qreg[i] = *(const f32x4*)(SC + (size_t)(_t0 + (ch >> 6)) * 2048 + ((it) & 7) * 256 + (ch & 63) * 4); } } while (0)
    if ((int)blockIdx.x < 2048) TK_QLOAD((int)blockIdx.x);
    for (int item = blockIdx.x; item < 2048; item += gridDim.x) {
        const int t0 = (item >> 3) * 64, h = item & 7;
        __syncthreads();
#pragma unroll
        for (int i = 0; i < 8; ++i) { const int ch = tid + 512 * i; *(f32x4*)(sc + (ch >> 6) * 260 + (ch & 63) * 4) = qreg[i]; }
        __syncthreads();
        if (item + (int)gridDim.x < 2048) TK_QLOAD(item + (int)gridDim.x);
        for (int g = 0; g < 4; ++g) {
            const int L = w * 16 + g * 4 + (lane >> 4); const int tok = L >> 1, cc = L & 1; const int pp = lane & 15;
            int key[8];
#pragma unroll
            for (int i = 0; i < 8; ++i) key[i] = (f2key(sc[tok * 260 + cc * 128 + i * 16 + pp]) & ~127) | (127 - (i * 16 + pp));
#define CE(a, b) do { const int _hi = max(key[a], key[b]), _lo = min(key[a], key[b]); key[a] = _hi; key[b] = _lo; } while (0)
            CE(0, 1); CE(2, 3); CE(4, 5); CE(6, 7);  CE(0, 2); CE(1, 3); CE(4, 6); CE(5, 7);  CE(1, 2); CE(5, 6);
            CE(0, 4); CE(1, 5); CE(2, 6); CE(3, 7);  CE(2, 4); CE(3, 5);  CE(1, 2); CE(3, 4); CE(5, 6);
#undef CE
            int mykey = 0;
#pragma unroll
            for (int r = 0; r < 16; ++r) {
                const int m = row_max_i(key[0]);
                const bool win = (key[0] == m);
#pragma unroll
                for (int i = 0; i < 7; ++i) key[i] = win ? key[i + 1] : key[i];
                key[7] = win ? (int)0x80000000 : key[7];
                mykey = (pp == r) ? m : mykey;
            }
            tk[L * 16 + pp] = mykey;
        }
        __syncthreads();
        for (int g = 0; g < 2; ++g) {
            const int tok = w * 8 + g * 4 + (lane >> 4); const int pp = lane & 15;
            int key[4];
#pragma unroll
            for (int q = 0; q < 4; ++q) {
                const int ij = ctab[q * 16 + pp];
                const float s1 = key2f(tk[(tok * 2) * 16 + ((ij >> 4) & 15)] & ~127), s2 = key2f(tk[(tok * 2 + 1) * 16 + (ij & 15)] & ~127);
                key[q] = (ij < 256) ? ((f2key(s1 + s2) & ~255) | (255 - ij)) : (int)0x80000000;
            }
            int mykey = 0;
#pragma unroll
            for (int r = 0; r < 16; ++r) {
                const int ml = max(max(key[0], key[1]), max(key[2], key[3]));
                const int m = row_max_i(ml);
#pragma unroll
                for (int q = 0; q < 4; ++q) key[q] = (key[q] == m) ? (int)0x80000000 : key[q];
                mykey = (pp == r) ? m : mykey;
            }
            const int ci = 255 - (mykey & 255); const float cs = key2f(mykey & ~255);
            const int e1 = 127 - (tk[(tok * 2) * 16 + (ci >> 4)] & 127), e2 = 127 - (tk[(tok * 2 + 1) * 16 + (ci & 15)] & 127);
            const float mx = __shfl(cs, lane & 48);
            const float e = __expf(cs - mx);
            float sum = e; sum += dpp_f<0xB1, 0xf>(sum); sum += dpp_f<0x4E, 0xf>(sum); sum += dpp_f<0x141, 0xf>(sum); sum += dpp_f<0x140, 0xf>(sum);
            IDS[(size_t)(t0 + tok) * 128 + h * 16 + pp] = (e1 * 128 + e2) & 16383;
            GATES[(size_t)(t0 + tok) * 128 + h * 16 + pp] = e / sum;
        }
    }
#undef TK_QLOAD
}

__device__ __forceinline__ float gelu_fast(float x) { const float u = 0.7978845608028654f * (x + 0.044715f * x * x * x); return x / (1.0f + __expf(-2.0f * u)); }
__device__ __forceinline__ void phase_gather(const Params& p, unsigned char* shm) {
    const float* X1 = (const float*)(p.ws + WS_X1); const float* SSQ = (const float*)(p.ws + WS_SSQ);
    const unsigned char* U6 = p.ws + WS_UB; const unsigned char* V6 = p.ws + WS_VB;
    const int* IDS = (const int*)(p.ws + WS_IDS); const float* GATES = (const float*)(p.ws + WS_GATES);
    const float* nf = p.in[25];
    const int tid = threadIdx.x, w = tid >> 6, lane = tid & 63;
    int nid0 = 0, nid1 = 0; float ngt0 = 0.f, ngt1 = 0.f, nssq = 0.f;
#define GT_META(tt) do { nid0 = IDS[(size_t)(tt) * 128 + lane]; nid1 = IDS[(size_t)(tt) * 128 + 64 + lane]; ngt0 = GATES[(size_t)(tt) * 128 + lane]; ngt1 = GATES[(size_t)(tt) * 128 + 64 + lane]; \
        nssq = (lane < 32) ? SSQ[(size_t)(tt) * 32 + lane] : 0.f; } while (0)
    if ((int)(blockIdx.x * 8 + w) < S_) GT_META(blockIdx.x * 8 + w);
    for (int t = blockIdx.x * 8 + w; t < S_; t += gridDim.x * 8) {
        const int id0 = nid0, id1 = nid1; const float gt0 = ngt0, gt1 = ngt1, ssqv = nssq;
        if (t + (int)gridDim.x * 8 < S_) GT_META(t + (int)gridDim.x * 8);
        f32x2 op[16];
#pragma unroll
        for (int j = 0; j < 8; ++j) { const float4 x = *(const float4*)(X1 + (size_t)t * D_ + (j * 64 + lane) * 4);
            op[2 * j] = (f32x2){x.x, x.y}; op[2 * j + 1] = (f32x2){x.z, x.w}; }
        f32x2 hp[16];
#pragma unroll
        for (int i = 0; i < 16; ++i) hp[i] = op[i];
        const float rs = rsqrtf(wave_sum_dpp(ssqv) * (1.0f / 2048.0f) + 1e-6f);
        u32x4 uaA[4], ubA[4], vbA[4]; u32x2 uaB[4], ubB[4], vbB[4];
#define G_LOADU(dA, dB, grp) do { _Pragma("unroll") for (int j = 0; j < 4; ++j) { const int e = (grp) * 4 + j; const int id = __builtin_amdgcn_readlane(e < 64 ? id0 : id1, e & 63); \
            const unsigned char* ur = U6 + (size_t)id * ROW6; dA[j] = *(const u32x4*)(ur + lane * 16); dB[j] = *(const u32x2*)(ur + 1024 + lane * 8); } } while (0)
#define G_LOADV(grp) do { _Pragma("unroll") for (int j = 0; j < 4; ++j) { const int e = (grp) * 4 + j; const int id = __builtin_amdgcn_readlane(e < 64 ? id0 : id1, e & 63); \
            const unsigned char* vr = V6 + (size_t)id * ROW6; vbA[j] = *(const u32x4*)(vr + lane * 16); vbB[j] = *(const u32x2*)(vr + 1024 + lane * 8); } } while (0)
#define G_DEC(A, B) __builtin_amdgcn_cvt_scalef32_pk32_f32_fp6((u32x6){A[0], A[1], A[2], A[3], B[0], B[1]}, 1.0f)
#define G_BODY(cA, cB, nA, nB, grp) do { \
            G_LOADV(grp); \
            G_LOADU(nA, nB, ((grp) + 1 < 32 ? (grp) + 1 : 31)); \
            float dsel = 0.f; \
            _Pragma("unroll") for (int j = 0; j < 4; ++j) { const f32x32 dd = G_DEC(cA[j], cB[j]); f32x2 d2 = (f32x2){0.f, 0.f}; \
                _Pragma("unroll") for (int m = 0; m < 16; ++m) d2 += (f32x2){dd[2 * m], dd[2 * m + 1]} * hp[m]; \
                const float d = wave_sum_dpp(d2.x + d2.y); dsel = (lane == j) ? d : dsel; } \
            const float av = gelu_fast(dsel * (rs * (1.f / U6_SCALE))) * (1.f / V6_SCALE); \
            _Pragma("unroll") for (int j = 0; j < 4; ++j) { const int e = (grp) * 4 + j; \
                const float a = __int_as_float(__builtin_amdgcn_readlane(__float_as_int(av), j)) * __int_as_float(__builtin_amdgcn_readlane(__float_as_int(e < 64 ? gt0 : gt1), e & 63)); \
                const f32x2 a2 = (f32x2){a, a}; const f32x32 dd = G_DEC(vbA[j], vbB[j]); \
                _Pragma("unroll") for (int m = 0; m < 16; ++m) op[m] += a2 * (f32x2){dd[2 * m], dd[2 * m + 1]}; } \
        } while (0)
        G_LOADU(uaA, uaB, 0);
#pragma unroll 1
        for (int g2 = 0; g2 < 32; g2 += 2) { G_BODY(uaA, uaB, ubA, ubB, g2); G_BODY(ubA, ubB, uaA, uaB, g2 + 1); }
#undef G_LOADU
#undef G_LOADV
#undef G_DEC
#undef G_BODY
        float ss = 0.f;
#pragma unroll
        for (int m = 0; m < 16; ++m) ss += op[m].x * op[m].x + op[m].y * op[m].y;
        ss = wave_sum_dpp(ss);
        const float scl = rsqrtf(ss * (1.f / 2048.f) + 1e-6f);
#pragma unroll
        for (int j = 0; j < 8; ++j) { const float4 g = *(const float4*)(nf + (j * 64 + lane) * 4);
            *(float4*)(p.out + (size_t)t * D_ + (j * 64 + lane) * 4) = make_float4(op[2 * j].x * scl * g.x, op[2 * j].y * scl * g.y, op[2 * j + 1].x * scl * g.z, op[2 * j + 1].y * scl * g.w); }
    }
#undef GT_META
}

#define XB_TMO      128
#define XB_XCNT(j)  (256  + 64 * (j))
#define XB_XSUB(j)  (1280 + 64 * (j))
#define XB_XGEN(j)  (2304 + 64 * (j))
#define XB_TOP      3328
#define XB_TOPGEN   3392
#define XCD_BAR_WORDS 3456
#define XB_SPIN_CAP (1u << 18)
__device__ __forceinline__ unsigned xb_ld(unsigned* p)              { return __hip_atomic_load(p, __ATOMIC_RELAXED, __HIP_MEMORY_SCOPE_AGENT); }
__device__ __forceinline__ unsigned xb_add(unsigned* p, unsigned v) { return __hip_atomic_fetch_add(p, v, __ATOMIC_RELAXED, __HIP_MEMORY_SCOPE_AGENT); }
__device__ __forceinline__ unsigned xb_xcc_id() { return (unsigned)__builtin_amdgcn_s_getreg((3 << 11) | 20) & 0xFu; }
#define XB_SPIN(cond, bar) do { unsigned _sp = 0; while (cond) { __builtin_amdgcn_s_sleep(1); \
    if ((++_sp & 255u) == 0u) { if (xb_ld(&(bar)[XB_TMO])) break; if (_sp > XB_SPIN_CAP) { atomicAdd(&(bar)[XB_TMO], 1u); break; } } } } while (0)
struct XcdBarrier { unsigned* bar; unsigned x; volatile LAS unsigned* st; };
__device__ __forceinline__ XcdBarrier xcd_barrier_post(unsigned* bar, volatile LAS unsigned* st) {
    XcdBarrier b; b.bar = bar; b.x = xb_xcc_id(); b.st = st;
    if (threadIdx.x == 0) (void)xb_add(&bar[XB_XCNT(b.x)], 1u);
    return b;
}
__device__ __forceinline__ void xcd_barrier_complete(unsigned* bar, unsigned x, unsigned& nloc, unsigned& nx) {
    const unsigned G = gridDim.x * gridDim.y * gridDim.z;
    unsigned sum, cnt, mine, sp = 0u;
    for (;;) {
        sum = 0u; cnt = 0u; mine = 0u;
#pragma unroll
        for (unsigned j = 0; j < 16; ++j) { const unsigned c = xb_ld(&bar[XB_XCNT(j)]); sum += c; cnt += (c > 0u) ? 1u : 0u; mine = (j == x) ? c : mine; }
        if (sum == G) break;
        __builtin_amdgcn_s_sleep(1);
        if ((++sp & 255u) == 0u) { if (xb_ld(&bar[XB_TMO])) break; if (sp > XB_SPIN_CAP) { atomicAdd(&bar[XB_TMO], 1u); break; } }
    }
    nloc = mine > 0u ? mine : 1u; nx = cnt > 0u ? cnt : 1u;
}
__device__ __forceinline__ void xcd_barrier(const XcdBarrier& b) {
    asm volatile("s_waitcnt vmcnt(0)" ::: "memory");
    __syncthreads();
    if (threadIdx.x == 0) {
        unsigned* bar = b.bar;
        __builtin_amdgcn_s_waitcnt(0);
        unsigned nloc = b.st[0], nx = b.st[1];
        if (nloc == 0u) { xcd_barrier_complete(bar, b.x, nloc, nx); b.st[0] = nloc; b.st[1] = nx; }
        const unsigned old = xb_add(&bar[XB_XSUB(b.x)], 1u);
        const unsigned gen = old / nloc;
        if (old + 1u == (gen + 1u) * nloc) {
            __builtin_amdgcn_fence(__ATOMIC_RELEASE, "agent");
            asm volatile("s_waitcnt vmcnt(0)" ::: "memory");
            const unsigned og = xb_add(&bar[XB_TOP], 1u);
            const unsigned tg = og / nx;
            if (og + 1u == (tg + 1u) * nx) xb_add(&bar[XB_TOPGEN], 1u);
            else XB_SPIN(xb_ld(&bar[XB_TOPGEN]) == tg, bar);
            __builtin_amdgcn_fence(__ATOMIC_ACQUIRE, "agent");
            xb_add(&bar[XB_XGEN(b.x)], 1u);
            asm volatile("s_waitcnt vmcnt(0)" ::: "memory");
        } else {
            XB_SPIN(xb_ld(&bar[XB_XGEN(b.x)]) == gen, bar);
            __builtin_amdgcn_fence(__ATOMIC_ACQUIRE, "agent");
            asm volatile("s_waitcnt vmcnt(0)" ::: "memory");
        }
    }
    __syncthreads();
}

__global__ void __launch_bounds__(512, 2) mega(Params p) {
    extern __shared__ __attribute__((aligned(16))) unsigned char shm[];
    cg::grid_group grid = cg::this_grid();
    LAS unsigned char* lds = (LAS unsigned char*)shm;
    volatile LAS unsigned* bst = (volatile LAS unsigned*)(lds + LDS_BYTES - 16);
    if (threadIdx.x == 0) { bst[0] = 0u; bst[1] = 0u; }
    __syncthreads();
    const XcdBarrier xbar = xcd_barrier_post((unsigned*)(p.ws + WS_BAR), bst);
    if (p.ph_hi > 1000) grid.sync();
    const int lo = p.ph_lo, hi = p.ph_hi;
#define IN(k) (lo <= (k) && (k) < hi)
#define REP(k) for (int _r = 0; _r < ((k) == DUP_PHASE ? 2 : 1); ++_r)
#define SEAM(k) do { if (IN(k) && IN((k) + 1)) xcd_barrier(xbar); } while (0)
    if (IN(0)) REP(0) { if (_r) xcd_barrier(xbar); phase0(p, shm); }
    SEAM(0);
    if (IN(1)) REP(1) { if (_r) xcd_barrier(xbar);
        pg8::Gemm g{(const bf16_t*)(p.ws + WS_H), (const bf16_t*)(p.ws + WS_WB1), S_, NAUG, 2048};
        pg8::StaticOrder so; so.init(g.M, g.N, (int)gridDim.x, (int)blockIdx.x);
        pg8::EpiBf16 E{(bf16_t*)(p.ws + WS_PROJ), NAUG};
        pg8::gemm_phase(lds, g, so, E);
    }
    SEAM(1);
    if (IN(2)) REP(2) { if (_r) xcd_barrier(xbar);
        phase_prepM(p, lds);
        phase_prepE(p);
    }
    SEAM(2);
    if (IN(3)) REP(3) { if (_r) xcd_barrier(xbar); phase_chunkA(p, lds); }
    SEAM(3);
    if (IN(4)) REP(4) { if (_r) xcd_barrier(xbar); if (blockIdx.x < 64) phase_seq(p);
        else { const int bid = blockIdx.x - 64, nblk = gridDim.x - 64;
            convert_fp6(p.in[23], p.ws + WS_UB, 16384, U6_SCALE, p.in[20], bid, nblk);
            convert_fp6(p.in[24], p.ws + WS_VB, 16384, V6_SCALE, nullptr, bid, nblk);
            build_wpt(p.in[21], p.in[20], (const bf16_t*)(p.ws + WS_KEYB), (bf16_t*)(p.ws + WS_WQT), bid, nblk);
            transpose_convert(p.in[19], 2048, 2048, (bf16_t*)(p.ws + WS_WOT), (float*)shm, bid, nblk); } }
    SEAM(4);
    if (IN(5)) REP(5) { if (_r) xcd_barrier(xbar); phase_chunkY(p, lds); }
    SEAM(5);
    if (IN(6)) REP(6) { if (_r) xcd_barrier(xbar);
        pg8::Gemm g{(const bf16_t*)(p.ws + WS_YMIX), (const bf16_t*)(p.ws + WS_WOT), S_, 2048, 2048};
        pg8::StaticOrder so; so.init(g.M, g.N, (int)gridDim.x, (int)blockIdx.x);
        pg8::EpiRes2 E{(float*)(p.ws + WS_X1), p.in[0], (bf16_t*)(p.ws + WS_H2), (float*)(p.ws + WS_SSQ), 2048};
        pg8::gemm_phase(lds, g, so, E);
    }
    SEAM(6);
    if (IN(8)) REP(8) { if (_r) xcd_barrier(xbar);
        pg8::Gemm g{(const bf16_t*)(p.ws + WS_H2), (const bf16_t*)(p.ws + WS_WQT), S_, 2048, 2048};
        pg8::StaticOrder so; so.init(g.M, g.N, (int)gridDim.x, (int)blockIdx.x);
        pg8::EpiRowScaleF32 E{(float*)(p.ws + WS_Q), (const float*)(p.ws + WS_SSQ), 2048};
        pg8::gemm_phase(lds, g, so, E);
    }
    SEAM(8);
    if (IN(9)) REP(9) { if (_r) xcd_barrier(xbar); phase_topk(p, shm); }
    SEAM(9);
    if (IN(10)) REP(10) { if (_r) xcd_barrier(xbar); phase_gather(p, shm); }
#undef IN
#undef REP
#undef SEAM
}

extern "C" void kernel_launch(void* const* d_in, const int* in_sizes, int n_in, void* d_out, int out_size, void* d_ws, size_t ws_size, hipStream_t stream) {
    static int grid_blocks = 0;
    if (grid_blocks == 0) {
        if (n_in != 26 || ws_size < WS_NEED) { fprintf(stderr, "kernel_launch: unexpected n_in %d / ws_size %zu\n", n_in, ws_size); grid_blocks = -1; return; }
        int dev = 0, cus = 0, per_cu = 0;
        (void)hipGetDevice(&dev);
        (void)hipDeviceGetAttribute(&cus, hipDeviceAttributeMultiprocessorCount, dev);
        (void)hipFuncSetAttribute((const void*)mega, hipFuncAttributeMaxDynamicSharedMemorySize, LDS_BYTES);
        (void)hipOccupancyMaxActiveBlocksPerMultiprocessor(&per_cu, (const void*)mega, 512, LDS_BYTES);
        if (per_cu < 1) { fprintf(stderr, "kernel_launch: occupancy query says %d blocks/CU\n", per_cu); per_cu = 1; }
        grid_blocks = cus * per_cu;
        fprintf(stderr, "kernel_launch: cus %d per_cu %d grid %d\n", cus, per_cu, grid_blocks);
    }
    if (grid_blocks < 0) return;
    Params p{};
    for (int i = 0; i < 26; ++i) p.in[i] = (const float*)d_in[i];
    p.out = (float*)d_out; p.ws = (unsigned char*)d_ws;
#if MULTI_LAUNCH
    for (int ph = 0; ph < NPHASE; ++ph) {
        p.ph_lo = ph; p.ph_hi = ph + 1;
        hipLaunchKernelGGL(mega, dim3(grid_blocks), dim3(512), LDS_BYTES, stream, p);
    }
#else
    p.ph_lo = 0; p.ph_hi = NPHASE;
    if (hipMemsetAsync((unsigned char*)d_ws + WS_BAR, 0, XCD_BAR_WORDS * 4, stream) != hipSuccess) fprintf(stderr, "kernel_launch: barrier memset failed\n");
    void* args[] = {&p};
    hipError_t e = hipLaunchCooperativeKernel((const void*)mega, dim3(grid_blocks), dim3(512), args, LDS_BYTES, stream);
    if (e != hipSuccess) fprintf(stderr, "cooperative launch failed: %s (grid %d)\n", hipGetErrorString(e), grid_blocks);
#endif
}
```

```cpp
#include <hip/hip_runtime.h>
#include <hip/hip_cooperative_groups.h>
#include <cstdio>
namespace cg = cooperative_groups;

#ifndef DUP_PHASE
#define DUP_PHASE -1
#endif
#ifndef MULTI_LAUNCH
#define MULTI_LAUNCH 0
#endif

#define LAS __attribute__((address_space(3)))
typedef unsigned short bf16_t;
typedef short bf16x8 __attribute__((ext_vector_type(8)));
typedef float f32x4 __attribute__((ext_vector_type(4)));
typedef float f32x2 __attribute__((ext_vector_type(2)));
typedef unsigned u32x4 __attribute__((ext_vector_type(4)));
typedef unsigned u32x2 __attribute__((ext_vector_type(2)));
typedef unsigned u32x6 __attribute__((ext_vector_type(6)));
typedef float f32x32 __attribute__((ext_vector_type(32)));
typedef __bf16 bf16x32_t __attribute__((ext_vector_type(32)));

constexpr int S_ = 16384, D_ = 2048, DR = 1024, NAUG = 6912;
constexpr size_t MiB = 1ull << 20;
constexpr size_t WS_PROJ = 0, WS_H = 216 * MiB, WS_WB1 = 280 * MiB, WS_WQT = 280 * MiB, WS_WOT = 296 * MiB;
constexpr size_t WS_R = 307 * MiB, WS_K = 339 * MiB, WS_V = 371 * MiB, WS_KK = 403 * MiB, WS_A = 435 * MiB, WS_LW = 467 * MiB;
constexpr size_t WS_G = 216 * MiB, WS_YC = 248 * MiB, WS_YMIX = 307 * MiB, WS_X1 = 0, WS_H2 = 128 * MiB, WS_Q = 307 * MiB;
constexpr size_t WS_GT = 0, WS_HT = 32 * MiB, WS_QE = 96 * MiB, WS_YL = 128 * MiB, WS_S0 = 160 * MiB;
constexpr size_t WS_IDS = 192 * MiB, WS_GATES = 200 * MiB, WS_UB = 467 * MiB, WS_VB = 435 * MiB, WS_BON = 500 * MiB, WS_BAR = 502 * MiB, WS_KEYB = 503 * MiB, WS_SSQ = 504 * MiB, WS_NEED = 506 * MiB;
constexpr size_t WS_W2T = 499 * MiB, WS_A2T = WS_W2T + 131072, WS_G2T = WS_A2T + 131072;
constexpr int TLD = 72, TSLOT = 64 * TLD * 2;
constexpr int LDS_BYTES = 16 * TSLOT + 2048 + 256 + 16;
constexpr int NPHASE = 11;

struct Params {
    const float* in[26];
    float* out;
    unsigned char* ws;
    int ph_lo, ph_hi;
};

__device__ __forceinline__ float bf2f(bf16_t b) { return __uint_as_float(((unsigned)b) << 16); }
__device__ __forceinline__ bf16_t f2bf(float f) { unsigned u = __float_as_uint(f); u += 0x7FFFu + ((u >> 16) & 1u); return (bf16_t)(u >> 16); }
typedef __bf16 bf16v2_t __attribute__((ext_vector_type(2)));
__device__ __forceinline__ unsigned cvt_pk_bf16(float lo, float hi) { const f32x2 v = {lo, hi}; const bf16v2_t r = __builtin_convertvector(v, bf16v2_t); return __builtin_bit_cast(unsigned, r); }
__device__ __forceinline__ u32x4 pack8(const float* f) { u32x4 w; w.x = cvt_pk_bf16(f[0], f[1]); w.y = cvt_pk_bf16(f[2], f[3]); w.z = cvt_pk_bf16(f[4], f[5]); w.w = cvt_pk_bf16(f[6], f[7]); return w; }
__device__ __forceinline__ float lo_bf(unsigned w) { return __uint_as_float(w << 16); }
__device__ __forceinline__ float hi_bf(unsigned w) { return __uint_as_float(w & 0xffff0000u); }
__device__ __forceinline__ void unpack8(const u32x4 v, float* f) {
#pragma unroll
    for (int i = 0; i < 4; ++i) { f[2 * i] = lo_bf(v[i]); f[2 * i + 1] = hi_bf(v[i]); }
}
__device__ __forceinline__ float wave_sum(float v) {
#pragma unroll
    for (int o = 32; o; o >>= 1) v += __shfl_xor(v, o);
    return v;
}
template <int CTRL, int RM> __device__ __forceinline__ float dpp_f(float v) { return __int_as_float(__builtin_amdgcn_update_dpp(0, __float_as_int(v), CTRL, RM, 0xf, false)); }
__device__ __forceinline__ float wave_sum_dpp(float v) {
    v += dpp_f<0xB1, 0xf>(v); v += dpp_f<0x4E, 0xf>(v); v += dpp_f<0x141, 0xf>(v); v += dpp_f<0x140, 0xf>(v);
    v += dpp_f<0x142, 0xa>(v); v += dpp_f<0x143, 0xc>(v);
    return __int_as_float(__builtin_amdgcn_readlane(__float_as_int(v), 63));
}
__device__ __forceinline__ float wave_max(float v) {
#pragma unroll
    for (int o = 32; o; o >>= 1) v = fmaxf(v, __shfl_xor(v, o));
    return v;
}
__device__ __forceinline__ float sigmoidf_(float x) { return 1.0f / (1.0f + __expf(-x)); }
__device__ __forceinline__ float gelu_tanh(float x) { float u = 0.7978845608028654f * (x + 0.044715f * x * x * x); return 0.5f * x * (1.0f + tanhf(u)); }

namespace pg8 {
constexpr int BM = 256, BK = 64, HALF = 128, HTB = HALF * BK * 2, STAGE_BYTES = 8 * HTB, NXCD = 8, WGM = 8;
__device__ __forceinline__ int lds_byte(int r, int c) { const int st = (r >> 4) * 2 + (c >> 5), rr = r & 15, cc = c & 31, ob = rr * 64 + cc * 2; return st * 1024 + (ob ^ (((ob >> 9) & 1) << 5)); }
__device__ __forceinline__ void stage_rc(int b, int& R, int& C) { const int st = b / 1024, sb = b % 1024, swz = sb ^ (((sb >> 9) & 1) << 5); R = (st >> 1) * 16 + swz / 64; C = (st & 1) * 32 + (swz % 64) / 2; }
__device__ __forceinline__ int perm32(int rho) { const int n = rho >> 4, i = rho & 15; return 8 * (i >> 2) + 4 * n + (i & 3); }
struct Unit { int pm, pn; };
struct Gemm { const bf16_t* A; const bf16_t* Bt; int M, N, K; };
struct StaticOrder {
    int nM, nN, nwg, G, c;
    __device__ void init(int M, int N, int G_, int c_) { nM = M / BM; nN = N / BM; nwg = nM * nN; G = G_; c = c_; }
    __device__ bool next(int i, Unit& u) const {
        const long L = (long)i * G + c; if (L >= nwg) return false;
        int wgid = (int)L; { const int q = nwg / NXCD, r = nwg % NXCD, xcd = wgid % NXCD, off = wgid / NXCD; wgid = (xcd < r ? xcd * (q + 1) : r * (q + 1) + (xcd - r) * q) + off; }
        const int nig = WGM * nN, gid = wgid / nig, fm = gid * WGM, gsz = (nM - fm) < WGM ? (nM - fm) : WGM;
        u.pm = fm + ((wgid % nig) % gsz); u.pn = (wgid % nig) / gsz; return true;
    }
    __device__ __forceinline__ void a_ready(const Unit&) const {}
    __device__ __forceinline__ void done(const Unit&) const {}
};
struct EpiResF32 {
    static constexpr bool PERM = false;
    float* C; const float* Res; int ldc;
    __device__ __forceinline__ void operator()(const f32x4 (&acc)[2][2][4][2], const Unit& u, int wr, int wc, int fr, int fq) const {
        const int row0 = u.pm * BM + wr * 64 + fr, col0 = u.pn * BM + wc * 32 + 4 * fq;
#pragma unroll
        for (int ai = 0; ai < 2; ++ai)
#pragma unroll
            for (int m = 0; m < 4; ++m) { const size_t ro = (size_t)(row0 + ai * HALF + m * 16) * ldc + col0;
#pragma unroll
                for (int bj = 0; bj < 2; ++bj)
#pragma unroll
                    for (int n = 0; n < 2; ++n) { const f32x4 rs = *(const f32x4*)(Res + ro + bj * HALF + n * 16); *(f32x4*)(C + ro + bj * HALF + n * 16) = acc[ai][bj][m][n] + rs; } }
    }
};
struct EpiRes2 {
    static constexpr bool PERM = false;
    float* C; const float* Res; bf16_t* Cb; float* SSQ; int ldc;
    __device__ __forceinline__ void operator()(const f32x4 (&acc)[2][2][4][2], const Unit& u, int wr, int wc, int fr, int fq) const {
        const int row0 = u.pm * BM + wr * 64 + fr, col0 = u.pn * BM + wc * 32 + 4 * fq;
#pragma unroll
        for (int ai = 0; ai < 2; ++ai)
#pragma unroll
            for (int m = 0; m < 4; ++m) { const int row = row0 + ai * HALF + m * 16; const size_t ro = (size_t)row * ldc + col0; float ss = 0.f;
#pragma unroll
                for (int bj = 0; bj < 2; ++bj)
#pragma unroll
                    for (int n = 0; n < 2; ++n) { const f32x4 v = acc[ai][bj][m][n] + *(const f32x4*)(Res + ro + bj * HALF + n * 16);
                        *(f32x4*)(C + ro + bj * HALF + n * 16) = v;
                        u32x2 wv; wv.x = cvt_pk_bf16(v[0], v[1]); wv.y = cvt_pk_bf16(v[2], v[3]); *(u32x2*)(Cb + ro + bj * HALF + n * 16) = wv;
                        ss += v[0] * v[0] + v[1] * v[1] + v[2] * v[2] + v[3] * v[3]; }
                ss += __shfl_xor(ss, 16); ss += __shfl_xor(ss, 32);
                if (fq == 0) SSQ[(size_t)row * 32 + u.pn * 4 + wc] = ss; }
    }
};
struct EpiRowScaleF32 {
    static constexpr bool PERM = false;
    float* C; const float* SSQ; int ldc;
    __device__ __forceinline__ void operator()(const f32x4 (&acc)[2][2][4][2], const Unit& u, int wr, int wc, int fr, int fq) const {
        const int row0 = u.pm * BM + wr * 64 + fr, col0 = u.pn * BM + wc * 32 + 4 * fq;
#pragma unroll
        for (int ai = 0; ai < 2; ++ai)
#pragma unroll
            for (int m = 0; m < 4; ++m) { const int row = row0 + ai * HALF + m * 16; const size_t ro = (size_t)row * ldc + col0;
                const f32x4* sp = (const f32x4*)(SSQ + (size_t)row * 32); float sq = 0.f;
#pragma unroll
                for (int q = 0; q < 8; ++q) { const f32x4 v = sp[q]; sq += (v[0] + v[1]) + (v[2] + v[3]); }
                const float rs = rsqrtf(sq * (1.0f / 2048.0f) + 1e-6f);
#pragma unroll
                for (int bj = 0; bj < 2; ++bj)
#pragma unroll
                    for (int n = 0; n < 2; ++n) *(f32x4*)(C + ro + bj * HALF + n * 16) = acc[ai][bj][m][n] * rs; }
    }
};
struct EpiF32 {
    static constexpr bool PERM = false;
    float* C; int ldc;
    __device__ __forceinline__ void operator()(const f32x4 (&acc)[2][2][4][2], const Unit& u, int wr, int wc, int fr, int fq) const {
        const int row0 = u.pm * BM + wr * 64 + fr, col0 = u.pn * BM + wc * 32 + 4 * fq;
#pragma unroll
        for (int ai = 0; ai < 2; ++ai)
#pragma unroll
            for (int m = 0; m < 4; ++m) { const size_t ro = (size_t)(row0 + ai * HALF + m * 16) * ldc + col0;
#pragma unroll
                for (int bj = 0; bj < 2; ++bj)
#pragma unroll
                    for (int n = 0; n < 2; ++n) *(f32x4*)(C + ro + bj * HALF + n * 16) = acc[ai][bj][m][n]; }
    }
};
struct EpiBf16 {
    static constexpr bool PERM = true;
    bf16_t* O; int ldc;
    __device__ __forceinline__ void operator()(const f32x4 (&acc)[2][2][4][2], const Unit& u, int wr, int wc, int fr, int fq) const {
        const int row0 = u.pm * BM + wr * 64 + fr; const int col0 = u.pn * BM + wc * 32 + 8 * fq;
#pragma unroll
        for (int ai = 0; ai < 2; ++ai)
#pragma unroll
            for (int m = 0; m < 4; ++m) { bf16_t* rowp = O + (size_t)(row0 + ai * HALF + m * 16) * ldc + col0;
#pragma unroll
                for (int bj = 0; bj < 2; ++bj) { const f32x4 v0 = acc[ai][bj][m][0], v1 = acc[ai][bj][m][1];
                    u32x4 w; w.x = cvt_pk_bf16(v0[0], v0[1]); w.y = cvt_pk_bf16(v0[2], v0[3]); w.z = cvt_pk_bf16(v1[0], v1[1]); w.w = cvt_pk_bf16(v1[2], v1[3]);
                    *(u32x4*)(rowp + bj * HALF) = w; } }
    }
};

template <class Epi, class Sched>
__device__ __forceinline__ void gemm_phase(LAS unsigned char* lds, const Gemm g, const Sched& S, const Epi& E) {
    const int tid = threadIdx.x, wid = __builtin_amdgcn_readfirstlane(tid >> 6), lane = tid & 63, wr = wid >> 2, wc = wid & 3, fr = lane & 15, fq = lane >> 4;
    const int K = g.K, nt = K / BK;
    unsigned voffA[2], voffB[2];
#pragma unroll
    for (int i = 0; i < 2; ++i) { int R, C; stage_rc(tid * 16 + i * 8192, R, C); const int Rb = Epi::PERM ? ((R & ~31) + perm32(R & 31)) : R;
        voffA[i] = (unsigned)(R * K + C) * 2u; voffB[i] = (unsigned)(Rb * K + C) * 2u; }
    const size_t kstep = (size_t)(BK * 2);
    const size_t hstep = (size_t)HALF * K * 2;
    const size_t tstep = 2 * hstep;
    const unsigned ldsw = (unsigned)wid * 1024u;
    const int aoff = lds_byte(wr * 64 + fr, fq * 8), boff = lds_byte(wc * 32 + fr, fq * 8);
#define PG8_SA(b, h) (((b) * 2 + (h)) * HTB)
#define PG8_SB(b, h) ((4 + (b) * 2 + (h)) * HTB)
#define PG8_STAGE(bufoff, gbase, voff) do { _Pragma("unroll") for (int _i = 0; _i < 2; ++_i) \
        __builtin_amdgcn_global_load_lds((const unsigned*)((const char*)(gbase) + (voff)[_i]), (LAS unsigned*)(lds + (bufoff) + ldsw + _i * 8192), 16, 0, 0); } while (0)
#define PG8_LDA(dst, b, h) do { _Pragma("unroll") for (int m = 0; m < 4; ++m) _Pragma("unroll") for (int k = 0; k < 2; ++k) dst[m][k] = *(const LAS bf16x8*)(lds + PG8_SA(b, h) + aoff + m * 2048 + k * 1024); } while (0)
#define PG8_LDB(dst, b, h) do { _Pragma("unroll") for (int n = 0; n < 2; ++n) _Pragma("unroll") for (int k = 0; k < 2; ++k) dst[n][k] = *(const LAS bf16x8*)(lds + PG8_SB(b, h) + boff + n * 2048 + k * 1024); } while (0)
#define PG8_MMA(ai, bj, At, Bt) do { __builtin_amdgcn_s_setprio(1); _Pragma("unroll") for (int m = 0; m < 4; ++m) _Pragma("unroll") for (int n = 0; n < 2; ++n) _Pragma("unroll") for (int k = 0; k < 2; ++k) \
        acc[ai][bj][m][n] = __builtin_amdgcn_mfma_f32_16x16x32_bf16(Bt[n][k], At[m][k], acc[ai][bj][m][n], 0, 0, 0); __builtin_amdgcn_s_setprio(0); } while (0)
#define PG8_WAIT_V(n) asm volatile("s_waitcnt vmcnt(" #n ")" ::: "memory")
#define PG8_WAIT_L(n) asm volatile("s_waitcnt lgkmcnt(" #n ")" ::: "memory")
#define PG8_BAR __builtin_amdgcn_s_barrier()
#define PG8_SCHED __builtin_amdgcn_sched_barrier(0)
    Unit cur, nxt; int ui = 0;
    if (!S.next(0, cur)) return;
    f32x4 acc[2][2][4][2];
#pragma unroll
    for (int a = 0; a < 2; ++a)
#pragma unroll
        for (int b = 0; b < 2; ++b)
#pragma unroll
            for (int m = 0; m < 4; ++m)
#pragma unroll
                for (int n = 0; n < 2; ++n) acc[a][b][m][n] = (f32x4){0.f, 0.f, 0.f, 0.f};
    bf16x8 At[4][2], B0[2][2], B1[2][2];
    const char* cA = (const char*)g.A + (size_t)cur.pm * tstep; const char* cB = (const char*)g.Bt + (size_t)cur.pn * tstep;
    S.a_ready(cur);
    PG8_STAGE(PG8_SB(0, 0), cB, voffB); PG8_STAGE(PG8_SA(0, 0), cA, voffA); PG8_STAGE(PG8_SB(0, 1), cB + hstep, voffB); PG8_STAGE(PG8_SA(0, 1), cA + hstep, voffA);
    if (wr == 1) PG8_BAR;
    PG8_WAIT_V(4); PG8_BAR;
    PG8_STAGE(PG8_SB(1, 0), cB + kstep, voffB); PG8_STAGE(PG8_SA(1, 0), cA + kstep, voffA); PG8_STAGE(PG8_SB(1, 1), cB + hstep + kstep, voffB);
    PG8_WAIT_V(6); PG8_BAR;
    for (;;) {
        const bool has_next = S.next(ui + 1, nxt);
        const char* nA = has_next ? (const char*)g.A + (size_t)nxt.pm * tstep : cA; const char* nB = has_next ? (const char*)g.Bt + (size_t)nxt.pn * tstep : cB;
        for (int t = 0; t < nt; t += 2) {
            const bool last = (t == nt - 2);
            const char* a1 = cA + (size_t)(t + 1) * kstep;
            const char* a2 = last ? nA : cA + (size_t)(t + 2) * kstep; const char* b2 = last ? nB : cB + (size_t)(t + 2) * kstep;
            const char* a3 = a2 + kstep; const char* b3 = b2 + kstep;
            if (last && has_next) S.a_ready(nxt);
            PG8_LDB(B0, 0, 0); PG8_SCHED; PG8_LDA(At, 0, 0); PG8_STAGE(PG8_SA(1, 1), a1 + hstep, voffA);
            PG8_WAIT_L(8); PG8_BAR; PG8_WAIT_L(0); PG8_MMA(0, 0, At, B0); PG8_BAR; PG8_SCHED;
            PG8_LDB(B1, 0, 1); PG8_STAGE(PG8_SB(0, 0), b2, voffB);
            PG8_BAR; PG8_WAIT_L(0); PG8_MMA(0, 1, At, B1); PG8_BAR;
            PG8_LDA(At, 0, 1); PG8_STAGE(PG8_SA(0, 0), a2, voffA);
            PG8_BAR; PG8_WAIT_L(0); PG8_MMA(1, 0, At, B0); PG8_BAR; PG8_SCHED;
            PG8_STAGE(PG8_SB(0, 1), b2 + hstep, voffB);
            PG8_WAIT_V(6); PG8_BAR; PG8_MMA(1, 1, At, B1); PG8_BAR;
            PG8_LDB(B0, 1, 0); PG8_SCHED; PG8_LDA(At, 1, 0); PG8_STAGE(PG8_SA(0, 1), a2 + hstep, voffA);
            PG8_WAIT_L(8); PG8_BAR; PG8_WAIT_L(0); PG8_MMA(0, 0, At, B0); PG8_BAR; PG8_SCHED;
            PG8_LDB(B1, 1, 1); PG8_STAGE(PG8_SB(1, 0), b3, voffB);
            PG8_BAR; PG8_WAIT_L(0); PG8_MMA(0, 1, At, B1); PG8_BAR;
            PG8_LDA(At, 1, 1); PG8_STAGE(PG8_SA(1, 0), a3, voffA);
            PG8_BAR; PG8_WAIT_L(0); PG8_MMA(1, 0, At, B0); PG8_BAR; PG8_SCHED;
            PG8_STAGE(PG8_SB(1, 1), b3 + hstep, voffB);
            PG8_WAIT_V(6); PG8_BAR; PG8_MMA(1, 1, At, B1); PG8_BAR;
        }
        E(acc, cur, wr, wc, fr, fq); S.done(cur);
        if (!has_next) break;
#pragma unroll
        for (int a = 0; a < 2; ++a)
#pragma unroll
            for (int b = 0; b < 2; ++b)
#pragma unroll
                for (int m = 0; m < 4; ++m)
#pragma unroll
                    for (int n = 0; n < 2; ++n) acc[a][b][m][n] = (f32x4){0.f, 0.f, 0.f, 0.f};
        cur = nxt; cA = nA; cB = nB; ++ui;
    }
    PG8_WAIT_V(0);
    if (wr == 0) PG8_BAR;
    PG8_BAR;
#undef PG8_SA
#undef PG8_SB
#undef PG8_STAGE
#undef PG8_LDA
#undef PG8_LDB
#undef PG8_MMA
#undef PG8_WAIT_V
#undef PG8_WAIT_L
#undef PG8_BAR
#undef PG8_SCHED
}
}

__device__ __forceinline__ void rmsnorm_rows(const float* X, const float* gain, bf16_t* H) {
    const int wave = threadIdx.x >> 6, lane = threadIdx.x & 63;
    float4 nv[8];
    { const int row0 = blockIdx.x * 8 + wave;
      if (row0 < S_) {
#pragma unroll
          for (int i = 0; i < 8; ++i) nv[i] = ((const float4*)(X + (size_t)row0 * D_))[i * 64 + lane]; } }
    for (int row = blockIdx.x * 8 + wave; row < S_; row += gridDim.x * 8) {
        float4 v[8]; float ss = 0.f;
#pragma unroll
        for (int i = 0; i < 8; ++i) { v[i] = nv[i]; ss += v[i].x * v[i].x + v[i].y * v[i].y + v[i].z * v[i].z + v[i].w * v[i].w; }
        const int nrow = row + gridDim.x * 8;
        if (nrow < S_) {
#pragma unroll
            for (int i = 0; i < 8; ++i) nv[i] = ((const float4*)(X + (size_t)nrow * D_))[i * 64 + lane]; }
        ss = wave_sum_dpp(ss);
        const float sc = rsqrtf(ss * (1.0f / 2048.0f) + 1e-6f);
#pragma unroll
        for (int i = 0; i < 8; ++i) { const float4 g = ((const float4*)gain)[i * 64 + lane];
            u32x2 w; w.x = cvt_pk_bf16(v[i].x * sc * g.x, v[i].y * sc * g.y); w.y = cvt_pk_bf16(v[i].z * sc * g.z, v[i].w * sc * g.w);
            *(u32x2*)(H + (size_t)row * D_ + (i * 64 + lane) * 4) = w; }
    }
}

__device__ __forceinline__ void transpose_convert(const float* W, int K, int N, bf16_t* Bt, float* tile, int bid, int nblk) {
    const int tid = threadIdx.x; const int tk = K / 64, tn = N / 64, nt = tk * tn;
    float4 rg[2];
#define TC_LOAD(u) do { const int _k0 = ((u) / tn) * 64, _n0 = ((u) % tn) * 64; _Pragma("unroll") for (int i = 0; i < 2; ++i) { const int idx = tid + 512 * i; \
        rg[i] = *(const float4*)(W + (size_t)(_k0 + (idx >> 4)) * N + _n0 + (idx & 15) * 4); } } while (0)
    if (bid < nt) TC_LOAD(bid);
    for (int u = bid; u < nt; u += nblk) {
        const int k0 = (u / tn) * 64, n0 = (u % tn) * 64;
        __syncthreads();
#pragma unroll
        for (int i = 0; i < 2; ++i) { const int idx = tid + 512 * i; float* q = tile + (idx >> 4) * 65 + (idx & 15) * 4; q[0] = rg[i].x; q[1] = rg[i].y; q[2] = rg[i].z; q[3] = rg[i].w; }
        __syncthreads();
        if (u + nblk < nt) TC_LOAD(u + nblk);
#pragma unroll
        for (int i = 0; i < 4; ++i) { const int nn = i * 16 + (tid >> 5), kp = (tid & 31) * 2;
            *(unsigned*)(Bt + (size_t)(n0 + nn) * K + k0 + kp) = cvt_pk_bf16(tile[kp * 65 + nn], tile[(kp + 1) * 65 + nn]); }
    }
#undef TC_LOAD
}

__device__ __forceinline__ void convert_flat(const float* src, bf16_t* dst, size_t n) {
    for (size_t i = ((size_t)blockIdx.x * 512 + threadIdx.x) * 8; i < n; i += (size_t)gridDim.x * 512 * 8) {
        const float4 a = *(const float4*)(src + i), b = *(const float4*)(src + i + 4);
        u32x4 w; w.x = cvt_pk_bf16(a.x, a.y); w.y = cvt_pk_bf16(a.z, a.w); w.z = cvt_pk_bf16(b.x, b.y); w.w = cvt_pk_bf16(b.z, b.w);
        *(u32x4*)(dst + i) = w;
    }
}

__device__ __forceinline__ void convert_fp8(const float* src, unsigned char* dst, size_t n, float sc, const float* colgain, int bid, int nblk) {
    const int lane = threadIdx.x & 63, wv = threadIdx.x >> 6;
    for (size_t base = ((size_t)bid * 8 + wv) * 1024; base < n; base += (size_t)nblk * 8 * 1024) {
        float4 a[4];
#pragma unroll
        for (int j = 0; j < 4; ++j) a[j] = *(const float4*)(src + base + (size_t)(j * 64 + lane) * 4);
#pragma unroll
        for (int j = 0; j < 4; ++j) { float4 gg = make_float4(sc, sc, sc, sc);
            if (colgain) { const float4 cgv = *(const float4*)(colgain + ((base + (size_t)(j * 64 + lane) * 4) & 2047)); gg.x *= cgv.x; gg.y *= cgv.y; gg.z *= cgv.z; gg.w *= cgv.w; }
            int x = __builtin_amdgcn_cvt_pk_fp8_f32(a[j].x * gg.x, a[j].y * gg.y, 0, false); x = __builtin_amdgcn_cvt_pk_fp8_f32(a[j].z * gg.z, a[j].w * gg.w, x, true);
            *(unsigned*)(dst + base + (size_t)(j * 64 + lane) * 4) = (unsigned)x; }
    }
}

constexpr int ROW6 = 1536;
constexpr float U6_SCALE = 56.f, V6_SCALE = 28.f;
__device__ __forceinline__ void convert_fp6(const float* src, unsigned char* dst, int nrows, float sc, const float* colgain, int bid, int nblk) {
    const int lane = threadIdx.x & 63, wv = threadIdx.x >> 6;
    float g[32];
#pragma unroll
    for (int j = 0; j < 8; ++j) { float4 cg = make_float4(1.f, 1.f, 1.f, 1.f); if (colgain) cg = *(const float4*)(colgain + (j * 64 + lane) * 4);
        g[j * 4] = sc * cg.x; g[j * 4 + 1] = sc * cg.y; g[j * 4 + 2] = sc * cg.z; g[j * 4 + 3] = sc * cg.w; }
    for (int row = bid * 8 + wv; row < nrows; row += nblk * 8) {
        f32x32 x;
#pragma unroll
        for (int j = 0; j < 8; ++j) { const f32x4 a = __builtin_nontemporal_load((const f32x4*)(src + (size_t)row * 2048 + (j * 64 + lane) * 4));
            x[j * 4] = a[0] * g[j * 4]; x[j * 4 + 1] = a[1] * g[j * 4 + 1]; x[j * 4 + 2] = a[2] * g[j * 4 + 2]; x[j * 4 + 3] = a[3] * g[j * 4 + 3]; }
        const bf16x32_t b = __builtin_convertvector(x, bf16x32_t);
        const u32x6 wv6 = __builtin_amdgcn_cvt_scalef32_pk32_fp6_bf16(b, 1.0f);
        *(u32x4*)(dst + (size_t)row * ROW6 + lane * 16) = (u32x4){wv6[0], wv6[1], wv6[2], wv6[3]};
        *(u32x2*)(dst + (size_t)row * ROW6 + 1024 + lane * 8) = (u32x2){wv6[4], wv6[5]};
    }
}

__device__ __forceinline__ void build_wpt(const float* wq, const float* gain, const bf16_t* KEYB, bf16_t* WPT, int bid, int nblk) {
    const int w = threadIdx.x >> 6, lane = threadIdx.x & 63, fr = lane & 15, fq = lane >> 4;
    for (int task = bid * 8 + w; task < 16 * 128; task += nblk * 8) {
        const int g = task >> 7, kb = task & 127;
        f32x4 acc[8];
#pragma unroll
        for (int n = 0; n < 8; ++n) acc[n] = (f32x4){0.f, 0.f, 0.f, 0.f};
#pragma unroll 2
        for (int ks = 0; ks < 8; ++ks) {
            const float4* wp = (const float4*)(wq + (size_t)(kb * 16 + fr) * 4096 + g * 256 + ks * 32 + fq * 8);
            const float4 x0 = wp[0], x1 = wp[1]; const float gk = gain[kb * 16 + fr];
            u32x4 wv; wv.x = cvt_pk_bf16(x0.x * gk, x0.y * gk); wv.y = cvt_pk_bf16(x0.z * gk, x0.w * gk); wv.z = cvt_pk_bf16(x1.x * gk, x1.y * gk); wv.w = cvt_pk_bf16(x1.z * gk, x1.w * gk);
            const bf16x8 a = __builtin_bit_cast(bf16x8, wv);
#pragma unroll
            for (int n = 0; n < 8; ++n) {
                const bf16x8 b = *(const bf16x8*)(KEYB + (size_t)(g * 128 + n * 16 + fr) * 256 + ks * 32 + fq * 8);
                acc[n] = __builtin_amdgcn_mfma_f32_16x16x32_bf16(a, b, acc[n], 0, 0, 0);
            }
        }
#pragma unroll
        for (int n = 0; n < 8; ++n) { u32x2 o; o.x = cvt_pk_bf16(acc[n][0], acc[n][1]); o.y = cvt_pk_bf16(acc[n][2], acc[n][3]);
            *(u32x2*)(WPT + (size_t)(g * 128 + n * 16 + fr) * 2048 + kb * 16 + fq * 4) = o; }
    }
}

__device__ __forceinline__ void phase0(const Params& p, unsigned char* shm) {
    bf16_t* WB1 = (bf16_t*)(p.ws + WS_WB1);
    rmsnorm_rows(p.in[0], p.in[1], (bf16_t*)(p.ws + WS_H));
    transpose_convert(p.in[2], 2048, 6144, WB1, (float*)shm, blockIdx.x, gridDim.x);
    const float* mu = p.in[4]; const float* w1 = p.in[6]; const float* a1 = p.in[9]; const float* g1 = p.in[11];
    for (int idx = blockIdx.x * 512 + threadIdx.x; idx < 768 * 2048; idx += gridDim.x * 512) {
        const int j = idx >> 11, k = idx & 2047; float val = 0.f;
        if (j < 128) { const float m = mu[k], w = w1[k * 64 + (j & 63)]; val = (j < 64) ? w * (1.f - m) : w * m; }
        else if (j < 256) { const float m = mu[2048 + k], w = a1[k * 64 + (j & 63)]; val = (j < 192) ? w * (1.f - m) : w * m; }
        else if (j < 576) { const float m = mu[4096 + k]; const int jj = j - 256; const int c = jj < 160 ? jj : jj - 160; const float w = g1[k * 160 + c]; val = jj < 160 ? w * (1.f - m) : w * m; }
        WB1[(size_t)(6144 + j) * 2048 + k] = f2bf(val);
    }
    convert_flat(p.in[22], (bf16_t*)(p.ws + WS_KEYB), (size_t)8 * 2 * 128 * 256);
    bf16_t* W2T = (bf16_t*)(p.ws + WS_W2T); bf16_t* A2T = (bf16_t*)(p.ws + WS_A2T); bf16_t* G2T = (bf16_t*)(p.ws + WS_G2T);
    const float* w2 = p.in[7]; const float* a2 = p.in[10]; const float* g2 = p.in[12];
    for (int idx = blockIdx.x * 512 + threadIdx.x; idx < 1024 * 288; idx += gridDim.x * 512) {
        if (idx < 65536) { const int c = idx >> 6, j = idx & 63; W2T[idx] = f2bf(w2[j * 1024 + c]); }
        else if (idx < 131072) { const int i2 = idx - 65536; const int c = i2 >> 6, j = i2 & 63; A2T[i2] = f2bf(a2[j * 1024 + c]); }
        else { const int i2 = idx - 131072; const int c = i2 / 160, j = i2 % 160; G2T[i2] = f2bf(g2[j * 1024 + c]); }
    }
}

constexpr int ACT_LD = 296;
template <int KS, int KOFF, int KTOT, int KIND>
__device__ __forceinline__ void lora_stage(const LAS bf16_t* act, const bf16_t* WT, const float* bias, bf16_t* OUT, int t0, int w, int fr, int fq) {
#pragma unroll 1
    for (int nh = 0; nh < 2; ++nh) {
        f32x4 acc[4][4];
#pragma unroll
        for (int m = 0; m < 4; ++m)
#pragma unroll
            for (int n = 0; n < 4; ++n) acc[m][n] = (f32x4){0.f, 0.f, 0.f, 0.f};
        bf16x8 bfr[KS][4];
#pragma unroll
        for (int ks = 0; ks < KS; ++ks)
#pragma unroll
            for (int n = 0; n < 4; ++n) bfr[ks][n] = *(const bf16x8*)(WT + (size_t)(w * 128 + (nh * 4 + n) * 16 + fr) * KTOT + ks * 32 + fq * 8);
#pragma unroll
        for (int ks = 0; ks < KS; ++ks) {
            bf16x8 a[4];
#pragma unroll
            for (int m = 0; m < 4; ++m) a[m] = *(const LAS bf16x8*)(act + (m * 16 + fr) * ACT_LD + KOFF + ks * 32 + fq * 8);
#pragma unroll
            for (int n = 0; n < 4; ++n)
#pragma unroll
                for (int m = 0; m < 4; ++m) acc[m][n] = __builtin_amdgcn_mfma_f32_16x16x32_bf16(bfr[ks][n], a[m], acc[m][n], 0, 0, 0);
        }
#pragma unroll
        for (int n = 0; n < 4; ++n) {
            const int c = w * 128 + (nh * 4 + n) * 16 + fq * 4;
            float bs[4] = {0.f, 0.f, 0.f, 0.f};
            if (KIND < 2) { const float4 bv = *(const float4*)(bias + c); bs[0] = bv.x; bs[1] = bv.y; bs[2] = bv.z; bs[3] = bv.w; }
#pragma unroll
            for (int m = 0; m < 4; ++m) {
                float o[4];
#pragma unroll
                for (int j = 0; j < 4; ++j) {
                    const float val = acc[m][n][j];
                    if (KIND == 0) { const float x = -(bs[j] + val); const float sp = fmaxf(x, 0.f) + __logf(1.f + __expf(-fabsf(x))); o[j] = -__expf(-sp - 0.5f); }
                    else if (KIND == 1) o[j] = sigmoidf_(bs[j] + val);
                    else o[j] = val;
                }
                u32x2 wv; wv.x = cvt_pk_bf16(o[0], o[1]); wv.y = cvt_pk_bf16(o[2], o[3]);
                *(u32x2*)(OUT + (size_t)(t0 + m * 16 + fr) * DR + c) = wv;
            }
        }
    }
}
__device__ __forceinline__ void phase_prepM(const Params& p, LAS unsigned char* lds) {
    LAS bf16_t* act = (LAS bf16_t*)lds;
    const bf16_t* P = (const bf16_t*)(p.ws + WS_PROJ);
    const int tid = threadIdx.x, w = tid >> 6, lane = tid & 63, fr = lane & 15, fq = lane >> 4;
    for (int tile = blockIdx.x; tile < S_ / 64; tile += gridDim.x) {
        const int t0 = tile * 64;
        __syncthreads();
        for (int task = tid; task < 64 * 36; task += 512) {
            const int t = task / 36, j0 = (task % 36) * 8; const int tg = t0 + t;
            int ccur, cprev;
            if (j0 < 64) { ccur = 6144 + j0; cprev = 6208 + j0; }
            else if (j0 < 128) { ccur = 6272 + (j0 - 64); cprev = 6336 + (j0 - 64); }
            else { ccur = 6400 + (j0 - 128); cprev = 6560 + (j0 - 128); }
            float cu[8], pv[8], o8[8];
            unpack8(*(const u32x4*)(P + (size_t)tg * NAUG + ccur), cu);
            if (tg > 0) unpack8(*(const u32x4*)(P + (size_t)(tg - 1) * NAUG + cprev), pv);
            else {
#pragma unroll
                for (int i = 0; i < 8; ++i) pv[i] = 0.f;
            }
#pragma unroll
            for (int i = 0; i < 8; ++i) { const float sv = cu[i] + pv[i];
                o8[i] = j0 < 64 ? (1.f - 2.f / (1.f + __expf(2.f * sv))) : (j0 < 128 ? sv : sigmoidf_(sv)); }
            *(LAS u32x4*)(act + t * ACT_LD + j0) = pack8(o8);
        }
        __syncthreads();
        lora_stage<2, 0, 64, 0>(act, (const bf16_t*)(p.ws + WS_W2T), p.in[5], (bf16_t*)(p.ws + WS_LW), t0, w, fr, fq);
        lora_stage<2, 64, 64, 1>(act, (const bf16_t*)(p.ws + WS_A2T), p.in[8], (bf16_t*)(p.ws + WS_A), t0, w, fr, fq);
        lora_stage<5, 128, 160, 2>(act, (const bf16_t*)(p.ws + WS_G2T), nullptr, (bf16_t*)(p.ws + WS_G), t0, w, fr, fq);
    }
}

__device__ __forceinline__ void phase_prepE(const Params& p) {
    const bf16_t* P = (const bf16_t*)(p.ws + WS_PROJ);
    bf16_t* R = (bf16_t*)(p.ws + WS_R); bf16_t* Kk = (bf16_t*)(p.ws + WS_K); bf16_t* V = (bf16_t*)(p.ws + WS_V); bf16_t* KK = (bf16_t*)(p.ws + WS_KK); bf16_t* YC = (bf16_t*)(p.ws + WS_YC);
    const float* mu_rkv = p.in[3]; const float* k_k = p.in[13]; const float* cw = p.in[18];
    const int tid = threadIdx.x, cg = tid & 127, c0 = cg * 8, tgrp = tid >> 7;
    float mr[8], mk[8], mv[8], kkc[8], cw0[8], cw1[8], cw2[8];
#pragma unroll
    for (int i = 0; i < 8; ++i) { mr[i] = mu_rkv[c0 + i]; mk[i] = mu_rkv[1024 + c0 + i]; mv[i] = mu_rkv[2048 + c0 + i]; kkc[i] = k_k[c0 + i]; cw0[i] = cw[c0 + i]; cw1[i] = cw[1024 + c0 + i]; cw2[i] = cw[2048 + c0 + i]; }
    for (int run = blockIdx.x * 4 + tgrp; run < S_ / 16; run += gridDim.x * 4) {
        const int t0 = run * 16;
        float pr[8], pk[8], pv[8], u1[8], u2[8];
#pragma unroll
        for (int i = 0; i < 8; ++i) { pr[i] = 0.f; pk[i] = 0.f; pv[i] = 0.f; u1[i] = 0.f; u2[i] = 0.f; }
        if (t0 > 0) {
            const size_t o = (size_t)(t0 - 1) * NAUG + c0;
            unpack8(*(const u32x4*)(P + o), pr); unpack8(*(const u32x4*)(P + o + 1024), pk); unpack8(*(const u32x4*)(P + o + 2048), pv);
            float x[8], y[8];
            unpack8(*(const u32x4*)(P + o + 4096), x); unpack8(*(const u32x4*)(P + o + 5120), y);
#pragma unroll
            for (int i = 0; i < 8; ++i) u1[i] = x[i] * y[i];
            unpack8(*(const u32x4*)(P + o - NAUG + 4096), x); unpack8(*(const u32x4*)(P + o - NAUG + 5120), y);
#pragma unroll
            for (int i = 0; i < 8; ++i) u2[i] = x[i] * y[i];
        }
        u32x4 nxA[6], nxB[6];
#define PE_LOAD(buf, tt) do { const size_t _o = (size_t)(t0 + ((tt) < 16 ? (tt) : 15)) * NAUG + c0; _Pragma("unroll") for (int q = 0; q < 6; ++q) buf[q] = *(const u32x4*)(P + _o + 1024 * q); } while (0)
#define PE_BODY(buf, tt) do { \
            float cr[8], ck[8], cv[8], bg[8], cgt[8], xc[8]; \
            unpack8(buf[0], cr); unpack8(buf[1], ck); unpack8(buf[2], cv); unpack8(buf[3], bg); unpack8(buf[4], cgt); unpack8(buf[5], xc); \
            PE_LOAD(buf, (tt) + 2); \
            float r[8], k[8], v[8], kkv[8], yc[8]; float ss = 0.f; \
            _Pragma("unroll") for (int i = 0; i < 8; ++i) { \
                r[i] = cr[i] + (pr[i] - cr[i]) * mr[i]; k[i] = ck[i] + (pk[i] - ck[i]) * mk[i]; v[i] = cv[i] + (pv[i] - cv[i]) * mv[i]; \
                pr[i] = cr[i]; pk[i] = ck[i]; pv[i] = cv[i]; \
                kkv[i] = k[i] * kkc[i]; ss += kkv[i] * kkv[i]; \
                const float u0 = cgt[i] * xc[i]; \
                yc[i] = bg[i] * (cw0[i] * u2[i] + cw1[i] * u1[i] + cw2[i] * u0); \
                u2[i] = u1[i]; u1[i] = u0; } \
            ss += dpp_f<0xB1, 0xf>(ss); ss += dpp_f<0x4E, 0xf>(ss); ss += dpp_f<0x141, 0xf>(ss); \
            const float inv = 1.0f / fmaxf(sqrtf(ss), 1e-12f); \
            _Pragma("unroll") for (int i = 0; i < 8; ++i) kkv[i] *= inv; \
            const size_t oo = (size_t)(t0 + (tt)) * DR + c0; \
            *(u32x4*)(R + oo) = pack8(r); *(u32x4*)(Kk + oo) = pack8(k); *(u32x4*)(V + oo) = pack8(v); *(u32x4*)(KK + oo) = pack8(kkv); *(u32x4*)(YC + oo) = pack8(yc); \
        } while (0)
        PE_LOAD(nxA, 0); PE_LOAD(nxB, 1);
#pragma unroll 1
        for (int t = 0; t < 16; t += 2) { PE_BODY(nxA, t); PE_BODY(nxB, t + 1); }
#undef PE_LOAD
#undef PE_BODY
    }
}

#define TILE(i) ((LAS bf16_t*)(lds + (i) * TSLOT))
__device__ __forceinline__ f32x4 mm_tile(f32x4 acc, const LAS bf16_t* A, const LAS bf16_t* Bt, int mi, int ni, int fr, int fq) {
#pragma unroll
    for (int ks = 0; ks < 2; ++ks) {
        const bf16x8 a = *(const LAS bf16x8*)(A + (mi * 16 + fr) * TLD + ks * 32 + fq * 8);
        const bf16x8 b = *(const LAS bf16x8*)(Bt + (ni * 16 + fr) * TLD + ks * 32 + fq * 8);
        acc = __builtin_amdgcn_mfma_f32_16x16x32_bf16(a, b, acc, 0, 0, 0);
    }
    return acc;
}
__device__ __forceinline__ void st_rm(LAS bf16_t* X, f32x4 v, int mi, int ni, int fr, int fq) {
    const unsigned w0 = cvt_pk_bf16(v[0], v[1]), w1 = cvt_pk_bf16(v[2], v[3]);
    LAS bf16_t* q = X + (mi * 16 + fq * 4) * TLD + ni * 16 + fr;
    q[0] = (bf16_t)(w0 & 0xffffu); q[TLD] = (bf16_t)(w0 >> 16); q[2 * TLD] = (bf16_t)(w1 & 0xffffu); q[3 * TLD] = (bf16_t)(w1 >> 16);
}
__device__ __forceinline__ void st_tr(LAS bf16_t* XT, f32x4 v, int mi, int ni, int fr, int fq) {
    u32x2 w; w.x = cvt_pk_bf16(v[0], v[1]); w.y = cvt_pk_bf16(v[2], v[3]);
    *(LAS u32x2*)(XT + (ni * 16 + fr) * TLD + mi * 16 + fq * 4) = w;
}
__device__ __forceinline__ f32x4 ld_rm(const LAS bf16_t* X, int mi, int ni, int fr, int fq) {
    const LAS bf16_t* q = X + (mi * 16 + fq * 4) * TLD + ni * 16 + fr;
    return (f32x4){bf2f(q[0]), bf2f(q[TLD]), bf2f(q[2 * TLD]), bf2f(q[3 * TLD])};
}
__device__ __forceinline__ f32x4 ld_tr(const LAS bf16_t* XT, int mi, int ni, int fr, int fq) {
    const u32x2 w = *(const LAS u32x2*)(XT + (ni * 16 + fr) * TLD + mi * 16 + fq * 4);
    return (f32x4){lo_bf(w.x), hi_bf(w.x), lo_bf(w.y), hi_bf(w.y)};
}

__device__ __forceinline__ void phase_chunkA(const Params& p, LAS unsigned char* lds) {
    const int tid = threadIdx.x, w = tid >> 6, lane = tid & 63, fr = lane & 15, fq = lane >> 4;
    const int mi = w >> 1, nb = (w & 1) * 2;
    LAS float* cl = (LAS float*)(lds + 14 * TSLOT);
    LAS float* gs = (LAS float*)(lds + 16 * TSLOT);
    LAS float* wc = gs + 512;
    const bf16_t* R = (const bf16_t*)(p.ws + WS_R); const bf16_t* Kk = (const bf16_t*)(p.ws + WS_K); const bf16_t* V = (const bf16_t*)(p.ws + WS_V);
    const bf16_t* KK = (const bf16_t*)(p.ws + WS_KK); const bf16_t* A = (const bf16_t*)(p.ws + WS_A); const bf16_t* LW = (const bf16_t*)(p.ws + WS_LW);
    bf16_t* GT = (bf16_t*)(p.ws + WS_GT); float* HT = (float*)(p.ws + WS_HT); bf16_t* QE = (bf16_t*)(p.ws + WS_QE); bf16_t* YL = (bf16_t*)(p.ws + WS_YL);
    const f32x4 z4 = (f32x4){0.f, 0.f, 0.f, 0.f};
    const float* k_a = p.in[14]; const float* r_k = p.in[15]; float* BON = (float*)(p.ws + WS_BON);
    u32x4 nr4, nk4, nv4, nkk4, na4, nlw4;
#define CA_LOAD(it) do { const size_t _go = (size_t)(((it) >> 4) * 64 + (tid >> 3)) * DR + ((it) & 15) * 64 + (tid & 7) * 8; \
        nr4 = *(const u32x4*)(R + _go); nk4 = *(const u32x4*)(Kk + _go); nv4 = *(const u32x4*)(V + _go); nkk4 = *(const u32x4*)(KK + _go); na4 = *(const u32x4*)(A + _go); nlw4 = *(const u32x4*)(LW + _go); } while (0)
    for (int item = blockIdx.x; item < 4096; item += gridDim.x) {
        const int c = item >> 4, h = item & 15;
        const int t = tid >> 3, k0 = (tid & 7) * 8;
        if (item == (int)blockIdx.x) CA_LOAD(item);
        const u32x4 r4 = nr4, k4 = nk4, v4 = nv4, kk4 = nkk4, a4 = na4, lw4 = nlw4;
        __syncthreads();
        {
            float lwf8[8]; unpack8(lw4, lwf8);
            *(LAS f32x4*)(cl + t * 64 + k0) = (f32x4){lwf8[0], lwf8[1], lwf8[2], lwf8[3]};
            *(LAS f32x4*)(cl + t * 64 + k0 + 4) = (f32x4){lwf8[4], lwf8[5], lwf8[6], lwf8[7]};
            __syncthreads();
            const int g = w, k = lane;
            float pfx[8]; float run = 0.f;
#pragma unroll
            for (int i = 0; i < 8; ++i) { run += cl[(g * 8 + i) * 64 + k]; pfx[i] = run; }
            gs[g * 64 + k] = run;
            __syncthreads();
            float off = 0.f;
#pragma unroll
            for (int gg = 0; gg < 7; ++gg) { const float x = gs[gg * 64 + k]; off += (gg < g) ? x : 0.f; }
#pragma unroll
            for (int i = 0; i < 8; ++i) cl[(g * 8 + i) * 64 + k] = off + pfx[i];
            if (g == 7) wc[k] = __expf(off + pfx[7]);
            __syncthreads();
        }
        if (item + (int)gridDim.x < 4096) CA_LOAD(item + (int)gridDim.x);
        {
            float at[8], rt[8], bt[8], kt[8], bh[8], kh[8], vv[8]; float bsum = 0.f;
#pragma unroll
            for (int i = 0; i < 8; ++i) {
                const int q = i >> 1; const bool hi = i & 1;
                const float rf = hi ? hi_bf(r4[q]) : lo_bf(r4[q]), kraw = hi ? hi_bf(k4[q]) : lo_bf(k4[q]), vf = hi ? hi_bf(v4[q]) : lo_bf(v4[q]);
                const float kkf = hi ? hi_bf(kk4[q]) : lo_bf(kk4[q]), af = hi ? hi_bf(a4[q]) : lo_bf(a4[q]), lwf = hi ? hi_bf(lw4[q]) : lo_bf(lw4[q]);
                const float kf = kraw * (1.f + (af - 1.f) * k_a[h * 64 + k0 + i]);
                bsum += rf * kf * r_k[h * 64 + k0 + i];
                const float clv = cl[t * 64 + k0 + i], cle = cl[63 * 64 + k0 + i];
                const float e = __expf(clv), ex = __expf(clv - lwf), ei = __expf(-clv), eh = __expf(cle - clv);
                const float bb = kkf * af;
                at[i] = -kkf * ex; rt[i] = rf * e; bt[i] = bb * ei; kt[i] = kf * ei; bh[i] = bb * eh; kh[i] = kf * eh; vv[i] = vf;
            }
            bsum += dpp_f<0xB1, 0xf>(bsum); bsum += dpp_f<0x4E, 0xf>(bsum); bsum += dpp_f<0x141, 0xf>(bsum);
            if ((tid & 7) == 0) BON[(size_t)(c * 64 + t) * 16 + h] = bsum;
            *(LAS u32x4*)(TILE(0) + t * TLD + k0) = pack8(at);
            *(LAS u32x4*)(TILE(2) + t * TLD + k0) = pack8(rt);
            *(LAS u32x4*)(TILE(3) + t * TLD + k0) = pack8(bt);
            *(LAS u32x4*)(TILE(4) + t * TLD + k0) = pack8(kt);
            const u32x4 atp = pack8(at), bhp = pack8(bh), khp = pack8(kh);
#pragma unroll
            for (int i = 0; i < 8; ++i) {
                const int q = i >> 1; const bool hi = i & 1;
                TILE(1)[(k0 + i) * TLD + t] = (bf16_t)(hi ? (atp[q] >> 16) : (atp[q] & 0xffffu));
                TILE(5)[(k0 + i) * TLD + t] = (bf16_t)(hi ? (bhp[q] >> 16) : (bhp[q] & 0xffffu));
                TILE(6)[(k0 + i) * TLD + t] = (bf16_t)(hi ? (khp[q] >> 16) : (khp[q] & 0xffffu));
                TILE(7)[(k0 + i) * TLD + t] = (bf16_t)(hi ? (v4[q] >> 16) : (v4[q] & 0xffffu));
            }
            __syncthreads();
        }
#pragma unroll
        for (int nn = 0; nn < 2; ++nn) {
            const int ni = nb + nn; const int col = ni * 16 + fr, row0 = mi * 16 + fq * 4;
            f32x4 x = mm_tile(z4, TILE(0), TILE(3), mi, ni, fr, fq);
#pragma unroll
            for (int j = 0; j < 4; ++j) x[j] = (col < row0 + j) ? x[j] : 0.f;
            st_rm(TILE(8), x, mi, ni, fr, fq); st_tr(TILE(9), x, mi, ni, fr, fq);
            x = mm_tile(z4, TILE(0), TILE(4), mi, ni, fr, fq);
#pragma unroll
            for (int j = 0; j < 4; ++j) x[j] = (col < row0 + j) ? x[j] : 0.f;
            st_rm(TILE(10), x, mi, ni, fr, fq);
            x = mm_tile(z4, TILE(2), TILE(3), mi, ni, fr, fq);
#pragma unroll
            for (int j = 0; j < 4; ++j) x[j] = (col <= row0 + j) ? x[j] : 0.f;
            st_rm(TILE(11), x, mi, ni, fr, fq);
            x = mm_tile(z4, TILE(2), TILE(4), mi, ni, fr, fq);
#pragma unroll
            for (int j = 0; j < 4; ++j) x[j] = (col <= row0 + j) ? x[j] : 0.f;
            st_rm(TILE(12), x, mi, ni, fr, fq);
        }
        __syncthreads();
#pragma unroll
        for (int nn = 0; nn < 2; ++nn) {
            const int ni = nb + nn;
            st_tr(TILE(13), mm_tile(z4, TILE(10), TILE(7), mi, ni, fr, fq), mi, ni, fr, fq);
            const f32x4 x = mm_tile(z4, TILE(8), TILE(9), mi, ni, fr, fq);
            st_rm(TILE(0), x, mi, ni, fr, fq); st_tr(TILE(3), x, mi, ni, fr, fq);
        }
        __syncthreads();
#pragma unroll
        for (int rd = 0; rd < 5; ++rd) {
            const int tq = (rd & 1) ? 14 : 8, tqo = (rd & 1) ? 8 : 14;
            const int lx = (rd & 1) ? 4 : 0, lxt = (rd & 1) ? 9 : 3, lxo = (rd & 1) ? 0 : 4, lxto = (rd & 1) ? 3 : 9;
#pragma unroll
            for (int nn = 0; nn < 2; ++nn) {
                const int ni = nb + nn;
                f32x4 x = ld_rm(TILE(tq), mi, ni, fr, fq) + ld_rm(TILE(lx), mi, ni, fr, fq);
                x = mm_tile(x, TILE(tq), TILE(lxt), mi, ni, fr, fq);
                st_rm(TILE(tqo), x, mi, ni, fr, fq);
                if (rd < 4) { const f32x4 y = mm_tile(z4, TILE(lx), TILE(lxt), mi, ni, fr, fq); st_rm(TILE(lxo), y, mi, ni, fr, fq); st_tr(TILE(lxto), y, mi, ni, fr, fq); }
            }
            __syncthreads();
        }
#pragma unroll
        for (int nn = 0; nn < 2; ++nn) {
            const int ni = nb + nn;
            st_tr(TILE(10), mm_tile(ld_tr(TILE(1), mi, ni, fr, fq), TILE(14), TILE(1), mi, ni, fr, fq), mi, ni, fr, fq);
            st_tr(TILE(15), mm_tile(ld_tr(TILE(13), mi, ni, fr, fq), TILE(14), TILE(13), mi, ni, fr, fq), mi, ni, fr, fq);
        }
        __syncthreads();
#pragma unroll
        for (int nn = 0; nn < 2; ++nn) {
            const int ni = nb + nn;
            {
                f32x4 x = mm_tile(z4, TILE(5), TILE(10), mi, ni, fr, fq);
                if (mi == ni) {
#pragma unroll
                    for (int j = 0; j < 4; ++j) x[j] += (fq * 4 + j == fr) ? wc[ni * 16 + fr] : 0.f;
                }
                const unsigned w0 = cvt_pk_bf16(x[0], x[1]), w1 = cvt_pk_bf16(x[2], x[3]);
                bf16_t* gp = GT + (size_t)item * 4096 + (size_t)((mi * 2 + (ni >> 1)) * 64 + (fr >> 2) * 16 + fq * 4) * 8 + (ni & 1) * 4 + (fr & 3);
                gp[0] = (bf16_t)(w0 & 0xffffu); gp[8] = (bf16_t)(w0 >> 16); gp[16] = (bf16_t)(w1 & 0xffffu); gp[24] = (bf16_t)(w1 >> 16);
            }
            {
                f32x4 x = mm_tile(z4, TILE(5), TILE(15), mi, ni, fr, fq);
                x = mm_tile(x, TILE(6), TILE(7), mi, ni, fr, fq);
                *(f32x4*)(HT + (size_t)item * 4096 + (size_t)((ni * 4 + mi) * 64 + lane) * 4) = x;
            }
            {
                f32x4 x = ld_tr(TILE(2), mi, ni, fr, fq);
                x = mm_tile(x, TILE(10), TILE(11), mi, ni, fr, fq);
                u32x2 wv; wv.x = cvt_pk_bf16(x[0], x[1]); wv.y = cvt_pk_bf16(x[2], x[3]);
                *(u32x2*)(QE + (size_t)item * 4096 + (ni * 16 + fr) * 64 + mi * 16 + fq * 4) = wv;
            }
            {
                f32x4 x = mm_tile(z4, TILE(11), TILE(15), mi, ni, fr, fq);
                x = mm_tile(x, TILE(12), TILE(7), mi, ni, fr, fq);
                u32x2 wv; wv.x = cvt_pk_bf16(x[0], x[1]); wv.y = cvt_pk_bf16(x[2], x[3]);
                *(u32x2*)(YL + (size_t)item * 4096 + (size_t)((mi * 4 + ni) * 64 + lane) * 4) = wv;
            }
        }
    }
}

__device__ __forceinline__ void phase_seq(const Params& p) {
    if (threadIdx.x >= 64) return;
    const int head = blockIdx.x >> 2, vt = blockIdx.x & 3, lane = threadIdx.x, fr = lane & 15, fq = lane >> 4;
    const bf16_t* GT = (const bf16_t*)(p.ws + WS_GT); const float* HT = (const float*)(p.ws + WS_HT); bf16_t* S0 = (bf16_t*)(p.ws + WS_S0);
    f32x4 acc[4];
#pragma unroll
    for (int mb = 0; mb < 4; ++mb) acc[mb] = (f32x4){0.f, 0.f, 0.f, 0.f};
    bf16x8 ga[4][4][2]; f32x4 hh[4][4];
#define SEQ_LOAD(buf, cc) do { const size_t _it = (size_t)((cc) < 256 ? (cc) : 255) * 16 + head; \
        _Pragma("unroll") for (int mb = 0; mb < 4; ++mb) { \
            _Pragma("unroll") for (int ks = 0; ks < 2; ++ks) ga[buf][mb][ks] = *(const bf16x8*)(GT + _it * 4096 + (size_t)((mb * 2 + ks) * 64 + lane) * 8); \
            hh[buf][mb] = *(const f32x4*)(HT + _it * 4096 + (size_t)((vt * 4 + mb) * 64 + lane) * 4); } } while (0)
    SEQ_LOAD(0, 0); SEQ_LOAD(1, 1); SEQ_LOAD(2, 2); SEQ_LOAD(3, 3);
    for (int c0 = 0; c0 < 256; c0 += 4) {
#pragma unroll
        for (int b = 0; b < 4; ++b) {
            const int c = c0 + b; const size_t item = (size_t)c * 16 + head;
            u32x2 pk[4];
#pragma unroll
            for (int mb = 0; mb < 4; ++mb) { pk[mb].x = cvt_pk_bf16(acc[mb][0], acc[mb][1]); pk[mb].y = cvt_pk_bf16(acc[mb][2], acc[mb][3]);
                *(u32x2*)(S0 + item * 4096 + (vt * 16 + fr) * 64 + mb * 16 + fq * 4) = pk[mb]; }
            u32x4 b0w, b1w; b0w.x = pk[0].x; b0w.y = pk[0].y; b0w.z = pk[1].x; b0w.w = pk[1].y; b1w.x = pk[2].x; b1w.y = pk[2].y; b1w.z = pk[3].x; b1w.w = pk[3].y;
            const bf16x8 b0 = __builtin_bit_cast(bf16x8, b0w), b1 = __builtin_bit_cast(bf16x8, b1w);
#pragma unroll
            for (int mb = 0; mb < 4; ++mb) {
                const f32x4 x = __builtin_amdgcn_mfma_f32_16x16x32_bf16(ga[b][mb][0], b0, hh[b][mb], 0, 0, 0);
                acc[mb] = __builtin_amdgcn_mfma_f32_16x16x32_bf16(ga[b][mb][1], b1, x, 0, 0, 0);
            }
            SEQ_LOAD(b, c + 4);
        }
    }
#undef SEQ_LOAD
}

__device__ __forceinline__ void phase_chunkY(const Params& p, LAS unsigned char* lds) {
    LAS float* Yb = (LAS float*)lds;
    const int tid = threadIdx.x, w = tid >> 6, lane = tid & 63, fr = lane & 15, fq = lane >> 4;
    const int mi = w >> 1, nb = (w & 1) * 2;
    const bf16_t* R = (const bf16_t*)(p.ws + WS_R); const bf16_t* Kk = (const bf16_t*)(p.ws + WS_K); const bf16_t* V = (const bf16_t*)(p.ws + WS_V);
    const bf16_t* G = (const bf16_t*)(p.ws + WS_G); const bf16_t* YC = (const bf16_t*)(p.ws + WS_YC);
    const bf16_t* QE = (const bf16_t*)(p.ws + WS_QE); const bf16_t* YL = (const bf16_t*)(p.ws + WS_YL); const bf16_t* S0 = (const bf16_t*)(p.ws + WS_S0);
    bf16_t* YM = (bf16_t*)(p.ws + WS_YMIX);
    const float* gn_w = p.in[16]; const float* gn_b = p.in[17];
    u32x2 ywn[2]; bf16x8 an[2], bn[2][2]; bool first = true;
    u32x4 nv4, ng4, nyc4; float nbon; const float* BONp = (const float*)(p.ws + WS_BON);
#define CY_LOAD(it) do { const bf16_t* _q = QE + (size_t)(it) * 4096; const bf16_t* _s = S0 + (size_t)(it) * 4096; const bf16_t* _y = YL + (size_t)(it) * 4096; \
        _Pragma("unroll") for (int ks = 0; ks < 2; ++ks) an[ks] = *(const bf16x8*)(_q + (mi * 16 + fr) * 64 + ks * 32 + fq * 8); \
        _Pragma("unroll") for (int nn = 0; nn < 2; ++nn) { ywn[nn] = *(const u32x2*)(_y + (size_t)((mi * 4 + nb + nn) * 64 + lane) * 4); \
            _Pragma("unroll") for (int ks = 0; ks < 2; ++ks) bn[nn][ks] = *(const bf16x8*)(_s + (nb + nn) * 16 * 64 + fr * 64 + ks * 32 + fq * 8); } \
        { const size_t _tg = (size_t)((it) >> 4) * 64 + (tid >> 3); const size_t _o = _tg * DR + ((it) & 15) * 64 + (tid & 7) * 8; \
          nv4 = *(const u32x4*)(V + _o); ng4 = *(const u32x4*)(G + _o); nyc4 = *(const u32x4*)(YC + _o); nbon = BONp[_tg * 16 + ((it) & 15)]; } } while (0)
    for (int item = blockIdx.x; item < 4096; item += gridDim.x) {
        const int c = item >> 4, h = item & 15;
        if (first) { first = false; CY_LOAD(item); }
        __syncthreads();
        const u32x2 ywc[2] = {ywn[0], ywn[1]}; const bf16x8 ac[2] = {an[0], an[1]}; const bf16x8 bc[2][2] = {{bn[0][0], bn[0][1]}, {bn[1][0], bn[1][1]}};
        const u32x4 v4 = nv4, g4 = ng4, yc4 = nyc4; const float bon = nbon;
        if (item + (int)gridDim.x < 4096) CY_LOAD(item + (int)gridDim.x);
#pragma unroll
        for (int nn = 0; nn < 2; ++nn) {
            const int ni = nb + nn;
            const u32x2 yw = ywc[nn];
            f32x4 acc = (f32x4){lo_bf(yw.x), hi_bf(yw.x), lo_bf(yw.y), hi_bf(yw.y)};
#pragma unroll
            for (int ks = 0; ks < 2; ++ks) acc = __builtin_amdgcn_mfma_f32_16x16x32_bf16(ac[ks], bc[nn][ks], acc, 0, 0, 0);
#pragma unroll
            for (int j = 0; j < 4; ++j) Yb[(mi * 16 + fq * 4 + j) * 68 + ni * 16 + fr] = acc[j];
        }
        __syncthreads();
        {
            const int t = tid >> 3, k0 = (tid & 7) * 8; const int ch = h * 64 + k0;
            const size_t tg = (size_t)c * 64 + t; const size_t o = tg * DR + ch;
            const float4 gw0 = *(const float4*)(gn_w + ch), gw1 = *(const float4*)(gn_w + ch + 4), gb0 = *(const float4*)(gn_b + ch), gb1 = *(const float4*)(gn_b + ch + 4);
            const float gwv[8] = {gw0.x, gw0.y, gw0.z, gw0.w, gw1.x, gw1.y, gw1.z, gw1.w}, gbv[8] = {gb0.x, gb0.y, gb0.z, gb0.w, gb1.x, gb1.y, gb1.z, gb1.w};
            const f32x4 y0 = *(const LAS f32x4*)(Yb + t * 68 + k0), y1 = *(const LAS f32x4*)(Yb + t * 68 + k0 + 4);
            const float y[8] = {y0[0], y0[1], y0[2], y0[3], y1[0], y1[1], y1[2], y1[3]};
            float sm = 0.f;
#pragma unroll
            for (int i = 0; i < 8; ++i) sm += y[i];
            sm += dpp_f<0xB1, 0xf>(sm); sm += dpp_f<0x4E, 0xf>(sm); sm += dpp_f<0x141, 0xf>(sm);
            const float mean = sm * (1.f / 64.f);
            float vs = 0.f;
#pragma unroll
            for (int i = 0; i < 8; ++i) { const float d = y[i] - mean; vs += d * d; }
            vs += dpp_f<0xB1, 0xf>(vs); vs += dpp_f<0x4E, 0xf>(vs); vs += dpp_f<0x141, 0xf>(vs);
            const float rs = rsqrtf(vs * (1.f / 64.f) + 64e-5f);
            float vf[8], gf[8], of[8];
            unpack8(v4, vf); unpack8(g4, gf);
#pragma unroll
            for (int i = 0; i < 8; ++i) of[i] = ((y[i] - mean) * rs * gwv[i] + gbv[i] + bon * vf[i]) * gf[i];
            *(u32x4*)(YM + tg * D_ + ch) = pack8(of);
            *(u32x4*)(YM + tg * D_ + 1024 + ch) = yc4;
        }
    }
#undef CY_LOAD
}

__device__ __forceinline__ int f2key(float x) { const int u = __float_as_int(x); return u ^ ((u >> 31) & 0x7fffffff); }
__device__ __forceinline__ float key2f(int k) { return __int_as_float(k ^ ((k >> 31) & 0x7fffffff)); }
template <int CTRL> __device__ __forceinline__ int dpp_i(int v) { return __builtin_amdgcn_update_dpp(v, v, CTRL, 0xf, 0xf, false); }
__device__ __forceinline__ int row_max_i(int v) { v = max(v, dpp_i<0xB1>(v)); v = max(v, dpp_i<0x4E>(v)); v = max(v, dpp_i<0x141>(v)); v = max(v, dpp_i<0x140>(v)); return v; }
__device__ __forceinline__ void phase_topk(const Params& p, unsigned char* shm) {
    float* sc = (float*)shm;
    int* tk = (int*)(sc + 64 * 260);
    int* ctab = tk + 2048;
    if (threadIdx.x < 64) { int n = threadIdx.x, v = 256;
        for (int i = 0; i < 16; ++i) { const int cnt = 16 / (i + 1); if (n < cnt) { v = i * 16 + n; break; } n -= cnt; }
        ctab[threadIdx.x] = v; }
    const float* SC = (const float*)(p.ws + WS_Q);
    int* IDS = (int*)(p.ws + WS_IDS); float* GATES = (float*)(p.ws + WS_GATES);
    const int tid = threadIdx.x, w = tid >> 6, lane = tid & 63;
    f32x4 qreg[8];
#define TK_QLOAD(it) do { const int _t0 = ((it) >> 3) * 64; _Pragma("unroll") for (int i = 0; i < 8; ++i) { const int ch = tid + 512 * i; \
        qreg[i] = *(const f32x4*)(SC + (size_t)(_t0 + (ch >> 6)) * 2048 + ((it) & 7) * 256 + (ch & 63) * 4); } } while (0)
    if ((int)blockIdx.x < 2048) TK_QLOAD((int)blockIdx.x);
    for (int item = blockIdx.x; item < 2048; item += gridDim.x) {
        const int t0 = (item >> 3) * 64, h = item & 7;
        __syncthreads();
#pragma unroll
        for (int i = 0; i < 8; ++i) { const int ch = tid + 512 * i; *(f32x4*)(sc + (ch >> 6) * 260 + (ch & 63) * 4) = qreg[i]; }
        __syncthreads();
        if (item + (int)gridDim.x < 2048) TK_QLOAD(item + (int)gridDim.x);
        for (int g = 0; g < 4; ++g) {
            const int L = w * 16 + g * 4 + (lane >> 4); const int tok = L >> 1, cc = L & 1; const int pp = lane & 15;
            int key[8];
#pragma unroll
            for (int i = 0; i < 8; ++i) key[i] = (f2key(sc[tok * 260 + cc * 128 + i * 16 + pp]) & ~127) | (127 - (i * 16 + pp));
#define CE(a, b) do { const int _hi = max(key[a], key[b]), _lo = min(key[a], key[b]); key[a] = _hi; key[b] = _lo; } while (0)
            CE(0, 1); CE(2, 3); CE(4, 5); CE(6, 7);  CE(0, 2); CE(1, 3); CE(4, 6); CE(5, 7);  CE(1, 2); CE(5, 6);
            CE(0, 4); CE(1, 5); CE(2, 6); CE(3, 7);  CE(2, 4); CE(3, 5);  CE(1, 2); CE(3, 4); CE(5, 6);
#undef CE
            int mykey = 0;
#pragma unroll
            for (int r = 0; r < 16; ++r) {
                const int m = row_max_i(key[0]);
                const bool win = (key[0] == m);
#pragma unroll
                for (int i = 0; i < 7; ++i) key[i] = win ? key[i + 1] : key[i];
                key[7] = win ? (int)0x80000000 : key[7];
                mykey = (pp == r) ? m : mykey;
            }
            tk[L * 16 + pp] = mykey;
        }
        __syncthreads();
        for (int g = 0; g < 2; ++g) {
            const int tok = w * 8 + g * 4 + (lane >> 4); const int pp = lane & 15;
            int key[4];
#pragma unroll
            for (int q = 0; q < 4; ++q) {
                const int ij = ctab[q * 16 + pp];
                const float s1 = key2f(tk[(tok * 2) * 16 + ((ij >> 4) & 15)] & ~127), s2 = key2f(tk[(tok * 2 + 1) * 16 + (ij & 15)] & ~127);
                key[q] = (ij < 256) ? ((f2key(s1 + s2) & ~255) | (255 - ij)) : (int)0x80000000;
            }
            int mykey = 0;
#pragma unroll
            for (int r = 0; r < 16; ++r) {
                const int ml = max(max(key[0], key[1]), max(key[2], key[3]));
                const int m = row_max_i(ml);
#pragma unroll
                for (int q = 0; q < 4; ++q) key[q] = (key[q] == m) ? (int)0x80000000 : key[q];
                mykey = (pp == r) ? m : mykey;
            }
            const int ci = 255 - (mykey & 255); const float cs = key2f(mykey & ~255);
            const int e1 = 127 - (tk[(tok * 2) * 16 + (ci >> 4)] & 127), e2 = 127 - (tk[(tok * 2 + 1) * 16 + (ci & 15)] & 127);
            const float mx = __shfl(cs, lane & 48);
            const float e = __expf(cs - mx);
            float sum = e; sum += dpp_f<0xB1, 0xf>(sum); sum += dpp_f<0x4E, 0xf>(sum); sum += dpp_f<0x141, 0xf>(sum); sum += dpp_f<0x140, 0xf>(sum);
            IDS[(size_t)(t0 + tok) * 128 + h * 16 + pp] = (e1 * 128 + e2) & 16383;
            GATES[(size_t)(t0 + tok) * 128 + h * 16 + pp] = e / sum;
        }
    }
#undef TK_QLOAD
}

__device__ __forceinline__ float gelu_fast(float x) { const float u = 0.7978845608028654f * (x + 0.044715f * x * x * x); return x / (1.0f + __expf(-2.0f * u)); }
__device__ __forceinline__ void phase_gather(const Params& p, unsigned char* shm) {
    const float* X1 = (const float*)(p.ws + WS_X1); const float* SSQ = (const float*)(p.ws + WS_SSQ);
    const unsigned char* U6 = p.ws + WS_UB; const unsigned char* V6 = p.ws + WS_VB;
    const int* IDS = (const int*)(p.ws + WS_IDS); const float* GATES = (const float*)(p.ws + WS_GATES);
    const float* nf = p.in[25];
    const int tid = threadIdx.x, w = tid >> 6, lane = tid & 63;
    int nid0 = 0, nid1 = 0; float ngt0 = 0.f, ngt1 = 0.f, nssq = 0.f;
#define GT_META(tt) do { nid0 = IDS[(size_t)(tt) * 128 + lane]; nid1 = IDS[(size_t)(tt) * 128 + 64 + lane]; ngt0 = GATES[(size_t)(tt) * 128 + lane]; ngt1 = GATES[(size_t)(tt) * 128 + 64 + lane]; \
        nssq = (lane < 32) ? SSQ[(size_t)(tt) * 32 + lane] : 0.f; } while (0)
    if ((int)(blockIdx.x * 8 + w) < S_) GT_META(blockIdx.x * 8 + w);
    for (int t = blockIdx.x * 8 + w; t < S_; t += gridDim.x * 8) {
        const int id0 = nid0, id1 = nid1; const float gt0 = ngt0, gt1 = ngt1, ssqv = nssq;
        if (t + (int)gridDim.x * 8 < S_) GT_META(t + (int)gridDim.x * 8);
        f32x2 op[16];
#pragma unroll
        for (int j = 0; j < 8; ++j) { const float4 x = *(const float4*)(X1 + (size_t)t * D_ + (j * 64 + lane) * 4);
            op[2 * j] = (f32x2){x.x, x.y}; op[2 * j + 1] = (f32x2){x.z, x.w}; }
        f32x2 hp[16];
#pragma unroll
        for (int i = 0; i < 16; ++i) hp[i] = op[i];
        const float rs = rsqrtf(wave_sum_dpp(ssqv) * (1.0f / 2048.0f) + 1e-6f);
        u32x4 uaA[4], ubA[4], vbA[4]; u32x2 uaB[4], ubB[4], vbB[4];
#define G_LOADU(dA, dB, grp) do { _Pragma("unroll") for (int j = 0; j < 4; ++j) { const int e = (grp) * 4 + j; const int id = __builtin_amdgcn_readlane(e < 64 ? id0 : id1, e & 63); \
            const unsigned char* ur = U6 + (size_t)id * ROW6; dA[j] = *(const u32x4*)(ur + lane * 16); dB[j] = *(const u32x2*)(ur + 1024 + lane * 8); } } while (0)
#define G_LOADV(grp) do { _Pragma("unroll") for (int j = 0; j < 4; ++j) { const int e = (grp) * 4 + j; const int id = __builtin_amdgcn_readlane(e < 64 ? id0 : id1, e & 63); \
            const unsigned char* vr = V6 + (size_t)id * ROW6; vbA[j] = *(const u32x4*)(vr + lane * 16); vbB[j] = *(const u32x2*)(vr + 1024 + lane * 8); } } while (0)
#define G_DEC(A, B) __builtin_amdgcn_cvt_scalef32_pk32_f32_fp6((u32x6){A[0], A[1], A[2], A[3], B[0], B[1]}, 1.0f)
#define G_BODY(cA, cB, nA, nB, grp) do { \
            G_LOADV(grp); \
            G_LOADU(nA, nB, ((grp) + 1 < 32 ? (grp) + 1 : 31)); \
            float dsel = 0.f; \
            _Pragma("unroll") for (int j = 0; j < 4; ++j) { const f32x32 dd = G_DEC(cA[j], cB[j]); f32x2 d2 = (f32x2){0.f, 0.f}; \
                _Pragma("unroll") for (int m = 0; m < 16; ++m) d2 += (f32x2){dd[2 * m], dd[2 * m + 1]} * hp[m]; \
                const float d = wave_sum_dpp(d2.x + d2.y); dsel = (lane == j) ? d : dsel; } \
            const float av = gelu_fast(dsel * (rs * (1.f / U6_SCALE))) * (1.f / V6_SCALE); \
            _Pragma("unroll") for (int j = 0; j < 4; ++j) { const int e = (grp) * 4 + j; \
                const float a = __int_as_float(__builtin_amdgcn_readlane(__float_as_int(av), j)) * __int_as_float(__builtin_amdgcn_readlane(__float_as_int(e < 64 ? gt0 : gt1), e & 63)); \
                const f32x2 a2 = (f32x2){a, a}; const f32x32 dd = G_DEC(vbA[j], vbB[j]); \
                _Pragma("unroll") for (int m = 0; m < 16; ++m) op[m] += a2 * (f32x2){dd[2 * m], dd[2 * m + 1]}; } \
        } while (0)
        G_LOADU(uaA, uaB, 0);
#pragma unroll 1
        for (int g2 = 0; g2 < 32; g2 += 2) { G_BODY(uaA, uaB, ubA, ubB, g2); G_BODY(ubA, ubB, uaA, uaB, g2 + 1); }
#undef G_LOADU
#undef G_LOADV
#undef G_DEC
#undef G_BODY
        float ss = 0.f;
#pragma unroll
        for (int m = 0; m < 16; ++m) ss += op[m].x * op[m].x + op[m].y * op[m].y;
        ss = wave_sum_dpp(ss);
        const float scl = rsqrtf(ss * (1.f / 2048.f) + 1e-6f);
#pragma unroll
        for (int j = 0; j < 8; ++j) { const float4 g = *(const float4*)(nf + (j * 64 + lane) * 4);
            *(float4*)(p.out + (size_t)t * D_ + (j * 64 + lane) * 4) = make_float4(op[2 * j].x * scl * g.x, op[2 * j].y * scl * g.y, op[2 * j + 1].x * scl * g.z, op[2 * j + 1].y * scl * g.w); }
    }
#undef GT_META
}

#define XB_TMO      128
#define XB_XCNT(j)  (256  + 64 * (j))
#define XB_XSUB(j)  (1280 + 64 * (j))
#define XB_XGEN(j)  (2304 + 64 * (j))
#define XB_TOP      3328
#define XB_TOPGEN   3392
#define XCD_BAR_WORDS 3456
#define XB_SPIN_CAP (1u << 18)
__device__ __forceinline__ unsigned xb_ld(unsigned* p)              { return __hip_atomic_load(p, __ATOMIC_RELAXED, __HIP_MEMORY_SCOPE_AGENT); }
__device__ __forceinline__ unsigned xb_add(unsigned* p, unsigned v) { return __hip_atomic_fetch_add(p, v, __ATOMIC_RELAXED, __HIP_MEMORY_SCOPE_AGENT); }
__device__ __forceinline__ unsigned xb_xcc_id() { return (unsigned)__builtin_amdgcn_s_getreg((3 << 11) | 20) & 0xFu; }
#define XB_SPIN(cond, bar) do { unsigned _sp = 0; while (cond) { __builtin_amdgcn_s_sleep(1); \
    if ((++_sp & 255u) == 0u) { if (xb_ld(&(bar)[XB_TMO])) break; if (_sp > XB_SPIN_CAP) { atomicAdd(&(bar)[XB_TMO], 1u); break; } } } } while (0)
struct XcdBarrier { unsigned* bar; unsigned x; volatile LAS unsigned* st; };
__device__ __forceinline__ XcdBarrier xcd_barrier_post(unsigned* bar, volatile LAS unsigned* st) {
    XcdBarrier b; b.bar = bar; b.x = xb_xcc_id(); b.st = st;
    if (threadIdx.x == 0) (void)xb_add(&bar[XB_XCNT(b.x)], 1u);
    return b;
}
__device__ __forceinline__ void xcd_barrier_complete(unsigned* bar, unsigned x, unsigned& nloc, unsigned& nx) {
    const unsigned G = gridDim.x * gridDim.y * gridDim.z;
    unsigned sum, cnt, mine, sp = 0u;
    for (;;) {
        sum = 0u; cnt = 0u; mine = 0u;
#pragma unroll
        for (unsigned j = 0; j < 16; ++j) { const unsigned c = xb_ld(&bar[XB_XCNT(j)]); sum += c; cnt += (c > 0u) ? 1u : 0u; mine = (j == x) ? c : mine; }
        if (sum == G) break;
        __builtin_amdgcn_s_sleep(1);
        if ((++sp & 255u) == 0u) { if (xb_ld(&bar[XB_TMO])) break; if (sp > XB_SPIN_CAP) { atomicAdd(&bar[XB_TMO], 1u); break; } }
    }
    nloc = mine > 0u ? mine : 1u; nx = cnt > 0u ? cnt : 1u;
}
__device__ __forceinline__ void xcd_barrier(const XcdBarrier& b) {
    asm volatile("s_waitcnt vmcnt(0)" ::: "memory");
    __syncthreads();
    if (threadIdx.x == 0) {
        unsigned* bar = b.bar;
        __builtin_amdgcn_s_waitcnt(0);
        unsigned nloc = b.st[0], nx = b.st[1];
        if (nloc == 0u) { xcd_barrier_complete(bar, b.x, nloc, nx); b.st[0] = nloc; b.st[1] = nx; }
        const unsigned old = xb_add(&bar[XB_XSUB(b.x)], 1u);
        const unsigned gen = old / nloc;
        if (old + 1u == (gen + 1u) * nloc) {
            __builtin_amdgcn_fence(__ATOMIC_RELEASE, "agent");
            asm volatile("s_waitcnt vmcnt(0)" ::: "memory");
            const unsigned og = xb_add(&bar[XB_TOP], 1u);
            const unsigned tg = og / nx;
            if (og + 1u == (tg + 1u) * nx) xb_add(&bar[XB_TOPGEN], 1u);
            else XB_SPIN(xb_ld(&bar[XB_TOPGEN]) == tg, bar);
            __builtin_amdgcn_fence(__ATOMIC_ACQUIRE, "agent");
            xb_add(&bar[XB_XGEN(b.x)], 1u);
            asm volatile("s_waitcnt vmcnt(0)" ::: "memory");
        } else {
            XB_SPIN(xb_ld(&bar[XB_XGEN(b.x)]) == gen, bar);
            __builtin_amdgcn_fence(__ATOMIC_ACQUIRE, "agent");
            asm volatile("s_waitcnt vmcnt(0)" ::: "memory");
        }
    }
    __syncthreads();
}

__global__ void __launch_bounds__(512, 2) mega(Params p) {
    extern __shared__ __attribute__((aligned(16))) unsigned char shm[];
    cg::grid_group grid = cg::this_grid();
    LAS unsigned char* lds = (LAS unsigned char*)shm;
    volatile LAS unsigned* bst = (volatile LAS unsigned*)(lds + LDS_BYTES - 16);
    if (threadIdx.x == 0) { bst[0] = 0u; bst[1] = 0u; }
    __syncthreads();
    const XcdBarrier xbar = xcd_barrier_post((unsigned*)(p.ws + WS_BAR), bst);
    if (p.ph_hi > 1000) grid.sync();
    const int lo = p.ph_lo, hi = p.ph_hi;
#define IN(k) (lo <= (k) && (k) < hi)
#define REP(k) for (int _r = 0; _r < ((k) == DUP_PHASE ? 2 : 1); ++_r)
#define SEAM(k) do { if (IN(k) && IN((k) + 1)) xcd_barrier(xbar); } while (0)
    if (IN(0)) REP(0) { if (_r) xcd_barrier(xbar); phase0(p, shm); }
    SEAM(0);
    if (IN(1)) REP(1) { if (_r) xcd_barrier(xbar);
        pg8::Gemm g{(const bf16_t*)(p.ws + WS_H), (const bf16_t*)(p.ws + WS_WB1), S_, NAUG, 2048};
        pg8::StaticOrder so; so.init(g.M, g.N, (int)gridDim.x, (int)blockIdx.x);
        pg8::EpiBf16 E{(bf16_t*)(p.ws + WS_PROJ), NAUG};
        pg8::gemm_phase(lds, g, so, E);
    }
    SEAM(1);
    if (IN(2)) REP(2) { if (_r) xcd_barrier(xbar);
        phase_prepM(p, lds);
        phase_prepE(p);
    }
    SEAM(2);
    if (IN(3)) REP(3) { if (_r) xcd_barrier(xbar); phase_chunkA(p, lds); }
    SEAM(3);
    if (IN(4)) REP(4) { if (_r) xcd_barrier(xbar); if (blockIdx.x < 64) phase_seq(p);
        else { const int bid = blockIdx.x - 64, nblk = gridDim.x - 64;
            build_wpt(p.in[21], p.in[20], (const bf16_t*)(p.ws + WS_KEYB), (bf16_t*)(p.ws + WS_WQT), bid, nblk);
            transpose_convert(p.in[19], 2048, 2048, (bf16_t*)(p.ws + WS_WOT), (float*)shm, bid, nblk); } }
    SEAM(4);
    if (IN(5)) REP(5) { if (_r) xcd_barrier(xbar); phase_chunkY(p, lds);
        convert_fp6(p.in[23], p.ws + WS_UB, 16384, U6_SCALE, p.in[20], blockIdx.x, gridDim.x);
        convert_fp6(p.in[24], p.ws + WS_VB, 16384, V6_SCALE, nullptr, blockIdx.x, gridDim.x); }
    SEAM(5);
    if (IN(6)) REP(6) { if (_r) xcd_barrier(xbar);
        pg8::Gemm g{(const bf16_t*)(p.ws + WS_YMIX), (const bf16_t*)(p.ws + WS_WOT), S_, 2048, 2048};
        pg8::StaticOrder so; so.init(g.M, g.N, (int)gridDim.x, (int)blockIdx.x);
        pg8::EpiRes2 E{(float*)(p.ws + WS_X1), p.in[0], (bf16_t*)(p.ws + WS_H2), (float*)(p.ws + WS_SSQ), 2048};
        pg8::gemm_phase(lds, g, so, E);
    }
    SEAM(6);
    if (IN(8)) REP(8) { if (_r) xcd_barrier(xbar);
        pg8::Gemm g{(const bf16_t*)(p.ws + WS_H2), (const bf16_t*)(p.ws + WS_WQT), S_, 2048, 2048};
        pg8::StaticOrder so; so.init(g.M, g.N, (int)gridDim.x, (int)blockIdx.x);
        pg8::EpiRowScaleF32 E{(float*)(p.ws + WS_Q), (const float*)(p.ws + WS_SSQ), 2048};
        pg8::gemm_phase(lds, g, so, E);
    }
    SEAM(8);
    if (IN(9)) REP(9) { if (_r) xcd_barrier(xbar); phase_topk(p, shm); }
    SEAM(9);
    if (IN(10)) REP(10) { if (_r) xcd_barrier(xbar); phase_gather(p, shm); }
#undef IN
#undef REP
#undef SEAM
}

extern "C" void kernel_launch(void* const* d_in, const int* in_sizes, int n_in, void* d_out, int out_size, void* d_ws, size_t ws_size, hipStream_t stream) {
    static int grid_blocks = 0;
    if (grid_blocks == 0) {
        if (n_in != 26 || ws_size < WS_NEED) { fprintf(stderr, "kernel_launch: unexpected n_in %d / ws_size %zu\n", n_in, ws_size); grid_blocks = -1; return; }
        int dev = 0, cus = 0, per_cu = 0;
        (void)hipGetDevice(&dev);
        (void)hipDeviceGetAttribute(&cus, hipDeviceAttributeMultiprocessorCount, dev);
        (void)hipFuncSetAttribute((const void*)mega, hipFuncAttributeMaxDynamicSharedMemorySize, LDS_BYTES);
        (void)hipOccupancyMaxActiveBlocksPerMultiprocessor(&per_cu, (const void*)mega, 512, LDS_BYTES);
        if (per_cu < 1) { fprintf(stderr, "kernel_launch: occupancy query says %d blocks/CU\n", per_cu); per_cu = 1; }
        grid_blocks = cus * per_cu;
        fprintf(stderr, "kernel_launch: cus %d per_cu %d grid %d\n", cus, per_cu, grid_blocks);
    }
    if (grid_blocks < 0) return;
    Params p{};
    for (int i = 0; i < 26; ++i) p.in[i] = (const float*)d_in[i];
    p.out = (float*)d_out; p.ws = (unsigned char*)d_ws;
#if MULTI_LAUNCH
    for (int ph = 0; ph < NPHASE; ++ph) {
        p.ph_lo = ph; p.ph_hi = ph + 1;
        hipLaunchKernelGGL(mega, dim3(grid_blocks), dim3(512), LDS_BYTES, stream, p);
    }
#else
    p.ph_lo = 0; p.ph_hi = NPHASE;
    if (hipMemsetAsync((unsigned char*)d_ws + WS_BAR, 0, XCD_BAR_WORDS * 4, stream) != hipSuccess) fprintf(stderr, "kernel_launch: barrier memset failed\n");
    void* args[] = {&p};
    hipError_t e = hipLaunchCooperativeKernel((const void*)mega, dim3(grid_blocks), dim3(512), args, LDS_BYTES, stream);
    if (e != hipSuccess) fprintf(stderr, "cooperative launch failed: %s (grid %d)\n", hipGetErrorString(e), grid_blocks);
#endif
}
```

```cpp
#include <hip/hip_runtime.h>
#include <hip/hip_cooperative_groups.h>
#include <cstdio>
namespace cg = cooperative_groups;

#ifndef DUP_PHASE
#define DUP_PHASE -1
#endif
#ifndef MULTI_LAUNCH
#define MULTI_LAUNCH 0
#endif

#define LAS __attribute__((address_space(3)))
typedef unsigned short bf16_t;
typedef short bf16x8 __attribute__((ext_vector_type(8)));
typedef float f32x4 __attribute__((ext_vector_type(4)));
typedef float f32x2 __attribute__((ext_vector_type(2)));
typedef unsigned u32x4 __attribute__((ext_vector_type(4)));
typedef unsigned u32x2 __attribute__((ext_vector_type(2)));
typedef unsigned u32x6 __attribute__((ext_vector_type(6)));
typedef float f32x32 __attribute__((ext_vector_type(32)));
typedef __bf16 bf16x32_t __attribute__((ext_vector_type(32)));

constexpr int S_ = 16384, D_ = 2048, DR = 1024, NAUG = 6912;
constexpr size_t MiB = 1ull << 20;
constexpr size_t WS_PROJ = 0, WS_H = 216 * MiB, WS_WB1 = 280 * MiB, WS_WQT = 280 * MiB, WS_WOT = 296 * MiB;
constexpr size_t WS_R = 307 * MiB, WS_K = 339 * MiB, WS_V = 371 * MiB, WS_KK = 403 * MiB, WS_A = 435 * MiB, WS_LW = 467 * MiB;
constexpr size_t WS_G = 216 * MiB, WS_YC = 248 * MiB, WS_YMIX = 307 * MiB, WS_X1 = 0, WS_H2 = 128 * MiB, WS_Q = 307 * MiB;
constexpr size_t WS_GT = 0, WS_HT = 32 * MiB, WS_QE = 96 * MiB, WS_YL = 128 * MiB, WS_S0 = 160 * MiB;
constexpr size_t WS_IDS = 192 * MiB, WS_GATES = 200 * MiB, WS_UB = 467 * MiB, WS_VB = 435 * MiB, WS_BON = 500 * MiB, WS_BAR = 502 * MiB, WS_KEYB = 503 * MiB, WS_SSQ = 504 * MiB, WS_SSQ2 = 506 * MiB, WS_NEED = 507 * MiB;
constexpr size_t WS_ZP = 128 * MiB, WS_X2 = 307 * MiB;
constexpr size_t WS_W2T = 499 * MiB, WS_A2T = WS_W2T + 131072, WS_G2T = WS_A2T + 131072;
constexpr int TLD = 72, TSLOT = 64 * TLD * 2;
constexpr int LDS_BYTES = 16 * TSLOT + 2048 + 256 + 16;
constexpr int NPHASE = 13;

struct Params {
    const float* in[26];
    float* out;
    unsigned char* ws;
    int ph_lo, ph_hi;
};

__device__ __forceinline__ float bf2f(bf16_t b) { return __uint_as_float(((unsigned)b) << 16); }
__device__ __forceinline__ bf16_t f2bf(float f) { unsigned u = __float_as_uint(f); u += 0x7FFFu + ((u >> 16) & 1u); return (bf16_t)(u >> 16); }
typedef __bf16 bf16v2_t __attribute__((ext_vector_type(2)));
__device__ __forceinline__ unsigned cvt_pk_bf16(float lo, float hi) { const f32x2 v = {lo, hi}; const bf16v2_t r = __builtin_convertvector(v, bf16v2_t); return __builtin_bit_cast(unsigned, r); }
__device__ __forceinline__ u32x4 pack8(const float* f) { u32x4 w; w.x = cvt_pk_bf16(f[0], f[1]); w.y = cvt_pk_bf16(f[2], f[3]); w.z = cvt_pk_bf16(f[4], f[5]); w.w = cvt_pk_bf16(f[6], f[7]); return w; }
__device__ __forceinline__ float lo_bf(unsigned w) { return __uint_as_float(w << 16); }
__device__ __forceinline__ float hi_bf(unsigned w) { return __uint_as_float(w & 0xffff0000u); }
__device__ __forceinline__ void unpack8(const u32x4 v, float* f) {
#pragma unroll
    for (int i = 0; i < 4; ++i) { f[2 * i] = lo_bf(v[i]); f[2 * i + 1] = hi_bf(v[i]); }
}
__device__ __forceinline__ float wave_sum(float v) {
#pragma unroll
    for (int o = 32; o; o >>= 1) v += __shfl_xor(v, o);
    return v;
}
template <int CTRL, int RM> __device__ __forceinline__ float dpp_f(float v) { return __int_as_float(__builtin_amdgcn_update_dpp(0, __float_as_int(v), CTRL, RM, 0xf, false)); }
__device__ __forceinline__ float wave_sum_dpp(float v) {
    v += dpp_f<0xB1, 0xf>(v); v += dpp_f<0x4E, 0xf>(v); v += dpp_f<0x141, 0xf>(v); v += dpp_f<0x140, 0xf>(v);
    v += dpp_f<0x142, 0xa>(v); v += dpp_f<0x143, 0xc>(v);
    return __int_as_float(__builtin_amdgcn_readlane(__float_as_int(v), 63));
}
__device__ __forceinline__ float wave_max(float v) {
#pragma unroll
    for (int o = 32; o; o >>= 1) v = fmaxf(v, __shfl_xor(v, o));
    return v;
}
__device__ __forceinline__ float sigmoidf_(float x) { return 1.0f / (1.0f + __expf(-x)); }
__device__ __forceinline__ float gelu_tanh(float x) { float u = 0.7978845608028654f * (x + 0.044715f * x * x * x); return 0.5f * x * (1.0f + tanhf(u)); }

namespace pg8 {
constexpr int BM = 256, BK = 64, HALF = 128, HTB = HALF * BK * 2, STAGE_BYTES = 8 * HTB, NXCD = 8, WGM = 8;
__device__ __forceinline__ int lds_byte(int r, int c) { const int st = (r >> 4) * 2 + (c >> 5), rr = r & 15, cc = c & 31, ob = rr * 64 + cc * 2; return st * 1024 + (ob ^ (((ob >> 9) & 1) << 5)); }
__device__ __forceinline__ void stage_rc(int b, int& R, int& C) { const int st = b / 1024, sb = b % 1024, swz = sb ^ (((sb >> 9) & 1) << 5); R = (st >> 1) * 16 + swz / 64; C = (st & 1) * 32 + (swz % 64) / 2; }
__device__ __forceinline__ int perm32(int rho) { const int n = rho >> 4, i = rho & 15; return 8 * (i >> 2) + 4 * n + (i & 3); }
struct Unit { int pm, pn; };
struct Gemm { const bf16_t* A; const bf16_t* Bt; int M, N, K; };
struct StaticOrder {
    int nM, nN, nwg, G, c;
    __device__ void init(int M, int N, int G_, int c_) { nM = M / BM; nN = N / BM; nwg = nM * nN; G = G_; c = c_; }
    __device__ bool next(int i, Unit& u) const {
        const long L = (long)i * G + c; if (L >= nwg) return false;
        int wgid = (int)L; { const int q = nwg / NXCD, r = nwg % NXCD, xcd = wgid % NXCD, off = wgid / NXCD; wgid = (xcd < r ? xcd * (q + 1) : r * (q + 1) + (xcd - r) * q) + off; }
        const int nig = WGM * nN, gid = wgid / nig, fm = gid * WGM, gsz = (nM - fm) < WGM ? (nM - fm) : WGM;
        u.pm = fm + ((wgid % nig) % gsz); u.pn = (wgid % nig) / gsz; return true;
    }
    __device__ __forceinline__ void a_ready(const Unit&) const {}
    __device__ __forceinline__ void done(const Unit&) const {}
};
struct EpiResF32 {
    static constexpr bool PERM = false;
    float* C; const float* Res; int ldc;
    __device__ __forceinline__ void operator()(const f32x4 (&acc)[2][2][4][2], const Unit& u, int wr, int wc, int fr, int fq) const {
        const int row0 = u.pm * BM + wr * 64 + fr, col0 = u.pn * BM + wc * 32 + 4 * fq;
#pragma unroll
        for (int ai = 0; ai < 2; ++ai)
#pragma unroll
            for (int m = 0; m < 4; ++m) { const size_t ro = (size_t)(row0 + ai * HALF + m * 16) * ldc + col0;
#pragma unroll
                for (int bj = 0; bj < 2; ++bj)
#pragma unroll
                    for (int n = 0; n < 2; ++n) { const f32x4 rs = *(const f32x4*)(Res + ro + bj * HALF + n * 16); *(f32x4*)(C + ro + bj * HALF + n * 16) = acc[ai][bj][m][n] + rs; } }
    }
};
struct EpiRes2 {
    static constexpr bool PERM = false;
    float* C; const float* Res; bf16_t* Cb; float* SSQ; int ldc;
    __device__ __forceinline__ void operator()(const f32x4 (&acc)[2][2][4][2], const Unit& u, int wr, int wc, int fr, int fq) const {
        const int row0 = u.pm * BM + wr * 64 + fr, col0 = u.pn * BM + wc * 32 + 4 * fq;
#pragma unroll
        for (int ai = 0; ai < 2; ++ai)
#pragma unroll
            for (int m = 0; m < 4; ++m) { const int row = row0 + ai * HALF + m * 16; const size_t ro = (size_t)row * ldc + col0; float ss = 0.f;
#pragma unroll
                for (int bj = 0; bj < 2; ++bj)
#pragma unroll
                    for (int n = 0; n < 2; ++n) { const f32x4 v = acc[ai][bj][m][n] + *(const f32x4*)(Res + ro + bj * HALF + n * 16);
                        *(f32x4*)(C + ro + bj * HALF + n * 16) = v;
                        u32x2 wv; wv.x = cvt_pk_bf16(v[0], v[1]); wv.y = cvt_pk_bf16(v[2], v[3]); *(u32x2*)(Cb + ro + bj * HALF + n * 16) = wv;
                        ss += v[0] * v[0] + v[1] * v[1] + v[2] * v[2] + v[3] * v[3]; }
                ss += __shfl_xor(ss, 16); ss += __shfl_xor(ss, 32);
                if (fq == 0) SSQ[(size_t)row * 32 + u.pn * 4 + wc] = ss; }
    }
};
struct EpiRowScaleF32 {
    static constexpr bool PERM = false;
    float* C; const float* SSQ; int ldc;
    __device__ __forceinline__ void operator()(const f32x4 (&acc)[2][2][4][2], const Unit& u, int wr, int wc, int fr, int fq) const {
        const int row0 = u.pm * BM + wr * 64 + fr, col0 = u.pn * BM + wc * 32 + 4 * fq;
#pragma unroll
        for (int ai = 0; ai < 2; ++ai)
#pragma unroll
            for (int m = 0; m < 4; ++m) { const int row = row0 + ai * HALF + m * 16; const size_t ro = (size_t)row * ldc + col0;
                const f32x4* sp = (const f32x4*)(SSQ + (size_t)row * 32); float sq = 0.f;
#pragma unroll
                for (int q = 0; q < 8; ++q) { const f32x4 v = sp[q]; sq += (v[0] + v[1]) + (v[2] + v[3]); }
                const float rs = rsqrtf(sq * (1.0f / 2048.0f) + 1e-6f);
#pragma unroll
                for (int bj = 0; bj < 2; ++bj)
#pragma unroll
                    for (int n = 0; n < 2; ++n) *(f32x4*)(C + ro + bj * HALF + n * 16) = acc[ai][bj][m][n] * rs; }
    }
};
struct EpiF32 {
    static constexpr bool PERM = false;
    float* C; int ldc;
    __device__ __forceinline__ void operator()(const f32x4 (&acc)[2][2][4][2], const Unit& u, int wr, int wc, int fr, int fq) const {
        const int row0 = u.pm * BM + wr * 64 + fr, col0 = u.pn * BM + wc * 32 + 4 * fq;
#pragma unroll
        for (int ai = 0; ai < 2; ++ai)
#pragma unroll
            for (int m = 0; m < 4; ++m) { const size_t ro = (size_t)(row0 + ai * HALF + m * 16) * ldc + col0;
#pragma unroll
                for (int bj = 0; bj < 2; ++bj)
#pragma unroll
                    for (int n = 0; n < 2; ++n) *(f32x4*)(C + ro + bj * HALF + n * 16) = acc[ai][bj][m][n]; }
    }
};
struct EpiBf16 {
    static constexpr bool PERM = true;
    bf16_t* O; int ldc;
    __device__ __forceinline__ void operator()(const f32x4 (&acc)[2][2][4][2], const Unit& u, int wr, int wc, int fr, int fq) const {
        const int row0 = u.pm * BM + wr * 64 + fr; const int col0 = u.pn * BM + wc * 32 + 8 * fq;
#pragma unroll
        for (int ai = 0; ai < 2; ++ai)
#pragma unroll
            for (int m = 0; m < 4; ++m) { bf16_t* rowp = O + (size_t)(row0 + ai * HALF + m * 16) * ldc + col0;
#pragma unroll
                for (int bj = 0; bj < 2; ++bj) { const f32x4 v0 = acc[ai][bj][m][0], v1 = acc[ai][bj][m][1];
                    u32x4 w; w.x = cvt_pk_bf16(v0[0], v0[1]); w.y = cvt_pk_bf16(v0[2], v0[3]); w.z = cvt_pk_bf16(v1[0], v1[1]); w.w = cvt_pk_bf16(v1[2], v1[3]);
                    *(u32x4*)(rowp + bj * HALF) = w; } }
    }
};

template <class Epi, class Sched>
__device__ __forceinline__ void gemm_phase(LAS unsigned char* lds, const Gemm g, const Sched& S, const Epi& E) {
    const int tid = threadIdx.x, wid = __builtin_amdgcn_readfirstlane(tid >> 6), lane = tid & 63, wr = wid >> 2, wc = wid & 3, fr = lane & 15, fq = lane >> 4;
    const int K = g.K, nt = K / BK;
    unsigned voffA[2], voffB[2];
#pragma unroll
    for (int i = 0; i < 2; ++i) { int R, C; stage_rc(tid * 16 + i * 8192, R, C); const int Rb = Epi::PERM ? ((R & ~31) + perm32(R & 31)) : R;
        voffA[i] = (unsigned)(R * K + C) * 2u; voffB[i] = (unsigned)(Rb * K + C) * 2u; }
    const size_t kstep = (size_t)(BK * 2);
    const size_t hstep = (size_t)HALF * K * 2;
    const size_t tstep = 2 * hstep;
    const unsigned ldsw = (unsigned)wid * 1024u;
    const int aoff = lds_byte(wr * 64 + fr, fq * 8), boff = lds_byte(wc * 32 + fr, fq * 8);
#define PG8_SA(b, h) (((b) * 2 + (h)) * HTB)
#define PG8_SB(b, h) ((4 + (b) * 2 + (h)) * HTB)
#define PG8_STAGE(bufoff, gbase, voff) do { _Pragma("unroll") for (int _i = 0; _i < 2; ++_i) \
        __builtin_amdgcn_global_load_lds((const unsigned*)((const char*)(gbase) + (voff)[_i]), (LAS unsigned*)(lds + (bufoff) + ldsw + _i * 8192), 16, 0, 0); } while (0)
#define PG8_LDA(dst, b, h) do { _Pragma("unroll") for (int m = 0; m < 4; ++m) _Pragma("unroll") for (int k = 0; k < 2; ++k) dst[m][k] = *(const LAS bf16x8*)(lds + PG8_SA(b, h) + aoff + m * 2048 + k * 1024); } while (0)
#define PG8_LDB(dst, b, h) do { _Pragma("unroll") for (int n = 0; n < 2; ++n) _Pragma("unroll") for (int k = 0; k < 2; ++k) dst[n][k] = *(const LAS bf16x8*)(lds + PG8_SB(b, h) + boff + n * 2048 + k * 1024); } while (0)
#define PG8_MMA(ai, bj, At, Bt) do { __builtin_amdgcn_s_setprio(1); _Pragma("unroll") for (int m = 0; m < 4; ++m) _Pragma("unroll") for (int n = 0; n < 2; ++n) _Pragma("unroll") for (int k = 0; k < 2; ++k) \
        acc[ai][bj][m][n] = __builtin_amdgcn_mfma_f32_16x16x32_bf16(Bt[n][k], At[m][k], acc[ai][bj][m][n], 0, 0, 0); __builtin_amdgcn_s_setprio(0); } while (0)
#define PG8_WAIT_V(n) asm volatile("s_waitcnt vmcnt(" #n ")" ::: "memory")
#define PG8_WAIT_L(n) asm volatile("s_waitcnt lgkmcnt(" #n ")" ::: "memory")
#define PG8_BAR __builtin_amdgcn_s_barrier()
#define PG8_SCHED __builtin_amdgcn_sched_barrier(0)
    Unit cur, nxt; int ui = 0;
    if (!S.next(0, cur)) return;
    f32x4 acc[2][2][4][2];
#pragma unroll
    for (int a = 0; a < 2; ++a)
#pragma unroll
        for (int b = 0; b < 2; ++b)
#pragma unroll
            for (int m = 0; m < 4; ++m)
#pragma unroll
                for (int n = 0; n < 2; ++n) acc[a][b][m][n] = (f32x4){0.f, 0.f, 0.f, 0.f};
    bf16x8 At[4][2], B0[2][2], B1[2][2];
    const char* cA = (const char*)g.A + (size_t)cur.pm * tstep; const char* cB = (const char*)g.Bt + (size_t)cur.pn * tstep;
    S.a_ready(cur);
    PG8_STAGE(PG8_SB(0, 0), cB, voffB); PG8_STAGE(PG8_SA(0, 0), cA, voffA); PG8_STAGE(PG8_SB(0, 1), cB + hstep, voffB); PG8_STAGE(PG8_SA(0, 1), cA + hstep, voffA);
    if (wr == 1) PG8_BAR;
    PG8_WAIT_V(4); PG8_BAR;
    PG8_STAGE(PG8_SB(1, 0), cB + kstep, voffB); PG8_STAGE(PG8_SA(1, 0), cA + kstep, voffA); PG8_STAGE(PG8_SB(1, 1), cB + hstep + kstep, voffB);
    PG8_WAIT_V(6); PG8_BAR;
    for (;;) {
        const bool has_next = S.next(ui + 1, nxt);
        const char* nA = has_next ? (const char*)g.A + (size_t)nxt.pm * tstep : cA; const char* nB = has_next ? (const char*)g.Bt + (size_t)nxt.pn * tstep : cB;
        for (int t = 0; t < nt; t += 2) {
            const bool last = (t == nt - 2);
            const char* a1 = cA + (size_t)(t + 1) * kstep;
            const char* a2 = last ? nA : cA + (size_t)(t + 2) * kstep; const char* b2 = last ? nB : cB + (size_t)(t + 2) * kstep;
            const char* a3 = a2 + kstep; const char* b3 = b2 + kstep;
            if (last && has_next) S.a_ready(nxt);
            PG8_LDB(B0, 0, 0); PG8_SCHED; PG8_LDA(At, 0, 0); PG8_STAGE(PG8_SA(1, 1), a1 + hstep, voffA);
            PG8_WAIT_L(8); PG8_BAR; PG8_WAIT_L(0); PG8_MMA(0, 0, At, B0); PG8_BAR; PG8_SCHED;
            PG8_LDB(B1, 0, 1); PG8_STAGE(PG8_SB(0, 0), b2, voffB);
            PG8_BAR; PG8_WAIT_L(0); PG8_MMA(0, 1, At, B1); PG8_BAR;
            PG8_LDA(At, 0, 1); PG8_STAGE(PG8_SA(0, 0), a2, voffA);
            PG8_BAR; PG8_WAIT_L(0); PG8_MMA(1, 0, At, B0); PG8_BAR; PG8_SCHED;
            PG8_STAGE(PG8_SB(0, 1), b2 + hstep, voffB);
            PG8_WAIT_V(6); PG8_BAR; PG8_MMA(1, 1, At, B1); PG8_BAR;
            PG8_LDB(B0, 1, 0); PG8_SCHED; PG8_LDA(At, 1, 0); PG8_STAGE(PG8_SA(0, 1), a2 + hstep, voffA);
            PG8_WAIT_L(8); PG8_BAR; PG8_WAIT_L(0); PG8_MMA(0, 0, At, B0); PG8_BAR; PG8_SCHED;
            PG8_LDB(B1, 1, 1); PG8_STAGE(PG8_SB(1, 0), b3, voffB);
            PG8_BAR; PG8_WAIT_L(0); PG8_MMA(0, 1, At, B1); PG8_BAR;
            PG8_LDA(At, 1, 1); PG8_STAGE(PG8_SA(1, 0), a3, voffA);
            PG8_BAR; PG8_WAIT_L(0); PG8_MMA(1, 0, At, B0); PG8_BAR; PG8_SCHED;
            PG8_STAGE(PG8_SB(1, 1), b3 + hstep, voffB);
            PG8_WAIT_V(6); PG8_BAR; PG8_MMA(1, 1, At, B1); PG8_BAR;
        }
        E(acc, cur, wr, wc, fr, fq); S.done(cur);
        if (!has_next) break;
#pragma unroll
        for (int a = 0; a < 2; ++a)
#pragma unroll
            for (int b = 0; b < 2; ++b)
#pragma unroll
                for (int m = 0; m < 4; ++m)
#pragma unroll
                    for (int n = 0; n < 2; ++n) acc[a][b][m][n] = (f32x4){0.f, 0.f, 0.f, 0.f};
        cur = nxt; cA = nA; cB = nB; ++ui;
    }
    PG8_WAIT_V(0);
    if (wr == 0) PG8_BAR;
    PG8_BAR;
#undef PG8_SA
#undef PG8_SB
#undef PG8_STAGE
#undef PG8_LDA
#undef PG8_LDB
#undef PG8_MMA
#undef PG8_WAIT_V
#undef PG8_WAIT_L
#undef PG8_BAR
#undef PG8_SCHED
}
}

__device__ __forceinline__ void rmsnorm_rows(const float* X, const float* gain, bf16_t* H) {
    const int wave = threadIdx.x >> 6, lane = threadIdx.x & 63;
    for (int row = blockIdx.x * 8 + wave; row < S_; row += gridDim.x * 8) {
        const float4* xr = (const float4*)(X + (size_t)row * D_);
        float4 v[8]; float ss = 0.f;
#pragma unroll
        for (int i = 0; i < 8; ++i) { v[i] = xr[i * 64 + lane]; ss += v[i].x * v[i].x + v[i].y * v[i].y + v[i].z * v[i].z + v[i].w * v[i].w; }
        ss = wave_sum(ss);
        const float sc = rsqrtf(ss * (1.0f / 2048.0f) + 1e-6f);
#pragma unroll
        for (int i = 0; i < 8; ++i) { const float4 g = ((const float4*)gain)[i * 64 + lane];
            u32x2 w; w.x = cvt_pk_bf16(v[i].x * sc * g.x, v[i].y * sc * g.y); w.y = cvt_pk_bf16(v[i].z * sc * g.z, v[i].w * sc * g.w);
            *(u32x2*)(H + (size_t)row * D_ + (i * 64 + lane) * 4) = w; }
    }
}

__device__ __forceinline__ void transpose_convert(const float* W, int K, int N, bf16_t* Bt, float* tile, int bid, int nblk) {
    const int tid = threadIdx.x; const int tk = K / 64, tn = N / 64, nt = tk * tn;
    float4 rg[2];
#define TC_LOAD(u) do { const int _k0 = ((u) / tn) * 64, _n0 = ((u) % tn) * 64; _Pragma("unroll") for (int i = 0; i < 2; ++i) { const int idx = tid + 512 * i; \
        rg[i] = *(const float4*)(W + (size_t)(_k0 + (idx >> 4)) * N + _n0 + (idx & 15) * 4); } } while (0)
    if (bid < nt) TC_LOAD(bid);
    for (int u = bid; u < nt; u += nblk) {
        const int k0 = (u / tn) * 64, n0 = (u % tn) * 64;
        __syncthreads();
#pragma unroll
        for (int i = 0; i < 2; ++i) { const int idx = tid + 512 * i; float* q = tile + (idx >> 4) * 65 + (idx & 15) * 4; q[0] = rg[i].x; q[1] = rg[i].y; q[2] = rg[i].z; q[3] = rg[i].w; }
        __syncthreads();
        if (u + nblk < nt) TC_LOAD(u + nblk);
#pragma unroll
        for (int i = 0; i < 4; ++i) { const int nn = i * 16 + (tid >> 5), kp = (tid & 31) * 2;
            *(unsigned*)(Bt + (size_t)(n0 + nn) * K + k0 + kp) = cvt_pk_bf16(tile[kp * 65 + nn], tile[(kp + 1) * 65 + nn]); }
    }
#undef TC_LOAD
}

__device__ __forceinline__ void convert_flat(const float* src, bf16_t* dst, size_t n) {
    for (size_t i = ((size_t)blockIdx.x * 512 + threadIdx.x) * 8; i < n; i += (size_t)gridDim.x * 512 * 8) {
        const float4 a = *(const float4*)(src + i), b = *(const float4*)(src + i + 4);
        u32x4 w; w.x = cvt_pk_bf16(a.x, a.y); w.y = cvt_pk_bf16(a.z, a.w); w.z = cvt_pk_bf16(b.x, b.y); w.w = cvt_pk_bf16(b.z, b.w);
        *(u32x4*)(dst + i) = w;
    }
}

__device__ __forceinline__ void convert_fp8(const float* src, unsigned char* dst, size_t n, float sc, const float* colgain, int bid, int nblk) {
    const int lane = threadIdx.x & 63, wv = threadIdx.x >> 6;
    for (size_t base = ((size_t)bid * 8 + wv) * 1024; base < n; base += (size_t)nblk * 8 * 1024) {
        float4 a[4];
#pragma unroll
        for (int j = 0; j < 4; ++j) a[j] = *(const float4*)(src + base + (size_t)(j * 64 + lane) * 4);
#pragma unroll
        for (int j = 0; j < 4; ++j) { float4 gg = make_float4(sc, sc, sc, sc);
            if (colgain) { const float4 cgv = *(const float4*)(colgain + ((base + (size_t)(j * 64 + lane) * 4) & 2047)); gg.x *= cgv.x; gg.y *= cgv.y; gg.z *= cgv.z; gg.w *= cgv.w; }
            int x = __builtin_amdgcn_cvt_pk_fp8_f32(a[j].x * gg.x, a[j].y * gg.y, 0, false); x = __builtin_amdgcn_cvt_pk_fp8_f32(a[j].z * gg.z, a[j].w * gg.w, x, true);
            *(unsigned*)(dst + base + (size_t)(j * 64 + lane) * 4) = (unsigned)x; }
    }
}

constexpr int ROW6 = 1536;
constexpr float U6_SCALE = 56.f, V6_SCALE = 28.f;
__device__ __forceinline__ void convert_fp6(const float* src, unsigned char* dst, int nrows, float sc, const float* colgain, int bid, int nblk) {
    const int lane = threadIdx.x & 63, wv = threadIdx.x >> 6;
    float g[32];
#pragma unroll
    for (int j = 0; j < 8; ++j) { float4 cg = make_float4(1.f, 1.f, 1.f, 1.f); if (colgain) cg = *(const float4*)(colgain + (j * 64 + lane) * 4);
        g[j * 4] = sc * cg.x; g[j * 4 + 1] = sc * cg.y; g[j * 4 + 2] = sc * cg.z; g[j * 4 + 3] = sc * cg.w; }
    for (int row = bid * 8 + wv; row < nrows; row += nblk * 8) {
        f32x32 x;
#pragma unroll
        for (int j = 0; j < 8; ++j) { const f32x4 a = __builtin_nontemporal_load((const f32x4*)(src + (size_t)row * 2048 + (j * 64 + lane) * 4));
            x[j * 4] = a[0] * g[j * 4]; x[j * 4 + 1] = a[1] * g[j * 4 + 1]; x[j * 4 + 2] = a[2] * g[j * 4 + 2]; x[j * 4 + 3] = a[3] * g[j * 4 + 3]; }
        const bf16x32_t b = __builtin_convertvector(x, bf16x32_t);
        const u32x6 wv6 = __builtin_amdgcn_cvt_scalef32_pk32_fp6_bf16(b, 1.0f);
        *(u32x4*)(dst + (size_t)row * ROW6 + lane * 16) = (u32x4){wv6[0], wv6[1], wv6[2], wv6[3]};
        *(u32x2*)(dst + (size_t)row * ROW6 + 1024 + lane * 8) = (u32x2){wv6[4], wv6[5]};
    }
}

__device__ __forceinline__ void convert_fp6s(const float* src, unsigned char* dst, int nrows, float sc, const float* colgain, int bid, int nblk) {
    const int lane = threadIdx.x & 63, wv = threadIdx.x >> 6, x = lane >> 3, pt = lane & 7;
    float g[32];
#pragma unroll
    for (int j = 0; j < 8; ++j) { float4 cg = make_float4(1.f, 1.f, 1.f, 1.f); if (colgain) cg = *(const float4*)(colgain + x * 256 + (j * 8 + pt) * 4);
        g[j * 4] = sc * cg.x; g[j * 4 + 1] = sc * cg.y; g[j * 4 + 2] = sc * cg.z; g[j * 4 + 3] = sc * cg.w; }
    for (int row = bid * 8 + wv; row < nrows; row += nblk * 8) {
        f32x32 v;
#pragma unroll
        for (int j = 0; j < 8; ++j) { const f32x4 a = __builtin_nontemporal_load((const f32x4*)(src + (size_t)row * 2048 + x * 256 + (j * 8 + pt) * 4));
            v[j * 4] = a[0] * g[j * 4]; v[j * 4 + 1] = a[1] * g[j * 4 + 1]; v[j * 4 + 2] = a[2] * g[j * 4 + 2]; v[j * 4 + 3] = a[3] * g[j * 4 + 3]; }
        const bf16x32_t b = __builtin_convertvector(v, bf16x32_t);
        const u32x6 w6 = __builtin_amdgcn_cvt_scalef32_pk32_fp6_bf16(b, 1.0f);
        unsigned char* q = dst + ((size_t)x * 16384 + row) * 192 + pt * 24;
        *(u32x2*)q = (u32x2){w6[0], w6[1]}; *(u32x2*)(q + 8) = (u32x2){w6[2], w6[3]}; *(u32x2*)(q + 16) = (u32x2){w6[4], w6[5]};
    }
}

__device__ __forceinline__ void build_wpt(const float* wq, const float* gain, const bf16_t* KEYB, bf16_t* WPT, int bid, int nblk) {
    const int w = threadIdx.x >> 6, lane = threadIdx.x & 63, fr = lane & 15, fq = lane >> 4;
    for (int task = bid * 8 + w; task < 16 * 128; task += nblk * 8) {
        const int g = task >> 7, kb = task & 127;
        f32x4 acc[8];
#pragma unroll
        for (int n = 0; n < 8; ++n) acc[n] = (f32x4){0.f, 0.f, 0.f, 0.f};
#pragma unroll 2
        for (int ks = 0; ks < 8; ++ks) {
            const float4* wp = (const float4*)(wq + (size_t)(kb * 16 + fr) * 4096 + g * 256 + ks * 32 + fq * 8);
            const float4 x0 = wp[0], x1 = wp[1]; const float gk = gain[kb * 16 + fr];
            u32x4 wv; wv.x = cvt_pk_bf16(x0.x * gk, x0.y * gk); wv.y = cvt_pk_bf16(x0.z * gk, x0.w * gk); wv.z = cvt_pk_bf16(x1.x * gk, x1.y * gk); wv.w = cvt_pk_bf16(x1.z * gk, x1.w * gk);
            const bf16x8 a = __builtin_bit_cast(bf16x8, wv);
#pragma unroll
            for (int n = 0; n < 8; ++n) {
                const bf16x8 b = *(const bf16x8*)(KEYB + (size_t)(g * 128 + n * 16 + fr) * 256 + ks * 32 + fq * 8);
                acc[n] = __builtin_amdgcn_mfma_f32_16x16x32_bf16(a, b, acc[n], 0, 0, 0);
            }
        }
#pragma unroll
        for (int n = 0; n < 8; ++n) { u32x2 o; o.x = cvt_pk_bf16(acc[n][0], acc[n][1]); o.y = cvt_pk_bf16(acc[n][2], acc[n][3]);
            *(u32x2*)(WPT + (size_t)(g * 128 + n * 16 + fr) * 2048 + kb * 16 + fq * 4) = o; }
    }
}

__device__ __forceinline__ void phase0(const Params& p, unsigned char* shm) {
    bf16_t* WB1 = (bf16_t*)(p.ws + WS_WB1);
    rmsnorm_rows(p.in[0], p.in[1], (bf16_t*)(p.ws + WS_H));
    transpose_convert(p.in[2], 2048, 6144, WB1, (float*)shm, blockIdx.x, gridDim.x);
    const float* mu = p.in[4]; const float* w1 = p.in[6]; const float* a1 = p.in[9]; const float* g1 = p.in[11];
    for (int idx = blockIdx.x * 512 + threadIdx.x; idx < 768 * 2048; idx += gridDim.x * 512) {
        const int j = idx >> 11, k = idx & 2047; float val = 0.f;
        if (j < 128) { const float m = mu[k], w = w1[k * 64 + (j & 63)]; val = (j < 64) ? w * (1.f - m) : w * m; }
        else if (j < 256) { const float m = mu[2048 + k], w = a1[k * 64 + (j & 63)]; val = (j < 192) ? w * (1.f - m) : w * m; }
        else if (j < 576) { const float m = mu[4096 + k]; const int jj = j - 256; const int c = jj < 160 ? jj : jj - 160; const float w = g1[k * 160 + c]; val = jj < 160 ? w * (1.f - m) : w * m; }
        WB1[(size_t)(6144 + j) * 2048 + k] = f2bf(val);
    }
    convert_flat(p.in[22], (bf16_t*)(p.ws + WS_KEYB), (size_t)8 * 2 * 128 * 256);
    bf16_t* W2T = (bf16_t*)(p.ws + WS_W2T); bf16_t* A2T = (bf16_t*)(p.ws + WS_A2T); bf16_t* G2T = (bf16_t*)(p.ws + WS_G2T);
    const float* w2 = p.in[7]; const float* a2 = p.in[10]; const float* g2 = p.in[12];
    for (int idx = blockIdx.x * 512 + threadIdx.x; idx < 1024 * 288; idx += gridDim.x * 512) {
        if (idx < 65536) { const int c = idx >> 6, j = idx & 63; W2T[idx] = f2bf(w2[j * 1024 + c]); }
        else if (idx < 131072) { const int i2 = idx - 65536; const int c = i2 >> 6, j = i2 & 63; A2T[i2] = f2bf(a2[j * 1024 + c]); }
        else { const int i2 = idx - 131072; const int c = i2 / 160, j = i2 % 160; G2T[i2] = f2bf(g2[j * 1024 + c]); }
    }
}

constexpr int ACT_LD = 296;
template <int KS, int KOFF, int KTOT, int KIND>
__device__ __forceinline__ void lora_stage(const LAS bf16_t* act, const bf16_t* WT, const float* bias, bf16_t* OUT, int t0, int w, int fr, int fq) {
#pragma unroll 1
    for (int nh = 0; nh < 2; ++nh) {
        f32x4 acc[4][4];
#pragma unroll
        for (int m = 0; m < 4; ++m)
#pragma unroll
            for (int n = 0; n < 4; ++n) acc[m][n] = (f32x4){0.f, 0.f, 0.f, 0.f};
        bf16x8 bfr[KS][4];
#pragma unroll
        for (int ks = 0; ks < KS; ++ks)
#pragma unroll
            for (int n = 0; n < 4; ++n) bfr[ks][n] = *(const bf16x8*)(WT + (size_t)(w * 128 + (nh * 4 + n) * 16 + fr) * KTOT + ks * 32 + fq * 8);
#pragma unroll
        for (int ks = 0; ks < KS; ++ks) {
            bf16x8 a[4];
#pragma unroll
            for (int m = 0; m < 4; ++m) a[m] = *(const LAS bf16x8*)(act + (m * 16 + fr) * ACT_LD + KOFF + ks * 32 + fq * 8);
#pragma unroll
            for (int n = 0; n < 4; ++n)
#pragma unroll
                for (int m = 0; m < 4; ++m) acc[m][n] = __builtin_amdgcn_mfma_f32_16x16x32_bf16(bfr[ks][n], a[m], acc[m][n], 0, 0, 0);
        }
#pragma unroll
        for (int n = 0; n < 4; ++n) {
            const int c = w * 128 + (nh * 4 + n) * 16 + fq * 4;
            float bs[4] = {0.f, 0.f, 0.f, 0.f};
            if (KIND < 2) { const float4 bv = *(const float4*)(bias + c); bs[0] = bv.x; bs[1] = bv.y; bs[2] = bv.z; bs[3] = bv.w; }
#pragma unroll
            for (int m = 0; m < 4; ++m) {
                float o[4];
#pragma unroll
                for (int j = 0; j < 4; ++j) {
                    const float val = acc[m][n][j];
                    if (KIND == 0) { const float x = -(bs[j] + val); const float sp = fmaxf(x, 0.f) + __logf(1.f + __expf(-fabsf(x))); o[j] = -__expf(-sp - 0.5f); }
                    else if (KIND == 1) o[j] = sigmoidf_(bs[j] + val);
                    else o[j] = val;
                }
                u32x2 wv; wv.x = cvt_pk_bf16(o[0], o[1]); wv.y = cvt_pk_bf16(o[2], o[3]);
                *(u32x2*)(OUT + (size_t)(t0 + m * 16 + fr) * DR + c) = wv;
            }
        }
    }
}
__device__ __forceinline__ void phase_prepM(const Params& p, LAS unsigned char* lds) {
    LAS bf16_t* act = (LAS bf16_t*)lds;
    const bf16_t* P = (const bf16_t*)(p.ws + WS_PROJ);
    const int tid = threadIdx.x, w = tid >> 6, lane = tid & 63, fr = lane & 15, fq = lane >> 4;
    for (int tile = blockIdx.x; tile < S_ / 64; tile += gridDim.x) {
        const int t0 = tile * 64;
        __syncthreads();
        for (int task = tid; task < 64 * 36; task += 512) {
            const int t = task / 36, j0 = (task % 36) * 8; const int tg = t0 + t;
            int ccur, cprev;
            if (j0 < 64) { ccur = 6144 + j0; cprev = 6208 + j0; }
            else if (j0 < 128) { ccur = 6272 + (j0 - 64); cprev = 6336 + (j0 - 64); }
            else { ccur = 6400 + (j0 - 128); cprev = 6560 + (j0 - 128); }
            float cu[8], pv[8], o8[8];
            unpack8(*(const u32x4*)(P + (size_t)tg * NAUG + ccur), cu);
            if (tg > 0) unpack8(*(const u32x4*)(P + (size_t)(tg - 1) * NAUG + cprev), pv);
            else {
#pragma unroll
                for (int i = 0; i < 8; ++i) pv[i] = 0.f;
            }
#pragma unroll
            for (int i = 0; i < 8; ++i) { const float sv = cu[i] + pv[i];
                o8[i] = j0 < 64 ? (1.f - 2.f / (1.f + __expf(2.f * sv))) : (j0 < 128 ? sv : sigmoidf_(sv)); }
            *(LAS u32x4*)(act + t * ACT_LD + j0) = pack8(o8);
        }
        __syncthreads();
        lora_stage<2, 0, 64, 0>(act, (const bf16_t*)(p.ws + WS_W2T), p.in[5], (bf16_t*)(p.ws + WS_LW), t0, w, fr, fq);
        lora_stage<2, 64, 64, 1>(act, (const bf16_t*)(p.ws + WS_A2T), p.in[8], (bf16_t*)(p.ws + WS_A), t0, w, fr, fq);
        lora_stage<5, 128, 160, 2>(act, (const bf16_t*)(p.ws + WS_G2T), nullptr, (bf16_t*)(p.ws + WS_G), t0, w, fr, fq);
    }
}

__device__ __forceinline__ void phase_prepE(const Params& p) {
    const bf16_t* P = (const bf16_t*)(p.ws + WS_PROJ);
    bf16_t* R = (bf16_t*)(p.ws + WS_R); bf16_t* Kk = (bf16_t*)(p.ws + WS_K); bf16_t* V = (bf16_t*)(p.ws + WS_V); bf16_t* KK = (bf16_t*)(p.ws + WS_KK); bf16_t* YC = (bf16_t*)(p.ws + WS_YC);
    const float* mu_rkv = p.in[3]; const float* k_k = p.in[13]; const float* cw = p.in[18];
    const int tid = threadIdx.x, cg = tid & 127, c0 = cg * 8, tgrp = tid >> 7;
    float mr[8], mk[8], mv[8], kkc[8], cw0[8], cw1[8], cw2[8];
#pragma unroll
    for (int i = 0; i < 8; ++i) { mr[i] = mu_rkv[c0 + i]; mk[i] = mu_rkv[1024 + c0 + i]; mv[i] = mu_rkv[2048 + c0 + i]; kkc[i] = k_k[c0 + i]; cw0[i] = cw[c0 + i]; cw1[i] = cw[1024 + c0 + i]; cw2[i] = cw[2048 + c0 + i]; }
    for (int run = blockIdx.x * 4 + tgrp; run < S_ / 16; run += gridDim.x * 4) {
        const int t0 = run * 16;
        float pr[8], pk[8], pv[8], u1[8], u2[8];
#pragma unroll
        for (int i = 0; i < 8; ++i) { pr[i] = 0.f; pk[i] = 0.f; pv[i] = 0.f; u1[i] = 0.f; u2[i] = 0.f; }
        if (t0 > 0) {
            const size_t o = (size_t)(t0 - 1) * NAUG + c0;
            unpack8(*(const u32x4*)(P + o), pr); unpack8(*(const u32x4*)(P + o + 1024), pk); unpack8(*(const u32x4*)(P + o + 2048), pv);
            float x[8], y[8];
            unpack8(*(const u32x4*)(P + o + 4096), x); unpack8(*(const u32x4*)(P + o + 5120), y);
#pragma unroll
            for (int i = 0; i < 8; ++i) u1[i] = x[i] * y[i];
            unpack8(*(const u32x4*)(P + o - NAUG + 4096), x); unpack8(*(const u32x4*)(P + o - NAUG + 5120), y);
#pragma unroll
            for (int i = 0; i < 8; ++i) u2[i] = x[i] * y[i];
        }
        u32x4 nx[6];
        { const size_t o = (size_t)t0 * NAUG + c0;
#pragma unroll
          for (int q = 0; q < 6; ++q) nx[q] = *(const u32x4*)(P + o + 1024 * q); }
#pragma unroll 1
        for (int t = 0; t < 16; ++t) {
            float cr[8], ck[8], cv[8], bg[8], cgt[8], xc[8];
            unpack8(nx[0], cr); unpack8(nx[1], ck); unpack8(nx[2], cv); unpack8(nx[3], bg); unpack8(nx[4], cgt); unpack8(nx[5], xc);
            { const size_t o = (size_t)(t0 + (t < 15 ? t + 1 : t)) * NAUG + c0;
#pragma unroll
              for (int q = 0; q < 6; ++q) nx[q] = *(const u32x4*)(P + o + 1024 * q); }
            float r[8], k[8], v[8], kkv[8], yc[8]; float ss = 0.f;
#pragma unroll
            for (int i = 0; i < 8; ++i) {
                r[i] = cr[i] + (pr[i] - cr[i]) * mr[i]; k[i] = ck[i] + (pk[i] - ck[i]) * mk[i]; v[i] = cv[i] + (pv[i] - cv[i]) * mv[i];
                pr[i] = cr[i]; pk[i] = ck[i]; pv[i] = cv[i];
                kkv[i] = k[i] * kkc[i]; ss += kkv[i] * kkv[i];
                const float u0 = cgt[i] * xc[i];
                yc[i] = bg[i] * (cw0[i] * u2[i] + cw1[i] * u1[i] + cw2[i] * u0);
                u2[i] = u1[i]; u1[i] = u0;
            }
            ss += dpp_f<0xB1, 0xf>(ss); ss += dpp_f<0x4E, 0xf>(ss); ss += dpp_f<0x141, 0xf>(ss);
            const float inv = 1.0f / fmaxf(sqrtf(ss), 1e-12f);
#pragma unroll
            for (int i = 0; i < 8; ++i) kkv[i] *= inv;
            const size_t oo = (size_t)(t0 + t) * DR + c0;
            *(u32x4*)(R + oo) = pack8(r); *(u32x4*)(Kk + oo) = pack8(k); *(u32x4*)(V + oo) = pack8(v); *(u32x4*)(KK + oo) = pack8(kkv); *(u32x4*)(YC + oo) = pack8(yc);
        }
    }
}

#define TILE(i) ((LAS bf16_t*)(lds + (i) * TSLOT))
__device__ __forceinline__ f32x4 mm_tile(f32x4 acc, const LAS bf16_t* A, const LAS bf16_t* Bt, int mi, int ni, int fr, int fq) {
#pragma unroll
    for (int ks = 0; ks < 2; ++ks) {
        const bf16x8 a = *(const LAS bf16x8*)(A + (mi * 16 + fr) * TLD + ks * 32 + fq * 8);
        const bf16x8 b = *(const LAS bf16x8*)(Bt + (ni * 16 + fr) * TLD + ks * 32 + fq * 8);
        acc = __builtin_amdgcn_mfma_f32_16x16x32_bf16(a, b, acc, 0, 0, 0);
    }
    return acc;
}
__device__ __forceinline__ void st_rm(LAS bf16_t* X, f32x4 v, int mi, int ni, int fr, int fq) {
    const unsigned w0 = cvt_pk_bf16(v[0], v[1]), w1 = cvt_pk_bf16(v[2], v[3]);
    LAS bf16_t* q = X + (mi * 16 + fq * 4) * TLD + ni * 16 + fr;
    q[0] = (bf16_t)(w0 & 0xffffu); q[TLD] = (bf16_t)(w0 >> 16); q[2 * TLD] = (bf16_t)(w1 & 0xffffu); q[3 * TLD] = (bf16_t)(w1 >> 16);
}
__device__ __forceinline__ void st_tr(LAS bf16_t* XT, f32x4 v, int mi, int ni, int fr, int fq) {
    u32x2 w; w.x = cvt_pk_bf16(v[0], v[1]); w.y = cvt_pk_bf16(v[2], v[3]);
    *(LAS u32x2*)(XT + (ni * 16 + fr) * TLD + mi * 16 + fq * 4) = w;
}
__device__ __forceinline__ f32x4 ld_rm(const LAS bf16_t* X, int mi, int ni, int fr, int fq) {
    const LAS bf16_t* q = X + (mi * 16 + fq * 4) * TLD + ni * 16 + fr;
    return (f32x4){bf2f(q[0]), bf2f(q[TLD]), bf2f(q[2 * TLD]), bf2f(q[3 * TLD])};
}
__device__ __forceinline__ f32x4 ld_tr(const LAS bf16_t* XT, int mi, int ni, int fr, int fq) {
    const u32x2 w = *(const LAS u32x2*)(XT + (ni * 16 + fr) * TLD + mi * 16 + fq * 4);
    return (f32x4){lo_bf(w.x), hi_bf(w.x), lo_bf(w.y), hi_bf(w.y)};
}

__device__ __forceinline__ void phase_chunkA(const Params& p, LAS unsigned char* lds) {
    const int tid = threadIdx.x, w = tid >> 6, lane = tid & 63, fr = lane & 15, fq = lane >> 4;
    const int mi = w >> 1, nb = (w & 1) * 2;
    LAS float* cl = (LAS float*)(lds + 14 * TSLOT);
    LAS float* gs = (LAS float*)(lds + 16 * TSLOT);
    LAS float* wc = gs + 512;
    const bf16_t* R = (const bf16_t*)(p.ws + WS_R); const bf16_t* Kk = (const bf16_t*)(p.ws + WS_K); const bf16_t* V = (const bf16_t*)(p.ws + WS_V);
    const bf16_t* KK = (const bf16_t*)(p.ws + WS_KK); const bf16_t* A = (const bf16_t*)(p.ws + WS_A); const bf16_t* LW = (const bf16_t*)(p.ws + WS_LW);
    bf16_t* GT = (bf16_t*)(p.ws + WS_GT); float* HT = (float*)(p.ws + WS_HT); bf16_t* QE = (bf16_t*)(p.ws + WS_QE); bf16_t* YL = (bf16_t*)(p.ws + WS_YL);
    const f32x4 z4 = (f32x4){0.f, 0.f, 0.f, 0.f};
    const float* k_a = p.in[14]; const float* r_k = p.in[15]; float* BON = (float*)(p.ws + WS_BON);
    u32x4 nr4, nk4, nv4, nkk4, na4, nlw4;
#define CA_LOAD(it) do { const size_t _go = (size_t)(((it) >> 4) * 64 + (tid >> 3)) * DR + ((it) & 15) * 64 + (tid & 7) * 8; \
        nr4 = *(const u32x4*)(R + _go); nk4 = *(const u32x4*)(Kk + _go); nv4 = *(const u32x4*)(V + _go); nkk4 = *(const u32x4*)(KK + _go); na4 = *(const u32x4*)(A + _go); nlw4 = *(const u32x4*)(LW + _go); } while (0)
    for (int item = blockIdx.x; item < 4096; item += gridDim.x) {
        const int c = item >> 4, h = item & 15;
        const int t = tid >> 3, k0 = (tid & 7) * 8;
        if (item == (int)blockIdx.x) CA_LOAD(item);
        const u32x4 r4 = nr4, k4 = nk4, v4 = nv4, kk4 = nkk4, a4 = na4, lw4 = nlw4;
        __syncthreads();
        {
            float lwf8[8]; unpack8(lw4, lwf8);
            *(LAS f32x4*)(cl + t * 64 + k0) = (f32x4){lwf8[0], lwf8[1], lwf8[2], lwf8[3]};
            *(LAS f32x4*)(cl + t * 64 + k0 + 4) = (f32x4){lwf8[4], lwf8[5], lwf8[6], lwf8[7]};
            __syncthreads();
            const int g = w, k = lane;
            float pfx[8]; float run = 0.f;
#pragma unroll
            for (int i = 0; i < 8; ++i) { run += cl[(g * 8 + i) * 64 + k]; pfx[i] = run; }
            gs[g * 64 + k] = run;
            __syncthreads();
            float off = 0.f;
#pragma unroll
            for (int gg = 0; gg < 7; ++gg) { const float x = gs[gg * 64 + k]; off += (gg < g) ? x : 0.f; }
#pragma unroll
            for (int i = 0; i < 8; ++i) cl[(g * 8 + i) * 64 + k] = off + pfx[i];
            if (g == 7) wc[k] = __expf(off + pfx[7]);
            __syncthreads();
        }
        if (item + (int)gridDim.x < 4096) CA_LOAD(item + (int)gridDim.x);
        {
            float at[8], rt[8], bt[8], kt[8], bh[8], kh[8], vv[8]; float bsum = 0.f;
#pragma unroll
            for (int i = 0; i < 8; ++i) {
                const int q = i >> 1; const bool hi = i & 1;
                const float rf = hi ? hi_bf(r4[q]) : lo_bf(r4[q]), kraw = hi ? hi_bf(k4[q]) : lo_bf(k4[q]), vf = hi ? hi_bf(v4[q]) : lo_bf(v4[q]);
                const float kkf = hi ? hi_bf(kk4[q]) : lo_bf(kk4[q]), af = hi ? hi_bf(a4[q]) : lo_bf(a4[q]), lwf = hi ? hi_bf(lw4[q]) : lo_bf(lw4[q]);
                const float kf = kraw * (1.f + (af - 1.f) * k_a[h * 64 + k0 + i]);
                bsum += rf * kf * r_k[h * 64 + k0 + i];
                const float clv = cl[t * 64 + k0 + i], cle = cl[63 * 64 + k0 + i];
                const float e = __expf(clv), ex = __expf(clv - lwf), ei = __expf(-clv), eh = __expf(cle - clv);
                const float bb = kkf * af;
                at[i] = -kkf * ex; rt[i] = rf * e; bt[i] = bb * ei; kt[i] = kf * ei; bh[i] = bb * eh; kh[i] = kf * eh; vv[i] = vf;
            }
            bsum += dpp_f<0xB1, 0xf>(bsum); bsum += dpp_f<0x4E, 0xf>(bsum); bsum += dpp_f<0x141, 0xf>(bsum);
            if ((tid & 7) == 0) BON[(size_t)(c * 64 + t) * 16 + h] = bsum;
            *(LAS u32x4*)(TILE(0) + t * TLD + k0) = pack8(at);
            *(LAS u32x4*)(TILE(2) + t * TLD + k0) = pack8(rt);
            *(LAS u32x4*)(TILE(3) + t * TLD + k0) = pack8(bt);
            *(LAS u32x4*)(TILE(4) + t * TLD + k0) = pack8(kt);
            const u32x4 atp = pack8(at), bhp = pack8(bh), khp = pack8(kh);
#pragma unroll
            for (int i = 0; i < 8; ++i) {
                const int q = i >> 1; const bool hi = i & 1;
                TILE(1)[(k0 + i) * TLD + t] = (bf16_t)(hi ? (atp[q] >> 16) : (atp[q] & 0xffffu));
                TILE(5)[(k0 + i) * TLD + t] = (bf16_t)(hi ? (bhp[q] >> 16) : (bhp[q] & 0xffffu));
                TILE(6)[(k0 + i) * TLD + t] = (bf16_t)(hi ? (khp[q] >> 16) : (khp[q] & 0xffffu));
                TILE(7)[(k0 + i) * TLD + t] = (bf16_t)(hi ? (v4[q] >> 16) : (v4[q] & 0xffffu));
            }
            __syncthreads();
        }
#pragma unroll
        for (int nn = 0; nn < 2; ++nn) {
            const int ni = nb + nn; const int col = ni * 16 + fr, row0 = mi * 16 + fq * 4;
            f32x4 x = mm_tile(z4, TILE(0), TILE(3), mi, ni, fr, fq);
#pragma unroll
            for (int j = 0; j < 4; ++j) x[j] = (col < row0 + j) ? x[j] : 0.f;
            st_rm(TILE(8), x, mi, ni, fr, fq); st_tr(TILE(9), x, mi, ni, fr, fq);
            x = mm_tile(z4, TILE(0), TILE(4), mi, ni, fr, fq);
#pragma unroll
            for (int j = 0; j < 4; ++j) x[j] = (col < row0 + j) ? x[j] : 0.f;
            st_rm(TILE(10), x, mi, ni, fr, fq);
            x = mm_tile(z4, TILE(2), TILE(3), mi, ni, fr, fq);
#pragma unroll
            for (int j = 0; j < 4; ++j) x[j] = (col <= row0 + j) ? x[j] : 0.f;
            st_rm(TILE(11), x, mi, ni, fr, fq);
            x = mm_tile(z4, TILE(2), TILE(4), mi, ni, fr, fq);
#pragma unroll
            for (int j = 0; j < 4; ++j) x[j] = (col <= row0 + j) ? x[j] : 0.f;
            st_rm(TILE(12), x, mi, ni, fr, fq);
        }
        __syncthreads();
#pragma unroll
        for (int nn = 0; nn < 2; ++nn) {
            const int ni = nb + nn;
            st_tr(TILE(13), mm_tile(z4, TILE(10), TILE(7), mi, ni, fr, fq), mi, ni, fr, fq);
            const f32x4 x = mm_tile(z4, TILE(8), TILE(9), mi, ni, fr, fq);
            st_rm(TILE(0), x, mi, ni, fr, fq); st_tr(TILE(3), x, mi, ni, fr, fq);
        }
        __syncthreads();
#pragma unroll
        for (int rd = 0; rd < 5; ++rd) {
            const int tq = (rd & 1) ? 14 : 8, tqo = (rd & 1) ? 8 : 14;
            const int lx = (rd & 1) ? 4 : 0, lxt = (rd & 1) ? 9 : 3, lxo = (rd & 1) ? 0 : 4, lxto = (rd & 1) ? 3 : 9;
#pragma unroll
            for (int nn = 0; nn < 2; ++nn) {
                const int ni = nb + nn;
                f32x4 x = ld_rm(TILE(tq), mi, ni, fr, fq) + ld_rm(TILE(lx), mi, ni, fr, fq);
                x = mm_tile(x, TILE(tq), TILE(lxt), mi, ni, fr, fq);
                st_rm(TILE(tqo), x, mi, ni, fr, fq);
                if (rd < 4) { const f32x4 y = mm_tile(z4, TILE(lx), TILE(lxt), mi, ni, fr, fq); st_rm(TILE(lxo), y, mi, ni, fr, fq); st_tr(TILE(lxto), y, mi, ni, fr, fq); }
            }
            __syncthreads();
        }
#pragma unroll
        for (int nn = 0; nn < 2; ++nn) {
            const int ni = nb + nn;
            st_tr(TILE(10), mm_tile(ld_tr(TILE(1), mi, ni, fr, fq), TILE(14), TILE(1), mi, ni, fr, fq), mi, ni, fr, fq);
            st_tr(TILE(15), mm_tile(ld_tr(TILE(13), mi, ni, fr, fq), TILE(14), TILE(13), mi, ni, fr, fq), mi, ni, fr, fq);
        }
        __syncthreads();
#pragma unroll
        for (int nn = 0; nn < 2; ++nn) {
            const int ni = nb + nn;
            {
                f32x4 x = mm_tile(z4, TILE(5), TILE(10), mi, ni, fr, fq);
                if (mi == ni) {
#pragma unroll
                    for (int j = 0; j < 4; ++j) x[j] += (fq * 4 + j == fr) ? wc[ni * 16 + fr] : 0.f;
                }
                const unsigned w0 = cvt_pk_bf16(x[0], x[1]), w1 = cvt_pk_bf16(x[2], x[3]);
                bf16_t* gp = GT + (size_t)item * 4096 + (size_t)((mi * 2 + (ni >> 1)) * 64 + (fr >> 2) * 16 + fq * 4) * 8 + (ni & 1) * 4 + (fr & 3);
                gp[0] = (bf16_t)(w0 & 0xffffu); gp[8] = (bf16_t)(w0 >> 16); gp[16] = (bf16_t)(w1 & 0xffffu); gp[24] = (bf16_t)(w1 >> 16);
            }
            {
                f32x4 x = mm_tile(z4, TILE(5), TILE(15), mi, ni, fr, fq);
                x = mm_tile(x, TILE(6), TILE(7), mi, ni, fr, fq);
                *(f32x4*)(HT + (size_t)item * 4096 + (size_t)((ni * 4 + mi) * 64 + lane) * 4) = x;
            }
            {
                f32x4 x = ld_tr(TILE(2), mi, ni, fr, fq);
                x = mm_tile(x, TILE(10), TILE(11), mi, ni, fr, fq);
                u32x2 wv; wv.x = cvt_pk_bf16(x[0], x[1]); wv.y = cvt_pk_bf16(x[2], x[3]);
                *(u32x2*)(QE + (size_t)item * 4096 + (ni * 16 + fr) * 64 + mi * 16 + fq * 4) = wv;
            }
            {
                f32x4 x = mm_tile(z4, TILE(11), TILE(15), mi, ni, fr, fq);
                x = mm_tile(x, TILE(12), TILE(7), mi, ni, fr, fq);
                u32x2 wv; wv.x = cvt_pk_bf16(x[0], x[1]); wv.y = cvt_pk_bf16(x[2], x[3]);
                *(u32x2*)(YL + (size_t)item * 4096 + (size_t)((mi * 4 + ni) * 64 + lane) * 4) = wv;
            }
        }
    }
}

__device__ __forceinline__ void phase_seq(const Params& p) {
    if (threadIdx.x >= 64) return;
    const int head = blockIdx.x >> 2, vt = blockIdx.x & 3, lane = threadIdx.x, fr = lane & 15, fq = lane >> 4;
    const bf16_t* GT = (const bf16_t*)(p.ws + WS_GT); const float* HT = (const float*)(p.ws + WS_HT); bf16_t* S0 = (bf16_t*)(p.ws + WS_S0);
    f32x4 acc[4];
#pragma unroll
    for (int mb = 0; mb < 4; ++mb) acc[mb] = (f32x4){0.f, 0.f, 0.f, 0.f};
    bf16x8 ga[4][4][2]; f32x4 hh[4][4];
#define SEQ_LOAD(buf, cc) do { const size_t _it = (size_t)((cc) < 256 ? (cc) : 255) * 16 + head; \
        _Pragma("unroll") for (int mb = 0; mb < 4; ++mb) { \
            _Pragma("unroll") for (int ks = 0; ks < 2; ++ks) ga[buf][mb][ks] = *(const bf16x8*)(GT + _it * 4096 + (size_t)((mb * 2 + ks) * 64 + lane) * 8); \
            hh[buf][mb] = *(const f32x4*)(HT + _it * 4096 + (size_t)((vt * 4 + mb) * 64 + lane) * 4); } } while (0)
    SEQ_LOAD(0, 0); SEQ_LOAD(1, 1); SEQ_LOAD(2, 2); SEQ_LOAD(3, 3);
    for (int c0 = 0; c0 < 256; c0 += 4) {
#pragma unroll
        for (int b = 0; b < 4; ++b) {
            const int c = c0 + b; const size_t item = (size_t)c * 16 + head;
            u32x2 pk[4];
#pragma unroll
            for (int mb = 0; mb < 4; ++mb) { pk[mb].x = cvt_pk_bf16(acc[mb][0], acc[mb][1]); pk[mb].y = cvt_pk_bf16(acc[mb][2], acc[mb][3]);
                *(u32x2*)(S0 + item * 4096 + (vt * 16 + fr) * 64 + mb * 16 + fq * 4) = pk[mb]; }
            u32x4 b0w, b1w; b0w.x = pk[0].x; b0w.y = pk[0].y; b0w.z = pk[1].x; b0w.w = pk[1].y; b1w.x = pk[2].x; b1w.y = pk[2].y; b1w.z = pk[3].x; b1w.w = pk[3].y;
            const bf16x8 b0 = __builtin_bit_cast(bf16x8, b0w), b1 = __builtin_bit_cast(bf16x8, b1w);
#pragma unroll
            for (int mb = 0; mb < 4; ++mb) {
                const f32x4 x = __builtin_amdgcn_mfma_f32_16x16x32_bf16(ga[b][mb][0], b0, hh[b][mb], 0, 0, 0);
                acc[mb] = __builtin_amdgcn_mfma_f32_16x16x32_bf16(ga[b][mb][1], b1, x, 0, 0, 0);
            }
            SEQ_LOAD(b, c + 4);
        }
    }
#undef SEQ_LOAD
}

__device__ __forceinline__ void phase_chunkY(const Params& p, LAS unsigned char* lds) {
    LAS float* Yb = (LAS float*)lds;
    const int tid = threadIdx.x, w = tid >> 6, lane = tid & 63, fr = lane & 15, fq = lane >> 4;
    const int mi = w >> 1, nb = (w & 1) * 2;
    const bf16_t* R = (const bf16_t*)(p.ws + WS_R); const bf16_t* Kk = (const bf16_t*)(p.ws + WS_K); const bf16_t* V = (const bf16_t*)(p.ws + WS_V);
    const bf16_t* G = (const bf16_t*)(p.ws + WS_G); const bf16_t* YC = (const bf16_t*)(p.ws + WS_YC);
    const bf16_t* QE = (const bf16_t*)(p.ws + WS_QE); const bf16_t* YL = (const bf16_t*)(p.ws + WS_YL); const bf16_t* S0 = (const bf16_t*)(p.ws + WS_S0);
    bf16_t* YM = (bf16_t*)(p.ws + WS_YMIX);
    const float* gn_w = p.in[16]; const float* gn_b = p.in[17];
    u32x2 ywn[2]; bf16x8 an[2], bn[2][2]; bool first = true;
    u32x4 nv4, ng4, nyc4; float nbon; const float* BONp = (const float*)(p.ws + WS_BON);
#define CY_LOAD(it) do { const bf16_t* _q = QE + (size_t)(it) * 4096; const bf16_t* _s = S0 + (size_t)(it) * 4096; const bf16_t* _y = YL + (size_t)(it) * 4096; \
        _Pragma("unroll") for (int ks = 0; ks < 2; ++ks) an[ks] = *(const bf16x8*)(_q + (mi * 16 + fr) * 64 + ks * 32 + fq * 8); \
        _Pragma("unroll") for (int nn = 0; nn < 2; ++nn) { ywn[nn] = *(const u32x2*)(_y + (size_t)((mi * 4 + nb + nn) * 64 + lane) * 4); \
            _Pragma("unroll") for (int ks = 0; ks < 2; ++ks) bn[nn][ks] = *(const bf16x8*)(_s + (nb + nn) * 16 * 64 + fr * 64 + ks * 32 + fq * 8); } \
        { const size_t _tg = (size_t)((it) >> 4) * 64 + (tid >> 3); const size_t _o = _tg * DR + ((it) & 15) * 64 + (tid & 7) * 8; \
          nv4 = *(const u32x4*)(V + _o); ng4 = *(const u32x4*)(G + _o); nyc4 = *(const u32x4*)(YC + _o); nbon = BONp[_tg * 16 + ((it) & 15)]; } } while (0)
    for (int item = blockIdx.x; item < 4096; item += gridDim.x) {
        const int c = item >> 4, h = item & 15;
        if (first) { first = false; CY_LOAD(item); }
        __syncthreads();
        const u32x2 ywc[2] = {ywn[0], ywn[1]}; const bf16x8 ac[2] = {an[0], an[1]}; const bf16x8 bc[2][2] = {{bn[0][0], bn[0][1]}, {bn[1][0], bn[1][1]}};
        const u32x4 v4 = nv4, g4 = ng4, yc4 = nyc4; const float bon = nbon;
        if (item + (int)gridDim.x < 4096) CY_LOAD(item + (int)gridDim.x);
#pragma unroll
        for (int nn = 0; nn < 2; ++nn) {
            const int ni = nb + nn;
            const u32x2 yw = ywc[nn];
            f32x4 acc = (f32x4){lo_bf(yw.x), hi_bf(yw.x), lo_bf(yw.y), hi_bf(yw.y)};
#pragma unroll
            for (int ks = 0; ks < 2; ++ks) acc = __builtin_amdgcn_mfma_f32_16x16x32_bf16(ac[ks], bc[nn][ks], acc, 0, 0, 0);
#pragma unroll
            for (int j = 0; j < 4; ++j) Yb[(mi * 16 + fq * 4 + j) * 68 + ni * 16 + fr] = acc[j];
        }
        __syncthreads();
        {
            const int t = tid >> 3, k0 = (tid & 7) * 8; const int ch = h * 64 + k0;
            const size_t tg = (size_t)c * 64 + t; const size_t o = tg * DR + ch;
            const float4 gw0 = *(const float4*)(gn_w + ch), gw1 = *(const float4*)(gn_w + ch + 4), gb0 = *(const float4*)(gn_b + ch), gb1 = *(const float4*)(gn_b + ch + 4);
            const float gwv[8] = {gw0.x, gw0.y, gw0.z, gw0.w, gw1.x, gw1.y, gw1.z, gw1.w}, gbv[8] = {gb0.x, gb0.y, gb0.z, gb0.w, gb1.x, gb1.y, gb1.z, gb1.w};
            const f32x4 y0 = *(const LAS f32x4*)(Yb + t * 68 + k0), y1 = *(const LAS f32x4*)(Yb + t * 68 + k0 + 4);
            const float y[8] = {y0[0], y0[1], y0[2], y0[3], y1[0], y1[1], y1[2], y1[3]};
            float sm = 0.f;
#pragma unroll
            for (int i = 0; i < 8; ++i) sm += y[i];
            sm += dpp_f<0xB1, 0xf>(sm); sm += dpp_f<0x4E, 0xf>(sm); sm += dpp_f<0x141, 0xf>(sm);
            const float mean = sm * (1.f / 64.f);
            float vs = 0.f;
#pragma unroll
            for (int i = 0; i < 8; ++i) { const float d = y[i] - mean; vs += d * d; }
            vs += dpp_f<0xB1, 0xf>(vs); vs += dpp_f<0x4E, 0xf>(vs); vs += dpp_f<0x141, 0xf>(vs);
            const float rs = rsqrtf(vs * (1.f / 64.f) + 64e-5f);
            float vf[8], gf[8], of[8];
            unpack8(v4, vf); unpack8(g4, gf);
#pragma unroll
            for (int i = 0; i < 8; ++i) of[i] = ((y[i] - mean) * rs * gwv[i] + gbv[i] + bon * vf[i]) * gf[i];
            *(u32x4*)(YM + tg * D_ + ch) = pack8(of);
            *(u32x4*)(YM + tg * D_ + 1024 + ch) = yc4;
        }
    }
#undef CY_LOAD
}

__device__ __forceinline__ int f2key(float x) { const int u = __float_as_int(x); return u ^ ((u >> 31) & 0x7fffffff); }
__device__ __forceinline__ float key2f(int k) { return __int_as_float(k ^ ((k >> 31) & 0x7fffffff)); }
template <int CTRL> __device__ __forceinline__ int dpp_i(int v) { return __builtin_amdgcn_update_dpp(v, v, CTRL, 0xf, 0xf, false); }
__device__ __forceinline__ int row_max_i(int v) { v = max(v, dpp_i<0xB1>(v)); v = max(v, dpp_i<0x4E>(v)); v = max(v, dpp_i<0x141>(v)); v = max(v, dpp_i<0x140>(v)); return v; }
__device__ __forceinline__ void phase_topk(const Params& p, unsigned char* shm) {
    float* sc = (float*)shm;
    int* tk = (int*)(sc + 64 * 260);
    int* ctab = tk + 2048;
    if (threadIdx.x < 64) { int n = threadIdx.x, v = 256;
        for (int i = 0; i < 16; ++i) { const int cnt = 16 / (i + 1); if (n < cnt) { v = i * 16 + n; break; } n -= cnt; }
        ctab[threadIdx.x] = v; }
    const float* SC = (const float*)(p.ws + WS_Q);
    int* IDS = (int*)(p.ws + WS_IDS); float* GATES = (float*)(p.ws + WS_GATES);
    const int tid = threadIdx.x, w = tid >> 6, lane = tid & 63;
    f32x4 qreg[8];
#define TK_QLOAD(it) do { const int _t0 = ((it) >> 3) * 64; _Pragma("unroll") for (int i = 0; i < 8; ++i) { const int ch = tid + 512 * i; \
        qreg[i] = *(const f32x4*)(SC + (size_t)(_t0 + (ch >> 6)) * 2048 + ((it) & 7) * 256 + (ch & 63) * 4); } } while (0)
    if ((int)blockIdx.x < 2048) TK_QLOAD((int)blockIdx.x);
    for (int item = blockIdx.x; item < 2048; item += gridDim.x) {
        const int t0 = (item >> 3) * 64, h = item & 7;
        __syncthreads();
#pragma unroll
        for (int i = 0; i < 8; ++i) { const int ch = tid + 512 * i; *(f32x4*)(sc + (ch >> 6) * 260 + (ch & 63) * 4) = qreg[i]; }
        __syncthreads();
        if (item + (int)gridDim.x < 2048) TK_QLOAD(item + (int)gridDim.x);
        for (int g = 0; g < 4; ++g) {
            const int L = w * 16 + g * 4 + (lane >> 4); const int tok = L >> 1, cc = L & 1; const int pp = lane & 15;
            int key[8];
#pragma unroll
            for (int i = 0; i < 8; ++i) key[i] = (f2key(sc[tok * 260 + cc * 128 + i * 16 + pp]) & ~127) | (127 - (i * 16 + pp));
#define CE(a, b) do { const int _hi = max(key[a], key[b]), _lo = min(key[a], key[b]); key[a] = _hi; key[b] = _lo; } while (0)
            CE(0, 1); CE(2, 3); CE(4, 5); CE(6, 7);  CE(0, 2); CE(1, 3); CE(4, 6); CE(5, 7);  CE(1, 2); CE(5, 6);
            CE(0, 4); CE(1, 5); CE(2, 6); CE(3, 7);  CE(2, 4); CE(3, 5);  CE(1, 2); CE(3, 4); CE(5, 6);
#undef CE
            int mykey = 0;
#pragma unroll
            for (int r = 0; r < 16; ++r) {
                const int m = row_max_i(key[0]);
                const bool win = (key[0] == m);
#pragma unroll
                for (int i = 0; i < 7; ++i) key[i] = win ? key[i + 1] : key[i];
                key[7] = win ? (int)0x80000000 : key[7];
                mykey = (pp == r) ? m : mykey;
            }
            tk[L * 16 + pp] = mykey;
        }
        __syncthreads();
        for (int g = 0; g < 2; ++g) {
            const int tok = w * 8 + g * 4 + (lane >> 4); const int pp = lane & 15;
            int key[4];
#pragma unroll
            for (int q = 0; q < 4; ++q) {
                const int ij = ctab[q * 16 + pp];
                const float s1 = key2f(tk[(tok * 2) * 16 + ((ij >> 4) & 15)] & ~127), s2 = key2f(tk[(tok * 2 + 1) * 16 + (ij & 15)] & ~127);
                key[q] = (ij < 256) ? ((f2key(s1 + s2) & ~255) | (255 - ij)) : (int)0x80000000;
            }
            int mykey = 0;
#pragma unroll
            for (int r = 0; r < 16; ++r) {
                const int ml = max(max(key[0], key[1]), max(key[2], key[3]));
                const int m = row_max_i(ml);
#pragma unroll
                for (int q = 0; q < 4; ++q) key[q] = (key[q] == m) ? (int)0x80000000 : key[q];
                mykey = (pp == r) ? m : mykey;
            }
            const int ci = 255 - (mykey & 255); const float cs = key2f(mykey & ~255);
            const int e1 = 127 - (tk[(tok * 2) * 16 + (ci >> 4)] & 127), e2 = 127 - (tk[(tok * 2 + 1) * 16 + (ci & 15)] & 127);
            const float mx = __shfl(cs, lane & 48);
            const float e = __expf(cs - mx);
            float sum = e; sum += dpp_f<0xB1, 0xf>(sum); sum += dpp_f<0x4E, 0xf>(sum); sum += dpp_f<0x141, 0xf>(sum); sum += dpp_f<0x140, 0xf>(sum);
            IDS[(size_t)(t0 + tok) * 128 + h * 16 + pp] = (e1 * 128 + e2) & 16383;
            GATES[(size_t)(t0 + tok) * 128 + h * 16 + pp] = e / sum;
        }
    }
#undef TK_QLOAD
}

__device__ __forceinline__ float gelu_fast(float x) { const float u = 0.7978845608028654f * (x + 0.044715f * x * x * x); return x / (1.0f + __expf(-2.0f * u)); }
__device__ __forceinline__ void phase_gather(const Params& p, unsigned char* shm) {
    const float* X1 = (const float*)(p.ws + WS_X1); const float* SSQ = (const float*)(p.ws + WS_SSQ);
    const unsigned char* U6 = p.ws + WS_UB; const unsigned char* V6 = p.ws + WS_VB;
    const int* IDS = (const int*)(p.ws + WS_IDS); const float* GATES = (const float*)(p.ws + WS_GATES);
    const float* nf = p.in[25];
    const int tid = threadIdx.x, w = tid >> 6, lane = tid & 63;
    int nid0 = 0, nid1 = 0; float ngt0 = 0.f, ngt1 = 0.f, nssq = 0.f;
#define GT_META(tt) do { nid0 = IDS[(size_t)(tt) * 128 + lane]; nid1 = IDS[(size_t)(tt) * 128 + 64 + lane]; ngt0 = GATES[(size_t)(tt) * 128 + lane]; ngt1 = GATES[(size_t)(tt) * 128 + 64 + lane]; \
        nssq = (lane < 32) ? SSQ[(size_t)(tt) * 32 + lane] : 0.f; } while (0)
    if ((int)(blockIdx.x * 8 + w) < S_) GT_META(blockIdx.x * 8 + w);
    for (int t = blockIdx.x * 8 + w; t < S_; t += gridDim.x * 8) {
        const int id0 = nid0, id1 = nid1; const float gt0 = ngt0, gt1 = ngt1, ssqv = nssq;
        if (t + (int)gridDim.x * 8 < S_) GT_META(t + (int)gridDim.x * 8);
        f32x2 op[16];
#pragma unroll
        for (int j = 0; j < 8; ++j) { const float4 x = *(const float4*)(X1 + (size_t)t * D_ + (j * 64 + lane) * 4);
            op[2 * j] = (f32x2){x.x, x.y}; op[2 * j + 1] = (f32x2){x.z, x.w}; }
        f32x2 hp[16];
#pragma unroll
        for (int i = 0; i < 16; ++i) hp[i] = op[i];
        const float rs = rsqrtf(wave_sum_dpp(ssqv) * (1.0f / 2048.0f) + 1e-6f);
        u32x4 uaA[4], ubA[4], vbA[4]; u32x2 uaB[4], ubB[4], vbB[4];
#define G_LOADU(dA, dB, grp) do { _Pragma("unroll") for (int j = 0; j < 4; ++j) { const int e = (grp) * 4 + j; const int id = __builtin_amdgcn_readlane(e < 64 ? id0 : id1, e & 63); \
            const unsigned char* ur = U6 + (size_t)id * ROW6; dA[j] = *(const u32x4*)(ur + lane * 16); dB[j] = *(const u32x2*)(ur + 1024 + lane * 8); } } while (0)
#define G_LOADV(grp) do { _Pragma("unroll") for (int j = 0; j < 4; ++j) { const int e = (grp) * 4 + j; const int id = __builtin_amdgcn_readlane(e < 64 ? id0 : id1, e & 63); \
            const unsigned char* vr = V6 + (size_t)id * ROW6; vbA[j] = *(const u32x4*)(vr + lane * 16); vbB[j] = *(const u32x2*)(vr + 1024 + lane * 8); } } while (0)
#define G_DEC(A, B) __builtin_amdgcn_cvt_scalef32_pk32_f32_fp6((u32x6){A[0], A[1], A[2], A[3], B[0], B[1]}, 1.0f)
#define G_BODY(cA, cB, nA, nB, grp) do { \
            G_LOADV(grp); \
            G_LOADU(nA, nB, ((grp) + 1 < 32 ? (grp) + 1 : 31)); \
            float dsel = 0.f; \
            _Pragma("unroll") for (int j = 0; j < 4; ++j) { const f32x32 dd = G_DEC(cA[j], cB[j]); f32x2 d2 = (f32x2){0.f, 0.f}; \
                _Pragma("unroll") for (int m = 0; m < 16; ++m) d2 += (f32x2){dd[2 * m], dd[2 * m + 1]} * hp[m]; \
                const float d = wave_sum_dpp(d2.x + d2.y); dsel = (lane == j) ? d : dsel; } \
            const float av = gelu_fast(dsel * (rs * (1.f / U6_SCALE))) * (1.f / V6_SCALE); \
            _Pragma("unroll") for (int j = 0; j < 4; ++j) { const int e = (grp) * 4 + j; \
                const float a = __int_as_float(__builtin_amdgcn_readlane(__float_as_int(av), j)) * __int_as_float(__builtin_amdgcn_readlane(__float_as_int(e < 64 ? gt0 : gt1), e & 63)); \
                const f32x2 a2 = (f32x2){a, a}; const f32x32 dd = G_DEC(vbA[j], vbB[j]); \
                _Pragma("unroll") for (int m = 0; m < 16; ++m) op[m] += a2 * (f32x2){dd[2 * m], dd[2 * m + 1]}; } \
        } while (0)
        G_LOADU(uaA, uaB, 0);
#pragma unroll 1
        for (int g2 = 0; g2 < 32; g2 += 2) { G_BODY(uaA, uaB, ubA, ubB, g2); G_BODY(ubA, ubB, uaA, uaB, g2 + 1); }
#undef G_LOADU
#undef G_LOADV
#undef G_DEC
#undef G_BODY
        float ss = 0.f;
#pragma unroll
        for (int m = 0; m < 16; ++m) ss += op[m].x * op[m].x + op[m].y * op[m].y;
        ss = wave_sum_dpp(ss);
        const float scl = rsqrtf(ss * (1.f / 2048.f) + 1e-6f);
#pragma unroll
        for (int j = 0; j < 8; ++j) { const float4 g = *(const float4*)(nf + (j * 64 + lane) * 4);
            *(float4*)(p.out + (size_t)t * D_ + (j * 64 + lane) * 4) = make_float4(op[2 * j].x * scl * g.x, op[2 * j].y * scl * g.y, op[2 * j + 1].x * scl * g.z, op[2 * j + 1].y * scl * g.w); }
    }
#undef GT_META
}

#define PEER_LD6(dstA, dstB, base, id) do { const unsigned char* _q = (base) + ((size_t)xs * 16384 + (id)) * 192 + pt * 24; dstA = *(const u32x4*)_q; dstB = *(const u32x2*)(_q + 16); } while (0)
#define PEER_DEC(A, B) __builtin_amdgcn_cvt_scalef32_pk32_f32_fp6((u32x6){A[0], A[1], A[2], A[3], B[0], B[1]}, 1.0f)
__device__ __forceinline__ void phase_peerZ(const Params& p) {
    const float* X1 = (const float*)(p.ws + WS_X1); const unsigned char* U6 = p.ws + WS_UB; const int* IDS = (const int*)(p.ws + WS_IDS);
    float* ZP = (float*)(p.ws + WS_ZP);
    const int lane = threadIdx.x & 63, w = threadIdx.x >> 6, es = lane >> 3, pt = lane & 7;
    const int xs = blockIdx.x & 7, nwg = (gridDim.x >> 3) * 8;
    for (int t = (blockIdx.x >> 3) * 8 + w; t < S_; t += nwg) {
        f32x2 hp[16];
#pragma unroll
        for (int j = 0; j < 8; ++j) { const float4 v = *(const float4*)(X1 + (size_t)t * D_ + xs * 256 + (j * 8 + pt) * 4); hp[2 * j] = (f32x2){v.x, v.y}; hp[2 * j + 1] = (f32x2){v.z, v.w}; }
        const int id0 = IDS[(size_t)t * 128 + lane], id1 = IDS[(size_t)t * 128 + 64 + lane];
        u32x4 bA[4]; u32x2 bB[4];
#pragma unroll
        for (int g = 0; g < 4; ++g) { const int id = __shfl(id0, g * 8 + es); PEER_LD6(bA[g], bB[g], U6, id); }
#pragma unroll
        for (int g = 0; g < 16; ++g) {
            const f32x32 dd = PEER_DEC(bA[g & 3], bB[g & 3]);
            if (g + 4 < 16) { const int id = __shfl((g + 4) < 8 ? id0 : id1, ((g + 4) * 8 + es) & 63); PEER_LD6(bA[g & 3], bB[g & 3], U6, id); }
            f32x2 d2 = (f32x2){0.f, 0.f};
#pragma unroll
            for (int m = 0; m < 16; ++m) d2 += (f32x2){dd[2 * m], dd[2 * m + 1]} * hp[m];
            float d = d2.x + d2.y;
            d += dpp_f<0xB1, 0xf>(d); d += dpp_f<0x4E, 0xf>(d); d += dpp_f<0x141, 0xf>(d);
            if (pt == 0) ZP[((size_t)t * 8 + xs) * 128 + g * 8 + es] = d;
        }
    }
}
__device__ __forceinline__ void phase_peerV(const Params& p) {
    const float* X1 = (const float*)(p.ws + WS_X1); const unsigned char* V6 = p.ws + WS_VB; const int* IDS = (const int*)(p.ws + WS_IDS);
    const float* GATES = (const float*)(p.ws + WS_GATES); const float* ZP = (const float*)(p.ws + WS_ZP); const float* SSQ = (const float*)(p.ws + WS_SSQ);
    float* X2 = (float*)(p.ws + WS_X2); float* SSQ2 = (float*)(p.ws + WS_SSQ2);
    const int lane = threadIdx.x & 63, w = threadIdx.x >> 6, es = lane >> 3, pt = lane & 7;
    const int xs = blockIdx.x & 7, nwg = (gridDim.x >> 3) * 8;
    for (int t = (blockIdx.x >> 3) * 8 + w; t < S_; t += nwg) {
        const int id0 = IDS[(size_t)t * 128 + lane], id1 = IDS[(size_t)t * 128 + 64 + lane];
        u32x4 bA[4]; u32x2 bB[4];
#pragma unroll
        for (int g = 0; g < 4; ++g) { const int id = __shfl(id0, g * 8 + es); PEER_LD6(bA[g], bB[g], V6, id); }
        float z0 = 0.f, z1 = 0.f;
#pragma unroll
        for (int x = 0; x < 8; ++x) { z0 += ZP[((size_t)t * 8 + x) * 128 + lane]; z1 += ZP[((size_t)t * 8 + x) * 128 + 64 + lane]; }
        const float rs = rsqrtf(wave_sum_dpp(lane < 32 ? SSQ[(size_t)t * 32 + lane] : 0.f) * (1.0f / 2048.0f) + 1e-6f);
        const float a0 = gelu_fast(z0 * (rs * (1.f / U6_SCALE))) * GATES[(size_t)t * 128 + lane] * (1.f / V6_SCALE);
        const float a1 = gelu_fast(z1 * (rs * (1.f / U6_SCALE))) * GATES[(size_t)t * 128 + 64 + lane] * (1.f / V6_SCALE);
        f32x2 op[16];
#pragma unroll
        for (int m = 0; m < 16; ++m) op[m] = (f32x2){0.f, 0.f};
#pragma unroll
        for (int g = 0; g < 16; ++g) {
            const f32x32 dd = PEER_DEC(bA[g & 3], bB[g & 3]);
            if (g + 4 < 16) { const int id = __shfl((g + 4) < 8 ? id0 : id1, ((g + 4) * 8 + es) & 63); PEER_LD6(bA[g & 3], bB[g & 3], V6, id); }
            const float a = __shfl(g < 8 ? a0 : a1, (g * 8 + es) & 63);
            const f32x2 a2 = (f32x2){a, a};
#pragma unroll
            for (int m = 0; m < 16; ++m) op[m] += a2 * (f32x2){dd[2 * m], dd[2 * m + 1]};
        }
#pragma unroll
        for (int m = 0; m < 16; ++m) {
            float vx = op[m].x, vy = op[m].y;
            vx += __shfl_xor(vx, 8); vy += __shfl_xor(vy, 8); vx += __shfl_xor(vx, 16); vy += __shfl_xor(vy, 16); vx += __shfl_xor(vx, 32); vy += __shfl_xor(vy, 32);
            op[m] = (f32x2){vx, vy};
        }
        if (es == 0) {
            float ss = 0.f;
#pragma unroll
            for (int j = 0; j < 8; ++j) { float4 v = *(const float4*)(X1 + (size_t)t * D_ + xs * 256 + (j * 8 + pt) * 4);
                v.x += op[2 * j].x; v.y += op[2 * j].y; v.z += op[2 * j + 1].x; v.w += op[2 * j + 1].y;
                ss += v.x * v.x + v.y * v.y + v.z * v.z + v.w * v.w;
                *(float4*)(X2 + (size_t)t * D_ + xs * 256 + (j * 8 + pt) * 4) = v; }
            ss += dpp_f<0xB1, 0xf>(ss); ss += dpp_f<0x4E, 0xf>(ss); ss += dpp_f<0x141, 0xf>(ss);
            if (pt == 0) SSQ2[(size_t)t * 8 + xs] = ss;
        }
    }
}
__device__ __forceinline__ void phase_final(const Params& p) {
    const float* X2 = (const float*)(p.ws + WS_X2); const float* SSQ2 = (const float*)(p.ws + WS_SSQ2); const float* nf = p.in[25];
    const int lane = threadIdx.x & 63, w = threadIdx.x >> 6;
    for (int t = blockIdx.x * 8 + w; t < S_; t += gridDim.x * 8) {
        const f32x4 s0 = *(const f32x4*)(SSQ2 + (size_t)t * 8), s1 = *(const f32x4*)(SSQ2 + (size_t)t * 8 + 4);
        const float scl = rsqrtf(((s0[0] + s0[1]) + (s0[2] + s0[3]) + (s1[0] + s1[1]) + (s1[2] + s1[3])) * (1.f / 2048.f) + 1e-6f);
#pragma unroll
        for (int j = 0; j < 8; ++j) { const float4 v = *(const float4*)(X2 + (size_t)t * D_ + (j * 64 + lane) * 4); const float4 g = *(const float4*)(nf + (j * 64 + lane) * 4);
            *(float4*)(p.out + (size_t)t * D_ + (j * 64 + lane) * 4) = make_float4(v.x * scl * g.x, v.y * scl * g.y, v.z * scl * g.z, v.w * scl * g.w); }
    }
}

#define XB_TMO      128
#define XB_XCNT(j)  (256  + 64 * (j))
#define XB_XSUB(j)  (1280 + 64 * (j))
#define XB_XGEN(j)  (2304 + 64 * (j))
#define XB_TOP      3328
#define XB_TOPGEN   3392
#define XCD_BAR_WORDS 3456
#define XB_SPIN_CAP (1u << 18)
__device__ __forceinline__ unsigned xb_ld(unsigned* p)              { return __hip_atomic_load(p, __ATOMIC_RELAXED, __HIP_MEMORY_SCOPE_AGENT); }
__device__ __forceinline__ unsigned xb_add(unsigned* p, unsigned v) { return __hip_atomic_fetch_add(p, v, __ATOMIC_RELAXED, __HIP_MEMORY_SCOPE_AGENT); }
__device__ __forceinline__ unsigned xb_xcc_id() { return (unsigned)__builtin_amdgcn_s_getreg((3 << 11) | 20) & 0xFu; }
#define XB_SPIN(cond, bar) do { unsigned _sp = 0; while (cond) { __builtin_amdgcn_s_sleep(1); \
    if ((++_sp & 255u) == 0u) { if (xb_ld(&(bar)[XB_TMO])) break; if (_sp > XB_SPIN_CAP) { atomicAdd(&(bar)[XB_TMO], 1u); break; } } } } while (0)
struct XcdBarrier { unsigned* bar; unsigned x; volatile LAS unsigned* st; };
__device__ __forceinline__ XcdBarrier xcd_barrier_post(unsigned* bar, volatile LAS unsigned* st) {
    XcdBarrier b; b.bar = bar; b.x = xb_xcc_id(); b.st = st;
    if (threadIdx.x == 0) (void)xb_add(&bar[XB_XCNT(b.x)], 1u);
    return b;
}
__device__ __forceinline__ void xcd_barrier_complete(unsigned* bar, unsigned x, unsigned& nloc, unsigned& nx) {
    const unsigned G = gridDim.x * gridDim.y * gridDim.z;
    unsigned sum, cnt, mine, sp = 0u;
    for (;;) {
        sum = 0u; cnt = 0u; mine = 0u;
#pragma unroll
        for (unsigned j = 0; j < 16; ++j) { const unsigned c = xb_ld(&bar[XB_XCNT(j)]); sum += c; cnt += (c > 0u) ? 1u : 0u; mine = (j == x) ? c : mine; }
        if (sum == G) break;
        __builtin_amdgcn_s_sleep(1);
        if ((++sp & 255u) == 0u) { if (xb_ld(&bar[XB_TMO])) break; if (sp > XB_SPIN_CAP) { atomicAdd(&bar[XB_TMO], 1u); break; } }
    }
    nloc = mine > 0u ? mine : 1u; nx = cnt > 0u ? cnt : 1u;
}
__device__ __forceinline__ void xcd_barrier(const XcdBarrier& b) {
    asm volatile("s_waitcnt vmcnt(0)" ::: "memory");
    __syncthreads();
    if (threadIdx.x == 0) {
        unsigned* bar = b.bar;
        __builtin_amdgcn_s_waitcnt(0);
        unsigned nloc = b.st[0], nx = b.st[1];
        if (nloc == 0u) { xcd_barrier_complete(bar, b.x, nloc, nx); b.st[0] = nloc; b.st[1] = nx; }
        const unsigned old = xb_add(&bar[XB_XSUB(b.x)], 1u);
        const unsigned gen = old / nloc;
        if (old + 1u == (gen + 1u) * nloc) {
            __builtin_amdgcn_fence(__ATOMIC_RELEASE, "agent");
            asm volatile("s_waitcnt vmcnt(0)" ::: "memory");
            const unsigned og = xb_add(&bar[XB_TOP], 1u);
            const unsigned tg = og / nx;
            if (og + 1u == (tg + 1u) * nx) xb_add(&bar[XB_TOPGEN], 1u);
            else XB_SPIN(xb_ld(&bar[XB_TOPGEN]) == tg, bar);
            __builtin_amdgcn_fence(__ATOMIC_ACQUIRE, "agent");
            xb_add(&bar[XB_XGEN(b.x)], 1u);
            asm volatile("s_waitcnt vmcnt(0)" ::: "memory");
        } else {
            XB_SPIN(xb_ld(&bar[XB_XGEN(b.x)]) == gen, bar);
            __builtin_amdgcn_fence(__ATOMIC_ACQUIRE, "agent");
            asm volatile("s_waitcnt vmcnt(0)" ::: "memory");
        }
    }
    __syncthreads();
}

__global__ void __launch_bounds__(512, 2) mega(Params p) {
    extern __shared__ __attribute__((aligned(16))) unsigned char shm[];
    cg::grid_group grid = cg::this_grid();
    LAS unsigned char* lds = (LAS unsigned char*)shm;
    volatile LAS unsigned* bst = (volatile LAS unsigned*)(lds + LDS_BYTES - 16);
    if (threadIdx.x == 0) { bst[0] = 0u; bst[1] = 0u; }
    __syncthreads();
    const XcdBarrier xbar = xcd_barrier_post((unsigned*)(p.ws + WS_BAR), bst);
    if (p.ph_hi > 1000) grid.sync();
    const int lo = p.ph_lo, hi = p.ph_hi;
#define IN(k) (lo <= (k) && (k) < hi)
#define REP(k) for (int _r = 0; _r < ((k) == DUP_PHASE ? 2 : 1); ++_r)
#define SEAM(k) do { if (IN(k) && IN((k) + 1)) xcd_barrier(xbar); } while (0)
    if (IN(0)) REP(0) { if (_r) xcd_barrier(xbar); phase0(p, shm); }
    SEAM(0);
    if (IN(1)) REP(1) { if (_r) xcd_barrier(xbar);
        pg8::Gemm g{(const bf16_t*)(p.ws + WS_H), (const bf16_t*)(p.ws + WS_WB1), S_, NAUG, 2048};
        pg8::StaticOrder so; so.init(g.M, g.N, (int)gridDim.x, (int)blockIdx.x);
        pg8::EpiBf16 E{(bf16_t*)(p.ws + WS_PROJ), NAUG};
        pg8::gemm_phase(lds, g, so, E);
    }
    SEAM(1);
    if (IN(2)) REP(2) { if (_r) xcd_barrier(xbar);
        phase_prepM(p, lds);
        phase_prepE(p);
    }
    SEAM(2);
    if (IN(3)) REP(3) { if (_r) xcd_barrier(xbar); phase_chunkA(p, lds); }
    SEAM(3);
    if (IN(4)) REP(4) { if (_r) xcd_barrier(xbar); if (blockIdx.x < 64) phase_seq(p);
        else { const int bid = blockIdx.x - 64, nblk = gridDim.x - 64;
            convert_fp6s(p.in[23], p.ws + WS_UB, 16384, U6_SCALE, p.in[20], bid, nblk);
            convert_fp6s(p.in[24], p.ws + WS_VB, 16384, V6_SCALE, nullptr, bid, nblk);
            build_wpt(p.in[21], p.in[20], (const bf16_t*)(p.ws + WS_KEYB), (bf16_t*)(p.ws + WS_WQT), bid, nblk);
            transpose_convert(p.in[19], 2048, 2048, (bf16_t*)(p.ws + WS_WOT), (float*)shm, bid, nblk); } }
    SEAM(4);
    if (IN(5)) REP(5) { if (_r) xcd_barrier(xbar); phase_chunkY(p, lds); }
    SEAM(5);
    if (IN(6)) REP(6) { if (_r) xcd_barrier(xbar);
        pg8::Gemm g{(const bf16_t*)(p.ws + WS_YMIX), (const bf16_t*)(p.ws + WS_WOT), S_, 2048, 2048};
        pg8::StaticOrder so; so.init(g.M, g.N, (int)gridDim.x, (int)blockIdx.x);
        pg8::EpiRes2 E{(float*)(p.ws + WS_X1), p.in[0], (bf16_t*)(p.ws + WS_H2), (float*)(p.ws + WS_SSQ), 2048};
        pg8::gemm_phase(lds, g, so, E);
    }
    SEAM(6);
    if (IN(8)) REP(8) { if (_r) xcd_barrier(xbar);
        pg8::Gemm g{(const bf16_t*)(p.ws + WS_H2), (const bf16_t*)(p.ws + WS_WQT), S_, 2048, 2048};
        pg8::StaticOrder so; so.init(g.M, g.N, (int)gridDim.x, (int)blockIdx.x);
        pg8::EpiRowScaleF32 E{(float*)(p.ws + WS_Q), (const float*)(p.ws + WS_SSQ), 2048};
        pg8::gemm_phase(lds, g, so, E);
    }
    SEAM(8);
    if (IN(9)) REP(9) { if (_r) xcd_barrier(xbar); phase_topk(p, shm); }
    SEAM(9);
    if (IN(10)) REP(10) { if (_r) xcd_barrier(xbar); phase_peerZ(p); }
    SEAM(10);
    if (IN(11)) REP(11) { if (_r) xcd_barrier(xbar); phase_peerV(p); }
    SEAM(11);
    if (IN(12)) REP(12) { if (_r) xcd_barrier(xbar); phase_final(p); }
#undef IN
#undef REP
#undef SEAM
}

extern "C" void kernel_launch(void* const* d_in, const int* in_sizes, int n_in, void* d_out, int out_size, void* d_ws, size_t ws_size, hipStream_t stream) {
    static int grid_blocks = 0;
    if (grid_blocks == 0) {
        if (n_in != 26 || ws_size < WS_NEED) { fprintf(stderr, "kernel_launch: unexpected n_in %d / ws_size %zu\n", n_in, ws_size); grid_blocks = -1; return; }
        int dev = 0, cus = 0, per_cu = 0;
        (void)hipGetDevice(&dev);
        (void)hipDeviceGetAttribute(&cus, hipDeviceAttributeMultiprocessorCount, dev);
        (void)hipFuncSetAttribute((const void*)mega, hipFuncAttributeMaxDynamicSharedMemorySize, LDS_BYTES);
        (void)hipOccupancyMaxActiveBlocksPerMultiprocessor(&per_cu, (const void*)mega, 512, LDS_BYTES);
        if (per_cu < 1) { fprintf(stderr, "kernel_launch: occupancy query says %d blocks/CU\n", per_cu); per_cu = 1; }
        grid_blocks = cus * per_cu;
        fprintf(stderr, "kernel_launch: cus %d per_cu %d grid %d\n", cus, per_cu, grid_blocks);
    }
    if (grid_blocks < 0) return;
    Params p{};
    for (int i = 0; i < 26; ++i) p.in[i] = (const float*)d_in[i];
    p.out = (float*)d_out; p.ws = (unsigned char*)d_ws;
#if MULTI_LAUNCH
    for (int ph = 0; ph < NPHASE; ++ph) {
        p.ph_lo = ph; p.ph_hi = ph + 1;
        hipLaunchKernelGGL(mega, dim3(grid_blocks), dim3(512), LDS_BYTES, stream, p);
    }
#else
    p.ph_lo = 0; p.ph_hi = NPHASE;
    if (hipMemsetAsync((unsigned char*)d_ws + WS_BAR, 0, XCD_BAR_WORDS * 4, stream) != hipSuccess) fprintf(stderr, "kernel_launch: barrier memset failed\n");
    void* args[] = {&p};
    hipError_t e = hipLaunchCooperativeKernel((const void*)mega, dim3(grid_blocks), dim3(512), args, LDS_BYTES, stream);
    if (e != hipSuccess) fprintf(stderr, "cooperative launch failed: %s (grid %d)\n", hipGetErrorString(e), grid_blocks);
#endif
}
```

```cpp
#include <hip/hip_runtime.h>
#include <hip/hip_cooperative_groups.h>
#include <cstdio>
namespace cg = cooperative_groups;

#ifndef DUP_PHASE
#define DUP_PHASE -1
#endif
#ifndef MULTI_LAUNCH
#define MULTI_LAUNCH 0
#endif

#define LAS __attribute__((address_space(3)))
typedef unsigned short bf16_t;
typedef short bf16x8 __attribute__((ext_vector_type(8)));
typedef float f32x4 __attribute__((ext_vector_type(4)));
typedef float f32x2 __attribute__((ext_vector_type(2)));
typedef unsigned u32x4 __attribute__((ext_vector_type(4)));
typedef unsigned u32x2 __attribute__((ext_vector_type(2)));
typedef unsigned u32x6 __attribute__((ext_vector_type(6)));
typedef float f32x32 __attribute__((ext_vector_type(32)));
typedef __bf16 bf16x32_t __attribute__((ext_vector_type(32)));

constexpr int S_ = 16384, D_ = 2048, DR = 1024, NAUG = 6912;
constexpr size_t MiB = 1ull << 20;
constexpr size_t WS_PROJ = 0, WS_H = 216 * MiB, WS_WB1 = 280 * MiB, WS_WQT = 280 * MiB, WS_WOT = 296 * MiB;
constexpr size_t WS_R = 307 * MiB, WS_K = 339 * MiB, WS_V = 371 * MiB, WS_KK = 403 * MiB, WS_A = 435 * MiB, WS_LW = 467 * MiB;
constexpr size_t WS_G = 216 * MiB, WS_YC = 248 * MiB, WS_YMIX = 307 * MiB, WS_X1 = 0, WS_H2 = 128 * MiB, WS_Q = 307 * MiB;
constexpr size_t WS_GT = 0, WS_HT = 32 * MiB, WS_QE = 96 * MiB, WS_YL = 128 * MiB, WS_S0 = 160 * MiB;
constexpr size_t WS_IDS = 192 * MiB, WS_GATES = 200 * MiB, WS_UB = 467 * MiB, WS_VB = 435 * MiB, WS_BON = 500 * MiB, WS_BAR = 502 * MiB, WS_KEYB = 503 * MiB, WS_SSQ = 504 * MiB, WS_SSQ2 = 506 * MiB, WS_NEED = 507 * MiB;
constexpr size_t WS_ZP = 128 * MiB, WS_X2 = 307 * MiB;
constexpr size_t WS_W2T = 499 * MiB, WS_A2T = WS_W2T + 131072, WS_G2T = WS_A2T + 131072;
constexpr int TLD = 72, TSLOT = 64 * TLD * 2;
constexpr int LDS_BYTES = 16 * TSLOT + 2048 + 256 + 16;
constexpr int NPHASE = 13;

struct Params {
    const float* in[26];
    float* out;
    unsigned char* ws;
    int ph_lo, ph_hi;
};

__device__ __forceinline__ float bf2f(bf16_t b) { return __uint_as_float(((unsigned)b) << 16); }
__device__ __forceinline__ bf16_t f2bf(float f) { unsigned u = __float_as_uint(f); u += 0x7FFFu + ((u >> 16) & 1u); return (bf16_t)(u >> 16); }
typedef __bf16 bf16v2_t __attribute__((ext_vector_type(2)));
__device__ __forceinline__ unsigned cvt_pk_bf16(float lo, float hi) { const f32x2 v = {lo, hi}; const bf16v2_t r = __builtin_convertvector(v, bf16v2_t); return __builtin_bit_cast(unsigned, r); }
__device__ __forceinline__ u32x4 pack8(const float* f) { u32x4 w; w.x = cvt_pk_bf16(f[0], f[1]); w.y = cvt_pk_bf16(f[2], f[3]); w.z = cvt_pk_bf16(f[4], f[5]); w.w = cvt_pk_bf16(f[6], f[7]); return w; }
__device__ __forceinline__ float lo_bf(unsigned w) { return __uint_as_float(w << 16); }
__device__ __forceinline__ float hi_bf(unsigned w) { return __uint_as_float(w & 0xffff0000u); }
__device__ __forceinline__ void unpack8(const u32x4 v, float* f) {
#pragma unroll
    for (int i = 0; i < 4; ++i) { f[2 * i] = lo_bf(v[i]); f[2 * i + 1] = hi_bf(v[i]); }
}
__device__ __forceinline__ float wave_sum(float v) {
#pragma unroll
    for (int o = 32; o; o >>= 1) v += __shfl_xor(v, o);
    return v;
}
template <int CTRL, int RM> __device__ __forceinline__ float dpp_f(float v) { return __int_as_float(__builtin_amdgcn_update_dpp(0, __float_as_int(v), CTRL, RM, 0xf, false)); }
__device__ __forceinline__ float wave_sum_dpp(float v) {
    v += dpp_f<0xB1, 0xf>(v); v += dpp_f<0x4E, 0xf>(v); v += dpp_f<0x141, 0xf>(v); v += dpp_f<0x140, 0xf>(v);
    v += dpp_f<0x142, 0xa>(v); v += dpp_f<0x143, 0xc>(v);
    return __int_as_float(__builtin_amdgcn_readlane(__float_as_int(v), 63));
}
__device__ __forceinline__ float wave_max(float v) {
#pragma unroll
    for (int o = 32; o; o >>= 1) v = fmaxf(v, __shfl_xor(v, o));
    return v;
}
__device__ __forceinline__ float sigmoidf_(float x) { return 1.0f / (1.0f + __expf(-x)); }
__device__ __forceinline__ float gelu_tanh(float x) { float u = 0.7978845608028654f * (x + 0.044715f * x * x * x); return 0.5f * x * (1.0f + tanhf(u)); }

namespace pg8 {
constexpr int BM = 256, BK = 64, HALF = 128, HTB = HALF * BK * 2, STAGE_BYTES = 8 * HTB, NXCD = 8, WGM = 8;
__device__ __forceinline__ int lds_byte(int r, int c) { const int st = (r >> 4) * 2 + (c >> 5), rr = r & 15, cc = c & 31, ob = rr * 64 + cc * 2; return st * 1024 + (ob ^ (((ob >> 9) & 1) << 5)); }
__device__ __forceinline__ void stage_rc(int b, int& R, int& C) { const int st = b / 1024, sb = b % 1024, swz = sb ^ (((sb >> 9) & 1) << 5); R = (st >> 1) * 16 + swz / 64; C = (st & 1) * 32 + (swz % 64) / 2; }
__device__ __forceinline__ int perm32(int rho) { const int n = rho >> 4, i = rho & 15; return 8 * (i >> 2) + 4 * n + (i & 3); }
struct Unit { int pm, pn; };
struct Gemm { const bf16_t* A; const bf16_t* Bt; int M, N, K; };
struct StaticOrder {
    int nM, nN, nwg, G, c;
    __device__ void init(int M, int N, int G_, int c_) { nM = M / BM; nN = N / BM; nwg = nM * nN; G = G_; c = c_; }
    __device__ bool next(int i, Unit& u) const {
        const long L = (long)i * G + c; if (L >= nwg) return false;
        int wgid = (int)L; { const int q = nwg / NXCD, r = nwg % NXCD, xcd = wgid % NXCD, off = wgid / NXCD; wgid = (xcd < r ? xcd * (q + 1) : r * (q + 1) + (xcd - r) * q) + off; }
        const int nig = WGM * nN, gid = wgid / nig, fm = gid * WGM, gsz = (nM - fm) < WGM ? (nM - fm) : WGM;
        u.pm = fm + ((wgid % nig) % gsz); u.pn = (wgid % nig) / gsz; return true;
    }
    __device__ __forceinline__ void a_ready(const Unit&) const {}
    __device__ __forceinline__ void done(const Unit&) const {}
};
struct EpiResF32 {
    static constexpr bool PERM = false;
    float* C; const float* Res; int ldc;
    __device__ __forceinline__ void operator()(const f32x4 (&acc)[2][2][4][2], const Unit& u, int wr, int wc, int fr, int fq) const {
        const int row0 = u.pm * BM + wr * 64 + fr, col0 = u.pn * BM + wc * 32 + 4 * fq;
#pragma unroll
        for (int ai = 0; ai < 2; ++ai)
#pragma unroll
            for (int m = 0; m < 4; ++m) { const size_t ro = (size_t)(row0 + ai * HALF + m * 16) * ldc + col0;
#pragma unroll
                for (int bj = 0; bj < 2; ++bj)
#pragma unroll
                    for (int n = 0; n < 2; ++n) { const f32x4 rs = *(const f32x4*)(Res + ro + bj * HALF + n * 16); *(f32x4*)(C + ro + bj * HALF + n * 16) = acc[ai][bj][m][n] + rs; } }
    }
};
struct EpiRes2 {
    static constexpr bool PERM = false;
    float* C; const float* Res; bf16_t* Cb; float* SSQ; int ldc;
    __device__ __forceinline__ void operator()(const f32x4 (&acc)[2][2][4][2], const Unit& u, int wr, int wc, int fr, int fq) const {
        const int row0 = u.pm * BM + wr * 64 + fr, col0 = u.pn * BM + wc * 32 + 4 * fq;
#pragma unroll
        for (int ai = 0; ai < 2; ++ai)
#pragma unroll
            for (int m = 0; m < 4; ++m) { const int row = row0 + ai * HALF + m * 16; const size_t ro = (size_t)row * ldc + col0; float ss = 0.f;
#pragma unroll
                for (int bj = 0; bj < 2; ++bj)
#pragma unroll
                    for (int n = 0; n < 2; ++n) { const f32x4 v = acc[ai][bj][m][n] + *(const f32x4*)(Res + ro + bj * HALF + n * 16);
                        *(f32x4*)(C + ro + bj * HALF + n * 16) = v;
                        u32x2 wv; wv.x = cvt_pk_bf16(v[0], v[1]); wv.y = cvt_pk_bf16(v[2], v[3]); *(u32x2*)(Cb + ro + bj * HALF + n * 16) = wv;
                        ss += v[0] * v[0] + v[1] * v[1] + v[2] * v[2] + v[3] * v[3]; }
                ss += __shfl_xor(ss, 16); ss += __shfl_xor(ss, 32);
                if (fq == 0) SSQ[(size_t)row * 32 + u.pn * 4 + wc] = ss; }
    }
};
struct EpiRowScaleF32 {
    static constexpr bool PERM = false;
    float* C; const float* SSQ; int ldc;
    __device__ __forceinline__ void operator()(const f32x4 (&acc)[2][2][4][2], const Unit& u, int wr, int wc, int fr, int fq) const {
        const int row0 = u.pm * BM + wr * 64 + fr, col0 = u.pn * BM + wc * 32 + 4 * fq;
#pragma unroll
        for (int ai = 0; ai < 2; ++ai)
#pragma unroll
            for (int m = 0; m < 4; ++m) { const int row = row0 + ai * HALF + m * 16; const size_t ro = (size_t)row * ldc + col0;
                const f32x4* sp = (const f32x4*)(SSQ + (size_t)row * 32); float sq = 0.f;
#pragma unroll
                for (int q = 0; q < 8; ++q) { const f32x4 v = sp[q]; sq += (v[0] + v[1]) + (v[2] + v[3]); }
                const float rs = rsqrtf(sq * (1.0f / 2048.0f) + 1e-6f);
#pragma unroll
                for (int bj = 0; bj < 2; ++bj)
#pragma unroll
                    for (int n = 0; n < 2; ++n) *(f32x4*)(C + ro + bj * HALF + n * 16) = acc[ai][bj][m][n] * rs; }
    }
};
struct EpiF32 {
    static constexpr bool PERM = false;
    float* C; int ldc;
    __device__ __forceinline__ void operator()(const f32x4 (&acc)[2][2][4][2], const Unit& u, int wr, int wc, int fr, int fq) const {
        const int row0 = u.pm * BM + wr * 64 + fr, col0 = u.pn * BM + wc * 32 + 4 * fq;
#pragma unroll
        for (int ai = 0; ai < 2; ++ai)
#pragma unroll
            for (int m = 0; m < 4; ++m) { const size_t ro = (size_t)(row0 + ai * HALF + m * 16) * ldc + col0;
#pragma unroll
                for (int bj = 0; bj < 2; ++bj)
#pragma unroll
                    for (int n = 0; n < 2; ++n) *(f32x4*)(C + ro + bj * HALF + n * 16) = acc[ai][bj][m][n]; }
    }
};
struct EpiBf16 {
    static constexpr bool PERM = true;
    bf16_t* O; int ldc;
    __device__ __forceinline__ void operator()(const f32x4 (&acc)[2][2][4][2], const Unit& u, int wr, int wc, int fr, int fq) const {
        const int row0 = u.pm * BM + wr * 64 + fr; const int col0 = u.pn * BM + wc * 32 + 8 * fq;
#pragma unroll
        for (int ai = 0; ai < 2; ++ai)
#pragma unroll
            for (int m = 0; m < 4; ++m) { bf16_t* rowp = O + (size_t)(row0 + ai * HALF + m * 16) * ldc + col0;
#pragma unroll
                for (int bj = 0; bj < 2; ++bj) { const f32x4 v0 = acc[ai][bj][m][0], v1 = acc[ai][bj][m][1];
                    u32x4 w; w.x = cvt_pk_bf16(v0[0], v0[1]); w.y = cvt_pk_bf16(v0[2], v0[3]); w.z = cvt_pk_bf16(v1[0], v1[1]); w.w = cvt_pk_bf16(v1[2], v1[3]);
                    *(u32x4*)(rowp + bj * HALF) = w; } }
    }
};

template <class Epi, class Sched>
__device__ __forceinline__ void gemm_phase(LAS unsigned char* lds, const Gemm g, const Sched& S, const Epi& E) {
    const int tid = threadIdx.x, wid = __builtin_amdgcn_readfirstlane(tid >> 6), lane = tid & 63, wr = wid >> 2, wc = wid & 3, fr = lane & 15, fq = lane >> 4;
    const int K = g.K, nt = K / BK;
    unsigned voffA[2], voffB[2];
#pragma unroll
    for (int i = 0; i < 2; ++i) { int R, C; stage_rc(tid * 16 + i * 8192, R, C); const int Rb = Epi::PERM ? ((R & ~31) + perm32(R & 31)) : R;
        voffA[i] = (unsigned)(R * K + C) * 2u; voffB[i] = (unsigned)(Rb * K + C) * 2u; }
    const size_t kstep = (size_t)(BK * 2);
    const size_t hstep = (size_t)HALF * K * 2;
    const size_t tstep = 2 * hstep;
    const unsigned ldsw = (unsigned)wid * 1024u;
    const int aoff = lds_byte(wr * 64 + fr, fq * 8), boff = lds_byte(wc * 32 + fr, fq * 8);
#define PG8_SA(b, h) (((b) * 2 + (h)) * HTB)
#define PG8_SB(b, h) ((4 + (b) * 2 + (h)) * HTB)
#define PG8_STAGE(bufoff, gbase, voff) do { _Pragma("unroll") for (int _i = 0; _i < 2; ++_i) \
        __builtin_amdgcn_global_load_lds((const unsigned*)((const char*)(gbase) + (voff)[_i]), (LAS unsigned*)(lds + (bufoff) + ldsw + _i * 8192), 16, 0, 0); } while (0)
#define PG8_LDA(dst, b, h) do { _Pragma("unroll") for (int m = 0; m < 4; ++m) _Pragma("unroll") for (int k = 0; k < 2; ++k) dst[m][k] = *(const LAS bf16x8*)(lds + PG8_SA(b, h) + aoff + m * 2048 + k * 1024); } while (0)
#define PG8_LDB(dst, b, h) do { _Pragma("unroll") for (int n = 0; n < 2; ++n) _Pragma("unroll") for (int k = 0; k < 2; ++k) dst[n][k] = *(const LAS bf16x8*)(lds + PG8_SB(b, h) + boff + n * 2048 + k * 1024); } while (0)
#define PG8_MMA(ai, bj, At, Bt) do { __builtin_amdgcn_s_setprio(1); _Pragma("unroll") for (int m = 0; m < 4; ++m) _Pragma("unroll") for (int n = 0; n < 2; ++n) _Pragma("unroll") for (int k = 0; k < 2; ++k) \
        acc[ai][bj][m][n] = __builtin_amdgcn_mfma_f32_16x16x32_bf16(Bt[n][k], At[m][k], acc[ai][bj][m][n], 0, 0, 0); __builtin_amdgcn_s_setprio(0); } while (0)
#define PG8_WAIT_V(n) asm volatile("s_waitcnt vmcnt(" #n ")" ::: "memory")
#define PG8_WAIT_L(n) asm volatile("s_waitcnt lgkmcnt(" #n ")" ::: "memory")
#define PG8_BAR __builtin_amdgcn_s_barrier()
#define PG8_SCHED __builtin_amdgcn_sched_barrier(0)
    Unit cur, nxt; int ui = 0;
    if (!S.next(0, cur)) return;
    f32x4 acc[2][2][4][2];
#pragma unroll
    for (int a = 0; a < 2; ++a)
#pragma unroll
        for (int b = 0; b < 2; ++b)
#pragma unroll
            for (int m = 0; m < 4; ++m)
#pragma unroll
                for (int n = 0; n < 2; ++n) acc[a][b][m][n] = (f32x4){0.f, 0.f, 0.f, 0.f};
    bf16x8 At[4][2], B0[2][2], B1[2][2];
    const char* cA = (const char*)g.A + (size_t)cur.pm * tstep; const char* cB = (const char*)g.Bt + (size_t)cur.pn * tstep;
    S.a_ready(cur);
    PG8_STAGE(PG8_SB(0, 0), cB, voffB); PG8_STAGE(PG8_SA(0, 0), cA, voffA); PG8_STAGE(PG8_SB(0, 1), cB + hstep, voffB); PG8_STAGE(PG8_SA(0, 1), cA + hstep, voffA);
    if (wr == 1) PG8_BAR;
    PG8_WAIT_V(4); PG8_BAR;
    PG8_STAGE(PG8_SB(1, 0), cB + kstep, voffB); PG8_STAGE(PG8_SA(1, 0), cA + kstep, voffA); PG8_STAGE(PG8_SB(1, 1), cB + hstep + kstep, voffB);
    PG8_WAIT_V(6); PG8_BAR;
    for (;;) {
        const bool has_next = S.next(ui + 1, nxt);
        const char* nA = has_next ? (const char*)g.A + (size_t)nxt.pm * tstep : cA; const char* nB = has_next ? (const char*)g.Bt + (size_t)nxt.pn * tstep : cB;
        for (int t = 0; t < nt; t += 2) {
            const bool last = (t == nt - 2);
            const char* a1 = cA + (size_t)(t + 1) * kstep;
            const char* a2 = last ? nA : cA + (size_t)(t + 2) * kstep; const char* b2 = last ? nB : cB + (size_t)(t + 2) * kstep;
            const char* a3 = a2 + kstep; const char* b3 = b2 + kstep;
            if (last && has_next) S.a_ready(nxt);
            PG8_LDB(B0, 0, 0); PG8_SCHED; PG8_LDA(At, 0, 0); PG8_STAGE(PG8_SA(1, 1), a1 + hstep, voffA);
            PG8_WAIT_L(8); PG8_BAR; PG8_WAIT_L(0); PG8_MMA(0, 0, At, B0); PG8_BAR; PG8_SCHED;
            PG8_LDB(B1, 0, 1); PG8_STAGE(PG8_SB(0, 0), b2, voffB);
            PG8_BAR; PG8_WAIT_L(0); PG8_MMA(0, 1, At, B1); PG8_BAR;
            PG8_LDA(At, 0, 1); PG8_STAGE(PG8_SA(0, 0), a2, voffA);
            PG8_BAR; PG8_WAIT_L(0); PG8_MMA(1, 0, At, B0); PG8_BAR; PG8_SCHED;
            PG8_STAGE(PG8_SB(0, 1), b2 + hstep, voffB);
            PG8_WAIT_V(6); PG8_BAR; PG8_MMA(1, 1, At, B1); PG8_BAR;
            PG8_LDB(B0, 1, 0); PG8_SCHED; PG8_LDA(At, 1, 0); PG8_STAGE(PG8_SA(0, 1), a2 + hstep, voffA);
            PG8_WAIT_L(8); PG8_BAR; PG8_WAIT_L(0); PG8_MMA(0, 0, At, B0); PG8_BAR; PG8_SCHED;
            PG8_LDB(B1, 1, 1); PG8_STAGE(PG8_SB(1, 0), b3, voffB);
            PG8_BAR; PG8_WAIT_L(0); PG8_MMA(0, 1, At, B1); PG8_BAR;
            PG8_LDA(At, 1, 1); PG8_STAGE(PG8_SA(1, 0), a3, voffA);
            PG8_BAR; PG8_WAIT_L(0); PG8_MMA(1, 0, At, B0); PG8_BAR; PG8_SCHED;
            PG8_STAGE(PG8_SB(1, 1), b3 + hstep, voffB);
            PG8_WAIT_V(6); PG8_BAR; PG8_MMA(1, 1, At, B1); PG8_BAR;
        }
        E(acc, cur, wr, wc, fr, fq); S.done(cur);
        if (!has_next) break;
#pragma unroll
        for (int a = 0; a < 2; ++a)
#pragma unroll
            for (int b = 0; b < 2; ++b)
#pragma unroll
                for (int m = 0; m < 4; ++m)
#pragma unroll
                    for (int n = 0; n < 2; ++n) acc[a][b][m][n] = (f32x4){0.f, 0.f, 0.f, 0.f};
        cur = nxt; cA = nA; cB = nB; ++ui;
    }
    PG8_WAIT_V(0);
    if (wr == 0) PG8_BAR;
    PG8_BAR;
#undef PG8_SA
#undef PG8_SB
#undef PG8_STAGE
#undef PG8_LDA
#undef PG8_LDB
#undef PG8_MMA
#undef PG8_WAIT_V
#undef PG8_WAIT_L
#undef PG8_BAR
#undef PG8_SCHED
}
}

__device__ __forceinline__ void rmsnorm_rows(const float* X, const float* gain, bf16_t* H) {
    const int wave = threadIdx.x >> 6, lane = threadIdx.x & 63;
    for (int row = blockIdx.x * 8 + wave; row < S_; row += gridDim.x * 8) {
        const float4* xr = (const float4*)(X + (size_t)row * D_);
        float4 v[8]; float ss = 0.f;
#pragma unroll
        for (int i = 0; i < 8; ++i) { v[i] = xr[i * 64 + lane]; ss += v[i].x * v[i].x + v[i].y * v[i].y + v[i].z * v[i].z + v[i].w * v[i].w; }
        ss = wave_sum(ss);
        const float sc = rsqrtf(ss * (1.0f / 2048.0f) + 1e-6f);
#pragma unroll
        for (int i = 0; i < 8; ++i) { const float4 g = ((const float4*)gain)[i * 64 + lane];
            u32x2 w; w.x = cvt_pk_bf16(v[i].x * sc * g.x, v[i].y * sc * g.y); w.y = cvt_pk_bf16(v[i].z * sc * g.z, v[i].w * sc * g.w);
            *(u32x2*)(H + (size_t)row * D_ + (i * 64 + lane) * 4) = w; }
    }
}

__device__ __forceinline__ void transpose_convert(const float* W, int K, int N, bf16_t* Bt, float* tile, int bid, int nblk) {
    const int tid = threadIdx.x; const int tk = K / 64, tn = N / 64, nt = tk * tn;
    float4 rg[2];
#define TC_LOAD(u) do { const int _k0 = ((u) / tn) * 64, _n0 = ((u) % tn) * 64; _Pragma("unroll") for (int i = 0; i < 2; ++i) { const int idx = tid + 512 * i; \
        rg[i] = *(const float4*)(W + (size_t)(_k0 + (idx >> 4)) * N + _n0 + (idx & 15) * 4); } } while (0)
    if (bid < nt) TC_LOAD(bid);
    for (int u = bid; u < nt; u += nblk) {
        const int k0 = (u / tn) * 64, n0 = (u % tn) * 64;
        __syncthreads();
#pragma unroll
        for (int i = 0; i < 2; ++i) { const int idx = tid + 512 * i; float* q = tile + (idx >> 4) * 65 + (idx & 15) * 4; q[0] = rg[i].x; q[1] = rg[i].y; q[2] = rg[i].z; q[3] = rg[i].w; }
        __syncthreads();
        if (u + nblk < nt) TC_LOAD(u + nblk);
#pragma unroll
        for (int i = 0; i < 4; ++i) { const int nn = i * 16 + (tid >> 5), kp = (tid & 31) * 2;
            *(unsigned*)(Bt + (size_t)(n0 + nn) * K + k0 + kp) = cvt_pk_bf16(tile[kp * 65 + nn], tile[(kp + 1) * 65 + nn]); }
    }
#undef TC_LOAD
}

__device__ __forceinline__ void convert_flat(const float* src, bf16_t* dst, size_t n) {
    for (size_t i = ((size_t)blockIdx.x * 512 + threadIdx.x) * 8; i < n; i += (size_t)gridDim.x * 512 * 8) {
        const float4 a = *(const float4*)(src + i), b = *(const float4*)(src + i + 4);
        u32x4 w; w.x = cvt_pk_bf16(a.x, a.y); w.y = cvt_pk_bf16(a.z, a.w); w.z = cvt_pk_bf16(b.x, b.y); w.w = cvt_pk_bf16(b.z, b.w);
        *(u32x4*)(dst + i) = w;
    }
}

__device__ __forceinline__ void convert_fp8(const float* src, unsigned char* dst, size_t n, float sc, const float* colgain, int bid, int nblk) {
    const int lane = threadIdx.x & 63, wv = threadIdx.x >> 6;
    for (size_t base = ((size_t)bid * 8 + wv) * 1024; base < n; base += (size_t)nblk * 8 * 1024) {
        float4 a[4];
#pragma unroll
        for (int j = 0; j < 4; ++j) a[j] = *(const float4*)(src + base + (size_t)(j * 64 + lane) * 4);
#pragma unroll
        for (int j = 0; j < 4; ++j) { float4 gg = make_float4(sc, sc, sc, sc);
            if (colgain) { const float4 cgv = *(const float4*)(colgain + ((base + (size_t)(j * 64 + lane) * 4) & 2047)); gg.x *= cgv.x; gg.y *= cgv.y; gg.z *= cgv.z; gg.w *= cgv.w; }
            int x = __builtin_amdgcn_cvt_pk_fp8_f32(a[j].x * gg.x, a[j].y * gg.y, 0, false); x = __builtin_amdgcn_cvt_pk_fp8_f32(a[j].z * gg.z, a[j].w * gg.w, x, true);
            *(unsigned*)(dst + base + (size_t)(j * 64 + lane) * 4) = (unsigned)x; }
    }
}

constexpr int ROW6 = 1536;
constexpr float U6_SCALE = 56.f, V6_SCALE = 28.f;
__device__ __forceinline__ void convert_fp6(const float* src, unsigned char* dst, int nrows, float sc, const float* colgain, int bid, int nblk) {
    const int lane = threadIdx.x & 63, wv = threadIdx.x >> 6;
    float g[32];
#pragma unroll
    for (int j = 0; j < 8; ++j) { float4 cg = make_float4(1.f, 1.f, 1.f, 1.f); if (colgain) cg = *(const float4*)(colgain + (j * 64 + lane) * 4);
        g[j * 4] = sc * cg.x; g[j * 4 + 1] = sc * cg.y; g[j * 4 + 2] = sc * cg.z; g[j * 4 + 3] = sc * cg.w; }
    for (int row = bid * 8 + wv; row < nrows; row += nblk * 8) {
        f32x32 x;
#pragma unroll
        for (int j = 0; j < 8; ++j) { const f32x4 a = __builtin_nontemporal_load((const f32x4*)(src + (size_t)row * 2048 + (j * 64 + lane) * 4));
            x[j * 4] = a[0] * g[j * 4]; x[j * 4 + 1] = a[1] * g[j * 4 + 1]; x[j * 4 + 2] = a[2] * g[j * 4 + 2]; x[j * 4 + 3] = a[3] * g[j * 4 + 3]; }
        const bf16x32_t b = __builtin_convertvector(x, bf16x32_t);
        const u32x6 wv6 = __builtin_amdgcn_cvt_scalef32_pk32_fp6_bf16(b, 1.0f);
        *(u32x4*)(dst + (size_t)row * ROW6 + lane * 16) = (u32x4){wv6[0], wv6[1], wv6[2], wv6[3]};
        *(u32x2*)(dst + (size_t)row * ROW6 + 1024 + lane * 8) = (u32x2){wv6[4], wv6[5]};
    }
}

__device__ __forceinline__ void convert_fp6s(const float* src, unsigned char* dst, int nrows, float sc, const float* colgain, int bid, int nblk) {
    const int lane = threadIdx.x & 63, wv = threadIdx.x >> 6, x = lane >> 3, pt = lane & 7;
    float g[32];
#pragma unroll
    for (int j = 0; j < 8; ++j) { float4 cg = make_float4(1.f, 1.f, 1.f, 1.f); if (colgain) cg = *(const float4*)(colgain + x * 256 + (j * 8 + pt) * 4);
        g[j * 4] = sc * cg.x; g[j * 4 + 1] = sc * cg.y; g[j * 4 + 2] = sc * cg.z; g[j * 4 + 3] = sc * cg.w; }
    for (int row = bid * 8 + wv; row < nrows; row += nblk * 8) {
        f32x32 v;
#pragma unroll
        for (int j = 0; j < 8; ++j) { const f32x4 a = __builtin_nontemporal_load((const f32x4*)(src + (size_t)row * 2048 + x * 256 + (j * 8 + pt) * 4));
            v[j * 4] = a[0] * g[j * 4]; v[j * 4 + 1] = a[1] * g[j * 4 + 1]; v[j * 4 + 2] = a[2] * g[j * 4 + 2]; v[j * 4 + 3] = a[3] * g[j * 4 + 3]; }
        const bf16x32_t b = __builtin_convertvector(v, bf16x32_t);
        const u32x6 w6 = __builtin_amdgcn_cvt_scalef32_pk32_fp6_bf16(b, 1.0f);
        unsigned char* q = dst + ((size_t)x * 16384 + row) * 192 + pt * 24;
        *(u32x2*)q = (u32x2){w6[0], w6[1]}; *(u32x2*)(q + 8) = (u32x2){w6[2], w6[3]}; *(u32x2*)(q + 16) = (u32x2){w6[4], w6[5]};
    }
}

__device__ __forceinline__ void build_wpt(const float* wq, const float* gain, const bf16_t* KEYB, bf16_t* WPT, int bid, int nblk) {
    const int w = threadIdx.x >> 6, lane = threadIdx.x & 63, fr = lane & 15, fq = lane >> 4;
    for (int task = bid * 8 + w; task < 16 * 128; task += nblk * 8) {
        const int g = task >> 7, kb = task & 127;
        f32x4 acc[8];
#pragma unroll
        for (int n = 0; n < 8; ++n) acc[n] = (f32x4){0.f, 0.f, 0.f, 0.f};
#pragma unroll 2
        for (int ks = 0; ks < 8; ++ks) {
            const float4* wp = (const float4*)(wq + (size_t)(kb * 16 + fr) * 4096 + g * 256 + ks * 32 + fq * 8);
            const float4 x0 = wp[0], x1 = wp[1]; const float gk = gain[kb * 16 + fr];
            u32x4 wv; wv.x = cvt_pk_bf16(x0.x * gk, x0.y * gk); wv.y = cvt_pk_bf16(x0.z * gk, x0.w * gk); wv.z = cvt_pk_bf16(x1.x * gk, x1.y * gk); wv.w = cvt_pk_bf16(x1.z * gk, x1.w * gk);
            const bf16x8 a = __builtin_bit_cast(bf16x8, wv);
#pragma unroll
            for (int n = 0; n < 8; ++n) {
                const bf16x8 b = *(const bf16x8*)(KEYB + (size_t)(g * 128 + n * 16 + fr) * 256 + ks * 32 + fq * 8);
                acc[n] = __builtin_amdgcn_mfma_f32_16x16x32_bf16(a, b, acc[n], 0, 0, 0);
            }
        }
#pragma unroll
        for (int n = 0; n < 8; ++n) { u32x2 o; o.x = cvt_pk_bf16(acc[n][0], acc[n][1]); o.y = cvt_pk_bf16(acc[n][2], acc[n][3]);
            *(u32x2*)(WPT + (size_t)(g * 128 + n * 16 + fr) * 2048 + kb * 16 + fq * 4) = o; }
    }
}

__device__ __forceinline__ void phase0(const Params& p, unsigned char* shm) {
    bf16_t* WB1 = (bf16_t*)(p.ws + WS_WB1);
    rmsnorm_rows(p.in[0], p.in[1], (bf16_t*)(p.ws + WS_H));
    transpose_convert(p.in[2], 2048, 6144, WB1, (float*)shm, blockIdx.x, gridDim.x);
    const float* mu = p.in[4]; const float* w1 = p.in[6]; const float* a1 = p.in[9]; const float* g1 = p.in[11];
    for (int idx = blockIdx.x * 512 + threadIdx.x; idx < 768 * 2048; idx += gridDim.x * 512) {
        const int j = idx >> 11, k = idx & 2047; float val = 0.f;
        if (j < 128) { const float m = mu[k], w = w1[k * 64 + (j & 63)]; val = (j < 64) ? w * (1.f - m) : w * m; }
        else if (j < 256) { const float m = mu[2048 + k], w = a1[k * 64 + (j & 63)]; val = (j < 192) ? w * (1.f - m) : w * m; }
        else if (j < 576) { const float m = mu[4096 + k]; const int jj = j - 256; const int c = jj < 160 ? jj : jj - 160; const float w = g1[k * 160 + c]; val = jj < 160 ? w * (1.f - m) : w * m; }
        WB1[(size_t)(6144 + j) * 2048 + k] = f2bf(val);
    }
    convert_flat(p.in[22], (bf16_t*)(p.ws + WS_KEYB), (size_t)8 * 2 * 128 * 256);
    bf16_t* W2T = (bf16_t*)(p.ws + WS_W2T); bf16_t* A2T = (bf16_t*)(p.ws + WS_A2T); bf16_t* G2T = (bf16_t*)(p.ws + WS_G2T);
    const float* w2 = p.in[7]; const float* a2 = p.in[10]; const float* g2 = p.in[12];
    for (int idx = blockIdx.x * 512 + threadIdx.x; idx < 1024 * 288; idx += gridDim.x * 512) {
        if (idx < 65536) { const int c = idx >> 6, j = idx & 63; W2T[idx] = f2bf(w2[j * 1024 + c]); }
        else if (idx < 131072) { const int i2 = idx - 65536; const int c = i2 >> 6, j = i2 & 63; A2T[i2] = f2bf(a2[j * 1024 + c]); }
        else { const int i2 = idx - 131072; const int c = i2 / 160, j = i2 % 160; G2T[i2] = f2bf(g2[j * 1024 + c]); }
    }
}

constexpr int ACT_LD = 296;
template <int KS, int KOFF, int KTOT, int KIND>
__device__ __forceinline__ void lora_stage(const LAS bf16_t* act, const bf16_t* WT, const float* bias, bf16_t* OUT, int t0, int w, int fr, int fq) {
#pragma unroll 1
    for (int nh = 0; nh < 2; ++nh) {
        f32x4 acc[4][4];
#pragma unroll
        for (int m = 0; m < 4; ++m)
#pragma unroll
            for (int n = 0; n < 4; ++n) acc[m][n] = (f32x4){0.f, 0.f, 0.f, 0.f};
        bf16x8 bfr[KS][4];
#pragma unroll
        for (int ks = 0; ks < KS; ++ks)
#pragma unroll
            for (int n = 0; n < 4; ++n) bfr[ks][n] = *(const bf16x8*)(WT + (size_t)(w * 128 + (nh * 4 + n) * 16 + fr) * KTOT + ks * 32 + fq * 8);
#pragma unroll
        for (int ks = 0; ks < KS; ++ks) {
            bf16x8 a[4];
#pragma unroll
            for (int m = 0; m < 4; ++m) a[m] = *(const LAS bf16x8*)(act + (m * 16 + fr) * ACT_LD + KOFF + ks * 32 + fq * 8);
#pragma unroll
            for (int n = 0; n < 4; ++n)
#pragma unroll
                for (int m = 0; m < 4; ++m) acc[m][n] = __builtin_amdgcn_mfma_f32_16x16x32_bf16(bfr[ks][n], a[m], acc[m][n], 0, 0, 0);
        }
#pragma unroll
        for (int n = 0; n < 4; ++n) {
            const int c = w * 128 + (nh * 4 + n) * 16 + fq * 4;
            float bs[4] = {0.f, 0.f, 0.f, 0.f};
            if (KIND < 2) { const float4 bv = *(const float4*)(bias + c); bs[0] = bv.x; bs[1] = bv.y; bs[2] = bv.z; bs[3] = bv.w; }
#pragma unroll
            for (int m = 0; m < 4; ++m) {
                float o[4];
#pragma unroll
                for (int j = 0; j < 4; ++j) {
                    const float val = acc[m][n][j];
                    if (KIND == 0) { const float x = -(bs[j] + val); const float sp = fmaxf(x, 0.f) + __logf(1.f + __expf(-fabsf(x))); o[j] = -__expf(-sp - 0.5f); }
                    else if (KIND == 1) o[j] = sigmoidf_(bs[j] + val);
                    else o[j] = val;
                }
                u32x2 wv; wv.x = cvt_pk_bf16(o[0], o[1]); wv.y = cvt_pk_bf16(o[2], o[3]);
                *(u32x2*)(OUT + (size_t)(t0 + m * 16 + fr) * DR + c) = wv;
            }
        }
    }
}
__device__ __forceinline__ void phase_prepM(const Params& p, LAS unsigned char* lds) {
    LAS bf16_t* act = (LAS bf16_t*)lds;
    const bf16_t* P = (const bf16_t*)(p.ws + WS_PROJ);
    const int tid = threadIdx.x, w = tid >> 6, lane = tid & 63, fr = lane & 15, fq = lane >> 4;
    for (int tile = blockIdx.x; tile < S_ / 64; tile += gridDim.x) {
        const int t0 = tile * 64;
        __syncthreads();
        for (int task = tid; task < 64 * 36; task += 512) {
            const int t = task / 36, j0 = (task % 36) * 8; const int tg = t0 + t;
            int ccur, cprev;
            if (j0 < 64) { ccur = 6144 + j0; cprev = 6208 + j0; }
            else if (j0 < 128) { ccur = 6272 + (j0 - 64); cprev = 6336 + (j0 - 64); }
            else { ccur = 6400 + (j0 - 128); cprev = 6560 + (j0 - 128); }
            float cu[8], pv[8], o8[8];
            unpack8(*(const u32x4*)(P + (size_t)tg * NAUG + ccur), cu);
            if (tg > 0) unpack8(*(const u32x4*)(P + (size_t)(tg - 1) * NAUG + cprev), pv);
            else {
#pragma unroll
                for (int i = 0; i < 8; ++i) pv[i] = 0.f;
            }
#pragma unroll
            for (int i = 0; i < 8; ++i) { const float sv = cu[i] + pv[i];
                o8[i] = j0 < 64 ? (1.f - 2.f / (1.f + __expf(2.f * sv))) : (j0 < 128 ? sv : sigmoidf_(sv)); }
            *(LAS u32x4*)(act + t * ACT_LD + j0) = pack8(o8);
        }
        __syncthreads();
        lora_stage<2, 0, 64, 0>(act, (const bf16_t*)(p.ws + WS_W2T), p.in[5], (bf16_t*)(p.ws + WS_LW), t0, w, fr, fq);
        lora_stage<2, 64, 64, 1>(act, (const bf16_t*)(p.ws + WS_A2T), p.in[8], (bf16_t*)(p.ws + WS_A), t0, w, fr, fq);
        lora_stage<5, 128, 160, 2>(act, (const bf16_t*)(p.ws + WS_G2T), nullptr, (bf16_t*)(p.ws + WS_G), t0, w, fr, fq);
    }
}

__device__ __forceinline__ void phase_prepE(const Params& p) {
    const bf16_t* P = (const bf16_t*)(p.ws + WS_PROJ);
    bf16_t* R = (bf16_t*)(p.ws + WS_R); bf16_t* Kk = (bf16_t*)(p.ws + WS_K); bf16_t* V = (bf16_t*)(p.ws + WS_V); bf16_t* KK = (bf16_t*)(p.ws + WS_KK); bf16_t* YC = (bf16_t*)(p.ws + WS_YC);
    const float* mu_rkv = p.in[3]; const float* k_k = p.in[13]; const float* cw = p.in[18];
    const int tid = threadIdx.x, cg = tid & 127, c0 = cg * 8, tgrp = tid >> 7;
    float mr[8], mk[8], mv[8], kkc[8], cw0[8], cw1[8], cw2[8];
#pragma unroll
    for (int i = 0; i < 8; ++i) { mr[i] = mu_rkv[c0 + i]; mk[i] = mu_rkv[1024 + c0 + i]; mv[i] = mu_rkv[2048 + c0 + i]; kkc[i] = k_k[c0 + i]; cw0[i] = cw[c0 + i]; cw1[i] = cw[1024 + c0 + i]; cw2[i] = cw[2048 + c0 + i]; }
    for (int run = blockIdx.x * 4 + tgrp; run < S_ / 16; run += gridDim.x * 4) {
        const int t0 = run * 16;
        float pr[8], pk[8], pv[8], u1[8], u2[8];
#pragma unroll
        for (int i = 0; i < 8; ++i) { pr[i] = 0.f; pk[i] = 0.f; pv[i] = 0.f; u1[i] = 0.f; u2[i] = 0.f; }
        if (t0 > 0) {
            const size_t o = (size_t)(t0 - 1) * NAUG + c0;
            unpack8(*(const u32x4*)(P + o), pr); unpack8(*(const u32x4*)(P + o + 1024), pk); unpack8(*(const u32x4*)(P + o + 2048), pv);
            float x[8], y[8];
            unpack8(*(const u32x4*)(P + o + 4096), x); unpack8(*(const u32x4*)(P + o + 5120), y);
#pragma unroll
            for (int i = 0; i < 8; ++i) u1[i] = x[i] * y[i];
            unpack8(*(const u32x4*)(P + o - NAUG + 4096), x); unpack8(*(const u32x4*)(P + o - NAUG + 5120), y);
#pragma unroll
            for (int i = 0; i < 8; ++i) u2[i] = x[i] * y[i];
        }
        u32x4 nx[6];
        { const size_t o = (size_t)t0 * NAUG + c0;
#pragma unroll
          for (int q = 0; q < 6; ++q) nx[q] = *(const u32x4*)(P + o + 1024 * q); }
#pragma unroll 1
        for (int t = 0; t < 16; ++t) {
            float cr[8], ck[8], cv[8], bg[8], cgt[8], xc[8];
            unpack8(nx[0], cr); unpack8(nx[1], ck); unpack8(nx[2], cv); unpack8(nx[3], bg); unpack8(nx[4], cgt); unpack8(nx[5], xc);
            { const size_t o = (size_t)(t0 + (t < 15 ? t + 1 : t)) * NAUG + c0;
#pragma unroll
              for (int q = 0; q < 6; ++q) nx[q] = *(const u32x4*)(P + o + 1024 * q); }
            float r[8], k[8], v[8], kkv[8], yc[8]; float ss = 0.f;
#pragma unroll
            for (int i = 0; i < 8; ++i) {
                r[i] = cr[i] + (pr[i] - cr[i]) * mr[i]; k[i] = ck[i] + (pk[i] - ck[i]) * mk[i]; v[i] = cv[i] + (pv[i] - cv[i]) * mv[i];
                pr[i] = cr[i]; pk[i] = ck[i]; pv[i] = cv[i];
                kkv[i] = k[i] * kkc[i]; ss += kkv[i] * kkv[i];
                const float u0 = cgt[i] * xc[i];
                yc[i] = bg[i] * (cw0[i] * u2[i] + cw1[i] * u1[i] + cw2[i] * u0);
                u2[i] = u1[i]; u1[i] = u0;
            }
            ss += dpp_f<0xB1, 0xf>(ss); ss += dpp_f<0x4E, 0xf>(ss); ss += dpp_f<0x141, 0xf>(ss);
            const float inv = 1.0f / fmaxf(sqrtf(ss), 1e-12f);
#pragma unroll
            for (int i = 0; i < 8; ++i) kkv[i] *= inv;
            const size_t oo = (size_t)(t0 + t) * DR + c0;
            *(u32x4*)(R + oo) = pack8(r); *(u32x4*)(Kk + oo) = pack8(k); *(u32x4*)(V + oo) = pack8(v); *(u32x4*)(KK + oo) = pack8(kkv); *(u32x4*)(YC + oo) = pack8(yc);
        }
    }
}

#define TILE(i) ((LAS bf16_t*)(lds + (i) * TSLOT))
__device__ __forceinline__ f32x4 mm_tile(f32x4 acc, const LAS bf16_t* A, const LAS bf16_t* Bt, int mi, int ni, int fr, int fq) {
#pragma unroll
    for (int ks = 0; ks < 2; ++ks) {
        const bf16x8 a = *(const LAS bf16x8*)(A + (mi * 16 + fr) * TLD + ks * 32 + fq * 8);
        const bf16x8 b = *(const LAS bf16x8*)(Bt + (ni * 16 + fr) * TLD + ks * 32 + fq * 8);
        acc = __builtin_amdgcn_mfma_f32_16x16x32_bf16(a, b, acc, 0, 0, 0);
    }
    return acc;
}
__device__ __forceinline__ void st_rm(LAS bf16_t* X, f32x4 v, int mi, int ni, int fr, int fq) {
    const unsigned w0 = cvt_pk_bf16(v[0], v[1]), w1 = cvt_pk_bf16(v[2], v[3]);
    LAS bf16_t* q = X + (mi * 16 + fq * 4) * TLD + ni * 16 + fr;
    q[0] = (bf16_t)(w0 & 0xffffu); q[TLD] = (bf16_t)(w0 >> 16); q[2 * TLD] = (bf16_t)(w1 & 0xffffu); q[3 * TLD] = (bf16_t)(w1 >> 16);
}
__device__ __forceinline__ void st_tr(LAS bf16_t* XT, f32x4 v, int mi, int ni, int fr, int fq) {
    u32x2 w; w.x = cvt_pk_bf16(v[0], v[1]); w.y = cvt_pk_bf16(v[2], v[3]);
    *(LAS u32x2*)(XT + (ni * 16 + fr) * TLD + mi * 16 + fq * 4) = w;
}
__device__ __forceinline__ f32x4 ld_rm(const LAS bf16_t* X, int mi, int ni, int fr, int fq) {
    const LAS bf16_t* q = X + (mi * 16 + fq * 4) * TLD + ni * 16 + fr;
    return (f32x4){bf2f(q[0]), bf2f(q[TLD]), bf2f(q[2 * TLD]), bf2f(q[3 * TLD])};
}
__device__ __forceinline__ f32x4 ld_tr(const LAS bf16_t* XT, int mi, int ni, int fr, int fq) {
    const u32x2 w = *(const LAS u32x2*)(XT + (ni * 16 + fr) * TLD + mi * 16 + fq * 4);
    return (f32x4){lo_bf(w.x), hi_bf(w.x), lo_bf(w.y), hi_bf(w.y)};
}

__device__ __forceinline__ void phase_chunkA(const Params& p, LAS unsigned char* lds) {
    const int tid = threadIdx.x, w = tid >> 6, lane = tid & 63, fr = lane & 15, fq = lane >> 4;
    const int mi = w >> 1, nb = (w & 1) * 2;
    LAS float* cl = (LAS float*)(lds + 14 * TSLOT);
    LAS float* gs = (LAS float*)(lds + 16 * TSLOT);
    LAS float* wc = gs + 512;
    const bf16_t* R = (const bf16_t*)(p.ws + WS_R); const bf16_t* Kk = (const bf16_t*)(p.ws + WS_K); const bf16_t* V = (const bf16_t*)(p.ws + WS_V);
    const bf16_t* KK = (const bf16_t*)(p.ws + WS_KK); const bf16_t* A = (const bf16_t*)(p.ws + WS_A); const bf16_t* LW = (const bf16_t*)(p.ws + WS_LW);
    bf16_t* GT = (bf16_t*)(p.ws + WS_GT); float* HT = (float*)(p.ws + WS_HT); bf16_t* QE = (bf16_t*)(p.ws + WS_QE); bf16_t* YL = (bf16_t*)(p.ws + WS_YL);
    const f32x4 z4 = (f32x4){0.f, 0.f, 0.f, 0.f};
    const float* k_a = p.in[14]; const float* r_k = p.in[15]; float* BON = (float*)(p.ws + WS_BON);
    u32x4 nr4, nk4, nv4, nkk4, na4, nlw4;
#define CA_LOAD(it) do { const size_t _go = (size_t)(((it) >> 4) * 64 + (tid >> 3)) * DR + ((it) & 15) * 64 + (tid & 7) * 8; \
        nr4 = *(const u32x4*)(R + _go); nk4 = *(const u32x4*)(Kk + _go); nv4 = *(const u32x4*)(V + _go); nkk4 = *(const u32x4*)(KK + _go); na4 = *(const u32x4*)(A + _go); nlw4 = *(const u32x4*)(LW + _go); } while (0)
    for (int item = blockIdx.x; item < 4096; item += gridDim.x) {
        const int c = item >> 4, h = item & 15;
        const int t = tid >> 3, k0 = (tid & 7) * 8;
        if (item == (int)blockIdx.x) CA_LOAD(item);
        const u32x4 r4 = nr4, k4 = nk4, v4 = nv4, kk4 = nkk4, a4 = na4, lw4 = nlw4;
        __syncthreads();
        {
            float lwf8[8]; unpack8(lw4, lwf8);
            *(LAS f32x4*)(cl + t * 64 + k0) = (f32x4){lwf8[0], lwf8[1], lwf8[2], lwf8[3]};
            *(LAS f32x4*)(cl + t * 64 + k0 + 4) = (f32x4){lwf8[4], lwf8[5], lwf8[6], lwf8[7]};
            __syncthreads();
            const int g = w, k = lane;
            float pfx[8]; float run = 0.f;
#pragma unroll
            for (int i = 0; i < 8; ++i) { run += cl[(g * 8 + i) * 64 + k]; pfx[i] = run; }
            gs[g * 64 + k] = run;
            __syncthreads();
            float off = 0.f;
#pragma unroll
            for (int gg = 0; gg < 7; ++gg) { const float x = gs[gg * 64 + k]; off += (gg < g) ? x : 0.f; }
#pragma unroll
            for (int i = 0; i < 8; ++i) cl[(g * 8 + i) * 64 + k] = off + pfx[i];
            if (g == 7) wc[k] = __expf(off + pfx[7]);
            __syncthreads();
        }
        if (item + (int)gridDim.x < 4096) CA_LOAD(item + (int)gridDim.x);
        {
            float at[8], rt[8], bt[8], kt[8], bh[8], kh[8], vv[8]; float bsum = 0.f;
#pragma unroll
            for (int i = 0; i < 8; ++i) {
                const int q = i >> 1; const bool hi = i & 1;
                const float rf = hi ? hi_bf(r4[q]) : lo_bf(r4[q]), kraw = hi ? hi_bf(k4[q]) : lo_bf(k4[q]), vf = hi ? hi_bf(v4[q]) : lo_bf(v4[q]);
                const float kkf = hi ? hi_bf(kk4[q]) : lo_bf(kk4[q]), af = hi ? hi_bf(a4[q]) : lo_bf(a4[q]), lwf = hi ? hi_bf(lw4[q]) : lo_bf(lw4[q]);
                const float kf = kraw * (1.f + (af - 1.f) * k_a[h * 64 + k0 + i]);
                bsum += rf * kf * r_k[h * 64 + k0 + i];
                const float clv = cl[t * 64 + k0 + i], cle = cl[63 * 64 + k0 + i];
                const float e = __expf(clv), ex = __expf(clv - lwf), ei = __expf(-clv), eh = __expf(cle - clv);
                const float bb = kkf * af;
                at[i] = -kkf * ex; rt[i] = rf * e; bt[i] = bb * ei; kt[i] = kf * ei; bh[i] = bb * eh; kh[i] = kf * eh; vv[i] = vf;
            }
            bsum += dpp_f<0xB1, 0xf>(bsum); bsum += dpp_f<0x4E, 0xf>(bsum); bsum += dpp_f<0x141, 0xf>(bsum);
            if ((tid & 7) == 0) BON[(size_t)(c * 64 + t) * 16 + h] = bsum;
            *(LAS u32x4*)(TILE(0) + t * TLD + k0) = pack8(at);
            *(LAS u32x4*)(TILE(2) + t * TLD + k0) = pack8(rt);
            *(LAS u32x4*)(TILE(3) + t * TLD + k0) = pack8(bt);
            *(LAS u32x4*)(TILE(4) + t * TLD + k0) = pack8(kt);
            const u32x4 atp = pack8(at), bhp = pack8(bh), khp = pack8(kh);
#pragma unroll
            for (int i = 0; i < 8; ++i) {
                const int q = i >> 1; const bool hi = i & 1;
                TILE(1)[(k0 + i) * TLD + t] = (bf16_t)(hi ? (atp[q] >> 16) : (atp[q] & 0xffffu));
                TILE(5)[(k0 + i) * TLD + t] = (bf16_t)(hi ? (bhp[q] >> 16) : (bhp[q] & 0xffffu));
                TILE(6)[(k0 + i) * TLD + t] = (bf16_t)(hi ? (khp[q] >> 16) : (khp[q] & 0xffffu));
                TILE(7)[(k0 + i) * TLD + t] = (bf16_t)(hi ? (v4[q] >> 16) : (v4[q] & 0xffffu));
            }
            __syncthreads();
        }
#pragma unroll
        for (int nn = 0; nn < 2; ++nn) {
            const int ni = nb + nn; const int col = ni * 16 + fr, row0 = mi * 16 + fq * 4;
            f32x4 x = mm_tile(z4, TILE(0), TILE(3), mi, ni, fr, fq);
#pragma unroll
            for (int j = 0; j < 4; ++j) x[j] = (col < row0 + j) ? x[j] : 0.f;
            st_rm(TILE(8), x, mi, ni, fr, fq); st_tr(TILE(9), x, mi, ni, fr, fq);
            x = mm_tile(z4, TILE(0), TILE(4), mi, ni, fr, fq);
#pragma unroll
            for (int j = 0; j < 4; ++j) x[j] = (col < row0 + j) ? x[j] : 0.f;
            st_rm(TILE(10), x, mi, ni, fr, fq);
            x = mm_tile(z4, TILE(2), TILE(3), mi, ni, fr, fq);
#pragma unroll
            for (int j = 0; j < 4; ++j) x[j] = (col <= row0 + j) ? x[j] : 0.f;
            st_rm(TILE(11), x, mi, ni, fr, fq);
            x = mm_tile(z4, TILE(2), TILE(4), mi, ni, fr, fq);
#pragma unroll
            for (int j = 0; j < 4; ++j) x[j] = (col <= row0 + j) ? x[j] : 0.f;
            st_rm(TILE(12), x, mi, ni, fr, fq);
        }
        __syncthreads();
#pragma unroll
        for (int nn = 0; nn < 2; ++nn) {
            const int ni = nb + nn;
            st_tr(TILE(13), mm_tile(z4, TILE(10), TILE(7), mi, ni, fr, fq), mi, ni, fr, fq);
            const f32x4 x = mm_tile(z4, TILE(8), TILE(9), mi, ni, fr, fq);
            st_rm(TILE(0), x, mi, ni, fr, fq); st_tr(TILE(3), x, mi, ni, fr, fq);
        }
        __syncthreads();
#pragma unroll
        for (int rd = 0; rd < 5; ++rd) {
            const int tq = (rd & 1) ? 14 : 8, tqo = (rd & 1) ? 8 : 14;
            const int lx = (rd & 1) ? 4 : 0, lxt = (rd & 1) ? 9 : 3, lxo = (rd & 1) ? 0 : 4, lxto = (rd & 1) ? 3 : 9;
#pragma unroll
            for (int nn = 0; nn < 2; ++nn) {
                const int ni = nb + nn;
                f32x4 x = ld_rm(TILE(tq), mi, ni, fr, fq) + ld_rm(TILE(lx), mi, ni, fr, fq);
                x = mm_tile(x, TILE(tq), TILE(lxt), mi, ni, fr, fq);
                st_rm(TILE(tqo), x, mi, ni, fr, fq);
                if (rd < 4) { const f32x4 y = mm_tile(z4, TILE(lx), TILE(lxt), mi, ni, fr, fq); st_rm(TILE(lxo), y, mi, ni, fr, fq); st_tr(TILE(lxto), y, mi, ni, fr, fq); }
            }
            __syncthreads();
        }
#pragma unroll
        for (int nn = 0; nn < 2; ++nn) {
            const int ni = nb + nn;
            st_tr(TILE(10), mm_tile(ld_tr(TILE(1), mi, ni, fr, fq), TILE(14), TILE(1), mi, ni, fr, fq), mi, ni, fr, fq);
            st_tr(TILE(15), mm_tile(ld_tr(TILE(13), mi, ni, fr, fq), TILE(14), TILE(13), mi, ni, fr, fq), mi, ni, fr, fq);
        }
        __syncthreads();
#pragma unroll
        for (int nn = 0; nn < 2; ++nn) {
            const int ni = nb + nn;
            {
                f32x4 x = mm_tile(z4, TILE(5), TILE(10), mi, ni, fr, fq);
                if (mi == ni) {
#pragma unroll
                    for (int j = 0; j < 4; ++j) x[j] += (fq * 4 + j == fr) ? wc[ni * 16 + fr] : 0.f;
                }
                const unsigned w0 = cvt_pk_bf16(x[0], x[1]), w1 = cvt_pk_bf16(x[2], x[3]);
                bf16_t* gp = GT + (size_t)item * 4096 + (size_t)((mi * 2 + (ni >> 1)) * 64 + (fr >> 2) * 16 + fq * 4) * 8 + (ni & 1) * 4 + (fr & 3);
                gp[0] = (bf16_t)(w0 & 0xffffu); gp[8] = (bf16_t)(w0 >> 16); gp[16] = (bf16_t)(w1 & 0xffffu); gp[24] = (bf16_t)(w1 >> 16);
            }
            {
                f32x4 x = mm_tile(z4, TILE(5), TILE(15), mi, ni, fr, fq);
                x = mm_tile(x, TILE(6), TILE(7), mi, ni, fr, fq);
                *(f32x4*)(HT + (size_t)item * 4096 + (size_t)((ni * 4 + mi) * 64 + lane) * 4) = x;
            }
            {
                f32x4 x = ld_tr(TILE(2), mi, ni, fr, fq);
                x = mm_tile(x, TILE(10), TILE(11), mi, ni, fr, fq);
                u32x2 wv; wv.x = cvt_pk_bf16(x[0], x[1]); wv.y = cvt_pk_bf16(x[2], x[3]);
                *(u32x2*)(QE + (size_t)item * 4096 + (ni * 16 + fr) * 64 + mi * 16 + fq * 4) = wv;
            }
            {
                f32x4 x = mm_tile(z4, TILE(11), TILE(15), mi, ni, fr, fq);
                x = mm_tile(x, TILE(12), TILE(7), mi, ni, fr, fq);
                u32x2 wv; wv.x = cvt_pk_bf16(x[0], x[1]); wv.y = cvt_pk_bf16(x[2], x[3]);
                *(u32x2*)(YL + (size_t)item * 4096 + (size_t)((mi * 4 + ni) * 64 + lane) * 4) = wv;
            }
        }
    }
}

__device__ __forceinline__ void phase_seq(const Params& p) {
    if (threadIdx.x >= 64) return;
    const int head = blockIdx.x >> 2, vt = blockIdx.x & 3, lane = threadIdx.x, fr = lane & 15, fq = lane >> 4;
    const bf16_t* GT = (const bf16_t*)(p.ws + WS_GT); const float* HT = (const float*)(p.ws + WS_HT); bf16_t* S0 = (bf16_t*)(p.ws + WS_S0);
    f32x4 acc[4];
#pragma unroll
    for (int mb = 0; mb < 4; ++mb) acc[mb] = (f32x4){0.f, 0.f, 0.f, 0.f};
    bf16x8 ga[4][4][2]; f32x4 hh[4][4];
#define SEQ_LOAD(buf, cc) do { const size_t _it = (size_t)((cc) < 256 ? (cc) : 255) * 16 + head; \
        _Pragma("unroll") for (int mb = 0; mb < 4; ++mb) { \
            _Pragma("unroll") for (int ks = 0; ks < 2; ++ks) ga[buf][mb][ks] = *(const bf16x8*)(GT + _it * 4096 + (size_t)((mb * 2 + ks) * 64 + lane) * 8); \
            hh[buf][mb] = *(const f32x4*)(HT + _it * 4096 + (size_t)((vt * 4 + mb) * 64 + lane) * 4); } } while (0)
    SEQ_LOAD(0, 0); SEQ_LOAD(1, 1); SEQ_LOAD(2, 2); SEQ_LOAD(3, 3);
    for (int c0 = 0; c0 < 256; c0 += 4) {
#pragma unroll
        for (int b = 0; b < 4; ++b) {
            const int c = c0 + b; const size_t item = (size_t)c * 16 + head;
            u32x2 pk[4];
#pragma unroll
            for (int mb = 0; mb < 4; ++mb) { pk[mb].x = cvt_pk_bf16(acc[mb][0], acc[mb][1]); pk[mb].y = cvt_pk_bf16(acc[mb][2], acc[mb][3]);
                *(u32x2*)(S0 + item * 4096 + (vt * 16 + fr) * 64 + mb * 16 + fq * 4) = pk[mb]; }
            u32x4 b0w, b1w; b0w.x = pk[0].x; b0w.y = pk[0].y; b0w.z = pk[1].x; b0w.w = pk[1].y; b1w.x = pk[2].x; b1w.y = pk[2].y; b1w.z = pk[3].x; b1w.w = pk[3].y;
            const bf16x8 b0 = __builtin_bit_cast(bf16x8, b0w), b1 = __builtin_bit_cast(bf16x8, b1w);
#pragma unroll
            for (int mb = 0; mb < 4; ++mb) {
                const f32x4 x = __builtin_amdgcn_mfma_f32_16x16x32_bf16(ga[b][mb][0], b0, hh[b][mb], 0, 0, 0);
                acc[mb] = __builtin_amdgcn_mfma_f32_16x16x32_bf16(ga[b][mb][1], b1, x, 0, 0, 0);
            }
            SEQ_LOAD(b, c + 4);
        }
    }
#undef SEQ_LOAD
}

__device__ __forceinline__ void phase_chunkY(const Params& p, LAS unsigned char* lds) {
    LAS float* Yb = (LAS float*)lds;
    const int tid = threadIdx.x, w = tid >> 6, lane = tid & 63, fr = lane & 15, fq = lane >> 4;
    const int mi = w >> 1, nb = (w & 1) * 2;
    const bf16_t* R = (const bf16_t*)(p.ws + WS_R); const bf16_t* Kk = (const bf16_t*)(p.ws + WS_K); const bf16_t* V = (const bf16_t*)(p.ws + WS_V);
    const bf16_t* G = (const bf16_t*)(p.ws + WS_G); const bf16_t* YC = (const bf16_t*)(p.ws + WS_YC);
    const bf16_t* QE = (const bf16_t*)(p.ws + WS_QE); const bf16_t* YL = (const bf16_t*)(p.ws + WS_YL); const bf16_t* S0 = (const bf16_t*)(p.ws + WS_S0);
    bf16_t* YM = (bf16_t*)(p.ws + WS_YMIX);
    const float* gn_w = p.in[16]; const float* gn_b = p.in[17];
    u32x2 ywn[2]; bf16x8 an[2], bn[2][2]; bool first = true;
    u32x4 nv4, ng4, nyc4; float nbon; const float* BONp = (const float*)(p.ws + WS_BON);
#define CY_LOAD(it) do { const bf16_t* _q = QE + (size_t)(it) * 4096; const bf16_t* _s = S0 + (size_t)(it) * 4096; const bf16_t* _y = YL + (size_t)(it) * 4096; \
        _Pragma("unroll") for (int ks = 0; ks < 2; ++ks) an[ks] = *(const bf16x8*)(_q + (mi * 16 + fr) * 64 + ks * 32 + fq * 8); \
        _Pragma("unroll") for (int nn = 0; nn < 2; ++nn) { ywn[nn] = *(const u32x2*)(_y + (size_t)((mi * 4 + nb + nn) * 64 + lane) * 4); \
            _Pragma("unroll") for (int ks = 0; ks < 2; ++ks) bn[nn][ks] = *(const bf16x8*)(_s + (nb + nn) * 16 * 64 + fr * 64 + ks * 32 + fq * 8); } \
        { const size_t _tg = (size_t)((it) >> 4) * 64 + (tid >> 3); const size_t _o = _tg * DR + ((it) & 15) * 64 + (tid & 7) * 8; \
          nv4 = *(const u32x4*)(V + _o); ng4 = *(const u32x4*)(G + _o); nyc4 = *(const u32x4*)(YC + _o); nbon = BONp[_tg * 16 + ((it) & 15)]; } } while (0)
    for (int item = blockIdx.x; item < 4096; item += gridDim.x) {
        const int c = item >> 4, h = item & 15;
        if (first) { first = false; CY_LOAD(item); }
        __syncthreads();
        const u32x2 ywc[2] = {ywn[0], ywn[1]}; const bf16x8 ac[2] = {an[0], an[1]}; const bf16x8 bc[2][2] = {{bn[0][0], bn[0][1]}, {bn[1][0], bn[1][1]}};
        const u32x4 v4 = nv4, g4 = ng4, yc4 = nyc4; const float bon = nbon;
        if (item + (int)gridDim.x < 4096) CY_LOAD(item + (int)gridDim.x);
#pragma unroll
        for (int nn = 0; nn < 2; ++nn) {
            const int ni = nb + nn;
            const u32x2 yw = ywc[nn];
            f32x4 acc = (f32x4){lo_bf(yw.x), hi_bf(yw.x), lo_bf(yw.y), hi_bf(yw.y)};
#pragma unroll
            for (int ks = 0; ks < 2; ++ks) acc = __builtin_amdgcn_mfma_f32_16x16x32_bf16(ac[ks], bc[nn][ks], acc, 0, 0, 0);
#pragma unroll
            for (int j = 0; j < 4; ++j) Yb[(mi * 16 + fq * 4 + j) * 68 + ni * 16 + fr] = acc[j];
        }
        __syncthreads();
        {
            const int t = tid >> 3, k0 = (tid & 7) * 8; const int ch = h * 64 + k0;
            const size_t tg = (size_t)c * 64 + t; const size_t o = tg * DR + ch;
            const float4 gw0 = *(const float4*)(gn_w + ch), gw1 = *(const float4*)(gn_w + ch + 4), gb0 = *(const float4*)(gn_b + ch), gb1 = *(const float4*)(gn_b + ch + 4);
            const float gwv[8] = {gw0.x, gw0.y, gw0.z, gw0.w, gw1.x, gw1.y, gw1.z, gw1.w}, gbv[8] = {gb0.x, gb0.y, gb0.z, gb0.w, gb1.x, gb1.y, gb1.z, gb1.w};
            const f32x4 y0 = *(const LAS f32x4*)(Yb + t * 68 + k0), y1 = *(const LAS f32x4*)(Yb + t * 68 + k0 + 4);
            const float y[8] = {y0[0], y0[1], y0[2], y0[3], y1[0], y1[1], y1[2], y1[3]};
            float sm = 0.f;
#pragma unroll
            for (int i = 0; i < 8; ++i) sm += y[i];
            sm += dpp_f<0xB1, 0xf>(sm); sm += dpp_f<0x4E, 0xf>(sm); sm += dpp_f<0x141, 0xf>(sm);
            const float mean = sm * (1.f / 64.f);
            float vs = 0.f;
#pragma unroll
            for (int i = 0; i < 8; ++i) { const float d = y[i] - mean; vs += d * d; }
            vs += dpp_f<0xB1, 0xf>(vs); vs += dpp_f<0x4E, 0xf>(vs); vs += dpp_f<0x141, 0xf>(vs);
            const float rs = rsqrtf(vs * (1.f / 64.f) + 64e-5f);
            float vf[8], gf[8], of[8];
            unpack8(v4, vf); unpack8(g4, gf);
#pragma unroll
            for (int i = 0; i < 8; ++i) of[i] = ((y[i] - mean) * rs * gwv[i] + gbv[i] + bon * vf[i]) * gf[i];
            *(u32x4*)(YM + tg * D_ + ch) = pack8(of);
            *(u32x4*)(YM + tg * D_ + 1024 + ch) = yc4;
        }
    }
#undef CY_LOAD
}

__device__ __forceinline__ int f2key(float x) { const int u = __float_as_int(x); return u ^ ((u >> 31) & 0x7fffffff); }
__device__ __forceinline__ float key2f(int k) { return __int_as_float(k ^ ((k >> 31) & 0x7fffffff)); }
template <int CTRL> __device__ __forceinline__ int dpp_i(int v) { return __builtin_amdgcn_update_dpp(v, v, CTRL, 0xf, 0xf, false); }
__device__ __forceinline__ int row_max_i(int v) { v = max(v, dpp_i<0xB1>(v)); v = max(v, dpp_i<0x4E>(v)); v = max(v, dpp_i<0x141>(v)); v = max(v, dpp_i<0x140>(v)); return v; }
__device__ __forceinline__ void phase_topk(const Params& p, unsigned char* shm) {
    float* sc = (float*)shm;
    int* tk = (int*)(sc + 64 * 260);
    int* ctab = tk + 2048;
    if (threadIdx.x < 64) { int n = threadIdx.x, v = 256;
        for (int i = 0; i < 16; ++i) { const int cnt = 16 / (i + 1); if (n < cnt) { v = i * 16 + n; break; } n -= cnt; }
        ctab[threadIdx.x] = v; }
    const float* SC = (const float*)(p.ws + WS_Q);
    int* IDS = (int*)(p.ws + WS_IDS); float* GATES = (float*)(p.ws + WS_GATES);
    const int tid = threadIdx.x, w = tid >> 6, lane = tid & 63;
    f32x4 qreg[8];
#define TK_QLOAD(it) do { const int _t0 = ((it) >> 3) * 64; _Pragma("unroll") for (int i = 0; i < 8; ++i) { const int ch = tid + 512 * i; \
        qreg[i] = *(const f32x4*)(SC + (size_t)(_t0 + (ch >> 6)) * 2048 + ((it) & 7) * 256 + (ch & 63) * 4); } } while (0)
    if ((int)blockIdx.x < 2048) TK_QLOAD((int)blockIdx.x);
    for (int item = blockIdx.x; item < 2048; item += gridDim.x) {
        const int t0 = (item >> 3) * 64, h = item & 7;
        __syncthreads();
#pragma unroll
        for (int i = 0; i < 8; ++i) { const int ch = tid + 512 * i; *(f32x4*)(sc + (ch >> 6) * 260 + (ch & 63) * 4) = qreg[i]; }
        __syncthreads();
        if (item + (int)gridDim.x < 2048) TK_QLOAD(item + (int)gridDim.x);
        for (int g = 0; g < 4; ++g) {
            const int L = w * 16 + g * 4 + (lane >> 4); const int tok = L >> 1, cc = L & 1; const int pp = lane & 15;
            int key[8];
#pragma unroll
            for (int i = 0; i < 8; ++i) key[i] = (f2key(sc[tok * 260 + cc * 128 + i * 16 + pp]) & ~127) | (127 - (i * 16 + pp));
#define CE(a, b) do { const int _hi = max(key[a], key[b]), _lo = min(key[a], key[b]); key[a] = _hi; key[b] = _lo; } while (0)
            CE(0, 1); CE(2, 3); CE(4, 5); CE(6, 7);  CE(0, 2); CE(1, 3); CE(4, 6); CE(5, 7);  CE(1, 2); CE(5, 6);
            CE(0, 4); CE(1, 5); CE(2, 6); CE(3, 7);  CE(2, 4); CE(3, 5);  CE(1, 2); CE(3, 4); CE(5, 6);
#undef CE
            int mykey = 0;
#pragma unroll
            for (int r = 0; r < 16; ++r) {
                const int m = row_max_i(key[0]);
                const bool win = (key[0] == m);
#pragma unroll
                for (int i = 0; i < 7; ++i) key[i] = win ? key[i + 1] : key[i];
                key[7] = win ? (int)0x80000000 : key[7];
                mykey = (pp == r) ? m : mykey;
            }
            tk[L * 16 + pp] = mykey;
        }
        __syncthreads();
        for (int g = 0; g < 2; ++g) {
            const int tok = w * 8 + g * 4 + (lane >> 4); const int pp = lane & 15;
            int key[4];
#pragma unroll
            for (int q = 0; q < 4; ++q) {
                const int ij = ctab[q * 16 + pp];
                const float s1 = key2f(tk[(tok * 2) * 16 + ((ij >> 4) & 15)] & ~127), s2 = key2f(tk[(tok * 2 + 1) * 16 + (ij & 15)] & ~127);
                key[q] = (ij < 256) ? ((f2key(s1 + s2) & ~255) | (255 - ij)) : (int)0x80000000;
            }
            int mykey = 0;
#pragma unroll
            for (int r = 0; r < 16; ++r) {
                const int ml = max(max(key[0], key[1]), max(key[2], key[3]));
                const int m = row_max_i(ml);
#pragma unroll
                for (int q = 0; q < 4; ++q) key[q] = (key[q] == m) ? (int)0x80000000 : key[q];
                mykey = (pp == r) ? m : mykey;
            }
            const int ci = 255 - (mykey & 255); const float cs = key2f(mykey & ~255);
            const int e1 = 127 - (tk[(tok * 2) * 16 + (ci >> 4)] & 127), e2 = 127 - (tk[(tok * 2 + 1) * 16 + (ci & 15)] & 127);
            const float mx = __shfl(cs, lane & 48);
            const float e = __expf(cs - mx);
            float sum = e; sum += dpp_f<0xB1, 0xf>(sum); sum += dpp_f<0x4E, 0xf>(sum); sum += dpp_f<0x141, 0xf>(sum); sum += dpp_f<0x140, 0xf>(sum);
            IDS[(size_t)(t0 + tok) * 128 + h * 16 + pp] = (e1 * 128 + e2) & 16383;
            GATES[(size_t)(t0 + tok) * 128 + h * 16 + pp] = e / sum;
        }
    }
#undef TK_QLOAD
}

__device__ __forceinline__ float gelu_fast(float x) { const float u = 0.7978845608028654f * (x + 0.044715f * x * x * x); return x / (1.0f + __expf(-2.0f * u)); }
__device__ __forceinline__ void phase_gather(const Params& p, unsigned char* shm) {
    const float* X1 = (const float*)(p.ws + WS_X1); const float* SSQ = (const float*)(p.ws + WS_SSQ);
    const unsigned char* U6 = p.ws + WS_UB; const unsigned char* V6 = p.ws + WS_VB;
    const int* IDS = (const int*)(p.ws + WS_IDS); const float* GATES = (const float*)(p.ws + WS_GATES);
    const float* nf = p.in[25];
    const int tid = threadIdx.x, w = tid >> 6, lane = tid & 63;
    int nid0 = 0, nid1 = 0; float ngt0 = 0.f, ngt1 = 0.f, nssq = 0.f;
#define GT_META(tt) do { nid0 = IDS[(size_t)(tt) * 128 + lane]; nid1 = IDS[(size_t)(tt) * 128 + 64 + lane]; ngt0 = GATES[(size_t)(tt) * 128 + lane]; ngt1 = GATES[(size_t)(tt) * 128 + 64 + lane]; \
        nssq = (lane < 32) ? SSQ[(size_t)(tt) * 32 + lane] : 0.f; } while (0)
    if ((int)(blockIdx.x * 8 + w) < S_) GT_META(blockIdx.x * 8 + w);
    for (int t = blockIdx.x * 8 + w; t < S_; t += gridDim.x * 8) {
        const int id0 = nid0, id1 = nid1; const float gt0 = ngt0, gt1 = ngt1, ssqv = nssq;
        if (t + (int)gridDim.x * 8 < S_) GT_META(t + (int)gridDim.x * 8);
        f32x2 op[16];
#pragma unroll
        for (int j = 0; j < 8; ++j) { const float4 x = *(const float4*)(X1 + (size_t)t * D_ + (j * 64 + lane) * 4);
            op[2 * j] = (f32x2){x.x, x.y}; op[2 * j + 1] = (f32x2){x.z, x.w}; }
        f32x2 hp[16];
#pragma unroll
        for (int i = 0; i < 16; ++i) hp[i] = op[i];
        const float rs = rsqrtf(wave_sum_dpp(ssqv) * (1.0f / 2048.0f) + 1e-6f);
        u32x4 uaA[4], ubA[4], vbA[4]; u32x2 uaB[4], ubB[4], vbB[4];
#define G_LOADU(dA, dB, grp) do { _Pragma("unroll") for (int j = 0; j < 4; ++j) { const int e = (grp) * 4 + j; const int id = __builtin_amdgcn_readlane(e < 64 ? id0 : id1, e & 63); \
            const unsigned char* ur = U6 + (size_t)id * ROW6; dA[j] = *(const u32x4*)(ur + lane * 16); dB[j] = *(const u32x2*)(ur + 1024 + lane * 8); } } while (0)
#define G_LOADV(grp) do { _Pragma("unroll") for (int j = 0; j < 4; ++j) { const int e = (grp) * 4 + j; const int id = __builtin_amdgcn_readlane(e < 64 ? id0 : id1, e & 63); \
            const unsigned char* vr = V6 + (size_t)id * ROW6; vbA[j] = *(const u32x4*)(vr + lane * 16); vbB[j] = *(const u32x2*)(vr + 1024 + lane * 8); } } while (0)
#define G_DEC(A, B) __builtin_amdgcn_cvt_scalef32_pk32_f32_fp6((u32x6){A[0], A[1], A[2], A[3], B[0], B[1]}, 1.0f)
#define G_BODY(cA, cB, nA, nB, grp) do { \
            G_LOADV(grp); \
            G_LOADU(nA, nB, ((grp) + 1 < 32 ? (grp) + 1 : 31)); \
            float dsel = 0.f; \
            _Pragma("unroll") for (int j = 0; j < 4; ++j) { const f32x32 dd = G_DEC(cA[j], cB[j]); f32x2 d2 = (f32x2){0.f, 0.f}; \
                _Pragma("unroll") for (int m = 0; m < 16; ++m) d2 += (f32x2){dd[2 * m], dd[2 * m + 1]} * hp[m]; \
                const float d = wave_sum_dpp(d2.x + d2.y); dsel = (lane == j) ? d : dsel; } \
            const float av = gelu_fast(dsel * (rs * (1.f / U6_SCALE))) * (1.f / V6_SCALE); \
            _Pragma("unroll") for (int j = 0; j < 4; ++j) { const int e = (grp) * 4 + j; \
                const float a = __int_as_float(__builtin_amdgcn_readlane(__float_as_int(av), j)) * __int_as_float(__builtin_amdgcn_readlane(__float_as_int(e < 64 ? gt0 : gt1), e & 63)); \
                const f32x2 a2 = (f32x2){a, a}; const f32x32 dd = G_DEC(vbA[j], vbB[j]); \
                _Pragma("unroll") for (int m = 0; m < 16; ++m) op[m] += a2 * (f32x2){dd[2 * m], dd[2 * m + 1]}; } \
        } while (0)
        G_LOADU(uaA, uaB, 0);
#pragma unroll 1
        for (int g2 = 0; g2 < 32; g2 += 2) { G_BODY(uaA, uaB, ubA, ubB, g2); G_BODY(ubA, ubB, uaA, uaB, g2 + 1); }
#undef G_LOADU
#undef G_LOADV
#undef G_DEC
#undef G_BODY
        float ss = 0.f;
#pragma unroll
        for (int m = 0; m < 16; ++m) ss += op[m].x * op[m].x + op[m].y * op[m].y;
        ss = wave_sum_dpp(ss);
        const float scl = rsqrtf(ss * (1.f / 2048.f) + 1e-6f);
#pragma unroll
        for (int j = 0; j < 8; ++j) { const float4 g = *(const float4*)(nf + (j * 64 + lane) * 4);
            *(float4*)(p.out + (size_t)t * D_ + (j * 64 + lane) * 4) = make_float4(op[2 * j].x * scl * g.x, op[2 * j].y * scl * g.y, op[2 * j + 1].x * scl * g.z, op[2 * j + 1].y * scl * g.w); }
    }
#undef GT_META
}

#define PEER_LD6(dstA, dstB, base, id) do { const unsigned char* _q = (base) + ((size_t)xs * 16384 + (id)) * 192 + pt * 24; dstA = *(const u32x4*)_q; dstB = *(const u32x2*)(_q + 16); } while (0)
#define PEER_DEC(A, B) __builtin_amdgcn_cvt_scalef32_pk32_f32_fp6((u32x6){A[0], A[1], A[2], A[3], B[0], B[1]}, 1.0f)
__device__ __forceinline__ void phase_peerZ(const Params& p) {
    const float* X1 = (const float*)(p.ws + WS_X1); const unsigned char* U6 = p.ws + WS_UB; const int* IDS = (const int*)(p.ws + WS_IDS);
    float* ZP = (float*)(p.ws + WS_ZP);
    const int lane = threadIdx.x & 63, w = threadIdx.x >> 6, es = lane >> 3, pt = lane & 7;
    const int xs = blockIdx.x & 7, nwg = (gridDim.x >> 3) * 8;
    float4 nh[8]; int nid0 = 0, nid1 = 0;
#define PZ_META(tt) do { _Pragma("unroll") for (int j = 0; j < 8; ++j) nh[j] = *(const float4*)(X1 + (size_t)(tt) * D_ + xs * 256 + (j * 8 + pt) * 4); \
        nid0 = IDS[(size_t)(tt) * 128 + lane]; nid1 = IDS[(size_t)(tt) * 128 + 64 + lane]; } while (0)
    { const int t0 = (blockIdx.x >> 3) * 8 + w; if (t0 < S_) PZ_META(t0); }
    for (int t = (blockIdx.x >> 3) * 8 + w; t < S_; t += nwg) {
        f32x2 hp[16];
#pragma unroll
        for (int j = 0; j < 8; ++j) { hp[2 * j] = (f32x2){nh[j].x, nh[j].y}; hp[2 * j + 1] = (f32x2){nh[j].z, nh[j].w}; }
        const int id0 = nid0, id1 = nid1;
        u32x4 bA[4]; u32x2 bB[4];
#pragma unroll
        for (int g = 0; g < 4; ++g) { const int id = __shfl(id0, g * 8 + es); PEER_LD6(bA[g], bB[g], U6, id); }
        if (t + nwg < S_) PZ_META(t + nwg);
#pragma unroll
        for (int g = 0; g < 16; ++g) {
            const f32x32 dd = PEER_DEC(bA[g & 3], bB[g & 3]);
            if (g + 4 < 16) { const int id = __shfl((g + 4) < 8 ? id0 : id1, ((g + 4) * 8 + es) & 63); PEER_LD6(bA[g & 3], bB[g & 3], U6, id); }
            f32x2 d2 = (f32x2){0.f, 0.f};
#pragma unroll
            for (int m = 0; m < 16; ++m) d2 += (f32x2){dd[2 * m], dd[2 * m + 1]} * hp[m];
            float d = d2.x + d2.y;
            d += dpp_f<0xB1, 0xf>(d); d += dpp_f<0x4E, 0xf>(d); d += dpp_f<0x141, 0xf>(d);
            if (pt == 0) ZP[((size_t)t * 8 + xs) * 128 + g * 8 + es] = d;
        }
    }
#undef PZ_META
}
__device__ __forceinline__ void phase_peerV(const Params& p) {
    const float* X1 = (const float*)(p.ws + WS_X1); const unsigned char* V6 = p.ws + WS_VB; const int* IDS = (const int*)(p.ws + WS_IDS);
    const float* GATES = (const float*)(p.ws + WS_GATES); const float* ZP = (const float*)(p.ws + WS_ZP); const float* SSQ = (const float*)(p.ws + WS_SSQ);
    float* X2 = (float*)(p.ws + WS_X2); float* SSQ2 = (float*)(p.ws + WS_SSQ2);
    const int lane = threadIdx.x & 63, w = threadIdx.x >> 6, es = lane >> 3, pt = lane & 7;
    const int xs = blockIdx.x & 7, nwg = (gridDim.x >> 3) * 8;
    for (int t = (blockIdx.x >> 3) * 8 + w; t < S_; t += nwg) {
        const int id0 = IDS[(size_t)t * 128 + lane], id1 = IDS[(size_t)t * 128 + 64 + lane];
        u32x4 bA[4]; u32x2 bB[4];
#pragma unroll
        for (int g = 0; g < 4; ++g) { const int id = __shfl(id0, g * 8 + es); PEER_LD6(bA[g], bB[g], V6, id); }
        float z0 = 0.f, z1 = 0.f;
#pragma unroll
        for (int x = 0; x < 8; ++x) { z0 += ZP[((size_t)t * 8 + x) * 128 + lane]; z1 += ZP[((size_t)t * 8 + x) * 128 + 64 + lane]; }
        const float rs = rsqrtf(wave_sum_dpp(lane < 32 ? SSQ[(size_t)t * 32 + lane] : 0.f) * (1.0f / 2048.0f) + 1e-6f);
        const float a0 = gelu_fast(z0 * (rs * (1.f / U6_SCALE))) * GATES[(size_t)t * 128 + lane] * (1.f / V6_SCALE);
        const float a1 = gelu_fast(z1 * (rs * (1.f / U6_SCALE))) * GATES[(size_t)t * 128 + 64 + lane] * (1.f / V6_SCALE);
        f32x2 op[16];
#pragma unroll
        for (int m = 0; m < 16; ++m) op[m] = (f32x2){0.f, 0.f};
#pragma unroll
        for (int g = 0; g < 16; ++g) {
            const f32x32 dd = PEER_DEC(bA[g & 3], bB[g & 3]);
            if (g + 4 < 16) { const int id = __shfl((g + 4) < 8 ? id0 : id1, ((g + 4) * 8 + es) & 63); PEER_LD6(bA[g & 3], bB[g & 3], V6, id); }
            const float a = __shfl(g < 8 ? a0 : a1, (g * 8 + es) & 63);
            const f32x2 a2 = (f32x2){a, a};
#pragma unroll
            for (int m = 0; m < 16; ++m) op[m] += a2 * (f32x2){dd[2 * m], dd[2 * m + 1]};
        }
#pragma unroll
        for (int m = 0; m < 16; ++m) {
            float vx = op[m].x, vy = op[m].y;
            vx += __shfl_xor(vx, 8); vy += __shfl_xor(vy, 8); vx += __shfl_xor(vx, 16); vy += __shfl_xor(vy, 16); vx += __shfl_xor(vx, 32); vy += __shfl_xor(vy, 32);
            op[m] = (f32x2){vx, vy};
        }
        if (es == 0) {
            float ss = 0.f;
#pragma unroll
            for (int j = 0; j < 8; ++j) { float4 v = *(const float4*)(X1 + (size_t)t * D_ + xs * 256 + (j * 8 + pt) * 4);
                v.x += op[2 * j].x; v.y += op[2 * j].y; v.z += op[2 * j + 1].x; v.w += op[2 * j + 1].y;
                ss += v.x * v.x + v.y * v.y + v.z * v.z + v.w * v.w;
                *(float4*)(X2 + (size_t)t * D_ + xs * 256 + (j * 8 + pt) * 4) = v; }
            ss += dpp_f<0xB1, 0xf>(ss); ss += dpp_f<0x4E, 0xf>(ss); ss += dpp_f<0x141, 0xf>(ss);
            if (pt == 0) SSQ2[(size_t)t * 8 + xs] = ss;
        }
    }
}
__device__ __forceinline__ void phase_final(const Params& p) {
    const float* X2 = (const float*)(p.ws + WS_X2); const float* SSQ2 = (const float*)(p.ws + WS_SSQ2); const float* nf = p.in[25];
    const int lane = threadIdx.x & 63, w = threadIdx.x >> 6;
    for (int t = blockIdx.x * 8 + w; t < S_; t += gridDim.x * 8) {
        const f32x4 s0 = *(const f32x4*)(SSQ2 + (size_t)t * 8), s1 = *(const f32x4*)(SSQ2 + (size_t)t * 8 + 4);
        const float scl = rsqrtf(((s0[0] + s0[1]) + (s0[2] + s0[3]) + (s1[0] + s1[1]) + (s1[2] + s1[3])) * (1.f / 2048.f) + 1e-6f);
#pragma unroll
        for (int j = 0; j < 8; ++j) { const float4 v = *(const float4*)(X2 + (size_t)t * D_ + (j * 64 + lane) * 4); const float4 g = *(const float4*)(nf + (j * 64 + lane) * 4);
            *(float4*)(p.out + (size_t)t * D_ + (j * 64 + lane) * 4) = make_float4(v.x * scl * g.x, v.y * scl * g.y, v.z * scl * g.z, v.w * scl * g.w); }
    }
}

#define XB_TMO      128
#define XB_XCNT(j)  (256  + 64 * (j))
#define XB_XSUB(j)  (1280 + 64 * (j))
#define XB_XGEN(j)  (2304 + 64 * (j))
#define XB_TOP      3328
#define XB_TOPGEN   3392
#define XCD_BAR_WORDS 3456
#define XB_SPIN_CAP (1u << 18)
__device__ __forceinline__ unsigned xb_ld(unsigned* p)              { return __hip_atomic_load(p, __ATOMIC_RELAXED, __HIP_MEMORY_SCOPE_AGENT); }
__device__ __forceinline__ unsigned xb_add(unsigned* p, unsigned v) { return __hip_atomic_fetch_add(p, v, __ATOMIC_RELAXED, __HIP_MEMORY_SCOPE_AGENT); }
__device__ __forceinline__ unsigned xb_xcc_id() { return (unsigned)__builtin_amdgcn_s_getreg((3 << 11) | 20) & 0xFu; }
#define XB_SPIN(cond, bar) do { unsigned _sp = 0; while (cond) { __builtin_amdgcn_s_sleep(1); \
    if ((++_sp & 255u) == 0u) { if (xb_ld(&(bar)[XB_TMO])) break; if (_sp > XB_SPIN_CAP) { atomicAdd(&(bar)[XB_TMO], 1u); break; } } } } while (0)
struct XcdBarrier { unsigned* bar; unsigned x; volatile LAS unsigned* st; };
__device__ __forceinline__ XcdBarrier xcd_barrier_post(unsigned* bar, volatile LAS unsigned* st) {
    XcdBarrier b; b.bar = bar; b.x = xb_xcc_id(); b.st = st;
    if (threadIdx.x == 0) (void)xb_add(&bar[XB_XCNT(b.x)], 1u);
    return b;
}
__device__ __forceinline__ void xcd_barrier_complete(unsigned* bar, unsigned x, unsigned& nloc, unsigned& nx) {
    const unsigned G = gridDim.x * gridDim.y * gridDim.z;
    unsigned sum, cnt, mine, sp = 0u;
    for (;;) {
        sum = 0u; cnt = 0u; mine = 0u;
#pragma unroll
        for (unsigned j = 0; j < 16; ++j) { const unsigned c = xb_ld(&bar[XB_XCNT(j)]); sum += c; cnt += (c > 0u) ? 1u : 0u; mine = (j == x) ? c : mine; }
        if (sum == G) break;
        __builtin_amdgcn_s_sleep(1);
        if ((++sp & 255u) == 0u) { if (xb_ld(&bar[XB_TMO])) break; if (sp > XB_SPIN_CAP) { atomicAdd(&bar[XB_TMO], 1u); break; } }
    }
    nloc = mine > 0u ? mine : 1u; nx = cnt > 0u ? cnt : 1u;
}
__device__ __forceinline__ void xcd_barrier(const XcdBarrier& b) {
    asm volatile("s_waitcnt vmcnt(0)" ::: "memory");
    __syncthreads();
    if (threadIdx.x == 0) {
        unsigned* bar = b.bar;
        __builtin_amdgcn_s_waitcnt(0);
        unsigned nloc = b.st[0], nx = b.st[1];
        if (nloc == 0u) { xcd_barrier_complete(bar, b.x, nloc, nx); b.st[0] = nloc; b.st[1] = nx; }
        const unsigned old = xb_add(&bar[XB_XSUB(b.x)], 1u);
        const unsigned gen = old / nloc;
        if (old + 1u == (gen + 1u) * nloc) {
            __builtin_amdgcn_fence(__ATOMIC_RELEASE, "agent");
            asm volatile("s_waitcnt vmcnt(0)" ::: "memory");
            const unsigned og = xb_add(&bar[XB_TOP], 1u);
            const unsigned tg = og / nx;
            if (og + 1u == (tg + 1u) * nx) xb_add(&bar[XB_TOPGEN], 1u);
            else XB_SPIN(xb_ld(&bar[XB_TOPGEN]) == tg, bar);
            __builtin_amdgcn_fence(__ATOMIC_ACQUIRE, "agent");
            xb_add(&bar[XB_XGEN(b.x)], 1u);
            asm volatile("s_waitcnt vmcnt(0)" ::: "memory");
        } else {
            XB_SPIN(xb_ld(&bar[XB_XGEN(b.x)]) == gen, bar);
            __builtin_amdgcn_fence(__ATOMIC_ACQUIRE, "agent");
            asm volatile("s_waitcnt vmcnt(0)" ::: "memory");
        }
    }
    __syncthreads();
}

__global__ void __launch_bounds__(512, 2) mega(Params p) {
    extern __shared__ __attribute__((aligned(16))) unsigned char shm[];
    cg::grid_group grid = cg::this_grid();
    LAS unsigned char* lds = (LAS unsigned char*)shm;
    volatile LAS unsigned* bst = (volatile LAS unsigned*)(lds + LDS_BYTES - 16);
    if (threadIdx.x == 0) { bst[0] = 0u; bst[1] = 0u; }
    __syncthreads();
    const XcdBarrier xbar = xcd_barrier_post((unsigned*)(p.ws + WS_BAR), bst);
    if (p.ph_hi > 1000) grid.sync();
    const int lo = p.ph_lo, hi = p.ph_hi;
#define IN(k) (lo <= (k) && (k) < hi)
#define REP(k) for (int _r = 0; _r < ((k) == DUP_PHASE ? 2 : 1); ++_r)
#define SEAM(k) do { if (IN(k) && IN((k) + 1)) xcd_barrier(xbar); } while (0)
    if (IN(0)) REP(0) { if (_r) xcd_barrier(xbar); phase0(p, shm); }
    SEAM(0);
    if (IN(1)) REP(1) { if (_r) xcd_barrier(xbar);
        pg8::Gemm g{(const bf16_t*)(p.ws + WS_H), (const bf16_t*)(p.ws + WS_WB1), S_, NAUG, 2048};
        pg8::StaticOrder so; so.init(g.M, g.N, (int)gridDim.x, (int)blockIdx.x);
        pg8::EpiBf16 E{(bf16_t*)(p.ws + WS_PROJ), NAUG};
        pg8::gemm_phase(lds, g, so, E);
    }
    SEAM(1);
    if (IN(2)) REP(2) { if (_r) xcd_barrier(xbar);
        phase_prepM(p, lds);
        phase_prepE(p);
    }
    SEAM(2);
    if (IN(3)) REP(3) { if (_r) xcd_barrier(xbar); phase_chunkA(p, lds); }
    SEAM(3);
    if (IN(4)) REP(4) { if (_r) xcd_barrier(xbar); if (blockIdx.x < 64) phase_seq(p);
        else { const int bid = blockIdx.x - 64, nblk = gridDim.x - 64;
            convert_fp6s(p.in[23], p.ws + WS_UB, 16384, U6_SCALE, p.in[20], bid, nblk);
            convert_fp6s(p.in[24], p.ws + WS_VB, 16384, V6_SCALE, nullptr, bid, nblk);
            build_wpt(p.in[21], p.in[20], (const bf16_t*)(p.ws + WS_KEYB), (bf16_t*)(p.ws + WS_WQT), bid, nblk);
            transpose_convert(p.in[19], 2048, 2048, (bf16_t*)(p.ws + WS_WOT), (float*)shm, bid, nblk); } }
    SEAM(4);
    if (IN(5)) REP(5) { if (_r) xcd_barrier(xbar); phase_chunkY(p, lds); }
    SEAM(5);
    if (IN(6)) REP(6) { if (_r) xcd_barrier(xbar);
        pg8::Gemm g{(const bf16_t*)(p.ws + WS_YMIX), (const bf16_t*)(p.ws + WS_WOT), S_, 2048, 2048};
        pg8::StaticOrder so; so.init(g.M, g.N, (int)gridDim.x, (int)blockIdx.x);
        pg8::EpiRes2 E{(float*)(p.ws + WS_X1), p.in[0], (bf16_t*)(p.ws + WS_H2), (float*)(p.ws + WS_SSQ), 2048};
        pg8::gemm_phase(lds, g, so, E);
    }
    SEAM(6);
    if (IN(8)) REP(8) { if (_r) xcd_barrier(xbar);
        pg8::Gemm g{(const bf16_t*)(p.ws + WS_H2), (const bf16_t*)(p.ws + WS_WQT), S_, 2048, 2048};
        pg8::StaticOrder so; so.init(g.M, g.N, (int)gridDim.x, (int)blockIdx.x);
        pg8::EpiRowScaleF32 E{(float*)(p.ws + WS_Q), (const float*)(p.ws + WS_SSQ), 2048};
        pg8::gemm_phase(lds, g, so, E);
    }
    SEAM(8);
    if (IN(9)) REP(9) { if (_r) xcd_barrier(xbar); phase_topk(p, shm); }
    SEAM(9);
    if (IN(10)) REP(10) { if (_r) xcd_barrier(xbar); phase_peerZ(p); }
    SEAM(10);
    if (IN(11)) REP(11) { if (_r) xcd_barrier(xbar); phase_peerV(p); }
    SEAM(11);
    if (IN(12)) REP(12) { if (_r) xcd_barrier(xbar); phase_final(p); }
#undef IN
#undef REP
#undef SEAM
}

extern "C" void kernel_launch(void* const* d_in, const int* in_sizes, int n_in, void* d_out, int out_size, void* d_ws, size_t ws_size, hipStream_t stream) {
    static int grid_blocks = 0;
    if (grid_blocks == 0) {
        if (n_in != 26 || ws_size < WS_NEED) { fprintf(stderr, "kernel_launch: unexpected n_in %d / ws_size %zu\n", n_in, ws_size); grid_blocks = -1; return; }
        int dev = 0, cus = 0, per_cu = 0;
        (void)hipGetDevice(&dev);
        (void)hipDeviceGetAttribute(&cus, hipDeviceAttributeMultiprocessorCount, dev);
        (void)hipFuncSetAttribute((const void*)mega, hipFuncAttributeMaxDynamicSharedMemorySize, LDS_BYTES);
        (void)hipOccupancyMaxActiveBlocksPerMultiprocessor(&per_cu, (const void*)mega, 512, LDS_BYTES);
        if (per_cu < 1) { fprintf(stderr, "kernel_launch: occupancy query says %d blocks/CU\n", per_cu); per_cu = 1; }
        grid_blocks = cus * per_cu;
        fprintf(stderr, "kernel_launch: cus %d per_cu %d grid %d\n", cus, per_cu, grid_blocks);
    }
    if (grid_blocks < 0) return;
    Params p{};
    for (int i = 0; i < 26; ++i) p.in[i] = (const float*)d_in[i];
    p.out = (float*)d_out; p.ws = (unsigned char*)d_ws;
#if MULTI_LAUNCH
    for (int ph = 0; ph < NPHASE; ++ph) {
        p.ph_lo = ph; p.ph_hi = ph + 1;
        hipLaunchKernelGGL(mega, dim3(grid_blocks), dim3(512), LDS_BYTES, stream, p);
    }
#else
    p.ph_lo = 0; p.ph_hi = NPHASE;
    if (hipMemsetAsync((unsigned char*)d_ws + WS_BAR, 0, XCD_BAR_WORDS * 4, stream) != hipSuccess) fprintf(stderr, "kernel_launch: barrier memset failed\n");
    void* args[] = {&p};
    hipError_t e = hipLaunchCooperativeKernel((const void*)mega, dim3(grid_blocks), dim3(512), args, LDS_BYTES, stream);
    if (e != hipSuccess) fprintf(stderr, "cooperative launch failed: %s (grid %d)\n", hipGetErrorString(e), grid_blocks);
#endif
}
```

```cpp
#include <hip/hip_runtime.h>
#include <hip/hip_cooperative_groups.h>
#include <cstdio>
namespace cg = cooperative_groups;

#ifndef DUP_PHASE
#define DUP_PHASE -1
#endif
#ifndef MULTI_LAUNCH
#define MULTI_LAUNCH 0
#endif

#define LAS __attribute__((address_space(3)))
typedef unsigned short bf16_t;
typedef short bf16x8 __attribute__((ext_vector_type(8)));
typedef float f32x4 __attribute__((ext_vector_type(4)));
typedef float f32x2 __attribute__((ext_vector_type(2)));
typedef unsigned u32x4 __attribute__((ext_vector_type(4)));
typedef unsigned u32x2 __attribute__((ext_vector_type(2)));
typedef unsigned u32x6 __attribute__((ext_vector_type(6)));
typedef float f32x32 __attribute__((ext_vector_type(32)));
typedef __bf16 bf16x32_t __attribute__((ext_vector_type(32)));

constexpr int S_ = 16384, D_ = 2048, DR = 1024, NAUG = 6912;
constexpr size_t MiB = 1ull << 20;
constexpr size_t WS_PROJ = 0, WS_H = 216 * MiB, WS_WB1 = 280 * MiB, WS_WQT = 280 * MiB, WS_WOT = 296 * MiB;
constexpr size_t WS_R = 307 * MiB, WS_K = 339 * MiB, WS_V = 371 * MiB, WS_KK = 403 * MiB, WS_A = 435 * MiB, WS_LW = 467 * MiB;
constexpr size_t WS_G = 216 * MiB, WS_YC = 248 * MiB, WS_YMIX = 307 * MiB, WS_X1 = 0, WS_H2 = 128 * MiB, WS_Q = 307 * MiB;
constexpr size_t WS_GT = 0, WS_HT = 32 * MiB, WS_QE = 96 * MiB, WS_YL = 128 * MiB, WS_S0 = 160 * MiB;
constexpr size_t WS_IDS = 192 * MiB, WS_GATES = 200 * MiB, WS_UB = 467 * MiB, WS_VB = 435 * MiB, WS_BON = 500 * MiB, WS_BAR = 502 * MiB, WS_KEYB = 503 * MiB, WS_SSQ = 504 * MiB, WS_SSQ2 = 506 * MiB, WS_NEED = 507 * MiB;
constexpr size_t WS_ZP = 128 * MiB, WS_X2 = 307 * MiB;
constexpr size_t WS_W2T = 499 * MiB, WS_A2T = WS_W2T + 131072, WS_G2T = WS_A2T + 131072;
constexpr int TLD = 72, TSLOT = 64 * TLD * 2;
constexpr int LDS_BYTES = 16 * TSLOT + 2048 + 256 + 16;
constexpr int NPHASE = 13;

struct Params {
    const float* in[26];
    float* out;
    unsigned char* ws;
    int ph_lo, ph_hi;
};

__device__ __forceinline__ float bf2f(bf16_t b) { return __uint_as_float(((unsigned)b) << 16); }
__device__ __forceinline__ bf16_t f2bf(float f) { unsigned u = __float_as_uint(f); u += 0x7FFFu + ((u >> 16) & 1u); return (bf16_t)(u >> 16); }
typedef __bf16 bf16v2_t __attribute__((ext_vector_type(2)));
__device__ __forceinline__ unsigned cvt_pk_bf16(float lo, float hi) { const f32x2 v = {lo, hi}; const bf16v2_t r = __builtin_convertvector(v, bf16v2_t); return __builtin_bit_cast(unsigned, r); }
__device__ __forceinline__ u32x4 pack8(const float* f) { u32x4 w; w.x = cvt_pk_bf16(f[0], f[1]); w.y = cvt_pk_bf16(f[2], f[3]); w.z = cvt_pk_bf16(f[4], f[5]); w.w = cvt_pk_bf16(f[6], f[7]); return w; }
__device__ __forceinline__ float lo_bf(unsigned w) { return __uint_as_float(w << 16); }
__device__ __forceinline__ float hi_bf(unsigned w) { return __uint_as_float(w & 0xffff0000u); }
__device__ __forceinline__ void unpack8(const u32x4 v, float* f) {
#pragma unroll
    for (int i = 0; i < 4; ++i) { f[2 * i] = lo_bf(v[i]); f[2 * i + 1] = hi_bf(v[i]); }
}
__device__ __forceinline__ float wave_sum(float v) {
#pragma unroll
    for (int o = 32; o; o >>= 1) v += __shfl_xor(v, o);
    return v;
}
template <int CTRL, int RM> __device__ __forceinline__ float dpp_f(float v) { return __int_as_float(__builtin_amdgcn_update_dpp(0, __float_as_int(v), CTRL, RM, 0xf, false)); }
__device__ __forceinline__ float wave_sum_dpp(float v) {
    v += dpp_f<0xB1, 0xf>(v); v += dpp_f<0x4E, 0xf>(v); v += dpp_f<0x141, 0xf>(v); v += dpp_f<0x140, 0xf>(v);
    v += dpp_f<0x142, 0xa>(v); v += dpp_f<0x143, 0xc>(v);
    return __int_as_float(__builtin_amdgcn_readlane(__float_as_int(v), 63));
}
__device__ __forceinline__ float wave_max(float v) {
#pragma unroll
    for (int o = 32; o; o >>= 1) v = fmaxf(v, __shfl_xor(v, o));
    return v;
}
__device__ __forceinline__ float sigmoidf_(float x) { return 1.0f / (1.0f + __expf(-x)); }
__device__ __forceinline__ float gelu_tanh(float x) { float u = 0.7978845608028654f * (x + 0.044715f * x * x * x); return 0.5f * x * (1.0f + tanhf(u)); }

namespace pg8 {
constexpr int BM = 256, BK = 64, HALF = 128, HTB = HALF * BK * 2, STAGE_BYTES = 8 * HTB, NXCD = 8, WGM = 8;
__device__ __forceinline__ int lds_byte(int r, int c) { const int st = (r >> 4) * 2 + (c >> 5), rr = r & 15, cc = c & 31, ob = rr * 64 + cc * 2; return st * 1024 + (ob ^ (((ob >> 9) & 1) << 5)); }
__device__ __forceinline__ void stage_rc(int b, int& R, int& C) { const int st = b / 1024, sb = b % 1024, swz = sb ^ (((sb >> 9) & 1) << 5); R = (st >> 1) * 16 + swz / 64; C = (st & 1) * 32 + (swz % 64) / 2; }
__device__ __forceinline__ int perm32(int rho) { const int n = rho >> 4, i = rho & 15; return 8 * (i >> 2) + 4 * n + (i & 3); }
struct Unit { int pm, pn; };
struct Gemm { const bf16_t* A; const bf16_t* Bt; int M, N, K; };
struct StaticOrder {
    int nM, nN, nwg, G, c;
    __device__ void init(int M, int N, int G_, int c_) { nM = M / BM; nN = N / BM; nwg = nM * nN; G = G_; c = c_; }
    __device__ bool next(int i, Unit& u) const {
        const long L = (long)i * G + c; if (L >= nwg) return false;
        int wgid = (int)L; { const int q = nwg / NXCD, r = nwg % NXCD, xcd = wgid % NXCD, off = wgid / NXCD; wgid = (xcd < r ? xcd * (q + 1) : r * (q + 1) + (xcd - r) * q) + off; }
        const int nig = WGM * nN, gid = wgid / nig, fm = gid * WGM, gsz = (nM - fm) < WGM ? (nM - fm) : WGM;
        u.pm = fm + ((wgid % nig) % gsz); u.pn = (wgid % nig) / gsz; return true;
    }
    __device__ __forceinline__ void a_ready(const Unit&) const {}
    __device__ __forceinline__ void done(const Unit&) const {}
};
struct EpiResF32 {
    static constexpr bool PERM = false;
    float* C; const float* Res; int ldc;
    __device__ __forceinline__ void operator()(const f32x4 (&acc)[2][2][4][2], const Unit& u, int wr, int wc, int fr, int fq) const {
        const int row0 = u.pm * BM + wr * 64 + fr, col0 = u.pn * BM + wc * 32 + 4 * fq;
#pragma unroll
        for (int ai = 0; ai < 2; ++ai)
#pragma unroll
            for (int m = 0; m < 4; ++m) { const size_t ro = (size_t)(row0 + ai * HALF + m * 16) * ldc + col0;
#pragma unroll
                for (int bj = 0; bj < 2; ++bj)
#pragma unroll
                    for (int n = 0; n < 2; ++n) { const f32x4 rs = *(const f32x4*)(Res + ro + bj * HALF + n * 16); *(f32x4*)(C + ro + bj * HALF + n * 16) = acc[ai][bj][m][n] + rs; } }
    }
};
struct EpiRes2 {
    static constexpr bool PERM = false;
    float* C; const float* Res; bf16_t* Cb; float* SSQ; int ldc;
    __device__ __forceinline__ void operator()(const f32x4 (&acc)[2][2][4][2], const Unit& u, int wr, int wc, int fr, int fq) const {
        const int row0 = u.pm * BM + wr * 64 + fr, col0 = u.pn * BM + wc * 32 + 4 * fq;
#pragma unroll
        for (int ai = 0; ai < 2; ++ai)
#pragma unroll
            for (int m = 0; m < 4; ++m) { const int row = row0 + ai * HALF + m * 16; const size_t ro = (size_t)row * ldc + col0; float ss = 0.f;
#pragma unroll
                for (int bj = 0; bj < 2; ++bj)
#pragma unroll
                    for (int n = 0; n < 2; ++n) { const f32x4 v = acc[ai][bj][m][n] + *(const f32x4*)(Res + ro + bj * HALF + n * 16);
                        *(f32x4*)(C + ro + bj * HALF + n * 16) = v;
                        u32x2 wv; wv.x = cvt_pk_bf16(v[0], v[1]); wv.y = cvt_pk_bf16(v[2], v[3]); *(u32x2*)(Cb + ro + bj * HALF + n * 16) = wv;
                        ss += v[0] * v[0] + v[1] * v[1] + v[2] * v[2] + v[3] * v[3]; }
                ss += __shfl_xor(ss, 16); ss += __shfl_xor(ss, 32);
                if (fq == 0) SSQ[(size_t)row * 32 + u.pn * 4 + wc] = ss; }
    }
};
struct EpiRowScaleF32 {
    static constexpr bool PERM = false;
    float* C; const float* SSQ; int ldc;
    __device__ __forceinline__ void operator()(const f32x4 (&acc)[2][2][4][2], const Unit& u, int wr, int wc, int fr, int fq) const {
        const int row0 = u.pm * BM + wr * 64 + fr, col0 = u.pn * BM + wc * 32 + 4 * fq;
#pragma unroll
        for (int ai = 0; ai < 2; ++ai)
#pragma unroll
            for (int m = 0; m < 4; ++m) { const int row = row0 + ai * HALF + m * 16; const size_t ro = (size_t)row * ldc + col0;
                const f32x4* sp = (const f32x4*)(SSQ + (size_t)row * 32); float sq = 0.f;
#pragma unroll
                for (int q = 0; q < 8; ++q) { const f32x4 v = sp[q]; sq += (v[0] + v[1]) + (v[2] + v[3]); }
                const float rs = rsqrtf(sq * (1.0f / 2048.0f) + 1e-6f);
#pragma unroll
                for (int bj = 0; bj < 2; ++bj)
#pragma unroll
                    for (int n = 0; n < 2; ++n) *(f32x4*)(C + ro + bj * HALF + n * 16) = acc[ai][bj][m][n] * rs; }
    }
};
struct EpiF32 {
    static constexpr bool PERM = false;
    float* C; int ldc;
    __device__ __forceinline__ void operator()(const f32x4 (&acc)[2][2][4][2], const Unit& u, int wr, int wc, int fr, int fq) const {
        const int row0 = u.pm * BM + wr * 64 + fr, col0 = u.pn * BM + wc * 32 + 4 * fq;
#pragma unroll
        for (int ai = 0; ai < 2; ++ai)
#pragma unroll
            for (int m = 0; m < 4; ++m) { const size_t ro = (size_t)(row0 + ai * HALF + m * 16) * ldc + col0;
#pragma unroll
                for (int bj = 0; bj < 2; ++bj)
#pragma unroll
                    for (int n = 0; n < 2; ++n) *(f32x4*)(C + ro + bj * HALF + n * 16) = acc[ai][bj][m][n]; }
    }
};
struct EpiBf16 {
    static constexpr bool PERM = true;
    bf16_t* O; int ldc;
    __device__ __forceinline__ void operator()(const f32x4 (&acc)[2][2][4][2], const Unit& u, int wr, int wc, int fr, int fq) const {
        const int row0 = u.pm * BM + wr * 64 + fr; const int col0 = u.pn * BM + wc * 32 + 8 * fq;
#pragma unroll
        for (int ai = 0; ai < 2; ++ai)
#pragma unroll
            for (int m = 0; m < 4; ++m) { bf16_t* rowp = O + (size_t)(row0 + ai * HALF + m * 16) * ldc + col0;
#pragma unroll
                for (int bj = 0; bj < 2; ++bj) { const f32x4 v0 = acc[ai][bj][m][0], v1 = acc[ai][bj][m][1];
                    u32x4 w; w.x = cvt_pk_bf16(v0[0], v0[1]); w.y = cvt_pk_bf16(v0[2], v0[3]); w.z = cvt_pk_bf16(v1[0], v1[1]); w.w = cvt_pk_bf16(v1[2], v1[3]);
                    *(u32x4*)(rowp + bj * HALF) = w; } }
    }
};

template <class Epi, class Sched>
__device__ __forceinline__ void gemm_phase(LAS unsigned char* lds, const Gemm g, const Sched& S, const Epi& E) {
    const int tid = threadIdx.x, wid = __builtin_amdgcn_readfirstlane(tid >> 6), lane = tid & 63, wr = wid >> 2, wc = wid & 3, fr = lane & 15, fq = lane >> 4;
    const int K = g.K, nt = K / BK;
    unsigned voffA[2], voffB[2];
#pragma unroll
    for (int i = 0; i < 2; ++i) { int R, C; stage_rc(tid * 16 + i * 8192, R, C); const int Rb = Epi::PERM ? ((R & ~31) + perm32(R & 31)) : R;
        voffA[i] = (unsigned)(R * K + C) * 2u; voffB[i] = (unsigned)(Rb * K + C) * 2u; }
    const size_t kstep = (size_t)(BK * 2);
    const size_t hstep = (size_t)HALF * K * 2;
    const size_t tstep = 2 * hstep;
    const unsigned ldsw = (unsigned)wid * 1024u;
    const int aoff = lds_byte(wr * 64 + fr, fq * 8), boff = lds_byte(wc * 32 + fr, fq * 8);
#define PG8_SA(b, h) (((b) * 2 + (h)) * HTB)
#define PG8_SB(b, h) ((4 + (b) * 2 + (h)) * HTB)
#define PG8_STAGE(bufoff, gbase, voff) do { _Pragma("unroll") for (int _i = 0; _i < 2; ++_i) \
        __builtin_amdgcn_global_load_lds((const unsigned*)((const char*)(gbase) + (voff)[_i]), (LAS unsigned*)(lds + (bufoff) + ldsw + _i * 8192), 16, 0, 0); } while (0)
#define PG8_LDA(dst, b, h) do { _Pragma("unroll") for (int m = 0; m < 4; ++m) _Pragma("unroll") for (int k = 0; k < 2; ++k) dst[m][k] = *(const LAS bf16x8*)(lds + PG8_SA(b, h) + aoff + m * 2048 + k * 1024); } while (0)
#define PG8_LDB(dst, b, h) do { _Pragma("unroll") for (int n = 0; n < 2; ++n) _Pragma("unroll") for (int k = 0; k < 2; ++k) dst[n][k] = *(const LAS bf16x8*)(lds + PG8_SB(b, h) + boff + n * 2048 + k * 1024); } while (0)
#define PG8_MMA(ai, bj, At, Bt) do { __builtin_amdgcn_s_setprio(1); _Pragma("unroll") for (int m = 0; m < 4; ++m) _Pragma("unroll") for (int n = 0; n < 2; ++n) _Pragma("unroll") for (int k = 0; k < 2; ++k) \
        acc[ai][bj][m][n] = __builtin_amdgcn_mfma_f32_16x16x32_bf16(Bt[n][k], At[m][k], acc[ai][bj][m][n], 0, 0, 0); __builtin_amdgcn_s_setprio(0); } while (0)
#define PG8_WAIT_V(n) asm volatile("s_waitcnt vmcnt(" #n ")" ::: "memory")
#define PG8_WAIT_L(n) asm volatile("s_waitcnt lgkmcnt(" #n ")" ::: "memory")
#define PG8_BAR __builtin_amdgcn_s_barrier()
#define PG8_SCHED __builtin_amdgcn_sched_barrier(0)
    Unit cur, nxt; int ui = 0;
    if (!S.next(0, cur)) return;
    f32x4 acc[2][2][4][2];
#pragma unroll
    for (int a = 0; a < 2; ++a)
#pragma unroll
        for (int b = 0; b < 2; ++b)
#pragma unroll
            for (int m = 0; m < 4; ++m)
#pragma unroll
                for (int n = 0; n < 2; ++n) acc[a][b][m][n] = (f32x4){0.f, 0.f, 0.f, 0.f};
    bf16x8 At[4][2], B0[2][2], B1[2][2];
    const char* cA = (const char*)g.A + (size_t)cur.pm * tstep; const char* cB = (const char*)g.Bt + (size_t)cur.pn * tstep;
    S.a_ready(cur);
    PG8_STAGE(PG8_SB(0, 0), cB, voffB); PG8_STAGE(PG8_SA(0, 0), cA, voffA); PG8_STAGE(PG8_SB(0, 1), cB + hstep, voffB); PG8_STAGE(PG8_SA(0, 1), cA + hstep, voffA);
    if (wr == 1) PG8_BAR;
    PG8_WAIT_V(4); PG8_BAR;
    PG8_STAGE(PG8_SB(1, 0), cB + kstep, voffB); PG8_STAGE(PG8_SA(1, 0), cA + kstep, voffA); PG8_STAGE(PG8_SB(1, 1), cB + hstep + kstep, voffB);
    PG8_WAIT_V(6); PG8_BAR;
    for (;;) {
        const bool has_next = S.next(ui + 1, nxt);
        const char* nA = has_next ? (const char*)g.A + (size_t)nxt.pm * tstep : cA; const char* nB = has_next ? (const char*)g.Bt + (size_t)nxt.pn * tstep : cB;
        for (int t = 0; t < nt; t += 2) {
            const bool last = (t == nt - 2);
            const char* a1 = cA + (size_t)(t + 1) * kstep;
            const char* a2 = last ? nA : cA + (size_t)(t + 2) * kstep; const char* b2 = last ? nB : cB + (size_t)(t + 2) * kstep;
            const char* a3 = a2 + kstep; const char* b3 = b2 + kstep;
            if (last && has_next) S.a_ready(nxt);
            PG8_LDB(B0, 0, 0); PG8_SCHED; PG8_LDA(At, 0, 0); PG8_STAGE(PG8_SA(1, 1), a1 + hstep, voffA);
            PG8_WAIT_L(8); PG8_BAR; PG8_WAIT_L(0); PG8_MMA(0, 0, At, B0); PG8_BAR; PG8_SCHED;
            PG8_LDB(B1, 0, 1); PG8_STAGE(PG8_SB(0, 0), b2, voffB);
            PG8_BAR; PG8_WAIT_L(0); PG8_MMA(0, 1, At, B1); PG8_BAR;
            PG8_LDA(At, 0, 1); PG8_STAGE(PG8_SA(0, 0), a2, voffA);
            PG8_BAR; PG8_WAIT_L(0); PG8_MMA(1, 0, At, B0); PG8_BAR; PG8_SCHED;
            PG8_STAGE(PG8_SB(0, 1), b2 + hstep, voffB);
            PG8_WAIT_V(6); PG8_BAR; PG8_MMA(1, 1, At, B1); PG8_BAR;
            PG8_LDB(B0, 1, 0); PG8_SCHED; PG8_LDA(At, 1, 0); PG8_STAGE(PG8_SA(0, 1), a2 + hstep, voffA);
            PG8_WAIT_L(8); PG8_BAR; PG8_WAIT_L(0); PG8_MMA(0, 0, At, B0); PG8_BAR; PG8_SCHED;
            PG8_LDB(B1, 1, 1); PG8_STAGE(PG8_SB(1, 0), b3, voffB);
            PG8_BAR; PG8_WAIT_L(0); PG8_MMA(0, 1, At, B1); PG8_BAR;
            PG8_LDA(At, 1, 1); PG8_STAGE(PG8_SA(1, 0), a3, voffA);
            PG8_BAR; PG8_WAIT_L(0); PG8_MMA(1, 0, At, B0); PG8_BAR; PG8_SCHED;
            PG8_STAGE(PG8_SB(1, 1), b3 + hstep, voffB);
            PG8_WAIT_V(6); PG8_BAR; PG8_MMA(1, 1, At, B1); PG8_BAR;
        }
        E(acc, cur, wr, wc, fr, fq); S.done(cur);
        if (!has_next) break;
#pragma unroll
        for (int a = 0; a < 2; ++a)
#pragma unroll
            for (int b = 0; b < 2; ++b)
#pragma unroll
                for (int m = 0; m < 4; ++m)
#pragma unroll
                    for (int n = 0; n < 2; ++n) acc[a][b][m][n] = (f32x4){0.f, 0.f, 0.f, 0.f};
        cur = nxt; cA = nA; cB = nB; ++ui;
    }
    PG8_WAIT_V(0);
    if (wr == 0) PG8_BAR;
    PG8_BAR;
#undef PG8_SA
#undef PG8_SB
#undef PG8_STAGE
#undef PG8_LDA
#undef PG8_LDB
#undef PG8_MMA
#undef PG8_WAIT_V
#undef PG8_WAIT_L
#undef PG8_BAR
#undef PG8_SCHED
}
}

__device__ __forceinline__ void rmsnorm_rows(const float* X, const float* gain, bf16_t* H) {
    const int wave = threadIdx.x >> 6, lane = threadIdx.x & 63;
    for (int row = blockIdx.x * 8 + wave; row < S_; row += gridDim.x * 8) {
        const float4* xr = (const float4*)(X + (size_t)row * D_);
        float4 v[8]; float ss = 0.f;
#pragma unroll
        for (int i = 0; i < 8; ++i) { v[i] = xr[i * 64 + lane]; ss += v[i].x * v[i].x + v[i].y * v[i].y + v[i].z * v[i].z + v[i].w * v[i].w; }
        ss = wave_sum(ss);
        const float sc = rsqrtf(ss * (1.0f / 2048.0f) + 1e-6f);
#pragma unroll
        for (int i = 0; i < 8; ++i) { const float4 g = ((const float4*)gain)[i * 64 + lane];
            u32x2 w; w.x = cvt_pk_bf16(v[i].x * sc * g.x, v[i].y * sc * g.y); w.y = cvt_pk_bf16(v[i].z * sc * g.z, v[i].w * sc * g.w);
            *(u32x2*)(H + (size_t)row * D_ + (i * 64 + lane) * 4) = w; }
    }
}

__device__ __forceinline__ void transpose_convert(const float* W, int K, int N, bf16_t* Bt, float* tile, int bid, int nblk) {
    const int tid = threadIdx.x; const int tk = K / 64, tn = N / 64, nt = tk * tn;
    float4 rg[2];
#define TC_LOAD(u) do { const int _k0 = ((u) / tn) * 64, _n0 = ((u) % tn) * 64; _Pragma("unroll") for (int i = 0; i < 2; ++i) { const int idx = tid + 512 * i; \
        rg[i] = *(const float4*)(W + (size_t)(_k0 + (idx >> 4)) * N + _n0 + (idx & 15) * 4); } } while (0)
    if (bid < nt) TC_LOAD(bid);
    for (int u = bid; u < nt; u += nblk) {
        const int k0 = (u / tn) * 64, n0 = (u % tn) * 64;
        __syncthreads();
#pragma unroll
        for (int i = 0; i < 2; ++i) { const int idx = tid + 512 * i; float* q = tile + (idx >> 4) * 65 + (idx & 15) * 4; q[0] = rg[i].x; q[1] = rg[i].y; q[2] = rg[i].z; q[3] = rg[i].w; }
        __syncthreads();
        if (u + nblk < nt) TC_LOAD(u + nblk);
#pragma unroll
        for (int i = 0; i < 4; ++i) { const int nn = i * 16 + (tid >> 5), kp = (tid & 31) * 2;
            *(unsigned*)(Bt + (size_t)(n0 + nn) * K + k0 + kp) = cvt_pk_bf16(tile[kp * 65 + nn], tile[(kp + 1) * 65 + nn]); }
    }
#undef TC_LOAD
}

__device__ __forceinline__ void convert_flat(const float* src, bf16_t* dst, size_t n) {
    for (size_t i = ((size_t)blockIdx.x * 512 + threadIdx.x) * 8; i < n; i += (size_t)gridDim.x * 512 * 8) {
        const float4 a = *(const float4*)(src + i), b = *(const float4*)(src + i + 4);
        u32x4 w; w.x = cvt_pk_bf16(a.x, a.y); w.y = cvt_pk_bf16(a.z, a.w); w.z = cvt_pk_bf16(b.x, b.y); w.w = cvt_pk_bf16(b.z, b.w);
        *(u32x4*)(dst + i) = w;
    }
}

__device__ __forceinline__ void convert_fp8(const float* src, unsigned char* dst, size_t n, float sc, const float* colgain, int bid, int nblk) {
    const int lane = threadIdx.x & 63, wv = threadIdx.x >> 6;
    for (size_t base = ((size_t)bid * 8 + wv) * 1024; base < n; base += (size_t)nblk * 8 * 1024) {
        float4 a[4];
#pragma unroll
        for (int j = 0; j < 4; ++j) a[j] = *(const float4*)(src + base + (size_t)(j * 64 + lane) * 4);
#pragma unroll
        for (int j = 0; j < 4; ++j) { float4 gg = make_float4(sc, sc, sc, sc);
            if (colgain) { const float4 cgv = *(const float4*)(colgain + ((base + (size_t)(j * 64 + lane) * 4) & 2047)); gg.x *= cgv.x; gg.y *= cgv.y; gg.z *= cgv.z; gg.w *= cgv.w; }
            int x = __builtin_amdgcn_cvt_pk_fp8_f32(a[j].x * gg.x, a[j].y * gg.y, 0, false); x = __builtin_amdgcn_cvt_pk_fp8_f32(a[j].z * gg.z, a[j].w * gg.w, x, true);
            *(unsigned*)(dst + base + (size_t)(j * 64 + lane) * 4) = (unsigned)x; }
    }
}

constexpr int ROW6 = 1536;
constexpr float U6_SCALE = 56.f, V6_SCALE = 28.f;
__device__ __forceinline__ void convert_fp6(const float* src, unsigned char* dst, int nrows, float sc, const float* colgain, int bid, int nblk) {
    const int lane = threadIdx.x & 63, wv = threadIdx.x >> 6;
    float g[32];
#pragma unroll
    for (int j = 0; j < 8; ++j) { float4 cg = make_float4(1.f, 1.f, 1.f, 1.f); if (colgain) cg = *(const float4*)(colgain + (j * 64 + lane) * 4);
        g[j * 4] = sc * cg.x; g[j * 4 + 1] = sc * cg.y; g[j * 4 + 2] = sc * cg.z; g[j * 4 + 3] = sc * cg.w; }
    for (int row = bid * 8 + wv; row < nrows; row += nblk * 8) {
        f32x32 x;
#pragma unroll
        for (int j = 0; j < 8; ++j) { const f32x4 a = __builtin_nontemporal_load((const f32x4*)(src + (size_t)row * 2048 + (j * 64 + lane) * 4));
            x[j * 4] = a[0] * g[j * 4]; x[j * 4 + 1] = a[1] * g[j * 4 + 1]; x[j * 4 + 2] = a[2] * g[j * 4 + 2]; x[j * 4 + 3] = a[3] * g[j * 4 + 3]; }
        const bf16x32_t b = __builtin_convertvector(x, bf16x32_t);
        const u32x6 wv6 = __builtin_amdgcn_cvt_scalef32_pk32_fp6_bf16(b, 1.0f);
        *(u32x4*)(dst + (size_t)row * ROW6 + lane * 16) = (u32x4){wv6[0], wv6[1], wv6[2], wv6[3]};
        *(u32x2*)(dst + (size_t)row * ROW6 + 1024 + lane * 8) = (u32x2){wv6[4], wv6[5]};
    }
}

__device__ __forceinline__ void convert_fp6s(const float* src, unsigned char* dst, int nrows, float sc, const float* colgain, int bid, int nblk) {
    const int lane = threadIdx.x & 63, wv = threadIdx.x >> 6, x = lane >> 3, pt = lane & 7;
    float g[32];
#pragma unroll
    for (int j = 0; j < 8; ++j) { float4 cg = make_float4(1.f, 1.f, 1.f, 1.f); if (colgain) cg = *(const float4*)(colgain + x * 256 + (j * 8 + pt) * 4);
        g[j * 4] = sc * cg.x; g[j * 4 + 1] = sc * cg.y; g[j * 4 + 2] = sc * cg.z; g[j * 4 + 3] = sc * cg.w; }
    for (int row = bid * 8 + wv; row < nrows; row += nblk * 8) {
        f32x32 v;
#pragma unroll
        for (int j = 0; j < 8; ++j) { const f32x4 a = __builtin_nontemporal_load((const f32x4*)(src + (size_t)row * 2048 + x * 256 + (j * 8 + pt) * 4));
            v[j * 4] = a[0] * g[j * 4]; v[j * 4 + 1] = a[1] * g[j * 4 + 1]; v[j * 4 + 2] = a[2] * g[j * 4 + 2]; v[j * 4 + 3] = a[3] * g[j * 4 + 3]; }
        const bf16x32_t b = __builtin_convertvector(v, bf16x32_t);
        const u32x6 w6 = __builtin_amdgcn_cvt_scalef32_pk32_fp6_bf16(b, 1.0f);
        unsigned char* q = dst + ((size_t)x * 16384 + row) * 192 + pt * 24;
        *(u32x2*)q = (u32x2){w6[0], w6[1]}; *(u32x2*)(q + 8) = (u32x2){w6[2], w6[3]}; *(u32x2*)(q + 16) = (u32x2){w6[4], w6[5]};
    }
}

__device__ __forceinline__ void build_wpt(const float* wq, const float* gain, const bf16_t* KEYB, bf16_t* WPT, int bid, int nblk) {
    const int w = threadIdx.x >> 6, lane = threadIdx.x & 63, fr = lane & 15, fq = lane >> 4;
    for (int task = bid * 8 + w; task < 16 * 128; task += nblk * 8) {
        const int g = task >> 7, kb = task & 127;
        f32x4 acc[8];
#pragma unroll
        for (int n = 0; n < 8; ++n) acc[n] = (f32x4){0.f, 0.f, 0.f, 0.f};
#pragma unroll 2
        for (int ks = 0; ks < 8; ++ks) {
            const float4* wp = (const float4*)(wq + (size_t)(kb * 16 + fr) * 4096 + g * 256 + ks * 32 + fq * 8);
            const float4 x0 = wp[0], x1 = wp[1]; const float gk = gain[kb * 16 + fr];
            u32x4 wv; wv.x = cvt_pk_bf16(x0.x * gk, x0.y * gk); wv.y = cvt_pk_bf16(x0.z * gk, x0.w * gk); wv.z = cvt_pk_bf16(x1.x * gk, x1.y * gk); wv.w = cvt_pk_bf16(x1.z * gk, x1.w * gk);
            const bf16x8 a = __builtin_bit_cast(bf16x8, wv);
#pragma unroll
            for (int n = 0; n < 8; ++n) {
                const bf16x8 b = *(const bf16x8*)(KEYB + (size_t)(g * 128 + n * 16 + fr) * 256 + ks * 32 + fq * 8);
                acc[n] = __builtin_amdgcn_mfma_f32_16x16x32_bf16(a, b, acc[n], 0, 0, 0);
            }
        }
#pragma unroll
        for (int n = 0; n < 8; ++n) { u32x2 o; o.x = cvt_pk_bf16(acc[n][0], acc[n][1]); o.y = cvt_pk_bf16(acc[n][2], acc[n][3]);
            *(u32x2*)(WPT + (size_t)(g * 128 + n * 16 + fr) * 2048 + kb * 16 + fq * 4) = o; }
    }
}

__device__ __forceinline__ void phase0(const Params& p, unsigned char* shm) {
    bf16_t* WB1 = (bf16_t*)(p.ws + WS_WB1);
    rmsnorm_rows(p.in[0], p.in[1], (bf16_t*)(p.ws + WS_H));
    transpose_convert(p.in[2], 2048, 6144, WB1, (float*)shm, blockIdx.x, gridDim.x);
    const float* mu = p.in[4]; const float* w1 = p.in[6]; const float* a1 = p.in[9]; const float* g1 = p.in[11];
    for (int idx = blockIdx.x * 512 + threadIdx.x; idx < 768 * 2048; idx += gridDim.x * 512) {
        const int j = idx >> 11, k = idx & 2047; float val = 0.f;
        if (j < 128) { const float m = mu[k], w = w1[k * 64 + (j & 63)]; val = (j < 64) ? w * (1.f - m) : w * m; }
        else if (j < 256) { const float m = mu[2048 + k], w = a1[k * 64 + (j & 63)]; val = (j < 192) ? w * (1.f - m) : w * m; }
        else if (j < 576) { const float m = mu[4096 + k]; const int jj = j - 256; const int c = jj < 160 ? jj : jj - 160; const float w = g1[k * 160 + c]; val = jj < 160 ? w * (1.f - m) : w * m; }
        WB1[(size_t)(6144 + j) * 2048 + k] = f2bf(val);
    }
    convert_flat(p.in[22], (bf16_t*)(p.ws + WS_KEYB), (size_t)8 * 2 * 128 * 256);
    bf16_t* W2T = (bf16_t*)(p.ws + WS_W2T); bf16_t* A2T = (bf16_t*)(p.ws + WS_A2T); bf16_t* G2T = (bf16_t*)(p.ws + WS_G2T);
    const float* w2 = p.in[7]; const float* a2 = p.in[10]; const float* g2 = p.in[12];
    for (int idx = blockIdx.x * 512 + threadIdx.x; idx < 1024 * 288; idx += gridDim.x * 512) {
        if (idx < 65536) { const int c = idx >> 6, j = idx & 63; W2T[idx] = f2bf(w2[j * 1024 + c]); }
        else if (idx < 131072) { const int i2 = idx - 65536; const int c = i2 >> 6, j = i2 & 63; A2T[i2] = f2bf(a2[j * 1024 + c]); }
        else { const int i2 = idx - 131072; const int c = i2 / 160, j = i2 % 160; G2T[i2] = f2bf(g2[j * 1024 + c]); }
    }
}

constexpr int ACT_LD = 296;
template <int KS, int KOFF, int KTOT, int KIND>
__device__ __forceinline__ void lora_stage(const LAS bf16_t* act, const bf16_t* WT, const float* bias, bf16_t* OUT, int t0, int w, int fr, int fq) {
#pragma unroll 1
    for (int nh = 0; nh < 2; ++nh) {
        f32x4 acc[4][4];
#pragma unroll
        for (int m = 0; m < 4; ++m)
#pragma unroll
            for (int n = 0; n < 4; ++n) acc[m][n] = (f32x4){0.f, 0.f, 0.f, 0.f};
        bf16x8 bfr[KS][4];
#pragma unroll
        for (int ks = 0; ks < KS; ++ks)
#pragma unroll
            for (int n = 0; n < 4; ++n) bfr[ks][n] = *(const bf16x8*)(WT + (size_t)(w * 128 + (nh * 4 + n) * 16 + fr) * KTOT + ks * 32 + fq * 8);
#pragma unroll
        for (int ks = 0; ks < KS; ++ks) {
            bf16x8 a[4];
#pragma unroll
            for (int m = 0; m < 4; ++m) a[m] = *(const LAS bf16x8*)(act + (m * 16 + fr) * ACT_LD + KOFF + ks * 32 + fq * 8);
#pragma unroll
            for (int n = 0; n < 4; ++n)
#pragma unroll
                for (int m = 0; m < 4; ++m) acc[m][n] = __builtin_amdgcn_mfma_f32_16x16x32_bf16(bfr[ks][n], a[m], acc[m][n], 0, 0, 0);
        }
#pragma unroll
        for (int n = 0; n < 4; ++n) {
            const int c = w * 128 + (nh * 4 + n) * 16 + fq * 4;
            float bs[4] = {0.f, 0.f, 0.f, 0.f};
            if (KIND < 2) { const float4 bv = *(const float4*)(bias + c); bs[0] = bv.x; bs[1] = bv.y; bs[2] = bv.z; bs[3] = bv.w; }
#pragma unroll
            for (int m = 0; m < 4; ++m) {
                float o[4];
#pragma unroll
                for (int j = 0; j < 4; ++j) {
                    const float val = acc[m][n][j];
                    if (KIND == 0) { const float x = -(bs[j] + val); const float sp = fmaxf(x, 0.f) + __logf(1.f + __expf(-fabsf(x))); o[j] = -__expf(-sp - 0.5f); }
                    else if (KIND == 1) o[j] = sigmoidf_(bs[j] + val);
                    else o[j] = val;
                }
                u32x2 wv; wv.x = cvt_pk_bf16(o[0], o[1]); wv.y = cvt_pk_bf16(o[2], o[3]);
                *(u32x2*)(OUT + (size_t)(t0 + m * 16 + fr) * DR + c) = wv;
            }
        }
    }
}
__device__ __forceinline__ void phase_prepM(const Params& p, LAS unsigned char* lds) {
    LAS bf16_t* act = (LAS bf16_t*)lds;
    const bf16_t* P = (const bf16_t*)(p.ws + WS_PROJ);
    const int tid = threadIdx.x, w = tid >> 6, lane = tid & 63, fr = lane & 15, fq = lane >> 4;
    for (int tile = blockIdx.x; tile < S_ / 64; tile += gridDim.x) {
        const int t0 = tile * 64;
        __syncthreads();
        for (int task = tid; task < 64 * 36; task += 512) {
            const int t = task / 36, j0 = (task % 36) * 8; const int tg = t0 + t;
            int ccur, cprev;
            if (j0 < 64) { ccur = 6144 + j0; cprev = 6208 + j0; }
            else if (j0 < 128) { ccur = 6272 + (j0 - 64); cprev = 6336 + (j0 - 64); }
            else { ccur = 6400 + (j0 - 128); cprev = 6560 + (j0 - 128); }
            float cu[8], pv[8], o8[8];
            unpack8(*(const u32x4*)(P + (size_t)tg * NAUG + ccur), cu);
            if (tg > 0) unpack8(*(const u32x4*)(P + (size_t)(tg - 1) * NAUG + cprev), pv);
            else {
#pragma unroll
                for (int i = 0; i < 8; ++i) pv[i] = 0.f;
            }
#pragma unroll
            for (int i = 0; i < 8; ++i) { const float sv = cu[i] + pv[i];
                o8[i] = j0 < 64 ? (1.f - 2.f / (1.f + __expf(2.f * sv))) : (j0 < 128 ? sv : sigmoidf_(sv)); }
            *(LAS u32x4*)(act + t * ACT_LD + j0) = pack8(o8);
        }
        __syncthreads();
        lora_stage<2, 0, 64, 0>(act, (const bf16_t*)(p.ws + WS_W2T), p.in[5], (bf16_t*)(p.ws + WS_LW), t0, w, fr, fq);
        lora_stage<2, 64, 64, 1>(act, (const bf16_t*)(p.ws + WS_A2T), p.in[8], (bf16_t*)(p.ws + WS_A), t0, w, fr, fq);
        lora_stage<5, 128, 160, 2>(act, (const bf16_t*)(p.ws + WS_G2T), nullptr, (bf16_t*)(p.ws + WS_G), t0, w, fr, fq);
    }
}

__device__ __forceinline__ void phase_prepE(const Params& p) {
    const bf16_t* P = (const bf16_t*)(p.ws + WS_PROJ);
    bf16_t* R = (bf16_t*)(p.ws + WS_R); bf16_t* Kk = (bf16_t*)(p.ws + WS_K); bf16_t* V = (bf16_t*)(p.ws + WS_V); bf16_t* KK = (bf16_t*)(p.ws + WS_KK); bf16_t* YC = (bf16_t*)(p.ws + WS_YC);
    const float* mu_rkv = p.in[3]; const float* k_k = p.in[13]; const float* cw = p.in[18];
    const int tid = threadIdx.x, cg = tid & 127, c0 = cg * 8, tgrp = tid >> 7;
    float mr[8], mk[8], mv[8], kkc[8], cw0[8], cw1[8], cw2[8];
#pragma unroll
    for (int i = 0; i < 8; ++i) { mr[i] = mu_rkv[c0 + i]; mk[i] = mu_rkv[1024 + c0 + i]; mv[i] = mu_rkv[2048 + c0 + i]; kkc[i] = k_k[c0 + i]; cw0[i] = cw[c0 + i]; cw1[i] = cw[1024 + c0 + i]; cw2[i] = cw[2048 + c0 + i]; }
    for (int run = blockIdx.x * 4 + tgrp; run < S_ / 16; run += gridDim.x * 4) {
        const int t0 = run * 16;
        float pr[8], pk[8], pv[8], u1[8], u2[8];
#pragma unroll
        for (int i = 0; i < 8; ++i) { pr[i] = 0.f; pk[i] = 0.f; pv[i] = 0.f; u1[i] = 0.f; u2[i] = 0.f; }
        if (t0 > 0) {
            const size_t o = (size_t)(t0 - 1) * NAUG + c0;
            unpack8(*(const u32x4*)(P + o), pr); unpack8(*(const u32x4*)(P + o + 1024), pk); unpack8(*(const u32x4*)(P + o + 2048), pv);
            float x[8], y[8];
            unpack8(*(const u32x4*)(P + o + 4096), x); unpack8(*(const u32x4*)(P + o + 5120), y);
#pragma unroll
            for (int i = 0; i < 8; ++i) u1[i] = x[i] * y[i];
            unpack8(*(const u32x4*)(P + o - NAUG + 4096), x); unpack8(*(const u32x4*)(P + o - NAUG + 5120), y);
#pragma unroll
            for (int i = 0; i < 8; ++i) u2[i] = x[i] * y[i];
        }
        u32x4 nx[6];
        { const size_t o = (size_t)t0 * NAUG + c0;
#pragma unroll
          for (int q = 0; q < 6; ++q) nx[q] = *(const u32x4*)(P + o + 1024 * q); }
#pragma unroll 1
        for (int t = 0; t < 16; ++t) {
            float cr[8], ck[8], cv[8], bg[8], cgt[8], xc[8];
            unpack8(nx[0], cr); unpack8(nx[1], ck); unpack8(nx[2], cv); unpack8(nx[3], bg); unpack8(nx[4], cgt); unpack8(nx[5], xc);
            { const size_t o = (size_t)(t0 + (t < 15 ? t + 1 : t)) * NAUG + c0;
#pragma unroll
              for (int q = 0; q < 6; ++q) nx[q] = *(const u32x4*)(P + o + 1024 * q); }
            float r[8], k[8], v[8], kkv[8], yc[8]; float ss = 0.f;
#pragma unroll
            for (int i = 0; i < 8; ++i) {
                r[i] = cr[i] + (pr[i] - cr[i]) * mr[i]; k[i] = ck[i] + (pk[i] - ck[i]) * mk[i]; v[i] = cv[i] + (pv[i] - cv[i]) * mv[i];
                pr[i] = cr[i]; pk[i] = ck[i]; pv[i] = cv[i];
                kkv[i] = k[i] * kkc[i]; ss += kkv[i] * kkv[i];
                const float u0 = cgt[i] * xc[i];
                yc[i] = bg[i] * (cw0[i] * u2[i] + cw1[i] * u1[i] + cw2[i] * u0);
                u2[i] = u1[i]; u1[i] = u0;
            }
            ss += dpp_f<0xB1, 0xf>(ss); ss += dpp_f<0x4E, 0xf>(ss); ss += dpp_f<0x141, 0xf>(ss);
            const float inv = 1.0f / fmaxf(sqrtf(ss), 1e-12f);
#pragma unroll
            for (int i = 0; i < 8; ++i) kkv[i] *= inv;
            const size_t oo = (size_t)(t0 + t) * DR + c0;
            *(u32x4*)(R + oo) = pack8(r); *(u32x4*)(Kk + oo) = pack8(k); *(u32x4*)(V + oo) = pack8(v); *(u32x4*)(KK + oo) = pack8(kkv); *(u32x4*)(YC + oo) = pack8(yc);
        }
    }
}

#define TILE(i) ((LAS bf16_t*)(lds + (i) * TSLOT))
__device__ __forceinline__ f32x4 mm_tile(f32x4 acc, const LAS bf16_t* A, const LAS bf16_t* Bt, int mi, int ni, int fr, int fq) {
#pragma unroll
    for (int ks = 0; ks < 2; ++ks) {
        const bf16x8 a = *(const LAS bf16x8*)(A + (mi * 16 + fr) * TLD + ks * 32 + fq * 8);
        const bf16x8 b = *(const LAS bf16x8*)(Bt + (ni * 16 + fr) * TLD + ks * 32 + fq * 8);
        acc = __builtin_amdgcn_mfma_f32_16x16x32_bf16(a, b, acc, 0, 0, 0);
    }
    return acc;
}
__device__ __forceinline__ void st_rm(LAS bf16_t* X, f32x4 v, int mi, int ni, int fr, int fq) {
    const unsigned w0 = cvt_pk_bf16(v[0], v[1]), w1 = cvt_pk_bf16(v[2], v[3]);
    LAS bf16_t* q = X + (mi * 16 + fq * 4) * TLD + ni * 16 + fr;
    q[0] = (bf16_t)(w0 & 0xffffu); q[TLD] = (bf16_t)(w0 >> 16); q[2 * TLD] = (bf16_t)(w1 & 0xffffu); q[3 * TLD] = (bf16_t)(w1 >> 16);
}
__device__ __forceinline__ void st_tr(LAS bf16_t* XT, f32x4 v, int mi, int ni, int fr, int fq) {
    u32x2 w; w.x = cvt_pk_bf16(v[0], v[1]); w.y = cvt_pk_bf16(v[2], v[3]);
    *(LAS u32x2*)(XT + (ni * 16 + fr) * TLD + mi * 16 + fq * 4) = w;
}
__device__ __forceinline__ f32x4 ld_rm(const LAS bf16_t* X, int mi, int ni, int fr, int fq) {
    const LAS bf16_t* q = X + (mi * 16 + fq * 4) * TLD + ni * 16 + fr;
    return (f32x4){bf2f(q[0]), bf2f(q[TLD]), bf2f(q[2 * TLD]), bf2f(q[3 * TLD])};
}
__device__ __forceinline__ f32x4 ld_tr(const LAS bf16_t* XT, int mi, int ni, int fr, int fq) {
    const u32x2 w = *(const LAS u32x2*)(XT + (ni * 16 + fr) * TLD + mi * 16 + fq * 4);
    return (f32x4){lo_bf(w.x), hi_bf(w.x), lo_bf(w.y), hi_bf(w.y)};
}

__device__ __forceinline__ void phase_chunkA(const Params& p, LAS unsigned char* lds) {
    const int tid = threadIdx.x, w = tid >> 6, lane = tid & 63, fr = lane & 15, fq = lane >> 4;
    const int mi = w >> 1, nb = (w & 1) * 2;
    LAS float* cl = (LAS float*)(lds + 14 * TSLOT);
    LAS float* gs = (LAS float*)(lds + 16 * TSLOT);
    LAS float* wc = gs + 512;
    const bf16_t* R = (const bf16_t*)(p.ws + WS_R); const bf16_t* Kk = (const bf16_t*)(p.ws + WS_K); const bf16_t* V = (const bf16_t*)(p.ws + WS_V);
    const bf16_t* KK = (const bf16_t*)(p.ws + WS_KK); const bf16_t* A = (const bf16_t*)(p.ws + WS_A); const bf16_t* LW = (const bf16_t*)(p.ws + WS_LW);
    bf16_t* GT = (bf16_t*)(p.ws + WS_GT); float* HT = (float*)(p.ws + WS_HT); bf16_t* QE = (bf16_t*)(p.ws + WS_QE); bf16_t* YL = (bf16_t*)(p.ws + WS_YL);
    const f32x4 z4 = (f32x4){0.f, 0.f, 0.f, 0.f};
    const float* k_a = p.in[14]; const float* r_k = p.in[15]; float* BON = (float*)(p.ws + WS_BON);
    u32x4 nr4, nk4, nv4, nkk4, na4, nlw4;
#define CA_LOAD(it) do { const size_t _go = (size_t)(((it) >> 4) * 64 + (tid >> 3)) * DR + ((it) & 15) * 64 + (tid & 7) * 8; \
        nr4 = *(const u32x4*)(R + _go); nk4 = *(const u32x4*)(Kk + _go); nv4 = *(const u32x4*)(V + _go); nkk4 = *(const u32x4*)(KK + _go); na4 = *(const u32x4*)(A + _go); nlw4 = *(const u32x4*)(LW + _go); } while (0)
    for (int item = blockIdx.x; item < 4096; item += gridDim.x) {
        const int c = item >> 4, h = item & 15;
        const int t = tid >> 3, k0 = (tid & 7) * 8;
        if (item == (int)blockIdx.x) CA_LOAD(item);
        const u32x4 r4 = nr4, k4 = nk4, v4 = nv4, kk4 = nkk4, a4 = na4, lw4 = nlw4;
        __syncthreads();
        {
            float lwf8[8]; unpack8(lw4, lwf8);
            *(LAS f32x4*)(cl + t * 64 + k0) = (f32x4){lwf8[0], lwf8[1], lwf8[2], lwf8[3]};
            *(LAS f32x4*)(cl + t * 64 + k0 + 4) = (f32x4){lwf8[4], lwf8[5], lwf8[6], lwf8[7]};
            __syncthreads();
            const int g = w, k = lane;
            float pfx[8]; float run = 0.f;
#pragma unroll
            for (int i = 0; i < 8; ++i) { run += cl[(g * 8 + i) * 64 + k]; pfx[i] = run; }
            gs[g * 64 + k] = run;
            __syncthreads();
            float off = 0.f;
#pragma unroll
            for (int gg = 0; gg < 7; ++gg) { const float x = gs[gg * 64 + k]; off += (gg < g) ? x : 0.f; }
#pragma unroll
            for (int i = 0; i < 8; ++i) cl[(g * 8 + i) * 64 + k] = off + pfx[i];
            if (g == 7) wc[k] = __expf(off + pfx[7]);
            __syncthreads();
        }
        if (item + (int)gridDim.x < 4096) CA_LOAD(item + (int)gridDim.x);
        {
            float at[8], rt[8], bt[8], kt[8], bh[8], kh[8], vv[8]; float bsum = 0.f;
#pragma unroll
            for (int i = 0; i < 8; ++i) {
                const int q = i >> 1; const bool hi = i & 1;
                const float rf = hi ? hi_bf(r4[q]) : lo_bf(r4[q]), kraw = hi ? hi_bf(k4[q]) : lo_bf(k4[q]), vf = hi ? hi_bf(v4[q]) : lo_bf(v4[q]);
                const float kkf = hi ? hi_bf(kk4[q]) : lo_bf(kk4[q]), af = hi ? hi_bf(a4[q]) : lo_bf(a4[q]), lwf = hi ? hi_bf(lw4[q]) : lo_bf(lw4[q]);
                const float kf = kraw * (1.f + (af - 1.f) * k_a[h * 64 + k0 + i]);
                bsum += rf * kf * r_k[h * 64 + k0 + i];
                const float clv = cl[t * 64 + k0 + i], cle = cl[63 * 64 + k0 + i];
                const float e = __expf(clv), ex = __expf(clv - lwf), ei = __expf(-clv), eh = __expf(cle - clv);
                const float bb = kkf * af;
                at[i] = -kkf * ex; rt[i] = rf * e; bt[i] = bb * ei; kt[i] = kf * ei; bh[i] = bb * eh; kh[i] = kf * eh; vv[i] = vf;
            }
            bsum += dpp_f<0xB1, 0xf>(bsum); bsum += dpp_f<0x4E, 0xf>(bsum); bsum += dpp_f<0x141, 0xf>(bsum);
            if ((tid & 7) == 0) BON[(size_t)(c * 64 + t) * 16 + h] = bsum;
            *(LAS u32x4*)(TILE(0) + t * TLD + k0) = pack8(at);
            *(LAS u32x4*)(TILE(2) + t * TLD + k0) = pack8(rt);
            *(LAS u32x4*)(TILE(3) + t * TLD + k0) = pack8(bt);
            *(LAS u32x4*)(TILE(4) + t * TLD + k0) = pack8(kt);
            const u32x4 atp = pack8(at), bhp = pack8(bh), khp = pack8(kh);
#pragma unroll
            for (int i = 0; i < 8; ++i) {
                const int q = i >> 1; const bool hi = i & 1;
                TILE(1)[(k0 + i) * TLD + t] = (bf16_t)(hi ? (atp[q] >> 16) : (atp[q] & 0xffffu));
                TILE(5)[(k0 + i) * TLD + t] = (bf16_t)(hi ? (bhp[q] >> 16) : (bhp[q] & 0xffffu));
                TILE(6)[(k0 + i) * TLD + t] = (bf16_t)(hi ? (khp[q] >> 16) : (khp[q] & 0xffffu));
                TILE(7)[(k0 + i) * TLD + t] = (bf16_t)(hi ? (v4[q] >> 16) : (v4[q] & 0xffffu));
            }
            __syncthreads();
        }
#pragma unroll
        for (int nn = 0; nn < 2; ++nn) {
            const int ni = nb + nn; const int col = ni * 16 + fr, row0 = mi * 16 + fq * 4;
            f32x4 x = mm_tile(z4, TILE(0), TILE(3), mi, ni, fr, fq);
#pragma unroll
            for (int j = 0; j < 4; ++j) x[j] = (col < row0 + j) ? x[j] : 0.f;
            st_rm(TILE(8), x, mi, ni, fr, fq); st_tr(TILE(9), x, mi, ni, fr, fq);
            x = mm_tile(z4, TILE(0), TILE(4), mi, ni, fr, fq);
#pragma unroll
            for (int j = 0; j < 4; ++j) x[j] = (col < row0 + j) ? x[j] : 0.f;
            st_rm(TILE(10), x, mi, ni, fr, fq);
            x = mm_tile(z4, TILE(2), TILE(3), mi, ni, fr, fq);
#pragma unroll
            for (int j = 0; j < 4; ++j) x[j] = (col <= row0 + j) ? x[j] : 0.f;
            st_rm(TILE(11), x, mi, ni, fr, fq);
            x = mm_tile(z4, TILE(2), TILE(4), mi, ni, fr, fq);
#pragma unroll
            for (int j = 0; j < 4; ++j) x[j] = (col <= row0 + j) ? x[j] : 0.f;
            st_rm(TILE(12), x, mi, ni, fr, fq);
        }
        __syncthreads();
#pragma unroll
        for (int nn = 0; nn < 2; ++nn) {
            const int ni = nb + nn;
            st_tr(TILE(13), mm_tile(z4, TILE(10), TILE(7), mi, ni, fr, fq), mi, ni, fr, fq);
            const f32x4 x = mm_tile(z4, TILE(8), TILE(9), mi, ni, fr, fq);
            st_rm(TILE(0), x, mi, ni, fr, fq); st_tr(TILE(3), x, mi, ni, fr, fq);
        }
        __syncthreads();
#pragma unroll
        for (int rd = 0; rd < 5; ++rd) {
            const int tq = (rd & 1) ? 14 : 8, tqo = (rd & 1) ? 8 : 14;
            const int lx = (rd & 1) ? 4 : 0, lxt = (rd & 1) ? 9 : 3, lxo = (rd & 1) ? 0 : 4, lxto = (rd & 1) ? 3 : 9;
#pragma unroll
            for (int nn = 0; nn < 2; ++nn) {
                const int ni = nb + nn;
                f32x4 x = ld_rm(TILE(tq), mi, ni, fr, fq) + ld_rm(TILE(lx), mi, ni, fr, fq);
                x = mm_tile(x, TILE(tq), TILE(lxt), mi, ni, fr, fq);
                st_rm(TILE(tqo), x, mi, ni, fr, fq);
                if (rd < 4) { const f32x4 y = mm_tile(z4, TILE(lx), TILE(lxt), mi, ni, fr, fq); st_rm(TILE(lxo), y, mi, ni, fr, fq); st_tr(TILE(lxto), y, mi, ni, fr, fq); }
            }
            __syncthreads();
        }
#pragma unroll
        for (int nn = 0; nn < 2; ++nn) {
            const int ni = nb + nn;
            st_tr(TILE(10), mm_tile(ld_tr(TILE(1), mi, ni, fr, fq), TILE(14), TILE(1), mi, ni, fr, fq), mi, ni, fr, fq);
            st_tr(TILE(15), mm_tile(ld_tr(TILE(13), mi, ni, fr, fq), TILE(14), TILE(13), mi, ni, fr, fq), mi, ni, fr, fq);
        }
        __syncthreads();
#pragma unroll
        for (int nn = 0; nn < 2; ++nn) {
            const int ni = nb + nn;
            {
                f32x4 x = mm_tile(z4, TILE(5), TILE(10), mi, ni, fr, fq);
                if (mi == ni) {
#pragma unroll
                    for (int j = 0; j < 4; ++j) x[j] += (fq * 4 + j == fr) ? wc[ni * 16 + fr] : 0.f;
                }
                const unsigned w0 = cvt_pk_bf16(x[0], x[1]), w1 = cvt_pk_bf16(x[2], x[3]);
                bf16_t* gp = GT + (size_t)item * 4096 + (size_t)((mi * 2 + (ni >> 1)) * 64 + (fr >> 2) * 16 + fq * 4) * 8 + (ni & 1) * 4 + (fr & 3);
                gp[0] = (bf16_t)(w0 & 0xffffu); gp[8] = (bf16_t)(w0 >> 16); gp[16] = (bf16_t)(w1 & 0xffffu); gp[24] = (bf16_t)(w1 >> 16);
            }
            {
                f32x4 x = mm_tile(z4, TILE(5), TILE(15), mi, ni, fr, fq);
                x = mm_tile(x, TILE(6), TILE(7), mi, ni, fr, fq);
                *(f32x4*)(HT + (size_t)item * 4096 + (size_t)((ni * 4 + mi) * 64 + lane) * 4) = x;
            }
            {
                f32x4 x = ld_tr(TILE(2), mi, ni, fr, fq);
                x = mm_tile(x, TILE(10), TILE(11), mi, ni, fr, fq);
                u32x2 wv; wv.x = cvt_pk_bf16(x[0], x[1]); wv.y = cvt_pk_bf16(x[2], x[3]);
                *(u32x2*)(QE + (size_t)item * 4096 + (ni * 16 + fr) * 64 + mi * 16 + fq * 4) = wv;
            }
            {
                f32x4 x = mm_tile(z4, TILE(11), TILE(15), mi, ni, fr, fq);
                x = mm_tile(x, TILE(12), TILE(7), mi, ni, fr, fq);
                u32x2 wv; wv.x = cvt_pk_bf16(x[0], x[1]); wv.y = cvt_pk_bf16(x[2], x[3]);
                *(u32x2*)(YL + (size_t)item * 4096 + (size_t)((mi * 4 + ni) * 64 + lane) * 4) = wv;
            }
        }
    }
}

__device__ __forceinline__ void phase_seq(const Params& p) {
    if (threadIdx.x >= 64) return;
    const int head = blockIdx.x >> 2, vt = blockIdx.x & 3, lane = threadIdx.x, fr = lane & 15, fq = lane >> 4;
    const bf16_t* GT = (const bf16_t*)(p.ws + WS_GT); const float* HT = (const float*)(p.ws + WS_HT); bf16_t* S0 = (bf16_t*)(p.ws + WS_S0);
    f32x4 acc[4];
#pragma unroll
    for (int mb = 0; mb < 4; ++mb) acc[mb] = (f32x4){0.f, 0.f, 0.f, 0.f};
    bf16x8 ga[4][4][2]; f32x4 hh[4][4];
#define SEQ_LOAD(buf, cc) do { const size_t _it = (size_t)((cc) < 256 ? (cc) : 255) * 16 + head; \
        _Pragma("unroll") for (int mb = 0; mb < 4; ++mb) { \
            _Pragma("unroll") for (int ks = 0; ks < 2; ++ks) ga[buf][mb][ks] = *(const bf16x8*)(GT + _it * 4096 + (size_t)((mb * 2 + ks) * 64 + lane) * 8); \
            hh[buf][mb] = *(const f32x4*)(HT + _it * 4096 + (size_t)((vt * 4 + mb) * 64 + lane) * 4); } } while (0)
    SEQ_LOAD(0, 0); SEQ_LOAD(1, 1); SEQ_LOAD(2, 2); SEQ_LOAD(3, 3);
    for (int c0 = 0; c0 < 256; c0 += 4) {
#pragma unroll
        for (int b = 0; b < 4; ++b) {
            const int c = c0 + b; const size_t item = (size_t)c * 16 + head;
            u32x2 pk[4];
#pragma unroll
            for (int mb = 0; mb < 4; ++mb) { pk[mb].x = cvt_pk_bf16(acc[mb][0], acc[mb][1]); pk[mb].y = cvt_pk_bf16(acc[mb][2], acc[mb][3]);
                *(u32x2*)(S0 + item * 4096 + (vt * 16 + fr) * 64 + mb * 16 + fq * 4) = pk[mb]; }
            u32x4 b0w, b1w; b0w.x = pk[0].x; b0w.y = pk[0].y; b0w.z = pk[1].x; b0w.w = pk[1].y; b1w.x = pk[2].x; b1w.y = pk[2].y; b1w.z = pk[3].x; b1w.w = pk[3].y;
            const bf16x8 b0 = __builtin_bit_cast(bf16x8, b0w), b1 = __builtin_bit_cast(bf16x8, b1w);
#pragma unroll
            for (int mb = 0; mb < 4; ++mb) {
                const f32x4 x = __builtin_amdgcn_mfma_f32_16x16x32_bf16(ga[b][mb][0], b0, hh[b][mb], 0, 0, 0);
                acc[mb] = __builtin_amdgcn_mfma_f32_16x16x32_bf16(ga[b][mb][1], b1, x, 0, 0, 0);
            }
            SEQ_LOAD(b, c + 4);
        }
    }
#undef SEQ_LOAD
}

__device__ __forceinline__ void phase_chunkY(const Params& p, LAS unsigned char* lds) {
    LAS float* Yb = (LAS float*)lds;
    const int tid = threadIdx.x, w = tid >> 6, lane = tid & 63, fr = lane & 15, fq = lane >> 4;
    const int mi = w >> 1, nb = (w & 1) * 2;
    const bf16_t* R = (const bf16_t*)(p.ws + WS_R); const bf16_t* Kk = (const bf16_t*)(p.ws + WS_K); const bf16_t* V = (const bf16_t*)(p.ws + WS_V);
    const bf16_t* G = (const bf16_t*)(p.ws + WS_G); const bf16_t* YC = (const bf16_t*)(p.ws + WS_YC);
    const bf16_t* QE = (const bf16_t*)(p.ws + WS_QE); const bf16_t* YL = (const bf16_t*)(p.ws + WS_YL); const bf16_t* S0 = (const bf16_t*)(p.ws + WS_S0);
    bf16_t* YM = (bf16_t*)(p.ws + WS_YMIX);
    const float* gn_w = p.in[16]; const float* gn_b = p.in[17];
    u32x2 ywn[2]; bf16x8 an[2], bn[2][2]; bool first = true;
    u32x4 nv4, ng4, nyc4; float nbon; const float* BONp = (const float*)(p.ws + WS_BON);
#define CY_LOAD(it) do { const bf16_t* _q = QE + (size_t)(it) * 4096; const bf16_t* _s = S0 + (size_t)(it) * 4096; const bf16_t* _y = YL + (size_t)(it) * 4096; \
        _Pragma("unroll") for (int ks = 0; ks < 2; ++ks) an[ks] = *(const bf16x8*)(_q + (mi * 16 + fr) * 64 + ks * 32 + fq * 8); \
        _Pragma("unroll") for (int nn = 0; nn < 2; ++nn) { ywn[nn] = *(const u32x2*)(_y + (size_t)((mi * 4 + nb + nn) * 64 + lane) * 4); \
            _Pragma("unroll") for (int ks = 0; ks < 2; ++ks) bn[nn][ks] = *(const bf16x8*)(_s + (nb + nn) * 16 * 64 + fr * 64 + ks * 32 + fq * 8); } \
        { const size_t _tg = (size_t)((it) >> 4) * 64 + (tid >> 3); const size_t _o = _tg * DR + ((it) & 15) * 64 + (tid & 7) * 8; \
          nv4 = *(const u32x4*)(V + _o); ng4 = *(const u32x4*)(G + _o); nyc4 = *(const u32x4*)(YC + _o); nbon = BONp[_tg * 16 + ((it) & 15)]; } } while (0)
    for (int item = blockIdx.x; item < 4096; item += gridDim.x) {
        const int c = item >> 4, h = item & 15;
        if (first) { first = false; CY_LOAD(item); }
        __syncthreads();
        const u32x2 ywc[2] = {ywn[0], ywn[1]}; const bf16x8 ac[2] = {an[0], an[1]}; const bf16x8 bc[2][2] = {{bn[0][0], bn[0][1]}, {bn[1][0], bn[1][1]}};
        const u32x4 v4 = nv4, g4 = ng4, yc4 = nyc4; const float bon = nbon;
        if (item + (int)gridDim.x < 4096) CY_LOAD(item + (int)gridDim.x);
#pragma unroll
        for (int nn = 0; nn < 2; ++nn) {
            const int ni = nb + nn;
            const u32x2 yw = ywc[nn];
            f32x4 acc = (f32x4){lo_bf(yw.x), hi_bf(yw.x), lo_bf(yw.y), hi_bf(yw.y)};
#pragma unroll
            for (int ks = 0; ks < 2; ++ks) acc = __builtin_amdgcn_mfma_f32_16x16x32_bf16(ac[ks], bc[nn][ks], acc, 0, 0, 0);
#pragma unroll
            for (int j = 0; j < 4; ++j) Yb[(mi * 16 + fq * 4 + j) * 68 + ni * 16 + fr] = acc[j];
        }
        __syncthreads();
        {
            const int t = tid >> 3, k0 = (tid & 7) * 8; const int ch = h * 64 + k0;
            const size_t tg = (size_t)c * 64 + t; const size_t o = tg * DR + ch;
            const float4 gw0 = *(const float4*)(gn_w + ch), gw1 = *(const float4*)(gn_w + ch + 4), gb0 = *(const float4*)(gn_b + ch), gb1 = *(const float4*)(gn_b + ch + 4);
            const float gwv[8] = {gw0.x, gw0.y, gw0.z, gw0.w, gw1.x, gw1.y, gw1.z, gw1.w}, gbv[8] = {gb0.x, gb0.y, gb0.z, gb0.w, gb1.x, gb1.y, gb1.z, gb1.w};
            const f32x4 y0 = *(const LAS f32x4*)(Yb + t * 68 + k0), y1 = *(const LAS f32x4*)(Yb + t * 68 + k0 + 4);
            const float y[8] = {y0[0], y0[1], y0[2], y0[3], y1[0], y1[1], y1[2], y1[3]};
            float sm = 0.f;
#pragma unroll
            for (int i = 0; i < 8; ++i) sm += y[i];
            sm += dpp_f<0xB1, 0xf>(sm); sm += dpp_f<0x4E, 0xf>(sm); sm += dpp_f<0x141, 0xf>(sm);
            const float mean = sm * (1.f / 64.f);
            float vs = 0.f;
#pragma unroll
            for (int i = 0; i < 8; ++i) { const float d = y[i] - mean; vs += d * d; }
            vs += dpp_f<0xB1, 0xf>(vs); vs += dpp_f<0x4E, 0xf>(vs); vs += dpp_f<0x141, 0xf>(vs);
            const float rs = rsqrtf(vs * (1.f / 64.f) + 64e-5f);
            float vf[8], gf[8], of[8];
            unpack8(v4, vf); unpack8(g4, gf);
#pragma unroll
            for (int i = 0; i < 8; ++i) of[i] = ((y[i] - mean) * rs * gwv[i] + gbv[i] + bon * vf[i]) * gf[i];
            *(u32x4*)(YM + tg * D_ + ch) = pack8(of);
            *(u32x4*)(YM + tg * D_ + 1024 + ch) = yc4;
        }
    }
#undef CY_LOAD
}

__device__ __forceinline__ int f2key(float x) { const int u = __float_as_int(x); return u ^ ((u >> 31) & 0x7fffffff); }
__device__ __forceinline__ float key2f(int k) { return __int_as_float(k ^ ((k >> 31) & 0x7fffffff)); }
template <int CTRL> __device__ __forceinline__ int dpp_i(int v) { return __builtin_amdgcn_update_dpp(v, v, CTRL, 0xf, 0xf, false); }
__device__ __forceinline__ int row_max_i(int v) { v = max(v, dpp_i<0xB1>(v)); v = max(v, dpp_i<0x4E>(v)); v = max(v, dpp_i<0x141>(v)); v = max(v, dpp_i<0x140>(v)); return v; }
__device__ __forceinline__ void phase_topk(const Params& p, unsigned char* shm) {
    float* sc = (float*)shm;
    int* tk = (int*)(sc + 64 * 260);
    int* ctab = tk + 2048;
    if (threadIdx.x < 64) { int n = threadIdx.x, v = 256;
        for (int i = 0; i < 16; ++i) { const int cnt = 16 / (i + 1); if (n < cnt) { v = i * 16 + n; break; } n -= cnt; }
        ctab[threadIdx.x] = v; }
    const float* SC = (const float*)(p.ws + WS_Q);
    int* IDS = (int*)(p.ws + WS_IDS); float* GATES = (float*)(p.ws + WS_GATES);
    const int tid = threadIdx.x, w = tid >> 6, lane = tid & 63;
    f32x4 qreg[8];
#define TK_QLOAD(it) do { const int _t0 = ((it) >> 3) * 64; _Pragma("unroll") for (int i = 0; i < 8; ++i) { const int ch = tid + 512 * i; \
        qreg[i] = *(const f32x4*)(SC + (size_t)(_t0 + (ch >> 6)) * 2048 + ((it) & 7) * 256 + (ch & 63) * 4); } } while (0)
    if ((int)blockIdx.x < 2048) TK_QLOAD((int)blockIdx.x);
    for (int item = blockIdx.x; item < 2048; item += gridDim.x) {
        const int t0 = (item >> 3) * 64, h = item & 7;
        __syncthreads();
#pragma unroll
        for (int i = 0; i < 8; ++i) { const int ch = tid + 512 * i; *(f32x4*)(sc + (ch >> 6) * 260 + (ch & 63) * 4) = qreg[i]; }
        __syncthreads();
        if (item + (int)gridDim.x < 2048) TK_QLOAD(item + (int)gridDim.x);
        for (int g = 0; g < 4; ++g) {
            const int L = w * 16 + g * 4 + (lane >> 4); const int tok = L >> 1, cc = L & 1; const int pp = lane & 15;
            int key[8];
#pragma unroll
            for (int i = 0; i < 8; ++i) key[i] = (f2key(sc[tok * 260 + cc * 128 + i * 16 + pp]) & ~127) | (127 - (i * 16 + pp));
#define CE(a, b) do { const int _hi = max(key[a], key[b]), _lo = min(key[a], key[b]); key[a] = _hi; key[b] = _lo; } while (0)
            CE(0, 1); CE(2, 3); CE(4, 5); CE(6, 7);  CE(0, 2); CE(1, 3); CE(4, 6); CE(5, 7);  CE(1, 2); CE(5, 6);
            CE(0, 4); CE(1, 5); CE(2, 6); CE(3, 7);  CE(2, 4); CE(3, 5);  CE(1, 2); CE(3, 4); CE(5, 6);
#undef CE
            int mykey = 0;
#pragma unroll
            for (int r = 0; r < 16; ++r) {
                const int m = row_max_i(key[0]);
                const bool win = (key[0] == m);
#pragma unroll
                for (int i = 0; i < 7; ++i) key[i] = win ? key[i + 1] : key[i];
                key[7] = win ? (int)0x80000000 : key[7];
                mykey = (pp == r) ? m : mykey;
            }
            tk[L * 16 + pp] = mykey;
        }
        __syncthreads();
        for (int g = 0; g < 2; ++g) {
            const int tok = w * 8 + g * 4 + (lane >> 4); const int pp = lane & 15;
            int key[4];
#pragma unroll
            for (int q = 0; q < 4; ++q) {
                const int ij = ctab[q * 16 + pp];
                const float s1 = key2f(tk[(tok * 2) * 16 + ((ij >> 4) & 15)] & ~127), s2 = key2f(tk[(tok * 2 + 1) * 16 + (ij & 15)] & ~127);
                key[q] = (ij < 256) ? ((f2key(s1 + s2) & ~255) | (255 - ij)) : (int)0x80000000;
            }
            int mykey = 0;
#pragma unroll
            for (int r = 0; r < 16; ++r) {
                const int ml = max(max(key[0], key[1]), max(key[2], key[3]));
                const int m = row_max_i(ml);
#pragma unroll
                for (int q = 0; q < 4; ++q) key[q] = (key[q] == m) ? (int)0x80000000 : key[q];
                mykey = (pp == r) ? m : mykey;
            }
            const int ci = 255 - (mykey & 255); const float cs = key2f(mykey & ~255);
            const int e1 = 127 - (tk[(tok * 2) * 16 + (ci >> 4)] & 127), e2 = 127 - (tk[(tok * 2 + 1) * 16 + (ci & 15)] & 127);
            const float mx = __shfl(cs, lane & 48);
            const float e = __expf(cs - mx);
            float sum = e; sum += dpp_f<0xB1, 0xf>(sum); sum += dpp_f<0x4E, 0xf>(sum); sum += dpp_f<0x141, 0xf>(sum); sum += dpp_f<0x140, 0xf>(sum);
            IDS[(size_t)(t0 + tok) * 128 + h * 16 + pp] = (e1 * 128 + e2) & 16383;
            GATES[(size_t)(t0 + tok) * 128 + h * 16 + pp] = e / sum;
        }
    }
#undef TK_QLOAD
}

__device__ __forceinline__ float gelu_fast(float x) { const float u = 0.7978845608028654f * (x + 0.044715f * x * x * x); return x / (1.0f + __expf(-2.0f * u)); }
__device__ __forceinline__ void phase_gather(const Params& p, unsigned char* shm) {
    const float* X1 = (const float*)(p.ws + WS_X1); const float* SSQ = (const float*)(p.ws + WS_SSQ);
    const unsigned char* U6 = p.ws + WS_UB; const unsigned char* V6 = p.ws + WS_VB;
    const int* IDS = (const int*)(p.ws + WS_IDS); const float* GATES = (const float*)(p.ws + WS_GATES);
    const float* nf = p.in[25];
    const int tid = threadIdx.x, w = tid >> 6, lane = tid & 63;
    int nid0 = 0, nid1 = 0; float ngt0 = 0.f, ngt1 = 0.f, nssq = 0.f;
#define GT_META(tt) do { nid0 = IDS[(size_t)(tt) * 128 + lane]; nid1 = IDS[(size_t)(tt) * 128 + 64 + lane]; ngt0 = GATES[(size_t)(tt) * 128 + lane]; ngt1 = GATES[(size_t)(tt) * 128 + 64 + lane]; \
        nssq = (lane < 32) ? SSQ[(size_t)(tt) * 32 + lane] : 0.f; } while (0)
    if ((int)(blockIdx.x * 8 + w) < S_) GT_META(blockIdx.x * 8 + w);
    for (int t = blockIdx.x * 8 + w; t < S_; t += gridDim.x * 8) {
        const int id0 = nid0, id1 = nid1; const float gt0 = ngt0, gt1 = ngt1, ssqv = nssq;
        if (t + (int)gridDim.x * 8 < S_) GT_META(t + (int)gridDim.x * 8);
        f32x2 op[16];
#pragma unroll
        for (int j = 0; j < 8; ++j) { const float4 x = *(const float4*)(X1 + (size_t)t * D_ + (j * 64 + lane) * 4);
            op[2 * j] = (f32x2){x.x, x.y}; op[2 * j + 1] = (f32x2){x.z, x.w}; }
        f32x2 hp[16];
#pragma unroll
        for (int i = 0; i < 16; ++i) hp[i] = op[i];
        const float rs = rsqrtf(wave_sum_dpp(ssqv) * (1.0f / 2048.0f) + 1e-6f);
        u32x4 uaA[4], ubA[4], vbA[4]; u32x2 uaB[4], ubB[4], vbB[4];
#define G_LOADU(dA, dB, grp) do { _Pragma("unroll") for (int j = 0; j < 4; ++j) { const int e = (grp) * 4 + j; const int id = __builtin_amdgcn_readlane(e < 64 ? id0 : id1, e & 63); \
            const unsigned char* ur = U6 + (size_t)id * ROW6; dA[j] = *(const u32x4*)(ur + lane * 16); dB[j] = *(const u32x2*)(ur + 1024 + lane * 8); } } while (0)
#define G_LOADV(grp) do { _Pragma("unroll") for (int j = 0; j < 4; ++j) { const int e = (grp) * 4 + j; const int id = __builtin_amdgcn_readlane(e < 64 ? id0 : id1, e & 63); \
            const unsigned char* vr = V6 + (size_t)id * ROW6; vbA[j] = *(const u32x4*)(vr + lane * 16); vbB[j] = *(const u32x2*)(vr + 1024 + lane * 8); } } while (0)
#define G_DEC(A, B) __builtin_amdgcn_cvt_scalef32_pk32_f32_fp6((u32x6){A[0], A[1], A[2], A[3], B[0], B[1]}, 1.0f)
#define G_BODY(cA, cB, nA, nB, grp) do { \
            G_LOADV(grp); \
            G_LOADU(nA, nB, ((grp) + 1 < 32 ? (grp) + 1 : 31)); \
            float dsel = 0.f; \
            _Pragma("unroll") for (int j = 0; j < 4; ++j) { const f32x32 dd = G_DEC(cA[j], cB[j]); f32x2 d2 = (f32x2){0.f, 0.f}; \
                _Pragma("unroll") for (int m = 0; m < 16; ++m) d2 += (f32x2){dd[2 * m], dd[2 * m + 1]} * hp[m]; \
                const float d = wave_sum_dpp(d2.x + d2.y); dsel = (lane == j) ? d : dsel; } \
            const float av = gelu_fast(dsel * (rs * (1.f / U6_SCALE))) * (1.f / V6_SCALE); \
            _Pragma("unroll") for (int j = 0; j < 4; ++j) { const int e = (grp) * 4 + j; \
                const float a = __int_as_float(__builtin_amdgcn_readlane(__float_as_int(av), j)) * __int_as_float(__builtin_amdgcn_readlane(__float_as_int(e < 64 ? gt0 : gt1), e & 63)); \
                const f32x2 a2 = (f32x2){a, a}; const f32x32 dd = G_DEC(vbA[j], vbB[j]); \
                _Pragma("unroll") for (int m = 0; m < 16; ++m) op[m] += a2 * (f32x2){dd[2 * m], dd[2 * m + 1]}; } \
        } while (0)
        G_LOADU(uaA, uaB, 0);
#pragma unroll 1
        for (int g2 = 0; g2 < 32; g2 += 2) { G_BODY(uaA, uaB, ubA, ubB, g2); G_BODY(ubA, ubB, uaA, uaB, g2 + 1); }
#undef G_LOADU
#undef G_LOADV
#undef G_DEC
#undef G_BODY
        float ss = 0.f;
#pragma unroll
        for (int m = 0; m < 16; ++m) ss += op[m].x * op[m].x + op[m].y * op[m].y;
        ss = wave_sum_dpp(ss);
        const float scl = rsqrtf(ss * (1.f / 2048.f) + 1e-6f);
#pragma unroll
        for (int j = 0; j < 8; ++j) { const float4 g = *(const float4*)(nf + (j * 64 + lane) * 4);
            *(float4*)(p.out + (size_t)t * D_ + (j * 64 + lane) * 4) = make_float4(op[2 * j].x * scl * g.x, op[2 * j].y * scl * g.y, op[2 * j + 1].x * scl * g.z, op[2 * j + 1].y * scl * g.w); }
    }
#undef GT_META
}

#define PEER_LD6(dstA, dstB, base, id) do { const unsigned char* _q = (base) + ((size_t)xs * 16384 + (id)) * 192 + pt * 24; dstA = *(const u32x4*)_q; dstB = *(const u32x2*)(_q + 16); } while (0)
#define PEER_DEC(A, B) __builtin_amdgcn_cvt_scalef32_pk32_f32_fp6((u32x6){A[0], A[1], A[2], A[3], B[0], B[1]}, 1.0f)
__device__ __forceinline__ void phase_peerZ(const Params& p) {
    const float* X1 = (const float*)(p.ws + WS_X1); const unsigned char* U6 = p.ws + WS_UB; const int* IDS = (const int*)(p.ws + WS_IDS);
    float* ZP = (float*)(p.ws + WS_ZP);
    const int lane = threadIdx.x & 63, w = threadIdx.x >> 6, es = lane >> 3, pt = lane & 7;
    const int xs = blockIdx.x & 7, nwg = (gridDim.x >> 3) * 8;
    int t = (blockIdx.x >> 3) * 8 + w;
    if (t >= S_) return;
    float4 nh[8];
#pragma unroll
    for (int j = 0; j < 8; ++j) nh[j] = *(const float4*)(X1 + (size_t)t * D_ + xs * 256 + (j * 8 + pt) * 4);
    int cid0 = IDS[(size_t)t * 128 + lane], cid1 = IDS[(size_t)t * 128 + 64 + lane], nid0 = 0, nid1 = 0;
    if (t + nwg < S_) { nid0 = IDS[(size_t)(t + nwg) * 128 + lane]; nid1 = IDS[(size_t)(t + nwg) * 128 + 64 + lane]; }
    u32x4 bA[8]; u32x2 bB[8];
#pragma unroll
    for (int g = 0; g < 8; ++g) { const int id = __shfl(cid0, g * 8 + es); PEER_LD6(bA[g], bB[g], U6, id); }
    for (; t < S_; t += nwg) {
        f32x2 hp[16];
#pragma unroll
        for (int j = 0; j < 8; ++j) { hp[2 * j] = (f32x2){nh[j].x, nh[j].y}; hp[2 * j + 1] = (f32x2){nh[j].z, nh[j].w}; }
        const bool has_next = (t + nwg < S_);
        if (has_next) {
#pragma unroll
            for (int j = 0; j < 8; ++j) nh[j] = *(const float4*)(X1 + (size_t)(t + nwg) * D_ + xs * 256 + (j * 8 + pt) * 4); }
        int n2id0 = 0, n2id1 = 0;
        if (t + 2 * nwg < S_) { n2id0 = IDS[(size_t)(t + 2 * nwg) * 128 + lane]; n2id1 = IDS[(size_t)(t + 2 * nwg) * 128 + 64 + lane]; }
#pragma unroll
        for (int g = 0; g < 16; ++g) {
            const f32x32 dd = PEER_DEC(bA[g & 7], bB[g & 7]);
            if (g + 8 < 16) { const int id = __shfl(cid1, ((g + 8) * 8 + es) & 63); PEER_LD6(bA[g & 7], bB[g & 7], U6, id); }
            else if (has_next) { const int id = __shfl(nid0, (g - 8) * 8 + es); PEER_LD6(bA[g & 7], bB[g & 7], U6, id); }
            f32x2 d2 = (f32x2){0.f, 0.f};
#pragma unroll
            for (int m = 0; m < 16; ++m) d2 += (f32x2){dd[2 * m], dd[2 * m + 1]} * hp[m];
            float d = d2.x + d2.y;
            d += dpp_f<0xB1, 0xf>(d); d += dpp_f<0x4E, 0xf>(d); d += dpp_f<0x141, 0xf>(d);
            if (pt == 0) ZP[((size_t)t * 8 + xs) * 128 + g * 8 + es] = d;
        }
        cid0 = nid0; cid1 = nid1; nid0 = n2id0; nid1 = n2id1;
    }
}
__device__ __forceinline__ void phase_peerV(const Params& p, LAS unsigned char* lds) {
    const float* X1 = (const float*)(p.ws + WS_X1); const unsigned char* V6 = p.ws + WS_VB; const int* IDS = (const int*)(p.ws + WS_IDS);
    const float* GATES = (const float*)(p.ws + WS_GATES); const float* ZP = (const float*)(p.ws + WS_ZP); const float* SSQ = (const float*)(p.ws + WS_SSQ);
    float* X2 = (float*)(p.ws + WS_X2); float* SSQ2 = (float*)(p.ws + WS_SSQ2);
    const int lane = threadIdx.x & 63, w = threadIdx.x >> 6, es = lane >> 3, pt = lane & 7;
    const int xs = blockIdx.x & 7, nwg = (gridDim.x >> 3) * 8;
    LAS float* red = (LAS float*)(lds + w * 8192);
    int t = (blockIdx.x >> 3) * 8 + w;
    if (t >= S_) return;
    float nz0 = 0.f, nz1 = 0.f, ng0 = 0.f, ng1 = 0.f, nsq = 0.f;
#define PV_META(tt) do { ng0 = GATES[(size_t)(tt) * 128 + lane]; ng1 = GATES[(size_t)(tt) * 128 + 64 + lane]; nsq = (lane < 32) ? SSQ[(size_t)(tt) * 32 + lane] : 0.f; \
        float _a = 0.f, _b = 0.f; _Pragma("unroll") for (int x = 0; x < 8; ++x) { _a += ZP[((size_t)(tt) * 8 + x) * 128 + lane]; _b += ZP[((size_t)(tt) * 8 + x) * 128 + 64 + lane]; } nz0 = _a; nz1 = _b; } while (0)
    PV_META(t);
    asm volatile("" : "+v"(nz0), "+v"(nz1), "+v"(ng0), "+v"(ng1), "+v"(nsq));
    int cid0 = IDS[(size_t)t * 128 + lane], cid1 = IDS[(size_t)t * 128 + 64 + lane], nid0 = 0, nid1 = 0;
    if (t + nwg < S_) { nid0 = IDS[(size_t)(t + nwg) * 128 + lane]; nid1 = IDS[(size_t)(t + nwg) * 128 + 64 + lane]; }
    u32x4 bA[4]; u32x2 bB[4];
#pragma unroll
    for (int g = 0; g < 4; ++g) { const int id = __shfl(cid0, g * 8 + es); PEER_LD6(bA[g], bB[g], V6, id); }
    for (; t < S_; t += nwg) {
        const float z0 = nz0, z1 = nz1, g0 = ng0, g1 = ng1, sq = nsq;
        const bool has_next = (t + nwg < S_);
        if (has_next) PV_META(t + nwg);
        int n2id0 = 0, n2id1 = 0;
        if (t + 2 * nwg < S_) { n2id0 = IDS[(size_t)(t + 2 * nwg) * 128 + lane]; n2id1 = IDS[(size_t)(t + 2 * nwg) * 128 + 64 + lane]; }
        const float rs = rsqrtf(wave_sum_dpp(sq) * (1.0f / 2048.0f) + 1e-6f);
        const float a0 = gelu_fast(z0 * (rs * (1.f / U6_SCALE))) * g0 * (1.f / V6_SCALE);
        const float a1 = gelu_fast(z1 * (rs * (1.f / U6_SCALE))) * g1 * (1.f / V6_SCALE);
        f32x2 op[16];
#pragma unroll
        for (int m = 0; m < 16; ++m) op[m] = (f32x2){0.f, 0.f};
#pragma unroll
        for (int g = 0; g < 16; ++g) {
            const f32x32 dd = PEER_DEC(bA[g & 3], bB[g & 3]);
            if (g + 4 < 16) { const int id = __shfl((g + 4) < 8 ? cid0 : cid1, ((g + 4) * 8 + es) & 63); PEER_LD6(bA[g & 3], bB[g & 3], V6, id); }
            else if (has_next) { const int id = __shfl(nid0, (g - 12) * 8 + es); PEER_LD6(bA[g & 3], bB[g & 3], V6, id); }
            const float a = __shfl(g < 8 ? a0 : a1, (g * 8 + es) & 63);
            const f32x2 a2 = (f32x2){a, a};
#pragma unroll
            for (int m = 0; m < 16; ++m) op[m] += a2 * (f32x2){dd[2 * m], dd[2 * m + 1]};
        }
#pragma unroll
        for (int k4 = 0; k4 < 8; ++k4) *(LAS f32x4*)(red + ((es * 8 + k4) * 8 + pt) * 4) = (f32x4){op[2 * k4].x, op[2 * k4].y, op[2 * k4 + 1].x, op[2 * k4 + 1].y};
        f32x4 sum = *(const f32x4*)(X1 + (size_t)t * D_ + xs * 256 + (es * 8 + pt) * 4);
#pragma unroll
        for (int e2 = 0; e2 < 8; ++e2) sum += *(const LAS f32x4*)(red + ((e2 * 8 + es) * 8 + pt) * 4);
        *(f32x4*)(X2 + (size_t)t * D_ + xs * 256 + (es * 8 + pt) * 4) = sum;
        const float ss = wave_sum_dpp(sum[0] * sum[0] + sum[1] * sum[1] + sum[2] * sum[2] + sum[3] * sum[3]);
        if (lane == 0) SSQ2[(size_t)t * 8 + xs] = ss;
        cid0 = nid0; cid1 = nid1; nid0 = n2id0; nid1 = n2id1;
    }
#undef PV_META
}
__device__ __forceinline__ void phase_final(const Params& p) {
    const float* X2 = (const float*)(p.ws + WS_X2); const float* SSQ2 = (const float*)(p.ws + WS_SSQ2); const float* nf = p.in[25];
    const int lane = threadIdx.x & 63, w = threadIdx.x >> 6;
    for (int t = blockIdx.x * 8 + w; t < S_; t += gridDim.x * 8) {
        const f32x4 s0 = *(const f32x4*)(SSQ2 + (size_t)t * 8), s1 = *(const f32x4*)(SSQ2 + (size_t)t * 8 + 4);
        const float scl = rsqrtf(((s0[0] + s0[1]) + (s0[2] + s0[3]) + (s1[0] + s1[1]) + (s1[2] + s1[3])) * (1.f / 2048.f) + 1e-6f);
#pragma unroll
        for (int j = 0; j < 8; ++j) { const float4 v = *(const float4*)(X2 + (size_t)t * D_ + (j * 64 + lane) * 4); const float4 g = *(const float4*)(nf + (j * 64 + lane) * 4);
            *(float4*)(p.out + (size_t)t * D_ + (j * 64 + lane) * 4) = make_float4(v.x * scl * g.x, v.y * scl * g.y, v.z * scl * g.z, v.w * scl * g.w); }
    }
}

#define XB_TMO      128
#define XB_XCNT(j)  (256  + 64 * (j))
#define XB_XSUB(j)  (1280 + 64 * (j))
#define XB_XGEN(j)  (2304 + 64 * (j))
#define XB_TOP      3328
#define XB_TOPGEN   3392
#define XCD_BAR_WORDS 3456
#define XB_SPIN_CAP (1u << 18)
__device__ __forceinline__ unsigned xb_ld(unsigned* p)              { return __hip_atomic_load(p, __ATOMIC_RELAXED, __HIP_MEMORY_SCOPE_AGENT); }
__device__ __forceinline__ unsigned xb_add(unsigned* p, unsigned v) { return __hip_atomic_fetch_add(p, v, __ATOMIC_RELAXED, __HIP_MEMORY_SCOPE_AGENT); }
__device__ __forceinline__ unsigned xb_xcc_id() { return (unsigned)__builtin_amdgcn_s_getreg((3 << 11) | 20) & 0xFu; }
#define XB_SPIN(cond, bar) do { unsigned _sp = 0; while (cond) { __builtin_amdgcn_s_sleep(1); \
    if ((++_sp & 255u) == 0u) { if (xb_ld(&(bar)[XB_TMO])) break; if (_sp > XB_SPIN_CAP) { atomicAdd(&(bar)[XB_TMO], 1u); break; } } } } while (0)
struct XcdBarrier { unsigned* bar; unsigned x; volatile LAS unsigned* st; };
__device__ __forceinline__ XcdBarrier xcd_barrier_post(unsigned* bar, volatile LAS unsigned* st) {
    XcdBarrier b; b.bar = bar; b.x = xb_xcc_id(); b.st = st;
    if (threadIdx.x == 0) (void)xb_add(&bar[XB_XCNT(b.x)], 1u);
    return b;
}
__device__ __forceinline__ void xcd_barrier_complete(unsigned* bar, unsigned x, unsigned& nloc, unsigned& nx) {
    const unsigned G = gridDim.x * gridDim.y * gridDim.z;
    unsigned sum, cnt, mine, sp = 0u;
    for (;;) {
        sum = 0u; cnt = 0u; mine = 0u;
#pragma unroll
        for (unsigned j = 0; j < 16; ++j) { const unsigned c = xb_ld(&bar[XB_XCNT(j)]); sum += c; cnt += (c > 0u) ? 1u : 0u; mine = (j == x) ? c : mine; }
        if (sum == G) break;
        __builtin_amdgcn_s_sleep(1);
        if ((++sp & 255u) == 0u) { if (xb_ld(&bar[XB_TMO])) break; if (sp > XB_SPIN_CAP) { atomicAdd(&bar[XB_TMO], 1u); break; } }
    }
    nloc = mine > 0u ? mine : 1u; nx = cnt > 0u ? cnt : 1u;
}
__device__ __forceinline__ void xcd_barrier(const XcdBarrier& b) {
    asm volatile("s_waitcnt vmcnt(0)" ::: "memory");
    __syncthreads();
    if (threadIdx.x == 0) {
        unsigned* bar = b.bar;
        __builtin_amdgcn_s_waitcnt(0);
        unsigned nloc = b.st[0], nx = b.st[1];
        if (nloc == 0u) { xcd_barrier_complete(bar, b.x, nloc, nx); b.st[0] = nloc; b.st[1] = nx; }
        const unsigned old = xb_add(&bar[XB_XSUB(b.x)], 1u);
        const unsigned gen = old / nloc;
        if (old + 1u == (gen + 1u) * nloc) {
            __builtin_amdgcn_fence(__ATOMIC_RELEASE, "agent");
            asm volatile("s_waitcnt vmcnt(0)" ::: "memory");
            const unsigned og = xb_add(&bar[XB_TOP], 1u);
            const unsigned tg = og / nx;
            if (og + 1u == (tg + 1u) * nx) xb_add(&bar[XB_TOPGEN], 1u);
            else XB_SPIN(xb_ld(&bar[XB_TOPGEN]) == tg, bar);
            __builtin_amdgcn_fence(__ATOMIC_ACQUIRE, "agent");
            xb_add(&bar[XB_XGEN(b.x)], 1u);
            asm volatile("s_waitcnt vmcnt(0)" ::: "memory");
        } else {
            XB_SPIN(xb_ld(&bar[XB_XGEN(b.x)]) == gen, bar);
            __builtin_amdgcn_fence(__ATOMIC_ACQUIRE, "agent");
            asm volatile("s_waitcnt vmcnt(0)" ::: "memory");
        }
    }
    __syncthreads();
}

__global__ void __launch_bounds__(512, 2) mega(Params p) {
    extern __shared__ __attribute__((aligned(16))) unsigned char shm[];
    cg::grid_group grid = cg::this_grid();
    LAS unsigned char* lds = (LAS unsigned char*)shm;
    volatile LAS unsigned* bst = (volatile LAS unsigned*)(lds + LDS_BYTES - 16);
    if (threadIdx.x == 0) { bst[0] = 0u; bst[1] = 0u; }
    __syncthreads();
    const XcdBarrier xbar = xcd_barrier_post((unsigned*)(p.ws + WS_BAR), bst);
    if (p.ph_hi > 1000) grid.sync();
    const int lo = p.ph_lo, hi = p.ph_hi;
#define IN(k) (lo <= (k) && (k) < hi)
#define REP(k) for (int _r = 0; _r < ((k) == DUP_PHASE ? 2 : 1); ++_r)
#define SEAM(k) do { if (IN(k) && IN((k) + 1)) xcd_barrier(xbar); } while (0)
    if (IN(0)) REP(0) { if (_r) xcd_barrier(xbar); phase0(p, shm); }
    SEAM(0);
    if (IN(1)) REP(1) { if (_r) xcd_barrier(xbar);
        pg8::Gemm g{(const bf16_t*)(p.ws + WS_H), (const bf16_t*)(p.ws + WS_WB1), S_, NAUG, 2048};
        pg8::StaticOrder so; so.init(g.M, g.N, (int)gridDim.x, (int)blockIdx.x);
        pg8::EpiBf16 E{(bf16_t*)(p.ws + WS_PROJ), NAUG};
        pg8::gemm_phase(lds, g, so, E);
    }
    SEAM(1);
    if (IN(2)) REP(2) { if (_r) xcd_barrier(xbar);
        phase_prepM(p, lds);
        phase_prepE(p);
    }
    SEAM(2);
    if (IN(3)) REP(3) { if (_r) xcd_barrier(xbar); phase_chunkA(p, lds); }
    SEAM(3);
    if (IN(4)) REP(4) { if (_r) xcd_barrier(xbar); if (blockIdx.x < 64) phase_seq(p);
        else { const int bid = blockIdx.x - 64, nblk = gridDim.x - 64;
            convert_fp6s(p.in[23], p.ws + WS_UB, 16384, U6_SCALE, p.in[20], bid, nblk);
            convert_fp6s(p.in[24], p.ws + WS_VB, 16384, V6_SCALE, nullptr, bid, nblk);
            build_wpt(p.in[21], p.in[20], (const bf16_t*)(p.ws + WS_KEYB), (bf16_t*)(p.ws + WS_WQT), bid, nblk);
            transpose_convert(p.in[19], 2048, 2048, (bf16_t*)(p.ws + WS_WOT), (float*)shm, bid, nblk); } }
    SEAM(4);
    if (IN(5)) REP(5) { if (_r) xcd_barrier(xbar); phase_chunkY(p, lds); }
    SEAM(5);
    if (IN(6)) REP(6) { if (_r) xcd_barrier(xbar);
        pg8::Gemm g{(const bf16_t*)(p.ws + WS_YMIX), (const bf16_t*)(p.ws + WS_WOT), S_, 2048, 2048};
        pg8::StaticOrder so; so.init(g.M, g.N, (int)gridDim.x, (int)blockIdx.x);
        pg8::EpiRes2 E{(float*)(p.ws + WS_X1), p.in[0], (bf16_t*)(p.ws + WS_H2), (float*)(p.ws + WS_SSQ), 2048};
        pg8::gemm_phase(lds, g, so, E);
    }
    SEAM(6);
    if (IN(8)) REP(8) { if (_r) xcd_barrier(xbar);
        pg8::Gemm g{(const bf16_t*)(p.ws + WS_H2), (const bf16_t*)(p.ws + WS_WQT), S_, 2048, 2048};
        pg8::StaticOrder so; so.init(g.M, g.N, (int)gridDim.x, (int)blockIdx.x);
        pg8::EpiRowScaleF32 E{(float*)(p.ws + WS_Q), (const float*)(p.ws + WS_SSQ), 2048};
        pg8::gemm_phase(lds, g, so, E);
    }
    SEAM(8);
    if (IN(9)) REP(9) { if (_r) xcd_barrier(xbar); phase_topk(p, shm); }
    SEAM(9);
    if (IN(10)) REP(10) { if (_r) xcd_barrier(xbar); phase_peerZ(p); }
    SEAM(10);
    if (IN(11)) REP(11) { if (_r) xcd_barrier(xbar); phase_peerV(p, lds); }
    SEAM(11);
    if (IN(12)) REP(12) { if (_r) xcd_barrier(xbar); phase_final(p); }
#undef IN
#undef REP
#undef SEAM
}

extern "C" void kernel_launch(void* const* d_in, const int* in_sizes, int n_in, void* d_out, int out_size, void* d_ws, size_t ws_size, hipStream_t stream) {
    static int grid_blocks = 0;
    if (grid_blocks == 0) {
        if (n_in != 26 || ws_size < WS_NEED) { fprintf(stderr, "kernel_launch: unexpected n_in %d / ws_size %zu\n", n_in, ws_size); grid_blocks = -1; return; }
        int dev = 0, cus = 0, per_cu = 0;
        (void)hipGetDevice(&dev);
        (void)hipDeviceGetAttribute(&cus, hipDeviceAttributeMultiprocessorCount, dev);
        (void)hipFuncSetAttribute((const void*)mega, hipFuncAttributeMaxDynamicSharedMemorySize, LDS_BYTES);
        (void)hipOccupancyMaxActiveBlocksPerMultiprocessor(&per_cu, (const void*)mega, 512, LDS_BYTES);
        if (per_cu < 1) { fprintf(stderr, "kernel_launch: occupancy query says %d blocks/CU\n", per_cu); per_cu = 1; }
        grid_blocks = cus * per_cu;
        fprintf(stderr, "kernel_launch: cus %d per_cu %d grid %d\n", cus, per_cu, grid_blocks);
    }
    if (grid_blocks < 0) return;
    Params p{};
    for (int i = 0; i < 26; ++i) p.in[i] = (const float*)d_in[i];
    p.out = (float*)d_out; p.ws = (unsigned char*)d_ws;
#if MULTI_LAUNCH
    for (int ph = 0; ph < NPHASE; ++ph) {
        p.ph_lo = ph; p.ph_hi = ph + 1;
        hipLaunchKernelGGL(mega, dim3(grid_blocks), dim3(512), LDS_BYTES, stream, p);
    }
#else
    p.ph_lo = 0; p.ph_hi = NPHASE;
    if (hipMemsetAsync((unsigned char*)d_ws + WS_BAR, 0, XCD_BAR_WORDS * 4, stream) != hipSuccess) fprintf(stderr, "kernel_launch: barrier memset failed\n");
    void* args[] = {&p};
    hipError_t e = hipLaunchCooperativeKernel((const void*)mega, dim3(grid_blocks), dim3(512), args, LDS_BYTES, stream);
    if (e != hipSuccess) fprintf(stderr, "cooperative launch failed: %s (grid %d)\n", hipGetErrorString(e), grid_blocks);
#endif
}
```

```cpp
#include <hip/hip_runtime.h>
#include <hip/hip_cooperative_groups.h>
#include <cstdio>
namespace cg = cooperative_groups;

#ifndef DUP_PHASE
#define DUP_PHASE -1
#endif
#ifndef MULTI_LAUNCH
#define MULTI_LAUNCH 0
#endif

#define LAS __attribute__((address_space(3)))
typedef unsigned short bf16_t;
typedef short bf16x8 __attribute__((ext_vector_type(8)));
typedef float f32x4 __attribute__((ext_vector_type(4)));
typedef float f32x2 __attribute__((ext_vector_type(2)));
typedef unsigned u32x4 __attribute__((ext_vector_type(4)));
typedef unsigned u32x2 __attribute__((ext_vector_type(2)));
typedef unsigned u32x6 __attribute__((ext_vector_type(6)));
typedef float f32x32 __attribute__((ext_vector_type(32)));
typedef __bf16 bf16x32_t __attribute__((ext_vector_type(32)));

constexpr int S_ = 16384, D_ = 2048, DR = 1024, NAUG = 6912;
constexpr size_t MiB = 1ull << 20;
constexpr size_t WS_PROJ = 0, WS_H = 216 * MiB, WS_WB1 = 280 * MiB, WS_WQT = 280 * MiB, WS_WOT = 296 * MiB;
constexpr size_t WS_R = 307 * MiB, WS_K = 339 * MiB, WS_V = 371 * MiB, WS_KK = 403 * MiB, WS_A = 435 * MiB, WS_LW = 467 * MiB;
constexpr size_t WS_G = 216 * MiB, WS_YC = 248 * MiB, WS_YMIX = 307 * MiB, WS_X1 = 0, WS_H2 = 128 * MiB, WS_Q = 307 * MiB;
constexpr size_t WS_GT = 0, WS_HT = 32 * MiB, WS_QE = 96 * MiB, WS_YL = 128 * MiB, WS_S0 = 160 * MiB;
constexpr size_t WS_IDS = 192 * MiB, WS_GATES = 200 * MiB, WS_UB = 467 * MiB, WS_VB = 435 * MiB, WS_BON = 500 * MiB, WS_BAR = 502 * MiB, WS_KEYB = 503 * MiB, WS_SSQ = 504 * MiB, WS_SSQ2 = 506 * MiB, WS_NEED = 507 * MiB;
constexpr size_t WS_ZP = 128 * MiB, WS_X2 = 307 * MiB;
constexpr size_t WS_W2T = 499 * MiB, WS_A2T = WS_W2T + 131072, WS_G2T = WS_A2T + 131072;
constexpr int TLD = 72, TSLOT = 64 * TLD * 2;
constexpr int LDS_BYTES = 16 * TSLOT + 2048 + 256 + 16;
constexpr int NPHASE = 13;

struct Params {
    const float* in[26];
    float* out;
    unsigned char* ws;
    int ph_lo, ph_hi;
};

__device__ __forceinline__ float bf2f(bf16_t b) { return __uint_as_float(((unsigned)b) << 16); }
__device__ __forceinline__ bf16_t f2bf(float f) { unsigned u = __float_as_uint(f); u += 0x7FFFu + ((u >> 16) & 1u); return (bf16_t)(u >> 16); }
typedef __bf16 bf16v2_t __attribute__((ext_vector_type(2)));
__device__ __forceinline__ unsigned cvt_pk_bf16(float lo, float hi) { const f32x2 v = {lo, hi}; const bf16v2_t r = __builtin_convertvector(v, bf16v2_t); return __builtin_bit_cast(unsigned, r); }
__device__ __forceinline__ u32x4 pack8(const float* f) { u32x4 w; w.x = cvt_pk_bf16(f[0], f[1]); w.y = cvt_pk_bf16(f[2], f[3]); w.z = cvt_pk_bf16(f[4], f[5]); w.w = cvt_pk_bf16(f[6], f[7]); return w; }
__device__ __forceinline__ float lo_bf(unsigned w) { return __uint_as_float(w << 16); }
__device__ __forceinline__ float hi_bf(unsigned w) { return __uint_as_float(w & 0xffff0000u); }
__device__ __forceinline__ void unpack8(const u32x4 v, float* f) {
#pragma unroll
    for (int i = 0; i < 4; ++i) { f[2 * i] = lo_bf(v[i]); f[2 * i + 1] = hi_bf(v[i]); }
}
__device__ __forceinline__ float wave_sum(float v) {
#pragma unroll
    for (int o = 32; o; o >>= 1) v += __shfl_xor(v, o);
    return v;
}
template <int CTRL, int RM> __device__ __forceinline__ float dpp_f(float v) { return __int_as_float(__builtin_amdgcn_update_dpp(0, __float_as_int(v), CTRL, RM, 0xf, false)); }
__device__ __forceinline__ float wave_sum_dpp(float v) {
    v += dpp_f<0xB1, 0xf>(v); v += dpp_f<0x4E, 0xf>(v); v += dpp_f<0x141, 0xf>(v); v += dpp_f<0x140, 0xf>(v);
    v += dpp_f<0x142, 0xa>(v); v += dpp_f<0x143, 0xc>(v);
    return __int_as_float(__builtin_amdgcn_readlane(__float_as_int(v), 63));
}
__device__ __forceinline__ float wave_max(float v) {
#pragma unroll
    for (int o = 32; o; o >>= 1) v = fmaxf(v, __shfl_xor(v, o));
    return v;
}
__device__ __forceinline__ float sigmoidf_(float x) { return 1.0f / (1.0f + __expf(-x)); }
__device__ __forceinline__ float gelu_tanh(float x) { float u = 0.7978845608028654f * (x + 0.044715f * x * x * x); return 0.5f * x * (1.0f + tanhf(u)); }

namespace pg8 {
constexpr int BM = 256, BK = 64, HALF = 128, HTB = HALF * BK * 2, STAGE_BYTES = 8 * HTB, NXCD = 8, WGM = 8;
__device__ __forceinline__ int lds_byte(int r, int c) { const int st = (r >> 4) * 2 + (c >> 5), rr = r & 15, cc = c & 31, ob = rr * 64 + cc * 2; return st * 1024 + (ob ^ (((ob >> 9) & 1) << 5)); }
__device__ __forceinline__ void stage_rc(int b, int& R, int& C) { const int st = b / 1024, sb = b % 1024, swz = sb ^ (((sb >> 9) & 1) << 5); R = (st >> 1) * 16 + swz / 64; C = (st & 1) * 32 + (swz % 64) / 2; }
__device__ __forceinline__ int perm32(int rho) { const int n = rho >> 4, i = rho & 15; return 8 * (i >> 2) + 4 * n + (i & 3); }
struct Unit { int pm, pn; };
struct Gemm { const bf16_t* A; const bf16_t* Bt; int M, N, K; };
struct StaticOrder {
    int nM, nN, nwg, G, c;
    __device__ void init(int M, int N, int G_, int c_) { nM = M / BM; nN = N / BM; nwg = nM * nN; G = G_; c = c_; }
    __device__ bool next(int i, Unit& u) const {
        const long L = (long)i * G + c; if (L >= nwg) return false;
        int wgid = (int)L; { const int q = nwg / NXCD, r = nwg % NXCD, xcd = wgid % NXCD, off = wgid / NXCD; wgid = (xcd < r ? xcd * (q + 1) : r * (q + 1) + (xcd - r) * q) + off; }
        const int nig = WGM * nN, gid = wgid / nig, fm = gid * WGM, gsz = (nM - fm) < WGM ? (nM - fm) : WGM;
        u.pm = fm + ((wgid % nig) % gsz); u.pn = (wgid % nig) / gsz; return true;
    }
    __device__ __forceinline__ void a_ready(const Unit&) const {}
    __device__ __forceinline__ void done(const Unit&) const {}
};
struct EpiResF32 {
    static constexpr bool PERM = false;
    float* C; const float* Res; int ldc;
    __device__ __forceinline__ void operator()(const f32x4 (&acc)[2][2][4][2], const Unit& u, int wr, int wc, int fr, int fq) const {
        const int row0 = u.pm * BM + wr * 64 + fr, col0 = u.pn * BM + wc * 32 + 4 * fq;
#pragma unroll
        for (int ai = 0; ai < 2; ++ai)
#pragma unroll
            for (int m = 0; m < 4; ++m) { const size_t ro = (size_t)(row0 + ai * HALF + m * 16) * ldc + col0;
#pragma unroll
                for (int bj = 0; bj < 2; ++bj)
#pragma unroll
                    for (int n = 0; n < 2; ++n) { const f32x4 rs = *(const f32x4*)(Res + ro + bj * HALF + n * 16); *(f32x4*)(C + ro + bj * HALF + n * 16) = acc[ai][bj][m][n] + rs; } }
    }
};
struct EpiRes2 {
    static constexpr bool PERM = false;
    float* C; const float* Res; bf16_t* Cb; float* SSQ; int ldc;
    __device__ __forceinline__ void operator()(const f32x4 (&acc)[2][2][4][2], const Unit& u, int wr, int wc, int fr, int fq) const {
        const int row0 = u.pm * BM + wr * 64 + fr, col0 = u.pn * BM + wc * 32 + 4 * fq;
#pragma unroll
        for (int ai = 0; ai < 2; ++ai)
#pragma unroll
            for (int m = 0; m < 4; ++m) { const int row = row0 + ai * HALF + m * 16; const size_t ro = (size_t)row * ldc + col0; float ss = 0.f;
#pragma unroll
                for (int bj = 0; bj < 2; ++bj)
#pragma unroll
                    for (int n = 0; n < 2; ++n) { const f32x4 v = acc[ai][bj][m][n] + *(const f32x4*)(Res + ro + bj * HALF + n * 16);
                        *(f32x4*)(C + ro + bj * HALF + n * 16) = v;
                        u32x2 wv; wv.x = cvt_pk_bf16(v[0], v[1]); wv.y = cvt_pk_bf16(v[2], v[3]); *(u32x2*)(Cb + ro + bj * HALF + n * 16) = wv;
                        ss += v[0] * v[0] + v[1] * v[1] + v[2] * v[2] + v[3] * v[3]; }
                ss += __shfl_xor(ss, 16); ss += __shfl_xor(ss, 32);
                if (fq == 0) SSQ[(size_t)row * 32 + u.pn * 4 + wc] = ss; }
    }
};
struct EpiRowScaleF32 {
    static constexpr bool PERM = false;
    float* C; const float* SSQ; int ldc;
    __device__ __forceinline__ void operator()(const f32x4 (&acc)[2][2][4][2], const Unit& u, int wr, int wc, int fr, int fq) const {
        const int row0 = u.pm * BM + wr * 64 + fr, col0 = u.pn * BM + wc * 32 + 4 * fq;
#pragma unroll
        for (int ai = 0; ai < 2; ++ai)
#pragma unroll
            for (int m = 0; m < 4; ++m) { const int row = row0 + ai * HALF + m * 16; const size_t ro = (size_t)row * ldc + col0;
                const f32x4* sp = (const f32x4*)(SSQ + (size_t)row * 32); float sq = 0.f;
#pragma unroll
                for (int q = 0; q < 8; ++q) { const f32x4 v = sp[q]; sq += (v[0] + v[1]) + (v[2] + v[3]); }
                const float rs = rsqrtf(sq * (1.0f / 2048.0f) + 1e-6f);
#pragma unroll
                for (int bj = 0; bj < 2; ++bj)
#pragma unroll
                    for (int n = 0; n < 2; ++n) *(f32x4*)(C + ro + bj * HALF + n * 16) = acc[ai][bj][m][n] * rs; }
    }
};
struct EpiF32 {
    static constexpr bool PERM = false;
    float* C; int ldc;
    __device__ __forceinline__ void operator()(const f32x4 (&acc)[2][2][4][2], const Unit& u, int wr, int wc, int fr, int fq) const {
        const int row0 = u.pm * BM + wr * 64 + fr, col0 = u.pn * BM + wc * 32 + 4 * fq;
#pragma unroll
        for (int ai = 0; ai < 2; ++ai)
#pragma unroll
            for (int m = 0; m < 4; ++m) { const size_t ro = (size_t)(row0 + ai * HALF + m * 16) * ldc + col0;
#pragma unroll
                for (int bj = 0; bj < 2; ++bj)
#pragma unroll
                    for (int n = 0; n < 2; ++n) *(f32x4*)(C + ro + bj * HALF + n * 16) = acc[ai][bj][m][n]; }
    }
};
struct EpiBf16 {
    static constexpr bool PERM = true;
    bf16_t* O; int ldc;
    __device__ __forceinline__ void operator()(const f32x4 (&acc)[2][2][4][2], const Unit& u, int wr, int wc, int fr, int fq) const {
        const int row0 = u.pm * BM + wr * 64 + fr; const int col0 = u.pn * BM + wc * 32 + 8 * fq;
#pragma unroll
        for (int ai = 0; ai < 2; ++ai)
#pragma unroll
            for (int m = 0; m < 4; ++m) { bf16_t* rowp = O + (size_t)(row0 + ai * HALF + m * 16) * ldc + col0;
#pragma unroll
                for (int bj = 0; bj < 2; ++bj) { const f32x4 v0 = acc[ai][bj][m][0], v1 = acc[ai][bj][m][1];
                    u32x4 w; w.x = cvt_pk_bf16(v0[0], v0[1]); w.y = cvt_pk_bf16(v0[2], v0[3]); w.z = cvt_pk_bf16(v1[0], v1[1]); w.w = cvt_pk_bf16(v1[2], v1[3]);
                    *(u32x4*)(rowp + bj * HALF) = w; } }
    }
};

template <class Epi, class Sched>
__device__ __forceinline__ void gemm_phase(LAS unsigned char* lds, const Gemm g, const Sched& S, const Epi& E) {
    const int tid = threadIdx.x, wid = __builtin_amdgcn_readfirstlane(tid >> 6), lane = tid & 63, wr = wid >> 2, wc = wid & 3, fr = lane & 15, fq = lane >> 4;
    const int K = g.K, nt = K / BK;
    unsigned voffA[2], voffB[2];
#pragma unroll
    for (int i = 0; i < 2; ++i) { int R, C; stage_rc(tid * 16 + i * 8192, R, C); const int Rb = Epi::PERM ? ((R & ~31) + perm32(R & 31)) : R;
        voffA[i] = (unsigned)(R * K + C) * 2u; voffB[i] = (unsigned)(Rb * K + C) * 2u; }
    const size_t kstep = (size_t)(BK * 2);
    const size_t hstep = (size_t)HALF * K * 2;
    const size_t tstep = 2 * hstep;
    const unsigned ldsw = (unsigned)wid * 1024u;
    const int aoff = lds_byte(wr * 64 + fr, fq * 8), boff = lds_byte(wc * 32 + fr, fq * 8);
#define PG8_SA(b, h) (((b) * 2 + (h)) * HTB)
#define PG8_SB(b, h) ((4 + (b) * 2 + (h)) * HTB)
#define PG8_STAGE(bufoff, gbase, voff) do { _Pragma("unroll") for (int _i = 0; _i < 2; ++_i) \
        __builtin_amdgcn_global_load_lds((const unsigned*)((const char*)(gbase) + (voff)[_i]), (LAS unsigned*)(lds + (bufoff) + ldsw + _i * 8192), 16, 0, 0); } while (0)
#define PG8_LDA(dst, b, h) do { _Pragma("unroll") for (int m = 0; m < 4; ++m) _Pragma("unroll") for (int k = 0; k < 2; ++k) dst[m][k] = *(const LAS bf16x8*)(lds + PG8_SA(b, h) + aoff + m * 2048 + k * 1024); } while (0)
#define PG8_LDB(dst, b, h) do { _Pragma("unroll") for (int n = 0; n < 2; ++n) _Pragma("unroll") for (int k = 0; k < 2; ++k) dst[n][k] = *(const LAS bf16x8*)(lds + PG8_SB(b, h) + boff + n * 2048 + k * 1024); } while (0)
#define PG8_MMA(ai, bj, At, Bt) do { __builtin_amdgcn_s_setprio(1); _Pragma("unroll") for (int m = 0; m < 4; ++m) _Pragma("unroll") for (int n = 0; n < 2; ++n) _Pragma("unroll") for (int k = 0; k < 2; ++k) \
        acc[ai][bj][m][n] = __builtin_amdgcn_mfma_f32_16x16x32_bf16(Bt[n][k], At[m][k], acc[ai][bj][m][n], 0, 0, 0); __builtin_amdgcn_s_setprio(0); } while (0)
#define PG8_WAIT_V(n) asm volatile("s_waitcnt vmcnt(" #n ")" ::: "memory")
#define PG8_WAIT_L(n) asm volatile("s_waitcnt lgkmcnt(" #n ")" ::: "memory")
#define PG8_BAR __builtin_amdgcn_s_barrier()
#define PG8_SCHED __builtin_amdgcn_sched_barrier(0)
    Unit cur, nxt; int ui = 0;
    if (!S.next(0, cur)) return;
    f32x4 acc[2][2][4][2];
#pragma unroll
    for (int a = 0; a < 2; ++a)
#pragma unroll
        for (int b = 0; b < 2; ++b)
#pragma unroll
            for (int m = 0; m < 4; ++m)
#pragma unroll
                for (int n = 0; n < 2; ++n) acc[a][b][m][n] = (f32x4){0.f, 0.f, 0.f, 0.f};
    bf16x8 At[4][2], B0[2][2], B1[2][2];
    const char* cA = (const char*)g.A + (size_t)cur.pm * tstep; const char* cB = (const char*)g.Bt + (size_t)cur.pn * tstep;
    S.a_ready(cur);
    PG8_STAGE(PG8_SB(0, 0), cB, voffB); PG8_STAGE(PG8_SA(0, 0), cA, voffA); PG8_STAGE(PG8_SB(0, 1), cB + hstep, voffB); PG8_STAGE(PG8_SA(0, 1), cA + hstep, voffA);
    if (wr == 1) PG8_BAR;
    PG8_WAIT_V(4); PG8_BAR;
    PG8_STAGE(PG8_SB(1, 0), cB + kstep, voffB); PG8_STAGE(PG8_SA(1, 0), cA + kstep, voffA); PG8_STAGE(PG8_SB(1, 1), cB + hstep + kstep, voffB);
    PG8_WAIT_V(6); PG8_BAR;
    for (;;) {
        const bool has_next = S.next(ui + 1, nxt);
        const char* nA = has_next ? (const char*)g.A + (size_t)nxt.pm * tstep : cA; const char* nB = has_next ? (const char*)g.Bt + (size_t)nxt.pn * tstep : cB;
        for (int t = 0; t < nt; t += 2) {
            const bool last = (t == nt - 2);
            const char* a1 = cA + (size_t)(t + 1) * kstep;
            const char* a2 = last ? nA : cA + (size_t)(t + 2) * kstep; const char* b2 = last ? nB : cB + (size_t)(t + 2) * kstep;
            const char* a3 = a2 + kstep; const char* b3 = b2 + kstep;
            if (last && has_next) S.a_ready(nxt);
            PG8_LDB(B0, 0, 0); PG8_SCHED; PG8_LDA(At, 0, 0); PG8_STAGE(PG8_SA(1, 1), a1 + hstep, voffA);
            PG8_WAIT_L(8); PG8_BAR; PG8_WAIT_L(0); PG8_MMA(0, 0, At, B0); PG8_BAR; PG8_SCHED;
            PG8_LDB(B1, 0, 1); PG8_STAGE(PG8_SB(0, 0), b2, voffB);
            PG8_BAR; PG8_WAIT_L(0); PG8_MMA(0, 1, At, B1); PG8_BAR;
            PG8_LDA(At, 0, 1); PG8_STAGE(PG8_SA(0, 0), a2, voffA);
            PG8_BAR; PG8_WAIT_L(0); PG8_MMA(1, 0, At, B0); PG8_BAR; PG8_SCHED;
            PG8_STAGE(PG8_SB(0, 1), b2 + hstep, voffB);
            PG8_WAIT_V(6); PG8_BAR; PG8_MMA(1, 1, At, B1); PG8_BAR;
            PG8_LDB(B0, 1, 0); PG8_SCHED; PG8_LDA(At, 1, 0); PG8_STAGE(PG8_SA(0, 1), a2 + hstep, voffA);
            PG8_WAIT_L(8); PG8_BAR; PG8_WAIT_L(0); PG8_MMA(0, 0, At, B0); PG8_BAR; PG8_SCHED;
            PG8_LDB(B1, 1, 1); PG8_STAGE(PG8_SB(1, 0), b3, voffB);
            PG8_BAR; PG8_WAIT_L(0); PG8_MMA(0, 1, At, B1); PG8_BAR;
            PG8_LDA(At, 1, 1); PG8_STAGE(PG8_SA(1, 0), a3, voffA);
            PG8_BAR; PG8_WAIT_L(0); PG8_MMA(1, 0, At, B0); PG8_BAR; PG8_SCHED;
            PG8_STAGE(PG8_SB(1, 1), b3 + hstep, voffB);
            PG8_WAIT_V(6); PG8_BAR; PG8_MMA(1, 1, At, B1); PG8_BAR;
        }
        E(acc, cur, wr, wc, fr, fq); S.done(cur);
        if (!has_next) break;
#pragma unroll
        for (int a = 0; a < 2; ++a)
#pragma unroll
            for (int b = 0; b < 2; ++b)
#pragma unroll
                for (int m = 0; m < 4; ++m)
#pragma unroll
                    for (int n = 0; n < 2; ++n) acc[a][b][m][n] = (f32x4){0.f, 0.f, 0.f, 0.f};
        cur = nxt; cA = nA; cB = nB; ++ui;
    }
    PG8_WAIT_V(0);
    if (wr == 0) PG8_BAR;
    PG8_BAR;
#undef PG8_SA
#undef PG8_SB
#undef PG8_STAGE
#undef PG8_LDA
#undef PG8_LDB
#undef PG8_MMA
#undef PG8_WAIT_V
#undef PG8_WAIT_L
#undef PG8_BAR
#undef PG8_SCHED
}
}

__device__ __forceinline__ void rmsnorm_rows(const float* X, const float* gain, bf16_t* H) {
    const int wave = threadIdx.x >> 6, lane = threadIdx.x & 63;
    for (int row = blockIdx.x * 8 + wave; row < S_; row += gridDim.x * 8) {
        const float4* xr = (const float4*)(X + (size_t)row * D_);
        float4 v[8]; float ss = 0.f;
#pragma unroll
        for (int i = 0; i < 8; ++i) { v[i] = xr[i * 64 + lane]; ss += v[i].x * v[i].x + v[i].y * v[i].y + v[i].z * v[i].z + v[i].w * v[i].w; }
        ss = wave_sum(ss);
        const float sc = rsqrtf(ss * (1.0f / 2048.0f) + 1e-6f);
#pragma unroll
        for (int i = 0; i < 8; ++i) { const float4 g = ((const float4*)gain)[i * 64 + lane];
            u32x2 w; w.x = cvt_pk_bf16(v[i].x * sc * g.x, v[i].y * sc * g.y); w.y = cvt_pk_bf16(v[i].z * sc * g.z, v[i].w * sc * g.w);
            *(u32x2*)(H + (size_t)row * D_ + (i * 64 + lane) * 4) = w; }
    }
}

__device__ __forceinline__ void transpose_convert(const float* W, int K, int N, bf16_t* Bt, float* tile, int bid, int nblk) {
    const int tid = threadIdx.x; const int tk = K / 64, tn = N / 64, nt = tk * tn;
    float4 rg[2];
#define TC_LOAD(u) do { const int _k0 = ((u) / tn) * 64, _n0 = ((u) % tn) * 64; _Pragma("unroll") for (int i = 0; i < 2; ++i) { const int idx = tid + 512 * i; \
        rg[i] = *(const float4*)(W + (size_t)(_k0 + (idx >> 4)) * N + _n0 + (idx & 15) * 4); } } while (0)
    if (bid < nt) TC_LOAD(bid);
    for (int u = bid; u < nt; u += nblk) {
        const int k0 = (u / tn) * 64, n0 = (u % tn) * 64;
        __syncthreads();
#pragma unroll
        for (int i = 0; i < 2; ++i) { const int idx = tid + 512 * i; float* q = tile + (idx >> 4) * 65 + (idx & 15) * 4; q[0] = rg[i].x; q[1] = rg[i].y; q[2] = rg[i].z; q[3] = rg[i].w; }
        __syncthreads();
        if (u + nblk < nt) TC_LOAD(u + nblk);
#pragma unroll
        for (int i = 0; i < 4; ++i) { const int nn = i * 16 + (tid >> 5), kp = (tid & 31) * 2;
            *(unsigned*)(Bt + (size_t)(n0 + nn) * K + k0 + kp) = cvt_pk_bf16(tile[kp * 65 + nn], tile[(kp + 1) * 65 + nn]); }
    }
#undef TC_LOAD
}

__device__ __forceinline__ void convert_flat(const float* src, bf16_t* dst, size_t n) {
    for (size_t i = ((size_t)blockIdx.x * 512 + threadIdx.x) * 8; i < n; i += (size_t)gridDim.x * 512 * 8) {
        const float4 a = *(const float4*)(src + i), b = *(const float4*)(src + i + 4);
        u32x4 w; w.x = cvt_pk_bf16(a.x, a.y); w.y = cvt_pk_bf16(a.z, a.w); w.z = cvt_pk_bf16(b.x, b.y); w.w = cvt_pk_bf16(b.z, b.w);
        *(u32x4*)(dst + i) = w;
    }
}

__device__ __forceinline__ void convert_fp8(const float* src, unsigned char* dst, size_t n, float sc, const float* colgain, int bid, int nblk) {
    const int lane = threadIdx.x & 63, wv = threadIdx.x >> 6;
    for (size_t base = ((size_t)bid * 8 + wv) * 1024; base < n; base += (size_t)nblk * 8 * 1024) {
        float4 a[4];
#pragma unroll
        for (int j = 0; j < 4; ++j) a[j] = *(const float4*)(src + base + (size_t)(j * 64 + lane) * 4);
#pragma unroll
        for (int j = 0; j < 4; ++j) { float4 gg = make_float4(sc, sc, sc, sc);
            if (colgain) { const float4 cgv = *(const float4*)(colgain + ((base + (size_t)(j * 64 + lane) * 4) & 2047)); gg.x *= cgv.x; gg.y *= cgv.y; gg.z *= cgv.z; gg.w *= cgv.w; }
            int x = __builtin_amdgcn_cvt_pk_fp8_f32(a[j].x * gg.x, a[j].y * gg.y, 0, false); x = __builtin_amdgcn_cvt_pk_fp8_f32(a[j].z * gg.z, a[j].w * gg.w, x, true);
            *(unsigned*)(dst + base + (size_t)(j * 64 + lane) * 4) = (unsigned)x; }
    }
}

constexpr int ROW6 = 1536;
constexpr float U6_SCALE = 56.f, V6_SCALE = 28.f;
__device__ __forceinline__ void convert_fp6(const float* src, unsigned char* dst, int nrows, float sc, const float* colgain, int bid, int nblk) {
    const int lane = threadIdx.x & 63, wv = threadIdx.x >> 6;
    float g[32];
#pragma unroll
    for (int j = 0; j < 8; ++j) { float4 cg = make_float4(1.f, 1.f, 1.f, 1.f); if (colgain) cg = *(const float4*)(colgain + (j * 64 + lane) * 4);
        g[j * 4] = sc * cg.x; g[j * 4 + 1] = sc * cg.y; g[j * 4 + 2] = sc * cg.z; g[j * 4 + 3] = sc * cg.w; }
    for (int row = bid * 8 + wv; row < nrows; row += nblk * 8) {
        f32x32 x;
#pragma unroll
        for (int j = 0; j < 8; ++j) { const f32x4 a = __builtin_nontemporal_load((const f32x4*)(src + (size_t)row * 2048 + (j * 64 + lane) * 4));
            x[j * 4] = a[0] * g[j * 4]; x[j * 4 + 1] = a[1] * g[j * 4 + 1]; x[j * 4 + 2] = a[2] * g[j * 4 + 2]; x[j * 4 + 3] = a[3] * g[j * 4 + 3]; }
        const bf16x32_t b = __builtin_convertvector(x, bf16x32_t);
        const u32x6 wv6 = __builtin_amdgcn_cvt_scalef32_pk32_fp6_bf16(b, 1.0f);
        *(u32x4*)(dst + (size_t)row * ROW6 + lane * 16) = (u32x4){wv6[0], wv6[1], wv6[2], wv6[3]};
        *(u32x2*)(dst + (size_t)row * ROW6 + 1024 + lane * 8) = (u32x2){wv6[4], wv6[5]};
    }
}

__device__ __forceinline__ void convert_fp6s(const float* src, unsigned char* dst, int nrows, float sc, const float* colgain, int bid, int nblk) {
    const int lane = threadIdx.x & 63, wv = threadIdx.x >> 6, x = lane >> 3, pt = lane & 7;
    float g[32];
#pragma unroll
    for (int j = 0; j < 8; ++j) { float4 cg = make_float4(1.f, 1.f, 1.f, 1.f); if (colgain) cg = *(const float4*)(colgain + x * 256 + (j * 8 + pt) * 4);
        g[j * 4] = sc * cg.x; g[j * 4 + 1] = sc * cg.y; g[j * 4 + 2] = sc * cg.z; g[j * 4 + 3] = sc * cg.w; }
    for (int row = bid * 8 + wv; row < nrows; row += nblk * 8) {
        f32x32 v;
#pragma unroll
        for (int j = 0; j < 8; ++j) { const f32x4 a = __builtin_nontemporal_load((const f32x4*)(src + (size_t)row * 2048 + x * 256 + (j * 8 + pt) * 4));
            v[j * 4] = a[0] * g[j * 4]; v[j * 4 + 1] = a[1] * g[j * 4 + 1]; v[j * 4 + 2] = a[2] * g[j * 4 + 2]; v[j * 4 + 3] = a[3] * g[j * 4 + 3]; }
        const bf16x32_t b = __builtin_convertvector(v, bf16x32_t);
        const u32x6 w6 = __builtin_amdgcn_cvt_scalef32_pk32_fp6_bf16(b, 1.0f);
        unsigned char* q = dst + ((size_t)x * 16384 + row) * 192 + pt * 24;
        *(u32x2*)q = (u32x2){w6[0], w6[1]}; *(u32x2*)(q + 8) = (u32x2){w6[2], w6[3]}; *(u32x2*)(q + 16) = (u32x2){w6[4], w6[5]};
    }
}

__device__ __forceinline__ void build_wpt(const float* wq, const float* gain, const bf16_t* KEYB, bf16_t* WPT, int bid, int nblk) {
    const int w = threadIdx.x >> 6, lane = threadIdx.x & 63, fr = lane & 15, fq = lane >> 4;
    for (int task = bid * 8 + w; task < 16 * 128; task += nblk * 8) {
        const int g = task >> 7, kb = task & 127;
        f32x4 acc[8];
#pragma unroll
        for (int n = 0; n < 8; ++n) acc[n] = (f32x4){0.f, 0.f, 0.f, 0.f};
#pragma unroll 2
        for (int ks = 0; ks < 8; ++ks) {
            const float4* wp = (const float4*)(wq + (size_t)(kb * 16 + fr) * 4096 + g * 256 + ks * 32 + fq * 8);
            const float4 x0 = wp[0], x1 = wp[1]; const float gk = gain[kb * 16 + fr];
            u32x4 wv; wv.x = cvt_pk_bf16(x0.x * gk, x0.y * gk); wv.y = cvt_pk_bf16(x0.z * gk, x0.w * gk); wv.z = cvt_pk_bf16(x1.x * gk, x1.y * gk); wv.w = cvt_pk_bf16(x1.z * gk, x1.w * gk);
            const bf16x8 a = __builtin_bit_cast(bf16x8, wv);
#pragma unroll
            for (int n = 0; n < 8; ++n) {
                const bf16x8 b = *(const bf16x8*)(KEYB + (size_t)(g * 128 + n * 16 + fr) * 256 + ks * 32 + fq * 8);
                acc[n] = __builtin_amdgcn_mfma_f32_16x16x32_bf16(a, b, acc[n], 0, 0, 0);
            }
        }
#pragma unroll
        for (int n = 0; n < 8; ++n) { u32x2 o; o.x = cvt_pk_bf16(acc[n][0], acc[n][1]); o.y = cvt_pk_bf16(acc[n][2], acc[n][3]);
            *(u32x2*)(WPT + (size_t)(g * 128 + n * 16 + fr) * 2048 + kb * 16 + fq * 4) = o; }
    }
}

__device__ __forceinline__ void phase0(const Params& p, unsigned char* shm) {
    bf16_t* WB1 = (bf16_t*)(p.ws + WS_WB1);
    rmsnorm_rows(p.in[0], p.in[1], (bf16_t*)(p.ws + WS_H));
    transpose_convert(p.in[2], 2048, 6144, WB1, (float*)shm, blockIdx.x, gridDim.x);
    const float* mu = p.in[4]; const float* w1 = p.in[6]; const float* a1 = p.in[9]; const float* g1 = p.in[11];
    for (int idx = blockIdx.x * 512 + threadIdx.x; idx < 768 * 2048; idx += gridDim.x * 512) {
        const int j = idx >> 11, k = idx & 2047; float val = 0.f;
        if (j < 128) { const float m = mu[k], w = w1[k * 64 + (j & 63)]; val = (j < 64) ? w * (1.f - m) : w * m; }
        else if (j < 256) { const float m = mu[2048 + k], w = a1[k * 64 + (j & 63)]; val = (j < 192) ? w * (1.f - m) : w * m; }
        else if (j < 576) { const float m = mu[4096 + k]; const int jj = j - 256; const int c = jj < 160 ? jj : jj - 160; const float w = g1[k * 160 + c]; val = jj < 160 ? w * (1.f - m) : w * m; }
        WB1[(size_t)(6144 + j) * 2048 + k] = f2bf(val);
    }
    convert_flat(p.in[22], (bf16_t*)(p.ws + WS_KEYB), (size_t)8 * 2 * 128 * 256);
    bf16_t* W2T = (bf16_t*)(p.ws + WS_W2T); bf16_t* A2T = (bf16_t*)(p.ws + WS_A2T); bf16_t* G2T = (bf16_t*)(p.ws + WS_G2T);
    const float* w2 = p.in[7]; const float* a2 = p.in[10]; const float* g2 = p.in[12];
    for (int idx = blockIdx.x * 512 + threadIdx.x; idx < 1024 * 288; idx += gridDim.x * 512) {
        if (idx < 65536) { const int c = idx >> 6, j = idx & 63; W2T[idx] = f2bf(w2[j * 1024 + c]); }
        else if (idx < 131072) { const int i2 = idx - 65536; const int c = i2 >> 6, j = i2 & 63; A2T[i2] = f2bf(a2[j * 1024 + c]); }
        else { const int i2 = idx - 131072; const int c = i2 / 160, j = i2 % 160; G2T[i2] = f2bf(g2[j * 1024 + c]); }
    }
}

constexpr int ACT_LD = 296;
template <int KS, int KOFF, int KTOT, int KIND>
__device__ __forceinline__ void lora_stage(const LAS bf16_t* act, const bf16_t* WT, const float* bias, bf16_t* OUT, int t0, int w, int fr, int fq) {
#pragma unroll 1
    for (int nh = 0; nh < 2; ++nh) {
        f32x4 acc[4][4];
#pragma unroll
        for (int m = 0; m < 4; ++m)
#pragma unroll
            for (int n = 0; n < 4; ++n) acc[m][n] = (f32x4){0.f, 0.f, 0.f, 0.f};
        bf16x8 bfr[KS][4];
#pragma unroll
        for (int ks = 0; ks < KS; ++ks)
#pragma unroll
            for (int n = 0; n < 4; ++n) bfr[ks][n] = *(const bf16x8*)(WT + (size_t)(w * 128 + (nh * 4 + n) * 16 + fr) * KTOT + ks * 32 + fq * 8);
#pragma unroll
        for (int ks = 0; ks < KS; ++ks) {
            bf16x8 a[4];
#pragma unroll
            for (int m = 0; m < 4; ++m) a[m] = *(const LAS bf16x8*)(act + (m * 16 + fr) * ACT_LD + KOFF + ks * 32 + fq * 8);
#pragma unroll
            for (int n = 0; n < 4; ++n)
#pragma unroll
                for (int m = 0; m < 4; ++m) acc[m][n] = __builtin_amdgcn_mfma_f32_16x16x32_bf16(bfr[ks][n], a[m], acc[m][n], 0, 0, 0);
        }
#pragma unroll
        for (int n = 0; n < 4; ++n) {
            const int c = w * 128 + (nh * 4 + n) * 16 + fq * 4;
            float bs[4] = {0.f, 0.f, 0.f, 0.f};
            if (KIND < 2) { const float4 bv = *(const float4*)(bias + c); bs[0] = bv.x; bs[1] = bv.y; bs[2] = bv.z; bs[3] = bv.w; }
#pragma unroll
            for (int m = 0; m < 4; ++m) {
                float o[4];
#pragma unroll
                for (int j = 0; j < 4; ++j) {
                    const float val = acc[m][n][j];
                    if (KIND == 0) { const float x = -(bs[j] + val); const float sp = fmaxf(x, 0.f) + __logf(1.f + __expf(-fabsf(x))); o[j] = -__expf(-sp - 0.5f); }
                    else if (KIND == 1) o[j] = sigmoidf_(bs[j] + val);
                    else o[j] = val;
                }
                u32x2 wv; wv.x = cvt_pk_bf16(o[0], o[1]); wv.y = cvt_pk_bf16(o[2], o[3]);
                *(u32x2*)(OUT + (size_t)(t0 + m * 16 + fr) * DR + c) = wv;
            }
        }
    }
}
__device__ __forceinline__ void phase_prepM(const Params& p, LAS unsigned char* lds) {
    LAS bf16_t* act = (LAS bf16_t*)lds;
    const bf16_t* P = (const bf16_t*)(p.ws + WS_PROJ);
    const int tid = threadIdx.x, w = tid >> 6, lane = tid & 63, fr = lane & 15, fq = lane >> 4;
    for (int tile = blockIdx.x; tile < S_ / 64; tile += gridDim.x) {
        const int t0 = tile * 64;
        __syncthreads();
        for (int task = tid; task < 64 * 36; task += 512) {
            const int t = task / 36, j0 = (task % 36) * 8; const int tg = t0 + t;
            int ccur, cprev;
            if (j0 < 64) { ccur = 6144 + j0; cprev = 6208 + j0; }
            else if (j0 < 128) { ccur = 6272 + (j0 - 64); cprev = 6336 + (j0 - 64); }
            else { ccur = 6400 + (j0 - 128); cprev = 6560 + (j0 - 128); }
            float cu[8], pv[8], o8[8];
            unpack8(*(const u32x4*)(P + (size_t)tg * NAUG + ccur), cu);
            if (tg > 0) unpack8(*(const u32x4*)(P + (size_t)(tg - 1) * NAUG + cprev), pv);
            else {
#pragma unroll
                for (int i = 0; i < 8; ++i) pv[i] = 0.f;
            }
#pragma unroll
            for (int i = 0; i < 8; ++i) { const float sv = cu[i] + pv[i];
                o8[i] = j0 < 64 ? (1.f - 2.f / (1.f + __expf(2.f * sv))) : (j0 < 128 ? sv : sigmoidf_(sv)); }
            *(LAS u32x4*)(act + t * ACT_LD + j0) = pack8(o8);
        }
        __syncthreads();
        lora_stage<2, 0, 64, 0>(act, (const bf16_t*)(p.ws + WS_W2T), p.in[5], (bf16_t*)(p.ws + WS_LW), t0, w, fr, fq);
        lora_stage<2, 64, 64, 1>(act, (const bf16_t*)(p.ws + WS_A2T), p.in[8], (bf16_t*)(p.ws + WS_A), t0, w, fr, fq);
        lora_stage<5, 128, 160, 2>(act, (const bf16_t*)(p.ws + WS_G2T), nullptr, (bf16_t*)(p.ws + WS_G), t0, w, fr, fq);
    }
}

__device__ __forceinline__ void phase_prepE(const Params& p) {
    const bf16_t* P = (const bf16_t*)(p.ws + WS_PROJ);
    bf16_t* R = (bf16_t*)(p.ws + WS_R); bf16_t* Kk = (bf16_t*)(p.ws + WS_K); bf16_t* V = (bf16_t*)(p.ws + WS_V); bf16_t* KK = (bf16_t*)(p.ws + WS_KK); bf16_t* YC = (bf16_t*)(p.ws + WS_YC);
    const float* mu_rkv = p.in[3]; const float* k_k = p.in[13]; const float* cw = p.in[18];
    const int tid = threadIdx.x, cg = tid & 127, c0 = cg * 8, tgrp = tid >> 7;
    float mr[8], mk[8], mv[8], kkc[8], cw0[8], cw1[8], cw2[8];
#pragma unroll
    for (int i = 0; i < 8; ++i) { mr[i] = mu_rkv[c0 + i]; mk[i] = mu_rkv[1024 + c0 + i]; mv[i] = mu_rkv[2048 + c0 + i]; kkc[i] = k_k[c0 + i]; cw0[i] = cw[c0 + i]; cw1[i] = cw[1024 + c0 + i]; cw2[i] = cw[2048 + c0 + i]; }
    for (int run = blockIdx.x * 4 + tgrp; run < S_ / 16; run += gridDim.x * 4) {
        const int t0 = run * 16;
        float pr[8], pk[8], pv[8], u1[8], u2[8];
#pragma unroll
        for (int i = 0; i < 8; ++i) { pr[i] = 0.f; pk[i] = 0.f; pv[i] = 0.f; u1[i] = 0.f; u2[i] = 0.f; }
        if (t0 > 0) {
            const size_t o = (size_t)(t0 - 1) * NAUG + c0;
            unpack8(*(const u32x4*)(P + o), pr); unpack8(*(const u32x4*)(P + o + 1024), pk); unpack8(*(const u32x4*)(P + o + 2048), pv);
            float x[8], y[8];
            unpack8(*(const u32x4*)(P + o + 4096), x); unpack8(*(const u32x4*)(P + o + 5120), y);
#pragma unroll
            for (int i = 0; i < 8; ++i) u1[i] = x[i] * y[i];
            unpack8(*(const u32x4*)(P + o - NAUG + 4096), x); unpack8(*(const u32x4*)(P + o - NAUG + 5120), y);
#pragma unroll
            for (int i = 0; i < 8; ++i) u2[i] = x[i] * y[i];
        }
        u32x4 nx[6];
        { const size_t o = (size_t)t0 * NAUG + c0;
#pragma unroll
          for (int q = 0; q < 6; ++q) nx[q] = *(const u32x4*)(P + o + 1024 * q); }
#pragma unroll 1
        for (int t = 0; t < 16; ++t) {
            float cr[8], ck[8], cv[8], bg[8], cgt[8], xc[8];
            unpack8(nx[0], cr); unpack8(nx[1], ck); unpack8(nx[2], cv); unpack8(nx[3], bg); unpack8(nx[4], cgt); unpack8(nx[5], xc);
            { const size_t o = (size_t)(t0 + (t < 15 ? t + 1 : t)) * NAUG + c0;
#pragma unroll
              for (int q = 0; q < 6; ++q) nx[q] = *(const u32x4*)(P + o + 1024 * q); }
            float r[8], k[8], v[8], kkv[8], yc[8]; float ss = 0.f;
#pragma unroll
            for (int i = 0; i < 8; ++i) {
                r[i] = cr[i] + (pr[i] - cr[i]) * mr[i]; k[i] = ck[i] + (pk[i] - ck[i]) * mk[i]; v[i] = cv[i] + (pv[i] - cv[i]) * mv[i];
                pr[i] = cr[i]; pk[i] = ck[i]; pv[i] = cv[i];
                kkv[i] = k[i] * kkc[i]; ss += kkv[i] * kkv[i];
                const float u0 = cgt[i] * xc[i];
                yc[i] = bg[i] * (cw0[i] * u2[i] + cw1[i] * u1[i] + cw2[i] * u0);
                u2[i] = u1[i]; u1[i] = u0;
            }
            ss += dpp_f<0xB1, 0xf>(ss); ss += dpp_f<0x4E, 0xf>(ss); ss += dpp_f<0x141, 0xf>(ss);
            const float inv = 1.0f / fmaxf(sqrtf(ss), 1e-12f);
#pragma unroll
            for (int i = 0; i < 8; ++i) kkv[i] *= inv;
            const size_t oo = (size_t)(t0 + t) * DR + c0;
            *(u32x4*)(R + oo) = pack8(r); *(u32x4*)(Kk + oo) = pack8(k); *(u32x4*)(V + oo) = pack8(v); *(u32x4*)(KK + oo) = pack8(kkv); *(u32x4*)(YC + oo) = pack8(yc);
        }
    }
}

#define TILE(i) ((LAS bf16_t*)(lds + (i) * TSLOT))
__device__ __forceinline__ f32x4 mm_tile(f32x4 acc, const LAS bf16_t* A, const LAS bf16_t* Bt, int mi, int ni, int fr, int fq) {
#pragma unroll
    for (int ks = 0; ks < 2; ++ks) {
        const bf16x8 a = *(const LAS bf16x8*)(A + (mi * 16 + fr) * TLD + ks * 32 + fq * 8);
        const bf16x8 b = *(const LAS bf16x8*)(Bt + (ni * 16 + fr) * TLD + ks * 32 + fq * 8);
        acc = __builtin_amdgcn_mfma_f32_16x16x32_bf16(a, b, acc, 0, 0, 0);
    }
    return acc;
}
__device__ __forceinline__ void st_rm(LAS bf16_t* X, f32x4 v, int mi, int ni, int fr, int fq) {
    const unsigned w0 = cvt_pk_bf16(v[0], v[1]), w1 = cvt_pk_bf16(v[2], v[3]);
    LAS bf16_t* q = X + (mi * 16 + fq * 4) * TLD + ni * 16 + fr;
    q[0] = (bf16_t)(w0 & 0xffffu); q[TLD] = (bf16_t)(w0 >> 16); q[2 * TLD] = (bf16_t)(w1 & 0xffffu); q[3 * TLD] = (bf16_t)(w1 >> 16);
}
__device__ __forceinline__ void st_tr(LAS bf16_t* XT, f32x4 v, int mi, int ni, int fr, int fq) {
    u32x2 w; w.x = cvt_pk_bf16(v[0], v[1]); w.y = cvt_pk_bf16(v[2], v[3]);
    *(LAS u32x2*)(XT + (ni * 16 + fr) * TLD + mi * 16 + fq * 4) = w;
}
__device__ __forceinline__ f32x4 ld_rm(const LAS bf16_t* X, int mi, int ni, int fr, int fq) {
    const LAS bf16_t* q = X + (mi * 16 + fq * 4) * TLD + ni * 16 + fr;
    return (f32x4){bf2f(q[0]), bf2f(q[TLD]), bf2f(q[2 * TLD]), bf2f(q[3 * TLD])};
}
__device__ __forceinline__ f32x4 ld_tr(const LAS bf16_t* XT, int mi, int ni, int fr, int fq) {
    const u32x2 w = *(const LAS u32x2*)(XT + (ni * 16 + fr) * TLD + mi * 16 + fq * 4);
    return (f32x4){lo_bf(w.x), hi_bf(w.x), lo_bf(w.y), hi_bf(w.y)};
}

__device__ __forceinline__ void phase_chunkA(const Params& p, LAS unsigned char* lds) {
    const int tid = threadIdx.x, w = tid >> 6, lane = tid & 63, fr = lane & 15, fq = lane >> 4;
    const int mi = w >> 1, nb = (w & 1) * 2;
    LAS float* cl = (LAS float*)(lds + 14 * TSLOT);
    LAS float* gs = (LAS float*)(lds + 16 * TSLOT);
    LAS float* wc = gs + 512;
    const bf16_t* R = (const bf16_t*)(p.ws + WS_R); const bf16_t* Kk = (const bf16_t*)(p.ws + WS_K); const bf16_t* V = (const bf16_t*)(p.ws + WS_V);
    const bf16_t* KK = (const bf16_t*)(p.ws + WS_KK); const bf16_t* A = (const bf16_t*)(p.ws + WS_A); const bf16_t* LW = (const bf16_t*)(p.ws + WS_LW);
    bf16_t* GT = (bf16_t*)(p.ws + WS_GT); float* HT = (float*)(p.ws + WS_HT); bf16_t* QE = (bf16_t*)(p.ws + WS_QE); bf16_t* YL = (bf16_t*)(p.ws + WS_YL);
    const f32x4 z4 = (f32x4){0.f, 0.f, 0.f, 0.f};
    const float* k_a = p.in[14]; const float* r_k = p.in[15]; float* BON = (float*)(p.ws + WS_BON);
    u32x4 nr4, nk4, nv4, nkk4, na4, nlw4;
#define CA_LOAD(it) do { const size_t _go = (size_t)(((it) >> 4) * 64 + (tid >> 3)) * DR + ((it) & 15) * 64 + (tid & 7) * 8; \
        nr4 = *(const u32x4*)(R + _go); nk4 = *(const u32x4*)(Kk + _go); nv4 = *(const u32x4*)(V + _go); nkk4 = *(const u32x4*)(KK + _go); na4 = *(const u32x4*)(A + _go); nlw4 = *(const u32x4*)(LW + _go); } while (0)
    for (int item = blockIdx.x; item < 4096; item += gridDim.x) {
        const int c = item >> 4, h = item & 15;
        const int t = tid >> 3, k0 = (tid & 7) * 8;
        if (item == (int)blockIdx.x) CA_LOAD(item);
        const u32x4 r4 = nr4, k4 = nk4, v4 = nv4, kk4 = nkk4, a4 = na4, lw4 = nlw4;
        __syncthreads();
        {
            float lwf8[8]; unpack8(lw4, lwf8);
            *(LAS f32x4*)(cl + t * 64 + k0) = (f32x4){lwf8[0], lwf8[1], lwf8[2], lwf8[3]};
            *(LAS f32x4*)(cl + t * 64 + k0 + 4) = (f32x4){lwf8[4], lwf8[5], lwf8[6], lwf8[7]};
            __syncthreads();
            const int g = w, k = lane;
            float pfx[8]; float run = 0.f;
#pragma unroll
            for (int i = 0; i < 8; ++i) { run += cl[(g * 8 + i) * 64 + k]; pfx[i] = run; }
            gs[g * 64 + k] = run;
            __syncthreads();
            float off = 0.f;
#pragma unroll
            for (int gg = 0; gg < 7; ++gg) { const float x = gs[gg * 64 + k]; off += (gg < g) ? x : 0.f; }
#pragma unroll
            for (int i = 0; i < 8; ++i) cl[(g * 8 + i) * 64 + k] = off + pfx[i];
            if (g == 7) wc[k] = __expf(off + pfx[7]);
            __syncthreads();
        }
        if (item + (int)gridDim.x < 4096) CA_LOAD(item + (int)gridDim.x);
        {
            float at[8], rt[8], bt[8], kt[8], bh[8], kh[8], vv[8]; float bsum = 0.f;
#pragma unroll
            for (int i = 0; i < 8; ++i) {
                const int q = i >> 1; const bool hi = i & 1;
                const float rf = hi ? hi_bf(r4[q]) : lo_bf(r4[q]), kraw = hi ? hi_bf(k4[q]) : lo_bf(k4[q]), vf = hi ? hi_bf(v4[q]) : lo_bf(v4[q]);
                const float kkf = hi ? hi_bf(kk4[q]) : lo_bf(kk4[q]), af = hi ? hi_bf(a4[q]) : lo_bf(a4[q]), lwf = hi ? hi_bf(lw4[q]) : lo_bf(lw4[q]);
                const float kf = kraw * (1.f + (af - 1.f) * k_a[h * 64 + k0 + i]);
                bsum += rf * kf * r_k[h * 64 + k0 + i];
                const float clv = cl[t * 64 + k0 + i], cle = cl[63 * 64 + k0 + i];
                const float e = __expf(clv), ex = __expf(clv - lwf), ei = __expf(-clv), eh = __expf(cle - clv);
                const float bb = kkf * af;
                at[i] = -kkf * ex; rt[i] = rf * e; bt[i] = bb * ei; kt[i] = kf * ei; bh[i] = bb * eh; kh[i] = kf * eh; vv[i] = vf;
            }
            bsum += dpp_f<0xB1, 0xf>(bsum); bsum += dpp_f<0x4E, 0xf>(bsum); bsum += dpp_f<0x141, 0xf>(bsum);
            if ((tid & 7) == 0) BON[(size_t)(c * 64 + t) * 16 + h] = bsum;
            *(LAS u32x4*)(TILE(0) + t * TLD + k0) = pack8(at);
            *(LAS u32x4*)(TILE(2) + t * TLD + k0) = pack8(rt);
            *(LAS u32x4*)(TILE(3) + t * TLD + k0) = pack8(bt);
            *(LAS u32x4*)(TILE(4) + t * TLD + k0) = pack8(kt);
            const u32x4 atp = pack8(at), bhp = pack8(bh), khp = pack8(kh);
#pragma unroll
            for (int i = 0; i < 8; ++i) {
                const int q = i >> 1; const bool hi = i & 1;
                TILE(1)[(k0 + i) * TLD + t] = (bf16_t)(hi ? (atp[q] >> 16) : (atp[q] & 0xffffu));
                TILE(5)[(k0 + i) * TLD + t] = (bf16_t)(hi ? (bhp[q] >> 16) : (bhp[q] & 0xffffu));
                TILE(6)[(k0 + i) * TLD + t] = (bf16_t)(hi ? (khp[q] >> 16) : (khp[q] & 0xffffu));
                TILE(7)[(k0 + i) * TLD + t] = (bf16_t)(hi ? (v4[q] >> 16) : (v4[q] & 0xffffu));
            }
            __syncthreads();
        }
#pragma unroll
        for (int nn = 0; nn < 2; ++nn) {
            const int ni = nb + nn; const int col = ni * 16 + fr, row0 = mi * 16 + fq * 4;
            f32x4 x = mm_tile(z4, TILE(0), TILE(3), mi, ni, fr, fq);
#pragma unroll
            for (int j = 0; j < 4; ++j) x[j] = (col < row0 + j) ? x[j] : 0.f;
            st_rm(TILE(8), x, mi, ni, fr, fq); st_tr(TILE(9), x, mi, ni, fr, fq);
            x = mm_tile(z4, TILE(0), TILE(4), mi, ni, fr, fq);
#pragma unroll
            for (int j = 0; j < 4; ++j) x[j] = (col < row0 + j) ? x[j] : 0.f;
            st_rm(TILE(10), x, mi, ni, fr, fq);
            x = mm_tile(z4, TILE(2), TILE(3), mi, ni, fr, fq);
#pragma unroll
            for (int j = 0; j < 4; ++j) x[j] = (col <= row0 + j) ? x[j] : 0.f;
            st_rm(TILE(11), x, mi, ni, fr, fq);
            x = mm_tile(z4, TILE(2), TILE(4), mi, ni, fr, fq);
#pragma unroll
            for (int j = 0; j < 4; ++j) x[j] = (col <= row0 + j) ? x[j] : 0.f;
            st_rm(TILE(12), x, mi, ni, fr, fq);
        }
        __syncthreads();
#pragma unroll
        for (int nn = 0; nn < 2; ++nn) {
            const int ni = nb + nn;
            st_tr(TILE(13), mm_tile(z4, TILE(10), TILE(7), mi, ni, fr, fq), mi, ni, fr, fq);
            const f32x4 x = mm_tile(z4, TILE(8), TILE(9), mi, ni, fr, fq);
            st_rm(TILE(0), x, mi, ni, fr, fq); st_tr(TILE(3), x, mi, ni, fr, fq);
        }
        __syncthreads();
#pragma unroll
        for (int rd = 0; rd < 5; ++rd) {
            const int tq = (rd & 1) ? 14 : 8, tqo = (rd & 1) ? 8 : 14;
            const int lx = (rd & 1) ? 4 : 0, lxt = (rd & 1) ? 9 : 3, lxo = (rd & 1) ? 0 : 4, lxto = (rd & 1) ? 3 : 9;
#pragma unroll
            for (int nn = 0; nn < 2; ++nn) {
                const int ni = nb + nn;
                f32x4 x = ld_rm(TILE(tq), mi, ni, fr, fq) + ld_rm(TILE(lx), mi, ni, fr, fq);
                x = mm_tile(x, TILE(tq), TILE(lxt), mi, ni, fr, fq);
                st_rm(TILE(tqo), x, mi, ni, fr, fq);
                if (rd < 4) { const f32x4 y = mm_tile(z4, TILE(lx), TILE(lxt), mi, ni, fr, fq); st_rm(TILE(lxo), y, mi, ni, fr, fq); st_tr(TILE(lxto), y, mi, ni, fr, fq); }
            }
            __syncthreads();
        }
#pragma unroll
        for (int nn = 0; nn < 2; ++nn) {
            const int ni = nb + nn;
            st_tr(TILE(10), mm_tile(ld_tr(TILE(1), mi, ni, fr, fq), TILE(14), TILE(1), mi, ni, fr, fq), mi, ni, fr, fq);
            st_tr(TILE(15), mm_tile(ld_tr(TILE(13), mi, ni, fr, fq), TILE(14), TILE(13), mi, ni, fr, fq), mi, ni, fr, fq);
        }
        __syncthreads();
#pragma unroll
        for (int nn = 0; nn < 2; ++nn) {
            const int ni = nb + nn;
            {
                f32x4 x = mm_tile(z4, TILE(5), TILE(10), mi, ni, fr, fq);
                if (mi == ni) {
#pragma unroll
                    for (int j = 0; j < 4; ++j) x[j] += (fq * 4 + j == fr) ? wc[ni * 16 + fr] : 0.f;
                }
                const unsigned w0 = cvt_pk_bf16(x[0], x[1]), w1 = cvt_pk_bf16(x[2], x[3]);
                bf16_t* gp = GT + (size_t)item * 4096 + (size_t)((mi * 2 + (ni >> 1)) * 64 + (fr >> 2) * 16 + fq * 4) * 8 + (ni & 1) * 4 + (fr & 3);
                gp[0] = (bf16_t)(w0 & 0xffffu); gp[8] = (bf16_t)(w0 >> 16); gp[16] = (bf16_t)(w1 & 0xffffu); gp[24] = (bf16_t)(w1 >> 16);
            }
            {
                f32x4 x = mm_tile(z4, TILE(5), TILE(15), mi, ni, fr, fq);
                x = mm_tile(x, TILE(6), TILE(7), mi, ni, fr, fq);
                *(f32x4*)(HT + (size_t)item * 4096 + (size_t)((ni * 4 + mi) * 64 + lane) * 4) = x;
            }
            {
                f32x4 x = ld_tr(TILE(2), mi, ni, fr, fq);
                x = mm_tile(x, TILE(10), TILE(11), mi, ni, fr, fq);
                u32x2 wv; wv.x = cvt_pk_bf16(x[0], x[1]); wv.y = cvt_pk_bf16(x[2], x[3]);
                *(u32x2*)(QE + (size_t)item * 4096 + (ni * 16 + fr) * 64 + mi * 16 + fq * 4) = wv;
            }
            {
                f32x4 x = mm_tile(z4, TILE(11), TILE(15), mi, ni, fr, fq);
                x = mm_tile(x, TILE(12), TILE(7), mi, ni, fr, fq);
                u32x2 wv; wv.x = cvt_pk_bf16(x[0], x[1]); wv.y = cvt_pk_bf16(x[2], x[3]);
                *(u32x2*)(YL + (size_t)item * 4096 + (size_t)((mi * 4 + ni) * 64 + lane) * 4) = wv;
            }
        }
    }
}

__device__ __forceinline__ void phase_seq(const Params& p) {
    if (threadIdx.x >= 64) return;
    const int head = blockIdx.x >> 2, vt = blockIdx.x & 3, lane = threadIdx.x, fr = lane & 15, fq = lane >> 4;
    const bf16_t* GT = (const bf16_t*)(p.ws + WS_GT); const float* HT = (const float*)(p.ws + WS_HT); bf16_t* S0 = (bf16_t*)(p.ws + WS_S0);
    f32x4 acc[4];
#pragma unroll
    for (int mb = 0; mb < 4; ++mb) acc[mb] = (f32x4){0.f, 0.f, 0.f, 0.f};
    bf16x8 ga[4][4][2]; f32x4 hh[4][4];
#define SEQ_LOAD(buf, cc) do { const size_t _it = (size_t)((cc) < 256 ? (cc) : 255) * 16 + head; \
        _Pragma("unroll") for (int mb = 0; mb < 4; ++mb) { \
            _Pragma("unroll") for (int ks = 0; ks < 2; ++ks) ga[buf][mb][ks] = *(const bf16x8*)(GT + _it * 4096 + (size_t)((mb * 2 + ks) * 64 + lane) * 8); \
            hh[buf][mb] = *(const f32x4*)(HT + _it * 4096 + (size_t)((vt * 4 + mb) * 64 + lane) * 4); } } while (0)
    SEQ_LOAD(0, 0); SEQ_LOAD(1, 1); SEQ_LOAD(2, 2); SEQ_LOAD(3, 3);
    for (int c0 = 0; c0 < 256; c0 += 4) {
#pragma unroll
        for (int b = 0; b < 4; ++b) {
            const int c = c0 + b; const size_t item = (size_t)c * 16 + head;
            u32x2 pk[4];
#pragma unroll
            for (int mb = 0; mb < 4; ++mb) { pk[mb].x = cvt_pk_bf16(acc[mb][0], acc[mb][1]); pk[mb].y = cvt_pk_bf16(acc[mb][2], acc[mb][3]);
                *(u32x2*)(S0 + item * 4096 + (vt * 16 + fr) * 64 + mb * 16 + fq * 4) = pk[mb]; }
            u32x4 b0w, b1w; b0w.x = pk[0].x; b0w.y = pk[0].y; b0w.z = pk[1].x; b0w.w = pk[1].y; b1w.x = pk[2].x; b1w.y = pk[2].y; b1w.z = pk[3].x; b1w.w = pk[3].y;
            const bf16x8 b0 = __builtin_bit_cast(bf16x8, b0w), b1 = __builtin_bit_cast(bf16x8, b1w);
#pragma unroll
            for (int mb = 0; mb < 4; ++mb) {
                const f32x4 x = __builtin_amdgcn_mfma_f32_16x16x32_bf16(ga[b][mb][0], b0, hh[b][mb], 0, 0, 0);
                acc[mb] = __builtin_amdgcn_mfma_f32_16x16x32_bf16(ga[b][mb][1], b1, x, 0, 0, 0);
            }
            SEQ_LOAD(b, c + 4);
        }
    }
#undef SEQ_LOAD
}

__device__ __forceinline__ void phase_chunkY(const Params& p, LAS unsigned char* lds) {
    LAS float* Yb = (LAS float*)lds;
    const int tid = threadIdx.x, w = tid >> 6, lane = tid & 63, fr = lane & 15, fq = lane >> 4;
    const int mi = w >> 1, nb = (w & 1) * 2;
    const bf16_t* R = (const bf16_t*)(p.ws + WS_R); const bf16_t* Kk = (const bf16_t*)(p.ws + WS_K); const bf16_t* V = (const bf16_t*)(p.ws + WS_V);
    const bf16_t* G = (const bf16_t*)(p.ws + WS_G); const bf16_t* YC = (const bf16_t*)(p.ws + WS_YC);
    const bf16_t* QE = (const bf16_t*)(p.ws + WS_QE); const bf16_t* YL = (const bf16_t*)(p.ws + WS_YL); const bf16_t* S0 = (const bf16_t*)(p.ws + WS_S0);
    bf16_t* YM = (bf16_t*)(p.ws + WS_YMIX);
    const float* gn_w = p.in[16]; const float* gn_b = p.in[17];
    u32x2 ywn[2]; bf16x8 an[2], bn[2][2]; bool first = true;
    u32x4 nv4, ng4, nyc4; float nbon; const float* BONp = (const float*)(p.ws + WS_BON);
#define CY_LOAD(it) do { const bf16_t* _q = QE + (size_t)(it) * 4096; const bf16_t* _s = S0 + (size_t)(it) * 4096; const bf16_t* _y = YL + (size_t)(it) * 4096; \
        _Pragma("unroll") for (int ks = 0; ks < 2; ++ks) an[ks] = *(const bf16x8*)(_q + (mi * 16 + fr) * 64 + ks * 32 + fq * 8); \
        _Pragma("unroll") for (int nn = 0; nn < 2; ++nn) { ywn[nn] = *(const u32x2*)(_y + (size_t)((mi * 4 + nb + nn) * 64 + lane) * 4); \
            _Pragma("unroll") for (int ks = 0; ks < 2; ++ks) bn[nn][ks] = *(const bf16x8*)(_s + (nb + nn) * 16 * 64 + fr * 64 + ks * 32 + fq * 8); } \
        { const size_t _tg = (size_t)((it) >> 4) * 64 + (tid >> 3); const size_t _o = _tg * DR + ((it) & 15) * 64 + (tid & 7) * 8; \
          nv4 = *(const u32x4*)(V + _o); ng4 = *(const u32x4*)(G + _o); nyc4 = *(const u32x4*)(YC + _o); nbon = BONp[_tg * 16 + ((it) & 15)]; } } while (0)
    for (int item = blockIdx.x; item < 4096; item += gridDim.x) {
        const int c = item >> 4, h = item & 15;
        if (first) { first = false; CY_LOAD(item); }
        __syncthreads();
        const u32x2 ywc[2] = {ywn[0], ywn[1]}; const bf16x8 ac[2] = {an[0], an[1]}; const bf16x8 bc[2][2] = {{bn[0][0], bn[0][1]}, {bn[1][0], bn[1][1]}};
        const u32x4 v4 = nv4, g4 = ng4, yc4 = nyc4; const float bon = nbon;
        if (item + (int)gridDim.x < 4096) CY_LOAD(item + (int)gridDim.x);
#pragma unroll
        for (int nn = 0; nn < 2; ++nn) {
            const int ni = nb + nn;
            const u32x2 yw = ywc[nn];
            f32x4 acc = (f32x4){lo_bf(yw.x), hi_bf(yw.x), lo_bf(yw.y), hi_bf(yw.y)};
#pragma unroll
            for (int ks = 0; ks < 2; ++ks) acc = __builtin_amdgcn_mfma_f32_16x16x32_bf16(ac[ks], bc[nn][ks], acc, 0, 0, 0);
#pragma unroll
            for (int j = 0; j < 4; ++j) Yb[(mi * 16 + fq * 4 + j) * 68 + ni * 16 + fr] = acc[j];
        }
        __syncthreads();
        {
            const int t = tid >> 3, k0 = (tid & 7) * 8; const int ch = h * 64 + k0;
            const size_t tg = (size_t)c * 64 + t; const size_t o = tg * DR + ch;
            const float4 gw0 = *(const float4*)(gn_w + ch), gw1 = *(const float4*)(gn_w + ch + 4), gb0 = *(const float4*)(gn_b + ch), gb1 = *(const float4*)(gn_b + ch + 4);
            const float gwv[8] = {gw0.x, gw0.y, gw0.z, gw0.w, gw1.x, gw1.y, gw1.z, gw1.w}, gbv[8] = {gb0.x, gb0.y, gb0.z, gb0.w, gb1.x, gb1.y, gb1.z, gb1.w};
            const f32x4 y0 = *(const LAS f32x4*)(Yb + t * 68 + k0), y1 = *(const LAS f32x4*)(Yb + t * 68 + k0 + 4);
            const float y[8] = {y0[0], y0[1], y0[2], y0[3], y1[0], y1[1], y1[2], y1[3]};
            float sm = 0.f;
#pragma unroll
            for (int i = 0; i < 8; ++i) sm += y[i];
            sm += dpp_f<0xB1, 0xf>(sm); sm += dpp_f<0x4E, 0xf>(sm); sm += dpp_f<0x141, 0xf>(sm);
            const float mean = sm * (1.f / 64.f);
            float vs = 0.f;
#pragma unroll
            for (int i = 0; i < 8; ++i) { const float d = y[i] - mean; vs += d * d; }
            vs += dpp_f<0xB1, 0xf>(vs); vs += dpp_f<0x4E, 0xf>(vs); vs += dpp_f<0x141, 0xf>(vs);
            const float rs = rsqrtf(vs * (1.f / 64.f) + 64e-5f);
            float vf[8], gf[8], of[8];
            unpack8(v4, vf); unpack8(g4, gf);
#pragma unroll
            for (int i = 0; i < 8; ++i) of[i] = ((y[i] - mean) * rs * gwv[i] + gbv[i] + bon * vf[i]) * gf[i];
            *(u32x4*)(YM + tg * D_ + ch) = pack8(of);
            *(u32x4*)(YM + tg * D_ + 1024 + ch) = yc4;
        }
    }
#undef CY_LOAD
}

__device__ __forceinline__ int f2key(float x) { const int u = __float_as_int(x); return u ^ ((u >> 31) & 0x7fffffff); }
__device__ __forceinline__ float key2f(int k) { return __int_as_float(k ^ ((k >> 31) & 0x7fffffff)); }
template <int CTRL> __device__ __forceinline__ int dpp_i(int v) { return __builtin_amdgcn_update_dpp(v, v, CTRL, 0xf, 0xf, false); }
__device__ __forceinline__ int row_max_i(int v) { v = max(v, dpp_i<0xB1>(v)); v = max(v, dpp_i<0x4E>(v)); v = max(v, dpp_i<0x141>(v)); v = max(v, dpp_i<0x140>(v)); return v; }
__device__ __forceinline__ void phase_topk(const Params& p, unsigned char* shm) {
    float* sc = (float*)shm;
    int* tk = (int*)(sc + 64 * 260);
    int* ctab = tk + 2048;
    if (threadIdx.x < 64) { int n = threadIdx.x, v = 256;
        for (int i = 0; i < 16; ++i) { const int cnt = 16 / (i + 1); if (n < cnt) { v = i * 16 + n; break; } n -= cnt; }
        ctab[threadIdx.x] = v; }
    const float* SC = (const float*)(p.ws + WS_Q);
    int* IDS = (int*)(p.ws + WS_IDS); float* GATES = (float*)(p.ws + WS_GATES);
    const int tid = threadIdx.x, w = tid >> 6, lane = tid & 63;
    f32x4 qreg[8];
#define TK_QLOAD(it) do { const int _t0 = ((it) >> 3) * 64; _Pragma("unroll") for (int i = 0; i < 8; ++i) { const int ch = tid + 512 * i; \
        qreg[i] = *(const f32x4*)(SC + (size_t)(_t0 + (ch >> 6)) * 2048 + ((it) & 7) * 256 + (ch & 63) * 4); } } while (0)
    if ((int)blockIdx.x < 2048) TK_QLOAD((int)blockIdx.x);
    for (int item = blockIdx.x; item < 2048; item += gridDim.x) {
        const int t0 = (item >> 3) * 64, h = item & 7;
        __syncthreads();
#pragma unroll
        for (int i = 0; i < 8; ++i) { const int ch = tid + 512 * i; *(f32x4*)(sc + (ch >> 6) * 260 + (ch & 63) * 4) = qreg[i]; }
        __syncthreads();
        if (item + (int)gridDim.x < 2048) TK_QLOAD(item + (int)gridDim.x);
        for (int g = 0; g < 4; ++g) {
            const int L = w * 16 + g * 4 + (lane >> 4); const int tok = L >> 1, cc = L & 1; const int pp = lane & 15;
            int key[8];
#pragma unroll
            for (int i = 0; i < 8; ++i) key[i] = (f2key(sc[tok * 260 + cc * 128 + i * 16 + pp]) & ~127) | (127 - (i * 16 + pp));
#define CE(a, b) do { const int _hi = max(key[a], key[b]), _lo = min(key[a], key[b]); key[a] = _hi; key[b] = _lo; } while (0)
            CE(0, 1); CE(2, 3); CE(4, 5); CE(6, 7);  CE(0, 2); CE(1, 3); CE(4, 6); CE(5, 7);  CE(1, 2); CE(5, 6);
            CE(0, 4); CE(1, 5); CE(2, 6); CE(3, 7);  CE(2, 4); CE(3, 5);  CE(1, 2); CE(3, 4); CE(5, 6);
#undef CE
            int mykey = 0;
#pragma unroll
            for (int r = 0; r < 16; ++r) {
                const int m = row_max_i(key[0]);
                const bool win = (key[0] == m);
#pragma unroll
                for (int i = 0; i < 7; ++i) key[i] = win ? key[i + 1] : key[i];
                key[7] = win ? (int)0x80000000 : key[7];
                mykey = (pp == r) ? m : mykey;
            }
            tk[L * 16 + pp] = mykey;
        }
        __syncthreads();
        for (int g = 0; g < 2; ++g) {
            const int tok = w * 8 + g * 4 + (lane >> 4); const int pp = lane & 15;
            int key[4];
#pragma unroll
            for (int q = 0; q < 4; ++q) {
                const int ij = ctab[q * 16 + pp];
                const float s1 = key2f(tk[(tok * 2) * 16 + ((ij >> 4) & 15)] & ~127), s2 = key2f(tk[(tok * 2 + 1) * 16 + (ij & 15)] & ~127);
                key[q] = (ij < 256) ? ((f2key(s1 + s2) & ~255) | (255 - ij)) : (int)0x80000000;
            }
            int mykey = 0;
#pragma unroll
            for (int r = 0; r < 16; ++r) {
                const int ml = max(max(key[0], key[1]), max(key[2], key[3]));
                const int m = row_max_i(ml);
#pragma unroll
                for (int q = 0; q < 4; ++q) key[q] = (key[q] == m) ? (int)0x80000000 : key[q];
                mykey = (pp == r) ? m : mykey;
            }
            const int ci = 255 - (mykey & 255); const float cs = key2f(mykey & ~255);
            const int e1 = 127 - (tk[(tok * 2) * 16 + (ci >> 4)] & 127), e2 = 127 - (tk[(tok * 2 + 1) * 16 + (ci & 15)] & 127);
            const float mx = __shfl(cs, lane & 48);
            const float e = __expf(cs - mx);
            float sum = e; sum += dpp_f<0xB1, 0xf>(sum); sum += dpp_f<0x4E, 0xf>(sum); sum += dpp_f<0x141, 0xf>(sum); sum += dpp_f<0x140, 0xf>(sum);
            IDS[(size_t)(t0 + tok) * 128 + h * 16 + pp] = (e1 * 128 + e2) & 16383;
            GATES[(size_t)(t0 + tok) * 128 + h * 16 + pp] = e / sum;
        }
    }
#undef TK_QLOAD
}

__device__ __forceinline__ float gelu_fast(float x) { const float u = 0.7978845608028654f * (x + 0.044715f * x * x * x); return x / (1.0f + __expf(-2.0f * u)); }
__device__ __forceinline__ void phase_gather(const Params& p, unsigned char* shm) {
    const float* X1 = (const float*)(p.ws + WS_X1); const float* SSQ = (const float*)(p.ws + WS_SSQ);
    const unsigned char* U6 = p.ws + WS_UB; const unsigned char* V6 = p.ws + WS_VB;
    const int* IDS = (const int*)(p.ws + WS_IDS); const float* GATES = (const float*)(p.ws + WS_GATES);
    const float* nf = p.in[25];
    const int tid = threadIdx.x, w = tid >> 6, lane = tid & 63;
    int nid0 = 0, nid1 = 0; float ngt0 = 0.f, ngt1 = 0.f, nssq = 0.f;
#define GT_META(tt) do { nid0 = IDS[(size_t)(tt) * 128 + lane]; nid1 = IDS[(size_t)(tt) * 128 + 64 + lane]; ngt0 = GATES[(size_t)(tt) * 128 + lane]; ngt1 = GATES[(size_t)(tt) * 128 + 64 + lane]; \
        nssq = (lane < 32) ? SSQ[(size_t)(tt) * 32 + lane] : 0.f; } while (0)
    if ((int)(blockIdx.x * 8 + w) < S_) GT_META(blockIdx.x * 8 + w);
    for (int t = blockIdx.x * 8 + w; t < S_; t += gridDim.x * 8) {
        const int id0 = nid0, id1 = nid1; const float gt0 = ngt0, gt1 = ngt1, ssqv = nssq;
        if (t + (int)gridDim.x * 8 < S_) GT_META(t + (int)gridDim.x * 8);
        f32x2 op[16];
#pragma unroll
        for (int j = 0; j < 8; ++j) { const float4 x = *(const float4*)(X1 + (size_t)t * D_ + (j * 64 + lane) * 4);
            op[2 * j] = (f32x2){x.x, x.y}; op[2 * j + 1] = (f32x2){x.z, x.w}; }
        f32x2 hp[16];
#pragma unroll
        for (int i = 0; i < 16; ++i) hp[i] = op[i];
        const float rs = rsqrtf(wave_sum_dpp(ssqv) * (1.0f / 2048.0f) + 1e-6f);
        u32x4 uaA[4], ubA[4], vbA[4]; u32x2 uaB[4], ubB[4], vbB[4];
#define G_LOADU(dA, dB, grp) do { _Pragma("unroll") for (int j = 0; j < 4; ++j) { const int e = (grp) * 4 + j; const int id = __builtin_amdgcn_readlane(e < 64 ? id0 : id1, e & 63); \
            const unsigned char* ur = U6 + (size_t)id * ROW6; dA[j] = *(const u32x4*)(ur + lane * 16); dB[j] = *(const u32x2*)(ur + 1024 + lane * 8); } } while (0)
#define G_LOADV(grp) do { _Pragma("unroll") for (int j = 0; j < 4; ++j) { const int e = (grp) * 4 + j; const int id = __builtin_amdgcn_readlane(e < 64 ? id0 : id1, e & 63); \
            const unsigned char* vr = V6 + (size_t)id * ROW6; vbA[j] = *(const u32x4*)(vr + lane * 16); vbB[j] = *(const u32x2*)(vr + 1024 + lane * 8); } } while (0)
#define G_DEC(A, B) __builtin_amdgcn_cvt_scalef32_pk32_f32_fp6((u32x6){A[0], A[1], A[2], A[3], B[0], B[1]}, 1.0f)
#define G_BODY(cA, cB, nA, nB, grp) do { \
            G_LOADV(grp); \
            G_LOADU(nA, nB, ((grp) + 1 < 32 ? (grp) + 1 : 31)); \
            float dsel = 0.f; \
            _Pragma("unroll") for (int j = 0; j < 4; ++j) { const f32x32 dd = G_DEC(cA[j], cB[j]); f32x2 d2 = (f32x2){0.f, 0.f}; \
                _Pragma("unroll") for (int m = 0; m < 16; ++m) d2 += (f32x2){dd[2 * m], dd[2 * m + 1]} * hp[m]; \
                const float d = wave_sum_dpp(d2.x + d2.y); dsel = (lane == j) ? d : dsel; } \
            const float av = gelu_fast(dsel * (rs * (1.f / U6_SCALE))) * (1.f / V6_SCALE); \
            _Pragma("unroll") for (int j = 0; j < 4; ++j) { const int e = (grp) * 4 + j; \
                const float a = __int_as_float(__builtin_amdgcn_readlane(__float_as_int(av), j)) * __int_as_float(__builtin_amdgcn_readlane(__float_as_int(e < 64 ? gt0 : gt1), e & 63)); \
                const f32x2 a2 = (f32x2){a, a}; const f32x32 dd = G_DEC(vbA[j], vbB[j]); \
                _Pragma("unroll") for (int m = 0; m < 16; ++m) op[m] += a2 * (f32x2){dd[2 * m], dd[2 * m + 1]}; } \
        } while (0)
        G_LOADU(uaA, uaB, 0);
#pragma unroll 1
        for (int g2 = 0; g2 < 32; g2 += 2) { G_BODY(uaA, uaB, ubA, ubB, g2); G_BODY(ubA, ubB, uaA, uaB, g2 + 1); }
#undef G_LOADU
#undef G_LOADV
#undef G_DEC
#undef G_BODY
        float ss = 0.f;
#pragma unroll
        for (int m = 0; m < 16; ++m) ss += op[m].x * op[m].x + op[m].y * op[m].y;
        ss = wave_sum_dpp(ss);
        const float scl = rsqrtf(ss * (1.f / 2048.f) + 1e-6f);
#pragma unroll
        for (int j = 0; j < 8; ++j) { const float4 g = *(const float4*)(nf + (j * 64 + lane) * 4);
            *(float4*)(p.out + (size_t)t * D_ + (j * 64 + lane) * 4) = make_float4(op[2 * j].x * scl * g.x, op[2 * j].y * scl * g.y, op[2 * j + 1].x * scl * g.z, op[2 * j + 1].y * scl * g.w); }
    }
#undef GT_META
}

#define PEER_LD6(dstA, dstB, base, id) do { const unsigned char* _q = (base) + ((size_t)xs * 16384 + (id)) * 192 + pt * 24; dstA = *(const u32x4*)_q; dstB = *(const u32x2*)(_q + 16); } while (0)
#define PEER_DEC(A, B) __builtin_amdgcn_cvt_scalef32_pk32_f32_fp6((u32x6){A[0], A[1], A[2], A[3], B[0], B[1]}, 1.0f)
__device__ __forceinline__ void phase_peerZ(const Params& p) {
    const float* X1 = (const float*)(p.ws + WS_X1); const unsigned char* U6 = p.ws + WS_UB; const int* IDS = (const int*)(p.ws + WS_IDS);
    float* ZP = (float*)(p.ws + WS_ZP);
    const int lane = threadIdx.x & 63, w = threadIdx.x >> 6, es = lane >> 3, pt = lane & 7;
    const int xs = blockIdx.x & 7, nwg = (gridDim.x >> 3) * 8;
    int t = (blockIdx.x >> 3) * 8 + w;
    if (t >= S_) return;
    float4 nh[8];
#pragma unroll
    for (int j = 0; j < 8; ++j) nh[j] = *(const float4*)(X1 + (size_t)t * D_ + xs * 256 + (j * 8 + pt) * 4);
    int cid0 = IDS[(size_t)t * 128 + lane], cid1 = IDS[(size_t)t * 128 + 64 + lane], nid0 = 0, nid1 = 0;
    if (t + nwg < S_) { nid0 = IDS[(size_t)(t + nwg) * 128 + lane]; nid1 = IDS[(size_t)(t + nwg) * 128 + 64 + lane]; }
    u32x4 bA[8]; u32x2 bB[8];
#pragma unroll
    for (int g = 0; g < 8; ++g) { const int id = __shfl(cid0, g * 8 + es); PEER_LD6(bA[g], bB[g], U6, id); }
    for (; t < S_; t += nwg) {
        f32x2 hp[16];
#pragma unroll
        for (int j = 0; j < 8; ++j) { hp[2 * j] = (f32x2){nh[j].x, nh[j].y}; hp[2 * j + 1] = (f32x2){nh[j].z, nh[j].w}; }
        const bool has_next = (t + nwg < S_);
        if (has_next) {
#pragma unroll
            for (int j = 0; j < 8; ++j) nh[j] = *(const float4*)(X1 + (size_t)(t + nwg) * D_ + xs * 256 + (j * 8 + pt) * 4); }
        int n2id0 = 0, n2id1 = 0;
        if (t + 2 * nwg < S_) { n2id0 = IDS[(size_t)(t + 2 * nwg) * 128 + lane]; n2id1 = IDS[(size_t)(t + 2 * nwg) * 128 + 64 + lane]; }
#pragma unroll
        for (int g = 0; g < 16; ++g) {
            const f32x32 dd = PEER_DEC(bA[g & 7], bB[g & 7]);
            if (g + 8 < 16) { const int id = __shfl(cid1, ((g + 8) * 8 + es) & 63); PEER_LD6(bA[g & 7], bB[g & 7], U6, id); }
            else if (has_next) { const int id = __shfl(nid0, (g - 8) * 8 + es); PEER_LD6(bA[g & 7], bB[g & 7], U6, id); }
            f32x2 d2 = (f32x2){0.f, 0.f};
#pragma unroll
            for (int m = 0; m < 16; ++m) d2 += (f32x2){dd[2 * m], dd[2 * m + 1]} * hp[m];
            float d = d2.x + d2.y;
            d += dpp_f<0xB1, 0xf>(d); d += dpp_f<0x4E, 0xf>(d); d += dpp_f<0x141, 0xf>(d);
            if (pt == 0) ZP[((size_t)t * 8 + xs) * 128 + g * 8 + es] = d;
        }
        cid0 = nid0; cid1 = nid1; nid0 = n2id0; nid1 = n2id1;
    }
}
__device__ __forceinline__ void phase_peerV(const Params& p, LAS unsigned char* lds) {
    const float* X1 = (const float*)(p.ws + WS_X1); const unsigned char* V6 = p.ws + WS_VB; const int* IDS = (const int*)(p.ws + WS_IDS);
    const float* GATES = (const float*)(p.ws + WS_GATES); const float* ZP = (const float*)(p.ws + WS_ZP); const float* SSQ = (const float*)(p.ws + WS_SSQ);
    float* X2 = (float*)(p.ws + WS_X2); float* SSQ2 = (float*)(p.ws + WS_SSQ2);
    const int lane = threadIdx.x & 63, w = threadIdx.x >> 6, es = lane >> 3, pt = lane & 7;
    const int xs = blockIdx.x & 7, nwg = (gridDim.x >> 3) * 8;
    LAS float* red = (LAS float*)(lds + w * 8192);
    int t = (blockIdx.x >> 3) * 8 + w;
    if (t >= S_) return;
    float nz0 = 0.f, nz1 = 0.f, ng0 = 0.f, ng1 = 0.f, nsq = 0.f;
#define PV_META(tt) do { ng0 = GATES[(size_t)(tt) * 128 + lane]; ng1 = GATES[(size_t)(tt) * 128 + 64 + lane]; nsq = (lane < 32) ? SSQ[(size_t)(tt) * 32 + lane] : 0.f; \
        float _a = 0.f, _b = 0.f; _Pragma("unroll") for (int x = 0; x < 8; ++x) { _a += ZP[((size_t)(tt) * 8 + x) * 128 + lane]; _b += ZP[((size_t)(tt) * 8 + x) * 128 + 64 + lane]; } nz0 = _a; nz1 = _b; } while (0)
    PV_META(t);
    asm volatile("" : "+v"(nz0), "+v"(nz1), "+v"(ng0), "+v"(ng1), "+v"(nsq));
    int cid0 = IDS[(size_t)t * 128 + lane], cid1 = IDS[(size_t)t * 128 + 64 + lane], nid0 = 0, nid1 = 0;
    if (t + nwg < S_) { nid0 = IDS[(size_t)(t + nwg) * 128 + lane]; nid1 = IDS[(size_t)(t + nwg) * 128 + 64 + lane]; }
    u32x4 bA[4]; u32x2 bB[4];
#pragma unroll
    for (int g = 0; g < 4; ++g) { const int id = __shfl(cid0, g * 8 + es); PEER_LD6(bA[g], bB[g], V6, id); }
    f32x4 nx1 = *(const f32x4*)(X1 + (size_t)t * D_ + xs * 256 + (es * 8 + pt) * 4);
    for (; t < S_; t += nwg) {
        const float z0 = nz0, z1 = nz1, g0 = ng0, g1 = ng1, sq = nsq; const f32x4 x1v = nx1;
        const bool has_next = (t + nwg < S_);
        const float rs = rsqrtf(wave_sum_dpp(sq) * (1.0f / 2048.0f) + 1e-6f);
        const float a0 = gelu_fast(z0 * (rs * (1.f / U6_SCALE))) * g0 * (1.f / V6_SCALE);
        const float a1 = gelu_fast(z1 * (rs * (1.f / U6_SCALE))) * g1 * (1.f / V6_SCALE);
        f32x2 op[16];
#pragma unroll
        for (int m = 0; m < 16; ++m) op[m] = (f32x2){0.f, 0.f};
#pragma unroll
        for (int g = 0; g < 16; ++g) {
            const f32x32 dd = PEER_DEC(bA[g & 3], bB[g & 3]);
            if (g + 4 < 16) { const int id = __shfl((g + 4) < 8 ? cid0 : cid1, ((g + 4) * 8 + es) & 63); PEER_LD6(bA[g & 3], bB[g & 3], V6, id); }
            else if (has_next) { const int id = __shfl(nid0, (g - 12) * 8 + es); PEER_LD6(bA[g & 3], bB[g & 3], V6, id); }
            const float a = __shfl(g < 8 ? a0 : a1, (g * 8 + es) & 63);
            const f32x2 a2 = (f32x2){a, a};
#pragma unroll
            for (int m = 0; m < 16; ++m) op[m] += a2 * (f32x2){dd[2 * m], dd[2 * m + 1]};
        }
        int n2id0 = 0, n2id1 = 0;
        if (has_next) { PV_META(t + nwg); nx1 = *(const f32x4*)(X1 + (size_t)(t + nwg) * D_ + xs * 256 + (es * 8 + pt) * 4); }
        if (t + 2 * nwg < S_) { n2id0 = IDS[(size_t)(t + 2 * nwg) * 128 + lane]; n2id1 = IDS[(size_t)(t + 2 * nwg) * 128 + 64 + lane]; }
#pragma unroll
        for (int k4 = 0; k4 < 8; ++k4) *(LAS f32x4*)(red + ((es * 8 + k4) * 8 + pt) * 4) = (f32x4){op[2 * k4].x, op[2 * k4].y, op[2 * k4 + 1].x, op[2 * k4 + 1].y};
        f32x4 sum = x1v;
#pragma unroll
        for (int e2 = 0; e2 < 8; ++e2) sum += *(const LAS f32x4*)(red + ((e2 * 8 + es) * 8 + pt) * 4);
        *(f32x4*)(X2 + (size_t)t * D_ + xs * 256 + (es * 8 + pt) * 4) = sum;
        const float ss = wave_sum_dpp(sum[0] * sum[0] + sum[1] * sum[1] + sum[2] * sum[2] + sum[3] * sum[3]);
        if (lane == 0) SSQ2[(size_t)t * 8 + xs] = ss;
        cid0 = nid0; cid1 = nid1; nid0 = n2id0; nid1 = n2id1;
    }
#undef PV_META
}
__device__ __forceinline__ void phase_final(const Params& p) {
    const float* X2 = (const float*)(p.ws + WS_X2); const float* SSQ2 = (const float*)(p.ws + WS_SSQ2); const float* nf = p.in[25];
    const int lane = threadIdx.x & 63, w = threadIdx.x >> 6;
    for (int t = blockIdx.x * 8 + w; t < S_; t += gridDim.x * 8) {
        const f32x4 s0 = *(const f32x4*)(SSQ2 + (size_t)t * 8), s1 = *(const f32x4*)(SSQ2 + (size_t)t * 8 + 4);
        const float scl = rsqrtf(((s0[0] + s0[1]) + (s0[2] + s0[3]) + (s1[0] + s1[1]) + (s1[2] + s1[3])) * (1.f / 2048.f) + 1e-6f);
#pragma unroll
        for (int j = 0; j < 8; ++j) { const float4 v = *(const float4*)(X2 + (size_t)t * D_ + (j * 64 + lane) * 4); const float4 g = *(const float4*)(nf + (j * 64 + lane) * 4);
            *(float4*)(p.out + (size_t)t * D_ + (j * 64 + lane) * 4) = make_float4(v.x * scl * g.x, v.y * scl * g.y, v.z * scl * g.z, v.w * scl * g.w); }
    }
}

#define XB_TMO      128
#define XB_XCNT(j)  (256  + 64 * (j))
#define XB_XSUB(j)  (1280 + 64 * (j))
#define XB_XGEN(j)  (2304 + 64 * (j))
#define XB_TOP      3328
#define XB_TOPGEN   3392
#define XCD_BAR_WORDS 3456
#define XB_SPIN_CAP (1u << 18)
__device__ __forceinline__ unsigned xb_ld(unsigned* p)              { return __hip_atomic_load(p, __ATOMIC_RELAXED, __HIP_MEMORY_SCOPE_AGENT); }
__device__ __forceinline__ unsigned xb_add(unsigned* p, unsigned v) { return __hip_atomic_fetch_add(p, v, __ATOMIC_RELAXED, __HIP_MEMORY_SCOPE_AGENT); }
__device__ __forceinline__ unsigned xb_xcc_id() { return (unsigned)__builtin_amdgcn_s_getreg((3 << 11) | 20) & 0xFu; }
#define XB_SPIN(cond, bar) do { unsigned _sp = 0; while (cond) { __builtin_amdgcn_s_sleep(1); \
    if ((++_sp & 255u) == 0u) { if (xb_ld(&(bar)[XB_TMO])) break; if (_sp > XB_SPIN_CAP) { atomicAdd(&(bar)[XB_TMO], 1u); break; } } } } while (0)
struct XcdBarrier { unsigned* bar; unsigned x; volatile LAS unsigned* st; };
__device__ __forceinline__ XcdBarrier xcd_barrier_post(unsigned* bar, volatile LAS unsigned* st) {
    XcdBarrier b; b.bar = bar; b.x = xb_xcc_id(); b.st = st;
    if (threadIdx.x == 0) (void)xb_add(&bar[XB_XCNT(b.x)], 1u);
    return b;
}
__device__ __forceinline__ void xcd_barrier_complete(unsigned* bar, unsigned x, unsigned& nloc, unsigned& nx) {
    const unsigned G = gridDim.x * gridDim.y * gridDim.z;
    unsigned sum, cnt, mine, sp = 0u;
    for (;;) {
        sum = 0u; cnt = 0u; mine = 0u;
#pragma unroll
        for (unsigned j = 0; j < 16; ++j) { const unsigned c = xb_ld(&bar[XB_XCNT(j)]); sum += c; cnt += (c > 0u) ? 1u : 0u; mine = (j == x) ? c : mine; }
        if (sum == G) break;
        __builtin_amdgcn_s_sleep(1);
        if ((++sp & 255u) == 0u) { if (xb_ld(&bar[XB_TMO])) break; if (sp > XB_SPIN_CAP) { atomicAdd(&bar[XB_TMO], 1u); break; } }
    }
    nloc = mine > 0u ? mine : 1u; nx = cnt > 0u ? cnt : 1u;
}
__device__ __forceinline__ void xcd_barrier(const XcdBarrier& b) {
    asm volatile("s_waitcnt vmcnt(0)" ::: "memory");
    __syncthreads();
    if (threadIdx.x == 0) {
        unsigned* bar = b.bar;
        __builtin_amdgcn_s_waitcnt(0);
        unsigned nloc = b.st[0], nx = b.st[1];
        if (nloc == 0u) { xcd_barrier_complete(bar, b.x, nloc, nx); b.st[0] = nloc; b.st[1] = nx; }
        const unsigned old = xb_add(&bar[XB_XSUB(b.x)], 1u);
        const unsigned gen = old / nloc;
        if (old + 1u == (gen + 1u) * nloc) {
            __builtin_amdgcn_fence(__ATOMIC_RELEASE, "agent");
            asm volatile("s_waitcnt vmcnt(0)" ::: "memory");
            const unsigned og = xb_add(&bar[XB_TOP], 1u);
            const unsigned tg = og / nx;
            if (og + 1u == (tg + 1u) * nx) xb_add(&bar[XB_TOPGEN], 1u);
            else XB_SPIN(xb_ld(&bar[XB_TOPGEN]) == tg, bar);
            __builtin_amdgcn_fence(__ATOMIC_ACQUIRE, "agent");
            xb_add(&bar[XB_XGEN(b.x)], 1u);
            asm volatile("s_waitcnt vmcnt(0)" ::: "memory");
        } else {
            XB_SPIN(xb_ld(&bar[XB_XGEN(b.x)]) == gen, bar);
            __builtin_amdgcn_fence(__ATOMIC_ACQUIRE, "agent");
            asm volatile("s_waitcnt vmcnt(0)" ::: "memory");
        }
    }
    __syncthreads();
}

__global__ void __launch_bounds__(512, 2) mega(Params p) {
    extern __shared__ __attribute__((aligned(16))) unsigned char shm[];
    cg::grid_group grid = cg::this_grid();
    LAS unsigned char* lds = (LAS unsigned char*)shm;
    volatile LAS unsigned* bst = (volatile LAS unsigned*)(lds + LDS_BYTES - 16);
    if (threadIdx.x == 0) { bst[0] = 0u; bst[1] = 0u; }
    __syncthreads();
    const XcdBarrier xbar = xcd_barrier_post((unsigned*)(p.ws + WS_BAR), bst);
    if (p.ph_hi > 1000) grid.sync();
    const int lo = p.ph_lo, hi = p.ph_hi;
#define IN(k) (lo <= (k) && (k) < hi)
#define REP(k) for (int _r = 0; _r < ((k) == DUP_PHASE ? 2 : 1); ++_r)
#define SEAM(k) do { if (IN(k) && IN((k) + 1)) xcd_barrier(xbar); } while (0)
    if (IN(0)) REP(0) { if (_r) xcd_barrier(xbar); phase0(p, shm); }
    SEAM(0);
    if (IN(1)) REP(1) { if (_r) xcd_barrier(xbar);
        pg8::Gemm g{(const bf16_t*)(p.ws + WS_H), (const bf16_t*)(p.ws + WS_WB1), S_, NAUG, 2048};
        pg8::StaticOrder so; so.init(g.M, g.N, (int)gridDim.x, (int)blockIdx.x);
        pg8::EpiBf16 E{(bf16_t*)(p.ws + WS_PROJ), NAUG};
        pg8::gemm_phase(lds, g, so, E);
    }
    SEAM(1);
    if (IN(2)) REP(2) { if (_r) xcd_barrier(xbar);
        phase_prepM(p, lds);
        phase_prepE(p);
    }
    SEAM(2);
    if (IN(3)) REP(3) { if (_r) xcd_barrier(xbar); phase_chunkA(p, lds); }
    SEAM(3);
    if (IN(4)) REP(4) { if (_r) xcd_barrier(xbar); if (blockIdx.x < 64) phase_seq(p);
        else { const int bid = blockIdx.x - 64, nblk = gridDim.x - 64;
            convert_fp6s(p.in[23], p.ws + WS_UB, 16384, U6_SCALE, p.in[20], bid, nblk);
            convert_fp6s(p.in[24], p.ws + WS_VB, 16384, V6_SCALE, nullptr, bid, nblk);
            build_wpt(p.in[21], p.in[20], (const bf16_t*)(p.ws + WS_KEYB), (bf16_t*)(p.ws + WS_WQT), bid, nblk);
            transpose_convert(p.in[19], 2048, 2048, (bf16_t*)(p.ws + WS_WOT), (float*)shm, bid, nblk); } }
    SEAM(4);
    if (IN(5)) REP(5) { if (_r) xcd_barrier(xbar); phase_chunkY(p, lds); }
    SEAM(5);
    if (IN(6)) REP(6) { if (_r) xcd_barrier(xbar);
        pg8::Gemm g{(const bf16_t*)(p.ws + WS_YMIX), (const bf16_t*)(p.ws + WS_WOT), S_, 2048, 2048};
        pg8::StaticOrder so; so.init(g.M, g.N, (int)gridDim.x, (int)blockIdx.x);
        pg8::EpiRes2 E{(float*)(p.ws + WS_X1), p.in[0], (bf16_t*)(p.ws + WS_H2), (float*)(p.ws + WS_SSQ), 2048};
        pg8::gemm_phase(lds, g, so, E);
    }
    SEAM(6);
    if (IN(8)) REP(8) { if (_r) xcd_barrier(xbar);
        pg8::Gemm g{(const bf16_t*)(p.ws + WS_H2), (const bf16_t*)(p.ws + WS_WQT), S_, 2048, 2048};
        pg8::StaticOrder so; so.init(g.M, g.N, (int)gridDim.x, (int)blockIdx.x);
        pg8::EpiRowScaleF32 E{(float*)(p.ws + WS_Q), (const float*)(p.ws + WS_SSQ), 2048};
        pg8::gemm_phase(lds, g, so, E);
    }
    SEAM(8);
    if (IN(9)) REP(9) { if (_r) xcd_barrier(xbar); phase_topk(p, shm); }
    SEAM(9);
    if (IN(10)) REP(10) { if (_r) xcd_barrier(xbar); phase_peerZ(p); }
    SEAM(10);
    if (IN(11)) REP(11) { if (_r) xcd_barrier(xbar); phase_peerV(p, lds); }
    SEAM(11);
    if (IN(12)) REP(12) { if (_r) xcd_barrier(xbar); phase_final(p); }
#undef IN
#undef REP
#undef SEAM
}

extern "C" void kernel_launch(void* const* d_in, const int* in_sizes, int n_in, void* d_out, int out_size, void* d_ws, size_t ws_size, hipStream_t stream) {
    static int grid_blocks = 0;
    if (grid_blocks == 0) {
        if (n_in != 26 || ws_size < WS_NEED) { fprintf(stderr, "kernel_launch: unexpected n_in %d / ws_size %zu\n", n_in, ws_size); grid_blocks = -1; return; }
        int dev = 0, cus = 0, per_cu = 0;
        (void)hipGetDevice(&dev);
        (void)hipDeviceGetAttribute(&cus, hipDeviceAttributeMultiprocessorCount, dev);
        (void)hipFuncSetAttribute((const void*)mega, hipFuncAttributeMaxDynamicSharedMemorySize, LDS_BYTES);
        (void)hipOccupancyMaxActiveBlocksPerMultiprocessor(&per_cu, (const void*)mega, 512, LDS_BYTES);
        if (per_cu < 1) { fprintf(stderr, "kernel_launch: occupancy query says %d blocks/CU\n", per_cu); per_cu = 1; }
        grid_blocks = cus * per_cu;
        fprintf(stderr, "kernel_launch: cus %d per_cu %d grid %d\n", cus, per_cu, grid_blocks);
    }
    if (grid_blocks < 0) return;
    Params p{};
    for (int i = 0; i < 26; ++i) p.in[i] = (const float*)d_in[i];
    p.out = (float*)d_out; p.ws = (unsigned char*)d_ws;
#if MULTI_LAUNCH
    for (int ph = 0; ph < NPHASE; ++ph) {
        p.ph_lo = ph; p.ph_hi = ph + 1;
        hipLaunchKernelGGL(mega, dim3(grid_blocks), dim3(512), LDS_BYTES, stream, p);
    }
#else
    p.ph_lo = 0; p.ph_hi = NPHASE;
    if (hipMemsetAsync((unsigned char*)d_ws + WS_BAR, 0, XCD_BAR_WORDS * 4, stream) != hipSuccess) fprintf(stderr, "kernel_launch: barrier memset failed\n");
    void* args[] = {&p};
    hipError_t e = hipLaunchCooperativeKernel((const void*)mega, dim3(grid_blocks), dim3(512), args, LDS_BYTES, stream);
    if (e != hipSuccess) fprintf(stderr, "cooperative launch failed: %s (grid %d)\n", hipGetErrorString(e), grid_blocks);
#endif
}
```

```cpp
#include <hip/hip_runtime.h>
#include <hip/hip_cooperative_groups.h>
#include <cstdio>
namespace cg = cooperative_groups;

#ifndef DUP_PHASE
#define DUP_PHASE -1
#endif
#ifndef MULTI_LAUNCH
#define MULTI_LAUNCH 0
#endif

#define LAS __attribute__((address_space(3)))
typedef unsigned short bf16_t;
typedef short bf16x8 __attribute__((ext_vector_type(8)));
typedef float f32x4 __attribute__((ext_vector_type(4)));
typedef float f32x2 __attribute__((ext_vector_type(2)));
typedef unsigned u32x4 __attribute__((ext_vector_type(4)));
typedef unsigned u32x2 __attribute__((ext_vector_type(2)));
typedef unsigned u32x6 __attribute__((ext_vector_type(6)));
typedef float f32x32 __attribute__((ext_vector_type(32)));
typedef __bf16 bf16x32_t __attribute__((ext_vector_type(32)));

constexpr int S_ = 16384, D_ = 2048, DR = 1024, NAUG = 6912;
constexpr size_t MiB = 1ull << 20;
constexpr size_t WS_PROJ = 0, WS_H = 216 * MiB, WS_WB1 = 280 * MiB, WS_WQT = 280 * MiB, WS_WOT = 296 * MiB;
constexpr size_t WS_R = 307 * MiB, WS_K = 339 * MiB, WS_V = 371 * MiB, WS_KK = 403 * MiB, WS_A = 435 * MiB, WS_LW = 467 * MiB;
constexpr size_t WS_G = 216 * MiB, WS_YC = 248 * MiB, WS_YMIX = 307 * MiB, WS_X1 = 0, WS_H2 = 128 * MiB, WS_Q = 307 * MiB;
constexpr size_t WS_GT = 0, WS_HT = 32 * MiB, WS_QE = 96 * MiB, WS_YL = 128 * MiB, WS_S0 = 160 * MiB;
constexpr size_t WS_IDS = 192 * MiB, WS_GATES = 200 * MiB, WS_UB = 467 * MiB, WS_VB = 435 * MiB, WS_BON = 500 * MiB, WS_BAR = 502 * MiB, WS_KEYB = 503 * MiB, WS_SSQ = 504 * MiB, WS_SSQ2 = 506 * MiB, WS_NEED = 507 * MiB;
constexpr size_t WS_ZP = 128 * MiB, WS_X2 = 307 * MiB;
constexpr size_t WS_W2T = 499 * MiB, WS_A2T = WS_W2T + 131072, WS_G2T = WS_A2T + 131072;
constexpr int TLD = 72, TSLOT = 64 * TLD * 2;
constexpr int LDS_BYTES = 16 * TSLOT + 2048 + 256 + 16;
constexpr int NPHASE = 13;

struct Params {
    const float* in[26];
    float* out;
    unsigned char* ws;
    int ph_lo, ph_hi;
};

__device__ __forceinline__ float bf2f(bf16_t b) { return __uint_as_float(((unsigned)b) << 16); }
__device__ __forceinline__ bf16_t f2bf(float f) { unsigned u = __float_as_uint(f); u += 0x7FFFu + ((u >> 16) & 1u); return (bf16_t)(u >> 16); }
typedef __bf16 bf16v2_t __attribute__((ext_vector_type(2)));
__device__ __forceinline__ unsigned cvt_pk_bf16(float lo, float hi) { const f32x2 v = {lo, hi}; const bf16v2_t r = __builtin_convertvector(v, bf16v2_t); return __builtin_bit_cast(unsigned, r); }
__device__ __forceinline__ u32x4 pack8(const float* f) { u32x4 w; w.x = cvt_pk_bf16(f[0], f[1]); w.y = cvt_pk_bf16(f[2], f[3]); w.z = cvt_pk_bf16(f[4], f[5]); w.w = cvt_pk_bf16(f[6], f[7]); return w; }
__device__ __forceinline__ float lo_bf(unsigned w) { return __uint_as_float(w << 16); }
__device__ __forceinline__ float hi_bf(unsigned w) { return __uint_as_float(w & 0xffff0000u); }
__device__ __forceinline__ void unpack8(const u32x4 v, float* f) {
#pragma unroll
    for (int i = 0; i < 4; ++i) { f[2 * i] = lo_bf(v[i]); f[2 * i + 1] = hi_bf(v[i]); }
}
__device__ __forceinline__ float wave_sum(float v) {
#pragma unroll
    for (int o = 32; o; o >>= 1) v += __shfl_xor(v, o);
    return v;
}
template <int CTRL, int RM> __device__ __forceinline__ float dpp_f(float v) { return __int_as_float(__builtin_amdgcn_update_dpp(0, __float_as_int(v), CTRL, RM, 0xf, false)); }
__device__ __forceinline__ float wave_sum_dpp(float v) {
    v += dpp_f<0xB1, 0xf>(v); v += dpp_f<0x4E, 0xf>(v); v += dpp_f<0x141, 0xf>(v); v += dpp_f<0x140, 0xf>(v);
    v += dpp_f<0x142, 0xa>(v); v += dpp_f<0x143, 0xc>(v);
    return __int_as_float(__builtin_amdgcn_readlane(__float_as_int(v), 63));
}
__device__ __forceinline__ float wave_max(float v) {
#pragma unroll
    for (int o = 32; o; o >>= 1) v = fmaxf(v, __shfl_xor(v, o));
    return v;
}
__device__ __forceinline__ float sigmoidf_(float x) { return 1.0f / (1.0f + __expf(-x)); }
__device__ __forceinline__ float gelu_tanh(float x) { float u = 0.7978845608028654f * (x + 0.044715f * x * x * x); return 0.5f * x * (1.0f + tanhf(u)); }

namespace pg8 {
constexpr int BM = 256, BK = 64, HALF = 128, HTB = HALF * BK * 2, STAGE_BYTES = 8 * HTB, NXCD = 8, WGM = 8;
__device__ __forceinline__ int lds_byte(int r, int c) { const int st = (r >> 4) * 2 + (c >> 5), rr = r & 15, cc = c & 31, ob = rr * 64 + cc * 2; return st * 1024 + (ob ^ (((ob >> 9) & 1) << 5)); }
__device__ __forceinline__ void stage_rc(int b, int& R, int& C) { const int st = b / 1024, sb = b % 1024, swz = sb ^ (((sb >> 9) & 1) << 5); R = (st >> 1) * 16 + swz / 64; C = (st & 1) * 32 + (swz % 64) / 2; }
__device__ __forceinline__ int perm32(int rho) { const int n = rho >> 4, i = rho & 15; return 8 * (i >> 2) + 4 * n + (i & 3); }
struct Unit { int pm, pn; };
struct Gemm { const bf16_t* A; const bf16_t* Bt; int M, N, K; };
struct StaticOrder {
    int nM, nN, nwg, G, c;
    __device__ void init(int M, int N, int G_, int c_) { nM = M / BM; nN = N / BM; nwg = nM * nN; G = G_; c = c_; }
    __device__ bool next(int i, Unit& u) const {
        const long L = (long)i * G + c; if (L >= nwg) return false;
        int wgid = (int)L; { const int q = nwg / NXCD, r = nwg % NXCD, xcd = wgid % NXCD, off = wgid / NXCD; wgid = (xcd < r ? xcd * (q + 1) : r * (q + 1) + (xcd - r) * q) + off; }
        const int nig = WGM * nN, gid = wgid / nig, fm = gid * WGM, gsz = (nM - fm) < WGM ? (nM - fm) : WGM;
        u.pm = fm + ((wgid % nig) % gsz); u.pn = (wgid % nig) / gsz; return true;
    }
    __device__ __forceinline__ void a_ready(const Unit&) const {}
    __device__ __forceinline__ void done(const Unit&) const {}
};
struct EpiResF32 {
    static constexpr bool PERM = false;
    float* C; const float* Res; int ldc;
    __device__ __forceinline__ void operator()(const f32x4 (&acc)[2][2][4][2], const Unit& u, int wr, int wc, int fr, int fq) const {
        const int row0 = u.pm * BM + wr * 64 + fr, col0 = u.pn * BM + wc * 32 + 4 * fq;
#pragma unroll
        for (int ai = 0; ai < 2; ++ai)
#pragma unroll
            for (int m = 0; m < 4; ++m) { const size_t ro = (size_t)(row0 + ai * HALF + m * 16) * ldc + col0;
#pragma unroll
                for (int bj = 0; bj < 2; ++bj)
#pragma unroll
                    for (int n = 0; n < 2; ++n) { const f32x4 rs = *(const f32x4*)(Res + ro + bj * HALF + n * 16); *(f32x4*)(C + ro + bj * HALF + n * 16) = acc[ai][bj][m][n] + rs; } }
    }
};
struct EpiRes2 {
    static constexpr bool PERM = false;
    float* C; const float* Res; bf16_t* Cb; float* SSQ; int ldc;
    __device__ __forceinline__ void operator()(const f32x4 (&acc)[2][2][4][2], const Unit& u, int wr, int wc, int fr, int fq) const {
        const int row0 = u.pm * BM + wr * 64 + fr, col0 = u.pn * BM + wc * 32 + 4 * fq;
#pragma unroll
        for (int ai = 0; ai < 2; ++ai)
#pragma unroll
            for (int m = 0; m < 4; ++m) { const int row = row0 + ai * HALF + m * 16; const size_t ro = (size_t)row * ldc + col0; float ss = 0.f;
#pragma unroll
                for (int bj = 0; bj < 2; ++bj)
#pragma unroll
                    for (int n = 0; n < 2; ++n) { const f32x4 v = acc[ai][bj][m][n] + *(const f32x4*)(Res + ro + bj * HALF + n * 16);
                        *(f32x4*)(C + ro + bj * HALF + n * 16) = v;
                        u32x2 wv; wv.x = cvt_pk_bf16(v[0], v[1]); wv.y = cvt_pk_bf16(v[2], v[3]); *(u32x2*)(Cb + ro + bj * HALF + n * 16) = wv;
                        ss += v[0] * v[0] + v[1] * v[1] + v[2] * v[2] + v[3] * v[3]; }
                ss += __shfl_xor(ss, 16); ss += __shfl_xor(ss, 32);
                if (fq == 0) SSQ[(size_t)row * 32 + u.pn * 4 + wc] = ss; }
    }
};
struct EpiRowScaleF32 {
    static constexpr bool PERM = false;
    float* C; const float* SSQ; int ldc;
    __device__ __forceinline__ void operator()(const f32x4 (&acc)[2][2][4][2], const Unit& u, int wr, int wc, int fr, int fq) const {
        const int row0 = u.pm * BM + wr * 64 + fr, col0 = u.pn * BM + wc * 32 + 4 * fq;
#pragma unroll
        for (int ai = 0; ai < 2; ++ai)
#pragma unroll
            for (int m = 0; m < 4; ++m) { const int row = row0 + ai * HALF + m * 16; const size_t ro = (size_t)row * ldc + col0;
                const f32x4* sp = (const f32x4*)(SSQ + (size_t)row * 32); float sq = 0.f;
#pragma unroll
                for (int q = 0; q < 8; ++q) { const f32x4 v = sp[q]; sq += (v[0] + v[1]) + (v[2] + v[3]); }
                const float rs = rsqrtf(sq * (1.0f / 2048.0f) + 1e-6f);
#pragma unroll
                for (int bj = 0; bj < 2; ++bj)
#pragma unroll
                    for (int n = 0; n < 2; ++n) *(f32x4*)(C + ro + bj * HALF + n * 16) = acc[ai][bj][m][n] * rs; }
    }
};
struct EpiF32 {
    static constexpr bool PERM = false;
    float* C; int ldc;
    __device__ __forceinline__ void operator()(const f32x4 (&acc)[2][2][4][2], const Unit& u, int wr, int wc, int fr, int fq) const {
        const int row0 = u.pm * BM + wr * 64 + fr, col0 = u.pn * BM + wc * 32 + 4 * fq;
#pragma unroll
        for (int ai = 0; ai < 2; ++ai)
#pragma unroll
            for (int m = 0; m < 4; ++m) { const size_t ro = (size_t)(row0 + ai * HALF + m * 16) * ldc + col0;
#pragma unroll
                for (int bj = 0; bj < 2; ++bj)
#pragma unroll
                    for (int n = 0; n < 2; ++n) *(f32x4*)(C + ro + bj * HALF + n * 16) = acc[ai][bj][m][n]; }
    }
};
struct EpiBf16 {
    static constexpr bool PERM = true;
    bf16_t* O; int ldc;
    __device__ __forceinline__ void operator()(const f32x4 (&acc)[2][2][4][2], const Unit& u, int wr, int wc, int fr, int fq) const {
        const int row0 = u.pm * BM + wr * 64 + fr; const int col0 = u.pn * BM + wc * 32 + 8 * fq;
#pragma unroll
        for (int ai = 0; ai < 2; ++ai)
#pragma unroll
            for (int m = 0; m < 4; ++m) { bf16_t* rowp = O + (size_t)(row0 + ai * HALF + m * 16) * ldc + col0;
#pragma unroll
                for (int bj = 0; bj < 2; ++bj) { const f32x4 v0 = acc[ai][bj][m][0], v1 = acc[ai][bj][m][1];
                    u32x4 w; w.x = cvt_pk_bf16(v0[0], v0[1]); w.y = cvt_pk_bf16(v0[2], v0[3]); w.z = cvt_pk_bf16(v1[0], v1[1]); w.w = cvt_pk_bf16(v1[2], v1[3]);
                    *(u32x4*)(rowp + bj * HALF) = w; } }
    }
};

template <class Epi, class Sched>
__device__ __forceinline__ void gemm_phase(LAS unsigned char* lds, const Gemm g, const Sched& S, const Epi& E) {
    const int tid = threadIdx.x, wid = __builtin_amdgcn_readfirstlane(tid >> 6), lane = tid & 63, wr = wid >> 2, wc = wid & 3, fr = lane & 15, fq = lane >> 4;
    const int K = g.K, nt = K / BK;
    unsigned voffA[2], voffB[2];
#pragma unroll
    for (int i = 0; i < 2; ++i) { int R, C; stage_rc(tid * 16 + i * 8192, R, C); const int Rb = Epi::PERM ? ((R & ~31) + perm32(R & 31)) : R;
        voffA[i] = (unsigned)(R * K + C) * 2u; voffB[i] = (unsigned)(Rb * K + C) * 2u; }
    const size_t kstep = (size_t)(BK * 2);
    const size_t hstep = (size_t)HALF * K * 2;
    const size_t tstep = 2 * hstep;
    const unsigned ldsw = (unsigned)wid * 1024u;
    const int aoff = lds_byte(wr * 64 + fr, fq * 8), boff = lds_byte(wc * 32 + fr, fq * 8);
#define PG8_SA(b, h) (((b) * 2 + (h)) * HTB)
#define PG8_SB(b, h) ((4 + (b) * 2 + (h)) * HTB)
#define PG8_STAGE(bufoff, gbase, voff) do { _Pragma("unroll") for (int _i = 0; _i < 2; ++_i) \
        __builtin_amdgcn_global_load_lds((const unsigned*)((const char*)(gbase) + (voff)[_i]), (LAS unsigned*)(lds + (bufoff) + ldsw + _i * 8192), 16, 0, 0); } while (0)
#define PG8_LDA(dst, b, h) do { _Pragma("unroll") for (int m = 0; m < 4; ++m) _Pragma("unroll") for (int k = 0; k < 2; ++k) dst[m][k] = *(const LAS bf16x8*)(lds + PG8_SA(b, h) + aoff + m * 2048 + k * 1024); } while (0)
#define PG8_LDB(dst, b, h) do { _Pragma("unroll") for (int n = 0; n < 2; ++n) _Pragma("unroll") for (int k = 0; k < 2; ++k) dst[n][k] = *(const LAS bf16x8*)(lds + PG8_SB(b, h) + boff + n * 2048 + k * 1024); } while (0)
#define PG8_MMA(ai, bj, At, Bt) do { __builtin_amdgcn_s_setprio(1); _Pragma("unroll") for (int m = 0; m < 4; ++m) _Pragma("unroll") for (int n = 0; n < 2; ++n) _Pragma("unroll") for (int k = 0; k < 2; ++k) \
        acc[ai][bj][m][n] = __builtin_amdgcn_mfma_f32_16x16x32_bf16(Bt[n][k], At[m][k], acc[ai][bj][m][n], 0, 0, 0); __builtin_amdgcn_s_setprio(0); } while (0)
#define PG8_WAIT_V(n) asm volatile("s_waitcnt vmcnt(" #n ")" ::: "memory")
#define PG8_WAIT_L(n) asm volatile("s_waitcnt lgkmcnt(" #n ")" ::: "memory")
#define PG8_BAR __builtin_amdgcn_s_barrier()
#define PG8_SCHED __builtin_amdgcn_sched_barrier(0)
    Unit cur, nxt; int ui = 0;
    if (!S.next(0, cur)) return;
    f32x4 acc[2][2][4][2];
#pragma unroll
    for (int a = 0; a < 2; ++a)
#pragma unroll
        for (int b = 0; b < 2; ++b)
#pragma unroll
            for (int m = 0; m < 4; ++m)
#pragma unroll
                for (int n = 0; n < 2; ++n) acc[a][b][m][n] = (f32x4){0.f, 0.f, 0.f, 0.f};
    bf16x8 At[4][2], B0[2][2], B1[2][2];
    const char* cA = (const char*)g.A + (size_t)cur.pm * tstep; const char* cB = (const char*)g.Bt + (size_t)cur.pn * tstep;
    S.a_ready(cur);
    PG8_STAGE(PG8_SB(0, 0), cB, voffB); PG8_STAGE(PG8_SA(0, 0), cA, voffA); PG8_STAGE(PG8_SB(0, 1), cB + hstep, voffB); PG8_STAGE(PG8_SA(0, 1), cA + hstep, voffA);
    if (wr == 1) PG8_BAR;
    PG8_WAIT_V(4); PG8_BAR;
    PG8_STAGE(PG8_SB(1, 0), cB + kstep, voffB); PG8_STAGE(PG8_SA(1, 0), cA + kstep, voffA); PG8_STAGE(PG8_SB(1, 1), cB + hstep + kstep, voffB);
    PG8_WAIT_V(6); PG8_BAR;
    for (;;) {
        const bool has_next = S.next(ui + 1, nxt);
        const char* nA = has_next ? (const char*)g.A + (size_t)nxt.pm * tstep : cA; const char* nB = has_next ? (const char*)g.Bt + (size_t)nxt.pn * tstep : cB;
        for (int t = 0; t < nt; t += 2) {
            const bool last = (t == nt - 2);
            const char* a1 = cA + (size_t)(t + 1) * kstep;
            const char* a2 = last ? nA : cA + (size_t)(t + 2) * kstep; const char* b2 = last ? nB : cB + (size_t)(t + 2) * kstep;
            const char* a3 = a2 + kstep; const char* b3 = b2 + kstep;
            if (last && has_next) S.a_ready(nxt);
            PG8_LDB(B0, 0, 0); PG8_SCHED; PG8_LDA(At, 0, 0); PG8_STAGE(PG8_SA(1, 1), a1 + hstep, voffA);
            PG8_WAIT_L(8); PG8_BAR; PG8_WAIT_L(0); PG8_MMA(0, 0, At, B0); PG8_BAR; PG8_SCHED;
            PG8_LDB(B1, 0, 1); PG8_STAGE(PG8_SB(0, 0), b2, voffB);
            PG8_BAR; PG8_WAIT_L(0); PG8_MMA(0, 1, At, B1); PG8_BAR;
            PG8_LDA(At, 0, 1); PG8_STAGE(PG8_SA(0, 0), a2, voffA);
            PG8_BAR; PG8_WAIT_L(0); PG8_MMA(1, 0, At, B0); PG8_BAR; PG8_SCHED;
            PG8_STAGE(PG8_SB(0, 1), b2 + hstep, voffB);
            PG8_WAIT_V(6); PG8_BAR; PG8_MMA(1, 1, At, B1); PG8_BAR;
            PG8_LDB(B0, 1, 0); PG8_SCHED; PG8_LDA(At, 1, 0); PG8_STAGE(PG8_SA(0, 1), a2 + hstep, voffA);
            PG8_WAIT_L(8); PG8_BAR; PG8_WAIT_L(0); PG8_MMA(0, 0, At, B0); PG8_BAR; PG8_SCHED;
            PG8_LDB(B1, 1, 1); PG8_STAGE(PG8_SB(1, 0), b3, voffB);
            PG8_BAR; PG8_WAIT_L(0); PG8_MMA(0, 1, At, B1); PG8_BAR;
            PG8_LDA(At, 1, 1); PG8_STAGE(PG8_SA(1, 0), a3, voffA);
            PG8_BAR; PG8_WAIT_L(0); PG8_MMA(1, 0, At, B0); PG8_BAR; PG8_SCHED;
            PG8_STAGE(PG8_SB(1, 1), b3 + hstep, voffB);
            PG8_WAIT_V(6); PG8_BAR; PG8_MMA(1, 1, At, B1); PG8_BAR;
        }
        E(acc, cur, wr, wc, fr, fq); S.done(cur);
        if (!has_next) break;
#pragma unroll
        for (int a = 0; a < 2; ++a)
#pragma unroll
            for (int b = 0; b < 2; ++b)
#pragma unroll
                for (int m = 0; m < 4; ++m)
#pragma unroll
                    for (int n = 0; n < 2; ++n) acc[a][b][m][n] = (f32x4){0.f, 0.f, 0.f, 0.f};
        cur = nxt; cA = nA; cB = nB; ++ui;
    }
    PG8_WAIT_V(0);
    if (wr == 0) PG8_BAR;
    PG8_BAR;
#undef PG8_SA
#undef PG8_SB
#undef PG8_STAGE
#undef PG8_LDA
#undef PG8_LDB
#undef PG8_MMA
#undef PG8_WAIT_V
#undef PG8_WAIT_L
#undef PG8_BAR
#undef PG8_SCHED
}
}

__device__ __forceinline__ void rmsnorm_rows(const float* X, const float* gain, bf16_t* H) {
    const int wave = threadIdx.x >> 6, lane = threadIdx.x & 63;
    for (int row = blockIdx.x * 8 + wave; row < S_; row += gridDim.x * 8) {
        const float4* xr = (const float4*)(X + (size_t)row * D_);
        float4 v[8]; float ss = 0.f;
#pragma unroll
        for (int i = 0; i < 8; ++i) { v[i] = xr[i * 64 + lane]; ss += v[i].x * v[i].x + v[i].y * v[i].y + v[i].z * v[i].z + v[i].w * v[i].w; }
        ss = wave_sum(ss);
        const float sc = rsqrtf(ss * (1.0f / 2048.0f) + 1e-6f);
#pragma unroll
        for (int i = 0; i < 8; ++i) { const float4 g = ((const float4*)gain)[i * 64 + lane];
            u32x2 w; w.x = cvt_pk_bf16(v[i].x * sc * g.x, v[i].y * sc * g.y); w.y = cvt_pk_bf16(v[i].z * sc * g.z, v[i].w * sc * g.w);
            *(u32x2*)(H + (size_t)row * D_ + (i * 64 + lane) * 4) = w; }
    }
}

__device__ __forceinline__ void transpose_convert(const float* W, int K, int N, bf16_t* Bt, float* tile, int bid, int nblk) {
    const int tid = threadIdx.x; const int tk = K / 64, tn = N / 64, nt = tk * tn;
    float4 rg[2];
#define TC_LOAD(u) do { const int _k0 = ((u) / tn) * 64, _n0 = ((u) % tn) * 64; _Pragma("unroll") for (int i = 0; i < 2; ++i) { const int idx = tid + 512 * i; \
        rg[i] = *(const float4*)(W + (size_t)(_k0 + (idx >> 4)) * N + _n0 + (idx & 15) * 4); } } while (0)
    if (bid < nt) TC_LOAD(bid);
    for (int u = bid; u < nt; u += nblk) {
        const int k0 = (u / tn) * 64, n0 = (u % tn) * 64;
        __syncthreads();
#pragma unroll
        for (int i = 0; i < 2; ++i) { const int idx = tid + 512 * i; float* q = tile + (idx >> 4) * 65 + (idx & 15) * 4; q[0] = rg[i].x; q[1] = rg[i].y; q[2] = rg[i].z; q[3] = rg[i].w; }
        __syncthreads();
        if (u + nblk < nt) TC_LOAD(u + nblk);
        { const int nn = tid & 63, kq = (tid >> 6) * 8;
            u32x4 o;
#pragma unroll
            for (int i = 0; i < 4; ++i) o[i] = cvt_pk_bf16(tile[(kq + 2 * i) * 65 + nn], tile[(kq + 2 * i + 1) * 65 + nn]);
            *(u32x4*)(Bt + (size_t)(n0 + nn) * K + k0 + kq) = o; }
    }
#undef TC_LOAD
}

__device__ __forceinline__ void convert_flat(const float* src, bf16_t* dst, size_t n) {
    for (size_t i = ((size_t)blockIdx.x * 512 + threadIdx.x) * 8; i < n; i += (size_t)gridDim.x * 512 * 8) {
        const float4 a = *(const float4*)(src + i), b = *(const float4*)(src + i + 4);
        u32x4 w; w.x = cvt_pk_bf16(a.x, a.y); w.y = cvt_pk_bf16(a.z, a.w); w.z = cvt_pk_bf16(b.x, b.y); w.w = cvt_pk_bf16(b.z, b.w);
        *(u32x4*)(dst + i) = w;
    }
}

__device__ __forceinline__ void convert_fp8(const float* src, unsigned char* dst, size_t n, float sc, const float* colgain, int bid, int nblk) {
    const int lane = threadIdx.x & 63, wv = threadIdx.x >> 6;
    for (size_t base = ((size_t)bid * 8 + wv) * 1024; base < n; base += (size_t)nblk * 8 * 1024) {
        float4 a[4];
#pragma unroll
        for (int j = 0; j < 4; ++j) a[j] = *(const float4*)(src + base + (size_t)(j * 64 + lane) * 4);
#pragma unroll
        for (int j = 0; j < 4; ++j) { float4 gg = make_float4(sc, sc, sc, sc);
            if (colgain) { const float4 cgv = *(const float4*)(colgain + ((base + (size_t)(j * 64 + lane) * 4) & 2047)); gg.x *= cgv.x; gg.y *= cgv.y; gg.z *= cgv.z; gg.w *= cgv.w; }
            int x = __builtin_amdgcn_cvt_pk_fp8_f32(a[j].x * gg.x, a[j].y * gg.y, 0, false); x = __builtin_amdgcn_cvt_pk_fp8_f32(a[j].z * gg.z, a[j].w * gg.w, x, true);
            *(unsigned*)(dst + base + (size_t)(j * 64 + lane) * 4) = (unsigned)x; }
    }
}

constexpr int ROW6 = 1536;
constexpr float U6_SCALE = 56.f, V6_SCALE = 28.f;
__device__ __forceinline__ void convert_fp6(const float* src, unsigned char* dst, int nrows, float sc, const float* colgain, int bid, int nblk) {
    const int lane = threadIdx.x & 63, wv = threadIdx.x >> 6;
    float g[32];
#pragma unroll
    for (int j = 0; j < 8; ++j) { float4 cg = make_float4(1.f, 1.f, 1.f, 1.f); if (colgain) cg = *(const float4*)(colgain + (j * 64 + lane) * 4);
        g[j * 4] = sc * cg.x; g[j * 4 + 1] = sc * cg.y; g[j * 4 + 2] = sc * cg.z; g[j * 4 + 3] = sc * cg.w; }
    for (int row = bid * 8 + wv; row < nrows; row += nblk * 8) {
        f32x32 x;
#pragma unroll
        for (int j = 0; j < 8; ++j) { const f32x4 a = __builtin_nontemporal_load((const f32x4*)(src + (size_t)row * 2048 + (j * 64 + lane) * 4));
            x[j * 4] = a[0] * g[j * 4]; x[j * 4 + 1] = a[1] * g[j * 4 + 1]; x[j * 4 + 2] = a[2] * g[j * 4 + 2]; x[j * 4 + 3] = a[3] * g[j * 4 + 3]; }
        const bf16x32_t b = __builtin_convertvector(x, bf16x32_t);
        const u32x6 wv6 = __builtin_amdgcn_cvt_scalef32_pk32_fp6_bf16(b, 1.0f);
        *(u32x4*)(dst + (size_t)row * ROW6 + lane * 16) = (u32x4){wv6[0], wv6[1], wv6[2], wv6[3]};
        *(u32x2*)(dst + (size_t)row * ROW6 + 1024 + lane * 8) = (u32x2){wv6[4], wv6[5]};
    }
}

__device__ __forceinline__ void convert_fp6s(const float* src, unsigned char* dst, int nrows, float sc, const float* colgain, int bid, int nblk) {
    const int lane = threadIdx.x & 63, wv = threadIdx.x >> 6, x = lane >> 3, pt = lane & 7;
    float g[32];
#pragma unroll
    for (int j = 0; j < 8; ++j) { float4 cg = make_float4(1.f, 1.f, 1.f, 1.f); if (colgain) cg = *(const float4*)(colgain + x * 256 + (j * 8 + pt) * 4);
        g[j * 4] = sc * cg.x; g[j * 4 + 1] = sc * cg.y; g[j * 4 + 2] = sc * cg.z; g[j * 4 + 3] = sc * cg.w; }
    f32x4 nx[8];
    { const int row0 = bid * 8 + wv;
      if (row0 < nrows) {
#pragma unroll
          for (int j = 0; j < 8; ++j) nx[j] = __builtin_nontemporal_load((const f32x4*)(src + (size_t)row0 * 2048 + x * 256 + (j * 8 + pt) * 4)); } }
    for (int row = bid * 8 + wv; row < nrows; row += nblk * 8) {
        f32x32 v;
#pragma unroll
        for (int j = 0; j < 8; ++j) { const f32x4 a = nx[j];
            v[j * 4] = a[0] * g[j * 4]; v[j * 4 + 1] = a[1] * g[j * 4 + 1]; v[j * 4 + 2] = a[2] * g[j * 4 + 2]; v[j * 4 + 3] = a[3] * g[j * 4 + 3]; }
        const int nrow = row + nblk * 8;
        if (nrow < nrows) {
#pragma unroll
            for (int j = 0; j < 8; ++j) nx[j] = __builtin_nontemporal_load((const f32x4*)(src + (size_t)nrow * 2048 + x * 256 + (j * 8 + pt) * 4)); }
        const bf16x32_t b = __builtin_convertvector(v, bf16x32_t);
        const u32x6 w6 = __builtin_amdgcn_cvt_scalef32_pk32_fp6_bf16(b, 1.0f);
        unsigned char* q = dst + ((size_t)x * 16384 + row) * 192 + pt * 24;
        *(u32x2*)q = (u32x2){w6[0], w6[1]}; *(u32x2*)(q + 8) = (u32x2){w6[2], w6[3]}; *(u32x2*)(q + 16) = (u32x2){w6[4], w6[5]};
    }
}

__device__ __forceinline__ void build_wpt(const float* wq, const float* gain, const bf16_t* KEYB, bf16_t* WPT, int bid, int nblk) {
    const int w = threadIdx.x >> 6, lane = threadIdx.x & 63, fr = lane & 15, fq = lane >> 4;
    for (int task = bid * 8 + w; task < 16 * 128; task += nblk * 8) {
        const int g = task >> 7, kb = task & 127;
        f32x4 acc[8];
#pragma unroll
        for (int n = 0; n < 8; ++n) acc[n] = (f32x4){0.f, 0.f, 0.f, 0.f};
#pragma unroll 2
        for (int ks = 0; ks < 8; ++ks) {
            const float4* wp = (const float4*)(wq + (size_t)(kb * 16 + fr) * 4096 + g * 256 + ks * 32 + fq * 8);
            const float4 x0 = wp[0], x1 = wp[1]; const float gk = gain[kb * 16 + fr];
            u32x4 wv; wv.x = cvt_pk_bf16(x0.x * gk, x0.y * gk); wv.y = cvt_pk_bf16(x0.z * gk, x0.w * gk); wv.z = cvt_pk_bf16(x1.x * gk, x1.y * gk); wv.w = cvt_pk_bf16(x1.z * gk, x1.w * gk);
            const bf16x8 a = __builtin_bit_cast(bf16x8, wv);
#pragma unroll
            for (int n = 0; n < 8; ++n) {
                const bf16x8 b = *(const bf16x8*)(KEYB + (size_t)(g * 128 + n * 16 + fr) * 256 + ks * 32 + fq * 8);
                acc[n] = __builtin_amdgcn_mfma_f32_16x16x32_bf16(a, b, acc[n], 0, 0, 0);
            }
        }
#pragma unroll
        for (int n = 0; n < 8; ++n) { u32x2 o; o.x = cvt_pk_bf16(acc[n][0], acc[n][1]); o.y = cvt_pk_bf16(acc[n][2], acc[n][3]);
            *(u32x2*)(WPT + (size_t)(g * 128 + n * 16 + fr) * 2048 + kb * 16 + fq * 4) = o; }
    }
}

__device__ __forceinline__ void phase0(const Params& p, unsigned char* shm) {
    bf16_t* WB1 = (bf16_t*)(p.ws + WS_WB1);
    rmsnorm_rows(p.in[0], p.in[1], (bf16_t*)(p.ws + WS_H));
    transpose_convert(p.in[2], 2048, 6144, WB1, (float*)shm, blockIdx.x, gridDim.x);
    const float* mu = p.in[4]; const float* w1 = p.in[6]; const float* a1 = p.in[9]; const float* g1 = p.in[11];
    for (int idx = blockIdx.x * 512 + threadIdx.x; idx < 768 * 2048; idx += gridDim.x * 512) {
        const int j = idx >> 11, k = idx & 2047; float val = 0.f;
        if (j < 128) { const float m = mu[k], w = w1[k * 64 + (j & 63)]; val = (j < 64) ? w * (1.f - m) : w * m; }
        else if (j < 256) { const float m = mu[2048 + k], w = a1[k * 64 + (j & 63)]; val = (j < 192) ? w * (1.f - m) : w * m; }
        else if (j < 576) { const float m = mu[4096 + k]; const int jj = j - 256; const int c = jj < 160 ? jj : jj - 160; const float w = g1[k * 160 + c]; val = jj < 160 ? w * (1.f - m) : w * m; }
        WB1[(size_t)(6144 + j) * 2048 + k] = f2bf(val);
    }
    convert_flat(p.in[22], (bf16_t*)(p.ws + WS_KEYB), (size_t)8 * 2 * 128 * 256);
    bf16_t* W2T = (bf16_t*)(p.ws + WS_W2T); bf16_t* A2T = (bf16_t*)(p.ws + WS_A2T); bf16_t* G2T = (bf16_t*)(p.ws + WS_G2T);
    const float* w2 = p.in[7]; const float* a2 = p.in[10]; const float* g2 = p.in[12];
    for (int idx = blockIdx.x * 512 + threadIdx.x; idx < 1024 * 288; idx += gridDim.x * 512) {
        if (idx < 65536) { const int c = idx >> 6, j = idx & 63; W2T[idx] = f2bf(w2[j * 1024 + c]); }
        else if (idx < 131072) { const int i2 = idx - 65536; const int c = i2 >> 6, j = i2 & 63; A2T[i2] = f2bf(a2[j * 1024 + c]); }
        else { const int i2 = idx - 131072; const int c = i2 / 160, j = i2 % 160; G2T[i2] = f2bf(g2[j * 1024 + c]); }
    }
}

constexpr int ACT_LD = 296;
template <int KS, int KOFF, int KTOT, int KIND>
__device__ __forceinline__ void lora_stage(const LAS bf16_t* act, const bf16_t* WT, const float* bias, bf16_t* OUT, int t0, int w, int fr, int fq) {
#pragma unroll 1
    for (int nh = 0; nh < 2; ++nh) {
        f32x4 acc[4][4];
#pragma unroll
        for (int m = 0; m < 4; ++m)
#pragma unroll
            for (int n = 0; n < 4; ++n) acc[m][n] = (f32x4){0.f, 0.f, 0.f, 0.f};
        bf16x8 bfr[KS][4];
#pragma unroll
        for (int ks = 0; ks < KS; ++ks)
#pragma unroll
            for (int n = 0; n < 4; ++n) bfr[ks][n] = *(const bf16x8*)(WT + (size_t)(w * 128 + (nh * 4 + n) * 16 + fr) * KTOT + ks * 32 + fq * 8);
#pragma unroll
        for (int ks = 0; ks < KS; ++ks) {
            bf16x8 a[4];
#pragma unroll
            for (int m = 0; m < 4; ++m) a[m] = *(const LAS bf16x8*)(act + (m * 16 + fr) * ACT_LD + KOFF + ks * 32 + fq * 8);
#pragma unroll
            for (int n = 0; n < 4; ++n)
#pragma unroll
                for (int m = 0; m < 4; ++m) acc[m][n] = __builtin_amdgcn_mfma_f32_16x16x32_bf16(bfr[ks][n], a[m], acc[m][n], 0, 0, 0);
        }
#pragma unroll
        for (int n = 0; n < 4; ++n) {
            const int c = w * 128 + (nh * 4 + n) * 16 + fq * 4;
            float bs[4] = {0.f, 0.f, 0.f, 0.f};
            if (KIND < 2) { const float4 bv = *(const float4*)(bias + c); bs[0] = bv.x; bs[1] = bv.y; bs[2] = bv.z; bs[3] = bv.w; }
#pragma unroll
            for (int m = 0; m < 4; ++m) {
                float o[4];
#pragma unroll
                for (int j = 0; j < 4; ++j) {
                    const float val = acc[m][n][j];
                    if (KIND == 0) { const float x = -(bs[j] + val); const float sp = fmaxf(x, 0.f) + __logf(1.f + __expf(-fabsf(x))); o[j] = -__expf(-sp - 0.5f); }
                    else if (KIND == 1) o[j] = sigmoidf_(bs[j] + val);
                    else o[j] = val;
                }
                u32x2 wv; wv.x = cvt_pk_bf16(o[0], o[1]); wv.y = cvt_pk_bf16(o[2], o[3]);
                *(u32x2*)(OUT + (size_t)(t0 + m * 16 + fr) * DR + c) = wv;
            }
        }
    }
}
__device__ __forceinline__ void phase_prepM(const Params& p, LAS unsigned char* lds) {
    LAS bf16_t* act = (LAS bf16_t*)lds;
    const bf16_t* P = (const bf16_t*)(p.ws + WS_PROJ);
    const int tid = threadIdx.x, w = tid >> 6, lane = tid & 63, fr = lane & 15, fq = lane >> 4;
    for (int tile = blockIdx.x; tile < S_ / 64; tile += gridDim.x) {
        const int t0 = tile * 64;
        __syncthreads();
        for (int task = tid; task < 64 * 36; task += 512) {
            const int t = task / 36, j0 = (task % 36) * 8; const int tg = t0 + t;
            int ccur, cprev;
            if (j0 < 64) { ccur = 6144 + j0; cprev = 6208 + j0; }
            else if (j0 < 128) { ccur = 6272 + (j0 - 64); cprev = 6336 + (j0 - 64); }
            else { ccur = 6400 + (j0 - 128); cprev = 6560 + (j0 - 128); }
            float cu[8], pv[8], o8[8];
            unpack8(*(const u32x4*)(P + (size_t)tg * NAUG + ccur), cu);
            if (tg > 0) unpack8(*(const u32x4*)(P + (size_t)(tg - 1) * NAUG + cprev), pv);
            else {
#pragma unroll
                for (int i = 0; i < 8; ++i) pv[i] = 0.f;
            }
#pragma unroll
            for (int i = 0; i < 8; ++i) { const float sv = cu[i] + pv[i];
                o8[i] = j0 < 64 ? (1.f - 2.f / (1.f + __expf(2.f * sv))) : (j0 < 128 ? sv : sigmoidf_(sv)); }
            *(LAS u32x4*)(act + t * ACT_LD + j0) = pack8(o8);
        }
        __syncthreads();
        lora_stage<2, 0, 64, 0>(act, (const bf16_t*)(p.ws + WS_W2T), p.in[5], (bf16_t*)(p.ws + WS_LW), t0, w, fr, fq);
        lora_stage<2, 64, 64, 1>(act, (const bf16_t*)(p.ws + WS_A2T), p.in[8], (bf16_t*)(p.ws + WS_A), t0, w, fr, fq);
        lora_stage<5, 128, 160, 2>(act, (const bf16_t*)(p.ws + WS_G2T), nullptr, (bf16_t*)(p.ws + WS_G), t0, w, fr, fq);
    }
}

__device__ __forceinline__ void phase_prepE(const Params& p) {
    const bf16_t* P = (const bf16_t*)(p.ws + WS_PROJ);
    bf16_t* R = (bf16_t*)(p.ws + WS_R); bf16_t* Kk = (bf16_t*)(p.ws + WS_K); bf16_t* V = (bf16_t*)(p.ws + WS_V); bf16_t* KK = (bf16_t*)(p.ws + WS_KK); bf16_t* YC = (bf16_t*)(p.ws + WS_YC);
    const float* mu_rkv = p.in[3]; const float* k_k = p.in[13]; const float* cw = p.in[18];
    const int tid = threadIdx.x, cg = tid & 127, c0 = cg * 8, tgrp = tid >> 7;
    float mr[8], mk[8], mv[8], kkc[8], cw0[8], cw1[8], cw2[8];
#pragma unroll
    for (int i = 0; i < 8; ++i) { mr[i] = mu_rkv[c0 + i]; mk[i] = mu_rkv[1024 + c0 + i]; mv[i] = mu_rkv[2048 + c0 + i]; kkc[i] = k_k[c0 + i]; cw0[i] = cw[c0 + i]; cw1[i] = cw[1024 + c0 + i]; cw2[i] = cw[2048 + c0 + i]; }
    for (int run = blockIdx.x * 4 + tgrp; run < S_ / 16; run += gridDim.x * 4) {
        const int t0 = run * 16;
        float pr[8], pk[8], pv[8], u1[8], u2[8];
#pragma unroll
        for (int i = 0; i < 8; ++i) { pr[i] = 0.f; pk[i] = 0.f; pv[i] = 0.f; u1[i] = 0.f; u2[i] = 0.f; }
        if (t0 > 0) {
            const size_t o = (size_t)(t0 - 1) * NAUG + c0;
            unpack8(*(const u32x4*)(P + o), pr); unpack8(*(const u32x4*)(P + o + 1024), pk); unpack8(*(const u32x4*)(P + o + 2048), pv);
            float x[8], y[8];
            unpack8(*(const u32x4*)(P + o + 4096), x); unpack8(*(const u32x4*)(P + o + 5120), y);
#pragma unroll
            for (int i = 0; i < 8; ++i) u1[i] = x[i] * y[i];
            unpack8(*(const u32x4*)(P + o - NAUG + 4096), x); unpack8(*(const u32x4*)(P + o - NAUG + 5120), y);
#pragma unroll
            for (int i = 0; i < 8; ++i) u2[i] = x[i] * y[i];
        }
        u32x4 nx[6];
        { const size_t o = (size_t)t0 * NAUG + c0;
#pragma unroll
          for (int q = 0; q < 6; ++q) nx[q] = *(const u32x4*)(P + o + 1024 * q); }
#pragma unroll 1
        for (int t = 0; t < 16; ++t) {
            float cr[8], ck[8], cv[8], bg[8], cgt[8], xc[8];
            unpack8(nx[0], cr); unpack8(nx[1], ck); unpack8(nx[2], cv); unpack8(nx[3], bg); unpack8(nx[4], cgt); unpack8(nx[5], xc);
            { const size_t o = (size_t)(t0 + (t < 15 ? t + 1 : t)) * NAUG + c0;
#pragma unroll
              for (int q = 0; q < 6; ++q) nx[q] = *(const u32x4*)(P + o + 1024 * q); }
            float r[8], k[8], v[8], kkv[8], yc[8]; float ss = 0.f;
#pragma unroll
            for (int i = 0; i < 8; ++i) {
                r[i] = cr[i] + (pr[i] - cr[i]) * mr[i]; k[i] = ck[i] + (pk[i] - ck[i]) * mk[i]; v[i] = cv[i] + (pv[i] - cv[i]) * mv[i];
                pr[i] = cr[i]; pk[i] = ck[i]; pv[i] = cv[i];
                kkv[i] = k[i] * kkc[i]; ss += kkv[i] * kkv[i];
                const float u0 = cgt[i] * xc[i];
                yc[i] = bg[i] * (cw0[i] * u2[i] + cw1[i] * u1[i] + cw2[i] * u0);
                u2[i] = u1[i]; u1[i] = u0;
            }
            ss += dpp_f<0xB1, 0xf>(ss); ss += dpp_f<0x4E, 0xf>(ss); ss += dpp_f<0x141, 0xf>(ss);
            const float inv = 1.0f / fmaxf(sqrtf(ss), 1e-12f);
#pragma unroll
            for (int i = 0; i < 8; ++i) kkv[i] *= inv;
            const size_t oo = (size_t)(t0 + t) * DR + c0;
            *(u32x4*)(R + oo) = pack8(r); *(u32x4*)(Kk + oo) = pack8(k); *(u32x4*)(V + oo) = pack8(v); *(u32x4*)(KK + oo) = pack8(kkv); *(u32x4*)(YC + oo) = pack8(yc);
        }
    }
}

#define TILE(i) ((LAS bf16_t*)(lds + (i) * TSLOT))
__device__ __forceinline__ f32x4 mm_tile(f32x4 acc, const LAS bf16_t* A, const LAS bf16_t* Bt, int mi, int ni, int fr, int fq) {
#pragma unroll
    for (int ks = 0; ks < 2; ++ks) {
        const bf16x8 a = *(const LAS bf16x8*)(A + (mi * 16 + fr) * TLD + ks * 32 + fq * 8);
        const bf16x8 b = *(const LAS bf16x8*)(Bt + (ni * 16 + fr) * TLD + ks * 32 + fq * 8);
        acc = __builtin_amdgcn_mfma_f32_16x16x32_bf16(a, b, acc, 0, 0, 0);
    }
    return acc;
}
__device__ __forceinline__ void st_rm(LAS bf16_t* X, f32x4 v, int mi, int ni, int fr, int fq) {
    const unsigned w0 = cvt_pk_bf16(v[0], v[1]), w1 = cvt_pk_bf16(v[2], v[3]);
    LAS bf16_t* q = X + (mi * 16 + fq * 4) * TLD + ni * 16 + fr;
    q[0] = (bf16_t)(w0 & 0xffffu); q[TLD] = (bf16_t)(w0 >> 16); q[2 * TLD] = (bf16_t)(w1 & 0xffffu); q[3 * TLD] = (bf16_t)(w1 >> 16);
}
__device__ __forceinline__ void st_tr(LAS bf16_t* XT, f32x4 v, int mi, int ni, int fr, int fq) {
    u32x2 w; w.x = cvt_pk_bf16(v[0], v[1]); w.y = cvt_pk_bf16(v[2], v[3]);
    *(LAS u32x2*)(XT + (ni * 16 + fr) * TLD + mi * 16 + fq * 4) = w;
}
__device__ __forceinline__ f32x4 ld_rm(const LAS bf16_t* X, int mi, int ni, int fr, int fq) {
    const LAS bf16_t* q = X + (mi * 16 + fq * 4) * TLD + ni * 16 + fr;
    return (f32x4){bf2f(q[0]), bf2f(q[TLD]), bf2f(q[2 * TLD]), bf2f(q[3 * TLD])};
}
__device__ __forceinline__ f32x4 ld_tr(const LAS bf16_t* XT, int mi, int ni, int fr, int fq) {
    const u32x2 w = *(const LAS u32x2*)(XT + (ni * 16 + fr) * TLD + mi * 16 + fq * 4);
    return (f32x4){lo_bf(w.x), hi_bf(w.x), lo_bf(w.y), hi_bf(w.y)};
}

__device__ __forceinline__ void phase_chunkA(const Params& p, LAS unsigned char* lds) {
    const int tid = threadIdx.x, w = tid >> 6, lane = tid & 63, fr = lane & 15, fq = lane >> 4;
    const int mi = w >> 1, nb = (w & 1) * 2;
    LAS float* cl = (LAS float*)(lds + 14 * TSLOT);
    LAS float* gs = (LAS float*)(lds + 16 * TSLOT);
    LAS float* wc = gs + 512;
    const bf16_t* R = (const bf16_t*)(p.ws + WS_R); const bf16_t* Kk = (const bf16_t*)(p.ws + WS_K); const bf16_t* V = (const bf16_t*)(p.ws + WS_V);
    const bf16_t* KK = (const bf16_t*)(p.ws + WS_KK); const bf16_t* A = (const bf16_t*)(p.ws + WS_A); const bf16_t* LW = (const bf16_t*)(p.ws + WS_LW);
    bf16_t* GT = (bf16_t*)(p.ws + WS_GT); float* HT = (float*)(p.ws + WS_HT); bf16_t* QE = (bf16_t*)(p.ws + WS_QE); bf16_t* YL = (bf16_t*)(p.ws + WS_YL);
    const f32x4 z4 = (f32x4){0.f, 0.f, 0.f, 0.f};
    const float* k_a = p.in[14]; const float* r_k = p.in[15]; float* BON = (float*)(p.ws + WS_BON);
    u32x4 nr4, nk4, nv4, nkk4, na4, nlw4;
#define CA_LOAD(it) do { const size_t _go = (size_t)(((it) >> 4) * 64 + (tid >> 3)) * DR + ((it) & 15) * 64 + (tid & 7) * 8; \
        nr4 = *(const u32x4*)(R + _go); nk4 = *(const u32x4*)(Kk + _go); nv4 = *(const u32x4*)(V + _go); nkk4 = *(const u32x4*)(KK + _go); na4 = *(const u32x4*)(A + _go); nlw4 = *(const u32x4*)(LW + _go); } while (0)
    for (int item = blockIdx.x; item < 4096; item += gridDim.x) {
        const int c = item >> 4, h = item & 15;
        const int t = tid >> 3, k0 = (tid & 7) * 8;
        if (item == (int)blockIdx.x) CA_LOAD(item);
        const u32x4 r4 = nr4, k4 = nk4, v4 = nv4, kk4 = nkk4, a4 = na4, lw4 = nlw4;
        __syncthreads();
        {
            float lwf8[8]; unpack8(lw4, lwf8);
            *(LAS f32x4*)(cl + t * 64 + k0) = (f32x4){lwf8[0], lwf8[1], lwf8[2], lwf8[3]};
            *(LAS f32x4*)(cl + t * 64 + k0 + 4) = (f32x4){lwf8[4], lwf8[5], lwf8[6], lwf8[7]};
            __syncthreads();
            const int g = w, k = lane;
            float pfx[8]; float run = 0.f;
#pragma unroll
            for (int i = 0; i < 8; ++i) { run += cl[(g * 8 + i) * 64 + k]; pfx[i] = run; }
            gs[g * 64 + k] = run;
            __syncthreads();
            float off = 0.f;
#pragma unroll
            for (int gg = 0; gg < 7; ++gg) { const float x = gs[gg * 64 + k]; off += (gg < g) ? x : 0.f; }
#pragma unroll
            for (int i = 0; i < 8; ++i) cl[(g * 8 + i) * 64 + k] = off + pfx[i];
            if (g == 7) wc[k] = __expf(off + pfx[7]);
            __syncthreads();
        }
        if (item + (int)gridDim.x < 4096) CA_LOAD(item + (int)gridDim.x);
        {
            float at[8], rt[8], bt[8], kt[8], bh[8], kh[8], vv[8]; float bsum = 0.f;
#pragma unroll
            for (int i = 0; i < 8; ++i) {
                const int q = i >> 1; const bool hi = i & 1;
                const float rf = hi ? hi_bf(r4[q]) : lo_bf(r4[q]), kraw = hi ? hi_bf(k4[q]) : lo_bf(k4[q]), vf = hi ? hi_bf(v4[q]) : lo_bf(v4[q]);
                const float kkf = hi ? hi_bf(kk4[q]) : lo_bf(kk4[q]), af = hi ? hi_bf(a4[q]) : lo_bf(a4[q]), lwf = hi ? hi_bf(lw4[q]) : lo_bf(lw4[q]);
                const float kf = kraw * (1.f + (af - 1.f) * k_a[h * 64 + k0 + i]);
                bsum += rf * kf * r_k[h * 64 + k0 + i];
                const float clv = cl[t * 64 + k0 + i], cle = cl[63 * 64 + k0 + i];
                const float e = __expf(clv), ex = __expf(clv - lwf), ei = __expf(-clv), eh = __expf(cle - clv);
                const float bb = kkf * af;
                at[i] = -kkf * ex; rt[i] = rf * e; bt[i] = bb * ei; kt[i] = kf * ei; bh[i] = bb * eh; kh[i] = kf * eh; vv[i] = vf;
            }
            bsum += dpp_f<0xB1, 0xf>(bsum); bsum += dpp_f<0x4E, 0xf>(bsum); bsum += dpp_f<0x141, 0xf>(bsum);
            if ((tid & 7) == 0) BON[(size_t)(c * 64 + t) * 16 + h] = bsum;
            *(LAS u32x4*)(TILE(0) + t * TLD + k0) = pack8(at);
            *(LAS u32x4*)(TILE(2) + t * TLD + k0) = pack8(rt);
            *(LAS u32x4*)(TILE(3) + t * TLD + k0) = pack8(bt);
            *(LAS u32x4*)(TILE(4) + t * TLD + k0) = pack8(kt);
            const u32x4 atp = pack8(at), bhp = pack8(bh), khp = pack8(kh);
#pragma unroll
            for (int i = 0; i < 8; ++i) {
                const int q = i >> 1; const bool hi = i & 1;
                TILE(1)[(k0 + i) * TLD + t] = (bf16_t)(hi ? (atp[q] >> 16) : (atp[q] & 0xffffu));
                TILE(5)[(k0 + i) * TLD + t] = (bf16_t)(hi ? (bhp[q] >> 16) : (bhp[q] & 0xffffu));
                TILE(6)[(k0 + i) * TLD + t] = (bf16_t)(hi ? (khp[q] >> 16) : (khp[q] & 0xffffu));
                TILE(7)[(k0 + i) * TLD + t] = (bf16_t)(hi ? (v4[q] >> 16) : (v4[q] & 0xffffu));
            }
            __syncthreads();
        }
#pragma unroll
        for (int nn = 0; nn < 2; ++nn) {
            const int ni = nb + nn; const int col = ni * 16 + fr, row0 = mi * 16 + fq * 4;
            f32x4 x = mm_tile(z4, TILE(0), TILE(3), mi, ni, fr, fq);
#pragma unroll
            for (int j = 0; j < 4; ++j) x[j] = (col < row0 + j) ? x[j] : 0.f;
            st_rm(TILE(8), x, mi, ni, fr, fq); st_tr(TILE(9), x, mi, ni, fr, fq);
            x = mm_tile(z4, TILE(0), TILE(4), mi, ni, fr, fq);
#pragma unroll
            for (int j = 0; j < 4; ++j) x[j] = (col < row0 + j) ? x[j] : 0.f;
            st_rm(TILE(10), x, mi, ni, fr, fq);
            x = mm_tile(z4, TILE(2), TILE(3), mi, ni, fr, fq);
#pragma unroll
            for (int j = 0; j < 4; ++j) x[j] = (col <= row0 + j) ? x[j] : 0.f;
            st_rm(TILE(11), x, mi, ni, fr, fq);
            x = mm_tile(z4, TILE(2), TILE(4), mi, ni, fr, fq);
#pragma unroll
            for (int j = 0; j < 4; ++j) x[j] = (col <= row0 + j) ? x[j] : 0.f;
            st_rm(TILE(12), x, mi, ni, fr, fq);
        }
        __syncthreads();
#pragma unroll
        for (int nn = 0; nn < 2; ++nn) {
            const int ni = nb + nn;
            st_tr(TILE(13), mm_tile(z4, TILE(10), TILE(7), mi, ni, fr, fq), mi, ni, fr, fq);
            const f32x4 x = mm_tile(z4, TILE(8), TILE(9), mi, ni, fr, fq);
            st_rm(TILE(0), x, mi, ni, fr, fq); st_tr(TILE(3), x, mi, ni, fr, fq);
        }
        __syncthreads();
#pragma unroll
        for (int rd = 0; rd < 5; ++rd) {
            const int tq = (rd & 1) ? 14 : 8, tqo = (rd & 1) ? 8 : 14;
            const int lx = (rd & 1) ? 4 : 0, lxt = (rd & 1) ? 9 : 3, lxo = (rd & 1) ? 0 : 4, lxto = (rd & 1) ? 3 : 9;
#pragma unroll
            for (int nn = 0; nn < 2; ++nn) {
                const int ni = nb + nn;
                f32x4 x = ld_rm(TILE(tq), mi, ni, fr, fq) + ld_rm(TILE(lx), mi, ni, fr, fq);
                x = mm_tile(x, TILE(tq), TILE(lxt), mi, ni, fr, fq);
                st_rm(TILE(tqo), x, mi, ni, fr, fq);
                if (rd < 4) { const f32x4 y = mm_tile(z4, TILE(lx), TILE(lxt), mi, ni, fr, fq); st_rm(TILE(lxo), y, mi, ni, fr, fq); st_tr(TILE(lxto), y, mi, ni, fr, fq); }
            }
            __syncthreads();
        }
#pragma unroll
        for (int nn = 0; nn < 2; ++nn) {
            const int ni = nb + nn;
            st_tr(TILE(10), mm_tile(ld_tr(TILE(1), mi, ni, fr, fq), TILE(14), TILE(1), mi, ni, fr, fq), mi, ni, fr, fq);
            st_tr(TILE(15), mm_tile(ld_tr(TILE(13), mi, ni, fr, fq), TILE(14), TILE(13), mi, ni, fr, fq), mi, ni, fr, fq);
        }
        __syncthreads();
#pragma unroll
        for (int nn = 0; nn < 2; ++nn) {
            const int ni = nb + nn;
            {
                f32x4 x = mm_tile(z4, TILE(5), TILE(10), mi, ni, fr, fq);
                if (mi == ni) {
#pragma unroll
                    for (int j = 0; j < 4; ++j) x[j] += (fq * 4 + j == fr) ? wc[ni * 16 + fr] : 0.f;
                }
                const unsigned w0 = cvt_pk_bf16(x[0], x[1]), w1 = cvt_pk_bf16(x[2], x[3]);
                bf16_t* gp = GT + (size_t)item * 4096 + (size_t)((mi * 2 + (ni >> 1)) * 64 + (fr >> 2) * 16 + fq * 4) * 8 + (ni & 1) * 4 + (fr & 3);
                gp[0] = (bf16_t)(w0 & 0xffffu); gp[8] = (bf16_t)(w0 >> 16); gp[16] = (bf16_t)(w1 & 0xffffu); gp[24] = (bf16_t)(w1 >> 16);
            }
            {
                f32x4 x = mm_tile(z4, TILE(5), TILE(15), mi, ni, fr, fq);
                x = mm_tile(x, TILE(6), TILE(7), mi, ni, fr, fq);
                *(f32x4*)(HT + (size_t)item * 4096 + (size_t)((ni * 4 + mi) * 64 + lane) * 4) = x;
            }
            {
                f32x4 x = ld_tr(TILE(2), mi, ni, fr, fq);
                x = mm_tile(x, TILE(10), TILE(11), mi, ni, fr, fq);
                u32x2 wv; wv.x = cvt_pk_bf16(x[0], x[1]); wv.y = cvt_pk_bf16(x[2], x[3]);
                *(u32x2*)(QE + (size_t)item * 4096 + (ni * 16 + fr) * 64 + mi * 16 + fq * 4) = wv;
            }
            {
                f32x4 x = mm_tile(z4, TILE(11), TILE(15), mi, ni, fr, fq);
                x = mm_tile(x, TILE(12), TILE(7), mi, ni, fr, fq);
                u32x2 wv; wv.x = cvt_pk_bf16(x[0], x[1]); wv.y = cvt_pk_bf16(x[2], x[3]);
                *(u32x2*)(YL + (size_t)item * 4096 + (size_t)((mi * 4 + ni) * 64 + lane) * 4) = wv;
            }
        }
    }
}

__device__ __forceinline__ void phase_seq(const Params& p) {
    if (threadIdx.x >= 64) return;
    const int head = blockIdx.x >> 2, vt = blockIdx.x & 3, lane = threadIdx.x, fr = lane & 15, fq = lane >> 4;
    const bf16_t* GT = (const bf16_t*)(p.ws + WS_GT); const float* HT = (const float*)(p.ws + WS_HT); bf16_t* S0 = (bf16_t*)(p.ws + WS_S0);
    f32x4 acc[4];
#pragma unroll
    for (int mb = 0; mb < 4; ++mb) acc[mb] = (f32x4){0.f, 0.f, 0.f, 0.f};
    bf16x8 ga[4][4][2]; f32x4 hh[4][4];
#define SEQ_LOAD(buf, cc) do { const size_t _it = (size_t)((cc) < 256 ? (cc) : 255) * 16 + head; \
        _Pragma("unroll") for (int mb = 0; mb < 4; ++mb) { \
            _Pragma("unroll") for (int ks = 0; ks < 2; ++ks) ga[buf][mb][ks] = *(const bf16x8*)(GT + _it * 4096 + (size_t)((mb * 2 + ks) * 64 + lane) * 8); \
            hh[buf][mb] = *(const f32x4*)(HT + _it * 4096 + (size_t)((vt * 4 + mb) * 64 + lane) * 4); } } while (0)
    SEQ_LOAD(0, 0); SEQ_LOAD(1, 1); SEQ_LOAD(2, 2); SEQ_LOAD(3, 3);
    for (int c0 = 0; c0 < 256; c0 += 4) {
#pragma unroll
        for (int b = 0; b < 4; ++b) {
            const int c = c0 + b; const size_t item = (size_t)c * 16 + head;
            u32x2 pk[4];
#pragma unroll
            for (int mb = 0; mb < 4; ++mb) { pk[mb].x = cvt_pk_bf16(acc[mb][0], acc[mb][1]); pk[mb].y = cvt_pk_bf16(acc[mb][2], acc[mb][3]);
                *(u32x2*)(S0 + item * 4096 + (vt * 16 + fr) * 64 + mb * 16 + fq * 4) = pk[mb]; }
            u32x4 b0w, b1w; b0w.x = pk[0].x; b0w.y = pk[0].y; b0w.z = pk[1].x; b0w.w = pk[1].y; b1w.x = pk[2].x; b1w.y = pk[2].y; b1w.z = pk[3].x; b1w.w = pk[3].y;
            const bf16x8 b0 = __builtin_bit_cast(bf16x8, b0w), b1 = __builtin_bit_cast(bf16x8, b1w);
#pragma unroll
            for (int mb = 0; mb < 4; ++mb) {
                const f32x4 x = __builtin_amdgcn_mfma_f32_16x16x32_bf16(ga[b][mb][0], b0, hh[b][mb], 0, 0, 0);
                acc[mb] = __builtin_amdgcn_mfma_f32_16x16x32_bf16(ga[b][mb][1], b1, x, 0, 0, 0);
            }
            SEQ_LOAD(b, c + 4);
        }
    }
#undef SEQ_LOAD
}

__device__ __forceinline__ void phase_chunkY(const Params& p, LAS unsigned char* lds) {
    LAS float* Yb = (LAS float*)lds;
    const int tid = threadIdx.x, w = tid >> 6, lane = tid & 63, fr = lane & 15, fq = lane >> 4;
    const int mi = w >> 1, nb = (w & 1) * 2;
    const bf16_t* R = (const bf16_t*)(p.ws + WS_R); const bf16_t* Kk = (const bf16_t*)(p.ws + WS_K); const bf16_t* V = (const bf16_t*)(p.ws + WS_V);
    const bf16_t* G = (const bf16_t*)(p.ws + WS_G); const bf16_t* YC = (const bf16_t*)(p.ws + WS_YC);
    const bf16_t* QE = (const bf16_t*)(p.ws + WS_QE); const bf16_t* YL = (const bf16_t*)(p.ws + WS_YL); const bf16_t* S0 = (const bf16_t*)(p.ws + WS_S0);
    bf16_t* YM = (bf16_t*)(p.ws + WS_YMIX);
    const float* gn_w = p.in[16]; const float* gn_b = p.in[17];
    u32x2 ywn[2]; bf16x8 an[2], bn[2][2]; bool first = true;
    u32x4 nv4, ng4, nyc4; float nbon; const float* BONp = (const float*)(p.ws + WS_BON);
#define CY_LOAD(it) do { const bf16_t* _q = QE + (size_t)(it) * 4096; const bf16_t* _s = S0 + (size_t)(it) * 4096; const bf16_t* _y = YL + (size_t)(it) * 4096; \
        _Pragma("unroll") for (int ks = 0; ks < 2; ++ks) an[ks] = *(const bf16x8*)(_q + (mi * 16 + fr) * 64 + ks * 32 + fq * 8); \
        _Pragma("unroll") for (int nn = 0; nn < 2; ++nn) { ywn[nn] = *(const u32x2*)(_y + (size_t)((mi * 4 + nb + nn) * 64 + lane) * 4); \
            _Pragma("unroll") for (int ks = 0; ks < 2; ++ks) bn[nn][ks] = *(const bf16x8*)(_s + (nb + nn) * 16 * 64 + fr * 64 + ks * 32 + fq * 8); } \
        { const size_t _tg = (size_t)((it) >> 4) * 64 + (tid >> 3); const size_t _o = _tg * DR + ((it) & 15) * 64 + (tid & 7) * 8; \
          nv4 = *(const u32x4*)(V + _o); ng4 = *(const u32x4*)(G + _o); nyc4 = *(const u32x4*)(YC + _o); nbon = BONp[_tg * 16 + ((it) & 15)]; } } while (0)
    for (int item = blockIdx.x; item < 4096; item += gridDim.x) {
        const int c = item >> 4, h = item & 15;
        if (first) { first = false; CY_LOAD(item); }
        __syncthreads();
        const u32x2 ywc[2] = {ywn[0], ywn[1]}; const bf16x8 ac[2] = {an[0], an[1]}; const bf16x8 bc[2][2] = {{bn[0][0], bn[0][1]}, {bn[1][0], bn[1][1]}};
        const u32x4 v4 = nv4, g4 = ng4, yc4 = nyc4; const float bon = nbon;
        if (item + (int)gridDim.x < 4096) CY_LOAD(item + (int)gridDim.x);
#pragma unroll
        for (int nn = 0; nn < 2; ++nn) {
            const int ni = nb + nn;
            const u32x2 yw = ywc[nn];
            f32x4 acc = (f32x4){lo_bf(yw.x), hi_bf(yw.x), lo_bf(yw.y), hi_bf(yw.y)};
#pragma unroll
            for (int ks = 0; ks < 2; ++ks) acc = __builtin_amdgcn_mfma_f32_16x16x32_bf16(ac[ks], bc[nn][ks], acc, 0, 0, 0);
#pragma unroll
            for (int j = 0; j < 4; ++j) Yb[(mi * 16 + fq * 4 + j) * 68 + ni * 16 + fr] = acc[j];
        }
        __syncthreads();
        {
            const int t = tid >> 3, k0 = (tid & 7) * 8; const int ch = h * 64 + k0;
            const size_t tg = (size_t)c * 64 + t; const size_t o = tg * DR + ch;
            const float4 gw0 = *(const float4*)(gn_w + ch), gw1 = *(const float4*)(gn_w + ch + 4), gb0 = *(const float4*)(gn_b + ch), gb1 = *(const float4*)(gn_b + ch + 4);
            const float gwv[8] = {gw0.x, gw0.y, gw0.z, gw0.w, gw1.x, gw1.y, gw1.z, gw1.w}, gbv[8] = {gb0.x, gb0.y, gb0.z, gb0.w, gb1.x, gb1.y, gb1.z, gb1.w};
            const f32x4 y0 = *(const LAS f32x4*)(Yb + t * 68 + k0), y1 = *(const LAS f32x4*)(Yb + t * 68 + k0 + 4);
            const float y[8] = {y0[0], y0[1], y0[2], y0[3], y1[0], y1[1], y1[2], y1[3]};
            float sm = 0.f;
#pragma unroll
            for (int i = 0; i < 8; ++i) sm += y[i];
            sm += dpp_f<0xB1, 0xf>(sm); sm += dpp_f<0x4E, 0xf>(sm); sm += dpp_f<0x141, 0xf>(sm);
            const float mean = sm * (1.f / 64.f);
            float vs = 0.f;
#pragma unroll
            for (int i = 0; i < 8; ++i) { const float d = y[i] - mean; vs += d * d; }
            vs += dpp_f<0xB1, 0xf>(vs); vs += dpp_f<0x4E, 0xf>(vs); vs += dpp_f<0x141, 0xf>(vs);
            const float rs = rsqrtf(vs * (1.f / 64.f) + 64e-5f);
            float vf[8], gf[8], of[8];
            unpack8(v4, vf); unpack8(g4, gf);
#pragma unroll
            for (int i = 0; i < 8; ++i) of[i] = ((y[i] - mean) * rs * gwv[i] + gbv[i] + bon * vf[i]) * gf[i];
            *(u32x4*)(YM + tg * D_ + ch) = pack8(of);
            *(u32x4*)(YM + tg * D_ + 1024 + ch) = yc4;
        }
    }
#undef CY_LOAD
}

__device__ __forceinline__ int f2key(float x) { const int u = __float_as_int(x); return u ^ ((u >> 31) & 0x7fffffff); }
__device__ __forceinline__ float key2f(int k) { return __int_as_float(k ^ ((k >> 31) & 0x7fffffff)); }
template <int CTRL> __device__ __forceinline__ int dpp_i(int v) { return __builtin_amdgcn_update_dpp(v, v, CTRL, 0xf, 0xf, false); }
__device__ __forceinline__ int row_max_i(int v) { v = max(v, dpp_i<0xB1>(v)); v = max(v, dpp_i<0x4E>(v)); v = max(v, dpp_i<0x141>(v)); v = max(v, dpp_i<0x140>(v)); return v; }
__device__ __forceinline__ void phase_topk(const Params& p, unsigned char* shm) {
    float* sc = (float*)shm;
    int* tk = (int*)(sc + 64 * 260);
    int* ctab = tk + 2048;
    if (threadIdx.x < 64) { int n = threadIdx.x, v = 256;
        for (int i = 0; i < 16; ++i) { const int cnt = 16 / (i + 1); if (n < cnt) { v = i * 16 + n; break; } n -= cnt; }
        ctab[threadIdx.x] = v; }
    const float* SC = (const float*)(p.ws + WS_Q);
    int* IDS = (int*)(p.ws + WS_IDS); float* GATES = (float*)(p.ws + WS_GATES);
    const int tid = threadIdx.x, w = tid >> 6, lane = tid & 63;
    f32x4 qreg[8];
#define TK_QLOAD(it) do { const int _t0 = ((it) >> 3) * 64; _Pragma("unroll") for (int i = 0; i < 8; ++i) { const int ch = tid + 512 * i; \
        qreg[i] = *(const f32x4*)(SC + (size_t)(_t0 + (ch >> 6)) * 2048 + ((it) & 7) * 256 + (ch & 63) * 4); } } while (0)
    if ((int)blockIdx.x < 2048) TK_QLOAD((int)blockIdx.x);
    for (int item = blockIdx.x; item < 2048; item += gridDim.x) {
        const int t0 = (item >> 3) * 64, h = item & 7;
        __syncthreads();
#pragma unroll
        for (int i = 0; i < 8; ++i) { const int ch = tid + 512 * i; *(f32x4*)(sc + (ch >> 6) * 260 + (ch & 63) * 4) = qreg[i]; }
        __syncthreads();
        if (item + (int)gridDim.x < 2048) TK_QLOAD(item + (int)gridDim.x);
        for (int g = 0; g < 4; ++g) {
            const int L = w * 16 + g * 4 + (lane >> 4); const int tok = L >> 1, cc = L & 1; const int pp = lane & 15;
            int key[8];
#pragma unroll
            for (int i = 0; i < 8; ++i) key[i] = (f2key(sc[tok * 260 + cc * 128 + i * 16 + pp]) & ~127) | (127 - (i * 16 + pp));
#define CE(a, b) do { const int _hi = max(key[a], key[b]), _lo = min(key[a], key[b]); key[a] = _hi; key[b] = _lo; } while (0)
            CE(0, 1); CE(2, 3); CE(4, 5); CE(6, 7);  CE(0, 2); CE(1, 3); CE(4, 6); CE(5, 7);  CE(1, 2); CE(5, 6);
            CE(0, 4); CE(1, 5); CE(2, 6); CE(3, 7);  CE(2, 4); CE(3, 5);  CE(1, 2); CE(3, 4); CE(5, 6);
#undef CE
            int mykey = 0;
#pragma unroll
            for (int r = 0; r < 16; ++r) {
                const int m = row_max_i(key[0]);
                const bool win = (key[0] == m);
#pragma unroll
                for (int i = 0; i < 7; ++i) key[i] = win ? key[i + 1] : key[i];
                key[7] = win ? (int)0x80000000 : key[7];
                mykey = (pp == r) ? m : mykey;
            }
            tk[L * 16 + pp] = mykey;
        }
        __syncthreads();
        for (int g = 0; g < 2; ++g) {
            const int tok = w * 8 + g * 4 + (lane >> 4); const int pp = lane & 15;
            int key[4];
#pragma unroll
            for (int q = 0; q < 4; ++q) {
                const int ij = ctab[q * 16 + pp];
                const float s1 = key2f(tk[(tok * 2) * 16 + ((ij >> 4) & 15)] & ~127), s2 = key2f(tk[(tok * 2 + 1) * 16 + (ij & 15)] & ~127);
                key[q] = (ij < 256) ? ((f2key(s1 + s2) & ~255) | (255 - ij)) : (int)0x80000000;
            }
            int mykey = 0;
#pragma unroll
            for (int r = 0; r < 16; ++r) {
                const int ml = max(max(key[0], key[1]), max(key[2], key[3]));
                const int m = row_max_i(ml);
#pragma unroll
                for (int q = 0; q < 4; ++q) key[q] = (key[q] == m) ? (int)0x80000000 : key[q];
                mykey = (pp == r) ? m : mykey;
            }
            const int ci = 255 - (mykey & 255); const float cs = key2f(mykey & ~255);
            const int e1 = 127 - (tk[(tok * 2) * 16 + (ci >> 4)] & 127), e2 = 127 - (tk[(tok * 2 + 1) * 16 + (ci & 15)] & 127);
            const float mx = __shfl(cs, lane & 48);
            const float e = __expf(cs - mx);
            float sum = e; sum += dpp_f<0xB1, 0xf>(sum); sum += dpp_f<0x4E, 0xf>(sum); sum += dpp_f<0x141, 0xf>(sum); sum += dpp_f<0x140, 0xf>(sum);
            IDS[(size_t)(t0 + tok) * 128 + h * 16 + pp] = (e1 * 128 + e2) & 16383;
            GATES[(size_t)(t0 + tok) * 128 + h * 16 + pp] = e / sum;
        }
    }
#undef TK_QLOAD
}

__device__ __forceinline__ float gelu_fast(float x) { const float u = 0.7978845608028654f * (x + 0.044715f * x * x * x); return x / (1.0f + __expf(-2.0f * u)); }
__device__ __forceinline__ void phase_gather(const Params& p, unsigned char* shm) {
    const float* X1 = (const float*)(p.ws + WS_X1); const float* SSQ = (const float*)(p.ws + WS_SSQ);
    const unsigned char* U6 = p.ws + WS_UB; const unsigned char* V6 = p.ws + WS_VB;
    const int* IDS = (const int*)(p.ws + WS_IDS); const float* GATES = (const float*)(p.ws + WS_GATES);
    const float* nf = p.in[25];
    const int tid = threadIdx.x, w = tid >> 6, lane = tid & 63;
    int nid0 = 0, nid1 = 0; float ngt0 = 0.f, ngt1 = 0.f, nssq = 0.f;
#define GT_META(tt) do { nid0 = IDS[(size_t)(tt) * 128 + lane]; nid1 = IDS[(size_t)(tt) * 128 + 64 + lane]; ngt0 = GATES[(size_t)(tt) * 128 + lane]; ngt1 = GATES[(size_t)(tt) * 128 + 64 + lane]; \
        nssq = (lane < 32) ? SSQ[(size_t)(tt) * 32 + lane] : 0.f; } while (0)
    if ((int)(blockIdx.x * 8 + w) < S_) GT_META(blockIdx.x * 8 + w);
    for (int t = blockIdx.x * 8 + w; t < S_; t += gridDim.x * 8) {
        const int id0 = nid0, id1 = nid1; const float gt0 = ngt0, gt1 = ngt1, ssqv = nssq;
        if (t + (int)gridDim.x * 8 < S_) GT_META(t + (int)gridDim.x * 8);
        f32x2 op[16];
#pragma unroll
        for (int j = 0; j < 8; ++j) { const float4 x = *(const float4*)(X1 + (size_t)t * D_ + (j * 64 + lane) * 4);
            op[2 * j] = (f32x2){x.x, x.y}; op[2 * j + 1] = (f32x2){x.z, x.w}; }
        f32x2 hp[16];
#pragma unroll
        for (int i = 0; i < 16; ++i) hp[i] = op[i];
        const float rs = rsqrtf(wave_sum_dpp(ssqv) * (1.0f / 2048.0f) + 1e-6f);
        u32x4 uaA[4], ubA[4], vbA[4]; u32x2 uaB[4], ubB[4], vbB[4];
#define G_LOADU(dA, dB, grp) do { _Pragma("unroll") for (int j = 0; j < 4; ++j) { const int e = (grp) * 4 + j; const int id = __builtin_amdgcn_readlane(e < 64 ? id0 : id1, e & 63); \
            const unsigned char* ur = U6 + (size_t)id * ROW6; dA[j] = *(const u32x4*)(ur + lane * 16); dB[j] = *(const u32x2*)(ur + 1024 + lane * 8); } } while (0)
#define G_LOADV(grp) do { _Pragma("unroll") for (int j = 0; j < 4; ++j) { const int e = (grp) * 4 + j; const int id = __builtin_amdgcn_readlane(e < 64 ? id0 : id1, e & 63); \
            const unsigned char* vr = V6 + (size_t)id * ROW6; vbA[j] = *(const u32x4*)(vr + lane * 16); vbB[j] = *(const u32x2*)(vr + 1024 + lane * 8); } } while (0)
#define G_DEC(A, B) __builtin_amdgcn_cvt_scalef32_pk32_f32_fp6((u32x6){A[0], A[1], A[2], A[3], B[0], B[1]}, 1.0f)
#define G_BODY(cA, cB, nA, nB, grp) do { \
            G_LOADV(grp); \
            G_LOADU(nA, nB, ((grp) + 1 < 32 ? (grp) + 1 : 31)); \
            float dsel = 0.f; \
            _Pragma("unroll") for (int j = 0; j < 4; ++j) { const f32x32 dd = G_DEC(cA[j], cB[j]); f32x2 d2 = (f32x2){0.f, 0.f}; \
                _Pragma("unroll") for (int m = 0; m < 16; ++m) d2 += (f32x2){dd[2 * m], dd[2 * m + 1]} * hp[m]; \
                const float d = wave_sum_dpp(d2.x + d2.y); dsel = (lane == j) ? d : dsel; } \
            const float av = gelu_fast(dsel * (rs * (1.f / U6_SCALE))) * (1.f / V6_SCALE); \
            _Pragma("unroll") for (int j = 0; j < 4; ++j) { const int e = (grp) * 4 + j; \
                const float a = __int_as_float(__builtin_amdgcn_readlane(__float_as_int(av), j)) * __int_as_float(__builtin_amdgcn_readlane(__float_as_int(e < 64 ? gt0 : gt1), e & 63)); \
                const f32x2 a2 = (f32x2){a, a}; const f32x32 dd = G_DEC(vbA[j], vbB[j]); \
                _Pragma("unroll") for (int m = 0; m < 16; ++m) op[m] += a2 * (f32x2){dd[2 * m], dd[2 * m + 1]}; } \
        } while (0)
        G_LOADU(uaA, uaB, 0);
#pragma unroll 1
        for (int g2 = 0; g2 < 32; g2 += 2) { G_BODY(uaA, uaB, ubA, ubB, g2); G_BODY(ubA, ubB, uaA, uaB, g2 + 1); }
#undef G_LOADU
#undef G_LOADV
#undef G_DEC
#undef G_BODY
        float ss = 0.f;
#pragma unroll
        for (int m = 0; m < 16; ++m) ss += op[m].x * op[m].x + op[m].y * op[m].y;
        ss = wave_sum_dpp(ss);
        const float scl = rsqrtf(ss * (1.f / 2048.f) + 1e-6f);
#pragma unroll
        for (int j = 0; j < 8; ++j) { const float4 g = *(const float4*)(nf + (j * 64 + lane) * 4);
            *(float4*)(p.out + (size_t)t * D_ + (j * 64 + lane) * 4) = make_float4(op[2 * j].x * scl * g.x, op[2 * j].y * scl * g.y, op[2 * j + 1].x * scl * g.z, op[2 * j + 1].y * scl * g.w); }
    }
#undef GT_META
}

#define PEER_LD6(dstA, dstB, base, id) do { const unsigned char* _q = (base) + ((size_t)xs * 16384 + (id)) * 192 + pt * 24; dstA = *(const u32x4*)_q; dstB = *(const u32x2*)(_q + 16); } while (0)
#define PEER_DEC(A, B) __builtin_amdgcn_cvt_scalef32_pk32_f32_fp6((u32x6){A[0], A[1], A[2], A[3], B[0], B[1]}, 1.0f)
__device__ __forceinline__ void phase_peerZ(const Params& p) {
    const float* X1 = (const float*)(p.ws + WS_X1); const unsigned char* U6 = p.ws + WS_UB; const int* IDS = (const int*)(p.ws + WS_IDS);
    float* ZP = (float*)(p.ws + WS_ZP);
    const int lane = threadIdx.x & 63, w = threadIdx.x >> 6, es = lane >> 3, pt = lane & 7;
    const int xs = blockIdx.x & 7, nwg = (gridDim.x >> 3) * 8;
    int t = (blockIdx.x >> 3) * 8 + w;
    if (t >= S_) return;
    float4 nh[8];
#pragma unroll
    for (int j = 0; j < 8; ++j) nh[j] = *(const float4*)(X1 + (size_t)t * D_ + xs * 256 + (j * 8 + pt) * 4);
    int cid0 = IDS[(size_t)t * 128 + lane], cid1 = IDS[(size_t)t * 128 + 64 + lane], nid0 = 0, nid1 = 0;
    if (t + nwg < S_) { nid0 = IDS[(size_t)(t + nwg) * 128 + lane]; nid1 = IDS[(size_t)(t + nwg) * 128 + 64 + lane]; }
    u32x4 bA[8]; u32x2 bB[8];
#pragma unroll
    for (int g = 0; g < 8; ++g) { const int id = __shfl(cid0, g * 8 + es); PEER_LD6(bA[g], bB[g], U6, id); }
    for (; t < S_; t += nwg) {
        f32x2 hp[16];
#pragma unroll
        for (int j = 0; j < 8; ++j) { hp[2 * j] = (f32x2){nh[j].x, nh[j].y}; hp[2 * j + 1] = (f32x2){nh[j].z, nh[j].w}; }
        const bool has_next = (t + nwg < S_);
        if (has_next) {
#pragma unroll
            for (int j = 0; j < 8; ++j) nh[j] = *(const float4*)(X1 + (size_t)(t + nwg) * D_ + xs * 256 + (j * 8 + pt) * 4); }
        int n2id0 = 0, n2id1 = 0;
        if (t + 2 * nwg < S_) { n2id0 = IDS[(size_t)(t + 2 * nwg) * 128 + lane]; n2id1 = IDS[(size_t)(t + 2 * nwg) * 128 + 64 + lane]; }
#pragma unroll
        for (int g = 0; g < 16; ++g) {
            const f32x32 dd = PEER_DEC(bA[g & 7], bB[g & 7]);
            if (g + 8 < 16) { const int id = __shfl(cid1, ((g + 8) * 8 + es) & 63); PEER_LD6(bA[g & 7], bB[g & 7], U6, id); }
            else if (has_next) { const int id = __shfl(nid0, (g - 8) * 8 + es); PEER_LD6(bA[g & 7], bB[g & 7], U6, id); }
            f32x2 d2 = (f32x2){0.f, 0.f};
#pragma unroll
            for (int m = 0; m < 16; ++m) d2 += (f32x2){dd[2 * m], dd[2 * m + 1]} * hp[m];
            float d = d2.x + d2.y;
            d += dpp_f<0xB1, 0xf>(d); d += dpp_f<0x4E, 0xf>(d); d += dpp_f<0x141, 0xf>(d);
            if (pt == 0) ZP[((size_t)t * 8 + xs) * 128 + g * 8 + es] = d;
        }
        cid0 = nid0; cid1 = nid1; nid0 = n2id0; nid1 = n2id1;
    }
}
__device__ __forceinline__ void phase_peerV(const Params& p, LAS unsigned char* lds) {
    const float* X1 = (const float*)(p.ws + WS_X1); const unsigned char* V6 = p.ws + WS_VB; const int* IDS = (const int*)(p.ws + WS_IDS);
    const float* GATES = (const float*)(p.ws + WS_GATES); const float* ZP = (const float*)(p.ws + WS_ZP); const float* SSQ = (const float*)(p.ws + WS_SSQ);
    float* X2 = (float*)(p.ws + WS_X2); float* SSQ2 = (float*)(p.ws + WS_SSQ2);
    const int lane = threadIdx.x & 63, w = threadIdx.x >> 6, es = lane >> 3, pt = lane & 7;
    const int xs = blockIdx.x & 7, nwg = (gridDim.x >> 3) * 8;
    LAS float* red = (LAS float*)(lds + w * 8192);
    int t = (blockIdx.x >> 3) * 8 + w;
    if (t >= S_) return;
    float nz0 = 0.f, nz1 = 0.f, ng0 = 0.f, ng1 = 0.f, nsq = 0.f;
#define PV_META(tt) do { ng0 = GATES[(size_t)(tt) * 128 + lane]; ng1 = GATES[(size_t)(tt) * 128 + 64 + lane]; nsq = (lane < 32) ? SSQ[(size_t)(tt) * 32 + lane] : 0.f; \
        float _a = 0.f, _b = 0.f; _Pragma("unroll") for (int x = 0; x < 8; ++x) { _a += ZP[((size_t)(tt) * 8 + x) * 128 + lane]; _b += ZP[((size_t)(tt) * 8 + x) * 128 + 64 + lane]; } nz0 = _a; nz1 = _b; } while (0)
    PV_META(t);
    asm volatile("" : "+v"(nz0), "+v"(nz1), "+v"(ng0), "+v"(ng1), "+v"(nsq));
    int cid0 = IDS[(size_t)t * 128 + lane], cid1 = IDS[(size_t)t * 128 + 64 + lane], nid0 = 0, nid1 = 0;
    if (t + nwg < S_) { nid0 = IDS[(size_t)(t + nwg) * 128 + lane]; nid1 = IDS[(size_t)(t + nwg) * 128 + 64 + lane]; }
    u32x4 bA[4]; u32x2 bB[4];
#pragma unroll
    for (int g = 0; g < 4; ++g) { const int id = __shfl(cid0, g * 8 + es); PEER_LD6(bA[g], bB[g], V6, id); }
    f32x4 nx1 = *(const f32x4*)(X1 + (size_t)t * D_ + xs * 256 + (es * 8 + pt) * 4);
    for (; t < S_; t += nwg) {
        const float z0 = nz0, z1 = nz1, g0 = ng0, g1 = ng1, sq = nsq; const f32x4 x1v = nx1;
        const bool has_next = (t + nwg < S_);
        const float rs = rsqrtf(wave_sum_dpp(sq) * (1.0f / 2048.0f) + 1e-6f);
        const float a0 = gelu_fast(z0 * (rs * (1.f / U6_SCALE))) * g0 * (1.f / V6_SCALE);
        const float a1 = gelu_fast(z1 * (rs * (1.f / U6_SCALE))) * g1 * (1.f / V6_SCALE);
        f32x2 op[16];
#pragma unroll
        for (int m = 0; m < 16; ++m) op[m] = (f32x2){0.f, 0.f};
#pragma unroll
        for (int g = 0; g < 16; ++g) {
            const f32x32 dd = PEER_DEC(bA[g & 3], bB[g & 3]);
            if (g + 4 < 16) { const int id = __shfl((g + 4) < 8 ? cid0 : cid1, ((g + 4) * 8 + es) & 63); PEER_LD6(bA[g & 3], bB[g & 3], V6, id); }
            else if (has_next) { const int id = __shfl(nid0, (g - 12) * 8 + es); PEER_LD6(bA[g & 3], bB[g & 3], V6, id); }
            const float a = __shfl(g < 8 ? a0 : a1, (g * 8 + es) & 63);
            const f32x2 a2 = (f32x2){a, a};
#pragma unroll
            for (int m = 0; m < 16; ++m) op[m] += a2 * (f32x2){dd[2 * m], dd[2 * m + 1]};
        }
        int n2id0 = 0, n2id1 = 0;
        if (has_next) { PV_META(t + nwg); nx1 = *(const f32x4*)(X1 + (size_t)(t + nwg) * D_ + xs * 256 + (es * 8 + pt) * 4); }
        if (t + 2 * nwg < S_) { n2id0 = IDS[(size_t)(t + 2 * nwg) * 128 + lane]; n2id1 = IDS[(size_t)(t + 2 * nwg) * 128 + 64 + lane]; }
#pragma unroll
        for (int k4 = 0; k4 < 8; ++k4) *(LAS f32x4*)(red + ((es * 8 + k4) * 8 + pt) * 4) = (f32x4){op[2 * k4].x, op[2 * k4].y, op[2 * k4 + 1].x, op[2 * k4 + 1].y};
        f32x4 sum = x1v;
#pragma unroll
        for (int e2 = 0; e2 < 8; ++e2) sum += *(const LAS f32x4*)(red + ((e2 * 8 + es) * 8 + pt) * 4);
        *(f32x4*)(X2 + (size_t)t * D_ + xs * 256 + (es * 8 + pt) * 4) = sum;
        const float ss = wave_sum_dpp(sum[0] * sum[0] + sum[1] * sum[1] + sum[2] * sum[2] + sum[3] * sum[3]);
        if (lane == 0) SSQ2[(size_t)t * 8 + xs] = ss;
        cid0 = nid0; cid1 = nid1; nid0 = n2id0; nid1 = n2id1;
    }
#undef PV_META
}
__device__ __forceinline__ void phase_final(const Params& p) {
    const float* X2 = (const float*)(p.ws + WS_X2); const float* SSQ2 = (const float*)(p.ws + WS_SSQ2); const float* nf = p.in[25];
    const int lane = threadIdx.x & 63, w = threadIdx.x >> 6;
    for (int t = blockIdx.x * 8 + w; t < S_; t += gridDim.x * 8) {
        const f32x4 s0 = *(const f32x4*)(SSQ2 + (size_t)t * 8), s1 = *(const f32x4*)(SSQ2 + (size_t)t * 8 + 4);
        const float scl = rsqrtf(((s0[0] + s0[1]) + (s0[2] + s0[3]) + (s1[0] + s1[1]) + (s1[2] + s1[3])) * (1.f / 2048.f) + 1e-6f);
#pragma unroll
        for (int j = 0; j < 8; ++j) { const float4 v = *(const float4*)(X2 + (size_t)t * D_ + (j * 64 + lane) * 4); const float4 g = *(const float4*)(nf + (j * 64 + lane) * 4);
            *(float4*)(p.out + (size_t)t * D_ + (j * 64 + lane) * 4) = make_float4(v.x * scl * g.x, v.y * scl * g.y, v.z * scl * g.z, v.w * scl * g.w); }
    }
}

#define XB_TMO      128
#define XB_XCNT(j)  (256  + 64 * (j))
#define XB_XSUB(j)  (1280 + 64 * (j))
#define XB_XGEN(j)  (2304 + 64 * (j))
#define XB_TOP      3328
#define XB_TOPGEN   3392
#define XCD_BAR_WORDS 3456
#define XB_SPIN_CAP (1u << 18)
__device__ __forceinline__ unsigned xb_ld(unsigned* p)              { return __hip_atomic_load(p, __ATOMIC_RELAXED, __HIP_MEMORY_SCOPE_AGENT); }
__device__ __forceinline__ unsigned xb_add(unsigned* p, unsigned v) { return __hip_atomic_fetch_add(p, v, __ATOMIC_RELAXED, __HIP_MEMORY_SCOPE_AGENT); }
__device__ __forceinline__ unsigned xb_xcc_id() { return (unsigned)__builtin_amdgcn_s_getreg((3 << 11) | 20) & 0xFu; }
#define XB_SPIN(cond, bar) do { unsigned _sp = 0; while (cond) { __builtin_amdgcn_s_sleep(1); \
    if ((++_sp & 255u) == 0u) { if (xb_ld(&(bar)[XB_TMO])) break; if (_sp > XB_SPIN_CAP) { atomicAdd(&(bar)[XB_TMO], 1u); break; } } } } while (0)
struct XcdBarrier { unsigned* bar; unsigned x; volatile LAS unsigned* st; };
__device__ __forceinline__ XcdBarrier xcd_barrier_post(unsigned* bar, volatile LAS unsigned* st) {
    XcdBarrier b; b.bar = bar; b.x = xb_xcc_id(); b.st = st;
    if (threadIdx.x == 0) (void)xb_add(&bar[XB_XCNT(b.x)], 1u);
    return b;
}
__device__ __forceinline__ void xcd_barrier_complete(unsigned* bar, unsigned x, unsigned& nloc, unsigned& nx) {
    const unsigned G = gridDim.x * gridDim.y * gridDim.z;
    unsigned sum, cnt, mine, sp = 0u;
    for (;;) {
        sum = 0u; cnt = 0u; mine = 0u;
#pragma unroll
        for (unsigned j = 0; j < 16; ++j) { const unsigned c = xb_ld(&bar[XB_XCNT(j)]); sum += c; cnt += (c > 0u) ? 1u : 0u; mine = (j == x) ? c : mine; }
        if (sum == G) break;
        __builtin_amdgcn_s_sleep(1);
        if ((++sp & 255u) == 0u) { if (xb_ld(&bar[XB_TMO])) break; if (sp > XB_SPIN_CAP) { atomicAdd(&bar[XB_TMO], 1u); break; } }
    }
    nloc = mine > 0u ? mine : 1u; nx = cnt > 0u ? cnt : 1u;
}
__device__ __forceinline__ void xcd_barrier(const XcdBarrier& b) {
    asm volatile("s_waitcnt vmcnt(0)" ::: "memory");
    __syncthreads();
    if (threadIdx.x == 0) {
        unsigned* bar = b.bar;
        __builtin_amdgcn_s_waitcnt(0);
        unsigned nloc = b.st[0], nx = b.st[1];
        if (nloc == 0u) { xcd_barrier_complete(bar, b.x, nloc, nx); b.st[0] = nloc; b.st[1] = nx; }
        const unsigned old = xb_add(&bar[XB_XSUB(b.x)], 1u);
        const unsigned gen = old / nloc;
        if (old + 1u == (gen + 1u) * nloc) {
            __builtin_amdgcn_fence(__ATOMIC_RELEASE, "agent");
            asm volatile("s_waitcnt vmcnt(0)" ::: "memory");
            const unsigned og = xb_add(&bar[XB_TOP], 1u);
            const unsigned tg = og / nx;
            if (og + 1u == (tg + 1u) * nx) xb_add(&bar[XB_TOPGEN], 1u);
            else XB_SPIN(xb_ld(&bar[XB_TOPGEN]) == tg, bar);
            __builtin_amdgcn_fence(__ATOMIC_ACQUIRE, "agent");
            xb_add(&bar[XB_XGEN(b.x)], 1u);
            asm volatile("s_waitcnt vmcnt(0)" ::: "memory");
        } else {
            XB_SPIN(xb_ld(&bar[XB_XGEN(b.x)]) == gen, bar);
            __builtin_amdgcn_fence(__ATOMIC_ACQUIRE, "agent");
            asm volatile("s_waitcnt vmcnt(0)" ::: "memory");
        }
    }
    __syncthreads();
}

__global__ void __launch_bounds__(512, 2) mega(Params p) {
    extern __shared__ __attribute__((aligned(16))) unsigned char shm[];
    cg::grid_group grid = cg::this_grid();
    LAS unsigned char* lds = (LAS unsigned char*)shm;
    volatile LAS unsigned* bst = (volatile LAS unsigned*)(lds + LDS_BYTES - 16);
    if (threadIdx.x == 0) { bst[0] = 0u; bst[1] = 0u; }
    __syncthreads();
    const XcdBarrier xbar = xcd_barrier_post((unsigned*)(p.ws + WS_BAR), bst);
    if (p.ph_hi > 1000) grid.sync();
    const int lo = p.ph_lo, hi = p.ph_hi;
#define IN(k) (lo <= (k) && (k) < hi)
#define REP(k) for (int _r = 0; _r < ((k) == DUP_PHASE ? 2 : 1); ++_r)
#define SEAM(k) do { if (IN(k) && IN((k) + 1)) xcd_barrier(xbar); } while (0)
    if (IN(0)) REP(0) { if (_r) xcd_barrier(xbar); phase0(p, shm); }
    SEAM(0);
    if (IN(1)) REP(1) { if (_r) xcd_barrier(xbar);
        pg8::Gemm g{(const bf16_t*)(p.ws + WS_H), (const bf16_t*)(p.ws + WS_WB1), S_, NAUG, 2048};
        pg8::StaticOrder so; so.init(g.M, g.N, (int)gridDim.x, (int)blockIdx.x);
        pg8::EpiBf16 E{(bf16_t*)(p.ws + WS_PROJ), NAUG};
        pg8::gemm_phase(lds, g, so, E);
    }
    SEAM(1);
    if (IN(2)) REP(2) { if (_r) xcd_barrier(xbar);
        phase_prepM(p, lds);
        phase_prepE(p);
    }
    SEAM(2);
    if (IN(3)) REP(3) { if (_r) xcd_barrier(xbar); phase_chunkA(p, lds); }
    SEAM(3);
    if (IN(4)) REP(4) { if (_r) xcd_barrier(xbar); if (blockIdx.x < 64) phase_seq(p);
        else { const int bid = blockIdx.x - 64, nblk = gridDim.x - 64;
            convert_fp6s(p.in[23], p.ws + WS_UB, 16384, U6_SCALE, p.in[20], bid, nblk);
            convert_fp6s(p.in[24], p.ws + WS_VB, 16384, V6_SCALE, nullptr, bid, nblk);
            build_wpt(p.in[21], p.in[20], (const bf16_t*)(p.ws + WS_KEYB), (bf16_t*)(p.ws + WS_WQT), bid, nblk);
            transpose_convert(p.in[19], 2048, 2048, (bf16_t*)(p.ws + WS_WOT), (float*)shm, bid, nblk); } }
    SEAM(4);
    if (IN(5)) REP(5) { if (_r) xcd_barrier(xbar); phase_chunkY(p, lds); }
    SEAM(5);
    if (IN(6)) REP(6) { if (_r) xcd_barrier(xbar);
        pg8::Gemm g{(const bf16_t*)(p.ws + WS_YMIX), (const bf16_t*)(p.ws + WS_WOT), S_, 2048, 2048};
        pg8::StaticOrder so; so.init(g.M, g.N, (int)gridDim.x, (int)blockIdx.x);
        pg8::EpiRes2 E{(float*)(p.ws + WS_X1), p.in[0], (bf16_t*)(p.ws + WS_H2), (float*)(p.ws + WS_SSQ), 2048};
        pg8::gemm_phase(lds, g, so, E);
    }
    SEAM(6);
    if (IN(8)) REP(8) { if (_r) xcd_barrier(xbar);
        pg8::Gemm g{(const bf16_t*)(p.ws + WS_H2), (const bf16_t*)(p.ws + WS_WQT), S_, 2048, 2048};
        pg8::StaticOrder so; so.init(g.M, g.N, (int)gridDim.x, (int)blockIdx.x);
        pg8::EpiRowScaleF32 E{(float*)(p.ws + WS_Q), (const float*)(p.ws + WS_SSQ), 2048};
        pg8::gemm_phase(lds, g, so, E);
    }
    SEAM(8);
    if (IN(9)) REP(9) { if (_r) xcd_barrier(xbar); phase_topk(p, shm); }
    SEAM(9);
    if (IN(10)) REP(10) { if (_r) xcd_barrier(xbar); phase_peerZ(p); }
    SEAM(10);
    if (IN(11)) REP(11) { if (_r) xcd_barrier(xbar); phase_peerV(p, lds); }
    SEAM(11);
    if (IN(12)) REP(12) { if (_r) xcd_barrier(xbar); phase_final(p); }
#undef IN
#undef REP
#undef SEAM
}

extern "C" void kernel_launch(void* const* d_in, const int* in_sizes, int n_in, void* d_out, int out_size, void* d_ws, size_t ws_size, hipStream_t stream) {
    static int grid_blocks = 0;
    if (grid_blocks == 0) {
        if (n_in != 26 || ws_size < WS_NEED) { fprintf(stderr, "kernel_launch: unexpected n_in %d / ws_size %zu\n", n_in, ws_size); grid_blocks = -1; return; }
        int dev = 0, cus = 0, per_cu = 0;
        (void)hipGetDevice(&dev);
        (void)hipDeviceGetAttribute(&cus, hipDeviceAttributeMultiprocessorCount, dev);
        (void)hipFuncSetAttribute((const void*)mega, hipFuncAttributeMaxDynamicSharedMemorySize, LDS_BYTES);
        (void)hipOccupancyMaxActiveBlocksPerMultiprocessor(&per_cu, (const void*)mega, 512, LDS_BYTES);
        if (per_cu < 1) { fprintf(stderr, "kernel_launch: occupancy query says %d blocks/CU\n", per_cu); per_cu = 1; }
        grid_blocks = cus * per_cu;
        fprintf(stderr, "kernel_launch: cus %d per_cu %d grid %d\n", cus, per_cu, grid_blocks);
    }
    if (grid_blocks < 0) return;
    Params p{};
    for (int i = 0; i < 26; ++i) p.in[i] = (const float*)d_in[i];
    p.out = (float*)d_out; p.ws = (unsigned char*)d_ws;
#if MULTI_LAUNCH
    for (int ph = 0; ph < NPHASE; ++ph) {
        p.ph_lo = ph; p.ph_hi = ph + 1;
        hipLaunchKernelGGL(mega, dim3(grid_blocks), dim3(512), LDS_BYTES, stream, p);
    }
#else
    p.ph_lo = 0; p.ph_hi = NPHASE;
    if (hipMemsetAsync((unsigned char*)d_ws + WS_BAR, 0, XCD_BAR_WORDS * 4, stream) != hipSuccess) fprintf(stderr, "kernel_launch: barrier memset failed\n");
    void* args[] = {&p};
    hipError_t e = hipLaunchCooperativeKernel((const void*)mega, dim3(grid_blocks), dim3(512), args, LDS_BYTES, stream);
    if (e != hipSuccess) fprintf(stderr, "cooperative launch failed: %s (grid %d)\n", hipGetErrorString(e), grid_blocks);
#endif
}
```
